# Optimizing an MI355X kernel written in HIP

```python
import math
import jax, jax.numpy as jnp
from jax import lax
import numpy as np

D_MODEL = 1024
BATCH = 2
SEQ = 16384
DEPTH = 4

HEAD_DIM = 64
BRANCH_WIDTH = 8 * HEAD_DIM
RWKV_HEADS = BRANCH_WIDTH // HEAD_DIM
RWKV_WIDTH = BRANCH_WIDTH
RWKV_W_LORA = 64
RWKV_A_LORA = 64
RWKV_G_LORA = 128
RWKV_LN_EPS = 64e-5
NSA_HEADS = BRANCH_WIDTH // HEAD_DIM
NSA_KV_GROUPS = 2
NSA_WIDTH = BRANCH_WIDTH
NSA_KV_WIDTH = NSA_KV_GROUPS * HEAD_DIM
CMP_STRIDE = 16
CMP_LEN = 2 * CMP_STRIDE
CMP_HIDDEN = 256
SEL_BLOCK = 64
SEL_TOPK = 16
SEL_OVERLAP_W = (1.0, 2.0, 2.0, 2.0, 1.0)
SEL_FORCE_SCORE = 1e4
NSA_WINDOW = 512
Q_BLOCK = 128
SWA_HEADS = BRANCH_WIDTH // HEAD_DIM
SWA_KV_HEADS = 2
SWA_WIDTH = BRANCH_WIDTH
SWA_KV_WIDTH = SWA_KV_HEADS * HEAD_DIM
SWA_WINDOW = 128
REL_BUCKETS = 32
REL_MAX_DIST = 1024
FFN_HIDDEN = ((8 * D_MODEL + 3 * 256 - 1) // (3 * 256)) * 256
N_BRANCHES = 3
NORM_EPS = 1e-6
NEG_INF = -1e30
RWKV_COLS = 3 * RWKV_WIDTH + RWKV_W_LORA + RWKV_A_LORA + RWKV_G_LORA
NSA_COLS = NSA_WIDTH + 6 * NSA_KV_WIDTH + 3 * NSA_HEADS
SWA_COLS = SWA_WIDTH + 2 * SWA_KV_WIDTH
GATE_COLS = N_BRANCHES * D_MODEL
IN_COLS = RWKV_COLS + NSA_COLS + SWA_COLS + GATE_COLS

kernel_name = "hybrid_rwkv7_nsa_swa_gated_trunk"


def _split(x, sizes):
    idx = [int(v) for v in np.cumsum(sizes)[:-1]]
    return jnp.split(x, idx, axis=-1)


def rms_norm(x, g):
    xf = x.astype(jnp.float32)
    y = xf * lax.rsqrt(jnp.mean(xf * xf, axis=-1, keepdims=True) + NORM_EPS)
    return (y * g.astype(jnp.float32)).astype(x.dtype)


def t5_bucket(dist):
    n = jnp.maximum(dist, 0)
    max_exact = REL_BUCKETS // 2
    nf = jnp.maximum(n, 1).astype(jnp.float32)
    large = max_exact + (jnp.log(nf / max_exact) / math.log(REL_MAX_DIST / max_exact)
                         * (REL_BUCKETS - max_exact)).astype(jnp.int32)
    large = jnp.minimum(large, REL_BUCKETS - 1)
    return jnp.where(n < max_exact, n, large)


def rel_bias_2d(table, dist, groups):
    b = table[t5_bucket(dist)].astype(jnp.float32)
    return b.reshape(dist.shape + (groups, -1)).transpose(2, 3, 0, 1)


def masked_softmax(s, mask, sink=None):
    s = jnp.where(mask, s, NEG_INF)
    m = jnp.max(s, axis=-1, keepdims=True)
    if sink is not None:
        m = jnp.maximum(m, sink)
    p = jnp.where(mask, jnp.exp(s - m), 0.0)
    den = jnp.sum(p, axis=-1, keepdims=True)
    if sink is not None:
        den = den + jnp.exp(sink - m)
    return p / jnp.where(den > 0, den, 1.0)


def rwkv7_time_mix(p, mu, w0, w2, a0, a2, g2, k_k, k_a, r_k, ln_w, ln_b):
    B, T, _ = p.shape
    H, N = RWKV_HEADS, HEAD_DIM
    f32 = jnp.float32
    prev = jnp.pad(p, ((0, 0), (1, 0), (0, 0)))[:, :-1]
    p = p + (prev - p) * mu
    r, k, v, zw, za, zg = _split(p, (RWKV_WIDTH,) * 3 + (RWKV_W_LORA, RWKV_A_LORA, RWKV_G_LORA))
    w = -jax.nn.softplus(-(w0 + jnp.tanh(zw) @ w2).astype(f32)) - 0.5
    decay = jnp.exp(-jnp.exp(w))
    a = jax.nn.sigmoid((a0 + za @ a2).astype(f32))
    g = jax.nn.sigmoid(zg) @ g2
    kk = (k * k_k).astype(f32).reshape(B, T, H, N)
    kk = kk / jnp.maximum(jnp.sqrt(jnp.sum(kk * kk, axis=-1, keepdims=True)), 1e-12)
    k = k.astype(f32) * (1.0 + (a - 1.0) * k_a.astype(f32))

    def heads(z):
        return z.astype(f32).reshape(B, T, H, N)
    r_h, w_h, k_h, v_h, a_h = heads(r), heads(decay), heads(k), heads(v), heads(a)
    xs = tuple(jnp.swapaxes(z, 0, 1) for z in (r_h, w_h, k_h, v_h, -kk, kk * a_h))

    def step(S, inp):
        r_t, w_t, k_t, v_t, a_t, b_t = inp
        sa = jnp.einsum('bhij,bhj->bhi', S, a_t)
        S = S * w_t[:, :, None, :] + sa[..., None] * b_t[:, :, None, :] + v_t[..., None] * k_t[:, :, None, :]
        y = jnp.einsum('bhij,bhj->bhi', S, r_t)
        return S, y

    S0 = jnp.zeros((B, H, N, N), f32)
    _, y = lax.scan(step, S0, xs)
    y = jnp.swapaxes(y, 0, 1)
    mean = jnp.mean(y, axis=-1, keepdims=True)
    var = jnp.mean(jnp.square(y - mean), axis=-1, keepdims=True)
    y = ((y - mean) * lax.rsqrt(var + RWKV_LN_EPS)).reshape(B, T, RWKV_WIDTH)
    y = y * ln_w.astype(f32) + ln_b.astype(f32)
    bonus = jnp.sum(r_h * k_h * r_k.astype(f32), axis=-1, keepdims=True) * v_h
    y = y + bonus.reshape(B, T, RWKV_WIDTH)
    return (y * g.astype(f32)).astype(p.dtype)


def nsa_mix(p, pe_k, pe_v, ck_w1, ck_w2, cv_w1, cv_w2, rel_tbl):
    B, T, _ = p.shape
    G, R, N = NSA_KV_GROUPS, NSA_HEADS // NSA_KV_GROUPS, HEAD_DIM
    f32 = jnp.float32
    q, kc, vc, ks, vs, kw, vw, gl = _split(p, (NSA_WIDTH,) + (NSA_KV_WIDTH,) * 6 + (3 * NSA_HEADS,))
    nq = T // Q_BLOCK
    n_cmp = T // CMP_STRIDE - 1
    n_sel = T // SEL_BLOCK
    topk = min(SEL_TOPK, n_sel)
    sel_per_cmp = SEL_BLOCK // CMP_STRIDE

    def compress(z, pe, w1, w2):
        c = z.reshape(B, T // CMP_STRIDE, CMP_STRIDE, G, N)
        blk = jnp.concatenate([c[:, :-1], c[:, 1:]], axis=2) + pe[None, None, :, None, :]
        blk = blk.transpose(0, 3, 1, 2, 4).reshape(B, G, n_cmp, CMP_LEN * N)
        return jax.nn.gelu(blk @ w1) @ w2

    k_cmp = compress(kc, pe_k, ck_w1, ck_w2)
    v_cmp = compress(vc, pe_v, cv_w1, cv_w2)
    cmp_end = jnp.arange(n_cmp) * CMP_STRIDE + (CMP_LEN - 1)

    k_sel = ks.reshape(B, n_sel, SEL_BLOCK, G, N).transpose(0, 3, 1, 2, 4)
    v_sel = vs.reshape(B, n_sel, SEL_BLOCK, G, N).transpose(0, 3, 1, 2, 4)
    pad = ((0, 0), (NSA_WINDOW, 0), (0, 0), (0, 0))
    k_win = jnp.pad(kw.reshape(B, T, G, N), pad)
    v_win = jnp.pad(vw.reshape(B, T, G, N), pad)

    q_blk = (q * HEAD_DIM ** -0.5).reshape(B, nq, Q_BLOCK, G, R, N).transpose(1, 0, 3, 4, 2, 5)
    gates = jax.nn.sigmoid(gl.astype(f32)).reshape(B, nq, Q_BLOCK, 3, G, R).transpose(1, 0, 3, 4, 5, 2)
    tbl_g = rel_tbl.reshape(REL_BUCKETS, G, R).transpose(1, 0, 2).astype(f32)
    b_idx = jnp.arange(B)[:, None, None, None]
    g_idx = jnp.arange(G)[None, :, None, None]
    sel_ids = jnp.arange(n_sel)

    def one_block(args):
        qb, gb, blk = args
        t = blk * Q_BLOCK + jnp.arange(Q_BLOCK)
        dist_c = t[:, None] - cmp_end[None, :]
        s_c = jnp.einsum('bgrqd,bgcd->bgrqc', qb, k_cmp).astype(f32) + rel_bias_2d(rel_tbl, dist_c, G)
        p_c = masked_softmax(s_c, dist_c >= 0)
        o_c = jnp.einsum('bgrqc,bgcd->bgrqd', p_c.astype(v_cmp.dtype), v_cmp)
        imp = jnp.pad(jnp.sum(p_c, axis=2), ((0, 0), (0, 0), (0, 0), (1, sel_per_cmp)))
        imp = sum(wt * lax.slice_in_dim(imp, o, o + sel_per_cmp * (n_sel - 1) + 1, stride=sel_per_cmp, axis=3)
                  for o, wt in enumerate(SEL_OVERLAP_W))
        cur = (t // SEL_BLOCK)[:, None]
        sid = sel_ids[None, :]
        forced = (sid == 0) | (sid == cur) | (sid == cur - 1)
        score = jnp.where(forced, SEL_FORCE_SCORE, jnp.where(sid <= cur, imp, -1.0))
        _, sel = lax.top_k(score, topk)
        k_g = k_sel[b_idx, g_idx, sel].reshape(B, G, Q_BLOCK, topk * SEL_BLOCK, N)
        v_g = v_sel[b_idx, g_idx, sel].reshape(B, G, Q_BLOCK, topk * SEL_BLOCK, N)
        pos = (sel[..., None] * SEL_BLOCK + jnp.arange(SEL_BLOCK)).reshape(B, G, Q_BLOCK, topk * SEL_BLOCK)
        dist_s = t[None, None, :, None] - pos
        bias_s = jnp.moveaxis(tbl_g[g_idx, t5_bucket(dist_s)], -1, 2)
        s_s = jnp.einsum('bgrqd,bgqmd->bgrqm', qb, k_g).astype(f32) + bias_s
        p_s = masked_softmax(s_s, (dist_s >= 0)[:, :, None])
        o_s = jnp.einsum('bgrqm,bgqmd->bgrqd', p_s.astype(v_g.dtype), v_g)
        start = blk * Q_BLOCK
        k_w = lax.dynamic_slice_in_dim(k_win, start, Q_BLOCK + NSA_WINDOW, axis=1)
        v_w = lax.dynamic_slice_in_dim(v_win, start, Q_BLOCK + NSA_WINDOW, axis=1)
        spos = start - NSA_WINDOW + jnp.arange(Q_BLOCK + NSA_WINDOW)
        dist_w = t[:, None] - spos[None, :]
        mask_w = (dist_w >= 0) & (dist_w < NSA_WINDOW) & (spos[None, :] >= 0)
        s_w = jnp.einsum('bgrqd,bsgd->bgrqs', qb, k_w).astype(f32) + rel_bias_2d(rel_tbl, dist_w, G)
        p_w = masked_softmax(s_w, mask_w)
        o_w = jnp.einsum('bgrqs,bsgd->bgrqd', p_w.astype(v_w.dtype), v_w)
        gb = gb[..., None]
        out = gb[:, 0] * o_c + gb[:, 1] * o_s + gb[:, 2] * o_w
        return out.astype(qb.dtype)

    o = lax.map(one_block, (q_blk, gates, jnp.arange(nq)))
    return o.transpose(1, 0, 4, 2, 3, 5).reshape(B, T, NSA_WIDTH)


def swa_sink_mix(p, sinks, rel_tbl):
    B, T, _ = p.shape
    G, R, N, W = SWA_KV_HEADS, SWA_HEADS // SWA_KV_HEADS, HEAD_DIM, SWA_WINDOW
    f32 = jnp.float32
    q, k, v = _split(p, (SWA_WIDTH, SWA_KV_WIDTH, SWA_KV_WIDTH))
    nb = T // W
    q = (q * HEAD_DIM ** -0.5).reshape(B, nb, W, G, R, N)
    k = k.reshape(B, nb, W, G, N)
    v = v.reshape(B, nb, W, G, N)
    shift = ((0, 0), (1, 0), (0, 0), (0, 0), (0, 0))
    kb = jnp.concatenate([jnp.pad(k, shift)[:, :-1], k], axis=2)
    vb = jnp.concatenate([jnp.pad(v, shift)[:, :-1], v], axis=2)
    i = jnp.arange(W)
    j = jnp.arange(2 * W)
    dist = W + i[:, None] - j[None, :]
    valid_key = (jnp.arange(nb)[:, None] > 0) | (j[None, :] >= W)
    mask = ((dist >= 0) & (dist < W))[None] & valid_key[:, None, :]
    s = jnp.einsum('bnqgrd,bnkgd->bngrqk', q, kb).astype(f32) + rel_bias_2d(rel_tbl, dist, G)[None, None]
    sink = sinks.astype(f32).reshape(G, R)[None, None, :, :, None, None]
    pr = masked_softmax(s, mask[None, :, None, None], sink)
    o = jnp.einsum('bngrqk,bnkgd->bnqgrd', pr.astype(vb.dtype), vb)
    return o.reshape(B, T, SWA_WIDTH)


def setup_inputs(seed: int = 0) -> dict:
    key = jax.random.key(seed)
    ks = jax.random.split(key, 32)
    f32 = jnp.float32
    L, D = DEPTH, D_MODEL

    def nrm(k, shape, scale):
        return jax.random.normal(k, shape, f32) * scale

    def gain(k, shape):
        return 1.0 + nrm(k, shape, 0.1)

    return {
        "x": nrm(ks[0], (BATCH, SEQ, D), 1.0),
        "norm_pre_mix": gain(ks[1], (L, D)),
        "norm_post_mix": gain(ks[2], (L, D)),
        "norm_pre_ffn": gain(ks[3], (L, D)),
        "norm_post_ffn": gain(ks[4], (L, D)),
        "w_in": nrm(ks[5], (L, D, IN_COLS), D ** -0.5),
        "rwkv_mu": jax.random.uniform(ks[6], (L, RWKV_COLS), f32),
        "rwkv_w0": jax.random.uniform(ks[7], (L, RWKV_WIDTH), f32, -6.0, 0.0),
        "rwkv_w2": nrm(ks[8], (L, RWKV_W_LORA, RWKV_WIDTH), 0.5 * RWKV_W_LORA ** -0.5),
        "rwkv_a0": nrm(ks[9], (L, RWKV_WIDTH), 0.5),
        "rwkv_a2": nrm(ks[10], (L, RWKV_A_LORA, RWKV_WIDTH), RWKV_A_LORA ** -0.5),
        "rwkv_g2": nrm(ks[11], (L, RWKV_G_LORA, RWKV_WIDTH), RWKV_G_LORA ** -0.5),
        "rwkv_k_k": 0.85 + nrm(ks[12], (L, RWKV_WIDTH), 0.1),
        "rwkv_k_a": 1.0 + nrm(ks[13], (L, RWKV_WIDTH), 0.1),
        "rwkv_r_k": nrm(ks[14], (L, RWKV_HEADS, HEAD_DIM), 0.1),
        "rwkv_ln_w": gain(ks[15], (L, RWKV_WIDTH)),
        "rwkv_ln_b": nrm(ks[16], (L, RWKV_WIDTH), 0.02),
        "nsa_pe_k": nrm(ks[17], (L, CMP_LEN, HEAD_DIM), 0.1),
        "nsa_pe_v": nrm(ks[18], (L, CMP_LEN, HEAD_DIM), 0.1),
        "nsa_ck_w1": nrm(ks[19], (L, CMP_LEN * HEAD_DIM, CMP_HIDDEN), (CMP_LEN * HEAD_DIM) ** -0.5),
        "nsa_ck_w2": nrm(ks[20], (L, CMP_HIDDEN, HEAD_DIM), CMP_HIDDEN ** -0.5),
        "nsa_cv_w1": nrm(ks[21], (L, CMP_LEN * HEAD_DIM, CMP_HIDDEN), (CMP_LEN * HEAD_DIM) ** -0.5),
        "nsa_cv_w2": nrm(ks[22], (L, CMP_HIDDEN, HEAD_DIM), CMP_HIDDEN ** -0.5),
        "swa_sinks": nrm(ks[23], (L, SWA_HEADS), 1.0),
        "rel_bias": nrm(ks[24], (REL_BUCKETS, NSA_HEADS + SWA_HEADS), 0.5),
        "w_branch": nrm(ks[25], (L, N_BRANCHES, BRANCH_WIDTH, D), BRANCH_WIDTH ** -0.5),
        "w_out": nrm(ks[26], (L, D, D), D ** -0.5),
        "ffn_w_gate": nrm(ks[27], (L, D, FFN_HIDDEN), D ** -0.5),
        "ffn_w_up": nrm(ks[28], (L, D, FFN_HIDDEN), D ** -0.5),
        "ffn_w_down": nrm(ks[29], (L, FFN_HIDDEN, D), FFN_HIDDEN ** -0.5),
    }


def reference(x, norm_pre_mix, norm_post_mix, norm_pre_ffn, norm_post_ffn, w_in, rwkv_mu, rwkv_w0, rwkv_w2,
              rwkv_a0, rwkv_a2, rwkv_g2, rwkv_k_k, rwkv_k_a, rwkv_r_k, rwkv_ln_w, rwkv_ln_b, nsa_pe_k, nsa_pe_v,
              nsa_ck_w1, nsa_ck_w2, nsa_cv_w1, nsa_cv_w2, swa_sinks, rel_bias, w_branch, w_out,
              ffn_w_gate, ffn_w_up, ffn_w_down):
    B, T, D = x.shape
    rel_nsa = rel_bias[:, :NSA_HEADS]
    rel_swa = rel_bias[:, NSA_HEADS:]
    for l in range(DEPTH):
        h = rms_norm(x, norm_pre_mix[l])
        proj = h @ w_in[l]
        p_rwkv, p_nsa, p_swa, p_gate = _split(proj, (RWKV_COLS, NSA_COLS, SWA_COLS, GATE_COLS))
        o_rwkv = rwkv7_time_mix(p_rwkv, rwkv_mu[l], rwkv_w0[l], rwkv_w2[l], rwkv_a0[l], rwkv_a2[l],
                                rwkv_g2[l], rwkv_k_k[l], rwkv_k_a[l], rwkv_r_k[l], rwkv_ln_w[l], rwkv_ln_b[l])
        o_nsa = nsa_mix(p_nsa, nsa_pe_k[l], nsa_pe_v[l], nsa_ck_w1[l], nsa_ck_w2[l], nsa_cv_w1[l],
                        nsa_cv_w2[l], rel_nsa)
        o_swa = swa_sink_mix(p_swa, swa_sinks[l], rel_swa)
        gates = jax.nn.sigmoid(p_gate.astype(jnp.float32)).reshape(B, T, N_BRANCHES, D).astype(x.dtype)
        merged = (gates[:, :, 0] * (o_rwkv @ w_branch[l, 0])
                  + gates[:, :, 1] * (o_nsa @ w_branch[l, 1])
                  + gates[:, :, 2] * (o_swa @ w_branch[l, 2]))
        x = x + rms_norm(merged @ w_out[l], norm_post_mix[l])
        h = rms_norm(x, norm_pre_ffn[l])
        f = (jax.nn.silu(h @ ffn_w_gate[l]) * (h @ ffn_w_up[l])) @ ffn_w_down[l]
        x = x + rms_norm(f, norm_post_ffn[l])
    return x
```

```cpp
#include <hip/hip_runtime.h>
#include <stdint.h>
#include <stdio.h>

#ifndef MK_ONE_LAUNCH
#define MK_ONE_LAUNCH 0
#endif

#define LAS __attribute__((address_space(3)))
typedef unsigned short bf16_t;
typedef short bf16x8 __attribute__((ext_vector_type(8)));
typedef float f32x4 __attribute__((ext_vector_type(4)));
typedef float f32x2 __attribute__((ext_vector_type(2)));
typedef unsigned u32x4 __attribute__((ext_vector_type(4)));
typedef unsigned u32x2 __attribute__((ext_vector_type(2)));

constexpr int D = 1024, NBATCH = 2, T = 16384, DEPTH = 4, MROWS = NBATCH * T;
constexpr int IN_COLS = 6936, FFN = 2816;
constexpr int PLD = 4096;
constexpr int PC_R = 0, PC_K = 512, PC_V = 1024, PC_ZW = 1536, PC_ZA = 1600, PC_ZG = 1664;
constexpr int PC_NQ = 1792, PC_KC = 2304, PC_VC = 2432, PC_KS = 2560, PC_VS = 2688, PC_KW = 2816, PC_VW = 2944, PC_GL = 3072;
constexpr int PC_SQ = 3328, PC_SK = 3840, PC_SV = 3968;
constexpr int NIN = 7168;
constexpr int NCMP = 1023;
constexpr float NORM_EPS = 1e-6f;

constexpr size_t MiB = 1u << 20;
constexpr size_t WS_CTL = 0, CTL_BYTES = 1 * MiB;
constexpr size_t WS_WB = 1 * MiB;
constexpr size_t WB_WIN = 0, WB_WBR = WB_WIN + (size_t)NIN * D, WB_WOUT = WB_WBR + (size_t)3 * D * 512, WB_WGU = WB_WOUT + (size_t)D * D,
                 WB_WDN = WB_WGU + (size_t)2 * FFN * D, WB_END = WB_WDN + (size_t)D * FFN;
static_assert(WB_END * 2 <= 41 * MiB, "weights");
constexpr size_t WS_XB = 42 * MiB;
constexpr size_t WS_RS = 106 * MiB;
constexpr size_t WS_KCMP = 107 * MiB;
constexpr size_t WS_VCMP = WS_KCMP + 512 * 1024;
constexpr size_t WS_SEL = 108 * MiB;
constexpr size_t WS_ML = 110 * MiB;
constexpr size_t WS_HID = 112 * MiB;
constexpr size_t WS_BIG = 116 * MiB;
constexpr size_t WS_PROJ = WS_BIG;
constexpr size_t WS_GATES = WS_PROJ + 128 * MiB;
constexpr size_t WS_RWKVS = WS_GATES + 96 * MiB;
constexpr size_t WS_MERGED = WS_RWKVS;
constexpr size_t WS_TMPB = WS_RWKVS + 32 * MiB;
constexpr size_t WS_NSAACC = WS_RWKVS + 80 * MiB;
constexpr size_t WS_O = WS_NSAACC + 32 * MiB;
constexpr size_t WS_END = WS_O + 48 * MiB;
constexpr size_t WS_ACT = WS_BIG;
constexpr size_t WS_TMPF = WS_BIG + 176 * MiB;
static_assert(WS_END <= 512 * MiB, "workspace");
static_assert(WS_TMPF + 64 * MiB <= WS_NSAACC, "ffn overlay");

constexpr int LDS_BYTES = 147456;
constexpr int LDS_MISC = 131072 + 8192;

__device__ __forceinline__ float bf2f(unsigned v) { return __uint_as_float(v << 16); }
__device__ __forceinline__ unsigned f2bf(float f) { unsigned u = __float_as_uint(f); return (u + 0x7fffu + ((u >> 16) & 1u)) >> 16; }
__device__ __forceinline__ unsigned pk2(float lo, float hi) { unsigned r; asm volatile("v_cvt_pk_bf16_f32 %0, %1, %2" : "=v"(r) : "v"(lo), "v"(hi)); return r; }
__device__ __forceinline__ void unpack8(const u32x4 w, float (&f)[8]) {
    f[0] = __uint_as_float(w.x << 16); f[1] = __uint_as_float(w.x & 0xffff0000u); f[2] = __uint_as_float(w.y << 16); f[3] = __uint_as_float(w.y & 0xffff0000u);
    f[4] = __uint_as_float(w.z << 16); f[5] = __uint_as_float(w.z & 0xffff0000u); f[6] = __uint_as_float(w.w << 16); f[7] = __uint_as_float(w.w & 0xffff0000u);
}
__device__ __forceinline__ float wave_sum(float v) {
#pragma unroll
    for (int o = 32; o >= 1; o >>= 1) v += __shfl_xor(v, o);
    return v;
}
__device__ __forceinline__ float sigmoidf_(float x) { return 1.0f / (1.0f + __expf(-x)); }
__device__ __forceinline__ int t5_bucket(int n) {
    if (n < 16) return n;
    int b = 16;
    b += (n >= 21); b += (n >= 27); b += (n >= 35); b += (n >= 46); b += (n >= 59); b += (n >= 77); b += (n >= 99); b += (n >= 128);
    b += (n >= 166); b += (n >= 216); b += (n >= 280); b += (n >= 363); b += (n >= 470); b += (n >= 609); b += (n >= 790);
    return b;
}

#define XB_TMO      128
#define XB_XCNT(j)  (256  + 64 * (j))
#define XB_XSUB(j)  (1280 + 64 * (j))
#define XB_XGEN(j)  (2304 + 64 * (j))
#define XB_TOP      3328
#define XB_TOPGEN   3392
#define XCD_BAR_WORDS 3456
#define XB_SPIN_CAP (1u << 22)
__device__ __forceinline__ unsigned xb_ld(unsigned* p)              { return __hip_atomic_load(p, __ATOMIC_RELAXED, __HIP_MEMORY_SCOPE_AGENT); }
__device__ __forceinline__ unsigned xb_add(unsigned* p, unsigned v) { return __hip_atomic_fetch_add(p, v, __ATOMIC_RELAXED, __HIP_MEMORY_SCOPE_AGENT); }
__device__ __forceinline__ unsigned xb_xcc_id() { return (unsigned)__builtin_amdgcn_s_getreg((3 << 11) | 20) & 0xFu; }
#define XB_SPIN(cond, bar) do { unsigned _sp = 0; while (cond) { __builtin_amdgcn_s_sleep(1); \
    if ((++_sp & 255u) == 0u) { if (xb_ld(&(bar)[XB_TMO])) break; if (_sp > XB_SPIN_CAP) { atomicAdd(&(bar)[XB_TMO], 1u); break; } } } } while (0)
struct XcdBarrier { unsigned* bar; unsigned x; volatile LAS unsigned* st; };
__device__ __forceinline__ XcdBarrier xcd_barrier_post(unsigned* bar, volatile LAS unsigned* st) {
    XcdBarrier b; b.bar = bar; b.x = xb_xcc_id(); b.st = st;
    if (threadIdx.x == 0) (void)xb_add(&bar[XB_XCNT(b.x)], 1u);
    return b;
}
__device__ __forceinline__ void xcd_barrier_complete(unsigned* bar, unsigned x, unsigned& nloc, unsigned& nx) {
    const unsigned G = gridDim.x * gridDim.y * gridDim.z;
    unsigned sum, cnt, mine, sp = 0u;
    for (;;) {
        sum = 0u; cnt = 0u; mine = 0u;
#pragma unroll
        for (unsigned j = 0; j < 16; ++j) { const unsigned c = xb_ld(&bar[XB_XCNT(j)]); sum += c; cnt += (c > 0u) ? 1u : 0u; mine = (j == x) ? c : mine; }
        if (sum == G) break;
        __builtin_amdgcn_s_sleep(1);
        if ((++sp & 255u) == 0u) { if (xb_ld(&bar[XB_TMO])) break; if (sp > XB_SPIN_CAP) { atomicAdd(&bar[XB_TMO], 1u); break; } }
    }
    nloc = mine > 0u ? mine : 1u; nx = cnt > 0u ? cnt : 1u;
}
__device__ __forceinline__ void xcd_barrier(const XcdBarrier& b) {
    asm volatile("s_waitcnt vmcnt(0)" ::: "memory");
    __syncthreads();
    if (threadIdx.x == 0) {
        unsigned* bar = b.bar;
        __builtin_amdgcn_s_waitcnt(0);
        unsigned nloc = b.st[0], nx = b.st[1];
        if (nloc == 0u) { xcd_barrier_complete(bar, b.x, nloc, nx); b.st[0] = nloc; b.st[1] = nx; }
        const unsigned old = xb_add(&bar[XB_XSUB(b.x)], 1u);
        const unsigned gen = old / nloc;
        if (old + 1u == (gen + 1u) * nloc) {
            __builtin_amdgcn_fence(__ATOMIC_RELEASE, "agent");
            asm volatile("s_waitcnt vmcnt(0)" ::: "memory");
            const unsigned og = xb_add(&bar[XB_TOP], 1u);
            const unsigned tg = og / nx;
            if (og + 1u == (tg + 1u) * nx) xb_add(&bar[XB_TOPGEN], 1u);
            else XB_SPIN(xb_ld(&bar[XB_TOPGEN]) == tg, bar);
            __builtin_amdgcn_fence(__ATOMIC_ACQUIRE, "agent");
            xb_add(&bar[XB_XGEN(b.x)], 1u);
            asm volatile("s_waitcnt vmcnt(0)" ::: "memory");
        } else {
            XB_SPIN(xb_ld(&bar[XB_XGEN(b.x)]) == gen, bar);
            __builtin_amdgcn_fence(__ATOMIC_ACQUIRE, "agent");
            asm volatile("s_waitcnt vmcnt(0)" ::: "memory");
        }
    }
    __syncthreads();
}

namespace pg8 {
constexpr int BM = 256, BK = 64, HALF = 128, HTB = HALF * BK * 2, STAGE_BYTES = 8 * HTB, NXCD = 8, WGM = 8;
__device__ __forceinline__ int lds_byte(int r, int c) { const int st = (r >> 4) * 2 + (c >> 5), rr = r & 15, cc = c & 31, ob = rr * 64 + cc * 2; return st * 1024 + (ob ^ (((ob >> 9) & 1) << 5)); }
__device__ __forceinline__ void stage_rc(int b, int& R, int& C) { const int st = b / 1024, sb = b % 1024, swz = sb ^ (((sb >> 9) & 1) << 5); R = (st >> 1) * 16 + swz / 64; C = (st & 1) * 32 + (swz % 64) / 2; }
__device__ __forceinline__ int perm32(int rho) { const int n = rho >> 4, i = rho & 15; return 8 * (i >> 2) + 4 * n + (i & 3); }

struct Unit { int pm, pn, sub; unsigned aoff, boff; };
struct Gemm { const bf16_t* A; const bf16_t* Bt; int lda, ldb, K; };
struct Sched {
    int nM, nN, nwg, G, c, nsub; unsigned a_row, a_sub, b_row, b_sub;
    __device__ __forceinline__ void init(int nM_, int nN_, int G_, int c_, int nsub_, unsigned a_row_, unsigned a_sub_, unsigned b_row_, unsigned b_sub_) {
        nM = nM_; nN = nN_; nwg = nM * nN; G = G_; c = c_; nsub = nsub_; a_row = a_row_; a_sub = a_sub_; b_row = b_row_; b_sub = b_sub_; }
    __device__ __forceinline__ bool next(int i, Unit& u) const {
        const int round = i / nsub; u.sub = i - round * nsub;
        const long L = (long)round * G + c; if (L >= nwg) return false;
        int wgid = (int)L; { const int q = nwg / NXCD, r = nwg % NXCD, xcd = wgid % NXCD, off = wgid / NXCD; wgid = (xcd < r ? xcd * (q + 1) : r * (q + 1) + (xcd - r) * q) + off; }
        const int nig = WGM * nN, gid = wgid / nig, fm = gid * WGM, gsz = (nM - fm) < WGM ? (nM - fm) : WGM;
        u.pm = fm + ((wgid % nig) % gsz); u.pn = (wgid % nig) / gsz;
        u.aoff = (unsigned)u.pm * a_row + (unsigned)u.sub * a_sub; u.boff = (unsigned)u.pn * b_row + (unsigned)u.sub * b_sub; return true;
    }
};

template <class Epi>
__device__ __forceinline__ void gemm_phase(LAS unsigned char* lds, const int tid, const Gemm g, const Sched& S, const Epi& E) {
    const int wid = __builtin_amdgcn_readfirstlane(tid >> 6), lane = tid & 63, wr = wid >> 2, wc = wid & 3, fr = lane & 15, fq = lane >> 4;
    const int K = g.K, nt = K / BK;
    unsigned voffA[2], voffB[2];
#pragma unroll
    for (int i = 0; i < 2; ++i) { int R, C; stage_rc(tid * 16 + i * 8192, R, C); const int Rb = Epi::PERM ? ((R & ~31) + perm32(R & 31)) : R;
        voffA[i] = (unsigned)(R * g.lda + C) * 2u; voffB[i] = (unsigned)(Rb * g.ldb + C) * 2u; }
    const size_t kstep = (size_t)(BK * 2);
    const size_t hstepA = (size_t)HALF * g.lda * 2, hstepB = (size_t)HALF * g.ldb * 2;
    const unsigned ldsw = (unsigned)wid * 1024u;
    const int aoff = lds_byte(wr * 64 + fr, fq * 8), boff = lds_byte(wc * 32 + fr, fq * 8);
#define PG8_SA(b, h) (((b) * 2 + (h)) * HTB)
#define PG8_SB(b, h) ((4 + (b) * 2 + (h)) * HTB)
#define PG8_STAGE(bufoff, gbase, voff) do { _Pragma("unroll") for (int _i = 0; _i < 2; ++_i) \
        __builtin_amdgcn_global_load_lds((const unsigned*)((const char*)(gbase) + (voff)[_i]), (LAS unsigned*)(lds + (bufoff) + ldsw + _i * 8192), 16, 0, 0); } while (0)
#define PG8_LDA(dst, b, h) do { _Pragma("unroll") for (int m = 0; m < 4; ++m) _Pragma("unroll") for (int k = 0; k < 2; ++k) dst[m][k] = *(const LAS bf16x8*)(lds + PG8_SA(b, h) + aoff + m * 2048 + k * 1024); } while (0)
#define PG8_LDB(dst, b, h) do { _Pragma("unroll") for (int n = 0; n < 2; ++n) _Pragma("unroll") for (int k = 0; k < 2; ++k) dst[n][k] = *(const LAS bf16x8*)(lds + PG8_SB(b, h) + boff + n * 2048 + k * 1024); } while (0)
#define PG8_MMA(ai, bj, At, Bt) do { __builtin_amdgcn_s_setprio(1); _Pragma("unroll") for (int m = 0; m < 4; ++m) _Pragma("unroll") for (int n = 0; n < 2; ++n) _Pragma("unroll") for (int k = 0; k < 2; ++k) \
        acc[ai][bj][m][n] = __builtin_amdgcn_mfma_f32_16x16x32_bf16(Bt[n][k], At[m][k], acc[ai][bj][m][n], 0, 0, 0); __builtin_amdgcn_s_setprio(0); } while (0)
#define PG8_WAIT_V(n) asm volatile("s_waitcnt vmcnt(" #n ")" ::: "memory")
#define PG8_WAIT_L(n) asm volatile("s_waitcnt lgkmcnt(" #n ")" ::: "memory")
#define PG8_BAR __builtin_amdgcn_s_barrier()
#define PG8_SCHED __builtin_amdgcn_sched_barrier(0)
    Unit cur, nxt; int ui = 0;
    if (!S.next(0, cur)) return;
    f32x4 acc[2][2][4][2];
#pragma unroll
    for (int a = 0; a < 2; ++a)
#pragma unroll
        for (int b = 0; b < 2; ++b)
#pragma unroll
            for (int m = 0; m < 4; ++m)
#pragma unroll
                for (int n = 0; n < 2; ++n) acc[a][b][m][n] = (f32x4){0.f, 0.f, 0.f, 0.f};
    bf16x8 At[4][2], B0[2][2], B1[2][2];
    const char* cA = (const char*)g.A + cur.aoff; const char* cB = (const char*)g.Bt + cur.boff;
    PG8_STAGE(PG8_SB(0, 0), cB, voffB); PG8_STAGE(PG8_SA(0, 0), cA, voffA); PG8_STAGE(PG8_SB(0, 1), cB + hstepB, voffB); PG8_STAGE(PG8_SA(0, 1), cA + hstepA, voffA);
    if (wr == 1) PG8_BAR;
    PG8_WAIT_V(4); PG8_BAR;
    PG8_STAGE(PG8_SB(1, 0), cB + kstep, voffB); PG8_STAGE(PG8_SA(1, 0), cA + kstep, voffA); PG8_STAGE(PG8_SB(1, 1), cB + hstepB + kstep, voffB);
    PG8_WAIT_V(6); PG8_BAR;
    for (;;) {
        const bool has_next = S.next(ui + 1, nxt);
        const char* nA = has_next ? (const char*)g.A + nxt.aoff : cA; const char* nB = has_next ? (const char*)g.Bt + nxt.boff : cB;
        for (int t = 0; t < nt; t += 2) {
            const bool last = (t == nt - 2);
            const char* a1 = cA + (size_t)(t + 1) * kstep;
            const char* a2 = last ? nA : cA + (size_t)(t + 2) * kstep; const char* b2 = last ? nB : cB + (size_t)(t + 2) * kstep;
            const char* a3 = a2 + kstep; const char* b3 = b2 + kstep;
            PG8_LDB(B0, 0, 0); PG8_SCHED; PG8_LDA(At, 0, 0); PG8_STAGE(PG8_SA(1, 1), a1 + hstepA, voffA);
            PG8_WAIT_L(8); PG8_BAR; PG8_WAIT_L(0); PG8_MMA(0, 0, At, B0); PG8_BAR; PG8_SCHED;
            PG8_LDB(B1, 0, 1); PG8_STAGE(PG8_SB(0, 0), b2, voffB);
            PG8_BAR; PG8_WAIT_L(0); PG8_MMA(0, 1, At, B1); PG8_BAR;
            PG8_LDA(At, 0, 1); PG8_STAGE(PG8_SA(0, 0), a2, voffA);
            PG8_BAR; PG8_WAIT_L(0); PG8_MMA(1, 0, At, B0); PG8_BAR; PG8_SCHED;
            PG8_STAGE(PG8_SB(0, 1), b2 + hstepB, voffB);
            PG8_WAIT_V(6); PG8_BAR; PG8_MMA(1, 1, At, B1); PG8_BAR;
            PG8_LDB(B0, 1, 0); PG8_SCHED; PG8_LDA(At, 1, 0); PG8_STAGE(PG8_SA(0, 1), a2 + hstepA, voffA);
            PG8_WAIT_L(8); PG8_BAR; PG8_WAIT_L(0); PG8_MMA(0, 0, At, B0); PG8_BAR; PG8_SCHED;
            PG8_LDB(B1, 1, 1); PG8_STAGE(PG8_SB(1, 0), b3, voffB);
            PG8_BAR; PG8_WAIT_L(0); PG8_MMA(0, 1, At, B1); PG8_BAR;
            PG8_LDA(At, 1, 1); PG8_STAGE(PG8_SA(1, 0), a3, voffA);
            PG8_BAR; PG8_WAIT_L(0); PG8_MMA(1, 0, At, B0); PG8_BAR; PG8_SCHED;
            PG8_STAGE(PG8_SB(1, 1), b3 + hstepB, voffB);
            PG8_WAIT_V(6); PG8_BAR; PG8_MMA(1, 1, At, B1); PG8_BAR;
        }
        const bool keep = E(acc, cur, wr, wc, fr, fq);
        if (!has_next) break;
        if (!keep) {
#pragma unroll
            for (int a = 0; a < 2; ++a)
#pragma unroll
                for (int b = 0; b < 2; ++b)
#pragma unroll
                    for (int m = 0; m < 4; ++m)
#pragma unroll
                        for (int n = 0; n < 2; ++n) acc[a][b][m][n] = (f32x4){0.f, 0.f, 0.f, 0.f};
        }
        cur = nxt; cA = nA; cB = nB; ++ui;
    }
    PG8_WAIT_V(0);
    if (wr == 0) PG8_BAR;
    PG8_BAR;
#undef PG8_SA
#undef PG8_SB
#undef PG8_STAGE
#undef PG8_LDA
#undef PG8_LDB
#undef PG8_MMA
#undef PG8_WAIT_V
#undef PG8_WAIT_L
#undef PG8_BAR
#undef PG8_SCHED
}

struct EpiInProj {
    static constexpr bool PERM = true;
    bf16_t* proj; bf16_t* gates; const float* rs;
    __device__ __forceinline__ bool operator()(f32x4 (&acc)[2][2][4][2], const Unit& u, int wr, int wc, int fr, int fq) const {
        const int row0 = u.pm * BM + wr * 64 + fr; const bool is_gate = u.pn >= 16;
        bf16_t* base = is_gate ? gates + (u.pn - 16) * 256 : proj + u.pn * 256; const int ld = is_gate ? 3072 : PLD;
        const int col0 = wc * 32 + 8 * fq;
#pragma unroll
        for (int ai = 0; ai < 2; ++ai)
#pragma unroll
            for (int m = 0; m < 4; ++m) { const int row = row0 + ai * HALF + m * 16; const float s = rs[row]; bf16_t* rowp = base + (size_t)row * ld + col0;
#pragma unroll
                for (int bj = 0; bj < 2; ++bj) { f32x4 v0 = acc[ai][bj][m][0] * s, v1 = acc[ai][bj][m][1] * s;
                    if (is_gate) {
#pragma unroll
                        for (int j = 0; j < 4; ++j) { v0[j] = sigmoidf_(v0[j]); v1[j] = sigmoidf_(v1[j]); } }
                    u32x4 w; w.x = pk2(v0[0], v0[1]); w.y = pk2(v0[2], v0[3]); w.z = pk2(v1[0], v1[1]); w.w = pk2(v1[2], v1[3]);
                    *(u32x4*)(rowp + bj * HALF) = w; } }
        return false;
    }
};
struct EpiStore {
    static constexpr bool PERM = true;
    bf16_t* out; int ld;
    __device__ __forceinline__ bool operator()(f32x4 (&acc)[2][2][4][2], const Unit& u, int wr, int wc, int fr, int fq) const {
        const int row0 = u.pm * BM + wr * 64 + fr; const int col0 = u.pn * BM + wc * 32 + 8 * fq;
#pragma unroll
        for (int ai = 0; ai < 2; ++ai)
#pragma unroll
            for (int m = 0; m < 4; ++m) { bf16_t* rowp = out + (size_t)(row0 + ai * HALF + m * 16) * ld + col0;
#pragma unroll
                for (int bj = 0; bj < 2; ++bj) { const f32x4 v0 = acc[ai][bj][m][0], v1 = acc[ai][bj][m][1];
                    u32x4 w; w.x = pk2(v0[0], v0[1]); w.y = pk2(v0[2], v0[3]); w.z = pk2(v1[0], v1[1]); w.w = pk2(v1[2], v1[3]);
                    *(u32x4*)(rowp + bj * HALF) = w; } }
        return false;
    }
};
struct EpiMerge {
    static constexpr bool PERM = true;
    const bf16_t* gates; bf16_t* merged;
    __device__ __forceinline__ bool operator()(f32x4 (&acc)[2][2][4][2], const Unit& u, int wr, int wc, int fr, int fq) const {
        const int row0 = u.pm * BM + wr * 64 + fr; const int col0 = u.pn * BM + wc * 32 + 8 * fq; const int sub = u.sub;
#pragma unroll
        for (int ai = 0; ai < 2; ++ai)
#pragma unroll
            for (int m = 0; m < 4; ++m) { const int row = row0 + ai * HALF + m * 16; const bf16_t* gp = gates + (size_t)row * 3072 + sub * 1024 + col0;
#pragma unroll
                for (int bj = 0; bj < 2; ++bj) {
                    float sc[8], sn[8]; unpack8(*(const u32x4*)(gp + bj * HALF), sc);
                    if (sub < 2) { unpack8(*(const u32x4*)(gp + 1024 + bj * HALF), sn);
#pragma unroll
                        for (int j = 0; j < 8; ++j) sc[j] = sc[j] / fmaxf(sn[j], 1e-30f); }
                    f32x4 v0 = acc[ai][bj][m][0], v1 = acc[ai][bj][m][1];
#pragma unroll
                    for (int j = 0; j < 4; ++j) { v0[j] *= sc[j]; v1[j] *= sc[4 + j]; }
                    acc[ai][bj][m][0] = v0; acc[ai][bj][m][1] = v1;
                    if (sub == 2) { u32x4 w; w.x = pk2(v0[0], v0[1]); w.y = pk2(v0[2], v0[3]); w.z = pk2(v1[0], v1[1]); w.w = pk2(v1[2], v1[3]);
                        *(u32x4*)(merged + (size_t)row * D + col0 + bj * HALF) = w; } } }
        return sub != 2;
    }
};
struct EpiSwiGLU {
    static constexpr bool PERM = true;
    bf16_t* act; const float* rs;
    __device__ __forceinline__ bool operator()(f32x4 (&acc)[2][2][4][2], const Unit& u, int wr, int wc, int fr, int fq) const {
        const int row0 = u.pm * BM + wr * 64 + fr; const int col0 = u.pn * HALF + wc * 32 + 8 * fq;
#pragma unroll
        for (int ai = 0; ai < 2; ++ai)
#pragma unroll
            for (int m = 0; m < 4; ++m) { const int row = row0 + ai * HALF + m * 16; const float s = rs[row];
                float o[8];
#pragma unroll
                for (int n = 0; n < 2; ++n)
#pragma unroll
                    for (int j = 0; j < 4; ++j) { const float gg = acc[ai][0][m][n][j] * s, uu = acc[ai][1][m][n][j] * s; o[n * 4 + j] = gg * sigmoidf_(gg) * uu; }
                u32x4 w; w.x = pk2(o[0], o[1]); w.y = pk2(o[2], o[3]); w.z = pk2(o[4], o[5]); w.w = pk2(o[6], o[7]);
                *(u32x4*)(act + (size_t)row * FFN + col0) = w; }
        return false;
    }
};
}

struct Args { const float* in[30]; float* out; unsigned char* ws; int lo, hi; };
enum { I_X = 0, I_NPM, I_NQM, I_NPF, I_NQF, I_WIN, I_MU, I_W0, I_W2, I_A0, I_A2, I_G2, I_KK, I_KA, I_RK, I_LNW, I_LNB, I_PEK, I_PEV, I_CKW1, I_CKW2, I_CVW1, I_CVW2, I_SINK, I_REL, I_WBR, I_WOUT, I_FG, I_FU, I_FD };

struct Ctx { LAS unsigned char* lds; int tid, lane, wave, G, bid; };

__device__ __forceinline__ void phase_init(const Ctx& c, const float* x, float* xo, bf16_t* xb, float* rs) {
    const int gw = c.bid * 8 + c.wave, NGW = c.G * 8;
    for (int row = gw; row < MROWS; row += NGW) {
        const float* xr = x + (size_t)row * D; float ss = 0.f;
#pragma unroll
        for (int j = 0; j < 2; ++j) { const int e = c.lane * 8 + 512 * j; const f32x4 a = *(const f32x4*)(xr + e), b = *(const f32x4*)(xr + e + 4);
            ss += a[0] * a[0] + a[1] * a[1] + a[2] * a[2] + a[3] * a[3] + b[0] * b[0] + b[1] * b[1] + b[2] * b[2] + b[3] * b[3];
            *(f32x4*)(xo + (size_t)row * D + e) = a; *(f32x4*)(xo + (size_t)row * D + e + 4) = b;
            u32x4 w; w.x = pk2(a[0], a[1]); w.y = pk2(a[2], a[3]); w.z = pk2(b[0], b[1]); w.w = pk2(b[2], b[3]); *(u32x4*)(xb + (size_t)row * D + e) = w; }
        ss = wave_sum(ss);
        if (c.lane == 0) rs[row] = rsqrtf(ss * (1.0f / D) + NORM_EPS);
    }
}
__device__ __forceinline__ void phase_norm_res(const Ctx& c, const bf16_t* y, const float* gain, float* x, bf16_t* xb, float* rs, int row0, int nrows) {
    const int gw = c.bid * 8 + c.wave, NGW = c.G * 8;
    for (int r = gw; r < nrows; r += NGW) {
        const int row = row0 + r; float yv[16]; float ss = 0.f;
#pragma unroll
        for (int j = 0; j < 2; ++j) { float f[8]; unpack8(*(const u32x4*)(y + (size_t)r * D + c.lane * 8 + 512 * j), f);
#pragma unroll
            for (int k = 0; k < 8; ++k) { yv[j * 8 + k] = f[k]; ss += f[k] * f[k]; } }
        ss = wave_sum(ss); const float sc = rsqrtf(ss * (1.0f / D) + NORM_EPS); float s2 = 0.f;
#pragma unroll
        for (int j = 0; j < 2; ++j) { const int e = c.lane * 8 + 512 * j; float* xr = x + (size_t)row * D + e;
            f32x4 a = *(const f32x4*)xr, b = *(const f32x4*)(xr + 4); const f32x4 ga = *(const f32x4*)(gain + e), gb = *(const f32x4*)(gain + e + 4);
#pragma unroll
            for (int k = 0; k < 4; ++k) { a[k] += yv[j * 8 + k] * sc * ga[k]; b[k] += yv[j * 8 + 4 + k] * sc * gb[k]; s2 += a[k] * a[k] + b[k] * b[k]; }
            *(f32x4*)xr = a; *(f32x4*)(xr + 4) = b;
            u32x4 w; w.x = pk2(a[0], a[1]); w.y = pk2(a[2], a[3]); w.z = pk2(b[0], b[1]); w.w = pk2(b[2], b[3]); *(u32x4*)(xb + (size_t)row * D + e) = w; }
        s2 = wave_sum(s2);
        if (c.lane == 0) rs[row] = rsqrtf(s2 * (1.0f / D) + NORM_EPS);
    }
}

__device__ __forceinline__ float cvt_fetch(const Args& a, int layer, int kind, int sub, int k, int n) {
    switch (kind) {
    case 0: { int src; float sc = a.in[I_NPM][layer * D + k];
        if (n < 3096) src = n; else if (n < 3328) return 0.f; else if (n < 4096) src = 3096 + (n - 3328); else src = 3864 + (n - 4096);
        if ((n >= PC_NQ && n < PC_NQ + 512) || (n >= PC_SQ && n < PC_SQ + 512)) sc *= 0.125f;
        return a.in[I_WIN][((size_t)layer * D + k) * IN_COLS + src] * sc; }
    case 1: return a.in[I_WBR][(((size_t)layer * 3 + sub) * 512 + k) * D + n];
    case 2: return a.in[I_WOUT][((size_t)layer * D + k) * D + n];
    case 3: { const int pn = n >> 8, r = n & 255; const float sc = a.in[I_NPF][layer * D + k];
        return (r < 128 ? a.in[I_FG][((size_t)layer * D + k) * FFN + pn * 128 + r] : a.in[I_FU][((size_t)layer * D + k) * FFN + pn * 128 + r - 128]) * sc; }
    default: return a.in[I_FD][((size_t)layer * FFN + k) * D + n];
    }
}
__device__ __forceinline__ void phase_cvt(const Ctx& c, const Args& a, int layer, bf16_t* wb) {
    LAS float* tile = (LAS float*)c.lds;
    constexpr int I0 = 16 * 112, I1 = 3 * 8 * 16, I2 = 16 * 16, I3 = 16 * 88, I4 = 44 * 16, NIT = I0 + I1 + I2 + I3 + I4;
    for (int it = c.bid; it < NIT; it += c.G) {
        int r = it, kind, sub = 0, K, nblk; bf16_t* dst;
        if (r < I0) { kind = 0; K = D; nblk = 112; dst = wb + WB_WIN; }
        else if ((r -= I0) < I1) { kind = 1; sub = r / 128; r -= sub * 128; K = 512; nblk = 16; dst = wb + WB_WBR + (size_t)sub * D * 512; }
        else if ((r -= I1) < I2) { kind = 2; K = D; nblk = 16; dst = wb + WB_WOUT; }
        else if ((r -= I2) < I3) { kind = 3; K = D; nblk = 88; dst = wb + WB_WGU; }
        else { r -= I3; kind = 4; K = FFN; nblk = 16; dst = wb + WB_WDN; }
        const int kb = r / nblk, nb = r % nblk, k0 = kb * 64, n0 = nb * 64;
        for (int e = c.tid; e < 4096; e += 512) { const int kk = e >> 6, nn = e & 63; tile[kk * 65 + nn] = cvt_fetch(a, layer, kind, sub, k0 + kk, n0 + nn); }
        __syncthreads();
        for (int e = c.tid; e < 2048; e += 512) { const int nn = e >> 5, kp = (e & 31) * 2;
            *(unsigned*)(dst + (size_t)(n0 + nn) * K + k0 + kp) = pk2(tile[kp * 65 + nn], tile[(kp + 1) * 65 + nn]); }
        __syncthreads();
    }
}

struct RowState { float q[64]; float o[64]; float m, l; };
__device__ __forceinline__ void row_init(RowState& s, const bf16_t* qp) {
#pragma unroll
    for (int i = 0; i < 8; ++i) { float f[8]; unpack8(*(const u32x4*)(qp + i * 8), f);
#pragma unroll
        for (int k = 0; k < 8; ++k) s.q[i * 8 + k] = f[k]; }
}
__device__ __forceinline__ void row_reset(RowState& s) {
#pragma unroll
    for (int i = 0; i < 64; ++i) s.o[i] = 0.f;
    s.m = -1e30f; s.l = 0.f;
}
__device__ __forceinline__ void row_key_bf16(RowState& s, const bf16_t* kp, const bf16_t* vp, float bias) {
    float sc = bias;
#pragma unroll
    for (int i = 0; i < 8; ++i) { float f[8]; unpack8(*(const u32x4*)(kp + i * 8), f);
#pragma unroll
        for (int k = 0; k < 8; ++k) sc += s.q[i * 8 + k] * f[k];
        if ((i & 1) == 1) __builtin_amdgcn_sched_barrier(0); }
    const float mn = fmaxf(s.m, sc), corr = __expf(s.m - mn), p = __expf(sc - mn);
    s.l = s.l * corr + p; s.m = mn;
#pragma unroll
    for (int i = 0; i < 8; ++i) { float f[8]; unpack8(*(const u32x4*)(vp + i * 8), f);
#pragma unroll
        for (int k = 0; k < 8; ++k) s.o[i * 8 + k] = s.o[i * 8 + k] * corr + p * f[k];
        if ((i & 1) == 1) __builtin_amdgcn_sched_barrier(0); }
}
__device__ __forceinline__ void row_key_f32(RowState& s, const float* kp, const float* vp, float bias) {
    float sc = bias;
#pragma unroll
    for (int i = 0; i < 16; ++i) { const f32x4 f = *(const f32x4*)(kp + i * 4); sc += s.q[i * 4] * f[0] + s.q[i * 4 + 1] * f[1] + s.q[i * 4 + 2] * f[2] + s.q[i * 4 + 3] * f[3];
        if ((i & 3) == 3) __builtin_amdgcn_sched_barrier(0); }
    const float mn = fmaxf(s.m, sc), corr = __expf(s.m - mn), p = __expf(sc - mn);
    s.l = s.l * corr + p; s.m = mn;
#pragma unroll
    for (int i = 0; i < 16; ++i) { const f32x4 f = *(const f32x4*)(vp + i * 4);
#pragma unroll
        for (int k = 0; k < 4; ++k) s.o[i * 4 + k] = s.o[i * 4 + k] * corr + p * f[k];
        if ((i & 3) == 3) __builtin_amdgcn_sched_barrier(0); }
}

__device__ __forceinline__ float gelu_tanh(float x) { const float t = tanhf(0.7978845608028654f * (x + 0.044715f * x * x * x)); return 0.5f * x * (1.0f + t); }
__device__ __forceinline__ void phase_cmp1(const Ctx& c, const Args& a, int layer, const bf16_t* proj, float* hid) {
    for (int unit = c.bid; unit < 2048; unit += c.G) {
        const int kv = unit >> 10, g = (unit >> 9) & 1, cp = unit & 511; const int cc = cp * 2 + (c.tid >> 8), u = c.tid & 255;
        if (cc >= NCMP) continue;
        const float* w1 = a.in[kv ? I_CVW1 : I_CKW1] + (size_t)layer * 2048 * 256; const float* pe = a.in[kv ? I_PEV : I_PEK] + (size_t)layer * 32 * 64;
        const bf16_t* xp = proj + (size_t)(16 * cc) * PLD + (kv ? PC_VC : PC_KC) + g * 64;
        float acc = 0.f;
        for (int l = 0; l < 32; ++l) {
#pragma unroll
            for (int i = 0; i < 8; ++i) { float f[8]; unpack8(*(const u32x4*)(xp + (size_t)l * PLD + i * 8), f);
#pragma unroll
                for (int k = 0; k < 8; ++k) acc += (f[k] + pe[l * 64 + i * 8 + k]) * w1[(size_t)(l * 64 + i * 8 + k) * 256 + u]; }
        }
        hid[(((size_t)kv * 2 + g) * 1024 + cc) * 256 + u] = gelu_tanh(acc);
    }
}
__device__ __forceinline__ void phase_cmp2(const Ctx& c, const Args& a, int layer, const float* hid, float* kcmp, float* vcmp) {
    for (int unit = c.bid; unit < 512; unit += c.G) {
        const int kv = unit >> 8, g = (unit >> 7) & 1, cc = (unit & 127) * 8 + (c.tid >> 6), d = c.tid & 63;
        if (cc >= NCMP) continue;
        const float* w2 = a.in[kv ? I_CVW2 : I_CKW2] + (size_t)layer * 256 * 64; const float* hp = hid + (((size_t)kv * 2 + g) * 1024 + cc) * 256;
        float acc = 0.f;
        for (int u = 0; u < 256; ++u) acc += hp[u] * w2[u * 64 + d];
        (kv ? vcmp : kcmp)[((size_t)g * 1024 + cc) * 64 + d] = acc;
    }
}
__device__ __forceinline__ void phase_nsa13(const Ctx& c, const Args& a, const bf16_t* proj, const float* kcmp, const float* vcmp, float* nsaacc, float* ml) {
    LAS float* tb = (LAS float*)c.lds;
    for (int e = c.tid; e < 512; e += 512) tb[e] = a.in[I_REL][e];
    __syncthreads();
    for (int unit = c.bid; unit < T / 64; unit += c.G) {
        const int hh = c.tid >> 6, t = unit * 64 + (c.tid & 63), g = hh >> 2;
        RowState s; row_init(s, proj + (size_t)t * PLD + PC_NQ + hh * 64);
        const bf16_t* glp = proj + (size_t)t * PLD + PC_GL;
        const float g0 = sigmoidf_(bf2f(glp[hh])), g2 = sigmoidf_(bf2f(glp[16 + hh]));
        row_reset(s);
        const int nv = t >= 31 ? (t - 31) / 16 + 1 : 0;
        for (int cc = 0; cc < nv; ++cc) { const float bias = tb[t5_bucket(t - 16 * cc - 31) * 16 + hh];
            row_key_f32(s, kcmp + ((size_t)g * 1024 + cc) * 64, vcmp + ((size_t)g * 1024 + cc) * 64, bias); }
        ml[((size_t)t * 8 + hh) * 2] = s.m; ml[((size_t)t * 8 + hh) * 2 + 1] = s.l;
        float* op = nsaacc + (size_t)t * 512 + hh * 64;
        { const float inv = s.l > 0.f ? g0 / s.l : 0.f;
#pragma unroll
            for (int i = 0; i < 16; ++i) { f32x4 w; w[0] = s.o[i * 4] * inv; w[1] = s.o[i * 4 + 1] * inv; w[2] = s.o[i * 4 + 2] * inv; w[3] = s.o[i * 4 + 3] * inv; *(f32x4*)(op + i * 4) = w; } }
        row_reset(s);
        const int s0 = t - 511 > 0 ? t - 511 : 0;
        for (int sp = s0; sp <= t; ++sp) { const float bias = tb[t5_bucket(t - sp) * 16 + hh];
            row_key_bf16(s, proj + (size_t)sp * PLD + PC_KW + g * 64, proj + (size_t)sp * PLD + PC_VW + g * 64, bias); }
        { const float inv = s.l > 0.f ? g2 / s.l : 0.f;
#pragma unroll
            for (int i = 0; i < 16; ++i) { f32x4 w = *(const f32x4*)(op + i * 4); w[0] += s.o[i * 4] * inv; w[1] += s.o[i * 4 + 1] * inv; w[2] += s.o[i * 4 + 2] * inv; w[3] += s.o[i * 4 + 3] * inv; *(f32x4*)(op + i * 4) = w; } }
    }
}
__device__ __forceinline__ void phase_nsa_topk(const Ctx& c, const Args& a, const bf16_t* proj, const float* kcmp, const float* ml, int* sel) {
    LAS float* tb = (LAS float*)c.lds;
    LAS float* qs = (LAS float*)(c.lds + 4096) + c.wave * 256;
    LAS float* sv = (LAS float*)(c.lds + 16384) + c.wave * 256;
    for (int e = c.tid; e < 512; e += 512) tb[e] = a.in[I_REL][e];
    __syncthreads();
    const int gw = c.bid * 8 + c.wave, NGW = c.G * 8;
    for (int item = gw; item < T * 2; item += NGW) {
        const int t = item >> 1, g = item & 1, cur = t >> 6;
        { const bf16_t* qp = proj + (size_t)t * PLD + PC_NQ + g * 256 + c.lane * 4; const u32x2 w = *(const u32x2*)qp;
          qs[c.lane * 4] = __uint_as_float(w.x << 16); qs[c.lane * 4 + 1] = __uint_as_float(w.x & 0xffff0000u); qs[c.lane * 4 + 2] = __uint_as_float(w.y << 16); qs[c.lane * 4 + 3] = __uint_as_float(w.y & 0xffff0000u); }
        float mr[4], il[4];
#pragma unroll
        for (int r = 0; r < 4; ++r) { mr[r] = ml[((size_t)t * 8 + g * 4 + r) * 2]; const float l = ml[((size_t)t * 8 + g * 4 + r) * 2 + 1]; il[r] = l > 0.f ? 1.0f / l : 0.f; }
        const int nv = t >= 31 ? (t - 31) / 16 + 1 : 0;
        asm volatile("s_waitcnt lgkmcnt(0)" ::: "memory");
#pragma unroll 1
        for (int jj = 0; jj < 4; ++jj) {
            const int j = c.lane + 64 * jj; float sc;
            if (j == 0 || j == cur || j == cur - 1) sc = 1e4f;
            else if (j > cur) sc = -1.0f;
            else { sc = 0.f;
#pragma unroll 1
                for (int o = 0; o < 5; ++o) { const int cc = 4 * j + o - 1; if (cc < 0 || cc >= nv) continue;
                    const float* kp = kcmp + ((size_t)g * 1024 + cc) * 64; float d0 = 0.f, d1 = 0.f, d2 = 0.f, d3 = 0.f;
#pragma unroll 4
                    for (int i = 0; i < 16; ++i) { const f32x4 f = *(const f32x4*)(kp + i * 4);
#pragma unroll
                        for (int k = 0; k < 4; ++k) { d0 += qs[i * 4 + k] * f[k]; d1 += qs[64 + i * 4 + k] * f[k]; d2 += qs[128 + i * 4 + k] * f[k]; d3 += qs[192 + i * 4 + k] * f[k]; } }
                    const int bk = t5_bucket(t - 16 * cc - 31) * 16 + g * 4;
                    const float imp = __expf(d0 + tb[bk] - mr[0]) * il[0] + __expf(d1 + tb[bk + 1] - mr[1]) * il[1] + __expf(d2 + tb[bk + 2] - mr[2]) * il[2] + __expf(d3 + tb[bk + 3] - mr[3]) * il[3];
                    sc += ((o == 0 || o == 4) ? 1.0f : 2.0f) * imp; }
            }
            sv[j] = sc;
        }
        asm volatile("s_waitcnt lgkmcnt(0)" ::: "memory");
        float val[4];
#pragma unroll
        for (int jj = 0; jj < 4; ++jj) val[jj] = sv[c.lane + 64 * jj];
        for (int k = 0; k < 16; ++k) {
            float bv = val[0]; int bi = c.lane;
#pragma unroll
            for (int jj = 1; jj < 4; ++jj) if (val[jj] > bv) { bv = val[jj]; bi = c.lane + 64 * jj; }
#pragma unroll
            for (int o = 32; o >= 1; o >>= 1) { const float ov = __shfl_xor(bv, o); const int oi = __shfl_xor(bi, o); if (ov > bv || (ov == bv && oi < bi)) { bv = ov; bi = oi; } }
#pragma unroll
            for (int jj = 0; jj < 4; ++jj) if (bi == c.lane + 64 * jj) val[jj] = -3e38f;
            if (c.lane == 0) sel[(size_t)item * 16 + k] = bi;
        }
    }
}
__device__ __forceinline__ void phase_nsa2(const Ctx& c, const Args& a, const bf16_t* proj, const int* sel, const float* nsaacc, bf16_t* onsa) {
    LAS float* tb = (LAS float*)c.lds;
    for (int e = c.tid; e < 512; e += 512) tb[e] = a.in[I_REL][e];
    __syncthreads();
    for (int unit = c.bid; unit < T / 64; unit += c.G) {
        const int hh = c.tid >> 6, t = unit * 64 + (c.tid & 63), g = hh >> 2;
        RowState s; row_init(s, proj + (size_t)t * PLD + PC_NQ + hh * 64); row_reset(s);
        const float g1 = sigmoidf_(bf2f(proj[(size_t)t * PLD + PC_GL + 8 + hh]));
        for (int k = 0; k < 16; ++k) { const int j = sel[((size_t)t * 2 + g) * 16 + k];
            for (int p = 0; p < 64; ++p) { const int pos = j * 64 + p; if (pos > t) break;
                const float bias = tb[t5_bucket(t - pos) * 16 + hh];
                row_key_bf16(s, proj + (size_t)pos * PLD + PC_KS + g * 64, proj + (size_t)pos * PLD + PC_VS + g * 64, bias); } }
        const float inv = s.l > 0.f ? g1 / s.l : 0.f; const float* ap = nsaacc + (size_t)t * 512 + hh * 64; bf16_t* op = onsa + (size_t)t * 512 + hh * 64;
#pragma unroll
        for (int i = 0; i < 8; ++i) { const f32x4 x0 = *(const f32x4*)(ap + i * 8), x1 = *(const f32x4*)(ap + i * 8 + 4); u32x4 w;
            w.x = pk2(x0[0] + s.o[i * 8] * inv, x0[1] + s.o[i * 8 + 1] * inv); w.y = pk2(x0[2] + s.o[i * 8 + 2] * inv, x0[3] + s.o[i * 8 + 3] * inv);
            w.z = pk2(x1[0] + s.o[i * 8 + 4] * inv, x1[1] + s.o[i * 8 + 5] * inv); w.w = pk2(x1[2] + s.o[i * 8 + 6] * inv, x1[3] + s.o[i * 8 + 7] * inv);
            *(u32x4*)(op + i * 8) = w; }
    }
}
__device__ __forceinline__ void phase_swa(const Ctx& c, const Args& a, int layer, const bf16_t* proj, bf16_t* oswa) {
    LAS float* tb = (LAS float*)c.lds;
    for (int e = c.tid; e < 512; e += 512) tb[e] = a.in[I_REL][e];
    __syncthreads();
    for (int unit = c.bid; unit < T / 64; unit += c.G) {
        const int hh = c.tid >> 6, t = unit * 64 + (c.tid & 63), g = hh >> 2;
        RowState s; row_init(s, proj + (size_t)t * PLD + PC_SQ + hh * 64); row_reset(s);
        const int s0 = t - 127 > 0 ? t - 127 : 0;
        for (int sp = s0; sp <= t; ++sp) { const float bias = tb[t5_bucket(t - sp) * 16 + 8 + hh];
            row_key_bf16(s, proj + (size_t)sp * PLD + PC_SK + g * 64, proj + (size_t)sp * PLD + PC_SV + g * 64, bias); }
        const float sink = a.in[I_SINK][layer * 8 + hh]; const float mf = fmaxf(s.m, sink); const float corr = __expf(s.m - mf);
        const float den = s.l * corr + __expf(sink - mf); const float inv = corr / den;
        bf16_t* op = oswa + (size_t)t * 512 + hh * 64;
#pragma unroll
        for (int i = 0; i < 8; ++i) { u32x4 w; w.x = pk2(s.o[i * 8] * inv, s.o[i * 8 + 1] * inv); w.y = pk2(s.o[i * 8 + 2] * inv, s.o[i * 8 + 3] * inv);
            w.z = pk2(s.o[i * 8 + 4] * inv, s.o[i * 8 + 5] * inv); w.w = pk2(s.o[i * 8 + 6] * inv, s.o[i * 8 + 7] * inv); *(u32x4*)(op + i * 8) = w; }
    }
}

constexpr int RL = 65;
__device__ __forceinline__ float rwkv_mixed(const bf16_t* proj, const float* mu, int t, int col) {
    const float cur = bf2f(proj[(size_t)t * PLD + col]); const float prev = t > 0 ? bf2f(proj[(size_t)(t - 1) * PLD + col]) : 0.f;
    return cur + (prev - cur) * mu[col];
}
__device__ __forceinline__ void lora64(const Ctx& c, const LAS float* in, const float* W, const float* bias, LAS float* out, bool accum) {
    const int j = c.tid & 63, tg = (c.tid >> 6) * 8;
    float acc[8];
#pragma unroll
    for (int i = 0; i < 8; ++i) acc[i] = accum ? out[(tg + i) * RL + j] : (bias ? bias[j] : 0.f);
#pragma unroll 4
    for (int m = 0; m < 64; ++m) { const float w = W[(size_t)m * 512 + j];
#pragma unroll
        for (int i = 0; i < 8; ++i) acc[i] += in[(tg + i) * RL + m] * w; }
#pragma unroll
    for (int i = 0; i < 8; ++i) out[(tg + i) * RL + j] = acc[i];
}
struct RwkvLds { LAS float *R, *K, *V, *A, *B, *W, *G, *TMP; };
__device__ __forceinline__ RwkvLds rwkv_lds(LAS unsigned char* lds) {
    RwkvLds s; LAS float* p = (LAS float*)lds; constexpr int SZ = 64 * RL;
    s.R = p; s.K = p + SZ; s.V = p + 2 * SZ; s.A = p + 3 * SZ; s.B = p + 4 * SZ; s.W = p + 5 * SZ; s.G = p + 6 * SZ; s.TMP = p + 7 * SZ; return s;
}
template <bool LOGDECAY>
__device__ __forceinline__ void rwkv_prep(const Ctx& c, const Args& a, int layer, const bf16_t* proj, int t0, int h, const RwkvLds& s) {
    const float* mu = a.in[I_MU] + (size_t)layer * 1792;
    const int j = c.tid & 63, tg = c.tid >> 6;
#pragma unroll 2
    for (int i = 0; i < 8; ++i) { const int tt = tg * 8 + i; s.TMP[tt * RL + j] = tanhf(rwkv_mixed(proj, mu, t0 + tt, PC_ZW + j)); }
    __syncthreads();
    lora64(c, s.TMP, a.in[I_W2] + (size_t)layer * 64 * 512 + h * 64, a.in[I_W0] + layer * 512 + h * 64, s.W, false);
    __syncthreads();
#pragma unroll 2
    for (int i = 0; i < 8; ++i) { const int tt = tg * 8 + i; s.TMP[tt * RL + j] = rwkv_mixed(proj, mu, t0 + tt, PC_ZA + j); }
    __syncthreads();
    lora64(c, s.TMP, a.in[I_A2] + (size_t)layer * 64 * 512 + h * 64, a.in[I_A0] + layer * 512 + h * 64, s.B, false);
    __syncthreads();
#pragma unroll 2
    for (int i = 0; i < 8; ++i) { const int tt = tg * 8 + i; s.TMP[tt * RL + j] = sigmoidf_(rwkv_mixed(proj, mu, t0 + tt, PC_ZG + j)); }
    __syncthreads();
    lora64(c, s.TMP, a.in[I_G2] + (size_t)layer * 128 * 512 + h * 64, nullptr, s.G, false);
    __syncthreads();
#pragma unroll 2
    for (int i = 0; i < 8; ++i) { const int tt = tg * 8 + i; s.TMP[tt * RL + j] = sigmoidf_(rwkv_mixed(proj, mu, t0 + tt, PC_ZG + 64 + j)); }
    __syncthreads();
    lora64(c, s.TMP, a.in[I_G2] + ((size_t)layer * 128 + 64) * 512 + h * 64, nullptr, s.G, true);
    const float kkw = a.in[I_KK][layer * 512 + h * 64 + j], kaw = a.in[I_KA][layer * 512 + h * 64 + j];
#pragma unroll 1
    for (int i = 0; i < 8; ++i) { const int tt = tg * 8 + i, t = t0 + tt;
        const float r = rwkv_mixed(proj, mu, t, PC_R + h * 64 + j), k = rwkv_mixed(proj, mu, t, PC_K + h * 64 + j), v = rwkv_mixed(proj, mu, t, PC_V + h * 64 + j);
        const float wl = s.W[tt * RL + j], al = sigmoidf_(s.B[tt * RL + j]);
        const float sp = (-wl > 20.f) ? -wl : log1pf(__expf(-wl)); const float w = -sp - 0.5f; const float ew = __expf(w);
        float kk = k * kkw; const float n2 = wave_sum(kk * kk); kk = kk / fmaxf(sqrtf(n2), 1e-12f);
        s.R[tt * RL + j] = r; s.V[tt * RL + j] = v; s.K[tt * RL + j] = k * (1.0f + (al - 1.0f) * kaw);
        s.A[tt * RL + j] = -kk; s.B[tt * RL + j] = kk * al; s.W[tt * RL + j] = LOGDECAY ? -ew : __expf(-ew); }
    __syncthreads();
}
__device__ __forceinline__ void rwkv_post(const Ctx& c, const Args& a, int layer, int t0, int h, const RwkvLds& s, const LAS float* Y, bf16_t* orwkv) {
    const int i = c.lane, tg = c.wave;
    const float lnw = a.in[I_LNW][layer * 512 + h * 64 + i], lnb = a.in[I_LNB][layer * 512 + h * 64 + i], rk = a.in[I_RK][layer * 512 + h * 64 + i];
#pragma unroll 1
    for (int q = 0; q < 8; ++q) { const int tt = tg * 8 + q; const float y = Y[tt * RL + i];
        const float mean = wave_sum(y) * (1.0f / 64.0f); const float d = y - mean; const float var = wave_sum(d * d) * (1.0f / 64.0f);
        const float bonus = wave_sum(s.R[tt * RL + i] * s.K[tt * RL + i] * rk);
        const float o = (d * rsqrtf(var + 64e-5f) * lnw + lnb + bonus * s.V[tt * RL + i]) * s.G[tt * RL + i];
        orwkv[(size_t)(t0 + tt) * 512 + h * 64 + i] = (bf16_t)f2bf(o); }
}
__device__ __forceinline__ void phase_rwkv_naive(const Ctx& c, const Args& a, int layer, const bf16_t* proj, bf16_t* orwkv) {
    if (c.bid >= 8) return;
    const int h = c.bid; const RwkvLds s = rwkv_lds(c.lds);
    float S[64];
#pragma unroll
    for (int j = 0; j < 64; ++j) S[j] = 0.f;
    for (int ch = 0; ch < T / 64; ++ch) {
        rwkv_prep<false>(c, a, layer, proj, ch * 64, h, s);
        if (c.wave == 0) {
            const int i = c.lane;
            for (int tt = 0; tt < 64; ++tt) {
                float sa = 0.f;
#pragma unroll
                for (int j = 0; j < 64; ++j) { sa += S[j] * s.A[tt * RL + j]; if ((j & 7) == 7) __builtin_amdgcn_sched_barrier(0); }
                const float vi = s.V[tt * RL + i]; float y = 0.f;
#pragma unroll
                for (int j = 0; j < 64; ++j) { S[j] = S[j] * s.W[tt * RL + j] + sa * s.B[tt * RL + j] + vi * s.K[tt * RL + j]; y += S[j] * s.R[tt * RL + j]; if ((j & 3) == 3) __builtin_amdgcn_sched_barrier(0); }
                s.TMP[tt * RL + i] = y;
            }
        }
        __syncthreads();
        rwkv_post(c, a, layer, ch * 64, h, s, s.TMP, orwkv);
        __syncthreads();
    }
}

constexpr int PH_PER_BATCH = 11, PH_PER_LAYER = 1 + 2 * PH_PER_BATCH + 3, PH_TOTAL = 1 + DEPTH * PH_PER_LAYER;

__global__ void __launch_bounds__(512, 2) fwd_kernel(Args args) {
    extern __shared__ __attribute__((aligned(16))) unsigned char lds_raw[];
    Ctx c0; c0.lds = (LAS unsigned char*)lds_raw; c0.tid = threadIdx.x; c0.lane = c0.tid & 63; c0.wave = __builtin_amdgcn_readfirstlane(c0.tid >> 6); c0.G = gridDim.x; c0.bid = blockIdx.x; const Ctx& c = c0;
    unsigned char* ws = args.ws;
    volatile LAS unsigned* misc = (volatile LAS unsigned*)(c.lds + LDS_MISC);
    if (c.tid < 4) misc[c.tid] = 0u;
    __syncthreads();
    XcdBarrier bar; bar.bar = (unsigned*)(ws + WS_CTL); bar.x = 0; bar.st = misc;
    const int lo = args.lo, hi = args.hi;
    const bool multi = (hi - lo) > 1;
    if (multi) bar = xcd_barrier_post((unsigned*)(ws + WS_CTL), misc);
    int gp = 0;
#ifndef ONLY_PH
#define ONLY_PH -1
#endif
#ifndef PHMASK
#define PHMASK 0xffff
#endif
#define PHASE_BEGIN(id) if (gp >= lo && gp < hi) { if ((ONLY_PH < 0 || ONLY_PH == (id)) && ((PHMASK >> (id)) & 1)) { \
    Ctx pc = c0; asm volatile("" : "+v"(pc.tid), "+s"(pc.bid)); pc.lane = pc.tid & 63; pc.wave = __builtin_amdgcn_readfirstlane(pc.tid >> 6); const Ctx& c = pc;
#define PHASE_END   } if (gp + 1 < hi) xcd_barrier(bar); } ++gp;

    bf16_t* wb = (bf16_t*)(ws + WS_WB); bf16_t* xb = (bf16_t*)(ws + WS_XB); float* rs = (float*)(ws + WS_RS);
    float* kcmp = (float*)(ws + WS_KCMP); float* vcmp = (float*)(ws + WS_VCMP); int* sel = (int*)(ws + WS_SEL); float* ml = (float*)(ws + WS_ML); float* hid = (float*)(ws + WS_HID);
    bf16_t* proj = (bf16_t*)(ws + WS_PROJ); bf16_t* gates = (bf16_t*)(ws + WS_GATES); bf16_t* merged = (bf16_t*)(ws + WS_MERGED); bf16_t* tmpb = (bf16_t*)(ws + WS_TMPB);
    float* nsaacc = (float*)(ws + WS_NSAACC); bf16_t* obuf = (bf16_t*)(ws + WS_O); bf16_t* act = (bf16_t*)(ws + WS_ACT); bf16_t* tmpf = (bf16_t*)(ws + WS_TMPF);
    float* x = args.out;

    PHASE_BEGIN(0) phase_init(c, args.in[I_X], x, xb, rs); PHASE_END

    for (int layer = 0; layer < DEPTH; ++layer) {
        PHASE_BEGIN(1) phase_cvt(c, args, layer, wb); PHASE_END
        for (int b = 0; b < NBATCH; ++b) {
            const int row0 = b * T;
            PHASE_BEGIN(2) {
                pg8::Gemm g{xb + (size_t)row0 * D, wb + WB_WIN, D, D, D}; pg8::Sched S; S.init(T / 256, NIN / 256, c.G, c.bid, 1, (size_t)256 * D * 2, 0, (size_t)256 * D * 2, 0);
                pg8::EpiInProj E{proj, gates, rs + row0}; pg8::gemm_phase(c.lds, c.tid, g, S, E); } PHASE_END
            PHASE_BEGIN(3) phase_cmp1(c, args, layer, proj, hid); PHASE_END
            PHASE_BEGIN(4) phase_cmp2(c, args, layer, hid, kcmp, vcmp); PHASE_END
            PHASE_BEGIN(5) phase_nsa13(c, args, proj, kcmp, vcmp, nsaacc, ml); PHASE_END
            PHASE_BEGIN(6) phase_nsa_topk(c, args, proj, kcmp, ml, sel); PHASE_END
            PHASE_BEGIN(7) phase_nsa2(c, args, proj, sel, nsaacc, obuf + (size_t)T * 512); PHASE_END
            PHASE_BEGIN(8) phase_swa(c, args, layer, proj, obuf + (size_t)2 * T * 512); PHASE_END
            PHASE_BEGIN(9) phase_rwkv_naive(c, args, layer, proj, obuf); PHASE_END
            PHASE_BEGIN(10) {
                pg8::Gemm g{obuf, wb + WB_WBR, 512, 512, 512}; pg8::Sched S; S.init(T / 256, D / 256, c.G, c.bid, 3, (size_t)256 * 512 * 2, (size_t)T * 512 * 2, (size_t)256 * 512 * 2, (size_t)D * 512 * 2);
                pg8::EpiMerge E{gates, merged}; pg8::gemm_phase(c.lds, c.tid, g, S, E); } PHASE_END
            PHASE_BEGIN(11) {
                pg8::Gemm g{merged, wb + WB_WOUT, D, D, D}; pg8::Sched S; S.init(T / 256, D / 256, c.G, c.bid, 1, (size_t)256 * D * 2, 0, (size_t)256 * D * 2, 0);
                pg8::EpiStore E{tmpb, D}; pg8::gemm_phase(c.lds, c.tid, g, S, E); } PHASE_END
            PHASE_BEGIN(12) phase_norm_res(c, tmpb, args.in[I_NQM] + layer * D, x, xb, rs, row0, T); PHASE_END
        }
        PHASE_BEGIN(13) {
            pg8::Gemm g{xb, wb + WB_WGU, D, D, D}; pg8::Sched S; S.init(MROWS / 256, 2 * FFN / 256, c.G, c.bid, 1, (size_t)256 * D * 2, 0, (size_t)256 * D * 2, 0);
            pg8::EpiSwiGLU E{act, rs}; pg8::gemm_phase(c.lds, c.tid, g, S, E); } PHASE_END
        PHASE_BEGIN(14) {
            pg8::Gemm g{act, wb + WB_WDN, FFN, FFN, FFN}; pg8::Sched S; S.init(MROWS / 256, D / 256, c.G, c.bid, 1, (size_t)256 * FFN * 2, 0, (size_t)256 * FFN * 2, 0);
            pg8::EpiStore E{tmpf, D}; pg8::gemm_phase(c.lds, c.tid, g, S, E); } PHASE_END
        PHASE_BEGIN(15) phase_norm_res(c, tmpf, args.in[I_NQF] + layer * D, x, xb, rs, 0, MROWS); PHASE_END
    }
#undef PHASE_BEGIN
#undef PHASE_END
}

extern "C" void kernel_launch(void* const* d_in, const int* in_sizes, int n_in, void* d_out, int out_size, void* d_ws, size_t ws_size, hipStream_t stream) {
    static int grid = 0;
    if (grid == 0) {
        if (n_in != 30 || out_size != MROWS * D || ws_size < WS_END) { fprintf(stderr, "kernel_launch: unexpected shapes (n_in %d out %d ws %zu)\n", n_in, out_size, ws_size); grid = -1; return; }
        int dev = 0, cus = 0;
        if (hipGetDevice(&dev) != hipSuccess || hipDeviceGetAttribute(&cus, hipDeviceAttributeMultiprocessorCount, dev) != hipSuccess) { grid = -1; return; }
        if (hipFuncSetAttribute((const void*)fwd_kernel, hipFuncAttributeMaxDynamicSharedMemorySize, LDS_BYTES) != hipSuccess) { fprintf(stderr, "hipFuncSetAttribute failed\n"); grid = -1; return; }
        int per_cu = 0;
        if (hipOccupancyMaxActiveBlocksPerMultiprocessor(&per_cu, (const void*)fwd_kernel, 512, LDS_BYTES) != hipSuccess || per_cu < 1) { fprintf(stderr, "occupancy query: %d\n", per_cu); }
        (void)hipGetLastError();
        grid = cus;
    }
    if (grid < 0) return;
    (void)hipMemsetAsync((char*)d_ws + WS_CTL, 0, CTL_BYTES, stream);
    Args a{};
    for (int i = 0; i < 30; ++i) a.in[i] = (const float*)d_in[i];
    a.out = (float*)d_out; a.ws = (unsigned char*)d_ws;
#if MK_ONE_LAUNCH
    a.lo = 0; a.hi = PH_TOTAL;
    hipLaunchKernelGGL(fwd_kernel, dim3(grid), dim3(512), LDS_BYTES, stream, a);
#else
    for (int p = 0; p < PH_TOTAL; ++p) { a.lo = p; a.hi = p + 1; hipLaunchKernelGGL(fwd_kernel, dim3(grid), dim3(512), LDS_BYTES, stream, a); }
#endif
}
```

```cpp
#include <hip/hip_runtime.h>
#include <stdint.h>
#include <stdio.h>

#ifndef MK_ONE_LAUNCH
#define MK_ONE_LAUNCH 1
#endif

#define LAS __attribute__((address_space(3)))
typedef unsigned short bf16_t;
typedef short bf16x8 __attribute__((ext_vector_type(8)));
typedef float f32x4 __attribute__((ext_vector_type(4)));
typedef float f32x2 __attribute__((ext_vector_type(2)));
typedef unsigned u32x4 __attribute__((ext_vector_type(4)));
typedef unsigned u32x2 __attribute__((ext_vector_type(2)));

constexpr int D = 1024, NBATCH = 2, T = 16384, DEPTH = 4, MROWS = NBATCH * T;
constexpr int IN_COLS = 6936, FFN = 2816;
constexpr int PLD = 4096;
constexpr int PC_R = 0, PC_K = 512, PC_V = 1024, PC_ZW = 1536, PC_ZA = 1600, PC_ZG = 1664;
constexpr int PC_NQ = 1792, PC_KC = 2304, PC_VC = 2432, PC_KS = 2560, PC_VS = 2688, PC_KW = 2816, PC_VW = 2944, PC_GL = 3072;
constexpr int PC_SQ = 3328, PC_SK = 3840, PC_SV = 3968;
constexpr int NIN = 7168;
constexpr int NCMP = 1023;
constexpr float NORM_EPS = 1e-6f;

constexpr size_t MiB = 1u << 20;
constexpr size_t WS_CTL = 0, CTL_BYTES = 1 * MiB;
constexpr size_t WS_WB = 1 * MiB;
constexpr size_t WB_WIN = 0, WB_WBR = WB_WIN + (size_t)NIN * D, WB_WOUT = WB_WBR + (size_t)3 * D * 512, WB_WGU = WB_WOUT + (size_t)D * D,
                 WB_WDN = WB_WGU + (size_t)2 * FFN * D, WB_END = WB_WDN + (size_t)D * FFN;
static_assert(WB_END * 2 <= 41 * MiB, "weights");
constexpr size_t WS_XB = 42 * MiB;
constexpr size_t WS_RS = 106 * MiB;
constexpr size_t WS_KCMP = 107 * MiB;
constexpr size_t WS_VCMP = WS_KCMP + 512 * 1024;
constexpr size_t WS_SEL = 108 * MiB;
constexpr size_t WS_ML = 110 * MiB;
constexpr size_t WS_HID = 112 * MiB;
constexpr size_t WS_BIG = 116 * MiB;
constexpr size_t WS_PROJ = WS_BIG;
constexpr size_t WS_GATES = WS_PROJ + 128 * MiB;
constexpr size_t WS_RWKVS = WS_GATES + 96 * MiB;
constexpr size_t WS_MERGED = WS_RWKVS;
constexpr size_t WS_TMPB = WS_RWKVS + 32 * MiB;
constexpr size_t WS_NSAACC = WS_RWKVS + 80 * MiB;
constexpr size_t WS_O = WS_NSAACC + 32 * MiB;
constexpr size_t WS_END = WS_O + 48 * MiB;
constexpr size_t WS_ACT = WS_BIG;
constexpr size_t WS_TMPF = WS_BIG + 176 * MiB;
static_assert(WS_END <= 512 * MiB, "workspace");
static_assert(WS_TMPF + 64 * MiB <= WS_NSAACC, "ffn overlay");

constexpr int LDS_BYTES = 147456;
constexpr int LDS_MISC = 131072 + 8192;

__device__ __forceinline__ float bf2f(unsigned v) { return __uint_as_float(v << 16); }
__device__ __forceinline__ unsigned f2bf(float f) { unsigned u = __float_as_uint(f); return (u + 0x7fffu + ((u >> 16) & 1u)) >> 16; }
__device__ __forceinline__ unsigned pk2(float lo, float hi) { unsigned r; asm volatile("v_cvt_pk_bf16_f32 %0, %1, %2" : "=v"(r) : "v"(lo), "v"(hi)); return r; }
__device__ __forceinline__ void unpack8(const u32x4 w, float (&f)[8]) {
    f[0] = __uint_as_float(w.x << 16); f[1] = __uint_as_float(w.x & 0xffff0000u); f[2] = __uint_as_float(w.y << 16); f[3] = __uint_as_float(w.y & 0xffff0000u);
    f[4] = __uint_as_float(w.z << 16); f[5] = __uint_as_float(w.z & 0xffff0000u); f[6] = __uint_as_float(w.w << 16); f[7] = __uint_as_float(w.w & 0xffff0000u);
}
__device__ __forceinline__ float wave_sum(float v) {
#pragma unroll
    for (int o = 32; o >= 1; o >>= 1) v += __shfl_xor(v, o);
    return v;
}
__device__ __forceinline__ float sigmoidf_(float x) { return 1.0f / (1.0f + __expf(-x)); }
__device__ __forceinline__ int t5_bucket(int n) {
    if (n < 16) return n;
    int b = 16;
    b += (n >= 21); b += (n >= 27); b += (n >= 35); b += (n >= 46); b += (n >= 59); b += (n >= 77); b += (n >= 99); b += (n >= 128);
    b += (n >= 166); b += (n >= 216); b += (n >= 280); b += (n >= 363); b += (n >= 470); b += (n >= 609); b += (n >= 790);
    return b;
}

#define XB_TMO      128
#define XB_XCNT(j)  (256  + 64 * (j))
#define XB_XSUB(j)  (1280 + 64 * (j))
#define XB_XGEN(j)  (2304 + 64 * (j))
#define XB_TOP      3328
#define XB_TOPGEN   3392
#define XCD_BAR_WORDS 3456
#define XB_SPIN_CAP (1u << 22)
__device__ __forceinline__ unsigned xb_ld(unsigned* p)              { return __hip_atomic_load(p, __ATOMIC_RELAXED, __HIP_MEMORY_SCOPE_AGENT); }
__device__ __forceinline__ unsigned xb_add(unsigned* p, unsigned v) { return __hip_atomic_fetch_add(p, v, __ATOMIC_RELAXED, __HIP_MEMORY_SCOPE_AGENT); }
__device__ __forceinline__ unsigned xb_xcc_id() { return (unsigned)__builtin_amdgcn_s_getreg((3 << 11) | 20) & 0xFu; }
#define XB_SPIN(cond, bar) do { unsigned _sp = 0; while (cond) { __builtin_amdgcn_s_sleep(1); \
    if ((++_sp & 255u) == 0u) { if (xb_ld(&(bar)[XB_TMO])) break; if (_sp > XB_SPIN_CAP) { atomicAdd(&(bar)[XB_TMO], 1u); break; } } } } while (0)
struct XcdBarrier { unsigned* bar; unsigned x; volatile LAS unsigned* st; };
__device__ __forceinline__ XcdBarrier xcd_barrier_post(unsigned* bar, volatile LAS unsigned* st) {
    XcdBarrier b; b.bar = bar; b.x = xb_xcc_id(); b.st = st;
    if (threadIdx.x == 0) (void)xb_add(&bar[XB_XCNT(b.x)], 1u);
    return b;
}
__device__ __forceinline__ void xcd_barrier_complete(unsigned* bar, unsigned x, unsigned& nloc, unsigned& nx) {
    const unsigned G = gridDim.x * gridDim.y * gridDim.z;
    unsigned sum, cnt, mine, sp = 0u;
    for (;;) {
        sum = 0u; cnt = 0u; mine = 0u;
#pragma unroll
        for (unsigned j = 0; j < 16; ++j) { const unsigned c = xb_ld(&bar[XB_XCNT(j)]); sum += c; cnt += (c > 0u) ? 1u : 0u; mine = (j == x) ? c : mine; }
        if (sum == G) break;
        __builtin_amdgcn_s_sleep(1);
        if ((++sp & 255u) == 0u) { if (xb_ld(&bar[XB_TMO])) break; if (sp > XB_SPIN_CAP) { atomicAdd(&bar[XB_TMO], 1u); break; } }
    }
    nloc = mine > 0u ? mine : 1u; nx = cnt > 0u ? cnt : 1u;
}
__device__ __forceinline__ void xcd_barrier(const XcdBarrier& b) {
    asm volatile("s_waitcnt vmcnt(0)" ::: "memory");
    __syncthreads();
    if (threadIdx.x == 0) {
        unsigned* bar = b.bar;
        __builtin_amdgcn_s_waitcnt(0);
        unsigned nloc = b.st[0], nx = b.st[1];
        if (nloc == 0u) { xcd_barrier_complete(bar, b.x, nloc, nx); b.st[0] = nloc; b.st[1] = nx; }
        const unsigned old = xb_add(&bar[XB_XSUB(b.x)], 1u);
        const unsigned gen = old / nloc;
        if (old + 1u == (gen + 1u) * nloc) {
            __builtin_amdgcn_fence(__ATOMIC_RELEASE, "agent");
            asm volatile("s_waitcnt vmcnt(0)" ::: "memory");
            const unsigned og = xb_add(&bar[XB_TOP], 1u);
            const unsigned tg = og / nx;
            if (og + 1u == (tg + 1u) * nx) xb_add(&bar[XB_TOPGEN], 1u);
            else XB_SPIN(xb_ld(&bar[XB_TOPGEN]) == tg, bar);
            __builtin_amdgcn_fence(__ATOMIC_ACQUIRE, "agent");
            xb_add(&bar[XB_XGEN(b.x)], 1u);
            asm volatile("s_waitcnt vmcnt(0)" ::: "memory");
        } else {
            XB_SPIN(xb_ld(&bar[XB_XGEN(b.x)]) == gen, bar);
            __builtin_amdgcn_fence(__ATOMIC_ACQUIRE, "agent");
            asm volatile("s_waitcnt vmcnt(0)" ::: "memory");
        }
    }
    __syncthreads();
}

namespace pg8 {
constexpr int BM = 256, BK = 64, HALF = 128, HTB = HALF * BK * 2, STAGE_BYTES = 8 * HTB, NXCD = 8, WGM = 8;
__device__ __forceinline__ int lds_byte(int r, int c) { const int st = (r >> 4) * 2 + (c >> 5), rr = r & 15, cc = c & 31, ob = rr * 64 + cc * 2; return st * 1024 + (ob ^ (((ob >> 9) & 1) << 5)); }
__device__ __forceinline__ void stage_rc(int b, int& R, int& C) { const int st = b / 1024, sb = b % 1024, swz = sb ^ (((sb >> 9) & 1) << 5); R = (st >> 1) * 16 + swz / 64; C = (st & 1) * 32 + (swz % 64) / 2; }
__device__ __forceinline__ int perm32(int rho) { const int n = rho >> 4, i = rho & 15; return 8 * (i >> 2) + 4 * n + (i & 3); }

struct Unit { int pm, pn, sub; unsigned aoff, boff; };
struct Gemm { const bf16_t* A; const bf16_t* Bt; int lda, ldb, K; };
struct Sched {
    int nM, nN, nwg, G, c, nsub; unsigned a_row, a_sub, b_row, b_sub;
    __device__ __forceinline__ void init(int nM_, int nN_, int G_, int c_, int nsub_, unsigned a_row_, unsigned a_sub_, unsigned b_row_, unsigned b_sub_) {
        nM = nM_; nN = nN_; nwg = nM * nN; G = G_; c = c_; nsub = nsub_; a_row = a_row_; a_sub = a_sub_; b_row = b_row_; b_sub = b_sub_; }
    __device__ __forceinline__ bool next(int i, Unit& u) const {
        const int round = i / nsub; u.sub = i - round * nsub;
        const long L = (long)round * G + c; if (L >= nwg) return false;
        int wgid = (int)L; { const int q = nwg / NXCD, r = nwg % NXCD, xcd = wgid % NXCD, off = wgid / NXCD; wgid = (xcd < r ? xcd * (q + 1) : r * (q + 1) + (xcd - r) * q) + off; }
        const int nig = WGM * nN, gid = wgid / nig, fm = gid * WGM, gsz = (nM - fm) < WGM ? (nM - fm) : WGM;
        u.pm = fm + ((wgid % nig) % gsz); u.pn = (wgid % nig) / gsz;
        u.aoff = (unsigned)u.pm * a_row + (unsigned)u.sub * a_sub; u.boff = (unsigned)u.pn * b_row + (unsigned)u.sub * b_sub; return true;
    }
};

template <class Epi>
__device__ __forceinline__ void gemm_phase(LAS unsigned char* lds, const int tid, const Gemm g, const Sched& S, const Epi& E) {
    const int wid = __builtin_amdgcn_readfirstlane(tid >> 6), lane = tid & 63, wr = wid >> 2, wc = wid & 3, fr = lane & 15, fq = lane >> 4;
    const int K = g.K, nt = K / BK;
    unsigned voffA[2], voffB[2];
#pragma unroll
    for (int i = 0; i < 2; ++i) { int R, C; stage_rc(tid * 16 + i * 8192, R, C); const int Rb = Epi::PERM ? ((R & ~31) + perm32(R & 31)) : R;
        voffA[i] = (unsigned)(R * g.lda + C) * 2u; voffB[i] = (unsigned)(Rb * g.ldb + C) * 2u; }
    const size_t kstep = (size_t)(BK * 2);
    const size_t hstepA = (size_t)HALF * g.lda * 2, hstepB = (size_t)HALF * g.ldb * 2;
    const unsigned ldsw = (unsigned)wid * 1024u;
    const int aoff = lds_byte(wr * 64 + fr, fq * 8), boff = lds_byte(wc * 32 + fr, fq * 8);
#define PG8_SA(b, h) (((b) * 2 + (h)) * HTB)
#define PG8_SB(b, h) ((4 + (b) * 2 + (h)) * HTB)
#define PG8_STAGE(bufoff, gbase, voff) do { _Pragma("unroll") for (int _i = 0; _i < 2; ++_i) \
        __builtin_amdgcn_global_load_lds((const unsigned*)((const char*)(gbase) + (voff)[_i]), (LAS unsigned*)(lds + (bufoff) + ldsw + _i * 8192), 16, 0, 0); } while (0)
#define PG8_LDA(dst, b, h) do { _Pragma("unroll") for (int m = 0; m < 4; ++m) _Pragma("unroll") for (int k = 0; k < 2; ++k) dst[m][k] = *(const LAS bf16x8*)(lds + PG8_SA(b, h) + aoff + m * 2048 + k * 1024); } while (0)
#define PG8_LDB(dst, b, h) do { _Pragma("unroll") for (int n = 0; n < 2; ++n) _Pragma("unroll") for (int k = 0; k < 2; ++k) dst[n][k] = *(const LAS bf16x8*)(lds + PG8_SB(b, h) + boff + n * 2048 + k * 1024); } while (0)
#define PG8_MMA(ai, bj, At, Bt) do { __builtin_amdgcn_s_setprio(1); _Pragma("unroll") for (int m = 0; m < 4; ++m) _Pragma("unroll") for (int n = 0; n < 2; ++n) _Pragma("unroll") for (int k = 0; k < 2; ++k) \
        acc[ai][bj][m][n] = __builtin_amdgcn_mfma_f32_16x16x32_bf16(Bt[n][k], At[m][k], acc[ai][bj][m][n], 0, 0, 0); __builtin_amdgcn_s_setprio(0); } while (0)
#define PG8_WAIT_V(n) asm volatile("s_waitcnt vmcnt(" #n ")" ::: "memory")
#define PG8_WAIT_L(n) asm volatile("s_waitcnt lgkmcnt(" #n ")" ::: "memory")
#define PG8_BAR __builtin_amdgcn_s_barrier()
#define PG8_SCHED __builtin_amdgcn_sched_barrier(0)
    Unit cur, nxt; int ui = 0;
    if (!S.next(0, cur)) return;
    f32x4 acc[2][2][4][2];
#pragma unroll
    for (int a = 0; a < 2; ++a)
#pragma unroll
        for (int b = 0; b < 2; ++b)
#pragma unroll
            for (int m = 0; m < 4; ++m)
#pragma unroll
                for (int n = 0; n < 2; ++n) acc[a][b][m][n] = (f32x4){0.f, 0.f, 0.f, 0.f};
    bf16x8 At[4][2], B0[2][2], B1[2][2];
    const char* cA = (const char*)g.A + cur.aoff; const char* cB = (const char*)g.Bt + cur.boff;
    PG8_STAGE(PG8_SB(0, 0), cB, voffB); PG8_STAGE(PG8_SA(0, 0), cA, voffA); PG8_STAGE(PG8_SB(0, 1), cB + hstepB, voffB); PG8_STAGE(PG8_SA(0, 1), cA + hstepA, voffA);
    if (wr == 1) PG8_BAR;
    PG8_WAIT_V(4); PG8_BAR;
    PG8_STAGE(PG8_SB(1, 0), cB + kstep, voffB); PG8_STAGE(PG8_SA(1, 0), cA + kstep, voffA); PG8_STAGE(PG8_SB(1, 1), cB + hstepB + kstep, voffB);
    PG8_WAIT_V(6); PG8_BAR;
    for (;;) {
        const bool has_next = S.next(ui + 1, nxt);
        const char* nA = has_next ? (const char*)g.A + nxt.aoff : cA; const char* nB = has_next ? (const char*)g.Bt + nxt.boff : cB;
        for (int t = 0; t < nt; t += 2) {
            const bool last = (t == nt - 2);
            const char* a1 = cA + (size_t)(t + 1) * kstep;
            const char* a2 = last ? nA : cA + (size_t)(t + 2) * kstep; const char* b2 = last ? nB : cB + (size_t)(t + 2) * kstep;
            const char* a3 = a2 + kstep; const char* b3 = b2 + kstep;
            PG8_LDB(B0, 0, 0); PG8_SCHED; PG8_LDA(At, 0, 0); PG8_STAGE(PG8_SA(1, 1), a1 + hstepA, voffA);
            PG8_WAIT_L(8); PG8_BAR; PG8_WAIT_L(0); PG8_MMA(0, 0, At, B0); PG8_BAR; PG8_SCHED;
            PG8_LDB(B1, 0, 1); PG8_STAGE(PG8_SB(0, 0), b2, voffB);
            PG8_BAR; PG8_WAIT_L(0); PG8_MMA(0, 1, At, B1); PG8_BAR;
            PG8_LDA(At, 0, 1); PG8_STAGE(PG8_SA(0, 0), a2, voffA);
            PG8_BAR; PG8_WAIT_L(0); PG8_MMA(1, 0, At, B0); PG8_BAR; PG8_SCHED;
            PG8_STAGE(PG8_SB(0, 1), b2 + hstepB, voffB);
            PG8_WAIT_V(6); PG8_BAR; PG8_MMA(1, 1, At, B1); PG8_BAR;
            PG8_LDB(B0, 1, 0); PG8_SCHED; PG8_LDA(At, 1, 0); PG8_STAGE(PG8_SA(0, 1), a2 + hstepA, voffA);
            PG8_WAIT_L(8); PG8_BAR; PG8_WAIT_L(0); PG8_MMA(0, 0, At, B0); PG8_BAR; PG8_SCHED;
            PG8_LDB(B1, 1, 1); PG8_STAGE(PG8_SB(1, 0), b3, voffB);
            PG8_BAR; PG8_WAIT_L(0); PG8_MMA(0, 1, At, B1); PG8_BAR;
            PG8_LDA(At, 1, 1); PG8_STAGE(PG8_SA(1, 0), a3, voffA);
            PG8_BAR; PG8_WAIT_L(0); PG8_MMA(1, 0, At, B0); PG8_BAR; PG8_SCHED;
            PG8_STAGE(PG8_SB(1, 1), b3 + hstepB, voffB);
            PG8_WAIT_V(6); PG8_BAR; PG8_MMA(1, 1, At, B1); PG8_BAR;
        }
        const bool keep = E(acc, cur, wr, wc, fr, fq);
        if (!has_next) break;
        if (!keep) {
#pragma unroll
            for (int a = 0; a < 2; ++a)
#pragma unroll
                for (int b = 0; b < 2; ++b)
#pragma unroll
                    for (int m = 0; m < 4; ++m)
#pragma unroll
                        for (int n = 0; n < 2; ++n) acc[a][b][m][n] = (f32x4){0.f, 0.f, 0.f, 0.f};
        }
        cur = nxt; cA = nA; cB = nB; ++ui;
    }
    PG8_WAIT_V(0);
    if (wr == 0) PG8_BAR;
    PG8_BAR;
#undef PG8_SA
#undef PG8_SB
#undef PG8_STAGE
#undef PG8_LDA
#undef PG8_LDB
#undef PG8_MMA
#undef PG8_WAIT_V
#undef PG8_WAIT_L
#undef PG8_BAR
#undef PG8_SCHED
}

struct EpiInProj {
    static constexpr bool PERM = true;
    bf16_t* proj; bf16_t* gates; const float* rs;
    __device__ __forceinline__ bool operator()(f32x4 (&acc)[2][2][4][2], const Unit& u, int wr, int wc, int fr, int fq) const {
        const int row0 = u.pm * BM + wr * 64 + fr; const bool is_gate = u.pn >= 16;
        bf16_t* base = is_gate ? gates + (u.pn - 16) * 256 : proj + u.pn * 256; const int ld = is_gate ? 3072 : PLD;
        const int col0 = wc * 32 + 8 * fq;
#pragma unroll
        for (int ai = 0; ai < 2; ++ai)
#pragma unroll
            for (int m = 0; m < 4; ++m) { const int row = row0 + ai * HALF + m * 16; const float s = rs[row]; bf16_t* rowp = base + (size_t)row * ld + col0;
#pragma unroll
                for (int bj = 0; bj < 2; ++bj) { f32x4 v0 = acc[ai][bj][m][0] * s, v1 = acc[ai][bj][m][1] * s;
                    if (is_gate) {
#pragma unroll
                        for (int j = 0; j < 4; ++j) { v0[j] = sigmoidf_(v0[j]); v1[j] = sigmoidf_(v1[j]); } }
                    u32x4 w; w.x = pk2(v0[0], v0[1]); w.y = pk2(v0[2], v0[3]); w.z = pk2(v1[0], v1[1]); w.w = pk2(v1[2], v1[3]);
                    *(u32x4*)(rowp + bj * HALF) = w; } }
        return false;
    }
};
struct EpiStore {
    static constexpr bool PERM = true;
    bf16_t* out; int ld;
    __device__ __forceinline__ bool operator()(f32x4 (&acc)[2][2][4][2], const Unit& u, int wr, int wc, int fr, int fq) const {
        const int row0 = u.pm * BM + wr * 64 + fr; const int col0 = u.pn * BM + wc * 32 + 8 * fq;
#pragma unroll
        for (int ai = 0; ai < 2; ++ai)
#pragma unroll
            for (int m = 0; m < 4; ++m) { bf16_t* rowp = out + (size_t)(row0 + ai * HALF + m * 16) * ld + col0;
#pragma unroll
                for (int bj = 0; bj < 2; ++bj) { const f32x4 v0 = acc[ai][bj][m][0], v1 = acc[ai][bj][m][1];
                    u32x4 w; w.x = pk2(v0[0], v0[1]); w.y = pk2(v0[2], v0[3]); w.z = pk2(v1[0], v1[1]); w.w = pk2(v1[2], v1[3]);
                    *(u32x4*)(rowp + bj * HALF) = w; } }
        return false;
    }
};
struct EpiMerge {
    static constexpr bool PERM = true;
    const bf16_t* gates; bf16_t* merged;
    __device__ __forceinline__ bool operator()(f32x4 (&acc)[2][2][4][2], const Unit& u, int wr, int wc, int fr, int fq) const {
        const int row0 = u.pm * BM + wr * 64 + fr; const int col0 = u.pn * BM + wc * 32 + 8 * fq; const int sub = u.sub;
#pragma unroll
        for (int ai = 0; ai < 2; ++ai)
#pragma unroll
            for (int m = 0; m < 4; ++m) { const int row = row0 + ai * HALF + m * 16; const bf16_t* gp = gates + (size_t)row * 3072 + sub * 1024 + col0;
#pragma unroll
                for (int bj = 0; bj < 2; ++bj) {
                    float sc[8], sn[8]; unpack8(*(const u32x4*)(gp + bj * HALF), sc);
                    if (sub < 2) { unpack8(*(const u32x4*)(gp + 1024 + bj * HALF), sn);
#pragma unroll
                        for (int j = 0; j < 8; ++j) sc[j] = sc[j] / fmaxf(sn[j], 1e-30f); }
                    f32x4 v0 = acc[ai][bj][m][0], v1 = acc[ai][bj][m][1];
#pragma unroll
                    for (int j = 0; j < 4; ++j) { v0[j] *= sc[j]; v1[j] *= sc[4 + j]; }
                    acc[ai][bj][m][0] = v0; acc[ai][bj][m][1] = v1;
                    if (sub == 2) { u32x4 w; w.x = pk2(v0[0], v0[1]); w.y = pk2(v0[2], v0[3]); w.z = pk2(v1[0], v1[1]); w.w = pk2(v1[2], v1[3]);
                        *(u32x4*)(merged + (size_t)row * D + col0 + bj * HALF) = w; } } }
        return sub != 2;
    }
};
struct EpiSwiGLU {
    static constexpr bool PERM = true;
    bf16_t* act; const float* rs;
    __device__ __forceinline__ bool operator()(f32x4 (&acc)[2][2][4][2], const Unit& u, int wr, int wc, int fr, int fq) const {
        const int row0 = u.pm * BM + wr * 64 + fr; const int col0 = u.pn * HALF + wc * 32 + 8 * fq;
#pragma unroll
        for (int ai = 0; ai < 2; ++ai)
#pragma unroll
            for (int m = 0; m < 4; ++m) { const int row = row0 + ai * HALF + m * 16; const float s = rs[row];
                float o[8];
#pragma unroll
                for (int n = 0; n < 2; ++n)
#pragma unroll
                    for (int j = 0; j < 4; ++j) { const float gg = acc[ai][0][m][n][j] * s, uu = acc[ai][1][m][n][j] * s; o[n * 4 + j] = gg * sigmoidf_(gg) * uu; }
                u32x4 w; w.x = pk2(o[0], o[1]); w.y = pk2(o[2], o[3]); w.z = pk2(o[4], o[5]); w.w = pk2(o[6], o[7]);
                *(u32x4*)(act + (size_t)row * FFN + col0) = w; }
        return false;
    }
};
}

struct Args { const float* in[30]; float* out; unsigned char* ws; int lo, hi; };
enum { I_X = 0, I_NPM, I_NQM, I_NPF, I_NQF, I_WIN, I_MU, I_W0, I_W2, I_A0, I_A2, I_G2, I_KK, I_KA, I_RK, I_LNW, I_LNB, I_PEK, I_PEV, I_CKW1, I_CKW2, I_CVW1, I_CVW2, I_SINK, I_REL, I_WBR, I_WOUT, I_FG, I_FU, I_FD };

struct Ctx { LAS unsigned char* lds; int tid, lane, wave, G, bid; };

__device__ __forceinline__ void phase_init(const Ctx& c, const float* x, float* xo, bf16_t* xb, float* rs) {
    const int gw = c.bid * 8 + c.wave, NGW = c.G * 8;
    for (int row = gw; row < MROWS; row += NGW) {
        const float* xr = x + (size_t)row * D; float ss = 0.f;
#pragma unroll
        for (int j = 0; j < 2; ++j) { const int e = c.lane * 8 + 512 * j; const f32x4 a = *(const f32x4*)(xr + e), b = *(const f32x4*)(xr + e + 4);
            ss += a[0] * a[0] + a[1] * a[1] + a[2] * a[2] + a[3] * a[3] + b[0] * b[0] + b[1] * b[1] + b[2] * b[2] + b[3] * b[3];
            *(f32x4*)(xo + (size_t)row * D + e) = a; *(f32x4*)(xo + (size_t)row * D + e + 4) = b;
            u32x4 w; w.x = pk2(a[0], a[1]); w.y = pk2(a[2], a[3]); w.z = pk2(b[0], b[1]); w.w = pk2(b[2], b[3]); *(u32x4*)(xb + (size_t)row * D + e) = w; }
        ss = wave_sum(ss);
        if (c.lane == 0) rs[row] = rsqrtf(ss * (1.0f / D) + NORM_EPS);
    }
}
__device__ __forceinline__ void phase_norm_res(const Ctx& c, const bf16_t* y, const float* gain, float* x, bf16_t* xb, float* rs, int row0, int nrows) {
    const int gw = c.bid * 8 + c.wave, NGW = c.G * 8;
    for (int r = gw; r < nrows; r += NGW) {
        const int row = row0 + r; float yv[16]; float ss = 0.f;
#pragma unroll
        for (int j = 0; j < 2; ++j) { float f[8]; unpack8(*(const u32x4*)(y + (size_t)r * D + c.lane * 8 + 512 * j), f);
#pragma unroll
            for (int k = 0; k < 8; ++k) { yv[j * 8 + k] = f[k]; ss += f[k] * f[k]; } }
        ss = wave_sum(ss); const float sc = rsqrtf(ss * (1.0f / D) + NORM_EPS); float s2 = 0.f;
#pragma unroll
        for (int j = 0; j < 2; ++j) { const int e = c.lane * 8 + 512 * j; float* xr = x + (size_t)row * D + e;
            f32x4 a = *(const f32x4*)xr, b = *(const f32x4*)(xr + 4); const f32x4 ga = *(const f32x4*)(gain + e), gb = *(const f32x4*)(gain + e + 4);
#pragma unroll
            for (int k = 0; k < 4; ++k) { a[k] += yv[j * 8 + k] * sc * ga[k]; b[k] += yv[j * 8 + 4 + k] * sc * gb[k]; s2 += a[k] * a[k] + b[k] * b[k]; }
            *(f32x4*)xr = a; *(f32x4*)(xr + 4) = b;
            u32x4 w; w.x = pk2(a[0], a[1]); w.y = pk2(a[2], a[3]); w.z = pk2(b[0], b[1]); w.w = pk2(b[2], b[3]); *(u32x4*)(xb + (size_t)row * D + e) = w; }
        s2 = wave_sum(s2);
        if (c.lane == 0) rs[row] = rsqrtf(s2 * (1.0f / D) + NORM_EPS);
    }
}

__device__ __forceinline__ float cvt_fetch(const Args& a, int layer, int kind, int sub, int k, int n) {
    switch (kind) {
    case 0: { int src; float sc = a.in[I_NPM][layer * D + k];
        if (n < 3096) src = n; else if (n < 3328) return 0.f; else if (n < 4096) src = 3096 + (n - 3328); else src = 3864 + (n - 4096);
        if ((n >= PC_NQ && n < PC_NQ + 512) || (n >= PC_SQ && n < PC_SQ + 512)) sc *= 0.125f;
        return a.in[I_WIN][((size_t)layer * D + k) * IN_COLS + src] * sc; }
    case 1: return a.in[I_WBR][(((size_t)layer * 3 + sub) * 512 + k) * D + n];
    case 2: return a.in[I_WOUT][((size_t)layer * D + k) * D + n];
    case 3: { const int pn = n >> 8, r = n & 255; const float sc = a.in[I_NPF][layer * D + k];
        return (r < 128 ? a.in[I_FG][((size_t)layer * D + k) * FFN + pn * 128 + r] : a.in[I_FU][((size_t)layer * D + k) * FFN + pn * 128 + r - 128]) * sc; }
    default: return a.in[I_FD][((size_t)layer * FFN + k) * D + n];
    }
}
__device__ __forceinline__ void phase_cvt(const Ctx& c, const Args& a, int layer, bf16_t* wb) {
    LAS float* tile = (LAS float*)c.lds;
    constexpr int I0 = 16 * 112, I1 = 3 * 8 * 16, I2 = 16 * 16, I3 = 16 * 88, I4 = 44 * 16, NIT = I0 + I1 + I2 + I3 + I4;
    for (int it = c.bid; it < NIT; it += c.G) {
        int r = it, kind, sub = 0, K, nblk; bf16_t* dst;
        if (r < I0) { kind = 0; K = D; nblk = 112; dst = wb + WB_WIN; }
        else if ((r -= I0) < I1) { kind = 1; sub = r / 128; r -= sub * 128; K = 512; nblk = 16; dst = wb + WB_WBR + (size_t)sub * D * 512; }
        else if ((r -= I1) < I2) { kind = 2; K = D; nblk = 16; dst = wb + WB_WOUT; }
        else if ((r -= I2) < I3) { kind = 3; K = D; nblk = 88; dst = wb + WB_WGU; }
        else { r -= I3; kind = 4; K = FFN; nblk = 16; dst = wb + WB_WDN; }
        const int kb = r / nblk, nb = r % nblk, k0 = kb * 64, n0 = nb * 64;
        for (int e = c.tid; e < 4096; e += 512) { const int kk = e >> 6, nn = e & 63; tile[kk * 65 + nn] = cvt_fetch(a, layer, kind, sub, k0 + kk, n0 + nn); }
        __syncthreads();
        for (int e = c.tid; e < 2048; e += 512) { const int nn = e >> 5, kp = (e & 31) * 2;
            *(unsigned*)(dst + (size_t)(n0 + nn) * K + k0 + kp) = pk2(tile[kp * 65 + nn], tile[(kp + 1) * 65 + nn]); }
        __syncthreads();
    }
}

struct RowState { float q[64]; float o[64]; float m, l; };
__device__ __forceinline__ void row_init(RowState& s, const bf16_t* qp) {
#pragma unroll
    for (int i = 0; i < 8; ++i) { float f[8]; unpack8(*(const u32x4*)(qp + i * 8), f);
#pragma unroll
        for (int k = 0; k < 8; ++k) s.q[i * 8 + k] = f[k]; }
}
__device__ __forceinline__ void row_reset(RowState& s) {
#pragma unroll
    for (int i = 0; i < 64; ++i) s.o[i] = 0.f;
    s.m = -1e30f; s.l = 0.f;
}
__device__ __forceinline__ void row_key_bf16(RowState& s, const bf16_t* kp, const bf16_t* vp, float bias) {
    float sc = bias;
#pragma unroll
    for (int i = 0; i < 8; ++i) { float f[8]; unpack8(*(const u32x4*)(kp + i * 8), f);
#pragma unroll
        for (int k = 0; k < 8; ++k) sc += s.q[i * 8 + k] * f[k];
        if ((i & 1) == 1) __builtin_amdgcn_sched_barrier(0); }
    const float mn = fmaxf(s.m, sc), corr = __expf(s.m - mn), p = __expf(sc - mn);
    s.l = s.l * corr + p; s.m = mn;
#pragma unroll
    for (int i = 0; i < 8; ++i) { float f[8]; unpack8(*(const u32x4*)(vp + i * 8), f);
#pragma unroll
        for (int k = 0; k < 8; ++k) s.o[i * 8 + k] = s.o[i * 8 + k] * corr + p * f[k];
        if ((i & 1) == 1) __builtin_amdgcn_sched_barrier(0); }
}
__device__ __forceinline__ void row_key_f32(RowState& s, const float* kp, const float* vp, float bias) {
    float sc = bias;
#pragma unroll
    for (int i = 0; i < 16; ++i) { const f32x4 f = *(const f32x4*)(kp + i * 4); sc += s.q[i * 4] * f[0] + s.q[i * 4 + 1] * f[1] + s.q[i * 4 + 2] * f[2] + s.q[i * 4 + 3] * f[3];
        if ((i & 3) == 3) __builtin_amdgcn_sched_barrier(0); }
    const float mn = fmaxf(s.m, sc), corr = __expf(s.m - mn), p = __expf(sc - mn);
    s.l = s.l * corr + p; s.m = mn;
#pragma unroll
    for (int i = 0; i < 16; ++i) { const f32x4 f = *(const f32x4*)(vp + i * 4);
#pragma unroll
        for (int k = 0; k < 4; ++k) s.o[i * 4 + k] = s.o[i * 4 + k] * corr + p * f[k];
        if ((i & 3) == 3) __builtin_amdgcn_sched_barrier(0); }
}

__device__ __forceinline__ float gelu_tanh(float x) { const float t = tanhf(0.7978845608028654f * (x + 0.044715f * x * x * x)); return 0.5f * x * (1.0f + t); }
__device__ __forceinline__ void phase_cmp1(const Ctx& c, const Args& a, int layer, const bf16_t* proj, float* hid) {
    for (int unit = c.bid; unit < 2048; unit += c.G) {
        const int kv = unit >> 10, g = (unit >> 9) & 1, cp = unit & 511; const int cc = cp * 2 + (c.tid >> 8), u = c.tid & 255;
        if (cc >= NCMP) continue;
        const float* w1 = a.in[kv ? I_CVW1 : I_CKW1] + (size_t)layer * 2048 * 256; const float* pe = a.in[kv ? I_PEV : I_PEK] + (size_t)layer * 32 * 64;
        const bf16_t* xp = proj + (size_t)(16 * cc) * PLD + (kv ? PC_VC : PC_KC) + g * 64;
        float acc = 0.f;
        for (int l = 0; l < 32; ++l) {
#pragma unroll
            for (int i = 0; i < 8; ++i) { float f[8]; unpack8(*(const u32x4*)(xp + (size_t)l * PLD + i * 8), f);
#pragma unroll
                for (int k = 0; k < 8; ++k) acc += (f[k] + pe[l * 64 + i * 8 + k]) * w1[(size_t)(l * 64 + i * 8 + k) * 256 + u]; }
        }
        hid[(((size_t)kv * 2 + g) * 1024 + cc) * 256 + u] = gelu_tanh(acc);
    }
}
__device__ __forceinline__ void phase_cmp2(const Ctx& c, const Args& a, int layer, const float* hid, float* kcmp, float* vcmp) {
    for (int unit = c.bid; unit < 512; unit += c.G) {
        const int kv = unit >> 8, g = (unit >> 7) & 1, cc = (unit & 127) * 8 + (c.tid >> 6), d = c.tid & 63;
        if (cc >= NCMP) continue;
        const float* w2 = a.in[kv ? I_CVW2 : I_CKW2] + (size_t)layer * 256 * 64; const float* hp = hid + (((size_t)kv * 2 + g) * 1024 + cc) * 256;
        float acc = 0.f;
        for (int u = 0; u < 256; ++u) acc += hp[u] * w2[u * 64 + d];
        (kv ? vcmp : kcmp)[((size_t)g * 1024 + cc) * 64 + d] = acc;
    }
}
__device__ __forceinline__ void phase_nsa13(const Ctx& c, const Args& a, const bf16_t* proj, const float* kcmp, const float* vcmp, float* nsaacc, float* ml) {
    LAS float* tb = (LAS float*)c.lds;
    for (int e = c.tid; e < 512; e += 512) tb[e] = a.in[I_REL][e];
    __syncthreads();
    for (int unit = c.bid; unit < T / 64; unit += c.G) {
        const int hh = c.tid >> 6, t = unit * 64 + (c.tid & 63), g = hh >> 2;
        RowState s; row_init(s, proj + (size_t)t * PLD + PC_NQ + hh * 64);
        const bf16_t* glp = proj + (size_t)t * PLD + PC_GL;
        const float g0 = sigmoidf_(bf2f(glp[hh])), g2 = sigmoidf_(bf2f(glp[16 + hh]));
        row_reset(s);
        const int nv = t >= 31 ? (t - 31) / 16 + 1 : 0;
        for (int cc = 0; cc < nv; ++cc) { const float bias = tb[t5_bucket(t - 16 * cc - 31) * 16 + hh];
            row_key_f32(s, kcmp + ((size_t)g * 1024 + cc) * 64, vcmp + ((size_t)g * 1024 + cc) * 64, bias); }
        ml[((size_t)t * 8 + hh) * 2] = s.m; ml[((size_t)t * 8 + hh) * 2 + 1] = s.l;
        float* op = nsaacc + (size_t)t * 512 + hh * 64;
        { const float inv = s.l > 0.f ? g0 / s.l : 0.f;
#pragma unroll
            for (int i = 0; i < 16; ++i) { f32x4 w; w[0] = s.o[i * 4] * inv; w[1] = s.o[i * 4 + 1] * inv; w[2] = s.o[i * 4 + 2] * inv; w[3] = s.o[i * 4 + 3] * inv; *(f32x4*)(op + i * 4) = w; } }
        row_reset(s);
        const int s0 = t - 511 > 0 ? t - 511 : 0;
        for (int sp = s0; sp <= t; ++sp) { const float bias = tb[t5_bucket(t - sp) * 16 + hh];
            row_key_bf16(s, proj + (size_t)sp * PLD + PC_KW + g * 64, proj + (size_t)sp * PLD + PC_VW + g * 64, bias); }
        { const float inv = s.l > 0.f ? g2 / s.l : 0.f;
#pragma unroll
            for (int i = 0; i < 16; ++i) { f32x4 w = *(const f32x4*)(op + i * 4); w[0] += s.o[i * 4] * inv; w[1] += s.o[i * 4 + 1] * inv; w[2] += s.o[i * 4 + 2] * inv; w[3] += s.o[i * 4 + 3] * inv; *(f32x4*)(op + i * 4) = w; } }
    }
}
__device__ __forceinline__ void phase_nsa_topk(const Ctx& c, const Args& a, const bf16_t* proj, const float* kcmp, const float* ml, int* sel) {
    LAS float* tb = (LAS float*)c.lds;
    LAS float* qs = (LAS float*)(c.lds + 4096) + c.wave * 256;
    LAS float* sv = (LAS float*)(c.lds + 16384) + c.wave * 256;
    for (int e = c.tid; e < 512; e += 512) tb[e] = a.in[I_REL][e];
    __syncthreads();
    const int gw = c.bid * 8 + c.wave, NGW = c.G * 8;
    for (int item = gw; item < T * 2; item += NGW) {
        const int t = item >> 1, g = item & 1, cur = t >> 6;
        { const bf16_t* qp = proj + (size_t)t * PLD + PC_NQ + g * 256 + c.lane * 4; const u32x2 w = *(const u32x2*)qp;
          qs[c.lane * 4] = __uint_as_float(w.x << 16); qs[c.lane * 4 + 1] = __uint_as_float(w.x & 0xffff0000u); qs[c.lane * 4 + 2] = __uint_as_float(w.y << 16); qs[c.lane * 4 + 3] = __uint_as_float(w.y & 0xffff0000u); }
        float mr[4], il[4];
#pragma unroll
        for (int r = 0; r < 4; ++r) { mr[r] = ml[((size_t)t * 8 + g * 4 + r) * 2]; const float l = ml[((size_t)t * 8 + g * 4 + r) * 2 + 1]; il[r] = l > 0.f ? 1.0f / l : 0.f; }
        const int nv = t >= 31 ? (t - 31) / 16 + 1 : 0;
        asm volatile("s_waitcnt lgkmcnt(0)" ::: "memory");
#pragma unroll 1
        for (int jj = 0; jj < 4; ++jj) {
            const int j = c.lane + 64 * jj; float sc;
            if (j == 0 || j == cur || j == cur - 1) sc = 1e4f;
            else if (j > cur) sc = -1.0f;
            else { sc = 0.f;
#pragma unroll 1
                for (int o = 0; o < 5; ++o) { const int cc = 4 * j + o - 1; if (cc < 0 || cc >= nv) continue;
                    const float* kp = kcmp + ((size_t)g * 1024 + cc) * 64; float d0 = 0.f, d1 = 0.f, d2 = 0.f, d3 = 0.f;
#pragma unroll 4
                    for (int i = 0; i < 16; ++i) { const f32x4 f = *(const f32x4*)(kp + i * 4);
#pragma unroll
                        for (int k = 0; k < 4; ++k) { d0 += qs[i * 4 + k] * f[k]; d1 += qs[64 + i * 4 + k] * f[k]; d2 += qs[128 + i * 4 + k] * f[k]; d3 += qs[192 + i * 4 + k] * f[k]; } }
                    const int bk = t5_bucket(t - 16 * cc - 31) * 16 + g * 4;
                    const float imp = __expf(d0 + tb[bk] - mr[0]) * il[0] + __expf(d1 + tb[bk + 1] - mr[1]) * il[1] + __expf(d2 + tb[bk + 2] - mr[2]) * il[2] + __expf(d3 + tb[bk + 3] - mr[3]) * il[3];
                    sc += ((o == 0 || o == 4) ? 1.0f : 2.0f) * imp; }
            }
            sv[j] = sc;
        }
        asm volatile("s_waitcnt lgkmcnt(0)" ::: "memory");
        float val[4];
#pragma unroll
        for (int jj = 0; jj < 4; ++jj) val[jj] = sv[c.lane + 64 * jj];
        for (int k = 0; k < 16; ++k) {
            float bv = val[0]; int bi = c.lane;
#pragma unroll
            for (int jj = 1; jj < 4; ++jj) if (val[jj] > bv) { bv = val[jj]; bi = c.lane + 64 * jj; }
#pragma unroll
            for (int o = 32; o >= 1; o >>= 1) { const float ov = __shfl_xor(bv, o); const int oi = __shfl_xor(bi, o); if (ov > bv || (ov == bv && oi < bi)) { bv = ov; bi = oi; } }
#pragma unroll
            for (int jj = 0; jj < 4; ++jj) if (bi == c.lane + 64 * jj) val[jj] = -3e38f;
            if (c.lane == 0) sel[(size_t)item * 16 + k] = bi;
        }
    }
}
__device__ __forceinline__ void phase_nsa2(const Ctx& c, const Args& a, const bf16_t* proj, const int* sel, const float* nsaacc, bf16_t* onsa) {
    LAS float* tb = (LAS float*)c.lds;
    for (int e = c.tid; e < 512; e += 512) tb[e] = a.in[I_REL][e];
    __syncthreads();
    for (int unit = c.bid; unit < T / 64; unit += c.G) {
        const int hh = c.tid >> 6, t = unit * 64 + (c.tid & 63), g = hh >> 2;
        RowState s; row_init(s, proj + (size_t)t * PLD + PC_NQ + hh * 64); row_reset(s);
        const float g1 = sigmoidf_(bf2f(proj[(size_t)t * PLD + PC_GL + 8 + hh]));
        for (int k = 0; k < 16; ++k) { const int j = sel[((size_t)t * 2 + g) * 16 + k];
            for (int p = 0; p < 64; ++p) { const int pos = j * 64 + p; if (pos > t) break;
                const float bias = tb[t5_bucket(t - pos) * 16 + hh];
                row_key_bf16(s, proj + (size_t)pos * PLD + PC_KS + g * 64, proj + (size_t)pos * PLD + PC_VS + g * 64, bias); } }
        const float inv = s.l > 0.f ? g1 / s.l : 0.f; const float* ap = nsaacc + (size_t)t * 512 + hh * 64; bf16_t* op = onsa + (size_t)t * 512 + hh * 64;
#pragma unroll
        for (int i = 0; i < 8; ++i) { const f32x4 x0 = *(const f32x4*)(ap + i * 8), x1 = *(const f32x4*)(ap + i * 8 + 4); u32x4 w;
            w.x = pk2(x0[0] + s.o[i * 8] * inv, x0[1] + s.o[i * 8 + 1] * inv); w.y = pk2(x0[2] + s.o[i * 8 + 2] * inv, x0[3] + s.o[i * 8 + 3] * inv);
            w.z = pk2(x1[0] + s.o[i * 8 + 4] * inv, x1[1] + s.o[i * 8 + 5] * inv); w.w = pk2(x1[2] + s.o[i * 8 + 6] * inv, x1[3] + s.o[i * 8 + 7] * inv);
            *(u32x4*)(op + i * 8) = w; }
    }
}
__device__ __forceinline__ void phase_swa(const Ctx& c, const Args& a, int layer, const bf16_t* proj, bf16_t* oswa) {
    LAS float* tb = (LAS float*)c.lds;
    for (int e = c.tid; e < 512; e += 512) tb[e] = a.in[I_REL][e];
    __syncthreads();
    for (int unit = c.bid; unit < T / 64; unit += c.G) {
        const int hh = c.tid >> 6, t = unit * 64 + (c.tid & 63), g = hh >> 2;
        RowState s; row_init(s, proj + (size_t)t * PLD + PC_SQ + hh * 64); row_reset(s);
        const int s0 = t - 127 > 0 ? t - 127 : 0;
        for (int sp = s0; sp <= t; ++sp) { const float bias = tb[t5_bucket(t - sp) * 16 + 8 + hh];
            row_key_bf16(s, proj + (size_t)sp * PLD + PC_SK + g * 64, proj + (size_t)sp * PLD + PC_SV + g * 64, bias); }
        const float sink = a.in[I_SINK][layer * 8 + hh]; const float mf = fmaxf(s.m, sink); const float corr = __expf(s.m - mf);
        const float den = s.l * corr + __expf(sink - mf); const float inv = corr / den;
        bf16_t* op = oswa + (size_t)t * 512 + hh * 64;
#pragma unroll
        for (int i = 0; i < 8; ++i) { u32x4 w; w.x = pk2(s.o[i * 8] * inv, s.o[i * 8 + 1] * inv); w.y = pk2(s.o[i * 8 + 2] * inv, s.o[i * 8 + 3] * inv);
            w.z = pk2(s.o[i * 8 + 4] * inv, s.o[i * 8 + 5] * inv); w.w = pk2(s.o[i * 8 + 6] * inv, s.o[i * 8 + 7] * inv); *(u32x4*)(op + i * 8) = w; }
    }
}

constexpr int RL = 65;
__device__ __forceinline__ float rwkv_mixed(const bf16_t* proj, const float* mu, int t, int col) {
    const float cur = bf2f(proj[(size_t)t * PLD + col]); const float prev = t > 0 ? bf2f(proj[(size_t)(t - 1) * PLD + col]) : 0.f;
    return cur + (prev - cur) * mu[col];
}
__device__ __forceinline__ void lora64(const Ctx& c, const LAS float* in, const float* W, const float* bias, LAS float* out, bool accum) {
    const int j = c.tid & 63, tg = (c.tid >> 6) * 8;
    float acc[8];
#pragma unroll
    for (int i = 0; i < 8; ++i) acc[i] = accum ? out[(tg + i) * RL + j] : (bias ? bias[j] : 0.f);
#pragma unroll 4
    for (int m = 0; m < 64; ++m) { const float w = W[(size_t)m * 512 + j];
#pragma unroll
        for (int i = 0; i < 8; ++i) acc[i] += in[(tg + i) * RL + m] * w; }
#pragma unroll
    for (int i = 0; i < 8; ++i) out[(tg + i) * RL + j] = acc[i];
}
struct RwkvLds { LAS float *R, *K, *V, *A, *B, *W, *G, *TMP; };
__device__ __forceinline__ RwkvLds rwkv_lds(LAS unsigned char* lds) {
    RwkvLds s; LAS float* p = (LAS float*)lds; constexpr int SZ = 64 * RL;
    s.R = p; s.K = p + SZ; s.V = p + 2 * SZ; s.A = p + 3 * SZ; s.B = p + 4 * SZ; s.W = p + 5 * SZ; s.G = p + 6 * SZ; s.TMP = p + 7 * SZ; return s;
}
template <bool LOGDECAY>
__device__ __forceinline__ void rwkv_prep(const Ctx& c, const Args& a, int layer, const bf16_t* proj, int t0, int h, const RwkvLds& s) {
    const float* mu = a.in[I_MU] + (size_t)layer * 1792;
    const int j = c.tid & 63, tg = c.tid >> 6;
#pragma unroll 2
    for (int i = 0; i < 8; ++i) { const int tt = tg * 8 + i; s.TMP[tt * RL + j] = tanhf(rwkv_mixed(proj, mu, t0 + tt, PC_ZW + j)); }
    __syncthreads();
    lora64(c, s.TMP, a.in[I_W2] + (size_t)layer * 64 * 512 + h * 64, a.in[I_W0] + layer * 512 + h * 64, s.W, false);
    __syncthreads();
#pragma unroll 2
    for (int i = 0; i < 8; ++i) { const int tt = tg * 8 + i; s.TMP[tt * RL + j] = rwkv_mixed(proj, mu, t0 + tt, PC_ZA + j); }
    __syncthreads();
    lora64(c, s.TMP, a.in[I_A2] + (size_t)layer * 64 * 512 + h * 64, a.in[I_A0] + layer * 512 + h * 64, s.B, false);
    __syncthreads();
#pragma unroll 2
    for (int i = 0; i < 8; ++i) { const int tt = tg * 8 + i; s.TMP[tt * RL + j] = sigmoidf_(rwkv_mixed(proj, mu, t0 + tt, PC_ZG + j)); }
    __syncthreads();
    lora64(c, s.TMP, a.in[I_G2] + (size_t)layer * 128 * 512 + h * 64, nullptr, s.G, false);
    __syncthreads();
#pragma unroll 2
    for (int i = 0; i < 8; ++i) { const int tt = tg * 8 + i; s.TMP[tt * RL + j] = sigmoidf_(rwkv_mixed(proj, mu, t0 + tt, PC_ZG + 64 + j)); }
    __syncthreads();
    lora64(c, s.TMP, a.in[I_G2] + ((size_t)layer * 128 + 64) * 512 + h * 64, nullptr, s.G, true);
    const float kkw = a.in[I_KK][layer * 512 + h * 64 + j], kaw = a.in[I_KA][layer * 512 + h * 64 + j];
#pragma unroll 1
    for (int i = 0; i < 8; ++i) { const int tt = tg * 8 + i, t = t0 + tt;
        const float r = rwkv_mixed(proj, mu, t, PC_R + h * 64 + j), k = rwkv_mixed(proj, mu, t, PC_K + h * 64 + j), v = rwkv_mixed(proj, mu, t, PC_V + h * 64 + j);
        const float wl = s.W[tt * RL + j], al = sigmoidf_(s.B[tt * RL + j]);
        const float sp = (-wl > 20.f) ? -wl : log1pf(__expf(-wl)); const float w = -sp - 0.5f; const float ew = __expf(w);
        float kk = k * kkw; const float n2 = wave_sum(kk * kk); kk = kk / fmaxf(sqrtf(n2), 1e-12f);
        s.R[tt * RL + j] = r; s.V[tt * RL + j] = v; s.K[tt * RL + j] = k * (1.0f + (al - 1.0f) * kaw);
        s.A[tt * RL + j] = -kk; s.B[tt * RL + j] = kk * al; s.W[tt * RL + j] = LOGDECAY ? -ew : __expf(-ew); }
    __syncthreads();
}
__device__ __forceinline__ void rwkv_post(const Ctx& c, const Args& a, int layer, int t0, int h, const RwkvLds& s, const LAS float* Y, bf16_t* orwkv) {
    const int i = c.lane, tg = c.wave;
    const float lnw = a.in[I_LNW][layer * 512 + h * 64 + i], lnb = a.in[I_LNB][layer * 512 + h * 64 + i], rk = a.in[I_RK][layer * 512 + h * 64 + i];
#pragma unroll 1
    for (int q = 0; q < 8; ++q) { const int tt = tg * 8 + q; const float y = Y[tt * RL + i];
        const float mean = wave_sum(y) * (1.0f / 64.0f); const float d = y - mean; const float var = wave_sum(d * d) * (1.0f / 64.0f);
        const float bonus = wave_sum(s.R[tt * RL + i] * s.K[tt * RL + i] * rk);
        const float o = (d * rsqrtf(var + 64e-5f) * lnw + lnb + bonus * s.V[tt * RL + i]) * s.G[tt * RL + i];
        orwkv[(size_t)(t0 + tt) * 512 + h * 64 + i] = (bf16_t)f2bf(o); }
}
__device__ __forceinline__ void phase_rwkv_naive(const Ctx& c, const Args& a, int layer, const bf16_t* proj, bf16_t* orwkv) {
    if (c.bid >= 8) return;
    const int h = c.bid; const RwkvLds s = rwkv_lds(c.lds);
    float S[64];
#pragma unroll
    for (int j = 0; j < 64; ++j) S[j] = 0.f;
    for (int ch = 0; ch < T / 64; ++ch) {
        rwkv_prep<false>(c, a, layer, proj, ch * 64, h, s);
        if (c.wave == 0) {
            const int i = c.lane;
            for (int tt = 0; tt < 64; ++tt) {
                float sa = 0.f;
#pragma unroll
                for (int j = 0; j < 64; ++j) { sa += S[j] * s.A[tt * RL + j]; if ((j & 7) == 7) __builtin_amdgcn_sched_barrier(0); }
                const float vi = s.V[tt * RL + i]; float y = 0.f;
#pragma unroll
                for (int j = 0; j < 64; ++j) { S[j] = S[j] * s.W[tt * RL + j] + sa * s.B[tt * RL + j] + vi * s.K[tt * RL + j]; y += S[j] * s.R[tt * RL + j]; if ((j & 3) == 3) __builtin_amdgcn_sched_barrier(0); }
                s.TMP[tt * RL + i] = y;
            }
        }
        __syncthreads();
        rwkv_post(c, a, layer, ch * 64, h, s, s.TMP, orwkv);
        __syncthreads();
    }
}

constexpr int PH_PER_BATCH = 11, PH_PER_LAYER = 1 + 2 * PH_PER_BATCH + 3, PH_TOTAL = 1 + DEPTH * PH_PER_LAYER;

__global__ void __launch_bounds__(512, 2) fwd_kernel(Args args) {
    extern __shared__ __attribute__((aligned(16))) unsigned char lds_raw[];
    Ctx c0; c0.lds = (LAS unsigned char*)lds_raw; c0.tid = threadIdx.x; c0.lane = c0.tid & 63; c0.wave = __builtin_amdgcn_readfirstlane(c0.tid >> 6); c0.G = gridDim.x; c0.bid = blockIdx.x; const Ctx& c = c0;
    unsigned char* ws = args.ws;
    volatile LAS unsigned* misc = (volatile LAS unsigned*)(c.lds + LDS_MISC);
    if (c.tid < 4) misc[c.tid] = 0u;
    __syncthreads();
    XcdBarrier bar; bar.bar = (unsigned*)(ws + WS_CTL); bar.x = 0; bar.st = misc;
    const int lo = args.lo, hi = args.hi;
    const bool multi = (hi - lo) > 1;
    if (multi) bar = xcd_barrier_post((unsigned*)(ws + WS_CTL), misc);
    int gp = 0;
#ifndef ONLY_PH
#define ONLY_PH -1
#endif
#ifndef PHMASK
#define PHMASK 0xffff
#endif
#define PHASE_BEGIN(id) if (gp >= lo && gp < hi) { if ((ONLY_PH < 0 || ONLY_PH == (id)) && ((PHMASK >> (id)) & 1)) { \
    Ctx pc = c0; asm volatile("" : "+v"(pc.tid), "+s"(pc.bid)); pc.lane = pc.tid & 63; pc.wave = __builtin_amdgcn_readfirstlane(pc.tid >> 6); const Ctx& c = pc;
#define PHASE_END   } if (gp + 1 < hi) xcd_barrier(bar); } ++gp;

    bf16_t* wb = (bf16_t*)(ws + WS_WB); bf16_t* xb = (bf16_t*)(ws + WS_XB); float* rs = (float*)(ws + WS_RS);
    float* kcmp = (float*)(ws + WS_KCMP); float* vcmp = (float*)(ws + WS_VCMP); int* sel = (int*)(ws + WS_SEL); float* ml = (float*)(ws + WS_ML); float* hid = (float*)(ws + WS_HID);
    bf16_t* proj = (bf16_t*)(ws + WS_PROJ); bf16_t* gates = (bf16_t*)(ws + WS_GATES); bf16_t* merged = (bf16_t*)(ws + WS_MERGED); bf16_t* tmpb = (bf16_t*)(ws + WS_TMPB);
    float* nsaacc = (float*)(ws + WS_NSAACC); bf16_t* obuf = (bf16_t*)(ws + WS_O); bf16_t* act = (bf16_t*)(ws + WS_ACT); bf16_t* tmpf = (bf16_t*)(ws + WS_TMPF);
    float* x = args.out;

    PHASE_BEGIN(0) phase_init(c, args.in[I_X], x, xb, rs); PHASE_END

    for (int layer = 0; layer < DEPTH; ++layer) {
        PHASE_BEGIN(1) phase_cvt(c, args, layer, wb); PHASE_END
        for (int b = 0; b < NBATCH; ++b) {
            const int row0 = b * T;
            PHASE_BEGIN(2) {
                pg8::Gemm g{xb + (size_t)row0 * D, wb + WB_WIN, D, D, D}; pg8::Sched S; S.init(T / 256, NIN / 256, c.G, c.bid, 1, (size_t)256 * D * 2, 0, (size_t)256 * D * 2, 0);
                pg8::EpiInProj E{proj, gates, rs + row0}; pg8::gemm_phase(c.lds, c.tid, g, S, E); } PHASE_END
            PHASE_BEGIN(3) phase_cmp1(c, args, layer, proj, hid); PHASE_END
            PHASE_BEGIN(4) phase_cmp2(c, args, layer, hid, kcmp, vcmp); PHASE_END
            PHASE_BEGIN(5) phase_nsa13(c, args, proj, kcmp, vcmp, nsaacc, ml); PHASE_END
            PHASE_BEGIN(6) phase_nsa_topk(c, args, proj, kcmp, ml, sel); PHASE_END
            PHASE_BEGIN(7) phase_nsa2(c, args, proj, sel, nsaacc, obuf + (size_t)T * 512); PHASE_END
            PHASE_BEGIN(8) phase_swa(c, args, layer, proj, obuf + (size_t)2 * T * 512); PHASE_END
            PHASE_BEGIN(9) phase_rwkv_naive(c, args, layer, proj, obuf); PHASE_END
            PHASE_BEGIN(10) {
                pg8::Gemm g{obuf, wb + WB_WBR, 512, 512, 512}; pg8::Sched S; S.init(T / 256, D / 256, c.G, c.bid, 3, (size_t)256 * 512 * 2, (size_t)T * 512 * 2, (size_t)256 * 512 * 2, (size_t)D * 512 * 2);
                pg8::EpiMerge E{gates, merged}; pg8::gemm_phase(c.lds, c.tid, g, S, E); } PHASE_END
            PHASE_BEGIN(11) {
                pg8::Gemm g{merged, wb + WB_WOUT, D, D, D}; pg8::Sched S; S.init(T / 256, D / 256, c.G, c.bid, 1, (size_t)256 * D * 2, 0, (size_t)256 * D * 2, 0);
                pg8::EpiStore E{tmpb, D}; pg8::gemm_phase(c.lds, c.tid, g, S, E); } PHASE_END
            PHASE_BEGIN(12) phase_norm_res(c, tmpb, args.in[I_NQM] + layer * D, x, xb, rs, row0, T); PHASE_END
        }
        PHASE_BEGIN(13) {
            pg8::Gemm g{xb, wb + WB_WGU, D, D, D}; pg8::Sched S; S.init(MROWS / 256, 2 * FFN / 256, c.G, c.bid, 1, (size_t)256 * D * 2, 0, (size_t)256 * D * 2, 0);
            pg8::EpiSwiGLU E{act, rs}; pg8::gemm_phase(c.lds, c.tid, g, S, E); } PHASE_END
        PHASE_BEGIN(14) {
            pg8::Gemm g{act, wb + WB_WDN, FFN, FFN, FFN}; pg8::Sched S; S.init(MROWS / 256, D / 256, c.G, c.bid, 1, (size_t)256 * FFN * 2, 0, (size_t)256 * FFN * 2, 0);
            pg8::EpiStore E{tmpf, D}; pg8::gemm_phase(c.lds, c.tid, g, S, E); } PHASE_END
        PHASE_BEGIN(15) phase_norm_res(c, tmpf, args.in[I_NQF] + layer * D, x, xb, rs, 0, MROWS); PHASE_END
    }
#undef PHASE_BEGIN
#undef PHASE_END
}

extern "C" void kernel_launch(void* const* d_in, const int* in_sizes, int n_in, void* d_out, int out_size, void* d_ws, size_t ws_size, hipStream_t stream) {
    static int grid = 0;
    if (grid == 0) {
        if (n_in != 30 || out_size != MROWS * D || ws_size < WS_END) { fprintf(stderr, "kernel_launch: unexpected shapes (n_in %d out %d ws %zu)\n", n_in, out_size, ws_size); grid = -1; return; }
        int dev = 0, cus = 0;
        if (hipGetDevice(&dev) != hipSuccess || hipDeviceGetAttribute(&cus, hipDeviceAttributeMultiprocessorCount, dev) != hipSuccess) { grid = -1; return; }
        if (hipFuncSetAttribute((const void*)fwd_kernel, hipFuncAttributeMaxDynamicSharedMemorySize, LDS_BYTES) != hipSuccess) { fprintf(stderr, "hipFuncSetAttribute failed\n"); grid = -1; return; }
        int per_cu = 0;
        if (hipOccupancyMaxActiveBlocksPerMultiprocessor(&per_cu, (const void*)fwd_kernel, 512, LDS_BYTES) != hipSuccess || per_cu < 1) { fprintf(stderr, "occupancy query: %d\n", per_cu); }
        (void)hipGetLastError();
        grid = cus;
    }
    if (grid < 0) return;
    (void)hipMemsetAsync((char*)d_ws + WS_CTL, 0, CTL_BYTES, stream);
    Args a{};
    for (int i = 0; i < 30; ++i) a.in[i] = (const float*)d_in[i];
    a.out = (float*)d_out; a.ws = (unsigned char*)d_ws;
#if MK_ONE_LAUNCH
    a.lo = 0; a.hi = PH_TOTAL;
    hipLaunchKernelGGL(fwd_kernel, dim3(grid), dim3(512), LDS_BYTES, stream, a);
#else
    for (int p = 0; p < PH_TOTAL; ++p) { a.lo = p; a.hi = p + 1; hipLaunchKernelGGL(fwd_kernel, dim3(grid), dim3(512), LDS_BYTES, stream, a); }
#endif
}
```

```cpp
#include <hip/hip_runtime.h>
#include <stdint.h>
#include <stdio.h>

#ifndef MK_ONE_LAUNCH
#define MK_ONE_LAUNCH 1
#endif

#define LAS __attribute__((address_space(3)))
typedef unsigned short bf16_t;
typedef short bf16x8 __attribute__((ext_vector_type(8)));
typedef float f32x4 __attribute__((ext_vector_type(4)));
typedef float f32x2 __attribute__((ext_vector_type(2)));
typedef unsigned u32x4 __attribute__((ext_vector_type(4)));
typedef unsigned u32x2 __attribute__((ext_vector_type(2)));

constexpr int D = 1024, NBATCH = 2, T = 16384, DEPTH = 4, MROWS = NBATCH * T;
constexpr int IN_COLS = 6936, FFN = 2816;
constexpr int PLD = 4096;
constexpr int PC_R = 0, PC_K = 512, PC_V = 1024, PC_ZW = 1536, PC_ZA = 1600, PC_ZG = 1664;
constexpr int PC_NQ = 1792, PC_KC = 2304, PC_VC = 2432, PC_KS = 2560, PC_VS = 2688, PC_KW = 2816, PC_VW = 2944, PC_GL = 3072;
constexpr int PC_SQ = 3328, PC_SK = 3840, PC_SV = 3968;
constexpr int NIN = 7168;
constexpr int NCMP = 1023;
constexpr float NORM_EPS = 1e-6f;

constexpr size_t MiB = 1u << 20;
constexpr size_t WS_CTL = 0, CTL_BYTES = 1 * MiB;
constexpr size_t WS_WB = 1 * MiB;
constexpr size_t WB_WIN = 0, WB_WBR = WB_WIN + (size_t)NIN * D, WB_WOUT = WB_WBR + (size_t)3 * D * 512, WB_WGU = WB_WOUT + (size_t)D * D,
                 WB_WDN = WB_WGU + (size_t)2 * FFN * D, WB_LORA = WB_WDN + (size_t)D * FFN, WB_END = WB_LORA + (size_t)1536 * 256;
static_assert(WB_END * 2 <= 41 * MiB, "weights");
constexpr size_t WS_XB = 42 * MiB;
constexpr size_t WS_RS = 106 * MiB;
constexpr size_t WS_KCMP = 107 * MiB;
constexpr size_t WS_VCMP = WS_KCMP + 512 * 1024;
constexpr size_t WS_SEL = 108 * MiB;
constexpr size_t WS_ML = 110 * MiB;
constexpr size_t WS_BONUS = 111 * MiB;
constexpr size_t WS_HID = 112 * MiB;
constexpr size_t WS_ALORA = 116 * MiB;
constexpr size_t WS_BIG = 124 * MiB;
constexpr size_t WS_PROJ = WS_BIG;
constexpr size_t WS_GATES = WS_PROJ + 128 * MiB;
constexpr size_t WS_RWKVS = WS_GATES + 96 * MiB;
constexpr size_t WS_RWU = WS_RWKVS;
constexpr size_t WS_RWS = WS_RWKVS + 64 * MiB;
constexpr size_t WS_MERGED = WS_RWKVS;
constexpr size_t WS_TMPB = WS_RWKVS + 32 * MiB;
constexpr size_t WS_NSAACC = WS_RWKVS + 80 * MiB;
constexpr size_t WS_O = WS_NSAACC + 32 * MiB;
constexpr size_t WS_END = WS_O + 48 * MiB;
constexpr size_t WS_ACT = WS_BIG;
constexpr size_t WS_TMPF = WS_BIG + 176 * MiB;
static_assert(WS_END <= 512 * MiB, "workspace");
static_assert(WS_TMPF + 64 * MiB <= WS_NSAACC, "ffn overlay");

constexpr int LDS_BYTES = 147456;
constexpr int LDS_MISC = 131072 + 8192;

__device__ __forceinline__ float bf2f(unsigned v) { return __uint_as_float(v << 16); }
typedef __bf16 bf16n2 __attribute__((ext_vector_type(2)));
__device__ __forceinline__ unsigned pk2(float lo, float hi) { const f32x2 f = {lo, hi}; const bf16n2 v = __builtin_convertvector(f, bf16n2); return __builtin_bit_cast(unsigned, v); }
__device__ __forceinline__ unsigned f2bf(float f) { return pk2(f, 0.f) & 0xffffu; }
__device__ __forceinline__ void unpack8(const u32x4 w, float (&f)[8]) {
    f[0] = __uint_as_float(w.x << 16); f[1] = __uint_as_float(w.x & 0xffff0000u); f[2] = __uint_as_float(w.y << 16); f[3] = __uint_as_float(w.y & 0xffff0000u);
    f[4] = __uint_as_float(w.z << 16); f[5] = __uint_as_float(w.z & 0xffff0000u); f[6] = __uint_as_float(w.w << 16); f[7] = __uint_as_float(w.w & 0xffff0000u);
}
__device__ __forceinline__ float wave_sum(float v) {
#pragma unroll
    for (int o = 32; o >= 1; o >>= 1) v += __shfl_xor(v, o);
    return v;
}
__device__ __forceinline__ float sigmoidf_(float x) { return 1.0f / (1.0f + __expf(-x)); }
__device__ __forceinline__ int t5_bucket(int n) {
    if (n < 16) return n;
    int b = 16;
    b += (n >= 21); b += (n >= 27); b += (n >= 35); b += (n >= 46); b += (n >= 59); b += (n >= 77); b += (n >= 99); b += (n >= 128);
    b += (n >= 166); b += (n >= 216); b += (n >= 280); b += (n >= 363); b += (n >= 470); b += (n >= 609); b += (n >= 790);
    return b;
}

#define XB_TMO      128
#define XB_XCNT(j)  (256  + 64 * (j))
#define XB_XSUB(j)  (1280 + 64 * (j))
#define XB_XGEN(j)  (2304 + 64 * (j))
#define XB_TOP      3328
#define XB_TOPGEN   3392
#define XCD_BAR_WORDS 3456
#define XB_SPIN_CAP (1u << 22)
__device__ __forceinline__ unsigned xb_ld(unsigned* p)              { return __hip_atomic_load(p, __ATOMIC_RELAXED, __HIP_MEMORY_SCOPE_AGENT); }
__device__ __forceinline__ unsigned xb_add(unsigned* p, unsigned v) { return __hip_atomic_fetch_add(p, v, __ATOMIC_RELAXED, __HIP_MEMORY_SCOPE_AGENT); }
__device__ __forceinline__ unsigned xb_xcc_id() { return (unsigned)__builtin_amdgcn_s_getreg((3 << 11) | 20) & 0xFu; }
#define XB_SPIN(cond, bar) do { unsigned _sp = 0; while (cond) { __builtin_amdgcn_s_sleep(1); \
    if ((++_sp & 255u) == 0u) { if (xb_ld(&(bar)[XB_TMO])) break; if (_sp > XB_SPIN_CAP) { atomicAdd(&(bar)[XB_TMO], 1u); break; } } } } while (0)
struct XcdBarrier { unsigned* bar; unsigned x; volatile LAS unsigned* st; };
__device__ __forceinline__ XcdBarrier xcd_barrier_post(unsigned* bar, volatile LAS unsigned* st) {
    XcdBarrier b; b.bar = bar; b.x = xb_xcc_id(); b.st = st;
    if (threadIdx.x == 0) (void)xb_add(&bar[XB_XCNT(b.x)], 1u);
    return b;
}
__device__ __forceinline__ void xcd_barrier_complete(unsigned* bar, unsigned x, unsigned& nloc, unsigned& nx) {
    const unsigned G = gridDim.x * gridDim.y * gridDim.z;
    unsigned sum, cnt, mine, sp = 0u;
    for (;;) {
        sum = 0u; cnt = 0u; mine = 0u;
#pragma unroll
        for (unsigned j = 0; j < 16; ++j) { const unsigned c = xb_ld(&bar[XB_XCNT(j)]); sum += c; cnt += (c > 0u) ? 1u : 0u; mine = (j == x) ? c : mine; }
        if (sum == G) break;
        __builtin_amdgcn_s_sleep(1);
        if ((++sp & 255u) == 0u) { if (xb_ld(&bar[XB_TMO])) break; if (sp > XB_SPIN_CAP) { atomicAdd(&bar[XB_TMO], 1u); break; } }
    }
    nloc = mine > 0u ? mine : 1u; nx = cnt > 0u ? cnt : 1u;
}
__device__ __forceinline__ void xcd_barrier(const XcdBarrier& b) {
    asm volatile("s_waitcnt vmcnt(0)" ::: "memory");
    __syncthreads();
    if (threadIdx.x == 0) {
        unsigned* bar = b.bar;
        __builtin_amdgcn_s_waitcnt(0);
        unsigned nloc = b.st[0], nx = b.st[1];
        if (nloc == 0u) { xcd_barrier_complete(bar, b.x, nloc, nx); b.st[0] = nloc; b.st[1] = nx; }
        const unsigned old = xb_add(&bar[XB_XSUB(b.x)], 1u);
        const unsigned gen = old / nloc;
        if (old + 1u == (gen + 1u) * nloc) {
            __builtin_amdgcn_fence(__ATOMIC_RELEASE, "agent");
            asm volatile("s_waitcnt vmcnt(0)" ::: "memory");
            const unsigned og = xb_add(&bar[XB_TOP], 1u);
            const unsigned tg = og / nx;
            if (og + 1u == (tg + 1u) * nx) xb_add(&bar[XB_TOPGEN], 1u);
            else XB_SPIN(xb_ld(&bar[XB_TOPGEN]) == tg, bar);
            __builtin_amdgcn_fence(__ATOMIC_ACQUIRE, "agent");
            xb_add(&bar[XB_XGEN(b.x)], 1u);
            asm volatile("s_waitcnt vmcnt(0)" ::: "memory");
        } else {
            XB_SPIN(xb_ld(&bar[XB_XGEN(b.x)]) == gen, bar);
            __builtin_amdgcn_fence(__ATOMIC_ACQUIRE, "agent");
            asm volatile("s_waitcnt vmcnt(0)" ::: "memory");
        }
    }
    __syncthreads();
}

namespace pg8 {
constexpr int BM = 256, BK = 64, HALF = 128, HTB = HALF * BK * 2, STAGE_BYTES = 8 * HTB, NXCD = 8, WGM = 8;
__device__ __forceinline__ int lds_byte(int r, int c) { const int st = (r >> 4) * 2 + (c >> 5), rr = r & 15, cc = c & 31, ob = rr * 64 + cc * 2; return st * 1024 + (ob ^ (((ob >> 9) & 1) << 5)); }
__device__ __forceinline__ void stage_rc(int b, int& R, int& C) { const int st = b / 1024, sb = b % 1024, swz = sb ^ (((sb >> 9) & 1) << 5); R = (st >> 1) * 16 + swz / 64; C = (st & 1) * 32 + (swz % 64) / 2; }
__device__ __forceinline__ int perm32(int rho) { const int n = rho >> 4, i = rho & 15; return 8 * (i >> 2) + 4 * n + (i & 3); }

struct Unit { int pm, pn, sub; unsigned aoff, boff; };
struct Gemm { const bf16_t* A; const bf16_t* Bt; int lda, ldb, K; };
struct Sched {
    int nM, nN, nwg, G, c, nsub; unsigned a_row, a_sub, b_row, b_sub;
    __device__ __forceinline__ void init(int nM_, int nN_, int G_, int c_, int nsub_, unsigned a_row_, unsigned a_sub_, unsigned b_row_, unsigned b_sub_) {
        nM = nM_; nN = nN_; nwg = nM * nN; G = G_; c = c_; nsub = nsub_; a_row = a_row_; a_sub = a_sub_; b_row = b_row_; b_sub = b_sub_; }
    __device__ __forceinline__ bool next(int i, Unit& u) const {
        const int round = i / nsub; u.sub = i - round * nsub;
        const long L = (long)round * G + c; if (L >= nwg) return false;
        int wgid = (int)L; { const int q = nwg / NXCD, r = nwg % NXCD, xcd = wgid % NXCD, off = wgid / NXCD; wgid = (xcd < r ? xcd * (q + 1) : r * (q + 1) + (xcd - r) * q) + off; }
        const int nig = WGM * nN, gid = wgid / nig, fm = gid * WGM, gsz = (nM - fm) < WGM ? (nM - fm) : WGM;
        u.pm = fm + ((wgid % nig) % gsz); u.pn = (wgid % nig) / gsz;
        u.aoff = (unsigned)u.pm * a_row + (unsigned)u.sub * a_sub; u.boff = (unsigned)u.pn * b_row + (unsigned)u.sub * b_sub; return true;
    }
};

template <class Epi>
__device__ __forceinline__ void gemm_phase(LAS unsigned char* lds, const int tid, const Gemm g, const Sched& S, const Epi& E) {
    const int wid = __builtin_amdgcn_readfirstlane(tid >> 6), lane = tid & 63, wr = wid >> 2, wc = wid & 3, fr = lane & 15, fq = lane >> 4;
    const int K = g.K, nt = K / BK;
    unsigned voffA[2], voffB[2];
#pragma unroll
    for (int i = 0; i < 2; ++i) { int R, C; stage_rc(tid * 16 + i * 8192, R, C); const int Rb = Epi::PERM ? ((R & ~31) + perm32(R & 31)) : R;
        voffA[i] = (unsigned)(R * g.lda + C) * 2u; voffB[i] = (unsigned)(Rb * g.ldb + C) * 2u; }
    const size_t kstep = (size_t)(BK * 2);
    const size_t hstepA = (size_t)HALF * g.lda * 2, hstepB = (size_t)HALF * g.ldb * 2;
    const unsigned ldsw = (unsigned)wid * 1024u;
    const int aoff = lds_byte(wr * 64 + fr, fq * 8), boff = lds_byte(wc * 32 + fr, fq * 8);
#define PG8_SA(b, h) (((b) * 2 + (h)) * HTB)
#define PG8_SB(b, h) ((4 + (b) * 2 + (h)) * HTB)
#define PG8_STAGE(bufoff, gbase, voff) do { _Pragma("unroll") for (int _i = 0; _i < 2; ++_i) \
        __builtin_amdgcn_global_load_lds((const unsigned*)((const char*)(gbase) + (voff)[_i]), (LAS unsigned*)(lds + (bufoff) + ldsw + _i * 8192), 16, 0, 0); } while (0)
#define PG8_LDA(dst, b, h) do { _Pragma("unroll") for (int m = 0; m < 4; ++m) _Pragma("unroll") for (int k = 0; k < 2; ++k) dst[m][k] = *(const LAS bf16x8*)(lds + PG8_SA(b, h) + aoff + m * 2048 + k * 1024); } while (0)
#define PG8_LDB(dst, b, h) do { _Pragma("unroll") for (int n = 0; n < 2; ++n) _Pragma("unroll") for (int k = 0; k < 2; ++k) dst[n][k] = *(const LAS bf16x8*)(lds + PG8_SB(b, h) + boff + n * 2048 + k * 1024); } while (0)
#define PG8_MMA(ai, bj, At, Bt) do { __builtin_amdgcn_s_setprio(1); _Pragma("unroll") for (int m = 0; m < 4; ++m) _Pragma("unroll") for (int n = 0; n < 2; ++n) _Pragma("unroll") for (int k = 0; k < 2; ++k) \
        acc[ai][bj][m][n] = __builtin_amdgcn_mfma_f32_16x16x32_bf16(Bt[n][k], At[m][k], acc[ai][bj][m][n], 0, 0, 0); __builtin_amdgcn_s_setprio(0); } while (0)
#define PG8_WAIT_V(n) asm volatile("s_waitcnt vmcnt(" #n ")" ::: "memory")
#define PG8_WAIT_L(n) asm volatile("s_waitcnt lgkmcnt(" #n ")" ::: "memory")
#define PG8_BAR __builtin_amdgcn_s_barrier()
#define PG8_SCHED __builtin_amdgcn_sched_barrier(0)
    Unit cur, nxt; int ui = 0;
    if (!S.next(0, cur)) return;
    f32x4 acc[2][2][4][2];
#pragma unroll
    for (int a = 0; a < 2; ++a)
#pragma unroll
        for (int b = 0; b < 2; ++b)
#pragma unroll
            for (int m = 0; m < 4; ++m)
#pragma unroll
                for (int n = 0; n < 2; ++n) acc[a][b][m][n] = (f32x4){0.f, 0.f, 0.f, 0.f};
    bf16x8 At[4][2], B0[2][2], B1[2][2];
    const char* cA = (const char*)g.A + cur.aoff; const char* cB = (const char*)g.Bt + cur.boff;
    PG8_STAGE(PG8_SB(0, 0), cB, voffB); PG8_STAGE(PG8_SA(0, 0), cA, voffA); PG8_STAGE(PG8_SB(0, 1), cB + hstepB, voffB); PG8_STAGE(PG8_SA(0, 1), cA + hstepA, voffA);
    if (wr == 1) PG8_BAR;
    PG8_WAIT_V(4); PG8_BAR;
    PG8_STAGE(PG8_SB(1, 0), cB + kstep, voffB); PG8_STAGE(PG8_SA(1, 0), cA + kstep, voffA); PG8_STAGE(PG8_SB(1, 1), cB + hstepB + kstep, voffB);
    PG8_WAIT_V(6); PG8_BAR;
    for (;;) {
        const bool has_next = S.next(ui + 1, nxt);
        const char* nA = has_next ? (const char*)g.A + nxt.aoff : cA; const char* nB = has_next ? (const char*)g.Bt + nxt.boff : cB;
        for (int t = 0; t < nt; t += 2) {
            const bool last = (t == nt - 2);
            const char* a1 = cA + (size_t)(t + 1) * kstep;
            const char* a2 = last ? nA : cA + (size_t)(t + 2) * kstep; const char* b2 = last ? nB : cB + (size_t)(t + 2) * kstep;
            const char* a3 = a2 + kstep; const char* b3 = b2 + kstep;
            PG8_LDB(B0, 0, 0); PG8_SCHED; PG8_LDA(At, 0, 0); PG8_STAGE(PG8_SA(1, 1), a1 + hstepA, voffA);
            PG8_WAIT_L(8); PG8_BAR; PG8_WAIT_L(0); PG8_MMA(0, 0, At, B0); PG8_BAR; PG8_SCHED;
            PG8_LDB(B1, 0, 1); PG8_STAGE(PG8_SB(0, 0), b2, voffB);
            PG8_BAR; PG8_WAIT_L(0); PG8_MMA(0, 1, At, B1); PG8_BAR;
            PG8_LDA(At, 0, 1); PG8_STAGE(PG8_SA(0, 0), a2, voffA);
            PG8_BAR; PG8_WAIT_L(0); PG8_MMA(1, 0, At, B0); PG8_BAR; PG8_SCHED;
            PG8_STAGE(PG8_SB(0, 1), b2 + hstepB, voffB);
            PG8_WAIT_V(6); PG8_BAR; PG8_MMA(1, 1, At, B1); PG8_BAR;
            PG8_LDB(B0, 1, 0); PG8_SCHED; PG8_LDA(At, 1, 0); PG8_STAGE(PG8_SA(0, 1), a2 + hstepA, voffA);
            PG8_WAIT_L(8); PG8_BAR; PG8_WAIT_L(0); PG8_MMA(0, 0, At, B0); PG8_BAR; PG8_SCHED;
            PG8_LDB(B1, 1, 1); PG8_STAGE(PG8_SB(1, 0), b3, voffB);
            PG8_BAR; PG8_WAIT_L(0); PG8_MMA(0, 1, At, B1); PG8_BAR;
            PG8_LDA(At, 1, 1); PG8_STAGE(PG8_SA(1, 0), a3, voffA);
            PG8_BAR; PG8_WAIT_L(0); PG8_MMA(1, 0, At, B0); PG8_BAR; PG8_SCHED;
            PG8_STAGE(PG8_SB(1, 1), b3 + hstepB, voffB);
            PG8_WAIT_V(6); PG8_BAR; PG8_MMA(1, 1, At, B1); PG8_BAR;
        }
        const bool keep = E(acc, cur, wr, wc, fr, fq);
        if (!has_next) break;
        if (!keep) {
#pragma unroll
            for (int a = 0; a < 2; ++a)
#pragma unroll
                for (int b = 0; b < 2; ++b)
#pragma unroll
                    for (int m = 0; m < 4; ++m)
#pragma unroll
                        for (int n = 0; n < 2; ++n) acc[a][b][m][n] = (f32x4){0.f, 0.f, 0.f, 0.f};
        }
        cur = nxt; cA = nA; cB = nB; ++ui;
    }
    PG8_WAIT_V(0);
    if (wr == 0) PG8_BAR;
    PG8_BAR;
#undef PG8_SA
#undef PG8_SB
#undef PG8_STAGE
#undef PG8_LDA
#undef PG8_LDB
#undef PG8_MMA
#undef PG8_WAIT_V
#undef PG8_WAIT_L
#undef PG8_BAR
#undef PG8_SCHED
}

struct EpiInProj {
    static constexpr bool PERM = true;
    bf16_t* proj; bf16_t* gates; const float* rs;
    __device__ __forceinline__ bool operator()(f32x4 (&acc)[2][2][4][2], const Unit& u, int wr, int wc, int fr, int fq) const {
        const int row0 = u.pm * BM + wr * 64 + fr; const bool is_gate = u.pn >= 16;
        bf16_t* base = is_gate ? gates + (u.pn - 16) * 256 : proj + u.pn * 256; const int ld = is_gate ? 3072 : PLD;
        const int col0 = wc * 32 + 8 * fq;
#pragma unroll
        for (int ai = 0; ai < 2; ++ai)
#pragma unroll
            for (int m = 0; m < 4; ++m) { const int row = row0 + ai * HALF + m * 16; const float s = rs[row]; bf16_t* rowp = base + (size_t)row * ld + col0;
#pragma unroll
                for (int bj = 0; bj < 2; ++bj) { f32x4 v0 = acc[ai][bj][m][0] * s, v1 = acc[ai][bj][m][1] * s;
                    if (is_gate) {
#pragma unroll
                        for (int j = 0; j < 4; ++j) { v0[j] = sigmoidf_(v0[j]); v1[j] = sigmoidf_(v1[j]); } }
                    u32x4 w; w.x = pk2(v0[0], v0[1]); w.y = pk2(v0[2], v0[3]); w.z = pk2(v1[0], v1[1]); w.w = pk2(v1[2], v1[3]);
                    *(u32x4*)(rowp + bj * HALF) = w; } }
        return false;
    }
};
struct EpiStore {
    static constexpr bool PERM = true;
    bf16_t* out; int ld;
    __device__ __forceinline__ bool operator()(f32x4 (&acc)[2][2][4][2], const Unit& u, int wr, int wc, int fr, int fq) const {
        const int row0 = u.pm * BM + wr * 64 + fr; const int col0 = u.pn * BM + wc * 32 + 8 * fq;
#pragma unroll
        for (int ai = 0; ai < 2; ++ai)
#pragma unroll
            for (int m = 0; m < 4; ++m) { bf16_t* rowp = out + (size_t)(row0 + ai * HALF + m * 16) * ld + col0;
#pragma unroll
                for (int bj = 0; bj < 2; ++bj) { const f32x4 v0 = acc[ai][bj][m][0], v1 = acc[ai][bj][m][1];
                    u32x4 w; w.x = pk2(v0[0], v0[1]); w.y = pk2(v0[2], v0[3]); w.z = pk2(v1[0], v1[1]); w.w = pk2(v1[2], v1[3]);
                    *(u32x4*)(rowp + bj * HALF) = w; } }
        return false;
    }
};
struct EpiLora {
    static constexpr bool PERM = true;
    bf16_t* obuf;
    __device__ __forceinline__ bool operator()(f32x4 (&acc)[2][2][4][2], const Unit& u, int wr, int wc, int fr, int fq) const {
        const int sel = u.pn >> 1; bf16_t* out = obuf + (size_t)(sel == 2 ? 0 : sel + 1) * T * 512;
        const int row0 = u.pm * BM + wr * 64 + fr; const int col0 = (u.pn & 1) * BM + wc * 32 + 8 * fq;
#pragma unroll
        for (int ai = 0; ai < 2; ++ai)
#pragma unroll
            for (int m = 0; m < 4; ++m) { bf16_t* rowp = out + (size_t)(row0 + ai * HALF + m * 16) * 512 + col0;
#pragma unroll
                for (int bj = 0; bj < 2; ++bj) { const f32x4 v0 = acc[ai][bj][m][0], v1 = acc[ai][bj][m][1];
                    u32x4 w; w.x = pk2(v0[0], v0[1]); w.y = pk2(v0[2], v0[3]); w.z = pk2(v1[0], v1[1]); w.w = pk2(v1[2], v1[3]);
                    *(u32x4*)(rowp + bj * HALF) = w; } }
        return false;
    }
};
struct EpiMerge {
    static constexpr bool PERM = true;
    const bf16_t* gates; bf16_t* merged;
    __device__ __forceinline__ bool operator()(f32x4 (&acc)[2][2][4][2], const Unit& u, int wr, int wc, int fr, int fq) const {
        const int row0 = u.pm * BM + wr * 64 + fr; const int col0 = u.pn * BM + wc * 32 + 8 * fq; const int sub = u.sub;
#pragma unroll
        for (int ai = 0; ai < 2; ++ai)
#pragma unroll
            for (int m = 0; m < 4; ++m) { const int row = row0 + ai * HALF + m * 16; const bf16_t* gp = gates + (size_t)row * 3072 + sub * 1024 + col0;
#pragma unroll
                for (int bj = 0; bj < 2; ++bj) {
                    float sc[8], sn[8]; unpack8(*(const u32x4*)(gp + bj * HALF), sc);
                    if (sub < 2) { unpack8(*(const u32x4*)(gp + 1024 + bj * HALF), sn);
#pragma unroll
                        for (int j = 0; j < 8; ++j) sc[j] = sc[j] / fmaxf(sn[j], 1e-30f); }
                    f32x4 v0 = acc[ai][bj][m][0], v1 = acc[ai][bj][m][1];
#pragma unroll
                    for (int j = 0; j < 4; ++j) { v0[j] *= sc[j]; v1[j] *= sc[4 + j]; }
                    acc[ai][bj][m][0] = v0; acc[ai][bj][m][1] = v1;
                    if (sub == 2) { u32x4 w; w.x = pk2(v0[0], v0[1]); w.y = pk2(v0[2], v0[3]); w.z = pk2(v1[0], v1[1]); w.w = pk2(v1[2], v1[3]);
                        *(u32x4*)(merged + (size_t)row * D + col0 + bj * HALF) = w; } } }
        return sub != 2;
    }
};
struct EpiSwiGLU {
    static constexpr bool PERM = true;
    bf16_t* act; const float* rs;
    __device__ __forceinline__ bool operator()(f32x4 (&acc)[2][2][4][2], const Unit& u, int wr, int wc, int fr, int fq) const {
        const int row0 = u.pm * BM + wr * 64 + fr; const int col0 = u.pn * HALF + wc * 32 + 8 * fq;
#pragma unroll
        for (int ai = 0; ai < 2; ++ai)
#pragma unroll
            for (int m = 0; m < 4; ++m) { const int row = row0 + ai * HALF + m * 16; const float s = rs[row];
                float o[8];
#pragma unroll
                for (int n = 0; n < 2; ++n)
#pragma unroll
                    for (int j = 0; j < 4; ++j) { const float gg = acc[ai][0][m][n][j] * s, uu = acc[ai][1][m][n][j] * s; o[n * 4 + j] = gg * sigmoidf_(gg) * uu; }
                u32x4 w; w.x = pk2(o[0], o[1]); w.y = pk2(o[2], o[3]); w.z = pk2(o[4], o[5]); w.w = pk2(o[6], o[7]);
                *(u32x4*)(act + (size_t)row * FFN + col0) = w; }
        return false;
    }
};
}

struct Args { const float* in[30]; float* out; unsigned char* ws; int lo, hi; };
enum { I_X = 0, I_NPM, I_NQM, I_NPF, I_NQF, I_WIN, I_MU, I_W0, I_W2, I_A0, I_A2, I_G2, I_KK, I_KA, I_RK, I_LNW, I_LNB, I_PEK, I_PEV, I_CKW1, I_CKW2, I_CVW1, I_CVW2, I_SINK, I_REL, I_WBR, I_WOUT, I_FG, I_FU, I_FD };

struct Ctx { LAS unsigned char* lds; int tid, lane, wave, G, bid; };

__device__ __forceinline__ void phase_init(const Ctx& c, const float* x, float* xo, bf16_t* xb, float* rs) {
    const int gw = c.bid * 8 + c.wave, NGW = c.G * 8;
    for (int row = gw; row < MROWS; row += NGW) {
        const float* xr = x + (size_t)row * D; float ss = 0.f;
#pragma unroll
        for (int j = 0; j < 2; ++j) { const int e = c.lane * 8 + 512 * j; const f32x4 a = *(const f32x4*)(xr + e), b = *(const f32x4*)(xr + e + 4);
            ss += a[0] * a[0] + a[1] * a[1] + a[2] * a[2] + a[3] * a[3] + b[0] * b[0] + b[1] * b[1] + b[2] * b[2] + b[3] * b[3];
            *(f32x4*)(xo + (size_t)row * D + e) = a; *(f32x4*)(xo + (size_t)row * D + e + 4) = b;
            u32x4 w; w.x = pk2(a[0], a[1]); w.y = pk2(a[2], a[3]); w.z = pk2(b[0], b[1]); w.w = pk2(b[2], b[3]); *(u32x4*)(xb + (size_t)row * D + e) = w; }
        ss = wave_sum(ss);
        if (c.lane == 0) rs[row] = rsqrtf(ss * (1.0f / D) + NORM_EPS);
    }
}
__device__ __forceinline__ void phase_norm_res(const Ctx& c, const bf16_t* y, const float* gain, float* x, bf16_t* xb, float* rs, int row0, int nrows) {
    const int gw = c.bid * 8 + c.wave, NGW = c.G * 8;
    for (int r = gw; r < nrows; r += NGW) {
        const int row = row0 + r; float yv[16]; float ss = 0.f;
#pragma unroll
        for (int j = 0; j < 2; ++j) { float f[8]; unpack8(*(const u32x4*)(y + (size_t)r * D + c.lane * 8 + 512 * j), f);
#pragma unroll
            for (int k = 0; k < 8; ++k) { yv[j * 8 + k] = f[k]; ss += f[k] * f[k]; } }
        ss = wave_sum(ss); const float sc = rsqrtf(ss * (1.0f / D) + NORM_EPS); float s2 = 0.f;
#pragma unroll
        for (int j = 0; j < 2; ++j) { const int e = c.lane * 8 + 512 * j; float* xr = x + (size_t)row * D + e;
            f32x4 a = *(const f32x4*)xr, b = *(const f32x4*)(xr + 4); const f32x4 ga = *(const f32x4*)(gain + e), gb = *(const f32x4*)(gain + e + 4);
#pragma unroll
            for (int k = 0; k < 4; ++k) { a[k] += yv[j * 8 + k] * sc * ga[k]; b[k] += yv[j * 8 + 4 + k] * sc * gb[k]; s2 += a[k] * a[k] + b[k] * b[k]; }
            *(f32x4*)xr = a; *(f32x4*)(xr + 4) = b;
            u32x4 w; w.x = pk2(a[0], a[1]); w.y = pk2(a[2], a[3]); w.z = pk2(b[0], b[1]); w.w = pk2(b[2], b[3]); *(u32x4*)(xb + (size_t)row * D + e) = w; }
        s2 = wave_sum(s2);
        if (c.lane == 0) rs[row] = rsqrtf(s2 * (1.0f / D) + NORM_EPS);
    }
}

__device__ __forceinline__ float cvt_fetch(const Args& a, int layer, int kind, int sub, int k, int n) {
    switch (kind) {
    case 0: { int src; float sc = a.in[I_NPM][layer * D + k];
        if (n < 3096) src = n; else if (n < 3328) return 0.f; else if (n < 4096) src = 3096 + (n - 3328); else src = 3864 + (n - 4096);
        if ((n >= PC_NQ && n < PC_NQ + 512) || (n >= PC_SQ && n < PC_SQ + 512)) sc *= 0.125f;
        return a.in[I_WIN][((size_t)layer * D + k) * IN_COLS + src] * sc; }
    case 1: return a.in[I_WBR][(((size_t)layer * 3 + sub) * 512 + k) * D + n];
    case 2: return a.in[I_WOUT][((size_t)layer * D + k) * D + n];
    case 3: { const int pn = n >> 8, r = n & 255; const float sc = a.in[I_NPF][layer * D + k];
        return (r < 128 ? a.in[I_FG][((size_t)layer * D + k) * FFN + pn * 128 + r] : a.in[I_FU][((size_t)layer * D + k) * FFN + pn * 128 + r - 128]) * sc; }
    case 4: return a.in[I_FD][((size_t)layer * FFN + k) * D + n];
    default: {
        if (n < 512) return k < 64 ? a.in[I_W2][((size_t)layer * 64 + k) * 512 + n] : 0.f;
        if (n < 1024) return (k >= 64 && k < 128) ? a.in[I_A2][((size_t)layer * 64 + k - 64) * 512 + n - 512] : 0.f;
        return k >= 128 ? a.in[I_G2][((size_t)layer * 128 + k - 128) * 512 + n - 1024] : 0.f; }
    }
}
__device__ __forceinline__ void phase_cvt(const Ctx& c, const Args& a, int layer, bf16_t* wb) {
    LAS float* tile = (LAS float*)c.lds;
    constexpr int I0 = 16 * 112, I1 = 3 * 8 * 16, I2 = 16 * 16, I3 = 16 * 88, I4 = 44 * 16, I5 = 4 * 24, NIT = I0 + I1 + I2 + I3 + I4 + I5;
    for (int it = c.bid; it < NIT; it += c.G) {
        int r = it, kind, sub = 0, K, nblk; bf16_t* dst;
        if (r < I0) { kind = 0; K = D; nblk = 112; dst = wb + WB_WIN; }
        else if ((r -= I0) < I1) { kind = 1; sub = r / 128; r -= sub * 128; K = 512; nblk = 16; dst = wb + WB_WBR + (size_t)sub * D * 512; }
        else if ((r -= I1) < I2) { kind = 2; K = D; nblk = 16; dst = wb + WB_WOUT; }
        else if ((r -= I2) < I3) { kind = 3; K = D; nblk = 88; dst = wb + WB_WGU; }
        else if ((r -= I3) < I4) { kind = 4; K = FFN; nblk = 16; dst = wb + WB_WDN; }
        else { r -= I4; kind = 5; K = 256; nblk = 24; dst = wb + WB_LORA; }
        const int kb = r / nblk, nb = r % nblk, k0 = kb * 64, n0 = nb * 64;
        for (int e = c.tid; e < 4096; e += 512) { const int kk = e >> 6, nn = e & 63; tile[kk * 65 + nn] = cvt_fetch(a, layer, kind, sub, k0 + kk, n0 + nn); }
        __syncthreads();
        for (int e = c.tid; e < 2048; e += 512) { const int nn = e >> 5, kp = (e & 31) * 2;
            *(unsigned*)(dst + (size_t)(n0 + nn) * K + k0 + kp) = pk2(tile[kp * 65 + nn], tile[(kp + 1) * 65 + nn]); }
        __syncthreads();
    }
}

struct RowState { float q[64]; float o[64]; float m, l; };
__device__ __forceinline__ void row_init(RowState& s, const bf16_t* qp) {
#pragma unroll
    for (int i = 0; i < 8; ++i) { float f[8]; unpack8(*(const u32x4*)(qp + i * 8), f);
#pragma unroll
        for (int k = 0; k < 8; ++k) s.q[i * 8 + k] = f[k]; }
}
__device__ __forceinline__ void row_reset(RowState& s) {
#pragma unroll
    for (int i = 0; i < 64; ++i) s.o[i] = 0.f;
    s.m = -1e30f; s.l = 0.f;
}
__device__ __forceinline__ void row_key_bf16(RowState& s, const bf16_t* kp, const bf16_t* vp, float bias) {
    float sc = bias;
#pragma unroll
    for (int i = 0; i < 8; ++i) { float f[8]; unpack8(*(const u32x4*)(kp + i * 8), f);
#pragma unroll
        for (int k = 0; k < 8; ++k) sc += s.q[i * 8 + k] * f[k];
        if ((i & 1) == 1) __builtin_amdgcn_sched_barrier(0); }
    const float mn = fmaxf(s.m, sc), corr = __expf(s.m - mn), p = __expf(sc - mn);
    s.l = s.l * corr + p; s.m = mn;
#pragma unroll
    for (int i = 0; i < 8; ++i) { float f[8]; unpack8(*(const u32x4*)(vp + i * 8), f);
#pragma unroll
        for (int k = 0; k < 8; ++k) s.o[i * 8 + k] = s.o[i * 8 + k] * corr + p * f[k];
        if ((i & 1) == 1) __builtin_amdgcn_sched_barrier(0); }
}
__device__ __forceinline__ void row_key_f32(RowState& s, const float* kp, const float* vp, float bias) {
    float sc = bias;
#pragma unroll
    for (int i = 0; i < 16; ++i) { const f32x4 f = *(const f32x4*)(kp + i * 4); sc += s.q[i * 4] * f[0] + s.q[i * 4 + 1] * f[1] + s.q[i * 4 + 2] * f[2] + s.q[i * 4 + 3] * f[3];
        if ((i & 3) == 3) __builtin_amdgcn_sched_barrier(0); }
    const float mn = fmaxf(s.m, sc), corr = __expf(s.m - mn), p = __expf(sc - mn);
    s.l = s.l * corr + p; s.m = mn;
#pragma unroll
    for (int i = 0; i < 16; ++i) { const f32x4 f = *(const f32x4*)(vp + i * 4);
#pragma unroll
        for (int k = 0; k < 4; ++k) s.o[i * 4 + k] = s.o[i * 4 + k] * corr + p * f[k];
        if ((i & 3) == 3) __builtin_amdgcn_sched_barrier(0); }
}

__device__ __forceinline__ float gelu_tanh(float x) { const float t = tanhf(0.7978845608028654f * (x + 0.044715f * x * x * x)); return 0.5f * x * (1.0f + t); }
__device__ __forceinline__ void phase_cmp1(const Ctx& c, const Args& a, int layer, const bf16_t* proj, float* hid) {
    for (int unit = c.bid; unit < 2048; unit += c.G) {
        const int kv = unit >> 10, g = (unit >> 9) & 1, cp = unit & 511; const int cc = cp * 2 + (c.tid >> 8), u = c.tid & 255;
        if (cc >= NCMP) continue;
        const float* w1 = a.in[kv ? I_CVW1 : I_CKW1] + (size_t)layer * 2048 * 256; const float* pe = a.in[kv ? I_PEV : I_PEK] + (size_t)layer * 32 * 64;
        const bf16_t* xp = proj + (size_t)(16 * cc) * PLD + (kv ? PC_VC : PC_KC) + g * 64;
        float acc = 0.f;
        for (int l = 0; l < 32; ++l) {
#pragma unroll
            for (int i = 0; i < 8; ++i) { float f[8]; unpack8(*(const u32x4*)(xp + (size_t)l * PLD + i * 8), f);
#pragma unroll
                for (int k = 0; k < 8; ++k) acc += (f[k] + pe[l * 64 + i * 8 + k]) * w1[(size_t)(l * 64 + i * 8 + k) * 256 + u]; }
        }
        hid[(((size_t)kv * 2 + g) * 1024 + cc) * 256 + u] = gelu_tanh(acc);
    }
}
__device__ __forceinline__ void phase_cmp2(const Ctx& c, const Args& a, int layer, const float* hid, float* kcmp, float* vcmp) {
    for (int unit = c.bid; unit < 512; unit += c.G) {
        const int kv = unit >> 8, g = (unit >> 7) & 1, cc = (unit & 127) * 8 + (c.tid >> 6), d = c.tid & 63;
        if (cc >= NCMP) continue;
        const float* w2 = a.in[kv ? I_CVW2 : I_CKW2] + (size_t)layer * 256 * 64; const float* hp = hid + (((size_t)kv * 2 + g) * 1024 + cc) * 256;
        float acc = 0.f;
        for (int u = 0; u < 256; ++u) acc += hp[u] * w2[u * 64 + d];
        (kv ? vcmp : kcmp)[((size_t)g * 1024 + cc) * 64 + d] = acc;
    }
}
__device__ __forceinline__ void phase_nsa13(const Ctx& c, const Args& a, const bf16_t* proj, const float* kcmp, const float* vcmp, float* nsaacc, float* ml) {
    LAS float* tb = (LAS float*)c.lds;
    for (int e = c.tid; e < 512; e += 512) tb[e] = a.in[I_REL][e];
    __syncthreads();
    for (int unit = c.bid; unit < T / 64; unit += c.G) {
        const int hh = c.tid >> 6, t = unit * 64 + (c.tid & 63), g = hh >> 2;
        RowState s; row_init(s, proj + (size_t)t * PLD + PC_NQ + hh * 64);
        const bf16_t* glp = proj + (size_t)t * PLD + PC_GL;
        const float g0 = sigmoidf_(bf2f(glp[hh])), g2 = sigmoidf_(bf2f(glp[16 + hh]));
        row_reset(s);
        const int nv = t >= 31 ? (t - 31) / 16 + 1 : 0;
        for (int cc = 0; cc < nv; ++cc) { const float bias = tb[t5_bucket(t - 16 * cc - 31) * 16 + hh];
            row_key_f32(s, kcmp + ((size_t)g * 1024 + cc) * 64, vcmp + ((size_t)g * 1024 + cc) * 64, bias); }
        ml[((size_t)t * 8 + hh) * 2] = s.m; ml[((size_t)t * 8 + hh) * 2 + 1] = s.l;
        float* op = nsaacc + (size_t)t * 512 + hh * 64;
        { const float inv = s.l > 0.f ? g0 / s.l : 0.f;
#pragma unroll
            for (int i = 0; i < 16; ++i) { f32x4 w; w[0] = s.o[i * 4] * inv; w[1] = s.o[i * 4 + 1] * inv; w[2] = s.o[i * 4 + 2] * inv; w[3] = s.o[i * 4 + 3] * inv; *(f32x4*)(op + i * 4) = w; } }
        row_reset(s);
        const int s0 = t - 511 > 0 ? t - 511 : 0;
        for (int sp = s0; sp <= t; ++sp) { const float bias = tb[t5_bucket(t - sp) * 16 + hh];
            row_key_bf16(s, proj + (size_t)sp * PLD + PC_KW + g * 64, proj + (size_t)sp * PLD + PC_VW + g * 64, bias); }
        { const float inv = s.l > 0.f ? g2 / s.l : 0.f;
#pragma unroll
            for (int i = 0; i < 16; ++i) { f32x4 w = *(const f32x4*)(op + i * 4); w[0] += s.o[i * 4] * inv; w[1] += s.o[i * 4 + 1] * inv; w[2] += s.o[i * 4 + 2] * inv; w[3] += s.o[i * 4 + 3] * inv; *(f32x4*)(op + i * 4) = w; } }
    }
}
__device__ __forceinline__ void phase_nsa_topk(const Ctx& c, const Args& a, const bf16_t* proj, const float* kcmp, const float* ml, int* sel) {
    LAS float* tb = (LAS float*)c.lds;
    LAS float* qs = (LAS float*)(c.lds + 4096) + c.wave * 256;
    LAS float* sv = (LAS float*)(c.lds + 16384) + c.wave * 256;
    for (int e = c.tid; e < 512; e += 512) tb[e] = a.in[I_REL][e];
    __syncthreads();
    const int gw = c.bid * 8 + c.wave, NGW = c.G * 8;
    for (int item = gw; item < T * 2; item += NGW) {
        const int t = item >> 1, g = item & 1, cur = t >> 6;
        { const bf16_t* qp = proj + (size_t)t * PLD + PC_NQ + g * 256 + c.lane * 4; const u32x2 w = *(const u32x2*)qp;
          qs[c.lane * 4] = __uint_as_float(w.x << 16); qs[c.lane * 4 + 1] = __uint_as_float(w.x & 0xffff0000u); qs[c.lane * 4 + 2] = __uint_as_float(w.y << 16); qs[c.lane * 4 + 3] = __uint_as_float(w.y & 0xffff0000u); }
        float mr[4], il[4];
#pragma unroll
        for (int r = 0; r < 4; ++r) { mr[r] = ml[((size_t)t * 8 + g * 4 + r) * 2]; const float l = ml[((size_t)t * 8 + g * 4 + r) * 2 + 1]; il[r] = l > 0.f ? 1.0f / l : 0.f; }
        const int nv = t >= 31 ? (t - 31) / 16 + 1 : 0;
        asm volatile("s_waitcnt lgkmcnt(0)" ::: "memory");
#pragma unroll 1
        for (int jj = 0; jj < 4; ++jj) {
            const int j = c.lane + 64 * jj; float sc;
            if (j == 0 || j == cur || j == cur - 1) sc = 1e4f;
            else if (j > cur) sc = -1.0f;
            else { sc = 0.f;
#pragma unroll 1
                for (int o = 0; o < 5; ++o) { const int cc = 4 * j + o - 1; if (cc < 0 || cc >= nv) continue;
                    const float* kp = kcmp + ((size_t)g * 1024 + cc) * 64; float d0 = 0.f, d1 = 0.f, d2 = 0.f, d3 = 0.f;
#pragma unroll 4
                    for (int i = 0; i < 16; ++i) { const f32x4 f = *(const f32x4*)(kp + i * 4);
#pragma unroll
                        for (int k = 0; k < 4; ++k) { d0 += qs[i * 4 + k] * f[k]; d1 += qs[64 + i * 4 + k] * f[k]; d2 += qs[128 + i * 4 + k] * f[k]; d3 += qs[192 + i * 4 + k] * f[k]; } }
                    const int bk = t5_bucket(t - 16 * cc - 31) * 16 + g * 4;
                    const float imp = __expf(d0 + tb[bk] - mr[0]) * il[0] + __expf(d1 + tb[bk + 1] - mr[1]) * il[1] + __expf(d2 + tb[bk + 2] - mr[2]) * il[2] + __expf(d3 + tb[bk + 3] - mr[3]) * il[3];
                    sc += ((o == 0 || o == 4) ? 1.0f : 2.0f) * imp; }
            }
            sv[j] = sc;
        }
        asm volatile("s_waitcnt lgkmcnt(0)" ::: "memory");
        float val[4];
#pragma unroll
        for (int jj = 0; jj < 4; ++jj) val[jj] = sv[c.lane + 64 * jj];
        for (int k = 0; k < 16; ++k) {
            float bv = val[0]; int bi = c.lane;
#pragma unroll
            for (int jj = 1; jj < 4; ++jj) if (val[jj] > bv) { bv = val[jj]; bi = c.lane + 64 * jj; }
#pragma unroll
            for (int o = 32; o >= 1; o >>= 1) { const float ov = __shfl_xor(bv, o); const int oi = __shfl_xor(bi, o); if (ov > bv || (ov == bv && oi < bi)) { bv = ov; bi = oi; } }
#pragma unroll
            for (int jj = 0; jj < 4; ++jj) if (bi == c.lane + 64 * jj) val[jj] = -3e38f;
            if (c.lane == 0) sel[(size_t)item * 16 + k] = bi;
        }
    }
}
__device__ __forceinline__ void phase_nsa2(const Ctx& c, const Args& a, const bf16_t* proj, const int* sel, const float* nsaacc, bf16_t* onsa) {
    LAS float* tb = (LAS float*)c.lds;
    for (int e = c.tid; e < 512; e += 512) tb[e] = a.in[I_REL][e];
    __syncthreads();
    for (int unit = c.bid; unit < T / 64; unit += c.G) {
        const int hh = c.tid >> 6, t = unit * 64 + (c.tid & 63), g = hh >> 2;
        RowState s; row_init(s, proj + (size_t)t * PLD + PC_NQ + hh * 64); row_reset(s);
        const float g1 = sigmoidf_(bf2f(proj[(size_t)t * PLD + PC_GL + 8 + hh]));
        for (int k = 0; k < 16; ++k) { const int j = sel[((size_t)t * 2 + g) * 16 + k];
            for (int p = 0; p < 64; ++p) { const int pos = j * 64 + p; if (pos > t) break;
                const float bias = tb[t5_bucket(t - pos) * 16 + hh];
                row_key_bf16(s, proj + (size_t)pos * PLD + PC_KS + g * 64, proj + (size_t)pos * PLD + PC_VS + g * 64, bias); } }
        const float inv = s.l > 0.f ? g1 / s.l : 0.f; const float* ap = nsaacc + (size_t)t * 512 + hh * 64; bf16_t* op = onsa + (size_t)t * 512 + hh * 64;
#pragma unroll
        for (int i = 0; i < 8; ++i) { const f32x4 x0 = *(const f32x4*)(ap + i * 8), x1 = *(const f32x4*)(ap + i * 8 + 4); u32x4 w;
            w.x = pk2(x0[0] + s.o[i * 8] * inv, x0[1] + s.o[i * 8 + 1] * inv); w.y = pk2(x0[2] + s.o[i * 8 + 2] * inv, x0[3] + s.o[i * 8 + 3] * inv);
            w.z = pk2(x1[0] + s.o[i * 8 + 4] * inv, x1[1] + s.o[i * 8 + 5] * inv); w.w = pk2(x1[2] + s.o[i * 8 + 6] * inv, x1[3] + s.o[i * 8 + 7] * inv);
            *(u32x4*)(op + i * 8) = w; }
    }
}
__device__ __forceinline__ void phase_swa(const Ctx& c, const Args& a, int layer, const bf16_t* proj, bf16_t* oswa) {
    LAS float* tb = (LAS float*)c.lds;
    for (int e = c.tid; e < 512; e += 512) tb[e] = a.in[I_REL][e];
    __syncthreads();
    for (int unit = c.bid; unit < T / 64; unit += c.G) {
        const int hh = c.tid >> 6, t = unit * 64 + (c.tid & 63), g = hh >> 2;
        RowState s; row_init(s, proj + (size_t)t * PLD + PC_SQ + hh * 64); row_reset(s);
        const int s0 = t - 127 > 0 ? t - 127 : 0;
        for (int sp = s0; sp <= t; ++sp) { const float bias = tb[t5_bucket(t - sp) * 16 + 8 + hh];
            row_key_bf16(s, proj + (size_t)sp * PLD + PC_SK + g * 64, proj + (size_t)sp * PLD + PC_SV + g * 64, bias); }
        const float sink = a.in[I_SINK][layer * 8 + hh]; const float mf = fmaxf(s.m, sink); const float corr = __expf(s.m - mf);
        const float den = s.l * corr + __expf(sink - mf); const float inv = corr / den;
        bf16_t* op = oswa + (size_t)t * 512 + hh * 64;
#pragma unroll
        for (int i = 0; i < 8; ++i) { u32x4 w; w.x = pk2(s.o[i * 8] * inv, s.o[i * 8 + 1] * inv); w.y = pk2(s.o[i * 8 + 2] * inv, s.o[i * 8 + 3] * inv);
            w.z = pk2(s.o[i * 8 + 4] * inv, s.o[i * 8 + 5] * inv); w.w = pk2(s.o[i * 8 + 6] * inv, s.o[i * 8 + 7] * inv); *(u32x4*)(op + i * 8) = w; }
    }
}

constexpr int RL = 65;
__device__ __forceinline__ float rwkv_mixed(const bf16_t* proj, const float* mu, int t, int col) {
    const float cur = bf2f(proj[(size_t)t * PLD + col]); const float prev = t > 0 ? bf2f(proj[(size_t)(t - 1) * PLD + col]) : 0.f;
    return cur + (prev - cur) * mu[col];
}
__device__ __forceinline__ void lora64(const Ctx& c, const LAS float* in, const float* W, const float* bias, LAS float* out, bool accum) {
    const int j = c.tid & 63, tg = (c.tid >> 6) * 8;
    float acc[8];
#pragma unroll
    for (int i = 0; i < 8; ++i) acc[i] = accum ? out[(tg + i) * RL + j] : (bias ? bias[j] : 0.f);
#pragma unroll 4
    for (int m = 0; m < 64; ++m) { const float w = W[(size_t)m * 512 + j];
#pragma unroll
        for (int i = 0; i < 8; ++i) acc[i] += in[(tg + i) * RL + m] * w; }
#pragma unroll
    for (int i = 0; i < 8; ++i) out[(tg + i) * RL + j] = acc[i];
}
struct RwkvLds { LAS float *R, *K, *V, *A, *B, *W, *G, *TMP; };
__device__ __forceinline__ RwkvLds rwkv_lds(LAS unsigned char* lds) {
    RwkvLds s; LAS float* p = (LAS float*)lds; constexpr int SZ = 64 * RL;
    s.R = p; s.K = p + SZ; s.V = p + 2 * SZ; s.A = p + 3 * SZ; s.B = p + 4 * SZ; s.W = p + 5 * SZ; s.G = p + 6 * SZ; s.TMP = p + 7 * SZ; return s;
}
template <bool LOGDECAY>
__device__ __forceinline__ void rwkv_prep(const Ctx& c, const Args& a, int layer, const bf16_t* proj, int t0, int h, const RwkvLds& s) {
    const float* mu = a.in[I_MU] + (size_t)layer * 1792;
    const int j = c.tid & 63, tg = c.tid >> 6;
#pragma unroll 2
    for (int i = 0; i < 8; ++i) { const int tt = tg * 8 + i; s.TMP[tt * RL + j] = tanhf(rwkv_mixed(proj, mu, t0 + tt, PC_ZW + j)); }
    __syncthreads();
    lora64(c, s.TMP, a.in[I_W2] + (size_t)layer * 64 * 512 + h * 64, a.in[I_W0] + layer * 512 + h * 64, s.W, false);
    __syncthreads();
#pragma unroll 2
    for (int i = 0; i < 8; ++i) { const int tt = tg * 8 + i; s.TMP[tt * RL + j] = rwkv_mixed(proj, mu, t0 + tt, PC_ZA + j); }
    __syncthreads();
    lora64(c, s.TMP, a.in[I_A2] + (size_t)layer * 64 * 512 + h * 64, a.in[I_A0] + layer * 512 + h * 64, s.B, false);
    __syncthreads();
#pragma unroll 2
    for (int i = 0; i < 8; ++i) { const int tt = tg * 8 + i; s.TMP[tt * RL + j] = sigmoidf_(rwkv_mixed(proj, mu, t0 + tt, PC_ZG + j)); }
    __syncthreads();
    lora64(c, s.TMP, a.in[I_G2] + (size_t)layer * 128 * 512 + h * 64, nullptr, s.G, false);
    __syncthreads();
#pragma unroll 2
    for (int i = 0; i < 8; ++i) { const int tt = tg * 8 + i; s.TMP[tt * RL + j] = sigmoidf_(rwkv_mixed(proj, mu, t0 + tt, PC_ZG + 64 + j)); }
    __syncthreads();
    lora64(c, s.TMP, a.in[I_G2] + ((size_t)layer * 128 + 64) * 512 + h * 64, nullptr, s.G, true);
    const float kkw = a.in[I_KK][layer * 512 + h * 64 + j], kaw = a.in[I_KA][layer * 512 + h * 64 + j];
#pragma unroll 1
    for (int i = 0; i < 8; ++i) { const int tt = tg * 8 + i, t = t0 + tt;
        const float r = rwkv_mixed(proj, mu, t, PC_R + h * 64 + j), k = rwkv_mixed(proj, mu, t, PC_K + h * 64 + j), v = rwkv_mixed(proj, mu, t, PC_V + h * 64 + j);
        const float wl = s.W[tt * RL + j], al = sigmoidf_(s.B[tt * RL + j]);
        const float sp = (-wl > 20.f) ? -wl : log1pf(__expf(-wl)); const float w = -sp - 0.5f; const float ew = __expf(w);
        float kk = k * kkw; const float n2 = wave_sum(kk * kk); kk = kk / fmaxf(sqrtf(n2), 1e-12f);
        s.R[tt * RL + j] = r; s.V[tt * RL + j] = v; s.K[tt * RL + j] = k * (1.0f + (al - 1.0f) * kaw);
        s.A[tt * RL + j] = -kk; s.B[tt * RL + j] = kk * al; s.W[tt * RL + j] = LOGDECAY ? -ew : __expf(-ew); }
    __syncthreads();
}
__device__ __forceinline__ void rwkv_post(const Ctx& c, const Args& a, int layer, int t0, int h, const RwkvLds& s, const LAS float* Y, bf16_t* orwkv) {
    const int i = c.lane, tg = c.wave;
    const float lnw = a.in[I_LNW][layer * 512 + h * 64 + i], lnb = a.in[I_LNB][layer * 512 + h * 64 + i], rk = a.in[I_RK][layer * 512 + h * 64 + i];
#pragma unroll 1
    for (int q = 0; q < 8; ++q) { const int tt = tg * 8 + q; const float y = Y[tt * RL + i];
        const float mean = wave_sum(y) * (1.0f / 64.0f); const float d = y - mean; const float var = wave_sum(d * d) * (1.0f / 64.0f);
        const float bonus = wave_sum(s.R[tt * RL + i] * s.K[tt * RL + i] * rk);
        const float o = (d * rsqrtf(var + 64e-5f) * lnw + lnb + bonus * s.V[tt * RL + i]) * s.G[tt * RL + i];
        orwkv[(size_t)(t0 + tt) * 512 + h * 64 + i] = (bf16_t)f2bf(o); }
}
__device__ __forceinline__ void phase_rwkv_naive(const Ctx& c, const Args& a, int layer, const bf16_t* proj, bf16_t* orwkv) {
    if (c.bid >= 8) return;
    const int h = c.bid; const RwkvLds s = rwkv_lds(c.lds);
    float S[64];
#pragma unroll
    for (int j = 0; j < 64; ++j) S[j] = 0.f;
    for (int ch = 0; ch < T / 64; ++ch) {
        rwkv_prep<false>(c, a, layer, proj, ch * 64, h, s);
        if (c.wave == 0) {
            const int i = c.lane;
            for (int tt = 0; tt < 64; ++tt) {
                float sa = 0.f;
#pragma unroll
                for (int j = 0; j < 64; ++j) { sa += S[j] * s.A[tt * RL + j]; if ((j & 7) == 7) __builtin_amdgcn_sched_barrier(0); }
                const float vi = s.V[tt * RL + i]; float y = 0.f;
#pragma unroll
                for (int j = 0; j < 64; ++j) { S[j] = S[j] * s.W[tt * RL + j] + sa * s.B[tt * RL + j] + vi * s.K[tt * RL + j]; y += S[j] * s.R[tt * RL + j]; if ((j & 3) == 3) __builtin_amdgcn_sched_barrier(0); }
                s.TMP[tt * RL + i] = y;
            }
        }
        __syncthreads();
        rwkv_post(c, a, layer, ch * 64, h, s, s.TMP, orwkv);
        __syncthreads();
    }
}


__device__ __forceinline__ int kperm32(int jl) { return 8 * ((jl >> 2) & 3) + 4 * (jl >> 4) + (jl & 3); }
__device__ __forceinline__ f32x4 tile_mma64(const LAS unsigned char* A, const LAS unsigned char* B, int a, int b, int lane, f32x4 acc) {
    const int m = lane & 15, q = lane >> 4;
#pragma unroll
    for (int ks = 0; ks < 2; ++ks) {
        const bf16x8 af = *(const LAS bf16x8*)(A + (16 * a + m) * 144 + (32 * ks + 8 * q) * 2);
        const bf16x8 bf = *(const LAS bf16x8*)(B + (16 * b + m) * 144 + (32 * ks + 8 * q) * 2);
        acc = __builtin_amdgcn_mfma_f32_16x16x32_bf16(af, bf, acc, 0, 0, 0);
    }
    return acc;
}
__device__ __forceinline__ void lds_st_bf16(LAS unsigned char* base, int idx, float v) { *(LAS bf16_t*)(base + idx * 2) = (bf16_t)f2bf(v); }

__device__ __forceinline__ void phase_lora_a(const Ctx& c, const Args& a, int layer, const bf16_t* proj, bf16_t* alora) {
    const float* mu = a.in[I_MU] + (size_t)layer * 1792;
    const int sub = c.tid & 31, rloc = c.tid >> 5;
    for (int t = c.bid * 16 + rloc; t < T; t += c.G * 16) {
        const int col = PC_ZW + sub * 8; float cur[8], prv[8];
        unpack8(*(const u32x4*)(proj + (size_t)t * PLD + col), cur);
        if (t > 0) unpack8(*(const u32x4*)(proj + (size_t)(t - 1) * PLD + col), prv); else {
#pragma unroll
            for (int k = 0; k < 8; ++k) prv[k] = 0.f; }
        float o[8];
#pragma unroll
        for (int k = 0; k < 8; ++k) { const float v = cur[k] + (prv[k] - cur[k]) * mu[col + k]; o[k] = sub < 8 ? tanhf(v) : (sub < 16 ? v : sigmoidf_(v)); }
        u32x4 w; w.x = pk2(o[0], o[1]); w.y = pk2(o[2], o[3]); w.z = pk2(o[4], o[5]); w.w = pk2(o[6], o[7]);
        *(u32x4*)(alora + (size_t)t * 256 + sub * 8) = w;
    }
}

constexpr int RC_L = 0, RC_AL = 16640, RC_AAK = 0, RC_ARB = 9216, RC_ARK = 18432, RC_AAB = 33280, RC_P2T = 33280, RC_WC = 50688, RC_BS = 50944, RC_M = 52992;
constexpr int RC_AT = RC_M, RC_TINV = RC_M, RC_ATT = RC_M + 9216, RC_RT = RC_M + 2 * 9216, RC_BT = RC_M + 3 * 9216, RC_XT = RC_BT, RC_KT = RC_M + 4 * 9216, RC_P1T = RC_KT,
              RC_VT = RC_M + 5 * 9216, RC_BHT = RC_M + 6 * 9216, RC_KHT = RC_M + 7 * 9216;
static_assert(RC_M + 8 * 9216 <= LDS_MISC, "rwkv chunk LDS");

__device__ __forceinline__ void phase_rwkv_chunk(const Ctx& c, const Args& a, int layer, const bf16_t* proj, const bf16_t* wlb, const bf16_t* alb, bf16_t* rwu, float* bonusg) {
    LAS unsigned char* L = c.lds;
    LAS float* sL = (LAS float*)(L + RC_L); LAS float* sAL = (LAS float*)(L + RC_AL); LAS float* sAAB = (LAS float*)(L + RC_AAB);
    LAS float* sWC = (LAS float*)(L + RC_WC); LAS float* sBS = (LAS float*)(L + RC_BS);
    const float* mu = a.in[I_MU] + (size_t)layer * 1792;
    const int lane = c.lane, wave = c.wave, n = lane & 15, q = lane >> 4;
    for (int unit = c.bid; unit < 2048; unit += c.G) {
        const int ch = unit >> 3, h = unit & 7, t0 = ch * 64, j = lane;
        {
            const float w0 = a.in[I_W0][layer * 512 + h * 64 + j], a0 = a.in[I_A0][layer * 512 + h * 64 + j];
            float run = 0.f;
#pragma unroll 2
            for (int i = 0; i < 8; ++i) { const int tt = wave * 8 + i; const size_t gi = (size_t)(t0 + tt) * 512 + h * 64 + j;
                const float wl = w0 + bf2f(wlb[gi]); const float nx = -wl; const float sp = nx > 20.f ? nx : log1pf(__expf(nx)); const float ld = -__expf(-sp - 0.5f);
                run += ld; sL[tt * RL + j] = run; sAL[tt * RL + j] = sigmoidf_(a0 + bf2f(alb[gi])); }
            sBS[wave * 64 + j] = run;
        }
        __syncthreads();
        {
            float off = 0.f, tot = 0.f;
#pragma unroll
            for (int w2 = 0; w2 < 8; ++w2) { const float v = sBS[w2 * 64 + j]; tot += v; off += (w2 < wave) ? v : 0.f; }
            if (wave == 0) sWC[j] = __expf(tot);
            const float kkw = a.in[I_KK][layer * 512 + h * 64 + j], kaw = a.in[I_KA][layer * 512 + h * 64 + j], rk = a.in[I_RK][layer * 512 + h * 64 + j];
            float Lprev = off;
#pragma unroll 1
            for (int i = 0; i < 8; ++i) { const int tt = wave * 8 + i, t = t0 + tt;
                const float Lc = sL[tt * RL + j] + off, al = sAL[tt * RL + j];
                const float r = rwkv_mixed(proj, mu, t, PC_R + h * 64 + j), k = rwkv_mixed(proj, mu, t, PC_K + h * 64 + j), v = rwkv_mixed(proj, mu, t, PC_V + h * 64 + j);
                float kk = k * kkw; const float n2 = wave_sum(kk * kk); kk = kk / fmaxf(sqrtf(n2), 1e-12f);
                const float kp = k * (1.0f + (al - 1.0f) * kaw), av = -kk, bv = kk * al;
                const float eW = __expf(Lc), eWex = __expf(Lprev), eInv = __expf(-Lc), eC = __expf(tot - Lc);
                lds_st_bf16(L + RC_AT, tt * 72 + j, av * eWex); lds_st_bf16(L + RC_ATT, j * 72 + tt, av * eWex);
                lds_st_bf16(L + RC_RT, tt * 72 + j, r * eW); lds_st_bf16(L + RC_BT, tt * 72 + j, bv * eInv); lds_st_bf16(L + RC_KT, tt * 72 + j, kp * eInv);
                lds_st_bf16(L + RC_VT, j * 72 + tt, v); lds_st_bf16(L + RC_BHT, j * 72 + tt, bv * eC); lds_st_bf16(L + RC_KHT, j * 72 + tt, kp * eC);
                const float bon = wave_sum(r * kp * rk); if (lane == 0) bonusg[(size_t)t * 8 + h] = bon;
                Lprev = Lc; }
        }
        __syncthreads();
        for (int job = wave; job < 64; job += 8) {
            const int p = job >> 4, ta = (job >> 2) & 3, tb = job & 3;
            f32x4 acc = (f32x4){0.f, 0.f, 0.f, 0.f};
            if (ta >= tb) acc = tile_mma64(L + (p < 2 ? RC_AT : RC_RT), L + ((p & 1) ? RC_KT : RC_BT), ta, tb, lane, acc);
            LAS unsigned char* dst = L + (p == 1 ? RC_AAK : (p == 2 ? RC_ARB : RC_ARK));
#pragma unroll
            for (int r = 0; r < 4; ++r) { const int tt = 16 * ta + 4 * q + r, ss = 16 * tb + n; const bool keep = (p < 2) ? (ss < tt) : (ss <= tt); const float v = keep ? acc[r] : 0.f;
                if (p == 0) sAAB[tt * 68 + ss] = v; else lds_st_bf16(dst, tt * 72 + ss, v); }
        }
        __syncthreads();
        if (wave == 0) {
            float X[64];
#pragma unroll
            for (int tt = 0; tt < 64; ++tt) { float acc = (tt == lane) ? 1.f : 0.f;
#pragma unroll
                for (int ss = 0; ss < tt; ++ss) acc += sAAB[tt * 68 + ss] * X[ss];
                X[tt] = acc; lds_st_bf16(L + RC_TINV, tt * 72 + lane, acc); }
        } else {
            for (int job = wave - 1; job < 16; job += 7) { const int ta = job >> 2, tb = job & 3;
                const f32x4 acc = tile_mma64(L + RC_VT, L + RC_AAK, ta, tb, lane, (f32x4){0.f, 0.f, 0.f, 0.f});
#pragma unroll
                for (int r = 0; r < 4; ++r) lds_st_bf16(L + RC_XT, (16 * ta + 4 * q + r) * 72 + 16 * tb + n, acc[r]); }
        }
        __syncthreads();
        for (int job = wave; job < 32; job += 8) { const int p = job >> 4, ta = (job >> 2) & 3, tb = job & 3;
            const f32x4 acc = tile_mma64(L + (p ? RC_XT : RC_ATT), L + RC_TINV, ta, tb, lane, (f32x4){0.f, 0.f, 0.f, 0.f});
#pragma unroll
            for (int r = 0; r < 4; ++r) lds_st_bf16(L + (p ? RC_P2T : RC_P1T), (16 * ta + 4 * q + r) * 72 + 16 * tb + n, acc[r]); }
        __syncthreads();
        bf16_t* ug = rwu + (size_t)unit * 16384;
        for (int job = wave; job < 64; job += 8) { const int p = job >> 4, ta = (job >> 2) & 3, tb = job & 3;
            f32x4 acc = (f32x4){0.f, 0.f, 0.f, 0.f};
            if (p == 0) { acc = tile_mma64(L + RC_ARB, L + RC_P1T, ta, tb, lane, acc);
#pragma unroll
                for (int r = 0; r < 4; ++r) { const int tt = 16 * ta + 4 * q + r, jj = 16 * tb + n; const float v = acc[r] + bf2f(*(const LAS bf16_t*)(L + RC_RT + (tt * 72 + jj) * 2));
                    ug[8192 + tt * 64 + (jj & 32) + kperm32(jj & 31)] = (bf16_t)f2bf(v); } }
            else if (p == 1) { acc = tile_mma64(L + RC_ARB, L + RC_P2T, ta, tb, lane, acc); acc = tile_mma64(L + RC_ARK, L + RC_VT, ta, tb, lane, acc);
                u32x2 w; w.x = pk2(acc[0], acc[1]); w.y = pk2(acc[2], acc[3]); *(u32x2*)(ug + 12288 + ((tb * 4 + ta) * 64 + lane) * 4) = w; }
            else if (p == 2) { acc = tile_mma64(L + RC_BHT, L + RC_P1T, ta, tb, lane, acc);
#pragma unroll
                for (int r = 0; r < 4; ++r) { const int jr = 16 * ta + 4 * q + r, jc = 16 * tb + n; const float v = acc[r] + (jr == jc ? sWC[jr] : 0.f);
                    ug[jr * 64 + (jc & 32) + kperm32(jc & 31)] = (bf16_t)f2bf(v); } }
            else { acc = tile_mma64(L + RC_BHT, L + RC_P2T, ta, tb, lane, acc); acc = tile_mma64(L + RC_KHT, L + RC_VT, ta, tb, lane, acc);
                u32x2 w; w.x = pk2(acc[0], acc[1]); w.y = pk2(acc[2], acc[3]); *(u32x2*)(ug + 4096 + ((tb * 4 + ta) * 64 + lane) * 4) = w; }
        }
        __syncthreads();
    }
}

__device__ __forceinline__ void phase_rwkv_scan(const Ctx& c, const bf16_t* rwu, bf16_t* rws) {
    const int idx = c.bid * 8 + c.wave; if (idx >= 32) return;
    const int h = idx >> 2, cq = idx & 3, lane = c.lane, m = lane & 15, q = lane >> 4;
    bf16x8 Bhi[2], Blo[2];
#pragma unroll
    for (int s = 0; s < 2; ++s) { Bhi[s] = (bf16x8){0, 0, 0, 0, 0, 0, 0, 0}; Blo[s] = Bhi[s]; }
    bf16x8 An[4][2]; u32x2 Zn[4];
    { const bf16_t* ug = rwu + (size_t)h * 16384;
#pragma unroll
      for (int ta = 0; ta < 4; ++ta) { An[ta][0] = *(const bf16x8*)(ug + (16 * ta + m) * 64 + 8 * q); An[ta][1] = *(const bf16x8*)(ug + (16 * ta + m) * 64 + 32 + 8 * q);
          Zn[ta] = *(const u32x2*)(ug + 4096 + ((cq * 4 + ta) * 64 + lane) * 4); } }
    for (int ch = 0; ch < T / 64; ++ch) {
        const int unit = ch * 8 + h;
        bf16x8 Ac[4][2]; u32x2 Zc[4];
#pragma unroll
        for (int ta = 0; ta < 4; ++ta) { Ac[ta][0] = An[ta][0]; Ac[ta][1] = An[ta][1]; Zc[ta] = Zn[ta]; }
        if (ch + 1 < T / 64) { const bf16_t* ug = rwu + (size_t)(unit + 8) * 16384;
#pragma unroll
            for (int ta = 0; ta < 4; ++ta) { An[ta][0] = *(const bf16x8*)(ug + (16 * ta + m) * 64 + 8 * q); An[ta][1] = *(const bf16x8*)(ug + (16 * ta + m) * 64 + 32 + 8 * q);
                Zn[ta] = *(const u32x2*)(ug + 4096 + ((cq * 4 + ta) * 64 + lane) * 4); } }
        bf16_t* sg = rws + (size_t)unit * 4096 + cq * 1024 + lane * 8;
        *(bf16x8*)(sg) = Bhi[0]; *(bf16x8*)(sg + 512) = Bhi[1];
        f32x4 acc[4];
#pragma unroll
        for (int ta = 0; ta < 4; ++ta) { acc[ta] = (f32x4){__uint_as_float(Zc[ta].x << 16), __uint_as_float(Zc[ta].x & 0xffff0000u), __uint_as_float(Zc[ta].y << 16), __uint_as_float(Zc[ta].y & 0xffff0000u)};
#pragma unroll
            for (int s = 0; s < 2; ++s) { acc[ta] = __builtin_amdgcn_mfma_f32_16x16x32_bf16(Ac[ta][s], Bhi[s], acc[ta], 0, 0, 0); acc[ta] = __builtin_amdgcn_mfma_f32_16x16x32_bf16(Ac[ta][s], Blo[s], acc[ta], 0, 0, 0); } }
#pragma unroll
        for (int s = 0; s < 2; ++s) { u32x4 hi, lo; float rem[8];
#pragma unroll
            for (int p = 0; p < 8; ++p) { const float v = acc[2 * s + (p >> 2)][p & 3]; const unsigned hb = f2bf(v); rem[p] = v - __uint_as_float(hb << 16); }
            hi.x = pk2(acc[2 * s][0], acc[2 * s][1]); hi.y = pk2(acc[2 * s][2], acc[2 * s][3]); hi.z = pk2(acc[2 * s + 1][0], acc[2 * s + 1][1]); hi.w = pk2(acc[2 * s + 1][2], acc[2 * s + 1][3]);
            lo.x = pk2(rem[0], rem[1]); lo.y = pk2(rem[2], rem[3]); lo.z = pk2(rem[4], rem[5]); lo.w = pk2(rem[6], rem[7]);
            Bhi[s] = __builtin_bit_cast(bf16x8, hi); Blo[s] = __builtin_bit_cast(bf16x8, lo); }
    }
}

__device__ __forceinline__ void phase_rwkv_out(const Ctx& c, const Args& a, int layer, const bf16_t* proj, const bf16_t* rwu, const bf16_t* rws, const float* bonusg, bf16_t* orwkv) {
    const float* mu = a.in[I_MU] + (size_t)layer * 1792;
    const int lane = c.lane, m = lane & 15, q = lane >> 4;
    for (int unit = c.bid * 8 + c.wave; unit < 2048; unit += c.G * 8) {
        const int ch = unit >> 3, h = unit & 7, t0 = ch * 64; const bf16_t* ug = rwu + (size_t)unit * 16384; const bf16_t* sg = rws + (size_t)unit * 4096;
        bf16x8 Bf[4][2];
#pragma unroll
        for (int cq = 0; cq < 4; ++cq) { Bf[cq][0] = *(const bf16x8*)(sg + cq * 1024 + lane * 8); Bf[cq][1] = *(const bf16x8*)(sg + cq * 1024 + 512 + lane * 8); }
        float lnw[4], lnb[4];
#pragma unroll
        for (int cq = 0; cq < 4; ++cq) { lnw[cq] = a.in[I_LNW][layer * 512 + h * 64 + 16 * cq + m]; lnb[cq] = a.in[I_LNB][layer * 512 + h * 64 + 16 * cq + m]; }
#pragma unroll 1
        for (int ta = 0; ta < 4; ++ta) {
            const bf16x8 A0 = *(const bf16x8*)(ug + 8192 + (16 * ta + m) * 64 + 8 * q), A1 = *(const bf16x8*)(ug + 8192 + (16 * ta + m) * 64 + 32 + 8 * q);
            f32x4 y[4];
#pragma unroll
            for (int cq = 0; cq < 4; ++cq) { const u32x2 z = *(const u32x2*)(ug + 12288 + ((cq * 4 + ta) * 64 + lane) * 4);
                y[cq] = (f32x4){__uint_as_float(z.x << 16), __uint_as_float(z.x & 0xffff0000u), __uint_as_float(z.y << 16), __uint_as_float(z.y & 0xffff0000u)};
                y[cq] = __builtin_amdgcn_mfma_f32_16x16x32_bf16(A0, Bf[cq][0], y[cq], 0, 0, 0); y[cq] = __builtin_amdgcn_mfma_f32_16x16x32_bf16(A1, Bf[cq][1], y[cq], 0, 0, 0); }
#pragma unroll
            for (int r = 0; r < 4; ++r) { const int t = t0 + 16 * ta + 4 * q + r;
                float sm = y[0][r] + y[1][r] + y[2][r] + y[3][r];
                sm += __shfl_xor(sm, 1); sm += __shfl_xor(sm, 2); sm += __shfl_xor(sm, 4); sm += __shfl_xor(sm, 8);
                const float mean = sm * (1.0f / 64.0f); float d[4], vs = 0.f;
#pragma unroll
                for (int cq = 0; cq < 4; ++cq) { d[cq] = y[cq][r] - mean; vs += d[cq] * d[cq]; }
                vs += __shfl_xor(vs, 1); vs += __shfl_xor(vs, 2); vs += __shfl_xor(vs, 4); vs += __shfl_xor(vs, 8);
                const float rstd = rsqrtf(vs * (1.0f / 64.0f) + 64e-5f); const float bon = bonusg[(size_t)t * 8 + h];
#pragma unroll
                for (int cq = 0; cq < 4; ++cq) { const int col = h * 64 + 16 * cq + m; const float v = rwkv_mixed(proj, mu, t, PC_V + col);
                    bf16_t* op = orwkv + (size_t)t * 512 + col; const float g = bf2f(*op);
                    *op = (bf16_t)f2bf((d[cq] * rstd * lnw[cq] + lnb[cq] + bon * v) * g); } }
        }
    }
}

constexpr int PH_PER_BATCH = 15, PH_PER_LAYER = 1 + 2 * PH_PER_BATCH + 3, PH_TOTAL = 1 + DEPTH * PH_PER_LAYER;

__global__ void __launch_bounds__(512, 2) fwd_kernel(Args args) {
    extern __shared__ __attribute__((aligned(16))) unsigned char lds_raw[];
    Ctx c0; c0.lds = (LAS unsigned char*)lds_raw; c0.tid = threadIdx.x; c0.lane = c0.tid & 63; c0.wave = __builtin_amdgcn_readfirstlane(c0.tid >> 6); c0.G = gridDim.x; c0.bid = blockIdx.x; const Ctx& c = c0;
    unsigned char* ws = args.ws;
    volatile LAS unsigned* misc = (volatile LAS unsigned*)(c.lds + LDS_MISC);
    if (c.tid < 4) misc[c.tid] = 0u;
    __syncthreads();
    XcdBarrier bar; bar.bar = (unsigned*)(ws + WS_CTL); bar.x = 0; bar.st = misc;
    const int lo = args.lo, hi = args.hi;
    const bool multi = (hi - lo) > 1;
    if (multi) bar = xcd_barrier_post((unsigned*)(ws + WS_CTL), misc);
    int gp = 0;
#ifndef ONLY_PH
#define ONLY_PH -1
#endif
#ifndef PHMASK
#define PHMASK 0xfffff
#endif
#define PHASE_BEGIN(id) if (gp >= lo && gp < hi) { if ((ONLY_PH < 0 || ONLY_PH == (id)) && ((PHMASK >> (id)) & 1)) { \
    Ctx pc = c0; asm volatile("" : "+v"(pc.tid), "+s"(pc.bid)); pc.lane = pc.tid & 63; pc.wave = __builtin_amdgcn_readfirstlane(pc.tid >> 6); const Ctx& c = pc;
#define PHASE_END   } if (gp + 1 < hi) xcd_barrier(bar); } ++gp;

    bf16_t* wb = (bf16_t*)(ws + WS_WB); bf16_t* xb = (bf16_t*)(ws + WS_XB); float* rs = (float*)(ws + WS_RS);
    float* kcmp = (float*)(ws + WS_KCMP); float* vcmp = (float*)(ws + WS_VCMP); int* sel = (int*)(ws + WS_SEL); float* ml = (float*)(ws + WS_ML); float* hid = (float*)(ws + WS_HID);
    bf16_t* proj = (bf16_t*)(ws + WS_PROJ); bf16_t* gates = (bf16_t*)(ws + WS_GATES); bf16_t* merged = (bf16_t*)(ws + WS_MERGED); bf16_t* tmpb = (bf16_t*)(ws + WS_TMPB);
    bf16_t* alora = (bf16_t*)(ws + WS_ALORA); bf16_t* rwu = (bf16_t*)(ws + WS_RWU); bf16_t* rws = (bf16_t*)(ws + WS_RWS); float* bonusg = (float*)(ws + WS_BONUS);
    float* nsaacc = (float*)(ws + WS_NSAACC); bf16_t* obuf = (bf16_t*)(ws + WS_O); bf16_t* act = (bf16_t*)(ws + WS_ACT); bf16_t* tmpf = (bf16_t*)(ws + WS_TMPF);
    float* x = args.out;

    PHASE_BEGIN(0) phase_init(c, args.in[I_X], x, xb, rs); PHASE_END

    for (int layer = 0; layer < DEPTH; ++layer) {
        PHASE_BEGIN(1) phase_cvt(c, args, layer, wb); PHASE_END
        for (int b = 0; b < NBATCH; ++b) {
            const int row0 = b * T;
            PHASE_BEGIN(2) {
                pg8::Gemm g{xb + (size_t)row0 * D, wb + WB_WIN, D, D, D}; pg8::Sched S; S.init(T / 256, NIN / 256, c.G, c.bid, 1, (size_t)256 * D * 2, 0, (size_t)256 * D * 2, 0);
                pg8::EpiInProj E{proj, gates, rs + row0}; pg8::gemm_phase(c.lds, c.tid, g, S, E); } PHASE_END
            PHASE_BEGIN(16) phase_lora_a(c, args, layer, proj, alora); PHASE_END
            PHASE_BEGIN(17) {
                pg8::Gemm g{alora, wb + WB_LORA, 256, 256, 256}; pg8::Sched S; S.init(T / 256, 6, c.G, c.bid, 1, (unsigned)256 * 256 * 2, 0, (unsigned)256 * 256 * 2, 0);
                pg8::EpiLora E{obuf}; pg8::gemm_phase(c.lds, c.tid, g, S, E); } PHASE_END
            PHASE_BEGIN(18) phase_rwkv_chunk(c, args, layer, proj, obuf + (size_t)T * 512, obuf + (size_t)2 * T * 512, rwu, bonusg); PHASE_END
            PHASE_BEGIN(19) phase_rwkv_scan(c, rwu, rws); PHASE_END
            PHASE_BEGIN(9) phase_rwkv_out(c, args, layer, proj, rwu, rws, bonusg, obuf); PHASE_END
            PHASE_BEGIN(3) phase_cmp1(c, args, layer, proj, hid); PHASE_END
            PHASE_BEGIN(4) phase_cmp2(c, args, layer, hid, kcmp, vcmp); PHASE_END
            PHASE_BEGIN(5) phase_nsa13(c, args, proj, kcmp, vcmp, nsaacc, ml); PHASE_END
            PHASE_BEGIN(6) phase_nsa_topk(c, args, proj, kcmp, ml, sel); PHASE_END
            PHASE_BEGIN(7) phase_nsa2(c, args, proj, sel, nsaacc, obuf + (size_t)T * 512); PHASE_END
            PHASE_BEGIN(8) phase_swa(c, args, layer, proj, obuf + (size_t)2 * T * 512); PHASE_END
            PHASE_BEGIN(10) {
                pg8::Gemm g{obuf, wb + WB_WBR, 512, 512, 512}; pg8::Sched S; S.init(T / 256, D / 256, c.G, c.bid, 3, (size_t)256 * 512 * 2, (size_t)T * 512 * 2, (size_t)256 * 512 * 2, (size_t)D * 512 * 2);
                pg8::EpiMerge E{gates, merged}; pg8::gemm_phase(c.lds, c.tid, g, S, E); } PHASE_END
            PHASE_BEGIN(11) {
                pg8::Gemm g{merged, wb + WB_WOUT, D, D, D}; pg8::Sched S; S.init(T / 256, D / 256, c.G, c.bid, 1, (size_t)256 * D * 2, 0, (size_t)256 * D * 2, 0);
                pg8::EpiStore E{tmpb, D}; pg8::gemm_phase(c.lds, c.tid, g, S, E); } PHASE_END
            PHASE_BEGIN(12) phase_norm_res(c, tmpb, args.in[I_NQM] + layer * D, x, xb, rs, row0, T); PHASE_END
        }
        PHASE_BEGIN(13) {
            pg8::Gemm g{xb, wb + WB_WGU, D, D, D}; pg8::Sched S; S.init(MROWS / 256, 2 * FFN / 256, c.G, c.bid, 1, (size_t)256 * D * 2, 0, (size_t)256 * D * 2, 0);
            pg8::EpiSwiGLU E{act, rs}; pg8::gemm_phase(c.lds, c.tid, g, S, E); } PHASE_END
        PHASE_BEGIN(14) {
            pg8::Gemm g{act, wb + WB_WDN, FFN, FFN, FFN}; pg8::Sched S; S.init(MROWS / 256, D / 256, c.G, c.bid, 1, (size_t)256 * FFN * 2, 0, (size_t)256 * FFN * 2, 0);
            pg8::EpiStore E{tmpf, D}; pg8::gemm_phase(c.lds, c.tid, g, S, E); } PHASE_END
        PHASE_BEGIN(15) phase_norm_res(c, tmpf, args.in[I_NQF] + layer * D, x, xb, rs, 0, MROWS); PHASE_END
    }
#undef PHASE_BEGIN
#undef PHASE_END
}

extern "C" void kernel_launch(void* const* d_in, const int* in_sizes, int n_in, void* d_out, int out_size, void* d_ws, size_t ws_size, hipStream_t stream) {
    static int grid = 0;
    if (grid == 0) {
        if (n_in != 30 || out_size != MROWS * D || ws_size < WS_END) { fprintf(stderr, "kernel_launch: unexpected shapes (n_in %d out %d ws %zu)\n", n_in, out_size, ws_size); grid = -1; return; }
        int dev = 0, cus = 0;
        if (hipGetDevice(&dev) != hipSuccess || hipDeviceGetAttribute(&cus, hipDeviceAttributeMultiprocessorCount, dev) != hipSuccess) { grid = -1; return; }
        if (hipFuncSetAttribute((const void*)fwd_kernel, hipFuncAttributeMaxDynamicSharedMemorySize, LDS_BYTES) != hipSuccess) { fprintf(stderr, "hipFuncSetAttribute failed\n"); grid = -1; return; }
        int per_cu = 0;
        if (hipOccupancyMaxActiveBlocksPerMultiprocessor(&per_cu, (const void*)fwd_kernel, 512, LDS_BYTES) != hipSuccess || per_cu < 1) { fprintf(stderr, "occupancy query: %d\n", per_cu); }
        (void)hipGetLastError();
        grid = cus;
    }
    if (grid < 0) return;
    (void)hipMemsetAsync((char*)d_ws + WS_CTL, 0, CTL_BYTES, stream);
    Args a{};
    for (int i = 0; i < 30; ++i) a.in[i] = (const float*)d_in[i];
    a.out = (float*)d_out; a.ws = (unsigned char*)d_ws;
#if MK_ONE_LAUNCH
    a.lo = 0; a.hi = PH_TOTAL;
    hipLaunchKernelGGL(fwd_kernel, dim3(grid), dim3(512), LDS_BYTES, stream, a);
#else
    for (int p = 0; p < PH_TOTAL; ++p) { a.lo = p; a.hi = p + 1; hipLaunchKernelGGL(fwd_kernel, dim3(grid), dim3(512), LDS_BYTES, stream, a); }
#endif
}
```

```cpp
#include <hip/hip_runtime.h>
#include <stdint.h>
#include <stdio.h>

#ifndef MK_ONE_LAUNCH
#define MK_ONE_LAUNCH 1
#endif

#define LAS __attribute__((address_space(3)))
typedef unsigned short bf16_t;
typedef short bf16x8 __attribute__((ext_vector_type(8)));
typedef float f32x4 __attribute__((ext_vector_type(4)));
typedef float f32x2 __attribute__((ext_vector_type(2)));
typedef unsigned u32x4 __attribute__((ext_vector_type(4)));
typedef unsigned u32x2 __attribute__((ext_vector_type(2)));

constexpr int D = 1024, NBATCH = 2, T = 16384, DEPTH = 4, MROWS = NBATCH * T;
constexpr int IN_COLS = 6936, FFN = 2816;
constexpr int PLD = 4096;
constexpr int PC_R = 0, PC_K = 512, PC_V = 1024, PC_ZW = 1536, PC_ZA = 1600, PC_ZG = 1664;
constexpr int PC_NQ = 1792, PC_KC = 2304, PC_VC = 2432, PC_KS = 2560, PC_VS = 2688, PC_KW = 2816, PC_VW = 2944, PC_GL = 3072;
constexpr int PC_SQ = 3328, PC_SK = 3840, PC_SV = 3968;
constexpr int NIN = 7168;
constexpr int NCMP = 1023;
constexpr float NORM_EPS = 1e-6f;

constexpr size_t MiB = 1u << 20;
constexpr size_t WS_CTL = 0, CTL_BYTES = 1 * MiB;
constexpr size_t WS_WB = 1 * MiB;
constexpr size_t WB_WIN = 0, WB_WBR = WB_WIN + (size_t)NIN * D, WB_WOUT = WB_WBR + (size_t)3 * D * 512, WB_WGU = WB_WOUT + (size_t)D * D,
                 WB_WDN = WB_WGU + (size_t)2 * FFN * D, WB_LORA = WB_WDN + (size_t)D * FFN, WB_END = WB_LORA + (size_t)1536 * 256;
static_assert(WB_END * 2 <= 37 * MiB, "weights");
constexpr size_t WS_XB = 38 * MiB;
constexpr size_t WS_RS = 102 * MiB;
constexpr size_t WS_KCB = 103 * MiB;
constexpr size_t WS_VCT = WS_KCB + 262144;
constexpr size_t WS_SEL = 104 * MiB;
constexpr size_t WS_ML = 106 * MiB;
constexpr size_t WS_BONUS = 107 * MiB;
constexpr size_t WS_ALORA = 108 * MiB;
constexpr size_t WS_HID = 108 * MiB;
constexpr size_t WS_VT = 116 * MiB;
constexpr size_t WS_BIG = 128 * MiB;
constexpr size_t WS_PROJ = WS_BIG;
constexpr size_t WS_GATES = WS_PROJ + 128 * MiB;
constexpr size_t WS_RWKVS = WS_GATES + 96 * MiB;
constexpr size_t WS_RWU = WS_RWKVS;
constexpr size_t WS_RWS = WS_RWKVS + 64 * MiB;
constexpr size_t WS_SCORES = WS_RWKVS;
constexpr size_t WS_MERGED = WS_RWKVS;
constexpr size_t WS_TMPB = WS_RWKVS + 32 * MiB;
constexpr size_t WS_NSAACC = WS_RWKVS + 80 * MiB;
constexpr size_t WS_O = WS_NSAACC + 32 * MiB;
constexpr size_t WS_END = WS_O + 48 * MiB;
constexpr size_t WS_ACT = WS_BIG;
constexpr size_t WS_TMPF = WS_BIG + 176 * MiB;
static_assert(WS_END <= 512 * MiB, "workspace");
static_assert(WS_TMPF + 64 * MiB <= WS_NSAACC, "ffn overlay");

constexpr int LDS_BYTES = 147456;
constexpr int LDS_MISC = 131072 + 8192;

__device__ __forceinline__ float bf2f(unsigned v) { return __uint_as_float(v << 16); }
typedef __bf16 bf16n2 __attribute__((ext_vector_type(2)));
__device__ __forceinline__ unsigned pk2(float lo, float hi) { const f32x2 f = {lo, hi}; const bf16n2 v = __builtin_convertvector(f, bf16n2); return __builtin_bit_cast(unsigned, v); }
__device__ __forceinline__ unsigned f2bf(float f) { return pk2(f, 0.f) & 0xffffu; }
__device__ __forceinline__ void unpack8(const u32x4 w, float (&f)[8]) {
    f[0] = __uint_as_float(w.x << 16); f[1] = __uint_as_float(w.x & 0xffff0000u); f[2] = __uint_as_float(w.y << 16); f[3] = __uint_as_float(w.y & 0xffff0000u);
    f[4] = __uint_as_float(w.z << 16); f[5] = __uint_as_float(w.z & 0xffff0000u); f[6] = __uint_as_float(w.w << 16); f[7] = __uint_as_float(w.w & 0xffff0000u);
}
__device__ __forceinline__ float wave_sum(float v) {
#pragma unroll
    for (int o = 32; o >= 1; o >>= 1) v += __shfl_xor(v, o);
    return v;
}
__device__ __forceinline__ float sigmoidf_(float x) { return 1.0f / (1.0f + __expf(-x)); }
__device__ __forceinline__ int t5_bucket(int n) {
    if (n < 16) return n;
    int b = 16;
    b += (n >= 21); b += (n >= 27); b += (n >= 35); b += (n >= 46); b += (n >= 59); b += (n >= 77); b += (n >= 99); b += (n >= 128);
    b += (n >= 166); b += (n >= 216); b += (n >= 280); b += (n >= 363); b += (n >= 470); b += (n >= 609); b += (n >= 790);
    return b;
}

#define XB_TMO      128
#define XB_XCNT(j)  (256  + 64 * (j))
#define XB_XSUB(j)  (1280 + 64 * (j))
#define XB_XGEN(j)  (2304 + 64 * (j))
#define XB_TOP      3328
#define XB_TOPGEN   3392
#define XCD_BAR_WORDS 3456
#define XB_SPIN_CAP (1u << 22)
__device__ __forceinline__ unsigned xb_ld(unsigned* p)              { return __hip_atomic_load(p, __ATOMIC_RELAXED, __HIP_MEMORY_SCOPE_AGENT); }
__device__ __forceinline__ unsigned xb_add(unsigned* p, unsigned v) { return __hip_atomic_fetch_add(p, v, __ATOMIC_RELAXED, __HIP_MEMORY_SCOPE_AGENT); }
__device__ __forceinline__ unsigned xb_xcc_id() { return (unsigned)__builtin_amdgcn_s_getreg((3 << 11) | 20) & 0xFu; }
#define XB_SPIN(cond, bar) do { unsigned _sp = 0; while (cond) { __builtin_amdgcn_s_sleep(1); \
    if ((++_sp & 255u) == 0u) { if (xb_ld(&(bar)[XB_TMO])) break; if (_sp > XB_SPIN_CAP) { atomicAdd(&(bar)[XB_TMO], 1u); break; } } } } while (0)
struct XcdBarrier { unsigned* bar; unsigned x; volatile LAS unsigned* st; };
__device__ __forceinline__ XcdBarrier xcd_barrier_post(unsigned* bar, volatile LAS unsigned* st) {
    XcdBarrier b; b.bar = bar; b.x = xb_xcc_id(); b.st = st;
    if (threadIdx.x == 0) (void)xb_add(&bar[XB_XCNT(b.x)], 1u);
    return b;
}
__device__ __forceinline__ void xcd_barrier_complete(unsigned* bar, unsigned x, unsigned& nloc, unsigned& nx) {
    const unsigned G = gridDim.x * gridDim.y * gridDim.z;
    unsigned sum, cnt, mine, sp = 0u;
    for (;;) {
        sum = 0u; cnt = 0u; mine = 0u;
#pragma unroll
        for (unsigned j = 0; j < 16; ++j) { const unsigned c = xb_ld(&bar[XB_XCNT(j)]); sum += c; cnt += (c > 0u) ? 1u : 0u; mine = (j == x) ? c : mine; }
        if (sum == G) break;
        __builtin_amdgcn_s_sleep(1);
        if ((++sp & 255u) == 0u) { if (xb_ld(&bar[XB_TMO])) break; if (sp > XB_SPIN_CAP) { atomicAdd(&bar[XB_TMO], 1u); break; } }
    }
    nloc = mine > 0u ? mine : 1u; nx = cnt > 0u ? cnt : 1u;
}
__device__ __forceinline__ void xcd_barrier(const XcdBarrier& b) {
    asm volatile("s_waitcnt vmcnt(0)" ::: "memory");
    __syncthreads();
    if (threadIdx.x == 0) {
        unsigned* bar = b.bar;
        __builtin_amdgcn_s_waitcnt(0);
        unsigned nloc = b.st[0], nx = b.st[1];
        if (nloc == 0u) { xcd_barrier_complete(bar, b.x, nloc, nx); b.st[0] = nloc; b.st[1] = nx; }
        const unsigned old = xb_add(&bar[XB_XSUB(b.x)], 1u);
        const unsigned gen = old / nloc;
        if (old + 1u == (gen + 1u) * nloc) {
            __builtin_amdgcn_fence(__ATOMIC_RELEASE, "agent");
            asm volatile("s_waitcnt vmcnt(0)" ::: "memory");
            const unsigned og = xb_add(&bar[XB_TOP], 1u);
            const unsigned tg = og / nx;
            if (og + 1u == (tg + 1u) * nx) xb_add(&bar[XB_TOPGEN], 1u);
            else XB_SPIN(xb_ld(&bar[XB_TOPGEN]) == tg, bar);
            __builtin_amdgcn_fence(__ATOMIC_ACQUIRE, "agent");
            xb_add(&bar[XB_XGEN(b.x)], 1u);
            asm volatile("s_waitcnt vmcnt(0)" ::: "memory");
        } else {
            XB_SPIN(xb_ld(&bar[XB_XGEN(b.x)]) == gen, bar);
            __builtin_amdgcn_fence(__ATOMIC_ACQUIRE, "agent");
            asm volatile("s_waitcnt vmcnt(0)" ::: "memory");
        }
    }
    __syncthreads();
}

namespace pg8 {
constexpr int BM = 256, BK = 64, HALF = 128, HTB = HALF * BK * 2, STAGE_BYTES = 8 * HTB, NXCD = 8, WGM = 8;
__device__ __forceinline__ int lds_byte(int r, int c) { const int st = (r >> 4) * 2 + (c >> 5), rr = r & 15, cc = c & 31, ob = rr * 64 + cc * 2; return st * 1024 + (ob ^ (((ob >> 9) & 1) << 5)); }
__device__ __forceinline__ void stage_rc(int b, int& R, int& C) { const int st = b / 1024, sb = b % 1024, swz = sb ^ (((sb >> 9) & 1) << 5); R = (st >> 1) * 16 + swz / 64; C = (st & 1) * 32 + (swz % 64) / 2; }
__device__ __forceinline__ int perm32(int rho) { const int n = rho >> 4, i = rho & 15; return 8 * (i >> 2) + 4 * n + (i & 3); }

struct Unit { int pm, pn, sub; unsigned aoff, boff; };
struct Gemm { const bf16_t* A; const bf16_t* Bt; int lda, ldb, K; };
struct Sched {
    int nM, nN, nwg, G, c, nsub; unsigned a_row, a_sub, b_row, b_sub;
    __device__ __forceinline__ void init(int nM_, int nN_, int G_, int c_, int nsub_, unsigned a_row_, unsigned a_sub_, unsigned b_row_, unsigned b_sub_) {
        nM = nM_; nN = nN_; nwg = nM * nN; G = G_; c = c_; nsub = nsub_; a_row = a_row_; a_sub = a_sub_; b_row = b_row_; b_sub = b_sub_; }
    __device__ __forceinline__ bool next(int i, Unit& u) const {
        const int round = i / nsub; u.sub = i - round * nsub;
        const long L = (long)round * G + c; if (L >= nwg) return false;
        int wgid = (int)L; { const int q = nwg / NXCD, r = nwg % NXCD, xcd = wgid % NXCD, off = wgid / NXCD; wgid = (xcd < r ? xcd * (q + 1) : r * (q + 1) + (xcd - r) * q) + off; }
        const int nig = WGM * nN, gid = wgid / nig, fm = gid * WGM, gsz = (nM - fm) < WGM ? (nM - fm) : WGM;
        u.pm = fm + ((wgid % nig) % gsz); u.pn = (wgid % nig) / gsz;
        u.aoff = (unsigned)u.pm * a_row + (unsigned)u.sub * a_sub; u.boff = (unsigned)u.pn * b_row + (unsigned)u.sub * b_sub; return true;
    }
};

template <class Epi>
__device__ __forceinline__ void gemm_phase(LAS unsigned char* lds, const int tid, const Gemm g, const Sched& S, const Epi& E) {
    const int wid = __builtin_amdgcn_readfirstlane(tid >> 6), lane = tid & 63, wr = wid >> 2, wc = wid & 3, fr = lane & 15, fq = lane >> 4;
    const int K = g.K, nt = K / BK;
    unsigned voffA[2], voffB[2];
#pragma unroll
    for (int i = 0; i < 2; ++i) { int R, C; stage_rc(tid * 16 + i * 8192, R, C); const int Rb = Epi::PERM ? ((R & ~31) + perm32(R & 31)) : R;
        voffA[i] = (unsigned)(R * g.lda + C) * 2u; voffB[i] = (unsigned)(Rb * g.ldb + C) * 2u; }
    const size_t kstep = (size_t)(BK * 2);
    const size_t hstepA = (size_t)HALF * g.lda * 2, hstepB = (size_t)HALF * g.ldb * 2;
    const unsigned ldsw = (unsigned)wid * 1024u;
    const int aoff = lds_byte(wr * 64 + fr, fq * 8), boff = lds_byte(wc * 32 + fr, fq * 8);
#define PG8_SA(b, h) (((b) * 2 + (h)) * HTB)
#define PG8_SB(b, h) ((4 + (b) * 2 + (h)) * HTB)
#define PG8_STAGE(bufoff, gbase, voff) do { _Pragma("unroll") for (int _i = 0; _i < 2; ++_i) \
        __builtin_amdgcn_global_load_lds((const unsigned*)((const char*)(gbase) + (voff)[_i]), (LAS unsigned*)(lds + (bufoff) + ldsw + _i * 8192), 16, 0, 0); } while (0)
#define PG8_LDA(dst, b, h) do { _Pragma("unroll") for (int m = 0; m < 4; ++m) _Pragma("unroll") for (int k = 0; k < 2; ++k) dst[m][k] = *(const LAS bf16x8*)(lds + PG8_SA(b, h) + aoff + m * 2048 + k * 1024); } while (0)
#define PG8_LDB(dst, b, h) do { _Pragma("unroll") for (int n = 0; n < 2; ++n) _Pragma("unroll") for (int k = 0; k < 2; ++k) dst[n][k] = *(const LAS bf16x8*)(lds + PG8_SB(b, h) + boff + n * 2048 + k * 1024); } while (0)
#define PG8_MMA(ai, bj, At, Bt) do { __builtin_amdgcn_s_setprio(1); _Pragma("unroll") for (int m = 0; m < 4; ++m) _Pragma("unroll") for (int n = 0; n < 2; ++n) _Pragma("unroll") for (int k = 0; k < 2; ++k) \
        acc[ai][bj][m][n] = __builtin_amdgcn_mfma_f32_16x16x32_bf16(Bt[n][k], At[m][k], acc[ai][bj][m][n], 0, 0, 0); __builtin_amdgcn_s_setprio(0); } while (0)
#define PG8_WAIT_V(n) asm volatile("s_waitcnt vmcnt(" #n ")" ::: "memory")
#define PG8_WAIT_L(n) asm volatile("s_waitcnt lgkmcnt(" #n ")" ::: "memory")
#define PG8_BAR __builtin_amdgcn_s_barrier()
#define PG8_SCHED __builtin_amdgcn_sched_barrier(0)
    Unit cur, nxt; int ui = 0;
    if (!S.next(0, cur)) return;
    f32x4 acc[2][2][4][2];
#pragma unroll
    for (int a = 0; a < 2; ++a)
#pragma unroll
        for (int b = 0; b < 2; ++b)
#pragma unroll
            for (int m = 0; m < 4; ++m)
#pragma unroll
                for (int n = 0; n < 2; ++n) acc[a][b][m][n] = (f32x4){0.f, 0.f, 0.f, 0.f};
    bf16x8 At[4][2], B0[2][2], B1[2][2];
    const char* cA = (const char*)g.A + cur.aoff; const char* cB = (const char*)g.Bt + cur.boff;
    PG8_STAGE(PG8_SB(0, 0), cB, voffB); PG8_STAGE(PG8_SA(0, 0), cA, voffA); PG8_STAGE(PG8_SB(0, 1), cB + hstepB, voffB); PG8_STAGE(PG8_SA(0, 1), cA + hstepA, voffA);
    if (wr == 1) PG8_BAR;
    PG8_WAIT_V(4); PG8_BAR;
    PG8_STAGE(PG8_SB(1, 0), cB + kstep, voffB); PG8_STAGE(PG8_SA(1, 0), cA + kstep, voffA); PG8_STAGE(PG8_SB(1, 1), cB + hstepB + kstep, voffB);
    PG8_WAIT_V(6); PG8_BAR;
    for (;;) {
        const bool has_next = S.next(ui + 1, nxt);
        const char* nA = has_next ? (const char*)g.A + nxt.aoff : cA; const char* nB = has_next ? (const char*)g.Bt + nxt.boff : cB;
        for (int t = 0; t < nt; t += 2) {
            const bool last = (t == nt - 2);
            const char* a1 = cA + (size_t)(t + 1) * kstep;
            const char* a2 = last ? nA : cA + (size_t)(t + 2) * kstep; const char* b2 = last ? nB : cB + (size_t)(t + 2) * kstep;
            const char* a3 = a2 + kstep; const char* b3 = b2 + kstep;
            PG8_LDB(B0, 0, 0); PG8_SCHED; PG8_LDA(At, 0, 0); PG8_STAGE(PG8_SA(1, 1), a1 + hstepA, voffA);
            PG8_WAIT_L(8); PG8_BAR; PG8_WAIT_L(0); PG8_MMA(0, 0, At, B0); PG8_BAR; PG8_SCHED;
            PG8_LDB(B1, 0, 1); PG8_STAGE(PG8_SB(0, 0), b2, voffB);
            PG8_BAR; PG8_WAIT_L(0); PG8_MMA(0, 1, At, B1); PG8_BAR;
            PG8_LDA(At, 0, 1); PG8_STAGE(PG8_SA(0, 0), a2, voffA);
            PG8_BAR; PG8_WAIT_L(0); PG8_MMA(1, 0, At, B0); PG8_BAR; PG8_SCHED;
            PG8_STAGE(PG8_SB(0, 1), b2 + hstepB, voffB);
            PG8_WAIT_V(6); PG8_BAR; PG8_MMA(1, 1, At, B1); PG8_BAR;
            PG8_LDB(B0, 1, 0); PG8_SCHED; PG8_LDA(At, 1, 0); PG8_STAGE(PG8_SA(0, 1), a2 + hstepA, voffA);
            PG8_WAIT_L(8); PG8_BAR; PG8_WAIT_L(0); PG8_MMA(0, 0, At, B0); PG8_BAR; PG8_SCHED;
            PG8_LDB(B1, 1, 1); PG8_STAGE(PG8_SB(1, 0), b3, voffB);
            PG8_BAR; PG8_WAIT_L(0); PG8_MMA(0, 1, At, B1); PG8_BAR;
            PG8_LDA(At, 1, 1); PG8_STAGE(PG8_SA(1, 0), a3, voffA);
            PG8_BAR; PG8_WAIT_L(0); PG8_MMA(1, 0, At, B0); PG8_BAR; PG8_SCHED;
            PG8_STAGE(PG8_SB(1, 1), b3 + hstepB, voffB);
            PG8_WAIT_V(6); PG8_BAR; PG8_MMA(1, 1, At, B1); PG8_BAR;
        }
        const bool keep = E(acc, cur, wr, wc, fr, fq);
        if (!has_next) break;
        if (!keep) {
#pragma unroll
            for (int a = 0; a < 2; ++a)
#pragma unroll
                for (int b = 0; b < 2; ++b)
#pragma unroll
                    for (int m = 0; m < 4; ++m)
#pragma unroll
                        for (int n = 0; n < 2; ++n) acc[a][b][m][n] = (f32x4){0.f, 0.f, 0.f, 0.f};
        }
        cur = nxt; cA = nA; cB = nB; ++ui;
    }
    PG8_WAIT_V(0);
    if (wr == 0) PG8_BAR;
    PG8_BAR;
#undef PG8_SA
#undef PG8_SB
#undef PG8_STAGE
#undef PG8_LDA
#undef PG8_LDB
#undef PG8_MMA
#undef PG8_WAIT_V
#undef PG8_WAIT_L
#undef PG8_BAR
#undef PG8_SCHED
}

struct EpiInProj {
    static constexpr bool PERM = true;
    bf16_t* proj; bf16_t* gates; const float* rs;
    __device__ __forceinline__ bool operator()(f32x4 (&acc)[2][2][4][2], const Unit& u, int wr, int wc, int fr, int fq) const {
        const int row0 = u.pm * BM + wr * 64 + fr; const bool is_gate = u.pn >= 16;
        bf16_t* base = is_gate ? gates + (u.pn - 16) * 256 : proj + u.pn * 256; const int ld = is_gate ? 3072 : PLD;
        const int col0 = wc * 32 + 8 * fq;
#pragma unroll
        for (int ai = 0; ai < 2; ++ai)
#pragma unroll
            for (int m = 0; m < 4; ++m) { const int row = row0 + ai * HALF + m * 16; const float s = rs[row]; bf16_t* rowp = base + (size_t)row * ld + col0;
#pragma unroll
                for (int bj = 0; bj < 2; ++bj) { f32x4 v0 = acc[ai][bj][m][0] * s, v1 = acc[ai][bj][m][1] * s;
                    if (is_gate) {
#pragma unroll
                        for (int j = 0; j < 4; ++j) { v0[j] = sigmoidf_(v0[j]); v1[j] = sigmoidf_(v1[j]); } }
                    u32x4 w; w.x = pk2(v0[0], v0[1]); w.y = pk2(v0[2], v0[3]); w.z = pk2(v1[0], v1[1]); w.w = pk2(v1[2], v1[3]);
                    *(u32x4*)(rowp + bj * HALF) = w; } }
        return false;
    }
};
struct EpiStore {
    static constexpr bool PERM = true;
    bf16_t* out; int ld;
    __device__ __forceinline__ bool operator()(f32x4 (&acc)[2][2][4][2], const Unit& u, int wr, int wc, int fr, int fq) const {
        const int row0 = u.pm * BM + wr * 64 + fr; const int col0 = u.pn * BM + wc * 32 + 8 * fq;
#pragma unroll
        for (int ai = 0; ai < 2; ++ai)
#pragma unroll
            for (int m = 0; m < 4; ++m) { bf16_t* rowp = out + (size_t)(row0 + ai * HALF + m * 16) * ld + col0;
#pragma unroll
                for (int bj = 0; bj < 2; ++bj) { const f32x4 v0 = acc[ai][bj][m][0], v1 = acc[ai][bj][m][1];
                    u32x4 w; w.x = pk2(v0[0], v0[1]); w.y = pk2(v0[2], v0[3]); w.z = pk2(v1[0], v1[1]); w.w = pk2(v1[2], v1[3]);
                    *(u32x4*)(rowp + bj * HALF) = w; } }
        return false;
    }
};
struct EpiLora {
    static constexpr bool PERM = true;
    bf16_t* obuf;
    __device__ __forceinline__ bool operator()(f32x4 (&acc)[2][2][4][2], const Unit& u, int wr, int wc, int fr, int fq) const {
        const int sel = u.pn >> 1; bf16_t* out = obuf + (size_t)(sel == 2 ? 0 : sel + 1) * T * 512;
        const int row0 = u.pm * BM + wr * 64 + fr; const int col0 = (u.pn & 1) * BM + wc * 32 + 8 * fq;
#pragma unroll
        for (int ai = 0; ai < 2; ++ai)
#pragma unroll
            for (int m = 0; m < 4; ++m) { bf16_t* rowp = out + (size_t)(row0 + ai * HALF + m * 16) * 512 + col0;
#pragma unroll
                for (int bj = 0; bj < 2; ++bj) { const f32x4 v0 = acc[ai][bj][m][0], v1 = acc[ai][bj][m][1];
                    u32x4 w; w.x = pk2(v0[0], v0[1]); w.y = pk2(v0[2], v0[3]); w.z = pk2(v1[0], v1[1]); w.w = pk2(v1[2], v1[3]);
                    *(u32x4*)(rowp + bj * HALF) = w; } }
        return false;
    }
};
struct EpiMerge {
    static constexpr bool PERM = true;
    const bf16_t* gates; bf16_t* merged;
    __device__ __forceinline__ bool operator()(f32x4 (&acc)[2][2][4][2], const Unit& u, int wr, int wc, int fr, int fq) const {
        const int row0 = u.pm * BM + wr * 64 + fr; const int col0 = u.pn * BM + wc * 32 + 8 * fq; const int sub = u.sub;
#pragma unroll
        for (int ai = 0; ai < 2; ++ai)
#pragma unroll
            for (int m = 0; m < 4; ++m) { const int row = row0 + ai * HALF + m * 16; const bf16_t* gp = gates + (size_t)row * 3072 + sub * 1024 + col0;
#pragma unroll
                for (int bj = 0; bj < 2; ++bj) {
                    float sc[8], sn[8]; unpack8(*(const u32x4*)(gp + bj * HALF), sc);
                    if (sub < 2) { unpack8(*(const u32x4*)(gp + 1024 + bj * HALF), sn);
#pragma unroll
                        for (int j = 0; j < 8; ++j) sc[j] = sc[j] / fmaxf(sn[j], 1e-30f); }
                    f32x4 v0 = acc[ai][bj][m][0], v1 = acc[ai][bj][m][1];
#pragma unroll
                    for (int j = 0; j < 4; ++j) { v0[j] *= sc[j]; v1[j] *= sc[4 + j]; }
                    acc[ai][bj][m][0] = v0; acc[ai][bj][m][1] = v1;
                    if (sub == 2) { u32x4 w; w.x = pk2(v0[0], v0[1]); w.y = pk2(v0[2], v0[3]); w.z = pk2(v1[0], v1[1]); w.w = pk2(v1[2], v1[3]);
                        *(u32x4*)(merged + (size_t)row * D + col0 + bj * HALF) = w; } } }
        return sub != 2;
    }
};
struct EpiSwiGLU {
    static constexpr bool PERM = true;
    bf16_t* act; const float* rs;
    __device__ __forceinline__ bool operator()(f32x4 (&acc)[2][2][4][2], const Unit& u, int wr, int wc, int fr, int fq) const {
        const int row0 = u.pm * BM + wr * 64 + fr; const int col0 = u.pn * HALF + wc * 32 + 8 * fq;
#pragma unroll
        for (int ai = 0; ai < 2; ++ai)
#pragma unroll
            for (int m = 0; m < 4; ++m) { const int row = row0 + ai * HALF + m * 16; const float s = rs[row];
                float o[8];
#pragma unroll
                for (int n = 0; n < 2; ++n)
#pragma unroll
                    for (int j = 0; j < 4; ++j) { const float gg = acc[ai][0][m][n][j] * s, uu = acc[ai][1][m][n][j] * s; o[n * 4 + j] = gg * sigmoidf_(gg) * uu; }
                u32x4 w; w.x = pk2(o[0], o[1]); w.y = pk2(o[2], o[3]); w.z = pk2(o[4], o[5]); w.w = pk2(o[6], o[7]);
                *(u32x4*)(act + (size_t)row * FFN + col0) = w; }
        return false;
    }
};
}

struct Args { const float* in[30]; float* out; unsigned char* ws; int lo, hi; };
enum { I_X = 0, I_NPM, I_NQM, I_NPF, I_NQF, I_WIN, I_MU, I_W0, I_W2, I_A0, I_A2, I_G2, I_KK, I_KA, I_RK, I_LNW, I_LNB, I_PEK, I_PEV, I_CKW1, I_CKW2, I_CVW1, I_CVW2, I_SINK, I_REL, I_WBR, I_WOUT, I_FG, I_FU, I_FD };

struct Ctx { LAS unsigned char* lds; int tid, lane, wave, G, bid; };
__device__ __forceinline__ const float* inptr(const Ctx& c, int i) {
    const volatile LAS unsigned* t = (const volatile LAS unsigned*)(c.lds + LDS_MISC + 64) + 2 * i;
    const unsigned lo = __builtin_amdgcn_readfirstlane(t[0]), hi = __builtin_amdgcn_readfirstlane(t[1]);
    return (const float*)(((unsigned long long)hi << 32) | lo);
}

__device__ __forceinline__ void phase_init(const Ctx& c, const float* x, float* xo, bf16_t* xb, float* rs) {
    const int gw = c.bid * 8 + c.wave, NGW = c.G * 8;
    for (int row = gw; row < MROWS; row += NGW) {
        const float* xr = x + (size_t)row * D; float ss = 0.f;
#pragma unroll
        for (int j = 0; j < 2; ++j) { const int e = c.lane * 8 + 512 * j; const f32x4 a = *(const f32x4*)(xr + e), b = *(const f32x4*)(xr + e + 4);
            ss += a[0] * a[0] + a[1] * a[1] + a[2] * a[2] + a[3] * a[3] + b[0] * b[0] + b[1] * b[1] + b[2] * b[2] + b[3] * b[3];
            *(f32x4*)(xo + (size_t)row * D + e) = a; *(f32x4*)(xo + (size_t)row * D + e + 4) = b;
            u32x4 w; w.x = pk2(a[0], a[1]); w.y = pk2(a[2], a[3]); w.z = pk2(b[0], b[1]); w.w = pk2(b[2], b[3]); *(u32x4*)(xb + (size_t)row * D + e) = w; }
        ss = wave_sum(ss);
        if (c.lane == 0) rs[row] = rsqrtf(ss * (1.0f / D) + NORM_EPS);
    }
}
__device__ __forceinline__ void phase_norm_res(const Ctx& c, const bf16_t* y, const float* gain, float* x, bf16_t* xb, float* rs, int row0, int nrows) {
    const int gw = c.bid * 8 + c.wave, NGW = c.G * 8;
    for (int r = gw; r < nrows; r += NGW) {
        const int row = row0 + r; float yv[16]; float ss = 0.f;
#pragma unroll
        for (int j = 0; j < 2; ++j) { float f[8]; unpack8(*(const u32x4*)(y + (size_t)r * D + c.lane * 8 + 512 * j), f);
#pragma unroll
            for (int k = 0; k < 8; ++k) { yv[j * 8 + k] = f[k]; ss += f[k] * f[k]; } }
        ss = wave_sum(ss); const float sc = rsqrtf(ss * (1.0f / D) + NORM_EPS); float s2 = 0.f;
#pragma unroll
        for (int j = 0; j < 2; ++j) { const int e = c.lane * 8 + 512 * j; float* xr = x + (size_t)row * D + e;
            f32x4 a = *(const f32x4*)xr, b = *(const f32x4*)(xr + 4); const f32x4 ga = *(const f32x4*)(gain + e), gb = *(const f32x4*)(gain + e + 4);
#pragma unroll
            for (int k = 0; k < 4; ++k) { a[k] += yv[j * 8 + k] * sc * ga[k]; b[k] += yv[j * 8 + 4 + k] * sc * gb[k]; s2 += a[k] * a[k] + b[k] * b[k]; }
            *(f32x4*)xr = a; *(f32x4*)(xr + 4) = b;
            u32x4 w; w.x = pk2(a[0], a[1]); w.y = pk2(a[2], a[3]); w.z = pk2(b[0], b[1]); w.w = pk2(b[2], b[3]); *(u32x4*)(xb + (size_t)row * D + e) = w; }
        s2 = wave_sum(s2);
        if (c.lane == 0) rs[row] = rsqrtf(s2 * (1.0f / D) + NORM_EPS);
    }
}

__device__ __forceinline__ float cvt_fetch(const Ctx& c, int layer, int kind, int sub, int k, int n) {
    switch (kind) {
    case 0: { int src; float sc = inptr(c, I_NPM)[layer * D + k];
        if (n < 3096) src = n; else if (n < 3328) return 0.f; else if (n < 4096) src = 3096 + (n - 3328); else src = 3864 + (n - 4096);
        if ((n >= PC_NQ && n < PC_NQ + 512) || (n >= PC_SQ && n < PC_SQ + 512)) sc *= 0.125f;
        return inptr(c, I_WIN)[((size_t)layer * D + k) * IN_COLS + src] * sc; }
    case 1: return inptr(c, I_WBR)[(((size_t)layer * 3 + sub) * 512 + k) * D + n];
    case 2: return inptr(c, I_WOUT)[((size_t)layer * D + k) * D + n];
    case 3: { const int pn = n >> 8, r = n & 255; const float sc = inptr(c, I_NPF)[layer * D + k];
        return (r < 128 ? inptr(c, I_FG)[((size_t)layer * D + k) * FFN + pn * 128 + r] : inptr(c, I_FU)[((size_t)layer * D + k) * FFN + pn * 128 + r - 128]) * sc; }
    case 4: return inptr(c, I_FD)[((size_t)layer * FFN + k) * D + n];
    default: {
        if (n < 512) return k < 64 ? inptr(c, I_W2)[((size_t)layer * 64 + k) * 512 + n] : 0.f;
        if (n < 1024) return (k >= 64 && k < 128) ? inptr(c, I_A2)[((size_t)layer * 64 + k - 64) * 512 + n - 512] : 0.f;
        return k >= 128 ? inptr(c, I_G2)[((size_t)layer * 128 + k - 128) * 512 + n - 1024] : 0.f; }
    }
}
__device__ __forceinline__ void phase_cvt(const Ctx& c, const Args& a, int layer, bf16_t* wb) {
    LAS float* tile = (LAS float*)c.lds;
    constexpr int I0 = 16 * 112, I1 = 3 * 8 * 16, I2 = 16 * 16, I3 = 16 * 88, I4 = 44 * 16, I5 = 4 * 24, NIT = I0 + I1 + I2 + I3 + I4 + I5;
    for (int it = c.bid; it < NIT; it += c.G) {
        int r = it, kind, sub = 0, K, nblk; bf16_t* dst;
        if (r < I0) { kind = 0; K = D; nblk = 112; dst = wb + WB_WIN; }
        else if ((r -= I0) < I1) { kind = 1; sub = r / 128; r -= sub * 128; K = 512; nblk = 16; dst = wb + WB_WBR + (size_t)sub * D * 512; }
        else if ((r -= I1) < I2) { kind = 2; K = D; nblk = 16; dst = wb + WB_WOUT; }
        else if ((r -= I2) < I3) { kind = 3; K = D; nblk = 88; dst = wb + WB_WGU; }
        else if ((r -= I3) < I4) { kind = 4; K = FFN; nblk = 16; dst = wb + WB_WDN; }
        else { r -= I4; kind = 5; K = 256; nblk = 24; dst = wb + WB_LORA; }
        const int kb = r / nblk, nb = r % nblk, k0 = kb * 64, n0 = nb * 64;
        for (int e = c.tid; e < 4096; e += 512) { const int kk = e >> 6, nn = e & 63; tile[kk * 65 + nn] = cvt_fetch(c, layer, kind, sub, k0 + kk, n0 + nn); }
        __syncthreads();
        for (int e = c.tid; e < 2048; e += 512) { const int nn = e >> 5, kp = (e & 31) * 2;
            *(unsigned*)(dst + (size_t)(n0 + nn) * K + k0 + kp) = pk2(tile[kp * 65 + nn], tile[(kp + 1) * 65 + nn]); }
        __syncthreads();
    }
}

struct RowState { float q[64]; float o[64]; float m, l; };
__device__ __forceinline__ void row_init(RowState& s, const bf16_t* qp) {
#pragma unroll
    for (int i = 0; i < 8; ++i) { float f[8]; unpack8(*(const u32x4*)(qp + i * 8), f);
#pragma unroll
        for (int k = 0; k < 8; ++k) s.q[i * 8 + k] = f[k]; }
}
__device__ __forceinline__ void row_reset(RowState& s) {
#pragma unroll
    for (int i = 0; i < 64; ++i) s.o[i] = 0.f;
    s.m = -1e30f; s.l = 0.f;
}
__device__ __forceinline__ void row_key_bf16(RowState& s, const bf16_t* kp, const bf16_t* vp, float bias) {
    float sc = bias;
#pragma unroll
    for (int i = 0; i < 8; ++i) { float f[8]; unpack8(*(const u32x4*)(kp + i * 8), f);
#pragma unroll
        for (int k = 0; k < 8; ++k) sc += s.q[i * 8 + k] * f[k];
        if ((i & 1) == 1) __builtin_amdgcn_sched_barrier(0); }
    const float mn = fmaxf(s.m, sc), corr = __expf(s.m - mn), p = __expf(sc - mn);
    s.l = s.l * corr + p; s.m = mn;
#pragma unroll
    for (int i = 0; i < 8; ++i) { float f[8]; unpack8(*(const u32x4*)(vp + i * 8), f);
#pragma unroll
        for (int k = 0; k < 8; ++k) s.o[i * 8 + k] = s.o[i * 8 + k] * corr + p * f[k];
        if ((i & 1) == 1) __builtin_amdgcn_sched_barrier(0); }
}
__device__ __forceinline__ void row_key_f32(RowState& s, const float* kp, const float* vp, float bias) {
    float sc = bias;
#pragma unroll
    for (int i = 0; i < 16; ++i) { const f32x4 f = *(const f32x4*)(kp + i * 4); sc += s.q[i * 4] * f[0] + s.q[i * 4 + 1] * f[1] + s.q[i * 4 + 2] * f[2] + s.q[i * 4 + 3] * f[3];
        if ((i & 3) == 3) __builtin_amdgcn_sched_barrier(0); }
    const float mn = fmaxf(s.m, sc), corr = __expf(s.m - mn), p = __expf(sc - mn);
    s.l = s.l * corr + p; s.m = mn;
#pragma unroll
    for (int i = 0; i < 16; ++i) { const f32x4 f = *(const f32x4*)(vp + i * 4);
#pragma unroll
        for (int k = 0; k < 4; ++k) s.o[i * 4 + k] = s.o[i * 4 + k] * corr + p * f[k];
        if ((i & 3) == 3) __builtin_amdgcn_sched_barrier(0); }
}

__device__ __forceinline__ float gelu_tanh(float x) { const float t = tanhf(0.7978845608028654f * (x + 0.044715f * x * x * x)); return 0.5f * x * (1.0f + t); }
__device__ __forceinline__ void phase_cmp1(const Ctx& c, const Args& a, int layer, const bf16_t* proj, float* hid) {
    for (int unit = c.bid; unit < 2048; unit += c.G) {
        const int kv = unit >> 10, g = (unit >> 9) & 1, cp = unit & 511; const int cc = cp * 2 + (c.tid >> 8), u = c.tid & 255;
        if (cc >= NCMP) continue;
        const float* w1 = a.in[kv ? I_CVW1 : I_CKW1] + (size_t)layer * 2048 * 256; const float* pe = a.in[kv ? I_PEV : I_PEK] + (size_t)layer * 32 * 64;
        const bf16_t* xp = proj + (size_t)(16 * cc) * PLD + (kv ? PC_VC : PC_KC) + g * 64;
        float acc = 0.f;
        for (int l = 0; l < 32; ++l) {
#pragma unroll
            for (int i = 0; i < 8; ++i) { float f[8]; unpack8(*(const u32x4*)(xp + (size_t)l * PLD + i * 8), f);
#pragma unroll
                for (int k = 0; k < 8; ++k) acc += (f[k] + pe[l * 64 + i * 8 + k]) * w1[(size_t)(l * 64 + i * 8 + k) * 256 + u]; }
        }
        hid[(((size_t)kv * 2 + g) * 1024 + cc) * 256 + u] = gelu_tanh(acc);
    }
}
__device__ __forceinline__ void phase_cmp2(const Ctx& c, const Args& a, int layer, const float* hid, bf16_t* kcb, bf16_t* vctb) {
    for (int unit = c.bid; unit < 512; unit += c.G) {
        const int kv = unit >> 8, g = (unit >> 7) & 1, cc = (unit & 127) * 8 + (c.tid >> 6), d = c.tid & 63;
        float acc = 0.f;
        if (cc < NCMP) { const float* w2 = a.in[kv ? I_CVW2 : I_CKW2] + (size_t)layer * 256 * 64; const float* hp = hid + (((size_t)kv * 2 + g) * 1024 + cc) * 256;
            for (int u = 0; u < 256; ++u) acc += hp[u] * w2[u * 64 + d]; }
        if (kv) vctb[((size_t)g * 64 + d) * 1024 + cc] = (bf16_t)f2bf(acc); else kcb[((size_t)g * 1024 + cc) * 64 + d] = (bf16_t)f2bf(acc);
    }
}
__device__ __forceinline__ void phase_nsa13(const Ctx& c, const Args& a, const bf16_t* proj, const float* kcmp, const float* vcmp, float* nsaacc, float* ml) {
    LAS float* tb = (LAS float*)c.lds;
    for (int e = c.tid; e < 512; e += 512) tb[e] = inptr(c, I_REL)[e];
    __syncthreads();
    for (int unit = c.bid; unit < T / 64; unit += c.G) {
        const int hh = c.tid >> 6, t = unit * 64 + (c.tid & 63), g = hh >> 2;
        RowState s; row_init(s, proj + (size_t)t * PLD + PC_NQ + hh * 64);
        const bf16_t* glp = proj + (size_t)t * PLD + PC_GL;
        const float g0 = sigmoidf_(bf2f(glp[hh])), g2 = sigmoidf_(bf2f(glp[16 + hh]));
        row_reset(s);
        const int nv = t >= 31 ? (t - 31) / 16 + 1 : 0;
        for (int cc = 0; cc < nv; ++cc) { const float bias = tb[t5_bucket(t - 16 * cc - 31) * 16 + hh];
            row_key_f32(s, kcmp + ((size_t)g * 1024 + cc) * 64, vcmp + ((size_t)g * 1024 + cc) * 64, bias); }
        ml[((size_t)t * 8 + hh) * 2] = s.m; ml[((size_t)t * 8 + hh) * 2 + 1] = s.l;
        float* op = nsaacc + (size_t)t * 512 + hh * 64;
        { const float inv = s.l > 0.f ? g0 / s.l : 0.f;
#pragma unroll
            for (int i = 0; i < 16; ++i) { f32x4 w; w[0] = s.o[i * 4] * inv; w[1] = s.o[i * 4 + 1] * inv; w[2] = s.o[i * 4 + 2] * inv; w[3] = s.o[i * 4 + 3] * inv; *(f32x4*)(op + i * 4) = w; } }
        row_reset(s);
        const int s0 = t - 511 > 0 ? t - 511 : 0;
        for (int sp = s0; sp <= t; ++sp) { const float bias = tb[t5_bucket(t - sp) * 16 + hh];
            row_key_bf16(s, proj + (size_t)sp * PLD + PC_KW + g * 64, proj + (size_t)sp * PLD + PC_VW + g * 64, bias); }
        { const float inv = s.l > 0.f ? g2 / s.l : 0.f;
#pragma unroll
            for (int i = 0; i < 16; ++i) { f32x4 w = *(const f32x4*)(op + i * 4); w[0] += s.o[i * 4] * inv; w[1] += s.o[i * 4 + 1] * inv; w[2] += s.o[i * 4 + 2] * inv; w[3] += s.o[i * 4 + 3] * inv; *(f32x4*)(op + i * 4) = w; } }
    }
}
__device__ __forceinline__ void phase_nsa_topk(const Ctx& c, const Args& a, const bf16_t* proj, const float* kcmp, const float* ml, int* sel) {
    LAS float* tb = (LAS float*)c.lds;
    LAS float* qs = (LAS float*)(c.lds + 4096) + c.wave * 256;
    LAS float* sv = (LAS float*)(c.lds + 16384) + c.wave * 256;
    for (int e = c.tid; e < 512; e += 512) tb[e] = inptr(c, I_REL)[e];
    __syncthreads();
    const int gw = c.bid * 8 + c.wave, NGW = c.G * 8;
    for (int item = gw; item < T * 2; item += NGW) {
        const int t = item >> 1, g = item & 1, cur = t >> 6;
        { const bf16_t* qp = proj + (size_t)t * PLD + PC_NQ + g * 256 + c.lane * 4; const u32x2 w = *(const u32x2*)qp;
          qs[c.lane * 4] = __uint_as_float(w.x << 16); qs[c.lane * 4 + 1] = __uint_as_float(w.x & 0xffff0000u); qs[c.lane * 4 + 2] = __uint_as_float(w.y << 16); qs[c.lane * 4 + 3] = __uint_as_float(w.y & 0xffff0000u); }
        float mr[4], il[4];
#pragma unroll
        for (int r = 0; r < 4; ++r) { mr[r] = ml[((size_t)t * 8 + g * 4 + r) * 2]; const float l = ml[((size_t)t * 8 + g * 4 + r) * 2 + 1]; il[r] = l > 0.f ? 1.0f / l : 0.f; }
        const int nv = t >= 31 ? (t - 31) / 16 + 1 : 0;
        asm volatile("s_waitcnt lgkmcnt(0)" ::: "memory");
#pragma unroll 1
        for (int jj = 0; jj < 4; ++jj) {
            const int j = c.lane + 64 * jj; float sc;
            if (j == 0 || j == cur || j == cur - 1) sc = 1e4f;
            else if (j > cur) sc = -1.0f;
            else { sc = 0.f;
#pragma unroll 1
                for (int o = 0; o < 5; ++o) { const int cc = 4 * j + o - 1; if (cc < 0 || cc >= nv) continue;
                    const float* kp = kcmp + ((size_t)g * 1024 + cc) * 64; float d0 = 0.f, d1 = 0.f, d2 = 0.f, d3 = 0.f;
#pragma unroll 4
                    for (int i = 0; i < 16; ++i) { const f32x4 f = *(const f32x4*)(kp + i * 4);
#pragma unroll
                        for (int k = 0; k < 4; ++k) { d0 += qs[i * 4 + k] * f[k]; d1 += qs[64 + i * 4 + k] * f[k]; d2 += qs[128 + i * 4 + k] * f[k]; d3 += qs[192 + i * 4 + k] * f[k]; } }
                    const int bk = t5_bucket(t - 16 * cc - 31) * 16 + g * 4;
                    const float imp = __expf(d0 + tb[bk] - mr[0]) * il[0] + __expf(d1 + tb[bk + 1] - mr[1]) * il[1] + __expf(d2 + tb[bk + 2] - mr[2]) * il[2] + __expf(d3 + tb[bk + 3] - mr[3]) * il[3];
                    sc += ((o == 0 || o == 4) ? 1.0f : 2.0f) * imp; }
            }
            sv[j] = sc;
        }
        asm volatile("s_waitcnt lgkmcnt(0)" ::: "memory");
        float val[4];
#pragma unroll
        for (int jj = 0; jj < 4; ++jj) val[jj] = sv[c.lane + 64 * jj];
        for (int k = 0; k < 16; ++k) {
            float bv = val[0]; int bi = c.lane;
#pragma unroll
            for (int jj = 1; jj < 4; ++jj) if (val[jj] > bv) { bv = val[jj]; bi = c.lane + 64 * jj; }
#pragma unroll
            for (int o = 32; o >= 1; o >>= 1) { const float ov = __shfl_xor(bv, o); const int oi = __shfl_xor(bi, o); if (ov > bv || (ov == bv && oi < bi)) { bv = ov; bi = oi; } }
#pragma unroll
            for (int jj = 0; jj < 4; ++jj) if (bi == c.lane + 64 * jj) val[jj] = -3e38f;
            if (c.lane == 0) sel[(size_t)item * 16 + k] = bi;
        }
    }
}
__device__ __forceinline__ void phase_nsa2(const Ctx& c, const Args& a, const bf16_t* proj, const int* sel, const float* nsaacc, bf16_t* onsa) {
    LAS float* tb = (LAS float*)c.lds;
    for (int e = c.tid; e < 512; e += 512) tb[e] = inptr(c, I_REL)[e];
    __syncthreads();
    for (int unit = c.bid; unit < T / 64; unit += c.G) {
        const int hh = c.tid >> 6, t = unit * 64 + (c.tid & 63), g = hh >> 2;
        RowState s; row_init(s, proj + (size_t)t * PLD + PC_NQ + hh * 64); row_reset(s);
        const float g1 = sigmoidf_(bf2f(proj[(size_t)t * PLD + PC_GL + 8 + hh]));
        for (int k = 0; k < 16; ++k) { const int j = sel[((size_t)t * 2 + g) * 16 + k];
            for (int p = 0; p < 64; ++p) { const int pos = j * 64 + p; if (pos > t) break;
                const float bias = tb[t5_bucket(t - pos) * 16 + hh];
                row_key_bf16(s, proj + (size_t)pos * PLD + PC_KS + g * 64, proj + (size_t)pos * PLD + PC_VS + g * 64, bias); } }
        const float inv = s.l > 0.f ? g1 / s.l : 0.f; const float* ap = nsaacc + (size_t)t * 512 + hh * 64; bf16_t* op = onsa + (size_t)t * 512 + hh * 64;
#pragma unroll
        for (int i = 0; i < 8; ++i) { const f32x4 x0 = *(const f32x4*)(ap + i * 8), x1 = *(const f32x4*)(ap + i * 8 + 4); u32x4 w;
            w.x = pk2(x0[0] + s.o[i * 8] * inv, x0[1] + s.o[i * 8 + 1] * inv); w.y = pk2(x0[2] + s.o[i * 8 + 2] * inv, x0[3] + s.o[i * 8 + 3] * inv);
            w.z = pk2(x1[0] + s.o[i * 8 + 4] * inv, x1[1] + s.o[i * 8 + 5] * inv); w.w = pk2(x1[2] + s.o[i * 8 + 6] * inv, x1[3] + s.o[i * 8 + 7] * inv);
            *(u32x4*)(op + i * 8) = w; }
    }
}
__device__ __forceinline__ void phase_swa(const Ctx& c, const Args& a, int layer, const bf16_t* proj, bf16_t* oswa) {
    LAS float* tb = (LAS float*)c.lds;
    for (int e = c.tid; e < 512; e += 512) tb[e] = inptr(c, I_REL)[e];
    __syncthreads();
    for (int unit = c.bid; unit < T / 64; unit += c.G) {
        const int hh = c.tid >> 6, t = unit * 64 + (c.tid & 63), g = hh >> 2;
        RowState s; row_init(s, proj + (size_t)t * PLD + PC_SQ + hh * 64); row_reset(s);
        const int s0 = t - 127 > 0 ? t - 127 : 0;
        for (int sp = s0; sp <= t; ++sp) { const float bias = tb[t5_bucket(t - sp) * 16 + 8 + hh];
            row_key_bf16(s, proj + (size_t)sp * PLD + PC_SK + g * 64, proj + (size_t)sp * PLD + PC_SV + g * 64, bias); }
        const float sink = inptr(c, I_SINK)[layer * 8 + hh]; const float mf = fmaxf(s.m, sink); const float corr = __expf(s.m - mf);
        const float den = s.l * corr + __expf(sink - mf); const float inv = corr / den;
        bf16_t* op = oswa + (size_t)t * 512 + hh * 64;
#pragma unroll
        for (int i = 0; i < 8; ++i) { u32x4 w; w.x = pk2(s.o[i * 8] * inv, s.o[i * 8 + 1] * inv); w.y = pk2(s.o[i * 8 + 2] * inv, s.o[i * 8 + 3] * inv);
            w.z = pk2(s.o[i * 8 + 4] * inv, s.o[i * 8 + 5] * inv); w.w = pk2(s.o[i * 8 + 6] * inv, s.o[i * 8 + 7] * inv); *(u32x4*)(op + i * 8) = w; }
    }
}

constexpr int RL = 65;
__device__ __forceinline__ float rwkv_mixed(const bf16_t* proj, const float* mu, int t, int col) {
    const float cur = bf2f(proj[(size_t)t * PLD + col]); const float prev = t > 0 ? bf2f(proj[(size_t)(t - 1) * PLD + col]) : 0.f;
    return cur + (prev - cur) * mu[col];
}
__device__ __forceinline__ void lora64(const Ctx& c, const LAS float* in, const float* W, const float* bias, LAS float* out, bool accum) {
    const int j = c.tid & 63, tg = (c.tid >> 6) * 8;
    float acc[8];
#pragma unroll
    for (int i = 0; i < 8; ++i) acc[i] = accum ? out[(tg + i) * RL + j] : (bias ? bias[j] : 0.f);
#pragma unroll 4
    for (int m = 0; m < 64; ++m) { const float w = W[(size_t)m * 512 + j];
#pragma unroll
        for (int i = 0; i < 8; ++i) acc[i] += in[(tg + i) * RL + m] * w; }
#pragma unroll
    for (int i = 0; i < 8; ++i) out[(tg + i) * RL + j] = acc[i];
}
struct RwkvLds { LAS float *R, *K, *V, *A, *B, *W, *G, *TMP; };
__device__ __forceinline__ RwkvLds rwkv_lds(LAS unsigned char* lds) {
    RwkvLds s; LAS float* p = (LAS float*)lds; constexpr int SZ = 64 * RL;
    s.R = p; s.K = p + SZ; s.V = p + 2 * SZ; s.A = p + 3 * SZ; s.B = p + 4 * SZ; s.W = p + 5 * SZ; s.G = p + 6 * SZ; s.TMP = p + 7 * SZ; return s;
}
template <bool LOGDECAY>
__device__ __forceinline__ void rwkv_prep(const Ctx& c, const Args& a, int layer, const bf16_t* proj, int t0, int h, const RwkvLds& s) {
    const float* mu = inptr(c, I_MU) + (size_t)layer * 1792;
    const int j = c.tid & 63, tg = c.tid >> 6;
#pragma unroll 2
    for (int i = 0; i < 8; ++i) { const int tt = tg * 8 + i; s.TMP[tt * RL + j] = tanhf(rwkv_mixed(proj, mu, t0 + tt, PC_ZW + j)); }
    __syncthreads();
    lora64(c, s.TMP, inptr(c, I_W2) + (size_t)layer * 64 * 512 + h * 64, inptr(c, I_W0) + layer * 512 + h * 64, s.W, false);
    __syncthreads();
#pragma unroll 2
    for (int i = 0; i < 8; ++i) { const int tt = tg * 8 + i; s.TMP[tt * RL + j] = rwkv_mixed(proj, mu, t0 + tt, PC_ZA + j); }
    __syncthreads();
    lora64(c, s.TMP, inptr(c, I_A2) + (size_t)layer * 64 * 512 + h * 64, inptr(c, I_A0) + layer * 512 + h * 64, s.B, false);
    __syncthreads();
#pragma unroll 2
    for (int i = 0; i < 8; ++i) { const int tt = tg * 8 + i; s.TMP[tt * RL + j] = sigmoidf_(rwkv_mixed(proj, mu, t0 + tt, PC_ZG + j)); }
    __syncthreads();
    lora64(c, s.TMP, inptr(c, I_G2) + (size_t)layer * 128 * 512 + h * 64, nullptr, s.G, false);
    __syncthreads();
#pragma unroll 2
    for (int i = 0; i < 8; ++i) { const int tt = tg * 8 + i; s.TMP[tt * RL + j] = sigmoidf_(rwkv_mixed(proj, mu, t0 + tt, PC_ZG + 64 + j)); }
    __syncthreads();
    lora64(c, s.TMP, inptr(c, I_G2) + ((size_t)layer * 128 + 64) * 512 + h * 64, nullptr, s.G, true);
    const float kkw = inptr(c, I_KK)[layer * 512 + h * 64 + j], kaw = inptr(c, I_KA)[layer * 512 + h * 64 + j];
#pragma unroll 1
    for (int i = 0; i < 8; ++i) { const int tt = tg * 8 + i, t = t0 + tt;
        const float r = rwkv_mixed(proj, mu, t, PC_R + h * 64 + j), k = rwkv_mixed(proj, mu, t, PC_K + h * 64 + j), v = rwkv_mixed(proj, mu, t, PC_V + h * 64 + j);
        const float wl = s.W[tt * RL + j], al = sigmoidf_(s.B[tt * RL + j]);
        const float sp = (-wl > 20.f) ? -wl : log1pf(__expf(-wl)); const float w = -sp - 0.5f; const float ew = __expf(w);
        float kk = k * kkw; const float n2 = wave_sum(kk * kk); kk = kk / fmaxf(sqrtf(n2), 1e-12f);
        s.R[tt * RL + j] = r; s.V[tt * RL + j] = v; s.K[tt * RL + j] = k * (1.0f + (al - 1.0f) * kaw);
        s.A[tt * RL + j] = -kk; s.B[tt * RL + j] = kk * al; s.W[tt * RL + j] = LOGDECAY ? -ew : __expf(-ew); }
    __syncthreads();
}
__device__ __forceinline__ void rwkv_post(const Ctx& c, const Args& a, int layer, int t0, int h, const RwkvLds& s, const LAS float* Y, bf16_t* orwkv) {
    const int i = c.lane, tg = c.wave;
    const float lnw = inptr(c, I_LNW)[layer * 512 + h * 64 + i], lnb = inptr(c, I_LNB)[layer * 512 + h * 64 + i], rk = inptr(c, I_RK)[layer * 512 + h * 64 + i];
#pragma unroll 1
    for (int q = 0; q < 8; ++q) { const int tt = tg * 8 + q; const float y = Y[tt * RL + i];
        const float mean = wave_sum(y) * (1.0f / 64.0f); const float d = y - mean; const float var = wave_sum(d * d) * (1.0f / 64.0f);
        const float bonus = wave_sum(s.R[tt * RL + i] * s.K[tt * RL + i] * rk);
        const float o = (d * rsqrtf(var + 64e-5f) * lnw + lnb + bonus * s.V[tt * RL + i]) * s.G[tt * RL + i];
        orwkv[(size_t)(t0 + tt) * 512 + h * 64 + i] = (bf16_t)f2bf(o); }
}
__device__ __forceinline__ void phase_rwkv_naive(const Ctx& c, const Args& a, int layer, const bf16_t* proj, bf16_t* orwkv) {
    if (c.bid >= 8) return;
    const int h = c.bid; const RwkvLds s = rwkv_lds(c.lds);
    float S[64];
#pragma unroll
    for (int j = 0; j < 64; ++j) S[j] = 0.f;
    for (int ch = 0; ch < T / 64; ++ch) {
        rwkv_prep<false>(c, a, layer, proj, ch * 64, h, s);
        if (c.wave == 0) {
            const int i = c.lane;
            for (int tt = 0; tt < 64; ++tt) {
                float sa = 0.f;
#pragma unroll
                for (int j = 0; j < 64; ++j) { sa += S[j] * s.A[tt * RL + j]; if ((j & 7) == 7) __builtin_amdgcn_sched_barrier(0); }
                const float vi = s.V[tt * RL + i]; float y = 0.f;
#pragma unroll
                for (int j = 0; j < 64; ++j) { S[j] = S[j] * s.W[tt * RL + j] + sa * s.B[tt * RL + j] + vi * s.K[tt * RL + j]; y += S[j] * s.R[tt * RL + j]; if ((j & 3) == 3) __builtin_amdgcn_sched_barrier(0); }
                s.TMP[tt * RL + i] = y;
            }
        }
        __syncthreads();
        rwkv_post(c, a, layer, ch * 64, h, s, s.TMP, orwkv);
        __syncthreads();
    }
}


__device__ __forceinline__ int kperm32(int jl) { return 8 * ((jl >> 2) & 3) + 4 * (jl >> 4) + (jl & 3); }
__device__ __forceinline__ f32x4 tile_mma64(const LAS unsigned char* A, const LAS unsigned char* B, int a, int b, int lane, f32x4 acc) {
    const int m = lane & 15, q = lane >> 4;
#pragma unroll
    for (int ks = 0; ks < 2; ++ks) {
        const bf16x8 af = *(const LAS bf16x8*)(A + (16 * a + m) * 144 + (32 * ks + 8 * q) * 2);
        const bf16x8 bf = *(const LAS bf16x8*)(B + (16 * b + m) * 144 + (32 * ks + 8 * q) * 2);
        acc = __builtin_amdgcn_mfma_f32_16x16x32_bf16(af, bf, acc, 0, 0, 0);
    }
    return acc;
}
__device__ __forceinline__ void lds_st_bf16(LAS unsigned char* base, int idx, float v) { *(LAS bf16_t*)(base + idx * 2) = (bf16_t)f2bf(v); }

__device__ __forceinline__ void phase_lora_a(const Ctx& c, const Args& a, int layer, const bf16_t* proj, bf16_t* alora) {
    const float* mu = inptr(c, I_MU) + (size_t)layer * 1792;
    const int sub = c.tid & 31, rloc = c.tid >> 5;
    for (int t = c.bid * 16 + rloc; t < T; t += c.G * 16) {
        const int col = PC_ZW + sub * 8; float cur[8], prv[8];
        unpack8(*(const u32x4*)(proj + (size_t)t * PLD + col), cur);
        if (t > 0) unpack8(*(const u32x4*)(proj + (size_t)(t - 1) * PLD + col), prv); else {
#pragma unroll
            for (int k = 0; k < 8; ++k) prv[k] = 0.f; }
        float o[8];
#pragma unroll
        for (int k = 0; k < 8; ++k) { const float v = cur[k] + (prv[k] - cur[k]) * mu[col + k]; o[k] = sub < 8 ? tanhf(v) : (sub < 16 ? v : sigmoidf_(v)); }
        u32x4 w; w.x = pk2(o[0], o[1]); w.y = pk2(o[2], o[3]); w.z = pk2(o[4], o[5]); w.w = pk2(o[6], o[7]);
        *(u32x4*)(alora + (size_t)t * 256 + sub * 8) = w;
    }
}

constexpr int RC_L = 0, RC_AL = 16640, RC_AAK = 0, RC_ARB = 9216, RC_ARK = 18432, RC_AAB = 33280, RC_P2T = 33280, RC_WC = 50688, RC_BS = 50944, RC_M = 52992;
constexpr int RC_AT = RC_M, RC_TINV = RC_M, RC_ATT = RC_M + 9216, RC_RT = RC_M + 2 * 9216, RC_BT = RC_M + 3 * 9216, RC_XT = RC_BT, RC_KT = RC_M + 4 * 9216, RC_P1T = RC_KT,
              RC_VT = RC_M + 5 * 9216, RC_BHT = RC_M + 6 * 9216, RC_KHT = RC_M + 7 * 9216;
static_assert(RC_M + 8 * 9216 <= LDS_MISC, "rwkv chunk LDS");

__device__ __forceinline__ void phase_rwkv_chunk(const Ctx& c, const Args& a, int layer, const bf16_t* proj, const bf16_t* wlb, const bf16_t* alb, bf16_t* rwu, float* bonusg) {
    LAS unsigned char* L = c.lds;
    LAS float* sL = (LAS float*)(L + RC_L); LAS float* sAL = (LAS float*)(L + RC_AL); LAS float* sAAB = (LAS float*)(L + RC_AAB);
    LAS float* sWC = (LAS float*)(L + RC_WC); LAS float* sBS = (LAS float*)(L + RC_BS);
    const float* mu = inptr(c, I_MU) + (size_t)layer * 1792;
    const int lane = c.lane, wave = c.wave, n = lane & 15, q = lane >> 4;
    for (int unit = c.bid; unit < 2048; unit += c.G) {
        const int ch = unit >> 3, h = unit & 7, t0 = ch * 64, j = lane;
        {
            const float w0 = inptr(c, I_W0)[layer * 512 + h * 64 + j], a0 = inptr(c, I_A0)[layer * 512 + h * 64 + j];
            float run = 0.f;
#pragma unroll 2
            for (int i = 0; i < 8; ++i) { const int tt = wave * 8 + i; const size_t gi = (size_t)(t0 + tt) * 512 + h * 64 + j;
                const float wl = w0 + bf2f(wlb[gi]); const float nx = -wl; const float sp = nx > 20.f ? nx : log1pf(__expf(nx)); const float ld = -__expf(-sp - 0.5f);
                run += ld; sL[tt * RL + j] = run; sAL[tt * RL + j] = sigmoidf_(a0 + bf2f(alb[gi])); }
            sBS[wave * 64 + j] = run;
        }
        __syncthreads();
        {
            float off = 0.f, tot = 0.f;
#pragma unroll
            for (int w2 = 0; w2 < 8; ++w2) { const float v = sBS[w2 * 64 + j]; tot += v; off += (w2 < wave) ? v : 0.f; }
            if (wave == 0) sWC[j] = __expf(tot);
            const float kkw = inptr(c, I_KK)[layer * 512 + h * 64 + j], kaw = inptr(c, I_KA)[layer * 512 + h * 64 + j], rk = inptr(c, I_RK)[layer * 512 + h * 64 + j];
            float Lprev = off;
#pragma unroll 1
            for (int i = 0; i < 8; ++i) { const int tt = wave * 8 + i, t = t0 + tt;
                const float Lc = sL[tt * RL + j] + off, al = sAL[tt * RL + j];
                const float r = rwkv_mixed(proj, mu, t, PC_R + h * 64 + j), k = rwkv_mixed(proj, mu, t, PC_K + h * 64 + j), v = rwkv_mixed(proj, mu, t, PC_V + h * 64 + j);
                float kk = k * kkw; const float n2 = wave_sum(kk * kk); kk = kk / fmaxf(sqrtf(n2), 1e-12f);
                const float kp = k * (1.0f + (al - 1.0f) * kaw), av = -kk, bv = kk * al;
                const float eW = __expf(Lc), eWex = __expf(Lprev), eInv = __expf(-Lc), eC = __expf(tot - Lc);
                lds_st_bf16(L + RC_AT, tt * 72 + j, av * eWex); lds_st_bf16(L + RC_ATT, j * 72 + tt, av * eWex);
                lds_st_bf16(L + RC_RT, tt * 72 + j, r * eW); lds_st_bf16(L + RC_BT, tt * 72 + j, bv * eInv); lds_st_bf16(L + RC_KT, tt * 72 + j, kp * eInv);
                lds_st_bf16(L + RC_VT, j * 72 + tt, v); lds_st_bf16(L + RC_BHT, j * 72 + tt, bv * eC); lds_st_bf16(L + RC_KHT, j * 72 + tt, kp * eC);
                const float bon = wave_sum(r * kp * rk); if (lane == 0) bonusg[(size_t)t * 8 + h] = bon;
                Lprev = Lc; }
        }
        __syncthreads();
        for (int job = wave; job < 64; job += 8) {
            const int p = job >> 4, ta = (job >> 2) & 3, tb = job & 3;
            f32x4 acc = (f32x4){0.f, 0.f, 0.f, 0.f};
            if (ta >= tb) acc = tile_mma64(L + (p < 2 ? RC_AT : RC_RT), L + ((p & 1) ? RC_KT : RC_BT), ta, tb, lane, acc);
            LAS unsigned char* dst = L + (p == 1 ? RC_AAK : (p == 2 ? RC_ARB : RC_ARK));
#pragma unroll
            for (int r = 0; r < 4; ++r) { const int tt = 16 * ta + 4 * q + r, ss = 16 * tb + n; const bool keep = (p < 2) ? (ss < tt) : (ss <= tt); const float v = keep ? acc[r] : 0.f;
                if (p == 0) sAAB[tt * 68 + ss] = v; else lds_st_bf16(dst, tt * 72 + ss, v); }
        }
        __syncthreads();
        if (wave == 0) {
            float X[64];
#pragma unroll
            for (int tt = 0; tt < 64; ++tt) { float acc = (tt == lane) ? 1.f : 0.f;
#pragma unroll
                for (int ss = 0; ss < tt; ++ss) acc += sAAB[tt * 68 + ss] * X[ss];
                X[tt] = acc; lds_st_bf16(L + RC_TINV, tt * 72 + lane, acc); }
        } else {
            for (int job = wave - 1; job < 16; job += 7) { const int ta = job >> 2, tb = job & 3;
                const f32x4 acc = tile_mma64(L + RC_VT, L + RC_AAK, ta, tb, lane, (f32x4){0.f, 0.f, 0.f, 0.f});
#pragma unroll
                for (int r = 0; r < 4; ++r) lds_st_bf16(L + RC_XT, (16 * ta + 4 * q + r) * 72 + 16 * tb + n, acc[r]); }
        }
        __syncthreads();
        for (int job = wave; job < 32; job += 8) { const int p = job >> 4, ta = (job >> 2) & 3, tb = job & 3;
            const f32x4 acc = tile_mma64(L + (p ? RC_XT : RC_ATT), L + RC_TINV, ta, tb, lane, (f32x4){0.f, 0.f, 0.f, 0.f});
#pragma unroll
            for (int r = 0; r < 4; ++r) lds_st_bf16(L + (p ? RC_P2T : RC_P1T), (16 * ta + 4 * q + r) * 72 + 16 * tb + n, acc[r]); }
        __syncthreads();
        bf16_t* ug = rwu + (size_t)unit * 16384;
        for (int job = wave; job < 64; job += 8) { const int p = job >> 4, ta = (job >> 2) & 3, tb = job & 3;
            f32x4 acc = (f32x4){0.f, 0.f, 0.f, 0.f};
            if (p == 0) { acc = tile_mma64(L + RC_ARB, L + RC_P1T, ta, tb, lane, acc);
#pragma unroll
                for (int r = 0; r < 4; ++r) { const int tt = 16 * ta + 4 * q + r, jj = 16 * tb + n; const float v = acc[r] + bf2f(*(const LAS bf16_t*)(L + RC_RT + (tt * 72 + jj) * 2));
                    ug[8192 + tt * 64 + (jj & 32) + kperm32(jj & 31)] = (bf16_t)f2bf(v); } }
            else if (p == 1) { acc = tile_mma64(L + RC_ARB, L + RC_P2T, ta, tb, lane, acc); acc = tile_mma64(L + RC_ARK, L + RC_VT, ta, tb, lane, acc);
                u32x2 w; w.x = pk2(acc[0], acc[1]); w.y = pk2(acc[2], acc[3]); *(u32x2*)(ug + 12288 + ((tb * 4 + ta) * 64 + lane) * 4) = w; }
            else if (p == 2) { acc = tile_mma64(L + RC_BHT, L + RC_P1T, ta, tb, lane, acc);
#pragma unroll
                for (int r = 0; r < 4; ++r) { const int jr = 16 * ta + 4 * q + r, jc = 16 * tb + n; const float v = acc[r] + (jr == jc ? sWC[jr] : 0.f);
                    ug[jr * 64 + (jc & 32) + kperm32(jc & 31)] = (bf16_t)f2bf(v); } }
            else { acc = tile_mma64(L + RC_BHT, L + RC_P2T, ta, tb, lane, acc); acc = tile_mma64(L + RC_KHT, L + RC_VT, ta, tb, lane, acc);
                u32x2 w; w.x = pk2(acc[0], acc[1]); w.y = pk2(acc[2], acc[3]); *(u32x2*)(ug + 4096 + ((tb * 4 + ta) * 64 + lane) * 4) = w; }
        }
        __syncthreads();
    }
}

__device__ __forceinline__ void phase_rwkv_scan(const Ctx& c, const bf16_t* rwu, bf16_t* rws) {
    const int idx = c.bid * 8 + c.wave; if (idx >= 32) return;
    const int h = idx >> 2, cq = idx & 3, lane = c.lane, m = lane & 15, q = lane >> 4;
    bf16x8 Bhi[2], Blo[2];
#pragma unroll
    for (int s = 0; s < 2; ++s) { Bhi[s] = (bf16x8){0, 0, 0, 0, 0, 0, 0, 0}; Blo[s] = Bhi[s]; }
    bf16x8 An[4][2]; u32x2 Zn[4];
    { const bf16_t* ug = rwu + (size_t)h * 16384;
#pragma unroll
      for (int ta = 0; ta < 4; ++ta) { An[ta][0] = *(const bf16x8*)(ug + (16 * ta + m) * 64 + 8 * q); An[ta][1] = *(const bf16x8*)(ug + (16 * ta + m) * 64 + 32 + 8 * q);
          Zn[ta] = *(const u32x2*)(ug + 4096 + ((cq * 4 + ta) * 64 + lane) * 4); } }
    for (int ch = 0; ch < T / 64; ++ch) {
        const int unit = ch * 8 + h;
        bf16x8 Ac[4][2]; u32x2 Zc[4];
#pragma unroll
        for (int ta = 0; ta < 4; ++ta) { Ac[ta][0] = An[ta][0]; Ac[ta][1] = An[ta][1]; Zc[ta] = Zn[ta]; }
        if (ch + 1 < T / 64) { const bf16_t* ug = rwu + (size_t)(unit + 8) * 16384;
#pragma unroll
            for (int ta = 0; ta < 4; ++ta) { An[ta][0] = *(const bf16x8*)(ug + (16 * ta + m) * 64 + 8 * q); An[ta][1] = *(const bf16x8*)(ug + (16 * ta + m) * 64 + 32 + 8 * q);
                Zn[ta] = *(const u32x2*)(ug + 4096 + ((cq * 4 + ta) * 64 + lane) * 4); } }
        bf16_t* sg = rws + (size_t)unit * 4096 + cq * 1024 + lane * 8;
        *(bf16x8*)(sg) = Bhi[0]; *(bf16x8*)(sg + 512) = Bhi[1];
        f32x4 acc[4];
#pragma unroll
        for (int ta = 0; ta < 4; ++ta) { acc[ta] = (f32x4){__uint_as_float(Zc[ta].x << 16), __uint_as_float(Zc[ta].x & 0xffff0000u), __uint_as_float(Zc[ta].y << 16), __uint_as_float(Zc[ta].y & 0xffff0000u)};
#pragma unroll
            for (int s = 0; s < 2; ++s) { acc[ta] = __builtin_amdgcn_mfma_f32_16x16x32_bf16(Ac[ta][s], Bhi[s], acc[ta], 0, 0, 0); acc[ta] = __builtin_amdgcn_mfma_f32_16x16x32_bf16(Ac[ta][s], Blo[s], acc[ta], 0, 0, 0); } }
#pragma unroll
        for (int s = 0; s < 2; ++s) { u32x4 hi, lo; float rem[8];
#pragma unroll
            for (int p = 0; p < 8; ++p) { const float v = acc[2 * s + (p >> 2)][p & 3]; const unsigned hb = f2bf(v); rem[p] = v - __uint_as_float(hb << 16); }
            hi.x = pk2(acc[2 * s][0], acc[2 * s][1]); hi.y = pk2(acc[2 * s][2], acc[2 * s][3]); hi.z = pk2(acc[2 * s + 1][0], acc[2 * s + 1][1]); hi.w = pk2(acc[2 * s + 1][2], acc[2 * s + 1][3]);
            lo.x = pk2(rem[0], rem[1]); lo.y = pk2(rem[2], rem[3]); lo.z = pk2(rem[4], rem[5]); lo.w = pk2(rem[6], rem[7]);
            Bhi[s] = __builtin_bit_cast(bf16x8, hi); Blo[s] = __builtin_bit_cast(bf16x8, lo); }
    }
}

__device__ __forceinline__ void phase_rwkv_out(const Ctx& c, const Args& a, int layer, const bf16_t* proj, const bf16_t* rwu, const bf16_t* rws, const float* bonusg, bf16_t* orwkv) {
    const float* mu = inptr(c, I_MU) + (size_t)layer * 1792;
    const int lane = c.lane, m = lane & 15, q = lane >> 4;
    for (int unit = c.bid * 8 + c.wave; unit < 2048; unit += c.G * 8) {
        const int ch = unit >> 3, h = unit & 7, t0 = ch * 64; const bf16_t* ug = rwu + (size_t)unit * 16384; const bf16_t* sg = rws + (size_t)unit * 4096;
        bf16x8 Bf[4][2];
#pragma unroll
        for (int cq = 0; cq < 4; ++cq) { Bf[cq][0] = *(const bf16x8*)(sg + cq * 1024 + lane * 8); Bf[cq][1] = *(const bf16x8*)(sg + cq * 1024 + 512 + lane * 8); }
        float lnw[4], lnb[4];
#pragma unroll
        for (int cq = 0; cq < 4; ++cq) { lnw[cq] = inptr(c, I_LNW)[layer * 512 + h * 64 + 16 * cq + m]; lnb[cq] = inptr(c, I_LNB)[layer * 512 + h * 64 + 16 * cq + m]; }
#pragma unroll 1
        for (int ta = 0; ta < 4; ++ta) {
            const bf16x8 A0 = *(const bf16x8*)(ug + 8192 + (16 * ta + m) * 64 + 8 * q), A1 = *(const bf16x8*)(ug + 8192 + (16 * ta + m) * 64 + 32 + 8 * q);
            f32x4 y[4];
#pragma unroll
            for (int cq = 0; cq < 4; ++cq) { const u32x2 z = *(const u32x2*)(ug + 12288 + ((cq * 4 + ta) * 64 + lane) * 4);
                y[cq] = (f32x4){__uint_as_float(z.x << 16), __uint_as_float(z.x & 0xffff0000u), __uint_as_float(z.y << 16), __uint_as_float(z.y & 0xffff0000u)};
                y[cq] = __builtin_amdgcn_mfma_f32_16x16x32_bf16(A0, Bf[cq][0], y[cq], 0, 0, 0); y[cq] = __builtin_amdgcn_mfma_f32_16x16x32_bf16(A1, Bf[cq][1], y[cq], 0, 0, 0); }
#pragma unroll
            for (int r = 0; r < 4; ++r) { const int t = t0 + 16 * ta + 4 * q + r;
                float sm = y[0][r] + y[1][r] + y[2][r] + y[3][r];
                sm += __shfl_xor(sm, 1); sm += __shfl_xor(sm, 2); sm += __shfl_xor(sm, 4); sm += __shfl_xor(sm, 8);
                const float mean = sm * (1.0f / 64.0f); float d[4], vs = 0.f;
#pragma unroll
                for (int cq = 0; cq < 4; ++cq) { d[cq] = y[cq][r] - mean; vs += d[cq] * d[cq]; }
                vs += __shfl_xor(vs, 1); vs += __shfl_xor(vs, 2); vs += __shfl_xor(vs, 4); vs += __shfl_xor(vs, 8);
                const float rstd = rsqrtf(vs * (1.0f / 64.0f) + 64e-5f); const float bon = bonusg[(size_t)t * 8 + h];
#pragma unroll
                for (int cq = 0; cq < 4; ++cq) { const int col = h * 64 + 16 * cq + m; const float v = rwkv_mixed(proj, mu, t, PC_V + col);
                    bf16_t* op = orwkv + (size_t)t * 512 + col; const float g = bf2f(*op);
                    *op = (bf16_t)f2bf((d[cq] * rstd * lnw[cq] + lnb[cq] + bon * v) * g); } }
        }
    }
}


constexpr int AT_K = 0, AT_V = 9216, AT_BIAS = 18432, AT_SELM = 34816, AT_LIST = 38912, AT_NLIST = 39936, AT_NEED = 39968;
__device__ __forceinline__ void vt_transpose(const Ctx& c, const bf16_t* proj, bf16_t* vt) {
    LAS bf16_t* tl = (LAS bf16_t*)c.lds;
    for (int it = c.bid; it < 3 * 2 * 256; it += c.G) {
        const int which = it / 512, g = (it >> 8) & 1, tt = it & 255;
        const int col = (which == 0 ? PC_VS : (which == 1 ? PC_VW : PC_SV)) + g * 64;
        { const int tok = c.tid >> 3, ch = c.tid & 7; const u32x4 w = *(const u32x4*)(proj + (size_t)(tt * 64 + tok) * PLD + col + ch * 8);
          *(LAS u32x4*)(tl + tok * 72 + ch * 8) = w; }
        __syncthreads();
        { const int d = c.tid >> 3, ch = c.tid & 7; unsigned short e[8];
#pragma unroll
          for (int k = 0; k < 8; ++k) e[k] = tl[(ch * 8 + k) * 72 + d];
          u32x4 w; w.x = e[0] | ((unsigned)e[1] << 16); w.y = e[2] | ((unsigned)e[3] << 16); w.z = e[4] | ((unsigned)e[5] << 16); w.w = e[6] | ((unsigned)e[7] << 16);
          *(u32x4*)(vt + ((size_t)(which * 2 + g) * 64 + d) * T + tt * 64 + ch * 8) = w; }
        __syncthreads();
    }
}

template <int MODE, int NQ>
__device__ __forceinline__ void phase_attn(const Ctx& c, const Args& a, int layer, const bf16_t* proj, const bf16_t* vtb, const bf16_t* kcb, const bf16_t* vctb,
                                           const int* sel, float* nsaacc, float* scores, bf16_t* oout) {
    LAS unsigned char* L = c.lds;
    LAS float* biasd = (LAS float*)(L + AT_BIAS);
    LAS unsigned* selm = (LAS unsigned*)(L + AT_SELM);
    LAS int* list = (LAS int*)(L + AT_LIST);
    LAS int* nlist = (LAS int*)(L + AT_NLIST);
    LAS unsigned* need = (LAS unsigned*)(L + AT_NEED);
    const int lane = c.lane, wave = c.wave, n = lane & 15, q = lane >> 4, hr = n & 3;
    constexpr int TW = 4 * NQ, TB = 8 * TW, NU = T / TB;
    for (int unit = c.bid; unit < 2 * NU; unit += c.G) {
        const int g = unit / NU, t0 = (unit % NU) * TB, tw0 = t0 + wave * TW;
        __syncthreads();
        for (int e = c.tid; e < 4096; e += 512) { const int r = e >> 10, d = e & 1023; biasd[e] = inptr(c, I_REL)[t5_bucket(d) * 16 + (MODE == 0 ? 8 : 0) + g * 4 + r]; }
        if (MODE == 3) {
            for (int e = c.tid; e < 1024; e += 512) selm[e] = 0u;
            if (c.tid < 8) need[c.tid] = 0u;
            __syncthreads();
            if ((c.tid >> 2) < TB) { const int tok = c.tid >> 2, k4 = (c.tid & 3) * 4; const int* sp = sel + ((size_t)(t0 + tok) * 2 + g) * 16 + k4;
#pragma unroll
              for (int k = 0; k < 4; ++k) { const int j = sp[k]; atomicOr((unsigned*)&selm[tok * 8 + (j >> 5)], 1u << (j & 31)); atomicOr((unsigned*)&need[j >> 5], 1u << (j & 31)); } }
            __syncthreads();
            if (c.tid < 256) { const int j = c.tid; const unsigned wd = need[j >> 5];
                if ((wd >> (j & 31)) & 1u) { int pos = __popc(wd & ((1u << (j & 31)) - 1u)); for (int w2 = 0; w2 < (j >> 5); ++w2) pos += __popc(need[w2]); list[pos] = j; } }
            if (c.tid == 0) { int cnt = 0; for (int w2 = 0; w2 < 8; ++w2) cnt += __popc(need[w2]); nlist[0] = cnt; }
        }
        __syncthreads();
        int ntiles, tile_lo = 0;
        if (MODE == 0) { ntiles = 2 + TB / 64; tile_lo = t0 - 128; }
        else if (MODE == 1) { ntiles = 8 + TB / 64; tile_lo = t0 - 512; }
        else if (MODE == 2) { const int cmax = (t0 + TB - 1 - 31) >> 4; ntiles = cmax < 0 ? 0 : (cmax >> 6) + 1; }
        else ntiles = nlist[0];
        const bf16_t* Ksrc; size_t kstride; const bf16_t* Vsrc; size_t vstride; int qcol;
        if (MODE == 0) { Ksrc = proj + PC_SK + g * 64; kstride = PLD; Vsrc = vtb + (size_t)(4 + g) * 64 * T; vstride = T; qcol = PC_SQ + g * 256; }
        else if (MODE == 1) { Ksrc = proj + PC_KW + g * 64; kstride = PLD; Vsrc = vtb + (size_t)(2 + g) * 64 * T; vstride = T; qcol = PC_NQ + g * 256; }
        else if (MODE == 2) { Ksrc = kcb + (size_t)g * 1024 * 64; kstride = 64; Vsrc = vctb + (size_t)g * 64 * 1024; vstride = 1024; qcol = PC_NQ + g * 256; }
        else { Ksrc = proj + PC_KS + g * 64; kstride = PLD; Vsrc = vtb + (size_t)(0 + g) * 64 * T; vstride = T; qcol = PC_NQ + g * 256; }
        bf16x8 Bq[NQ][2];
#pragma unroll
        for (int qd = 0; qd < NQ; ++qd) { const bf16_t* qp = proj + (size_t)(tw0 + 4 * qd + (n >> 2)) * PLD + qcol + hr * 64 + 8 * q;
            Bq[qd][0] = *(const bf16x8*)qp; Bq[qd][1] = *(const bf16x8*)(qp + 32); }
        float mrun[NQ], lrun[NQ]; f32x4 O[NQ][4];
#pragma unroll
        for (int qd = 0; qd < NQ; ++qd) { mrun[qd] = -1e30f; lrun[qd] = 0.f;
#pragma unroll
            for (int dt = 0; dt < 4; ++dt) O[qd][dt] = (f32x4){0.f, 0.f, 0.f, 0.f}; }
        float carry3[NQ]; for (int i = 0; i < NQ; ++i) carry3[i] = 0.f;
        const int npass = (MODE == 2) ? 2 : 1;
        for (int pass = 0; pass < npass; ++pass) {
            const bool do_pv = (MODE != 2) || pass == 1;
            float linv[NQ];
            if (MODE == 2 && pass == 1) {
#pragma unroll
                for (int qd = 0; qd < NQ; ++qd) { float lt = lrun[qd]; lt += __shfl_xor(lt, 16); lt += __shfl_xor(lt, 32); linv[qd] = lt > 0.f ? 1.0f / lt : 0.f; }
            }
            u32x4 kreg, vreg; int p0n;
            { const int ti = 0; p0n = (MODE == 3) ? list[ti] * 64 : (MODE == 2 ? ti * 64 : tile_lo + ti * 64);
              if (ntiles > 0 && p0n >= 0) { kreg = *(const u32x4*)(Ksrc + (size_t)(p0n + (c.tid >> 3)) * kstride + (c.tid & 7) * 8);
                  if (do_pv) vreg = *(const u32x4*)(Vsrc + (size_t)(c.tid >> 3) * vstride + p0n + (c.tid & 7) * 8); } }
            for (int ti = 0; ti < ntiles; ++ti) {
                const int p0 = p0n;
                __syncthreads();
                if (p0 >= 0) { *(LAS u32x4*)(L + AT_K + (c.tid >> 3) * 144 + (c.tid & 7) * 16) = kreg; if (do_pv) *(LAS u32x4*)(L + AT_V + (c.tid >> 3) * 144 + (c.tid & 7) * 16) = vreg; }
                if (ti + 1 < ntiles) { p0n = (MODE == 3) ? list[ti + 1] * 64 : (MODE == 2 ? (ti + 1) * 64 : tile_lo + (ti + 1) * 64);
                    if (p0n >= 0) { kreg = *(const u32x4*)(Ksrc + (size_t)(p0n + (c.tid >> 3)) * kstride + (c.tid & 7) * 8);
                        if (do_pv) vreg = *(const u32x4*)(Vsrc + (size_t)(c.tid >> 3) * vstride + p0n + (c.tid & 7) * 8); } }
                __syncthreads();
                if (p0 < 0) continue;
                if (MODE == 0) { if (p0 > tw0 + TW - 1 || p0 + 63 < tw0 - 127) continue; }
                if (MODE == 1) { if (p0 > tw0 + TW - 1 || p0 + 63 < tw0 - 511) continue; }
                if (MODE == 2) { if (16 * p0 + 31 > tw0 + TW - 1) continue; }
                if (MODE == 3) { if (p0 > tw0 + TW - 1) continue; }
                const int jblk = p0 >> 6;
#pragma unroll
                for (int qd = 0; qd < NQ; ++qd) {
                    const int tq = tw0 + 4 * qd + (n >> 2);
                    bool colsel = true;
                    if (MODE == 3) { colsel = (selm[(wave * TW + 4 * qd + (n >> 2)) * 8 + (jblk >> 5)] >> (jblk & 31)) & 1u; if (__ballot(colsel) == 0ull) continue; }
#pragma unroll
                    for (int st = 0; st < 2; ++st) {
                        f32x4 sc[2];
#pragma unroll
                        for (int kt = 0; kt < 2; ++kt) { sc[kt] = (f32x4){0.f, 0.f, 0.f, 0.f};
#pragma unroll
                            for (int ks = 0; ks < 2; ++ks) { const bf16x8 ak = *(const LAS bf16x8*)(L + AT_K + (32 * st + 16 * kt + n) * 144 + (32 * ks + 8 * q) * 2);
                                sc[kt] = __builtin_amdgcn_mfma_f32_16x16x32_bf16(ak, Bq[qd][ks], sc[kt], 0, 0, 0); } }
                        float mx = -1e30f;
#pragma unroll
                        for (int kt = 0; kt < 2; ++kt)
#pragma unroll
                            for (int r = 0; r < 4; ++r) { const int kl = 32 * st + 16 * kt + 4 * q + r; int dist; bool v;
                                if (MODE == 2) { dist = tq - (16 * (p0 + kl) + 31); v = dist >= 0; }
                                else { dist = tq - (p0 + kl); v = dist >= 0; if (MODE == 0) v = v && dist < 128; if (MODE == 1) v = v && dist < 512; if (MODE == 3) v = v && colsel; }
                                const int di = dist < 0 ? 0 : (dist > 1023 ? 1023 : dist);
                                const float s2 = v ? sc[kt][r] + biasd[hr * 1024 + di] : -1e30f; sc[kt][r] = s2; mx = fmaxf(mx, s2); }
                        float p[2][4];
                        if (MODE == 2 && pass == 1) {
#pragma unroll
                            for (int kt = 0; kt < 2; ++kt)
#pragma unroll
                                for (int r = 0; r < 4; ++r) p[kt][r] = __expf(sc[kt][r] - mrun[qd]) * linv[qd];
                        } else {
                            mx = fmaxf(mx, __shfl_xor(mx, 16)); mx = fmaxf(mx, __shfl_xor(mx, 32));
                            const float mn = fmaxf(mrun[qd], mx), corr = __expf(mrun[qd] - mn); mrun[qd] = mn; float ps = 0.f;
                            const float mne = mn < -1e29f ? 0.f : mn;
#pragma unroll
                            for (int kt = 0; kt < 2; ++kt)
#pragma unroll
                                for (int r = 0; r < 4; ++r) { p[kt][r] = __expf(sc[kt][r] - mne); ps += p[kt][r]; }
                            lrun[qd] = lrun[qd] * corr + ps;
                            if (do_pv) {
#pragma unroll
                                for (int dt = 0; dt < 4; ++dt) O[qd][dt] = O[qd][dt] * corr; }
                        }
                        if (MODE == 2 && pass == 1) {
                            float i3prev = carry3[qd];
#pragma unroll
                            for (int kt = 0; kt < 2; ++kt) { float im[4];
#pragma unroll
                                for (int r = 0; r < 4; ++r) { float v = p[kt][r]; v += __shfl_xor(v, 1); v += __shfl_xor(v, 2); im[r] = v; }
                                const float same = __shfl(im[3], (lane + 48) & 63), prevt = __shfl(i3prev, (lane + 48) & 63);
                                const float pv3 = q > 0 ? same : prevt;
                                const int jg = (p0 + 32 * st + 16 * kt + 4 * q) >> 2;
                                if (hr == 0 && jg < 256) scores[((size_t)g * T + tq) * 256 + jg] = 2.0f * (im[0] + im[1] + im[2]) + im[3] + pv3;
                                i3prev = im[3]; }
                            carry3[qd] = i3prev;
                        }
                        if (do_pv) {
                            u32x4 pw; pw.x = pk2(p[0][0], p[0][1]); pw.y = pk2(p[0][2], p[0][3]); pw.z = pk2(p[1][0], p[1][1]); pw.w = pk2(p[1][2], p[1][3]);
                            const bf16x8 pf = __builtin_bit_cast(bf16x8, pw);
#pragma unroll
                            for (int dt = 0; dt < 4; ++dt) { const LAS unsigned char* vp = L + AT_V + (16 * dt + n) * 144 + (32 * st + 4 * q) * 2;
                                const u32x2 v0 = *(const LAS u32x2*)vp, v1 = *(const LAS u32x2*)(vp + 32); u32x4 vw; vw.x = v0.x; vw.y = v0.y; vw.z = v1.x; vw.w = v1.y;
                                O[qd][dt] = __builtin_amdgcn_mfma_f32_16x16x32_bf16(__builtin_bit_cast(bf16x8, vw), pf, O[qd][dt], 0, 0, 0); }
                        }
                        __builtin_amdgcn_sched_barrier(0);
                    }
                }
            }
        }
#pragma unroll
        for (int qd = 0; qd < NQ; ++qd) {
            const int tq = tw0 + 4 * qd + (n >> 2), hh = g * 4 + hr;
            float scale;
            if (MODE == 2) scale = 1.0f;
            else { float lt = lrun[qd]; lt += __shfl_xor(lt, 16); lt += __shfl_xor(lt, 32);
                if (MODE == 0) { const float sink = inptr(c, I_SINK)[layer * 8 + hh]; const float mf = fmaxf(mrun[qd], sink), cr = __expf(mrun[qd] - mf); scale = cr / (lt * cr + __expf(sink - mf)); }
                else scale = lt > 0.f ? 1.0f / lt : 0.f; }
            if (MODE != 0) scale *= sigmoidf_(bf2f(proj[(size_t)tq * PLD + PC_GL + (MODE == 2 ? 0 : (MODE == 3 ? 8 : 16)) + hh]));
#pragma unroll
            for (int dt = 0; dt < 4; ++dt) { const f32x4 o = O[qd][dt] * scale; const int col = hh * 64 + 16 * dt + 4 * q;
                if (MODE == 0) { u32x2 w; w.x = pk2(o[0], o[1]); w.y = pk2(o[2], o[3]); *(u32x2*)(oout + (size_t)tq * 512 + col) = w; }
                else if (MODE == 2) *(f32x4*)(nsaacc + (size_t)tq * 512 + col) = o;
                else if (MODE == 1) { f32x4* ap = (f32x4*)(nsaacc + (size_t)tq * 512 + col); *ap = *ap + o; }
                else { const f32x4 t2 = *(const f32x4*)(nsaacc + (size_t)tq * 512 + col) + o; u32x2 w; w.x = pk2(t2[0], t2[1]); w.y = pk2(t2[2], t2[3]); *(u32x2*)(oout + (size_t)tq * 512 + col) = w; } }
        }
    }
}
__device__ __forceinline__ void phase_topk2(const Ctx& c, const float* scores, int* sel) {
    const int gw = c.bid * 8 + c.wave, NGW = c.G * 8;
    for (int item = gw; item < T * 2; item += NGW) {
        const int t = item >> 1, g = item & 1, cur = t >> 6;
        const float* sp = scores + ((size_t)g * T + t) * 256;
        float val[4];
#pragma unroll
        for (int jj = 0; jj < 4; ++jj) { const int j = c.lane + 64 * jj; float sc;
            if (j == 0 || j == cur || j == cur - 1) sc = 1e4f; else if (j > cur) sc = -1.0f; else sc = sp[j];
            val[jj] = sc; }
        for (int k = 0; k < 16; ++k) {
            float bv = val[0]; int bi = c.lane;
#pragma unroll
            for (int jj = 1; jj < 4; ++jj) if (val[jj] > bv) { bv = val[jj]; bi = c.lane + 64 * jj; }
#pragma unroll
            for (int o = 32; o >= 1; o >>= 1) { const float ov = __shfl_xor(bv, o); const int oi = __shfl_xor(bi, o); if (ov > bv || (ov == bv && oi < bi)) { bv = ov; bi = oi; } }
#pragma unroll
            for (int jj = 0; jj < 4; ++jj) if (bi == c.lane + 64 * jj) val[jj] = -3e38f;
            if (c.lane == 0) sel[(size_t)item * 16 + k] = bi;
        }
    }
}

#define wb ((bf16_t*)(ws + WS_WB))
#define xb ((bf16_t*)(ws + WS_XB))
#define rs ((float*)(ws + WS_RS))
#define kcb ((bf16_t*)(ws + WS_KCB))
#define vctb ((bf16_t*)(ws + WS_VCT))
#define vtb ((bf16_t*)(ws + WS_VT))
#define scores ((float*)(ws + WS_SCORES))
#define sel ((int*)(ws + WS_SEL))
#define ml ((float*)(ws + WS_ML))
#define hid ((float*)(ws + WS_HID))
#define proj ((bf16_t*)(ws + WS_PROJ))
#define gates ((bf16_t*)(ws + WS_GATES))
#define merged ((bf16_t*)(ws + WS_MERGED))
#define tmpb ((bf16_t*)(ws + WS_TMPB))
#define alora ((bf16_t*)(ws + WS_ALORA))
#define rwu ((bf16_t*)(ws + WS_RWU))
#define rws ((bf16_t*)(ws + WS_RWS))
#define bonusg ((float*)(ws + WS_BONUS))
#define nsaacc ((float*)(ws + WS_NSAACC))
#define obuf ((bf16_t*)(ws + WS_O))
#define act ((bf16_t*)(ws + WS_ACT))
#define tmpf ((bf16_t*)(ws + WS_TMPF))
constexpr int PH_PER_BATCH = 16, PH_PER_LAYER = 1 + 2 * PH_PER_BATCH + 3, PH_TOTAL = 1 + DEPTH * PH_PER_LAYER;

__global__ void __launch_bounds__(512, 2) fwd_kernel(Args args) {
    extern __shared__ __attribute__((aligned(16))) unsigned char lds_raw[];
    Ctx c0; c0.lds = (LAS unsigned char*)lds_raw; c0.tid = threadIdx.x; c0.lane = c0.tid & 63; c0.wave = __builtin_amdgcn_readfirstlane(c0.tid >> 6); c0.G = gridDim.x; c0.bid = blockIdx.x; const Ctx& c = c0;
    unsigned char* ws = args.ws;
    volatile LAS unsigned* misc = (volatile LAS unsigned*)(c.lds + LDS_MISC);
    if (c.tid < 4) misc[c.tid] = 0u;
    if (c.tid < 30) { const unsigned long long pv = (unsigned long long)args.in[c.tid & 31]; misc[16 + 2 * c.tid] = (unsigned)pv; misc[17 + 2 * c.tid] = (unsigned)(pv >> 32); }
    __syncthreads();
    XcdBarrier bar; bar.bar = (unsigned*)(ws + WS_CTL); bar.x = 0; bar.st = misc;
    const int lo = args.lo, hi = args.hi;
    const bool multi = (hi - lo) > 1;
    if (multi) bar = xcd_barrier_post((unsigned*)(ws + WS_CTL), misc);
    int gp = 0;
#ifndef ONLY_PH
#define ONLY_PH -1
#endif
#ifndef PHMASK
#define PHMASK 0xffffff
#endif
#define PHASE_BEGIN(id) if (gp >= lo && gp < hi) { if ((ONLY_PH < 0 || ONLY_PH == (id)) && ((PHMASK >> (id)) & 1)) { \
    Ctx pc = c0; asm volatile("" : "+v"(pc.tid), "+s"(pc.bid)); pc.lane = pc.tid & 63; pc.wave = __builtin_amdgcn_readfirstlane(pc.tid >> 6); const Ctx& c = pc;
#define PHASE_END   } if (gp + 1 < hi) xcd_barrier(bar); } ++gp;

    float* x = args.out;
    PHASE_BEGIN(0) phase_init(c, inptr(c, I_X), x, xb, rs); PHASE_END

    for (int layer = 0; layer < DEPTH; ++layer) {
        PHASE_BEGIN(1) phase_cvt(c, args, layer, wb); PHASE_END
        for (int b = 0; b < NBATCH; ++b) {
            const int row0 = b * T;
            PHASE_BEGIN(2) {
                pg8::Gemm g{xb + (size_t)row0 * D, wb + WB_WIN, D, D, D}; pg8::Sched S; S.init(T / 256, NIN / 256, c.G, c.bid, 1, (size_t)256 * D * 2, 0, (size_t)256 * D * 2, 0);
                pg8::EpiInProj E{proj, gates, rs + row0}; pg8::gemm_phase(c.lds, c.tid, g, S, E); } PHASE_END
            PHASE_BEGIN(16) { phase_lora_a(c, args, layer, proj, alora); vt_transpose(c, proj, vtb); } PHASE_END
            PHASE_BEGIN(17) {
                pg8::Gemm g{alora, wb + WB_LORA, 256, 256, 256}; pg8::Sched S; S.init(T / 256, 6, c.G, c.bid, 1, (unsigned)256 * 256 * 2, 0, (unsigned)256 * 256 * 2, 0);
                pg8::EpiLora E{obuf}; pg8::gemm_phase(c.lds, c.tid, g, S, E); } PHASE_END
            PHASE_BEGIN(18) phase_rwkv_chunk(c, args, layer, proj, obuf + (size_t)T * 512, obuf + (size_t)2 * T * 512, rwu, bonusg); PHASE_END
            PHASE_BEGIN(19) phase_rwkv_scan(c, rwu, rws); PHASE_END
            PHASE_BEGIN(9) phase_rwkv_out(c, args, layer, proj, rwu, rws, bonusg, obuf); PHASE_END
            PHASE_BEGIN(3) phase_cmp1(c, args, layer, proj, hid); PHASE_END
            PHASE_BEGIN(4) phase_cmp2(c, args, layer, hid, kcb, vctb); PHASE_END
            PHASE_BEGIN(5) phase_attn<2, 2>(c, args, layer, proj, vtb, kcb, vctb, sel, nsaacc, scores, obuf + (size_t)T * 512); PHASE_END
            PHASE_BEGIN(6) phase_topk2(c, scores, sel); PHASE_END
            PHASE_BEGIN(7) phase_attn<1, 2>(c, args, layer, proj, vtb, kcb, vctb, sel, nsaacc, scores, obuf + (size_t)T * 512); PHASE_END
            PHASE_BEGIN(8) phase_attn<3, 2>(c, args, layer, proj, vtb, kcb, vctb, sel, nsaacc, scores, obuf + (size_t)T * 512); PHASE_END
            PHASE_BEGIN(20) phase_attn<0, 2>(c, args, layer, proj, vtb, kcb, vctb, sel, nsaacc, scores, obuf + (size_t)2 * T * 512); PHASE_END
            PHASE_BEGIN(10) {
                pg8::Gemm g{obuf, wb + WB_WBR, 512, 512, 512}; pg8::Sched S; S.init(T / 256, D / 256, c.G, c.bid, 3, (size_t)256 * 512 * 2, (size_t)T * 512 * 2, (size_t)256 * 512 * 2, (size_t)D * 512 * 2);
                pg8::EpiMerge E{gates, merged}; pg8::gemm_phase(c.lds, c.tid, g, S, E); } PHASE_END
            PHASE_BEGIN(11) {
                pg8::Gemm g{merged, wb + WB_WOUT, D, D, D}; pg8::Sched S; S.init(T / 256, D / 256, c.G, c.bid, 1, (size_t)256 * D * 2, 0, (size_t)256 * D * 2, 0);
                pg8::EpiStore E{tmpb, D}; pg8::gemm_phase(c.lds, c.tid, g, S, E); } PHASE_END
            PHASE_BEGIN(12) phase_norm_res(c, tmpb, inptr(c, I_NQM) + layer * D, x, xb, rs, row0, T); PHASE_END
        }
        PHASE_BEGIN(13) {
            pg8::Gemm g{xb, wb + WB_WGU, D, D, D}; pg8::Sched S; S.init(MROWS / 256, 2 * FFN / 256, c.G, c.bid, 1, (size_t)256 * D * 2, 0, (size_t)256 * D * 2, 0);
            pg8::EpiSwiGLU E{act, rs}; pg8::gemm_phase(c.lds, c.tid, g, S, E); } PHASE_END
        PHASE_BEGIN(14) {
            pg8::Gemm g{act, wb + WB_WDN, FFN, FFN, FFN}; pg8::Sched S; S.init(MROWS / 256, D / 256, c.G, c.bid, 1, (size_t)256 * FFN * 2, 0, (size_t)256 * FFN * 2, 0);
            pg8::EpiStore E{tmpf, D}; pg8::gemm_phase(c.lds, c.tid, g, S, E); } PHASE_END
        PHASE_BEGIN(15) phase_norm_res(c, tmpf, inptr(c, I_NQF) + layer * D, x, xb, rs, 0, MROWS); PHASE_END
    }
#undef PHASE_BEGIN
#undef PHASE_END
}

extern "C" void kernel_launch(void* const* d_in, const int* in_sizes, int n_in, void* d_out, int out_size, void* d_ws, size_t ws_size, hipStream_t stream) {
    static int grid = 0;
    if (grid == 0) {
        if (n_in != 30 || out_size != MROWS * D || ws_size < WS_END) { fprintf(stderr, "kernel_launch: unexpected shapes (n_in %d out %d ws %zu)\n", n_in, out_size, ws_size); grid = -1; return; }
        int dev = 0, cus = 0;
        if (hipGetDevice(&dev) != hipSuccess || hipDeviceGetAttribute(&cus, hipDeviceAttributeMultiprocessorCount, dev) != hipSuccess) { grid = -1; return; }
        if (hipFuncSetAttribute((const void*)fwd_kernel, hipFuncAttributeMaxDynamicSharedMemorySize, LDS_BYTES) != hipSuccess) { fprintf(stderr, "hipFuncSetAttribute failed\n"); grid = -1; return; }
        int per_cu = 0;
        if (hipOccupancyMaxActiveBlocksPerMultiprocessor(&per_cu, (const void*)fwd_kernel, 512, LDS_BYTES) != hipSuccess || per_cu < 1) { fprintf(stderr, "occupancy query: %d\n", per_cu); }
        (void)hipGetLastError();
        grid = cus;
    }
    if (grid < 0) return;
    (void)hipMemsetAsync((char*)d_ws + WS_CTL, 0, CTL_BYTES, stream);
    Args a{};
    for (int i = 0; i < 30; ++i) a.in[i] = (const float*)d_in[i];
    a.out = (float*)d_out; a.ws = (unsigned char*)d_ws;
#if MK_ONE_LAUNCH
    a.lo = 0; a.hi = PH_TOTAL;
    hipLaunchKernelGGL(fwd_kernel, dim3(grid), dim3(512), LDS_BYTES, stream, a);
#else
    for (int p = 0; p < PH_TOTAL; ++p) { a.lo = p; a.hi = p + 1; hipLaunchKernelGGL(fwd_kernel, dim3(grid), dim3(512), LDS_BYTES, stream, a); }
#endif
}
```

```cpp
#include <hip/hip_runtime.h>
#include <stdint.h>
#include <stdio.h>

#ifndef MK_ONE_LAUNCH
#define MK_ONE_LAUNCH 1
#endif

#define LAS __attribute__((address_space(3)))
typedef unsigned short bf16_t;
typedef short bf16x8 __attribute__((ext_vector_type(8)));
typedef float f32x4 __attribute__((ext_vector_type(4)));
typedef float f32x2 __attribute__((ext_vector_type(2)));
typedef unsigned u32x4 __attribute__((ext_vector_type(4)));
typedef unsigned u32x2 __attribute__((ext_vector_type(2)));

constexpr int D = 1024, NBATCH = 2, T = 16384, DEPTH = 4, MROWS = NBATCH * T;
constexpr int IN_COLS = 6936, FFN = 2816;
constexpr int PLD = 4096;
constexpr int PC_R = 0, PC_K = 512, PC_V = 1024, PC_ZW = 1536, PC_ZA = 1600, PC_ZG = 1664;
constexpr int PC_NQ = 1792, PC_KC = 2304, PC_VC = 2432, PC_KS = 2560, PC_VS = 2688, PC_KW = 2816, PC_VW = 2944, PC_GL = 3072;
constexpr int PC_SQ = 3328, PC_SK = 3840, PC_SV = 3968;
constexpr int NIN = 7168;
constexpr int NCMP = 1023;
constexpr float NORM_EPS = 1e-6f;

constexpr size_t MiB = 1u << 20;
constexpr size_t WS_CTL = 0, CTL_BYTES = 65536;
constexpr size_t WS_WB = 65536;
constexpr size_t WB_WIN = 0, WB_WBR = WB_WIN + (size_t)NIN * D, WB_WOUT = WB_WBR + (size_t)3 * D * 512, WB_WGU = WB_WOUT + (size_t)D * D,
                 WB_WDN = WB_WGU + (size_t)2 * FFN * D, WB_LORA = WB_WDN + (size_t)D * FFN, WB_W1T = WB_LORA + (size_t)1536 * 256, WB_W2T = WB_W1T + (size_t)2 * 256 * 2048,
                 WB_BH = WB_W2T + (size_t)2 * 256 * 256, WB_END = WB_BH + 1024;
static_assert(WS_WB + WB_END * 2 <= 39 * MiB, "weights");
constexpr size_t WS_XB = 39 * MiB;
constexpr size_t WS_RS = 103 * MiB;
constexpr size_t WS_KCB = 103 * MiB + 262144;
constexpr size_t WS_VCT = WS_KCB + 262144;
constexpr size_t WS_SEL = 104 * MiB;
constexpr size_t WS_BONUS = 106 * MiB;
constexpr size_t WS_ML = 106 * MiB + 524288;
constexpr size_t WS_ALORA = 107 * MiB;
constexpr size_t WS_HID = 107 * MiB;
constexpr size_t WS_VT = 115 * MiB;
constexpr size_t WS_BIG = 127 * MiB;
constexpr size_t WS_PROJ = WS_BIG;
constexpr size_t WS_GATES = WS_PROJ + 128 * MiB;
constexpr size_t WS_RWKVS = WS_GATES + 96 * MiB;
constexpr size_t WS_RWU = WS_RWKVS;
constexpr size_t WS_RWS = WS_RWKVS + 64 * MiB;
constexpr size_t WS_SCORES = WS_RWKVS;
constexpr size_t WS_MERGED = WS_RWKVS;
constexpr size_t WS_TMPB = WS_RWKVS + 32 * MiB;
constexpr size_t WS_NSAACC = WS_RWKVS + 80 * MiB;
constexpr size_t WS_O = WS_NSAACC + 32 * MiB;
constexpr size_t WS_END = WS_O + 48 * MiB;
constexpr size_t WS_ACT = WS_BIG;
constexpr size_t WS_TMPF = WS_BIG + 176 * MiB;
static_assert(WS_END <= 512 * MiB, "workspace");
static_assert(WS_TMPF + 64 * MiB <= WS_NSAACC, "ffn overlay");

constexpr int LDS_BYTES = 147456;
constexpr int LDS_MISC = 131072 + 8192;

__device__ __forceinline__ float bf2f(unsigned v) { return __uint_as_float(v << 16); }
typedef __bf16 bf16n2 __attribute__((ext_vector_type(2)));
__device__ __forceinline__ unsigned pk2(float lo, float hi) { const f32x2 f = {lo, hi}; const bf16n2 v = __builtin_convertvector(f, bf16n2); return __builtin_bit_cast(unsigned, v); }
__device__ __forceinline__ unsigned f2bf(float f) { return pk2(f, 0.f) & 0xffffu; }
__device__ __forceinline__ void unpack8(const u32x4 w, float (&f)[8]) {
    f[0] = __uint_as_float(w.x << 16); f[1] = __uint_as_float(w.x & 0xffff0000u); f[2] = __uint_as_float(w.y << 16); f[3] = __uint_as_float(w.y & 0xffff0000u);
    f[4] = __uint_as_float(w.z << 16); f[5] = __uint_as_float(w.z & 0xffff0000u); f[6] = __uint_as_float(w.w << 16); f[7] = __uint_as_float(w.w & 0xffff0000u);
}
__device__ __forceinline__ float wave_sum(float v) {
#pragma unroll
    for (int o = 32; o >= 1; o >>= 1) v += __shfl_xor(v, o);
    return v;
}
__device__ __forceinline__ float sigmoidf_(float x) { return 1.0f / (1.0f + __expf(-x)); }
__device__ __forceinline__ int t5_bucket(int n) {
    if (n < 16) return n;
    int b = 16;
    b += (n >= 21); b += (n >= 27); b += (n >= 35); b += (n >= 46); b += (n >= 59); b += (n >= 77); b += (n >= 99); b += (n >= 128);
    b += (n >= 166); b += (n >= 216); b += (n >= 280); b += (n >= 363); b += (n >= 470); b += (n >= 609); b += (n >= 790);
    return b;
}

#define XB_TMO      128
#define XB_XCNT(j)  (256  + 64 * (j))
#define XB_XSUB(j)  (1280 + 64 * (j))
#define XB_XGEN(j)  (2304 + 64 * (j))
#define XB_TOP      3328
#define XB_TOPGEN   3392
#define XCD_BAR_WORDS 3456
#define XB_SPIN_CAP (1u << 22)
__device__ __forceinline__ unsigned xb_ld(unsigned* p)              { return __hip_atomic_load(p, __ATOMIC_RELAXED, __HIP_MEMORY_SCOPE_AGENT); }
__device__ __forceinline__ unsigned xb_add(unsigned* p, unsigned v) { return __hip_atomic_fetch_add(p, v, __ATOMIC_RELAXED, __HIP_MEMORY_SCOPE_AGENT); }
__device__ __forceinline__ unsigned xb_xcc_id() { return (unsigned)__builtin_amdgcn_s_getreg((3 << 11) | 20) & 0xFu; }
#define XB_SPIN(cond, bar) do { unsigned _sp = 0; while (cond) { __builtin_amdgcn_s_sleep(1); \
    if ((++_sp & 255u) == 0u) { if (xb_ld(&(bar)[XB_TMO])) break; if (_sp > XB_SPIN_CAP) { atomicAdd(&(bar)[XB_TMO], 1u); break; } } } } while (0)
struct XcdBarrier { unsigned* bar; unsigned x; volatile LAS unsigned* st; };
__device__ __forceinline__ XcdBarrier xcd_barrier_post(unsigned* bar, volatile LAS unsigned* st) {
    XcdBarrier b; b.bar = bar; b.x = xb_xcc_id(); b.st = st;
    if (threadIdx.x == 0) (void)xb_add(&bar[XB_XCNT(b.x)], 1u);
    return b;
}
__device__ __forceinline__ void xcd_barrier_complete(unsigned* bar, unsigned x, unsigned& nloc, unsigned& nx) {
    const unsigned G = gridDim.x * gridDim.y * gridDim.z;
    unsigned sum, cnt, mine, sp = 0u;
    for (;;) {
        sum = 0u; cnt = 0u; mine = 0u;
#pragma unroll
        for (unsigned j = 0; j < 16; ++j) { const unsigned c = xb_ld(&bar[XB_XCNT(j)]); sum += c; cnt += (c > 0u) ? 1u : 0u; mine = (j == x) ? c : mine; }
        if (sum == G) break;
        __builtin_amdgcn_s_sleep(1);
        if ((++sp & 255u) == 0u) { if (xb_ld(&bar[XB_TMO])) break; if (sp > XB_SPIN_CAP) { atomicAdd(&bar[XB_TMO], 1u); break; } }
    }
    nloc = mine > 0u ? mine : 1u; nx = cnt > 0u ? cnt : 1u;
}
__device__ __forceinline__ void xcd_barrier(const XcdBarrier& b) {
    asm volatile("s_waitcnt vmcnt(0)" ::: "memory");
    __syncthreads();
    if (threadIdx.x == 0) {
        unsigned* bar = b.bar;
        __builtin_amdgcn_s_waitcnt(0);
        unsigned nloc = b.st[0], nx = b.st[1];
        if (nloc == 0u) { xcd_barrier_complete(bar, b.x, nloc, nx); b.st[0] = nloc; b.st[1] = nx; }
        const unsigned old = xb_add(&bar[XB_XSUB(b.x)], 1u);
        const unsigned gen = old / nloc;
        if (old + 1u == (gen + 1u) * nloc) {
            __builtin_amdgcn_fence(__ATOMIC_RELEASE, "agent");
            asm volatile("s_waitcnt vmcnt(0)" ::: "memory");
            const unsigned og = xb_add(&bar[XB_TOP], 1u);
            const unsigned tg = og / nx;
            if (og + 1u == (tg + 1u) * nx) xb_add(&bar[XB_TOPGEN], 1u);
            else XB_SPIN(xb_ld(&bar[XB_TOPGEN]) == tg, bar);
            __builtin_amdgcn_fence(__ATOMIC_ACQUIRE, "agent");
            xb_add(&bar[XB_XGEN(b.x)], 1u);
            asm volatile("s_waitcnt vmcnt(0)" ::: "memory");
        } else {
            XB_SPIN(xb_ld(&bar[XB_XGEN(b.x)]) == gen, bar);
            __builtin_amdgcn_fence(__ATOMIC_ACQUIRE, "agent");
            asm volatile("s_waitcnt vmcnt(0)" ::: "memory");
        }
    }
    __syncthreads();
}

namespace pg8 {
constexpr int BM = 256, BK = 64, HALF = 128, HTB = HALF * BK * 2, STAGE_BYTES = 8 * HTB, NXCD = 8, WGM = 8;
__device__ __forceinline__ int lds_byte(int r, int c) { const int st = (r >> 4) * 2 + (c >> 5), rr = r & 15, cc = c & 31, ob = rr * 64 + cc * 2; return st * 1024 + (ob ^ (((ob >> 9) & 1) << 5)); }
__device__ __forceinline__ void stage_rc(int b, int& R, int& C) { const int st = b / 1024, sb = b % 1024, swz = sb ^ (((sb >> 9) & 1) << 5); R = (st >> 1) * 16 + swz / 64; C = (st & 1) * 32 + (swz % 64) / 2; }
__device__ __forceinline__ int perm32(int rho) { const int n = rho >> 4, i = rho & 15; return 8 * (i >> 2) + 4 * n + (i & 3); }

struct Unit { int pm, pn, sub; unsigned aoff, boff; };
struct Gemm { const bf16_t* A; const bf16_t* Bt; int lda, ldb, K; unsigned kstepA = 128; };
struct Sched {
    int nM, nN, nwg, G, c, nsub, mode = 0; unsigned a_row, a_sub, b_row, b_sub;
    __device__ __forceinline__ void init(int nM_, int nN_, int G_, int c_, int nsub_, unsigned a_row_, unsigned a_sub_, unsigned b_row_, unsigned b_sub_) {
        nM = nM_; nN = nN_; nwg = nM * nN; G = G_; c = c_; nsub = nsub_; a_row = a_row_; a_sub = a_sub_; b_row = b_row_; b_sub = b_sub_; }
    __device__ __forceinline__ bool next(int i, Unit& u) const {
        const int round = i / nsub; u.sub = i - round * nsub;
        const long L = (long)round * G + c; if (L >= nwg) return false;
        int wgid = (int)L; { const int q = nwg / NXCD, r = nwg % NXCD, xcd = wgid % NXCD, off = wgid / NXCD; wgid = (xcd < r ? xcd * (q + 1) : r * (q + 1) + (xcd - r) * q) + off; }
        const int nig = WGM * nN, gid = wgid / nig, fm = gid * WGM, gsz = (nM - fm) < WGM ? (nM - fm) : WGM;
        u.pm = fm + ((wgid % nig) % gsz); u.pn = (wgid % nig) / gsz;
        u.aoff = (unsigned)u.pm * a_row + (unsigned)u.sub * a_sub; u.boff = (unsigned)u.pn * b_row + (unsigned)u.sub * b_sub;
        if (mode == 1) { const int kv = u.pm >> 3, g = (u.pm >> 2) & 1, cp = u.pm & 3;
            u.aoff = (unsigned)(((size_t)cp * 256 * 16 * PLD + (kv ? PC_VC : PC_KC) + g * 64) * 2); u.boff = (unsigned)kv * (256u * 2048u * 2u); }
        if (mode == 2) { const int kv = u.pm >> 3; u.boff = (unsigned)kv * (256u * 256u * 2u); }
        return true;
    }
};

template <class Epi>
__device__ __forceinline__ void gemm_phase(LAS unsigned char* lds, const int tid, const Gemm g, const Sched& S, const Epi& E) {
    const int wid = __builtin_amdgcn_readfirstlane(tid >> 6), lane = tid & 63, wr = wid >> 2, wc = wid & 3, fr = lane & 15, fq = lane >> 4;
    const int K = g.K, nt = K / BK;
    unsigned voffA[2], voffB[2];
#pragma unroll
    for (int i = 0; i < 2; ++i) { int R, C; stage_rc(tid * 16 + i * 8192, R, C); const int Rb = Epi::PERM ? ((R & ~31) + perm32(R & 31)) : R;
        voffA[i] = (unsigned)(R * g.lda + C) * 2u; voffB[i] = (unsigned)(Rb * g.ldb + C) * 2u; }
    const size_t kstep = (size_t)(BK * 2), kstA = g.kstepA;
    const size_t hstepA = (size_t)HALF * g.lda * 2, hstepB = (size_t)HALF * g.ldb * 2;
    const unsigned ldsw = (unsigned)wid * 1024u;
    const int aoff = lds_byte(wr * 64 + fr, fq * 8), boff = lds_byte(wc * 32 + fr, fq * 8);
#define PG8_SA(b, h) (((b) * 2 + (h)) * HTB)
#define PG8_SB(b, h) ((4 + (b) * 2 + (h)) * HTB)
#define PG8_STAGE(bufoff, gbase, voff) do { _Pragma("unroll") for (int _i = 0; _i < 2; ++_i) \
        __builtin_amdgcn_global_load_lds((const unsigned*)((const char*)(gbase) + (voff)[_i]), (LAS unsigned*)(lds + (bufoff) + ldsw + _i * 8192), 16, 0, 0); } while (0)
#define PG8_LDA(dst, b, h) do { _Pragma("unroll") for (int m = 0; m < 4; ++m) _Pragma("unroll") for (int k = 0; k < 2; ++k) dst[m][k] = *(const LAS bf16x8*)(lds + PG8_SA(b, h) + aoff + m * 2048 + k * 1024); } while (0)
#define PG8_LDB(dst, b, h) do { _Pragma("unroll") for (int n = 0; n < 2; ++n) _Pragma("unroll") for (int k = 0; k < 2; ++k) dst[n][k] = *(const LAS bf16x8*)(lds + PG8_SB(b, h) + boff + n * 2048 + k * 1024); } while (0)
#define PG8_MMA(ai, bj, At, Bt) do { __builtin_amdgcn_s_setprio(1); _Pragma("unroll") for (int m = 0; m < 4; ++m) _Pragma("unroll") for (int n = 0; n < 2; ++n) _Pragma("unroll") for (int k = 0; k < 2; ++k) \
        acc[ai][bj][m][n] = __builtin_amdgcn_mfma_f32_16x16x32_bf16(Bt[n][k], At[m][k], acc[ai][bj][m][n], 0, 0, 0); __builtin_amdgcn_s_setprio(0); } while (0)
#define PG8_WAIT_V(n) asm volatile("s_waitcnt vmcnt(" #n ")" ::: "memory")
#define PG8_WAIT_L(n) asm volatile("s_waitcnt lgkmcnt(" #n ")" ::: "memory")
#define PG8_BAR __builtin_amdgcn_s_barrier()
#define PG8_SCHED __builtin_amdgcn_sched_barrier(0)
    Unit cur, nxt; int ui = 0;
    if (!S.next(0, cur)) return;
    f32x4 acc[2][2][4][2];
#pragma unroll
    for (int a = 0; a < 2; ++a)
#pragma unroll
        for (int b = 0; b < 2; ++b)
#pragma unroll
            for (int m = 0; m < 4; ++m)
#pragma unroll
                for (int n = 0; n < 2; ++n) acc[a][b][m][n] = (f32x4){0.f, 0.f, 0.f, 0.f};
    bf16x8 At[4][2], B0[2][2], B1[2][2];
    const char* cA = (const char*)g.A + cur.aoff; const char* cB = (const char*)g.Bt + cur.boff;
    PG8_STAGE(PG8_SB(0, 0), cB, voffB); PG8_STAGE(PG8_SA(0, 0), cA, voffA); PG8_STAGE(PG8_SB(0, 1), cB + hstepB, voffB); PG8_STAGE(PG8_SA(0, 1), cA + hstepA, voffA);
    if (wr == 1) PG8_BAR;
    PG8_WAIT_V(4); PG8_BAR;
    PG8_STAGE(PG8_SB(1, 0), cB + kstep, voffB); PG8_STAGE(PG8_SA(1, 0), cA + kstA, voffA); PG8_STAGE(PG8_SB(1, 1), cB + hstepB + kstep, voffB);
    PG8_WAIT_V(6); PG8_BAR;
    for (;;) {
        const bool has_next = S.next(ui + 1, nxt);
        const char* nA = has_next ? (const char*)g.A + nxt.aoff : cA; const char* nB = has_next ? (const char*)g.Bt + nxt.boff : cB;
        for (int t = 0; t < nt; t += 2) {
            const bool last = (t == nt - 2);
            const char* a1 = cA + (size_t)(t + 1) * kstA;
            const char* a2 = last ? nA : cA + (size_t)(t + 2) * kstA; const char* b2 = last ? nB : cB + (size_t)(t + 2) * kstep;
            const char* a3 = a2 + kstA; const char* b3 = b2 + kstep;
            PG8_LDB(B0, 0, 0); PG8_SCHED; PG8_LDA(At, 0, 0); PG8_STAGE(PG8_SA(1, 1), a1 + hstepA, voffA);
            PG8_WAIT_L(8); PG8_BAR; PG8_WAIT_L(0); PG8_MMA(0, 0, At, B0); PG8_BAR; PG8_SCHED;
            PG8_LDB(B1, 0, 1); PG8_STAGE(PG8_SB(0, 0), b2, voffB);
            PG8_BAR; PG8_WAIT_L(0); PG8_MMA(0, 1, At, B1); PG8_BAR;
            PG8_LDA(At, 0, 1); PG8_STAGE(PG8_SA(0, 0), a2, voffA);
            PG8_BAR; PG8_WAIT_L(0); PG8_MMA(1, 0, At, B0); PG8_BAR; PG8_SCHED;
            PG8_STAGE(PG8_SB(0, 1), b2 + hstepB, voffB);
            PG8_WAIT_V(6); PG8_BAR; PG8_MMA(1, 1, At, B1); PG8_BAR;
            PG8_LDB(B0, 1, 0); PG8_SCHED; PG8_LDA(At, 1, 0); PG8_STAGE(PG8_SA(0, 1), a2 + hstepA, voffA);
            PG8_WAIT_L(8); PG8_BAR; PG8_WAIT_L(0); PG8_MMA(0, 0, At, B0); PG8_BAR; PG8_SCHED;
            PG8_LDB(B1, 1, 1); PG8_STAGE(PG8_SB(1, 0), b3, voffB);
            PG8_BAR; PG8_WAIT_L(0); PG8_MMA(0, 1, At, B1); PG8_BAR;
            PG8_LDA(At, 1, 1); PG8_STAGE(PG8_SA(1, 0), a3, voffA);
            PG8_BAR; PG8_WAIT_L(0); PG8_MMA(1, 0, At, B0); PG8_BAR; PG8_SCHED;
            PG8_STAGE(PG8_SB(1, 1), b3 + hstepB, voffB);
            PG8_WAIT_V(6); PG8_BAR; PG8_MMA(1, 1, At, B1); PG8_BAR;
        }
        const bool keep = E(acc, cur, wr, wc, fr, fq);
        if (!has_next) break;
        if (!keep) {
#pragma unroll
            for (int a = 0; a < 2; ++a)
#pragma unroll
                for (int b = 0; b < 2; ++b)
#pragma unroll
                    for (int m = 0; m < 4; ++m)
#pragma unroll
                        for (int n = 0; n < 2; ++n) acc[a][b][m][n] = (f32x4){0.f, 0.f, 0.f, 0.f};
        }
        cur = nxt; cA = nA; cB = nB; ++ui;
    }
    PG8_WAIT_V(0);
    if (wr == 0) PG8_BAR;
    PG8_BAR;
#undef PG8_SA
#undef PG8_SB
#undef PG8_STAGE
#undef PG8_LDA
#undef PG8_LDB
#undef PG8_MMA
#undef PG8_WAIT_V
#undef PG8_WAIT_L
#undef PG8_BAR
#undef PG8_SCHED
}

struct EpiInProj {
    static constexpr bool PERM = true;
    bf16_t* proj; bf16_t* gates; const float* rs;
    __device__ __forceinline__ bool operator()(f32x4 (&acc)[2][2][4][2], const Unit& u, int wr, int wc, int fr, int fq) const {
        const int row0 = u.pm * BM + wr * 64 + fr; const bool is_gate = u.pn >= 16;
        bf16_t* base = is_gate ? gates + (u.pn - 16) * 256 : proj + u.pn * 256; const int ld = is_gate ? 3072 : PLD;
        const int col0 = wc * 32 + 8 * fq;
#pragma unroll
        for (int ai = 0; ai < 2; ++ai)
#pragma unroll
            for (int m = 0; m < 4; ++m) { const int row = row0 + ai * HALF + m * 16; const float s = rs[row]; bf16_t* rowp = base + (size_t)row * ld + col0;
#pragma unroll
                for (int bj = 0; bj < 2; ++bj) { f32x4 v0 = acc[ai][bj][m][0] * s, v1 = acc[ai][bj][m][1] * s;
                    if (is_gate) {
#pragma unroll
                        for (int j = 0; j < 4; ++j) { v0[j] = sigmoidf_(v0[j]); v1[j] = sigmoidf_(v1[j]); } }
                    u32x4 w; w.x = pk2(v0[0], v0[1]); w.y = pk2(v0[2], v0[3]); w.z = pk2(v1[0], v1[1]); w.w = pk2(v1[2], v1[3]);
                    *(u32x4*)(rowp + bj * HALF) = w; } }
        return false;
    }
};
struct EpiStore {
    static constexpr bool PERM = true;
    bf16_t* out; int ld;
    __device__ __forceinline__ bool operator()(f32x4 (&acc)[2][2][4][2], const Unit& u, int wr, int wc, int fr, int fq) const {
        const int row0 = u.pm * BM + wr * 64 + fr; const int col0 = u.pn * BM + wc * 32 + 8 * fq;
#pragma unroll
        for (int ai = 0; ai < 2; ++ai)
#pragma unroll
            for (int m = 0; m < 4; ++m) { bf16_t* rowp = out + (size_t)(row0 + ai * HALF + m * 16) * ld + col0;
#pragma unroll
                for (int bj = 0; bj < 2; ++bj) { const f32x4 v0 = acc[ai][bj][m][0], v1 = acc[ai][bj][m][1];
                    u32x4 w; w.x = pk2(v0[0], v0[1]); w.y = pk2(v0[2], v0[3]); w.z = pk2(v1[0], v1[1]); w.w = pk2(v1[2], v1[3]);
                    *(u32x4*)(rowp + bj * HALF) = w; } }
        return false;
    }
};
struct EpiCmp1 {
    static constexpr bool PERM = true;
    bf16_t* hid; const float* bh;
    __device__ __forceinline__ bool operator()(f32x4 (&acc)[2][2][4][2], const Unit& u, int wr, int wc, int fr, int fq) const {
        const int kv = u.pm >> 3; const int row0 = (u.pm & 7) * BM + wr * 64 + fr; const int col0 = wc * 32 + 8 * fq;
#pragma unroll
        for (int ai = 0; ai < 2; ++ai)
#pragma unroll
            for (int m = 0; m < 4; ++m) { bf16_t* rowp = hid + ((size_t)kv * 2048 + row0 + ai * HALF + m * 16) * 256 + col0;
#pragma unroll
                for (int bj = 0; bj < 2; ++bj) { float o[8];
#pragma unroll
                    for (int j = 0; j < 8; ++j) { const float x = acc[ai][bj][m][j >> 2][j & 3] + bh[kv * 256 + col0 + bj * HALF + j];
                        o[j] = x * sigmoidf_(1.5957691216f * (x + 0.044715f * x * x * x)); }
                    u32x4 w; w.x = pk2(o[0], o[1]); w.y = pk2(o[2], o[3]); w.z = pk2(o[4], o[5]); w.w = pk2(o[6], o[7]);
                    *(u32x4*)(rowp + bj * HALF) = w; } }
        return false;
    }
};
struct EpiCmp2 {
    static constexpr bool PERM = true;
    bf16_t* kcb; bf16_t* vct;
    __device__ __forceinline__ bool operator()(f32x4 (&acc)[2][2][4][2], const Unit& u, int wr, int wc, int fr, int fq) const {
        const int kv = u.pm >> 3; const int row0 = (u.pm & 7) * BM + wr * 64 + fr; const int col0 = wc * 32 + 8 * fq;
        if (col0 >= 64) return false;
#pragma unroll
        for (int ai = 0; ai < 2; ++ai)
#pragma unroll
            for (int m = 0; m < 4; ++m) { const int row = row0 + ai * HALF + m * 16, g = row >> 10, cc = row & 1023; const bool zr = cc == 1023; const f32x4 zz = (f32x4){0.f, 0.f, 0.f, 0.f};
                const f32x4 v0 = zr ? zz : acc[ai][0][m][0], v1 = zr ? zz : acc[ai][0][m][1];
                if (kv == 0) { u32x4 w; w.x = pk2(v0[0], v0[1]); w.y = pk2(v0[2], v0[3]); w.z = pk2(v1[0], v1[1]); w.w = pk2(v1[2], v1[3]); *(u32x4*)(kcb + ((size_t)g * 1024 + cc) * 64 + col0) = w; }
                else {
#pragma unroll
                    for (int j = 0; j < 4; ++j) { vct[((size_t)g * 64 + col0 + j) * 1024 + cc] = (bf16_t)f2bf(v0[j]); vct[((size_t)g * 64 + col0 + 4 + j) * 1024 + cc] = (bf16_t)f2bf(v1[j]); } } }
        return false;
    }
};
struct EpiLora {
    static constexpr bool PERM = true;
    bf16_t* obuf;
    __device__ __forceinline__ bool operator()(f32x4 (&acc)[2][2][4][2], const Unit& u, int wr, int wc, int fr, int fq) const {
        const int sel = u.pn >> 1; bf16_t* out = obuf + (size_t)(sel == 2 ? 0 : sel + 1) * T * 512;
        const int row0 = u.pm * BM + wr * 64 + fr; const int col0 = (u.pn & 1) * BM + wc * 32 + 8 * fq;
#pragma unroll
        for (int ai = 0; ai < 2; ++ai)
#pragma unroll
            for (int m = 0; m < 4; ++m) { bf16_t* rowp = out + (size_t)(row0 + ai * HALF + m * 16) * 512 + col0;
#pragma unroll
                for (int bj = 0; bj < 2; ++bj) { const f32x4 v0 = acc[ai][bj][m][0], v1 = acc[ai][bj][m][1];
                    u32x4 w; w.x = pk2(v0[0], v0[1]); w.y = pk2(v0[2], v0[3]); w.z = pk2(v1[0], v1[1]); w.w = pk2(v1[2], v1[3]);
                    *(u32x4*)(rowp + bj * HALF) = w; } }
        return false;
    }
};
struct EpiMerge {
    static constexpr bool PERM = true;
    const bf16_t* gates; bf16_t* merged;
    __device__ __forceinline__ bool operator()(f32x4 (&acc)[2][2][4][2], const Unit& u, int wr, int wc, int fr, int fq) const {
        const int row0 = u.pm * BM + wr * 64 + fr; const int col0 = u.pn * BM + wc * 32 + 8 * fq; const int sub = u.sub;
#pragma unroll
        for (int ai = 0; ai < 2; ++ai)
#pragma unroll
            for (int m = 0; m < 4; ++m) { const int row = row0 + ai * HALF + m * 16; const bf16_t* gp = gates + (size_t)row * 3072 + sub * 1024 + col0;
#pragma unroll
                for (int bj = 0; bj < 2; ++bj) {
                    float sc[8], sn[8]; unpack8(*(const u32x4*)(gp + bj * HALF), sc);
                    if (sub < 2) { unpack8(*(const u32x4*)(gp + 1024 + bj * HALF), sn);
#pragma unroll
                        for (int j = 0; j < 8; ++j) sc[j] = sc[j] / fmaxf(sn[j], 1e-30f); }
                    f32x4 v0 = acc[ai][bj][m][0], v1 = acc[ai][bj][m][1];
#pragma unroll
                    for (int j = 0; j < 4; ++j) { v0[j] *= sc[j]; v1[j] *= sc[4 + j]; }
                    acc[ai][bj][m][0] = v0; acc[ai][bj][m][1] = v1;
                    if (sub == 2) { u32x4 w; w.x = pk2(v0[0], v0[1]); w.y = pk2(v0[2], v0[3]); w.z = pk2(v1[0], v1[1]); w.w = pk2(v1[2], v1[3]);
                        *(u32x4*)(merged + (size_t)row * D + col0 + bj * HALF) = w; } } }
        return sub != 2;
    }
};
struct EpiSwiGLU {
    static constexpr bool PERM = true;
    bf16_t* act; const float* rs;
    __device__ __forceinline__ bool operator()(f32x4 (&acc)[2][2][4][2], const Unit& u, int wr, int wc, int fr, int fq) const {
        const int row0 = u.pm * BM + wr * 64 + fr; const int col0 = u.pn * HALF + wc * 32 + 8 * fq;
#pragma unroll
        for (int ai = 0; ai < 2; ++ai)
#pragma unroll
            for (int m = 0; m < 4; ++m) { const int row = row0 + ai * HALF + m * 16; const float s = rs[row];
                float o[8];
#pragma unroll
                for (int n = 0; n < 2; ++n)
#pragma unroll
                    for (int j = 0; j < 4; ++j) { const float gg = acc[ai][0][m][n][j] * s, uu = acc[ai][1][m][n][j] * s; o[n * 4 + j] = gg * sigmoidf_(gg) * uu; }
                u32x4 w; w.x = pk2(o[0], o[1]); w.y = pk2(o[2], o[3]); w.z = pk2(o[4], o[5]); w.w = pk2(o[6], o[7]);
                *(u32x4*)(act + (size_t)row * FFN + col0) = w; }
        return false;
    }
};
}

struct Args { const float* in[30]; float* out; unsigned char* ws; int lo, hi; };
enum { I_X = 0, I_NPM, I_NQM, I_NPF, I_NQF, I_WIN, I_MU, I_W0, I_W2, I_A0, I_A2, I_G2, I_KK, I_KA, I_RK, I_LNW, I_LNB, I_PEK, I_PEV, I_CKW1, I_CKW2, I_CVW1, I_CVW2, I_SINK, I_REL, I_WBR, I_WOUT, I_FG, I_FU, I_FD };

struct Ctx { LAS unsigned char* lds; int tid, lane, wave, G, bid; };
__device__ __forceinline__ const float* inptr(const Ctx& c, int i) {
    const volatile LAS unsigned* t = (const volatile LAS unsigned*)(c.lds + LDS_MISC + 64) + 2 * i;
    const unsigned lo = __builtin_amdgcn_readfirstlane(t[0]), hi = __builtin_amdgcn_readfirstlane(t[1]);
    return (const float*)(((unsigned long long)hi << 32) | lo);
}

__device__ __forceinline__ void phase_init(const Ctx& c, const float* x, float* xo, bf16_t* xb, float* rs) {
    const int gw = c.bid * 8 + c.wave, NGW = c.G * 8;
    for (int row = gw; row < MROWS; row += NGW) {
        const float* xr = x + (size_t)row * D; float ss = 0.f;
#pragma unroll
        for (int j = 0; j < 2; ++j) { const int e = c.lane * 8 + 512 * j; const f32x4 a = *(const f32x4*)(xr + e), b = *(const f32x4*)(xr + e + 4);
            ss += a[0] * a[0] + a[1] * a[1] + a[2] * a[2] + a[3] * a[3] + b[0] * b[0] + b[1] * b[1] + b[2] * b[2] + b[3] * b[3];
            *(f32x4*)(xo + (size_t)row * D + e) = a; *(f32x4*)(xo + (size_t)row * D + e + 4) = b;
            u32x4 w; w.x = pk2(a[0], a[1]); w.y = pk2(a[2], a[3]); w.z = pk2(b[0], b[1]); w.w = pk2(b[2], b[3]); *(u32x4*)(xb + (size_t)row * D + e) = w; }
        ss = wave_sum(ss);
        if (c.lane == 0) rs[row] = rsqrtf(ss * (1.0f / D) + NORM_EPS);
    }
}
__device__ __forceinline__ void phase_norm_res(const Ctx& c, const bf16_t* y, const float* gain, float* x, bf16_t* xb, float* rs, int row0, int nrows) {
    const int gw = c.bid * 8 + c.wave, NGW = c.G * 8;
    for (int r = gw; r < nrows; r += NGW) {
        const int row = row0 + r; float yv[16]; float ss = 0.f;
#pragma unroll
        for (int j = 0; j < 2; ++j) { float f[8]; unpack8(*(const u32x4*)(y + (size_t)r * D + c.lane * 8 + 512 * j), f);
#pragma unroll
            for (int k = 0; k < 8; ++k) { yv[j * 8 + k] = f[k]; ss += f[k] * f[k]; } }
        ss = wave_sum(ss); const float sc = rsqrtf(ss * (1.0f / D) + NORM_EPS); float s2 = 0.f;
#pragma unroll
        for (int j = 0; j < 2; ++j) { const int e = c.lane * 8 + 512 * j; float* xr = x + (size_t)row * D + e;
            f32x4 a = *(const f32x4*)xr, b = *(const f32x4*)(xr + 4); const f32x4 ga = *(const f32x4*)(gain + e), gb = *(const f32x4*)(gain + e + 4);
#pragma unroll
            for (int k = 0; k < 4; ++k) { a[k] += yv[j * 8 + k] * sc * ga[k]; b[k] += yv[j * 8 + 4 + k] * sc * gb[k]; s2 += a[k] * a[k] + b[k] * b[k]; }
            *(f32x4*)xr = a; *(f32x4*)(xr + 4) = b;
            u32x4 w; w.x = pk2(a[0], a[1]); w.y = pk2(a[2], a[3]); w.z = pk2(b[0], b[1]); w.w = pk2(b[2], b[3]); *(u32x4*)(xb + (size_t)row * D + e) = w; }
        s2 = wave_sum(s2);
        if (c.lane == 0) rs[row] = rsqrtf(s2 * (1.0f / D) + NORM_EPS);
    }
}

__device__ __forceinline__ float cvt_fetch(const Ctx& c, int layer, int kind, int sub, int k, int n) {
    switch (kind) {
    case 0: { int src; float sc = inptr(c, I_NPM)[layer * D + k];
        if (n < 3096) src = n; else if (n < 3328) return 0.f; else if (n < 4096) src = 3096 + (n - 3328); else src = 3864 + (n - 4096);
        if ((n >= PC_NQ && n < PC_NQ + 512) || (n >= PC_SQ && n < PC_SQ + 512)) sc *= 0.125f;
        return inptr(c, I_WIN)[((size_t)layer * D + k) * IN_COLS + src] * sc; }
    case 1: return inptr(c, I_WBR)[(((size_t)layer * 3 + sub) * 512 + k) * D + n];
    case 2: return inptr(c, I_WOUT)[((size_t)layer * D + k) * D + n];
    case 3: { const int pn = n >> 8, r = n & 255; const float sc = inptr(c, I_NPF)[layer * D + k];
        return (r < 128 ? inptr(c, I_FG)[((size_t)layer * D + k) * FFN + pn * 128 + r] : inptr(c, I_FU)[((size_t)layer * D + k) * FFN + pn * 128 + r - 128]) * sc; }
    case 4: return inptr(c, I_FD)[((size_t)layer * FFN + k) * D + n];
    case 6: return inptr(c, sub ? I_CVW1 : I_CKW1)[((size_t)layer * 2048 + k) * 256 + n];
    case 7: return n < 64 ? inptr(c, sub ? I_CVW2 : I_CKW2)[((size_t)layer * 256 + k) * 64 + n] : 0.f;
    default: {
        if (n < 512) return k < 64 ? inptr(c, I_W2)[((size_t)layer * 64 + k) * 512 + n] : 0.f;
        if (n < 1024) return (k >= 64 && k < 128) ? inptr(c, I_A2)[((size_t)layer * 64 + k - 64) * 512 + n - 512] : 0.f;
        return k >= 128 ? inptr(c, I_G2)[((size_t)layer * 128 + k - 128) * 512 + n - 1024] : 0.f; }
    }
}
__device__ __forceinline__ void phase_cvt(const Ctx& c, const Args& a, int layer, bf16_t* wb) {
    LAS float* tile = (LAS float*)c.lds;
    constexpr int I0 = 16 * 112, I1 = 3 * 8 * 16, I2 = 16 * 16, I3 = 16 * 88, I4 = 44 * 16, I5 = 4 * 24, I6 = 2 * 32 * 4, I7 = 2 * 4 * 4, NIT = I0 + I1 + I2 + I3 + I4 + I5 + I6 + I7;
    for (int it = c.bid; it < NIT; it += c.G) {
        int r = it, kind, sub = 0, K, nblk; bf16_t* dst;
        if (r < I0) { kind = 0; K = D; nblk = 112; dst = wb + WB_WIN; }
        else if ((r -= I0) < I1) { kind = 1; sub = r / 128; r -= sub * 128; K = 512; nblk = 16; dst = wb + WB_WBR + (size_t)sub * D * 512; }
        else if ((r -= I1) < I2) { kind = 2; K = D; nblk = 16; dst = wb + WB_WOUT; }
        else if ((r -= I2) < I3) { kind = 3; K = D; nblk = 88; dst = wb + WB_WGU; }
        else if ((r -= I3) < I4) { kind = 4; K = FFN; nblk = 16; dst = wb + WB_WDN; }
        else if ((r -= I4) < I5) { kind = 5; K = 256; nblk = 24; dst = wb + WB_LORA; }
        else if ((r -= I5) < I6) { kind = 6; sub = r / 128; r -= sub * 128; K = 2048; nblk = 4; dst = wb + WB_W1T + (size_t)sub * 256 * 2048; }
        else { r -= I6; kind = 7; sub = r / 16; r -= sub * 16; K = 256; nblk = 4; dst = wb + WB_W2T + (size_t)sub * 256 * 256; }
        const int kb = r / nblk, nb = r % nblk, k0 = kb * 64, n0 = nb * 64;
        for (int e = c.tid; e < 4096; e += 512) { const int kk = e >> 6, nn = e & 63; tile[kk * 65 + nn] = cvt_fetch(c, layer, kind, sub, k0 + kk, n0 + nn); }
        __syncthreads();
        for (int e = c.tid; e < 2048; e += 512) { const int nn = e >> 5, kp = (e & 31) * 2;
            *(unsigned*)(dst + (size_t)(n0 + nn) * K + k0 + kp) = pk2(tile[kp * 65 + nn], tile[(kp + 1) * 65 + nn]); }
        __syncthreads();
    }
    if (c.bid == c.G - 1) {
        const int kv = c.tid >> 8, u = c.tid & 255; const float* w1 = inptr(c, kv ? I_CVW1 : I_CKW1) + (size_t)layer * 2048 * 256; const float* pe = inptr(c, kv ? I_PEV : I_PEK) + (size_t)layer * 2048;
        float acc = 0.f; for (int k = 0; k < 2048; ++k) acc += pe[k] * w1[(size_t)k * 256 + u];
        ((float*)(wb + WB_BH))[c.tid] = acc;
    }
}

struct RowState { float q[64]; float o[64]; float m, l; };
__device__ __forceinline__ void row_init(RowState& s, const bf16_t* qp) {
#pragma unroll
    for (int i = 0; i < 8; ++i) { float f[8]; unpack8(*(const u32x4*)(qp + i * 8), f);
#pragma unroll
        for (int k = 0; k < 8; ++k) s.q[i * 8 + k] = f[k]; }
}
__device__ __forceinline__ void row_reset(RowState& s) {
#pragma unroll
    for (int i = 0; i < 64; ++i) s.o[i] = 0.f;
    s.m = -1e30f; s.l = 0.f;
}
__device__ __forceinline__ void row_key_bf16(RowState& s, const bf16_t* kp, const bf16_t* vp, float bias) {
    float sc = bias;
#pragma unroll
    for (int i = 0; i < 8; ++i) { float f[8]; unpack8(*(const u32x4*)(kp + i * 8), f);
#pragma unroll
        for (int k = 0; k < 8; ++k) sc += s.q[i * 8 + k] * f[k];
        if ((i & 1) == 1) __builtin_amdgcn_sched_barrier(0); }
    const float mn = fmaxf(s.m, sc), corr = __expf(s.m - mn), p = __expf(sc - mn);
    s.l = s.l * corr + p; s.m = mn;
#pragma unroll
    for (int i = 0; i < 8; ++i) { float f[8]; unpack8(*(const u32x4*)(vp + i * 8), f);
#pragma unroll
        for (int k = 0; k < 8; ++k) s.o[i * 8 + k] = s.o[i * 8 + k] * corr + p * f[k];
        if ((i & 1) == 1) __builtin_amdgcn_sched_barrier(0); }
}
__device__ __forceinline__ void row_key_f32(RowState& s, const float* kp, const float* vp, float bias) {
    float sc = bias;
#pragma unroll
    for (int i = 0; i < 16; ++i) { const f32x4 f = *(const f32x4*)(kp + i * 4); sc += s.q[i * 4] * f[0] + s.q[i * 4 + 1] * f[1] + s.q[i * 4 + 2] * f[2] + s.q[i * 4 + 3] * f[3];
        if ((i & 3) == 3) __builtin_amdgcn_sched_barrier(0); }
    const float mn = fmaxf(s.m, sc), corr = __expf(s.m - mn), p = __expf(sc - mn);
    s.l = s.l * corr + p; s.m = mn;
#pragma unroll
    for (int i = 0; i < 16; ++i) { const f32x4 f = *(const f32x4*)(vp + i * 4);
#pragma unroll
        for (int k = 0; k < 4; ++k) s.o[i * 4 + k] = s.o[i * 4 + k] * corr + p * f[k];
        if ((i & 3) == 3) __builtin_amdgcn_sched_barrier(0); }
}

__device__ __forceinline__ float gelu_tanh(float x) { const float t = tanhf(0.7978845608028654f * (x + 0.044715f * x * x * x)); return 0.5f * x * (1.0f + t); }
__device__ __forceinline__ void phase_cmp1(const Ctx& c, const Args& a, int layer, const bf16_t* proj, float* hid) {
    for (int unit = c.bid; unit < 2048; unit += c.G) {
        const int kv = unit >> 10, g = (unit >> 9) & 1, cp = unit & 511; const int cc = cp * 2 + (c.tid >> 8), u = c.tid & 255;
        if (cc >= NCMP) continue;
        const float* w1 = a.in[kv ? I_CVW1 : I_CKW1] + (size_t)layer * 2048 * 256; const float* pe = a.in[kv ? I_PEV : I_PEK] + (size_t)layer * 32 * 64;
        const bf16_t* xp = proj + (size_t)(16 * cc) * PLD + (kv ? PC_VC : PC_KC) + g * 64;
        float acc = 0.f;
        for (int l = 0; l < 32; ++l) {
#pragma unroll
            for (int i = 0; i < 8; ++i) { float f[8]; unpack8(*(const u32x4*)(xp + (size_t)l * PLD + i * 8), f);
#pragma unroll
                for (int k = 0; k < 8; ++k) acc += (f[k] + pe[l * 64 + i * 8 + k]) * w1[(size_t)(l * 64 + i * 8 + k) * 256 + u]; }
        }
        hid[(((size_t)kv * 2 + g) * 1024 + cc) * 256 + u] = gelu_tanh(acc);
    }
}
__device__ __forceinline__ void phase_cmp2(const Ctx& c, const Args& a, int layer, const float* hid, bf16_t* kcb, bf16_t* vctb) {
    for (int unit = c.bid; unit < 512; unit += c.G) {
        const int kv = unit >> 8, g = (unit >> 7) & 1, cc = (unit & 127) * 8 + (c.tid >> 6), d = c.tid & 63;
        float acc = 0.f;
        if (cc < NCMP) { const float* w2 = a.in[kv ? I_CVW2 : I_CKW2] + (size_t)layer * 256 * 64; const float* hp = hid + (((size_t)kv * 2 + g) * 1024 + cc) * 256;
            for (int u = 0; u < 256; ++u) acc += hp[u] * w2[u * 64 + d]; }
        if (kv) vctb[((size_t)g * 64 + d) * 1024 + cc] = (bf16_t)f2bf(acc); else kcb[((size_t)g * 1024 + cc) * 64 + d] = (bf16_t)f2bf(acc);
    }
}
__device__ __forceinline__ void phase_nsa13(const Ctx& c, const Args& a, const bf16_t* proj, const float* kcmp, const float* vcmp, float* nsaacc, float* ml) {
    LAS float* tb = (LAS float*)c.lds;
    for (int e = c.tid; e < 512; e += 512) tb[e] = inptr(c, I_REL)[e];
    __syncthreads();
    for (int unit = c.bid; unit < T / 64; unit += c.G) {
        const int hh = c.tid >> 6, t = unit * 64 + (c.tid & 63), g = hh >> 2;
        RowState s; row_init(s, proj + (size_t)t * PLD + PC_NQ + hh * 64);
        const bf16_t* glp = proj + (size_t)t * PLD + PC_GL;
        const float g0 = sigmoidf_(bf2f(glp[hh])), g2 = sigmoidf_(bf2f(glp[16 + hh]));
        row_reset(s);
        const int nv = t >= 31 ? (t - 31) / 16 + 1 : 0;
        for (int cc = 0; cc < nv; ++cc) { const float bias = tb[t5_bucket(t - 16 * cc - 31) * 16 + hh];
            row_key_f32(s, kcmp + ((size_t)g * 1024 + cc) * 64, vcmp + ((size_t)g * 1024 + cc) * 64, bias); }
        ml[((size_t)t * 8 + hh) * 2] = s.m; ml[((size_t)t * 8 + hh) * 2 + 1] = s.l;
        float* op = nsaacc + (size_t)t * 512 + hh * 64;
        { const float inv = s.l > 0.f ? g0 / s.l : 0.f;
#pragma unroll
            for (int i = 0; i < 16; ++i) { f32x4 w; w[0] = s.o[i * 4] * inv; w[1] = s.o[i * 4 + 1] * inv; w[2] = s.o[i * 4 + 2] * inv; w[3] = s.o[i * 4 + 3] * inv; *(f32x4*)(op + i * 4) = w; } }
        row_reset(s);
        const int s0 = t - 511 > 0 ? t - 511 : 0;
        for (int sp = s0; sp <= t; ++sp) { const float bias = tb[t5_bucket(t - sp) * 16 + hh];
            row_key_bf16(s, proj + (size_t)sp * PLD + PC_KW + g * 64, proj + (size_t)sp * PLD + PC_VW + g * 64, bias); }
        { const float inv = s.l > 0.f ? g2 / s.l : 0.f;
#pragma unroll
            for (int i = 0; i < 16; ++i) { f32x4 w = *(const f32x4*)(op + i * 4); w[0] += s.o[i * 4] * inv; w[1] += s.o[i * 4 + 1] * inv; w[2] += s.o[i * 4 + 2] * inv; w[3] += s.o[i * 4 + 3] * inv; *(f32x4*)(op + i * 4) = w; } }
    }
}
__device__ __forceinline__ void phase_nsa_topk(const Ctx& c, const Args& a, const bf16_t* proj, const float* kcmp, const float* ml, int* sel) {
    LAS float* tb = (LAS float*)c.lds;
    LAS float* qs = (LAS float*)(c.lds + 4096) + c.wave * 256;
    LAS float* sv = (LAS float*)(c.lds + 16384) + c.wave * 256;
    for (int e = c.tid; e < 512; e += 512) tb[e] = inptr(c, I_REL)[e];
    __syncthreads();
    const int gw = c.bid * 8 + c.wave, NGW = c.G * 8;
    for (int item = gw; item < T * 2; item += NGW) {
        const int t = item >> 1, g = item & 1, cur = t >> 6;
        { const bf16_t* qp = proj + (size_t)t * PLD + PC_NQ + g * 256 + c.lane * 4; const u32x2 w = *(const u32x2*)qp;
          qs[c.lane * 4] = __uint_as_float(w.x << 16); qs[c.lane * 4 + 1] = __uint_as_float(w.x & 0xffff0000u); qs[c.lane * 4 + 2] = __uint_as_float(w.y << 16); qs[c.lane * 4 + 3] = __uint_as_float(w.y & 0xffff0000u); }
        float mr[4], il[4];
#pragma unroll
        for (int r = 0; r < 4; ++r) { mr[r] = ml[((size_t)t * 8 + g * 4 + r) * 2]; const float l = ml[((size_t)t * 8 + g * 4 + r) * 2 + 1]; il[r] = l > 0.f ? 1.0f / l : 0.f; }
        const int nv = t >= 31 ? (t - 31) / 16 + 1 : 0;
        asm volatile("s_waitcnt lgkmcnt(0)" ::: "memory");
#pragma unroll 1
        for (int jj = 0; jj < 4; ++jj) {
            const int j = c.lane + 64 * jj; float sc;
            if (j == 0 || j == cur || j == cur - 1) sc = 1e4f;
            else if (j > cur) sc = -1.0f;
            else { sc = 0.f;
#pragma unroll 1
                for (int o = 0; o < 5; ++o) { const int cc = 4 * j + o - 1; if (cc < 0 || cc >= nv) continue;
                    const float* kp = kcmp + ((size_t)g * 1024 + cc) * 64; float d0 = 0.f, d1 = 0.f, d2 = 0.f, d3 = 0.f;
#pragma unroll 4
                    for (int i = 0; i < 16; ++i) { const f32x4 f = *(const f32x4*)(kp + i * 4);
#pragma unroll
                        for (int k = 0; k < 4; ++k) { d0 += qs[i * 4 + k] * f[k]; d1 += qs[64 + i * 4 + k] * f[k]; d2 += qs[128 + i * 4 + k] * f[k]; d3 += qs[192 + i * 4 + k] * f[k]; } }
                    const int bk = t5_bucket(t - 16 * cc - 31) * 16 + g * 4;
                    const float imp = __expf(d0 + tb[bk] - mr[0]) * il[0] + __expf(d1 + tb[bk + 1] - mr[1]) * il[1] + __expf(d2 + tb[bk + 2] - mr[2]) * il[2] + __expf(d3 + tb[bk + 3] - mr[3]) * il[3];
                    sc += ((o == 0 || o == 4) ? 1.0f : 2.0f) * imp; }
            }
            sv[j] = sc;
        }
        asm volatile("s_waitcnt lgkmcnt(0)" ::: "memory");
        float val[4];
#pragma unroll
        for (int jj = 0; jj < 4; ++jj) val[jj] = sv[c.lane + 64 * jj];
        for (int k = 0; k < 16; ++k) {
            float bv = val[0]; int bi = c.lane;
#pragma unroll
            for (int jj = 1; jj < 4; ++jj) if (val[jj] > bv) { bv = val[jj]; bi = c.lane + 64 * jj; }
#pragma unroll
            for (int o = 32; o >= 1; o >>= 1) { const float ov = __shfl_xor(bv, o); const int oi = __shfl_xor(bi, o); if (ov > bv || (ov == bv && oi < bi)) { bv = ov; bi = oi; } }
#pragma unroll
            for (int jj = 0; jj < 4; ++jj) if (bi == c.lane + 64 * jj) val[jj] = -3e38f;
            if (c.lane == 0) sel[(size_t)item * 16 + k] = bi;
        }
    }
}
__device__ __forceinline__ void phase_nsa2(const Ctx& c, const Args& a, const bf16_t* proj, const int* sel, const float* nsaacc, bf16_t* onsa) {
    LAS float* tb = (LAS float*)c.lds;
    for (int e = c.tid; e < 512; e += 512) tb[e] = inptr(c, I_REL)[e];
    __syncthreads();
    for (int unit = c.bid; unit < T / 64; unit += c.G) {
        const int hh = c.tid >> 6, t = unit * 64 + (c.tid & 63), g = hh >> 2;
        RowState s; row_init(s, proj + (size_t)t * PLD + PC_NQ + hh * 64); row_reset(s);
        const float g1 = sigmoidf_(bf2f(proj[(size_t)t * PLD + PC_GL + 8 + hh]));
        for (int k = 0; k < 16; ++k) { const int j = sel[((size_t)t * 2 + g) * 16 + k];
            for (int p = 0; p < 64; ++p) { const int pos = j * 64 + p; if (pos > t) break;
                const float bias = tb[t5_bucket(t - pos) * 16 + hh];
                row_key_bf16(s, proj + (size_t)pos * PLD + PC_KS + g * 64, proj + (size_t)pos * PLD + PC_VS + g * 64, bias); } }
        const float inv = s.l > 0.f ? g1 / s.l : 0.f; const float* ap = nsaacc + (size_t)t * 512 + hh * 64; bf16_t* op = onsa + (size_t)t * 512 + hh * 64;
#pragma unroll
        for (int i = 0; i < 8; ++i) { const f32x4 x0 = *(const f32x4*)(ap + i * 8), x1 = *(const f32x4*)(ap + i * 8 + 4); u32x4 w;
            w.x = pk2(x0[0] + s.o[i * 8] * inv, x0[1] + s.o[i * 8 + 1] * inv); w.y = pk2(x0[2] + s.o[i * 8 + 2] * inv, x0[3] + s.o[i * 8 + 3] * inv);
            w.z = pk2(x1[0] + s.o[i * 8 + 4] * inv, x1[1] + s.o[i * 8 + 5] * inv); w.w = pk2(x1[2] + s.o[i * 8 + 6] * inv, x1[3] + s.o[i * 8 + 7] * inv);
            *(u32x4*)(op + i * 8) = w; }
    }
}
__device__ __forceinline__ void phase_swa(const Ctx& c, const Args& a, int layer, const bf16_t* proj, bf16_t* oswa) {
    LAS float* tb = (LAS float*)c.lds;
    for (int e = c.tid; e < 512; e += 512) tb[e] = inptr(c, I_REL)[e];
    __syncthreads();
    for (int unit = c.bid; unit < T / 64; unit += c.G) {
        const int hh = c.tid >> 6, t = unit * 64 + (c.tid & 63), g = hh >> 2;
        RowState s; row_init(s, proj + (size_t)t * PLD + PC_SQ + hh * 64); row_reset(s);
        const int s0 = t - 127 > 0 ? t - 127 : 0;
        for (int sp = s0; sp <= t; ++sp) { const float bias = tb[t5_bucket(t - sp) * 16 + 8 + hh];
            row_key_bf16(s, proj + (size_t)sp * PLD + PC_SK + g * 64, proj + (size_t)sp * PLD + PC_SV + g * 64, bias); }
        const float sink = inptr(c, I_SINK)[layer * 8 + hh]; const float mf = fmaxf(s.m, sink); const float corr = __expf(s.m - mf);
        const float den = s.l * corr + __expf(sink - mf); const float inv = corr / den;
        bf16_t* op = oswa + (size_t)t * 512 + hh * 64;
#pragma unroll
        for (int i = 0; i < 8; ++i) { u32x4 w; w.x = pk2(s.o[i * 8] * inv, s.o[i * 8 + 1] * inv); w.y = pk2(s.o[i * 8 + 2] * inv, s.o[i * 8 + 3] * inv);
            w.z = pk2(s.o[i * 8 + 4] * inv, s.o[i * 8 + 5] * inv); w.w = pk2(s.o[i * 8 + 6] * inv, s.o[i * 8 + 7] * inv); *(u32x4*)(op + i * 8) = w; }
    }
}

constexpr int RL = 65;
__device__ __forceinline__ float rwkv_mixed(const bf16_t* proj, const float* mu, int t, int col) {
    const float cur = bf2f(proj[(size_t)t * PLD + col]); const float prev = t > 0 ? bf2f(proj[(size_t)(t - 1) * PLD + col]) : 0.f;
    return cur + (prev - cur) * mu[col];
}
__device__ __forceinline__ void lora64(const Ctx& c, const LAS float* in, const float* W, const float* bias, LAS float* out, bool accum) {
    const int j = c.tid & 63, tg = (c.tid >> 6) * 8;
    float acc[8];
#pragma unroll
    for (int i = 0; i < 8; ++i) acc[i] = accum ? out[(tg + i) * RL + j] : (bias ? bias[j] : 0.f);
#pragma unroll 4
    for (int m = 0; m < 64; ++m) { const float w = W[(size_t)m * 512 + j];
#pragma unroll
        for (int i = 0; i < 8; ++i) acc[i] += in[(tg + i) * RL + m] * w; }
#pragma unroll
    for (int i = 0; i < 8; ++i) out[(tg + i) * RL + j] = acc[i];
}
struct RwkvLds { LAS float *R, *K, *V, *A, *B, *W, *G, *TMP; };
__device__ __forceinline__ RwkvLds rwkv_lds(LAS unsigned char* lds) {
    RwkvLds s; LAS float* p = (LAS float*)lds; constexpr int SZ = 64 * RL;
    s.R = p; s.K = p + SZ; s.V = p + 2 * SZ; s.A = p + 3 * SZ; s.B = p + 4 * SZ; s.W = p + 5 * SZ; s.G = p + 6 * SZ; s.TMP = p + 7 * SZ; return s;
}
template <bool LOGDECAY>
__device__ __forceinline__ void rwkv_prep(const Ctx& c, const Args& a, int layer, const bf16_t* proj, int t0, int h, const RwkvLds& s) {
    const float* mu = inptr(c, I_MU) + (size_t)layer * 1792;
    const int j = c.tid & 63, tg = c.tid >> 6;
#pragma unroll 2
    for (int i = 0; i < 8; ++i) { const int tt = tg * 8 + i; s.TMP[tt * RL + j] = tanhf(rwkv_mixed(proj, mu, t0 + tt, PC_ZW + j)); }
    __syncthreads();
    lora64(c, s.TMP, inptr(c, I_W2) + (size_t)layer * 64 * 512 + h * 64, inptr(c, I_W0) + layer * 512 + h * 64, s.W, false);
    __syncthreads();
#pragma unroll 2
    for (int i = 0; i < 8; ++i) { const int tt = tg * 8 + i; s.TMP[tt * RL + j] = rwkv_mixed(proj, mu, t0 + tt, PC_ZA + j); }
    __syncthreads();
    lora64(c, s.TMP, inptr(c, I_A2) + (size_t)layer * 64 * 512 + h * 64, inptr(c, I_A0) + layer * 512 + h * 64, s.B, false);
    __syncthreads();
#pragma unroll 2
    for (int i = 0; i < 8; ++i) { const int tt = tg * 8 + i; s.TMP[tt * RL + j] = sigmoidf_(rwkv_mixed(proj, mu, t0 + tt, PC_ZG + j)); }
    __syncthreads();
    lora64(c, s.TMP, inptr(c, I_G2) + (size_t)layer * 128 * 512 + h * 64, nullptr, s.G, false);
    __syncthreads();
#pragma unroll 2
    for (int i = 0; i < 8; ++i) { const int tt = tg * 8 + i; s.TMP[tt * RL + j] = sigmoidf_(rwkv_mixed(proj, mu, t0 + tt, PC_ZG + 64 + j)); }
    __syncthreads();
    lora64(c, s.TMP, inptr(c, I_G2) + ((size_t)layer * 128 + 64) * 512 + h * 64, nullptr, s.G, true);
    const float kkw = inptr(c, I_KK)[layer * 512 + h * 64 + j], kaw = inptr(c, I_KA)[layer * 512 + h * 64 + j];
#pragma unroll 1
    for (int i = 0; i < 8; ++i) { const int tt = tg * 8 + i, t = t0 + tt;
        const float r = rwkv_mixed(proj, mu, t, PC_R + h * 64 + j), k = rwkv_mixed(proj, mu, t, PC_K + h * 64 + j), v = rwkv_mixed(proj, mu, t, PC_V + h * 64 + j);
        const float wl = s.W[tt * RL + j], al = sigmoidf_(s.B[tt * RL + j]);
        const float sp = (-wl > 20.f) ? -wl : log1pf(__expf(-wl)); const float w = -sp - 0.5f; const float ew = __expf(w);
        float kk = k * kkw; const float n2 = wave_sum(kk * kk); kk = kk / fmaxf(sqrtf(n2), 1e-12f);
        s.R[tt * RL + j] = r; s.V[tt * RL + j] = v; s.K[tt * RL + j] = k * (1.0f + (al - 1.0f) * kaw);
        s.A[tt * RL + j] = -kk; s.B[tt * RL + j] = kk * al; s.W[tt * RL + j] = LOGDECAY ? -ew : __expf(-ew); }
    __syncthreads();
}
__device__ __forceinline__ void rwkv_post(const Ctx& c, const Args& a, int layer, int t0, int h, const RwkvLds& s, const LAS float* Y, bf16_t* orwkv) {
    const int i = c.lane, tg = c.wave;
    const float lnw = inptr(c, I_LNW)[layer * 512 + h * 64 + i], lnb = inptr(c, I_LNB)[layer * 512 + h * 64 + i], rk = inptr(c, I_RK)[layer * 512 + h * 64 + i];
#pragma unroll 1
    for (int q = 0; q < 8; ++q) { const int tt = tg * 8 + q; const float y = Y[tt * RL + i];
        const float mean = wave_sum(y) * (1.0f / 64.0f); const float d = y - mean; const float var = wave_sum(d * d) * (1.0f / 64.0f);
        const float bonus = wave_sum(s.R[tt * RL + i] * s.K[tt * RL + i] * rk);
        const float o = (d * rsqrtf(var + 64e-5f) * lnw + lnb + bonus * s.V[tt * RL + i]) * s.G[tt * RL + i];
        orwkv[(size_t)(t0 + tt) * 512 + h * 64 + i] = (bf16_t)f2bf(o); }
}
__device__ __forceinline__ void phase_rwkv_naive(const Ctx& c, const Args& a, int layer, const bf16_t* proj, bf16_t* orwkv) {
    if (c.bid >= 8) return;
    const int h = c.bid; const RwkvLds s = rwkv_lds(c.lds);
    float S[64];
#pragma unroll
    for (int j = 0; j < 64; ++j) S[j] = 0.f;
    for (int ch = 0; ch < T / 64; ++ch) {
        rwkv_prep<false>(c, a, layer, proj, ch * 64, h, s);
        if (c.wave == 0) {
            const int i = c.lane;
            for (int tt = 0; tt < 64; ++tt) {
                float sa = 0.f;
#pragma unroll
                for (int j = 0; j < 64; ++j) { sa += S[j] * s.A[tt * RL + j]; if ((j & 7) == 7) __builtin_amdgcn_sched_barrier(0); }
                const float vi = s.V[tt * RL + i]; float y = 0.f;
#pragma unroll
                for (int j = 0; j < 64; ++j) { S[j] = S[j] * s.W[tt * RL + j] + sa * s.B[tt * RL + j] + vi * s.K[tt * RL + j]; y += S[j] * s.R[tt * RL + j]; if ((j & 3) == 3) __builtin_amdgcn_sched_barrier(0); }
                s.TMP[tt * RL + i] = y;
            }
        }
        __syncthreads();
        rwkv_post(c, a, layer, ch * 64, h, s, s.TMP, orwkv);
        __syncthreads();
    }
}


__device__ __forceinline__ int kperm32(int jl) { return 8 * ((jl >> 2) & 3) + 4 * (jl >> 4) + (jl & 3); }
__device__ __forceinline__ f32x4 tile_mma64(const LAS unsigned char* A, const LAS unsigned char* B, int a, int b, int lane, f32x4 acc) {
    const int m = lane & 15, q = lane >> 4;
#pragma unroll
    for (int ks = 0; ks < 2; ++ks) {
        const bf16x8 af = *(const LAS bf16x8*)(A + (16 * a + m) * 144 + (32 * ks + 8 * q) * 2);
        const bf16x8 bf = *(const LAS bf16x8*)(B + (16 * b + m) * 144 + (32 * ks + 8 * q) * 2);
        acc = __builtin_amdgcn_mfma_f32_16x16x32_bf16(af, bf, acc, 0, 0, 0);
    }
    return acc;
}
__device__ __forceinline__ void lds_st_bf16(LAS unsigned char* base, int idx, float v) { *(LAS bf16_t*)(base + idx * 2) = (bf16_t)f2bf(v); }

__device__ __forceinline__ void phase_lora_a(const Ctx& c, const Args& a, int layer, const bf16_t* proj, bf16_t* alora) {
    const float* mu = inptr(c, I_MU) + (size_t)layer * 1792;
    const int sub = c.tid & 31, rloc = c.tid >> 5;
    for (int t = c.bid * 16 + rloc; t < T; t += c.G * 16) {
        const int col = PC_ZW + sub * 8; float cur[8], prv[8];
        unpack8(*(const u32x4*)(proj + (size_t)t * PLD + col), cur);
        if (t > 0) unpack8(*(const u32x4*)(proj + (size_t)(t - 1) * PLD + col), prv); else {
#pragma unroll
            for (int k = 0; k < 8; ++k) prv[k] = 0.f; }
        float o[8];
#pragma unroll
        for (int k = 0; k < 8; ++k) { const float v = cur[k] + (prv[k] - cur[k]) * mu[col + k]; o[k] = sub < 8 ? tanhf(v) : (sub < 16 ? v : sigmoidf_(v)); }
        u32x4 w; w.x = pk2(o[0], o[1]); w.y = pk2(o[2], o[3]); w.z = pk2(o[4], o[5]); w.w = pk2(o[6], o[7]);
        *(u32x4*)(alora + (size_t)t * 256 + sub * 8) = w;
    }
}

constexpr int RC_L = 0, RC_AL = 16640, RC_AAK = 0, RC_ARB = 9216, RC_ARK = 18432, RC_AAB = 33280, RC_P2T = 33280, RC_WC = 50688, RC_BS = 50944, RC_M = 52992;
constexpr int RC_AT = RC_M, RC_TINV = RC_M, RC_ATT = RC_M + 9216, RC_RT = RC_M + 2 * 9216, RC_BT = RC_M + 3 * 9216, RC_XT = RC_BT, RC_KT = RC_M + 4 * 9216, RC_P1T = RC_KT,
              RC_VT = RC_M + 5 * 9216, RC_BHT = RC_M + 6 * 9216, RC_KHT = RC_M + 7 * 9216;
static_assert(RC_M + 8 * 9216 <= LDS_MISC, "rwkv chunk LDS");

__device__ __forceinline__ void phase_rwkv_chunk(const Ctx& c, const Args& a, int layer, const bf16_t* proj, const bf16_t* wlb, const bf16_t* alb, bf16_t* rwu, float* bonusg) {
    LAS unsigned char* L = c.lds;
    LAS float* sL = (LAS float*)(L + RC_L); LAS float* sAL = (LAS float*)(L + RC_AL); LAS float* sAAB = (LAS float*)(L + RC_AAB);
    LAS float* sWC = (LAS float*)(L + RC_WC); LAS float* sBS = (LAS float*)(L + RC_BS);
    const float* mu = inptr(c, I_MU) + (size_t)layer * 1792;
    const int lane = c.lane, wave = c.wave, n = lane & 15, q = lane >> 4;
    for (int unit = c.bid; unit < 2048; unit += c.G) {
        const int ch = unit >> 3, h = unit & 7, t0 = ch * 64, j = lane;
        {
            const float w0 = inptr(c, I_W0)[layer * 512 + h * 64 + j], a0 = inptr(c, I_A0)[layer * 512 + h * 64 + j];
            float run = 0.f;
#pragma unroll 2
            for (int i = 0; i < 8; ++i) { const int tt = wave * 8 + i; const size_t gi = (size_t)(t0 + tt) * 512 + h * 64 + j;
                const float wl = w0 + bf2f(wlb[gi]); const float nx = -wl; const float sp = nx > 20.f ? nx : log1pf(__expf(nx)); const float ld = -__expf(-sp - 0.5f);
                run += ld; sL[tt * RL + j] = run; sAL[tt * RL + j] = sigmoidf_(a0 + bf2f(alb[gi])); }
            sBS[wave * 64 + j] = run;
        }
        __syncthreads();
        {
            float off = 0.f, tot = 0.f;
#pragma unroll
            for (int w2 = 0; w2 < 8; ++w2) { const float v = sBS[w2 * 64 + j]; tot += v; off += (w2 < wave) ? v : 0.f; }
            if (wave == 0) sWC[j] = __expf(tot);
            const float kkw = inptr(c, I_KK)[layer * 512 + h * 64 + j], kaw = inptr(c, I_KA)[layer * 512 + h * 64 + j], rk = inptr(c, I_RK)[layer * 512 + h * 64 + j];
            float Lprev = off;
#pragma unroll 1
            for (int i = 0; i < 8; ++i) { const int tt = wave * 8 + i, t = t0 + tt;
                const float Lc = sL[tt * RL + j] + off, al = sAL[tt * RL + j];
                const float r = rwkv_mixed(proj, mu, t, PC_R + h * 64 + j), k = rwkv_mixed(proj, mu, t, PC_K + h * 64 + j), v = rwkv_mixed(proj, mu, t, PC_V + h * 64 + j);
                float kk = k * kkw; const float n2 = wave_sum(kk * kk); kk = kk / fmaxf(sqrtf(n2), 1e-12f);
                const float kp = k * (1.0f + (al - 1.0f) * kaw), av = -kk, bv = kk * al;
                const float eW = __expf(Lc), eWex = __expf(Lprev), eInv = __expf(-Lc), eC = __expf(tot - Lc);
                lds_st_bf16(L + RC_AT, tt * 72 + j, av * eWex); lds_st_bf16(L + RC_ATT, j * 72 + tt, av * eWex);
                lds_st_bf16(L + RC_RT, tt * 72 + j, r * eW); lds_st_bf16(L + RC_BT, tt * 72 + j, bv * eInv); lds_st_bf16(L + RC_KT, tt * 72 + j, kp * eInv);
                lds_st_bf16(L + RC_VT, j * 72 + tt, v); lds_st_bf16(L + RC_BHT, j * 72 + tt, bv * eC); lds_st_bf16(L + RC_KHT, j * 72 + tt, kp * eC);
                const float bon = wave_sum(r * kp * rk); if (lane == 0) bonusg[(size_t)t * 8 + h] = bon;
                Lprev = Lc; }
        }
        __syncthreads();
        for (int job = wave; job < 64; job += 8) {
            const int p = job >> 4, ta = (job >> 2) & 3, tb = job & 3;
            f32x4 acc = (f32x4){0.f, 0.f, 0.f, 0.f};
            if (ta >= tb) acc = tile_mma64(L + (p < 2 ? RC_AT : RC_RT), L + ((p & 1) ? RC_KT : RC_BT), ta, tb, lane, acc);
            LAS unsigned char* dst = L + (p == 1 ? RC_AAK : (p == 2 ? RC_ARB : RC_ARK));
#pragma unroll
            for (int r = 0; r < 4; ++r) { const int tt = 16 * ta + 4 * q + r, ss = 16 * tb + n; const bool keep = (p < 2) ? (ss < tt) : (ss <= tt); const float v = keep ? acc[r] : 0.f;
                if (p == 0) sAAB[tt * 68 + ss] = v; else lds_st_bf16(dst, tt * 72 + ss, v); }
        }
        __syncthreads();
        if (wave == 0) {
            float X[64];
#pragma unroll
            for (int tt = 0; tt < 64; ++tt) { float acc = (tt == lane) ? 1.f : 0.f;
#pragma unroll
                for (int ss = 0; ss < tt; ++ss) acc += sAAB[tt * 68 + ss] * X[ss];
                X[tt] = acc; lds_st_bf16(L + RC_TINV, tt * 72 + lane, acc); }
        } else {
            for (int job = wave - 1; job < 16; job += 7) { const int ta = job >> 2, tb = job & 3;
                const f32x4 acc = tile_mma64(L + RC_VT, L + RC_AAK, ta, tb, lane, (f32x4){0.f, 0.f, 0.f, 0.f});
#pragma unroll
                for (int r = 0; r < 4; ++r) lds_st_bf16(L + RC_XT, (16 * ta + 4 * q + r) * 72 + 16 * tb + n, acc[r]); }
        }
        __syncthreads();
        for (int job = wave; job < 32; job += 8) { const int p = job >> 4, ta = (job >> 2) & 3, tb = job & 3;
            const f32x4 acc = tile_mma64(L + (p ? RC_XT : RC_ATT), L + RC_TINV, ta, tb, lane, (f32x4){0.f, 0.f, 0.f, 0.f});
#pragma unroll
            for (int r = 0; r < 4; ++r) lds_st_bf16(L + (p ? RC_P2T : RC_P1T), (16 * ta + 4 * q + r) * 72 + 16 * tb + n, acc[r]); }
        __syncthreads();
        bf16_t* ug = rwu + (size_t)unit * 16384;
        for (int job = wave; job < 64; job += 8) { const int p = job >> 4, ta = (job >> 2) & 3, tb = job & 3;
            f32x4 acc = (f32x4){0.f, 0.f, 0.f, 0.f};
            if (p == 0) { acc = tile_mma64(L + RC_ARB, L + RC_P1T, ta, tb, lane, acc);
#pragma unroll
                for (int r = 0; r < 4; ++r) { const int tt = 16 * ta + 4 * q + r, jj = 16 * tb + n; const float v = acc[r] + bf2f(*(const LAS bf16_t*)(L + RC_RT + (tt * 72 + jj) * 2));
                    ug[8192 + tt * 64 + (jj & 32) + kperm32(jj & 31)] = (bf16_t)f2bf(v); } }
            else if (p == 1) { acc = tile_mma64(L + RC_ARB, L + RC_P2T, ta, tb, lane, acc); acc = tile_mma64(L + RC_ARK, L + RC_VT, ta, tb, lane, acc);
                u32x2 w; w.x = pk2(acc[0], acc[1]); w.y = pk2(acc[2], acc[3]); *(u32x2*)(ug + 12288 + ((tb * 4 + ta) * 64 + lane) * 4) = w; }
            else if (p == 2) { acc = tile_mma64(L + RC_BHT, L + RC_P1T, ta, tb, lane, acc);
#pragma unroll
                for (int r = 0; r < 4; ++r) { const int jr = 16 * ta + 4 * q + r, jc = 16 * tb + n; const float v = acc[r] + (jr == jc ? sWC[jr] : 0.f);
                    ug[jr * 64 + (jc & 32) + kperm32(jc & 31)] = (bf16_t)f2bf(v); } }
            else { acc = tile_mma64(L + RC_BHT, L + RC_P2T, ta, tb, lane, acc); acc = tile_mma64(L + RC_KHT, L + RC_VT, ta, tb, lane, acc);
                u32x2 w; w.x = pk2(acc[0], acc[1]); w.y = pk2(acc[2], acc[3]); *(u32x2*)(ug + 4096 + ((tb * 4 + ta) * 64 + lane) * 4) = w; }
        }
        __syncthreads();
    }
}

__device__ __forceinline__ void phase_rwkv_scan(const Ctx& c, const bf16_t* rwu, bf16_t* rws) {
    const int idx = c.bid * 8 + c.wave; if (idx >= 32) return;
    const int h = idx >> 2, cq = idx & 3, lane = c.lane, m = lane & 15, q = lane >> 4;
    bf16x8 Bhi[2], Blo[2];
#pragma unroll
    for (int s = 0; s < 2; ++s) { Bhi[s] = (bf16x8){0, 0, 0, 0, 0, 0, 0, 0}; Blo[s] = Bhi[s]; }
    bf16x8 An[4][2]; u32x2 Zn[4];
    { const bf16_t* ug = rwu + (size_t)h * 16384;
#pragma unroll
      for (int ta = 0; ta < 4; ++ta) { An[ta][0] = *(const bf16x8*)(ug + (16 * ta + m) * 64 + 8 * q); An[ta][1] = *(const bf16x8*)(ug + (16 * ta + m) * 64 + 32 + 8 * q);
          Zn[ta] = *(const u32x2*)(ug + 4096 + ((cq * 4 + ta) * 64 + lane) * 4); } }
    for (int ch = 0; ch < T / 64; ++ch) {
        const int unit = ch * 8 + h;
        bf16x8 Ac[4][2]; u32x2 Zc[4];
#pragma unroll
        for (int ta = 0; ta < 4; ++ta) { Ac[ta][0] = An[ta][0]; Ac[ta][1] = An[ta][1]; Zc[ta] = Zn[ta]; }
        if (ch + 1 < T / 64) { const bf16_t* ug = rwu + (size_t)(unit + 8) * 16384;
#pragma unroll
            for (int ta = 0; ta < 4; ++ta) { An[ta][0] = *(const bf16x8*)(ug + (16 * ta + m) * 64 + 8 * q); An[ta][1] = *(const bf16x8*)(ug + (16 * ta + m) * 64 + 32 + 8 * q);
                Zn[ta] = *(const u32x2*)(ug + 4096 + ((cq * 4 + ta) * 64 + lane) * 4); } }
        bf16_t* sg = rws + (size_t)unit * 4096 + cq * 1024 + lane * 8;
        *(bf16x8*)(sg) = Bhi[0]; *(bf16x8*)(sg + 512) = Bhi[1];
        f32x4 acc[4];
#pragma unroll
        for (int ta = 0; ta < 4; ++ta) { acc[ta] = (f32x4){__uint_as_float(Zc[ta].x << 16), __uint_as_float(Zc[ta].x & 0xffff0000u), __uint_as_float(Zc[ta].y << 16), __uint_as_float(Zc[ta].y & 0xffff0000u)};
#pragma unroll
            for (int s = 0; s < 2; ++s) { acc[ta] = __builtin_amdgcn_mfma_f32_16x16x32_bf16(Ac[ta][s], Bhi[s], acc[ta], 0, 0, 0); acc[ta] = __builtin_amdgcn_mfma_f32_16x16x32_bf16(Ac[ta][s], Blo[s], acc[ta], 0, 0, 0); } }
#pragma unroll
        for (int s = 0; s < 2; ++s) { u32x4 hi, lo; float rem[8];
#pragma unroll
            for (int p = 0; p < 8; ++p) { const float v = acc[2 * s + (p >> 2)][p & 3]; const unsigned hb = f2bf(v); rem[p] = v - __uint_as_float(hb << 16); }
            hi.x = pk2(acc[2 * s][0], acc[2 * s][1]); hi.y = pk2(acc[2 * s][2], acc[2 * s][3]); hi.z = pk2(acc[2 * s + 1][0], acc[2 * s + 1][1]); hi.w = pk2(acc[2 * s + 1][2], acc[2 * s + 1][3]);
            lo.x = pk2(rem[0], rem[1]); lo.y = pk2(rem[2], rem[3]); lo.z = pk2(rem[4], rem[5]); lo.w = pk2(rem[6], rem[7]);
            Bhi[s] = __builtin_bit_cast(bf16x8, hi); Blo[s] = __builtin_bit_cast(bf16x8, lo); }
    }
}

__device__ __forceinline__ void phase_rwkv_out(const Ctx& c, const Args& a, int layer, const bf16_t* proj, const bf16_t* rwu, const bf16_t* rws, const float* bonusg, bf16_t* orwkv) {
    const float* mu = inptr(c, I_MU) + (size_t)layer * 1792;
    const int lane = c.lane, m = lane & 15, q = lane >> 4;
    for (int unit = c.bid * 8 + c.wave; unit < 2048; unit += c.G * 8) {
        const int ch = unit >> 3, h = unit & 7, t0 = ch * 64; const bf16_t* ug = rwu + (size_t)unit * 16384; const bf16_t* sg = rws + (size_t)unit * 4096;
        bf16x8 Bf[4][2];
#pragma unroll
        for (int cq = 0; cq < 4; ++cq) { Bf[cq][0] = *(const bf16x8*)(sg + cq * 1024 + lane * 8); Bf[cq][1] = *(const bf16x8*)(sg + cq * 1024 + 512 + lane * 8); }
        float lnw[4], lnb[4];
#pragma unroll
        for (int cq = 0; cq < 4; ++cq) { lnw[cq] = inptr(c, I_LNW)[layer * 512 + h * 64 + 16 * cq + m]; lnb[cq] = inptr(c, I_LNB)[layer * 512 + h * 64 + 16 * cq + m]; }
#pragma unroll 1
        for (int ta = 0; ta < 4; ++ta) {
            const bf16x8 A0 = *(const bf16x8*)(ug + 8192 + (16 * ta + m) * 64 + 8 * q), A1 = *(const bf16x8*)(ug + 8192 + (16 * ta + m) * 64 + 32 + 8 * q);
            f32x4 y[4];
#pragma unroll
            for (int cq = 0; cq < 4; ++cq) { const u32x2 z = *(const u32x2*)(ug + 12288 + ((cq * 4 + ta) * 64 + lane) * 4);
                y[cq] = (f32x4){__uint_as_float(z.x << 16), __uint_as_float(z.x & 0xffff0000u), __uint_as_float(z.y << 16), __uint_as_float(z.y & 0xffff0000u)};
                y[cq] = __builtin_amdgcn_mfma_f32_16x16x32_bf16(A0, Bf[cq][0], y[cq], 0, 0, 0); y[cq] = __builtin_amdgcn_mfma_f32_16x16x32_bf16(A1, Bf[cq][1], y[cq], 0, 0, 0); }
#pragma unroll
            for (int r = 0; r < 4; ++r) { const int t = t0 + 16 * ta + 4 * q + r;
                float sm = y[0][r] + y[1][r] + y[2][r] + y[3][r];
                sm += __shfl_xor(sm, 1); sm += __shfl_xor(sm, 2); sm += __shfl_xor(sm, 4); sm += __shfl_xor(sm, 8);
                const float mean = sm * (1.0f / 64.0f); float d[4], vs = 0.f;
#pragma unroll
                for (int cq = 0; cq < 4; ++cq) { d[cq] = y[cq][r] - mean; vs += d[cq] * d[cq]; }
                vs += __shfl_xor(vs, 1); vs += __shfl_xor(vs, 2); vs += __shfl_xor(vs, 4); vs += __shfl_xor(vs, 8);
                const float rstd = rsqrtf(vs * (1.0f / 64.0f) + 64e-5f); const float bon = bonusg[(size_t)t * 8 + h];
#pragma unroll
                for (int cq = 0; cq < 4; ++cq) { const int col = h * 64 + 16 * cq + m; const float v = rwkv_mixed(proj, mu, t, PC_V + col);
                    bf16_t* op = orwkv + (size_t)t * 512 + col; const float g = bf2f(*op);
                    *op = (bf16_t)f2bf((d[cq] * rstd * lnw[cq] + lnb[cq] + bon * v) * g); } }
        }
    }
}


constexpr int AT_K = 0, AT_V = 9216, AT_BIAS = 18432, AT_SELM = 34816, AT_LIST = 38912, AT_NLIST = 39936, AT_NEED = 39968;
__device__ __forceinline__ void vt_transpose(const Ctx& c, const bf16_t* proj, bf16_t* vt) {
    LAS bf16_t* tl = (LAS bf16_t*)c.lds;
    for (int it = c.bid; it < 3 * 2 * 256; it += c.G) {
        const int which = it / 512, g = (it >> 8) & 1, tt = it & 255;
        const int col = (which == 0 ? PC_VS : (which == 1 ? PC_VW : PC_SV)) + g * 64;
        { const int tok = c.tid >> 3, ch = c.tid & 7; const u32x4 w = *(const u32x4*)(proj + (size_t)(tt * 64 + tok) * PLD + col + ch * 8);
          *(LAS u32x4*)(tl + tok * 72 + ch * 8) = w; }
        __syncthreads();
        { const int d = c.tid >> 3, ch = c.tid & 7; unsigned short e[8];
#pragma unroll
          for (int k = 0; k < 8; ++k) e[k] = tl[(ch * 8 + k) * 72 + d];
          u32x4 w; w.x = e[0] | ((unsigned)e[1] << 16); w.y = e[2] | ((unsigned)e[3] << 16); w.z = e[4] | ((unsigned)e[5] << 16); w.w = e[6] | ((unsigned)e[7] << 16);
          *(u32x4*)(vt + ((size_t)(which * 2 + g) * 64 + d) * T + tt * 64 + ch * 8) = w; }
        __syncthreads();
    }
}

template <int MODE, int NQ>
__device__ __forceinline__ void phase_attn(const Ctx& c, const Args& a, int layer, const bf16_t* proj, const bf16_t* vtb, const bf16_t* kcb, const bf16_t* vctb,
                                           const int* sel, float* nsaacc, float* scores, bf16_t* oout) {
    LAS unsigned char* L = c.lds;
    LAS float* biasd = (LAS float*)(L + AT_BIAS);
    LAS unsigned* selm = (LAS unsigned*)(L + AT_SELM);
    LAS int* list = (LAS int*)(L + AT_LIST);
    LAS int* nlist = (LAS int*)(L + AT_NLIST);
    LAS unsigned* need = (LAS unsigned*)(L + AT_NEED);
    const int lane = c.lane, wave = c.wave, n = lane & 15, q = lane >> 4, hr = n & 3;
    constexpr int TW = 4 * NQ, TB = 8 * TW, NU = T / TB;
    for (int unit = c.bid; unit < 2 * NU; unit += c.G) {
        const int g = unit / NU, t0 = (unit % NU) * TB, tw0 = t0 + wave * TW;
        __syncthreads();
        for (int e = c.tid; e < 4096; e += 512) { const int r = e >> 10, d = e & 1023; biasd[e] = inptr(c, I_REL)[t5_bucket(d) * 16 + (MODE == 0 ? 8 : 0) + g * 4 + r]; }
        if (MODE == 3) {
            for (int e = c.tid; e < 1024; e += 512) selm[e] = 0u;
            if (c.tid < 8) need[c.tid] = 0u;
            __syncthreads();
            if ((c.tid >> 2) < TB) { const int tok = c.tid >> 2, k4 = (c.tid & 3) * 4; const int* sp = sel + ((size_t)(t0 + tok) * 2 + g) * 16 + k4;
#pragma unroll
              for (int k = 0; k < 4; ++k) { const int j = sp[k]; atomicOr((unsigned*)&selm[tok * 8 + (j >> 5)], 1u << (j & 31)); atomicOr((unsigned*)&need[j >> 5], 1u << (j & 31)); } }
            __syncthreads();
            if (c.tid < 256) { const int j = c.tid; const unsigned wd = need[j >> 5];
                if ((wd >> (j & 31)) & 1u) { int pos = __popc(wd & ((1u << (j & 31)) - 1u)); for (int w2 = 0; w2 < (j >> 5); ++w2) pos += __popc(need[w2]); list[pos] = j; } }
            if (c.tid == 0) { int cnt = 0; for (int w2 = 0; w2 < 8; ++w2) cnt += __popc(need[w2]); nlist[0] = cnt; }
        }
        __syncthreads();
        int ntiles, tile_lo = 0;
        if (MODE == 0) { ntiles = 2 + TB / 64; tile_lo = t0 - 128; }
        else if (MODE == 1) { ntiles = 8 + TB / 64; tile_lo = t0 - 512; }
        else if (MODE == 2) { const int cmax = (t0 + TB - 1 - 31) >> 4; ntiles = cmax < 0 ? 0 : (cmax >> 6) + 1; }
        else ntiles = nlist[0];
        const bf16_t* Ksrc; size_t kstride; const bf16_t* Vsrc; size_t vstride; int qcol;
        if (MODE == 0) { Ksrc = proj + PC_SK + g * 64; kstride = PLD; Vsrc = vtb + (size_t)(4 + g) * 64 * T; vstride = T; qcol = PC_SQ + g * 256; }
        else if (MODE == 1) { Ksrc = proj + PC_KW + g * 64; kstride = PLD; Vsrc = vtb + (size_t)(2 + g) * 64 * T; vstride = T; qcol = PC_NQ + g * 256; }
        else if (MODE == 2) { Ksrc = kcb + (size_t)g * 1024 * 64; kstride = 64; Vsrc = vctb + (size_t)g * 64 * 1024; vstride = 1024; qcol = PC_NQ + g * 256; }
        else { Ksrc = proj + PC_KS + g * 64; kstride = PLD; Vsrc = vtb + (size_t)(0 + g) * 64 * T; vstride = T; qcol = PC_NQ + g * 256; }
        bf16x8 Bq[NQ][2];
#pragma unroll
        for (int qd = 0; qd < NQ; ++qd) { const bf16_t* qp = proj + (size_t)(tw0 + 4 * qd + (n >> 2)) * PLD + qcol + hr * 64 + 8 * q;
            Bq[qd][0] = *(const bf16x8*)qp; Bq[qd][1] = *(const bf16x8*)(qp + 32); }
        float mrun[NQ], lrun[NQ]; f32x4 O[NQ][4];
#pragma unroll
        for (int qd = 0; qd < NQ; ++qd) { mrun[qd] = -1e30f; lrun[qd] = 0.f;
#pragma unroll
            for (int dt = 0; dt < 4; ++dt) O[qd][dt] = (f32x4){0.f, 0.f, 0.f, 0.f}; }
        float carry3[NQ]; for (int i = 0; i < NQ; ++i) carry3[i] = 0.f;
        const int npass = (MODE == 2) ? 2 : 1;
        for (int pass = 0; pass < npass; ++pass) {
            const bool do_pv = (MODE != 2) || pass == 1;
            float linv[NQ];
            if (MODE == 2 && pass == 1) {
#pragma unroll
                for (int qd = 0; qd < NQ; ++qd) { float lt = lrun[qd]; lt += __shfl_xor(lt, 16); lt += __shfl_xor(lt, 32); linv[qd] = lt > 0.f ? 1.0f / lt : 0.f; }
            }
            u32x4 kreg, vreg; int p0n;
            { const int ti = 0; p0n = (MODE == 3) ? list[ti] * 64 : (MODE == 2 ? ti * 64 : tile_lo + ti * 64);
              if (ntiles > 0 && p0n >= 0) { kreg = *(const u32x4*)(Ksrc + (size_t)(p0n + (c.tid >> 3)) * kstride + (c.tid & 7) * 8);
                  if (do_pv) vreg = *(const u32x4*)(Vsrc + (size_t)(c.tid >> 3) * vstride + p0n + (c.tid & 7) * 8); } }
            for (int ti = 0; ti < ntiles; ++ti) {
                const int p0 = p0n;
                __syncthreads();
                if (p0 >= 0) { *(LAS u32x4*)(L + AT_K + (c.tid >> 3) * 144 + (c.tid & 7) * 16) = kreg; if (do_pv) *(LAS u32x4*)(L + AT_V + (c.tid >> 3) * 144 + (c.tid & 7) * 16) = vreg; }
                if (ti + 1 < ntiles) { p0n = (MODE == 3) ? list[ti + 1] * 64 : (MODE == 2 ? (ti + 1) * 64 : tile_lo + (ti + 1) * 64);
                    if (p0n >= 0) { kreg = *(const u32x4*)(Ksrc + (size_t)(p0n + (c.tid >> 3)) * kstride + (c.tid & 7) * 8);
                        if (do_pv) vreg = *(const u32x4*)(Vsrc + (size_t)(c.tid >> 3) * vstride + p0n + (c.tid & 7) * 8); } }
                __syncthreads();
                if (p0 < 0) continue;
                if (MODE == 0) { if (p0 > tw0 + TW - 1 || p0 + 63 < tw0 - 127) continue; }
                if (MODE == 1) { if (p0 > tw0 + TW - 1 || p0 + 63 < tw0 - 511) continue; }
                if (MODE == 2) { if (16 * p0 + 31 > tw0 + TW - 1) continue; }
                if (MODE == 3) { if (p0 > tw0 + TW - 1) continue; }
                const int jblk = p0 >> 6;
#pragma unroll
                for (int qd = 0; qd < NQ; ++qd) {
                    const int tq = tw0 + 4 * qd + (n >> 2);
                    bool colsel = true;
                    if (MODE == 3) { colsel = (selm[(wave * TW + 4 * qd + (n >> 2)) * 8 + (jblk >> 5)] >> (jblk & 31)) & 1u; if (__ballot(colsel) == 0ull) continue; }
#pragma unroll
                    for (int st = 0; st < 2; ++st) {
                        f32x4 sc[2];
#pragma unroll
                        for (int kt = 0; kt < 2; ++kt) { sc[kt] = (f32x4){0.f, 0.f, 0.f, 0.f};
#pragma unroll
                            for (int ks = 0; ks < 2; ++ks) { const bf16x8 ak = *(const LAS bf16x8*)(L + AT_K + (32 * st + 16 * kt + n) * 144 + (32 * ks + 8 * q) * 2);
                                sc[kt] = __builtin_amdgcn_mfma_f32_16x16x32_bf16(ak, Bq[qd][ks], sc[kt], 0, 0, 0); } }
                        float mx = -1e30f;
#pragma unroll
                        for (int kt = 0; kt < 2; ++kt)
#pragma unroll
                            for (int r = 0; r < 4; ++r) { const int kl = 32 * st + 16 * kt + 4 * q + r; int dist; bool v;
                                if (MODE == 2) { dist = tq - (16 * (p0 + kl) + 31); v = dist >= 0; }
                                else { dist = tq - (p0 + kl); v = dist >= 0; if (MODE == 0) v = v && dist < 128; if (MODE == 1) v = v && dist < 512; if (MODE == 3) v = v && colsel; }
                                const int di = dist < 0 ? 0 : (dist > 1023 ? 1023 : dist);
                                const float s2 = v ? sc[kt][r] + biasd[hr * 1024 + di] : -1e30f; sc[kt][r] = s2; mx = fmaxf(mx, s2); }
                        float p[2][4];
                        if (MODE == 2 && pass == 1) {
#pragma unroll
                            for (int kt = 0; kt < 2; ++kt)
#pragma unroll
                                for (int r = 0; r < 4; ++r) p[kt][r] = __expf(sc[kt][r] - mrun[qd]) * linv[qd];
                        } else {
                            mx = fmaxf(mx, __shfl_xor(mx, 16)); mx = fmaxf(mx, __shfl_xor(mx, 32));
                            const float mn = fmaxf(mrun[qd], mx), corr = __expf(mrun[qd] - mn); mrun[qd] = mn; float ps = 0.f;
                            const float mne = mn < -1e29f ? 0.f : mn;
#pragma unroll
                            for (int kt = 0; kt < 2; ++kt)
#pragma unroll
                                for (int r = 0; r < 4; ++r) { p[kt][r] = __expf(sc[kt][r] - mne); ps += p[kt][r]; }
                            lrun[qd] = lrun[qd] * corr + ps;
                            if (do_pv) {
#pragma unroll
                                for (int dt = 0; dt < 4; ++dt) O[qd][dt] = O[qd][dt] * corr; }
                        }
                        if (MODE == 2 && pass == 1) {
                            float i3prev = carry3[qd];
#pragma unroll
                            for (int kt = 0; kt < 2; ++kt) { float im[4];
#pragma unroll
                                for (int r = 0; r < 4; ++r) { float v = p[kt][r]; v += __shfl_xor(v, 1); v += __shfl_xor(v, 2); im[r] = v; }
                                const float same = __shfl(im[3], (lane + 48) & 63), prevt = __shfl(i3prev, (lane + 48) & 63);
                                const float pv3 = q > 0 ? same : prevt;
                                const int jg = (p0 + 32 * st + 16 * kt + 4 * q) >> 2;
                                if (hr == 0 && jg < 256) scores[((size_t)g * T + tq) * 256 + jg] = 2.0f * (im[0] + im[1] + im[2]) + im[3] + pv3;
                                i3prev = im[3]; }
                            carry3[qd] = i3prev;
                        }
                        if (do_pv) {
                            u32x4 pw; pw.x = pk2(p[0][0], p[0][1]); pw.y = pk2(p[0][2], p[0][3]); pw.z = pk2(p[1][0], p[1][1]); pw.w = pk2(p[1][2], p[1][3]);
                            const bf16x8 pf = __builtin_bit_cast(bf16x8, pw);
#pragma unroll
                            for (int dt = 0; dt < 4; ++dt) { const LAS unsigned char* vp = L + AT_V + (16 * dt + n) * 144 + (32 * st + 4 * q) * 2;
                                const u32x2 v0 = *(const LAS u32x2*)vp, v1 = *(const LAS u32x2*)(vp + 32); u32x4 vw; vw.x = v0.x; vw.y = v0.y; vw.z = v1.x; vw.w = v1.y;
                                O[qd][dt] = __builtin_amdgcn_mfma_f32_16x16x32_bf16(__builtin_bit_cast(bf16x8, vw), pf, O[qd][dt], 0, 0, 0); }
                        }
                        __builtin_amdgcn_sched_barrier(0);
                    }
                }
            }
        }
#pragma unroll
        for (int qd = 0; qd < NQ; ++qd) {
            const int tq = tw0 + 4 * qd + (n >> 2), hh = g * 4 + hr;
            float scale;
            if (MODE == 2) scale = 1.0f;
            else { float lt = lrun[qd]; lt += __shfl_xor(lt, 16); lt += __shfl_xor(lt, 32);
                if (MODE == 0) { const float sink = inptr(c, I_SINK)[layer * 8 + hh]; const float mf = fmaxf(mrun[qd], sink), cr = __expf(mrun[qd] - mf); scale = cr / (lt * cr + __expf(sink - mf)); }
                else scale = lt > 0.f ? 1.0f / lt : 0.f; }
            if (MODE != 0) scale *= sigmoidf_(bf2f(proj[(size_t)tq * PLD + PC_GL + (MODE == 2 ? 0 : (MODE == 3 ? 8 : 16)) + hh]));
#pragma unroll
            for (int dt = 0; dt < 4; ++dt) { const f32x4 o = O[qd][dt] * scale; const int col = hh * 64 + 16 * dt + 4 * q;
                if (MODE == 0) { u32x2 w; w.x = pk2(o[0], o[1]); w.y = pk2(o[2], o[3]); *(u32x2*)(oout + (size_t)tq * 512 + col) = w; }
                else if (MODE == 2) *(f32x4*)(nsaacc + (size_t)tq * 512 + col) = o;
                else if (MODE == 1) { f32x4* ap = (f32x4*)(nsaacc + (size_t)tq * 512 + col); *ap = *ap + o; }
                else { const f32x4 t2 = *(const f32x4*)(nsaacc + (size_t)tq * 512 + col) + o; u32x2 w; w.x = pk2(t2[0], t2[1]); w.y = pk2(t2[2], t2[3]); *(u32x2*)(oout + (size_t)tq * 512 + col) = w; } }
        }
    }
}
__device__ __forceinline__ void phase_topk2(const Ctx& c, const float* scores, int* sel) {
    const int gw = c.bid * 8 + c.wave, NGW = c.G * 8;
    for (int item = gw; item < T * 2; item += NGW) {
        const int t = item >> 1, g = item & 1, cur = t >> 6;
        const float* sp = scores + ((size_t)g * T + t) * 256;
        float val[4];
#pragma unroll
        for (int jj = 0; jj < 4; ++jj) { const int j = c.lane + 64 * jj; float sc;
            if (j == 0 || j == cur || j == cur - 1) sc = 1e4f; else if (j > cur) sc = -1.0f; else sc = sp[j];
            val[jj] = sc; }
        for (int k = 0; k < 16; ++k) {
            float bv = val[0]; int bi = c.lane;
#pragma unroll
            for (int jj = 1; jj < 4; ++jj) if (val[jj] > bv) { bv = val[jj]; bi = c.lane + 64 * jj; }
#pragma unroll
            for (int o = 32; o >= 1; o >>= 1) { const float ov = __shfl_xor(bv, o); const int oi = __shfl_xor(bi, o); if (ov > bv || (ov == bv && oi < bi)) { bv = ov; bi = oi; } }
#pragma unroll
            for (int jj = 0; jj < 4; ++jj) if (bi == c.lane + 64 * jj) val[jj] = -3e38f;
            if (c.lane == 0) sel[(size_t)item * 16 + k] = bi;
        }
    }
}

#define wb ((bf16_t*)(ws + WS_WB))
#define xb ((bf16_t*)(ws + WS_XB))
#define rs ((float*)(ws + WS_RS))
#define kcb ((bf16_t*)(ws + WS_KCB))
#define vctb ((bf16_t*)(ws + WS_VCT))
#define vtb ((bf16_t*)(ws + WS_VT))
#define scores ((float*)(ws + WS_SCORES))
#define sel ((int*)(ws + WS_SEL))
#define ml ((float*)(ws + WS_ML))
#define hidb ((bf16_t*)(ws + WS_HID))
#define proj ((bf16_t*)(ws + WS_PROJ))
#define gates ((bf16_t*)(ws + WS_GATES))
#define merged ((bf16_t*)(ws + WS_MERGED))
#define tmpb ((bf16_t*)(ws + WS_TMPB))
#define alora ((bf16_t*)(ws + WS_ALORA))
#define rwu ((bf16_t*)(ws + WS_RWU))
#define rws ((bf16_t*)(ws + WS_RWS))
#define bonusg ((float*)(ws + WS_BONUS))
#define nsaacc ((float*)(ws + WS_NSAACC))
#define obuf ((bf16_t*)(ws + WS_O))
#define act ((bf16_t*)(ws + WS_ACT))
#define tmpf ((bf16_t*)(ws + WS_TMPF))
constexpr int PH_PER_BATCH = 16, PH_PER_LAYER = 1 + 2 * PH_PER_BATCH + 3, PH_TOTAL = 1 + DEPTH * PH_PER_LAYER;

__global__ void __launch_bounds__(512, 2) fwd_kernel(Args args) {
    extern __shared__ __attribute__((aligned(16))) unsigned char lds_raw[];
    Ctx c0; c0.lds = (LAS unsigned char*)lds_raw; c0.tid = threadIdx.x; c0.lane = c0.tid & 63; c0.wave = __builtin_amdgcn_readfirstlane(c0.tid >> 6); c0.G = gridDim.x; c0.bid = blockIdx.x; const Ctx& c = c0;
    unsigned char* ws = args.ws;
    volatile LAS unsigned* misc = (volatile LAS unsigned*)(c.lds + LDS_MISC);
    if (c.tid < 4) misc[c.tid] = 0u;
    if (c.tid < 30) { const unsigned long long pv = (unsigned long long)args.in[c.tid & 31]; misc[16 + 2 * c.tid] = (unsigned)pv; misc[17 + 2 * c.tid] = (unsigned)(pv >> 32); }
    __syncthreads();
    XcdBarrier bar; bar.bar = (unsigned*)(ws + WS_CTL); bar.x = 0; bar.st = misc;
    const int lo = args.lo, hi = args.hi;
    const bool multi = (hi - lo) > 1;
    if (multi) bar = xcd_barrier_post((unsigned*)(ws + WS_CTL), misc);
    int gp = 0;
#ifndef ONLY_PH
#define ONLY_PH -1
#endif
#ifndef PHMASK
#define PHMASK 0xffffff
#endif
#ifndef REPMASK
#define REPMASK 0
#endif
#define PHASE_BEGIN(id) if (gp >= lo && gp < hi) { for (int rep_ = 0; rep_ < (((REPMASK >> (id)) & 1) ? 2 : 1); ++rep_) { if (rep_) __syncthreads(); \
    Ctx pc = c0; asm volatile("" : "+v"(pc.tid), "+s"(pc.bid)); pc.lane = pc.tid & 63; pc.wave = __builtin_amdgcn_readfirstlane(pc.tid >> 6); const Ctx& c = pc;
#define PHASE_END   } if (gp + 1 < hi) xcd_barrier(bar); } ++gp;

    float* x = args.out;
    PHASE_BEGIN(0) phase_init(c, inptr(c, I_X), x, xb, rs); PHASE_END

    for (int layer = 0; layer < DEPTH; ++layer) {
        PHASE_BEGIN(1) phase_cvt(c, args, layer, wb); PHASE_END
        for (int b = 0; b < NBATCH; ++b) {
            const int row0 = b * T;
            PHASE_BEGIN(2) {
                pg8::Gemm g{xb + (size_t)row0 * D, wb + WB_WIN, D, D, D}; pg8::Sched S; S.init(T / 256, NIN / 256, c.G, c.bid, 1, (size_t)256 * D * 2, 0, (size_t)256 * D * 2, 0);
                pg8::EpiInProj E{proj, gates, rs + row0}; pg8::gemm_phase(c.lds, c.tid, g, S, E); } PHASE_END
            PHASE_BEGIN(16) { phase_lora_a(c, args, layer, proj, alora); vt_transpose(c, proj, vtb); } PHASE_END
            PHASE_BEGIN(17) {
                pg8::Gemm g{alora, wb + WB_LORA, 256, 256, 256}; pg8::Sched S; S.init(T / 256, 6, c.G, c.bid, 1, (unsigned)256 * 256 * 2, 0, (unsigned)256 * 256 * 2, 0);
                pg8::EpiLora E{obuf}; pg8::gemm_phase(c.lds, c.tid, g, S, E); } PHASE_END
            PHASE_BEGIN(18) phase_rwkv_chunk(c, args, layer, proj, obuf + (size_t)T * 512, obuf + (size_t)2 * T * 512, rwu, bonusg); PHASE_END
            PHASE_BEGIN(19) phase_rwkv_scan(c, rwu, rws); PHASE_END
            PHASE_BEGIN(9) phase_rwkv_out(c, args, layer, proj, rwu, rws, bonusg, obuf); PHASE_END
            PHASE_BEGIN(3) {
                pg8::Gemm g{proj, wb + WB_W1T, 16 * PLD, 2048, 2048, (unsigned)PLD * 2}; pg8::Sched S; S.init(16, 1, c.G, c.bid, 1, 0, 0, 0, 0); S.mode = 1;
                pg8::EpiCmp1 E{hidb, (const float*)(wb + WB_BH)}; pg8::gemm_phase(c.lds, c.tid, g, S, E); } PHASE_END
            PHASE_BEGIN(4) {
                pg8::Gemm g{hidb, wb + WB_W2T, 256, 256, 256}; pg8::Sched S; S.init(16, 1, c.G, c.bid, 1, (unsigned)256 * 256 * 2, 0, 0, 0); S.mode = 2;
                pg8::EpiCmp2 E{kcb, vctb}; pg8::gemm_phase(c.lds, c.tid, g, S, E); } PHASE_END
            PHASE_BEGIN(5) phase_attn<2, 2>(c, args, layer, proj, vtb, kcb, vctb, sel, nsaacc, scores, obuf + (size_t)T * 512); PHASE_END
            PHASE_BEGIN(6) phase_topk2(c, scores, sel); PHASE_END
            PHASE_BEGIN(7) phase_attn<1, 2>(c, args, layer, proj, vtb, kcb, vctb, sel, nsaacc, scores, obuf + (size_t)T * 512); PHASE_END
            PHASE_BEGIN(8) phase_attn<3, 2>(c, args, layer, proj, vtb, kcb, vctb, sel, nsaacc, scores, obuf + (size_t)T * 512); PHASE_END
            PHASE_BEGIN(20) phase_attn<0, 2>(c, args, layer, proj, vtb, kcb, vctb, sel, nsaacc, scores, obuf + (size_t)2 * T * 512); PHASE_END
            PHASE_BEGIN(10) {
                pg8::Gemm g{obuf, wb + WB_WBR, 512, 512, 512}; pg8::Sched S; S.init(T / 256, D / 256, c.G, c.bid, 3, (size_t)256 * 512 * 2, (size_t)T * 512 * 2, (size_t)256 * 512 * 2, (size_t)D * 512 * 2);
                pg8::EpiMerge E{gates, merged}; pg8::gemm_phase(c.lds, c.tid, g, S, E); } PHASE_END
            PHASE_BEGIN(11) {
                pg8::Gemm g{merged, wb + WB_WOUT, D, D, D}; pg8::Sched S; S.init(T / 256, D / 256, c.G, c.bid, 1, (size_t)256 * D * 2, 0, (size_t)256 * D * 2, 0);
                pg8::EpiStore E{tmpb, D}; pg8::gemm_phase(c.lds, c.tid, g, S, E); } PHASE_END
            PHASE_BEGIN(12) phase_norm_res(c, tmpb, inptr(c, I_NQM) + layer * D, x, xb, rs, row0, T); PHASE_END
        }
        PHASE_BEGIN(13) {
            pg8::Gemm g{xb, wb + WB_WGU, D, D, D}; pg8::Sched S; S.init(MROWS / 256, 2 * FFN / 256, c.G, c.bid, 1, (size_t)256 * D * 2, 0, (size_t)256 * D * 2, 0);
            pg8::EpiSwiGLU E{act, rs}; pg8::gemm_phase(c.lds, c.tid, g, S, E); } PHASE_END
        PHASE_BEGIN(14) {
            pg8::Gemm g{act, wb + WB_WDN, FFN, FFN, FFN}; pg8::Sched S; S.init(MROWS / 256, D / 256, c.G, c.bid, 1, (size_t)256 * FFN * 2, 0, (size_t)256 * FFN * 2, 0);
            pg8::EpiStore E{tmpf, D}; pg8::gemm_phase(c.lds, c.tid, g, S, E); } PHASE_END
        PHASE_BEGIN(15) phase_norm_res(c, tmpf, inptr(c, I_NQF) + layer * D, x, xb, rs, 0, MROWS); PHASE_END
    }
#undef PHASE_BEGIN
#undef PHASE_END
}

extern "C" void kernel_launch(void* const* d_in, const int* in_sizes, int n_in, void* d_out, int out_size, void* d_ws, size_t ws_size, hipStream_t stream) {
    static int grid = 0;
    if (grid == 0) {
        if (n_in != 30 || out_size != MROWS * D || ws_size < WS_END) { fprintf(stderr, "kernel_launch: unexpected shapes (n_in %d out %d ws %zu)\n", n_in, out_size, ws_size); grid = -1; return; }
        int dev = 0, cus = 0;
        if (hipGetDevice(&dev) != hipSuccess || hipDeviceGetAttribute(&cus, hipDeviceAttributeMultiprocessorCount, dev) != hipSuccess) { grid = -1; return; }
        if (hipFuncSetAttribute((const void*)fwd_kernel, hipFuncAttributeMaxDynamicSharedMemorySize, LDS_BYTES) != hipSuccess) { fprintf(stderr, "hipFuncSetAttribute failed\n"); grid = -1; return; }
        int per_cu = 0;
        if (hipOccupancyMaxActiveBlocksPerMultiprocessor(&per_cu, (const void*)fwd_kernel, 512, LDS_BYTES) != hipSuccess || per_cu < 1) { fprintf(stderr, "occupancy query: %d\n", per_cu); }
        (void)hipGetLastError();
        grid = cus;
    }
    if (grid < 0) return;
    (void)hipMemsetAsync((char*)d_ws + WS_CTL, 0, CTL_BYTES, stream);
    Args a{};
    for (int i = 0; i < 30; ++i) a.in[i] = (const float*)d_in[i];
    a.out = (float*)d_out; a.ws = (unsigned char*)d_ws;
#if MK_ONE_LAUNCH
    a.lo = 0; a.hi = PH_TOTAL;
    hipLaunchKernelGGL(fwd_kernel, dim3(grid), dim3(512), LDS_BYTES, stream, a);
#else
    for (int p = 0; p < PH_TOTAL; ++p) { a.lo = p; a.hi = p + 1; hipLaunchKernelGGL(fwd_kernel, dim3(grid), dim3(512), LDS_BYTES, stream, a); }
#endif
}
```

```cpp
#include <hip/hip_runtime.h>
#include <stdint.h>
#include <stdio.h>

#ifndef MK_ONE_LAUNCH
#define MK_ONE_LAUNCH 1
#endif

#define LAS __attribute__((address_space(3)))
typedef unsigned short bf16_t;
typedef short bf16x8 __attribute__((ext_vector_type(8)));
typedef float f32x4 __attribute__((ext_vector_type(4)));
typedef float f32x2 __attribute__((ext_vector_type(2)));
typedef unsigned u32x4 __attribute__((ext_vector_type(4)));
typedef unsigned u32x2 __attribute__((ext_vector_type(2)));

constexpr int D = 1024, NBATCH = 2, T = 16384, DEPTH = 4, MROWS = NBATCH * T;
constexpr int IN_COLS = 6936, FFN = 2816;
constexpr int PLD = 4096;
constexpr int PC_R = 0, PC_K = 512, PC_V = 1024, PC_ZW = 1536, PC_ZA = 1600, PC_ZG = 1664;
constexpr int PC_NQ = 1792, PC_KC = 2304, PC_VC = 2432, PC_KS = 2560, PC_VS = 2688, PC_KW = 2816, PC_VW = 2944, PC_GL = 3072;
constexpr int PC_SQ = 3328, PC_SK = 3840, PC_SV = 3968;
constexpr int NIN = 7168;
constexpr int NCMP = 1023;
constexpr float NORM_EPS = 1e-6f;

constexpr size_t MiB = 1u << 20;
constexpr size_t WS_CTL = 0, CTL_BYTES = 65536;
constexpr size_t WS_WB = 65536;
constexpr size_t WB_WIN = 0, WB_WBR = WB_WIN + (size_t)NIN * D, WB_WOUT = WB_WBR + (size_t)3 * D * 512, WB_WGU = WB_WOUT + (size_t)D * D,
                 WB_WDN = WB_WGU + (size_t)2 * FFN * D, WB_LORA = WB_WDN + (size_t)D * FFN, WB_W1T = WB_LORA + (size_t)1536 * 256, WB_W2T = WB_W1T + (size_t)2 * 256 * 2048,
                 WB_BH = WB_W2T + (size_t)2 * 256 * 256, WB_END = WB_BH + 1024;
static_assert(WS_WB + WB_END * 2 <= 39 * MiB, "weights");
constexpr size_t WS_XB = 39 * MiB;
constexpr size_t WS_RS = 103 * MiB;
constexpr size_t WS_KCB = 103 * MiB + 262144;
constexpr size_t WS_VCT = WS_KCB + 262144;
constexpr size_t WS_SEL = 104 * MiB;
constexpr size_t WS_BONUS = 106 * MiB;
constexpr size_t WS_ML = 106 * MiB + 524288;
constexpr size_t WS_ALORA = 107 * MiB;
constexpr size_t WS_HID = 107 * MiB;
constexpr size_t WS_VT = 115 * MiB;
constexpr size_t WS_BIG = 127 * MiB;
constexpr size_t WS_PROJ = WS_BIG;
constexpr size_t WS_GATES = WS_PROJ + 128 * MiB;
constexpr size_t WS_RWKVS = WS_GATES + 96 * MiB;
constexpr size_t WS_RWU = WS_RWKVS;
constexpr size_t WS_RWS = WS_RWKVS + 64 * MiB;
constexpr size_t WS_SCORES = WS_RWKVS;
constexpr size_t WS_MERGED = WS_RWKVS;
constexpr size_t WS_TMPB = WS_RWKVS + 32 * MiB;
constexpr size_t WS_NSAACC = WS_RWKVS + 80 * MiB;
constexpr size_t WS_O = WS_NSAACC + 32 * MiB;
constexpr size_t WS_END = WS_O + 48 * MiB;
constexpr size_t WS_ACT = WS_BIG;
constexpr size_t WS_TMPF = WS_BIG + 176 * MiB;
static_assert(WS_END <= 512 * MiB, "workspace");
static_assert(WS_TMPF + 64 * MiB <= WS_NSAACC, "ffn overlay");

constexpr int LDS_BYTES = 147456;
constexpr int LDS_MISC = 131072 + 8192;

__device__ __forceinline__ float bf2f(unsigned v) { return __uint_as_float(v << 16); }
typedef __bf16 bf16n2 __attribute__((ext_vector_type(2)));
__device__ __forceinline__ unsigned pk2(float lo, float hi) { const f32x2 f = {lo, hi}; const bf16n2 v = __builtin_convertvector(f, bf16n2); return __builtin_bit_cast(unsigned, v); }
__device__ __forceinline__ unsigned f2bf(float f) { return pk2(f, 0.f) & 0xffffu; }
__device__ __forceinline__ void unpack8(const u32x4 w, float (&f)[8]) {
    f[0] = __uint_as_float(w.x << 16); f[1] = __uint_as_float(w.x & 0xffff0000u); f[2] = __uint_as_float(w.y << 16); f[3] = __uint_as_float(w.y & 0xffff0000u);
    f[4] = __uint_as_float(w.z << 16); f[5] = __uint_as_float(w.z & 0xffff0000u); f[6] = __uint_as_float(w.w << 16); f[7] = __uint_as_float(w.w & 0xffff0000u);
}
__device__ __forceinline__ float wave_sum(float v) {
#pragma unroll
    for (int o = 32; o >= 1; o >>= 1) v += __shfl_xor(v, o);
    return v;
}
__device__ __forceinline__ float sigmoidf_(float x) { return 1.0f / (1.0f + __expf(-x)); }
__device__ __forceinline__ int t5_bucket(int n) {
    if (n < 16) return n;
    int b = 16;
    b += (n >= 21); b += (n >= 27); b += (n >= 35); b += (n >= 46); b += (n >= 59); b += (n >= 77); b += (n >= 99); b += (n >= 128);
    b += (n >= 166); b += (n >= 216); b += (n >= 280); b += (n >= 363); b += (n >= 470); b += (n >= 609); b += (n >= 790);
    return b;
}

#define XB_TMO      128
#define XB_XCNT(j)  (256  + 64 * (j))
#define XB_XSUB(j)  (1280 + 64 * (j))
#define XB_XGEN(j)  (2304 + 64 * (j))
#define XB_TOP      3328
#define XB_TOPGEN   3392
#define XCD_BAR_WORDS 3456
#define XB_SPIN_CAP (1u << 22)
__device__ __forceinline__ unsigned xb_ld(unsigned* p)              { return __hip_atomic_load(p, __ATOMIC_RELAXED, __HIP_MEMORY_SCOPE_AGENT); }
__device__ __forceinline__ unsigned xb_add(unsigned* p, unsigned v) { return __hip_atomic_fetch_add(p, v, __ATOMIC_RELAXED, __HIP_MEMORY_SCOPE_AGENT); }
__device__ __forceinline__ unsigned xb_xcc_id() { return (unsigned)__builtin_amdgcn_s_getreg((3 << 11) | 20) & 0xFu; }
#define XB_SPIN(cond, bar) do { unsigned _sp = 0; while (cond) { __builtin_amdgcn_s_sleep(1); \
    if ((++_sp & 255u) == 0u) { if (xb_ld(&(bar)[XB_TMO])) break; if (_sp > XB_SPIN_CAP) { atomicAdd(&(bar)[XB_TMO], 1u); break; } } } } while (0)
struct XcdBarrier { unsigned* bar; unsigned x; volatile LAS unsigned* st; };
__device__ __forceinline__ XcdBarrier xcd_barrier_post(unsigned* bar, volatile LAS unsigned* st) {
    XcdBarrier b; b.bar = bar; b.x = xb_xcc_id(); b.st = st;
    if (threadIdx.x == 0) (void)xb_add(&bar[XB_XCNT(b.x)], 1u);
    return b;
}
__device__ __forceinline__ void xcd_barrier_complete(unsigned* bar, unsigned x, unsigned& nloc, unsigned& nx) {
    const unsigned G = gridDim.x * gridDim.y * gridDim.z;
    unsigned sum, cnt, mine, sp = 0u;
    for (;;) {
        sum = 0u; cnt = 0u; mine = 0u;
#pragma unroll
        for (unsigned j = 0; j < 16; ++j) { const unsigned c = xb_ld(&bar[XB_XCNT(j)]); sum += c; cnt += (c > 0u) ? 1u : 0u; mine = (j == x) ? c : mine; }
        if (sum == G) break;
        __builtin_amdgcn_s_sleep(1);
        if ((++sp & 255u) == 0u) { if (xb_ld(&bar[XB_TMO])) break; if (sp > XB_SPIN_CAP) { atomicAdd(&bar[XB_TMO], 1u); break; } }
    }
    nloc = mine > 0u ? mine : 1u; nx = cnt > 0u ? cnt : 1u;
}
__device__ __forceinline__ void xcd_barrier(const XcdBarrier& b) {
    asm volatile("s_waitcnt vmcnt(0)" ::: "memory");
    __syncthreads();
    if (threadIdx.x == 0) {
        unsigned* bar = b.bar;
        __builtin_amdgcn_s_waitcnt(0);
        unsigned nloc = b.st[0], nx = b.st[1];
        if (nloc == 0u) { xcd_barrier_complete(bar, b.x, nloc, nx); b.st[0] = nloc; b.st[1] = nx; }
        const unsigned old = xb_add(&bar[XB_XSUB(b.x)], 1u);
        const unsigned gen = old / nloc;
        if (old + 1u == (gen + 1u) * nloc) {
            __builtin_amdgcn_fence(__ATOMIC_RELEASE, "agent");
            asm volatile("s_waitcnt vmcnt(0)" ::: "memory");
            const unsigned og = xb_add(&bar[XB_TOP], 1u);
            const unsigned tg = og / nx;
            if (og + 1u == (tg + 1u) * nx) xb_add(&bar[XB_TOPGEN], 1u);
            else XB_SPIN(xb_ld(&bar[XB_TOPGEN]) == tg, bar);
            __builtin_amdgcn_fence(__ATOMIC_ACQUIRE, "agent");
            xb_add(&bar[XB_XGEN(b.x)], 1u);
            asm volatile("s_waitcnt vmcnt(0)" ::: "memory");
        } else {
            XB_SPIN(xb_ld(&bar[XB_XGEN(b.x)]) == gen, bar);
            __builtin_amdgcn_fence(__ATOMIC_ACQUIRE, "agent");
            asm volatile("s_waitcnt vmcnt(0)" ::: "memory");
        }
    }
    __syncthreads();
}

namespace pg8 {
constexpr int BM = 256, BK = 64, HALF = 128, HTB = HALF * BK * 2, STAGE_BYTES = 8 * HTB, NXCD = 8, WGM = 8;
__device__ __forceinline__ int lds_byte(int r, int c) { const int st = (r >> 4) * 2 + (c >> 5), rr = r & 15, cc = c & 31, ob = rr * 64 + cc * 2; return st * 1024 + (ob ^ (((ob >> 9) & 1) << 5)); }
__device__ __forceinline__ void stage_rc(int b, int& R, int& C) { const int st = b / 1024, sb = b % 1024, swz = sb ^ (((sb >> 9) & 1) << 5); R = (st >> 1) * 16 + swz / 64; C = (st & 1) * 32 + (swz % 64) / 2; }
__device__ __forceinline__ int perm32(int rho) { const int n = rho >> 4, i = rho & 15; return 8 * (i >> 2) + 4 * n + (i & 3); }

struct Unit { int pm, pn, sub; unsigned aoff, boff; };
struct Gemm { const bf16_t* A; const bf16_t* Bt; int lda, ldb, K; unsigned kstepA = 128; };
struct Sched {
    int nM, nN, nwg, G, c, nsub, mode = 0; unsigned a_row, a_sub, b_row, b_sub;
    __device__ __forceinline__ void init(int nM_, int nN_, int G_, int c_, int nsub_, unsigned a_row_, unsigned a_sub_, unsigned b_row_, unsigned b_sub_) {
        nM = nM_; nN = nN_; nwg = nM * nN; G = G_; c = c_; nsub = nsub_; a_row = a_row_; a_sub = a_sub_; b_row = b_row_; b_sub = b_sub_; }
    __device__ __forceinline__ bool next(int i, Unit& u) const {
        const int round = i / nsub; u.sub = i - round * nsub;
        const long L = (long)round * G + c; if (L >= nwg) return false;
        int wgid = (int)L; { const int q = nwg / NXCD, r = nwg % NXCD, xcd = wgid % NXCD, off = wgid / NXCD; wgid = (xcd < r ? xcd * (q + 1) : r * (q + 1) + (xcd - r) * q) + off; }
        const int nig = WGM * nN, gid = wgid / nig, fm = gid * WGM, gsz = (nM - fm) < WGM ? (nM - fm) : WGM;
        u.pm = fm + ((wgid % nig) % gsz); u.pn = (wgid % nig) / gsz;
        u.aoff = (unsigned)u.pm * a_row + (unsigned)u.sub * a_sub; u.boff = (unsigned)u.pn * b_row + (unsigned)u.sub * b_sub;
        if (mode == 1) { const int kv = u.pm >> 3, g = (u.pm >> 2) & 1, cp = u.pm & 3;
            u.aoff = (unsigned)(((size_t)cp * 256 * 16 * PLD + (kv ? PC_VC : PC_KC) + g * 64) * 2); u.boff = (unsigned)kv * (256u * 2048u * 2u); }
        if (mode == 2) { const int kv = u.pm >> 3; u.boff = (unsigned)kv * (256u * 256u * 2u); }
        return true;
    }
};

template <class Epi>
__device__ __forceinline__ void gemm_phase(LAS unsigned char* lds, const int tid, const Gemm g, const Sched& S, const Epi& E) {
    const int wid = __builtin_amdgcn_readfirstlane(tid >> 6), lane = tid & 63, wr = wid >> 2, wc = wid & 3, fr = lane & 15, fq = lane >> 4;
    const int K = g.K, nt = K / BK;
    unsigned voffA[2], voffB[2];
#pragma unroll
    for (int i = 0; i < 2; ++i) { int R, C; stage_rc(tid * 16 + i * 8192, R, C); const int Rb = Epi::PERM ? ((R & ~31) + perm32(R & 31)) : R;
        voffA[i] = (unsigned)(R * g.lda + C) * 2u; voffB[i] = (unsigned)(Rb * g.ldb + C) * 2u; }
    const size_t kstep = (size_t)(BK * 2), kstA = g.kstepA;
    const size_t hstepA = (size_t)HALF * g.lda * 2, hstepB = (size_t)HALF * g.ldb * 2;
    const unsigned ldsw = (unsigned)wid * 1024u;
    const int aoff = lds_byte(wr * 64 + fr, fq * 8), boff = lds_byte(wc * 32 + fr, fq * 8);
#define PG8_SA(b, h) (((b) * 2 + (h)) * HTB)
#define PG8_SB(b, h) ((4 + (b) * 2 + (h)) * HTB)
#define PG8_STAGE(bufoff, gbase, voff) do { _Pragma("unroll") for (int _i = 0; _i < 2; ++_i) \
        __builtin_amdgcn_global_load_lds((const unsigned*)((const char*)(gbase) + (voff)[_i]), (LAS unsigned*)(lds + (bufoff) + ldsw + _i * 8192), 16, 0, 0); } while (0)
#define PG8_LDA(dst, b, h) do { _Pragma("unroll") for (int m = 0; m < 4; ++m) _Pragma("unroll") for (int k = 0; k < 2; ++k) dst[m][k] = *(const LAS bf16x8*)(lds + PG8_SA(b, h) + aoff + m * 2048 + k * 1024); } while (0)
#define PG8_LDB(dst, b, h) do { _Pragma("unroll") for (int n = 0; n < 2; ++n) _Pragma("unroll") for (int k = 0; k < 2; ++k) dst[n][k] = *(const LAS bf16x8*)(lds + PG8_SB(b, h) + boff + n * 2048 + k * 1024); } while (0)
#define PG8_MMA(ai, bj, At, Bt) do { __builtin_amdgcn_s_setprio(1); _Pragma("unroll") for (int m = 0; m < 4; ++m) _Pragma("unroll") for (int n = 0; n < 2; ++n) _Pragma("unroll") for (int k = 0; k < 2; ++k) \
        acc[ai][bj][m][n] = __builtin_amdgcn_mfma_f32_16x16x32_bf16(Bt[n][k], At[m][k], acc[ai][bj][m][n], 0, 0, 0); __builtin_amdgcn_s_setprio(0); } while (0)
#define PG8_WAIT_V(n) asm volatile("s_waitcnt vmcnt(" #n ")" ::: "memory")
#define PG8_WAIT_L(n) asm volatile("s_waitcnt lgkmcnt(" #n ")" ::: "memory")
#define PG8_BAR __builtin_amdgcn_s_barrier()
#define PG8_SCHED __builtin_amdgcn_sched_barrier(0)
    Unit cur, nxt; int ui = 0;
    if (!S.next(0, cur)) return;
    f32x4 acc[2][2][4][2];
#pragma unroll
    for (int a = 0; a < 2; ++a)
#pragma unroll
        for (int b = 0; b < 2; ++b)
#pragma unroll
            for (int m = 0; m < 4; ++m)
#pragma unroll
                for (int n = 0; n < 2; ++n) acc[a][b][m][n] = (f32x4){0.f, 0.f, 0.f, 0.f};
    bf16x8 At[4][2], B0[2][2], B1[2][2];
    const char* cA = (const char*)g.A + cur.aoff; const char* cB = (const char*)g.Bt + cur.boff;
    PG8_STAGE(PG8_SB(0, 0), cB, voffB); PG8_STAGE(PG8_SA(0, 0), cA, voffA); PG8_STAGE(PG8_SB(0, 1), cB + hstepB, voffB); PG8_STAGE(PG8_SA(0, 1), cA + hstepA, voffA);
    if (wr == 1) PG8_BAR;
    PG8_WAIT_V(4); PG8_BAR;
    PG8_STAGE(PG8_SB(1, 0), cB + kstep, voffB); PG8_STAGE(PG8_SA(1, 0), cA + kstA, voffA); PG8_STAGE(PG8_SB(1, 1), cB + hstepB + kstep, voffB);
    PG8_WAIT_V(6); PG8_BAR;
    for (;;) {
        const bool has_next = S.next(ui + 1, nxt);
        const char* nA = has_next ? (const char*)g.A + nxt.aoff : cA; const char* nB = has_next ? (const char*)g.Bt + nxt.boff : cB;
        for (int t = 0; t < nt; t += 2) {
            const bool last = (t == nt - 2);
            const char* a1 = cA + (size_t)(t + 1) * kstA;
            const char* a2 = last ? nA : cA + (size_t)(t + 2) * kstA; const char* b2 = last ? nB : cB + (size_t)(t + 2) * kstep;
            const char* a3 = a2 + kstA; const char* b3 = b2 + kstep;
            PG8_LDB(B0, 0, 0); PG8_SCHED; PG8_LDA(At, 0, 0); PG8_STAGE(PG8_SA(1, 1), a1 + hstepA, voffA);
            PG8_WAIT_L(8); PG8_BAR; PG8_WAIT_L(0); PG8_MMA(0, 0, At, B0); PG8_BAR; PG8_SCHED;
            PG8_LDB(B1, 0, 1); PG8_STAGE(PG8_SB(0, 0), b2, voffB);
            PG8_BAR; PG8_WAIT_L(0); PG8_MMA(0, 1, At, B1); PG8_BAR;
            PG8_LDA(At, 0, 1); PG8_STAGE(PG8_SA(0, 0), a2, voffA);
            PG8_BAR; PG8_WAIT_L(0); PG8_MMA(1, 0, At, B0); PG8_BAR; PG8_SCHED;
            PG8_STAGE(PG8_SB(0, 1), b2 + hstepB, voffB);
            PG8_WAIT_V(6); PG8_BAR; PG8_MMA(1, 1, At, B1); PG8_BAR;
            PG8_LDB(B0, 1, 0); PG8_SCHED; PG8_LDA(At, 1, 0); PG8_STAGE(PG8_SA(0, 1), a2 + hstepA, voffA);
            PG8_WAIT_L(8); PG8_BAR; PG8_WAIT_L(0); PG8_MMA(0, 0, At, B0); PG8_BAR; PG8_SCHED;
            PG8_LDB(B1, 1, 1); PG8_STAGE(PG8_SB(1, 0), b3, voffB);
            PG8_BAR; PG8_WAIT_L(0); PG8_MMA(0, 1, At, B1); PG8_BAR;
            PG8_LDA(At, 1, 1); PG8_STAGE(PG8_SA(1, 0), a3, voffA);
            PG8_BAR; PG8_WAIT_L(0); PG8_MMA(1, 0, At, B0); PG8_BAR; PG8_SCHED;
            PG8_STAGE(PG8_SB(1, 1), b3 + hstepB, voffB);
            PG8_WAIT_V(6); PG8_BAR; PG8_MMA(1, 1, At, B1); PG8_BAR;
        }
        const bool keep = E(acc, cur, wr, wc, fr, fq);
        if (!has_next) break;
        if (!keep) {
#pragma unroll
            for (int a = 0; a < 2; ++a)
#pragma unroll
                for (int b = 0; b < 2; ++b)
#pragma unroll
                    for (int m = 0; m < 4; ++m)
#pragma unroll
                        for (int n = 0; n < 2; ++n) acc[a][b][m][n] = (f32x4){0.f, 0.f, 0.f, 0.f};
        }
        cur = nxt; cA = nA; cB = nB; ++ui;
    }
    PG8_WAIT_V(0);
    if (wr == 0) PG8_BAR;
    PG8_BAR;
#undef PG8_SA
#undef PG8_SB
#undef PG8_STAGE
#undef PG8_LDA
#undef PG8_LDB
#undef PG8_MMA
#undef PG8_WAIT_V
#undef PG8_WAIT_L
#undef PG8_BAR
#undef PG8_SCHED
}

struct EpiInProj {
    static constexpr bool PERM = true;
    bf16_t* proj; bf16_t* gates; const float* rs;
    __device__ __forceinline__ bool operator()(f32x4 (&acc)[2][2][4][2], const Unit& u, int wr, int wc, int fr, int fq) const {
        const int row0 = u.pm * BM + wr * 64 + fr; const bool is_gate = u.pn >= 16;
        bf16_t* base = is_gate ? gates + (u.pn - 16) * 256 : proj + u.pn * 256; const int ld = is_gate ? 3072 : PLD;
        const int col0 = wc * 32 + 8 * fq;
#pragma unroll
        for (int ai = 0; ai < 2; ++ai)
#pragma unroll
            for (int m = 0; m < 4; ++m) { const int row = row0 + ai * HALF + m * 16; const float s = rs[row]; bf16_t* rowp = base + (size_t)row * ld + col0;
#pragma unroll
                for (int bj = 0; bj < 2; ++bj) { f32x4 v0 = acc[ai][bj][m][0] * s, v1 = acc[ai][bj][m][1] * s;
                    if (is_gate) {
#pragma unroll
                        for (int j = 0; j < 4; ++j) { v0[j] = sigmoidf_(v0[j]); v1[j] = sigmoidf_(v1[j]); } }
                    u32x4 w; w.x = pk2(v0[0], v0[1]); w.y = pk2(v0[2], v0[3]); w.z = pk2(v1[0], v1[1]); w.w = pk2(v1[2], v1[3]);
                    *(u32x4*)(rowp + bj * HALF) = w; } }
        return false;
    }
};
struct EpiStore {
    static constexpr bool PERM = true;
    bf16_t* out; int ld;
    __device__ __forceinline__ bool operator()(f32x4 (&acc)[2][2][4][2], const Unit& u, int wr, int wc, int fr, int fq) const {
        const int row0 = u.pm * BM + wr * 64 + fr; const int col0 = u.pn * BM + wc * 32 + 8 * fq;
#pragma unroll
        for (int ai = 0; ai < 2; ++ai)
#pragma unroll
            for (int m = 0; m < 4; ++m) { bf16_t* rowp = out + (size_t)(row0 + ai * HALF + m * 16) * ld + col0;
#pragma unroll
                for (int bj = 0; bj < 2; ++bj) { const f32x4 v0 = acc[ai][bj][m][0], v1 = acc[ai][bj][m][1];
                    u32x4 w; w.x = pk2(v0[0], v0[1]); w.y = pk2(v0[2], v0[3]); w.z = pk2(v1[0], v1[1]); w.w = pk2(v1[2], v1[3]);
                    *(u32x4*)(rowp + bj * HALF) = w; } }
        return false;
    }
};
struct EpiCmp1 {
    static constexpr bool PERM = true;
    bf16_t* hid; const float* bh;
    __device__ __forceinline__ bool operator()(f32x4 (&acc)[2][2][4][2], const Unit& u, int wr, int wc, int fr, int fq) const {
        const int kv = u.pm >> 3; const int row0 = (u.pm & 7) * BM + wr * 64 + fr; const int col0 = wc * 32 + 8 * fq;
#pragma unroll
        for (int ai = 0; ai < 2; ++ai)
#pragma unroll
            for (int m = 0; m < 4; ++m) { bf16_t* rowp = hid + ((size_t)kv * 2048 + row0 + ai * HALF + m * 16) * 256 + col0;
#pragma unroll
                for (int bj = 0; bj < 2; ++bj) { float o[8];
#pragma unroll
                    for (int j = 0; j < 8; ++j) { const float x = acc[ai][bj][m][j >> 2][j & 3] + bh[kv * 256 + col0 + bj * HALF + j];
                        o[j] = x * sigmoidf_(1.5957691216f * (x + 0.044715f * x * x * x)); }
                    u32x4 w; w.x = pk2(o[0], o[1]); w.y = pk2(o[2], o[3]); w.z = pk2(o[4], o[5]); w.w = pk2(o[6], o[7]);
                    *(u32x4*)(rowp + bj * HALF) = w; } }
        return false;
    }
};
struct EpiCmp2 {
    static constexpr bool PERM = true;
    bf16_t* kcb; bf16_t* vct;
    __device__ __forceinline__ bool operator()(f32x4 (&acc)[2][2][4][2], const Unit& u, int wr, int wc, int fr, int fq) const {
        const int kv = u.pm >> 3; const int row0 = (u.pm & 7) * BM + wr * 64 + fr; const int col0 = wc * 32 + 8 * fq;
        if (col0 >= 64) return false;
#pragma unroll
        for (int ai = 0; ai < 2; ++ai)
#pragma unroll
            for (int m = 0; m < 4; ++m) { const int row = row0 + ai * HALF + m * 16, g = row >> 10, cc = row & 1023; const bool zr = cc == 1023; const f32x4 zz = (f32x4){0.f, 0.f, 0.f, 0.f};
                const f32x4 v0 = zr ? zz : acc[ai][0][m][0], v1 = zr ? zz : acc[ai][0][m][1];
                if (kv == 0) { u32x4 w; w.x = pk2(v0[0], v0[1]); w.y = pk2(v0[2], v0[3]); w.z = pk2(v1[0], v1[1]); w.w = pk2(v1[2], v1[3]); *(u32x4*)(kcb + ((size_t)g * 1024 + cc) * 64 + col0) = w; }
                else {
#pragma unroll
                    for (int j = 0; j < 4; ++j) { vct[((size_t)g * 64 + col0 + j) * 1024 + cc] = (bf16_t)f2bf(v0[j]); vct[((size_t)g * 64 + col0 + 4 + j) * 1024 + cc] = (bf16_t)f2bf(v1[j]); } } }
        return false;
    }
};
struct EpiLora {
    static constexpr bool PERM = true;
    bf16_t* obuf;
    __device__ __forceinline__ bool operator()(f32x4 (&acc)[2][2][4][2], const Unit& u, int wr, int wc, int fr, int fq) const {
        const int sel = u.pn >> 1; bf16_t* out = obuf + (size_t)(sel == 2 ? 0 : sel + 1) * T * 512;
        const int row0 = u.pm * BM + wr * 64 + fr; const int col0 = (u.pn & 1) * BM + wc * 32 + 8 * fq;
#pragma unroll
        for (int ai = 0; ai < 2; ++ai)
#pragma unroll
            for (int m = 0; m < 4; ++m) { bf16_t* rowp = out + (size_t)(row0 + ai * HALF + m * 16) * 512 + col0;
#pragma unroll
                for (int bj = 0; bj < 2; ++bj) { const f32x4 v0 = acc[ai][bj][m][0], v1 = acc[ai][bj][m][1];
                    u32x4 w; w.x = pk2(v0[0], v0[1]); w.y = pk2(v0[2], v0[3]); w.z = pk2(v1[0], v1[1]); w.w = pk2(v1[2], v1[3]);
                    *(u32x4*)(rowp + bj * HALF) = w; } }
        return false;
    }
};
struct EpiMerge {
    static constexpr bool PERM = true;
    const bf16_t* gates; bf16_t* merged;
    __device__ __forceinline__ bool operator()(f32x4 (&acc)[2][2][4][2], const Unit& u, int wr, int wc, int fr, int fq) const {
        const int row0 = u.pm * BM + wr * 64 + fr; const int col0 = u.pn * BM + wc * 32 + 8 * fq; const int sub = u.sub;
#pragma unroll
        for (int ai = 0; ai < 2; ++ai)
#pragma unroll
            for (int m = 0; m < 4; ++m) { const int row = row0 + ai * HALF + m * 16; const bf16_t* gp = gates + (size_t)row * 3072 + sub * 1024 + col0;
#pragma unroll
                for (int bj = 0; bj < 2; ++bj) {
                    float sc[8], sn[8]; unpack8(*(const u32x4*)(gp + bj * HALF), sc);
                    if (sub < 2) { unpack8(*(const u32x4*)(gp + 1024 + bj * HALF), sn);
#pragma unroll
                        for (int j = 0; j < 8; ++j) sc[j] = sc[j] / fmaxf(sn[j], 1e-30f); }
                    f32x4 v0 = acc[ai][bj][m][0], v1 = acc[ai][bj][m][1];
#pragma unroll
                    for (int j = 0; j < 4; ++j) { v0[j] *= sc[j]; v1[j] *= sc[4 + j]; }
                    acc[ai][bj][m][0] = v0; acc[ai][bj][m][1] = v1;
                    if (sub == 2) { u32x4 w; w.x = pk2(v0[0], v0[1]); w.y = pk2(v0[2], v0[3]); w.z = pk2(v1[0], v1[1]); w.w = pk2(v1[2], v1[3]);
                        *(u32x4*)(merged + (size_t)row * D + col0 + bj * HALF) = w; } } }
        return sub != 2;
    }
};
struct EpiSwiGLU {
    static constexpr bool PERM = true;
    bf16_t* act; const float* rs;
    __device__ __forceinline__ bool operator()(f32x4 (&acc)[2][2][4][2], const Unit& u, int wr, int wc, int fr, int fq) const {
        const int row0 = u.pm * BM + wr * 64 + fr; const int col0 = u.pn * HALF + wc * 32 + 8 * fq;
#pragma unroll
        for (int ai = 0; ai < 2; ++ai)
#pragma unroll
            for (int m = 0; m < 4; ++m) { const int row = row0 + ai * HALF + m * 16; const float s = rs[row];
                float o[8];
#pragma unroll
                for (int n = 0; n < 2; ++n)
#pragma unroll
                    for (int j = 0; j < 4; ++j) { const float gg = acc[ai][0][m][n][j] * s, uu = acc[ai][1][m][n][j] * s; o[n * 4 + j] = gg * sigmoidf_(gg) * uu; }
                u32x4 w; w.x = pk2(o[0], o[1]); w.y = pk2(o[2], o[3]); w.z = pk2(o[4], o[5]); w.w = pk2(o[6], o[7]);
                *(u32x4*)(act + (size_t)row * FFN + col0) = w; }
        return false;
    }
};
}

struct Args { const float* in[30]; float* out; unsigned char* ws; int lo, hi; };
enum { I_X = 0, I_NPM, I_NQM, I_NPF, I_NQF, I_WIN, I_MU, I_W0, I_W2, I_A0, I_A2, I_G2, I_KK, I_KA, I_RK, I_LNW, I_LNB, I_PEK, I_PEV, I_CKW1, I_CKW2, I_CVW1, I_CVW2, I_SINK, I_REL, I_WBR, I_WOUT, I_FG, I_FU, I_FD };

struct Ctx { LAS unsigned char* lds; int tid, lane, wave, G, bid; };
__device__ __forceinline__ const float* inptr(const Ctx& c, int i) {
    const volatile LAS unsigned* t = (const volatile LAS unsigned*)(c.lds + LDS_MISC + 64) + 2 * i;
    const unsigned lo = __builtin_amdgcn_readfirstlane(t[0]), hi = __builtin_amdgcn_readfirstlane(t[1]);
    return (const float*)(((unsigned long long)hi << 32) | lo);
}

__device__ __forceinline__ void phase_init(const Ctx& c, const float* x, float* xo, bf16_t* xb, float* rs) {
    const int gw = c.bid * 8 + c.wave, NGW = c.G * 8;
    for (int row = gw; row < MROWS; row += NGW) {
        const float* xr = x + (size_t)row * D; float ss = 0.f;
#pragma unroll
        for (int j = 0; j < 2; ++j) { const int e = c.lane * 8 + 512 * j; const f32x4 a = *(const f32x4*)(xr + e), b = *(const f32x4*)(xr + e + 4);
            ss += a[0] * a[0] + a[1] * a[1] + a[2] * a[2] + a[3] * a[3] + b[0] * b[0] + b[1] * b[1] + b[2] * b[2] + b[3] * b[3];
            *(f32x4*)(xo + (size_t)row * D + e) = a; *(f32x4*)(xo + (size_t)row * D + e + 4) = b;
            u32x4 w; w.x = pk2(a[0], a[1]); w.y = pk2(a[2], a[3]); w.z = pk2(b[0], b[1]); w.w = pk2(b[2], b[3]); *(u32x4*)(xb + (size_t)row * D + e) = w; }
        ss = wave_sum(ss);
        if (c.lane == 0) rs[row] = rsqrtf(ss * (1.0f / D) + NORM_EPS);
    }
}
__device__ __forceinline__ void phase_norm_res(const Ctx& c, const bf16_t* y, const float* gain, float* x, bf16_t* xb, float* rs, int row0, int nrows) {
    const int gw = c.bid * 8 + c.wave, NGW = c.G * 8;
    for (int r = gw; r < nrows; r += NGW) {
        const int row = row0 + r; float yv[16]; float ss = 0.f;
#pragma unroll
        for (int j = 0; j < 2; ++j) { float f[8]; unpack8(*(const u32x4*)(y + (size_t)r * D + c.lane * 8 + 512 * j), f);
#pragma unroll
            for (int k = 0; k < 8; ++k) { yv[j * 8 + k] = f[k]; ss += f[k] * f[k]; } }
        ss = wave_sum(ss); const float sc = rsqrtf(ss * (1.0f / D) + NORM_EPS); float s2 = 0.f;
#pragma unroll
        for (int j = 0; j < 2; ++j) { const int e = c.lane * 8 + 512 * j; float* xr = x + (size_t)row * D + e;
            f32x4 a = *(const f32x4*)xr, b = *(const f32x4*)(xr + 4); const f32x4 ga = *(const f32x4*)(gain + e), gb = *(const f32x4*)(gain + e + 4);
#pragma unroll
            for (int k = 0; k < 4; ++k) { a[k] += yv[j * 8 + k] * sc * ga[k]; b[k] += yv[j * 8 + 4 + k] * sc * gb[k]; s2 += a[k] * a[k] + b[k] * b[k]; }
            *(f32x4*)xr = a; *(f32x4*)(xr + 4) = b;
            u32x4 w; w.x = pk2(a[0], a[1]); w.y = pk2(a[2], a[3]); w.z = pk2(b[0], b[1]); w.w = pk2(b[2], b[3]); *(u32x4*)(xb + (size_t)row * D + e) = w; }
        s2 = wave_sum(s2);
        if (c.lane == 0) rs[row] = rsqrtf(s2 * (1.0f / D) + NORM_EPS);
    }
}

__device__ __forceinline__ float cvt_fetch(const Ctx& c, int layer, int kind, int sub, int k, int n) {
    switch (kind) {
    case 0: { int src; float sc = inptr(c, I_NPM)[layer * D + k];
        if (n < 3096) src = n; else if (n < 3328) return 0.f; else if (n < 4096) src = 3096 + (n - 3328); else src = 3864 + (n - 4096);
        if ((n >= PC_NQ && n < PC_NQ + 512) || (n >= PC_SQ && n < PC_SQ + 512)) sc *= 0.125f;
        return inptr(c, I_WIN)[((size_t)layer * D + k) * IN_COLS + src] * sc; }
    case 1: return inptr(c, I_WBR)[(((size_t)layer * 3 + sub) * 512 + k) * D + n];
    case 2: return inptr(c, I_WOUT)[((size_t)layer * D + k) * D + n];
    case 3: { const int pn = n >> 8, r = n & 255; const float sc = inptr(c, I_NPF)[layer * D + k];
        return (r < 128 ? inptr(c, I_FG)[((size_t)layer * D + k) * FFN + pn * 128 + r] : inptr(c, I_FU)[((size_t)layer * D + k) * FFN + pn * 128 + r - 128]) * sc; }
    case 4: return inptr(c, I_FD)[((size_t)layer * FFN + k) * D + n];
    case 6: return inptr(c, sub ? I_CVW1 : I_CKW1)[((size_t)layer * 2048 + k) * 256 + n];
    case 7: return n < 64 ? inptr(c, sub ? I_CVW2 : I_CKW2)[((size_t)layer * 256 + k) * 64 + n] : 0.f;
    default: {
        if (n < 512) return k < 64 ? inptr(c, I_W2)[((size_t)layer * 64 + k) * 512 + n] : 0.f;
        if (n < 1024) return (k >= 64 && k < 128) ? inptr(c, I_A2)[((size_t)layer * 64 + k - 64) * 512 + n - 512] : 0.f;
        return k >= 128 ? inptr(c, I_G2)[((size_t)layer * 128 + k - 128) * 512 + n - 1024] : 0.f; }
    }
}
__device__ __forceinline__ void phase_cvt(const Ctx& c, const Args& a, int layer, bf16_t* wb) {
    LAS float* tile = (LAS float*)c.lds;
    constexpr int I0 = 16 * 112, I1 = 3 * 8 * 16, I2 = 16 * 16, I3 = 16 * 88, I4 = 44 * 16, I5 = 4 * 24, I6 = 2 * 32 * 4, I7 = 2 * 4 * 4, NIT = I0 + I1 + I2 + I3 + I4 + I5 + I6 + I7;
    for (int it = c.bid; it < NIT; it += c.G) {
        int r = it, kind, sub = 0, K, nblk; bf16_t* dst;
        if (r < I0) { kind = 0; K = D; nblk = 112; dst = wb + WB_WIN; }
        else if ((r -= I0) < I1) { kind = 1; sub = r / 128; r -= sub * 128; K = 512; nblk = 16; dst = wb + WB_WBR + (size_t)sub * D * 512; }
        else if ((r -= I1) < I2) { kind = 2; K = D; nblk = 16; dst = wb + WB_WOUT; }
        else if ((r -= I2) < I3) { kind = 3; K = D; nblk = 88; dst = wb + WB_WGU; }
        else if ((r -= I3) < I4) { kind = 4; K = FFN; nblk = 16; dst = wb + WB_WDN; }
        else if ((r -= I4) < I5) { kind = 5; K = 256; nblk = 24; dst = wb + WB_LORA; }
        else if ((r -= I5) < I6) { kind = 6; sub = r / 128; r -= sub * 128; K = 2048; nblk = 4; dst = wb + WB_W1T + (size_t)sub * 256 * 2048; }
        else { r -= I6; kind = 7; sub = r / 16; r -= sub * 16; K = 256; nblk = 4; dst = wb + WB_W2T + (size_t)sub * 256 * 256; }
        const int kb = r / nblk, nb = r % nblk, k0 = kb * 64, n0 = nb * 64;
        for (int e = c.tid; e < 4096; e += 512) { const int kk = e >> 6, nn = e & 63; tile[kk * 65 + nn] = cvt_fetch(c, layer, kind, sub, k0 + kk, n0 + nn); }
        __syncthreads();
        for (int e = c.tid; e < 2048; e += 512) { const int nn = e >> 5, kp = (e & 31) * 2;
            *(unsigned*)(dst + (size_t)(n0 + nn) * K + k0 + kp) = pk2(tile[kp * 65 + nn], tile[(kp + 1) * 65 + nn]); }
        __syncthreads();
    }
    if (c.bid == c.G - 1) {
        const int kv = c.tid >> 8, u = c.tid & 255; const float* w1 = inptr(c, kv ? I_CVW1 : I_CKW1) + (size_t)layer * 2048 * 256; const float* pe = inptr(c, kv ? I_PEV : I_PEK) + (size_t)layer * 2048;
        float acc = 0.f; for (int k = 0; k < 2048; ++k) acc += pe[k] * w1[(size_t)k * 256 + u];
        ((float*)(wb + WB_BH))[c.tid] = acc;
    }
}

struct RowState { float q[64]; float o[64]; float m, l; };
__device__ __forceinline__ void row_init(RowState& s, const bf16_t* qp) {
#pragma unroll
    for (int i = 0; i < 8; ++i) { float f[8]; unpack8(*(const u32x4*)(qp + i * 8), f);
#pragma unroll
        for (int k = 0; k < 8; ++k) s.q[i * 8 + k] = f[k]; }
}
__device__ __forceinline__ void row_reset(RowState& s) {
#pragma unroll
    for (int i = 0; i < 64; ++i) s.o[i] = 0.f;
    s.m = -1e30f; s.l = 0.f;
}
__device__ __forceinline__ void row_key_bf16(RowState& s, const bf16_t* kp, const bf16_t* vp, float bias) {
    float sc = bias;
#pragma unroll
    for (int i = 0; i < 8; ++i) { float f[8]; unpack8(*(const u32x4*)(kp + i * 8), f);
#pragma unroll
        for (int k = 0; k < 8; ++k) sc += s.q[i * 8 + k] * f[k];
        if ((i & 1) == 1) __builtin_amdgcn_sched_barrier(0); }
    const float mn = fmaxf(s.m, sc), corr = __expf(s.m - mn), p = __expf(sc - mn);
    s.l = s.l * corr + p; s.m = mn;
#pragma unroll
    for (int i = 0; i < 8; ++i) { float f[8]; unpack8(*(const u32x4*)(vp + i * 8), f);
#pragma unroll
        for (int k = 0; k < 8; ++k) s.o[i * 8 + k] = s.o[i * 8 + k] * corr + p * f[k];
        if ((i & 1) == 1) __builtin_amdgcn_sched_barrier(0); }
}
__device__ __forceinline__ void row_key_f32(RowState& s, const float* kp, const float* vp, float bias) {
    float sc = bias;
#pragma unroll
    for (int i = 0; i < 16; ++i) { const f32x4 f = *(const f32x4*)(kp + i * 4); sc += s.q[i * 4] * f[0] + s.q[i * 4 + 1] * f[1] + s.q[i * 4 + 2] * f[2] + s.q[i * 4 + 3] * f[3];
        if ((i & 3) == 3) __builtin_amdgcn_sched_barrier(0); }
    const float mn = fmaxf(s.m, sc), corr = __expf(s.m - mn), p = __expf(sc - mn);
    s.l = s.l * corr + p; s.m = mn;
#pragma unroll
    for (int i = 0; i < 16; ++i) { const f32x4 f = *(const f32x4*)(vp + i * 4);
#pragma unroll
        for (int k = 0; k < 4; ++k) s.o[i * 4 + k] = s.o[i * 4 + k] * corr + p * f[k];
        if ((i & 3) == 3) __builtin_amdgcn_sched_barrier(0); }
}

__device__ __forceinline__ float gelu_tanh(float x) { const float t = tanhf(0.7978845608028654f * (x + 0.044715f * x * x * x)); return 0.5f * x * (1.0f + t); }
__device__ __forceinline__ void phase_cmp1(const Ctx& c, const Args& a, int layer, const bf16_t* proj, float* hid) {
    for (int unit = c.bid; unit < 2048; unit += c.G) {
        const int kv = unit >> 10, g = (unit >> 9) & 1, cp = unit & 511; const int cc = cp * 2 + (c.tid >> 8), u = c.tid & 255;
        if (cc >= NCMP) continue;
        const float* w1 = a.in[kv ? I_CVW1 : I_CKW1] + (size_t)layer * 2048 * 256; const float* pe = a.in[kv ? I_PEV : I_PEK] + (size_t)layer * 32 * 64;
        const bf16_t* xp = proj + (size_t)(16 * cc) * PLD + (kv ? PC_VC : PC_KC) + g * 64;
        float acc = 0.f;
        for (int l = 0; l < 32; ++l) {
#pragma unroll
            for (int i = 0; i < 8; ++i) { float f[8]; unpack8(*(const u32x4*)(xp + (size_t)l * PLD + i * 8), f);
#pragma unroll
                for (int k = 0; k < 8; ++k) acc += (f[k] + pe[l * 64 + i * 8 + k]) * w1[(size_t)(l * 64 + i * 8 + k) * 256 + u]; }
        }
        hid[(((size_t)kv * 2 + g) * 1024 + cc) * 256 + u] = gelu_tanh(acc);
    }
}
__device__ __forceinline__ void phase_cmp2(const Ctx& c, const Args& a, int layer, const float* hid, bf16_t* kcb, bf16_t* vctb) {
    for (int unit = c.bid; unit < 512; unit += c.G) {
        const int kv = unit >> 8, g = (unit >> 7) & 1, cc = (unit & 127) * 8 + (c.tid >> 6), d = c.tid & 63;
        float acc = 0.f;
        if (cc < NCMP) { const float* w2 = a.in[kv ? I_CVW2 : I_CKW2] + (size_t)layer * 256 * 64; const float* hp = hid + (((size_t)kv * 2 + g) * 1024 + cc) * 256;
            for (int u = 0; u < 256; ++u) acc += hp[u] * w2[u * 64 + d]; }
        if (kv) vctb[((size_t)g * 64 + d) * 1024 + cc] = (bf16_t)f2bf(acc); else kcb[((size_t)g * 1024 + cc) * 64 + d] = (bf16_t)f2bf(acc);
    }
}
__device__ __forceinline__ void phase_nsa13(const Ctx& c, const Args& a, const bf16_t* proj, const float* kcmp, const float* vcmp, float* nsaacc, float* ml) {
    LAS float* tb = (LAS float*)c.lds;
    for (int e = c.tid; e < 512; e += 512) tb[e] = inptr(c, I_REL)[e];
    __syncthreads();
    for (int unit = c.bid; unit < T / 64; unit += c.G) {
        const int hh = c.tid >> 6, t = unit * 64 + (c.tid & 63), g = hh >> 2;
        RowState s; row_init(s, proj + (size_t)t * PLD + PC_NQ + hh * 64);
        const bf16_t* glp = proj + (size_t)t * PLD + PC_GL;
        const float g0 = sigmoidf_(bf2f(glp[hh])), g2 = sigmoidf_(bf2f(glp[16 + hh]));
        row_reset(s);
        const int nv = t >= 31 ? (t - 31) / 16 + 1 : 0;
        for (int cc = 0; cc < nv; ++cc) { const float bias = tb[t5_bucket(t - 16 * cc - 31) * 16 + hh];
            row_key_f32(s, kcmp + ((size_t)g * 1024 + cc) * 64, vcmp + ((size_t)g * 1024 + cc) * 64, bias); }
        ml[((size_t)t * 8 + hh) * 2] = s.m; ml[((size_t)t * 8 + hh) * 2 + 1] = s.l;
        float* op = nsaacc + (size_t)t * 512 + hh * 64;
        { const float inv = s.l > 0.f ? g0 / s.l : 0.f;
#pragma unroll
            for (int i = 0; i < 16; ++i) { f32x4 w; w[0] = s.o[i * 4] * inv; w[1] = s.o[i * 4 + 1] * inv; w[2] = s.o[i * 4 + 2] * inv; w[3] = s.o[i * 4 + 3] * inv; *(f32x4*)(op + i * 4) = w; } }
        row_reset(s);
        const int s0 = t - 511 > 0 ? t - 511 : 0;
        for (int sp = s0; sp <= t; ++sp) { const float bias = tb[t5_bucket(t - sp) * 16 + hh];
            row_key_bf16(s, proj + (size_t)sp * PLD + PC_KW + g * 64, proj + (size_t)sp * PLD + PC_VW + g * 64, bias); }
        { const float inv = s.l > 0.f ? g2 / s.l : 0.f;
#pragma unroll
            for (int i = 0; i < 16; ++i) { f32x4 w = *(const f32x4*)(op + i * 4); w[0] += s.o[i * 4] * inv; w[1] += s.o[i * 4 + 1] * inv; w[2] += s.o[i * 4 + 2] * inv; w[3] += s.o[i * 4 + 3] * inv; *(f32x4*)(op + i * 4) = w; } }
    }
}
__device__ __forceinline__ void phase_nsa_topk(const Ctx& c, const Args& a, const bf16_t* proj, const float* kcmp, const float* ml, int* sel) {
    LAS float* tb = (LAS float*)c.lds;
    LAS float* qs = (LAS float*)(c.lds + 4096) + c.wave * 256;
    LAS float* sv = (LAS float*)(c.lds + 16384) + c.wave * 256;
    for (int e = c.tid; e < 512; e += 512) tb[e] = inptr(c, I_REL)[e];
    __syncthreads();
    const int gw = c.bid * 8 + c.wave, NGW = c.G * 8;
    for (int item = gw; item < T * 2; item += NGW) {
        const int t = item >> 1, g = item & 1, cur = t >> 6;
        { const bf16_t* qp = proj + (size_t)t * PLD + PC_NQ + g * 256 + c.lane * 4; const u32x2 w = *(const u32x2*)qp;
          qs[c.lane * 4] = __uint_as_float(w.x << 16); qs[c.lane * 4 + 1] = __uint_as_float(w.x & 0xffff0000u); qs[c.lane * 4 + 2] = __uint_as_float(w.y << 16); qs[c.lane * 4 + 3] = __uint_as_float(w.y & 0xffff0000u); }
        float mr[4], il[4];
#pragma unroll
        for (int r = 0; r < 4; ++r) { mr[r] = ml[((size_t)t * 8 + g * 4 + r) * 2]; const float l = ml[((size_t)t * 8 + g * 4 + r) * 2 + 1]; il[r] = l > 0.f ? 1.0f / l : 0.f; }
        const int nv = t >= 31 ? (t - 31) / 16 + 1 : 0;
        asm volatile("s_waitcnt lgkmcnt(0)" ::: "memory");
#pragma unroll 1
        for (int jj = 0; jj < 4; ++jj) {
            const int j = c.lane + 64 * jj; float sc;
            if (j == 0 || j == cur || j == cur - 1) sc = 1e4f;
            else if (j > cur) sc = -1.0f;
            else { sc = 0.f;
#pragma unroll 1
                for (int o = 0; o < 5; ++o) { const int cc = 4 * j + o - 1; if (cc < 0 || cc >= nv) continue;
                    const float* kp = kcmp + ((size_t)g * 1024 + cc) * 64; float d0 = 0.f, d1 = 0.f, d2 = 0.f, d3 = 0.f;
#pragma unroll 4
                    for (int i = 0; i < 16; ++i) { const f32x4 f = *(const f32x4*)(kp + i * 4);
#pragma unroll
                        for (int k = 0; k < 4; ++k) { d0 += qs[i * 4 + k] * f[k]; d1 += qs[64 + i * 4 + k] * f[k]; d2 += qs[128 + i * 4 + k] * f[k]; d3 += qs[192 + i * 4 + k] * f[k]; } }
                    const int bk = t5_bucket(t - 16 * cc - 31) * 16 + g * 4;
                    const float imp = __expf(d0 + tb[bk] - mr[0]) * il[0] + __expf(d1 + tb[bk + 1] - mr[1]) * il[1] + __expf(d2 + tb[bk + 2] - mr[2]) * il[2] + __expf(d3 + tb[bk + 3] - mr[3]) * il[3];
                    sc += ((o == 0 || o == 4) ? 1.0f : 2.0f) * imp; }
            }
            sv[j] = sc;
        }
        asm volatile("s_waitcnt lgkmcnt(0)" ::: "memory");
        float val[4];
#pragma unroll
        for (int jj = 0; jj < 4; ++jj) val[jj] = sv[c.lane + 64 * jj];
        for (int k = 0; k < 16; ++k) {
            float bv = val[0]; int bi = c.lane;
#pragma unroll
            for (int jj = 1; jj < 4; ++jj) if (val[jj] > bv) { bv = val[jj]; bi = c.lane + 64 * jj; }
#pragma unroll
            for (int o = 32; o >= 1; o >>= 1) { const float ov = __shfl_xor(bv, o); const int oi = __shfl_xor(bi, o); if (ov > bv || (ov == bv && oi < bi)) { bv = ov; bi = oi; } }
#pragma unroll
            for (int jj = 0; jj < 4; ++jj) if (bi == c.lane + 64 * jj) val[jj] = -3e38f;
            if (c.lane == 0) sel[(size_t)item * 16 + k] = bi;
        }
    }
}
__device__ __forceinline__ void phase_nsa2(const Ctx& c, const Args& a, const bf16_t* proj, const int* sel, const float* nsaacc, bf16_t* onsa) {
    LAS float* tb = (LAS float*)c.lds;
    for (int e = c.tid; e < 512; e += 512) tb[e] = inptr(c, I_REL)[e];
    __syncthreads();
    for (int unit = c.bid; unit < T / 64; unit += c.G) {
        const int hh = c.tid >> 6, t = unit * 64 + (c.tid & 63), g = hh >> 2;
        RowState s; row_init(s, proj + (size_t)t * PLD + PC_NQ + hh * 64); row_reset(s);
        const float g1 = sigmoidf_(bf2f(proj[(size_t)t * PLD + PC_GL + 8 + hh]));
        for (int k = 0; k < 16; ++k) { const int j = sel[((size_t)t * 2 + g) * 16 + k];
            for (int p = 0; p < 64; ++p) { const int pos = j * 64 + p; if (pos > t) break;
                const float bias = tb[t5_bucket(t - pos) * 16 + hh];
                row_key_bf16(s, proj + (size_t)pos * PLD + PC_KS + g * 64, proj + (size_t)pos * PLD + PC_VS + g * 64, bias); } }
        const float inv = s.l > 0.f ? g1 / s.l : 0.f; const float* ap = nsaacc + (size_t)t * 512 + hh * 64; bf16_t* op = onsa + (size_t)t * 512 + hh * 64;
#pragma unroll
        for (int i = 0; i < 8; ++i) { const f32x4 x0 = *(const f32x4*)(ap + i * 8), x1 = *(const f32x4*)(ap + i * 8 + 4); u32x4 w;
            w.x = pk2(x0[0] + s.o[i * 8] * inv, x0[1] + s.o[i * 8 + 1] * inv); w.y = pk2(x0[2] + s.o[i * 8 + 2] * inv, x0[3] + s.o[i * 8 + 3] * inv);
            w.z = pk2(x1[0] + s.o[i * 8 + 4] * inv, x1[1] + s.o[i * 8 + 5] * inv); w.w = pk2(x1[2] + s.o[i * 8 + 6] * inv, x1[3] + s.o[i * 8 + 7] * inv);
            *(u32x4*)(op + i * 8) = w; }
    }
}
__device__ __forceinline__ void phase_swa(const Ctx& c, const Args& a, int layer, const bf16_t* proj, bf16_t* oswa) {
    LAS float* tb = (LAS float*)c.lds;
    for (int e = c.tid; e < 512; e += 512) tb[e] = inptr(c, I_REL)[e];
    __syncthreads();
    for (int unit = c.bid; unit < T / 64; unit += c.G) {
        const int hh = c.tid >> 6, t = unit * 64 + (c.tid & 63), g = hh >> 2;
        RowState s; row_init(s, proj + (size_t)t * PLD + PC_SQ + hh * 64); row_reset(s);
        const int s0 = t - 127 > 0 ? t - 127 : 0;
        for (int sp = s0; sp <= t; ++sp) { const float bias = tb[t5_bucket(t - sp) * 16 + 8 + hh];
            row_key_bf16(s, proj + (size_t)sp * PLD + PC_SK + g * 64, proj + (size_t)sp * PLD + PC_SV + g * 64, bias); }
        const float sink = inptr(c, I_SINK)[layer * 8 + hh]; const float mf = fmaxf(s.m, sink); const float corr = __expf(s.m - mf);
        const float den = s.l * corr + __expf(sink - mf); const float inv = corr / den;
        bf16_t* op = oswa + (size_t)t * 512 + hh * 64;
#pragma unroll
        for (int i = 0; i < 8; ++i) { u32x4 w; w.x = pk2(s.o[i * 8] * inv, s.o[i * 8 + 1] * inv); w.y = pk2(s.o[i * 8 + 2] * inv, s.o[i * 8 + 3] * inv);
            w.z = pk2(s.o[i * 8 + 4] * inv, s.o[i * 8 + 5] * inv); w.w = pk2(s.o[i * 8 + 6] * inv, s.o[i * 8 + 7] * inv); *(u32x4*)(op + i * 8) = w; }
    }
}

constexpr int RL = 65;
__device__ __forceinline__ float rwkv_mixed(const bf16_t* proj, const float* mu, int t, int col) {
    const float cur = bf2f(proj[(size_t)t * PLD + col]); const float prev = t > 0 ? bf2f(proj[(size_t)(t - 1) * PLD + col]) : 0.f;
    return cur + (prev - cur) * mu[col];
}
__device__ __forceinline__ void lora64(const Ctx& c, const LAS float* in, const float* W, const float* bias, LAS float* out, bool accum) {
    const int j = c.tid & 63, tg = (c.tid >> 6) * 8;
    float acc[8];
#pragma unroll
    for (int i = 0; i < 8; ++i) acc[i] = accum ? out[(tg + i) * RL + j] : (bias ? bias[j] : 0.f);
#pragma unroll 4
    for (int m = 0; m < 64; ++m) { const float w = W[(size_t)m * 512 + j];
#pragma unroll
        for (int i = 0; i < 8; ++i) acc[i] += in[(tg + i) * RL + m] * w; }
#pragma unroll
    for (int i = 0; i < 8; ++i) out[(tg + i) * RL + j] = acc[i];
}
struct RwkvLds { LAS float *R, *K, *V, *A, *B, *W, *G, *TMP; };
__device__ __forceinline__ RwkvLds rwkv_lds(LAS unsigned char* lds) {
    RwkvLds s; LAS float* p = (LAS float*)lds; constexpr int SZ = 64 * RL;
    s.R = p; s.K = p + SZ; s.V = p + 2 * SZ; s.A = p + 3 * SZ; s.B = p + 4 * SZ; s.W = p + 5 * SZ; s.G = p + 6 * SZ; s.TMP = p + 7 * SZ; return s;
}
template <bool LOGDECAY>
__device__ __forceinline__ void rwkv_prep(const Ctx& c, const Args& a, int layer, const bf16_t* proj, int t0, int h, const RwkvLds& s) {
    const float* mu = inptr(c, I_MU) + (size_t)layer * 1792;
    const int j = c.tid & 63, tg = c.tid >> 6;
#pragma unroll 2
    for (int i = 0; i < 8; ++i) { const int tt = tg * 8 + i; s.TMP[tt * RL + j] = tanhf(rwkv_mixed(proj, mu, t0 + tt, PC_ZW + j)); }
    __syncthreads();
    lora64(c, s.TMP, inptr(c, I_W2) + (size_t)layer * 64 * 512 + h * 64, inptr(c, I_W0) + layer * 512 + h * 64, s.W, false);
    __syncthreads();
#pragma unroll 2
    for (int i = 0; i < 8; ++i) { const int tt = tg * 8 + i; s.TMP[tt * RL + j] = rwkv_mixed(proj, mu, t0 + tt, PC_ZA + j); }
    __syncthreads();
    lora64(c, s.TMP, inptr(c, I_A2) + (size_t)layer * 64 * 512 + h * 64, inptr(c, I_A0) + layer * 512 + h * 64, s.B, false);
    __syncthreads();
#pragma unroll 2
    for (int i = 0; i < 8; ++i) { const int tt = tg * 8 + i; s.TMP[tt * RL + j] = sigmoidf_(rwkv_mixed(proj, mu, t0 + tt, PC_ZG + j)); }
    __syncthreads();
    lora64(c, s.TMP, inptr(c, I_G2) + (size_t)layer * 128 * 512 + h * 64, nullptr, s.G, false);
    __syncthreads();
#pragma unroll 2
    for (int i = 0; i < 8; ++i) { const int tt = tg * 8 + i; s.TMP[tt * RL + j] = sigmoidf_(rwkv_mixed(proj, mu, t0 + tt, PC_ZG + 64 + j)); }
    __syncthreads();
    lora64(c, s.TMP, inptr(c, I_G2) + ((size_t)layer * 128 + 64) * 512 + h * 64, nullptr, s.G, true);
    const float kkw = inptr(c, I_KK)[layer * 512 + h * 64 + j], kaw = inptr(c, I_KA)[layer * 512 + h * 64 + j];
#pragma unroll 1
    for (int i = 0; i < 8; ++i) { const int tt = tg * 8 + i, t = t0 + tt;
        const float r = rwkv_mixed(proj, mu, t, PC_R + h * 64 + j), k = rwkv_mixed(proj, mu, t, PC_K + h * 64 + j), v = rwkv_mixed(proj, mu, t, PC_V + h * 64 + j);
        const float wl = s.W[tt * RL + j], al = sigmoidf_(s.B[tt * RL + j]);
        const float sp = (-wl > 20.f) ? -wl : log1pf(__expf(-wl)); const float w = -sp - 0.5f; const float ew = __expf(w);
        float kk = k * kkw; const float n2 = wave_sum(kk * kk); kk = kk / fmaxf(sqrtf(n2), 1e-12f);
        s.R[tt * RL + j] = r; s.V[tt * RL + j] = v; s.K[tt * RL + j] = k * (1.0f + (al - 1.0f) * kaw);
        s.A[tt * RL + j] = -kk; s.B[tt * RL + j] = kk * al; s.W[tt * RL + j] = LOGDECAY ? -ew : __expf(-ew); }
    __syncthreads();
}
__device__ __forceinline__ void rwkv_post(const Ctx& c, const Args& a, int layer, int t0, int h, const RwkvLds& s, const LAS float* Y, bf16_t* orwkv) {
    const int i = c.lane, tg = c.wave;
    const float lnw = inptr(c, I_LNW)[layer * 512 + h * 64 + i], lnb = inptr(c, I_LNB)[layer * 512 + h * 64 + i], rk = inptr(c, I_RK)[layer * 512 + h * 64 + i];
#pragma unroll 1
    for (int q = 0; q < 8; ++q) { const int tt = tg * 8 + q; const float y = Y[tt * RL + i];
        const float mean = wave_sum(y) * (1.0f / 64.0f); const float d = y - mean; const float var = wave_sum(d * d) * (1.0f / 64.0f);
        const float bonus = wave_sum(s.R[tt * RL + i] * s.K[tt * RL + i] * rk);
        const float o = (d * rsqrtf(var + 64e-5f) * lnw + lnb + bonus * s.V[tt * RL + i]) * s.G[tt * RL + i];
        orwkv[(size_t)(t0 + tt) * 512 + h * 64 + i] = (bf16_t)f2bf(o); }
}
__device__ __forceinline__ void phase_rwkv_naive(const Ctx& c, const Args& a, int layer, const bf16_t* proj, bf16_t* orwkv) {
    if (c.bid >= 8) return;
    const int h = c.bid; const RwkvLds s = rwkv_lds(c.lds);
    float S[64];
#pragma unroll
    for (int j = 0; j < 64; ++j) S[j] = 0.f;
    for (int ch = 0; ch < T / 64; ++ch) {
        rwkv_prep<false>(c, a, layer, proj, ch * 64, h, s);
        if (c.wave == 0) {
            const int i = c.lane;
            for (int tt = 0; tt < 64; ++tt) {
                float sa = 0.f;
#pragma unroll
                for (int j = 0; j < 64; ++j) { sa += S[j] * s.A[tt * RL + j]; if ((j & 7) == 7) __builtin_amdgcn_sched_barrier(0); }
                const float vi = s.V[tt * RL + i]; float y = 0.f;
#pragma unroll
                for (int j = 0; j < 64; ++j) { S[j] = S[j] * s.W[tt * RL + j] + sa * s.B[tt * RL + j] + vi * s.K[tt * RL + j]; y += S[j] * s.R[tt * RL + j]; if ((j & 3) == 3) __builtin_amdgcn_sched_barrier(0); }
                s.TMP[tt * RL + i] = y;
            }
        }
        __syncthreads();
        rwkv_post(c, a, layer, ch * 64, h, s, s.TMP, orwkv);
        __syncthreads();
    }
}


__device__ __forceinline__ int kperm32(int jl) { return 8 * ((jl >> 2) & 3) + 4 * (jl >> 4) + (jl & 3); }
__device__ __forceinline__ f32x4 tile_mma64(const LAS unsigned char* A, const LAS unsigned char* B, int a, int b, int lane, f32x4 acc) {
    const int m = lane & 15, q = lane >> 4;
#pragma unroll
    for (int ks = 0; ks < 2; ++ks) {
        const bf16x8 af = *(const LAS bf16x8*)(A + (16 * a + m) * 144 + (32 * ks + 8 * q) * 2);
        const bf16x8 bf = *(const LAS bf16x8*)(B + (16 * b + m) * 144 + (32 * ks + 8 * q) * 2);
        acc = __builtin_amdgcn_mfma_f32_16x16x32_bf16(af, bf, acc, 0, 0, 0);
    }
    return acc;
}
__device__ __forceinline__ void lds_st_bf16(LAS unsigned char* base, int idx, float v) { *(LAS bf16_t*)(base + idx * 2) = (bf16_t)f2bf(v); }

__device__ __forceinline__ void phase_lora_a(const Ctx& c, const Args& a, int layer, const bf16_t* proj, bf16_t* alora) {
    const float* mu = inptr(c, I_MU) + (size_t)layer * 1792;
    const int sub = c.tid & 31, rloc = c.tid >> 5;
    for (int t = c.bid * 16 + rloc; t < T; t += c.G * 16) {
        const int col = PC_ZW + sub * 8; float cur[8], prv[8];
        unpack8(*(const u32x4*)(proj + (size_t)t * PLD + col), cur);
        if (t > 0) unpack8(*(const u32x4*)(proj + (size_t)(t - 1) * PLD + col), prv); else {
#pragma unroll
            for (int k = 0; k < 8; ++k) prv[k] = 0.f; }
        float o[8];
#pragma unroll
        for (int k = 0; k < 8; ++k) { const float v = cur[k] + (prv[k] - cur[k]) * mu[col + k]; o[k] = sub < 8 ? tanhf(v) : (sub < 16 ? v : sigmoidf_(v)); }
        u32x4 w; w.x = pk2(o[0], o[1]); w.y = pk2(o[2], o[3]); w.z = pk2(o[4], o[5]); w.w = pk2(o[6], o[7]);
        *(u32x4*)(alora + (size_t)t * 256 + sub * 8) = w;
    }
}

constexpr int RC_L = 0, RC_AL = 16640, RC_AAK = 0, RC_ARB = 9216, RC_ARK = 18432, RC_AAB = 33280, RC_P2T = 33280, RC_WC = 50688, RC_BS = 50944, RC_M = 52992;
constexpr int RC_AT = RC_M, RC_TINV = RC_M, RC_ATT = RC_M + 9216, RC_RT = RC_M + 2 * 9216, RC_BT = RC_M + 3 * 9216, RC_XT = RC_BT, RC_KT = RC_M + 4 * 9216, RC_P1T = RC_KT,
              RC_VT = RC_M + 5 * 9216, RC_BHT = RC_M + 6 * 9216, RC_KHT = RC_M + 7 * 9216;
constexpr int RC_XOFF = RC_M + 8 * 9216, RC_XTMP = RC_XOFF + 6144;
static_assert(RC_XTMP + 3 * 1088 <= LDS_MISC, "rwkv chunk LDS");

__device__ __forceinline__ void phase_rwkv_chunk(const Ctx& c, const Args& a, int layer, const bf16_t* proj, const bf16_t* wlb, const bf16_t* alb, bf16_t* rwu, float* bonusg) {
    LAS unsigned char* L = c.lds;
    LAS float* sL = (LAS float*)(L + RC_L); LAS float* sAL = (LAS float*)(L + RC_AL); LAS float* sAAB = (LAS float*)(L + RC_AAB);
    LAS float* sWC = (LAS float*)(L + RC_WC); LAS float* sBS = (LAS float*)(L + RC_BS);
    const float* mu = inptr(c, I_MU) + (size_t)layer * 1792;
    const int lane = c.lane, wave = c.wave, n = lane & 15, q = lane >> 4;
    for (int unit = c.bid; unit < 2048; unit += c.G) {
        const int ch = unit >> 3, h = unit & 7, t0 = ch * 64, j = lane;
        {
            const float w0 = inptr(c, I_W0)[layer * 512 + h * 64 + j], a0 = inptr(c, I_A0)[layer * 512 + h * 64 + j];
            bf16_t wraw[8], araw[8];
#pragma unroll
            for (int i = 0; i < 8; ++i) { const size_t gi = (size_t)(t0 + wave * 8 + i) * 512 + h * 64 + j; wraw[i] = wlb[gi]; araw[i] = alb[gi]; }
            float run = 0.f;
#pragma unroll
            for (int i = 0; i < 8; ++i) { const int tt = wave * 8 + i;
                const float wl = w0 + bf2f(wraw[i]); const float nx = -wl; const float sp = nx > 20.f ? nx : log1pf(__expf(nx)); const float ld = -__expf(-sp - 0.5f);
                run += ld; sL[tt * RL + j] = run; sAL[tt * RL + j] = sigmoidf_(a0 + bf2f(araw[i])); }
            sBS[wave * 64 + j] = run;
        }
        bf16_t rraw[9], kraw[9], vraw[9];
        {
#pragma unroll
            for (int i = 0; i < 9; ++i) { const int t = t0 + wave * 8 + i - 1; const bool ok = t >= 0; const size_t ro = (size_t)(ok ? t : 0) * PLD + h * 64 + j;
                rraw[i] = ok ? proj[ro + PC_R] : (bf16_t)0; kraw[i] = ok ? proj[ro + PC_K] : (bf16_t)0; vraw[i] = ok ? proj[ro + PC_V] : (bf16_t)0; }
        }
        __syncthreads();
        {
            float off = 0.f, tot = 0.f;
#pragma unroll
            for (int w2 = 0; w2 < 8; ++w2) { const float v = sBS[w2 * 64 + j]; tot += v; off += (w2 < wave) ? v : 0.f; }
            if (wave == 0) sWC[j] = __expf(tot);
            const float kkw = inptr(c, I_KK)[layer * 512 + h * 64 + j], kaw = inptr(c, I_KA)[layer * 512 + h * 64 + j], rk = inptr(c, I_RK)[layer * 512 + h * 64 + j];
            const float mur = mu[PC_R + h * 64 + j], muk = mu[PC_K + h * 64 + j], muv = mu[PC_V + h * 64 + j];
            float Lprev = off;
#pragma unroll
            for (int i = 0; i < 8; ++i) { const int tt = wave * 8 + i, t = t0 + tt;
                const float Lc = sL[tt * RL + j] + off, al = sAL[tt * RL + j];
                const float rc = bf2f(rraw[i + 1]), kc = bf2f(kraw[i + 1]), vc = bf2f(vraw[i + 1]);
                const float r = rc + (bf2f(rraw[i]) - rc) * mur, k = kc + (bf2f(kraw[i]) - kc) * muk, v = vc + (bf2f(vraw[i]) - vc) * muv;
                float kk = k * kkw; const float n2 = wave_sum(kk * kk); kk = kk / fmaxf(sqrtf(n2), 1e-12f);
                const float kp = k * (1.0f + (al - 1.0f) * kaw), av = -kk, bv = kk * al;
                const float eW = __expf(Lc), eWex = __expf(Lprev), eInv = __expf(-Lc), eC = __expf(tot - Lc);
                lds_st_bf16(L + RC_AT, tt * 72 + j, av * eWex); lds_st_bf16(L + RC_ATT, j * 72 + tt, av * eWex);
                lds_st_bf16(L + RC_RT, tt * 72 + j, r * eW); lds_st_bf16(L + RC_BT, tt * 72 + j, bv * eInv); lds_st_bf16(L + RC_KT, tt * 72 + j, kp * eInv);
                lds_st_bf16(L + RC_VT, j * 72 + tt, v); lds_st_bf16(L + RC_BHT, j * 72 + tt, bv * eC); lds_st_bf16(L + RC_KHT, j * 72 + tt, kp * eC);
                const float bon = wave_sum(r * kp * rk); if (lane == 0) bonusg[(size_t)t * 8 + h] = bon;
                Lprev = Lc; }
        }
        __syncthreads();
        for (int job = wave; job < 64; job += 8) {
            const int p = job >> 4, ta = (job >> 2) & 3, tb = job & 3;
            f32x4 acc = (f32x4){0.f, 0.f, 0.f, 0.f};
            if (ta >= tb) acc = tile_mma64(L + (p < 2 ? RC_AT : RC_RT), L + ((p & 1) ? RC_KT : RC_BT), ta, tb, lane, acc);
            LAS unsigned char* dst = L + (p == 1 ? RC_AAK : (p == 2 ? RC_ARB : RC_ARK));
#pragma unroll
            for (int r = 0; r < 4; ++r) { const int tt = 16 * ta + 4 * q + r, ss = 16 * tb + n; const bool keep = (p < 2) ? (ss < tt) : (ss <= tt); const float v = keep ? acc[r] : 0.f;
                if (p == 0) sAAB[tt * 68 + ss] = v; else lds_st_bf16(dst, tt * 72 + ss, v); }
        }
        __syncthreads();
        if (wave == 0) {
            const int blk = lane >> 4, cc = lane & 15; const LAS float* Ab = sAAB + (16 * blk) * 68 + 16 * blk; float xr[16];
#pragma unroll
            for (int tt = 0; tt < 16; ++tt) { float acc = (tt == cc) ? 1.f : 0.f;
#pragma unroll
                for (int ss = 0; ss < tt; ++ss) acc += Ab[tt * 68 + ss] * xr[ss];
                xr[tt] = acc; }
            asm volatile("s_waitcnt lgkmcnt(0)" ::: "memory");
#pragma unroll
            for (int tt = 0; tt < 16; ++tt) sAAB[(16 * blk + tt) * 68 + 16 * blk + cc] = xr[tt];
        } else {
            for (int job = wave - 1; job < 16; job += 7) { const int ta = job >> 2, tb = job & 3;
                const f32x4 acc = tile_mma64(L + RC_VT, L + RC_AAK, ta, tb, lane, (f32x4){0.f, 0.f, 0.f, 0.f});
#pragma unroll
                for (int r = 0; r < 4; ++r) lds_st_bf16(L + RC_XT, (16 * ta + 4 * q + r) * 72 + 16 * tb + n, acc[r]); }
        }
        __syncthreads();
        {
            LAS float* sXO = (LAS float*)(L + RC_XOFF); LAS float* sT = (LAS float*)(L + RC_XTMP) + wave * 272;
            const int rr = lane >> 2, c4 = (lane & 3) * 4;
#pragma unroll 1
            for (int lev = 1; lev <= 3; ++lev) {
                if (wave < 4 - lev) {
                    const int J = wave, I = wave + lev;
                    f32x4 tacc = (f32x4){0.f, 0.f, 0.f, 0.f};
                    for (int K = J; K < I; ++K) {
                        const LAS float* Ap = sAAB + (16 * I + rr) * 68 + 16 * K; const LAS float* Xp;
                        int xs;
                        if (K == J) { Xp = sAAB + (16 * J) * 68 + 16 * J + c4; xs = 68; }
                        else { const int d = K - J; const int bi = (d == 1) ? J : 3 + J; Xp = sXO + bi * 256 + c4; xs = 16; }
#pragma unroll
                        for (int k = 0; k < 16; ++k) { const float av = Ap[k]; const f32x4 xv = *(const LAS f32x4*)(Xp + k * xs); tacc += xv * av; }
                    }
                    *(LAS f32x4*)(sT + rr * 16 + c4) = tacc;
                    asm volatile("s_waitcnt lgkmcnt(0)" ::: "memory");
                    f32x4 xacc = (f32x4){0.f, 0.f, 0.f, 0.f};
                    const LAS float* Dp = sAAB + (16 * I + rr) * 68 + 16 * I;
#pragma unroll
                    for (int k = 0; k < 16; ++k) { const float dv = Dp[k]; const f32x4 tv = *(const LAS f32x4*)(sT + k * 16 + c4); xacc += tv * dv; }
                    const int bo = (lev == 1) ? J : (lev == 2 ? 3 + J : 5);
                    *(LAS f32x4*)(sXO + bo * 256 + rr * 16 + c4) = xacc;
                }
                __syncthreads();
            }
            for (int e = c.tid; e < 4096; e += 512) { const int tt = e >> 6, ss = e & 63, I = tt >> 4, J = ss >> 4; float v = 0.f;
                if (I == J) v = sAAB[tt * 68 + ss];
                else if (I > J) { const int d = I - J; const int bi = (d == 1) ? J : (d == 2 ? 3 + J : 5); v = sXO[bi * 256 + (tt & 15) * 16 + (ss & 15)]; }
                lds_st_bf16(L + RC_TINV, tt * 72 + ss, v); }
        }
        __syncthreads();
        for (int job = wave; job < 32; job += 8) { const int p = job >> 4, ta = (job >> 2) & 3, tb = job & 3;
            const f32x4 acc = tile_mma64(L + (p ? RC_XT : RC_ATT), L + RC_TINV, ta, tb, lane, (f32x4){0.f, 0.f, 0.f, 0.f});
#pragma unroll
            for (int r = 0; r < 4; ++r) lds_st_bf16(L + (p ? RC_P2T : RC_P1T), (16 * ta + 4 * q + r) * 72 + 16 * tb + n, acc[r]); }
        __syncthreads();
        bf16_t* ug = rwu + (size_t)unit * 16384;
        for (int job = wave; job < 64; job += 8) { const int p = job >> 4, ta = (job >> 2) & 3, tb = job & 3;
            f32x4 acc = (f32x4){0.f, 0.f, 0.f, 0.f};
            if (p == 0) { acc = tile_mma64(L + RC_ARB, L + RC_P1T, ta, tb, lane, acc);
#pragma unroll
                for (int r = 0; r < 4; ++r) { const int tt = 16 * ta + 4 * q + r, jj = 16 * tb + n; const float v = acc[r] + bf2f(*(const LAS bf16_t*)(L + RC_RT + (tt * 72 + jj) * 2));
                    ug[8192 + tt * 64 + (jj & 32) + kperm32(jj & 31)] = (bf16_t)f2bf(v); } }
            else if (p == 1) { acc = tile_mma64(L + RC_ARB, L + RC_P2T, ta, tb, lane, acc); acc = tile_mma64(L + RC_ARK, L + RC_VT, ta, tb, lane, acc);
                u32x2 w; w.x = pk2(acc[0], acc[1]); w.y = pk2(acc[2], acc[3]); *(u32x2*)(ug + 12288 + ((tb * 4 + ta) * 64 + lane) * 4) = w; }
            else if (p == 2) { acc = tile_mma64(L + RC_BHT, L + RC_P1T, ta, tb, lane, acc);
#pragma unroll
                for (int r = 0; r < 4; ++r) { const int jr = 16 * ta + 4 * q + r, jc = 16 * tb + n; const float v = acc[r] + (jr == jc ? sWC[jr] : 0.f);
                    ug[jr * 64 + (jc & 32) + kperm32(jc & 31)] = (bf16_t)f2bf(v); } }
            else { acc = tile_mma64(L + RC_BHT, L + RC_P2T, ta, tb, lane, acc); acc = tile_mma64(L + RC_KHT, L + RC_VT, ta, tb, lane, acc);
                u32x2 w; w.x = pk2(acc[0], acc[1]); w.y = pk2(acc[2], acc[3]); *(u32x2*)(ug + 4096 + ((tb * 4 + ta) * 64 + lane) * 4) = w; }
        }
        __syncthreads();
    }
}

#define RW_LOAD_SET(SET, UNIT) do { const bf16_t* ug_ = rwu + (size_t)(UNIT) * 16384; \
    _Pragma("unroll") for (int ta = 0; ta < 4; ++ta) { An[SET][ta][0] = *(const bf16x8*)(ug_ + (16 * ta + m) * 64 + 8 * q); An[SET][ta][1] = *(const bf16x8*)(ug_ + (16 * ta + m) * 64 + 32 + 8 * q); \
        Zn[SET][ta] = *(const u32x2*)(ug_ + 4096 + ((cq * 4 + ta) * 64 + lane) * 4); } } while (0)
template <int SM>
__device__ __forceinline__ void phase_rwkv_scan(const Ctx& c, const bf16_t* rwu, bf16_t* rws) {
    const int idx = c.bid; if (idx >= 32 || c.wave != 0) return;
    const int h = idx >> 2, cq = idx & 3, lane = c.lane, m = lane & 15, q = lane >> 4;
    bf16x8 Bhi[2], Blo[2];
#pragma unroll
    for (int s = 0; s < 2; ++s) { Bhi[s] = (bf16x8){0, 0, 0, 0, 0, 0, 0, 0}; Blo[s] = Bhi[s]; }
    bf16x8 An[4][4][2]; u32x2 Zn[4][4];
#pragma unroll
    for (int u = 0; u < 4; ++u) RW_LOAD_SET(u, u * 8 + h);
    if (SM == 1) {
        for (int ch = 0; ch < T / 64; ch += 8) {
#pragma unroll
            for (int uu = 0; uu < 8; ++uu) { const int u = uu & 3; const int unit = (ch + uu) * 8 + h;
                bf16_t* sg = rws + (size_t)unit * 4096 + cq * 1024 + lane * 8;
                *(bf16x8*)(sg) = Bhi[0]; *(bf16x8*)(sg + 512) = Bhi[1];
#pragma unroll
                for (int ta = 0; ta < 4; ++ta) { Bhi[0] = Bhi[0] ^ An[u][ta][0]; Bhi[1] = Bhi[1] ^ An[u][ta][1]; Bhi[0][0] ^= (short)Zn[u][ta].x; }
                RW_LOAD_SET(u, (ch + uu + 4 < T / 64) ? unit + 32 : unit); } }
        return;
    }
    for (int ch = 0; ch < T / 64; ch += 8) {
#pragma unroll
        for (int uu = 0; uu < 8; ++uu) {
            const int u = uu & 3;
            const int unit = (ch + uu) * 8 + h;
            bf16_t* sg = rws + (size_t)unit * 4096 + cq * 1024 + lane * 8;
            *(bf16x8*)(sg) = Bhi[0]; *(bf16x8*)(sg + 512) = Bhi[1];
            f32x4 acc[4];
#pragma unroll
            for (int ta = 0; ta < 4; ++ta) { const u32x2 z = Zn[u][ta];
                acc[ta] = (f32x4){__uint_as_float(z.x << 16), __uint_as_float(z.x & 0xffff0000u), __uint_as_float(z.y << 16), __uint_as_float(z.y & 0xffff0000u)};
#pragma unroll
                for (int s = 0; s < 2; ++s) { acc[ta] = __builtin_amdgcn_mfma_f32_16x16x32_bf16(An[u][ta][s], Bhi[s], acc[ta], 0, 0, 0); acc[ta] = __builtin_amdgcn_mfma_f32_16x16x32_bf16(An[u][ta][s], Blo[s], acc[ta], 0, 0, 0); } }
            if (SM == 0) RW_LOAD_SET(u, (ch + uu + 4 < T / 64) ? unit + 32 : unit);
#pragma unroll
            for (int s = 0; s < 2; ++s) { u32x4 hi, lo; float rem[8];
#pragma unroll
                for (int p = 0; p < 8; ++p) { const float v = acc[2 * s + (p >> 2)][p & 3]; const unsigned hb = f2bf(v); rem[p] = v - __uint_as_float(hb << 16); }
                hi.x = pk2(acc[2 * s][0], acc[2 * s][1]); hi.y = pk2(acc[2 * s][2], acc[2 * s][3]); hi.z = pk2(acc[2 * s + 1][0], acc[2 * s + 1][1]); hi.w = pk2(acc[2 * s + 1][2], acc[2 * s + 1][3]);
                lo.x = pk2(rem[0], rem[1]); lo.y = pk2(rem[2], rem[3]); lo.z = pk2(rem[4], rem[5]); lo.w = pk2(rem[6], rem[7]);
                Bhi[s] = __builtin_bit_cast(bf16x8, hi); Blo[s] = __builtin_bit_cast(bf16x8, lo); }
        }
    }
}
#undef RW_LOAD_SET

__device__ __forceinline__ void phase_rwkv_out(const Ctx& c, const Args& a, int layer, const bf16_t* proj, const bf16_t* rwu, const bf16_t* rws, const float* bonusg, bf16_t* orwkv) {
    const float* mu = inptr(c, I_MU) + (size_t)layer * 1792;
    const int lane = c.lane, m = lane & 15, q = lane >> 4;
    for (int unit = c.bid * 8 + c.wave; unit < 2048; unit += c.G * 8) {
        const int ch = unit >> 3, h = unit & 7, t0 = ch * 64; const bf16_t* ug = rwu + (size_t)unit * 16384; const bf16_t* sg = rws + (size_t)unit * 4096;
        bf16x8 Bf[4][2];
#pragma unroll
        for (int cq = 0; cq < 4; ++cq) { Bf[cq][0] = *(const bf16x8*)(sg + cq * 1024 + lane * 8); Bf[cq][1] = *(const bf16x8*)(sg + cq * 1024 + 512 + lane * 8); }
        float lnw[4], lnb[4];
#pragma unroll
        for (int cq = 0; cq < 4; ++cq) { lnw[cq] = inptr(c, I_LNW)[layer * 512 + h * 64 + 16 * cq + m]; lnb[cq] = inptr(c, I_LNB)[layer * 512 + h * 64 + 16 * cq + m]; }
#pragma unroll 1
        for (int ta = 0; ta < 4; ++ta) {
            const bf16x8 A0 = *(const bf16x8*)(ug + 8192 + (16 * ta + m) * 64 + 8 * q), A1 = *(const bf16x8*)(ug + 8192 + (16 * ta + m) * 64 + 32 + 8 * q);
            f32x4 y[4];
#pragma unroll
            for (int cq = 0; cq < 4; ++cq) { const u32x2 z = *(const u32x2*)(ug + 12288 + ((cq * 4 + ta) * 64 + lane) * 4);
                y[cq] = (f32x4){__uint_as_float(z.x << 16), __uint_as_float(z.x & 0xffff0000u), __uint_as_float(z.y << 16), __uint_as_float(z.y & 0xffff0000u)};
                y[cq] = __builtin_amdgcn_mfma_f32_16x16x32_bf16(A0, Bf[cq][0], y[cq], 0, 0, 0); y[cq] = __builtin_amdgcn_mfma_f32_16x16x32_bf16(A1, Bf[cq][1], y[cq], 0, 0, 0); }
#pragma unroll
            for (int r = 0; r < 4; ++r) { const int t = t0 + 16 * ta + 4 * q + r;
                float sm = y[0][r] + y[1][r] + y[2][r] + y[3][r];
                sm += __shfl_xor(sm, 1); sm += __shfl_xor(sm, 2); sm += __shfl_xor(sm, 4); sm += __shfl_xor(sm, 8);
                const float mean = sm * (1.0f / 64.0f); float d[4], vs = 0.f;
#pragma unroll
                for (int cq = 0; cq < 4; ++cq) { d[cq] = y[cq][r] - mean; vs += d[cq] * d[cq]; }
                vs += __shfl_xor(vs, 1); vs += __shfl_xor(vs, 2); vs += __shfl_xor(vs, 4); vs += __shfl_xor(vs, 8);
                const float rstd = rsqrtf(vs * (1.0f / 64.0f) + 64e-5f); const float bon = bonusg[(size_t)t * 8 + h];
#pragma unroll
                for (int cq = 0; cq < 4; ++cq) { const int col = h * 64 + 16 * cq + m; const float v = rwkv_mixed(proj, mu, t, PC_V + col);
                    bf16_t* op = orwkv + (size_t)t * 512 + col; const float g = bf2f(*op);
                    *op = (bf16_t)f2bf((d[cq] * rstd * lnw[cq] + lnb[cq] + bon * v) * g); } }
        }
    }
}


constexpr int AT_K = 0, AT_V = 9216, AT_BIAS = 18432, AT_SELM = 34816, AT_LIST = 38912, AT_NLIST = 39936, AT_NEED = 39968;
__device__ __forceinline__ void vt_transpose(const Ctx& c, const bf16_t* proj, bf16_t* vt) {
    LAS bf16_t* tl = (LAS bf16_t*)c.lds;
    for (int it = c.bid; it < 3 * 2 * 256; it += c.G) {
        const int which = it / 512, g = (it >> 8) & 1, tt = it & 255;
        const int col = (which == 0 ? PC_VS : (which == 1 ? PC_VW : PC_SV)) + g * 64;
        { const int tok = c.tid >> 3, ch = c.tid & 7; const u32x4 w = *(const u32x4*)(proj + (size_t)(tt * 64 + tok) * PLD + col + ch * 8);
          *(LAS u32x4*)(tl + tok * 72 + ch * 8) = w; }
        __syncthreads();
        { const int d = c.tid >> 3, ch = c.tid & 7; unsigned short e[8];
#pragma unroll
          for (int k = 0; k < 8; ++k) e[k] = tl[(ch * 8 + k) * 72 + d];
          u32x4 w; w.x = e[0] | ((unsigned)e[1] << 16); w.y = e[2] | ((unsigned)e[3] << 16); w.z = e[4] | ((unsigned)e[5] << 16); w.w = e[6] | ((unsigned)e[7] << 16);
          *(u32x4*)(vt + ((size_t)(which * 2 + g) * 64 + d) * T + tt * 64 + ch * 8) = w; }
        __syncthreads();
    }
}

template <int MODE, int NQ>
__device__ __forceinline__ void phase_attn(const Ctx& c, const Args& a, int layer, const bf16_t* proj, const bf16_t* vtb, const bf16_t* kcb, const bf16_t* vctb,
                                           const int* sel, float* nsaacc, float* scores, bf16_t* oout) {
    LAS unsigned char* L = c.lds;
    LAS float* biasd = (LAS float*)(L + AT_BIAS);
    LAS unsigned* selm = (LAS unsigned*)(L + AT_SELM);
    LAS int* list = (LAS int*)(L + AT_LIST);
    LAS int* nlist = (LAS int*)(L + AT_NLIST);
    LAS unsigned* need = (LAS unsigned*)(L + AT_NEED);
    const int lane = c.lane, wave = c.wave, n = lane & 15, q = lane >> 4, hr = n & 3;
    constexpr int TW = 4 * NQ, TB = 8 * TW, NU = T / TB;
    for (int unit = c.bid; unit < 2 * NU; unit += c.G) {
        const int g = unit / NU, t0 = (unit % NU) * TB, tw0 = t0 + wave * TW;
        __syncthreads();
        for (int e = c.tid; e < 4096; e += 512) { const int r = e >> 10, d = e & 1023; biasd[e] = inptr(c, I_REL)[t5_bucket(d) * 16 + (MODE == 0 ? 8 : 0) + g * 4 + r]; }
        if (MODE == 3) {
            for (int e = c.tid; e < 1024; e += 512) selm[e] = 0u;
            if (c.tid < 8) need[c.tid] = 0u;
            __syncthreads();
            if ((c.tid >> 2) < TB) { const int tok = c.tid >> 2, k4 = (c.tid & 3) * 4; const int* sp = sel + ((size_t)(t0 + tok) * 2 + g) * 16 + k4;
#pragma unroll
              for (int k = 0; k < 4; ++k) { const int j = sp[k]; atomicOr((unsigned*)&selm[tok * 8 + (j >> 5)], 1u << (j & 31)); atomicOr((unsigned*)&need[j >> 5], 1u << (j & 31)); } }
            __syncthreads();
            if (c.tid < 256) { const int j = c.tid; const unsigned wd = need[j >> 5];
                if ((wd >> (j & 31)) & 1u) { int pos = __popc(wd & ((1u << (j & 31)) - 1u)); for (int w2 = 0; w2 < (j >> 5); ++w2) pos += __popc(need[w2]); list[pos] = j; } }
            if (c.tid == 0) { int cnt = 0; for (int w2 = 0; w2 < 8; ++w2) cnt += __popc(need[w2]); nlist[0] = cnt; }
        }
        __syncthreads();
        int ntiles, tile_lo = 0;
        if (MODE == 0) { ntiles = 2 + TB / 64; tile_lo = t0 - 128; }
        else if (MODE == 1) { ntiles = 8 + TB / 64; tile_lo = t0 - 512; }
        else if (MODE == 2) { const int cmax = (t0 + TB - 1 - 31) >> 4; ntiles = cmax < 0 ? 0 : (cmax >> 6) + 1; }
        else ntiles = nlist[0];
        const bf16_t* Ksrc; size_t kstride; const bf16_t* Vsrc; size_t vstride; int qcol;
        if (MODE == 0) { Ksrc = proj + PC_SK + g * 64; kstride = PLD; Vsrc = vtb + (size_t)(4 + g) * 64 * T; vstride = T; qcol = PC_SQ + g * 256; }
        else if (MODE == 1) { Ksrc = proj + PC_KW + g * 64; kstride = PLD; Vsrc = vtb + (size_t)(2 + g) * 64 * T; vstride = T; qcol = PC_NQ + g * 256; }
        else if (MODE == 2) { Ksrc = kcb + (size_t)g * 1024 * 64; kstride = 64; Vsrc = vctb + (size_t)g * 64 * 1024; vstride = 1024; qcol = PC_NQ + g * 256; }
        else { Ksrc = proj + PC_KS + g * 64; kstride = PLD; Vsrc = vtb + (size_t)(0 + g) * 64 * T; vstride = T; qcol = PC_NQ + g * 256; }
        bf16x8 Bq[NQ][2];
#pragma unroll
        for (int qd = 0; qd < NQ; ++qd) { const bf16_t* qp = proj + (size_t)(tw0 + 4 * qd + (n >> 2)) * PLD + qcol + hr * 64 + 8 * q;
            Bq[qd][0] = *(const bf16x8*)qp; Bq[qd][1] = *(const bf16x8*)(qp + 32); }
        float mrun[NQ], lrun[NQ]; f32x4 O[NQ][4];
#pragma unroll
        for (int qd = 0; qd < NQ; ++qd) { mrun[qd] = -1e30f; lrun[qd] = 0.f;
#pragma unroll
            for (int dt = 0; dt < 4; ++dt) O[qd][dt] = (f32x4){0.f, 0.f, 0.f, 0.f}; }
        float carry3[NQ]; for (int i = 0; i < NQ; ++i) carry3[i] = 0.f;
        const int npass = (MODE == 2) ? 2 : 1;
        for (int pass = 0; pass < npass; ++pass) {
            const bool do_pv = (MODE != 2) || pass == 1;
            float linv[NQ];
            if (MODE == 2 && pass == 1) {
#pragma unroll
                for (int qd = 0; qd < NQ; ++qd) { float lt = lrun[qd]; lt += __shfl_xor(lt, 16); lt += __shfl_xor(lt, 32); linv[qd] = lt > 0.f ? 1.0f / lt : 0.f; }
            }
            u32x4 kreg, vreg; int p0n;
            { const int ti = 0; p0n = (MODE == 3) ? list[ti] * 64 : (MODE == 2 ? ti * 64 : tile_lo + ti * 64);
              if (ntiles > 0 && p0n >= 0) { kreg = *(const u32x4*)(Ksrc + (size_t)(p0n + (c.tid >> 3)) * kstride + (c.tid & 7) * 8);
                  if (do_pv) vreg = *(const u32x4*)(Vsrc + (size_t)(c.tid >> 3) * vstride + p0n + (c.tid & 7) * 8); } }
            for (int ti = 0; ti < ntiles; ++ti) {
                const int p0 = p0n;
                __syncthreads();
                if (p0 >= 0) { *(LAS u32x4*)(L + AT_K + (c.tid >> 3) * 144 + (c.tid & 7) * 16) = kreg; if (do_pv) *(LAS u32x4*)(L + AT_V + (c.tid >> 3) * 144 + (c.tid & 7) * 16) = vreg; }
                if (ti + 1 < ntiles) { p0n = (MODE == 3) ? list[ti + 1] * 64 : (MODE == 2 ? (ti + 1) * 64 : tile_lo + (ti + 1) * 64);
                    if (p0n >= 0) { kreg = *(const u32x4*)(Ksrc + (size_t)(p0n + (c.tid >> 3)) * kstride + (c.tid & 7) * 8);
                        if (do_pv) vreg = *(const u32x4*)(Vsrc + (size_t)(c.tid >> 3) * vstride + p0n + (c.tid & 7) * 8); } }
                __syncthreads();
                if (p0 < 0) continue;
                if (MODE == 0) { if (p0 > tw0 + TW - 1 || p0 + 63 < tw0 - 127) continue; }
                if (MODE == 1) { if (p0 > tw0 + TW - 1 || p0 + 63 < tw0 - 511) continue; }
                if (MODE == 2) { if (16 * p0 + 31 > tw0 + TW - 1) continue; }
                if (MODE == 3) { if (p0 > tw0 + TW - 1) continue; }
                const int jblk = p0 >> 6;
#pragma unroll
                for (int qd = 0; qd < NQ; ++qd) {
                    const int tq = tw0 + 4 * qd + (n >> 2);
                    bool colsel = true;
                    if (MODE == 3) { colsel = (selm[(wave * TW + 4 * qd + (n >> 2)) * 8 + (jblk >> 5)] >> (jblk & 31)) & 1u; if (__ballot(colsel) == 0ull) continue; }
#pragma unroll
                    for (int st = 0; st < 2; ++st) {
                        f32x4 sc[2];
#pragma unroll
                        for (int kt = 0; kt < 2; ++kt) { sc[kt] = (f32x4){0.f, 0.f, 0.f, 0.f};
#pragma unroll
                            for (int ks = 0; ks < 2; ++ks) { const bf16x8 ak = *(const LAS bf16x8*)(L + AT_K + (32 * st + 16 * kt + n) * 144 + (32 * ks + 8 * q) * 2);
                                sc[kt] = __builtin_amdgcn_mfma_f32_16x16x32_bf16(ak, Bq[qd][ks], sc[kt], 0, 0, 0); } }
                        float mx = -1e30f;
#pragma unroll
                        for (int kt = 0; kt < 2; ++kt)
#pragma unroll
                            for (int r = 0; r < 4; ++r) { const int kl = 32 * st + 16 * kt + 4 * q + r; int dist; bool v;
                                if (MODE == 2) { dist = tq - (16 * (p0 + kl) + 31); v = dist >= 0; }
                                else { dist = tq - (p0 + kl); v = dist >= 0; if (MODE == 0) v = v && dist < 128; if (MODE == 1) v = v && dist < 512; if (MODE == 3) v = v && colsel; }
                                const int di = dist < 0 ? 0 : (dist > 1023 ? 1023 : dist);
                                const float s2 = v ? sc[kt][r] + biasd[hr * 1024 + di] : -1e30f; sc[kt][r] = s2; mx = fmaxf(mx, s2); }
                        float p[2][4];
                        if (MODE == 2 && pass == 1) {
#pragma unroll
                            for (int kt = 0; kt < 2; ++kt)
#pragma unroll
                                for (int r = 0; r < 4; ++r) p[kt][r] = __expf(sc[kt][r] - mrun[qd]) * linv[qd];
                        } else {
                            mx = fmaxf(mx, __shfl_xor(mx, 16)); mx = fmaxf(mx, __shfl_xor(mx, 32));
                            const float mn = fmaxf(mrun[qd], mx), corr = __expf(mrun[qd] - mn); mrun[qd] = mn; float ps = 0.f;
                            const float mne = mn < -1e29f ? 0.f : mn;
#pragma unroll
                            for (int kt = 0; kt < 2; ++kt)
#pragma unroll
                                for (int r = 0; r < 4; ++r) { p[kt][r] = __expf(sc[kt][r] - mne); ps += p[kt][r]; }
                            lrun[qd] = lrun[qd] * corr + ps;
                            if (do_pv) {
#pragma unroll
                                for (int dt = 0; dt < 4; ++dt) O[qd][dt] = O[qd][dt] * corr; }
                        }
                        if (MODE == 2 && pass == 1) {
                            float i3prev = carry3[qd];
#pragma unroll
                            for (int kt = 0; kt < 2; ++kt) { float im[4];
#pragma unroll
                                for (int r = 0; r < 4; ++r) { float v = p[kt][r]; v += __shfl_xor(v, 1); v += __shfl_xor(v, 2); im[r] = v; }
                                const float same = __shfl(im[3], (lane + 48) & 63), prevt = __shfl(i3prev, (lane + 48) & 63);
                                const float pv3 = q > 0 ? same : prevt;
                                const int jg = (p0 + 32 * st + 16 * kt + 4 * q) >> 2;
                                if (hr == 0 && jg < 256) scores[((size_t)g * T + tq) * 256 + jg] = 2.0f * (im[0] + im[1] + im[2]) + im[3] + pv3;
                                i3prev = im[3]; }
                            carry3[qd] = i3prev;
                        }
                        if (do_pv) {
                            u32x4 pw; pw.x = pk2(p[0][0], p[0][1]); pw.y = pk2(p[0][2], p[0][3]); pw.z = pk2(p[1][0], p[1][1]); pw.w = pk2(p[1][2], p[1][3]);
                            const bf16x8 pf = __builtin_bit_cast(bf16x8, pw);
#pragma unroll
                            for (int dt = 0; dt < 4; ++dt) { const LAS unsigned char* vp = L + AT_V + (16 * dt + n) * 144 + (32 * st + 4 * q) * 2;
                                const u32x2 v0 = *(const LAS u32x2*)vp, v1 = *(const LAS u32x2*)(vp + 32); u32x4 vw; vw.x = v0.x; vw.y = v0.y; vw.z = v1.x; vw.w = v1.y;
                                O[qd][dt] = __builtin_amdgcn_mfma_f32_16x16x32_bf16(__builtin_bit_cast(bf16x8, vw), pf, O[qd][dt], 0, 0, 0); }
                        }
                        __builtin_amdgcn_sched_barrier(0);
                    }
                }
            }
        }
#pragma unroll
        for (int qd = 0; qd < NQ; ++qd) {
            const int tq = tw0 + 4 * qd + (n >> 2), hh = g * 4 + hr;
            float scale;
            if (MODE == 2) scale = 1.0f;
            else { float lt = lrun[qd]; lt += __shfl_xor(lt, 16); lt += __shfl_xor(lt, 32);
                if (MODE == 0) { const float sink = inptr(c, I_SINK)[layer * 8 + hh]; const float mf = fmaxf(mrun[qd], sink), cr = __expf(mrun[qd] - mf); scale = cr / (lt * cr + __expf(sink - mf)); }
                else scale = lt > 0.f ? 1.0f / lt : 0.f; }
            if (MODE != 0) scale *= sigmoidf_(bf2f(proj[(size_t)tq * PLD + PC_GL + (MODE == 2 ? 0 : (MODE == 3 ? 8 : 16)) + hh]));
#pragma unroll
            for (int dt = 0; dt < 4; ++dt) { const f32x4 o = O[qd][dt] * scale; const int col = hh * 64 + 16 * dt + 4 * q;
                if (MODE == 0) { u32x2 w; w.x = pk2(o[0], o[1]); w.y = pk2(o[2], o[3]); *(u32x2*)(oout + (size_t)tq * 512 + col) = w; }
                else if (MODE == 2) *(f32x4*)(nsaacc + (size_t)tq * 512 + col) = o;
                else if (MODE == 1) { f32x4* ap = (f32x4*)(nsaacc + (size_t)tq * 512 + col); *ap = *ap + o; }
                else { const f32x4 t2 = *(const f32x4*)(nsaacc + (size_t)tq * 512 + col) + o; u32x2 w; w.x = pk2(t2[0], t2[1]); w.y = pk2(t2[2], t2[3]); *(u32x2*)(oout + (size_t)tq * 512 + col) = w; } }
        }
    }
}
__device__ __forceinline__ void phase_topk2(const Ctx& c, const float* scores, int* sel) {
    const int gw = c.bid * 8 + c.wave, NGW = c.G * 8;
    for (int item = gw; item < T * 2; item += NGW) {
        const int t = item >> 1, g = item & 1, cur = t >> 6;
        const float* sp = scores + ((size_t)g * T + t) * 256;
        float val[4];
#pragma unroll
        for (int jj = 0; jj < 4; ++jj) { const int j = c.lane + 64 * jj; float sc;
            if (j == 0 || j == cur || j == cur - 1) sc = 1e4f; else if (j > cur) sc = -1.0f; else sc = sp[j];
            val[jj] = sc; }
        for (int k = 0; k < 16; ++k) {
            float bv = val[0]; int bi = c.lane;
#pragma unroll
            for (int jj = 1; jj < 4; ++jj) if (val[jj] > bv) { bv = val[jj]; bi = c.lane + 64 * jj; }
#pragma unroll
            for (int o = 32; o >= 1; o >>= 1) { const float ov = __shfl_xor(bv, o); const int oi = __shfl_xor(bi, o); if (ov > bv || (ov == bv && oi < bi)) { bv = ov; bi = oi; } }
#pragma unroll
            for (int jj = 0; jj < 4; ++jj) if (bi == c.lane + 64 * jj) val[jj] = -3e38f;
            if (c.lane == 0) sel[(size_t)item * 16 + k] = bi;
        }
    }
}

#define wb ((bf16_t*)(ws + WS_WB))
#define xb ((bf16_t*)(ws + WS_XB))
#define rs ((float*)(ws + WS_RS))
#define kcb ((bf16_t*)(ws + WS_KCB))
#define vctb ((bf16_t*)(ws + WS_VCT))
#define vtb ((bf16_t*)(ws + WS_VT))
#define scores ((float*)(ws + WS_SCORES))
#define sel ((int*)(ws + WS_SEL))
#define ml ((float*)(ws + WS_ML))
#define hidb ((bf16_t*)(ws + WS_HID))
#define proj ((bf16_t*)(ws + WS_PROJ))
#define gates ((bf16_t*)(ws + WS_GATES))
#define merged ((bf16_t*)(ws + WS_MERGED))
#define tmpb ((bf16_t*)(ws + WS_TMPB))
#define alora ((bf16_t*)(ws + WS_ALORA))
#define rwu ((bf16_t*)(ws + WS_RWU))
#define rws ((bf16_t*)(ws + WS_RWS))
#define bonusg ((float*)(ws + WS_BONUS))
#define nsaacc ((float*)(ws + WS_NSAACC))
#define obuf ((bf16_t*)(ws + WS_O))
#define act ((bf16_t*)(ws + WS_ACT))
#define tmpf ((bf16_t*)(ws + WS_TMPF))
constexpr int PH_PER_BATCH = 16, PH_PER_LAYER = 1 + 2 * PH_PER_BATCH + 3, PH_TOTAL = 1 + DEPTH * PH_PER_LAYER;

__global__ void __launch_bounds__(512, 2) fwd_kernel(Args args) {
    extern __shared__ __attribute__((aligned(16))) unsigned char lds_raw[];
    Ctx c0; c0.lds = (LAS unsigned char*)lds_raw; c0.tid = threadIdx.x; c0.lane = c0.tid & 63; c0.wave = __builtin_amdgcn_readfirstlane(c0.tid >> 6); c0.G = gridDim.x; c0.bid = blockIdx.x; const Ctx& c = c0;
    unsigned char* ws = args.ws;
    volatile LAS unsigned* misc = (volatile LAS unsigned*)(c.lds + LDS_MISC);
    if (c.tid < 4) misc[c.tid] = 0u;
    if (c.tid < 30) { const unsigned long long pv = (unsigned long long)args.in[c.tid & 31]; misc[16 + 2 * c.tid] = (unsigned)pv; misc[17 + 2 * c.tid] = (unsigned)(pv >> 32); }
    __syncthreads();
    XcdBarrier bar; bar.bar = (unsigned*)(ws + WS_CTL); bar.x = 0; bar.st = misc;
    const int lo = args.lo, hi = args.hi;
    const bool multi = (hi - lo) > 1;
    if (multi) bar = xcd_barrier_post((unsigned*)(ws + WS_CTL), misc);
    int gp = 0;
#ifndef ONLY_PH
#define ONLY_PH -1
#endif
#ifndef PHMASK
#define PHMASK 0xffffff
#endif
#ifndef REPMASK
#define REPMASK 0
#endif
#define PHASE_BEGIN(id) if (gp >= lo && gp < hi) { for (int rep_ = 0; rep_ < (((REPMASK >> (id)) & 1) ? 2 : 1); ++rep_) { if (rep_) __syncthreads(); \
    Ctx pc = c0; asm volatile("" : "+v"(pc.tid), "+s"(pc.bid)); pc.lane = pc.tid & 63; pc.wave = __builtin_amdgcn_readfirstlane(pc.tid >> 6); const Ctx& c = pc;
#define PHASE_END   } if (gp + 1 < hi) xcd_barrier(bar); } ++gp;

    float* x = args.out;
    PHASE_BEGIN(0) phase_init(c, inptr(c, I_X), x, xb, rs); PHASE_END

    for (int layer = 0; layer < DEPTH; ++layer) {
        PHASE_BEGIN(1) phase_cvt(c, args, layer, wb); PHASE_END
        for (int b = 0; b < NBATCH; ++b) {
            const int row0 = b * T;
            PHASE_BEGIN(2) {
                pg8::Gemm g{xb + (size_t)row0 * D, wb + WB_WIN, D, D, D}; pg8::Sched S; S.init(T / 256, NIN / 256, c.G, c.bid, 1, (size_t)256 * D * 2, 0, (size_t)256 * D * 2, 0);
                pg8::EpiInProj E{proj, gates, rs + row0}; pg8::gemm_phase(c.lds, c.tid, g, S, E); } PHASE_END
            PHASE_BEGIN(16) { phase_lora_a(c, args, layer, proj, alora); vt_transpose(c, proj, vtb); } PHASE_END
            PHASE_BEGIN(17) {
                pg8::Gemm g{alora, wb + WB_LORA, 256, 256, 256}; pg8::Sched S; S.init(T / 256, 6, c.G, c.bid, 1, (unsigned)256 * 256 * 2, 0, (unsigned)256 * 256 * 2, 0);
                pg8::EpiLora E{obuf}; pg8::gemm_phase(c.lds, c.tid, g, S, E); } PHASE_END
            PHASE_BEGIN(18) phase_rwkv_chunk(c, args, layer, proj, obuf + (size_t)T * 512, obuf + (size_t)2 * T * 512, rwu, bonusg); PHASE_END
            PHASE_BEGIN(19) phase_rwkv_scan<0>(c, rwu, rws);
#ifdef SCANPROBE
              __syncthreads(); phase_rwkv_scan<SCANPROBE>(c, rwu, (bf16_t*)nsaacc);
#endif
              PHASE_END
            PHASE_BEGIN(9) phase_rwkv_out(c, args, layer, proj, rwu, rws, bonusg, obuf); PHASE_END
            PHASE_BEGIN(3) {
                pg8::Gemm g{proj, wb + WB_W1T, 16 * PLD, 2048, 2048, (unsigned)PLD * 2}; pg8::Sched S; S.init(16, 1, c.G, c.bid, 1, 0, 0, 0, 0); S.mode = 1;
                pg8::EpiCmp1 E{hidb, (const float*)(wb + WB_BH)}; pg8::gemm_phase(c.lds, c.tid, g, S, E); } PHASE_END
            PHASE_BEGIN(4) {
                pg8::Gemm g{hidb, wb + WB_W2T, 256, 256, 256}; pg8::Sched S; S.init(16, 1, c.G, c.bid, 1, (unsigned)256 * 256 * 2, 0, 0, 0); S.mode = 2;
                pg8::EpiCmp2 E{kcb, vctb}; pg8::gemm_phase(c.lds, c.tid, g, S, E); } PHASE_END
            PHASE_BEGIN(5) phase_attn<2, 2>(c, args, layer, proj, vtb, kcb, vctb, sel, nsaacc, scores, obuf + (size_t)T * 512); PHASE_END
            PHASE_BEGIN(6) phase_topk2(c, scores, sel); PHASE_END
            PHASE_BEGIN(7) phase_attn<1, 2>(c, args, layer, proj, vtb, kcb, vctb, sel, nsaacc, scores, obuf + (size_t)T * 512); PHASE_END
            PHASE_BEGIN(8) phase_attn<3, 2>(c, args, layer, proj, vtb, kcb, vctb, sel, nsaacc, scores, obuf + (size_t)T * 512); PHASE_END
            PHASE_BEGIN(20) phase_attn<0, 2>(c, args, layer, proj, vtb, kcb, vctb, sel, nsaacc, scores, obuf + (size_t)2 * T * 512); PHASE_END
            PHASE_BEGIN(10) {
                pg8::Gemm g{obuf, wb + WB_WBR, 512, 512, 512}; pg8::Sched S; S.init(T / 256, D / 256, c.G, c.bid, 3, (size_t)256 * 512 * 2, (size_t)T * 512 * 2, (size_t)256 * 512 * 2, (size_t)D * 512 * 2);
                pg8::EpiMerge E{gates, merged}; pg8::gemm_phase(c.lds, c.tid, g, S, E); } PHASE_END
            PHASE_BEGIN(11) {
                pg8::Gemm g{merged, wb + WB_WOUT, D, D, D}; pg8::Sched S; S.init(T / 256, D / 256, c.G, c.bid, 1, (size_t)256 * D * 2, 0, (size_t)256 * D * 2, 0);
                pg8::EpiStore E{tmpb, D}; pg8::gemm_phase(c.lds, c.tid, g, S, E); } PHASE_END
            PHASE_BEGIN(12) phase_norm_res(c, tmpb, inptr(c, I_NQM) + layer * D, x, xb, rs, row0, T); PHASE_END
        }
        PHASE_BEGIN(13) {
            pg8::Gemm g{xb, wb + WB_WGU, D, D, D}; pg8::Sched S; S.init(MROWS / 256, 2 * FFN / 256, c.G, c.bid, 1, (size_t)256 * D * 2, 0, (size_t)256 * D * 2, 0);
            pg8::EpiSwiGLU E{act, rs}; pg8::gemm_phase(c.lds, c.tid, g, S, E); } PHASE_END
        PHASE_BEGIN(14) {
            pg8::Gemm g{act, wb + WB_WDN, FFN, FFN, FFN}; pg8::Sched S; S.init(MROWS / 256, D / 256, c.G, c.bid, 1, (size_t)256 * FFN * 2, 0, (size_t)256 * FFN * 2, 0);
            pg8::EpiStore E{tmpf, D}; pg8::gemm_phase(c.lds, c.tid, g, S, E); } PHASE_END
        PHASE_BEGIN(15) phase_norm_res(c, tmpf, inptr(c, I_NQF) + layer * D, x, xb, rs, 0, MROWS); PHASE_END
    }
#undef PHASE_BEGIN
#undef PHASE_END
}

extern "C" void kernel_launch(void* const* d_in, const int* in_sizes, int n_in, void* d_out, int out_size, void* d_ws, size_t ws_size, hipStream_t stream) {
    static int grid = 0;
    if (grid == 0) {
        if (n_in != 30 || out_size != MROWS * D || ws_size < WS_END) { fprintf(stderr, "kernel_launch: unexpected shapes (n_in %d out %d ws %zu)\n", n_in, out_size, ws_size); grid = -1; return; }
        int dev = 0, cus = 0;
        if (hipGetDevice(&dev) != hipSuccess || hipDeviceGetAttribute(&cus, hipDeviceAttributeMultiprocessorCount, dev) != hipSuccess) { grid = -1; return; }
        if (hipFuncSetAttribute((const void*)fwd_kernel, hipFuncAttributeMaxDynamicSharedMemorySize, LDS_BYTES) != hipSuccess) { fprintf(stderr, "hipFuncSetAttribute failed\n"); grid = -1; return; }
        int per_cu = 0;
        if (hipOccupancyMaxActiveBlocksPerMultiprocessor(&per_cu, (const void*)fwd_kernel, 512, LDS_BYTES) != hipSuccess || per_cu < 1) { fprintf(stderr, "occupancy query: %d\n", per_cu); }
        (void)hipGetLastError();
        grid = cus;
    }
    if (grid < 0) return;
    (void)hipMemsetAsync((char*)d_ws + WS_CTL, 0, CTL_BYTES, stream);
    Args a{};
    for (int i = 0; i < 30; ++i) a.in[i] = (const float*)d_in[i];
    a.out = (float*)d_out; a.ws = (unsigned char*)d_ws;
#if MK_ONE_LAUNCH
    a.lo = 0; a.hi = PH_TOTAL;
    hipLaunchKernelGGL(fwd_kernel, dim3(grid), dim3(512), LDS_BYTES, stream, a);
#else
    for (int p = 0; p < PH_TOTAL; ++p) { a.lo = p; a.hi = p + 1; hipLaunchKernelGGL(fwd_kernel, dim3(grid), dim3(512), LDS_BYTES, stream, a); }
#endif
}
```

```cpp
#include <hip/hip_runtime.h>
#include <stdint.h>
#include <stdio.h>

#ifndef MK_ONE_LAUNCH
#define MK_ONE_LAUNCH 1
#endif

#define LAS __attribute__((address_space(3)))
typedef unsigned short bf16_t;
typedef short bf16x8 __attribute__((ext_vector_type(8)));
typedef float f32x4 __attribute__((ext_vector_type(4)));
typedef float f32x2 __attribute__((ext_vector_type(2)));
typedef unsigned u32x4 __attribute__((ext_vector_type(4)));
typedef unsigned u32x2 __attribute__((ext_vector_type(2)));

constexpr int D = 1024, NBATCH = 2, T = 16384, DEPTH = 4, MROWS = NBATCH * T;
constexpr int IN_COLS = 6936, FFN = 2816;
constexpr int PLD = 4096;
constexpr int PC_R = 0, PC_K = 512, PC_V = 1024, PC_ZW = 1536, PC_ZA = 1600, PC_ZG = 1664;
constexpr int PC_NQ = 1792, PC_KC = 2304, PC_VC = 2432, PC_KS = 2560, PC_VS = 2688, PC_KW = 2816, PC_VW = 2944, PC_GL = 3072;
constexpr int PC_SQ = 3328, PC_SK = 3840, PC_SV = 3968;
constexpr int NIN = 7168;
constexpr int NCMP = 1023;
constexpr float NORM_EPS = 1e-6f;

constexpr size_t MiB = 1u << 20;
constexpr size_t WS_CTL = 0, CTL_BYTES = 65536;
constexpr size_t WS_WB = 65536;
constexpr size_t WB_WIN = 0, WB_WBR = WB_WIN + (size_t)NIN * D, WB_WOUT = WB_WBR + (size_t)3 * D * 512, WB_WGU = WB_WOUT + (size_t)D * D,
                 WB_WDN = WB_WGU + (size_t)2 * FFN * D, WB_LORA = WB_WDN + (size_t)D * FFN, WB_W1T = WB_LORA + (size_t)1536 * 256, WB_W2T = WB_W1T + (size_t)2 * 256 * 2048,
                 WB_BH = WB_W2T + (size_t)2 * 256 * 256, WB_END = WB_BH + 1024;
static_assert(WS_WB + WB_END * 2 <= 39 * MiB, "weights");
constexpr size_t WS_XB = 39 * MiB;
constexpr size_t WS_RS = 103 * MiB;
constexpr size_t WS_KCB = 103 * MiB + 262144;
constexpr size_t WS_VCT = WS_KCB + 262144;
constexpr size_t WS_SEL = 104 * MiB;
constexpr size_t WS_BONUS = 106 * MiB;
constexpr size_t WS_ML = 106 * MiB + 524288;
constexpr size_t WS_ALORA = 107 * MiB;
constexpr size_t WS_HID = 107 * MiB;
constexpr size_t WS_VT = 115 * MiB;
constexpr size_t WS_BIG = 127 * MiB;
constexpr size_t WS_PROJ = WS_BIG;
constexpr size_t WS_GATES = WS_PROJ + 128 * MiB;
constexpr size_t WS_RWKVS = WS_GATES + 96 * MiB;
constexpr size_t WS_RWU = WS_RWKVS;
constexpr size_t WS_RWS = WS_RWKVS + 64 * MiB;
constexpr size_t WS_SCORES = WS_RWKVS;
constexpr size_t WS_MERGED = WS_RWKVS;
constexpr size_t WS_TMPB = WS_RWKVS + 32 * MiB;
constexpr size_t WS_NSAACC = WS_RWKVS + 80 * MiB;
constexpr size_t WS_O = WS_NSAACC + 32 * MiB;
constexpr size_t WS_END = WS_O + 48 * MiB;
constexpr size_t WS_ACT = WS_BIG;
constexpr size_t WS_TMPF = WS_BIG + 176 * MiB;
static_assert(WS_END <= 512 * MiB, "workspace");
static_assert(WS_TMPF + 64 * MiB <= WS_NSAACC, "ffn overlay");

constexpr int LDS_BYTES = 147456;
constexpr int LDS_MISC = 131072 + 8192;

__device__ __forceinline__ float bf2f(unsigned v) { return __uint_as_float(v << 16); }
typedef __bf16 bf16n2 __attribute__((ext_vector_type(2)));
__device__ __forceinline__ unsigned pk2(float lo, float hi) { const f32x2 f = {lo, hi}; const bf16n2 v = __builtin_convertvector(f, bf16n2); return __builtin_bit_cast(unsigned, v); }
__device__ __forceinline__ unsigned f2bf(float f) { return pk2(f, 0.f) & 0xffffu; }
__device__ __forceinline__ void unpack8(const u32x4 w, float (&f)[8]) {
    f[0] = __uint_as_float(w.x << 16); f[1] = __uint_as_float(w.x & 0xffff0000u); f[2] = __uint_as_float(w.y << 16); f[3] = __uint_as_float(w.y & 0xffff0000u);
    f[4] = __uint_as_float(w.z << 16); f[5] = __uint_as_float(w.z & 0xffff0000u); f[6] = __uint_as_float(w.w << 16); f[7] = __uint_as_float(w.w & 0xffff0000u);
}
__device__ __forceinline__ float wave_sum(float v) {
#pragma unroll
    for (int o = 32; o >= 1; o >>= 1) v += __shfl_xor(v, o);
    return v;
}
__device__ __forceinline__ float sigmoidf_(float x) { return 1.0f / (1.0f + __expf(-x)); }
__device__ __forceinline__ int t5_bucket(int n) {
    if (n < 16) return n;
    int b = 16;
    b += (n >= 21); b += (n >= 27); b += (n >= 35); b += (n >= 46); b += (n >= 59); b += (n >= 77); b += (n >= 99); b += (n >= 128);
    b += (n >= 166); b += (n >= 216); b += (n >= 280); b += (n >= 363); b += (n >= 470); b += (n >= 609); b += (n >= 790);
    return b;
}

#define XB_TMO      128
#define XB_XCNT(j)  (256  + 64 * (j))
#define XB_XSUB(j)  (1280 + 64 * (j))
#define XB_XGEN(j)  (2304 + 64 * (j))
#define XB_TOP      3328
#define XB_TOPGEN   3392
#define XCD_BAR_WORDS 3456
#define XB_SPIN_CAP (1u << 22)
__device__ __forceinline__ unsigned xb_ld(unsigned* p)              { return __hip_atomic_load(p, __ATOMIC_RELAXED, __HIP_MEMORY_SCOPE_AGENT); }
__device__ __forceinline__ unsigned xb_add(unsigned* p, unsigned v) { return __hip_atomic_fetch_add(p, v, __ATOMIC_RELAXED, __HIP_MEMORY_SCOPE_AGENT); }
__device__ __forceinline__ unsigned xb_xcc_id() { return (unsigned)__builtin_amdgcn_s_getreg((3 << 11) | 20) & 0xFu; }
#define XB_SPIN(cond, bar) do { unsigned _sp = 0; while (cond) { __builtin_amdgcn_s_sleep(1); \
    if ((++_sp & 255u) == 0u) { if (xb_ld(&(bar)[XB_TMO])) break; if (_sp > XB_SPIN_CAP) { atomicAdd(&(bar)[XB_TMO], 1u); break; } } } } while (0)
struct XcdBarrier { unsigned* bar; unsigned x; volatile LAS unsigned* st; };
__device__ __forceinline__ XcdBarrier xcd_barrier_post(unsigned* bar, volatile LAS unsigned* st) {
    XcdBarrier b; b.bar = bar; b.x = xb_xcc_id(); b.st = st;
    if (threadIdx.x == 0) (void)xb_add(&bar[XB_XCNT(b.x)], 1u);
    return b;
}
__device__ __forceinline__ void xcd_barrier_complete(unsigned* bar, unsigned x, unsigned& nloc, unsigned& nx) {
    const unsigned G = gridDim.x * gridDim.y * gridDim.z;
    unsigned sum, cnt, mine, sp = 0u;
    for (;;) {
        sum = 0u; cnt = 0u; mine = 0u;
#pragma unroll
        for (unsigned j = 0; j < 16; ++j) { const unsigned c = xb_ld(&bar[XB_XCNT(j)]); sum += c; cnt += (c > 0u) ? 1u : 0u; mine = (j == x) ? c : mine; }
        if (sum == G) break;
        __builtin_amdgcn_s_sleep(1);
        if ((++sp & 255u) == 0u) { if (xb_ld(&bar[XB_TMO])) break; if (sp > XB_SPIN_CAP) { atomicAdd(&bar[XB_TMO], 1u); break; } }
    }
    nloc = mine > 0u ? mine : 1u; nx = cnt > 0u ? cnt : 1u;
}
__device__ __forceinline__ void xcd_barrier(const XcdBarrier& b) {
    asm volatile("s_waitcnt vmcnt(0)" ::: "memory");
    __syncthreads();
    if (threadIdx.x == 0) {
        unsigned* bar = b.bar;
        __builtin_amdgcn_s_waitcnt(0);
        unsigned nloc = b.st[0], nx = b.st[1];
        if (nloc == 0u) { xcd_barrier_complete(bar, b.x, nloc, nx); b.st[0] = nloc; b.st[1] = nx; }
        const unsigned old = xb_add(&bar[XB_XSUB(b.x)], 1u);
        const unsigned gen = old / nloc;
        if (old + 1u == (gen + 1u) * nloc) {
            __builtin_amdgcn_fence(__ATOMIC_RELEASE, "agent");
            asm volatile("s_waitcnt vmcnt(0)" ::: "memory");
            const unsigned og = xb_add(&bar[XB_TOP], 1u);
            const unsigned tg = og / nx;
            if (og + 1u == (tg + 1u) * nx) xb_add(&bar[XB_TOPGEN], 1u);
            else XB_SPIN(xb_ld(&bar[XB_TOPGEN]) == tg, bar);
            __builtin_amdgcn_fence(__ATOMIC_ACQUIRE, "agent");
            xb_add(&bar[XB_XGEN(b.x)], 1u);
            asm volatile("s_waitcnt vmcnt(0)" ::: "memory");
        } else {
            XB_SPIN(xb_ld(&bar[XB_XGEN(b.x)]) == gen, bar);
            __builtin_amdgcn_fence(__ATOMIC_ACQUIRE, "agent");
            asm volatile("s_waitcnt vmcnt(0)" ::: "memory");
        }
    }
    __syncthreads();
}

namespace pg8 {
constexpr int BM = 256, BK = 64, HALF = 128, HTB = HALF * BK * 2, STAGE_BYTES = 8 * HTB, NXCD = 8, WGM = 8;
__device__ __forceinline__ int lds_byte(int r, int c) { const int st = (r >> 4) * 2 + (c >> 5), rr = r & 15, cc = c & 31, ob = rr * 64 + cc * 2; return st * 1024 + (ob ^ (((ob >> 9) & 1) << 5)); }
__device__ __forceinline__ void stage_rc(int b, int& R, int& C) { const int st = b / 1024, sb = b % 1024, swz = sb ^ (((sb >> 9) & 1) << 5); R = (st >> 1) * 16 + swz / 64; C = (st & 1) * 32 + (swz % 64) / 2; }
__device__ __forceinline__ int perm32(int rho) { const int n = rho >> 4, i = rho & 15; return 8 * (i >> 2) + 4 * n + (i & 3); }

struct Unit { int pm, pn, sub; unsigned aoff, boff; };
struct Gemm { const bf16_t* A; const bf16_t* Bt; int lda, ldb, K; unsigned kstepA = 128; };
struct Sched {
    int nM, nN, nwg, G, c, nsub, mode = 0; unsigned a_row, a_sub, b_row, b_sub;
    __device__ __forceinline__ void init(int nM_, int nN_, int G_, int c_, int nsub_, unsigned a_row_, unsigned a_sub_, unsigned b_row_, unsigned b_sub_) {
        nM = nM_; nN = nN_; nwg = nM * nN; G = G_; c = c_; nsub = nsub_; a_row = a_row_; a_sub = a_sub_; b_row = b_row_; b_sub = b_sub_; }
    __device__ __forceinline__ bool next(int i, Unit& u) const {
        const int round = i / nsub; u.sub = i - round * nsub;
        const long L = (long)round * G + c; if (L >= nwg) return false;
        int wgid = (int)L; { const int q = nwg / NXCD, r = nwg % NXCD, xcd = wgid % NXCD, off = wgid / NXCD; wgid = (xcd < r ? xcd * (q + 1) : r * (q + 1) + (xcd - r) * q) + off; }
        const int nig = WGM * nN, gid = wgid / nig, fm = gid * WGM, gsz = (nM - fm) < WGM ? (nM - fm) : WGM;
        u.pm = fm + ((wgid % nig) % gsz); u.pn = (wgid % nig) / gsz;
        u.aoff = (unsigned)u.pm * a_row + (unsigned)u.sub * a_sub; u.boff = (unsigned)u.pn * b_row + (unsigned)u.sub * b_sub;
        if (mode == 1) { const int kv = u.pm >> 3, g = (u.pm >> 2) & 1, cp = u.pm & 3;
            u.aoff = (unsigned)(((size_t)cp * 256 * 16 * PLD + (kv ? PC_VC : PC_KC) + g * 64) * 2); u.boff = (unsigned)kv * (256u * 2048u * 2u); }
        if (mode == 2) { const int kv = u.pm >> 3; u.boff = (unsigned)kv * (256u * 256u * 2u); }
        return true;
    }
};

template <class Epi>
__device__ __forceinline__ void gemm_phase(LAS unsigned char* lds, const int tid, const Gemm g, const Sched& S, const Epi& E) {
    const int wid = __builtin_amdgcn_readfirstlane(tid >> 6), lane = tid & 63, wr = wid >> 2, wc = wid & 3, fr = lane & 15, fq = lane >> 4;
    const int K = g.K, nt = K / BK;
    unsigned voffA[2], voffB[2];
#pragma unroll
    for (int i = 0; i < 2; ++i) { int R, C; stage_rc(tid * 16 + i * 8192, R, C); const int Rb = Epi::PERM ? ((R & ~31) + perm32(R & 31)) : R;
        voffA[i] = (unsigned)(R * g.lda + C) * 2u; voffB[i] = (unsigned)(Rb * g.ldb + C) * 2u; }
    const size_t kstep = (size_t)(BK * 2), kstA = g.kstepA;
    const size_t hstepA = (size_t)HALF * g.lda * 2, hstepB = (size_t)HALF * g.ldb * 2;
    const unsigned ldsw = (unsigned)wid * 1024u;
    const int aoff = lds_byte(wr * 64 + fr, fq * 8), boff = lds_byte(wc * 32 + fr, fq * 8);
#define PG8_SA(b, h) (((b) * 2 + (h)) * HTB)
#define PG8_SB(b, h) ((4 + (b) * 2 + (h)) * HTB)
#define PG8_STAGE(bufoff, gbase, voff) do { _Pragma("unroll") for (int _i = 0; _i < 2; ++_i) \
        __builtin_amdgcn_global_load_lds((const unsigned*)((const char*)(gbase) + (voff)[_i]), (LAS unsigned*)(lds + (bufoff) + ldsw + _i * 8192), 16, 0, 0); } while (0)
#define PG8_LDA(dst, b, h) do { _Pragma("unroll") for (int m = 0; m < 4; ++m) _Pragma("unroll") for (int k = 0; k < 2; ++k) dst[m][k] = *(const LAS bf16x8*)(lds + PG8_SA(b, h) + aoff + m * 2048 + k * 1024); } while (0)
#define PG8_LDB(dst, b, h) do { _Pragma("unroll") for (int n = 0; n < 2; ++n) _Pragma("unroll") for (int k = 0; k < 2; ++k) dst[n][k] = *(const LAS bf16x8*)(lds + PG8_SB(b, h) + boff + n * 2048 + k * 1024); } while (0)
#define PG8_MMA(ai, bj, At, Bt) do { __builtin_amdgcn_s_setprio(1); _Pragma("unroll") for (int m = 0; m < 4; ++m) _Pragma("unroll") for (int n = 0; n < 2; ++n) _Pragma("unroll") for (int k = 0; k < 2; ++k) \
        acc[ai][bj][m][n] = __builtin_amdgcn_mfma_f32_16x16x32_bf16(Bt[n][k], At[m][k], acc[ai][bj][m][n], 0, 0, 0); __builtin_amdgcn_s_setprio(0); } while (0)
#define PG8_WAIT_V(n) asm volatile("s_waitcnt vmcnt(" #n ")" ::: "memory")
#define PG8_WAIT_L(n) asm volatile("s_waitcnt lgkmcnt(" #n ")" ::: "memory")
#define PG8_BAR __builtin_amdgcn_s_barrier()
#define PG8_SCHED __builtin_amdgcn_sched_barrier(0)
    Unit cur, nxt; int ui = 0;
    if (!S.next(0, cur)) return;
    f32x4 acc[2][2][4][2];
#pragma unroll
    for (int a = 0; a < 2; ++a)
#pragma unroll
        for (int b = 0; b < 2; ++b)
#pragma unroll
            for (int m = 0; m < 4; ++m)
#pragma unroll
                for (int n = 0; n < 2; ++n) acc[a][b][m][n] = (f32x4){0.f, 0.f, 0.f, 0.f};
    bf16x8 At[4][2], B0[2][2], B1[2][2];
    const char* cA = (const char*)g.A + cur.aoff; const char* cB = (const char*)g.Bt + cur.boff;
    PG8_STAGE(PG8_SB(0, 0), cB, voffB); PG8_STAGE(PG8_SA(0, 0), cA, voffA); PG8_STAGE(PG8_SB(0, 1), cB + hstepB, voffB); PG8_STAGE(PG8_SA(0, 1), cA + hstepA, voffA);
    if (wr == 1) PG8_BAR;
    PG8_WAIT_V(4); PG8_BAR;
    PG8_STAGE(PG8_SB(1, 0), cB + kstep, voffB); PG8_STAGE(PG8_SA(1, 0), cA + kstA, voffA); PG8_STAGE(PG8_SB(1, 1), cB + hstepB + kstep, voffB);
    PG8_WAIT_V(6); PG8_BAR;
    for (;;) {
        const bool has_next = S.next(ui + 1, nxt);
        const char* nA = has_next ? (const char*)g.A + nxt.aoff : cA; const char* nB = has_next ? (const char*)g.Bt + nxt.boff : cB;
        for (int t = 0; t < nt; t += 2) {
            const bool last = (t == nt - 2);
            const char* a1 = cA + (size_t)(t + 1) * kstA;
            const char* a2 = last ? nA : cA + (size_t)(t + 2) * kstA; const char* b2 = last ? nB : cB + (size_t)(t + 2) * kstep;
            const char* a3 = a2 + kstA; const char* b3 = b2 + kstep;
            PG8_LDB(B0, 0, 0); PG8_SCHED; PG8_LDA(At, 0, 0); PG8_STAGE(PG8_SA(1, 1), a1 + hstepA, voffA);
            PG8_WAIT_L(8); PG8_BAR; PG8_WAIT_L(0); PG8_MMA(0, 0, At, B0); PG8_BAR; PG8_SCHED;
            PG8_LDB(B1, 0, 1); PG8_STAGE(PG8_SB(0, 0), b2, voffB);
            PG8_BAR; PG8_WAIT_L(0); PG8_MMA(0, 1, At, B1); PG8_BAR;
            PG8_LDA(At, 0, 1); PG8_STAGE(PG8_SA(0, 0), a2, voffA);
            PG8_BAR; PG8_WAIT_L(0); PG8_MMA(1, 0, At, B0); PG8_BAR; PG8_SCHED;
            PG8_STAGE(PG8_SB(0, 1), b2 + hstepB, voffB);
            PG8_WAIT_V(6); PG8_BAR; PG8_MMA(1, 1, At, B1); PG8_BAR;
            PG8_LDB(B0, 1, 0); PG8_SCHED; PG8_LDA(At, 1, 0); PG8_STAGE(PG8_SA(0, 1), a2 + hstepA, voffA);
            PG8_WAIT_L(8); PG8_BAR; PG8_WAIT_L(0); PG8_MMA(0, 0, At, B0); PG8_BAR; PG8_SCHED;
            PG8_LDB(B1, 1, 1); PG8_STAGE(PG8_SB(1, 0), b3, voffB);
            PG8_BAR; PG8_WAIT_L(0); PG8_MMA(0, 1, At, B1); PG8_BAR;
            PG8_LDA(At, 1, 1); PG8_STAGE(PG8_SA(1, 0), a3, voffA);
            PG8_BAR; PG8_WAIT_L(0); PG8_MMA(1, 0, At, B0); PG8_BAR; PG8_SCHED;
            PG8_STAGE(PG8_SB(1, 1), b3 + hstepB, voffB);
            PG8_WAIT_V(6); PG8_BAR; PG8_MMA(1, 1, At, B1); PG8_BAR;
        }
        const bool keep = E(acc, cur, wr, wc, fr, fq);
        if (!has_next) break;
        if (!keep) {
#pragma unroll
            for (int a = 0; a < 2; ++a)
#pragma unroll
                for (int b = 0; b < 2; ++b)
#pragma unroll
                    for (int m = 0; m < 4; ++m)
#pragma unroll
                        for (int n = 0; n < 2; ++n) acc[a][b][m][n] = (f32x4){0.f, 0.f, 0.f, 0.f};
        }
        cur = nxt; cA = nA; cB = nB; ++ui;
    }
    PG8_WAIT_V(0);
    if (wr == 0) PG8_BAR;
    PG8_BAR;
#undef PG8_SA
#undef PG8_SB
#undef PG8_STAGE
#undef PG8_LDA
#undef PG8_LDB
#undef PG8_MMA
#undef PG8_WAIT_V
#undef PG8_WAIT_L
#undef PG8_BAR
#undef PG8_SCHED
}

struct EpiInProj {
    static constexpr bool PERM = true;
    bf16_t* proj; bf16_t* gates; const float* rs;
    __device__ __forceinline__ bool operator()(f32x4 (&acc)[2][2][4][2], const Unit& u, int wr, int wc, int fr, int fq) const {
        const int row0 = u.pm * BM + wr * 64 + fr; const bool is_gate = u.pn >= 16;
        bf16_t* base = is_gate ? gates + (u.pn - 16) * 256 : proj + u.pn * 256; const int ld = is_gate ? 3072 : PLD;
        const int col0 = wc * 32 + 8 * fq;
#pragma unroll
        for (int ai = 0; ai < 2; ++ai)
#pragma unroll
            for (int m = 0; m < 4; ++m) { const int row = row0 + ai * HALF + m * 16; const float s = rs[row]; bf16_t* rowp = base + (size_t)row * ld + col0;
#pragma unroll
                for (int bj = 0; bj < 2; ++bj) { f32x4 v0 = acc[ai][bj][m][0] * s, v1 = acc[ai][bj][m][1] * s;
                    if (is_gate) {
#pragma unroll
                        for (int j = 0; j < 4; ++j) { v0[j] = sigmoidf_(v0[j]); v1[j] = sigmoidf_(v1[j]); } }
                    u32x4 w; w.x = pk2(v0[0], v0[1]); w.y = pk2(v0[2], v0[3]); w.z = pk2(v1[0], v1[1]); w.w = pk2(v1[2], v1[3]);
                    *(u32x4*)(rowp + bj * HALF) = w; } }
        return false;
    }
};
struct EpiStore {
    static constexpr bool PERM = true;
    bf16_t* out; int ld;
    __device__ __forceinline__ bool operator()(f32x4 (&acc)[2][2][4][2], const Unit& u, int wr, int wc, int fr, int fq) const {
        const int row0 = u.pm * BM + wr * 64 + fr; const int col0 = u.pn * BM + wc * 32 + 8 * fq;
#pragma unroll
        for (int ai = 0; ai < 2; ++ai)
#pragma unroll
            for (int m = 0; m < 4; ++m) { bf16_t* rowp = out + (size_t)(row0 + ai * HALF + m * 16) * ld + col0;
#pragma unroll
                for (int bj = 0; bj < 2; ++bj) { const f32x4 v0 = acc[ai][bj][m][0], v1 = acc[ai][bj][m][1];
                    u32x4 w; w.x = pk2(v0[0], v0[1]); w.y = pk2(v0[2], v0[3]); w.z = pk2(v1[0], v1[1]); w.w = pk2(v1[2], v1[3]);
                    *(u32x4*)(rowp + bj * HALF) = w; } }
        return false;
    }
};
struct EpiCmp1 {
    static constexpr bool PERM = true;
    bf16_t* hid; const float* bh;
    __device__ __forceinline__ bool operator()(f32x4 (&acc)[2][2][4][2], const Unit& u, int wr, int wc, int fr, int fq) const {
        const int kv = u.pm >> 3; const int row0 = (u.pm & 7) * BM + wr * 64 + fr; const int col0 = wc * 32 + 8 * fq;
#pragma unroll
        for (int ai = 0; ai < 2; ++ai)
#pragma unroll
            for (int m = 0; m < 4; ++m) { bf16_t* rowp = hid + ((size_t)kv * 2048 + row0 + ai * HALF + m * 16) * 256 + col0;
#pragma unroll
                for (int bj = 0; bj < 2; ++bj) { float o[8];
#pragma unroll
                    for (int j = 0; j < 8; ++j) { const float x = acc[ai][bj][m][j >> 2][j & 3] + bh[kv * 256 + col0 + bj * HALF + j];
                        o[j] = x * sigmoidf_(1.5957691216f * (x + 0.044715f * x * x * x)); }
                    u32x4 w; w.x = pk2(o[0], o[1]); w.y = pk2(o[2], o[3]); w.z = pk2(o[4], o[5]); w.w = pk2(o[6], o[7]);
                    *(u32x4*)(rowp + bj * HALF) = w; } }
        return false;
    }
};
struct EpiCmp2 {
    static constexpr bool PERM = true;
    bf16_t* kcb; bf16_t* vct;
    __device__ __forceinline__ bool operator()(f32x4 (&acc)[2][2][4][2], const Unit& u, int wr, int wc, int fr, int fq) const {
        const int kv = u.pm >> 3; const int row0 = (u.pm & 7) * BM + wr * 64 + fr; const int col0 = wc * 32 + 8 * fq;
        if (col0 >= 64) return false;
#pragma unroll
        for (int ai = 0; ai < 2; ++ai)
#pragma unroll
            for (int m = 0; m < 4; ++m) { const int row = row0 + ai * HALF + m * 16, g = row >> 10, cc = row & 1023; const bool zr = cc == 1023; const f32x4 zz = (f32x4){0.f, 0.f, 0.f, 0.f};
                const f32x4 v0 = zr ? zz : acc[ai][0][m][0], v1 = zr ? zz : acc[ai][0][m][1];
                if (kv == 0) { u32x4 w; w.x = pk2(v0[0], v0[1]); w.y = pk2(v0[2], v0[3]); w.z = pk2(v1[0], v1[1]); w.w = pk2(v1[2], v1[3]); *(u32x4*)(kcb + ((size_t)g * 1024 + cc) * 64 + col0) = w; }
                else {
#pragma unroll
                    for (int j = 0; j < 4; ++j) { vct[((size_t)g * 64 + col0 + j) * 1024 + cc] = (bf16_t)f2bf(v0[j]); vct[((size_t)g * 64 + col0 + 4 + j) * 1024 + cc] = (bf16_t)f2bf(v1[j]); } } }
        return false;
    }
};
struct EpiLora {
    static constexpr bool PERM = true;
    bf16_t* obuf;
    __device__ __forceinline__ bool operator()(f32x4 (&acc)[2][2][4][2], const Unit& u, int wr, int wc, int fr, int fq) const {
        const int sel = u.pn >> 1; bf16_t* out = obuf + (size_t)(sel == 2 ? 0 : sel + 1) * T * 512;
        const int row0 = u.pm * BM + wr * 64 + fr; const int col0 = (u.pn & 1) * BM + wc * 32 + 8 * fq;
#pragma unroll
        for (int ai = 0; ai < 2; ++ai)
#pragma unroll
            for (int m = 0; m < 4; ++m) { bf16_t* rowp = out + (size_t)(row0 + ai * HALF + m * 16) * 512 + col0;
#pragma unroll
                for (int bj = 0; bj < 2; ++bj) { const f32x4 v0 = acc[ai][bj][m][0], v1 = acc[ai][bj][m][1];
                    u32x4 w; w.x = pk2(v0[0], v0[1]); w.y = pk2(v0[2], v0[3]); w.z = pk2(v1[0], v1[1]); w.w = pk2(v1[2], v1[3]);
                    *(u32x4*)(rowp + bj * HALF) = w; } }
        return false;
    }
};
struct EpiMerge {
    static constexpr bool PERM = true;
    const bf16_t* gates; bf16_t* merged;
    __device__ __forceinline__ bool operator()(f32x4 (&acc)[2][2][4][2], const Unit& u, int wr, int wc, int fr, int fq) const {
        const int row0 = u.pm * BM + wr * 64 + fr; const int col0 = u.pn * BM + wc * 32 + 8 * fq; const int sub = u.sub;
#pragma unroll
        for (int ai = 0; ai < 2; ++ai)
#pragma unroll
            for (int m = 0; m < 4; ++m) { const int row = row0 + ai * HALF + m * 16; const bf16_t* gp = gates + (size_t)row * 3072 + sub * 1024 + col0;
#pragma unroll
                for (int bj = 0; bj < 2; ++bj) {
                    float sc[8], sn[8]; unpack8(*(const u32x4*)(gp + bj * HALF), sc);
                    if (sub < 2) { unpack8(*(const u32x4*)(gp + 1024 + bj * HALF), sn);
#pragma unroll
                        for (int j = 0; j < 8; ++j) sc[j] = sc[j] / fmaxf(sn[j], 1e-30f); }
                    f32x4 v0 = acc[ai][bj][m][0], v1 = acc[ai][bj][m][1];
#pragma unroll
                    for (int j = 0; j < 4; ++j) { v0[j] *= sc[j]; v1[j] *= sc[4 + j]; }
                    acc[ai][bj][m][0] = v0; acc[ai][bj][m][1] = v1;
                    if (sub == 2) { u32x4 w; w.x = pk2(v0[0], v0[1]); w.y = pk2(v0[2], v0[3]); w.z = pk2(v1[0], v1[1]); w.w = pk2(v1[2], v1[3]);
                        *(u32x4*)(merged + (size_t)row * D + col0 + bj * HALF) = w; } } }
        return sub != 2;
    }
};
struct EpiSwiGLU {
    static constexpr bool PERM = true;
    bf16_t* act; const float* rs;
    __device__ __forceinline__ bool operator()(f32x4 (&acc)[2][2][4][2], const Unit& u, int wr, int wc, int fr, int fq) const {
        const int row0 = u.pm * BM + wr * 64 + fr; const int col0 = u.pn * HALF + wc * 32 + 8 * fq;
#pragma unroll
        for (int ai = 0; ai < 2; ++ai)
#pragma unroll
            for (int m = 0; m < 4; ++m) { const int row = row0 + ai * HALF + m * 16; const float s = rs[row];
                float o[8];
#pragma unroll
                for (int n = 0; n < 2; ++n)
#pragma unroll
                    for (int j = 0; j < 4; ++j) { const float gg = acc[ai][0][m][n][j] * s, uu = acc[ai][1][m][n][j] * s; o[n * 4 + j] = gg * sigmoidf_(gg) * uu; }
                u32x4 w; w.x = pk2(o[0], o[1]); w.y = pk2(o[2], o[3]); w.z = pk2(o[4], o[5]); w.w = pk2(o[6], o[7]);
                *(u32x4*)(act + (size_t)row * FFN + col0) = w; }
        return false;
    }
};
}

struct Args { const float* in[30]; float* out; unsigned char* ws; int lo, hi; };
enum { I_X = 0, I_NPM, I_NQM, I_NPF, I_NQF, I_WIN, I_MU, I_W0, I_W2, I_A0, I_A2, I_G2, I_KK, I_KA, I_RK, I_LNW, I_LNB, I_PEK, I_PEV, I_CKW1, I_CKW2, I_CVW1, I_CVW2, I_SINK, I_REL, I_WBR, I_WOUT, I_FG, I_FU, I_FD };

struct Ctx { LAS unsigned char* lds; int tid, lane, wave, G, bid; };
__device__ __forceinline__ const float* inptr(const Ctx& c, int i) {
    const volatile LAS unsigned* t = (const volatile LAS unsigned*)(c.lds + LDS_MISC + 64) + 2 * i;
    const unsigned lo = __builtin_amdgcn_readfirstlane(t[0]), hi = __builtin_amdgcn_readfirstlane(t[1]);
    return (const float*)(((unsigned long long)hi << 32) | lo);
}

__device__ __forceinline__ void phase_init(const Ctx& c, const float* x, float* xo, bf16_t* xb, float* rs) {
    const int gw = c.bid * 8 + c.wave, NGW = c.G * 8;
    for (int row = gw; row < MROWS; row += NGW) {
        const float* xr = x + (size_t)row * D; float ss = 0.f;
#pragma unroll
        for (int j = 0; j < 2; ++j) { const int e = c.lane * 8 + 512 * j; const f32x4 a = *(const f32x4*)(xr + e), b = *(const f32x4*)(xr + e + 4);
            ss += a[0] * a[0] + a[1] * a[1] + a[2] * a[2] + a[3] * a[3] + b[0] * b[0] + b[1] * b[1] + b[2] * b[2] + b[3] * b[3];
            *(f32x4*)(xo + (size_t)row * D + e) = a; *(f32x4*)(xo + (size_t)row * D + e + 4) = b;
            u32x4 w; w.x = pk2(a[0], a[1]); w.y = pk2(a[2], a[3]); w.z = pk2(b[0], b[1]); w.w = pk2(b[2], b[3]); *(u32x4*)(xb + (size_t)row * D + e) = w; }
        ss = wave_sum(ss);
        if (c.lane == 0) rs[row] = rsqrtf(ss * (1.0f / D) + NORM_EPS);
    }
}
__device__ __forceinline__ void phase_norm_res(const Ctx& c, const bf16_t* y, const float* gain, float* x, bf16_t* xb, float* rs, int row0, int nrows) {
    const int gw = c.bid * 8 + c.wave, NGW = c.G * 8;
    for (int r = gw; r < nrows; r += NGW) {
        const int row = row0 + r; float yv[16]; float ss = 0.f;
#pragma unroll
        for (int j = 0; j < 2; ++j) { float f[8]; unpack8(*(const u32x4*)(y + (size_t)r * D + c.lane * 8 + 512 * j), f);
#pragma unroll
            for (int k = 0; k < 8; ++k) { yv[j * 8 + k] = f[k]; ss += f[k] * f[k]; } }
        ss = wave_sum(ss); const float sc = rsqrtf(ss * (1.0f / D) + NORM_EPS); float s2 = 0.f;
#pragma unroll
        for (int j = 0; j < 2; ++j) { const int e = c.lane * 8 + 512 * j; float* xr = x + (size_t)row * D + e;
            f32x4 a = *(const f32x4*)xr, b = *(const f32x4*)(xr + 4); const f32x4 ga = *(const f32x4*)(gain + e), gb = *(const f32x4*)(gain + e + 4);
#pragma unroll
            for (int k = 0; k < 4; ++k) { a[k] += yv[j * 8 + k] * sc * ga[k]; b[k] += yv[j * 8 + 4 + k] * sc * gb[k]; s2 += a[k] * a[k] + b[k] * b[k]; }
            *(f32x4*)xr = a; *(f32x4*)(xr + 4) = b;
            u32x4 w; w.x = pk2(a[0], a[1]); w.y = pk2(a[2], a[3]); w.z = pk2(b[0], b[1]); w.w = pk2(b[2], b[3]); *(u32x4*)(xb + (size_t)row * D + e) = w; }
        s2 = wave_sum(s2);
        if (c.lane == 0) rs[row] = rsqrtf(s2 * (1.0f / D) + NORM_EPS);
    }
}

__device__ __forceinline__ float cvt_fetch(const Ctx& c, int layer, int kind, int sub, int k, int n) {
    switch (kind) {
    case 0: { int src; float sc = inptr(c, I_NPM)[layer * D + k];
        if (n < 3096) src = n; else if (n < 3328) return 0.f; else if (n < 4096) src = 3096 + (n - 3328); else src = 3864 + (n - 4096);
        if ((n >= PC_NQ && n < PC_NQ + 512) || (n >= PC_SQ && n < PC_SQ + 512)) sc *= 0.125f;
        return inptr(c, I_WIN)[((size_t)layer * D + k) * IN_COLS + src] * sc; }
    case 1: return inptr(c, I_WBR)[(((size_t)layer * 3 + sub) * 512 + k) * D + n];
    case 2: return inptr(c, I_WOUT)[((size_t)layer * D + k) * D + n];
    case 3: { const int pn = n >> 8, r = n & 255; const float sc = inptr(c, I_NPF)[layer * D + k];
        return (r < 128 ? inptr(c, I_FG)[((size_t)layer * D + k) * FFN + pn * 128 + r] : inptr(c, I_FU)[((size_t)layer * D + k) * FFN + pn * 128 + r - 128]) * sc; }
    case 4: return inptr(c, I_FD)[((size_t)layer * FFN + k) * D + n];
    case 6: return inptr(c, sub ? I_CVW1 : I_CKW1)[((size_t)layer * 2048 + k) * 256 + n];
    case 7: return n < 64 ? inptr(c, sub ? I_CVW2 : I_CKW2)[((size_t)layer * 256 + k) * 64 + n] : 0.f;
    default: {
        if (n < 512) return k < 64 ? inptr(c, I_W2)[((size_t)layer * 64 + k) * 512 + n] : 0.f;
        if (n < 1024) return (k >= 64 && k < 128) ? inptr(c, I_A2)[((size_t)layer * 64 + k - 64) * 512 + n - 512] : 0.f;
        return k >= 128 ? inptr(c, I_G2)[((size_t)layer * 128 + k - 128) * 512 + n - 1024] : 0.f; }
    }
}
__device__ __forceinline__ void phase_cvt(const Ctx& c, const Args& a, int layer, bf16_t* wb) {
    LAS float* tile = (LAS float*)c.lds;
    constexpr int I0 = 16 * 112, I1 = 3 * 8 * 16, I2 = 16 * 16, I3 = 16 * 88, I4 = 44 * 16, I5 = 4 * 24, I6 = 2 * 32 * 4, I7 = 2 * 4 * 4, NIT = I0 + I1 + I2 + I3 + I4 + I5 + I6 + I7;
    for (int it = c.bid; it < NIT; it += c.G) {
        int r = it, kind, sub = 0, K, nblk; bf16_t* dst;
        if (r < I0) { kind = 0; K = D; nblk = 112; dst = wb + WB_WIN; }
        else if ((r -= I0) < I1) { kind = 1; sub = r / 128; r -= sub * 128; K = 512; nblk = 16; dst = wb + WB_WBR + (size_t)sub * D * 512; }
        else if ((r -= I1) < I2) { kind = 2; K = D; nblk = 16; dst = wb + WB_WOUT; }
        else if ((r -= I2) < I3) { kind = 3; K = D; nblk = 88; dst = wb + WB_WGU; }
        else if ((r -= I3) < I4) { kind = 4; K = FFN; nblk = 16; dst = wb + WB_WDN; }
        else if ((r -= I4) < I5) { kind = 5; K = 256; nblk = 24; dst = wb + WB_LORA; }
        else if ((r -= I5) < I6) { kind = 6; sub = r / 128; r -= sub * 128; K = 2048; nblk = 4; dst = wb + WB_W1T + (size_t)sub * 256 * 2048; }
        else { r -= I6; kind = 7; sub = r / 16; r -= sub * 16; K = 256; nblk = 4; dst = wb + WB_W2T + (size_t)sub * 256 * 256; }
        const int kb = r / nblk, nb = r % nblk, k0 = kb * 64, n0 = nb * 64;
        for (int e = c.tid; e < 4096; e += 512) { const int kk = e >> 6, nn = e & 63; tile[kk * 65 + nn] = cvt_fetch(c, layer, kind, sub, k0 + kk, n0 + nn); }
        __syncthreads();
        for (int e = c.tid; e < 2048; e += 512) { const int nn = e >> 5, kp = (e & 31) * 2;
            *(unsigned*)(dst + (size_t)(n0 + nn) * K + k0 + kp) = pk2(tile[kp * 65 + nn], tile[(kp + 1) * 65 + nn]); }
        __syncthreads();
    }
    if (c.bid == c.G - 1) {
        const int kv = c.tid >> 8, u = c.tid & 255; const float* w1 = inptr(c, kv ? I_CVW1 : I_CKW1) + (size_t)layer * 2048 * 256; const float* pe = inptr(c, kv ? I_PEV : I_PEK) + (size_t)layer * 2048;
        float acc = 0.f; for (int k = 0; k < 2048; ++k) acc += pe[k] * w1[(size_t)k * 256 + u];
        ((float*)(wb + WB_BH))[c.tid] = acc;
    }
}

struct RowState { float q[64]; float o[64]; float m, l; };
__device__ __forceinline__ void row_init(RowState& s, const bf16_t* qp) {
#pragma unroll
    for (int i = 0; i < 8; ++i) { float f[8]; unpack8(*(const u32x4*)(qp + i * 8), f);
#pragma unroll
        for (int k = 0; k < 8; ++k) s.q[i * 8 + k] = f[k]; }
}
__device__ __forceinline__ void row_reset(RowState& s) {
#pragma unroll
    for (int i = 0; i < 64; ++i) s.o[i] = 0.f;
    s.m = -1e30f; s.l = 0.f;
}
__device__ __forceinline__ void row_key_bf16(RowState& s, const bf16_t* kp, const bf16_t* vp, float bias) {
    float sc = bias;
#pragma unroll
    for (int i = 0; i < 8; ++i) { float f[8]; unpack8(*(const u32x4*)(kp + i * 8), f);
#pragma unroll
        for (int k = 0; k < 8; ++k) sc += s.q[i * 8 + k] * f[k];
        if ((i & 1) == 1) __builtin_amdgcn_sched_barrier(0); }
    const float mn = fmaxf(s.m, sc), corr = __expf(s.m - mn), p = __expf(sc - mn);
    s.l = s.l * corr + p; s.m = mn;
#pragma unroll
    for (int i = 0; i < 8; ++i) { float f[8]; unpack8(*(const u32x4*)(vp + i * 8), f);
#pragma unroll
        for (int k = 0; k < 8; ++k) s.o[i * 8 + k] = s.o[i * 8 + k] * corr + p * f[k];
        if ((i & 1) == 1) __builtin_amdgcn_sched_barrier(0); }
}
__device__ __forceinline__ void row_key_f32(RowState& s, const float* kp, const float* vp, float bias) {
    float sc = bias;
#pragma unroll
    for (int i = 0; i < 16; ++i) { const f32x4 f = *(const f32x4*)(kp + i * 4); sc += s.q[i * 4] * f[0] + s.q[i * 4 + 1] * f[1] + s.q[i * 4 + 2] * f[2] + s.q[i * 4 + 3] * f[3];
        if ((i & 3) == 3) __builtin_amdgcn_sched_barrier(0); }
    const float mn = fmaxf(s.m, sc), corr = __expf(s.m - mn), p = __expf(sc - mn);
    s.l = s.l * corr + p; s.m = mn;
#pragma unroll
    for (int i = 0; i < 16; ++i) { const f32x4 f = *(const f32x4*)(vp + i * 4);
#pragma unroll
        for (int k = 0; k < 4; ++k) s.o[i * 4 + k] = s.o[i * 4 + k] * corr + p * f[k];
        if ((i & 3) == 3) __builtin_amdgcn_sched_barrier(0); }
}

__device__ __forceinline__ float gelu_tanh(float x) { const float t = tanhf(0.7978845608028654f * (x + 0.044715f * x * x * x)); return 0.5f * x * (1.0f + t); }
__device__ __forceinline__ void phase_cmp1(const Ctx& c, const Args& a, int layer, const bf16_t* proj, float* hid) {
    for (int unit = c.bid; unit < 2048; unit += c.G) {
        const int kv = unit >> 10, g = (unit >> 9) & 1, cp = unit & 511; const int cc = cp * 2 + (c.tid >> 8), u = c.tid & 255;
        if (cc >= NCMP) continue;
        const float* w1 = a.in[kv ? I_CVW1 : I_CKW1] + (size_t)layer * 2048 * 256; const float* pe = a.in[kv ? I_PEV : I_PEK] + (size_t)layer * 32 * 64;
        const bf16_t* xp = proj + (size_t)(16 * cc) * PLD + (kv ? PC_VC : PC_KC) + g * 64;
        float acc = 0.f;
        for (int l = 0; l < 32; ++l) {
#pragma unroll
            for (int i = 0; i < 8; ++i) { float f[8]; unpack8(*(const u32x4*)(xp + (size_t)l * PLD + i * 8), f);
#pragma unroll
                for (int k = 0; k < 8; ++k) acc += (f[k] + pe[l * 64 + i * 8 + k]) * w1[(size_t)(l * 64 + i * 8 + k) * 256 + u]; }
        }
        hid[(((size_t)kv * 2 + g) * 1024 + cc) * 256 + u] = gelu_tanh(acc);
    }
}
__device__ __forceinline__ void phase_cmp2(const Ctx& c, const Args& a, int layer, const float* hid, bf16_t* kcb, bf16_t* vctb) {
    for (int unit = c.bid; unit < 512; unit += c.G) {
        const int kv = unit >> 8, g = (unit >> 7) & 1, cc = (unit & 127) * 8 + (c.tid >> 6), d = c.tid & 63;
        float acc = 0.f;
        if (cc < NCMP) { const float* w2 = a.in[kv ? I_CVW2 : I_CKW2] + (size_t)layer * 256 * 64; const float* hp = hid + (((size_t)kv * 2 + g) * 1024 + cc) * 256;
            for (int u = 0; u < 256; ++u) acc += hp[u] * w2[u * 64 + d]; }
        if (kv) vctb[((size_t)g * 64 + d) * 1024 + cc] = (bf16_t)f2bf(acc); else kcb[((size_t)g * 1024 + cc) * 64 + d] = (bf16_t)f2bf(acc);
    }
}
__device__ __forceinline__ void phase_nsa13(const Ctx& c, const Args& a, const bf16_t* proj, const float* kcmp, const float* vcmp, float* nsaacc, float* ml) {
    LAS float* tb = (LAS float*)c.lds;
    for (int e = c.tid; e < 512; e += 512) tb[e] = inptr(c, I_REL)[e];
    __syncthreads();
    for (int unit = c.bid; unit < T / 64; unit += c.G) {
        const int hh = c.tid >> 6, t = unit * 64 + (c.tid & 63), g = hh >> 2;
        RowState s; row_init(s, proj + (size_t)t * PLD + PC_NQ + hh * 64);
        const bf16_t* glp = proj + (size_t)t * PLD + PC_GL;
        const float g0 = sigmoidf_(bf2f(glp[hh])), g2 = sigmoidf_(bf2f(glp[16 + hh]));
        row_reset(s);
        const int nv = t >= 31 ? (t - 31) / 16 + 1 : 0;
        for (int cc = 0; cc < nv; ++cc) { const float bias = tb[t5_bucket(t - 16 * cc - 31) * 16 + hh];
            row_key_f32(s, kcmp + ((size_t)g * 1024 + cc) * 64, vcmp + ((size_t)g * 1024 + cc) * 64, bias); }
        ml[((size_t)t * 8 + hh) * 2] = s.m; ml[((size_t)t * 8 + hh) * 2 + 1] = s.l;
        float* op = nsaacc + (size_t)t * 512 + hh * 64;
        { const float inv = s.l > 0.f ? g0 / s.l : 0.f;
#pragma unroll
            for (int i = 0; i < 16; ++i) { f32x4 w; w[0] = s.o[i * 4] * inv; w[1] = s.o[i * 4 + 1] * inv; w[2] = s.o[i * 4 + 2] * inv; w[3] = s.o[i * 4 + 3] * inv; *(f32x4*)(op + i * 4) = w; } }
        row_reset(s);
        const int s0 = t - 511 > 0 ? t - 511 : 0;
        for (int sp = s0; sp <= t; ++sp) { const float bias = tb[t5_bucket(t - sp) * 16 + hh];
            row_key_bf16(s, proj + (size_t)sp * PLD + PC_KW + g * 64, proj + (size_t)sp * PLD + PC_VW + g * 64, bias); }
        { const float inv = s.l > 0.f ? g2 / s.l : 0.f;
#pragma unroll
            for (int i = 0; i < 16; ++i) { f32x4 w = *(const f32x4*)(op + i * 4); w[0] += s.o[i * 4] * inv; w[1] += s.o[i * 4 + 1] * inv; w[2] += s.o[i * 4 + 2] * inv; w[3] += s.o[i * 4 + 3] * inv; *(f32x4*)(op + i * 4) = w; } }
    }
}
__device__ __forceinline__ void phase_nsa_topk(const Ctx& c, const Args& a, const bf16_t* proj, const float* kcmp, const float* ml, int* sel) {
    LAS float* tb = (LAS float*)c.lds;
    LAS float* qs = (LAS float*)(c.lds + 4096) + c.wave * 256;
    LAS float* sv = (LAS float*)(c.lds + 16384) + c.wave * 256;
    for (int e = c.tid; e < 512; e += 512) tb[e] = inptr(c, I_REL)[e];
    __syncthreads();
    const int gw = c.bid * 8 + c.wave, NGW = c.G * 8;
    for (int item = gw; item < T * 2; item += NGW) {
        const int t = item >> 1, g = item & 1, cur = t >> 6;
        { const bf16_t* qp = proj + (size_t)t * PLD + PC_NQ + g * 256 + c.lane * 4; const u32x2 w = *(const u32x2*)qp;
          qs[c.lane * 4] = __uint_as_float(w.x << 16); qs[c.lane * 4 + 1] = __uint_as_float(w.x & 0xffff0000u); qs[c.lane * 4 + 2] = __uint_as_float(w.y << 16); qs[c.lane * 4 + 3] = __uint_as_float(w.y & 0xffff0000u); }
        float mr[4], il[4];
#pragma unroll
        for (int r = 0; r < 4; ++r) { mr[r] = ml[((size_t)t * 8 + g * 4 + r) * 2]; const float l = ml[((size_t)t * 8 + g * 4 + r) * 2 + 1]; il[r] = l > 0.f ? 1.0f / l : 0.f; }
        const int nv = t >= 31 ? (t - 31) / 16 + 1 : 0;
        asm volatile("s_waitcnt lgkmcnt(0)" ::: "memory");
#pragma unroll 1
        for (int jj = 0; jj < 4; ++jj) {
            const int j = c.lane + 64 * jj; float sc;
            if (j == 0 || j == cur || j == cur - 1) sc = 1e4f;
            else if (j > cur) sc = -1.0f;
            else { sc = 0.f;
#pragma unroll 1
                for (int o = 0; o < 5; ++o) { const int cc = 4 * j + o - 1; if (cc < 0 || cc >= nv) continue;
                    const float* kp = kcmp + ((size_t)g * 1024 + cc) * 64; float d0 = 0.f, d1 = 0.f, d2 = 0.f, d3 = 0.f;
#pragma unroll 4
                    for (int i = 0; i < 16; ++i) { const f32x4 f = *(const f32x4*)(kp + i * 4);
#pragma unroll
                        for (int k = 0; k < 4; ++k) { d0 += qs[i * 4 + k] * f[k]; d1 += qs[64 + i * 4 + k] * f[k]; d2 += qs[128 + i * 4 + k] * f[k]; d3 += qs[192 + i * 4 + k] * f[k]; } }
                    const int bk = t5_bucket(t - 16 * cc - 31) * 16 + g * 4;
                    const float imp = __expf(d0 + tb[bk] - mr[0]) * il[0] + __expf(d1 + tb[bk + 1] - mr[1]) * il[1] + __expf(d2 + tb[bk + 2] - mr[2]) * il[2] + __expf(d3 + tb[bk + 3] - mr[3]) * il[3];
                    sc += ((o == 0 || o == 4) ? 1.0f : 2.0f) * imp; }
            }
            sv[j] = sc;
        }
        asm volatile("s_waitcnt lgkmcnt(0)" ::: "memory");
        float val[4];
#pragma unroll
        for (int jj = 0; jj < 4; ++jj) val[jj] = sv[c.lane + 64 * jj];
        for (int k = 0; k < 16; ++k) {
            float bv = val[0]; int bi = c.lane;
#pragma unroll
            for (int jj = 1; jj < 4; ++jj) if (val[jj] > bv) { bv = val[jj]; bi = c.lane + 64 * jj; }
#pragma unroll
            for (int o = 32; o >= 1; o >>= 1) { const float ov = __shfl_xor(bv, o); const int oi = __shfl_xor(bi, o); if (ov > bv || (ov == bv && oi < bi)) { bv = ov; bi = oi; } }
#pragma unroll
            for (int jj = 0; jj < 4; ++jj) if (bi == c.lane + 64 * jj) val[jj] = -3e38f;
            if (c.lane == 0) sel[(size_t)item * 16 + k] = bi;
        }
    }
}
__device__ __forceinline__ void phase_nsa2(const Ctx& c, const Args& a, const bf16_t* proj, const int* sel, const float* nsaacc, bf16_t* onsa) {
    LAS float* tb = (LAS float*)c.lds;
    for (int e = c.tid; e < 512; e += 512) tb[e] = inptr(c, I_REL)[e];
    __syncthreads();
    for (int unit = c.bid; unit < T / 64; unit += c.G) {
        const int hh = c.tid >> 6, t = unit * 64 + (c.tid & 63), g = hh >> 2;
        RowState s; row_init(s, proj + (size_t)t * PLD + PC_NQ + hh * 64); row_reset(s);
        const float g1 = sigmoidf_(bf2f(proj[(size_t)t * PLD + PC_GL + 8 + hh]));
        for (int k = 0; k < 16; ++k) { const int j = sel[((size_t)t * 2 + g) * 16 + k];
            for (int p = 0; p < 64; ++p) { const int pos = j * 64 + p; if (pos > t) break;
                const float bias = tb[t5_bucket(t - pos) * 16 + hh];
                row_key_bf16(s, proj + (size_t)pos * PLD + PC_KS + g * 64, proj + (size_t)pos * PLD + PC_VS + g * 64, bias); } }
        const float inv = s.l > 0.f ? g1 / s.l : 0.f; const float* ap = nsaacc + (size_t)t * 512 + hh * 64; bf16_t* op = onsa + (size_t)t * 512 + hh * 64;
#pragma unroll
        for (int i = 0; i < 8; ++i) { const f32x4 x0 = *(const f32x4*)(ap + i * 8), x1 = *(const f32x4*)(ap + i * 8 + 4); u32x4 w;
            w.x = pk2(x0[0] + s.o[i * 8] * inv, x0[1] + s.o[i * 8 + 1] * inv); w.y = pk2(x0[2] + s.o[i * 8 + 2] * inv, x0[3] + s.o[i * 8 + 3] * inv);
            w.z = pk2(x1[0] + s.o[i * 8 + 4] * inv, x1[1] + s.o[i * 8 + 5] * inv); w.w = pk2(x1[2] + s.o[i * 8 + 6] * inv, x1[3] + s.o[i * 8 + 7] * inv);
            *(u32x4*)(op + i * 8) = w; }
    }
}
__device__ __forceinline__ void phase_swa(const Ctx& c, const Args& a, int layer, const bf16_t* proj, bf16_t* oswa) {
    LAS float* tb = (LAS float*)c.lds;
    for (int e = c.tid; e < 512; e += 512) tb[e] = inptr(c, I_REL)[e];
    __syncthreads();
    for (int unit = c.bid; unit < T / 64; unit += c.G) {
        const int hh = c.tid >> 6, t = unit * 64 + (c.tid & 63), g = hh >> 2;
        RowState s; row_init(s, proj + (size_t)t * PLD + PC_SQ + hh * 64); row_reset(s);
        const int s0 = t - 127 > 0 ? t - 127 : 0;
        for (int sp = s0; sp <= t; ++sp) { const float bias = tb[t5_bucket(t - sp) * 16 + 8 + hh];
            row_key_bf16(s, proj + (size_t)sp * PLD + PC_SK + g * 64, proj + (size_t)sp * PLD + PC_SV + g * 64, bias); }
        const float sink = inptr(c, I_SINK)[layer * 8 + hh]; const float mf = fmaxf(s.m, sink); const float corr = __expf(s.m - mf);
        const float den = s.l * corr + __expf(sink - mf); const float inv = corr / den;
        bf16_t* op = oswa + (size_t)t * 512 + hh * 64;
#pragma unroll
        for (int i = 0; i < 8; ++i) { u32x4 w; w.x = pk2(s.o[i * 8] * inv, s.o[i * 8 + 1] * inv); w.y = pk2(s.o[i * 8 + 2] * inv, s.o[i * 8 + 3] * inv);
            w.z = pk2(s.o[i * 8 + 4] * inv, s.o[i * 8 + 5] * inv); w.w = pk2(s.o[i * 8 + 6] * inv, s.o[i * 8 + 7] * inv); *(u32x4*)(op + i * 8) = w; }
    }
}

constexpr int RL = 65;
__device__ __forceinline__ float rwkv_mixed(const bf16_t* proj, const float* mu, int t, int col) {
    const float cur = bf2f(proj[(size_t)t * PLD + col]); const float prev = t > 0 ? bf2f(proj[(size_t)(t - 1) * PLD + col]) : 0.f;
    return cur + (prev - cur) * mu[col];
}
__device__ __forceinline__ void lora64(const Ctx& c, const LAS float* in, const float* W, const float* bias, LAS float* out, bool accum) {
    const int j = c.tid & 63, tg = (c.tid >> 6) * 8;
    float acc[8];
#pragma unroll
    for (int i = 0; i < 8; ++i) acc[i] = accum ? out[(tg + i) * RL + j] : (bias ? bias[j] : 0.f);
#pragma unroll 4
    for (int m = 0; m < 64; ++m) { const float w = W[(size_t)m * 512 + j];
#pragma unroll
        for (int i = 0; i < 8; ++i) acc[i] += in[(tg + i) * RL + m] * w; }
#pragma unroll
    for (int i = 0; i < 8; ++i) out[(tg + i) * RL + j] = acc[i];
}
struct RwkvLds { LAS float *R, *K, *V, *A, *B, *W, *G, *TMP; };
__device__ __forceinline__ RwkvLds rwkv_lds(LAS unsigned char* lds) {
    RwkvLds s; LAS float* p = (LAS float*)lds; constexpr int SZ = 64 * RL;
    s.R = p; s.K = p + SZ; s.V = p + 2 * SZ; s.A = p + 3 * SZ; s.B = p + 4 * SZ; s.W = p + 5 * SZ; s.G = p + 6 * SZ; s.TMP = p + 7 * SZ; return s;
}
template <bool LOGDECAY>
__device__ __forceinline__ void rwkv_prep(const Ctx& c, const Args& a, int layer, const bf16_t* proj, int t0, int h, const RwkvLds& s) {
    const float* mu = inptr(c, I_MU) + (size_t)layer * 1792;
    const int j = c.tid & 63, tg = c.tid >> 6;
#pragma unroll 2
    for (int i = 0; i < 8; ++i) { const int tt = tg * 8 + i; s.TMP[tt * RL + j] = tanhf(rwkv_mixed(proj, mu, t0 + tt, PC_ZW + j)); }
    __syncthreads();
    lora64(c, s.TMP, inptr(c, I_W2) + (size_t)layer * 64 * 512 + h * 64, inptr(c, I_W0) + layer * 512 + h * 64, s.W, false);
    __syncthreads();
#pragma unroll 2
    for (int i = 0; i < 8; ++i) { const int tt = tg * 8 + i; s.TMP[tt * RL + j] = rwkv_mixed(proj, mu, t0 + tt, PC_ZA + j); }
    __syncthreads();
    lora64(c, s.TMP, inptr(c, I_A2) + (size_t)layer * 64 * 512 + h * 64, inptr(c, I_A0) + layer * 512 + h * 64, s.B, false);
    __syncthreads();
#pragma unroll 2
    for (int i = 0; i < 8; ++i) { const int tt = tg * 8 + i; s.TMP[tt * RL + j] = sigmoidf_(rwkv_mixed(proj, mu, t0 + tt, PC_ZG + j)); }
    __syncthreads();
    lora64(c, s.TMP, inptr(c, I_G2) + (size_t)layer * 128 * 512 + h * 64, nullptr, s.G, false);
    __syncthreads();
#pragma unroll 2
    for (int i = 0; i < 8; ++i) { const int tt = tg * 8 + i; s.TMP[tt * RL + j] = sigmoidf_(rwkv_mixed(proj, mu, t0 + tt, PC_ZG + 64 + j)); }
    __syncthreads();
    lora64(c, s.TMP, inptr(c, I_G2) + ((size_t)layer * 128 + 64) * 512 + h * 64, nullptr, s.G, true);
    const float kkw = inptr(c, I_KK)[layer * 512 + h * 64 + j], kaw = inptr(c, I_KA)[layer * 512 + h * 64 + j];
#pragma unroll 1
    for (int i = 0; i < 8; ++i) { const int tt = tg * 8 + i, t = t0 + tt;
        const float r = rwkv_mixed(proj, mu, t, PC_R + h * 64 + j), k = rwkv_mixed(proj, mu, t, PC_K + h * 64 + j), v = rwkv_mixed(proj, mu, t, PC_V + h * 64 + j);
        const float wl = s.W[tt * RL + j], al = sigmoidf_(s.B[tt * RL + j]);
        const float sp = (-wl > 20.f) ? -wl : log1pf(__expf(-wl)); const float w = -sp - 0.5f; const float ew = __expf(w);
        float kk = k * kkw; const float n2 = wave_sum(kk * kk); kk = kk / fmaxf(sqrtf(n2), 1e-12f);
        s.R[tt * RL + j] = r; s.V[tt * RL + j] = v; s.K[tt * RL + j] = k * (1.0f + (al - 1.0f) * kaw);
        s.A[tt * RL + j] = -kk; s.B[tt * RL + j] = kk * al; s.W[tt * RL + j] = LOGDECAY ? -ew : __expf(-ew); }
    __syncthreads();
}
__device__ __forceinline__ void rwkv_post(const Ctx& c, const Args& a, int layer, int t0, int h, const RwkvLds& s, const LAS float* Y, bf16_t* orwkv) {
    const int i = c.lane, tg = c.wave;
    const float lnw = inptr(c, I_LNW)[layer * 512 + h * 64 + i], lnb = inptr(c, I_LNB)[layer * 512 + h * 64 + i], rk = inptr(c, I_RK)[layer * 512 + h * 64 + i];
#pragma unroll 1
    for (int q = 0; q < 8; ++q) { const int tt = tg * 8 + q; const float y = Y[tt * RL + i];
        const float mean = wave_sum(y) * (1.0f / 64.0f); const float d = y - mean; const float var = wave_sum(d * d) * (1.0f / 64.0f);
        const float bonus = wave_sum(s.R[tt * RL + i] * s.K[tt * RL + i] * rk);
        const float o = (d * rsqrtf(var + 64e-5f) * lnw + lnb + bonus * s.V[tt * RL + i]) * s.G[tt * RL + i];
        orwkv[(size_t)(t0 + tt) * 512 + h * 64 + i] = (bf16_t)f2bf(o); }
}
__device__ __forceinline__ void phase_rwkv_naive(const Ctx& c, const Args& a, int layer, const bf16_t* proj, bf16_t* orwkv) {
    if (c.bid >= 8) return;
    const int h = c.bid; const RwkvLds s = rwkv_lds(c.lds);
    float S[64];
#pragma unroll
    for (int j = 0; j < 64; ++j) S[j] = 0.f;
    for (int ch = 0; ch < T / 64; ++ch) {
        rwkv_prep<false>(c, a, layer, proj, ch * 64, h, s);
        if (c.wave == 0) {
            const int i = c.lane;
            for (int tt = 0; tt < 64; ++tt) {
                float sa = 0.f;
#pragma unroll
                for (int j = 0; j < 64; ++j) { sa += S[j] * s.A[tt * RL + j]; if ((j & 7) == 7) __builtin_amdgcn_sched_barrier(0); }
                const float vi = s.V[tt * RL + i]; float y = 0.f;
#pragma unroll
                for (int j = 0; j < 64; ++j) { S[j] = S[j] * s.W[tt * RL + j] + sa * s.B[tt * RL + j] + vi * s.K[tt * RL + j]; y += S[j] * s.R[tt * RL + j]; if ((j & 3) == 3) __builtin_amdgcn_sched_barrier(0); }
                s.TMP[tt * RL + i] = y;
            }
        }
        __syncthreads();
        rwkv_post(c, a, layer, ch * 64, h, s, s.TMP, orwkv);
        __syncthreads();
    }
}


__device__ __forceinline__ int kperm32(int jl) { return 8 * ((jl >> 2) & 3) + 4 * (jl >> 4) + (jl & 3); }
__device__ __forceinline__ f32x4 tile_mma64(const LAS unsigned char* A, const LAS unsigned char* B, int a, int b, int lane, f32x4 acc) {
    const int m = lane & 15, q = lane >> 4;
#pragma unroll
    for (int ks = 0; ks < 2; ++ks) {
        const bf16x8 af = *(const LAS bf16x8*)(A + (16 * a + m) * 144 + (32 * ks + 8 * q) * 2);
        const bf16x8 bf = *(const LAS bf16x8*)(B + (16 * b + m) * 144 + (32 * ks + 8 * q) * 2);
        acc = __builtin_amdgcn_mfma_f32_16x16x32_bf16(af, bf, acc, 0, 0, 0);
    }
    return acc;
}
__device__ __forceinline__ void lds_st_bf16(LAS unsigned char* base, int idx, float v) { *(LAS bf16_t*)(base + idx * 2) = (bf16_t)f2bf(v); }

__device__ __forceinline__ void phase_lora_a(const Ctx& c, const Args& a, int layer, const bf16_t* proj, bf16_t* alora) {
    const float* mu = inptr(c, I_MU) + (size_t)layer * 1792;
    const int sub = c.tid & 31, rloc = c.tid >> 5;
    for (int t = c.bid * 16 + rloc; t < T; t += c.G * 16) {
        const int col = PC_ZW + sub * 8; float cur[8], prv[8];
        unpack8(*(const u32x4*)(proj + (size_t)t * PLD + col), cur);
        if (t > 0) unpack8(*(const u32x4*)(proj + (size_t)(t - 1) * PLD + col), prv); else {
#pragma unroll
            for (int k = 0; k < 8; ++k) prv[k] = 0.f; }
        float o[8];
#pragma unroll
        for (int k = 0; k < 8; ++k) { const float v = cur[k] + (prv[k] - cur[k]) * mu[col + k]; o[k] = sub < 8 ? tanhf(v) : (sub < 16 ? v : sigmoidf_(v)); }
        u32x4 w; w.x = pk2(o[0], o[1]); w.y = pk2(o[2], o[3]); w.z = pk2(o[4], o[5]); w.w = pk2(o[6], o[7]);
        *(u32x4*)(alora + (size_t)t * 256 + sub * 8) = w;
    }
}

constexpr int RC_L = 0, RC_AL = 16640, RC_AAK = 0, RC_ARB = 9216, RC_ARK = 18432, RC_AAB = 33280, RC_P2T = 33280, RC_WC = 50688, RC_BS = 50944, RC_M = 52992;
constexpr int RC_AT = RC_M, RC_TINV = RC_M, RC_ATT = RC_M + 9216, RC_RT = RC_M + 2 * 9216, RC_BT = RC_M + 3 * 9216, RC_XT = RC_BT, RC_KT = RC_M + 4 * 9216, RC_P1T = RC_KT,
              RC_VT = RC_M + 5 * 9216, RC_BHT = RC_M + 6 * 9216, RC_KHT = RC_M + 7 * 9216;
constexpr int RC_XOFF = RC_M + 8 * 9216, RC_XTMP = RC_XOFF + 6144;
static_assert(RC_XTMP + 3 * 1088 <= LDS_MISC, "rwkv chunk LDS");

__device__ __forceinline__ void phase_rwkv_chunk(const Ctx& c, const Args& a, int layer, const bf16_t* proj, const bf16_t* wlb, const bf16_t* alb, bf16_t* rwu, float* bonusg) {
    LAS unsigned char* L = c.lds;
    LAS float* sL = (LAS float*)(L + RC_L); LAS float* sAL = (LAS float*)(L + RC_AL); LAS float* sAAB = (LAS float*)(L + RC_AAB);
    LAS float* sWC = (LAS float*)(L + RC_WC); LAS float* sBS = (LAS float*)(L + RC_BS);
    const float* mu = inptr(c, I_MU) + (size_t)layer * 1792;
    const int lane = c.lane, wave = c.wave, n = lane & 15, q = lane >> 4;
    for (int unit = c.bid; unit < 2048; unit += c.G) {
        const int ch = unit >> 3, h = unit & 7, t0 = ch * 64, j = lane;
        {
            const float w0 = inptr(c, I_W0)[layer * 512 + h * 64 + j], a0 = inptr(c, I_A0)[layer * 512 + h * 64 + j];
            bf16_t wraw[8], araw[8];
#pragma unroll
            for (int i = 0; i < 8; ++i) { const size_t gi = (size_t)(t0 + wave * 8 + i) * 512 + h * 64 + j; wraw[i] = wlb[gi]; araw[i] = alb[gi]; }
            float run = 0.f;
#pragma unroll
            for (int i = 0; i < 8; ++i) { const int tt = wave * 8 + i;
                const float wl = w0 + bf2f(wraw[i]); const float nx = -wl; const float sp = nx > 20.f ? nx : log1pf(__expf(nx)); const float ld = -__expf(-sp - 0.5f);
                run += ld; sL[tt * RL + j] = run; sAL[tt * RL + j] = sigmoidf_(a0 + bf2f(araw[i])); }
            sBS[wave * 64 + j] = run;
        }
        bf16_t rraw[9], kraw[9], vraw[9];
        {
#pragma unroll
            for (int i = 0; i < 9; ++i) { const int t = t0 + wave * 8 + i - 1; const bool ok = t >= 0; const size_t ro = (size_t)(ok ? t : 0) * PLD + h * 64 + j;
                rraw[i] = ok ? proj[ro + PC_R] : (bf16_t)0; kraw[i] = ok ? proj[ro + PC_K] : (bf16_t)0; vraw[i] = ok ? proj[ro + PC_V] : (bf16_t)0; }
        }
        __syncthreads();
        {
            float off = 0.f, tot = 0.f;
#pragma unroll
            for (int w2 = 0; w2 < 8; ++w2) { const float v = sBS[w2 * 64 + j]; tot += v; off += (w2 < wave) ? v : 0.f; }
            if (wave == 0) sWC[j] = __expf(tot);
            const float kkw = inptr(c, I_KK)[layer * 512 + h * 64 + j], kaw = inptr(c, I_KA)[layer * 512 + h * 64 + j], rk = inptr(c, I_RK)[layer * 512 + h * 64 + j];
            const float mur = mu[PC_R + h * 64 + j], muk = mu[PC_K + h * 64 + j], muv = mu[PC_V + h * 64 + j];
            float Lprev = off;
#pragma unroll
            for (int i = 0; i < 8; ++i) { const int tt = wave * 8 + i, t = t0 + tt;
                const float Lc = sL[tt * RL + j] + off, al = sAL[tt * RL + j];
                const float rc = bf2f(rraw[i + 1]), kc = bf2f(kraw[i + 1]), vc = bf2f(vraw[i + 1]);
                const float r = rc + (bf2f(rraw[i]) - rc) * mur, k = kc + (bf2f(kraw[i]) - kc) * muk, v = vc + (bf2f(vraw[i]) - vc) * muv;
                float kk = k * kkw; const float n2 = wave_sum(kk * kk); kk = kk / fmaxf(sqrtf(n2), 1e-12f);
                const float kp = k * (1.0f + (al - 1.0f) * kaw), av = -kk, bv = kk * al;
                const float eW = __expf(Lc), eWex = __expf(Lprev), eInv = __expf(-Lc), eC = __expf(tot - Lc);
                lds_st_bf16(L + RC_AT, tt * 72 + j, av * eWex); lds_st_bf16(L + RC_ATT, j * 72 + tt, av * eWex);
                lds_st_bf16(L + RC_RT, tt * 72 + j, r * eW); lds_st_bf16(L + RC_BT, tt * 72 + j, bv * eInv); lds_st_bf16(L + RC_KT, tt * 72 + j, kp * eInv);
                lds_st_bf16(L + RC_VT, j * 72 + tt, v); lds_st_bf16(L + RC_BHT, j * 72 + tt, bv * eC); lds_st_bf16(L + RC_KHT, j * 72 + tt, kp * eC);
                const float bon = wave_sum(r * kp * rk); if (lane == 0) bonusg[(size_t)t * 8 + h] = bon;
                Lprev = Lc; }
        }
        __syncthreads();
        for (int job = wave; job < 64; job += 8) {
            const int p = job >> 4, ta = (job >> 2) & 3, tb = job & 3;
            f32x4 acc = (f32x4){0.f, 0.f, 0.f, 0.f};
            if (ta >= tb) acc = tile_mma64(L + (p < 2 ? RC_AT : RC_RT), L + ((p & 1) ? RC_KT : RC_BT), ta, tb, lane, acc);
            LAS unsigned char* dst = L + (p == 1 ? RC_AAK : (p == 2 ? RC_ARB : RC_ARK));
#pragma unroll
            for (int r = 0; r < 4; ++r) { const int tt = 16 * ta + 4 * q + r, ss = 16 * tb + n; const bool keep = (p < 2) ? (ss < tt) : (ss <= tt); const float v = keep ? acc[r] : 0.f;
                if (p == 0) sAAB[tt * 68 + ss] = v; else lds_st_bf16(dst, tt * 72 + ss, v); }
        }
        __syncthreads();
        if (wave == 0) {
            const int blk = lane >> 4, cc = lane & 15; const LAS float* Ab = sAAB + (16 * blk) * 68 + 16 * blk; float xr[16];
#pragma unroll
            for (int tt = 0; tt < 16; ++tt) { float acc = (tt == cc) ? 1.f : 0.f;
#pragma unroll
                for (int ss = 0; ss < tt; ++ss) acc += Ab[tt * 68 + ss] * xr[ss];
                xr[tt] = acc; }
            asm volatile("s_waitcnt lgkmcnt(0)" ::: "memory");
#pragma unroll
            for (int tt = 0; tt < 16; ++tt) sAAB[(16 * blk + tt) * 68 + 16 * blk + cc] = xr[tt];
        } else {
            for (int job = wave - 1; job < 16; job += 7) { const int ta = job >> 2, tb = job & 3;
                const f32x4 acc = tile_mma64(L + RC_VT, L + RC_AAK, ta, tb, lane, (f32x4){0.f, 0.f, 0.f, 0.f});
#pragma unroll
                for (int r = 0; r < 4; ++r) lds_st_bf16(L + RC_XT, (16 * ta + 4 * q + r) * 72 + 16 * tb + n, acc[r]); }
        }
        __syncthreads();
        {
            LAS float* sXO = (LAS float*)(L + RC_XOFF); LAS float* sT = (LAS float*)(L + RC_XTMP) + wave * 272;
            const int rr = lane >> 2, c4 = (lane & 3) * 4;
#pragma unroll 1
            for (int lev = 1; lev <= 3; ++lev) {
                if (wave < 4 - lev) {
                    const int J = wave, I = wave + lev;
                    f32x4 tacc = (f32x4){0.f, 0.f, 0.f, 0.f};
                    for (int K = J; K < I; ++K) {
                        const LAS float* Ap = sAAB + (16 * I + rr) * 68 + 16 * K; const LAS float* Xp;
                        int xs;
                        if (K == J) { Xp = sAAB + (16 * J) * 68 + 16 * J + c4; xs = 68; }
                        else { const int d = K - J; const int bi = (d == 1) ? J : 3 + J; Xp = sXO + bi * 256 + c4; xs = 16; }
#pragma unroll
                        for (int k = 0; k < 16; ++k) { const float av = Ap[k]; const f32x4 xv = *(const LAS f32x4*)(Xp + k * xs); tacc += xv * av; }
                    }
                    *(LAS f32x4*)(sT + rr * 16 + c4) = tacc;
                    asm volatile("s_waitcnt lgkmcnt(0)" ::: "memory");
                    f32x4 xacc = (f32x4){0.f, 0.f, 0.f, 0.f};
                    const LAS float* Dp = sAAB + (16 * I + rr) * 68 + 16 * I;
#pragma unroll
                    for (int k = 0; k < 16; ++k) { const float dv = Dp[k]; const f32x4 tv = *(const LAS f32x4*)(sT + k * 16 + c4); xacc += tv * dv; }
                    const int bo = (lev == 1) ? J : (lev == 2 ? 3 + J : 5);
                    *(LAS f32x4*)(sXO + bo * 256 + rr * 16 + c4) = xacc;
                }
                __syncthreads();
            }
            for (int e = c.tid; e < 4096; e += 512) { const int tt = e >> 6, ss = e & 63, I = tt >> 4, J = ss >> 4; float v = 0.f;
                if (I == J) v = sAAB[tt * 68 + ss];
                else if (I > J) { const int d = I - J; const int bi = (d == 1) ? J : (d == 2 ? 3 + J : 5); v = sXO[bi * 256 + (tt & 15) * 16 + (ss & 15)]; }
                lds_st_bf16(L + RC_TINV, tt * 72 + ss, v); }
        }
        __syncthreads();
        for (int job = wave; job < 32; job += 8) { const int p = job >> 4, ta = (job >> 2) & 3, tb = job & 3;
            const f32x4 acc = tile_mma64(L + (p ? RC_XT : RC_ATT), L + RC_TINV, ta, tb, lane, (f32x4){0.f, 0.f, 0.f, 0.f});
#pragma unroll
            for (int r = 0; r < 4; ++r) lds_st_bf16(L + (p ? RC_P2T : RC_P1T), (16 * ta + 4 * q + r) * 72 + 16 * tb + n, acc[r]); }
        __syncthreads();
        bf16_t* ug = rwu + (size_t)unit * 16384;
        for (int job = wave; job < 64; job += 8) { const int p = job >> 4, ta = (job >> 2) & 3, tb = job & 3;
            f32x4 acc = (f32x4){0.f, 0.f, 0.f, 0.f};
            if (p == 0) { acc = tile_mma64(L + RC_ARB, L + RC_P1T, ta, tb, lane, acc);
#pragma unroll
                for (int r = 0; r < 4; ++r) { const int tt = 16 * ta + 4 * q + r, jj = 16 * tb + n; const float v = acc[r] + bf2f(*(const LAS bf16_t*)(L + RC_RT + (tt * 72 + jj) * 2));
                    ug[8192 + tt * 64 + (jj & 32) + kperm32(jj & 31)] = (bf16_t)f2bf(v); } }
            else if (p == 1) { acc = tile_mma64(L + RC_ARB, L + RC_P2T, ta, tb, lane, acc); acc = tile_mma64(L + RC_ARK, L + RC_VT, ta, tb, lane, acc);
                u32x2 w; w.x = pk2(acc[0], acc[1]); w.y = pk2(acc[2], acc[3]); *(u32x2*)(ug + 12288 + ((tb * 4 + ta) * 64 + lane) * 4) = w; }
            else if (p == 2) { acc = tile_mma64(L + RC_BHT, L + RC_P1T, ta, tb, lane, acc);
#pragma unroll
                for (int r = 0; r < 4; ++r) { const int jr = 16 * ta + 4 * q + r, jc = 16 * tb + n; const float v = acc[r] + (jr == jc ? sWC[jr] : 0.f);
                    ug[jr * 64 + (jc & 32) + kperm32(jc & 31)] = (bf16_t)f2bf(v); } }
            else { acc = tile_mma64(L + RC_BHT, L + RC_P2T, ta, tb, lane, acc); acc = tile_mma64(L + RC_KHT, L + RC_VT, ta, tb, lane, acc);
                u32x2 w; w.x = pk2(acc[0], acc[1]); w.y = pk2(acc[2], acc[3]); *(u32x2*)(ug + 4096 + ((tb * 4 + ta) * 64 + lane) * 4) = w; }
        }
        __syncthreads();
    }
}

#define RW_LOAD_SET(SET, UNIT) do { const bf16_t* ug_ = rwu + (size_t)(UNIT) * 16384; \
    _Pragma("unroll") for (int ta = 0; ta < 4; ++ta) { An[SET][ta][0] = *(const bf16x8*)(ug_ + (16 * ta + m) * 64 + 8 * q); An[SET][ta][1] = *(const bf16x8*)(ug_ + (16 * ta + m) * 64 + 32 + 8 * q); \
        Zn[SET][ta] = *(const u32x2*)(ug_ + 4096 + ((cq * 4 + ta) * 64 + lane) * 4); } } while (0)
template <int SM>
__device__ __forceinline__ void phase_rwkv_scan(const Ctx& c, const bf16_t* rwu, bf16_t* rws) {
    const int idx = c.bid; if (idx >= 32 || c.wave != 0) return;
    const int h = idx >> 2, cq = idx & 3, lane = c.lane, m = lane & 15, q = lane >> 4;
    bf16x8 Bhi[2], Blo[2];
#pragma unroll
    for (int s = 0; s < 2; ++s) { Bhi[s] = (bf16x8){0, 0, 0, 0, 0, 0, 0, 0}; Blo[s] = Bhi[s]; }
    bf16x8 An[4][4][2]; u32x2 Zn[4][4];
#pragma unroll
    for (int u = 0; u < 4; ++u) RW_LOAD_SET(u, u * 8 + h);
    if (SM == 1) {
        for (int ch = 0; ch < T / 64; ch += 8) {
#pragma unroll
            for (int uu = 0; uu < 8; ++uu) { const int u = uu & 3; const int unit = (ch + uu) * 8 + h;
                bf16_t* sg = rws + (size_t)unit * 4096 + cq * 1024 + lane * 8;
                *(bf16x8*)(sg) = Bhi[0]; *(bf16x8*)(sg + 512) = Bhi[1];
#pragma unroll
                for (int ta = 0; ta < 4; ++ta) { Bhi[0] = Bhi[0] ^ An[u][ta][0]; Bhi[1] = Bhi[1] ^ An[u][ta][1]; Bhi[0][0] ^= (short)Zn[u][ta].x; }
                RW_LOAD_SET(u, (ch + uu + 4 < T / 64) ? unit + 32 : unit); } }
        return;
    }
    for (int ch = 0; ch < T / 64; ch += 8) {
#pragma unroll
        for (int uu = 0; uu < 8; ++uu) {
            const int u = uu & 3;
            const int unit = (ch + uu) * 8 + h;
            bf16_t* sg = rws + (size_t)unit * 4096 + cq * 1024 + lane * 8;
            *(bf16x8*)(sg) = Bhi[0]; *(bf16x8*)(sg + 512) = Bhi[1];
            f32x4 acc[4];
#pragma unroll
            for (int ta = 0; ta < 4; ++ta) { const u32x2 z = Zn[u][ta];
                acc[ta] = (f32x4){__uint_as_float(z.x << 16), __uint_as_float(z.x & 0xffff0000u), __uint_as_float(z.y << 16), __uint_as_float(z.y & 0xffff0000u)};
#pragma unroll
                for (int s = 0; s < 2; ++s) { acc[ta] = __builtin_amdgcn_mfma_f32_16x16x32_bf16(An[u][ta][s], Bhi[s], acc[ta], 0, 0, 0); acc[ta] = __builtin_amdgcn_mfma_f32_16x16x32_bf16(An[u][ta][s], Blo[s], acc[ta], 0, 0, 0); } }
            if (SM == 0) RW_LOAD_SET(u, (ch + uu + 4 < T / 64) ? unit + 32 : unit);
#pragma unroll
            for (int s = 0; s < 2; ++s) { u32x4 hi, lo; float rem[8];
#pragma unroll
                for (int p = 0; p < 8; ++p) { const float v = acc[2 * s + (p >> 2)][p & 3]; const unsigned hb = f2bf(v); rem[p] = v - __uint_as_float(hb << 16); }
                hi.x = pk2(acc[2 * s][0], acc[2 * s][1]); hi.y = pk2(acc[2 * s][2], acc[2 * s][3]); hi.z = pk2(acc[2 * s + 1][0], acc[2 * s + 1][1]); hi.w = pk2(acc[2 * s + 1][2], acc[2 * s + 1][3]);
                lo.x = pk2(rem[0], rem[1]); lo.y = pk2(rem[2], rem[3]); lo.z = pk2(rem[4], rem[5]); lo.w = pk2(rem[6], rem[7]);
                Bhi[s] = __builtin_bit_cast(bf16x8, hi); Blo[s] = __builtin_bit_cast(bf16x8, lo); }
        }
    }
}
#undef RW_LOAD_SET

__device__ __forceinline__ void phase_rwkv_out(const Ctx& c, const Args& a, int layer, const bf16_t* proj, const bf16_t* rwu, const bf16_t* rws, const float* bonusg, bf16_t* orwkv) {
    const float* mu = inptr(c, I_MU) + (size_t)layer * 1792;
    const int lane = c.lane, m = lane & 15, q = lane >> 4;
    for (int unit = c.bid * 8 + c.wave; unit < 2048; unit += c.G * 8) {
        const int ch = unit >> 3, h = unit & 7, t0 = ch * 64; const bf16_t* ug = rwu + (size_t)unit * 16384; const bf16_t* sg = rws + (size_t)unit * 4096;
        bf16x8 Bf[4][2];
#pragma unroll
        for (int cq = 0; cq < 4; ++cq) { Bf[cq][0] = *(const bf16x8*)(sg + cq * 1024 + lane * 8); Bf[cq][1] = *(const bf16x8*)(sg + cq * 1024 + 512 + lane * 8); }
        float lnw[4], lnb[4];
#pragma unroll
        for (int cq = 0; cq < 4; ++cq) { lnw[cq] = inptr(c, I_LNW)[layer * 512 + h * 64 + 16 * cq + m]; lnb[cq] = inptr(c, I_LNB)[layer * 512 + h * 64 + 16 * cq + m]; }
#pragma unroll 1
        for (int ta = 0; ta < 4; ++ta) {
            const bf16x8 A0 = *(const bf16x8*)(ug + 8192 + (16 * ta + m) * 64 + 8 * q), A1 = *(const bf16x8*)(ug + 8192 + (16 * ta + m) * 64 + 32 + 8 * q);
            f32x4 y[4];
#pragma unroll
            for (int cq = 0; cq < 4; ++cq) { const u32x2 z = *(const u32x2*)(ug + 12288 + ((cq * 4 + ta) * 64 + lane) * 4);
                y[cq] = (f32x4){__uint_as_float(z.x << 16), __uint_as_float(z.x & 0xffff0000u), __uint_as_float(z.y << 16), __uint_as_float(z.y & 0xffff0000u)};
                y[cq] = __builtin_amdgcn_mfma_f32_16x16x32_bf16(A0, Bf[cq][0], y[cq], 0, 0, 0); y[cq] = __builtin_amdgcn_mfma_f32_16x16x32_bf16(A1, Bf[cq][1], y[cq], 0, 0, 0); }
#pragma unroll
            for (int r = 0; r < 4; ++r) { const int t = t0 + 16 * ta + 4 * q + r;
                float sm = y[0][r] + y[1][r] + y[2][r] + y[3][r];
                sm += __shfl_xor(sm, 1); sm += __shfl_xor(sm, 2); sm += __shfl_xor(sm, 4); sm += __shfl_xor(sm, 8);
                const float mean = sm * (1.0f / 64.0f); float d[4], vs = 0.f;
#pragma unroll
                for (int cq = 0; cq < 4; ++cq) { d[cq] = y[cq][r] - mean; vs += d[cq] * d[cq]; }
                vs += __shfl_xor(vs, 1); vs += __shfl_xor(vs, 2); vs += __shfl_xor(vs, 4); vs += __shfl_xor(vs, 8);
                const float rstd = rsqrtf(vs * (1.0f / 64.0f) + 64e-5f); const float bon = bonusg[(size_t)t * 8 + h];
#pragma unroll
                for (int cq = 0; cq < 4; ++cq) { const int col = h * 64 + 16 * cq + m; const float v = rwkv_mixed(proj, mu, t, PC_V + col);
                    bf16_t* op = orwkv + (size_t)t * 512 + col; const float g = bf2f(*op);
                    *op = (bf16_t)f2bf((d[cq] * rstd * lnw[cq] + lnb[cq] + bon * v) * g); } }
        }
    }
}


constexpr int AT_K = 0, AT_V = 9216, AT_BIAS = 73728, AT_SELM = 90112, AT_LIST = 94208, AT_NLIST = 95232, AT_NEED = 95264;
__device__ __forceinline__ void vt_transpose(const Ctx& c, const bf16_t* proj, bf16_t* vt) {
    LAS bf16_t* tl = (LAS bf16_t*)c.lds;
    for (int it = c.bid; it < 3 * 2 * 256; it += c.G) {
        const int which = it / 512, g = (it >> 8) & 1, tt = it & 255;
        const int col = (which == 0 ? PC_VS : (which == 1 ? PC_VW : PC_SV)) + g * 64;
        { const int tok = c.tid >> 3, ch = c.tid & 7; const u32x4 w = *(const u32x4*)(proj + (size_t)(tt * 64 + tok) * PLD + col + ch * 8);
          *(LAS u32x4*)(tl + tok * 72 + ch * 8) = w; }
        __syncthreads();
        { const int d = c.tid >> 3, ch = c.tid & 7; unsigned short e[8];
#pragma unroll
          for (int k = 0; k < 8; ++k) e[k] = tl[(ch * 8 + k) * 72 + d];
          u32x4 w; w.x = e[0] | ((unsigned)e[1] << 16); w.y = e[2] | ((unsigned)e[3] << 16); w.z = e[4] | ((unsigned)e[5] << 16); w.w = e[6] | ((unsigned)e[7] << 16);
          *(u32x4*)(vt + ((size_t)(which * 2 + g) * 64 + d) * T + tt * 64 + ch * 8) = w; }
        __syncthreads();
    }
}

template <int MODE, int NQ>
__device__ __forceinline__ void phase_attn(const Ctx& c, const Args& a, int layer, const bf16_t* proj, const bf16_t* vtb, const bf16_t* kcb, const bf16_t* vctb,
                                           const int* sel, float* nsaacc, float* scores, bf16_t* oout) {
    LAS unsigned char* L = c.lds;
    LAS float* biasd = (LAS float*)(L + AT_BIAS);
    LAS unsigned* selm = (LAS unsigned*)(L + AT_SELM);
    LAS int* list = (LAS int*)(L + AT_LIST);
    LAS int* nlist = (LAS int*)(L + AT_NLIST);
    LAS unsigned* need = (LAS unsigned*)(L + AT_NEED);
    const int lane = c.lane, wave = c.wave, n = lane & 15, q = lane >> 4, hr = n & 3;
    constexpr int TW = 4 * NQ, TB = 8 * TW, NU = T / TB, TS = (MODE == 3) ? 4 : 1;
    for (int unit = c.bid; unit < 2 * NU; unit += c.G) {
        const int g = unit / NU, t0 = (unit % NU) * TB, tw0 = t0 + wave * TW;
        __syncthreads();
        for (int e = c.tid; e < 4096; e += 512) { const int r = e >> 10, d = e & 1023; biasd[e] = inptr(c, I_REL)[t5_bucket(d) * 16 + (MODE == 0 ? 8 : 0) + g * 4 + r]; }
        if (MODE == 3) {
            for (int e = c.tid; e < 1024; e += 512) selm[e] = 0u;
            if (c.tid < 8) need[c.tid] = 0u;
            __syncthreads();
            if ((c.tid >> 2) < TB) { const int tok = c.tid >> 2, k4 = (c.tid & 3) * 4; const int* sp = sel + ((size_t)(t0 + tok) * 2 + g) * 16 + k4;
#pragma unroll
              for (int k = 0; k < 4; ++k) { const int j = sp[k]; atomicOr((unsigned*)&selm[tok * 8 + (j >> 5)], 1u << (j & 31)); atomicOr((unsigned*)&need[j >> 5], 1u << (j & 31)); } }
            __syncthreads();
            if (c.tid < 256) { const int j = c.tid; const unsigned wd = need[j >> 5];
                if ((wd >> (j & 31)) & 1u) { int pos = __popc(wd & ((1u << (j & 31)) - 1u)); for (int w2 = 0; w2 < (j >> 5); ++w2) pos += __popc(need[w2]); list[pos] = j; } }
            if (c.tid == 0) { int cnt = 0; for (int w2 = 0; w2 < 8; ++w2) cnt += __popc(need[w2]); nlist[0] = cnt; }
        }
        __syncthreads();
        int ntiles, tile_lo = 0;
        if (MODE == 0) { ntiles = 2 + TB / 64; tile_lo = t0 - 128; }
        else if (MODE == 1) { ntiles = 8 + TB / 64; tile_lo = t0 - 512; }
        else if (MODE == 2) { const int cmax = (t0 + TB - 1 - 31) >> 4; ntiles = cmax < 0 ? 0 : (cmax >> 6) + 1; }
        else ntiles = nlist[0];
        const bf16_t* Ksrc; size_t kstride; const bf16_t* Vsrc; size_t vstride; int qcol;
        if (MODE == 0) { Ksrc = proj + PC_SK + g * 64; kstride = PLD; Vsrc = vtb + (size_t)(4 + g) * 64 * T; vstride = T; qcol = PC_SQ + g * 256; }
        else if (MODE == 1) { Ksrc = proj + PC_KW + g * 64; kstride = PLD; Vsrc = vtb + (size_t)(2 + g) * 64 * T; vstride = T; qcol = PC_NQ + g * 256; }
        else if (MODE == 2) { Ksrc = kcb + (size_t)g * 1024 * 64; kstride = 64; Vsrc = vctb + (size_t)g * 64 * 1024; vstride = 1024; qcol = PC_NQ + g * 256; }
        else { Ksrc = proj + PC_KS + g * 64; kstride = PLD; Vsrc = vtb + (size_t)(0 + g) * 64 * T; vstride = T; qcol = PC_NQ + g * 256; }
        bf16x8 Bq[NQ][2];
#pragma unroll
        for (int qd = 0; qd < NQ; ++qd) { const bf16_t* qp = proj + (size_t)(tw0 + 4 * qd + (n >> 2)) * PLD + qcol + hr * 64 + 8 * q;
            Bq[qd][0] = *(const bf16x8*)qp; Bq[qd][1] = *(const bf16x8*)(qp + 32); }
        const float bfar = biasd[hr * 1024 + 1023];
        float mrun[NQ], lrun[NQ]; f32x4 O[NQ][4];
#pragma unroll
        for (int qd = 0; qd < NQ; ++qd) { mrun[qd] = -1e30f; lrun[qd] = 0.f;
#pragma unroll
            for (int dt = 0; dt < 4; ++dt) O[qd][dt] = (f32x4){0.f, 0.f, 0.f, 0.f}; }
        float carry3[NQ]; for (int i = 0; i < NQ; ++i) carry3[i] = 0.f;
        const int npass = (MODE == 2) ? 2 : 1;
        for (int pass = 0; pass < npass; ++pass) {
            const bool do_pv = (MODE != 2) || pass == 1;
            float linv[NQ];
            if (MODE == 2 && pass == 1) {
#pragma unroll
                for (int qd = 0; qd < NQ; ++qd) { float lt = lrun[qd]; lt += __shfl_xor(lt, 16); lt += __shfl_xor(lt, 32); linv[qd] = lt > 0.f ? 1.0f / lt : 0.f; }
            }
#define AT_TILEPOS(ti) ((MODE == 3) ? list[ti] * 64 : (MODE == 2 ? (ti) * 64 : tile_lo + (ti) * 64))
#define AT_ISSUE(rd) do { _Pragma("unroll") for (int i_ = 0; i_ < TS; ++i_) { const int ti_ = (rd) * TS + i_; p0n[i_] = ti_ < ntiles ? AT_TILEPOS(ti_) : -1; \
        if (p0n[i_] >= 0) { kreg[i_] = *(const u32x4*)(Ksrc + (size_t)(p0n[i_] + (c.tid >> 3)) * kstride + (c.tid & 7) * 8); \
            if (do_pv) vreg[i_] = *(const u32x4*)(Vsrc + (size_t)(c.tid >> 3) * vstride + p0n[i_] + (c.tid & 7) * 8); } } } while (0)
            u32x4 kreg[TS], vreg[TS]; int p0n[TS];
            const int nrounds = (ntiles + TS - 1) / TS;
            if (nrounds > 0) AT_ISSUE(0);
            for (int rd = 0; rd < nrounds; ++rd) {
                int p0s[TS];
#pragma unroll
                for (int i = 0; i < TS; ++i) p0s[i] = p0n[i];
                __syncthreads();
#pragma unroll
                for (int i = 0; i < TS; ++i) if (p0s[i] >= 0) { *(LAS u32x4*)(L + AT_K + i * 18432 + (c.tid >> 3) * 144 + (c.tid & 7) * 16) = kreg[i];
                    if (do_pv) *(LAS u32x4*)(L + AT_V + i * 18432 + (c.tid >> 3) * 144 + (c.tid & 7) * 16) = vreg[i]; }
                if (rd + 1 < nrounds) AT_ISSUE(rd + 1);
                __syncthreads();
#pragma unroll
              for (int ts = 0; ts < TS; ++ts) {
                const int p0 = p0s[ts]; const int LK = AT_K + ts * 18432, LV = AT_V + ts * 18432;
                if (p0 < 0) continue;
                if (MODE == 0) { if (p0 > tw0 + TW - 1 || p0 + 63 < tw0 - 127) continue; }
                if (MODE == 1) { if (p0 > tw0 + TW - 1 || p0 + 63 < tw0 - 511) continue; }
                if (MODE == 2) { if (16 * p0 + 31 > tw0 + TW - 1) continue; }
                if (MODE == 3) { if (p0 > tw0 + TW - 1) continue; }
                const bool far = (MODE == 2) ? (tw0 - (16 * (p0 + 63) + 31) >= 790) : ((MODE == 3) ? (tw0 - (p0 + 63) >= 790) : false);
                const int jblk = p0 >> 6;
#pragma unroll
                for (int qd = 0; qd < NQ; ++qd) {
                    const int tq = tw0 + 4 * qd + (n >> 2);
                    bool colsel = true;
                    if (MODE == 3) { colsel = (selm[(wave * TW + 4 * qd + (n >> 2)) * 8 + (jblk >> 5)] >> (jblk & 31)) & 1u; if (__ballot(colsel) == 0ull) continue; }
#pragma unroll
                    for (int st = 0; st < 2; ++st) {
                        f32x4 sc[2];
#pragma unroll
                        for (int kt = 0; kt < 2; ++kt) { sc[kt] = (f32x4){0.f, 0.f, 0.f, 0.f};
#pragma unroll
                            for (int ks = 0; ks < 2; ++ks) { const bf16x8 ak = *(const LAS bf16x8*)(L + LK + (32 * st + 16 * kt + n) * 144 + (32 * ks + 8 * q) * 2);
                                sc[kt] = __builtin_amdgcn_mfma_f32_16x16x32_bf16(ak, Bq[qd][ks], sc[kt], 0, 0, 0); } }
                        float mx = -1e30f;
                        if (far) {
#pragma unroll
                            for (int kt = 0; kt < 2; ++kt)
#pragma unroll
                                for (int r = 0; r < 4; ++r) { const float s2 = (MODE == 3 && !colsel) ? -1e30f : sc[kt][r] + bfar; sc[kt][r] = s2; mx = fmaxf(mx, s2); }
                        } else {
#pragma unroll
                        for (int kt = 0; kt < 2; ++kt)
#pragma unroll
                            for (int r = 0; r < 4; ++r) { const int kl = 32 * st + 16 * kt + 4 * q + r; int dist; bool v;
                                if (MODE == 2) { dist = tq - (16 * (p0 + kl) + 31); v = dist >= 0; }
                                else { dist = tq - (p0 + kl); v = dist >= 0; if (MODE == 0) v = v && dist < 128; if (MODE == 1) v = v && dist < 512; if (MODE == 3) v = v && colsel; }
                                const int di = dist < 0 ? 0 : (dist > 1023 ? 1023 : dist);
                                const float s2 = v ? sc[kt][r] + biasd[hr * 1024 + di] : -1e30f; sc[kt][r] = s2; mx = fmaxf(mx, s2); }
                        }
                        float p[2][4];
                        if (MODE == 2 && pass == 1) {
#pragma unroll
                            for (int kt = 0; kt < 2; ++kt)
#pragma unroll
                                for (int r = 0; r < 4; ++r) p[kt][r] = __expf(sc[kt][r] - mrun[qd]) * linv[qd];
                        } else {
                            mx = fmaxf(mx, __shfl_xor(mx, 16)); mx = fmaxf(mx, __shfl_xor(mx, 32));
                            const float mn = fmaxf(mrun[qd], mx), corr = __expf(mrun[qd] - mn); mrun[qd] = mn; float ps = 0.f;
                            const float mne = mn < -1e29f ? 0.f : mn;
#pragma unroll
                            for (int kt = 0; kt < 2; ++kt)
#pragma unroll
                                for (int r = 0; r < 4; ++r) { p[kt][r] = __expf(sc[kt][r] - mne); ps += p[kt][r]; }
                            lrun[qd] = lrun[qd] * corr + ps;
                            if (do_pv) {
#pragma unroll
                                for (int dt = 0; dt < 4; ++dt) O[qd][dt] = O[qd][dt] * corr; }
                        }
                        if (MODE == 2 && pass == 1) {
                            float i3prev = carry3[qd];
#pragma unroll
                            for (int kt = 0; kt < 2; ++kt) { float im[4];
#pragma unroll
                                for (int r = 0; r < 4; ++r) { float v = p[kt][r]; v += __shfl_xor(v, 1); v += __shfl_xor(v, 2); im[r] = v; }
                                const float same = __shfl(im[3], (lane + 48) & 63), prevt = __shfl(i3prev, (lane + 48) & 63);
                                const float pv3 = q > 0 ? same : prevt;
                                const int jg = (p0 + 32 * st + 16 * kt + 4 * q) >> 2;
                                if (hr == 0 && jg < 256) scores[((size_t)g * T + tq) * 256 + jg] = 2.0f * (im[0] + im[1] + im[2]) + im[3] + pv3;
                                i3prev = im[3]; }
                            carry3[qd] = i3prev;
                        }
                        if (do_pv) {
                            u32x4 pw; pw.x = pk2(p[0][0], p[0][1]); pw.y = pk2(p[0][2], p[0][3]); pw.z = pk2(p[1][0], p[1][1]); pw.w = pk2(p[1][2], p[1][3]);
                            const bf16x8 pf = __builtin_bit_cast(bf16x8, pw);
#pragma unroll
                            for (int dt = 0; dt < 4; ++dt) { const LAS unsigned char* vp = L + LV + (16 * dt + n) * 144 + (32 * st + 4 * q) * 2;
                                const u32x2 v0 = *(const LAS u32x2*)vp, v1 = *(const LAS u32x2*)(vp + 32); u32x4 vw; vw.x = v0.x; vw.y = v0.y; vw.z = v1.x; vw.w = v1.y;
                                O[qd][dt] = __builtin_amdgcn_mfma_f32_16x16x32_bf16(__builtin_bit_cast(bf16x8, vw), pf, O[qd][dt], 0, 0, 0); }
                        }
                        __builtin_amdgcn_sched_barrier(0);
                    }
                }
              }
            }
        }
#undef AT_ISSUE
#undef AT_TILEPOS
#pragma unroll
        for (int qd = 0; qd < NQ; ++qd) {
            const int tq = tw0 + 4 * qd + (n >> 2), hh = g * 4 + hr;
            float scale;
            if (MODE == 2) scale = 1.0f;
            else { float lt = lrun[qd]; lt += __shfl_xor(lt, 16); lt += __shfl_xor(lt, 32);
                if (MODE == 0) { const float sink = inptr(c, I_SINK)[layer * 8 + hh]; const float mf = fmaxf(mrun[qd], sink), cr = __expf(mrun[qd] - mf); scale = cr / (lt * cr + __expf(sink - mf)); }
                else scale = lt > 0.f ? 1.0f / lt : 0.f; }
            if (MODE != 0) scale *= sigmoidf_(bf2f(proj[(size_t)tq * PLD + PC_GL + (MODE == 2 ? 0 : (MODE == 3 ? 8 : 16)) + hh]));
#pragma unroll
            for (int dt = 0; dt < 4; ++dt) { const f32x4 o = O[qd][dt] * scale; const int col = hh * 64 + 16 * dt + 4 * q;
                if (MODE == 0) { u32x2 w; w.x = pk2(o[0], o[1]); w.y = pk2(o[2], o[3]); *(u32x2*)(oout + (size_t)tq * 512 + col) = w; }
                else if (MODE == 2) *(f32x4*)(nsaacc + (size_t)tq * 512 + col) = o;
                else if (MODE == 1) { f32x4* ap = (f32x4*)(nsaacc + (size_t)tq * 512 + col); *ap = *ap + o; }
                else { const f32x4 t2 = *(const f32x4*)(nsaacc + (size_t)tq * 512 + col) + o; u32x2 w; w.x = pk2(t2[0], t2[1]); w.y = pk2(t2[2], t2[3]); *(u32x2*)(oout + (size_t)tq * 512 + col) = w; } }
        }
    }
}
__device__ __forceinline__ void phase_topk2(const Ctx& c, const float* scores, int* sel) {
    const int gw = c.bid * 8 + c.wave, NGW = c.G * 8;
    for (int item = gw; item < T * 2; item += NGW) {
        const int t = item >> 1, g = item & 1, cur = t >> 6;
        const float* sp = scores + ((size_t)g * T + t) * 256;
        float val[4];
#pragma unroll
        for (int jj = 0; jj < 4; ++jj) { const int j = c.lane + 64 * jj; float sc;
            if (j == 0 || j == cur || j == cur - 1) sc = 1e4f; else if (j > cur) sc = -1.0f; else sc = sp[j];
            val[jj] = sc; }
        for (int k = 0; k < 16; ++k) {
            float bv = val[0]; int bi = c.lane;
#pragma unroll
            for (int jj = 1; jj < 4; ++jj) if (val[jj] > bv) { bv = val[jj]; bi = c.lane + 64 * jj; }
#pragma unroll
            for (int o = 32; o >= 1; o >>= 1) { const float ov = __shfl_xor(bv, o); const int oi = __shfl_xor(bi, o); if (ov > bv || (ov == bv && oi < bi)) { bv = ov; bi = oi; } }
#pragma unroll
            for (int jj = 0; jj < 4; ++jj) if (bi == c.lane + 64 * jj) val[jj] = -3e38f;
            if (c.lane == 0) sel[(size_t)item * 16 + k] = bi;
        }
    }
}

#define wb ((bf16_t*)(ws + WS_WB))
#define xb ((bf16_t*)(ws + WS_XB))
#define rs ((float*)(ws + WS_RS))
#define kcb ((bf16_t*)(ws + WS_KCB))
#define vctb ((bf16_t*)(ws + WS_VCT))
#define vtb ((bf16_t*)(ws + WS_VT))
#define scores ((float*)(ws + WS_SCORES))
#define sel ((int*)(ws + WS_SEL))
#define ml ((float*)(ws + WS_ML))
#define hidb ((bf16_t*)(ws + WS_HID))
#define proj ((bf16_t*)(ws + WS_PROJ))
#define gates ((bf16_t*)(ws + WS_GATES))
#define merged ((bf16_t*)(ws + WS_MERGED))
#define tmpb ((bf16_t*)(ws + WS_TMPB))
#define alora ((bf16_t*)(ws + WS_ALORA))
#define rwu ((bf16_t*)(ws + WS_RWU))
#define rws ((bf16_t*)(ws + WS_RWS))
#define bonusg ((float*)(ws + WS_BONUS))
#define nsaacc ((float*)(ws + WS_NSAACC))
#define obuf ((bf16_t*)(ws + WS_O))
#define act ((bf16_t*)(ws + WS_ACT))
#define tmpf ((bf16_t*)(ws + WS_TMPF))
constexpr int PH_PER_BATCH = 16, PH_PER_LAYER = 1 + 2 * PH_PER_BATCH + 3, PH_TOTAL = 1 + DEPTH * PH_PER_LAYER;

__global__ void __launch_bounds__(512, 2) fwd_kernel(Args args) {
    extern __shared__ __attribute__((aligned(16))) unsigned char lds_raw[];
    Ctx c0; c0.lds = (LAS unsigned char*)lds_raw; c0.tid = threadIdx.x; c0.lane = c0.tid & 63; c0.wave = __builtin_amdgcn_readfirstlane(c0.tid >> 6); c0.G = gridDim.x; c0.bid = blockIdx.x; const Ctx& c = c0;
    unsigned char* ws = args.ws;
    volatile LAS unsigned* misc = (volatile LAS unsigned*)(c.lds + LDS_MISC);
    if (c.tid < 4) misc[c.tid] = 0u;
    if (c.tid < 30) { const unsigned long long pv = (unsigned long long)args.in[c.tid & 31]; misc[16 + 2 * c.tid] = (unsigned)pv; misc[17 + 2 * c.tid] = (unsigned)(pv >> 32); }
    __syncthreads();
    XcdBarrier bar; bar.bar = (unsigned*)(ws + WS_CTL); bar.x = 0; bar.st = misc;
    const int lo = args.lo, hi = args.hi;
    const bool multi = (hi - lo) > 1;
    if (multi) bar = xcd_barrier_post((unsigned*)(ws + WS_CTL), misc);
    int gp = 0;
#ifndef ONLY_PH
#define ONLY_PH -1
#endif
#ifndef PHMASK
#define PHMASK 0xffffff
#endif
#ifndef REPMASK
#define REPMASK 0
#endif
#define PHASE_BEGIN(id) if (gp >= lo && gp < hi) { for (int rep_ = 0; rep_ < (((REPMASK >> (id)) & 1) ? 2 : 1); ++rep_) { if (rep_) __syncthreads(); \
    Ctx pc = c0; asm volatile("" : "+v"(pc.tid), "+s"(pc.bid)); pc.lane = pc.tid & 63; pc.wave = __builtin_amdgcn_readfirstlane(pc.tid >> 6); const Ctx& c = pc;
#define PHASE_END   } if (gp + 1 < hi) xcd_barrier(bar); } ++gp;

    float* x = args.out;
    PHASE_BEGIN(0) phase_init(c, inptr(c, I_X), x, xb, rs); PHASE_END

    for (int layer = 0; layer < DEPTH; ++layer) {
        PHASE_BEGIN(1) phase_cvt(c, args, layer, wb); PHASE_END
        for (int b = 0; b < NBATCH; ++b) {
            const int row0 = b * T;
            PHASE_BEGIN(2) {
                pg8::Gemm g{xb + (size_t)row0 * D, wb + WB_WIN, D, D, D}; pg8::Sched S; S.init(T / 256, NIN / 256, c.G, c.bid, 1, (size_t)256 * D * 2, 0, (size_t)256 * D * 2, 0);
                pg8::EpiInProj E{proj, gates, rs + row0}; pg8::gemm_phase(c.lds, c.tid, g, S, E); } PHASE_END
            PHASE_BEGIN(16) { phase_lora_a(c, args, layer, proj, alora); vt_transpose(c, proj, vtb); } PHASE_END
            PHASE_BEGIN(17) {
                pg8::Gemm g{alora, wb + WB_LORA, 256, 256, 256}; pg8::Sched S; S.init(T / 256, 6, c.G, c.bid, 1, (unsigned)256 * 256 * 2, 0, (unsigned)256 * 256 * 2, 0);
                pg8::EpiLora E{obuf}; pg8::gemm_phase(c.lds, c.tid, g, S, E); } PHASE_END
            PHASE_BEGIN(18) phase_rwkv_chunk(c, args, layer, proj, obuf + (size_t)T * 512, obuf + (size_t)2 * T * 512, rwu, bonusg); PHASE_END
            PHASE_BEGIN(19) phase_rwkv_scan<0>(c, rwu, rws);
#ifdef SCANPROBE
              __syncthreads(); phase_rwkv_scan<SCANPROBE>(c, rwu, (bf16_t*)nsaacc);
#endif
              PHASE_END
            PHASE_BEGIN(9) phase_rwkv_out(c, args, layer, proj, rwu, rws, bonusg, obuf); PHASE_END
            PHASE_BEGIN(3) {
                pg8::Gemm g{proj, wb + WB_W1T, 16 * PLD, 2048, 2048, (unsigned)PLD * 2}; pg8::Sched S; S.init(16, 1, c.G, c.bid, 1, 0, 0, 0, 0); S.mode = 1;
                pg8::EpiCmp1 E{hidb, (const float*)(wb + WB_BH)}; pg8::gemm_phase(c.lds, c.tid, g, S, E); } PHASE_END
            PHASE_BEGIN(4) {
                pg8::Gemm g{hidb, wb + WB_W2T, 256, 256, 256}; pg8::Sched S; S.init(16, 1, c.G, c.bid, 1, (unsigned)256 * 256 * 2, 0, 0, 0); S.mode = 2;
                pg8::EpiCmp2 E{kcb, vctb}; pg8::gemm_phase(c.lds, c.tid, g, S, E); } PHASE_END
            PHASE_BEGIN(5) phase_attn<2, 2>(c, args, layer, proj, vtb, kcb, vctb, sel, nsaacc, scores, obuf + (size_t)T * 512); PHASE_END
            PHASE_BEGIN(6) phase_topk2(c, scores, sel); PHASE_END
            PHASE_BEGIN(7) phase_attn<1, 2>(c, args, layer, proj, vtb, kcb, vctb, sel, nsaacc, scores, obuf + (size_t)T * 512); PHASE_END
            PHASE_BEGIN(8) phase_attn<3, 2>(c, args, layer, proj, vtb, kcb, vctb, sel, nsaacc, scores, obuf + (size_t)T * 512); PHASE_END
            PHASE_BEGIN(20) phase_attn<0, 2>(c, args, layer, proj, vtb, kcb, vctb, sel, nsaacc, scores, obuf + (size_t)2 * T * 512); PHASE_END
            PHASE_BEGIN(10) {
                pg8::Gemm g{obuf, wb + WB_WBR, 512, 512, 512}; pg8::Sched S; S.init(T / 256, D / 256, c.G, c.bid, 3, (size_t)256 * 512 * 2, (size_t)T * 512 * 2, (size_t)256 * 512 * 2, (size_t)D * 512 * 2);
                pg8::EpiMerge E{gates, merged}; pg8::gemm_phase(c.lds, c.tid, g, S, E); } PHASE_END
            PHASE_BEGIN(11) {
                pg8::Gemm g{merged, wb + WB_WOUT, D, D, D}; pg8::Sched S; S.init(T / 256, D / 256, c.G, c.bid, 1, (size_t)256 * D * 2, 0, (size_t)256 * D * 2, 0);
                pg8::EpiStore E{tmpb, D}; pg8::gemm_phase(c.lds, c.tid, g, S, E); } PHASE_END
            PHASE_BEGIN(12) phase_norm_res(c, tmpb, inptr(c, I_NQM) + layer * D, x, xb, rs, row0, T); PHASE_END
        }
        PHASE_BEGIN(13) {
            pg8::Gemm g{xb, wb + WB_WGU, D, D, D}; pg8::Sched S; S.init(MROWS / 256, 2 * FFN / 256, c.G, c.bid, 1, (size_t)256 * D * 2, 0, (size_t)256 * D * 2, 0);
            pg8::EpiSwiGLU E{act, rs}; pg8::gemm_phase(c.lds, c.tid, g, S, E); } PHASE_END
        PHASE_BEGIN(14) {
            pg8::Gemm g{act, wb + WB_WDN, FFN, FFN, FFN}; pg8::Sched S; S.init(MROWS / 256, D / 256, c.G, c.bid, 1, (size_t)256 * FFN * 2, 0, (size_t)256 * FFN * 2, 0);
            pg8::EpiStore E{tmpf, D}; pg8::gemm_phase(c.lds, c.tid, g, S, E); } PHASE_END
        PHASE_BEGIN(15) phase_norm_res(c, tmpf, inptr(c, I_NQF) + layer * D, x, xb, rs, 0, MROWS); PHASE_END
    }
#undef PHASE_BEGIN
#undef PHASE_END
}

extern "C" void kernel_launch(void* const* d_in, const int* in_sizes, int n_in, void* d_out, int out_size, void* d_ws, size_t ws_size, hipStream_t stream) {
    static int grid = 0;
    if (grid == 0) {
        if (n_in != 30 || out_size != MROWS * D || ws_size < WS_END) { fprintf(stderr, "kernel_launch: unexpected shapes (n_in %d out %d ws %zu)\n", n_in, out_size, ws_size); grid = -1; return; }
        int dev = 0, cus = 0;
        if (hipGetDevice(&dev) != hipSuccess || hipDeviceGetAttribute(&cus, hipDeviceAttributeMultiprocessorCount, dev) != hipSuccess) { grid = -1; return; }
        if (hipFuncSetAttribute((const void*)fwd_kernel, hipFuncAttributeMaxDynamicSharedMemorySize, LDS_BYTES) != hipSuccess) { fprintf(stderr, "hipFuncSetAttribute failed\n"); grid = -1; return; }
        int per_cu = 0;
        if (hipOccupancyMaxActiveBlocksPerMultiprocessor(&per_cu, (const void*)fwd_kernel, 512, LDS_BYTES) != hipSuccess || per_cu < 1) { fprintf(stderr, "occupancy query: %d\n", per_cu); }
        (void)hipGetLastError();
        grid = cus;
    }
    if (grid < 0) return;
    (void)hipMemsetAsync((char*)d_ws + WS_CTL, 0, CTL_BYTES, stream);
    Args a{};
    for (int i = 0; i < 30; ++i) a.in[i] = (const float*)d_in[i];
    a.out = (float*)d_out; a.ws = (unsigned char*)d_ws;
#if MK_ONE_LAUNCH
    a.lo = 0; a.hi = PH_TOTAL;
    hipLaunchKernelGGL(fwd_kernel, dim3(grid), dim3(512), LDS_BYTES, stream, a);
#else
    for (int p = 0; p < PH_TOTAL; ++p) { a.lo = p; a.hi = p + 1; hipLaunchKernelGGL(fwd_kernel, dim3(grid), dim3(512), LDS_BYTES, stream, a); }
#endif
}
```

```cpp
#include <hip/hip_runtime.h>
#include <stdint.h>
#include <stdio.h>

#ifndef MK_ONE_LAUNCH
#define MK_ONE_LAUNCH 1
#endif

#define LAS __attribute__((address_space(3)))
typedef unsigned short bf16_t;
typedef short bf16x8 __attribute__((ext_vector_type(8)));
typedef float f32x4 __attribute__((ext_vector_type(4)));
typedef float f32x2 __attribute__((ext_vector_type(2)));
typedef unsigned u32x4 __attribute__((ext_vector_type(4)));
typedef unsigned u32x2 __attribute__((ext_vector_type(2)));

constexpr int D = 1024, NBATCH = 2, T = 16384, DEPTH = 4, MROWS = NBATCH * T;
constexpr int IN_COLS = 6936, FFN = 2816;
constexpr int PLD = 4096;
constexpr int PC_R = 0, PC_K = 512, PC_V = 1024, PC_ZW = 1536, PC_ZA = 1600, PC_ZG = 1664;
constexpr int PC_NQ = 1792, PC_KC = 2304, PC_VC = 2432, PC_KS = 2560, PC_VS = 2688, PC_KW = 2816, PC_VW = 2944, PC_GL = 3072;
constexpr int PC_SQ = 3328, PC_SK = 3840, PC_SV = 3968;
constexpr int NIN = 7168;
constexpr int NCMP = 1023;
constexpr float NORM_EPS = 1e-6f;

constexpr size_t MiB = 1u << 20;
constexpr size_t WS_CTL = 0, CTL_BYTES = 65536;
constexpr size_t WS_WB = 65536;
constexpr size_t WB_WIN = 0, WB_WBR = WB_WIN + (size_t)NIN * D, WB_WOUT = WB_WBR + (size_t)3 * D * 512, WB_WGU = WB_WOUT + (size_t)D * D,
                 WB_WDN = WB_WGU + (size_t)2 * FFN * D, WB_LORA = WB_WDN + (size_t)D * FFN, WB_W1T = WB_LORA + (size_t)1536 * 256, WB_W2T = WB_W1T + (size_t)2 * 256 * 2048,
                 WB_BH = WB_W2T + (size_t)2 * 256 * 256, WB_END = WB_BH + 1024;
static_assert(WS_WB + WB_END * 2 <= 39 * MiB, "weights");
constexpr size_t WS_XB = 39 * MiB;
constexpr size_t WS_RS = 103 * MiB;
constexpr size_t WS_KCB = 103 * MiB + 262144;
constexpr size_t WS_VCT = WS_KCB + 262144;
constexpr size_t WS_SEL = 104 * MiB;
constexpr size_t WS_BONUS = 106 * MiB;
constexpr size_t WS_ML = 106 * MiB + 524288;
constexpr size_t WS_ALORA = 107 * MiB;
constexpr size_t WS_HID = 104 * MiB + 524288;
constexpr size_t WS_VT = 115 * MiB;
constexpr size_t WS_BIG = 127 * MiB;
constexpr size_t WS_PROJ = WS_BIG;
constexpr size_t WS_GATES = WS_PROJ + 128 * MiB;
constexpr size_t WS_RWKVS = WS_GATES + 96 * MiB;
constexpr size_t WS_RWU = WS_RWKVS;
constexpr size_t WS_RWS = WS_RWKVS + 64 * MiB;
constexpr size_t WS_SCORES = WS_RWKVS;
constexpr size_t WS_MERGED = WS_RWKVS;
constexpr size_t WS_TMPB = WS_RWKVS + 32 * MiB;
constexpr size_t WS_NSAACC = WS_RWKVS + 80 * MiB;
constexpr size_t WS_O = WS_NSAACC + 32 * MiB;
constexpr size_t WS_END = WS_O + 48 * MiB;
constexpr size_t WS_ACT = WS_BIG;
constexpr size_t WS_TMPF = WS_BIG + 176 * MiB;
static_assert(WS_END <= 512 * MiB, "workspace");
static_assert(WS_TMPF + 64 * MiB <= WS_NSAACC, "ffn overlay");

constexpr int LDS_BYTES = 147456;
constexpr int LDS_MISC = 131072 + 8192;

__device__ __forceinline__ float bf2f(unsigned v) { return __uint_as_float(v << 16); }
typedef __bf16 bf16n2 __attribute__((ext_vector_type(2)));
__device__ __forceinline__ unsigned pk2(float lo, float hi) { const f32x2 f = {lo, hi}; const bf16n2 v = __builtin_convertvector(f, bf16n2); return __builtin_bit_cast(unsigned, v); }
__device__ __forceinline__ unsigned f2bf(float f) { return pk2(f, 0.f) & 0xffffu; }
__device__ __forceinline__ void unpack8(const u32x4 w, float (&f)[8]) {
    f[0] = __uint_as_float(w.x << 16); f[1] = __uint_as_float(w.x & 0xffff0000u); f[2] = __uint_as_float(w.y << 16); f[3] = __uint_as_float(w.y & 0xffff0000u);
    f[4] = __uint_as_float(w.z << 16); f[5] = __uint_as_float(w.z & 0xffff0000u); f[6] = __uint_as_float(w.w << 16); f[7] = __uint_as_float(w.w & 0xffff0000u);
}
__device__ __forceinline__ float wave_sum(float v) {
#pragma unroll
    for (int o = 32; o >= 1; o >>= 1) v += __shfl_xor(v, o);
    return v;
}
__device__ __forceinline__ float sigmoidf_(float x) { return 1.0f / (1.0f + __expf(-x)); }
__device__ __forceinline__ int t5_bucket(int n) {
    if (n < 16) return n;
    int b = 16;
    b += (n >= 21); b += (n >= 27); b += (n >= 35); b += (n >= 46); b += (n >= 59); b += (n >= 77); b += (n >= 99); b += (n >= 128);
    b += (n >= 166); b += (n >= 216); b += (n >= 280); b += (n >= 363); b += (n >= 470); b += (n >= 609); b += (n >= 790);
    return b;
}

#define XB_TMO      128
#define XB_XCNT(j)  (256  + 64 * (j))
#define XB_XSUB(j)  (1280 + 64 * (j))
#define XB_XGEN(j)  (2304 + 64 * (j))
#define XB_TOP      3328
#define XB_TOPGEN   3392
#define XCD_BAR_WORDS 3456
#define XB_SPIN_CAP (1u << 22)
__device__ __forceinline__ unsigned xb_ld(unsigned* p)              { return __hip_atomic_load(p, __ATOMIC_RELAXED, __HIP_MEMORY_SCOPE_AGENT); }
__device__ __forceinline__ unsigned xb_add(unsigned* p, unsigned v) { return __hip_atomic_fetch_add(p, v, __ATOMIC_RELAXED, __HIP_MEMORY_SCOPE_AGENT); }
__device__ __forceinline__ unsigned xb_xcc_id() { return (unsigned)__builtin_amdgcn_s_getreg((3 << 11) | 20) & 0xFu; }
#define XB_SPIN(cond, bar) do { unsigned _sp = 0; while (cond) { __builtin_amdgcn_s_sleep(1); \
    if ((++_sp & 255u) == 0u) { if (xb_ld(&(bar)[XB_TMO])) break; if (_sp > XB_SPIN_CAP) { atomicAdd(&(bar)[XB_TMO], 1u); break; } } } } while (0)
struct XcdBarrier { unsigned* bar; unsigned x; volatile LAS unsigned* st; };
__device__ __forceinline__ XcdBarrier xcd_barrier_post(unsigned* bar, volatile LAS unsigned* st) {
    XcdBarrier b; b.bar = bar; b.x = xb_xcc_id(); b.st = st;
    if (threadIdx.x == 0) (void)xb_add(&bar[XB_XCNT(b.x)], 1u);
    return b;
}
__device__ __forceinline__ void xcd_barrier_complete(unsigned* bar, unsigned x, unsigned& nloc, unsigned& nx) {
    const unsigned G = gridDim.x * gridDim.y * gridDim.z;
    unsigned sum, cnt, mine, sp = 0u;
    for (;;) {
        sum = 0u; cnt = 0u; mine = 0u;
#pragma unroll
        for (unsigned j = 0; j < 16; ++j) { const unsigned c = xb_ld(&bar[XB_XCNT(j)]); sum += c; cnt += (c > 0u) ? 1u : 0u; mine = (j == x) ? c : mine; }
        if (sum == G) break;
        __builtin_amdgcn_s_sleep(1);
        if ((++sp & 255u) == 0u) { if (xb_ld(&bar[XB_TMO])) break; if (sp > XB_SPIN_CAP) { atomicAdd(&bar[XB_TMO], 1u); break; } }
    }
    nloc = mine > 0u ? mine : 1u; nx = cnt > 0u ? cnt : 1u;
}
__device__ __forceinline__ void xcd_barrier(const XcdBarrier& b) {
    asm volatile("s_waitcnt vmcnt(0)" ::: "memory");
    __syncthreads();
    if (threadIdx.x == 0) {
        unsigned* bar = b.bar;
        __builtin_amdgcn_s_waitcnt(0);
        unsigned nloc = b.st[0], nx = b.st[1];
        if (nloc == 0u) { xcd_barrier_complete(bar, b.x, nloc, nx); b.st[0] = nloc; b.st[1] = nx; }
        const unsigned old = xb_add(&bar[XB_XSUB(b.x)], 1u);
        const unsigned gen = old / nloc;
        if (old + 1u == (gen + 1u) * nloc) {
            __builtin_amdgcn_fence(__ATOMIC_RELEASE, "agent");
            asm volatile("s_waitcnt vmcnt(0)" ::: "memory");
            const unsigned og = xb_add(&bar[XB_TOP], 1u);
            const unsigned tg = og / nx;
            if (og + 1u == (tg + 1u) * nx) xb_add(&bar[XB_TOPGEN], 1u);
            else XB_SPIN(xb_ld(&bar[XB_TOPGEN]) == tg, bar);
            __builtin_amdgcn_fence(__ATOMIC_ACQUIRE, "agent");
            xb_add(&bar[XB_XGEN(b.x)], 1u);
            asm volatile("s_waitcnt vmcnt(0)" ::: "memory");
        } else {
            XB_SPIN(xb_ld(&bar[XB_XGEN(b.x)]) == gen, bar);
            __builtin_amdgcn_fence(__ATOMIC_ACQUIRE, "agent");
            asm volatile("s_waitcnt vmcnt(0)" ::: "memory");
        }
    }
    __syncthreads();
}

namespace pg8 {
constexpr int BM = 256, BK = 64, HALF = 128, HTB = HALF * BK * 2, STAGE_BYTES = 8 * HTB, NXCD = 8, WGM = 8;
__device__ __forceinline__ int lds_byte(int r, int c) { const int st = (r >> 4) * 2 + (c >> 5), rr = r & 15, cc = c & 31, ob = rr * 64 + cc * 2; return st * 1024 + (ob ^ (((ob >> 9) & 1) << 5)); }
__device__ __forceinline__ void stage_rc(int b, int& R, int& C) { const int st = b / 1024, sb = b % 1024, swz = sb ^ (((sb >> 9) & 1) << 5); R = (st >> 1) * 16 + swz / 64; C = (st & 1) * 32 + (swz % 64) / 2; }
__device__ __forceinline__ int perm32(int rho) { const int n = rho >> 4, i = rho & 15; return 8 * (i >> 2) + 4 * n + (i & 3); }

struct Unit { int pm, pn, sub; unsigned aoff, boff; };
struct Gemm { const bf16_t* A; const bf16_t* Bt; int lda, ldb, K; unsigned kstepA = 128; };
struct Sched {
    int nM, nN, nwg, G, c, nsub, mode = 0; unsigned a_row, a_sub, b_row, b_sub;
    __device__ __forceinline__ void init(int nM_, int nN_, int G_, int c_, int nsub_, unsigned a_row_, unsigned a_sub_, unsigned b_row_, unsigned b_sub_) {
        nM = nM_; nN = nN_; nwg = nM * nN; G = G_; c = c_; nsub = nsub_; a_row = a_row_; a_sub = a_sub_; b_row = b_row_; b_sub = b_sub_; }
    __device__ __forceinline__ bool next(int i, Unit& u) const {
        const int round = i / nsub; u.sub = i - round * nsub;
        const long L = (long)round * G + c; if (L >= nwg) return false;
        int wgid = (int)L; { const int q = nwg / NXCD, r = nwg % NXCD, xcd = wgid % NXCD, off = wgid / NXCD; wgid = (xcd < r ? xcd * (q + 1) : r * (q + 1) + (xcd - r) * q) + off; }
        const int nig = WGM * nN, gid = wgid / nig, fm = gid * WGM, gsz = (nM - fm) < WGM ? (nM - fm) : WGM;
        u.pm = fm + ((wgid % nig) % gsz); u.pn = (wgid % nig) / gsz;
        u.aoff = (unsigned)u.pm * a_row + (unsigned)u.sub * a_sub; u.boff = (unsigned)u.pn * b_row + (unsigned)u.sub * b_sub;
        if (mode == 1) { const int kv = u.pm >> 3, g = (u.pm >> 2) & 1, cp = u.pm & 3;
            u.aoff = (unsigned)(((size_t)cp * 256 * 16 * PLD + (kv ? PC_VC : PC_KC) + g * 64) * 2); u.boff = (unsigned)kv * (256u * 2048u * 2u); }
        if (mode == 2) { const int kv = u.pm >> 3; u.boff = (unsigned)kv * (256u * 256u * 2u); }
        return true;
    }
};

template <class Epi>
__device__ __forceinline__ void gemm_phase(LAS unsigned char* lds, const int tid, const Gemm g, const Sched& S, const Epi& E) {
    const int wid = __builtin_amdgcn_readfirstlane(tid >> 6), lane = tid & 63, wr = wid >> 2, wc = wid & 3, fr = lane & 15, fq = lane >> 4;
    const int K = g.K, nt = K / BK;
    unsigned voffA[2], voffB[2];
#pragma unroll
    for (int i = 0; i < 2; ++i) { int R, C; stage_rc(tid * 16 + i * 8192, R, C); const int Rb = Epi::PERM ? ((R & ~31) + perm32(R & 31)) : R;
        voffA[i] = (unsigned)(R * g.lda + C) * 2u; voffB[i] = (unsigned)(Rb * g.ldb + C) * 2u; }
    const size_t kstep = (size_t)(BK * 2), kstA = g.kstepA;
    const size_t hstepA = (size_t)HALF * g.lda * 2, hstepB = (size_t)HALF * g.ldb * 2;
    const unsigned ldsw = (unsigned)wid * 1024u;
    const int aoff = lds_byte(wr * 64 + fr, fq * 8), boff = lds_byte(wc * 32 + fr, fq * 8);
#define PG8_SA(b, h) (((b) * 2 + (h)) * HTB)
#define PG8_SB(b, h) ((4 + (b) * 2 + (h)) * HTB)
#define PG8_STAGE(bufoff, gbase, voff) do { _Pragma("unroll") for (int _i = 0; _i < 2; ++_i) \
        __builtin_amdgcn_global_load_lds((const unsigned*)((const char*)(gbase) + (voff)[_i]), (LAS unsigned*)(lds + (bufoff) + ldsw + _i * 8192), 16, 0, 0); } while (0)
#define PG8_LDA(dst, b, h) do { _Pragma("unroll") for (int m = 0; m < 4; ++m) _Pragma("unroll") for (int k = 0; k < 2; ++k) dst[m][k] = *(const LAS bf16x8*)(lds + PG8_SA(b, h) + aoff + m * 2048 + k * 1024); } while (0)
#define PG8_LDB(dst, b, h) do { _Pragma("unroll") for (int n = 0; n < 2; ++n) _Pragma("unroll") for (int k = 0; k < 2; ++k) dst[n][k] = *(const LAS bf16x8*)(lds + PG8_SB(b, h) + boff + n * 2048 + k * 1024); } while (0)
#define PG8_MMA(ai, bj, At, Bt) do { __builtin_amdgcn_s_setprio(1); _Pragma("unroll") for (int m = 0; m < 4; ++m) _Pragma("unroll") for (int n = 0; n < 2; ++n) _Pragma("unroll") for (int k = 0; k < 2; ++k) \
        acc[ai][bj][m][n] = __builtin_amdgcn_mfma_f32_16x16x32_bf16(Bt[n][k], At[m][k], acc[ai][bj][m][n], 0, 0, 0); __builtin_amdgcn_s_setprio(0); } while (0)
#define PG8_WAIT_V(n) asm volatile("s_waitcnt vmcnt(" #n ")" ::: "memory")
#define PG8_WAIT_L(n) asm volatile("s_waitcnt lgkmcnt(" #n ")" ::: "memory")
#define PG8_BAR __builtin_amdgcn_s_barrier()
#define PG8_SCHED __builtin_amdgcn_sched_barrier(0)
    Unit cur, nxt; int ui = 0;
    if (!S.next(0, cur)) return;
    f32x4 acc[2][2][4][2];
#pragma unroll
    for (int a = 0; a < 2; ++a)
#pragma unroll
        for (int b = 0; b < 2; ++b)
#pragma unroll
            for (int m = 0; m < 4; ++m)
#pragma unroll
                for (int n = 0; n < 2; ++n) acc[a][b][m][n] = (f32x4){0.f, 0.f, 0.f, 0.f};
    bf16x8 At[4][2], B0[2][2], B1[2][2];
    const char* cA = (const char*)g.A + cur.aoff; const char* cB = (const char*)g.Bt + cur.boff;
    PG8_STAGE(PG8_SB(0, 0), cB, voffB); PG8_STAGE(PG8_SA(0, 0), cA, voffA); PG8_STAGE(PG8_SB(0, 1), cB + hstepB, voffB); PG8_STAGE(PG8_SA(0, 1), cA + hstepA, voffA);
    if (wr == 1) PG8_BAR;
    PG8_WAIT_V(4); PG8_BAR;
    PG8_STAGE(PG8_SB(1, 0), cB + kstep, voffB); PG8_STAGE(PG8_SA(1, 0), cA + kstA, voffA); PG8_STAGE(PG8_SB(1, 1), cB + hstepB + kstep, voffB);
    PG8_WAIT_V(6); PG8_BAR;
    for (;;) {
        const bool has_next = S.next(ui + 1, nxt);
        const char* nA = has_next ? (const char*)g.A + nxt.aoff : cA; const char* nB = has_next ? (const char*)g.Bt + nxt.boff : cB;
        for (int t = 0; t < nt; t += 2) {
            const bool last = (t == nt - 2);
            const char* a1 = cA + (size_t)(t + 1) * kstA;
            const char* a2 = last ? nA : cA + (size_t)(t + 2) * kstA; const char* b2 = last ? nB : cB + (size_t)(t + 2) * kstep;
            const char* a3 = a2 + kstA; const char* b3 = b2 + kstep;
            PG8_LDB(B0, 0, 0); PG8_SCHED; PG8_LDA(At, 0, 0); PG8_STAGE(PG8_SA(1, 1), a1 + hstepA, voffA);
            PG8_WAIT_L(8); PG8_BAR; PG8_WAIT_L(0); PG8_MMA(0, 0, At, B0); PG8_BAR; PG8_SCHED;
            PG8_LDB(B1, 0, 1); PG8_STAGE(PG8_SB(0, 0), b2, voffB);
            PG8_BAR; PG8_WAIT_L(0); PG8_MMA(0, 1, At, B1); PG8_BAR;
            PG8_LDA(At, 0, 1); PG8_STAGE(PG8_SA(0, 0), a2, voffA);
            PG8_BAR; PG8_WAIT_L(0); PG8_MMA(1, 0, At, B0); PG8_BAR; PG8_SCHED;
            PG8_STAGE(PG8_SB(0, 1), b2 + hstepB, voffB);
            PG8_WAIT_V(6); PG8_BAR; PG8_MMA(1, 1, At, B1); PG8_BAR;
            PG8_LDB(B0, 1, 0); PG8_SCHED; PG8_LDA(At, 1, 0); PG8_STAGE(PG8_SA(0, 1), a2 + hstepA, voffA);
            PG8_WAIT_L(8); PG8_BAR; PG8_WAIT_L(0); PG8_MMA(0, 0, At, B0); PG8_BAR; PG8_SCHED;
            PG8_LDB(B1, 1, 1); PG8_STAGE(PG8_SB(1, 0), b3, voffB);
            PG8_BAR; PG8_WAIT_L(0); PG8_MMA(0, 1, At, B1); PG8_BAR;
            PG8_LDA(At, 1, 1); PG8_STAGE(PG8_SA(1, 0), a3, voffA);
            PG8_BAR; PG8_WAIT_L(0); PG8_MMA(1, 0, At, B0); PG8_BAR; PG8_SCHED;
            PG8_STAGE(PG8_SB(1, 1), b3 + hstepB, voffB);
            PG8_WAIT_V(6); PG8_BAR; PG8_MMA(1, 1, At, B1); PG8_BAR;
        }
        const bool keep = E(acc, cur, wr, wc, fr, fq);
        if (!has_next) break;
        if (!keep) {
#pragma unroll
            for (int a = 0; a < 2; ++a)
#pragma unroll
                for (int b = 0; b < 2; ++b)
#pragma unroll
                    for (int m = 0; m < 4; ++m)
#pragma unroll
                        for (int n = 0; n < 2; ++n) acc[a][b][m][n] = (f32x4){0.f, 0.f, 0.f, 0.f};
        }
        cur = nxt; cA = nA; cB = nB; ++ui;
    }
    PG8_WAIT_V(0);
    if (wr == 0) PG8_BAR;
    PG8_BAR;
#undef PG8_SA
#undef PG8_SB
#undef PG8_STAGE
#undef PG8_LDA
#undef PG8_LDB
#undef PG8_MMA
#undef PG8_WAIT_V
#undef PG8_WAIT_L
#undef PG8_BAR
#undef PG8_SCHED
}

struct EpiInProj {
    static constexpr bool PERM = true;
    bf16_t* proj; bf16_t* gates; const float* rs;
    __device__ __forceinline__ bool operator()(f32x4 (&acc)[2][2][4][2], const Unit& u, int wr, int wc, int fr, int fq) const {
        const int row0 = u.pm * BM + wr * 64 + fr; const bool is_gate = u.pn >= 16;
        bf16_t* base = is_gate ? gates + (u.pn - 16) * 256 : proj + u.pn * 256; const int ld = is_gate ? 3072 : PLD;
        const int col0 = wc * 32 + 8 * fq;
#pragma unroll
        for (int ai = 0; ai < 2; ++ai)
#pragma unroll
            for (int m = 0; m < 4; ++m) { const int row = row0 + ai * HALF + m * 16; const float s = rs[row]; bf16_t* rowp = base + (size_t)row * ld + col0;
#pragma unroll
                for (int bj = 0; bj < 2; ++bj) { f32x4 v0 = acc[ai][bj][m][0] * s, v1 = acc[ai][bj][m][1] * s;
                    if (is_gate) {
#pragma unroll
                        for (int j = 0; j < 4; ++j) { v0[j] = sigmoidf_(v0[j]); v1[j] = sigmoidf_(v1[j]); } }
                    u32x4 w; w.x = pk2(v0[0], v0[1]); w.y = pk2(v0[2], v0[3]); w.z = pk2(v1[0], v1[1]); w.w = pk2(v1[2], v1[3]);
                    *(u32x4*)(rowp + bj * HALF) = w; } }
        return false;
    }
};
struct EpiStore {
    static constexpr bool PERM = true;
    bf16_t* out; int ld;
    __device__ __forceinline__ bool operator()(f32x4 (&acc)[2][2][4][2], const Unit& u, int wr, int wc, int fr, int fq) const {
        const int row0 = u.pm * BM + wr * 64 + fr; const int col0 = u.pn * BM + wc * 32 + 8 * fq;
#pragma unroll
        for (int ai = 0; ai < 2; ++ai)
#pragma unroll
            for (int m = 0; m < 4; ++m) { bf16_t* rowp = out + (size_t)(row0 + ai * HALF + m * 16) * ld + col0;
#pragma unroll
                for (int bj = 0; bj < 2; ++bj) { const f32x4 v0 = acc[ai][bj][m][0], v1 = acc[ai][bj][m][1];
                    u32x4 w; w.x = pk2(v0[0], v0[1]); w.y = pk2(v0[2], v0[3]); w.z = pk2(v1[0], v1[1]); w.w = pk2(v1[2], v1[3]);
                    *(u32x4*)(rowp + bj * HALF) = w; } }
        return false;
    }
};
struct EpiCmp1 {
    static constexpr bool PERM = true;
    bf16_t* hid; const float* bh;
    __device__ __forceinline__ bool operator()(f32x4 (&acc)[2][2][4][2], const Unit& u, int wr, int wc, int fr, int fq) const {
        const int kv = u.pm >> 3; const int row0 = (u.pm & 7) * BM + wr * 64 + fr; const int col0 = wc * 32 + 8 * fq;
#pragma unroll
        for (int ai = 0; ai < 2; ++ai)
#pragma unroll
            for (int m = 0; m < 4; ++m) { bf16_t* rowp = hid + ((size_t)kv * 2048 + row0 + ai * HALF + m * 16) * 256 + col0;
#pragma unroll
                for (int bj = 0; bj < 2; ++bj) { float o[8];
#pragma unroll
                    for (int j = 0; j < 8; ++j) { const float x = acc[ai][bj][m][j >> 2][j & 3] + bh[kv * 256 + col0 + bj * HALF + j];
                        o[j] = x * sigmoidf_(1.5957691216f * (x + 0.044715f * x * x * x)); }
                    u32x4 w; w.x = pk2(o[0], o[1]); w.y = pk2(o[2], o[3]); w.z = pk2(o[4], o[5]); w.w = pk2(o[6], o[7]);
                    *(u32x4*)(rowp + bj * HALF) = w; } }
        return false;
    }
};
struct EpiCmp2 {
    static constexpr bool PERM = true;
    bf16_t* kcb; bf16_t* vct;
    __device__ __forceinline__ bool operator()(f32x4 (&acc)[2][2][4][2], const Unit& u, int wr, int wc, int fr, int fq) const {
        const int kv = u.pm >> 3; const int row0 = (u.pm & 7) * BM + wr * 64 + fr; const int col0 = wc * 32 + 8 * fq;
        if (col0 >= 64) return false;
#pragma unroll
        for (int ai = 0; ai < 2; ++ai)
#pragma unroll
            for (int m = 0; m < 4; ++m) { const int row = row0 + ai * HALF + m * 16, g = row >> 10, cc = row & 1023; const bool zr = cc == 1023; const f32x4 zz = (f32x4){0.f, 0.f, 0.f, 0.f};
                const f32x4 v0 = zr ? zz : acc[ai][0][m][0], v1 = zr ? zz : acc[ai][0][m][1];
                if (kv == 0) { u32x4 w; w.x = pk2(v0[0], v0[1]); w.y = pk2(v0[2], v0[3]); w.z = pk2(v1[0], v1[1]); w.w = pk2(v1[2], v1[3]); *(u32x4*)(kcb + ((size_t)g * 1024 + cc) * 64 + col0) = w; }
                else {
#pragma unroll
                    for (int j = 0; j < 4; ++j) { vct[((size_t)g * 64 + col0 + j) * 1024 + cc] = (bf16_t)f2bf(v0[j]); vct[((size_t)g * 64 + col0 + 4 + j) * 1024 + cc] = (bf16_t)f2bf(v1[j]); } } }
        return false;
    }
};
struct EpiLora {
    static constexpr bool PERM = true;
    bf16_t* obuf;
    __device__ __forceinline__ bool operator()(f32x4 (&acc)[2][2][4][2], const Unit& u, int wr, int wc, int fr, int fq) const {
        const int sel = u.pn >> 1; bf16_t* out = obuf + (size_t)(sel == 2 ? 0 : sel + 1) * T * 512;
        const int row0 = u.pm * BM + wr * 64 + fr; const int col0 = (u.pn & 1) * BM + wc * 32 + 8 * fq;
#pragma unroll
        for (int ai = 0; ai < 2; ++ai)
#pragma unroll
            for (int m = 0; m < 4; ++m) { bf16_t* rowp = out + (size_t)(row0 + ai * HALF + m * 16) * 512 + col0;
#pragma unroll
                for (int bj = 0; bj < 2; ++bj) { const f32x4 v0 = acc[ai][bj][m][0], v1 = acc[ai][bj][m][1];
                    u32x4 w; w.x = pk2(v0[0], v0[1]); w.y = pk2(v0[2], v0[3]); w.z = pk2(v1[0], v1[1]); w.w = pk2(v1[2], v1[3]);
                    *(u32x4*)(rowp + bj * HALF) = w; } }
        return false;
    }
};
struct EpiMerge {
    static constexpr bool PERM = true;
    const bf16_t* gates; bf16_t* merged;
    __device__ __forceinline__ bool operator()(f32x4 (&acc)[2][2][4][2], const Unit& u, int wr, int wc, int fr, int fq) const {
        const int row0 = u.pm * BM + wr * 64 + fr; const int col0 = u.pn * BM + wc * 32 + 8 * fq; const int sub = u.sub;
#pragma unroll
        for (int ai = 0; ai < 2; ++ai)
#pragma unroll
            for (int m = 0; m < 4; ++m) { const int row = row0 + ai * HALF + m * 16; const bf16_t* gp = gates + (size_t)row * 3072 + sub * 1024 + col0;
#pragma unroll
                for (int bj = 0; bj < 2; ++bj) {
                    float sc[8], sn[8]; unpack8(*(const u32x4*)(gp + bj * HALF), sc);
                    if (sub < 2) { unpack8(*(const u32x4*)(gp + 1024 + bj * HALF), sn);
#pragma unroll
                        for (int j = 0; j < 8; ++j) sc[j] = sc[j] / fmaxf(sn[j], 1e-30f); }
                    f32x4 v0 = acc[ai][bj][m][0], v1 = acc[ai][bj][m][1];
#pragma unroll
                    for (int j = 0; j < 4; ++j) { v0[j] *= sc[j]; v1[j] *= sc[4 + j]; }
                    acc[ai][bj][m][0] = v0; acc[ai][bj][m][1] = v1;
                    if (sub == 2) { u32x4 w; w.x = pk2(v0[0], v0[1]); w.y = pk2(v0[2], v0[3]); w.z = pk2(v1[0], v1[1]); w.w = pk2(v1[2], v1[3]);
                        *(u32x4*)(merged + (size_t)row * D + col0 + bj * HALF) = w; } } }
        return sub != 2;
    }
};
struct EpiSwiGLU {
    static constexpr bool PERM = true;
    bf16_t* act; const float* rs;
    __device__ __forceinline__ bool operator()(f32x4 (&acc)[2][2][4][2], const Unit& u, int wr, int wc, int fr, int fq) const {
        const int row0 = u.pm * BM + wr * 64 + fr; const int col0 = u.pn * HALF + wc * 32 + 8 * fq;
#pragma unroll
        for (int ai = 0; ai < 2; ++ai)
#pragma unroll
            for (int m = 0; m < 4; ++m) { const int row = row0 + ai * HALF + m * 16; const float s = rs[row];
                float o[8];
#pragma unroll
                for (int n = 0; n < 2; ++n)
#pragma unroll
                    for (int j = 0; j < 4; ++j) { const float gg = acc[ai][0][m][n][j] * s, uu = acc[ai][1][m][n][j] * s; o[n * 4 + j] = gg * sigmoidf_(gg) * uu; }
                u32x4 w; w.x = pk2(o[0], o[1]); w.y = pk2(o[2], o[3]); w.z = pk2(o[4], o[5]); w.w = pk2(o[6], o[7]);
                *(u32x4*)(act + (size_t)row * FFN + col0) = w; }
        return false;
    }
};
}

struct Args { const float* in[30]; float* out; unsigned char* ws; int lo, hi; };
enum { I_X = 0, I_NPM, I_NQM, I_NPF, I_NQF, I_WIN, I_MU, I_W0, I_W2, I_A0, I_A2, I_G2, I_KK, I_KA, I_RK, I_LNW, I_LNB, I_PEK, I_PEV, I_CKW1, I_CKW2, I_CVW1, I_CVW2, I_SINK, I_REL, I_WBR, I_WOUT, I_FG, I_FU, I_FD };

struct Ctx { LAS unsigned char* lds; int tid, lane, wave, G, bid; };
__device__ __forceinline__ const float* inptr(const Ctx& c, int i) {
    const volatile LAS unsigned* t = (const volatile LAS unsigned*)(c.lds + LDS_MISC + 64) + 2 * i;
    const unsigned lo = __builtin_amdgcn_readfirstlane(t[0]), hi = __builtin_amdgcn_readfirstlane(t[1]);
    return (const float*)(((unsigned long long)hi << 32) | lo);
}

__device__ __forceinline__ void phase_init(const Ctx& c, const float* x, float* xo, bf16_t* xb, float* rs) {
    const int gw = c.bid * 8 + c.wave, NGW = c.G * 8;
    for (int row = gw; row < MROWS; row += NGW) {
        const float* xr = x + (size_t)row * D; float ss = 0.f;
#pragma unroll
        for (int j = 0; j < 2; ++j) { const int e = c.lane * 8 + 512 * j; const f32x4 a = *(const f32x4*)(xr + e), b = *(const f32x4*)(xr + e + 4);
            ss += a[0] * a[0] + a[1] * a[1] + a[2] * a[2] + a[3] * a[3] + b[0] * b[0] + b[1] * b[1] + b[2] * b[2] + b[3] * b[3];
            *(f32x4*)(xo + (size_t)row * D + e) = a; *(f32x4*)(xo + (size_t)row * D + e + 4) = b;
            u32x4 w; w.x = pk2(a[0], a[1]); w.y = pk2(a[2], a[3]); w.z = pk2(b[0], b[1]); w.w = pk2(b[2], b[3]); *(u32x4*)(xb + (size_t)row * D + e) = w; }
        ss = wave_sum(ss);
        if (c.lane == 0) rs[row] = rsqrtf(ss * (1.0f / D) + NORM_EPS);
    }
}
__device__ __forceinline__ void phase_norm_res(const Ctx& c, const bf16_t* y, const float* gain, float* x, bf16_t* xb, float* rs, int row0, int nrows) {
    const int gw = c.bid * 8 + c.wave, NGW = c.G * 8;
    for (int r = gw; r < nrows; r += NGW) {
        const int row = row0 + r; float yv[16]; float ss = 0.f;
#pragma unroll
        for (int j = 0; j < 2; ++j) { float f[8]; unpack8(*(const u32x4*)(y + (size_t)r * D + c.lane * 8 + 512 * j), f);
#pragma unroll
            for (int k = 0; k < 8; ++k) { yv[j * 8 + k] = f[k]; ss += f[k] * f[k]; } }
        ss = wave_sum(ss); const float sc = rsqrtf(ss * (1.0f / D) + NORM_EPS); float s2 = 0.f;
#pragma unroll
        for (int j = 0; j < 2; ++j) { const int e = c.lane * 8 + 512 * j; float* xr = x + (size_t)row * D + e;
            f32x4 a = *(const f32x4*)xr, b = *(const f32x4*)(xr + 4); const f32x4 ga = *(const f32x4*)(gain + e), gb = *(const f32x4*)(gain + e + 4);
#pragma unroll
            for (int k = 0; k < 4; ++k) { a[k] += yv[j * 8 + k] * sc * ga[k]; b[k] += yv[j * 8 + 4 + k] * sc * gb[k]; s2 += a[k] * a[k] + b[k] * b[k]; }
            *(f32x4*)xr = a; *(f32x4*)(xr + 4) = b;
            u32x4 w; w.x = pk2(a[0], a[1]); w.y = pk2(a[2], a[3]); w.z = pk2(b[0], b[1]); w.w = pk2(b[2], b[3]); *(u32x4*)(xb + (size_t)row * D + e) = w; }
        s2 = wave_sum(s2);
        if (c.lane == 0) rs[row] = rsqrtf(s2 * (1.0f / D) + NORM_EPS);
    }
}

__device__ __forceinline__ float cvt_fetch(const Ctx& c, int layer, int kind, int sub, int k, int n) {
    switch (kind) {
    case 0: { int src; float sc = inptr(c, I_NPM)[layer * D + k];
        if (n < 3096) src = n; else if (n < 3328) return 0.f; else if (n < 4096) src = 3096 + (n - 3328); else src = 3864 + (n - 4096);
        if ((n >= PC_NQ && n < PC_NQ + 512) || (n >= PC_SQ && n < PC_SQ + 512)) sc *= 0.125f;
        return inptr(c, I_WIN)[((size_t)layer * D + k) * IN_COLS + src] * sc; }
    case 1: return inptr(c, I_WBR)[(((size_t)layer * 3 + sub) * 512 + k) * D + n];
    case 2: return inptr(c, I_WOUT)[((size_t)layer * D + k) * D + n];
    case 3: { const int pn = n >> 8, r = n & 255; const float sc = inptr(c, I_NPF)[layer * D + k];
        return (r < 128 ? inptr(c, I_FG)[((size_t)layer * D + k) * FFN + pn * 128 + r] : inptr(c, I_FU)[((size_t)layer * D + k) * FFN + pn * 128 + r - 128]) * sc; }
    case 4: return inptr(c, I_FD)[((size_t)layer * FFN + k) * D + n];
    case 6: return inptr(c, sub ? I_CVW1 : I_CKW1)[((size_t)layer * 2048 + k) * 256 + n];
    case 7: return n < 64 ? inptr(c, sub ? I_CVW2 : I_CKW2)[((size_t)layer * 256 + k) * 64 + n] : 0.f;
    default: {
        if (n < 512) return k < 64 ? inptr(c, I_W2)[((size_t)layer * 64 + k) * 512 + n] : 0.f;
        if (n < 1024) return (k >= 64 && k < 128) ? inptr(c, I_A2)[((size_t)layer * 64 + k - 64) * 512 + n - 512] : 0.f;
        return k >= 128 ? inptr(c, I_G2)[((size_t)layer * 128 + k - 128) * 512 + n - 1024] : 0.f; }
    }
}
__device__ __forceinline__ void phase_cvt(const Ctx& c, const Args& a, int layer, bf16_t* wb) {
    LAS float* tile = (LAS float*)c.lds;
    constexpr int I0 = 16 * 112, I1 = 3 * 8 * 16, I2 = 16 * 16, I3 = 16 * 88, I4 = 44 * 16, I5 = 4 * 24, I6 = 2 * 32 * 4, I7 = 2 * 4 * 4, NIT = I0 + I1 + I2 + I3 + I4 + I5 + I6 + I7;
    for (int it = c.bid; it < NIT; it += c.G) {
        int r = it, kind, sub = 0, K, nblk; bf16_t* dst;
        if (r < I0) { kind = 0; K = D; nblk = 112; dst = wb + WB_WIN; }
        else if ((r -= I0) < I1) { kind = 1; sub = r / 128; r -= sub * 128; K = 512; nblk = 16; dst = wb + WB_WBR + (size_t)sub * D * 512; }
        else if ((r -= I1) < I2) { kind = 2; K = D; nblk = 16; dst = wb + WB_WOUT; }
        else if ((r -= I2) < I3) { kind = 3; K = D; nblk = 88; dst = wb + WB_WGU; }
        else if ((r -= I3) < I4) { kind = 4; K = FFN; nblk = 16; dst = wb + WB_WDN; }
        else if ((r -= I4) < I5) { kind = 5; K = 256; nblk = 24; dst = wb + WB_LORA; }
        else if ((r -= I5) < I6) { kind = 6; sub = r / 128; r -= sub * 128; K = 2048; nblk = 4; dst = wb + WB_W1T + (size_t)sub * 256 * 2048; }
        else { r -= I6; kind = 7; sub = r / 16; r -= sub * 16; K = 256; nblk = 4; dst = wb + WB_W2T + (size_t)sub * 256 * 256; }
        const int kb = r / nblk, nb = r % nblk, k0 = kb * 64, n0 = nb * 64;
        for (int e = c.tid; e < 4096; e += 512) { const int kk = e >> 6, nn = e & 63; tile[kk * 65 + nn] = cvt_fetch(c, layer, kind, sub, k0 + kk, n0 + nn); }
        __syncthreads();
        for (int e = c.tid; e < 2048; e += 512) { const int nn = e >> 5, kp = (e & 31) * 2;
            *(unsigned*)(dst + (size_t)(n0 + nn) * K + k0 + kp) = pk2(tile[kp * 65 + nn], tile[(kp + 1) * 65 + nn]); }
        __syncthreads();
    }
    if (c.bid == c.G - 1) {
        const int kv = c.tid >> 8, u = c.tid & 255; const float* w1 = inptr(c, kv ? I_CVW1 : I_CKW1) + (size_t)layer * 2048 * 256; const float* pe = inptr(c, kv ? I_PEV : I_PEK) + (size_t)layer * 2048;
        float acc = 0.f; for (int k = 0; k < 2048; ++k) acc += pe[k] * w1[(size_t)k * 256 + u];
        ((float*)(wb + WB_BH))[c.tid] = acc;
    }
}

struct RowState { float q[64]; float o[64]; float m, l; };
__device__ __forceinline__ void row_init(RowState& s, const bf16_t* qp) {
#pragma unroll
    for (int i = 0; i < 8; ++i) { float f[8]; unpack8(*(const u32x4*)(qp + i * 8), f);
#pragma unroll
        for (int k = 0; k < 8; ++k) s.q[i * 8 + k] = f[k]; }
}
__device__ __forceinline__ void row_reset(RowState& s) {
#pragma unroll
    for (int i = 0; i < 64; ++i) s.o[i] = 0.f;
    s.m = -1e30f; s.l = 0.f;
}
__device__ __forceinline__ void row_key_bf16(RowState& s, const bf16_t* kp, const bf16_t* vp, float bias) {
    float sc = bias;
#pragma unroll
    for (int i = 0; i < 8; ++i) { float f[8]; unpack8(*(const u32x4*)(kp + i * 8), f);
#pragma unroll
        for (int k = 0; k < 8; ++k) sc += s.q[i * 8 + k] * f[k];
        if ((i & 1) == 1) __builtin_amdgcn_sched_barrier(0); }
    const float mn = fmaxf(s.m, sc), corr = __expf(s.m - mn), p = __expf(sc - mn);
    s.l = s.l * corr + p; s.m = mn;
#pragma unroll
    for (int i = 0; i < 8; ++i) { float f[8]; unpack8(*(const u32x4*)(vp + i * 8), f);
#pragma unroll
        for (int k = 0; k < 8; ++k) s.o[i * 8 + k] = s.o[i * 8 + k] * corr + p * f[k];
        if ((i & 1) == 1) __builtin_amdgcn_sched_barrier(0); }
}
__device__ __forceinline__ void row_key_f32(RowState& s, const float* kp, const float* vp, float bias) {
    float sc = bias;
#pragma unroll
    for (int i = 0; i < 16; ++i) { const f32x4 f = *(const f32x4*)(kp + i * 4); sc += s.q[i * 4] * f[0] + s.q[i * 4 + 1] * f[1] + s.q[i * 4 + 2] * f[2] + s.q[i * 4 + 3] * f[3];
        if ((i & 3) == 3) __builtin_amdgcn_sched_barrier(0); }
    const float mn = fmaxf(s.m, sc), corr = __expf(s.m - mn), p = __expf(sc - mn);
    s.l = s.l * corr + p; s.m = mn;
#pragma unroll
    for (int i = 0; i < 16; ++i) { const f32x4 f = *(const f32x4*)(vp + i * 4);
#pragma unroll
        for (int k = 0; k < 4; ++k) s.o[i * 4 + k] = s.o[i * 4 + k] * corr + p * f[k];
        if ((i & 3) == 3) __builtin_amdgcn_sched_barrier(0); }
}

__device__ __forceinline__ float gelu_tanh(float x) { const float t = tanhf(0.7978845608028654f * (x + 0.044715f * x * x * x)); return 0.5f * x * (1.0f + t); }
__device__ __forceinline__ void phase_cmp1(const Ctx& c, const Args& a, int layer, const bf16_t* proj, float* hid) {
    for (int unit = c.bid; unit < 2048; unit += c.G) {
        const int kv = unit >> 10, g = (unit >> 9) & 1, cp = unit & 511; const int cc = cp * 2 + (c.tid >> 8), u = c.tid & 255;
        if (cc >= NCMP) continue;
        const float* w1 = a.in[kv ? I_CVW1 : I_CKW1] + (size_t)layer * 2048 * 256; const float* pe = a.in[kv ? I_PEV : I_PEK] + (size_t)layer * 32 * 64;
        const bf16_t* xp = proj + (size_t)(16 * cc) * PLD + (kv ? PC_VC : PC_KC) + g * 64;
        float acc = 0.f;
        for (int l = 0; l < 32; ++l) {
#pragma unroll
            for (int i = 0; i < 8; ++i) { float f[8]; unpack8(*(const u32x4*)(xp + (size_t)l * PLD + i * 8), f);
#pragma unroll
                for (int k = 0; k < 8; ++k) acc += (f[k] + pe[l * 64 + i * 8 + k]) * w1[(size_t)(l * 64 + i * 8 + k) * 256 + u]; }
        }
        hid[(((size_t)kv * 2 + g) * 1024 + cc) * 256 + u] = gelu_tanh(acc);
    }
}
__device__ __forceinline__ void phase_cmp2(const Ctx& c, const Args& a, int layer, const float* hid, bf16_t* kcb, bf16_t* vctb) {
    for (int unit = c.bid; unit < 512; unit += c.G) {
        const int kv = unit >> 8, g = (unit >> 7) & 1, cc = (unit & 127) * 8 + (c.tid >> 6), d = c.tid & 63;
        float acc = 0.f;
        if (cc < NCMP) { const float* w2 = a.in[kv ? I_CVW2 : I_CKW2] + (size_t)layer * 256 * 64; const float* hp = hid + (((size_t)kv * 2 + g) * 1024 + cc) * 256;
            for (int u = 0; u < 256; ++u) acc += hp[u] * w2[u * 64 + d]; }
        if (kv) vctb[((size_t)g * 64 + d) * 1024 + cc] = (bf16_t)f2bf(acc); else kcb[((size_t)g * 1024 + cc) * 64 + d] = (bf16_t)f2bf(acc);
    }
}
__device__ __forceinline__ void phase_nsa13(const Ctx& c, const Args& a, const bf16_t* proj, const float* kcmp, const float* vcmp, float* nsaacc, float* ml) {
    LAS float* tb = (LAS float*)c.lds;
    for (int e = c.tid; e < 512; e += 512) tb[e] = inptr(c, I_REL)[e];
    __syncthreads();
    for (int unit = c.bid; unit < T / 64; unit += c.G) {
        const int hh = c.tid >> 6, t = unit * 64 + (c.tid & 63), g = hh >> 2;
        RowState s; row_init(s, proj + (size_t)t * PLD + PC_NQ + hh * 64);
        const bf16_t* glp = proj + (size_t)t * PLD + PC_GL;
        const float g0 = sigmoidf_(bf2f(glp[hh])), g2 = sigmoidf_(bf2f(glp[16 + hh]));
        row_reset(s);
        const int nv = t >= 31 ? (t - 31) / 16 + 1 : 0;
        for (int cc = 0; cc < nv; ++cc) { const float bias = tb[t5_bucket(t - 16 * cc - 31) * 16 + hh];
            row_key_f32(s, kcmp + ((size_t)g * 1024 + cc) * 64, vcmp + ((size_t)g * 1024 + cc) * 64, bias); }
        ml[((size_t)t * 8 + hh) * 2] = s.m; ml[((size_t)t * 8 + hh) * 2 + 1] = s.l;
        float* op = nsaacc + (size_t)t * 512 + hh * 64;
        { const float inv = s.l > 0.f ? g0 / s.l : 0.f;
#pragma unroll
            for (int i = 0; i < 16; ++i) { f32x4 w; w[0] = s.o[i * 4] * inv; w[1] = s.o[i * 4 + 1] * inv; w[2] = s.o[i * 4 + 2] * inv; w[3] = s.o[i * 4 + 3] * inv; *(f32x4*)(op + i * 4) = w; } }
        row_reset(s);
        const int s0 = t - 511 > 0 ? t - 511 : 0;
        for (int sp = s0; sp <= t; ++sp) { const float bias = tb[t5_bucket(t - sp) * 16 + hh];
            row_key_bf16(s, proj + (size_t)sp * PLD + PC_KW + g * 64, proj + (size_t)sp * PLD + PC_VW + g * 64, bias); }
        { const float inv = s.l > 0.f ? g2 / s.l : 0.f;
#pragma unroll
            for (int i = 0; i < 16; ++i) { f32x4 w = *(const f32x4*)(op + i * 4); w[0] += s.o[i * 4] * inv; w[1] += s.o[i * 4 + 1] * inv; w[2] += s.o[i * 4 + 2] * inv; w[3] += s.o[i * 4 + 3] * inv; *(f32x4*)(op + i * 4) = w; } }
    }
}
__device__ __forceinline__ void phase_nsa_topk(const Ctx& c, const Args& a, const bf16_t* proj, const float* kcmp, const float* ml, int* sel) {
    LAS float* tb = (LAS float*)c.lds;
    LAS float* qs = (LAS float*)(c.lds + 4096) + c.wave * 256;
    LAS float* sv = (LAS float*)(c.lds + 16384) + c.wave * 256;
    for (int e = c.tid; e < 512; e += 512) tb[e] = inptr(c, I_REL)[e];
    __syncthreads();
    const int gw = c.bid * 8 + c.wave, NGW = c.G * 8;
    for (int item = gw; item < T * 2; item += NGW) {
        const int t = item >> 1, g = item & 1, cur = t >> 6;
        { const bf16_t* qp = proj + (size_t)t * PLD + PC_NQ + g * 256 + c.lane * 4; const u32x2 w = *(const u32x2*)qp;
          qs[c.lane * 4] = __uint_as_float(w.x << 16); qs[c.lane * 4 + 1] = __uint_as_float(w.x & 0xffff0000u); qs[c.lane * 4 + 2] = __uint_as_float(w.y << 16); qs[c.lane * 4 + 3] = __uint_as_float(w.y & 0xffff0000u); }
        float mr[4], il[4];
#pragma unroll
        for (int r = 0; r < 4; ++r) { mr[r] = ml[((size_t)t * 8 + g * 4 + r) * 2]; const float l = ml[((size_t)t * 8 + g * 4 + r) * 2 + 1]; il[r] = l > 0.f ? 1.0f / l : 0.f; }
        const int nv = t >= 31 ? (t - 31) / 16 + 1 : 0;
        asm volatile("s_waitcnt lgkmcnt(0)" ::: "memory");
#pragma unroll 1
        for (int jj = 0; jj < 4; ++jj) {
            const int j = c.lane + 64 * jj; float sc;
            if (j == 0 || j == cur || j == cur - 1) sc = 1e4f;
            else if (j > cur) sc = -1.0f;
            else { sc = 0.f;
#pragma unroll 1
                for (int o = 0; o < 5; ++o) { const int cc = 4 * j + o - 1; if (cc < 0 || cc >= nv) continue;
                    const float* kp = kcmp + ((size_t)g * 1024 + cc) * 64; float d0 = 0.f, d1 = 0.f, d2 = 0.f, d3 = 0.f;
#pragma unroll 4
                    for (int i = 0; i < 16; ++i) { const f32x4 f = *(const f32x4*)(kp + i * 4);
#pragma unroll
                        for (int k = 0; k < 4; ++k) { d0 += qs[i * 4 + k] * f[k]; d1 += qs[64 + i * 4 + k] * f[k]; d2 += qs[128 + i * 4 + k] * f[k]; d3 += qs[192 + i * 4 + k] * f[k]; } }
                    const int bk = t5_bucket(t - 16 * cc - 31) * 16 + g * 4;
                    const float imp = __expf(d0 + tb[bk] - mr[0]) * il[0] + __expf(d1 + tb[bk + 1] - mr[1]) * il[1] + __expf(d2 + tb[bk + 2] - mr[2]) * il[2] + __expf(d3 + tb[bk + 3] - mr[3]) * il[3];
                    sc += ((o == 0 || o == 4) ? 1.0f : 2.0f) * imp; }
            }
            sv[j] = sc;
        }
        asm volatile("s_waitcnt lgkmcnt(0)" ::: "memory");
        float val[4];
#pragma unroll
        for (int jj = 0; jj < 4; ++jj) val[jj] = sv[c.lane + 64 * jj];
        for (int k = 0; k < 16; ++k) {
            float bv = val[0]; int bi = c.lane;
#pragma unroll
            for (int jj = 1; jj < 4; ++jj) if (val[jj] > bv) { bv = val[jj]; bi = c.lane + 64 * jj; }
#pragma unroll
            for (int o = 32; o >= 1; o >>= 1) { const float ov = __shfl_xor(bv, o); const int oi = __shfl_xor(bi, o); if (ov > bv || (ov == bv && oi < bi)) { bv = ov; bi = oi; } }
#pragma unroll
            for (int jj = 0; jj < 4; ++jj) if (bi == c.lane + 64 * jj) val[jj] = -3e38f;
            if (c.lane == 0) sel[(size_t)item * 16 + k] = bi;
        }
    }
}
__device__ __forceinline__ void phase_nsa2(const Ctx& c, const Args& a, const bf16_t* proj, const int* sel, const float* nsaacc, bf16_t* onsa) {
    LAS float* tb = (LAS float*)c.lds;
    for (int e = c.tid; e < 512; e += 512) tb[e] = inptr(c, I_REL)[e];
    __syncthreads();
    for (int unit = c.bid; unit < T / 64; unit += c.G) {
        const int hh = c.tid >> 6, t = unit * 64 + (c.tid & 63), g = hh >> 2;
        RowState s; row_init(s, proj + (size_t)t * PLD + PC_NQ + hh * 64); row_reset(s);
        const float g1 = sigmoidf_(bf2f(proj[(size_t)t * PLD + PC_GL + 8 + hh]));
        for (int k = 0; k < 16; ++k) { const int j = sel[((size_t)t * 2 + g) * 16 + k];
            for (int p = 0; p < 64; ++p) { const int pos = j * 64 + p; if (pos > t) break;
                const float bias = tb[t5_bucket(t - pos) * 16 + hh];
                row_key_bf16(s, proj + (size_t)pos * PLD + PC_KS + g * 64, proj + (size_t)pos * PLD + PC_VS + g * 64, bias); } }
        const float inv = s.l > 0.f ? g1 / s.l : 0.f; const float* ap = nsaacc + (size_t)t * 512 + hh * 64; bf16_t* op = onsa + (size_t)t * 512 + hh * 64;
#pragma unroll
        for (int i = 0; i < 8; ++i) { const f32x4 x0 = *(const f32x4*)(ap + i * 8), x1 = *(const f32x4*)(ap + i * 8 + 4); u32x4 w;
            w.x = pk2(x0[0] + s.o[i * 8] * inv, x0[1] + s.o[i * 8 + 1] * inv); w.y = pk2(x0[2] + s.o[i * 8 + 2] * inv, x0[3] + s.o[i * 8 + 3] * inv);
            w.z = pk2(x1[0] + s.o[i * 8 + 4] * inv, x1[1] + s.o[i * 8 + 5] * inv); w.w = pk2(x1[2] + s.o[i * 8 + 6] * inv, x1[3] + s.o[i * 8 + 7] * inv);
            *(u32x4*)(op + i * 8) = w; }
    }
}
__device__ __forceinline__ void phase_swa(const Ctx& c, const Args& a, int layer, const bf16_t* proj, bf16_t* oswa) {
    LAS float* tb = (LAS float*)c.lds;
    for (int e = c.tid; e < 512; e += 512) tb[e] = inptr(c, I_REL)[e];
    __syncthreads();
    for (int unit = c.bid; unit < T / 64; unit += c.G) {
        const int hh = c.tid >> 6, t = unit * 64 + (c.tid & 63), g = hh >> 2;
        RowState s; row_init(s, proj + (size_t)t * PLD + PC_SQ + hh * 64); row_reset(s);
        const int s0 = t - 127 > 0 ? t - 127 : 0;
        for (int sp = s0; sp <= t; ++sp) { const float bias = tb[t5_bucket(t - sp) * 16 + 8 + hh];
            row_key_bf16(s, proj + (size_t)sp * PLD + PC_SK + g * 64, proj + (size_t)sp * PLD + PC_SV + g * 64, bias); }
        const float sink = inptr(c, I_SINK)[layer * 8 + hh]; const float mf = fmaxf(s.m, sink); const float corr = __expf(s.m - mf);
        const float den = s.l * corr + __expf(sink - mf); const float inv = corr / den;
        bf16_t* op = oswa + (size_t)t * 512 + hh * 64;
#pragma unroll
        for (int i = 0; i < 8; ++i) { u32x4 w; w.x = pk2(s.o[i * 8] * inv, s.o[i * 8 + 1] * inv); w.y = pk2(s.o[i * 8 + 2] * inv, s.o[i * 8 + 3] * inv);
            w.z = pk2(s.o[i * 8 + 4] * inv, s.o[i * 8 + 5] * inv); w.w = pk2(s.o[i * 8 + 6] * inv, s.o[i * 8 + 7] * inv); *(u32x4*)(op + i * 8) = w; }
    }
}

constexpr int RL = 65;
__device__ __forceinline__ float rwkv_mixed(const bf16_t* proj, const float* mu, int t, int col) {
    const float cur = bf2f(proj[(size_t)t * PLD + col]); const float prev = t > 0 ? bf2f(proj[(size_t)(t - 1) * PLD + col]) : 0.f;
    return cur + (prev - cur) * mu[col];
}
__device__ __forceinline__ void lora64(const Ctx& c, const LAS float* in, const float* W, const float* bias, LAS float* out, bool accum) {
    const int j = c.tid & 63, tg = (c.tid >> 6) * 8;
    float acc[8];
#pragma unroll
    for (int i = 0; i < 8; ++i) acc[i] = accum ? out[(tg + i) * RL + j] : (bias ? bias[j] : 0.f);
#pragma unroll 4
    for (int m = 0; m < 64; ++m) { const float w = W[(size_t)m * 512 + j];
#pragma unroll
        for (int i = 0; i < 8; ++i) acc[i] += in[(tg + i) * RL + m] * w; }
#pragma unroll
    for (int i = 0; i < 8; ++i) out[(tg + i) * RL + j] = acc[i];
}
struct RwkvLds { LAS float *R, *K, *V, *A, *B, *W, *G, *TMP; };
__device__ __forceinline__ RwkvLds rwkv_lds(LAS unsigned char* lds) {
    RwkvLds s; LAS float* p = (LAS float*)lds; constexpr int SZ = 64 * RL;
    s.R = p; s.K = p + SZ; s.V = p + 2 * SZ; s.A = p + 3 * SZ; s.B = p + 4 * SZ; s.W = p + 5 * SZ; s.G = p + 6 * SZ; s.TMP = p + 7 * SZ; return s;
}
template <bool LOGDECAY>
__device__ __forceinline__ void rwkv_prep(const Ctx& c, const Args& a, int layer, const bf16_t* proj, int t0, int h, const RwkvLds& s) {
    const float* mu = inptr(c, I_MU) + (size_t)layer * 1792;
    const int j = c.tid & 63, tg = c.tid >> 6;
#pragma unroll 2
    for (int i = 0; i < 8; ++i) { const int tt = tg * 8 + i; s.TMP[tt * RL + j] = tanhf(rwkv_mixed(proj, mu, t0 + tt, PC_ZW + j)); }
    __syncthreads();
    lora64(c, s.TMP, inptr(c, I_W2) + (size_t)layer * 64 * 512 + h * 64, inptr(c, I_W0) + layer * 512 + h * 64, s.W, false);
    __syncthreads();
#pragma unroll 2
    for (int i = 0; i < 8; ++i) { const int tt = tg * 8 + i; s.TMP[tt * RL + j] = rwkv_mixed(proj, mu, t0 + tt, PC_ZA + j); }
    __syncthreads();
    lora64(c, s.TMP, inptr(c, I_A2) + (size_t)layer * 64 * 512 + h * 64, inptr(c, I_A0) + layer * 512 + h * 64, s.B, false);
    __syncthreads();
#pragma unroll 2
    for (int i = 0; i < 8; ++i) { const int tt = tg * 8 + i; s.TMP[tt * RL + j] = sigmoidf_(rwkv_mixed(proj, mu, t0 + tt, PC_ZG + j)); }
    __syncthreads();
    lora64(c, s.TMP, inptr(c, I_G2) + (size_t)layer * 128 * 512 + h * 64, nullptr, s.G, false);
    __syncthreads();
#pragma unroll 2
    for (int i = 0; i < 8; ++i) { const int tt = tg * 8 + i; s.TMP[tt * RL + j] = sigmoidf_(rwkv_mixed(proj, mu, t0 + tt, PC_ZG + 64 + j)); }
    __syncthreads();
    lora64(c, s.TMP, inptr(c, I_G2) + ((size_t)layer * 128 + 64) * 512 + h * 64, nullptr, s.G, true);
    const float kkw = inptr(c, I_KK)[layer * 512 + h * 64 + j], kaw = inptr(c, I_KA)[layer * 512 + h * 64 + j];
#pragma unroll 1
    for (int i = 0; i < 8; ++i) { const int tt = tg * 8 + i, t = t0 + tt;
        const float r = rwkv_mixed(proj, mu, t, PC_R + h * 64 + j), k = rwkv_mixed(proj, mu, t, PC_K + h * 64 + j), v = rwkv_mixed(proj, mu, t, PC_V + h * 64 + j);
        const float wl = s.W[tt * RL + j], al = sigmoidf_(s.B[tt * RL + j]);
        const float sp = (-wl > 20.f) ? -wl : log1pf(__expf(-wl)); const float w = -sp - 0.5f; const float ew = __expf(w);
        float kk = k * kkw; const float n2 = wave_sum(kk * kk); kk = kk / fmaxf(sqrtf(n2), 1e-12f);
        s.R[tt * RL + j] = r; s.V[tt * RL + j] = v; s.K[tt * RL + j] = k * (1.0f + (al - 1.0f) * kaw);
        s.A[tt * RL + j] = -kk; s.B[tt * RL + j] = kk * al; s.W[tt * RL + j] = LOGDECAY ? -ew : __expf(-ew); }
    __syncthreads();
}
__device__ __forceinline__ void rwkv_post(const Ctx& c, const Args& a, int layer, int t0, int h, const RwkvLds& s, const LAS float* Y, bf16_t* orwkv) {
    const int i = c.lane, tg = c.wave;
    const float lnw = inptr(c, I_LNW)[layer * 512 + h * 64 + i], lnb = inptr(c, I_LNB)[layer * 512 + h * 64 + i], rk = inptr(c, I_RK)[layer * 512 + h * 64 + i];
#pragma unroll 1
    for (int q = 0; q < 8; ++q) { const int tt = tg * 8 + q; const float y = Y[tt * RL + i];
        const float mean = wave_sum(y) * (1.0f / 64.0f); const float d = y - mean; const float var = wave_sum(d * d) * (1.0f / 64.0f);
        const float bonus = wave_sum(s.R[tt * RL + i] * s.K[tt * RL + i] * rk);
        const float o = (d * rsqrtf(var + 64e-5f) * lnw + lnb + bonus * s.V[tt * RL + i]) * s.G[tt * RL + i];
        orwkv[(size_t)(t0 + tt) * 512 + h * 64 + i] = (bf16_t)f2bf(o); }
}
__device__ __forceinline__ void phase_rwkv_naive(const Ctx& c, const Args& a, int layer, const bf16_t* proj, bf16_t* orwkv) {
    if (c.bid >= 8) return;
    const int h = c.bid; const RwkvLds s = rwkv_lds(c.lds);
    float S[64];
#pragma unroll
    for (int j = 0; j < 64; ++j) S[j] = 0.f;
    for (int ch = 0; ch < T / 64; ++ch) {
        rwkv_prep<false>(c, a, layer, proj, ch * 64, h, s);
        if (c.wave == 0) {
            const int i = c.lane;
            for (int tt = 0; tt < 64; ++tt) {
                float sa = 0.f;
#pragma unroll
                for (int j = 0; j < 64; ++j) { sa += S[j] * s.A[tt * RL + j]; if ((j & 7) == 7) __builtin_amdgcn_sched_barrier(0); }
                const float vi = s.V[tt * RL + i]; float y = 0.f;
#pragma unroll
                for (int j = 0; j < 64; ++j) { S[j] = S[j] * s.W[tt * RL + j] + sa * s.B[tt * RL + j] + vi * s.K[tt * RL + j]; y += S[j] * s.R[tt * RL + j]; if ((j & 3) == 3) __builtin_amdgcn_sched_barrier(0); }
                s.TMP[tt * RL + i] = y;
            }
        }
        __syncthreads();
        rwkv_post(c, a, layer, ch * 64, h, s, s.TMP, orwkv);
        __syncthreads();
    }
}


__device__ __forceinline__ int kperm32(int jl) { return 8 * ((jl >> 2) & 3) + 4 * (jl >> 4) + (jl & 3); }
__device__ __forceinline__ f32x4 tile_mma64(const LAS unsigned char* A, const LAS unsigned char* B, int a, int b, int lane, f32x4 acc) {
    const int m = lane & 15, q = lane >> 4;
#pragma unroll
    for (int ks = 0; ks < 2; ++ks) {
        const bf16x8 af = *(const LAS bf16x8*)(A + (16 * a + m) * 144 + (32 * ks + 8 * q) * 2);
        const bf16x8 bf = *(const LAS bf16x8*)(B + (16 * b + m) * 144 + (32 * ks + 8 * q) * 2);
        acc = __builtin_amdgcn_mfma_f32_16x16x32_bf16(af, bf, acc, 0, 0, 0);
    }
    return acc;
}
__device__ __forceinline__ void lds_st_bf16(LAS unsigned char* base, int idx, float v) { *(LAS bf16_t*)(base + idx * 2) = (bf16_t)f2bf(v); }

__device__ __forceinline__ void phase_lora_a(const Ctx& c, const Args& a, int layer, const bf16_t* proj, bf16_t* alora) {
    const float* mu = inptr(c, I_MU) + (size_t)layer * 1792;
    const int sub = c.tid & 31, rloc = c.tid >> 5;
    for (int t = c.bid * 16 + rloc; t < T; t += c.G * 16) {
        const int col = PC_ZW + sub * 8; float cur[8], prv[8];
        unpack8(*(const u32x4*)(proj + (size_t)t * PLD + col), cur);
        if (t > 0) unpack8(*(const u32x4*)(proj + (size_t)(t - 1) * PLD + col), prv); else {
#pragma unroll
            for (int k = 0; k < 8; ++k) prv[k] = 0.f; }
        float o[8];
#pragma unroll
        for (int k = 0; k < 8; ++k) { const float v = cur[k] + (prv[k] - cur[k]) * mu[col + k]; o[k] = sub < 8 ? tanhf(v) : (sub < 16 ? v : sigmoidf_(v)); }
        u32x4 w; w.x = pk2(o[0], o[1]); w.y = pk2(o[2], o[3]); w.z = pk2(o[4], o[5]); w.w = pk2(o[6], o[7]);
        *(u32x4*)(alora + (size_t)t * 256 + sub * 8) = w;
    }
}

constexpr int RC_L = 0, RC_AL = 16640, RC_AAK = 0, RC_ARB = 9216, RC_ARK = 18432, RC_AAB = 33280, RC_P2T = 33280, RC_WC = 50688, RC_BS = 50944, RC_M = 52992;
constexpr int RC_AT = RC_M, RC_TINV = RC_M, RC_ATT = RC_M + 9216, RC_RT = RC_M + 2 * 9216, RC_BT = RC_M + 3 * 9216, RC_XT = RC_BT, RC_KT = RC_M + 4 * 9216, RC_P1T = RC_KT,
              RC_VT = RC_M + 5 * 9216, RC_BHT = RC_M + 6 * 9216, RC_KHT = RC_M + 7 * 9216;
constexpr int RC_XOFF = RC_M + 8 * 9216, RC_XTMP = RC_XOFF + 6144;
static_assert(RC_XTMP + 3 * 1088 <= LDS_MISC, "rwkv chunk LDS");

__device__ __forceinline__ void phase_rwkv_chunk(const Ctx& c, const Args& a, int layer, const bf16_t* proj, const bf16_t* wlb, const bf16_t* alb, bf16_t* rwu, float* bonusg) {
    LAS unsigned char* L = c.lds;
    LAS float* sL = (LAS float*)(L + RC_L); LAS float* sAL = (LAS float*)(L + RC_AL); LAS float* sAAB = (LAS float*)(L + RC_AAB);
    LAS float* sWC = (LAS float*)(L + RC_WC); LAS float* sBS = (LAS float*)(L + RC_BS);
    const float* mu = inptr(c, I_MU) + (size_t)layer * 1792;
    const int lane = c.lane, wave = c.wave, n = lane & 15, q = lane >> 4;
    for (int unit = c.bid; unit < 2048; unit += c.G) {
        const int ch = unit >> 3, h = unit & 7, t0 = ch * 64, j = lane;
        {
            const float w0 = inptr(c, I_W0)[layer * 512 + h * 64 + j], a0 = inptr(c, I_A0)[layer * 512 + h * 64 + j];
            bf16_t wraw[8], araw[8];
#pragma unroll
            for (int i = 0; i < 8; ++i) { const size_t gi = (size_t)(t0 + wave * 8 + i) * 512 + h * 64 + j; wraw[i] = wlb[gi]; araw[i] = alb[gi]; }
            float run = 0.f;
#pragma unroll
            for (int i = 0; i < 8; ++i) { const int tt = wave * 8 + i;
                const float wl = w0 + bf2f(wraw[i]); const float nx = -wl; const float sp = nx > 20.f ? nx : log1pf(__expf(nx)); const float ld = -__expf(-sp - 0.5f);
                run += ld; sL[tt * RL + j] = run; sAL[tt * RL + j] = sigmoidf_(a0 + bf2f(araw[i])); }
            sBS[wave * 64 + j] = run;
        }
        bf16_t rraw[9], kraw[9], vraw[9];
        {
#pragma unroll
            for (int i = 0; i < 9; ++i) { const int t = t0 + wave * 8 + i - 1; const bool ok = t >= 0; const size_t ro = (size_t)(ok ? t : 0) * PLD + h * 64 + j;
                rraw[i] = ok ? proj[ro + PC_R] : (bf16_t)0; kraw[i] = ok ? proj[ro + PC_K] : (bf16_t)0; vraw[i] = ok ? proj[ro + PC_V] : (bf16_t)0; }
        }
        __syncthreads();
        {
            float off = 0.f, tot = 0.f;
#pragma unroll
            for (int w2 = 0; w2 < 8; ++w2) { const float v = sBS[w2 * 64 + j]; tot += v; off += (w2 < wave) ? v : 0.f; }
            if (wave == 0) sWC[j] = __expf(tot);
            const float kkw = inptr(c, I_KK)[layer * 512 + h * 64 + j], kaw = inptr(c, I_KA)[layer * 512 + h * 64 + j], rk = inptr(c, I_RK)[layer * 512 + h * 64 + j];
            const float mur = mu[PC_R + h * 64 + j], muk = mu[PC_K + h * 64 + j], muv = mu[PC_V + h * 64 + j];
            float Lprev = off;
#pragma unroll
            for (int i = 0; i < 8; ++i) { const int tt = wave * 8 + i, t = t0 + tt;
                const float Lc = sL[tt * RL + j] + off, al = sAL[tt * RL + j];
                const float rc = bf2f(rraw[i + 1]), kc = bf2f(kraw[i + 1]), vc = bf2f(vraw[i + 1]);
                const float r = rc + (bf2f(rraw[i]) - rc) * mur, k = kc + (bf2f(kraw[i]) - kc) * muk, v = vc + (bf2f(vraw[i]) - vc) * muv;
                float kk = k * kkw; const float n2 = wave_sum(kk * kk); kk = kk / fmaxf(sqrtf(n2), 1e-12f);
                const float kp = k * (1.0f + (al - 1.0f) * kaw), av = -kk, bv = kk * al;
                const float eW = __expf(Lc), eWex = __expf(Lprev), eInv = __expf(-Lc), eC = __expf(tot - Lc);
                lds_st_bf16(L + RC_AT, tt * 72 + j, av * eWex); lds_st_bf16(L + RC_ATT, j * 72 + tt, av * eWex);
                lds_st_bf16(L + RC_RT, tt * 72 + j, r * eW); lds_st_bf16(L + RC_BT, tt * 72 + j, bv * eInv); lds_st_bf16(L + RC_KT, tt * 72 + j, kp * eInv);
                lds_st_bf16(L + RC_VT, j * 72 + tt, v); lds_st_bf16(L + RC_BHT, j * 72 + tt, bv * eC); lds_st_bf16(L + RC_KHT, j * 72 + tt, kp * eC);
                const float bon = wave_sum(r * kp * rk); if (lane == 0) bonusg[(size_t)t * 8 + h] = bon;
                Lprev = Lc; }
        }
        __syncthreads();
        for (int job = wave; job < 64; job += 8) {
            const int p = job >> 4, ta = (job >> 2) & 3, tb = job & 3;
            f32x4 acc = (f32x4){0.f, 0.f, 0.f, 0.f};
            if (ta >= tb) acc = tile_mma64(L + (p < 2 ? RC_AT : RC_RT), L + ((p & 1) ? RC_KT : RC_BT), ta, tb, lane, acc);
            LAS unsigned char* dst = L + (p == 1 ? RC_AAK : (p == 2 ? RC_ARB : RC_ARK));
#pragma unroll
            for (int r = 0; r < 4; ++r) { const int tt = 16 * ta + 4 * q + r, ss = 16 * tb + n; const bool keep = (p < 2) ? (ss < tt) : (ss <= tt); const float v = keep ? acc[r] : 0.f;
                if (p == 0) sAAB[tt * 68 + ss] = v; else lds_st_bf16(dst, tt * 72 + ss, v); }
        }
        __syncthreads();
        if (wave == 0) {
            const int blk = lane >> 4, cc = lane & 15; const LAS float* Ab = sAAB + (16 * blk) * 68 + 16 * blk; float xr[16];
#pragma unroll
            for (int tt = 0; tt < 16; ++tt) { float acc = (tt == cc) ? 1.f : 0.f;
#pragma unroll
                for (int ss = 0; ss < tt; ++ss) acc += Ab[tt * 68 + ss] * xr[ss];
                xr[tt] = acc; }
            asm volatile("s_waitcnt lgkmcnt(0)" ::: "memory");
#pragma unroll
            for (int tt = 0; tt < 16; ++tt) sAAB[(16 * blk + tt) * 68 + 16 * blk + cc] = xr[tt];
        } else {
            for (int job = wave - 1; job < 16; job += 7) { const int ta = job >> 2, tb = job & 3;
                const f32x4 acc = tile_mma64(L + RC_VT, L + RC_AAK, ta, tb, lane, (f32x4){0.f, 0.f, 0.f, 0.f});
#pragma unroll
                for (int r = 0; r < 4; ++r) lds_st_bf16(L + RC_XT, (16 * ta + 4 * q + r) * 72 + 16 * tb + n, acc[r]); }
        }
        __syncthreads();
        {
            LAS float* sXO = (LAS float*)(L + RC_XOFF); LAS float* sT = (LAS float*)(L + RC_XTMP) + wave * 272;
            const int rr = lane >> 2, c4 = (lane & 3) * 4;
#pragma unroll 1
            for (int lev = 1; lev <= 3; ++lev) {
                if (wave < 4 - lev) {
                    const int J = wave, I = wave + lev;
                    f32x4 tacc = (f32x4){0.f, 0.f, 0.f, 0.f};
                    for (int K = J; K < I; ++K) {
                        const LAS float* Ap = sAAB + (16 * I + rr) * 68 + 16 * K; const LAS float* Xp;
                        int xs;
                        if (K == J) { Xp = sAAB + (16 * J) * 68 + 16 * J + c4; xs = 68; }
                        else { const int d = K - J; const int bi = (d == 1) ? J : 3 + J; Xp = sXO + bi * 256 + c4; xs = 16; }
#pragma unroll
                        for (int k = 0; k < 16; ++k) { const float av = Ap[k]; const f32x4 xv = *(const LAS f32x4*)(Xp + k * xs); tacc += xv * av; }
                    }
                    *(LAS f32x4*)(sT + rr * 16 + c4) = tacc;
                    asm volatile("s_waitcnt lgkmcnt(0)" ::: "memory");
                    f32x4 xacc = (f32x4){0.f, 0.f, 0.f, 0.f};
                    const LAS float* Dp = sAAB + (16 * I + rr) * 68 + 16 * I;
#pragma unroll
                    for (int k = 0; k < 16; ++k) { const float dv = Dp[k]; const f32x4 tv = *(const LAS f32x4*)(sT + k * 16 + c4); xacc += tv * dv; }
                    const int bo = (lev == 1) ? J : (lev == 2 ? 3 + J : 5);
                    *(LAS f32x4*)(sXO + bo * 256 + rr * 16 + c4) = xacc;
                }
                __syncthreads();
            }
            for (int e = c.tid; e < 4096; e += 512) { const int tt = e >> 6, ss = e & 63, I = tt >> 4, J = ss >> 4; float v = 0.f;
                if (I == J) v = sAAB[tt * 68 + ss];
                else if (I > J) { const int d = I - J; const int bi = (d == 1) ? J : (d == 2 ? 3 + J : 5); v = sXO[bi * 256 + (tt & 15) * 16 + (ss & 15)]; }
                lds_st_bf16(L + RC_TINV, tt * 72 + ss, v); }
        }
        __syncthreads();
        for (int job = wave; job < 32; job += 8) { const int p = job >> 4, ta = (job >> 2) & 3, tb = job & 3;
            const f32x4 acc = tile_mma64(L + (p ? RC_XT : RC_ATT), L + RC_TINV, ta, tb, lane, (f32x4){0.f, 0.f, 0.f, 0.f});
#pragma unroll
            for (int r = 0; r < 4; ++r) lds_st_bf16(L + (p ? RC_P2T : RC_P1T), (16 * ta + 4 * q + r) * 72 + 16 * tb + n, acc[r]); }
        __syncthreads();
        bf16_t* ug = rwu + (size_t)unit * 16384;
        for (int job = wave; job < 64; job += 8) { const int p = job >> 4, ta = (job >> 2) & 3, tb = job & 3;
            f32x4 acc = (f32x4){0.f, 0.f, 0.f, 0.f};
            if (p == 0) { acc = tile_mma64(L + RC_ARB, L + RC_P1T, ta, tb, lane, acc);
#pragma unroll
                for (int r = 0; r < 4; ++r) { const int tt = 16 * ta + 4 * q + r, jj = 16 * tb + n; const float v = acc[r] + bf2f(*(const LAS bf16_t*)(L + RC_RT + (tt * 72 + jj) * 2));
                    ug[8192 + tt * 64 + (jj & 32) + kperm32(jj & 31)] = (bf16_t)f2bf(v); } }
            else if (p == 1) { acc = tile_mma64(L + RC_ARB, L + RC_P2T, ta, tb, lane, acc); acc = tile_mma64(L + RC_ARK, L + RC_VT, ta, tb, lane, acc);
                u32x2 w; w.x = pk2(acc[0], acc[1]); w.y = pk2(acc[2], acc[3]); *(u32x2*)(ug + 12288 + ((tb * 4 + ta) * 64 + lane) * 4) = w; }
            else if (p == 2) { acc = tile_mma64(L + RC_BHT, L + RC_P1T, ta, tb, lane, acc);
#pragma unroll
                for (int r = 0; r < 4; ++r) { const int jr = 16 * ta + 4 * q + r, jc = 16 * tb + n; const float v = acc[r] + (jr == jc ? sWC[jr] : 0.f);
                    ug[jr * 64 + (jc & 32) + kperm32(jc & 31)] = (bf16_t)f2bf(v); } }
            else { acc = tile_mma64(L + RC_BHT, L + RC_P2T, ta, tb, lane, acc); acc = tile_mma64(L + RC_KHT, L + RC_VT, ta, tb, lane, acc);
                u32x2 w; w.x = pk2(acc[0], acc[1]); w.y = pk2(acc[2], acc[3]); *(u32x2*)(ug + 4096 + ((tb * 4 + ta) * 64 + lane) * 4) = w; }
        }
        __syncthreads();
    }
}

#define RW_LOAD_SET(SET, UNIT) do { const bf16_t* ug_ = rwu + (size_t)(UNIT) * 16384; \
    _Pragma("unroll") for (int ta = 0; ta < 4; ++ta) { An[SET][ta][0] = *(const bf16x8*)(ug_ + (16 * ta + m) * 64 + 8 * q); An[SET][ta][1] = *(const bf16x8*)(ug_ + (16 * ta + m) * 64 + 32 + 8 * q); \
        Zn[SET][ta] = *(const u32x2*)(ug_ + 4096 + ((cq * 4 + ta) * 64 + lane) * 4); } } while (0)
template <int SM>
__device__ __forceinline__ void phase_rwkv_scan(const Ctx& c, const bf16_t* rwu, bf16_t* rws) {
    const int idx = c.bid; if (idx >= 32 || c.wave != 0) return;
    const int h = idx >> 2, cq = idx & 3, lane = c.lane, m = lane & 15, q = lane >> 4;
    bf16x8 Bhi[2], Blo[2];
#pragma unroll
    for (int s = 0; s < 2; ++s) { Bhi[s] = (bf16x8){0, 0, 0, 0, 0, 0, 0, 0}; Blo[s] = Bhi[s]; }
    bf16x8 An[4][4][2]; u32x2 Zn[4][4];
#pragma unroll
    for (int u = 0; u < 4; ++u) RW_LOAD_SET(u, u * 8 + h);
    if (SM == 1) {
        for (int ch = 0; ch < T / 64; ch += 8) {
#pragma unroll
            for (int uu = 0; uu < 8; ++uu) { const int u = uu & 3; const int unit = (ch + uu) * 8 + h;
                bf16_t* sg = rws + (size_t)unit * 4096 + cq * 1024 + lane * 8;
                *(bf16x8*)(sg) = Bhi[0]; *(bf16x8*)(sg + 512) = Bhi[1];
#pragma unroll
                for (int ta = 0; ta < 4; ++ta) { Bhi[0] = Bhi[0] ^ An[u][ta][0]; Bhi[1] = Bhi[1] ^ An[u][ta][1]; Bhi[0][0] ^= (short)Zn[u][ta].x; }
                RW_LOAD_SET(u, (ch + uu + 4 < T / 64) ? unit + 32 : unit); } }
        return;
    }
    for (int ch = 0; ch < T / 64; ch += 8) {
#pragma unroll
        for (int uu = 0; uu < 8; ++uu) {
            const int u = uu & 3;
            const int unit = (ch + uu) * 8 + h;
            bf16_t* sg = rws + (size_t)unit * 4096 + cq * 1024 + lane * 8;
            *(bf16x8*)(sg) = Bhi[0]; *(bf16x8*)(sg + 512) = Bhi[1];
            f32x4 acc[4];
#pragma unroll
            for (int ta = 0; ta < 4; ++ta) { const u32x2 z = Zn[u][ta];
                acc[ta] = (f32x4){__uint_as_float(z.x << 16), __uint_as_float(z.x & 0xffff0000u), __uint_as_float(z.y << 16), __uint_as_float(z.y & 0xffff0000u)};
#pragma unroll
                for (int s = 0; s < 2; ++s) { acc[ta] = __builtin_amdgcn_mfma_f32_16x16x32_bf16(An[u][ta][s], Bhi[s], acc[ta], 0, 0, 0); acc[ta] = __builtin_amdgcn_mfma_f32_16x16x32_bf16(An[u][ta][s], Blo[s], acc[ta], 0, 0, 0); } }
            if (SM == 0) RW_LOAD_SET(u, (ch + uu + 4 < T / 64) ? unit + 32 : unit);
#pragma unroll
            for (int s = 0; s < 2; ++s) { u32x4 hi, lo; float rem[8];
#pragma unroll
                for (int p = 0; p < 8; ++p) { const float v = acc[2 * s + (p >> 2)][p & 3]; const unsigned hb = f2bf(v); rem[p] = v - __uint_as_float(hb << 16); }
                hi.x = pk2(acc[2 * s][0], acc[2 * s][1]); hi.y = pk2(acc[2 * s][2], acc[2 * s][3]); hi.z = pk2(acc[2 * s + 1][0], acc[2 * s + 1][1]); hi.w = pk2(acc[2 * s + 1][2], acc[2 * s + 1][3]);
                lo.x = pk2(rem[0], rem[1]); lo.y = pk2(rem[2], rem[3]); lo.z = pk2(rem[4], rem[5]); lo.w = pk2(rem[6], rem[7]);
                Bhi[s] = __builtin_bit_cast(bf16x8, hi); Blo[s] = __builtin_bit_cast(bf16x8, lo); }
        }
    }
}
#undef RW_LOAD_SET

__device__ __forceinline__ void phase_rwkv_out(const Ctx& c, const Args& a, int layer, const bf16_t* proj, const bf16_t* rwu, const bf16_t* rws, const float* bonusg, bf16_t* orwkv) {
    const float* mu = inptr(c, I_MU) + (size_t)layer * 1792;
    const int lane = c.lane, m = lane & 15, q = lane >> 4;
    for (int unit = c.bid * 8 + c.wave; unit < 2048; unit += c.G * 8) {
        const int ch = unit >> 3, h = unit & 7, t0 = ch * 64; const bf16_t* ug = rwu + (size_t)unit * 16384; const bf16_t* sg = rws + (size_t)unit * 4096;
        bf16x8 Bf[4][2];
#pragma unroll
        for (int cq = 0; cq < 4; ++cq) { Bf[cq][0] = *(const bf16x8*)(sg + cq * 1024 + lane * 8); Bf[cq][1] = *(const bf16x8*)(sg + cq * 1024 + 512 + lane * 8); }
        float lnw[4], lnb[4];
#pragma unroll
        for (int cq = 0; cq < 4; ++cq) { lnw[cq] = inptr(c, I_LNW)[layer * 512 + h * 64 + 16 * cq + m]; lnb[cq] = inptr(c, I_LNB)[layer * 512 + h * 64 + 16 * cq + m]; }
#pragma unroll 1
        for (int ta = 0; ta < 4; ++ta) {
            const bf16x8 A0 = *(const bf16x8*)(ug + 8192 + (16 * ta + m) * 64 + 8 * q), A1 = *(const bf16x8*)(ug + 8192 + (16 * ta + m) * 64 + 32 + 8 * q);
            f32x4 y[4];
#pragma unroll
            for (int cq = 0; cq < 4; ++cq) { const u32x2 z = *(const u32x2*)(ug + 12288 + ((cq * 4 + ta) * 64 + lane) * 4);
                y[cq] = (f32x4){__uint_as_float(z.x << 16), __uint_as_float(z.x & 0xffff0000u), __uint_as_float(z.y << 16), __uint_as_float(z.y & 0xffff0000u)};
                y[cq] = __builtin_amdgcn_mfma_f32_16x16x32_bf16(A0, Bf[cq][0], y[cq], 0, 0, 0); y[cq] = __builtin_amdgcn_mfma_f32_16x16x32_bf16(A1, Bf[cq][1], y[cq], 0, 0, 0); }
#pragma unroll
            for (int r = 0; r < 4; ++r) { const int t = t0 + 16 * ta + 4 * q + r;
                float sm = y[0][r] + y[1][r] + y[2][r] + y[3][r];
                sm += __shfl_xor(sm, 1); sm += __shfl_xor(sm, 2); sm += __shfl_xor(sm, 4); sm += __shfl_xor(sm, 8);
                const float mean = sm * (1.0f / 64.0f); float d[4], vs = 0.f;
#pragma unroll
                for (int cq = 0; cq < 4; ++cq) { d[cq] = y[cq][r] - mean; vs += d[cq] * d[cq]; }
                vs += __shfl_xor(vs, 1); vs += __shfl_xor(vs, 2); vs += __shfl_xor(vs, 4); vs += __shfl_xor(vs, 8);
                const float rstd = rsqrtf(vs * (1.0f / 64.0f) + 64e-5f); const float bon = bonusg[(size_t)t * 8 + h];
#pragma unroll
                for (int cq = 0; cq < 4; ++cq) { const int col = h * 64 + 16 * cq + m; const float v = rwkv_mixed(proj, mu, t, PC_V + col);
                    bf16_t* op = orwkv + (size_t)t * 512 + col; const float g = bf2f(*op);
                    *op = (bf16_t)f2bf((d[cq] * rstd * lnw[cq] + lnb[cq] + bon * v) * g); } }
        }
    }
}


constexpr int AT_K = 0, AT_V = 9216, AT_SCORE = 18432  , AT_BIAS = 83968, AT_SELM = 100352, AT_LIST = 104448, AT_NLIST = 105472, AT_NEED = 105504;
__device__ __forceinline__ void vt_transpose(const Ctx& c, const bf16_t* proj, bf16_t* vt) {
    LAS bf16_t* tl = (LAS bf16_t*)c.lds;
    for (int it = c.bid; it < 3 * 2 * 256; it += c.G) {
        const int which = it / 512, g = (it >> 8) & 1, tt = it & 255;
        const int col = (which == 0 ? PC_VS : (which == 1 ? PC_VW : PC_SV)) + g * 64;
        { const int tok = c.tid >> 3, ch = c.tid & 7; const u32x4 w = *(const u32x4*)(proj + (size_t)(tt * 64 + tok) * PLD + col + ch * 8);
          *(LAS u32x4*)(tl + tok * 72 + ch * 8) = w; }
        __syncthreads();
        { const int d = c.tid >> 3, ch = c.tid & 7; unsigned short e[8];
#pragma unroll
          for (int k = 0; k < 8; ++k) e[k] = tl[(ch * 8 + k) * 72 + d];
          u32x4 w; w.x = e[0] | ((unsigned)e[1] << 16); w.y = e[2] | ((unsigned)e[3] << 16); w.z = e[4] | ((unsigned)e[5] << 16); w.w = e[6] | ((unsigned)e[7] << 16);
          *(u32x4*)(vt + ((size_t)(which * 2 + g) * 64 + d) * T + tt * 64 + ch * 8) = w; }
        __syncthreads();
    }
}

template <int MODE, int NQ>
__device__ __forceinline__ void phase_attn(const Ctx& c, const Args& a, int layer, const bf16_t* proj, const bf16_t* vtb, const bf16_t* kcb, const bf16_t* vctb,
                                           unsigned char* sel, float* nsaacc, bf16_t* oout) {
    LAS unsigned char* L = c.lds;
    LAS float* sscore = (LAS float*)(L + AT_SCORE);
    LAS float* biasd = (LAS float*)(L + AT_BIAS);
    LAS unsigned* selm = (LAS unsigned*)(L + AT_SELM);
    LAS int* list = (LAS int*)(L + AT_LIST);
    LAS int* nlist = (LAS int*)(L + AT_NLIST);
    LAS unsigned* need = (LAS unsigned*)(L + AT_NEED);
    const int lane = c.lane, wave = c.wave, n = lane & 15, q = lane >> 4, hr = n & 3;
    constexpr int TW = 4 * NQ, TB = 8 * TW, NU = T / TB, TS = (MODE == 3) ? 4 : 1;
    for (int unit = c.bid; unit < 2 * NU; unit += c.G) {
        const int g = unit / NU, t0 = (unit % NU) * TB, tw0 = t0 + wave * TW;
        __syncthreads();
        for (int e = c.tid; e < 4096; e += 512) { const int r = e >> 10, d = e & 1023; biasd[e] = inptr(c, I_REL)[t5_bucket(d) * 16 + (MODE == 0 ? 8 : 0) + g * 4 + r]; }
        if (MODE == 3) {
            for (int e = c.tid; e < 1024; e += 512) selm[e] = 0u;
            if (c.tid < 8) need[c.tid] = 0u;
            __syncthreads();
            if ((c.tid >> 2) < TB) { const int tok = c.tid >> 2, k4 = (c.tid & 3) * 4; const unsigned char* sp = sel + ((size_t)(t0 + tok) * 2 + g) * 16 + k4;
#pragma unroll
              for (int k = 0; k < 4; ++k) { const int j = sp[k]; atomicOr((unsigned*)&selm[tok * 8 + (j >> 5)], 1u << (j & 31)); atomicOr((unsigned*)&need[j >> 5], 1u << (j & 31)); } }
            __syncthreads();
            if (c.tid < 256) { const int j = c.tid; const unsigned wd = need[j >> 5];
                if ((wd >> (j & 31)) & 1u) { int pos = __popc(wd & ((1u << (j & 31)) - 1u)); for (int w2 = 0; w2 < (j >> 5); ++w2) pos += __popc(need[w2]); list[pos] = j; } }
            if (c.tid == 0) { int cnt = 0; for (int w2 = 0; w2 < 8; ++w2) cnt += __popc(need[w2]); nlist[0] = cnt; }
        }
        __syncthreads();
        int ntiles, tile_lo = 0;
        if (MODE == 0) { ntiles = 2 + TB / 64; tile_lo = t0 - 128; }
        else if (MODE == 1) { ntiles = 8 + TB / 64; tile_lo = t0 - 512; }
        else if (MODE == 2) { const int cmax = (t0 + TB - 1 - 31) >> 4; ntiles = cmax < 0 ? 0 : (cmax >> 6) + 1; }
        else ntiles = nlist[0];
        const bf16_t* Ksrc; size_t kstride; const bf16_t* Vsrc; size_t vstride; int qcol;
        if (MODE == 0) { Ksrc = proj + PC_SK + g * 64; kstride = PLD; Vsrc = vtb + (size_t)(4 + g) * 64 * T; vstride = T; qcol = PC_SQ + g * 256; }
        else if (MODE == 1) { Ksrc = proj + PC_KW + g * 64; kstride = PLD; Vsrc = vtb + (size_t)(2 + g) * 64 * T; vstride = T; qcol = PC_NQ + g * 256; }
        else if (MODE == 2) { Ksrc = kcb + (size_t)g * 1024 * 64; kstride = 64; Vsrc = vctb + (size_t)g * 64 * 1024; vstride = 1024; qcol = PC_NQ + g * 256; }
        else { Ksrc = proj + PC_KS + g * 64; kstride = PLD; Vsrc = vtb + (size_t)(0 + g) * 64 * T; vstride = T; qcol = PC_NQ + g * 256; }
        bf16x8 Bq[NQ][2];
#pragma unroll
        for (int qd = 0; qd < NQ; ++qd) { const bf16_t* qp = proj + (size_t)(tw0 + 4 * qd + (n >> 2)) * PLD + qcol + hr * 64 + 8 * q;
            Bq[qd][0] = *(const bf16x8*)qp; Bq[qd][1] = *(const bf16x8*)(qp + 32); }
        const float bfar = biasd[hr * 1024 + 1023];
        float mrun[NQ], lrun[NQ]; f32x4 O[NQ][4];
#pragma unroll
        for (int qd = 0; qd < NQ; ++qd) { mrun[qd] = -1e30f; lrun[qd] = 0.f;
#pragma unroll
            for (int dt = 0; dt < 4; ++dt) O[qd][dt] = (f32x4){0.f, 0.f, 0.f, 0.f}; }
        float carry3[NQ]; for (int i = 0; i < NQ; ++i) carry3[i] = 0.f;
        const int npass = (MODE == 2) ? 2 : 1;
        for (int pass = 0; pass < npass; ++pass) {
            const bool do_pv = (MODE != 2) || pass == 1;
            float linv[NQ];
            if (MODE == 2 && pass == 1) {
#pragma unroll
                for (int qd = 0; qd < NQ; ++qd) { float lt = lrun[qd]; lt += __shfl_xor(lt, 16); lt += __shfl_xor(lt, 32); linv[qd] = lt > 0.f ? 1.0f / lt : 0.f; }
            }
#define AT_TILEPOS(ti) ((MODE == 3) ? list[ti] * 64 : (MODE == 2 ? (ti) * 64 : tile_lo + (ti) * 64))
#define AT_ISSUE(rd) do { _Pragma("unroll") for (int i_ = 0; i_ < TS; ++i_) { const int ti_ = (rd) * TS + i_; p0n[i_] = ti_ < ntiles ? AT_TILEPOS(ti_) : -1; \
        if (p0n[i_] >= 0) { kreg[i_] = *(const u32x4*)(Ksrc + (size_t)(p0n[i_] + (c.tid >> 3)) * kstride + (c.tid & 7) * 8); \
            if (do_pv) vreg[i_] = *(const u32x4*)(Vsrc + (size_t)(c.tid >> 3) * vstride + p0n[i_] + (c.tid & 7) * 8); } } } while (0)
            u32x4 kreg[TS], vreg[TS]; int p0n[TS];
            const int nrounds = (ntiles + TS - 1) / TS;
            if (nrounds > 0) AT_ISSUE(0);
            for (int rd = 0; rd < nrounds; ++rd) {
                int p0s[TS];
#pragma unroll
                for (int i = 0; i < TS; ++i) p0s[i] = p0n[i];
                __syncthreads();
#pragma unroll
                for (int i = 0; i < TS; ++i) if (p0s[i] >= 0) { *(LAS u32x4*)(L + AT_K + i * 18432 + (c.tid >> 3) * 144 + (c.tid & 7) * 16) = kreg[i];
                    if (do_pv) *(LAS u32x4*)(L + AT_V + i * 18432 + (c.tid >> 3) * 144 + (c.tid & 7) * 16) = vreg[i]; }
                if (rd + 1 < nrounds) AT_ISSUE(rd + 1);
                __syncthreads();
#pragma unroll
              for (int ts = 0; ts < TS; ++ts) {
                const int p0 = p0s[ts]; const int LK = AT_K + ts * 18432, LV = AT_V + ts * 18432;
                if (p0 < 0) continue;
                if (MODE == 0) { if (p0 > tw0 + TW - 1 || p0 + 63 < tw0 - 127) continue; }
                if (MODE == 1) { if (p0 > tw0 + TW - 1 || p0 + 63 < tw0 - 511) continue; }
                if (MODE == 2) { if (16 * p0 + 31 > tw0 + TW - 1) continue; }
                if (MODE == 3) { if (p0 > tw0 + TW - 1) continue; }
                const bool far = (MODE == 2) ? (tw0 - (16 * (p0 + 63) + 31) >= 790) : ((MODE == 3) ? (tw0 - (p0 + 63) >= 790) : false);
                const int jblk = p0 >> 6;
#pragma unroll
                for (int qd = 0; qd < NQ; ++qd) {
                    const int tq = tw0 + 4 * qd + (n >> 2);
                    bool colsel = true;
                    if (MODE == 3) { colsel = (selm[(wave * TW + 4 * qd + (n >> 2)) * 8 + (jblk >> 5)] >> (jblk & 31)) & 1u; if (__ballot(colsel) == 0ull) continue; }
#pragma unroll
                    for (int st = 0; st < 2; ++st) {
                        f32x4 sc[2];
#pragma unroll
                        for (int kt = 0; kt < 2; ++kt) { sc[kt] = (f32x4){0.f, 0.f, 0.f, 0.f};
#pragma unroll
                            for (int ks = 0; ks < 2; ++ks) { const bf16x8 ak = *(const LAS bf16x8*)(L + LK + (32 * st + 16 * kt + n) * 144 + (32 * ks + 8 * q) * 2);
                                sc[kt] = __builtin_amdgcn_mfma_f32_16x16x32_bf16(ak, Bq[qd][ks], sc[kt], 0, 0, 0); } }
                        float mx = -1e30f;
                        if (far) {
#pragma unroll
                            for (int kt = 0; kt < 2; ++kt)
#pragma unroll
                                for (int r = 0; r < 4; ++r) { const float s2 = (MODE == 3 && !colsel) ? -1e30f : sc[kt][r] + bfar; sc[kt][r] = s2; mx = fmaxf(mx, s2); }
                        } else {
#pragma unroll
                        for (int kt = 0; kt < 2; ++kt)
#pragma unroll
                            for (int r = 0; r < 4; ++r) { const int kl = 32 * st + 16 * kt + 4 * q + r; int dist; bool v;
                                if (MODE == 2) { dist = tq - (16 * (p0 + kl) + 31); v = dist >= 0; }
                                else { dist = tq - (p0 + kl); v = dist >= 0; if (MODE == 0) v = v && dist < 128; if (MODE == 1) v = v && dist < 512; if (MODE == 3) v = v && colsel; }
                                const int di = dist < 0 ? 0 : (dist > 1023 ? 1023 : dist);
                                const float s2 = v ? sc[kt][r] + biasd[hr * 1024 + di] : -1e30f; sc[kt][r] = s2; mx = fmaxf(mx, s2); }
                        }
                        float p[2][4];
                        if (MODE == 2 && pass == 1) {
#pragma unroll
                            for (int kt = 0; kt < 2; ++kt)
#pragma unroll
                                for (int r = 0; r < 4; ++r) p[kt][r] = __expf(sc[kt][r] - mrun[qd]) * linv[qd];
                        } else {
                            mx = fmaxf(mx, __shfl_xor(mx, 16)); mx = fmaxf(mx, __shfl_xor(mx, 32));
                            const float mn = fmaxf(mrun[qd], mx), corr = __expf(mrun[qd] - mn); mrun[qd] = mn; float ps = 0.f;
                            const float mne = mn < -1e29f ? 0.f : mn;
#pragma unroll
                            for (int kt = 0; kt < 2; ++kt)
#pragma unroll
                                for (int r = 0; r < 4; ++r) { p[kt][r] = __expf(sc[kt][r] - mne); ps += p[kt][r]; }
                            lrun[qd] = lrun[qd] * corr + ps;
                            if (do_pv) {
#pragma unroll
                                for (int dt = 0; dt < 4; ++dt) O[qd][dt] = O[qd][dt] * corr; }
                        }
                        if (MODE == 2 && pass == 1) {
                            float i3prev = carry3[qd];
#pragma unroll
                            for (int kt = 0; kt < 2; ++kt) { float im[4];
#pragma unroll
                                for (int r = 0; r < 4; ++r) { float v = p[kt][r]; v += __shfl_xor(v, 1); v += __shfl_xor(v, 2); im[r] = v; }
                                const float same = __shfl(im[3], (lane + 48) & 63), prevt = __shfl(i3prev, (lane + 48) & 63);
                                const float pv3 = q > 0 ? same : prevt;
                                const int jg = (p0 + 32 * st + 16 * kt + 4 * q) >> 2;
                                if (hr == 0 && jg < 256) sscore[(tq - t0) * 256 + jg] = 2.0f * (im[0] + im[1] + im[2]) + im[3] + pv3;
                                i3prev = im[3]; }
                            carry3[qd] = i3prev;
                        }
                        if (do_pv) {
                            u32x4 pw; pw.x = pk2(p[0][0], p[0][1]); pw.y = pk2(p[0][2], p[0][3]); pw.z = pk2(p[1][0], p[1][1]); pw.w = pk2(p[1][2], p[1][3]);
                            const bf16x8 pf = __builtin_bit_cast(bf16x8, pw);
#pragma unroll
                            for (int dt = 0; dt < 4; ++dt) { const LAS unsigned char* vp = L + LV + (16 * dt + n) * 144 + (32 * st + 4 * q) * 2;
                                const u32x2 v0 = *(const LAS u32x2*)vp, v1 = *(const LAS u32x2*)(vp + 32); u32x4 vw; vw.x = v0.x; vw.y = v0.y; vw.z = v1.x; vw.w = v1.y;
                                O[qd][dt] = __builtin_amdgcn_mfma_f32_16x16x32_bf16(__builtin_bit_cast(bf16x8, vw), pf, O[qd][dt], 0, 0, 0); }
                        }
                        __builtin_amdgcn_sched_barrier(0);
                    }
                }
              }
            }
        }
#undef AT_ISSUE
#undef AT_TILEPOS
        if (MODE == 2) {
            __syncthreads();
#pragma unroll 1
            for (int tk = 0; tk < TW; ++tk) { const int t = tw0 + tk, cur = t >> 6; const LAS float* sp = sscore + (wave * TW + tk) * 256;
                float val[4];
#pragma unroll
                for (int jj = 0; jj < 4; ++jj) { const int j = lane + 64 * jj; float sc;
                    if (j == 0 || j == cur || j == cur - 1) sc = 1e4f; else if (j > cur) sc = -1.0f; else sc = sp[j];
                    val[jj] = sc; }
#pragma unroll 1
                for (int k = 0; k < 16; ++k) {
                    float bv = val[0]; int bi = lane;
#pragma unroll
                    for (int jj = 1; jj < 4; ++jj) if (val[jj] > bv) { bv = val[jj]; bi = lane + 64 * jj; }
#pragma unroll
                    for (int o = 32; o >= 1; o >>= 1) { const float ov = __shfl_xor(bv, o); const int oi = __shfl_xor(bi, o); if (ov > bv || (ov == bv && oi < bi)) { bv = ov; bi = oi; } }
#pragma unroll
                    for (int jj = 0; jj < 4; ++jj) if (bi == lane + 64 * jj) val[jj] = -3e38f;
                    if (lane == 0) sel[((size_t)t * 2 + g) * 16 + k] = (unsigned char)bi;
                } }
        }
#pragma unroll
        for (int qd = 0; qd < NQ; ++qd) {
            const int tq = tw0 + 4 * qd + (n >> 2), hh = g * 4 + hr;
            float scale;
            if (MODE == 2) scale = 1.0f;
            else { float lt = lrun[qd]; lt += __shfl_xor(lt, 16); lt += __shfl_xor(lt, 32);
                if (MODE == 0) { const float sink = inptr(c, I_SINK)[layer * 8 + hh]; const float mf = fmaxf(mrun[qd], sink), cr = __expf(mrun[qd] - mf); scale = cr / (lt * cr + __expf(sink - mf)); }
                else scale = lt > 0.f ? 1.0f / lt : 0.f; }
            if (MODE != 0) scale *= sigmoidf_(bf2f(proj[(size_t)tq * PLD + PC_GL + (MODE == 2 ? 0 : (MODE == 3 ? 8 : 16)) + hh]));
#pragma unroll
            for (int dt = 0; dt < 4; ++dt) { const f32x4 o = O[qd][dt] * scale; const int col = hh * 64 + 16 * dt + 4 * q;
                if (MODE == 0) { u32x2 w; w.x = pk2(o[0], o[1]); w.y = pk2(o[2], o[3]); *(u32x2*)(oout + (size_t)tq * 512 + col) = w; }
                else if (MODE == 2) *(f32x4*)(nsaacc + (size_t)tq * 512 + col) = o;
                else if (MODE == 1) { f32x4* ap = (f32x4*)(nsaacc + (size_t)tq * 512 + col); *ap = *ap + o; }
                else { const f32x4 t2 = *(const f32x4*)(nsaacc + (size_t)tq * 512 + col) + o; u32x2 w; w.x = pk2(t2[0], t2[1]); w.y = pk2(t2[2], t2[3]); *(u32x2*)(oout + (size_t)tq * 512 + col) = w; } }
        }
    }
}
__device__ __forceinline__ void phase_topk2(const Ctx& c, const float* scores, int* sel) {
    const int gw = c.bid * 8 + c.wave, NGW = c.G * 8;
    for (int item = gw; item < T * 2; item += NGW) {
        const int t = item >> 1, g = item & 1, cur = t >> 6;
        const float* sp = scores + ((size_t)g * T + t) * 256;
        float val[4];
#pragma unroll
        for (int jj = 0; jj < 4; ++jj) { const int j = c.lane + 64 * jj; float sc;
            if (j == 0 || j == cur || j == cur - 1) sc = 1e4f; else if (j > cur) sc = -1.0f; else sc = sp[j];
            val[jj] = sc; }
        for (int k = 0; k < 16; ++k) {
            float bv = val[0]; int bi = c.lane;
#pragma unroll
            for (int jj = 1; jj < 4; ++jj) if (val[jj] > bv) { bv = val[jj]; bi = c.lane + 64 * jj; }
#pragma unroll
            for (int o = 32; o >= 1; o >>= 1) { const float ov = __shfl_xor(bv, o); const int oi = __shfl_xor(bi, o); if (ov > bv || (ov == bv && oi < bi)) { bv = ov; bi = oi; } }
#pragma unroll
            for (int jj = 0; jj < 4; ++jj) if (bi == c.lane + 64 * jj) val[jj] = -3e38f;
            if (c.lane == 0) sel[(size_t)item * 16 + k] = bi;
        }
    }
}

#define wb ((bf16_t*)(ws + WS_WB))
#define xb ((bf16_t*)(ws + WS_XB))
#define rs ((float*)(ws + WS_RS))
#define kcb ((bf16_t*)(ws + WS_KCB))
#define vctb ((bf16_t*)(ws + WS_VCT))
#define vtb ((bf16_t*)(ws + WS_VT))
#define scores ((float*)(ws + WS_SCORES))
#define sel ((unsigned char*)(ws + WS_SEL))
#define ml ((float*)(ws + WS_ML))
#define hidb ((bf16_t*)(ws + WS_HID))
#define proj ((bf16_t*)(ws + WS_PROJ))
#define gates ((bf16_t*)(ws + WS_GATES))
#define merged ((bf16_t*)(ws + WS_MERGED))
#define tmpb ((bf16_t*)(ws + WS_TMPB))
#define alora ((bf16_t*)(ws + WS_ALORA))
#define rwu ((bf16_t*)(ws + WS_RWU))
#define rws ((bf16_t*)(ws + WS_RWS))
#define bonusg ((float*)(ws + WS_BONUS))
#define nsaacc ((float*)(ws + WS_NSAACC))
#define obuf ((bf16_t*)(ws + WS_O))
#define act ((bf16_t*)(ws + WS_ACT))
#define tmpf ((bf16_t*)(ws + WS_TMPF))
constexpr int PH_PER_BATCH = 9, PH_PER_LAYER = 1 + 2 * PH_PER_BATCH + 3, PH_TOTAL = 1 + DEPTH * PH_PER_LAYER;

__global__ void __launch_bounds__(512, 2) fwd_kernel(Args args) {
    extern __shared__ __attribute__((aligned(16))) unsigned char lds_raw[];
    Ctx c0; c0.lds = (LAS unsigned char*)lds_raw; c0.tid = threadIdx.x; c0.lane = c0.tid & 63; c0.wave = __builtin_amdgcn_readfirstlane(c0.tid >> 6); c0.G = gridDim.x; c0.bid = blockIdx.x; const Ctx& c = c0;
    unsigned char* ws = args.ws;
    volatile LAS unsigned* misc = (volatile LAS unsigned*)(c.lds + LDS_MISC);
    if (c.tid < 4) misc[c.tid] = 0u;
    if (c.tid < 30) { const unsigned long long pv = (unsigned long long)args.in[c.tid & 31]; misc[16 + 2 * c.tid] = (unsigned)pv; misc[17 + 2 * c.tid] = (unsigned)(pv >> 32); }
    __syncthreads();
    XcdBarrier bar; bar.bar = (unsigned*)(ws + WS_CTL); bar.x = 0; bar.st = misc;
    const int lo = args.lo, hi = args.hi;
    const bool multi = (hi - lo) > 1;
    if (multi) bar = xcd_barrier_post((unsigned*)(ws + WS_CTL), misc);
    int gp = 0;
#ifndef ONLY_PH
#define ONLY_PH -1
#endif
#ifndef PHMASK
#define PHMASK 0xffffff
#endif
#ifndef REPMASK
#define REPMASK 0
#endif
#define PHASE_BEGIN(id) if (gp >= lo && gp < hi) { for (int rep_ = 0; rep_ < (((REPMASK >> (id)) & 1) ? 2 : 1); ++rep_) { if (rep_) __syncthreads(); \
    Ctx pc = c0; asm volatile("" : "+v"(pc.tid), "+s"(pc.bid)); pc.lane = pc.tid & 63; pc.wave = __builtin_amdgcn_readfirstlane(pc.tid >> 6); const Ctx& c = pc;
#define PHASE_END   } if (gp + 1 < hi) xcd_barrier(bar); } ++gp;
#define RELAUNDER() do { asm volatile("" : "+v"(pc.tid), "+s"(pc.bid)); pc.lane = pc.tid & 63; pc.wave = __builtin_amdgcn_readfirstlane(pc.tid >> 6); } while (0)

    float* x = args.out;
    PHASE_BEGIN(0) phase_init(c, inptr(c, I_X), x, xb, rs); PHASE_END

    for (int layer = 0; layer < DEPTH; ++layer) {
        PHASE_BEGIN(1) phase_cvt(c, args, layer, wb); PHASE_END
        for (int b = 0; b < NBATCH; ++b) {
            const int row0 = b * T;
            PHASE_BEGIN(2) {
                pg8::Gemm g{xb + (size_t)row0 * D, wb + WB_WIN, D, D, D}; pg8::Sched S; S.init(T / 256, NIN / 256, c.G, c.bid, 1, (size_t)256 * D * 2, 0, (size_t)256 * D * 2, 0);
                pg8::EpiInProj E{proj, gates, rs + row0}; pg8::gemm_phase(c.lds, c.tid, g, S, E); } PHASE_END
            PHASE_BEGIN(16) {
                { pg8::Gemm g{proj, wb + WB_W1T, 16 * PLD, 2048, 2048, (unsigned)PLD * 2}; pg8::Sched S; S.init(16, 1, c.G, c.bid, 1, 0, 0, 0, 0); S.mode = 1;
                  pg8::EpiCmp1 E{hidb, (const float*)(wb + WB_BH)}; pg8::gemm_phase(c.lds, c.tid, g, S, E); }
                RELAUNDER();
                if (c.bid >= 16) { Ctx cv = c; cv.bid = c.bid - 16; cv.G = c.G - 16; phase_lora_a(cv, args, layer, proj, alora); vt_transpose(cv, proj, vtb); } } PHASE_END
            PHASE_BEGIN(17) {
                { pg8::Gemm g{alora, wb + WB_LORA, 256, 256, 256}; pg8::Sched S; S.init(T / 256, 6, c.G, c.bid, 1, (unsigned)256 * 256 * 2, 0, (unsigned)256 * 256 * 2, 0);
                  pg8::EpiLora E{obuf}; pg8::gemm_phase(c.lds, c.tid, g, S, E); }
                RELAUNDER();
                { pg8::Gemm g{hidb, wb + WB_W2T, 256, 256, 256}; pg8::Sched S; S.init(16, 1, c.G, (c.bid + 16) % c.G, 1, (unsigned)256 * 256 * 2, 0, 0, 0); S.mode = 2;
                  pg8::EpiCmp2 E{kcb, vctb}; pg8::gemm_phase(c.lds, c.tid, g, S, E); } } PHASE_END
            PHASE_BEGIN(18) {
                phase_rwkv_chunk(c, args, layer, proj, obuf + (size_t)T * 512, obuf + (size_t)2 * T * 512, rwu, bonusg);
                __syncthreads(); RELAUNDER();
                phase_attn<2, 2>(c, args, layer, proj, vtb, kcb, vctb, sel, nsaacc, obuf + (size_t)T * 512); } PHASE_END
            PHASE_BEGIN(19) {
                phase_rwkv_scan<0>(c, rwu, rws);
                RELAUNDER();
                if (c.bid >= 32) { Ctx cv = c; cv.bid = c.bid - 32; cv.G = c.G - 32;
                    phase_attn<1, 2>(cv, args, layer, proj, vtb, kcb, vctb, sel, nsaacc, obuf + (size_t)T * 512);
                    asm volatile("" : "+v"(cv.tid), "+s"(cv.bid)); cv.lane = cv.tid & 63; cv.wave = __builtin_amdgcn_readfirstlane(cv.tid >> 6);
                    phase_attn<0, 2>(cv, args, layer, proj, vtb, kcb, vctb, sel, nsaacc, obuf + (size_t)2 * T * 512); } } PHASE_END
            PHASE_BEGIN(9) {
                phase_rwkv_out(c, args, layer, proj, rwu, rws, bonusg, obuf);
                __syncthreads(); RELAUNDER();
                phase_attn<3, 2>(c, args, layer, proj, vtb, kcb, vctb, sel, nsaacc, obuf + (size_t)T * 512); } PHASE_END
            PHASE_BEGIN(10) {
                pg8::Gemm g{obuf, wb + WB_WBR, 512, 512, 512}; pg8::Sched S; S.init(T / 256, D / 256, c.G, c.bid, 3, (size_t)256 * 512 * 2, (size_t)T * 512 * 2, (size_t)256 * 512 * 2, (size_t)D * 512 * 2);
                pg8::EpiMerge E{gates, merged}; pg8::gemm_phase(c.lds, c.tid, g, S, E); } PHASE_END
            PHASE_BEGIN(11) {
                pg8::Gemm g{merged, wb + WB_WOUT, D, D, D}; pg8::Sched S; S.init(T / 256, D / 256, c.G, c.bid, 1, (size_t)256 * D * 2, 0, (size_t)256 * D * 2, 0);
                pg8::EpiStore E{tmpb, D}; pg8::gemm_phase(c.lds, c.tid, g, S, E); } PHASE_END
            PHASE_BEGIN(12) phase_norm_res(c, tmpb, inptr(c, I_NQM) + layer * D, x, xb, rs, row0, T); PHASE_END
        }
        PHASE_BEGIN(13) {
            pg8::Gemm g{xb, wb + WB_WGU, D, D, D}; pg8::Sched S; S.init(MROWS / 256, 2 * FFN / 256, c.G, c.bid, 1, (size_t)256 * D * 2, 0, (size_t)256 * D * 2, 0);
            pg8::EpiSwiGLU E{act, rs}; pg8::gemm_phase(c.lds, c.tid, g, S, E); } PHASE_END
        PHASE_BEGIN(14) {
            pg8::Gemm g{act, wb + WB_WDN, FFN, FFN, FFN}; pg8::Sched S; S.init(MROWS / 256, D / 256, c.G, c.bid, 1, (size_t)256 * FFN * 2, 0, (size_t)256 * FFN * 2, 0);
            pg8::EpiStore E{tmpf, D}; pg8::gemm_phase(c.lds, c.tid, g, S, E); } PHASE_END
        PHASE_BEGIN(15) phase_norm_res(c, tmpf, inptr(c, I_NQF) + layer * D, x, xb, rs, 0, MROWS); PHASE_END
    }
#undef PHASE_BEGIN
#undef PHASE_END
}

extern "C" void kernel_launch(void* const* d_in, const int* in_sizes, int n_in, void* d_out, int out_size, void* d_ws, size_t ws_size, hipStream_t stream) {
    static int grid = 0;
    if (grid == 0) {
        if (n_in != 30 || out_size != MROWS * D || ws_size < WS_END) { fprintf(stderr, "kernel_launch: unexpected shapes (n_in %d out %d ws %zu)\n", n_in, out_size, ws_size); grid = -1; return; }
        int dev = 0, cus = 0;
        if (hipGetDevice(&dev) != hipSuccess || hipDeviceGetAttribute(&cus, hipDeviceAttributeMultiprocessorCount, dev) != hipSuccess) { grid = -1; return; }
        if (hipFuncSetAttribute((const void*)fwd_kernel, hipFuncAttributeMaxDynamicSharedMemorySize, LDS_BYTES) != hipSuccess) { fprintf(stderr, "hipFuncSetAttribute failed\n"); grid = -1; return; }
        int per_cu = 0;
        if (hipOccupancyMaxActiveBlocksPerMultiprocessor(&per_cu, (const void*)fwd_kernel, 512, LDS_BYTES) != hipSuccess || per_cu < 1) { fprintf(stderr, "occupancy query: %d\n", per_cu); }
        (void)hipGetLastError();
        grid = cus;
    }
    if (grid < 0) return;
    (void)hipMemsetAsync((char*)d_ws + WS_CTL, 0, CTL_BYTES, stream);
    Args a{};
    for (int i = 0; i < 30; ++i) a.in[i] = (const float*)d_in[i];
    a.out = (float*)d_out; a.ws = (unsigned char*)d_ws;
#if MK_ONE_LAUNCH
    a.lo = 0; a.hi = PH_TOTAL;
    hipLaunchKernelGGL(fwd_kernel, dim3(grid), dim3(512), LDS_BYTES, stream, a);
#else
    for (int p = 0; p < PH_TOTAL; ++p) { a.lo = p; a.hi = p + 1; hipLaunchKernelGGL(fwd_kernel, dim3(grid), dim3(512), LDS_BYTES, stream, a); }
#endif
}
```

```cpp
#include <hip/hip_runtime.h>
#include <stdint.h>
#include <stdio.h>

#ifndef MK_ONE_LAUNCH
#define MK_ONE_LAUNCH 1
#endif

#define LAS __attribute__((address_space(3)))
typedef unsigned short bf16_t;
typedef short bf16x8 __attribute__((ext_vector_type(8)));
typedef float f32x4 __attribute__((ext_vector_type(4)));
typedef float f32x2 __attribute__((ext_vector_type(2)));
typedef unsigned u32x4 __attribute__((ext_vector_type(4)));
typedef unsigned u32x2 __attribute__((ext_vector_type(2)));

constexpr int D = 1024, NBATCH = 2, T = 16384, DEPTH = 4, MROWS = NBATCH * T;
constexpr int IN_COLS = 6936, FFN = 2816;
constexpr int PLD = 4096;
constexpr int PC_R = 0, PC_K = 512, PC_V = 1024, PC_ZW = 1536, PC_ZA = 1600, PC_ZG = 1664;
constexpr int PC_NQ = 1792, PC_KC = 2304, PC_VC = 2432, PC_KS = 2560, PC_VS = 2688, PC_KW = 2816, PC_VW = 2944, PC_GL = 3072;
constexpr int PC_SQ = 3328, PC_SK = 3840, PC_SV = 3968;
constexpr int NIN = 7168;
constexpr int NCMP = 1023;
constexpr float NORM_EPS = 1e-6f;

constexpr size_t MiB = 1u << 20;
constexpr size_t WS_CTL = 0, CTL_BYTES = 65536;
constexpr size_t WS_WB = 65536;
constexpr size_t WB_WIN = 0, WB_WBR = WB_WIN + (size_t)NIN * D, WB_WOUT = WB_WBR + (size_t)3 * D * 512, WB_WGU = WB_WOUT + (size_t)D * D,
                 WB_WDN = WB_WGU + (size_t)2 * FFN * D, WB_LORA = WB_WDN + (size_t)D * FFN, WB_W1T = WB_LORA + (size_t)1536 * 256, WB_W2T = WB_W1T + (size_t)2 * 256 * 2048,
                 WB_BH = WB_W2T + (size_t)2 * 256 * 256, WB_END = WB_BH + 1024;
static_assert(WS_WB + WB_END * 2 <= 38 * MiB + 786432, "weights");
constexpr size_t KiB = 1024;
constexpr size_t WS_XB = 38 * MiB + 768 * KiB;
constexpr size_t WS_RS = WS_XB + 64 * MiB;
constexpr size_t WS_BONUS = WS_RS + 128 * KiB;
constexpr size_t WS_KCB = WS_BONUS + 512 * KiB;
constexpr size_t WS_VCT = WS_KCB + 256 * KiB;
constexpr size_t WS_SEL = WS_VCT + 256 * KiB;
constexpr size_t WS_HID = WS_SEL + 1 * MiB;
constexpr size_t WS_ML = WS_HID;
static_assert(WS_HID + 2 * MiB <= 107 * MiB, "small region");
constexpr size_t WS_ALORA = 107 * MiB;
constexpr size_t WS_VT = 115 * MiB;
constexpr size_t WS_BIG = 127 * MiB;
constexpr size_t WS_PROJ = WS_BIG;
constexpr size_t WS_GATES = WS_PROJ + 128 * MiB;
constexpr size_t WS_RWKVS = WS_GATES + 96 * MiB;
constexpr size_t WS_RWU = WS_RWKVS;
constexpr size_t WS_RWS = WS_RWKVS + 64 * MiB;
constexpr size_t WS_SCORES = WS_RWKVS;
constexpr size_t WS_MERGED = WS_RWKVS;
constexpr size_t WS_TMPB = WS_RWKVS + 32 * MiB;
constexpr size_t WS_NSAACC = WS_RWKVS + 80 * MiB;
constexpr size_t WS_O = WS_NSAACC + 32 * MiB;
constexpr size_t WS_END = WS_O + 48 * MiB;
constexpr size_t WS_ACT = WS_BIG;
constexpr size_t WS_TMPF = WS_BIG + 176 * MiB;
static_assert(WS_END <= 512 * MiB, "workspace");
static_assert(WS_TMPF + 64 * MiB <= WS_NSAACC, "ffn overlay");

constexpr int LDS_BYTES = 147456;
constexpr int LDS_MISC = 131072 + 8192;

__device__ __forceinline__ float bf2f(unsigned v) { return __uint_as_float(v << 16); }
typedef __bf16 bf16n2 __attribute__((ext_vector_type(2)));
__device__ __forceinline__ unsigned pk2(float lo, float hi) { const f32x2 f = {lo, hi}; const bf16n2 v = __builtin_convertvector(f, bf16n2); return __builtin_bit_cast(unsigned, v); }
__device__ __forceinline__ unsigned f2bf(float f) { return pk2(f, 0.f) & 0xffffu; }
__device__ __forceinline__ void unpack8(const u32x4 w, float (&f)[8]) {
    f[0] = __uint_as_float(w.x << 16); f[1] = __uint_as_float(w.x & 0xffff0000u); f[2] = __uint_as_float(w.y << 16); f[3] = __uint_as_float(w.y & 0xffff0000u);
    f[4] = __uint_as_float(w.z << 16); f[5] = __uint_as_float(w.z & 0xffff0000u); f[6] = __uint_as_float(w.w << 16); f[7] = __uint_as_float(w.w & 0xffff0000u);
}
__device__ __forceinline__ float wave_sum(float v) {
#pragma unroll
    for (int o = 32; o >= 1; o >>= 1) v += __shfl_xor(v, o);
    return v;
}
__device__ __forceinline__ float dpp_xor1(float v) { return __int_as_float(__builtin_amdgcn_update_dpp(0, __float_as_int(v), 0xB1, 0xf, 0xf, false)); }
__device__ __forceinline__ float dpp_xor2(float v) { return __int_as_float(__builtin_amdgcn_update_dpp(0, __float_as_int(v), 0x4E, 0xf, 0xf, false)); }
__device__ __forceinline__ float sigmoidf_(float x) { return 1.0f / (1.0f + __expf(-x)); }
__device__ __forceinline__ int t5_bucket(int n) {
    if (n < 16) return n;
    int b = 16;
    b += (n >= 21); b += (n >= 27); b += (n >= 35); b += (n >= 46); b += (n >= 59); b += (n >= 77); b += (n >= 99); b += (n >= 128);
    b += (n >= 166); b += (n >= 216); b += (n >= 280); b += (n >= 363); b += (n >= 470); b += (n >= 609); b += (n >= 790);
    return b;
}

#define XB_TMO      128
#define XB_XCNT(j)  (256  + 64 * (j))
#define XB_XSUB(j)  (1280 + 64 * (j))
#define XB_XGEN(j)  (2304 + 64 * (j))
#define XB_TOP      3328
#define XB_TOPGEN   3392
#define XCD_BAR_WORDS 3456
#define XB_SPIN_CAP (1u << 22)
__device__ __forceinline__ unsigned xb_ld(unsigned* p)              { return __hip_atomic_load(p, __ATOMIC_RELAXED, __HIP_MEMORY_SCOPE_AGENT); }
__device__ __forceinline__ unsigned xb_add(unsigned* p, unsigned v) { return __hip_atomic_fetch_add(p, v, __ATOMIC_RELAXED, __HIP_MEMORY_SCOPE_AGENT); }
__device__ __forceinline__ unsigned xb_xcc_id() { return (unsigned)__builtin_amdgcn_s_getreg((3 << 11) | 20) & 0xFu; }
#define XB_SPIN(cond, bar) do { unsigned _sp = 0; while (cond) { __builtin_amdgcn_s_sleep(1); \
    if ((++_sp & 255u) == 0u) { if (xb_ld(&(bar)[XB_TMO])) break; if (_sp > XB_SPIN_CAP) { atomicAdd(&(bar)[XB_TMO], 1u); break; } } } } while (0)
struct XcdBarrier { unsigned* bar; unsigned x; volatile LAS unsigned* st; };
__device__ __forceinline__ XcdBarrier xcd_barrier_post(unsigned* bar, volatile LAS unsigned* st) {
    XcdBarrier b; b.bar = bar; b.x = xb_xcc_id(); b.st = st;
    if (threadIdx.x == 0) (void)xb_add(&bar[XB_XCNT(b.x)], 1u);
    return b;
}
__device__ __forceinline__ void xcd_barrier_complete(unsigned* bar, unsigned x, unsigned& nloc, unsigned& nx) {
    const unsigned G = gridDim.x * gridDim.y * gridDim.z;
    unsigned sum, cnt, mine, sp = 0u;
    for (;;) {
        sum = 0u; cnt = 0u; mine = 0u;
#pragma unroll
        for (unsigned j = 0; j < 16; ++j) { const unsigned c = xb_ld(&bar[XB_XCNT(j)]); sum += c; cnt += (c > 0u) ? 1u : 0u; mine = (j == x) ? c : mine; }
        if (sum == G) break;
        __builtin_amdgcn_s_sleep(1);
        if ((++sp & 255u) == 0u) { if (xb_ld(&bar[XB_TMO])) break; if (sp > XB_SPIN_CAP) { atomicAdd(&bar[XB_TMO], 1u); break; } }
    }
    nloc = mine > 0u ? mine : 1u; nx = cnt > 0u ? cnt : 1u;
}
__device__ __forceinline__ void xcd_barrier(const XcdBarrier& b) {
    asm volatile("s_waitcnt vmcnt(0)" ::: "memory");
    __syncthreads();
    if (threadIdx.x == 0) {
        unsigned* bar = b.bar;
        __builtin_amdgcn_s_waitcnt(0);
        unsigned nloc = b.st[0], nx = b.st[1];
        if (nloc == 0u) { xcd_barrier_complete(bar, b.x, nloc, nx); b.st[0] = nloc; b.st[1] = nx; }
        const unsigned old = xb_add(&bar[XB_XSUB(b.x)], 1u);
        const unsigned gen = old / nloc;
        if (old + 1u == (gen + 1u) * nloc) {
            __builtin_amdgcn_fence(__ATOMIC_RELEASE, "agent");
            asm volatile("s_waitcnt vmcnt(0)" ::: "memory");
            const unsigned og = xb_add(&bar[XB_TOP], 1u);
            const unsigned tg = og / nx;
            if (og + 1u == (tg + 1u) * nx) xb_add(&bar[XB_TOPGEN], 1u);
            else XB_SPIN(xb_ld(&bar[XB_TOPGEN]) == tg, bar);
            __builtin_amdgcn_fence(__ATOMIC_ACQUIRE, "agent");
            xb_add(&bar[XB_XGEN(b.x)], 1u);
            asm volatile("s_waitcnt vmcnt(0)" ::: "memory");
        } else {
            XB_SPIN(xb_ld(&bar[XB_XGEN(b.x)]) == gen, bar);
            __builtin_amdgcn_fence(__ATOMIC_ACQUIRE, "agent");
            asm volatile("s_waitcnt vmcnt(0)" ::: "memory");
        }
    }
    __syncthreads();
}

namespace pg8 {
constexpr int BM = 256, BK = 64, HALF = 128, HTB = HALF * BK * 2, STAGE_BYTES = 8 * HTB, NXCD = 8, WGM = 8;
__device__ __forceinline__ int lds_byte(int r, int c) { const int st = (r >> 4) * 2 + (c >> 5), rr = r & 15, cc = c & 31, ob = rr * 64 + cc * 2; return st * 1024 + (ob ^ (((ob >> 9) & 1) << 5)); }
__device__ __forceinline__ void stage_rc(int b, int& R, int& C) { const int st = b / 1024, sb = b % 1024, swz = sb ^ (((sb >> 9) & 1) << 5); R = (st >> 1) * 16 + swz / 64; C = (st & 1) * 32 + (swz % 64) / 2; }
__device__ __forceinline__ int perm32(int rho) { const int n = rho >> 4, i = rho & 15; return 8 * (i >> 2) + 4 * n + (i & 3); }

struct Unit { int pm, pn, sub; unsigned aoff, boff; };
struct Gemm { const bf16_t* A; const bf16_t* Bt; int lda, ldb, K; unsigned kstepA = 128; };
struct Sched {
    int nM, nN, nwg, G, c, nsub, mode = 0; unsigned a_row, a_sub, b_row, b_sub;
    __device__ __forceinline__ void init(int nM_, int nN_, int G_, int c_, int nsub_, unsigned a_row_, unsigned a_sub_, unsigned b_row_, unsigned b_sub_) {
        nM = nM_; nN = nN_; nwg = nM * nN; G = G_; c = c_; nsub = nsub_; a_row = a_row_; a_sub = a_sub_; b_row = b_row_; b_sub = b_sub_; }
    __device__ __forceinline__ bool next(int i, Unit& u) const {
        const int round = i / nsub; u.sub = i - round * nsub;
        const long L = (long)round * G + c; if (L >= nwg) return false;
        int wgid = (int)L; { const int q = nwg / NXCD, r = nwg % NXCD, xcd = wgid % NXCD, off = wgid / NXCD; wgid = (xcd < r ? xcd * (q + 1) : r * (q + 1) + (xcd - r) * q) + off; }
        const int nig = WGM * nN, gid = wgid / nig, fm = gid * WGM, gsz = (nM - fm) < WGM ? (nM - fm) : WGM;
        u.pm = fm + ((wgid % nig) % gsz); u.pn = (wgid % nig) / gsz;
        u.aoff = (unsigned)u.pm * a_row + (unsigned)u.sub * a_sub; u.boff = (unsigned)u.pn * b_row + (unsigned)u.sub * b_sub;
        if (mode == 1) { const int kv = u.pm >> 3, g = (u.pm >> 2) & 1, cp = u.pm & 3;
            u.aoff = (unsigned)(((size_t)cp * 256 * 16 * PLD + (kv ? PC_VC : PC_KC) + g * 64) * 2); u.boff = (unsigned)kv * (256u * 2048u * 2u); }
        if (mode == 2) { const int kv = u.pm >> 3; u.boff = (unsigned)kv * (256u * 256u * 2u); }
        return true;
    }
};

template <class Epi>
__device__ __forceinline__ void gemm_phase(LAS unsigned char* lds, const int tid, const Gemm g, const Sched& S, const Epi& E) {
    const int wid = __builtin_amdgcn_readfirstlane(tid >> 6), lane = tid & 63, wr = wid >> 2, wc = wid & 3, fr = lane & 15, fq = lane >> 4;
    const int K = g.K, nt = K / BK;
    unsigned voffA[2], voffB[2];
#pragma unroll
    for (int i = 0; i < 2; ++i) { int R, C; stage_rc(tid * 16 + i * 8192, R, C); const int Rb = Epi::PERM ? ((R & ~31) + perm32(R & 31)) : R;
        voffA[i] = (unsigned)(R * g.lda + C) * 2u; voffB[i] = (unsigned)(Rb * g.ldb + C) * 2u; }
    const size_t kstep = (size_t)(BK * 2), kstA = g.kstepA;
    const size_t hstepA = (size_t)HALF * g.lda * 2, hstepB = (size_t)HALF * g.ldb * 2;
    const unsigned ldsw = (unsigned)wid * 1024u;
    const int aoff = lds_byte(wr * 64 + fr, fq * 8), boff = lds_byte(wc * 32 + fr, fq * 8);
#define PG8_SA(b, h) (((b) * 2 + (h)) * HTB)
#define PG8_SB(b, h) ((4 + (b) * 2 + (h)) * HTB)
#define PG8_STAGE(bufoff, gbase, voff) do { _Pragma("unroll") for (int _i = 0; _i < 2; ++_i) \
        __builtin_amdgcn_global_load_lds((const unsigned*)((const char*)(gbase) + (voff)[_i]), (LAS unsigned*)(lds + (bufoff) + ldsw + _i * 8192), 16, 0, 0); } while (0)
#define PG8_LDA(dst, b, h) do { _Pragma("unroll") for (int m = 0; m < 4; ++m) _Pragma("unroll") for (int k = 0; k < 2; ++k) dst[m][k] = *(const LAS bf16x8*)(lds + PG8_SA(b, h) + aoff + m * 2048 + k * 1024); } while (0)
#define PG8_LDB(dst, b, h) do { _Pragma("unroll") for (int n = 0; n < 2; ++n) _Pragma("unroll") for (int k = 0; k < 2; ++k) dst[n][k] = *(const LAS bf16x8*)(lds + PG8_SB(b, h) + boff + n * 2048 + k * 1024); } while (0)
#define PG8_MMA(ai, bj, At, Bt) do { __builtin_amdgcn_s_setprio(1); _Pragma("unroll") for (int m = 0; m < 4; ++m) _Pragma("unroll") for (int n = 0; n < 2; ++n) _Pragma("unroll") for (int k = 0; k < 2; ++k) \
        acc[ai][bj][m][n] = __builtin_amdgcn_mfma_f32_16x16x32_bf16(Bt[n][k], At[m][k], acc[ai][bj][m][n], 0, 0, 0); __builtin_amdgcn_s_setprio(0); } while (0)
#define PG8_WAIT_V(n) asm volatile("s_waitcnt vmcnt(" #n ")" ::: "memory")
#define PG8_WAIT_L(n) asm volatile("s_waitcnt lgkmcnt(" #n ")" ::: "memory")
#define PG8_BAR __builtin_amdgcn_s_barrier()
#define PG8_SCHED __builtin_amdgcn_sched_barrier(0)
    Unit cur, nxt; int ui = 0;
    if (!S.next(0, cur)) return;
    f32x4 acc[2][2][4][2];
#pragma unroll
    for (int a = 0; a < 2; ++a)
#pragma unroll
        for (int b = 0; b < 2; ++b)
#pragma unroll
            for (int m = 0; m < 4; ++m)
#pragma unroll
                for (int n = 0; n < 2; ++n) acc[a][b][m][n] = (f32x4){0.f, 0.f, 0.f, 0.f};
    bf16x8 At[4][2], B0[2][2], B1[2][2];
    const char* cA = (const char*)g.A + cur.aoff; const char* cB = (const char*)g.Bt + cur.boff;
    PG8_STAGE(PG8_SB(0, 0), cB, voffB); PG8_STAGE(PG8_SA(0, 0), cA, voffA); PG8_STAGE(PG8_SB(0, 1), cB + hstepB, voffB); PG8_STAGE(PG8_SA(0, 1), cA + hstepA, voffA);
    if (wr == 1) PG8_BAR;
    PG8_WAIT_V(4); PG8_BAR;
    PG8_STAGE(PG8_SB(1, 0), cB + kstep, voffB); PG8_STAGE(PG8_SA(1, 0), cA + kstA, voffA); PG8_STAGE(PG8_SB(1, 1), cB + hstepB + kstep, voffB);
    PG8_WAIT_V(6); PG8_BAR;
    for (;;) {
        const bool has_next = S.next(ui + 1, nxt);
        const char* nA = has_next ? (const char*)g.A + nxt.aoff : cA; const char* nB = has_next ? (const char*)g.Bt + nxt.boff : cB;
        for (int t = 0; t < nt; t += 2) {
            const bool last = (t == nt - 2);
            const char* a1 = cA + (size_t)(t + 1) * kstA;
            const char* a2 = last ? nA : cA + (size_t)(t + 2) * kstA; const char* b2 = last ? nB : cB + (size_t)(t + 2) * kstep;
            const char* a3 = a2 + kstA; const char* b3 = b2 + kstep;
            PG8_LDB(B0, 0, 0); PG8_SCHED; PG8_LDA(At, 0, 0); PG8_STAGE(PG8_SA(1, 1), a1 + hstepA, voffA);
            PG8_WAIT_L(8); PG8_BAR; PG8_WAIT_L(0); PG8_MMA(0, 0, At, B0); PG8_BAR; PG8_SCHED;
            PG8_LDB(B1, 0, 1); PG8_STAGE(PG8_SB(0, 0), b2, voffB);
            PG8_BAR; PG8_WAIT_L(0); PG8_MMA(0, 1, At, B1); PG8_BAR;
            PG8_LDA(At, 0, 1); PG8_STAGE(PG8_SA(0, 0), a2, voffA);
            PG8_BAR; PG8_WAIT_L(0); PG8_MMA(1, 0, At, B0); PG8_BAR; PG8_SCHED;
            PG8_STAGE(PG8_SB(0, 1), b2 + hstepB, voffB);
            PG8_WAIT_V(6); PG8_BAR; PG8_MMA(1, 1, At, B1); PG8_BAR;
            PG8_LDB(B0, 1, 0); PG8_SCHED; PG8_LDA(At, 1, 0); PG8_STAGE(PG8_SA(0, 1), a2 + hstepA, voffA);
            PG8_WAIT_L(8); PG8_BAR; PG8_WAIT_L(0); PG8_MMA(0, 0, At, B0); PG8_BAR; PG8_SCHED;
            PG8_LDB(B1, 1, 1); PG8_STAGE(PG8_SB(1, 0), b3, voffB);
            PG8_BAR; PG8_WAIT_L(0); PG8_MMA(0, 1, At, B1); PG8_BAR;
            PG8_LDA(At, 1, 1); PG8_STAGE(PG8_SA(1, 0), a3, voffA);
            PG8_BAR; PG8_WAIT_L(0); PG8_MMA(1, 0, At, B0); PG8_BAR; PG8_SCHED;
            PG8_STAGE(PG8_SB(1, 1), b3 + hstepB, voffB);
            PG8_WAIT_V(6); PG8_BAR; PG8_MMA(1, 1, At, B1); PG8_BAR;
        }
        const bool keep = E(acc, cur, wr, wc, fr, fq);
        if (!has_next) break;
        if (!keep) {
#pragma unroll
            for (int a = 0; a < 2; ++a)
#pragma unroll
                for (int b = 0; b < 2; ++b)
#pragma unroll
                    for (int m = 0; m < 4; ++m)
#pragma unroll
                        for (int n = 0; n < 2; ++n) acc[a][b][m][n] = (f32x4){0.f, 0.f, 0.f, 0.f};
        }
        cur = nxt; cA = nA; cB = nB; ++ui;
    }
    PG8_WAIT_V(0);
    if (wr == 0) PG8_BAR;
    PG8_BAR;
#undef PG8_SA
#undef PG8_SB
#undef PG8_STAGE
#undef PG8_LDA
#undef PG8_LDB
#undef PG8_MMA
#undef PG8_WAIT_V
#undef PG8_WAIT_L
#undef PG8_BAR
#undef PG8_SCHED
}

struct EpiInProj {
    static constexpr bool PERM = true;
    bf16_t* proj; bf16_t* gates; const float* rs;
    __device__ __forceinline__ bool operator()(f32x4 (&acc)[2][2][4][2], const Unit& u, int wr, int wc, int fr, int fq) const {
        const int row0 = u.pm * BM + wr * 64 + fr; const bool is_gate = u.pn >= 16;
        bf16_t* base = is_gate ? gates + (u.pn - 16) * 256 : proj + u.pn * 256; const int ld = is_gate ? 3072 : PLD;
        const int col0 = wc * 32 + 8 * fq;
#pragma unroll
        for (int ai = 0; ai < 2; ++ai)
#pragma unroll
            for (int m = 0; m < 4; ++m) { const int row = row0 + ai * HALF + m * 16; const float s = rs[row]; bf16_t* rowp = base + (size_t)row * ld + col0;
#pragma unroll
                for (int bj = 0; bj < 2; ++bj) { f32x4 v0 = acc[ai][bj][m][0] * s, v1 = acc[ai][bj][m][1] * s;
                    if (is_gate) {
#pragma unroll
                        for (int j = 0; j < 4; ++j) { v0[j] = sigmoidf_(v0[j]); v1[j] = sigmoidf_(v1[j]); } }
                    u32x4 w; w.x = pk2(v0[0], v0[1]); w.y = pk2(v0[2], v0[3]); w.z = pk2(v1[0], v1[1]); w.w = pk2(v1[2], v1[3]);
                    *(u32x4*)(rowp + bj * HALF) = w; } }
        return false;
    }
};
struct EpiStore {
    static constexpr bool PERM = true;
    bf16_t* out; int ld;
    __device__ __forceinline__ bool operator()(f32x4 (&acc)[2][2][4][2], const Unit& u, int wr, int wc, int fr, int fq) const {
        const int row0 = u.pm * BM + wr * 64 + fr; const int col0 = u.pn * BM + wc * 32 + 8 * fq;
#pragma unroll
        for (int ai = 0; ai < 2; ++ai)
#pragma unroll
            for (int m = 0; m < 4; ++m) { bf16_t* rowp = out + (size_t)(row0 + ai * HALF + m * 16) * ld + col0;
#pragma unroll
                for (int bj = 0; bj < 2; ++bj) { const f32x4 v0 = acc[ai][bj][m][0], v1 = acc[ai][bj][m][1];
                    u32x4 w; w.x = pk2(v0[0], v0[1]); w.y = pk2(v0[2], v0[3]); w.z = pk2(v1[0], v1[1]); w.w = pk2(v1[2], v1[3]);
                    *(u32x4*)(rowp + bj * HALF) = w; } }
        return false;
    }
};
struct EpiCmp1 {
    static constexpr bool PERM = true;
    bf16_t* hid; const float* bh;
    __device__ __forceinline__ bool operator()(f32x4 (&acc)[2][2][4][2], const Unit& u, int wr, int wc, int fr, int fq) const {
        const int kv = u.pm >> 3; const int row0 = (u.pm & 7) * BM + wr * 64 + fr; const int col0 = wc * 32 + 8 * fq;
#pragma unroll
        for (int ai = 0; ai < 2; ++ai)
#pragma unroll
            for (int m = 0; m < 4; ++m) { bf16_t* rowp = hid + ((size_t)kv * 2048 + row0 + ai * HALF + m * 16) * 256 + col0;
#pragma unroll
                for (int bj = 0; bj < 2; ++bj) { float o[8];
#pragma unroll
                    for (int j = 0; j < 8; ++j) { const float x = acc[ai][bj][m][j >> 2][j & 3] + bh[kv * 256 + col0 + bj * HALF + j];
                        o[j] = x * sigmoidf_(1.5957691216f * (x + 0.044715f * x * x * x)); }
                    u32x4 w; w.x = pk2(o[0], o[1]); w.y = pk2(o[2], o[3]); w.z = pk2(o[4], o[5]); w.w = pk2(o[6], o[7]);
                    *(u32x4*)(rowp + bj * HALF) = w; } }
        return false;
    }
};
struct EpiCmp2 {
    static constexpr bool PERM = true;
    bf16_t* kcb; bf16_t* vct;
    __device__ __forceinline__ bool operator()(f32x4 (&acc)[2][2][4][2], const Unit& u, int wr, int wc, int fr, int fq) const {
        const int kv = u.pm >> 3; const int row0 = (u.pm & 7) * BM + wr * 64 + fr; const int col0 = wc * 32 + 8 * fq;
        if (col0 >= 64) return false;
#pragma unroll
        for (int ai = 0; ai < 2; ++ai)
#pragma unroll
            for (int m = 0; m < 4; ++m) { const int row = row0 + ai * HALF + m * 16, g = row >> 10, cc = row & 1023; const bool zr = cc == 1023; const f32x4 zz = (f32x4){0.f, 0.f, 0.f, 0.f};
                const f32x4 v0 = zr ? zz : acc[ai][0][m][0], v1 = zr ? zz : acc[ai][0][m][1];
                if (kv == 0) { u32x4 w; w.x = pk2(v0[0], v0[1]); w.y = pk2(v0[2], v0[3]); w.z = pk2(v1[0], v1[1]); w.w = pk2(v1[2], v1[3]); *(u32x4*)(kcb + ((size_t)g * 1024 + cc) * 64 + col0) = w; }
                else {
#pragma unroll
                    for (int j = 0; j < 4; ++j) { vct[((size_t)g * 64 + col0 + j) * 1024 + cc] = (bf16_t)f2bf(v0[j]); vct[((size_t)g * 64 + col0 + 4 + j) * 1024 + cc] = (bf16_t)f2bf(v1[j]); } } }
        return false;
    }
};
struct EpiLora {
    static constexpr bool PERM = true;
    bf16_t* obuf;
    __device__ __forceinline__ bool operator()(f32x4 (&acc)[2][2][4][2], const Unit& u, int wr, int wc, int fr, int fq) const {
        const int sel = u.pn >> 1; bf16_t* out = obuf + (size_t)(sel == 2 ? 0 : sel + 1) * T * 512;
        const int row0 = u.pm * BM + wr * 64 + fr; const int col0 = (u.pn & 1) * BM + wc * 32 + 8 * fq;
#pragma unroll
        for (int ai = 0; ai < 2; ++ai)
#pragma unroll
            for (int m = 0; m < 4; ++m) { bf16_t* rowp = out + (size_t)(row0 + ai * HALF + m * 16) * 512 + col0;
#pragma unroll
                for (int bj = 0; bj < 2; ++bj) { const f32x4 v0 = acc[ai][bj][m][0], v1 = acc[ai][bj][m][1];
                    u32x4 w; w.x = pk2(v0[0], v0[1]); w.y = pk2(v0[2], v0[3]); w.z = pk2(v1[0], v1[1]); w.w = pk2(v1[2], v1[3]);
                    *(u32x4*)(rowp + bj * HALF) = w; } }
        return false;
    }
};
struct EpiMerge {
    static constexpr bool PERM = true;
    const bf16_t* gates; bf16_t* merged;
    __device__ __forceinline__ bool operator()(f32x4 (&acc)[2][2][4][2], const Unit& u, int wr, int wc, int fr, int fq) const {
        const int row0 = u.pm * BM + wr * 64 + fr; const int col0 = u.pn * BM + wc * 32 + 8 * fq; const int sub = u.sub;
#pragma unroll
        for (int ai = 0; ai < 2; ++ai)
#pragma unroll
            for (int m = 0; m < 4; ++m) { const int row = row0 + ai * HALF + m * 16; const bf16_t* gp = gates + (size_t)row * 3072 + sub * 1024 + col0;
#pragma unroll
                for (int bj = 0; bj < 2; ++bj) {
                    float sc[8], sn[8]; unpack8(*(const u32x4*)(gp + bj * HALF), sc);
                    if (sub < 2) { unpack8(*(const u32x4*)(gp + 1024 + bj * HALF), sn);
#pragma unroll
                        for (int j = 0; j < 8; ++j) sc[j] = sc[j] / fmaxf(sn[j], 1e-30f); }
                    f32x4 v0 = acc[ai][bj][m][0], v1 = acc[ai][bj][m][1];
#pragma unroll
                    for (int j = 0; j < 4; ++j) { v0[j] *= sc[j]; v1[j] *= sc[4 + j]; }
                    acc[ai][bj][m][0] = v0; acc[ai][bj][m][1] = v1;
                    if (sub == 2) { u32x4 w; w.x = pk2(v0[0], v0[1]); w.y = pk2(v0[2], v0[3]); w.z = pk2(v1[0], v1[1]); w.w = pk2(v1[2], v1[3]);
                        *(u32x4*)(merged + (size_t)row * D + col0 + bj * HALF) = w; } } }
        return sub != 2;
    }
};
struct EpiSwiGLU {
    static constexpr bool PERM = true;
    bf16_t* act; const float* rs;
    __device__ __forceinline__ bool operator()(f32x4 (&acc)[2][2][4][2], const Unit& u, int wr, int wc, int fr, int fq) const {
        const int row0 = u.pm * BM + wr * 64 + fr; const int col0 = u.pn * HALF + wc * 32 + 8 * fq;
#pragma unroll
        for (int ai = 0; ai < 2; ++ai)
#pragma unroll
            for (int m = 0; m < 4; ++m) { const int row = row0 + ai * HALF + m * 16; const float s = rs[row];
                float o[8];
#pragma unroll
                for (int n = 0; n < 2; ++n)
#pragma unroll
                    for (int j = 0; j < 4; ++j) { const float gg = acc[ai][0][m][n][j] * s, uu = acc[ai][1][m][n][j] * s; o[n * 4 + j] = gg * sigmoidf_(gg) * uu; }
                u32x4 w; w.x = pk2(o[0], o[1]); w.y = pk2(o[2], o[3]); w.z = pk2(o[4], o[5]); w.w = pk2(o[6], o[7]);
                *(u32x4*)(act + (size_t)row * FFN + col0) = w; }
        return false;
    }
};
}

struct Args { const float* in[30]; float* out; unsigned char* ws; int lo, hi; };
enum { I_X = 0, I_NPM, I_NQM, I_NPF, I_NQF, I_WIN, I_MU, I_W0, I_W2, I_A0, I_A2, I_G2, I_KK, I_KA, I_RK, I_LNW, I_LNB, I_PEK, I_PEV, I_CKW1, I_CKW2, I_CVW1, I_CVW2, I_SINK, I_REL, I_WBR, I_WOUT, I_FG, I_FU, I_FD };

struct Ctx { LAS unsigned char* lds; int tid, lane, wave, G, bid; };
__device__ __forceinline__ const float* inptr(const Ctx& c, int i) {
    const volatile LAS unsigned* t = (const volatile LAS unsigned*)(c.lds + LDS_MISC + 64) + 2 * i;
    const unsigned lo = __builtin_amdgcn_readfirstlane(t[0]), hi = __builtin_amdgcn_readfirstlane(t[1]);
    return (const float*)(((unsigned long long)hi << 32) | lo);
}

__device__ __forceinline__ void phase_init(const Ctx& c, const float* x, float* xo, bf16_t* xb, float* rs) {
    const int gw = c.bid * 8 + c.wave, NGW = c.G * 8;
    for (int row = gw; row < MROWS; row += NGW) {
        const float* xr = x + (size_t)row * D; float ss = 0.f;
#pragma unroll
        for (int j = 0; j < 2; ++j) { const int e = c.lane * 8 + 512 * j; const f32x4 a = *(const f32x4*)(xr + e), b = *(const f32x4*)(xr + e + 4);
            ss += a[0] * a[0] + a[1] * a[1] + a[2] * a[2] + a[3] * a[3] + b[0] * b[0] + b[1] * b[1] + b[2] * b[2] + b[3] * b[3];
            *(f32x4*)(xo + (size_t)row * D + e) = a; *(f32x4*)(xo + (size_t)row * D + e + 4) = b;
            u32x4 w; w.x = pk2(a[0], a[1]); w.y = pk2(a[2], a[3]); w.z = pk2(b[0], b[1]); w.w = pk2(b[2], b[3]); *(u32x4*)(xb + (size_t)row * D + e) = w; }
        ss = wave_sum(ss);
        if (c.lane == 0) rs[row] = rsqrtf(ss * (1.0f / D) + NORM_EPS);
    }
}
__device__ __forceinline__ void phase_norm_res(const Ctx& c, const bf16_t* y, const float* gain, float* x, bf16_t* xb, float* rs, int row0, int nrows) {
    const int gw = c.bid * 8 + c.wave, NGW = c.G * 8;
    for (int r = gw; r < nrows; r += NGW) {
        const int row = row0 + r; float yv[16]; float ss = 0.f;
#pragma unroll
        for (int j = 0; j < 2; ++j) { float f[8]; unpack8(*(const u32x4*)(y + (size_t)r * D + c.lane * 8 + 512 * j), f);
#pragma unroll
            for (int k = 0; k < 8; ++k) { yv[j * 8 + k] = f[k]; ss += f[k] * f[k]; } }
        ss = wave_sum(ss); const float sc = rsqrtf(ss * (1.0f / D) + NORM_EPS); float s2 = 0.f;
#pragma unroll
        for (int j = 0; j < 2; ++j) { const int e = c.lane * 8 + 512 * j; float* xr = x + (size_t)row * D + e;
            f32x4 a = *(const f32x4*)xr, b = *(const f32x4*)(xr + 4); const f32x4 ga = *(const f32x4*)(gain + e), gb = *(const f32x4*)(gain + e + 4);
#pragma unroll
            for (int k = 0; k < 4; ++k) { a[k] += yv[j * 8 + k] * sc * ga[k]; b[k] += yv[j * 8 + 4 + k] * sc * gb[k]; s2 += a[k] * a[k] + b[k] * b[k]; }
            *(f32x4*)xr = a; *(f32x4*)(xr + 4) = b;
            u32x4 w; w.x = pk2(a[0], a[1]); w.y = pk2(a[2], a[3]); w.z = pk2(b[0], b[1]); w.w = pk2(b[2], b[3]); *(u32x4*)(xb + (size_t)row * D + e) = w; }
        s2 = wave_sum(s2);
        if (c.lane == 0) rs[row] = rsqrtf(s2 * (1.0f / D) + NORM_EPS);
    }
}

__device__ __forceinline__ void phase_cvt(const Ctx& c, const Args& a, int layer, bf16_t* wb) {
    LAS float* tile = (LAS float*)c.lds;
    constexpr int I0 = 16 * 112, I1 = 3 * 8 * 16, I2 = 16 * 16, I3 = 16 * 88, I4 = 44 * 16, I5 = 4 * 24, I6 = 2 * 32 * 4, I7 = 2 * 4 * 4, NIT = I0 + I1 + I2 + I3 + I4 + I5 + I6 + I7;
    for (int it = c.bid; it < NIT; it += c.G) {
        int r = it, kind, sub = 0, K, nblk; bf16_t* dst;
        if (r < I0) { kind = 0; K = D; nblk = 112; dst = wb + WB_WIN; }
        else if ((r -= I0) < I1) { kind = 1; sub = r / 128; r -= sub * 128; K = 512; nblk = 16; dst = wb + WB_WBR + (size_t)sub * D * 512; }
        else if ((r -= I1) < I2) { kind = 2; K = D; nblk = 16; dst = wb + WB_WOUT; }
        else if ((r -= I2) < I3) { kind = 3; K = D; nblk = 88; dst = wb + WB_WGU; }
        else if ((r -= I3) < I4) { kind = 4; K = FFN; nblk = 16; dst = wb + WB_WDN; }
        else if ((r -= I4) < I5) { kind = 5; K = 256; nblk = 24; dst = wb + WB_LORA; }
        else if ((r -= I5) < I6) { kind = 6; sub = r / 128; r -= sub * 128; K = 2048; nblk = 4; dst = wb + WB_W1T + (size_t)sub * 256 * 2048; }
        else { r -= I6; kind = 7; sub = r / 16; r -= sub * 16; K = 256; nblk = 4; dst = wb + WB_W2T + (size_t)sub * 256 * 256; }
        const int kb = r / nblk, nb = r % nblk, k0 = kb * 64, n0 = nb * 64;
        const float* src = nullptr; int ld = 0, nvalid = 64; float extra = 1.f; const float* gain = nullptr; bool kvalid = true;
        switch (kind) {
        case 0: { gain = inptr(c, I_NPM) + layer * D + k0; ld = IN_COLS;
            const int scol = n0 < 3096 ? n0 : n0 - 232; nvalid = (n0 < 3096) ? (3096 - n0 < 64 ? 3096 - n0 : 64) : (n0 < 3328 ? 0 : 64);
            if ((n0 >= PC_NQ && n0 < PC_NQ + 512) || (n0 >= PC_SQ && n0 < PC_SQ + 512)) extra = 0.125f;
            src = inptr(c, I_WIN) + ((size_t)layer * D + k0) * IN_COLS + scol; break; }
        case 1: src = inptr(c, I_WBR) + (((size_t)layer * 3 + sub) * 512 + k0) * D + n0; ld = D; break;
        case 2: src = inptr(c, I_WOUT) + ((size_t)layer * D + k0) * D + n0; ld = D; break;
        case 3: { gain = inptr(c, I_NPF) + layer * D + k0; ld = FFN; const int pn = n0 >> 8, rr = n0 & 255;
            src = inptr(c, rr < 128 ? I_FG : I_FU) + ((size_t)layer * D + k0) * FFN + pn * 128 + (rr & 127); break; }
        case 4: src = inptr(c, I_FD) + ((size_t)layer * FFN + k0) * D + n0; ld = D; break;
        case 5: { ld = 512;
            if (n0 < 512) { kvalid = k0 < 64; src = inptr(c, I_W2) + ((size_t)layer * 64 + k0) * 512 + n0; }
            else if (n0 < 1024) { kvalid = (k0 == 64); src = inptr(c, I_A2) + ((size_t)layer * 64 + (k0 - 64)) * 512 + n0 - 512; }
            else { kvalid = k0 >= 128; src = inptr(c, I_G2) + ((size_t)layer * 128 + (k0 - 128)) * 512 + n0 - 1024; }
            break; }
        case 6: src = inptr(c, sub ? I_CVW1 : I_CKW1) + ((size_t)layer * 2048 + k0) * 256 + n0; ld = 256; break;
        default: src = inptr(c, sub ? I_CVW2 : I_CKW2) + ((size_t)layer * 256 + k0) * 64 + n0; ld = 64; nvalid = n0 < 64 ? 64 : 0; break;
        }
#pragma unroll
        for (int i = 0; i < 8; ++i) { const int e = c.tid + 512 * i, kk = e >> 6, nn = e & 63; float v = 0.f;
            if (kvalid && nn < nvalid) { v = src[(size_t)kk * ld + nn] * extra; if (gain) v *= gain[kk]; }
            tile[kk * 65 + nn] = v; }
        __syncthreads();
        { const int nn = c.tid >> 3, kc = (c.tid & 7) * 8; u32x4 w;
          w.x = pk2(tile[(kc + 0) * 65 + nn], tile[(kc + 1) * 65 + nn]); w.y = pk2(tile[(kc + 2) * 65 + nn], tile[(kc + 3) * 65 + nn]);
          w.z = pk2(tile[(kc + 4) * 65 + nn], tile[(kc + 5) * 65 + nn]); w.w = pk2(tile[(kc + 6) * 65 + nn], tile[(kc + 7) * 65 + nn]);
          *(u32x4*)(dst + (size_t)(n0 + nn) * K + k0 + kc) = w; }
        __syncthreads();
    }
    if (c.bid == c.G - 1) {
        const int kv = c.tid >> 8, u = c.tid & 255; const float* w1 = inptr(c, kv ? I_CVW1 : I_CKW1) + (size_t)layer * 2048 * 256; const float* pe = inptr(c, kv ? I_PEV : I_PEK) + (size_t)layer * 2048;
        float acc = 0.f; for (int k = 0; k < 2048; ++k) acc += pe[k] * w1[(size_t)k * 256 + u];
        ((float*)(wb + WB_BH))[c.tid] = acc;
    }
}

struct RowState { float q[64]; float o[64]; float m, l; };
__device__ __forceinline__ void row_init(RowState& s, const bf16_t* qp) {
#pragma unroll
    for (int i = 0; i < 8; ++i) { float f[8]; unpack8(*(const u32x4*)(qp + i * 8), f);
#pragma unroll
        for (int k = 0; k < 8; ++k) s.q[i * 8 + k] = f[k]; }
}
__device__ __forceinline__ void row_reset(RowState& s) {
#pragma unroll
    for (int i = 0; i < 64; ++i) s.o[i] = 0.f;
    s.m = -1e30f; s.l = 0.f;
}
__device__ __forceinline__ void row_key_bf16(RowState& s, const bf16_t* kp, const bf16_t* vp, float bias) {
    float sc = bias;
#pragma unroll
    for (int i = 0; i < 8; ++i) { float f[8]; unpack8(*(const u32x4*)(kp + i * 8), f);
#pragma unroll
        for (int k = 0; k < 8; ++k) sc += s.q[i * 8 + k] * f[k];
        if ((i & 1) == 1) __builtin_amdgcn_sched_barrier(0); }
    const float mn = fmaxf(s.m, sc), corr = __expf(s.m - mn), p = __expf(sc - mn);
    s.l = s.l * corr + p; s.m = mn;
#pragma unroll
    for (int i = 0; i < 8; ++i) { float f[8]; unpack8(*(const u32x4*)(vp + i * 8), f);
#pragma unroll
        for (int k = 0; k < 8; ++k) s.o[i * 8 + k] = s.o[i * 8 + k] * corr + p * f[k];
        if ((i & 1) == 1) __builtin_amdgcn_sched_barrier(0); }
}
__device__ __forceinline__ void row_key_f32(RowState& s, const float* kp, const float* vp, float bias) {
    float sc = bias;
#pragma unroll
    for (int i = 0; i < 16; ++i) { const f32x4 f = *(const f32x4*)(kp + i * 4); sc += s.q[i * 4] * f[0] + s.q[i * 4 + 1] * f[1] + s.q[i * 4 + 2] * f[2] + s.q[i * 4 + 3] * f[3];
        if ((i & 3) == 3) __builtin_amdgcn_sched_barrier(0); }
    const float mn = fmaxf(s.m, sc), corr = __expf(s.m - mn), p = __expf(sc - mn);
    s.l = s.l * corr + p; s.m = mn;
#pragma unroll
    for (int i = 0; i < 16; ++i) { const f32x4 f = *(const f32x4*)(vp + i * 4);
#pragma unroll
        for (int k = 0; k < 4; ++k) s.o[i * 4 + k] = s.o[i * 4 + k] * corr + p * f[k];
        if ((i & 3) == 3) __builtin_amdgcn_sched_barrier(0); }
}

__device__ __forceinline__ float gelu_tanh(float x) { const float t = tanhf(0.7978845608028654f * (x + 0.044715f * x * x * x)); return 0.5f * x * (1.0f + t); }
__device__ __forceinline__ void phase_cmp1(const Ctx& c, const Args& a, int layer, const bf16_t* proj, float* hid) {
    for (int unit = c.bid; unit < 2048; unit += c.G) {
        const int kv = unit >> 10, g = (unit >> 9) & 1, cp = unit & 511; const int cc = cp * 2 + (c.tid >> 8), u = c.tid & 255;
        if (cc >= NCMP) continue;
        const float* w1 = a.in[kv ? I_CVW1 : I_CKW1] + (size_t)layer * 2048 * 256; const float* pe = a.in[kv ? I_PEV : I_PEK] + (size_t)layer * 32 * 64;
        const bf16_t* xp = proj + (size_t)(16 * cc) * PLD + (kv ? PC_VC : PC_KC) + g * 64;
        float acc = 0.f;
        for (int l = 0; l < 32; ++l) {
#pragma unroll
            for (int i = 0; i < 8; ++i) { float f[8]; unpack8(*(const u32x4*)(xp + (size_t)l * PLD + i * 8), f);
#pragma unroll
                for (int k = 0; k < 8; ++k) acc += (f[k] + pe[l * 64 + i * 8 + k]) * w1[(size_t)(l * 64 + i * 8 + k) * 256 + u]; }
        }
        hid[(((size_t)kv * 2 + g) * 1024 + cc) * 256 + u] = gelu_tanh(acc);
    }
}
__device__ __forceinline__ void phase_cmp2(const Ctx& c, const Args& a, int layer, const float* hid, bf16_t* kcb, bf16_t* vctb) {
    for (int unit = c.bid; unit < 512; unit += c.G) {
        const int kv = unit >> 8, g = (unit >> 7) & 1, cc = (unit & 127) * 8 + (c.tid >> 6), d = c.tid & 63;
        float acc = 0.f;
        if (cc < NCMP) { const float* w2 = a.in[kv ? I_CVW2 : I_CKW2] + (size_t)layer * 256 * 64; const float* hp = hid + (((size_t)kv * 2 + g) * 1024 + cc) * 256;
            for (int u = 0; u < 256; ++u) acc += hp[u] * w2[u * 64 + d]; }
        if (kv) vctb[((size_t)g * 64 + d) * 1024 + cc] = (bf16_t)f2bf(acc); else kcb[((size_t)g * 1024 + cc) * 64 + d] = (bf16_t)f2bf(acc);
    }
}
__device__ __forceinline__ void phase_nsa13(const Ctx& c, const Args& a, const bf16_t* proj, const float* kcmp, const float* vcmp, float* nsaacc, float* ml) {
    LAS float* tb = (LAS float*)c.lds;
    for (int e = c.tid; e < 512; e += 512) tb[e] = inptr(c, I_REL)[e];
    __syncthreads();
    for (int unit = c.bid; unit < T / 64; unit += c.G) {
        const int hh = c.tid >> 6, t = unit * 64 + (c.tid & 63), g = hh >> 2;
        RowState s; row_init(s, proj + (size_t)t * PLD + PC_NQ + hh * 64);
        const bf16_t* glp = proj + (size_t)t * PLD + PC_GL;
        const float g0 = sigmoidf_(bf2f(glp[hh])), g2 = sigmoidf_(bf2f(glp[16 + hh]));
        row_reset(s);
        const int nv = t >= 31 ? (t - 31) / 16 + 1 : 0;
        for (int cc = 0; cc < nv; ++cc) { const float bias = tb[t5_bucket(t - 16 * cc - 31) * 16 + hh];
            row_key_f32(s, kcmp + ((size_t)g * 1024 + cc) * 64, vcmp + ((size_t)g * 1024 + cc) * 64, bias); }
        ml[((size_t)t * 8 + hh) * 2] = s.m; ml[((size_t)t * 8 + hh) * 2 + 1] = s.l;
        float* op = nsaacc + (size_t)t * 512 + hh * 64;
        { const float inv = s.l > 0.f ? g0 / s.l : 0.f;
#pragma unroll
            for (int i = 0; i < 16; ++i) { f32x4 w; w[0] = s.o[i * 4] * inv; w[1] = s.o[i * 4 + 1] * inv; w[2] = s.o[i * 4 + 2] * inv; w[3] = s.o[i * 4 + 3] * inv; *(f32x4*)(op + i * 4) = w; } }
        row_reset(s);
        const int s0 = t - 511 > 0 ? t - 511 : 0;
        for (int sp = s0; sp <= t; ++sp) { const float bias = tb[t5_bucket(t - sp) * 16 + hh];
            row_key_bf16(s, proj + (size_t)sp * PLD + PC_KW + g * 64, proj + (size_t)sp * PLD + PC_VW + g * 64, bias); }
        { const float inv = s.l > 0.f ? g2 / s.l : 0.f;
#pragma unroll
            for (int i = 0; i < 16; ++i) { f32x4 w = *(const f32x4*)(op + i * 4); w[0] += s.o[i * 4] * inv; w[1] += s.o[i * 4 + 1] * inv; w[2] += s.o[i * 4 + 2] * inv; w[3] += s.o[i * 4 + 3] * inv; *(f32x4*)(op + i * 4) = w; } }
    }
}
__device__ __forceinline__ void phase_nsa_topk(const Ctx& c, const Args& a, const bf16_t* proj, const float* kcmp, const float* ml, int* sel) {
    LAS float* tb = (LAS float*)c.lds;
    LAS float* qs = (LAS float*)(c.lds + 4096) + c.wave * 256;
    LAS float* sv = (LAS float*)(c.lds + 16384) + c.wave * 256;
    for (int e = c.tid; e < 512; e += 512) tb[e] = inptr(c, I_REL)[e];
    __syncthreads();
    const int gw = c.bid * 8 + c.wave, NGW = c.G * 8;
    for (int item = gw; item < T * 2; item += NGW) {
        const int t = item >> 1, g = item & 1, cur = t >> 6;
        { const bf16_t* qp = proj + (size_t)t * PLD + PC_NQ + g * 256 + c.lane * 4; const u32x2 w = *(const u32x2*)qp;
          qs[c.lane * 4] = __uint_as_float(w.x << 16); qs[c.lane * 4 + 1] = __uint_as_float(w.x & 0xffff0000u); qs[c.lane * 4 + 2] = __uint_as_float(w.y << 16); qs[c.lane * 4 + 3] = __uint_as_float(w.y & 0xffff0000u); }
        float mr[4], il[4];
#pragma unroll
        for (int r = 0; r < 4; ++r) { mr[r] = ml[((size_t)t * 8 + g * 4 + r) * 2]; const float l = ml[((size_t)t * 8 + g * 4 + r) * 2 + 1]; il[r] = l > 0.f ? 1.0f / l : 0.f; }
        const int nv = t >= 31 ? (t - 31) / 16 + 1 : 0;
        asm volatile("s_waitcnt lgkmcnt(0)" ::: "memory");
#pragma unroll 1
        for (int jj = 0; jj < 4; ++jj) {
            const int j = c.lane + 64 * jj; float sc;
            if (j == 0 || j == cur || j == cur - 1) sc = 1e4f;
            else if (j > cur) sc = -1.0f;
            else { sc = 0.f;
#pragma unroll 1
                for (int o = 0; o < 5; ++o) { const int cc = 4 * j + o - 1; if (cc < 0 || cc >= nv) continue;
                    const float* kp = kcmp + ((size_t)g * 1024 + cc) * 64; float d0 = 0.f, d1 = 0.f, d2 = 0.f, d3 = 0.f;
#pragma unroll 4
                    for (int i = 0; i < 16; ++i) { const f32x4 f = *(const f32x4*)(kp + i * 4);
#pragma unroll
                        for (int k = 0; k < 4; ++k) { d0 += qs[i * 4 + k] * f[k]; d1 += qs[64 + i * 4 + k] * f[k]; d2 += qs[128 + i * 4 + k] * f[k]; d3 += qs[192 + i * 4 + k] * f[k]; } }
                    const int bk = t5_bucket(t - 16 * cc - 31) * 16 + g * 4;
                    const float imp = __expf(d0 + tb[bk] - mr[0]) * il[0] + __expf(d1 + tb[bk + 1] - mr[1]) * il[1] + __expf(d2 + tb[bk + 2] - mr[2]) * il[2] + __expf(d3 + tb[bk + 3] - mr[3]) * il[3];
                    sc += ((o == 0 || o == 4) ? 1.0f : 2.0f) * imp; }
            }
            sv[j] = sc;
        }
        asm volatile("s_waitcnt lgkmcnt(0)" ::: "memory");
        float val[4];
#pragma unroll
        for (int jj = 0; jj < 4; ++jj) val[jj] = sv[c.lane + 64 * jj];
        for (int k = 0; k < 16; ++k) {
            float bv = val[0]; int bi = c.lane;
#pragma unroll
            for (int jj = 1; jj < 4; ++jj) if (val[jj] > bv) { bv = val[jj]; bi = c.lane + 64 * jj; }
#pragma unroll
            for (int o = 32; o >= 1; o >>= 1) { const float ov = __shfl_xor(bv, o); const int oi = __shfl_xor(bi, o); if (ov > bv || (ov == bv && oi < bi)) { bv = ov; bi = oi; } }
#pragma unroll
            for (int jj = 0; jj < 4; ++jj) if (bi == c.lane + 64 * jj) val[jj] = -3e38f;
            if (c.lane == 0) sel[(size_t)item * 16 + k] = bi;
        }
    }
}
__device__ __forceinline__ void phase_nsa2(const Ctx& c, const Args& a, const bf16_t* proj, const int* sel, const float* nsaacc, bf16_t* onsa) {
    LAS float* tb = (LAS float*)c.lds;
    for (int e = c.tid; e < 512; e += 512) tb[e] = inptr(c, I_REL)[e];
    __syncthreads();
    for (int unit = c.bid; unit < T / 64; unit += c.G) {
        const int hh = c.tid >> 6, t = unit * 64 + (c.tid & 63), g = hh >> 2;
        RowState s; row_init(s, proj + (size_t)t * PLD + PC_NQ + hh * 64); row_reset(s);
        const float g1 = sigmoidf_(bf2f(proj[(size_t)t * PLD + PC_GL + 8 + hh]));
        for (int k = 0; k < 16; ++k) { const int j = sel[((size_t)t * 2 + g) * 16 + k];
            for (int p = 0; p < 64; ++p) { const int pos = j * 64 + p; if (pos > t) break;
                const float bias = tb[t5_bucket(t - pos) * 16 + hh];
                row_key_bf16(s, proj + (size_t)pos * PLD + PC_KS + g * 64, proj + (size_t)pos * PLD + PC_VS + g * 64, bias); } }
        const float inv = s.l > 0.f ? g1 / s.l : 0.f; const float* ap = nsaacc + (size_t)t * 512 + hh * 64; bf16_t* op = onsa + (size_t)t * 512 + hh * 64;
#pragma unroll
        for (int i = 0; i < 8; ++i) { const f32x4 x0 = *(const f32x4*)(ap + i * 8), x1 = *(const f32x4*)(ap + i * 8 + 4); u32x4 w;
            w.x = pk2(x0[0] + s.o[i * 8] * inv, x0[1] + s.o[i * 8 + 1] * inv); w.y = pk2(x0[2] + s.o[i * 8 + 2] * inv, x0[3] + s.o[i * 8 + 3] * inv);
            w.z = pk2(x1[0] + s.o[i * 8 + 4] * inv, x1[1] + s.o[i * 8 + 5] * inv); w.w = pk2(x1[2] + s.o[i * 8 + 6] * inv, x1[3] + s.o[i * 8 + 7] * inv);
            *(u32x4*)(op + i * 8) = w; }
    }
}
__device__ __forceinline__ void phase_swa(const Ctx& c, const Args& a, int layer, const bf16_t* proj, bf16_t* oswa) {
    LAS float* tb = (LAS float*)c.lds;
    for (int e = c.tid; e < 512; e += 512) tb[e] = inptr(c, I_REL)[e];
    __syncthreads();
    for (int unit = c.bid; unit < T / 64; unit += c.G) {
        const int hh = c.tid >> 6, t = unit * 64 + (c.tid & 63), g = hh >> 2;
        RowState s; row_init(s, proj + (size_t)t * PLD + PC_SQ + hh * 64); row_reset(s);
        const int s0 = t - 127 > 0 ? t - 127 : 0;
        for (int sp = s0; sp <= t; ++sp) { const float bias = tb[t5_bucket(t - sp) * 16 + 8 + hh];
            row_key_bf16(s, proj + (size_t)sp * PLD + PC_SK + g * 64, proj + (size_t)sp * PLD + PC_SV + g * 64, bias); }
        const float sink = inptr(c, I_SINK)[layer * 8 + hh]; const float mf = fmaxf(s.m, sink); const float corr = __expf(s.m - mf);
        const float den = s.l * corr + __expf(sink - mf); const float inv = corr / den;
        bf16_t* op = oswa + (size_t)t * 512 + hh * 64;
#pragma unroll
        for (int i = 0; i < 8; ++i) { u32x4 w; w.x = pk2(s.o[i * 8] * inv, s.o[i * 8 + 1] * inv); w.y = pk2(s.o[i * 8 + 2] * inv, s.o[i * 8 + 3] * inv);
            w.z = pk2(s.o[i * 8 + 4] * inv, s.o[i * 8 + 5] * inv); w.w = pk2(s.o[i * 8 + 6] * inv, s.o[i * 8 + 7] * inv); *(u32x4*)(op + i * 8) = w; }
    }
}

constexpr int RL = 65;
__device__ __forceinline__ float rwkv_mixed(const bf16_t* proj, const float* mu, int t, int col) {
    const float cur = bf2f(proj[(size_t)t * PLD + col]); const float prev = t > 0 ? bf2f(proj[(size_t)(t - 1) * PLD + col]) : 0.f;
    return cur + (prev - cur) * mu[col];
}
__device__ __forceinline__ void lora64(const Ctx& c, const LAS float* in, const float* W, const float* bias, LAS float* out, bool accum) {
    const int j = c.tid & 63, tg = (c.tid >> 6) * 8;
    float acc[8];
#pragma unroll
    for (int i = 0; i < 8; ++i) acc[i] = accum ? out[(tg + i) * RL + j] : (bias ? bias[j] : 0.f);
#pragma unroll 4
    for (int m = 0; m < 64; ++m) { const float w = W[(size_t)m * 512 + j];
#pragma unroll
        for (int i = 0; i < 8; ++i) acc[i] += in[(tg + i) * RL + m] * w; }
#pragma unroll
    for (int i = 0; i < 8; ++i) out[(tg + i) * RL + j] = acc[i];
}
struct RwkvLds { LAS float *R, *K, *V, *A, *B, *W, *G, *TMP; };
__device__ __forceinline__ RwkvLds rwkv_lds(LAS unsigned char* lds) {
    RwkvLds s; LAS float* p = (LAS float*)lds; constexpr int SZ = 64 * RL;
    s.R = p; s.K = p + SZ; s.V = p + 2 * SZ; s.A = p + 3 * SZ; s.B = p + 4 * SZ; s.W = p + 5 * SZ; s.G = p + 6 * SZ; s.TMP = p + 7 * SZ; return s;
}
template <bool LOGDECAY>
__device__ __forceinline__ void rwkv_prep(const Ctx& c, const Args& a, int layer, const bf16_t* proj, int t0, int h, const RwkvLds& s) {
    const float* mu = inptr(c, I_MU) + (size_t)layer * 1792;
    const int j = c.tid & 63, tg = c.tid >> 6;
#pragma unroll 2
    for (int i = 0; i < 8; ++i) { const int tt = tg * 8 + i; s.TMP[tt * RL + j] = tanhf(rwkv_mixed(proj, mu, t0 + tt, PC_ZW + j)); }
    __syncthreads();
    lora64(c, s.TMP, inptr(c, I_W2) + (size_t)layer * 64 * 512 + h * 64, inptr(c, I_W0) + layer * 512 + h * 64, s.W, false);
    __syncthreads();
#pragma unroll 2
    for (int i = 0; i < 8; ++i) { const int tt = tg * 8 + i; s.TMP[tt * RL + j] = rwkv_mixed(proj, mu, t0 + tt, PC_ZA + j); }
    __syncthreads();
    lora64(c, s.TMP, inptr(c, I_A2) + (size_t)layer * 64 * 512 + h * 64, inptr(c, I_A0) + layer * 512 + h * 64, s.B, false);
    __syncthreads();
#pragma unroll 2
    for (int i = 0; i < 8; ++i) { const int tt = tg * 8 + i; s.TMP[tt * RL + j] = sigmoidf_(rwkv_mixed(proj, mu, t0 + tt, PC_ZG + j)); }
    __syncthreads();
    lora64(c, s.TMP, inptr(c, I_G2) + (size_t)layer * 128 * 512 + h * 64, nullptr, s.G, false);
    __syncthreads();
#pragma unroll 2
    for (int i = 0; i < 8; ++i) { const int tt = tg * 8 + i; s.TMP[tt * RL + j] = sigmoidf_(rwkv_mixed(proj, mu, t0 + tt, PC_ZG + 64 + j)); }
    __syncthreads();
    lora64(c, s.TMP, inptr(c, I_G2) + ((size_t)layer * 128 + 64) * 512 + h * 64, nullptr, s.G, true);
    const float kkw = inptr(c, I_KK)[layer * 512 + h * 64 + j], kaw = inptr(c, I_KA)[layer * 512 + h * 64 + j];
#pragma unroll 1
    for (int i = 0; i < 8; ++i) { const int tt = tg * 8 + i, t = t0 + tt;
        const float r = rwkv_mixed(proj, mu, t, PC_R + h * 64 + j), k = rwkv_mixed(proj, mu, t, PC_K + h * 64 + j), v = rwkv_mixed(proj, mu, t, PC_V + h * 64 + j);
        const float wl = s.W[tt * RL + j], al = sigmoidf_(s.B[tt * RL + j]);
        const float sp = (-wl > 20.f) ? -wl : log1pf(__expf(-wl)); const float w = -sp - 0.5f; const float ew = __expf(w);
        float kk = k * kkw; const float n2 = wave_sum(kk * kk); kk = kk / fmaxf(sqrtf(n2), 1e-12f);
        s.R[tt * RL + j] = r; s.V[tt * RL + j] = v; s.K[tt * RL + j] = k * (1.0f + (al - 1.0f) * kaw);
        s.A[tt * RL + j] = -kk; s.B[tt * RL + j] = kk * al; s.W[tt * RL + j] = LOGDECAY ? -ew : __expf(-ew); }
    __syncthreads();
}
__device__ __forceinline__ void rwkv_post(const Ctx& c, const Args& a, int layer, int t0, int h, const RwkvLds& s, const LAS float* Y, bf16_t* orwkv) {
    const int i = c.lane, tg = c.wave;
    const float lnw = inptr(c, I_LNW)[layer * 512 + h * 64 + i], lnb = inptr(c, I_LNB)[layer * 512 + h * 64 + i], rk = inptr(c, I_RK)[layer * 512 + h * 64 + i];
#pragma unroll 1
    for (int q = 0; q < 8; ++q) { const int tt = tg * 8 + q; const float y = Y[tt * RL + i];
        const float mean = wave_sum(y) * (1.0f / 64.0f); const float d = y - mean; const float var = wave_sum(d * d) * (1.0f / 64.0f);
        const float bonus = wave_sum(s.R[tt * RL + i] * s.K[tt * RL + i] * rk);
        const float o = (d * rsqrtf(var + 64e-5f) * lnw + lnb + bonus * s.V[tt * RL + i]) * s.G[tt * RL + i];
        orwkv[(size_t)(t0 + tt) * 512 + h * 64 + i] = (bf16_t)f2bf(o); }
}
__device__ __forceinline__ void phase_rwkv_naive(const Ctx& c, const Args& a, int layer, const bf16_t* proj, bf16_t* orwkv) {
    if (c.bid >= 8) return;
    const int h = c.bid; const RwkvLds s = rwkv_lds(c.lds);
    float S[64];
#pragma unroll
    for (int j = 0; j < 64; ++j) S[j] = 0.f;
    for (int ch = 0; ch < T / 64; ++ch) {
        rwkv_prep<false>(c, a, layer, proj, ch * 64, h, s);
        if (c.wave == 0) {
            const int i = c.lane;
            for (int tt = 0; tt < 64; ++tt) {
                float sa = 0.f;
#pragma unroll
                for (int j = 0; j < 64; ++j) { sa += S[j] * s.A[tt * RL + j]; if ((j & 7) == 7) __builtin_amdgcn_sched_barrier(0); }
                const float vi = s.V[tt * RL + i]; float y = 0.f;
#pragma unroll
                for (int j = 0; j < 64; ++j) { S[j] = S[j] * s.W[tt * RL + j] + sa * s.B[tt * RL + j] + vi * s.K[tt * RL + j]; y += S[j] * s.R[tt * RL + j]; if ((j & 3) == 3) __builtin_amdgcn_sched_barrier(0); }
                s.TMP[tt * RL + i] = y;
            }
        }
        __syncthreads();
        rwkv_post(c, a, layer, ch * 64, h, s, s.TMP, orwkv);
        __syncthreads();
    }
}


__device__ __forceinline__ int kperm32(int jl) { return 8 * ((jl >> 2) & 3) + 4 * (jl >> 4) + (jl & 3); }
__device__ __forceinline__ f32x4 tile_mma64(const LAS unsigned char* A, const LAS unsigned char* B, int a, int b, int lane, f32x4 acc) {
    const int m = lane & 15, q = lane >> 4;
#pragma unroll
    for (int ks = 0; ks < 2; ++ks) {
        const bf16x8 af = *(const LAS bf16x8*)(A + (16 * a + m) * 144 + (32 * ks + 8 * q) * 2);
        const bf16x8 bf = *(const LAS bf16x8*)(B + (16 * b + m) * 144 + (32 * ks + 8 * q) * 2);
        acc = __builtin_amdgcn_mfma_f32_16x16x32_bf16(af, bf, acc, 0, 0, 0);
    }
    return acc;
}
__device__ __forceinline__ void lds_st_bf16(LAS unsigned char* base, int idx, float v) { *(LAS bf16_t*)(base + idx * 2) = (bf16_t)f2bf(v); }

__device__ __forceinline__ void phase_lora_a(const Ctx& c, const Args& a, int layer, const bf16_t* proj, bf16_t* alora) {
    const float* mu = inptr(c, I_MU) + (size_t)layer * 1792;
    const int sub = c.tid & 31, rloc = c.tid >> 5;
    for (int t = c.bid * 16 + rloc; t < T; t += c.G * 16) {
        const int col = PC_ZW + sub * 8; float cur[8], prv[8];
        unpack8(*(const u32x4*)(proj + (size_t)t * PLD + col), cur);
        if (t > 0) unpack8(*(const u32x4*)(proj + (size_t)(t - 1) * PLD + col), prv); else {
#pragma unroll
            for (int k = 0; k < 8; ++k) prv[k] = 0.f; }
        float o[8];
#pragma unroll
        for (int k = 0; k < 8; ++k) { const float v = cur[k] + (prv[k] - cur[k]) * mu[col + k]; o[k] = sub < 8 ? tanhf(v) : (sub < 16 ? v : sigmoidf_(v)); }
        u32x4 w; w.x = pk2(o[0], o[1]); w.y = pk2(o[2], o[3]); w.z = pk2(o[4], o[5]); w.w = pk2(o[6], o[7]);
        *(u32x4*)(alora + (size_t)t * 256 + sub * 8) = w;
    }
}

constexpr int RC_L = 0, RC_AL = 16640, RC_AAK = 0, RC_ARB = 9216, RC_ARK = 18432, RC_AAB = 33280, RC_P2T = 33280, RC_WC = 50688, RC_BS = 50944, RC_M = 52992;
constexpr int RC_AT = RC_M, RC_TINV = RC_M, RC_ATT = RC_M + 9216, RC_RT = RC_M + 2 * 9216, RC_BT = RC_M + 3 * 9216, RC_XT = RC_BT, RC_KT = RC_M + 4 * 9216, RC_P1T = RC_KT,
              RC_VT = RC_M + 5 * 9216, RC_BHT = RC_M + 6 * 9216, RC_KHT = RC_M + 7 * 9216;
constexpr int RC_XOFF = RC_M + 8 * 9216, RC_XTMP = RC_XOFF + 6144;
static_assert(RC_XTMP + 3 * 1088 <= LDS_MISC, "rwkv chunk LDS");

__device__ __forceinline__ void phase_rwkv_chunk(const Ctx& c, const Args& a, int layer, const bf16_t* proj, const bf16_t* wlb, const bf16_t* alb, bf16_t* rwu, float* bonusg) {
    LAS unsigned char* L = c.lds;
    LAS float* sL = (LAS float*)(L + RC_L); LAS float* sAL = (LAS float*)(L + RC_AL); LAS float* sAAB = (LAS float*)(L + RC_AAB);
    LAS float* sWC = (LAS float*)(L + RC_WC); LAS float* sBS = (LAS float*)(L + RC_BS);
    const float* mu = inptr(c, I_MU) + (size_t)layer * 1792;
    const int lane = c.lane, wave = c.wave, n = lane & 15, q = lane >> 4;
    for (int unit = c.bid; unit < 2048; unit += c.G) {
        const int ch = unit >> 3, h = unit & 7, t0 = ch * 64, j = lane;
        {
            const float w0 = inptr(c, I_W0)[layer * 512 + h * 64 + j], a0 = inptr(c, I_A0)[layer * 512 + h * 64 + j];
            bf16_t wraw[8], araw[8];
#pragma unroll
            for (int i = 0; i < 8; ++i) { const size_t gi = (size_t)(t0 + wave * 8 + i) * 512 + h * 64 + j; wraw[i] = wlb[gi]; araw[i] = alb[gi]; }
            float run = 0.f;
#pragma unroll
            for (int i = 0; i < 8; ++i) { const int tt = wave * 8 + i;
                const float wl = w0 + bf2f(wraw[i]); const float nx = -wl; const float sp = nx > 20.f ? nx : log1pf(__expf(nx)); const float ld = -__expf(-sp - 0.5f);
                run += ld; sL[tt * RL + j] = run; sAL[tt * RL + j] = sigmoidf_(a0 + bf2f(araw[i])); }
            sBS[wave * 64 + j] = run;
        }
        bf16_t rraw[9], kraw[9], vraw[9];
        {
#pragma unroll
            for (int i = 0; i < 9; ++i) { const int t = t0 + wave * 8 + i - 1; const bool ok = t >= 0; const size_t ro = (size_t)(ok ? t : 0) * PLD + h * 64 + j;
                rraw[i] = ok ? proj[ro + PC_R] : (bf16_t)0; kraw[i] = ok ? proj[ro + PC_K] : (bf16_t)0; vraw[i] = ok ? proj[ro + PC_V] : (bf16_t)0; }
        }
        __syncthreads();
        {
            float off = 0.f, tot = 0.f;
#pragma unroll
            for (int w2 = 0; w2 < 8; ++w2) { const float v = sBS[w2 * 64 + j]; tot += v; off += (w2 < wave) ? v : 0.f; }
            if (wave == 0) sWC[j] = __expf(tot);
            const float kkw = inptr(c, I_KK)[layer * 512 + h * 64 + j], kaw = inptr(c, I_KA)[layer * 512 + h * 64 + j], rk = inptr(c, I_RK)[layer * 512 + h * 64 + j];
            const float mur = mu[PC_R + h * 64 + j], muk = mu[PC_K + h * 64 + j], muv = mu[PC_V + h * 64 + j];
            float Lprev = off;
#pragma unroll
            for (int i = 0; i < 8; ++i) { const int tt = wave * 8 + i, t = t0 + tt;
                const float Lc = sL[tt * RL + j] + off, al = sAL[tt * RL + j];
                const float rc = bf2f(rraw[i + 1]), kc = bf2f(kraw[i + 1]), vc = bf2f(vraw[i + 1]);
                const float r = rc + (bf2f(rraw[i]) - rc) * mur, k = kc + (bf2f(kraw[i]) - kc) * muk, v = vc + (bf2f(vraw[i]) - vc) * muv;
                float kk = k * kkw; const float n2 = wave_sum(kk * kk); kk = kk / fmaxf(sqrtf(n2), 1e-12f);
                const float kp = k * (1.0f + (al - 1.0f) * kaw), av = -kk, bv = kk * al;
                const float eW = __expf(Lc), eWex = __expf(Lprev), eInv = __expf(-Lc), eC = __expf(tot - Lc);
                lds_st_bf16(L + RC_AT, tt * 72 + j, av * eWex); lds_st_bf16(L + RC_ATT, j * 72 + tt, av * eWex);
                lds_st_bf16(L + RC_RT, tt * 72 + j, r * eW); lds_st_bf16(L + RC_BT, tt * 72 + j, bv * eInv); lds_st_bf16(L + RC_KT, tt * 72 + j, kp * eInv);
                lds_st_bf16(L + RC_VT, j * 72 + tt, v); lds_st_bf16(L + RC_BHT, j * 72 + tt, bv * eC); lds_st_bf16(L + RC_KHT, j * 72 + tt, kp * eC);
                const float bon = wave_sum(r * kp * rk); if (lane == 0) bonusg[(size_t)t * 8 + h] = bon;
                Lprev = Lc; }
        }
        __syncthreads();
        for (int job = wave; job < 64; job += 8) {
            const int p = job >> 4, ta = (job >> 2) & 3, tb = job & 3;
            f32x4 acc = (f32x4){0.f, 0.f, 0.f, 0.f};
            if (ta >= tb) acc = tile_mma64(L + (p < 2 ? RC_AT : RC_RT), L + ((p & 1) ? RC_KT : RC_BT), ta, tb, lane, acc);
            LAS unsigned char* dst = L + (p == 1 ? RC_AAK : (p == 2 ? RC_ARB : RC_ARK));
#pragma unroll
            for (int r = 0; r < 4; ++r) { const int tt = 16 * ta + 4 * q + r, ss = 16 * tb + n; const bool keep = (p < 2) ? (ss < tt) : (ss <= tt); const float v = keep ? acc[r] : 0.f;
                if (p == 0) sAAB[tt * 68 + ss] = v; else lds_st_bf16(dst, tt * 72 + ss, v); }
        }
        __syncthreads();
        if (wave == 0) {
            const int blk = lane >> 4, cc = lane & 15; const LAS float* Ab = sAAB + (16 * blk) * 68 + 16 * blk; float xr[16];
#pragma unroll
            for (int tt = 0; tt < 16; ++tt) { float acc = (tt == cc) ? 1.f : 0.f;
#pragma unroll
                for (int ss = 0; ss < tt; ++ss) acc += Ab[tt * 68 + ss] * xr[ss];
                xr[tt] = acc; }
            asm volatile("s_waitcnt lgkmcnt(0)" ::: "memory");
#pragma unroll
            for (int tt = 0; tt < 16; ++tt) sAAB[(16 * blk + tt) * 68 + 16 * blk + cc] = xr[tt];
        } else {
            for (int job = wave - 1; job < 16; job += 7) { const int ta = job >> 2, tb = job & 3;
                const f32x4 acc = tile_mma64(L + RC_VT, L + RC_AAK, ta, tb, lane, (f32x4){0.f, 0.f, 0.f, 0.f});
#pragma unroll
                for (int r = 0; r < 4; ++r) lds_st_bf16(L + RC_XT, (16 * ta + 4 * q + r) * 72 + 16 * tb + n, acc[r]); }
        }
        __syncthreads();
        {
            LAS float* sXO = (LAS float*)(L + RC_XOFF); LAS float* sT = (LAS float*)(L + RC_XTMP) + wave * 272;
            const int rr = lane >> 2, c4 = (lane & 3) * 4;
#pragma unroll 1
            for (int lev = 1; lev <= 3; ++lev) {
                if (wave < 4 - lev) {
                    const int J = wave, I = wave + lev;
                    f32x4 tacc = (f32x4){0.f, 0.f, 0.f, 0.f};
                    for (int K = J; K < I; ++K) {
                        const LAS float* Ap = sAAB + (16 * I + rr) * 68 + 16 * K; const LAS float* Xp;
                        int xs;
                        if (K == J) { Xp = sAAB + (16 * J) * 68 + 16 * J + c4; xs = 68; }
                        else { const int d = K - J; const int bi = (d == 1) ? J : 3 + J; Xp = sXO + bi * 256 + c4; xs = 16; }
#pragma unroll
                        for (int k = 0; k < 16; ++k) { const float av = Ap[k]; const f32x4 xv = *(const LAS f32x4*)(Xp + k * xs); tacc += xv * av; }
                    }
                    *(LAS f32x4*)(sT + rr * 16 + c4) = tacc;
                    asm volatile("s_waitcnt lgkmcnt(0)" ::: "memory");
                    f32x4 xacc = (f32x4){0.f, 0.f, 0.f, 0.f};
                    const LAS float* Dp = sAAB + (16 * I + rr) * 68 + 16 * I;
#pragma unroll
                    for (int k = 0; k < 16; ++k) { const float dv = Dp[k]; const f32x4 tv = *(const LAS f32x4*)(sT + k * 16 + c4); xacc += tv * dv; }
                    const int bo = (lev == 1) ? J : (lev == 2 ? 3 + J : 5);
                    *(LAS f32x4*)(sXO + bo * 256 + rr * 16 + c4) = xacc;
                }
                __syncthreads();
            }
            for (int e = c.tid; e < 4096; e += 512) { const int tt = e >> 6, ss = e & 63, I = tt >> 4, J = ss >> 4; float v = 0.f;
                if (I == J) v = sAAB[tt * 68 + ss];
                else if (I > J) { const int d = I - J; const int bi = (d == 1) ? J : (d == 2 ? 3 + J : 5); v = sXO[bi * 256 + (tt & 15) * 16 + (ss & 15)]; }
                lds_st_bf16(L + RC_TINV, tt * 72 + ss, v); }
        }
        __syncthreads();
        for (int job = wave; job < 32; job += 8) { const int p = job >> 4, ta = (job >> 2) & 3, tb = job & 3;
            const f32x4 acc = tile_mma64(L + (p ? RC_XT : RC_ATT), L + RC_TINV, ta, tb, lane, (f32x4){0.f, 0.f, 0.f, 0.f});
#pragma unroll
            for (int r = 0; r < 4; ++r) lds_st_bf16(L + (p ? RC_P2T : RC_P1T), (16 * ta + 4 * q + r) * 72 + 16 * tb + n, acc[r]); }
        __syncthreads();
        bf16_t* ug = rwu + (size_t)unit * 16384;
        for (int job = wave; job < 64; job += 8) { const int p = job >> 4, ta = (job >> 2) & 3, tb = job & 3;
            f32x4 acc = (f32x4){0.f, 0.f, 0.f, 0.f};
            if (p == 0) { acc = tile_mma64(L + RC_ARB, L + RC_P1T, ta, tb, lane, acc);
#pragma unroll
                for (int r = 0; r < 4; ++r) { const int tt = 16 * ta + 4 * q + r, jj = 16 * tb + n; const float v = acc[r] + bf2f(*(const LAS bf16_t*)(L + RC_RT + (tt * 72 + jj) * 2));
                    ug[8192 + tt * 64 + (jj & 32) + kperm32(jj & 31)] = (bf16_t)f2bf(v); } }
            else if (p == 1) { acc = tile_mma64(L + RC_ARB, L + RC_P2T, ta, tb, lane, acc); acc = tile_mma64(L + RC_ARK, L + RC_VT, ta, tb, lane, acc);
                u32x2 w; w.x = pk2(acc[0], acc[1]); w.y = pk2(acc[2], acc[3]); *(u32x2*)(ug + 12288 + ((tb * 4 + ta) * 64 + lane) * 4) = w; }
            else if (p == 2) { acc = tile_mma64(L + RC_BHT, L + RC_P1T, ta, tb, lane, acc);
#pragma unroll
                for (int r = 0; r < 4; ++r) { const int jr = 16 * ta + 4 * q + r, jc = 16 * tb + n; const float v = acc[r] + (jr == jc ? sWC[jr] : 0.f);
                    ug[jr * 64 + (jc & 32) + kperm32(jc & 31)] = (bf16_t)f2bf(v); } }
            else { acc = tile_mma64(L + RC_BHT, L + RC_P2T, ta, tb, lane, acc); acc = tile_mma64(L + RC_KHT, L + RC_VT, ta, tb, lane, acc);
                u32x2 w; w.x = pk2(acc[0], acc[1]); w.y = pk2(acc[2], acc[3]); *(u32x2*)(ug + 4096 + ((tb * 4 + ta) * 64 + lane) * 4) = w; }
        }
        __syncthreads();
    }
}

#define RW_LOAD_SET(SET, UNIT) do { const bf16_t* ug_ = rwu + (size_t)(UNIT) * 16384; \
    _Pragma("unroll") for (int ta = 0; ta < 4; ++ta) { An[SET][ta][0] = *(const bf16x8*)(ug_ + (16 * ta + m) * 64 + 8 * q); An[SET][ta][1] = *(const bf16x8*)(ug_ + (16 * ta + m) * 64 + 32 + 8 * q); \
        Zn[SET][ta] = *(const u32x2*)(ug_ + 4096 + ((cq * 4 + ta) * 64 + lane) * 4); } } while (0)
template <int SM>
__device__ __forceinline__ void phase_rwkv_scan(const Ctx& c, const bf16_t* rwu, bf16_t* rws) {
    const int idx = c.bid; if (idx >= 32 || c.wave != 0) return;
    const int h = idx >> 2, cq = idx & 3, lane = c.lane, m = lane & 15, q = lane >> 4;
    bf16x8 Bhi[2], Blo[2];
#pragma unroll
    for (int s = 0; s < 2; ++s) { Bhi[s] = (bf16x8){0, 0, 0, 0, 0, 0, 0, 0}; Blo[s] = Bhi[s]; }
    bf16x8 An[4][4][2]; u32x2 Zn[4][4];
#pragma unroll
    for (int u = 0; u < 4; ++u) RW_LOAD_SET(u, u * 8 + h);
    if (SM == 1) {
        for (int ch = 0; ch < T / 64; ch += 8) {
#pragma unroll
            for (int uu = 0; uu < 8; ++uu) { const int u = uu & 3; const int unit = (ch + uu) * 8 + h;
                bf16_t* sg = rws + (size_t)unit * 4096 + cq * 1024 + lane * 8;
                *(bf16x8*)(sg) = Bhi[0]; *(bf16x8*)(sg + 512) = Bhi[1];
#pragma unroll
                for (int ta = 0; ta < 4; ++ta) { Bhi[0] = Bhi[0] ^ An[u][ta][0]; Bhi[1] = Bhi[1] ^ An[u][ta][1]; Bhi[0][0] ^= (short)Zn[u][ta].x; }
                RW_LOAD_SET(u, (ch + uu + 4 < T / 64) ? unit + 32 : unit); } }
        return;
    }
    for (int ch = 0; ch < T / 64; ch += 8) {
#pragma unroll
        for (int uu = 0; uu < 8; ++uu) {
            const int u = uu & 3;
            const int unit = (ch + uu) * 8 + h;
            bf16_t* sg = rws + (size_t)unit * 4096 + cq * 1024 + lane * 8;
            *(bf16x8*)(sg) = Bhi[0]; *(bf16x8*)(sg + 512) = Bhi[1];
            f32x4 acc[4];
#pragma unroll
            for (int ta = 0; ta < 4; ++ta) { const u32x2 z = Zn[u][ta];
                acc[ta] = (f32x4){__uint_as_float(z.x << 16), __uint_as_float(z.x & 0xffff0000u), __uint_as_float(z.y << 16), __uint_as_float(z.y & 0xffff0000u)};
#pragma unroll
                for (int s = 0; s < 2; ++s) { acc[ta] = __builtin_amdgcn_mfma_f32_16x16x32_bf16(An[u][ta][s], Bhi[s], acc[ta], 0, 0, 0); acc[ta] = __builtin_amdgcn_mfma_f32_16x16x32_bf16(An[u][ta][s], Blo[s], acc[ta], 0, 0, 0); } }
            if (SM == 0) RW_LOAD_SET(u, (ch + uu + 4 < T / 64) ? unit + 32 : unit);
#pragma unroll
            for (int s = 0; s < 2; ++s) { u32x4 hi, lo; float rem[8];
#pragma unroll
                for (int p = 0; p < 8; ++p) { const float v = acc[2 * s + (p >> 2)][p & 3]; const unsigned hb = f2bf(v); rem[p] = v - __uint_as_float(hb << 16); }
                hi.x = pk2(acc[2 * s][0], acc[2 * s][1]); hi.y = pk2(acc[2 * s][2], acc[2 * s][3]); hi.z = pk2(acc[2 * s + 1][0], acc[2 * s + 1][1]); hi.w = pk2(acc[2 * s + 1][2], acc[2 * s + 1][3]);
                lo.x = pk2(rem[0], rem[1]); lo.y = pk2(rem[2], rem[3]); lo.z = pk2(rem[4], rem[5]); lo.w = pk2(rem[6], rem[7]);
                Bhi[s] = __builtin_bit_cast(bf16x8, hi); Blo[s] = __builtin_bit_cast(bf16x8, lo); }
        }
    }
}
#undef RW_LOAD_SET

__device__ __forceinline__ void phase_rwkv_out(const Ctx& c, const Args& a, int layer, const bf16_t* proj, const bf16_t* rwu, const bf16_t* rws, const float* bonusg, bf16_t* orwkv) {
    const float* mu = inptr(c, I_MU) + (size_t)layer * 1792;
    const int lane = c.lane, m = lane & 15, q = lane >> 4;
    for (int unit = c.bid * 8 + c.wave; unit < 2048; unit += c.G * 8) {
        const int ch = unit >> 3, h = unit & 7, t0 = ch * 64; const bf16_t* ug = rwu + (size_t)unit * 16384; const bf16_t* sg = rws + (size_t)unit * 4096;
        bf16x8 Bf[4][2];
#pragma unroll
        for (int cq = 0; cq < 4; ++cq) { Bf[cq][0] = *(const bf16x8*)(sg + cq * 1024 + lane * 8); Bf[cq][1] = *(const bf16x8*)(sg + cq * 1024 + 512 + lane * 8); }
        float lnw[4], lnb[4];
#pragma unroll
        for (int cq = 0; cq < 4; ++cq) { lnw[cq] = inptr(c, I_LNW)[layer * 512 + h * 64 + 16 * cq + m]; lnb[cq] = inptr(c, I_LNB)[layer * 512 + h * 64 + 16 * cq + m]; }
#pragma unroll 1
        for (int ta = 0; ta < 4; ++ta) {
            const bf16x8 A0 = *(const bf16x8*)(ug + 8192 + (16 * ta + m) * 64 + 8 * q), A1 = *(const bf16x8*)(ug + 8192 + (16 * ta + m) * 64 + 32 + 8 * q);
            f32x4 y[4];
#pragma unroll
            for (int cq = 0; cq < 4; ++cq) { const u32x2 z = *(const u32x2*)(ug + 12288 + ((cq * 4 + ta) * 64 + lane) * 4);
                y[cq] = (f32x4){__uint_as_float(z.x << 16), __uint_as_float(z.x & 0xffff0000u), __uint_as_float(z.y << 16), __uint_as_float(z.y & 0xffff0000u)};
                y[cq] = __builtin_amdgcn_mfma_f32_16x16x32_bf16(A0, Bf[cq][0], y[cq], 0, 0, 0); y[cq] = __builtin_amdgcn_mfma_f32_16x16x32_bf16(A1, Bf[cq][1], y[cq], 0, 0, 0); }
#pragma unroll
            for (int r = 0; r < 4; ++r) { const int t = t0 + 16 * ta + 4 * q + r;
                float sm = y[0][r] + y[1][r] + y[2][r] + y[3][r];
                sm += __shfl_xor(sm, 1); sm += __shfl_xor(sm, 2); sm += __shfl_xor(sm, 4); sm += __shfl_xor(sm, 8);
                const float mean = sm * (1.0f / 64.0f); float d[4], vs = 0.f;
#pragma unroll
                for (int cq = 0; cq < 4; ++cq) { d[cq] = y[cq][r] - mean; vs += d[cq] * d[cq]; }
                vs += __shfl_xor(vs, 1); vs += __shfl_xor(vs, 2); vs += __shfl_xor(vs, 4); vs += __shfl_xor(vs, 8);
                const float rstd = rsqrtf(vs * (1.0f / 64.0f) + 64e-5f); const float bon = bonusg[(size_t)t * 8 + h];
#pragma unroll
                for (int cq = 0; cq < 4; ++cq) { const int col = h * 64 + 16 * cq + m; const float v = rwkv_mixed(proj, mu, t, PC_V + col);
                    bf16_t* op = orwkv + (size_t)t * 512 + col; const float g = bf2f(*op);
                    *op = (bf16_t)f2bf((d[cq] * rstd * lnw[cq] + lnb[cq] + bon * v) * g); } }
        }
    }
}


constexpr int AT_K = 0, AT_V = 9216, AT_SCORE = 18432  , AT_BIAS = 83968, AT_SELM = 100352, AT_LIST = 104448, AT_NLIST = 105472, AT_NEED = 105504;
__device__ __forceinline__ void vt_transpose(const Ctx& c, const bf16_t* proj, bf16_t* vt) {
    LAS bf16_t* tl = (LAS bf16_t*)c.lds;
    for (int it = c.bid; it < 3 * 2 * 256; it += c.G) {
        const int which = it / 512, g = (it >> 8) & 1, tt = it & 255;
        const int col = (which == 0 ? PC_VS : (which == 1 ? PC_VW : PC_SV)) + g * 64;
        { const int tok = c.tid >> 3, ch = c.tid & 7; const u32x4 w = *(const u32x4*)(proj + (size_t)(tt * 64 + tok) * PLD + col + ch * 8);
          *(LAS u32x4*)(tl + tok * 72 + ch * 8) = w; }
        __syncthreads();
        { const int d = c.tid >> 3, ch = c.tid & 7; unsigned short e[8];
#pragma unroll
          for (int k = 0; k < 8; ++k) e[k] = tl[(ch * 8 + k) * 72 + d];
          u32x4 w; w.x = e[0] | ((unsigned)e[1] << 16); w.y = e[2] | ((unsigned)e[3] << 16); w.z = e[4] | ((unsigned)e[5] << 16); w.w = e[6] | ((unsigned)e[7] << 16);
          *(u32x4*)(vt + ((size_t)(which * 2 + g) * 64 + d) * T + tt * 64 + ch * 8) = w; }
        __syncthreads();
    }
}

template <int MODE, int NQ>
__device__ __forceinline__ void phase_attn(const Ctx& c, const Args& a, int layer, const bf16_t* proj, const bf16_t* vtb, const bf16_t* kcb, const bf16_t* vctb,
                                           unsigned* sel, float* nsaacc, bf16_t* oout) {
    LAS unsigned char* L = c.lds;
    LAS float* sscore = (LAS float*)(L + AT_SCORE);
    LAS float* biasd = (LAS float*)(L + AT_BIAS);
    LAS unsigned* selm = (LAS unsigned*)(L + AT_SELM);
    LAS int* list = (LAS int*)(L + AT_LIST);
    LAS int* nlist = (LAS int*)(L + AT_NLIST);
    LAS unsigned* need = (LAS unsigned*)(L + AT_NEED);
    const int lane = c.lane, wave = c.wave, n = lane & 15, q = lane >> 4, hr = n & 3;
    constexpr int TW = 4 * NQ, TB = 8 * TW, NU = T / TB, TS = (MODE == 3) ? 4 : 1;
    for (int unit = c.bid; unit < 2 * NU; unit += c.G) {
        const int g = unit / NU, t0 = (unit % NU) * TB, tw0 = t0 + wave * TW;
        __syncthreads();
        for (int e = c.tid; e < 4096; e += 512) { const int r = e >> 10, d = e & 1023; biasd[e] = inptr(c, I_REL)[t5_bucket(d) * 16 + (MODE == 0 ? 8 : 0) + g * 4 + r]; }
        if (MODE == 3) {
            if (c.tid < 8) need[c.tid] = 0u;
            __syncthreads();
            { const int tok = c.tid >> 3, w8 = c.tid & 7; const unsigned mw = sel[((size_t)(t0 + tok) * 2 + g) * 8 + w8]; selm[tok * 8 + w8] = mw; atomicOr((unsigned*)&need[w8], mw); }
            __syncthreads();
            if (c.tid < 256) { const int j = c.tid; const unsigned wd = need[j >> 5];
                if ((wd >> (j & 31)) & 1u) { int pos = __popc(wd & ((1u << (j & 31)) - 1u)); for (int w2 = 0; w2 < (j >> 5); ++w2) pos += __popc(need[w2]); list[pos] = j; } }
            if (c.tid == 0) { int cnt = 0; for (int w2 = 0; w2 < 8; ++w2) cnt += __popc(need[w2]); nlist[0] = cnt; }
        }
        __syncthreads();
        int ntiles, tile_lo = 0;
        if (MODE == 0) { ntiles = 2 + TB / 64; tile_lo = t0 - 128; }
        else if (MODE == 1) { ntiles = 8 + TB / 64; tile_lo = t0 - 512; }
        else if (MODE == 2) { const int cmax = (t0 + TB - 1 - 31) >> 4; ntiles = cmax < 0 ? 0 : (cmax >> 6) + 1; }
        else ntiles = nlist[0];
        const bf16_t* Ksrc; size_t kstride; const bf16_t* Vsrc; size_t vstride; int qcol;
        if (MODE == 0) { Ksrc = proj + PC_SK + g * 64; kstride = PLD; Vsrc = vtb + (size_t)(4 + g) * 64 * T; vstride = T; qcol = PC_SQ + g * 256; }
        else if (MODE == 1) { Ksrc = proj + PC_KW + g * 64; kstride = PLD; Vsrc = vtb + (size_t)(2 + g) * 64 * T; vstride = T; qcol = PC_NQ + g * 256; }
        else if (MODE == 2) { Ksrc = kcb + (size_t)g * 1024 * 64; kstride = 64; Vsrc = vctb + (size_t)g * 64 * 1024; vstride = 1024; qcol = PC_NQ + g * 256; }
        else { Ksrc = proj + PC_KS + g * 64; kstride = PLD; Vsrc = vtb + (size_t)(0 + g) * 64 * T; vstride = T; qcol = PC_NQ + g * 256; }
        bf16x8 Bq[NQ][2];
#pragma unroll
        for (int qd = 0; qd < NQ; ++qd) { const bf16_t* qp = proj + (size_t)(tw0 + 4 * qd + (n >> 2)) * PLD + qcol + hr * 64 + 8 * q;
            Bq[qd][0] = *(const bf16x8*)qp; Bq[qd][1] = *(const bf16x8*)(qp + 32); }
        const float bfar = biasd[hr * 1024 + 1023];
        float mrun[NQ], lrun[NQ]; f32x4 O[NQ][4];
#pragma unroll
        for (int qd = 0; qd < NQ; ++qd) { mrun[qd] = -1e30f; lrun[qd] = 0.f;
#pragma unroll
            for (int dt = 0; dt < 4; ++dt) O[qd][dt] = (f32x4){0.f, 0.f, 0.f, 0.f}; }
        float carry3[NQ]; for (int i = 0; i < NQ; ++i) carry3[i] = 0.f;
        const int npass = (MODE == 2) ? 2 : 1;
        for (int pass = 0; pass < npass; ++pass) {
            const bool do_pv = (MODE != 2) || pass == 1;
            float linv[NQ];
            if (MODE == 2 && pass == 1) {
#pragma unroll
                for (int qd = 0; qd < NQ; ++qd) { float mt = mrun[qd]; mt = fmaxf(mt, __shfl_xor(mt, 16)); mt = fmaxf(mt, __shfl_xor(mt, 32));
                    float lt = lrun[qd] * __expf(mrun[qd] - mt); lt += __shfl_xor(lt, 16); lt += __shfl_xor(lt, 32); mrun[qd] = mt; linv[qd] = lt > 0.f ? 1.0f / lt : 0.f; }
            }
#define AT_TILEPOS(ti) ((MODE == 3) ? list[ti] * 64 : (MODE == 2 ? (ti) * 64 : tile_lo + (ti) * 64))
#define AT_ISSUE(rd) do { _Pragma("unroll") for (int i_ = 0; i_ < TS; ++i_) { const int ti_ = (rd) * TS + i_; p0n[i_] = ti_ < ntiles ? AT_TILEPOS(ti_) : -1; \
        if (p0n[i_] >= 0) { kreg[i_] = *(const u32x4*)(Ksrc + (size_t)(p0n[i_] + (c.tid >> 3)) * kstride + (c.tid & 7) * 8); \
            if (do_pv) vreg[i_] = *(const u32x4*)(Vsrc + (size_t)(c.tid >> 3) * vstride + p0n[i_] + (c.tid & 7) * 8); } } } while (0)
            u32x4 kreg[TS], vreg[TS]; int p0n[TS];
            const int nrounds = (ntiles + TS - 1) / TS;
            if (nrounds > 0) AT_ISSUE(0);
            for (int rd = 0; rd < nrounds; ++rd) {
                int p0s[TS];
#pragma unroll
                for (int i = 0; i < TS; ++i) p0s[i] = p0n[i];
                __syncthreads();
#pragma unroll
                for (int i = 0; i < TS; ++i) if (p0s[i] >= 0) { *(LAS u32x4*)(L + AT_K + i * 18432 + (c.tid >> 3) * 144 + (c.tid & 7) * 16) = kreg[i];
                    if (do_pv) *(LAS u32x4*)(L + AT_V + i * 18432 + (c.tid >> 3) * 144 + (c.tid & 7) * 16) = vreg[i]; }
                if (rd + 1 < nrounds) AT_ISSUE(rd + 1);
                __syncthreads();
#pragma unroll
              for (int ts = 0; ts < TS; ++ts) {
                const int p0 = p0s[ts]; const int LK = AT_K + ts * 18432, LV = AT_V + ts * 18432;
                if (p0 < 0) continue;
                if (MODE == 0) { if (p0 > tw0 + TW - 1 || p0 + 63 < tw0 - 127) continue; }
                if (MODE == 1) { if (p0 > tw0 + TW - 1 || p0 + 63 < tw0 - 511) continue; }
                if (MODE == 2) { if (16 * p0 + 31 > tw0 + TW - 1) continue; }
                if (MODE == 3) { if (p0 > tw0 + TW - 1) continue; }
                const bool far = (MODE == 2) ? (tw0 - (16 * (p0 + 63) + 31) >= 790) : ((MODE == 3) ? (tw0 - (p0 + 63) >= 790) : false);
                const int jblk = p0 >> 6;
#pragma unroll
                for (int qd = 0; qd < NQ; ++qd) {
                    const int tq = tw0 + 4 * qd + (n >> 2);
                    bool colsel = true;
                    if (MODE == 3) { colsel = (selm[(wave * TW + 4 * qd + (n >> 2)) * 8 + (jblk >> 5)] >> (jblk & 31)) & 1u; if (__ballot(colsel) == 0ull) continue; }
#pragma unroll
                    for (int st = 0; st < 2; ++st) {
                        f32x4 sc[2];
#pragma unroll
                        for (int kt = 0; kt < 2; ++kt) { sc[kt] = (f32x4){0.f, 0.f, 0.f, 0.f};
#pragma unroll
                            for (int ks = 0; ks < 2; ++ks) { const bf16x8 ak = *(const LAS bf16x8*)(L + LK + (32 * st + 16 * kt + n) * 144 + (32 * ks + 8 * q) * 2);
                                sc[kt] = __builtin_amdgcn_mfma_f32_16x16x32_bf16(ak, Bq[qd][ks], sc[kt], 0, 0, 0); } }
                        float mx = -1e30f;
                        if (far) {
#pragma unroll
                            for (int kt = 0; kt < 2; ++kt)
#pragma unroll
                                for (int r = 0; r < 4; ++r) { const float s2 = (MODE == 3 && !colsel) ? -1e30f : sc[kt][r] + bfar; sc[kt][r] = s2; mx = fmaxf(mx, s2); }
                        } else {
#pragma unroll
                        for (int kt = 0; kt < 2; ++kt)
#pragma unroll
                            for (int r = 0; r < 4; ++r) { const int kl = 32 * st + 16 * kt + 4 * q + r; int dist; bool v;
                                if (MODE == 2) { dist = tq - (16 * (p0 + kl) + 31); v = dist >= 0; }
                                else { dist = tq - (p0 + kl); v = dist >= 0; if (MODE == 0) v = v && dist < 128; if (MODE == 1) v = v && dist < 512; if (MODE == 3) v = v && colsel; }
                                const int di = dist < 0 ? 0 : (dist > 1023 ? 1023 : dist);
                                const float s2 = v ? sc[kt][r] + biasd[hr * 1024 + di] : -1e30f; sc[kt][r] = s2; mx = fmaxf(mx, s2); }
                        }
                        float p[2][4];
                        if (MODE == 2 && pass == 1) {
#pragma unroll
                            for (int kt = 0; kt < 2; ++kt)
#pragma unroll
                                for (int r = 0; r < 4; ++r) p[kt][r] = __expf(sc[kt][r] - mrun[qd]) * linv[qd];
                        } else if (MODE == 2) {
                            const float mn = fmaxf(mrun[qd], mx), corr = __expf(mrun[qd] - mn); mrun[qd] = mn; float ps = 0.f;
                            const float mne = mn < -1e29f ? 0.f : mn;
#pragma unroll
                            for (int kt = 0; kt < 2; ++kt)
#pragma unroll
                                for (int r = 0; r < 4; ++r) ps += __expf(sc[kt][r] - mne);
                            lrun[qd] = lrun[qd] * corr + ps;
                        } else {
                            if (__any(mx > mrun[qd])) {
                                mx = fmaxf(mx, __shfl_xor(mx, 16)); mx = fmaxf(mx, __shfl_xor(mx, 32));
                                const float mn = fmaxf(mrun[qd], mx), corr = __expf(mrun[qd] - mn); mrun[qd] = mn;
                                lrun[qd] *= corr;
#pragma unroll
                                for (int dt = 0; dt < 4; ++dt) O[qd][dt] = O[qd][dt] * corr;
                            }
                            const float mne = mrun[qd] < -1e29f ? 0.f : mrun[qd]; float ps = 0.f;
#pragma unroll
                            for (int kt = 0; kt < 2; ++kt)
#pragma unroll
                                for (int r = 0; r < 4; ++r) { p[kt][r] = __expf(sc[kt][r] - mne); ps += p[kt][r]; }
                            lrun[qd] += ps;
                        }
                        if (MODE == 2 && pass == 1) {
                            float i3prev = carry3[qd];
#pragma unroll
                            for (int kt = 0; kt < 2; ++kt) { float im[4];
#pragma unroll
                                for (int r = 0; r < 4; ++r) { float v = p[kt][r]; v += dpp_xor1(v); v += dpp_xor2(v); im[r] = v; }
                                const float same = __shfl(im[3], (lane + 48) & 63), prevt = __shfl(i3prev, (lane + 48) & 63);
                                const float pv3 = q > 0 ? same : prevt;
                                const int jg = (p0 + 32 * st + 16 * kt + 4 * q) >> 2;
                                if (hr == 0 && jg < 256) sscore[(tq - t0) * 256 + jg] = 2.0f * (im[0] + im[1] + im[2]) + im[3] + pv3;
                                i3prev = im[3]; }
                            carry3[qd] = i3prev;
                        }
                        if (do_pv) {
                            u32x4 pw; pw.x = pk2(p[0][0], p[0][1]); pw.y = pk2(p[0][2], p[0][3]); pw.z = pk2(p[1][0], p[1][1]); pw.w = pk2(p[1][2], p[1][3]);
                            const bf16x8 pf = __builtin_bit_cast(bf16x8, pw);
#pragma unroll
                            for (int dt = 0; dt < 4; ++dt) { const LAS unsigned char* vp = L + LV + (16 * dt + n) * 144 + (32 * st + 4 * q) * 2;
                                const u32x2 v0 = *(const LAS u32x2*)vp, v1 = *(const LAS u32x2*)(vp + 32); u32x4 vw; vw.x = v0.x; vw.y = v0.y; vw.z = v1.x; vw.w = v1.y;
                                O[qd][dt] = __builtin_amdgcn_mfma_f32_16x16x32_bf16(__builtin_bit_cast(bf16x8, vw), pf, O[qd][dt], 0, 0, 0); }
                        }
                        __builtin_amdgcn_sched_barrier(0);
                    }
                }
              }
            }
        }
#undef AT_ISSUE
#undef AT_TILEPOS
        if (MODE == 2) {
            __syncthreads();
#pragma unroll 1
            for (int tk = 0; tk < TW; ++tk) { const int t = tw0 + tk, cur = t >> 6; const LAS float* sp = sscore + (wave * TW + tk) * 256;
                unsigned key[4]; bool forced[4];
#pragma unroll
                for (int jj = 0; jj < 4; ++jj) { const int j = lane + 64 * jj; forced[jj] = (j == 0 || j == cur || j == cur - 1);
                    key[jj] = (!forced[jj] && j < cur - 1) ? __float_as_uint(sp[j]) + 1u : 0u; }
                const int nforced = cur >= 2 ? 3 : cur + 1;
                unsigned prefix = 0u; int remaining = 16 - nforced;
#pragma unroll 1
                for (int bit = 30; bit >= 0; --bit) { const unsigned test = prefix | (1u << bit); int cnt = 0;
#pragma unroll
                    for (int jj = 0; jj < 4; ++jj) cnt += __popcll(__ballot((key[jj] >> bit) == (test >> bit)));
                    if (cnt >= remaining) prefix = test; else remaining -= cnt; }
                int eqbase = 0;
#pragma unroll
                for (int jj = 0; jj < 4; ++jj) { const bool eq = key[jj] == prefix && key[jj] != 0u; const unsigned long long eb = __ballot(eq);
                    const int eqrank = eqbase + __popcll(eb & ((1ull << lane) - 1ull)); eqbase += __popcll(eb);
                    const bool on = forced[jj] || key[jj] > prefix || (eq && eqrank < remaining); const unsigned long long bl = __ballot(on);
                    if (lane == 0) { sel[((size_t)t * 2 + g) * 8 + 2 * jj] = (unsigned)bl; sel[((size_t)t * 2 + g) * 8 + 2 * jj + 1] = (unsigned)(bl >> 32); } }
            }
        }
#pragma unroll
        for (int qd = 0; qd < NQ; ++qd) {
            const int tq = tw0 + 4 * qd + (n >> 2), hh = g * 4 + hr;
            float scale;
            if (MODE == 2) scale = 1.0f;
            else { float lt = lrun[qd]; lt += __shfl_xor(lt, 16); lt += __shfl_xor(lt, 32);
                if (MODE == 0) { const float sink = inptr(c, I_SINK)[layer * 8 + hh]; const float mf = fmaxf(mrun[qd], sink), cr = __expf(mrun[qd] - mf); scale = cr / (lt * cr + __expf(sink - mf)); }
                else scale = lt > 0.f ? 1.0f / lt : 0.f; }
            if (MODE != 0) scale *= sigmoidf_(bf2f(proj[(size_t)tq * PLD + PC_GL + (MODE == 2 ? 0 : (MODE == 3 ? 8 : 16)) + hh]));
#pragma unroll
            for (int dt = 0; dt < 4; ++dt) { const f32x4 o = O[qd][dt] * scale; const int col = hh * 64 + 16 * dt + 4 * q;
                if (MODE == 0) { u32x2 w; w.x = pk2(o[0], o[1]); w.y = pk2(o[2], o[3]); *(u32x2*)(oout + (size_t)tq * 512 + col) = w; }
                else if (MODE == 2) *(f32x4*)(nsaacc + (size_t)tq * 512 + col) = o;
                else if (MODE == 1) { f32x4* ap = (f32x4*)(nsaacc + (size_t)tq * 512 + col); *ap = *ap + o; }
                else { const f32x4 t2 = *(const f32x4*)(nsaacc + (size_t)tq * 512 + col) + o; u32x2 w; w.x = pk2(t2[0], t2[1]); w.y = pk2(t2[2], t2[3]); *(u32x2*)(oout + (size_t)tq * 512 + col) = w; } }
        }
    }
}
__device__ __forceinline__ void phase_topk2(const Ctx& c, const float* scores, int* sel) {
    const int gw = c.bid * 8 + c.wave, NGW = c.G * 8;
    for (int item = gw; item < T * 2; item += NGW) {
        const int t = item >> 1, g = item & 1, cur = t >> 6;
        const float* sp = scores + ((size_t)g * T + t) * 256;
        float val[4];
#pragma unroll
        for (int jj = 0; jj < 4; ++jj) { const int j = c.lane + 64 * jj; float sc;
            if (j == 0 || j == cur || j == cur - 1) sc = 1e4f; else if (j > cur) sc = -1.0f; else sc = sp[j];
            val[jj] = sc; }
        for (int k = 0; k < 16; ++k) {
            float bv = val[0]; int bi = c.lane;
#pragma unroll
            for (int jj = 1; jj < 4; ++jj) if (val[jj] > bv) { bv = val[jj]; bi = c.lane + 64 * jj; }
#pragma unroll
            for (int o = 32; o >= 1; o >>= 1) { const float ov = __shfl_xor(bv, o); const int oi = __shfl_xor(bi, o); if (ov > bv || (ov == bv && oi < bi)) { bv = ov; bi = oi; } }
#pragma unroll
            for (int jj = 0; jj < 4; ++jj) if (bi == c.lane + 64 * jj) val[jj] = -3e38f;
            if (c.lane == 0) sel[(size_t)item * 16 + k] = bi;
        }
    }
}

#define wb ((bf16_t*)(ws + WS_WB))
#define xb ((bf16_t*)(ws + WS_XB))
#define rs ((float*)(ws + WS_RS))
#define kcb ((bf16_t*)(ws + WS_KCB))
#define vctb ((bf16_t*)(ws + WS_VCT))
#define vtb ((bf16_t*)(ws + WS_VT))
#define scores ((float*)(ws + WS_SCORES))
#define sel ((unsigned*)(ws + WS_SEL))
#define ml ((float*)(ws + WS_ML))
#define hidb ((bf16_t*)(ws + WS_HID))
#define proj ((bf16_t*)(ws + WS_PROJ))
#define gates ((bf16_t*)(ws + WS_GATES))
#define merged ((bf16_t*)(ws + WS_MERGED))
#define tmpb ((bf16_t*)(ws + WS_TMPB))
#define alora ((bf16_t*)(ws + WS_ALORA))
#define rwu ((bf16_t*)(ws + WS_RWU))
#define rws ((bf16_t*)(ws + WS_RWS))
#define bonusg ((float*)(ws + WS_BONUS))
#define nsaacc ((float*)(ws + WS_NSAACC))
#define obuf ((bf16_t*)(ws + WS_O))
#define act ((bf16_t*)(ws + WS_ACT))
#define tmpf ((bf16_t*)(ws + WS_TMPF))
constexpr int PH_PER_BATCH = 9, PH_PER_LAYER = 1 + 2 * PH_PER_BATCH + 3, PH_TOTAL = 1 + DEPTH * PH_PER_LAYER;

__global__ void __launch_bounds__(512, 2) fwd_kernel(Args args) {
    extern __shared__ __attribute__((aligned(16))) unsigned char lds_raw[];
    Ctx c0; c0.lds = (LAS unsigned char*)lds_raw; c0.tid = threadIdx.x; c0.lane = c0.tid & 63; c0.wave = __builtin_amdgcn_readfirstlane(c0.tid >> 6); c0.G = gridDim.x; c0.bid = blockIdx.x; const Ctx& c = c0;
    unsigned char* ws = args.ws;
    volatile LAS unsigned* misc = (volatile LAS unsigned*)(c.lds + LDS_MISC);
    if (c.tid < 4) misc[c.tid] = 0u;
    if (c.tid < 30) { const unsigned long long pv = (unsigned long long)args.in[c.tid & 31]; misc[16 + 2 * c.tid] = (unsigned)pv; misc[17 + 2 * c.tid] = (unsigned)(pv >> 32); }
    __syncthreads();
    XcdBarrier bar; bar.bar = (unsigned*)(ws + WS_CTL); bar.x = 0; bar.st = misc;
    const int lo = args.lo, hi = args.hi;
    const bool multi = (hi - lo) > 1;
    if (multi) bar = xcd_barrier_post((unsigned*)(ws + WS_CTL), misc);
    int gp = 0;
#ifndef ONLY_PH
#define ONLY_PH -1
#endif
#ifndef PHMASK
#define PHMASK 0xffffff
#endif
#ifndef REPMASK
#define REPMASK 0
#endif
#define PHASE_BEGIN(id) if (gp >= lo && gp < hi) { for (int rep_ = 0; rep_ < (((REPMASK >> (id)) & 1) ? 2 : 1); ++rep_) { if (rep_) __syncthreads(); \
    Ctx pc = c0; asm volatile("" : "+v"(pc.tid), "+s"(pc.bid)); pc.lane = pc.tid & 63; pc.wave = __builtin_amdgcn_readfirstlane(pc.tid >> 6); const Ctx& c = pc;
#define PHASE_END   } if (gp + 1 < hi) xcd_barrier(bar); } ++gp;
#define RELAUNDER() do { asm volatile("" : "+v"(pc.tid), "+s"(pc.bid)); pc.lane = pc.tid & 63; pc.wave = __builtin_amdgcn_readfirstlane(pc.tid >> 6); } while (0)

    float* x = args.out;
    PHASE_BEGIN(0) phase_init(c, inptr(c, I_X), x, xb, rs); PHASE_END

    for (int layer = 0; layer < DEPTH; ++layer) {
        PHASE_BEGIN(1) phase_cvt(c, args, layer, wb); PHASE_END
        for (int b = 0; b < NBATCH; ++b) {
            const int row0 = b * T;
            PHASE_BEGIN(2) {
                pg8::Gemm g{xb + (size_t)row0 * D, wb + WB_WIN, D, D, D}; pg8::Sched S; S.init(T / 256, NIN / 256, c.G, c.bid, 1, (size_t)256 * D * 2, 0, (size_t)256 * D * 2, 0);
                pg8::EpiInProj E{proj, gates, rs + row0}; pg8::gemm_phase(c.lds, c.tid, g, S, E); } PHASE_END
            PHASE_BEGIN(16) {
                { pg8::Gemm g{proj, wb + WB_W1T, 16 * PLD, 2048, 2048, (unsigned)PLD * 2}; pg8::Sched S; S.init(16, 1, c.G, c.bid, 1, 0, 0, 0, 0); S.mode = 1;
                  pg8::EpiCmp1 E{hidb, (const float*)(wb + WB_BH)}; pg8::gemm_phase(c.lds, c.tid, g, S, E); }
                RELAUNDER();
                if (c.bid >= 16) { Ctx cv = c; cv.bid = c.bid - 16; cv.G = c.G - 16; phase_lora_a(cv, args, layer, proj, alora); vt_transpose(cv, proj, vtb); } } PHASE_END
            PHASE_BEGIN(17) {
                { pg8::Gemm g{alora, wb + WB_LORA, 256, 256, 256}; pg8::Sched S; S.init(T / 256, 6, c.G, c.bid, 1, (unsigned)256 * 256 * 2, 0, (unsigned)256 * 256 * 2, 0);
                  pg8::EpiLora E{obuf}; pg8::gemm_phase(c.lds, c.tid, g, S, E); }
                RELAUNDER();
                { pg8::Gemm g{hidb, wb + WB_W2T, 256, 256, 256}; pg8::Sched S; S.init(16, 1, c.G, (c.bid + 16) % c.G, 1, (unsigned)256 * 256 * 2, 0, 0, 0); S.mode = 2;
                  pg8::EpiCmp2 E{kcb, vctb}; pg8::gemm_phase(c.lds, c.tid, g, S, E); } } PHASE_END
            PHASE_BEGIN(18) {
                phase_rwkv_chunk(c, args, layer, proj, obuf + (size_t)T * 512, obuf + (size_t)2 * T * 512, rwu, bonusg);
                __syncthreads(); RELAUNDER();
                phase_attn<2, 2>(c, args, layer, proj, vtb, kcb, vctb, sel, nsaacc, obuf + (size_t)T * 512); } PHASE_END
            PHASE_BEGIN(19) {
                phase_rwkv_scan<0>(c, rwu, rws);
                RELAUNDER();
                if (c.bid >= 32) { Ctx cv = c; cv.bid = c.bid - 32; cv.G = c.G - 32;
                    phase_attn<1, 2>(cv, args, layer, proj, vtb, kcb, vctb, sel, nsaacc, obuf + (size_t)T * 512);
                    asm volatile("" : "+v"(cv.tid), "+s"(cv.bid)); cv.lane = cv.tid & 63; cv.wave = __builtin_amdgcn_readfirstlane(cv.tid >> 6);
                    phase_attn<0, 2>(cv, args, layer, proj, vtb, kcb, vctb, sel, nsaacc, obuf + (size_t)2 * T * 512); } } PHASE_END
            PHASE_BEGIN(9) {
                phase_rwkv_out(c, args, layer, proj, rwu, rws, bonusg, obuf);
                __syncthreads(); RELAUNDER();
                phase_attn<3, 2>(c, args, layer, proj, vtb, kcb, vctb, sel, nsaacc, obuf + (size_t)T * 512); } PHASE_END
            PHASE_BEGIN(10) {
                pg8::Gemm g{obuf, wb + WB_WBR, 512, 512, 512}; pg8::Sched S; S.init(T / 256, D / 256, c.G, c.bid, 3, (size_t)256 * 512 * 2, (size_t)T * 512 * 2, (size_t)256 * 512 * 2, (size_t)D * 512 * 2);
                pg8::EpiMerge E{gates, merged}; pg8::gemm_phase(c.lds, c.tid, g, S, E); } PHASE_END
            PHASE_BEGIN(11) {
                pg8::Gemm g{merged, wb + WB_WOUT, D, D, D}; pg8::Sched S; S.init(T / 256, D / 256, c.G, c.bid, 1, (size_t)256 * D * 2, 0, (size_t)256 * D * 2, 0);
                pg8::EpiStore E{tmpb, D}; pg8::gemm_phase(c.lds, c.tid, g, S, E); } PHASE_END
            PHASE_BEGIN(12) phase_norm_res(c, tmpb, inptr(c, I_NQM) + layer * D, x, xb, rs, row0, T); PHASE_END
        }
        PHASE_BEGIN(13) {
            pg8::Gemm g{xb, wb + WB_WGU, D, D, D}; pg8::Sched S; S.init(MROWS / 256, 2 * FFN / 256, c.G, c.bid, 1, (size_t)256 * D * 2, 0, (size_t)256 * D * 2, 0);
            pg8::EpiSwiGLU E{act, rs}; pg8::gemm_phase(c.lds, c.tid, g, S, E); } PHASE_END
        PHASE_BEGIN(14) {
            pg8::Gemm g{act, wb + WB_WDN, FFN, FFN, FFN}; pg8::Sched S; S.init(MROWS / 256, D / 256, c.G, c.bid, 1, (size_t)256 * FFN * 2, 0, (size_t)256 * FFN * 2, 0);
            pg8::EpiStore E{tmpf, D}; pg8::gemm_phase(c.lds, c.tid, g, S, E); } PHASE_END
        PHASE_BEGIN(15) phase_norm_res(c, tmpf, inptr(c, I_NQF) + layer * D, x, xb, rs, 0, MROWS); PHASE_END
    }
#undef PHASE_BEGIN
#undef PHASE_END
}

extern "C" void kernel_launch(void* const* d_in, const int* in_sizes, int n_in, void* d_out, int out_size, void* d_ws, size_t ws_size, hipStream_t stream) {
    static int grid = 0;
    if (grid == 0) {
        if (n_in != 30 || out_size != MROWS * D || ws_size < WS_END) { fprintf(stderr, "kernel_launch: unexpected shapes (n_in %d out %d ws %zu)\n", n_in, out_size, ws_size); grid = -1; return; }
        int dev = 0, cus = 0;
        if (hipGetDevice(&dev) != hipSuccess || hipDeviceGetAttribute(&cus, hipDeviceAttributeMultiprocessorCount, dev) != hipSuccess) { grid = -1; return; }
        if (hipFuncSetAttribute((const void*)fwd_kernel, hipFuncAttributeMaxDynamicSharedMemorySize, LDS_BYTES) != hipSuccess) { fprintf(stderr, "hipFuncSetAttribute failed\n"); grid = -1; return; }
        int per_cu = 0;
        if (hipOccupancyMaxActiveBlocksPerMultiprocessor(&per_cu, (const void*)fwd_kernel, 512, LDS_BYTES) != hipSuccess || per_cu < 1) { fprintf(stderr, "occupancy query: %d\n", per_cu); }
        (void)hipGetLastError();
        grid = cus;
    }
    if (grid < 0) return;
    (void)hipMemsetAsync((char*)d_ws + WS_CTL, 0, CTL_BYTES, stream);
    Args a{};
    for (int i = 0; i < 30; ++i) a.in[i] = (const float*)d_in[i];
    a.out = (float*)d_out; a.ws = (unsigned char*)d_ws;
#if MK_ONE_LAUNCH
    a.lo = 0; a.hi = PH_TOTAL;
    hipLaunchKernelGGL(fwd_kernel, dim3(grid), dim3(512), LDS_BYTES, stream, a);
#else
    for (int p = 0; p < PH_TOTAL; ++p) { a.lo = p; a.hi = p + 1; hipLaunchKernelGGL(fwd_kernel, dim3(grid), dim3(512), LDS_BYTES, stream, a); }
#endif
}
```

```cpp
#include <hip/hip_runtime.h>
#include <stdint.h>
#include <stdio.h>

#ifndef MK_ONE_LAUNCH
#define MK_ONE_LAUNCH 1
#endif

#define LAS __attribute__((address_space(3)))
typedef unsigned short bf16_t;
typedef short bf16x8 __attribute__((ext_vector_type(8)));
typedef float f32x4 __attribute__((ext_vector_type(4)));
typedef float f32x2 __attribute__((ext_vector_type(2)));
typedef unsigned u32x4 __attribute__((ext_vector_type(4)));
typedef unsigned u32x2 __attribute__((ext_vector_type(2)));

constexpr int D = 1024, NBATCH = 2, T = 16384, DEPTH = 4, MROWS = NBATCH * T;
constexpr int IN_COLS = 6936, FFN = 2816;
constexpr int PLD = 4096;
constexpr int PC_R = 0, PC_K = 512, PC_V = 1024, PC_ZW = 1536, PC_ZA = 1600, PC_ZG = 1664;
constexpr int PC_NQ = 1792, PC_KC = 2304, PC_VC = 2432, PC_KS = 2560, PC_VS = 2688, PC_KW = 2816, PC_VW = 2944, PC_GL = 3072;
constexpr int PC_SQ = 3328, PC_SK = 3840, PC_SV = 3968;
constexpr int NIN = 7168;
constexpr int NCMP = 1023;
constexpr float NORM_EPS = 1e-6f;

constexpr size_t MiB = 1u << 20;
constexpr size_t WS_CTL = 0, CTL_BYTES = 65536;
constexpr size_t WS_WB = 65536;
constexpr size_t WB_WIN = 0, WB_WBR = WB_WIN + (size_t)NIN * D, WB_WOUT = WB_WBR + (size_t)3 * D * 512, WB_WGU = WB_WOUT + (size_t)D * D,
                 WB_WDN = WB_WGU + (size_t)2 * FFN * D, WB_LORA = WB_WDN + (size_t)D * FFN, WB_W1T = WB_LORA + (size_t)1536 * 256, WB_W2T = WB_W1T + (size_t)2 * 256 * 2048,
                 WB_BH = WB_W2T + (size_t)2 * 256 * 256, WB_END = WB_BH + 1024;
static_assert(WS_WB + WB_END * 2 <= 38 * MiB + 786432, "weights");
constexpr size_t KiB = 1024;
constexpr size_t WS_XB = 38 * MiB + 768 * KiB;
constexpr size_t WS_RS = WS_XB + 64 * MiB;
constexpr size_t WS_BONUS = WS_RS + 128 * KiB;
constexpr size_t WS_KCB = WS_BONUS + 512 * KiB;
constexpr size_t WS_VCT = WS_KCB + 256 * KiB;
constexpr size_t WS_SEL = WS_VCT + 256 * KiB;
constexpr size_t WS_HID = WS_SEL + 1 * MiB;
constexpr size_t WS_ML = WS_HID;
static_assert(WS_HID + 2 * MiB <= 107 * MiB, "small region");
constexpr size_t WS_ALORA = 107 * MiB;
constexpr size_t WS_VT = 115 * MiB;
constexpr size_t WS_BIG = 127 * MiB;
constexpr size_t WS_PROJ = WS_BIG;
constexpr size_t WS_GATES = WS_PROJ + 128 * MiB;
constexpr size_t WS_RWKVS = WS_GATES + 96 * MiB;
constexpr size_t WS_RWU = WS_RWKVS;
constexpr size_t WS_RWS = WS_RWKVS + 64 * MiB;
constexpr size_t WS_SCORES = WS_RWKVS;
constexpr size_t WS_MERGED = WS_RWKVS;
constexpr size_t WS_TMPB = WS_RWKVS + 32 * MiB;
constexpr size_t WS_NSAACC = WS_RWKVS + 80 * MiB;
constexpr size_t WS_O = WS_NSAACC + 32 * MiB;
constexpr size_t WS_END = WS_O + 48 * MiB;
constexpr size_t WS_ACT = WS_BIG;
constexpr size_t WS_TMPF = WS_BIG + 176 * MiB;
static_assert(WS_END <= 512 * MiB, "workspace");
static_assert(WS_TMPF + 64 * MiB <= WS_NSAACC, "ffn overlay");

constexpr int LDS_BYTES = 147456;
constexpr int LDS_MISC = 131072 + 8192;

__device__ __forceinline__ float bf2f(unsigned v) { return __uint_as_float(v << 16); }
typedef __bf16 bf16n2 __attribute__((ext_vector_type(2)));
__device__ __forceinline__ unsigned pk2(float lo, float hi) { const f32x2 f = {lo, hi}; const bf16n2 v = __builtin_convertvector(f, bf16n2); return __builtin_bit_cast(unsigned, v); }
__device__ __forceinline__ unsigned f2bf(float f) { return pk2(f, 0.f) & 0xffffu; }
__device__ __forceinline__ void unpack8(const u32x4 w, float (&f)[8]) {
    f[0] = __uint_as_float(w.x << 16); f[1] = __uint_as_float(w.x & 0xffff0000u); f[2] = __uint_as_float(w.y << 16); f[3] = __uint_as_float(w.y & 0xffff0000u);
    f[4] = __uint_as_float(w.z << 16); f[5] = __uint_as_float(w.z & 0xffff0000u); f[6] = __uint_as_float(w.w << 16); f[7] = __uint_as_float(w.w & 0xffff0000u);
}
__device__ __forceinline__ float wave_sum(float v) {
#pragma unroll
    for (int o = 32; o >= 1; o >>= 1) v += __shfl_xor(v, o);
    return v;
}
__device__ __forceinline__ float dpp_xor1(float v) { return __int_as_float(__builtin_amdgcn_update_dpp(0, __float_as_int(v), 0xB1, 0xf, 0xf, false)); }
__device__ __forceinline__ float dpp_xor2(float v) { return __int_as_float(__builtin_amdgcn_update_dpp(0, __float_as_int(v), 0x4E, 0xf, 0xf, false)); }
__device__ __forceinline__ float sigmoidf_(float x) { return 1.0f / (1.0f + __expf(-x)); }
__device__ __forceinline__ int t5_bucket(int n) {
    if (n < 16) return n;
    int b = 16;
    b += (n >= 21); b += (n >= 27); b += (n >= 35); b += (n >= 46); b += (n >= 59); b += (n >= 77); b += (n >= 99); b += (n >= 128);
    b += (n >= 166); b += (n >= 216); b += (n >= 280); b += (n >= 363); b += (n >= 470); b += (n >= 609); b += (n >= 790);
    return b;
}

#define XB_TMO      128
#define XB_XCNT(j)  (256  + 64 * (j))
#define XB_XSUB(j)  (1280 + 64 * (j))
#define XB_XGEN(j)  (2304 + 64 * (j))
#define XB_TOP      3328
#define XB_TOPGEN   3392
#define XCD_BAR_WORDS 3456
#define XB_SPIN_CAP (1u << 22)
__device__ __forceinline__ unsigned xb_ld(unsigned* p)              { return __hip_atomic_load(p, __ATOMIC_RELAXED, __HIP_MEMORY_SCOPE_AGENT); }
__device__ __forceinline__ unsigned xb_add(unsigned* p, unsigned v) { return __hip_atomic_fetch_add(p, v, __ATOMIC_RELAXED, __HIP_MEMORY_SCOPE_AGENT); }
__device__ __forceinline__ unsigned xb_xcc_id() { return (unsigned)__builtin_amdgcn_s_getreg((3 << 11) | 20) & 0xFu; }
#define XB_SPIN(cond, bar) do { unsigned _sp = 0; while (cond) { __builtin_amdgcn_s_sleep(1); \
    if ((++_sp & 255u) == 0u) { if (xb_ld(&(bar)[XB_TMO])) break; if (_sp > XB_SPIN_CAP) { atomicAdd(&(bar)[XB_TMO], 1u); break; } } } } while (0)
struct XcdBarrier { unsigned* bar; unsigned x; volatile LAS unsigned* st; };
__device__ __forceinline__ XcdBarrier xcd_barrier_post(unsigned* bar, volatile LAS unsigned* st) {
    XcdBarrier b; b.bar = bar; b.x = xb_xcc_id(); b.st = st;
    if (threadIdx.x == 0) (void)xb_add(&bar[XB_XCNT(b.x)], 1u);
    return b;
}
__device__ __forceinline__ void xcd_barrier_complete(unsigned* bar, unsigned x, unsigned& nloc, unsigned& nx) {
    const unsigned G = gridDim.x * gridDim.y * gridDim.z;
    unsigned sum, cnt, mine, sp = 0u;
    for (;;) {
        sum = 0u; cnt = 0u; mine = 0u;
#pragma unroll
        for (unsigned j = 0; j < 16; ++j) { const unsigned c = xb_ld(&bar[XB_XCNT(j)]); sum += c; cnt += (c > 0u) ? 1u : 0u; mine = (j == x) ? c : mine; }
        if (sum == G) break;
        __builtin_amdgcn_s_sleep(1);
        if ((++sp & 255u) == 0u) { if (xb_ld(&bar[XB_TMO])) break; if (sp > XB_SPIN_CAP) { atomicAdd(&bar[XB_TMO], 1u); break; } }
    }
    nloc = mine > 0u ? mine : 1u; nx = cnt > 0u ? cnt : 1u;
}
__device__ __forceinline__ void xcd_barrier(const XcdBarrier& b) {
    asm volatile("s_waitcnt vmcnt(0)" ::: "memory");
    __syncthreads();
    if (threadIdx.x == 0) {
        unsigned* bar = b.bar;
        __builtin_amdgcn_s_waitcnt(0);
        unsigned nloc = b.st[0], nx = b.st[1];
        if (nloc == 0u) { xcd_barrier_complete(bar, b.x, nloc, nx); b.st[0] = nloc; b.st[1] = nx; }
        const unsigned old = xb_add(&bar[XB_XSUB(b.x)], 1u);
        const unsigned gen = old / nloc;
        if (old + 1u == (gen + 1u) * nloc) {
            __builtin_amdgcn_fence(__ATOMIC_RELEASE, "agent");
            asm volatile("s_waitcnt vmcnt(0)" ::: "memory");
            const unsigned og = xb_add(&bar[XB_TOP], 1u);
            const unsigned tg = og / nx;
            if (og + 1u == (tg + 1u) * nx) xb_add(&bar[XB_TOPGEN], 1u);
            else XB_SPIN(xb_ld(&bar[XB_TOPGEN]) == tg, bar);
            __builtin_amdgcn_fence(__ATOMIC_ACQUIRE, "agent");
            xb_add(&bar[XB_XGEN(b.x)], 1u);
            asm volatile("s_waitcnt vmcnt(0)" ::: "memory");
        } else {
            XB_SPIN(xb_ld(&bar[XB_XGEN(b.x)]) == gen, bar);
            __builtin_amdgcn_fence(__ATOMIC_ACQUIRE, "agent");
            asm volatile("s_waitcnt vmcnt(0)" ::: "memory");
        }
    }
    __syncthreads();
}

namespace pg8 {
constexpr int BM = 256, BK = 64, HALF = 128, HTB = HALF * BK * 2, STAGE_BYTES = 8 * HTB, NXCD = 8, WGM = 8;
__device__ __forceinline__ int lds_byte(int r, int c) { const int st = (r >> 4) * 2 + (c >> 5), rr = r & 15, cc = c & 31, ob = rr * 64 + cc * 2; return st * 1024 + (ob ^ (((ob >> 9) & 1) << 5)); }
__device__ __forceinline__ void stage_rc(int b, int& R, int& C) { const int st = b / 1024, sb = b % 1024, swz = sb ^ (((sb >> 9) & 1) << 5); R = (st >> 1) * 16 + swz / 64; C = (st & 1) * 32 + (swz % 64) / 2; }
__device__ __forceinline__ int perm32(int rho) { const int n = rho >> 4, i = rho & 15; return 8 * (i >> 2) + 4 * n + (i & 3); }

struct Unit { int pm, pn, sub; unsigned aoff, boff; };
struct Gemm { const bf16_t* A; const bf16_t* Bt; int lda, ldb, K; unsigned kstepA = 128; };
struct Sched {
    int nM, nN, nwg, G, c, nsub, mode = 0; unsigned a_row, a_sub, b_row, b_sub;
    __device__ __forceinline__ void init(int nM_, int nN_, int G_, int c_, int nsub_, unsigned a_row_, unsigned a_sub_, unsigned b_row_, unsigned b_sub_) {
        nM = nM_; nN = nN_; nwg = nM * nN; G = G_; c = c_; nsub = nsub_; a_row = a_row_; a_sub = a_sub_; b_row = b_row_; b_sub = b_sub_; }
    __device__ __forceinline__ bool next(int i, Unit& u) const {
        const int round = i / nsub; u.sub = i - round * nsub;
        const long L = (long)round * G + c; if (L >= nwg) return false;
        int wgid = (int)L; { const int q = nwg / NXCD, r = nwg % NXCD, xcd = wgid % NXCD, off = wgid / NXCD; wgid = (xcd < r ? xcd * (q + 1) : r * (q + 1) + (xcd - r) * q) + off; }
        const int nig = WGM * nN, gid = wgid / nig, fm = gid * WGM, gsz = (nM - fm) < WGM ? (nM - fm) : WGM;
        u.pm = fm + ((wgid % nig) % gsz); u.pn = (wgid % nig) / gsz;
        u.aoff = (unsigned)u.pm * a_row + (unsigned)u.sub * a_sub; u.boff = (unsigned)u.pn * b_row + (unsigned)u.sub * b_sub;
        if (mode == 1) { const int kv = u.pm >> 3, g = (u.pm >> 2) & 1, cp = u.pm & 3;
            u.aoff = (unsigned)(((size_t)cp * 256 * 16 * PLD + (kv ? PC_VC : PC_KC) + g * 64) * 2); u.boff = (unsigned)kv * (256u * 2048u * 2u); }
        if (mode == 2) { const int kv = u.pm >> 3; u.boff = (unsigned)kv * (256u * 256u * 2u); }
        return true;
    }
};

template <class Epi>
__device__ __forceinline__ void gemm_phase(LAS unsigned char* lds, const int tid, const Gemm g, const Sched& S, const Epi& E) {
    const int wid = __builtin_amdgcn_readfirstlane(tid >> 6), lane = tid & 63, wr = wid >> 2, wc = wid & 3, fr = lane & 15, fq = lane >> 4;
    const int K = g.K, nt = K / BK;
    unsigned voffA[2], voffB[2];
#pragma unroll
    for (int i = 0; i < 2; ++i) { int R, C; stage_rc(tid * 16 + i * 8192, R, C); const int Rb = Epi::PERM ? ((R & ~31) + perm32(R & 31)) : R;
        voffA[i] = (unsigned)(R * g.lda + C) * 2u; voffB[i] = (unsigned)(Rb * g.ldb + C) * 2u; }
    const size_t kstep = (size_t)(BK * 2), kstA = g.kstepA;
    const size_t hstepA = (size_t)HALF * g.lda * 2, hstepB = (size_t)HALF * g.ldb * 2;
    const unsigned ldsw = (unsigned)wid * 1024u;
    const int aoff = lds_byte(wr * 64 + fr, fq * 8), boff = lds_byte(wc * 32 + fr, fq * 8);
#define PG8_SA(b, h) (((b) * 2 + (h)) * HTB)
#define PG8_SB(b, h) ((4 + (b) * 2 + (h)) * HTB)
#define PG8_STAGE(bufoff, gbase, voff) do { _Pragma("unroll") for (int _i = 0; _i < 2; ++_i) \
        __builtin_amdgcn_global_load_lds((const unsigned*)((const char*)(gbase) + (voff)[_i]), (LAS unsigned*)(lds + (bufoff) + ldsw + _i * 8192), 16, 0, 0); } while (0)
#define PG8_LDA(dst, b, h) do { _Pragma("unroll") for (int m = 0; m < 4; ++m) _Pragma("unroll") for (int k = 0; k < 2; ++k) dst[m][k] = *(const LAS bf16x8*)(lds + PG8_SA(b, h) + aoff + m * 2048 + k * 1024); } while (0)
#define PG8_LDB(dst, b, h) do { _Pragma("unroll") for (int n = 0; n < 2; ++n) _Pragma("unroll") for (int k = 0; k < 2; ++k) dst[n][k] = *(const LAS bf16x8*)(lds + PG8_SB(b, h) + boff + n * 2048 + k * 1024); } while (0)
#define PG8_MMA(ai, bj, At, Bt) do { __builtin_amdgcn_s_setprio(1); _Pragma("unroll") for (int m = 0; m < 4; ++m) _Pragma("unroll") for (int n = 0; n < 2; ++n) _Pragma("unroll") for (int k = 0; k < 2; ++k) \
        acc[ai][bj][m][n] = __builtin_amdgcn_mfma_f32_16x16x32_bf16(Bt[n][k], At[m][k], acc[ai][bj][m][n], 0, 0, 0); __builtin_amdgcn_s_setprio(0); } while (0)
#define PG8_WAIT_V(n) asm volatile("s_waitcnt vmcnt(" #n ")" ::: "memory")
#define PG8_WAIT_L(n) asm volatile("s_waitcnt lgkmcnt(" #n ")" ::: "memory")
#define PG8_BAR __builtin_amdgcn_s_barrier()
#define PG8_SCHED __builtin_amdgcn_sched_barrier(0)
    Unit cur, nxt; int ui = 0;
    if (!S.next(0, cur)) return;
    f32x4 acc[2][2][4][2];
#pragma unroll
    for (int a = 0; a < 2; ++a)
#pragma unroll
        for (int b = 0; b < 2; ++b)
#pragma unroll
            for (int m = 0; m < 4; ++m)
#pragma unroll
                for (int n = 0; n < 2; ++n) acc[a][b][m][n] = (f32x4){0.f, 0.f, 0.f, 0.f};
    bf16x8 At[4][2], B0[2][2], B1[2][2];
    const char* cA = (const char*)g.A + cur.aoff; const char* cB = (const char*)g.Bt + cur.boff;
    PG8_STAGE(PG8_SB(0, 0), cB, voffB); PG8_STAGE(PG8_SA(0, 0), cA, voffA); PG8_STAGE(PG8_SB(0, 1), cB + hstepB, voffB); PG8_STAGE(PG8_SA(0, 1), cA + hstepA, voffA);
    if (wr == 1) PG8_BAR;
    PG8_WAIT_V(4); PG8_BAR;
    PG8_STAGE(PG8_SB(1, 0), cB + kstep, voffB); PG8_STAGE(PG8_SA(1, 0), cA + kstA, voffA); PG8_STAGE(PG8_SB(1, 1), cB + hstepB + kstep, voffB);
    PG8_WAIT_V(6); PG8_BAR;
    for (;;) {
        const bool has_next = S.next(ui + 1, nxt);
        const char* nA = has_next ? (const char*)g.A + nxt.aoff : cA; const char* nB = has_next ? (const char*)g.Bt + nxt.boff : cB;
        for (int t = 0; t < nt; t += 2) {
            const bool last = (t == nt - 2);
            const char* a1 = cA + (size_t)(t + 1) * kstA;
            const char* a2 = last ? nA : cA + (size_t)(t + 2) * kstA; const char* b2 = last ? nB : cB + (size_t)(t + 2) * kstep;
            const char* a3 = a2 + kstA; const char* b3 = b2 + kstep;
            PG8_LDB(B0, 0, 0); PG8_SCHED; PG8_LDA(At, 0, 0); PG8_STAGE(PG8_SA(1, 1), a1 + hstepA, voffA);
            PG8_WAIT_L(8); PG8_BAR; PG8_WAIT_L(0); PG8_MMA(0, 0, At, B0); PG8_BAR; PG8_SCHED;
            PG8_LDB(B1, 0, 1); PG8_STAGE(PG8_SB(0, 0), b2, voffB);
            PG8_BAR; PG8_WAIT_L(0); PG8_MMA(0, 1, At, B1); PG8_BAR;
            PG8_LDA(At, 0, 1); PG8_STAGE(PG8_SA(0, 0), a2, voffA);
            PG8_BAR; PG8_WAIT_L(0); PG8_MMA(1, 0, At, B0); PG8_BAR; PG8_SCHED;
            PG8_STAGE(PG8_SB(0, 1), b2 + hstepB, voffB);
            PG8_WAIT_V(6); PG8_BAR; PG8_MMA(1, 1, At, B1); PG8_BAR;
            PG8_LDB(B0, 1, 0); PG8_SCHED; PG8_LDA(At, 1, 0); PG8_STAGE(PG8_SA(0, 1), a2 + hstepA, voffA);
            PG8_WAIT_L(8); PG8_BAR; PG8_WAIT_L(0); PG8_MMA(0, 0, At, B0); PG8_BAR; PG8_SCHED;
            PG8_LDB(B1, 1, 1); PG8_STAGE(PG8_SB(1, 0), b3, voffB);
            PG8_BAR; PG8_WAIT_L(0); PG8_MMA(0, 1, At, B1); PG8_BAR;
            PG8_LDA(At, 1, 1); PG8_STAGE(PG8_SA(1, 0), a3, voffA);
            PG8_BAR; PG8_WAIT_L(0); PG8_MMA(1, 0, At, B0); PG8_BAR; PG8_SCHED;
            PG8_STAGE(PG8_SB(1, 1), b3 + hstepB, voffB);
            PG8_WAIT_V(6); PG8_BAR; PG8_MMA(1, 1, At, B1); PG8_BAR;
        }
        const bool keep = E(acc, cur, wr, wc, fr, fq);
        if (!has_next) break;
        if (!keep) {
#pragma unroll
            for (int a = 0; a < 2; ++a)
#pragma unroll
                for (int b = 0; b < 2; ++b)
#pragma unroll
                    for (int m = 0; m < 4; ++m)
#pragma unroll
                        for (int n = 0; n < 2; ++n) acc[a][b][m][n] = (f32x4){0.f, 0.f, 0.f, 0.f};
        }
        cur = nxt; cA = nA; cB = nB; ++ui;
    }
    PG8_WAIT_V(0);
    if (wr == 0) PG8_BAR;
    PG8_BAR;
#undef PG8_SA
#undef PG8_SB
#undef PG8_STAGE
#undef PG8_LDA
#undef PG8_LDB
#undef PG8_MMA
#undef PG8_WAIT_V
#undef PG8_WAIT_L
#undef PG8_BAR
#undef PG8_SCHED
}

struct EpiInProj {
    static constexpr bool PERM = true;
    bf16_t* proj; bf16_t* gates; const float* rs;
    __device__ __forceinline__ bool operator()(f32x4 (&acc)[2][2][4][2], const Unit& u, int wr, int wc, int fr, int fq) const {
        const int row0 = u.pm * BM + wr * 64 + fr; const bool is_gate = u.pn >= 16;
        bf16_t* base = is_gate ? gates + (u.pn - 16) * 256 : proj + u.pn * 256; const int ld = is_gate ? 3072 : PLD;
        const int col0 = wc * 32 + 8 * fq;
#pragma unroll
        for (int ai = 0; ai < 2; ++ai)
#pragma unroll
            for (int m = 0; m < 4; ++m) { const int row = row0 + ai * HALF + m * 16; const float s = rs[row]; bf16_t* rowp = base + (size_t)row * ld + col0;
#pragma unroll
                for (int bj = 0; bj < 2; ++bj) { f32x4 v0 = acc[ai][bj][m][0] * s, v1 = acc[ai][bj][m][1] * s;
                    if (is_gate) {
#pragma unroll
                        for (int j = 0; j < 4; ++j) { v0[j] = sigmoidf_(v0[j]); v1[j] = sigmoidf_(v1[j]); } }
                    u32x4 w; w.x = pk2(v0[0], v0[1]); w.y = pk2(v0[2], v0[3]); w.z = pk2(v1[0], v1[1]); w.w = pk2(v1[2], v1[3]);
                    *(u32x4*)(rowp + bj * HALF) = w; } }
        return false;
    }
};
struct EpiStore {
    static constexpr bool PERM = true;
    bf16_t* out; int ld;
    __device__ __forceinline__ bool operator()(f32x4 (&acc)[2][2][4][2], const Unit& u, int wr, int wc, int fr, int fq) const {
        const int row0 = u.pm * BM + wr * 64 + fr; const int col0 = u.pn * BM + wc * 32 + 8 * fq;
#pragma unroll
        for (int ai = 0; ai < 2; ++ai)
#pragma unroll
            for (int m = 0; m < 4; ++m) { bf16_t* rowp = out + (size_t)(row0 + ai * HALF + m * 16) * ld + col0;
#pragma unroll
                for (int bj = 0; bj < 2; ++bj) { const f32x4 v0 = acc[ai][bj][m][0], v1 = acc[ai][bj][m][1];
                    u32x4 w; w.x = pk2(v0[0], v0[1]); w.y = pk2(v0[2], v0[3]); w.z = pk2(v1[0], v1[1]); w.w = pk2(v1[2], v1[3]);
                    *(u32x4*)(rowp + bj * HALF) = w; } }
        return false;
    }
};
struct EpiCmp1 {
    static constexpr bool PERM = true;
    bf16_t* hid; const float* bh;
    __device__ __forceinline__ bool operator()(f32x4 (&acc)[2][2][4][2], const Unit& u, int wr, int wc, int fr, int fq) const {
        const int kv = u.pm >> 3; const int row0 = (u.pm & 7) * BM + wr * 64 + fr; const int col0 = wc * 32 + 8 * fq;
#pragma unroll
        for (int ai = 0; ai < 2; ++ai)
#pragma unroll
            for (int m = 0; m < 4; ++m) { bf16_t* rowp = hid + ((size_t)kv * 2048 + row0 + ai * HALF + m * 16) * 256 + col0;
#pragma unroll
                for (int bj = 0; bj < 2; ++bj) { float o[8];
#pragma unroll
                    for (int j = 0; j < 8; ++j) { const float x = acc[ai][bj][m][j >> 2][j & 3] + bh[kv * 256 + col0 + bj * HALF + j];
                        o[j] = x * sigmoidf_(1.5957691216f * (x + 0.044715f * x * x * x)); }
                    u32x4 w; w.x = pk2(o[0], o[1]); w.y = pk2(o[2], o[3]); w.z = pk2(o[4], o[5]); w.w = pk2(o[6], o[7]);
                    *(u32x4*)(rowp + bj * HALF) = w; } }
        return false;
    }
};
struct EpiCmp2 {
    static constexpr bool PERM = true;
    bf16_t* kcb; bf16_t* vct;
    __device__ __forceinline__ bool operator()(f32x4 (&acc)[2][2][4][2], const Unit& u, int wr, int wc, int fr, int fq) const {
        const int kv = u.pm >> 3; const int row0 = (u.pm & 7) * BM + wr * 64 + fr; const int col0 = wc * 32 + 8 * fq;
        if (col0 >= 64) return false;
#pragma unroll
        for (int ai = 0; ai < 2; ++ai)
#pragma unroll
            for (int m = 0; m < 4; ++m) { const int row = row0 + ai * HALF + m * 16, g = row >> 10, cc = row & 1023; const bool zr = cc == 1023; const f32x4 zz = (f32x4){0.f, 0.f, 0.f, 0.f};
                const f32x4 v0 = zr ? zz : acc[ai][0][m][0], v1 = zr ? zz : acc[ai][0][m][1];
                if (kv == 0) { u32x4 w; w.x = pk2(v0[0], v0[1]); w.y = pk2(v0[2], v0[3]); w.z = pk2(v1[0], v1[1]); w.w = pk2(v1[2], v1[3]); *(u32x4*)(kcb + ((size_t)g * 1024 + cc) * 64 + col0) = w; }
                else {
#pragma unroll
                    for (int j = 0; j < 4; ++j) { vct[((size_t)g * 64 + col0 + j) * 1024 + cc] = (bf16_t)f2bf(v0[j]); vct[((size_t)g * 64 + col0 + 4 + j) * 1024 + cc] = (bf16_t)f2bf(v1[j]); } } }
        return false;
    }
};
struct EpiLora {
    static constexpr bool PERM = true;
    bf16_t* obuf;
    __device__ __forceinline__ bool operator()(f32x4 (&acc)[2][2][4][2], const Unit& u, int wr, int wc, int fr, int fq) const {
        const int sel = u.pn >> 1; bf16_t* out = obuf + (size_t)(sel == 2 ? 0 : sel + 1) * T * 512;
        const int row0 = u.pm * BM + wr * 64 + fr; const int col0 = (u.pn & 1) * BM + wc * 32 + 8 * fq;
#pragma unroll
        for (int ai = 0; ai < 2; ++ai)
#pragma unroll
            for (int m = 0; m < 4; ++m) { bf16_t* rowp = out + (size_t)(row0 + ai * HALF + m * 16) * 512 + col0;
#pragma unroll
                for (int bj = 0; bj < 2; ++bj) { const f32x4 v0 = acc[ai][bj][m][0], v1 = acc[ai][bj][m][1];
                    u32x4 w; w.x = pk2(v0[0], v0[1]); w.y = pk2(v0[2], v0[3]); w.z = pk2(v1[0], v1[1]); w.w = pk2(v1[2], v1[3]);
                    *(u32x4*)(rowp + bj * HALF) = w; } }
        return false;
    }
};
struct EpiMerge {
    static constexpr bool PERM = true;
    const bf16_t* gates; bf16_t* merged;
    __device__ __forceinline__ bool operator()(f32x4 (&acc)[2][2][4][2], const Unit& u, int wr, int wc, int fr, int fq) const {
        const int row0 = u.pm * BM + wr * 64 + fr; const int col0 = u.pn * BM + wc * 32 + 8 * fq; const int sub = u.sub;
#pragma unroll
        for (int ai = 0; ai < 2; ++ai)
#pragma unroll
            for (int m = 0; m < 4; ++m) { const int row = row0 + ai * HALF + m * 16; const bf16_t* gp = gates + (size_t)row * 3072 + sub * 1024 + col0;
#pragma unroll
                for (int bj = 0; bj < 2; ++bj) {
                    float sc[8], sn[8]; unpack8(*(const u32x4*)(gp + bj * HALF), sc);
                    if (sub < 2) { unpack8(*(const u32x4*)(gp + 1024 + bj * HALF), sn);
#pragma unroll
                        for (int j = 0; j < 8; ++j) sc[j] = sc[j] / fmaxf(sn[j], 1e-30f); }
                    f32x4 v0 = acc[ai][bj][m][0], v1 = acc[ai][bj][m][1];
#pragma unroll
                    for (int j = 0; j < 4; ++j) { v0[j] *= sc[j]; v1[j] *= sc[4 + j]; }
                    acc[ai][bj][m][0] = v0; acc[ai][bj][m][1] = v1;
                    if (sub == 2) { u32x4 w; w.x = pk2(v0[0], v0[1]); w.y = pk2(v0[2], v0[3]); w.z = pk2(v1[0], v1[1]); w.w = pk2(v1[2], v1[3]);
                        *(u32x4*)(merged + (size_t)row * D + col0 + bj * HALF) = w; } } }
        return sub != 2;
    }
};
struct EpiSwiGLU {
    static constexpr bool PERM = true;
    bf16_t* act; const float* rs;
    __device__ __forceinline__ bool operator()(f32x4 (&acc)[2][2][4][2], const Unit& u, int wr, int wc, int fr, int fq) const {
        const int row0 = u.pm * BM + wr * 64 + fr; const int col0 = u.pn * HALF + wc * 32 + 8 * fq;
#pragma unroll
        for (int ai = 0; ai < 2; ++ai)
#pragma unroll
            for (int m = 0; m < 4; ++m) { const int row = row0 + ai * HALF + m * 16; const float s = rs[row];
                float o[8];
#pragma unroll
                for (int n = 0; n < 2; ++n)
#pragma unroll
                    for (int j = 0; j < 4; ++j) { const float gg = acc[ai][0][m][n][j] * s, uu = acc[ai][1][m][n][j] * s; o[n * 4 + j] = gg * sigmoidf_(gg) * uu; }
                u32x4 w; w.x = pk2(o[0], o[1]); w.y = pk2(o[2], o[3]); w.z = pk2(o[4], o[5]); w.w = pk2(o[6], o[7]);
                *(u32x4*)(act + (size_t)row * FFN + col0) = w; }
        return false;
    }
};
}

struct Args { const float* in[30]; float* out; unsigned char* ws; int lo, hi; };
enum { I_X = 0, I_NPM, I_NQM, I_NPF, I_NQF, I_WIN, I_MU, I_W0, I_W2, I_A0, I_A2, I_G2, I_KK, I_KA, I_RK, I_LNW, I_LNB, I_PEK, I_PEV, I_CKW1, I_CKW2, I_CVW1, I_CVW2, I_SINK, I_REL, I_WBR, I_WOUT, I_FG, I_FU, I_FD };

struct Ctx { LAS unsigned char* lds; int tid, lane, wave, G, bid; };
__device__ __forceinline__ const float* inptr(const Ctx& c, int i) {
    const volatile LAS unsigned* t = (const volatile LAS unsigned*)(c.lds + LDS_MISC + 64) + 2 * i;
    const unsigned lo = __builtin_amdgcn_readfirstlane(t[0]), hi = __builtin_amdgcn_readfirstlane(t[1]);
    return (const float*)(((unsigned long long)hi << 32) | lo);
}

__device__ __forceinline__ void phase_init(const Ctx& c, const float* x, float* xo, bf16_t* xb, float* rs) {
    const int gw = c.bid * 8 + c.wave, NGW = c.G * 8;
    for (int row = gw; row < MROWS; row += NGW) {
        const float* xr = x + (size_t)row * D; float ss = 0.f;
#pragma unroll
        for (int j = 0; j < 2; ++j) { const int e = c.lane * 8 + 512 * j; const f32x4 a = *(const f32x4*)(xr + e), b = *(const f32x4*)(xr + e + 4);
            ss += a[0] * a[0] + a[1] * a[1] + a[2] * a[2] + a[3] * a[3] + b[0] * b[0] + b[1] * b[1] + b[2] * b[2] + b[3] * b[3];
            *(f32x4*)(xo + (size_t)row * D + e) = a; *(f32x4*)(xo + (size_t)row * D + e + 4) = b;
            u32x4 w; w.x = pk2(a[0], a[1]); w.y = pk2(a[2], a[3]); w.z = pk2(b[0], b[1]); w.w = pk2(b[2], b[3]); *(u32x4*)(xb + (size_t)row * D + e) = w; }
        ss = wave_sum(ss);
        if (c.lane == 0) rs[row] = rsqrtf(ss * (1.0f / D) + NORM_EPS);
    }
}
__device__ __forceinline__ void phase_norm_res(const Ctx& c, const bf16_t* y, const float* gain, float* x, bf16_t* xb, float* rs, int row0, int nrows) {
    const int gw = c.bid * 8 + c.wave, NGW = c.G * 8;
    for (int r = gw; r < nrows; r += NGW) {
        const int row = row0 + r; float yv[16]; float ss = 0.f;
#pragma unroll
        for (int j = 0; j < 2; ++j) { float f[8]; unpack8(*(const u32x4*)(y + (size_t)r * D + c.lane * 8 + 512 * j), f);
#pragma unroll
            for (int k = 0; k < 8; ++k) { yv[j * 8 + k] = f[k]; ss += f[k] * f[k]; } }
        ss = wave_sum(ss); const float sc = rsqrtf(ss * (1.0f / D) + NORM_EPS); float s2 = 0.f;
#pragma unroll
        for (int j = 0; j < 2; ++j) { const int e = c.lane * 8 + 512 * j; float* xr = x + (size_t)row * D + e;
            f32x4 a = *(const f32x4*)xr, b = *(const f32x4*)(xr + 4); const f32x4 ga = *(const f32x4*)(gain + e), gb = *(const f32x4*)(gain + e + 4);
#pragma unroll
            for (int k = 0; k < 4; ++k) { a[k] += yv[j * 8 + k] * sc * ga[k]; b[k] += yv[j * 8 + 4 + k] * sc * gb[k]; s2 += a[k] * a[k] + b[k] * b[k]; }
            *(f32x4*)xr = a; *(f32x4*)(xr + 4) = b;
            u32x4 w; w.x = pk2(a[0], a[1]); w.y = pk2(a[2], a[3]); w.z = pk2(b[0], b[1]); w.w = pk2(b[2], b[3]); *(u32x4*)(xb + (size_t)row * D + e) = w; }
        s2 = wave_sum(s2);
        if (c.lane == 0) rs[row] = rsqrtf(s2 * (1.0f / D) + NORM_EPS);
    }
}

__device__ __forceinline__ void phase_cvt(const Ctx& c, const Args& a, int layer, bf16_t* wb) {
    LAS float* tile = (LAS float*)c.lds;
    constexpr int I0 = 16 * 112, I1 = 3 * 8 * 16, I2 = 16 * 16, I3 = 16 * 88, I4 = 44 * 16, I5 = 4 * 24, I6 = 2 * 32 * 4, I7 = 2 * 4 * 4, NIT = I0 + I1 + I2 + I3 + I4 + I5 + I6 + I7;
    for (int it = c.bid; it < NIT; it += c.G) {
        int r = it, kind, sub = 0, K, nblk; bf16_t* dst;
        if (r < I0) { kind = 0; K = D; nblk = 112; dst = wb + WB_WIN; }
        else if ((r -= I0) < I1) { kind = 1; sub = r / 128; r -= sub * 128; K = 512; nblk = 16; dst = wb + WB_WBR + (size_t)sub * D * 512; }
        else if ((r -= I1) < I2) { kind = 2; K = D; nblk = 16; dst = wb + WB_WOUT; }
        else if ((r -= I2) < I3) { kind = 3; K = D; nblk = 88; dst = wb + WB_WGU; }
        else if ((r -= I3) < I4) { kind = 4; K = FFN; nblk = 16; dst = wb + WB_WDN; }
        else if ((r -= I4) < I5) { kind = 5; K = 256; nblk = 24; dst = wb + WB_LORA; }
        else if ((r -= I5) < I6) { kind = 6; sub = r / 128; r -= sub * 128; K = 2048; nblk = 4; dst = wb + WB_W1T + (size_t)sub * 256 * 2048; }
        else { r -= I6; kind = 7; sub = r / 16; r -= sub * 16; K = 256; nblk = 4; dst = wb + WB_W2T + (size_t)sub * 256 * 256; }
        const int kb = r / nblk, nb = r % nblk, k0 = kb * 64, n0 = nb * 64;
        const float* src = nullptr; int ld = 0, nvalid = 64; float extra = 1.f; const float* gain = nullptr; bool kvalid = true;
        switch (kind) {
        case 0: { gain = inptr(c, I_NPM) + layer * D + k0; ld = IN_COLS;
            const int scol = n0 < 3096 ? n0 : n0 - 232; nvalid = (n0 < 3096) ? (3096 - n0 < 64 ? 3096 - n0 : 64) : (n0 < 3328 ? 0 : 64);
            if ((n0 >= PC_NQ && n0 < PC_NQ + 512) || (n0 >= PC_SQ && n0 < PC_SQ + 512)) extra = 0.125f;
            src = inptr(c, I_WIN) + ((size_t)layer * D + k0) * IN_COLS + scol; break; }
        case 1: src = inptr(c, I_WBR) + (((size_t)layer * 3 + sub) * 512 + k0) * D + n0; ld = D; break;
        case 2: src = inptr(c, I_WOUT) + ((size_t)layer * D + k0) * D + n0; ld = D; break;
        case 3: { gain = inptr(c, I_NPF) + layer * D + k0; ld = FFN; const int pn = n0 >> 8, rr = n0 & 255;
            src = inptr(c, rr < 128 ? I_FG : I_FU) + ((size_t)layer * D + k0) * FFN + pn * 128 + (rr & 127); break; }
        case 4: src = inptr(c, I_FD) + ((size_t)layer * FFN + k0) * D + n0; ld = D; break;
        case 5: { ld = 512;
            if (n0 < 512) { kvalid = k0 < 64; src = inptr(c, I_W2) + ((size_t)layer * 64 + k0) * 512 + n0; }
            else if (n0 < 1024) { kvalid = (k0 == 64); src = inptr(c, I_A2) + ((size_t)layer * 64 + (k0 - 64)) * 512 + n0 - 512; }
            else { kvalid = k0 >= 128; src = inptr(c, I_G2) + ((size_t)layer * 128 + (k0 - 128)) * 512 + n0 - 1024; }
            break; }
        case 6: src = inptr(c, sub ? I_CVW1 : I_CKW1) + ((size_t)layer * 2048 + k0) * 256 + n0; ld = 256; break;
        default: src = inptr(c, sub ? I_CVW2 : I_CKW2) + ((size_t)layer * 256 + k0) * 64 + n0; ld = 64; nvalid = n0 < 64 ? 64 : 0; break;
        }
#pragma unroll
        for (int i = 0; i < 8; ++i) { const int e = c.tid + 512 * i, kk = e >> 6, nn = e & 63; float v = 0.f;
            if (kvalid && nn < nvalid) { v = src[(size_t)kk * ld + nn] * extra; if (gain) v *= gain[kk]; }
            tile[kk * 65 + nn] = v; }
        __syncthreads();
        { const int nn = c.tid >> 3, kc = (c.tid & 7) * 8; u32x4 w;
          w.x = pk2(tile[(kc + 0) * 65 + nn], tile[(kc + 1) * 65 + nn]); w.y = pk2(tile[(kc + 2) * 65 + nn], tile[(kc + 3) * 65 + nn]);
          w.z = pk2(tile[(kc + 4) * 65 + nn], tile[(kc + 5) * 65 + nn]); w.w = pk2(tile[(kc + 6) * 65 + nn], tile[(kc + 7) * 65 + nn]);
          *(u32x4*)(dst + (size_t)(n0 + nn) * K + k0 + kc) = w; }
        __syncthreads();
    }
    if (c.bid == c.G - 1) {
        const int kv = c.tid >> 8, u = c.tid & 255; const float* w1 = inptr(c, kv ? I_CVW1 : I_CKW1) + (size_t)layer * 2048 * 256; const float* pe = inptr(c, kv ? I_PEV : I_PEK) + (size_t)layer * 2048;
        float acc = 0.f; for (int k = 0; k < 2048; ++k) acc += pe[k] * w1[(size_t)k * 256 + u];
        ((float*)(wb + WB_BH))[c.tid] = acc;
    }
}

struct RowState { float q[64]; float o[64]; float m, l; };
__device__ __forceinline__ void row_init(RowState& s, const bf16_t* qp) {
#pragma unroll
    for (int i = 0; i < 8; ++i) { float f[8]; unpack8(*(const u32x4*)(qp + i * 8), f);
#pragma unroll
        for (int k = 0; k < 8; ++k) s.q[i * 8 + k] = f[k]; }
}
__device__ __forceinline__ void row_reset(RowState& s) {
#pragma unroll
    for (int i = 0; i < 64; ++i) s.o[i] = 0.f;
    s.m = -1e30f; s.l = 0.f;
}
__device__ __forceinline__ void row_key_bf16(RowState& s, const bf16_t* kp, const bf16_t* vp, float bias) {
    float sc = bias;
#pragma unroll
    for (int i = 0; i < 8; ++i) { float f[8]; unpack8(*(const u32x4*)(kp + i * 8), f);
#pragma unroll
        for (int k = 0; k < 8; ++k) sc += s.q[i * 8 + k] * f[k];
        if ((i & 1) == 1) __builtin_amdgcn_sched_barrier(0); }
    const float mn = fmaxf(s.m, sc), corr = __expf(s.m - mn), p = __expf(sc - mn);
    s.l = s.l * corr + p; s.m = mn;
#pragma unroll
    for (int i = 0; i < 8; ++i) { float f[8]; unpack8(*(const u32x4*)(vp + i * 8), f);
#pragma unroll
        for (int k = 0; k < 8; ++k) s.o[i * 8 + k] = s.o[i * 8 + k] * corr + p * f[k];
        if ((i & 1) == 1) __builtin_amdgcn_sched_barrier(0); }
}
__device__ __forceinline__ void row_key_f32(RowState& s, const float* kp, const float* vp, float bias) {
    float sc = bias;
#pragma unroll
    for (int i = 0; i < 16; ++i) { const f32x4 f = *(const f32x4*)(kp + i * 4); sc += s.q[i * 4] * f[0] + s.q[i * 4 + 1] * f[1] + s.q[i * 4 + 2] * f[2] + s.q[i * 4 + 3] * f[3];
        if ((i & 3) == 3) __builtin_amdgcn_sched_barrier(0); }
    const float mn = fmaxf(s.m, sc), corr = __expf(s.m - mn), p = __expf(sc - mn);
    s.l = s.l * corr + p; s.m = mn;
#pragma unroll
    for (int i = 0; i < 16; ++i) { const f32x4 f = *(const f32x4*)(vp + i * 4);
#pragma unroll
        for (int k = 0; k < 4; ++k) s.o[i * 4 + k] = s.o[i * 4 + k] * corr + p * f[k];
        if ((i & 3) == 3) __builtin_amdgcn_sched_barrier(0); }
}

__device__ __forceinline__ float gelu_tanh(float x) { const float t = tanhf(0.7978845608028654f * (x + 0.044715f * x * x * x)); return 0.5f * x * (1.0f + t); }
__device__ __forceinline__ void phase_cmp1(const Ctx& c, const Args& a, int layer, const bf16_t* proj, float* hid) {
    for (int unit = c.bid; unit < 2048; unit += c.G) {
        const int kv = unit >> 10, g = (unit >> 9) & 1, cp = unit & 511; const int cc = cp * 2 + (c.tid >> 8), u = c.tid & 255;
        if (cc >= NCMP) continue;
        const float* w1 = a.in[kv ? I_CVW1 : I_CKW1] + (size_t)layer * 2048 * 256; const float* pe = a.in[kv ? I_PEV : I_PEK] + (size_t)layer * 32 * 64;
        const bf16_t* xp = proj + (size_t)(16 * cc) * PLD + (kv ? PC_VC : PC_KC) + g * 64;
        float acc = 0.f;
        for (int l = 0; l < 32; ++l) {
#pragma unroll
            for (int i = 0; i < 8; ++i) { float f[8]; unpack8(*(const u32x4*)(xp + (size_t)l * PLD + i * 8), f);
#pragma unroll
                for (int k = 0; k < 8; ++k) acc += (f[k] + pe[l * 64 + i * 8 + k]) * w1[(size_t)(l * 64 + i * 8 + k) * 256 + u]; }
        }
        hid[(((size_t)kv * 2 + g) * 1024 + cc) * 256 + u] = gelu_tanh(acc);
    }
}
__device__ __forceinline__ void phase_cmp2(const Ctx& c, const Args& a, int layer, const float* hid, bf16_t* kcb, bf16_t* vctb) {
    for (int unit = c.bid; unit < 512; unit += c.G) {
        const int kv = unit >> 8, g = (unit >> 7) & 1, cc = (unit & 127) * 8 + (c.tid >> 6), d = c.tid & 63;
        float acc = 0.f;
        if (cc < NCMP) { const float* w2 = a.in[kv ? I_CVW2 : I_CKW2] + (size_t)layer * 256 * 64; const float* hp = hid + (((size_t)kv * 2 + g) * 1024 + cc) * 256;
            for (int u = 0; u < 256; ++u) acc += hp[u] * w2[u * 64 + d]; }
        if (kv) vctb[((size_t)g * 64 + d) * 1024 + cc] = (bf16_t)f2bf(acc); else kcb[((size_t)g * 1024 + cc) * 64 + d] = (bf16_t)f2bf(acc);
    }
}
__device__ __forceinline__ void phase_nsa13(const Ctx& c, const Args& a, const bf16_t* proj, const float* kcmp, const float* vcmp, float* nsaacc, float* ml) {
    LAS float* tb = (LAS float*)c.lds;
    for (int e = c.tid; e < 512; e += 512) tb[e] = inptr(c, I_REL)[e];
    __syncthreads();
    for (int unit = c.bid; unit < T / 64; unit += c.G) {
        const int hh = c.tid >> 6, t = unit * 64 + (c.tid & 63), g = hh >> 2;
        RowState s; row_init(s, proj + (size_t)t * PLD + PC_NQ + hh * 64);
        const bf16_t* glp = proj + (size_t)t * PLD + PC_GL;
        const float g0 = sigmoidf_(bf2f(glp[hh])), g2 = sigmoidf_(bf2f(glp[16 + hh]));
        row_reset(s);
        const int nv = t >= 31 ? (t - 31) / 16 + 1 : 0;
        for (int cc = 0; cc < nv; ++cc) { const float bias = tb[t5_bucket(t - 16 * cc - 31) * 16 + hh];
            row_key_f32(s, kcmp + ((size_t)g * 1024 + cc) * 64, vcmp + ((size_t)g * 1024 + cc) * 64, bias); }
        ml[((size_t)t * 8 + hh) * 2] = s.m; ml[((size_t)t * 8 + hh) * 2 + 1] = s.l;
        float* op = nsaacc + (size_t)t * 512 + hh * 64;
        { const float inv = s.l > 0.f ? g0 / s.l : 0.f;
#pragma unroll
            for (int i = 0; i < 16; ++i) { f32x4 w; w[0] = s.o[i * 4] * inv; w[1] = s.o[i * 4 + 1] * inv; w[2] = s.o[i * 4 + 2] * inv; w[3] = s.o[i * 4 + 3] * inv; *(f32x4*)(op + i * 4) = w; } }
        row_reset(s);
        const int s0 = t - 511 > 0 ? t - 511 : 0;
        for (int sp = s0; sp <= t; ++sp) { const float bias = tb[t5_bucket(t - sp) * 16 + hh];
            row_key_bf16(s, proj + (size_t)sp * PLD + PC_KW + g * 64, proj + (size_t)sp * PLD + PC_VW + g * 64, bias); }
        { const float inv = s.l > 0.f ? g2 / s.l : 0.f;
#pragma unroll
            for (int i = 0; i < 16; ++i) { f32x4 w = *(const f32x4*)(op + i * 4); w[0] += s.o[i * 4] * inv; w[1] += s.o[i * 4 + 1] * inv; w[2] += s.o[i * 4 + 2] * inv; w[3] += s.o[i * 4 + 3] * inv; *(f32x4*)(op + i * 4) = w; } }
    }
}
__device__ __forceinline__ void phase_nsa_topk(const Ctx& c, const Args& a, const bf16_t* proj, const float* kcmp, const float* ml, int* sel) {
    LAS float* tb = (LAS float*)c.lds;
    LAS float* qs = (LAS float*)(c.lds + 4096) + c.wave * 256;
    LAS float* sv = (LAS float*)(c.lds + 16384) + c.wave * 256;
    for (int e = c.tid; e < 512; e += 512) tb[e] = inptr(c, I_REL)[e];
    __syncthreads();
    const int gw = c.bid * 8 + c.wave, NGW = c.G * 8;
    for (int item = gw; item < T * 2; item += NGW) {
        const int t = item >> 1, g = item & 1, cur = t >> 6;
        { const bf16_t* qp = proj + (size_t)t * PLD + PC_NQ + g * 256 + c.lane * 4; const u32x2 w = *(const u32x2*)qp;
          qs[c.lane * 4] = __uint_as_float(w.x << 16); qs[c.lane * 4 + 1] = __uint_as_float(w.x & 0xffff0000u); qs[c.lane * 4 + 2] = __uint_as_float(w.y << 16); qs[c.lane * 4 + 3] = __uint_as_float(w.y & 0xffff0000u); }
        float mr[4], il[4];
#pragma unroll
        for (int r = 0; r < 4; ++r) { mr[r] = ml[((size_t)t * 8 + g * 4 + r) * 2]; const float l = ml[((size_t)t * 8 + g * 4 + r) * 2 + 1]; il[r] = l > 0.f ? 1.0f / l : 0.f; }
        const int nv = t >= 31 ? (t - 31) / 16 + 1 : 0;
        asm volatile("s_waitcnt lgkmcnt(0)" ::: "memory");
#pragma unroll 1
        for (int jj = 0; jj < 4; ++jj) {
            const int j = c.lane + 64 * jj; float sc;
            if (j == 0 || j == cur || j == cur - 1) sc = 1e4f;
            else if (j > cur) sc = -1.0f;
            else { sc = 0.f;
#pragma unroll 1
                for (int o = 0; o < 5; ++o) { const int cc = 4 * j + o - 1; if (cc < 0 || cc >= nv) continue;
                    const float* kp = kcmp + ((size_t)g * 1024 + cc) * 64; float d0 = 0.f, d1 = 0.f, d2 = 0.f, d3 = 0.f;
#pragma unroll 4
                    for (int i = 0; i < 16; ++i) { const f32x4 f = *(const f32x4*)(kp + i * 4);
#pragma unroll
                        for (int k = 0; k < 4; ++k) { d0 += qs[i * 4 + k] * f[k]; d1 += qs[64 + i * 4 + k] * f[k]; d2 += qs[128 + i * 4 + k] * f[k]; d3 += qs[192 + i * 4 + k] * f[k]; } }
                    const int bk = t5_bucket(t - 16 * cc - 31) * 16 + g * 4;
                    const float imp = __expf(d0 + tb[bk] - mr[0]) * il[0] + __expf(d1 + tb[bk + 1] - mr[1]) * il[1] + __expf(d2 + tb[bk + 2] - mr[2]) * il[2] + __expf(d3 + tb[bk + 3] - mr[3]) * il[3];
                    sc += ((o == 0 || o == 4) ? 1.0f : 2.0f) * imp; }
            }
            sv[j] = sc;
        }
        asm volatile("s_waitcnt lgkmcnt(0)" ::: "memory");
        float val[4];
#pragma unroll
        for (int jj = 0; jj < 4; ++jj) val[jj] = sv[c.lane + 64 * jj];
        for (int k = 0; k < 16; ++k) {
            float bv = val[0]; int bi = c.lane;
#pragma unroll
            for (int jj = 1; jj < 4; ++jj) if (val[jj] > bv) { bv = val[jj]; bi = c.lane + 64 * jj; }
#pragma unroll
            for (int o = 32; o >= 1; o >>= 1) { const float ov = __shfl_xor(bv, o); const int oi = __shfl_xor(bi, o); if (ov > bv || (ov == bv && oi < bi)) { bv = ov; bi = oi; } }
#pragma unroll
            for (int jj = 0; jj < 4; ++jj) if (bi == c.lane + 64 * jj) val[jj] = -3e38f;
            if (c.lane == 0) sel[(size_t)item * 16 + k] = bi;
        }
    }
}
__device__ __forceinline__ void phase_nsa2(const Ctx& c, const Args& a, const bf16_t* proj, const int* sel, const float* nsaacc, bf16_t* onsa) {
    LAS float* tb = (LAS float*)c.lds;
    for (int e = c.tid; e < 512; e += 512) tb[e] = inptr(c, I_REL)[e];
    __syncthreads();
    for (int unit = c.bid; unit < T / 64; unit += c.G) {
        const int hh = c.tid >> 6, t = unit * 64 + (c.tid & 63), g = hh >> 2;
        RowState s; row_init(s, proj + (size_t)t * PLD + PC_NQ + hh * 64); row_reset(s);
        const float g1 = sigmoidf_(bf2f(proj[(size_t)t * PLD + PC_GL + 8 + hh]));
        for (int k = 0; k < 16; ++k) { const int j = sel[((size_t)t * 2 + g) * 16 + k];
            for (int p = 0; p < 64; ++p) { const int pos = j * 64 + p; if (pos > t) break;
                const float bias = tb[t5_bucket(t - pos) * 16 + hh];
                row_key_bf16(s, proj + (size_t)pos * PLD + PC_KS + g * 64, proj + (size_t)pos * PLD + PC_VS + g * 64, bias); } }
        const float inv = s.l > 0.f ? g1 / s.l : 0.f; const float* ap = nsaacc + (size_t)t * 512 + hh * 64; bf16_t* op = onsa + (size_t)t * 512 + hh * 64;
#pragma unroll
        for (int i = 0; i < 8; ++i) { const f32x4 x0 = *(const f32x4*)(ap + i * 8), x1 = *(const f32x4*)(ap + i * 8 + 4); u32x4 w;
            w.x = pk2(x0[0] + s.o[i * 8] * inv, x0[1] + s.o[i * 8 + 1] * inv); w.y = pk2(x0[2] + s.o[i * 8 + 2] * inv, x0[3] + s.o[i * 8 + 3] * inv);
            w.z = pk2(x1[0] + s.o[i * 8 + 4] * inv, x1[1] + s.o[i * 8 + 5] * inv); w.w = pk2(x1[2] + s.o[i * 8 + 6] * inv, x1[3] + s.o[i * 8 + 7] * inv);
            *(u32x4*)(op + i * 8) = w; }
    }
}
__device__ __forceinline__ void phase_swa(const Ctx& c, const Args& a, int layer, const bf16_t* proj, bf16_t* oswa) {
    LAS float* tb = (LAS float*)c.lds;
    for (int e = c.tid; e < 512; e += 512) tb[e] = inptr(c, I_REL)[e];
    __syncthreads();
    for (int unit = c.bid; unit < T / 64; unit += c.G) {
        const int hh = c.tid >> 6, t = unit * 64 + (c.tid & 63), g = hh >> 2;
        RowState s; row_init(s, proj + (size_t)t * PLD + PC_SQ + hh * 64); row_reset(s);
        const int s0 = t - 127 > 0 ? t - 127 : 0;
        for (int sp = s0; sp <= t; ++sp) { const float bias = tb[t5_bucket(t - sp) * 16 + 8 + hh];
            row_key_bf16(s, proj + (size_t)sp * PLD + PC_SK + g * 64, proj + (size_t)sp * PLD + PC_SV + g * 64, bias); }
        const float sink = inptr(c, I_SINK)[layer * 8 + hh]; const float mf = fmaxf(s.m, sink); const float corr = __expf(s.m - mf);
        const float den = s.l * corr + __expf(sink - mf); const float inv = corr / den;
        bf16_t* op = oswa + (size_t)t * 512 + hh * 64;
#pragma unroll
        for (int i = 0; i < 8; ++i) { u32x4 w; w.x = pk2(s.o[i * 8] * inv, s.o[i * 8 + 1] * inv); w.y = pk2(s.o[i * 8 + 2] * inv, s.o[i * 8 + 3] * inv);
            w.z = pk2(s.o[i * 8 + 4] * inv, s.o[i * 8 + 5] * inv); w.w = pk2(s.o[i * 8 + 6] * inv, s.o[i * 8 + 7] * inv); *(u32x4*)(op + i * 8) = w; }
    }
}

constexpr int RL = 65;
__device__ __forceinline__ float rwkv_mixed(const bf16_t* proj, const float* mu, int t, int col) {
    const float cur = bf2f(proj[(size_t)t * PLD + col]); const float prev = t > 0 ? bf2f(proj[(size_t)(t - 1) * PLD + col]) : 0.f;
    return cur + (prev - cur) * mu[col];
}
__device__ __forceinline__ void lora64(const Ctx& c, const LAS float* in, const float* W, const float* bias, LAS float* out, bool accum) {
    const int j = c.tid & 63, tg = (c.tid >> 6) * 8;
    float acc[8];
#pragma unroll
    for (int i = 0; i < 8; ++i) acc[i] = accum ? out[(tg + i) * RL + j] : (bias ? bias[j] : 0.f);
#pragma unroll 4
    for (int m = 0; m < 64; ++m) { const float w = W[(size_t)m * 512 + j];
#pragma unroll
        for (int i = 0; i < 8; ++i) acc[i] += in[(tg + i) * RL + m] * w; }
#pragma unroll
    for (int i = 0; i < 8; ++i) out[(tg + i) * RL + j] = acc[i];
}
struct RwkvLds { LAS float *R, *K, *V, *A, *B, *W, *G, *TMP; };
__device__ __forceinline__ RwkvLds rwkv_lds(LAS unsigned char* lds) {
    RwkvLds s; LAS float* p = (LAS float*)lds; constexpr int SZ = 64 * RL;
    s.R = p; s.K = p + SZ; s.V = p + 2 * SZ; s.A = p + 3 * SZ; s.B = p + 4 * SZ; s.W = p + 5 * SZ; s.G = p + 6 * SZ; s.TMP = p + 7 * SZ; return s;
}
template <bool LOGDECAY>
__device__ __forceinline__ void rwkv_prep(const Ctx& c, const Args& a, int layer, const bf16_t* proj, int t0, int h, const RwkvLds& s) {
    const float* mu = inptr(c, I_MU) + (size_t)layer * 1792;
    const int j = c.tid & 63, tg = c.tid >> 6;
#pragma unroll 2
    for (int i = 0; i < 8; ++i) { const int tt = tg * 8 + i; s.TMP[tt * RL + j] = tanhf(rwkv_mixed(proj, mu, t0 + tt, PC_ZW + j)); }
    __syncthreads();
    lora64(c, s.TMP, inptr(c, I_W2) + (size_t)layer * 64 * 512 + h * 64, inptr(c, I_W0) + layer * 512 + h * 64, s.W, false);
    __syncthreads();
#pragma unroll 2
    for (int i = 0; i < 8; ++i) { const int tt = tg * 8 + i; s.TMP[tt * RL + j] = rwkv_mixed(proj, mu, t0 + tt, PC_ZA + j); }
    __syncthreads();
    lora64(c, s.TMP, inptr(c, I_A2) + (size_t)layer * 64 * 512 + h * 64, inptr(c, I_A0) + layer * 512 + h * 64, s.B, false);
    __syncthreads();
#pragma unroll 2
    for (int i = 0; i < 8; ++i) { const int tt = tg * 8 + i; s.TMP[tt * RL + j] = sigmoidf_(rwkv_mixed(proj, mu, t0 + tt, PC_ZG + j)); }
    __syncthreads();
    lora64(c, s.TMP, inptr(c, I_G2) + (size_t)layer * 128 * 512 + h * 64, nullptr, s.G, false);
    __syncthreads();
#pragma unroll 2
    for (int i = 0; i < 8; ++i) { const int tt = tg * 8 + i; s.TMP[tt * RL + j] = sigmoidf_(rwkv_mixed(proj, mu, t0 + tt, PC_ZG + 64 + j)); }
    __syncthreads();
    lora64(c, s.TMP, inptr(c, I_G2) + ((size_t)layer * 128 + 64) * 512 + h * 64, nullptr, s.G, true);
    const float kkw = inptr(c, I_KK)[layer * 512 + h * 64 + j], kaw = inptr(c, I_KA)[layer * 512 + h * 64 + j];
#pragma unroll 1
    for (int i = 0; i < 8; ++i) { const int tt = tg * 8 + i, t = t0 + tt;
        const float r = rwkv_mixed(proj, mu, t, PC_R + h * 64 + j), k = rwkv_mixed(proj, mu, t, PC_K + h * 64 + j), v = rwkv_mixed(proj, mu, t, PC_V + h * 64 + j);
        const float wl = s.W[tt * RL + j], al = sigmoidf_(s.B[tt * RL + j]);
        const float sp = (-wl > 20.f) ? -wl : log1pf(__expf(-wl)); const float w = -sp - 0.5f; const float ew = __expf(w);
        float kk = k * kkw; const float n2 = wave_sum(kk * kk); kk = kk / fmaxf(sqrtf(n2), 1e-12f);
        s.R[tt * RL + j] = r; s.V[tt * RL + j] = v; s.K[tt * RL + j] = k * (1.0f + (al - 1.0f) * kaw);
        s.A[tt * RL + j] = -kk; s.B[tt * RL + j] = kk * al; s.W[tt * RL + j] = LOGDECAY ? -ew : __expf(-ew); }
    __syncthreads();
}
__device__ __forceinline__ void rwkv_post(const Ctx& c, const Args& a, int layer, int t0, int h, const RwkvLds& s, const LAS float* Y, bf16_t* orwkv) {
    const int i = c.lane, tg = c.wave;
    const float lnw = inptr(c, I_LNW)[layer * 512 + h * 64 + i], lnb = inptr(c, I_LNB)[layer * 512 + h * 64 + i], rk = inptr(c, I_RK)[layer * 512 + h * 64 + i];
#pragma unroll 1
    for (int q = 0; q < 8; ++q) { const int tt = tg * 8 + q; const float y = Y[tt * RL + i];
        const float mean = wave_sum(y) * (1.0f / 64.0f); const float d = y - mean; const float var = wave_sum(d * d) * (1.0f / 64.0f);
        const float bonus = wave_sum(s.R[tt * RL + i] * s.K[tt * RL + i] * rk);
        const float o = (d * rsqrtf(var + 64e-5f) * lnw + lnb + bonus * s.V[tt * RL + i]) * s.G[tt * RL + i];
        orwkv[(size_t)(t0 + tt) * 512 + h * 64 + i] = (bf16_t)f2bf(o); }
}
__device__ __forceinline__ void phase_rwkv_naive(const Ctx& c, const Args& a, int layer, const bf16_t* proj, bf16_t* orwkv) {
    if (c.bid >= 8) return;
    const int h = c.bid; const RwkvLds s = rwkv_lds(c.lds);
    float S[64];
#pragma unroll
    for (int j = 0; j < 64; ++j) S[j] = 0.f;
    for (int ch = 0; ch < T / 64; ++ch) {
        rwkv_prep<false>(c, a, layer, proj, ch * 64, h, s);
        if (c.wave == 0) {
            const int i = c.lane;
            for (int tt = 0; tt < 64; ++tt) {
                float sa = 0.f;
#pragma unroll
                for (int j = 0; j < 64; ++j) { sa += S[j] * s.A[tt * RL + j]; if ((j & 7) == 7) __builtin_amdgcn_sched_barrier(0); }
                const float vi = s.V[tt * RL + i]; float y = 0.f;
#pragma unroll
                for (int j = 0; j < 64; ++j) { S[j] = S[j] * s.W[tt * RL + j] + sa * s.B[tt * RL + j] + vi * s.K[tt * RL + j]; y += S[j] * s.R[tt * RL + j]; if ((j & 3) == 3) __builtin_amdgcn_sched_barrier(0); }
                s.TMP[tt * RL + i] = y;
            }
        }
        __syncthreads();
        rwkv_post(c, a, layer, ch * 64, h, s, s.TMP, orwkv);
        __syncthreads();
    }
}


__device__ __forceinline__ int kperm32(int jl) { return 8 * ((jl >> 2) & 3) + 4 * (jl >> 4) + (jl & 3); }
__device__ __forceinline__ f32x4 tile_mma64(const LAS unsigned char* A, const LAS unsigned char* B, int a, int b, int lane, f32x4 acc) {
    const int m = lane & 15, q = lane >> 4;
#pragma unroll
    for (int ks = 0; ks < 2; ++ks) {
        const bf16x8 af = *(const LAS bf16x8*)(A + (16 * a + m) * 144 + (32 * ks + 8 * q) * 2);
        const bf16x8 bf = *(const LAS bf16x8*)(B + (16 * b + m) * 144 + (32 * ks + 8 * q) * 2);
        acc = __builtin_amdgcn_mfma_f32_16x16x32_bf16(af, bf, acc, 0, 0, 0);
    }
    return acc;
}
__device__ __forceinline__ void lds_st_bf16(LAS unsigned char* base, int idx, float v) { *(LAS bf16_t*)(base + idx * 2) = (bf16_t)f2bf(v); }

__device__ __forceinline__ void phase_lora_a(const Ctx& c, const Args& a, int layer, const bf16_t* proj, bf16_t* alora) {
    const float* mu = inptr(c, I_MU) + (size_t)layer * 1792;
    const int sub = c.tid & 31, rloc = c.tid >> 5;
    for (int t = c.bid * 16 + rloc; t < T; t += c.G * 16) {
        const int col = PC_ZW + sub * 8; float cur[8], prv[8];
        unpack8(*(const u32x4*)(proj + (size_t)t * PLD + col), cur);
        if (t > 0) unpack8(*(const u32x4*)(proj + (size_t)(t - 1) * PLD + col), prv); else {
#pragma unroll
            for (int k = 0; k < 8; ++k) prv[k] = 0.f; }
        float o[8];
#pragma unroll
        for (int k = 0; k < 8; ++k) { const float v = cur[k] + (prv[k] - cur[k]) * mu[col + k]; o[k] = sub < 8 ? tanhf(v) : (sub < 16 ? v : sigmoidf_(v)); }
        u32x4 w; w.x = pk2(o[0], o[1]); w.y = pk2(o[2], o[3]); w.z = pk2(o[4], o[5]); w.w = pk2(o[6], o[7]);
        *(u32x4*)(alora + (size_t)t * 256 + sub * 8) = w;
    }
}

constexpr int RC_L = 0, RC_AL = 16640, RC_AAK = 0, RC_ARB = 9216, RC_ARK = 18432, RC_AAB = 33280, RC_P2T = 33280, RC_WC = 50688, RC_BS = 50944, RC_M = 52992;
constexpr int RC_AT = RC_M, RC_TINV = RC_M, RC_ATT = RC_M + 9216, RC_RT = RC_M + 2 * 9216, RC_BT = RC_M + 3 * 9216, RC_XT = RC_BT, RC_KT = RC_M + 4 * 9216, RC_P1T = RC_KT,
              RC_VT = RC_M + 5 * 9216, RC_BHT = RC_M + 6 * 9216, RC_KHT = RC_M + 7 * 9216;
constexpr int RC_XOFF = RC_M + 8 * 9216, RC_XTMP = RC_XOFF + 6144;
static_assert(RC_XTMP + 3 * 1088 <= LDS_MISC, "rwkv chunk LDS");

__device__ __forceinline__ void phase_rwkv_chunk(const Ctx& c, const Args& a, int layer, const bf16_t* proj, const bf16_t* wlb, const bf16_t* alb, bf16_t* rwu, float* bonusg) {
    LAS unsigned char* L = c.lds;
    LAS float* sL = (LAS float*)(L + RC_L); LAS float* sAL = (LAS float*)(L + RC_AL); LAS float* sAAB = (LAS float*)(L + RC_AAB);
    LAS float* sWC = (LAS float*)(L + RC_WC); LAS float* sBS = (LAS float*)(L + RC_BS);
    const float* mu = inptr(c, I_MU) + (size_t)layer * 1792;
    const int lane = c.lane, wave = c.wave, n = lane & 15, q = lane >> 4;
    for (int unit = c.bid; unit < 2048; unit += c.G) {
        const int ch = unit >> 3, h = unit & 7, t0 = ch * 64, j = lane;
        {
            const float w0 = inptr(c, I_W0)[layer * 512 + h * 64 + j], a0 = inptr(c, I_A0)[layer * 512 + h * 64 + j];
            bf16_t wraw[8], araw[8];
#pragma unroll
            for (int i = 0; i < 8; ++i) { const size_t gi = (size_t)(t0 + wave * 8 + i) * 512 + h * 64 + j; wraw[i] = wlb[gi]; araw[i] = alb[gi]; }
            float run = 0.f;
#pragma unroll
            for (int i = 0; i < 8; ++i) { const int tt = wave * 8 + i;
                const float wl = w0 + bf2f(wraw[i]); const float nx = -wl; const float sp = nx > 20.f ? nx : log1pf(__expf(nx)); const float ld = -__expf(-sp - 0.5f);
                run += ld; sL[tt * RL + j] = run; sAL[tt * RL + j] = sigmoidf_(a0 + bf2f(araw[i])); }
            sBS[wave * 64 + j] = run;
        }
        bf16_t rraw[9], kraw[9], vraw[9];
        {
#pragma unroll
            for (int i = 0; i < 9; ++i) { const int t = t0 + wave * 8 + i - 1; const bool ok = t >= 0; const size_t ro = (size_t)(ok ? t : 0) * PLD + h * 64 + j;
                rraw[i] = ok ? proj[ro + PC_R] : (bf16_t)0; kraw[i] = ok ? proj[ro + PC_K] : (bf16_t)0; vraw[i] = ok ? proj[ro + PC_V] : (bf16_t)0; }
        }
        __syncthreads();
        {
            float off = 0.f, tot = 0.f;
#pragma unroll
            for (int w2 = 0; w2 < 8; ++w2) { const float v = sBS[w2 * 64 + j]; tot += v; off += (w2 < wave) ? v : 0.f; }
            if (wave == 0) sWC[j] = __expf(tot);
            const float kkw = inptr(c, I_KK)[layer * 512 + h * 64 + j], kaw = inptr(c, I_KA)[layer * 512 + h * 64 + j], rk = inptr(c, I_RK)[layer * 512 + h * 64 + j];
            const float mur = mu[PC_R + h * 64 + j], muk = mu[PC_K + h * 64 + j], muv = mu[PC_V + h * 64 + j];
            float Lprev = off;
#pragma unroll
            for (int i = 0; i < 8; ++i) { const int tt = wave * 8 + i, t = t0 + tt;
                const float Lc = sL[tt * RL + j] + off, al = sAL[tt * RL + j];
                const float rc = bf2f(rraw[i + 1]), kc = bf2f(kraw[i + 1]), vc = bf2f(vraw[i + 1]);
                const float r = rc + (bf2f(rraw[i]) - rc) * mur, k = kc + (bf2f(kraw[i]) - kc) * muk, v = vc + (bf2f(vraw[i]) - vc) * muv;
                float kk = k * kkw; const float n2 = wave_sum(kk * kk); kk = kk / fmaxf(sqrtf(n2), 1e-12f);
                const float kp = k * (1.0f + (al - 1.0f) * kaw), av = -kk, bv = kk * al;
                const float eW = __expf(Lc), eWex = __expf(Lprev), eInv = __expf(-Lc), eC = __expf(tot - Lc);
                lds_st_bf16(L + RC_AT, tt * 72 + j, av * eWex); lds_st_bf16(L + RC_ATT, j * 72 + tt, av * eWex);
                lds_st_bf16(L + RC_RT, tt * 72 + j, r * eW); lds_st_bf16(L + RC_BT, tt * 72 + j, bv * eInv); lds_st_bf16(L + RC_KT, tt * 72 + j, kp * eInv);
                lds_st_bf16(L + RC_VT, j * 72 + tt, v); lds_st_bf16(L + RC_BHT, j * 72 + tt, bv * eC); lds_st_bf16(L + RC_KHT, j * 72 + tt, kp * eC);
                const float bon = wave_sum(r * kp * rk); if (lane == 0) bonusg[(size_t)t * 8 + h] = bon;
                Lprev = Lc; }
        }
        __syncthreads();
        for (int job = wave; job < 64; job += 8) {
            const int p = job >> 4, ta = (job >> 2) & 3, tb = job & 3;
            f32x4 acc = (f32x4){0.f, 0.f, 0.f, 0.f};
            if (ta >= tb) acc = tile_mma64(L + (p < 2 ? RC_AT : RC_RT), L + ((p & 1) ? RC_KT : RC_BT), ta, tb, lane, acc);
            LAS unsigned char* dst = L + (p == 1 ? RC_AAK : (p == 2 ? RC_ARB : RC_ARK));
#pragma unroll
            for (int r = 0; r < 4; ++r) { const int tt = 16 * ta + 4 * q + r, ss = 16 * tb + n; const bool keep = (p < 2) ? (ss < tt) : (ss <= tt); const float v = keep ? acc[r] : 0.f;
                if (p == 0) sAAB[tt * 68 + ss] = v; else lds_st_bf16(dst, tt * 72 + ss, v); }
        }
        __syncthreads();
        if (wave == 0) {
            const int blk = lane >> 4, cc = lane & 15; const LAS float* Ab = sAAB + (16 * blk) * 68 + 16 * blk; float xr[16];
#pragma unroll
            for (int tt = 0; tt < 16; ++tt) { float acc = (tt == cc) ? 1.f : 0.f;
#pragma unroll
                for (int ss = 0; ss < tt; ++ss) acc += Ab[tt * 68 + ss] * xr[ss];
                xr[tt] = acc; }
            asm volatile("s_waitcnt lgkmcnt(0)" ::: "memory");
#pragma unroll
            for (int tt = 0; tt < 16; ++tt) sAAB[(16 * blk + tt) * 68 + 16 * blk + cc] = xr[tt];
        } else {
            for (int job = wave - 1; job < 16; job += 7) { const int ta = job >> 2, tb = job & 3;
                const f32x4 acc = tile_mma64(L + RC_VT, L + RC_AAK, ta, tb, lane, (f32x4){0.f, 0.f, 0.f, 0.f});
#pragma unroll
                for (int r = 0; r < 4; ++r) lds_st_bf16(L + RC_XT, (16 * ta + 4 * q + r) * 72 + 16 * tb + n, acc[r]); }
        }
        __syncthreads();
        {
            LAS float* sXO = (LAS float*)(L + RC_XOFF); LAS float* sT = (LAS float*)(L + RC_XTMP) + wave * 272;
            const int rr = lane >> 2, c4 = (lane & 3) * 4;
#pragma unroll 1
            for (int lev = 1; lev <= 3; ++lev) {
                if (wave < 4 - lev) {
                    const int J = wave, I = wave + lev;
                    f32x4 tacc = (f32x4){0.f, 0.f, 0.f, 0.f};
                    for (int K = J; K < I; ++K) {
                        const LAS float* Ap = sAAB + (16 * I + rr) * 68 + 16 * K; const LAS float* Xp;
                        int xs;
                        if (K == J) { Xp = sAAB + (16 * J) * 68 + 16 * J + c4; xs = 68; }
                        else { const int d = K - J; const int bi = (d == 1) ? J : 3 + J; Xp = sXO + bi * 256 + c4; xs = 16; }
#pragma unroll
                        for (int k = 0; k < 16; ++k) { const float av = Ap[k]; const f32x4 xv = *(const LAS f32x4*)(Xp + k * xs); tacc += xv * av; }
                    }
                    *(LAS f32x4*)(sT + rr * 16 + c4) = tacc;
                    asm volatile("s_waitcnt lgkmcnt(0)" ::: "memory");
                    f32x4 xacc = (f32x4){0.f, 0.f, 0.f, 0.f};
                    const LAS float* Dp = sAAB + (16 * I + rr) * 68 + 16 * I;
#pragma unroll
                    for (int k = 0; k < 16; ++k) { const float dv = Dp[k]; const f32x4 tv = *(const LAS f32x4*)(sT + k * 16 + c4); xacc += tv * dv; }
                    const int bo = (lev == 1) ? J : (lev == 2 ? 3 + J : 5);
                    *(LAS f32x4*)(sXO + bo * 256 + rr * 16 + c4) = xacc;
                }
                __syncthreads();
            }
            for (int e = c.tid; e < 4096; e += 512) { const int tt = e >> 6, ss = e & 63, I = tt >> 4, J = ss >> 4; float v = 0.f;
                if (I == J) v = sAAB[tt * 68 + ss];
                else if (I > J) { const int d = I - J; const int bi = (d == 1) ? J : (d == 2 ? 3 + J : 5); v = sXO[bi * 256 + (tt & 15) * 16 + (ss & 15)]; }
                lds_st_bf16(L + RC_TINV, tt * 72 + ss, v); }
        }
        __syncthreads();
        for (int job = wave; job < 32; job += 8) { const int p = job >> 4, ta = (job >> 2) & 3, tb = job & 3;
            const f32x4 acc = tile_mma64(L + (p ? RC_XT : RC_ATT), L + RC_TINV, ta, tb, lane, (f32x4){0.f, 0.f, 0.f, 0.f});
#pragma unroll
            for (int r = 0; r < 4; ++r) lds_st_bf16(L + (p ? RC_P2T : RC_P1T), (16 * ta + 4 * q + r) * 72 + 16 * tb + n, acc[r]); }
        __syncthreads();
        bf16_t* ug = rwu + (size_t)unit * 16384;
        for (int job = wave; job < 64; job += 8) { const int p = job >> 4, ta = (job >> 2) & 3, tb = job & 3;
            f32x4 acc = (f32x4){0.f, 0.f, 0.f, 0.f};
            if (p == 0) { acc = tile_mma64(L + RC_ARB, L + RC_P1T, ta, tb, lane, acc);
#pragma unroll
                for (int r = 0; r < 4; ++r) { const int tt = 16 * ta + 4 * q + r, jj = 16 * tb + n; const float v = acc[r] + bf2f(*(const LAS bf16_t*)(L + RC_RT + (tt * 72 + jj) * 2));
                    ug[8192 + tt * 64 + (jj & 32) + kperm32(jj & 31)] = (bf16_t)f2bf(v); } }
            else if (p == 1) { acc = tile_mma64(L + RC_ARB, L + RC_P2T, ta, tb, lane, acc); acc = tile_mma64(L + RC_ARK, L + RC_VT, ta, tb, lane, acc);
                u32x2 w; w.x = pk2(acc[0], acc[1]); w.y = pk2(acc[2], acc[3]); *(u32x2*)(ug + 12288 + ((tb * 4 + ta) * 64 + lane) * 4) = w; }
            else if (p == 2) { acc = tile_mma64(L + RC_BHT, L + RC_P1T, ta, tb, lane, acc);
#pragma unroll
                for (int r = 0; r < 4; ++r) { const int jr = 16 * ta + 4 * q + r, jc = 16 * tb + n; const float v = acc[r] + (jr == jc ? sWC[jr] : 0.f);
                    ug[jr * 64 + (jc & 32) + kperm32(jc & 31)] = (bf16_t)f2bf(v); } }
            else { acc = tile_mma64(L + RC_BHT, L + RC_P2T, ta, tb, lane, acc); acc = tile_mma64(L + RC_KHT, L + RC_VT, ta, tb, lane, acc);
                u32x2 w; w.x = pk2(acc[0], acc[1]); w.y = pk2(acc[2], acc[3]); *(u32x2*)(ug + 4096 + ((tb * 4 + ta) * 64 + lane) * 4) = w; }
        }
        __syncthreads();
    }
}

#define RW_LOAD_SET(SET, UNIT) do { const bf16_t* ug_ = rwu + (size_t)(UNIT) * 16384; \
    _Pragma("unroll") for (int ta = 0; ta < 4; ++ta) { An[SET][ta][0] = *(const bf16x8*)(ug_ + (16 * ta + m) * 64 + 8 * q); An[SET][ta][1] = *(const bf16x8*)(ug_ + (16 * ta + m) * 64 + 32 + 8 * q); \
        Zn[SET][ta] = *(const u32x2*)(ug_ + 4096 + ((cq * 4 + ta) * 64 + lane) * 4); } } while (0)
template <int SM>
__device__ __forceinline__ void phase_rwkv_scan(const Ctx& c, const bf16_t* rwu, bf16_t* rws) {
    const int idx = c.bid; if (idx >= 32 || c.wave != 0) return;
    const int h = idx >> 2, cq = idx & 3, lane = c.lane, m = lane & 15, q = lane >> 4;
    bf16x8 Bhi[2], Blo[2];
#pragma unroll
    for (int s = 0; s < 2; ++s) { Bhi[s] = (bf16x8){0, 0, 0, 0, 0, 0, 0, 0}; Blo[s] = Bhi[s]; }
    bf16x8 An[2][4][2]; u32x2 Zn[2][4];
#pragma unroll
    for (int u = 0; u < 2; ++u) RW_LOAD_SET(u, u * 8 + h);
    if (SM == 1) {
        for (int ch = 0; ch < T / 64; ch += 8) {
#pragma unroll
            for (int uu = 0; uu < 8; ++uu) { const int u = uu & 3; const int unit = (ch + uu) * 8 + h;
                bf16_t* sg = rws + (size_t)unit * 4096 + cq * 1024 + lane * 8;
                *(bf16x8*)(sg) = Bhi[0]; *(bf16x8*)(sg + 512) = Bhi[1];
#pragma unroll
                for (int ta = 0; ta < 4; ++ta) { Bhi[0] = Bhi[0] ^ An[u][ta][0]; Bhi[1] = Bhi[1] ^ An[u][ta][1]; Bhi[0][0] ^= (short)Zn[u][ta].x; }
                RW_LOAD_SET(u, (ch + uu + 4 < T / 64) ? unit + 32 : unit); } }
        return;
    }
    for (int ch = 0; ch < T / 64; ch += 8) {
#pragma unroll
        for (int uu = 0; uu < 8; ++uu) {
            const int u = uu & 1;
            const int unit = (ch + uu) * 8 + h;
            bf16_t* sg = rws + (size_t)unit * 4096 + cq * 1024 + lane * 8;
            *(bf16x8*)(sg) = Bhi[0]; *(bf16x8*)(sg + 512) = Bhi[1];
            f32x4 acc[4];
#pragma unroll
            for (int ta = 0; ta < 4; ++ta) { const u32x2 z = Zn[u][ta];
                acc[ta] = (f32x4){__uint_as_float(z.x << 16), __uint_as_float(z.x & 0xffff0000u), __uint_as_float(z.y << 16), __uint_as_float(z.y & 0xffff0000u)};
#pragma unroll
                for (int s = 0; s < 2; ++s) { acc[ta] = __builtin_amdgcn_mfma_f32_16x16x32_bf16(An[u][ta][s], Bhi[s], acc[ta], 0, 0, 0); acc[ta] = __builtin_amdgcn_mfma_f32_16x16x32_bf16(An[u][ta][s], Blo[s], acc[ta], 0, 0, 0); } }
            if (SM == 0) RW_LOAD_SET(u, (ch + uu + 2 < T / 64) ? unit + 16 : unit);
#pragma unroll
            for (int s = 0; s < 2; ++s) { u32x4 hi, lo; float rem[8];
#pragma unroll
                for (int p = 0; p < 8; ++p) { const float v = acc[2 * s + (p >> 2)][p & 3]; const unsigned hb = f2bf(v); rem[p] = v - __uint_as_float(hb << 16); }
                hi.x = pk2(acc[2 * s][0], acc[2 * s][1]); hi.y = pk2(acc[2 * s][2], acc[2 * s][3]); hi.z = pk2(acc[2 * s + 1][0], acc[2 * s + 1][1]); hi.w = pk2(acc[2 * s + 1][2], acc[2 * s + 1][3]);
                lo.x = pk2(rem[0], rem[1]); lo.y = pk2(rem[2], rem[3]); lo.z = pk2(rem[4], rem[5]); lo.w = pk2(rem[6], rem[7]);
                Bhi[s] = __builtin_bit_cast(bf16x8, hi); Blo[s] = __builtin_bit_cast(bf16x8, lo); }
        }
    }
}
#undef RW_LOAD_SET

__device__ __forceinline__ void phase_rwkv_out(const Ctx& c, const Args& a, int layer, const bf16_t* proj, const bf16_t* rwu, const bf16_t* rws, const float* bonusg, bf16_t* orwkv) {
    const float* mu = inptr(c, I_MU) + (size_t)layer * 1792;
    const int lane = c.lane, m = lane & 15, q = lane >> 4;
    for (int unit = c.bid * 8 + c.wave; unit < 2048; unit += c.G * 8) {
        const int ch = unit >> 3, h = unit & 7, t0 = ch * 64; const bf16_t* ug = rwu + (size_t)unit * 16384; const bf16_t* sg = rws + (size_t)unit * 4096;
        bf16x8 Bf[4][2];
#pragma unroll
        for (int cq = 0; cq < 4; ++cq) { Bf[cq][0] = *(const bf16x8*)(sg + cq * 1024 + lane * 8); Bf[cq][1] = *(const bf16x8*)(sg + cq * 1024 + 512 + lane * 8); }
        float lnw[4], lnb[4];
#pragma unroll
        for (int cq = 0; cq < 4; ++cq) { lnw[cq] = inptr(c, I_LNW)[layer * 512 + h * 64 + 16 * cq + m]; lnb[cq] = inptr(c, I_LNB)[layer * 512 + h * 64 + 16 * cq + m]; }
#pragma unroll 1
        for (int ta = 0; ta < 4; ++ta) {
            const bf16x8 A0 = *(const bf16x8*)(ug + 8192 + (16 * ta + m) * 64 + 8 * q), A1 = *(const bf16x8*)(ug + 8192 + (16 * ta + m) * 64 + 32 + 8 * q);
            f32x4 y[4];
#pragma unroll
            for (int cq = 0; cq < 4; ++cq) { const u32x2 z = *(const u32x2*)(ug + 12288 + ((cq * 4 + ta) * 64 + lane) * 4);
                y[cq] = (f32x4){__uint_as_float(z.x << 16), __uint_as_float(z.x & 0xffff0000u), __uint_as_float(z.y << 16), __uint_as_float(z.y & 0xffff0000u)};
                y[cq] = __builtin_amdgcn_mfma_f32_16x16x32_bf16(A0, Bf[cq][0], y[cq], 0, 0, 0); y[cq] = __builtin_amdgcn_mfma_f32_16x16x32_bf16(A1, Bf[cq][1], y[cq], 0, 0, 0); }
#pragma unroll
            for (int r = 0; r < 4; ++r) { const int t = t0 + 16 * ta + 4 * q + r;
                float sm = y[0][r] + y[1][r] + y[2][r] + y[3][r];
                sm += __shfl_xor(sm, 1); sm += __shfl_xor(sm, 2); sm += __shfl_xor(sm, 4); sm += __shfl_xor(sm, 8);
                const float mean = sm * (1.0f / 64.0f); float d[4], vs = 0.f;
#pragma unroll
                for (int cq = 0; cq < 4; ++cq) { d[cq] = y[cq][r] - mean; vs += d[cq] * d[cq]; }
                vs += __shfl_xor(vs, 1); vs += __shfl_xor(vs, 2); vs += __shfl_xor(vs, 4); vs += __shfl_xor(vs, 8);
                const float rstd = rsqrtf(vs * (1.0f / 64.0f) + 64e-5f); const float bon = bonusg[(size_t)t * 8 + h];
#pragma unroll
                for (int cq = 0; cq < 4; ++cq) { const int col = h * 64 + 16 * cq + m; const float v = rwkv_mixed(proj, mu, t, PC_V + col);
                    bf16_t* op = orwkv + (size_t)t * 512 + col; const float g = bf2f(*op);
                    *op = (bf16_t)f2bf((d[cq] * rstd * lnw[cq] + lnb[cq] + bon * v) * g); } }
        }
    }
}


constexpr int AT_K = 0, AT_V = 9216, AT_SCORE = 18432  , AT_BIAS = 83968, AT_SELM = 100352, AT_LIST = 104448, AT_NLIST = 105472, AT_NEED = 105504;
__device__ __forceinline__ void vt_transpose(const Ctx& c, const bf16_t* proj, bf16_t* vt) {
    LAS bf16_t* tl = (LAS bf16_t*)c.lds;
    for (int it = c.bid; it < 3 * 2 * 256; it += c.G) {
        const int which = it / 512, g = (it >> 8) & 1, tt = it & 255;
        const int col = (which == 0 ? PC_VS : (which == 1 ? PC_VW : PC_SV)) + g * 64;
        { const int tok = c.tid >> 3, ch = c.tid & 7; const u32x4 w = *(const u32x4*)(proj + (size_t)(tt * 64 + tok) * PLD + col + ch * 8);
          *(LAS u32x4*)(tl + tok * 72 + ch * 8) = w; }
        __syncthreads();
        { const int d = c.tid >> 3, ch = c.tid & 7; unsigned short e[8];
#pragma unroll
          for (int k = 0; k < 8; ++k) e[k] = tl[(ch * 8 + k) * 72 + d];
          u32x4 w; w.x = e[0] | ((unsigned)e[1] << 16); w.y = e[2] | ((unsigned)e[3] << 16); w.z = e[4] | ((unsigned)e[5] << 16); w.w = e[6] | ((unsigned)e[7] << 16);
          *(u32x4*)(vt + ((size_t)(which * 2 + g) * 64 + d) * T + tt * 64 + ch * 8) = w; }
        __syncthreads();
    }
}

template <int MODE, int NQ>
__device__ __forceinline__ void phase_attn(const Ctx& c, const Args& a, int layer, const bf16_t* proj, const bf16_t* vtb, const bf16_t* kcb, const bf16_t* vctb,
                                           unsigned* sel, float* nsaacc, bf16_t* oout) {
    LAS unsigned char* L = c.lds;
    LAS float* sscore = (LAS float*)(L + AT_SCORE);
    LAS float* biasd = (LAS float*)(L + AT_BIAS);
    LAS unsigned* selm = (LAS unsigned*)(L + AT_SELM);
    LAS int* list = (LAS int*)(L + AT_LIST);
    LAS int* nlist = (LAS int*)(L + AT_NLIST);
    LAS unsigned* need = (LAS unsigned*)(L + AT_NEED);
    const int lane = c.lane, wave = c.wave, n = lane & 15, q = lane >> 4, hr = n & 3;
    constexpr int TW = 4 * NQ, TB = 8 * TW, NU = T / TB, TS = (MODE == 3) ? 4 : 1;
    for (int unit = c.bid; unit < 2 * NU; unit += c.G) {
        const int g = unit / NU, t0 = (unit % NU) * TB, tw0 = t0 + wave * TW;
        __syncthreads();
        for (int e = c.tid; e < 4096; e += 512) { const int r = e >> 10, d = e & 1023; biasd[e] = inptr(c, I_REL)[t5_bucket(d) * 16 + (MODE == 0 ? 8 : 0) + g * 4 + r]; }
        if (MODE == 3) {
            if (c.tid < 8) need[c.tid] = 0u;
            __syncthreads();
            { const int tok = c.tid >> 3, w8 = c.tid & 7; const unsigned mw = sel[((size_t)(t0 + tok) * 2 + g) * 8 + w8]; selm[tok * 8 + w8] = mw; atomicOr((unsigned*)&need[w8], mw); }
            __syncthreads();
            if (c.tid < 256) { const int j = c.tid; const unsigned wd = need[j >> 5];
                if ((wd >> (j & 31)) & 1u) { int pos = __popc(wd & ((1u << (j & 31)) - 1u)); for (int w2 = 0; w2 < (j >> 5); ++w2) pos += __popc(need[w2]); list[pos] = j; } }
            if (c.tid == 0) { int cnt = 0; for (int w2 = 0; w2 < 8; ++w2) cnt += __popc(need[w2]); nlist[0] = cnt; }
        }
        __syncthreads();
        int ntiles, tile_lo = 0;
        if (MODE == 0) { ntiles = 2 + TB / 64; tile_lo = t0 - 128; }
        else if (MODE == 1) { ntiles = 8 + TB / 64; tile_lo = t0 - 512; }
        else if (MODE == 2) { const int cmax = (t0 + TB - 1 - 31) >> 4; ntiles = cmax < 0 ? 0 : (cmax >> 6) + 1; }
        else ntiles = nlist[0];
        const bf16_t* Ksrc; size_t kstride; const bf16_t* Vsrc; size_t vstride; int qcol;
        if (MODE == 0) { Ksrc = proj + PC_SK + g * 64; kstride = PLD; Vsrc = vtb + (size_t)(4 + g) * 64 * T; vstride = T; qcol = PC_SQ + g * 256; }
        else if (MODE == 1) { Ksrc = proj + PC_KW + g * 64; kstride = PLD; Vsrc = vtb + (size_t)(2 + g) * 64 * T; vstride = T; qcol = PC_NQ + g * 256; }
        else if (MODE == 2) { Ksrc = kcb + (size_t)g * 1024 * 64; kstride = 64; Vsrc = vctb + (size_t)g * 64 * 1024; vstride = 1024; qcol = PC_NQ + g * 256; }
        else { Ksrc = proj + PC_KS + g * 64; kstride = PLD; Vsrc = vtb + (size_t)(0 + g) * 64 * T; vstride = T; qcol = PC_NQ + g * 256; }
        bf16x8 Bq[NQ][2];
#pragma unroll
        for (int qd = 0; qd < NQ; ++qd) { const bf16_t* qp = proj + (size_t)(tw0 + 4 * qd + (n >> 2)) * PLD + qcol + hr * 64 + 8 * q;
            Bq[qd][0] = *(const bf16x8*)qp; Bq[qd][1] = *(const bf16x8*)(qp + 32); }
        const float bfar = biasd[hr * 1024 + 1023];
        float mrun[NQ], lrun[NQ]; f32x4 O[NQ][4];
#pragma unroll
        for (int qd = 0; qd < NQ; ++qd) { mrun[qd] = -1e30f; lrun[qd] = 0.f;
#pragma unroll
            for (int dt = 0; dt < 4; ++dt) O[qd][dt] = (f32x4){0.f, 0.f, 0.f, 0.f}; }
        float carry3[NQ]; for (int i = 0; i < NQ; ++i) carry3[i] = 0.f;
        const int npass = (MODE == 2) ? 2 : 1;
        for (int pass = 0; pass < npass; ++pass) {
            const bool do_pv = (MODE != 2) || pass == 1;
            float linv[NQ];
            if (MODE == 2 && pass == 1) {
#pragma unroll
                for (int qd = 0; qd < NQ; ++qd) { float mt = mrun[qd]; mt = fmaxf(mt, __shfl_xor(mt, 16)); mt = fmaxf(mt, __shfl_xor(mt, 32));
                    float lt = lrun[qd] * __expf(mrun[qd] - mt); lt += __shfl_xor(lt, 16); lt += __shfl_xor(lt, 32); mrun[qd] = mt; linv[qd] = lt > 0.f ? 1.0f / lt : 0.f; }
            }
#define AT_TILEPOS(ti) ((MODE == 3) ? list[ti] * 64 : (MODE == 2 ? (ti) * 64 : tile_lo + (ti) * 64))
#define AT_ISSUE(rd) do { _Pragma("unroll") for (int i_ = 0; i_ < TS; ++i_) { const int ti_ = (rd) * TS + i_; p0n[i_] = ti_ < ntiles ? AT_TILEPOS(ti_) : -1; \
        if (p0n[i_] >= 0) { kreg[i_] = *(const u32x4*)(Ksrc + (size_t)(p0n[i_] + (c.tid >> 3)) * kstride + (c.tid & 7) * 8); \
            if (do_pv) vreg[i_] = *(const u32x4*)(Vsrc + (size_t)(c.tid >> 3) * vstride + p0n[i_] + (c.tid & 7) * 8); } } } while (0)
            u32x4 kreg[TS], vreg[TS]; int p0n[TS];
            const int nrounds = (ntiles + TS - 1) / TS;
            if (nrounds > 0) AT_ISSUE(0);
            for (int rd = 0; rd < nrounds; ++rd) {
                int p0s[TS];
#pragma unroll
                for (int i = 0; i < TS; ++i) p0s[i] = p0n[i];
                __syncthreads();
#pragma unroll
                for (int i = 0; i < TS; ++i) if (p0s[i] >= 0) { *(LAS u32x4*)(L + AT_K + i * 18432 + (c.tid >> 3) * 144 + (c.tid & 7) * 16) = kreg[i];
                    if (do_pv) *(LAS u32x4*)(L + AT_V + i * 18432 + (c.tid >> 3) * 144 + (c.tid & 7) * 16) = vreg[i]; }
                if (rd + 1 < nrounds) AT_ISSUE(rd + 1);
                __syncthreads();
#pragma unroll
              for (int ts = 0; ts < TS; ++ts) {
                const int p0 = p0s[ts]; const int LK = AT_K + ts * 18432, LV = AT_V + ts * 18432;
                if (p0 < 0) continue;
                if (MODE == 0) { if (p0 > tw0 + TW - 1 || p0 + 63 < tw0 - 127) continue; }
                if (MODE == 1) { if (p0 > tw0 + TW - 1 || p0 + 63 < tw0 - 511) continue; }
                if (MODE == 2) { if (16 * p0 + 31 > tw0 + TW - 1) continue; }
                if (MODE == 3) { if (p0 > tw0 + TW - 1) continue; }
                const bool far = (MODE == 2) ? (tw0 - (16 * (p0 + 63) + 31) >= 790) : ((MODE == 3) ? (tw0 - (p0 + 63) >= 790) : false);
                const int jblk = p0 >> 6;
#pragma unroll
                for (int qd = 0; qd < NQ; ++qd) {
                    const int tq = tw0 + 4 * qd + (n >> 2);
                    bool colsel = true;
                    if (MODE == 3) { colsel = (selm[(wave * TW + 4 * qd + (n >> 2)) * 8 + (jblk >> 5)] >> (jblk & 31)) & 1u; if (__ballot(colsel) == 0ull) continue; }
                    {
                        f32x4 sc[4];
#pragma unroll
                        for (int kt = 0; kt < 4; ++kt) { sc[kt] = (f32x4){0.f, 0.f, 0.f, 0.f};
#pragma unroll
                            for (int ks = 0; ks < 2; ++ks) { const bf16x8 ak = *(const LAS bf16x8*)(L + LK + (16 * kt + n) * 144 + (32 * ks + 8 * q) * 2);
                                sc[kt] = __builtin_amdgcn_mfma_f32_16x16x32_bf16(ak, Bq[qd][ks], sc[kt], 0, 0, 0); } }
                        float mx = -1e30f;
                        if (far) {
#pragma unroll
                            for (int kt = 0; kt < 4; ++kt)
#pragma unroll
                                for (int r = 0; r < 4; ++r) { const float s2 = (MODE == 3 && !colsel) ? -1e30f : sc[kt][r] + bfar; sc[kt][r] = s2; mx = fmaxf(mx, s2); }
                        } else {
#pragma unroll
                        for (int kt = 0; kt < 4; ++kt)
#pragma unroll
                            for (int r = 0; r < 4; ++r) { const int kl = 16 * kt + 4 * q + r; int dist; bool v;
                                if (MODE == 2) { dist = tq - (16 * (p0 + kl) + 31); v = dist >= 0; }
                                else { dist = tq - (p0 + kl); v = dist >= 0; if (MODE == 0) v = v && dist < 128; if (MODE == 1) v = v && dist < 512; if (MODE == 3) v = v && colsel; }
                                const int di = dist < 0 ? 0 : (dist > 1023 ? 1023 : dist);
                                const float s2 = v ? sc[kt][r] + biasd[hr * 1024 + di] : -1e30f; sc[kt][r] = s2; mx = fmaxf(mx, s2); }
                        }
                        float p[4][4];
                        if (MODE == 2 && pass == 1) {
#pragma unroll
                            for (int kt = 0; kt < 4; ++kt)
#pragma unroll
                                for (int r = 0; r < 4; ++r) p[kt][r] = __expf(sc[kt][r] - mrun[qd]) * linv[qd];
                        } else if (MODE == 2) {
                            const float mn = fmaxf(mrun[qd], mx), corr = __expf(mrun[qd] - mn); mrun[qd] = mn; float ps = 0.f;
                            const float mne = mn < -1e29f ? 0.f : mn;
#pragma unroll
                            for (int kt = 0; kt < 4; ++kt)
#pragma unroll
                                for (int r = 0; r < 4; ++r) ps += __expf(sc[kt][r] - mne);
                            lrun[qd] = lrun[qd] * corr + ps;
                        } else {
                            if (__any(mx > mrun[qd])) {
                                mx = fmaxf(mx, __shfl_xor(mx, 16)); mx = fmaxf(mx, __shfl_xor(mx, 32));
                                const float mn = fmaxf(mrun[qd], mx), corr = __expf(mrun[qd] - mn); mrun[qd] = mn;
                                lrun[qd] *= corr;
#pragma unroll
                                for (int dt = 0; dt < 4; ++dt) O[qd][dt] = O[qd][dt] * corr;
                            }
                            const float mne = mrun[qd] < -1e29f ? 0.f : mrun[qd]; float ps = 0.f;
#pragma unroll
                            for (int kt = 0; kt < 4; ++kt)
#pragma unroll
                                for (int r = 0; r < 4; ++r) { p[kt][r] = __expf(sc[kt][r] - mne); ps += p[kt][r]; }
                            lrun[qd] += ps;
                        }
                        if (MODE == 2 && pass == 1) {
                            float i3prev = carry3[qd];
#pragma unroll
                            for (int kt = 0; kt < 4; ++kt) { float im[4];
#pragma unroll
                                for (int r = 0; r < 4; ++r) { float v = p[kt][r]; v += dpp_xor1(v); v += dpp_xor2(v); im[r] = v; }
                                const float same = __shfl(im[3], (lane + 48) & 63), prevt = __shfl(i3prev, (lane + 48) & 63);
                                const float pv3 = q > 0 ? same : prevt;
                                const int jg = (p0 + 16 * kt + 4 * q) >> 2;
                                if (hr == 0 && jg < 256) sscore[(tq - t0) * 256 + jg] = 2.0f * (im[0] + im[1] + im[2]) + im[3] + pv3;
                                i3prev = im[3]; }
                            carry3[qd] = i3prev;
                        }
                        if (do_pv) {
#pragma unroll
                            for (int st = 0; st < 2; ++st) {
                                u32x4 pw; pw.x = pk2(p[2 * st][0], p[2 * st][1]); pw.y = pk2(p[2 * st][2], p[2 * st][3]); pw.z = pk2(p[2 * st + 1][0], p[2 * st + 1][1]); pw.w = pk2(p[2 * st + 1][2], p[2 * st + 1][3]);
                                const bf16x8 pf = __builtin_bit_cast(bf16x8, pw);
#pragma unroll
                                for (int dt = 0; dt < 4; ++dt) { const LAS unsigned char* vp = L + LV + (16 * dt + n) * 144 + (32 * st + 4 * q) * 2;
                                    const u32x2 v0 = *(const LAS u32x2*)vp, v1 = *(const LAS u32x2*)(vp + 32); u32x4 vw; vw.x = v0.x; vw.y = v0.y; vw.z = v1.x; vw.w = v1.y;
                                    O[qd][dt] = __builtin_amdgcn_mfma_f32_16x16x32_bf16(__builtin_bit_cast(bf16x8, vw), pf, O[qd][dt], 0, 0, 0); } }
                        }
                        __builtin_amdgcn_sched_barrier(0);
                    }
                }
              }
            }
        }
#undef AT_ISSUE
#undef AT_TILEPOS
        if (MODE == 2) {
            __syncthreads();
#pragma unroll 1
            for (int tk = 0; tk < TW; ++tk) { const int t = tw0 + tk, cur = t >> 6; const LAS float* sp = sscore + (wave * TW + tk) * 256;
                unsigned key[4]; bool forced[4];
#pragma unroll
                for (int jj = 0; jj < 4; ++jj) { const int j = lane + 64 * jj; forced[jj] = (j == 0 || j == cur || j == cur - 1);
                    key[jj] = (!forced[jj] && j < cur - 1) ? __float_as_uint(sp[j]) + 1u : 0u; }
                const int nforced = cur >= 2 ? 3 : cur + 1;
                unsigned prefix = 0u; int remaining = 16 - nforced;
#pragma unroll 1
                for (int bit = 30; bit >= 0; --bit) { const unsigned test = prefix | (1u << bit); int cnt = 0;
#pragma unroll
                    for (int jj = 0; jj < 4; ++jj) cnt += __popcll(__ballot((key[jj] >> bit) == (test >> bit)));
                    if (cnt >= remaining) prefix = test; else remaining -= cnt; }
                int eqbase = 0;
#pragma unroll
                for (int jj = 0; jj < 4; ++jj) { const bool eq = key[jj] == prefix && key[jj] != 0u; const unsigned long long eb = __ballot(eq);
                    const int eqrank = eqbase + __popcll(eb & ((1ull << lane) - 1ull)); eqbase += __popcll(eb);
                    const bool on = forced[jj] || key[jj] > prefix || (eq && eqrank < remaining); const unsigned long long bl = __ballot(on);
                    if (lane == 0) { sel[((size_t)t * 2 + g) * 8 + 2 * jj] = (unsigned)bl; sel[((size_t)t * 2 + g) * 8 + 2 * jj + 1] = (unsigned)(bl >> 32); } }
            }
        }
#pragma unroll
        for (int qd = 0; qd < NQ; ++qd) {
            const int tq = tw0 + 4 * qd + (n >> 2), hh = g * 4 + hr;
            float scale;
            if (MODE == 2) scale = 1.0f;
            else { float lt = lrun[qd]; lt += __shfl_xor(lt, 16); lt += __shfl_xor(lt, 32);
                if (MODE == 0) { const float sink = inptr(c, I_SINK)[layer * 8 + hh]; const float mf = fmaxf(mrun[qd], sink), cr = __expf(mrun[qd] - mf); scale = cr / (lt * cr + __expf(sink - mf)); }
                else scale = lt > 0.f ? 1.0f / lt : 0.f; }
            if (MODE != 0) scale *= sigmoidf_(bf2f(proj[(size_t)tq * PLD + PC_GL + (MODE == 2 ? 0 : (MODE == 3 ? 8 : 16)) + hh]));
#pragma unroll
            for (int dt = 0; dt < 4; ++dt) { const f32x4 o = O[qd][dt] * scale; const int col = hh * 64 + 16 * dt + 4 * q;
                if (MODE == 0) { u32x2 w; w.x = pk2(o[0], o[1]); w.y = pk2(o[2], o[3]); *(u32x2*)(oout + (size_t)tq * 512 + col) = w; }
                else if (MODE == 2) *(f32x4*)(nsaacc + (size_t)tq * 512 + col) = o;
                else if (MODE == 1) { f32x4* ap = (f32x4*)(nsaacc + (size_t)tq * 512 + col); *ap = *ap + o; }
                else { const f32x4 t2 = *(const f32x4*)(nsaacc + (size_t)tq * 512 + col) + o; u32x2 w; w.x = pk2(t2[0], t2[1]); w.y = pk2(t2[2], t2[3]); *(u32x2*)(oout + (size_t)tq * 512 + col) = w; } }
        }
    }
}
__device__ __forceinline__ void phase_topk2(const Ctx& c, const float* scores, int* sel) {
    const int gw = c.bid * 8 + c.wave, NGW = c.G * 8;
    for (int item = gw; item < T * 2; item += NGW) {
        const int t = item >> 1, g = item & 1, cur = t >> 6;
        const float* sp = scores + ((size_t)g * T + t) * 256;
        float val[4];
#pragma unroll
        for (int jj = 0; jj < 4; ++jj) { const int j = c.lane + 64 * jj; float sc;
            if (j == 0 || j == cur || j == cur - 1) sc = 1e4f; else if (j > cur) sc = -1.0f; else sc = sp[j];
            val[jj] = sc; }
        for (int k = 0; k < 16; ++k) {
            float bv = val[0]; int bi = c.lane;
#pragma unroll
            for (int jj = 1; jj < 4; ++jj) if (val[jj] > bv) { bv = val[jj]; bi = c.lane + 64 * jj; }
#pragma unroll
            for (int o = 32; o >= 1; o >>= 1) { const float ov = __shfl_xor(bv, o); const int oi = __shfl_xor(bi, o); if (ov > bv || (ov == bv && oi < bi)) { bv = ov; bi = oi; } }
#pragma unroll
            for (int jj = 0; jj < 4; ++jj) if (bi == c.lane + 64 * jj) val[jj] = -3e38f;
            if (c.lane == 0) sel[(size_t)item * 16 + k] = bi;
        }
    }
}

#define wb ((bf16_t*)(ws + WS_WB))
#define xb ((bf16_t*)(ws + WS_XB))
#define rs ((float*)(ws + WS_RS))
#define kcb ((bf16_t*)(ws + WS_KCB))
#define vctb ((bf16_t*)(ws + WS_VCT))
#define vtb ((bf16_t*)(ws + WS_VT))
#define scores ((float*)(ws + WS_SCORES))
#define sel ((unsigned*)(ws + WS_SEL))
#define ml ((float*)(ws + WS_ML))
#define hidb ((bf16_t*)(ws + WS_HID))
#define proj ((bf16_t*)(ws + WS_PROJ))
#define gates ((bf16_t*)(ws + WS_GATES))
#define merged ((bf16_t*)(ws + WS_MERGED))
#define tmpb ((bf16_t*)(ws + WS_TMPB))
#define alora ((bf16_t*)(ws + WS_ALORA))
#define rwu ((bf16_t*)(ws + WS_RWU))
#define rws ((bf16_t*)(ws + WS_RWS))
#define bonusg ((float*)(ws + WS_BONUS))
#define nsaacc ((float*)(ws + WS_NSAACC))
#define obuf ((bf16_t*)(ws + WS_O))
#define act ((bf16_t*)(ws + WS_ACT))
#define tmpf ((bf16_t*)(ws + WS_TMPF))
constexpr int PH_PER_BATCH = 9, PH_PER_LAYER = 1 + 2 * PH_PER_BATCH + 3, PH_TOTAL = 1 + DEPTH * PH_PER_LAYER;

__global__ void __launch_bounds__(512, 2) fwd_kernel(Args args) {
    extern __shared__ __attribute__((aligned(16))) unsigned char lds_raw[];
    Ctx c0; c0.lds = (LAS unsigned char*)lds_raw; c0.tid = threadIdx.x; c0.lane = c0.tid & 63; c0.wave = __builtin_amdgcn_readfirstlane(c0.tid >> 6); c0.G = gridDim.x; c0.bid = blockIdx.x; const Ctx& c = c0;
    unsigned char* ws = args.ws;
    volatile LAS unsigned* misc = (volatile LAS unsigned*)(c.lds + LDS_MISC);
    if (c.tid < 4) misc[c.tid] = 0u;
    if (c.tid < 30) { const unsigned long long pv = (unsigned long long)args.in[c.tid & 31]; misc[16 + 2 * c.tid] = (unsigned)pv; misc[17 + 2 * c.tid] = (unsigned)(pv >> 32); }
    __syncthreads();
    XcdBarrier bar; bar.bar = (unsigned*)(ws + WS_CTL); bar.x = 0; bar.st = misc;
    const int lo = args.lo, hi = args.hi;
    const bool multi = (hi - lo) > 1;
    if (multi) bar = xcd_barrier_post((unsigned*)(ws + WS_CTL), misc);
    int gp = 0;
#ifndef ONLY_PH
#define ONLY_PH -1
#endif
#ifndef PHMASK
#define PHMASK 0xffffff
#endif
#ifndef REPMASK
#define REPMASK 0
#endif
#ifndef PR_SEL
#define PR_SEL 0
#endif
#ifndef PR_SWA
#define PR_SWA 0
#endif
#ifndef PR_CMP
#define PR_CMP 0
#endif
#ifndef PR_CHUNK
#define PR_CHUNK 0
#endif
#define PHASE_BEGIN(id) if (gp >= lo && gp < hi) { for (int rep_ = 0; rep_ < (((REPMASK >> (id)) & 1) ? 2 : 1); ++rep_) { if (rep_) __syncthreads(); \
    Ctx pc = c0; asm volatile("" : "+v"(pc.tid), "+s"(pc.bid)); pc.lane = pc.tid & 63; pc.wave = __builtin_amdgcn_readfirstlane(pc.tid >> 6); const Ctx& c = pc;
#define PHASE_END   } if (gp + 1 < hi) xcd_barrier(bar); } ++gp;
#define RELAUNDER() do { asm volatile("" : "+v"(pc.tid), "+s"(pc.bid)); pc.lane = pc.tid & 63; pc.wave = __builtin_amdgcn_readfirstlane(pc.tid >> 6); } while (0)

    float* x = args.out;
    PHASE_BEGIN(0) phase_init(c, inptr(c, I_X), x, xb, rs); PHASE_END

    for (int layer = 0; layer < DEPTH; ++layer) {
        PHASE_BEGIN(1) phase_cvt(c, args, layer, wb); PHASE_END
        for (int b = 0; b < NBATCH; ++b) {
            const int row0 = b * T;
            PHASE_BEGIN(2) {
                pg8::Gemm g{xb + (size_t)row0 * D, wb + WB_WIN, D, D, D}; pg8::Sched S; S.init(T / 256, NIN / 256, c.G, c.bid, 1, (size_t)256 * D * 2, 0, (size_t)256 * D * 2, 0);
                pg8::EpiInProj E{proj, gates, rs + row0}; pg8::gemm_phase(c.lds, c.tid, g, S, E); } PHASE_END
            PHASE_BEGIN(16) {
                { pg8::Gemm g{proj, wb + WB_W1T, 16 * PLD, 2048, 2048, (unsigned)PLD * 2}; pg8::Sched S; S.init(16, 1, c.G, c.bid, 1, 0, 0, 0, 0); S.mode = 1;
                  pg8::EpiCmp1 E{hidb, (const float*)(wb + WB_BH)}; pg8::gemm_phase(c.lds, c.tid, g, S, E); }
                RELAUNDER();
                if (c.bid >= 16) { Ctx cv = c; cv.bid = c.bid - 16; cv.G = c.G - 16; phase_lora_a(cv, args, layer, proj, alora); vt_transpose(cv, proj, vtb); } } PHASE_END
            PHASE_BEGIN(17) {
                { pg8::Gemm g{alora, wb + WB_LORA, 256, 256, 256}; pg8::Sched S; S.init(T / 256, 6, c.G, c.bid, 1, (unsigned)256 * 256 * 2, 0, (unsigned)256 * 256 * 2, 0);
                  pg8::EpiLora E{obuf}; pg8::gemm_phase(c.lds, c.tid, g, S, E); }
                RELAUNDER();
                { pg8::Gemm g{hidb, wb + WB_W2T, 256, 256, 256}; pg8::Sched S; S.init(16, 1, c.G, (c.bid + 16) % c.G, 1, (unsigned)256 * 256 * 2, 0, 0, 0); S.mode = 2;
                  pg8::EpiCmp2 E{kcb, vctb}; pg8::gemm_phase(c.lds, c.tid, g, S, E); } } PHASE_END
            PHASE_BEGIN(18) {
                for (int pr_ = 0; pr_ <= PR_CHUNK; ++pr_) { phase_rwkv_chunk(c, args, layer, proj, obuf + (size_t)T * 512, obuf + (size_t)2 * T * 512, rwu, bonusg);
                __syncthreads(); RELAUNDER(); }
                for (int pr_ = 0; pr_ <= PR_CMP; ++pr_) { phase_attn<2, 2>(c, args, layer, proj, vtb, kcb, vctb, sel, nsaacc, obuf + (size_t)T * 512); __syncthreads(); } } PHASE_END
            PHASE_BEGIN(19) {
                phase_rwkv_scan<0>(c, rwu, rws);
                RELAUNDER();
                if (c.bid >= 32) { Ctx cv = c; cv.bid = c.bid - 32; cv.G = c.G - 32;
                    phase_attn<1, 2>(cv, args, layer, proj, vtb, kcb, vctb, sel, nsaacc, obuf + (size_t)T * 512);
                    asm volatile("" : "+v"(cv.tid), "+s"(cv.bid)); cv.lane = cv.tid & 63; cv.wave = __builtin_amdgcn_readfirstlane(cv.tid >> 6);
                    for (int pr_ = 0; pr_ <= PR_SWA; ++pr_) { phase_attn<0, 2>(cv, args, layer, proj, vtb, kcb, vctb, sel, nsaacc, obuf + (size_t)2 * T * 512); __syncthreads(); } } } PHASE_END
            PHASE_BEGIN(9) {
                phase_rwkv_out(c, args, layer, proj, rwu, rws, bonusg, obuf);
                __syncthreads(); RELAUNDER();
                for (int pr_ = 0; pr_ <= PR_SEL; ++pr_) { phase_attn<3, 2>(c, args, layer, proj, vtb, kcb, vctb, sel, nsaacc, obuf + (size_t)T * 512); __syncthreads(); } } PHASE_END
            PHASE_BEGIN(10) {
                pg8::Gemm g{obuf, wb + WB_WBR, 512, 512, 512}; pg8::Sched S; S.init(T / 256, D / 256, c.G, c.bid, 3, (size_t)256 * 512 * 2, (size_t)T * 512 * 2, (size_t)256 * 512 * 2, (size_t)D * 512 * 2);
                pg8::EpiMerge E{gates, merged}; pg8::gemm_phase(c.lds, c.tid, g, S, E); } PHASE_END
            PHASE_BEGIN(11) {
                pg8::Gemm g{merged, wb + WB_WOUT, D, D, D}; pg8::Sched S; S.init(T / 256, D / 256, c.G, c.bid, 1, (size_t)256 * D * 2, 0, (size_t)256 * D * 2, 0);
                pg8::EpiStore E{tmpb, D}; pg8::gemm_phase(c.lds, c.tid, g, S, E); } PHASE_END
            PHASE_BEGIN(12) phase_norm_res(c, tmpb, inptr(c, I_NQM) + layer * D, x, xb, rs, row0, T); PHASE_END
        }
        PHASE_BEGIN(13) {
            pg8::Gemm g{xb, wb + WB_WGU, D, D, D}; pg8::Sched S; S.init(MROWS / 256, 2 * FFN / 256, c.G, c.bid, 1, (size_t)256 * D * 2, 0, (size_t)256 * D * 2, 0);
            pg8::EpiSwiGLU E{act, rs}; pg8::gemm_phase(c.lds, c.tid, g, S, E); } PHASE_END
        PHASE_BEGIN(14) {
            pg8::Gemm g{act, wb + WB_WDN, FFN, FFN, FFN}; pg8::Sched S; S.init(MROWS / 256, D / 256, c.G, c.bid, 1, (size_t)256 * FFN * 2, 0, (size_t)256 * FFN * 2, 0);
            pg8::EpiStore E{tmpf, D}; pg8::gemm_phase(c.lds, c.tid, g, S, E); } PHASE_END
        PHASE_BEGIN(15) phase_norm_res(c, tmpf, inptr(c, I_NQF) + layer * D, x, xb, rs, 0, MROWS); PHASE_END
    }
#undef PHASE_BEGIN
#undef PHASE_END
}

extern "C" void kernel_launch(void* const* d_in, const int* in_sizes, int n_in, void* d_out, int out_size, void* d_ws, size_t ws_size, hipStream_t stream) {
    static int grid = 0;
    if (grid == 0) {
        if (n_in != 30 || out_size != MROWS * D || ws_size < WS_END) { fprintf(stderr, "kernel_launch: unexpected shapes (n_in %d out %d ws %zu)\n", n_in, out_size, ws_size); grid = -1; return; }
        int dev = 0, cus = 0;
        if (hipGetDevice(&dev) != hipSuccess || hipDeviceGetAttribute(&cus, hipDeviceAttributeMultiprocessorCount, dev) != hipSuccess) { grid = -1; return; }
        if (hipFuncSetAttribute((const void*)fwd_kernel, hipFuncAttributeMaxDynamicSharedMemorySize, LDS_BYTES) != hipSuccess) { fprintf(stderr, "hipFuncSetAttribute failed\n"); grid = -1; return; }
        int per_cu = 0;
        if (hipOccupancyMaxActiveBlocksPerMultiprocessor(&per_cu, (const void*)fwd_kernel, 512, LDS_BYTES) != hipSuccess || per_cu < 1) { fprintf(stderr, "occupancy query: %d\n", per_cu); }
        (void)hipGetLastError();
        grid = cus;
    }
    if (grid < 0) return;
    (void)hipMemsetAsync((char*)d_ws + WS_CTL, 0, CTL_BYTES, stream);
    Args a{};
    for (int i = 0; i < 30; ++i) a.in[i] = (const float*)d_in[i];
    a.out = (float*)d_out; a.ws = (unsigned char*)d_ws;
#if MK_ONE_LAUNCH
    a.lo = 0; a.hi = PH_TOTAL;
    hipLaunchKernelGGL(fwd_kernel, dim3(grid), dim3(512), LDS_BYTES, stream, a);
#else
    for (int p = 0; p < PH_TOTAL; ++p) { a.lo = p; a.hi = p + 1; hipLaunchKernelGGL(fwd_kernel, dim3(grid), dim3(512), LDS_BYTES, stream, a); }
#endif
}
```

```cpp
#include <hip/hip_runtime.h>
#include <stdint.h>
#include <stdio.h>

#ifndef MK_ONE_LAUNCH
#define MK_ONE_LAUNCH 1
#endif

#define LAS __attribute__((address_space(3)))
typedef unsigned short bf16_t;
typedef short bf16x8 __attribute__((ext_vector_type(8)));
typedef float f32x4 __attribute__((ext_vector_type(4)));
typedef float f32x2 __attribute__((ext_vector_type(2)));
typedef unsigned u32x4 __attribute__((ext_vector_type(4)));
typedef unsigned u32x2 __attribute__((ext_vector_type(2)));

constexpr int D = 1024, NBATCH = 2, T = 16384, DEPTH = 4, MROWS = NBATCH * T;
constexpr int IN_COLS = 6936, FFN = 2816;
constexpr int PLD = 4096;
constexpr int PC_R = 0, PC_K = 512, PC_V = 1024, PC_ZW = 1536, PC_ZA = 1600, PC_ZG = 1664;
constexpr int PC_NQ = 1792, PC_KC = 2304, PC_VC = 2432, PC_KS = 2560, PC_VS = 2688, PC_KW = 2816, PC_VW = 2944, PC_GL = 3072;
constexpr int PC_SQ = 3328, PC_SK = 3840, PC_SV = 3968;
constexpr int NIN = 7168;
constexpr int NCMP = 1023;
constexpr float NORM_EPS = 1e-6f;

constexpr size_t MiB = 1u << 20;
constexpr size_t WS_CTL = 0, CTL_BYTES = 65536;
constexpr size_t WS_WB = 65536;
constexpr size_t WB_WIN = 0, WB_WBR = WB_WIN + (size_t)NIN * D, WB_WOUT = WB_WBR + (size_t)3 * D * 512, WB_WGU = WB_WOUT + (size_t)D * D,
                 WB_WDN = WB_WGU + (size_t)2 * FFN * D, WB_LORA = WB_WDN + (size_t)D * FFN, WB_W1T = WB_LORA + (size_t)1536 * 256, WB_W2T = WB_W1T + (size_t)2 * 256 * 2048,
                 WB_BH = WB_W2T + (size_t)2 * 256 * 256, WB_END = WB_BH + 1024;
static_assert(WS_WB + WB_END * 2 <= 38 * MiB + 786432, "weights");
constexpr size_t KiB = 1024;
constexpr size_t WS_XB = 38 * MiB + 768 * KiB;
constexpr size_t WS_RS = WS_XB + 64 * MiB;
constexpr size_t WS_BONUS = WS_RS + 128 * KiB;
constexpr size_t WS_KCB = WS_BONUS + 512 * KiB;
constexpr size_t WS_VCT = WS_KCB + 256 * KiB;
constexpr size_t WS_SEL = WS_VCT + 256 * KiB;
constexpr size_t WS_HID = WS_SEL + 1 * MiB;
constexpr size_t WS_ML = WS_HID;
static_assert(WS_HID + 2 * MiB <= 107 * MiB, "small region");
constexpr size_t WS_ALORA = 107 * MiB;
constexpr size_t WS_VT = 115 * MiB;
constexpr size_t WS_BIG = 127 * MiB;
constexpr size_t WS_PROJ = WS_BIG;
constexpr size_t WS_GATES = WS_PROJ + 128 * MiB;
constexpr size_t WS_RWKVS = WS_GATES + 96 * MiB;
constexpr size_t WS_RWU = WS_RWKVS;
constexpr size_t WS_RWS = WS_RWKVS + 64 * MiB;
constexpr size_t WS_SCORES = WS_RWKVS;
constexpr size_t WS_MERGED = WS_RWKVS;
constexpr size_t WS_TMPB = WS_RWKVS + 32 * MiB;
constexpr size_t WS_NSAACC = WS_RWKVS + 80 * MiB;
constexpr size_t WS_O = WS_NSAACC + 32 * MiB;
constexpr size_t WS_END = WS_O + 48 * MiB;
constexpr size_t WS_ACT = WS_BIG;
constexpr size_t WS_TMPF = WS_BIG + 176 * MiB;
static_assert(WS_END <= 512 * MiB, "workspace");
static_assert(WS_TMPF + 64 * MiB <= WS_NSAACC, "ffn overlay");

constexpr int LDS_BYTES = 147456;
constexpr int LDS_MISC = 131072 + 8192;

__device__ __forceinline__ float bf2f(unsigned v) { return __uint_as_float(v << 16); }
typedef __bf16 bf16n2 __attribute__((ext_vector_type(2)));
__device__ __forceinline__ unsigned pk2(float lo, float hi) { const f32x2 f = {lo, hi}; const bf16n2 v = __builtin_convertvector(f, bf16n2); return __builtin_bit_cast(unsigned, v); }
__device__ __forceinline__ unsigned f2bf(float f) { return pk2(f, 0.f) & 0xffffu; }
__device__ __forceinline__ void unpack8(const u32x4 w, float (&f)[8]) {
    f[0] = __uint_as_float(w.x << 16); f[1] = __uint_as_float(w.x & 0xffff0000u); f[2] = __uint_as_float(w.y << 16); f[3] = __uint_as_float(w.y & 0xffff0000u);
    f[4] = __uint_as_float(w.z << 16); f[5] = __uint_as_float(w.z & 0xffff0000u); f[6] = __uint_as_float(w.w << 16); f[7] = __uint_as_float(w.w & 0xffff0000u);
}
__device__ __forceinline__ float wave_sum(float v) {
#pragma unroll
    for (int o = 32; o >= 1; o >>= 1) v += __shfl_xor(v, o);
    return v;
}
__device__ __forceinline__ float dpp_xor1(float v) { return __int_as_float(__builtin_amdgcn_update_dpp(0, __float_as_int(v), 0xB1, 0xf, 0xf, false)); }
__device__ __forceinline__ float dpp_xor2(float v) { return __int_as_float(__builtin_amdgcn_update_dpp(0, __float_as_int(v), 0x4E, 0xf, 0xf, false)); }
__device__ __forceinline__ float sigmoidf_(float x) { return 1.0f / (1.0f + __expf(-x)); }
__device__ __forceinline__ int t5_bucket(int n) {
    if (n < 16) return n;
    int b = 16;
    b += (n >= 21); b += (n >= 27); b += (n >= 35); b += (n >= 46); b += (n >= 59); b += (n >= 77); b += (n >= 99); b += (n >= 128);
    b += (n >= 166); b += (n >= 216); b += (n >= 280); b += (n >= 363); b += (n >= 470); b += (n >= 609); b += (n >= 790);
    return b;
}

#define XB_TMO      128
#define XB_XCNT(j)  (256  + 64 * (j))
#define XB_XSUB(j)  (1280 + 64 * (j))
#define XB_XGEN(j)  (2304 + 64 * (j))
#define XB_TOP      3328
#define XB_TOPGEN   3392
#define XCD_BAR_WORDS 3456
#define XB_SPIN_CAP (1u << 22)
__device__ __forceinline__ unsigned xb_ld(unsigned* p)              { return __hip_atomic_load(p, __ATOMIC_RELAXED, __HIP_MEMORY_SCOPE_AGENT); }
__device__ __forceinline__ unsigned xb_add(unsigned* p, unsigned v) { return __hip_atomic_fetch_add(p, v, __ATOMIC_RELAXED, __HIP_MEMORY_SCOPE_AGENT); }
__device__ __forceinline__ unsigned xb_xcc_id() { return (unsigned)__builtin_amdgcn_s_getreg((3 << 11) | 20) & 0xFu; }
#define XB_SPIN(cond, bar) do { unsigned _sp = 0; while (cond) { __builtin_amdgcn_s_sleep(1); \
    if ((++_sp & 255u) == 0u) { if (xb_ld(&(bar)[XB_TMO])) break; if (_sp > XB_SPIN_CAP) { atomicAdd(&(bar)[XB_TMO], 1u); break; } } } } while (0)
struct XcdBarrier { unsigned* bar; unsigned x; volatile LAS unsigned* st; };
__device__ __forceinline__ XcdBarrier xcd_barrier_post(unsigned* bar, volatile LAS unsigned* st) {
    XcdBarrier b; b.bar = bar; b.x = xb_xcc_id(); b.st = st;
    if (threadIdx.x == 0) (void)xb_add(&bar[XB_XCNT(b.x)], 1u);
    return b;
}
__device__ __forceinline__ void xcd_barrier_complete(unsigned* bar, unsigned x, unsigned& nloc, unsigned& nx) {
    const unsigned G = gridDim.x * gridDim.y * gridDim.z;
    unsigned sum, cnt, mine, sp = 0u;
    for (;;) {
        sum = 0u; cnt = 0u; mine = 0u;
#pragma unroll
        for (unsigned j = 0; j < 16; ++j) { const unsigned c = xb_ld(&bar[XB_XCNT(j)]); sum += c; cnt += (c > 0u) ? 1u : 0u; mine = (j == x) ? c : mine; }
        if (sum == G) break;
        __builtin_amdgcn_s_sleep(1);
        if ((++sp & 255u) == 0u) { if (xb_ld(&bar[XB_TMO])) break; if (sp > XB_SPIN_CAP) { atomicAdd(&bar[XB_TMO], 1u); break; } }
    }
    nloc = mine > 0u ? mine : 1u; nx = cnt > 0u ? cnt : 1u;
}
__device__ __forceinline__ void xcd_barrier(const XcdBarrier& b) {
    asm volatile("s_waitcnt vmcnt(0)" ::: "memory");
    __syncthreads();
    if (threadIdx.x == 0) {
        unsigned* bar = b.bar;
        __builtin_amdgcn_s_waitcnt(0);
        unsigned nloc = b.st[0], nx = b.st[1];
        if (nloc == 0u) { xcd_barrier_complete(bar, b.x, nloc, nx); b.st[0] = nloc; b.st[1] = nx; }
        const unsigned old = xb_add(&bar[XB_XSUB(b.x)], 1u);
        const unsigned gen = old / nloc;
        if (old + 1u == (gen + 1u) * nloc) {
            __builtin_amdgcn_fence(__ATOMIC_RELEASE, "agent");
            asm volatile("s_waitcnt vmcnt(0)" ::: "memory");
            const unsigned og = xb_add(&bar[XB_TOP], 1u);
            const unsigned tg = og / nx;
            if (og + 1u == (tg + 1u) * nx) xb_add(&bar[XB_TOPGEN], 1u);
            else XB_SPIN(xb_ld(&bar[XB_TOPGEN]) == tg, bar);
            __builtin_amdgcn_fence(__ATOMIC_ACQUIRE, "agent");
            xb_add(&bar[XB_XGEN(b.x)], 1u);
            asm volatile("s_waitcnt vmcnt(0)" ::: "memory");
        } else {
            XB_SPIN(xb_ld(&bar[XB_XGEN(b.x)]) == gen, bar);
            __builtin_amdgcn_fence(__ATOMIC_ACQUIRE, "agent");
            asm volatile("s_waitcnt vmcnt(0)" ::: "memory");
        }
    }
    __syncthreads();
}

namespace pg8 {
constexpr int BM = 256, BK = 64, HALF = 128, HTB = HALF * BK * 2, STAGE_BYTES = 8 * HTB, NXCD = 8, WGM = 8;
__device__ __forceinline__ int lds_byte(int r, int c) { const int st = (r >> 4) * 2 + (c >> 5), rr = r & 15, cc = c & 31, ob = rr * 64 + cc * 2; return st * 1024 + (ob ^ (((ob >> 9) & 1) << 5)); }
__device__ __forceinline__ void stage_rc(int b, int& R, int& C) { const int st = b / 1024, sb = b % 1024, swz = sb ^ (((sb >> 9) & 1) << 5); R = (st >> 1) * 16 + swz / 64; C = (st & 1) * 32 + (swz % 64) / 2; }
__device__ __forceinline__ int perm32(int rho) { const int n = rho >> 4, i = rho & 15; return 8 * (i >> 2) + 4 * n + (i & 3); }

struct Unit { int pm, pn, sub; unsigned aoff, boff; };
struct Gemm { const bf16_t* A; const bf16_t* Bt; int lda, ldb, K; unsigned kstepA = 128; };
struct Sched {
    int nM, nN, nwg, G, c, nsub, mode = 0; unsigned a_row, a_sub, b_row, b_sub;
    __device__ __forceinline__ void init(int nM_, int nN_, int G_, int c_, int nsub_, unsigned a_row_, unsigned a_sub_, unsigned b_row_, unsigned b_sub_) {
        nM = nM_; nN = nN_; nwg = nM * nN; G = G_; c = c_; nsub = nsub_; a_row = a_row_; a_sub = a_sub_; b_row = b_row_; b_sub = b_sub_; }
    __device__ __forceinline__ bool next(int i, Unit& u) const {
        const int round = i / nsub; u.sub = i - round * nsub;
        const long L = (long)round * G + c; if (L >= nwg) return false;
        int wgid = (int)L; { const int q = nwg / NXCD, r = nwg % NXCD, xcd = wgid % NXCD, off = wgid / NXCD; wgid = (xcd < r ? xcd * (q + 1) : r * (q + 1) + (xcd - r) * q) + off; }
        const int nig = WGM * nN, gid = wgid / nig, fm = gid * WGM, gsz = (nM - fm) < WGM ? (nM - fm) : WGM;
        u.pm = fm + ((wgid % nig) % gsz); u.pn = (wgid % nig) / gsz;
        u.aoff = (unsigned)u.pm * a_row + (unsigned)u.sub * a_sub; u.boff = (unsigned)u.pn * b_row + (unsigned)u.sub * b_sub;
        if (mode == 1) { const int kv = u.pm >> 3, g = (u.pm >> 2) & 1, cp = u.pm & 3;
            u.aoff = (unsigned)(((size_t)cp * 256 * 16 * PLD + (kv ? PC_VC : PC_KC) + g * 64) * 2); u.boff = (unsigned)kv * (256u * 2048u * 2u); }
        if (mode == 2) { const int kv = u.pm >> 3; u.boff = (unsigned)kv * (256u * 256u * 2u); }
        return true;
    }
};

template <class Epi>
__device__ __forceinline__ void gemm_phase(LAS unsigned char* lds, const int tid, const Gemm g, const Sched& S, const Epi& E) {
    const int wid = __builtin_amdgcn_readfirstlane(tid >> 6), lane = tid & 63, wr = wid >> 2, wc = wid & 3, fr = lane & 15, fq = lane >> 4;
    const int K = g.K, nt = K / BK;
    unsigned voffA[2], voffB[2];
#pragma unroll
    for (int i = 0; i < 2; ++i) { int R, C; stage_rc(tid * 16 + i * 8192, R, C); const int Rb = Epi::PERM ? ((R & ~31) + perm32(R & 31)) : R;
        voffA[i] = (unsigned)(R * g.lda + C) * 2u; voffB[i] = (unsigned)(Rb * g.ldb + C) * 2u; }
    const size_t kstep = (size_t)(BK * 2), kstA = g.kstepA;
    const size_t hstepA = (size_t)HALF * g.lda * 2, hstepB = (size_t)HALF * g.ldb * 2;
    const unsigned ldsw = (unsigned)wid * 1024u;
    const int aoff = lds_byte(wr * 64 + fr, fq * 8), boff = lds_byte(wc * 32 + fr, fq * 8);
#define PG8_SA(b, h) (((b) * 2 + (h)) * HTB)
#define PG8_SB(b, h) ((4 + (b) * 2 + (h)) * HTB)
#define PG8_STAGE(bufoff, gbase, voff) do { _Pragma("unroll") for (int _i = 0; _i < 2; ++_i) \
        __builtin_amdgcn_global_load_lds((const unsigned*)((const char*)(gbase) + (voff)[_i]), (LAS unsigned*)(lds + (bufoff) + ldsw + _i * 8192), 16, 0, 0); } while (0)
#define PG8_LDA(dst, b, h) do { _Pragma("unroll") for (int m = 0; m < 4; ++m) _Pragma("unroll") for (int k = 0; k < 2; ++k) dst[m][k] = *(const LAS bf16x8*)(lds + PG8_SA(b, h) + aoff + m * 2048 + k * 1024); } while (0)
#define PG8_LDB(dst, b, h) do { _Pragma("unroll") for (int n = 0; n < 2; ++n) _Pragma("unroll") for (int k = 0; k < 2; ++k) dst[n][k] = *(const LAS bf16x8*)(lds + PG8_SB(b, h) + boff + n * 2048 + k * 1024); } while (0)
#define PG8_MMA(ai, bj, At, Bt) do { __builtin_amdgcn_s_setprio(1); _Pragma("unroll") for (int m = 0; m < 4; ++m) _Pragma("unroll") for (int n = 0; n < 2; ++n) _Pragma("unroll") for (int k = 0; k < 2; ++k) \
        acc[ai][bj][m][n] = __builtin_amdgcn_mfma_f32_16x16x32_bf16(Bt[n][k], At[m][k], acc[ai][bj][m][n], 0, 0, 0); __builtin_amdgcn_s_setprio(0); } while (0)
#define PG8_WAIT_V(n) asm volatile("s_waitcnt vmcnt(" #n ")" ::: "memory")
#define PG8_WAIT_L(n) asm volatile("s_waitcnt lgkmcnt(" #n ")" ::: "memory")
#define PG8_BAR __builtin_amdgcn_s_barrier()
#define PG8_SCHED __builtin_amdgcn_sched_barrier(0)
    Unit cur, nxt; int ui = 0;
    if (!S.next(0, cur)) return;
    f32x4 acc[2][2][4][2];
#pragma unroll
    for (int a = 0; a < 2; ++a)
#pragma unroll
        for (int b = 0; b < 2; ++b)
#pragma unroll
            for (int m = 0; m < 4; ++m)
#pragma unroll
                for (int n = 0; n < 2; ++n) acc[a][b][m][n] = (f32x4){0.f, 0.f, 0.f, 0.f};
    bf16x8 At[4][2], B0[2][2], B1[2][2];
    const char* cA = (const char*)g.A + cur.aoff; const char* cB = (const char*)g.Bt + cur.boff;
    PG8_STAGE(PG8_SB(0, 0), cB, voffB); PG8_STAGE(PG8_SA(0, 0), cA, voffA); PG8_STAGE(PG8_SB(0, 1), cB + hstepB, voffB); PG8_STAGE(PG8_SA(0, 1), cA + hstepA, voffA);
    if (wr == 1) PG8_BAR;
    PG8_WAIT_V(4); PG8_BAR;
    PG8_STAGE(PG8_SB(1, 0), cB + kstep, voffB); PG8_STAGE(PG8_SA(1, 0), cA + kstA, voffA); PG8_STAGE(PG8_SB(1, 1), cB + hstepB + kstep, voffB);
    PG8_WAIT_V(6); PG8_BAR;
    for (;;) {
        const bool has_next = S.next(ui + 1, nxt);
        const char* nA = has_next ? (const char*)g.A + nxt.aoff : cA; const char* nB = has_next ? (const char*)g.Bt + nxt.boff : cB;
        for (int t = 0; t < nt; t += 2) {
            const bool last = (t == nt - 2);
            const char* a1 = cA + (size_t)(t + 1) * kstA;
            const char* a2 = last ? nA : cA + (size_t)(t + 2) * kstA; const char* b2 = last ? nB : cB + (size_t)(t + 2) * kstep;
            const char* a3 = a2 + kstA; const char* b3 = b2 + kstep;
            PG8_LDB(B0, 0, 0); PG8_SCHED; PG8_LDA(At, 0, 0); PG8_STAGE(PG8_SA(1, 1), a1 + hstepA, voffA);
            PG8_WAIT_L(8); PG8_BAR; PG8_WAIT_L(0); PG8_MMA(0, 0, At, B0); PG8_BAR; PG8_SCHED;
            PG8_LDB(B1, 0, 1); PG8_STAGE(PG8_SB(0, 0), b2, voffB);
            PG8_BAR; PG8_WAIT_L(0); PG8_MMA(0, 1, At, B1); PG8_BAR;
            PG8_LDA(At, 0, 1); PG8_STAGE(PG8_SA(0, 0), a2, voffA);
            PG8_BAR; PG8_WAIT_L(0); PG8_MMA(1, 0, At, B0); PG8_BAR; PG8_SCHED;
            PG8_STAGE(PG8_SB(0, 1), b2 + hstepB, voffB);
            PG8_WAIT_V(6); PG8_BAR; PG8_MMA(1, 1, At, B1); PG8_BAR;
            PG8_LDB(B0, 1, 0); PG8_SCHED; PG8_LDA(At, 1, 0); PG8_STAGE(PG8_SA(0, 1), a2 + hstepA, voffA);
            PG8_WAIT_L(8); PG8_BAR; PG8_WAIT_L(0); PG8_MMA(0, 0, At, B0); PG8_BAR; PG8_SCHED;
            PG8_LDB(B1, 1, 1); PG8_STAGE(PG8_SB(1, 0), b3, voffB);
            PG8_BAR; PG8_WAIT_L(0); PG8_MMA(0, 1, At, B1); PG8_BAR;
            PG8_LDA(At, 1, 1); PG8_STAGE(PG8_SA(1, 0), a3, voffA);
            PG8_BAR; PG8_WAIT_L(0); PG8_MMA(1, 0, At, B0); PG8_BAR; PG8_SCHED;
            PG8_STAGE(PG8_SB(1, 1), b3 + hstepB, voffB);
            PG8_WAIT_V(6); PG8_BAR; PG8_MMA(1, 1, At, B1); PG8_BAR;
        }
        const bool keep = E(acc, cur, wr, wc, fr, fq);
        if (!has_next) break;
        if (!keep) {
#pragma unroll
            for (int a = 0; a < 2; ++a)
#pragma unroll
                for (int b = 0; b < 2; ++b)
#pragma unroll
                    for (int m = 0; m < 4; ++m)
#pragma unroll
                        for (int n = 0; n < 2; ++n) acc[a][b][m][n] = (f32x4){0.f, 0.f, 0.f, 0.f};
        }
        cur = nxt; cA = nA; cB = nB; ++ui;
    }
    PG8_WAIT_V(0);
    if (wr == 0) PG8_BAR;
    PG8_BAR;
#undef PG8_SA
#undef PG8_SB
#undef PG8_STAGE
#undef PG8_LDA
#undef PG8_LDB
#undef PG8_MMA
#undef PG8_WAIT_V
#undef PG8_WAIT_L
#undef PG8_BAR
#undef PG8_SCHED
}

struct EpiInProj {
    static constexpr bool PERM = true;
    bf16_t* proj; bf16_t* gates; const float* rs;
    __device__ __forceinline__ bool operator()(f32x4 (&acc)[2][2][4][2], const Unit& u, int wr, int wc, int fr, int fq) const {
        const int row0 = u.pm * BM + wr * 64 + fr; const bool is_gate = u.pn >= 16;
        bf16_t* base = is_gate ? gates + (u.pn - 16) * 256 : proj + u.pn * 256; const int ld = is_gate ? 3072 : PLD;
        const int col0 = wc * 32 + 8 * fq;
#pragma unroll
        for (int ai = 0; ai < 2; ++ai)
#pragma unroll
            for (int m = 0; m < 4; ++m) { const int row = row0 + ai * HALF + m * 16; const float s = rs[row]; bf16_t* rowp = base + (size_t)row * ld + col0;
#pragma unroll
                for (int bj = 0; bj < 2; ++bj) { f32x4 v0 = acc[ai][bj][m][0] * s, v1 = acc[ai][bj][m][1] * s;
                    if (is_gate) {
#pragma unroll
                        for (int j = 0; j < 4; ++j) { v0[j] = sigmoidf_(v0[j]); v1[j] = sigmoidf_(v1[j]); } }
                    u32x4 w; w.x = pk2(v0[0], v0[1]); w.y = pk2(v0[2], v0[3]); w.z = pk2(v1[0], v1[1]); w.w = pk2(v1[2], v1[3]);
                    *(u32x4*)(rowp + bj * HALF) = w; } }
        return false;
    }
};
struct EpiStore {
    static constexpr bool PERM = true;
    bf16_t* out; int ld;
    __device__ __forceinline__ bool operator()(f32x4 (&acc)[2][2][4][2], const Unit& u, int wr, int wc, int fr, int fq) const {
        const int row0 = u.pm * BM + wr * 64 + fr; const int col0 = u.pn * BM + wc * 32 + 8 * fq;
#pragma unroll
        for (int ai = 0; ai < 2; ++ai)
#pragma unroll
            for (int m = 0; m < 4; ++m) { bf16_t* rowp = out + (size_t)(row0 + ai * HALF + m * 16) * ld + col0;
#pragma unroll
                for (int bj = 0; bj < 2; ++bj) { const f32x4 v0 = acc[ai][bj][m][0], v1 = acc[ai][bj][m][1];
                    u32x4 w; w.x = pk2(v0[0], v0[1]); w.y = pk2(v0[2], v0[3]); w.z = pk2(v1[0], v1[1]); w.w = pk2(v1[2], v1[3]);
                    *(u32x4*)(rowp + bj * HALF) = w; } }
        return false;
    }
};
struct EpiCmp1 {
    static constexpr bool PERM = true;
    bf16_t* hid; const float* bh;
    __device__ __forceinline__ bool operator()(f32x4 (&acc)[2][2][4][2], const Unit& u, int wr, int wc, int fr, int fq) const {
        const int kv = u.pm >> 3; const int row0 = (u.pm & 7) * BM + wr * 64 + fr; const int col0 = wc * 32 + 8 * fq;
#pragma unroll
        for (int ai = 0; ai < 2; ++ai)
#pragma unroll
            for (int m = 0; m < 4; ++m) { bf16_t* rowp = hid + ((size_t)kv * 2048 + row0 + ai * HALF + m * 16) * 256 + col0;
#pragma unroll
                for (int bj = 0; bj < 2; ++bj) { float o[8];
#pragma unroll
                    for (int j = 0; j < 8; ++j) { const float x = acc[ai][bj][m][j >> 2][j & 3] + bh[kv * 256 + col0 + bj * HALF + j];
                        o[j] = x * sigmoidf_(1.5957691216f * (x + 0.044715f * x * x * x)); }
                    u32x4 w; w.x = pk2(o[0], o[1]); w.y = pk2(o[2], o[3]); w.z = pk2(o[4], o[5]); w.w = pk2(o[6], o[7]);
                    *(u32x4*)(rowp + bj * HALF) = w; } }
        return false;
    }
};
struct EpiCmp2 {
    static constexpr bool PERM = true;
    bf16_t* kcb; bf16_t* vct;
    __device__ __forceinline__ bool operator()(f32x4 (&acc)[2][2][4][2], const Unit& u, int wr, int wc, int fr, int fq) const {
        const int kv = u.pm >> 3; const int row0 = (u.pm & 7) * BM + wr * 64 + fr; const int col0 = wc * 32 + 8 * fq;
        if (col0 >= 64) return false;
#pragma unroll
        for (int ai = 0; ai < 2; ++ai)
#pragma unroll
            for (int m = 0; m < 4; ++m) { const int row = row0 + ai * HALF + m * 16, g = row >> 10, cc = row & 1023; const bool zr = cc == 1023; const f32x4 zz = (f32x4){0.f, 0.f, 0.f, 0.f};
                const f32x4 v0 = zr ? zz : acc[ai][0][m][0], v1 = zr ? zz : acc[ai][0][m][1];
                if (kv == 0) { u32x4 w; w.x = pk2(v0[0], v0[1]); w.y = pk2(v0[2], v0[3]); w.z = pk2(v1[0], v1[1]); w.w = pk2(v1[2], v1[3]); *(u32x4*)(kcb + ((size_t)g * 1024 + cc) * 64 + col0) = w; }
                else {
#pragma unroll
                    for (int j = 0; j < 4; ++j) { vct[((size_t)g * 64 + col0 + j) * 1024 + cc] = (bf16_t)f2bf(v0[j]); vct[((size_t)g * 64 + col0 + 4 + j) * 1024 + cc] = (bf16_t)f2bf(v1[j]); } } }
        return false;
    }
};
struct EpiLora {
    static constexpr bool PERM = true;
    bf16_t* obuf;
    __device__ __forceinline__ bool operator()(f32x4 (&acc)[2][2][4][2], const Unit& u, int wr, int wc, int fr, int fq) const {
        const int sel = u.pn >> 1; bf16_t* out = obuf + (size_t)(sel == 2 ? 0 : sel + 1) * T * 512;
        const int row0 = u.pm * BM + wr * 64 + fr; const int col0 = (u.pn & 1) * BM + wc * 32 + 8 * fq;
#pragma unroll
        for (int ai = 0; ai < 2; ++ai)
#pragma unroll
            for (int m = 0; m < 4; ++m) { bf16_t* rowp = out + (size_t)(row0 + ai * HALF + m * 16) * 512 + col0;
#pragma unroll
                for (int bj = 0; bj < 2; ++bj) { const f32x4 v0 = acc[ai][bj][m][0], v1 = acc[ai][bj][m][1];
                    u32x4 w; w.x = pk2(v0[0], v0[1]); w.y = pk2(v0[2], v0[3]); w.z = pk2(v1[0], v1[1]); w.w = pk2(v1[2], v1[3]);
                    *(u32x4*)(rowp + bj * HALF) = w; } }
        return false;
    }
};
struct EpiMerge {
    static constexpr bool PERM = true;
    const bf16_t* gates; bf16_t* merged;
    __device__ __forceinline__ bool operator()(f32x4 (&acc)[2][2][4][2], const Unit& u, int wr, int wc, int fr, int fq) const {
        const int row0 = u.pm * BM + wr * 64 + fr; const int col0 = u.pn * BM + wc * 32 + 8 * fq; const int sub = u.sub;
#pragma unroll
        for (int ai = 0; ai < 2; ++ai)
#pragma unroll
            for (int m = 0; m < 4; ++m) { const int row = row0 + ai * HALF + m * 16; const bf16_t* gp = gates + (size_t)row * 3072 + sub * 1024 + col0;
#pragma unroll
                for (int bj = 0; bj < 2; ++bj) {
                    float sc[8], sn[8]; unpack8(*(const u32x4*)(gp + bj * HALF), sc);
                    if (sub < 2) { unpack8(*(const u32x4*)(gp + 1024 + bj * HALF), sn);
#pragma unroll
                        for (int j = 0; j < 8; ++j) sc[j] = sc[j] / fmaxf(sn[j], 1e-30f); }
                    f32x4 v0 = acc[ai][bj][m][0], v1 = acc[ai][bj][m][1];
#pragma unroll
                    for (int j = 0; j < 4; ++j) { v0[j] *= sc[j]; v1[j] *= sc[4 + j]; }
                    acc[ai][bj][m][0] = v0; acc[ai][bj][m][1] = v1;
                    if (sub == 2) { u32x4 w; w.x = pk2(v0[0], v0[1]); w.y = pk2(v0[2], v0[3]); w.z = pk2(v1[0], v1[1]); w.w = pk2(v1[2], v1[3]);
                        *(u32x4*)(merged + (size_t)row * D + col0 + bj * HALF) = w; } } }
        return sub != 2;
    }
};
struct EpiSwiGLU {
    static constexpr bool PERM = true;
    bf16_t* act; const float* rs;
    __device__ __forceinline__ bool operator()(f32x4 (&acc)[2][2][4][2], const Unit& u, int wr, int wc, int fr, int fq) const {
        const int row0 = u.pm * BM + wr * 64 + fr; const int col0 = u.pn * HALF + wc * 32 + 8 * fq;
#pragma unroll
        for (int ai = 0; ai < 2; ++ai)
#pragma unroll
            for (int m = 0; m < 4; ++m) { const int row = row0 + ai * HALF + m * 16; const float s = rs[row];
                float o[8];
#pragma unroll
                for (int n = 0; n < 2; ++n)
#pragma unroll
                    for (int j = 0; j < 4; ++j) { const float gg = acc[ai][0][m][n][j] * s, uu = acc[ai][1][m][n][j] * s; o[n * 4 + j] = gg * sigmoidf_(gg) * uu; }
                u32x4 w; w.x = pk2(o[0], o[1]); w.y = pk2(o[2], o[3]); w.z = pk2(o[4], o[5]); w.w = pk2(o[6], o[7]);
                *(u32x4*)(act + (size_t)row * FFN + col0) = w; }
        return false;
    }
};
}

struct Args { const float* in[30]; float* out; unsigned char* ws; int lo, hi; };
enum { I_X = 0, I_NPM, I_NQM, I_NPF, I_NQF, I_WIN, I_MU, I_W0, I_W2, I_A0, I_A2, I_G2, I_KK, I_KA, I_RK, I_LNW, I_LNB, I_PEK, I_PEV, I_CKW1, I_CKW2, I_CVW1, I_CVW2, I_SINK, I_REL, I_WBR, I_WOUT, I_FG, I_FU, I_FD };

struct Ctx { LAS unsigned char* lds; int tid, lane, wave, G, bid; };
__device__ __forceinline__ const float* inptr(const Ctx& c, int i) {
    const volatile LAS unsigned* t = (const volatile LAS unsigned*)(c.lds + LDS_MISC + 64) + 2 * i;
    const unsigned lo = __builtin_amdgcn_readfirstlane(t[0]), hi = __builtin_amdgcn_readfirstlane(t[1]);
    return (const float*)(((unsigned long long)hi << 32) | lo);
}

__device__ __forceinline__ void phase_init(const Ctx& c, const float* x, float* xo, bf16_t* xb, float* rs) {
    const int gw = c.bid * 8 + c.wave, NGW = c.G * 8;
    for (int row = gw; row < MROWS; row += NGW) {
        const float* xr = x + (size_t)row * D; float ss = 0.f;
#pragma unroll
        for (int j = 0; j < 2; ++j) { const int e = c.lane * 8 + 512 * j; const f32x4 a = *(const f32x4*)(xr + e), b = *(const f32x4*)(xr + e + 4);
            ss += a[0] * a[0] + a[1] * a[1] + a[2] * a[2] + a[3] * a[3] + b[0] * b[0] + b[1] * b[1] + b[2] * b[2] + b[3] * b[3];
            *(f32x4*)(xo + (size_t)row * D + e) = a; *(f32x4*)(xo + (size_t)row * D + e + 4) = b;
            u32x4 w; w.x = pk2(a[0], a[1]); w.y = pk2(a[2], a[3]); w.z = pk2(b[0], b[1]); w.w = pk2(b[2], b[3]); *(u32x4*)(xb + (size_t)row * D + e) = w; }
        ss = wave_sum(ss);
        if (c.lane == 0) rs[row] = rsqrtf(ss * (1.0f / D) + NORM_EPS);
    }
}
__device__ __forceinline__ void phase_norm_res(const Ctx& c, const bf16_t* y, const float* gain, float* x, bf16_t* xb, float* rs, int row0, int nrows) {
    const int gw = c.bid * 8 + c.wave, NGW = c.G * 8;
    for (int r = gw; r < nrows; r += NGW) {
        const int row = row0 + r; float yv[16]; float ss = 0.f;
#pragma unroll
        for (int j = 0; j < 2; ++j) { float f[8]; unpack8(*(const u32x4*)(y + (size_t)r * D + c.lane * 8 + 512 * j), f);
#pragma unroll
            for (int k = 0; k < 8; ++k) { yv[j * 8 + k] = f[k]; ss += f[k] * f[k]; } }
        ss = wave_sum(ss); const float sc = rsqrtf(ss * (1.0f / D) + NORM_EPS); float s2 = 0.f;
#pragma unroll
        for (int j = 0; j < 2; ++j) { const int e = c.lane * 8 + 512 * j; float* xr = x + (size_t)row * D + e;
            f32x4 a = *(const f32x4*)xr, b = *(const f32x4*)(xr + 4); const f32x4 ga = *(const f32x4*)(gain + e), gb = *(const f32x4*)(gain + e + 4);
#pragma unroll
            for (int k = 0; k < 4; ++k) { a[k] += yv[j * 8 + k] * sc * ga[k]; b[k] += yv[j * 8 + 4 + k] * sc * gb[k]; s2 += a[k] * a[k] + b[k] * b[k]; }
            *(f32x4*)xr = a; *(f32x4*)(xr + 4) = b;
            u32x4 w; w.x = pk2(a[0], a[1]); w.y = pk2(a[2], a[3]); w.z = pk2(b[0], b[1]); w.w = pk2(b[2], b[3]); *(u32x4*)(xb + (size_t)row * D + e) = w; }
        s2 = wave_sum(s2);
        if (c.lane == 0) rs[row] = rsqrtf(s2 * (1.0f / D) + NORM_EPS);
    }
}

__device__ __forceinline__ void phase_cvt(const Ctx& c, const Args& a, int layer, bf16_t* wb) {
    LAS float* tile = (LAS float*)c.lds;
    constexpr int I0 = 16 * 112, I1 = 3 * 8 * 16, I2 = 16 * 16, I3 = 16 * 88, I4 = 44 * 16, I5 = 4 * 24, I6 = 2 * 32 * 4, I7 = 2 * 4 * 4, NIT = I0 + I1 + I2 + I3 + I4 + I5 + I6 + I7;
    for (int it = c.bid; it < NIT; it += c.G) {
        int r = it, kind, sub = 0, K, nblk; bf16_t* dst;
        if (r < I0) { kind = 0; K = D; nblk = 112; dst = wb + WB_WIN; }
        else if ((r -= I0) < I1) { kind = 1; sub = r / 128; r -= sub * 128; K = 512; nblk = 16; dst = wb + WB_WBR + (size_t)sub * D * 512; }
        else if ((r -= I1) < I2) { kind = 2; K = D; nblk = 16; dst = wb + WB_WOUT; }
        else if ((r -= I2) < I3) { kind = 3; K = D; nblk = 88; dst = wb + WB_WGU; }
        else if ((r -= I3) < I4) { kind = 4; K = FFN; nblk = 16; dst = wb + WB_WDN; }
        else if ((r -= I4) < I5) { kind = 5; K = 256; nblk = 24; dst = wb + WB_LORA; }
        else if ((r -= I5) < I6) { kind = 6; sub = r / 128; r -= sub * 128; K = 2048; nblk = 4; dst = wb + WB_W1T + (size_t)sub * 256 * 2048; }
        else { r -= I6; kind = 7; sub = r / 16; r -= sub * 16; K = 256; nblk = 4; dst = wb + WB_W2T + (size_t)sub * 256 * 256; }
        const int kb = r / nblk, nb = r % nblk, k0 = kb * 64, n0 = nb * 64;
        const float* src = nullptr; int ld = 0, nvalid = 64; float extra = 1.f; const float* gain = nullptr; bool kvalid = true;
        switch (kind) {
        case 0: { gain = inptr(c, I_NPM) + layer * D + k0; ld = IN_COLS;
            const int scol = n0 < 3096 ? n0 : n0 - 232; nvalid = (n0 < 3096) ? (3096 - n0 < 64 ? 3096 - n0 : 64) : (n0 < 3328 ? 0 : 64);
            if ((n0 >= PC_NQ && n0 < PC_NQ + 512) || (n0 >= PC_SQ && n0 < PC_SQ + 512)) extra = 0.125f;
            src = inptr(c, I_WIN) + ((size_t)layer * D + k0) * IN_COLS + scol; break; }
        case 1: src = inptr(c, I_WBR) + (((size_t)layer * 3 + sub) * 512 + k0) * D + n0; ld = D; break;
        case 2: src = inptr(c, I_WOUT) + ((size_t)layer * D + k0) * D + n0; ld = D; break;
        case 3: { gain = inptr(c, I_NPF) + layer * D + k0; ld = FFN; const int pn = n0 >> 8, rr = n0 & 255;
            src = inptr(c, rr < 128 ? I_FG : I_FU) + ((size_t)layer * D + k0) * FFN + pn * 128 + (rr & 127); break; }
        case 4: src = inptr(c, I_FD) + ((size_t)layer * FFN + k0) * D + n0; ld = D; break;
        case 5: { ld = 512;
            if (n0 < 512) { kvalid = k0 < 64; src = inptr(c, I_W2) + ((size_t)layer * 64 + k0) * 512 + n0; }
            else if (n0 < 1024) { kvalid = (k0 == 64); src = inptr(c, I_A2) + ((size_t)layer * 64 + (k0 - 64)) * 512 + n0 - 512; }
            else { kvalid = k0 >= 128; src = inptr(c, I_G2) + ((size_t)layer * 128 + (k0 - 128)) * 512 + n0 - 1024; }
            break; }
        case 6: src = inptr(c, sub ? I_CVW1 : I_CKW1) + ((size_t)layer * 2048 + k0) * 256 + n0; ld = 256; break;
        default: src = inptr(c, sub ? I_CVW2 : I_CKW2) + ((size_t)layer * 256 + k0) * 64 + n0; ld = 64; nvalid = n0 < 64 ? 64 : 0; break;
        }
#pragma unroll
        for (int i = 0; i < 8; ++i) { const int e = c.tid + 512 * i, kk = e >> 6, nn = e & 63; float v = 0.f;
            if (kvalid && nn < nvalid) { v = src[(size_t)kk * ld + nn] * extra; if (gain) v *= gain[kk]; }
            tile[kk * 65 + nn] = v; }
        __syncthreads();
        { const int nn = c.tid >> 3, kc = (c.tid & 7) * 8; u32x4 w;
          w.x = pk2(tile[(kc + 0) * 65 + nn], tile[(kc + 1) * 65 + nn]); w.y = pk2(tile[(kc + 2) * 65 + nn], tile[(kc + 3) * 65 + nn]);
          w.z = pk2(tile[(kc + 4) * 65 + nn], tile[(kc + 5) * 65 + nn]); w.w = pk2(tile[(kc + 6) * 65 + nn], tile[(kc + 7) * 65 + nn]);
          *(u32x4*)(dst + (size_t)(n0 + nn) * K + k0 + kc) = w; }
        __syncthreads();
    }
    if (c.bid == c.G - 1) {
        const int kv = c.tid >> 8, u = c.tid & 255; const float* w1 = inptr(c, kv ? I_CVW1 : I_CKW1) + (size_t)layer * 2048 * 256; const float* pe = inptr(c, kv ? I_PEV : I_PEK) + (size_t)layer * 2048;
        float acc = 0.f; for (int k = 0; k < 2048; ++k) acc += pe[k] * w1[(size_t)k * 256 + u];
        ((float*)(wb + WB_BH))[c.tid] = acc;
    }
}

struct RowState { float q[64]; float o[64]; float m, l; };
__device__ __forceinline__ void row_init(RowState& s, const bf16_t* qp) {
#pragma unroll
    for (int i = 0; i < 8; ++i) { float f[8]; unpack8(*(const u32x4*)(qp + i * 8), f);
#pragma unroll
        for (int k = 0; k < 8; ++k) s.q[i * 8 + k] = f[k]; }
}
__device__ __forceinline__ void row_reset(RowState& s) {
#pragma unroll
    for (int i = 0; i < 64; ++i) s.o[i] = 0.f;
    s.m = -1e30f; s.l = 0.f;
}
__device__ __forceinline__ void row_key_bf16(RowState& s, const bf16_t* kp, const bf16_t* vp, float bias) {
    float sc = bias;
#pragma unroll
    for (int i = 0; i < 8; ++i) { float f[8]; unpack8(*(const u32x4*)(kp + i * 8), f);
#pragma unroll
        for (int k = 0; k < 8; ++k) sc += s.q[i * 8 + k] * f[k];
        if ((i & 1) == 1) __builtin_amdgcn_sched_barrier(0); }
    const float mn = fmaxf(s.m, sc), corr = __expf(s.m - mn), p = __expf(sc - mn);
    s.l = s.l * corr + p; s.m = mn;
#pragma unroll
    for (int i = 0; i < 8; ++i) { float f[8]; unpack8(*(const u32x4*)(vp + i * 8), f);
#pragma unroll
        for (int k = 0; k < 8; ++k) s.o[i * 8 + k] = s.o[i * 8 + k] * corr + p * f[k];
        if ((i & 1) == 1) __builtin_amdgcn_sched_barrier(0); }
}
__device__ __forceinline__ void row_key_f32(RowState& s, const float* kp, const float* vp, float bias) {
    float sc = bias;
#pragma unroll
    for (int i = 0; i < 16; ++i) { const f32x4 f = *(const f32x4*)(kp + i * 4); sc += s.q[i * 4] * f[0] + s.q[i * 4 + 1] * f[1] + s.q[i * 4 + 2] * f[2] + s.q[i * 4 + 3] * f[3];
        if ((i & 3) == 3) __builtin_amdgcn_sched_barrier(0); }
    const float mn = fmaxf(s.m, sc), corr = __expf(s.m - mn), p = __expf(sc - mn);
    s.l = s.l * corr + p; s.m = mn;
#pragma unroll
    for (int i = 0; i < 16; ++i) { const f32x4 f = *(const f32x4*)(vp + i * 4);
#pragma unroll
        for (int k = 0; k < 4; ++k) s.o[i * 4 + k] = s.o[i * 4 + k] * corr + p * f[k];
        if ((i & 3) == 3) __builtin_amdgcn_sched_barrier(0); }
}

__device__ __forceinline__ float gelu_tanh(float x) { const float t = tanhf(0.7978845608028654f * (x + 0.044715f * x * x * x)); return 0.5f * x * (1.0f + t); }
__device__ __forceinline__ void phase_cmp1(const Ctx& c, const Args& a, int layer, const bf16_t* proj, float* hid) {
    for (int unit = c.bid; unit < 2048; unit += c.G) {
        const int kv = unit >> 10, g = (unit >> 9) & 1, cp = unit & 511; const int cc = cp * 2 + (c.tid >> 8), u = c.tid & 255;
        if (cc >= NCMP) continue;
        const float* w1 = a.in[kv ? I_CVW1 : I_CKW1] + (size_t)layer * 2048 * 256; const float* pe = a.in[kv ? I_PEV : I_PEK] + (size_t)layer * 32 * 64;
        const bf16_t* xp = proj + (size_t)(16 * cc) * PLD + (kv ? PC_VC : PC_KC) + g * 64;
        float acc = 0.f;
        for (int l = 0; l < 32; ++l) {
#pragma unroll
            for (int i = 0; i < 8; ++i) { float f[8]; unpack8(*(const u32x4*)(xp + (size_t)l * PLD + i * 8), f);
#pragma unroll
                for (int k = 0; k < 8; ++k) acc += (f[k] + pe[l * 64 + i * 8 + k]) * w1[(size_t)(l * 64 + i * 8 + k) * 256 + u]; }
        }
        hid[(((size_t)kv * 2 + g) * 1024 + cc) * 256 + u] = gelu_tanh(acc);
    }
}
__device__ __forceinline__ void phase_cmp2(const Ctx& c, const Args& a, int layer, const float* hid, bf16_t* kcb, bf16_t* vctb) {
    for (int unit = c.bid; unit < 512; unit += c.G) {
        const int kv = unit >> 8, g = (unit >> 7) & 1, cc = (unit & 127) * 8 + (c.tid >> 6), d = c.tid & 63;
        float acc = 0.f;
        if (cc < NCMP) { const float* w2 = a.in[kv ? I_CVW2 : I_CKW2] + (size_t)layer * 256 * 64; const float* hp = hid + (((size_t)kv * 2 + g) * 1024 + cc) * 256;
            for (int u = 0; u < 256; ++u) acc += hp[u] * w2[u * 64 + d]; }
        if (kv) vctb[((size_t)g * 64 + d) * 1024 + cc] = (bf16_t)f2bf(acc); else kcb[((size_t)g * 1024 + cc) * 64 + d] = (bf16_t)f2bf(acc);
    }
}
__device__ __forceinline__ void phase_nsa13(const Ctx& c, const Args& a, const bf16_t* proj, const float* kcmp, const float* vcmp, float* nsaacc, float* ml) {
    LAS float* tb = (LAS float*)c.lds;
    for (int e = c.tid; e < 512; e += 512) tb[e] = inptr(c, I_REL)[e];
    __syncthreads();
    for (int unit = c.bid; unit < T / 64; unit += c.G) {
        const int hh = c.tid >> 6, t = unit * 64 + (c.tid & 63), g = hh >> 2;
        RowState s; row_init(s, proj + (size_t)t * PLD + PC_NQ + hh * 64);
        const bf16_t* glp = proj + (size_t)t * PLD + PC_GL;
        const float g0 = sigmoidf_(bf2f(glp[hh])), g2 = sigmoidf_(bf2f(glp[16 + hh]));
        row_reset(s);
        const int nv = t >= 31 ? (t - 31) / 16 + 1 : 0;
        for (int cc = 0; cc < nv; ++cc) { const float bias = tb[t5_bucket(t - 16 * cc - 31) * 16 + hh];
            row_key_f32(s, kcmp + ((size_t)g * 1024 + cc) * 64, vcmp + ((size_t)g * 1024 + cc) * 64, bias); }
        ml[((size_t)t * 8 + hh) * 2] = s.m; ml[((size_t)t * 8 + hh) * 2 + 1] = s.l;
        float* op = nsaacc + (size_t)t * 512 + hh * 64;
        { const float inv = s.l > 0.f ? g0 / s.l : 0.f;
#pragma unroll
            for (int i = 0; i < 16; ++i) { f32x4 w; w[0] = s.o[i * 4] * inv; w[1] = s.o[i * 4 + 1] * inv; w[2] = s.o[i * 4 + 2] * inv; w[3] = s.o[i * 4 + 3] * inv; *(f32x4*)(op + i * 4) = w; } }
        row_reset(s);
        const int s0 = t - 511 > 0 ? t - 511 : 0;
        for (int sp = s0; sp <= t; ++sp) { const float bias = tb[t5_bucket(t - sp) * 16 + hh];
            row_key_bf16(s, proj + (size_t)sp * PLD + PC_KW + g * 64, proj + (size_t)sp * PLD + PC_VW + g * 64, bias); }
        { const float inv = s.l > 0.f ? g2 / s.l : 0.f;
#pragma unroll
            for (int i = 0; i < 16; ++i) { f32x4 w = *(const f32x4*)(op + i * 4); w[0] += s.o[i * 4] * inv; w[1] += s.o[i * 4 + 1] * inv; w[2] += s.o[i * 4 + 2] * inv; w[3] += s.o[i * 4 + 3] * inv; *(f32x4*)(op + i * 4) = w; } }
    }
}
__device__ __forceinline__ void phase_nsa_topk(const Ctx& c, const Args& a, const bf16_t* proj, const float* kcmp, const float* ml, int* sel) {
    LAS float* tb = (LAS float*)c.lds;
    LAS float* qs = (LAS float*)(c.lds + 4096) + c.wave * 256;
    LAS float* sv = (LAS float*)(c.lds + 16384) + c.wave * 256;
    for (int e = c.tid; e < 512; e += 512) tb[e] = inptr(c, I_REL)[e];
    __syncthreads();
    const int gw = c.bid * 8 + c.wave, NGW = c.G * 8;
    for (int item = gw; item < T * 2; item += NGW) {
        const int t = item >> 1, g = item & 1, cur = t >> 6;
        { const bf16_t* qp = proj + (size_t)t * PLD + PC_NQ + g * 256 + c.lane * 4; const u32x2 w = *(const u32x2*)qp;
          qs[c.lane * 4] = __uint_as_float(w.x << 16); qs[c.lane * 4 + 1] = __uint_as_float(w.x & 0xffff0000u); qs[c.lane * 4 + 2] = __uint_as_float(w.y << 16); qs[c.lane * 4 + 3] = __uint_as_float(w.y & 0xffff0000u); }
        float mr[4], il[4];
#pragma unroll
        for (int r = 0; r < 4; ++r) { mr[r] = ml[((size_t)t * 8 + g * 4 + r) * 2]; const float l = ml[((size_t)t * 8 + g * 4 + r) * 2 + 1]; il[r] = l > 0.f ? 1.0f / l : 0.f; }
        const int nv = t >= 31 ? (t - 31) / 16 + 1 : 0;
        asm volatile("s_waitcnt lgkmcnt(0)" ::: "memory");
#pragma unroll 1
        for (int jj = 0; jj < 4; ++jj) {
            const int j = c.lane + 64 * jj; float sc;
            if (j == 0 || j == cur || j == cur - 1) sc = 1e4f;
            else if (j > cur) sc = -1.0f;
            else { sc = 0.f;
#pragma unroll 1
                for (int o = 0; o < 5; ++o) { const int cc = 4 * j + o - 1; if (cc < 0 || cc >= nv) continue;
                    const float* kp = kcmp + ((size_t)g * 1024 + cc) * 64; float d0 = 0.f, d1 = 0.f, d2 = 0.f, d3 = 0.f;
#pragma unroll 4
                    for (int i = 0; i < 16; ++i) { const f32x4 f = *(const f32x4*)(kp + i * 4);
#pragma unroll
                        for (int k = 0; k < 4; ++k) { d0 += qs[i * 4 + k] * f[k]; d1 += qs[64 + i * 4 + k] * f[k]; d2 += qs[128 + i * 4 + k] * f[k]; d3 += qs[192 + i * 4 + k] * f[k]; } }
                    const int bk = t5_bucket(t - 16 * cc - 31) * 16 + g * 4;
                    const float imp = __expf(d0 + tb[bk] - mr[0]) * il[0] + __expf(d1 + tb[bk + 1] - mr[1]) * il[1] + __expf(d2 + tb[bk + 2] - mr[2]) * il[2] + __expf(d3 + tb[bk + 3] - mr[3]) * il[3];
                    sc += ((o == 0 || o == 4) ? 1.0f : 2.0f) * imp; }
            }
            sv[j] = sc;
        }
        asm volatile("s_waitcnt lgkmcnt(0)" ::: "memory");
        float val[4];
#pragma unroll
        for (int jj = 0; jj < 4; ++jj) val[jj] = sv[c.lane + 64 * jj];
        for (int k = 0; k < 16; ++k) {
            float bv = val[0]; int bi = c.lane;
#pragma unroll
            for (int jj = 1; jj < 4; ++jj) if (val[jj] > bv) { bv = val[jj]; bi = c.lane + 64 * jj; }
#pragma unroll
            for (int o = 32; o >= 1; o >>= 1) { const float ov = __shfl_xor(bv, o); const int oi = __shfl_xor(bi, o); if (ov > bv || (ov == bv && oi < bi)) { bv = ov; bi = oi; } }
#pragma unroll
            for (int jj = 0; jj < 4; ++jj) if (bi == c.lane + 64 * jj) val[jj] = -3e38f;
            if (c.lane == 0) sel[(size_t)item * 16 + k] = bi;
        }
    }
}
__device__ __forceinline__ void phase_nsa2(const Ctx& c, const Args& a, const bf16_t* proj, const int* sel, const float* nsaacc, bf16_t* onsa) {
    LAS float* tb = (LAS float*)c.lds;
    for (int e = c.tid; e < 512; e += 512) tb[e] = inptr(c, I_REL)[e];
    __syncthreads();
    for (int unit = c.bid; unit < T / 64; unit += c.G) {
        const int hh = c.tid >> 6, t = unit * 64 + (c.tid & 63), g = hh >> 2;
        RowState s; row_init(s, proj + (size_t)t * PLD + PC_NQ + hh * 64); row_reset(s);
        const float g1 = sigmoidf_(bf2f(proj[(size_t)t * PLD + PC_GL + 8 + hh]));
        for (int k = 0; k < 16; ++k) { const int j = sel[((size_t)t * 2 + g) * 16 + k];
            for (int p = 0; p < 64; ++p) { const int pos = j * 64 + p; if (pos > t) break;
                const float bias = tb[t5_bucket(t - pos) * 16 + hh];
                row_key_bf16(s, proj + (size_t)pos * PLD + PC_KS + g * 64, proj + (size_t)pos * PLD + PC_VS + g * 64, bias); } }
        const float inv = s.l > 0.f ? g1 / s.l : 0.f; const float* ap = nsaacc + (size_t)t * 512 + hh * 64; bf16_t* op = onsa + (size_t)t * 512 + hh * 64;
#pragma unroll
        for (int i = 0; i < 8; ++i) { const f32x4 x0 = *(const f32x4*)(ap + i * 8), x1 = *(const f32x4*)(ap + i * 8 + 4); u32x4 w;
            w.x = pk2(x0[0] + s.o[i * 8] * inv, x0[1] + s.o[i * 8 + 1] * inv); w.y = pk2(x0[2] + s.o[i * 8 + 2] * inv, x0[3] + s.o[i * 8 + 3] * inv);
            w.z = pk2(x1[0] + s.o[i * 8 + 4] * inv, x1[1] + s.o[i * 8 + 5] * inv); w.w = pk2(x1[2] + s.o[i * 8 + 6] * inv, x1[3] + s.o[i * 8 + 7] * inv);
            *(u32x4*)(op + i * 8) = w; }
    }
}
__device__ __forceinline__ void phase_swa(const Ctx& c, const Args& a, int layer, const bf16_t* proj, bf16_t* oswa) {
    LAS float* tb = (LAS float*)c.lds;
    for (int e = c.tid; e < 512; e += 512) tb[e] = inptr(c, I_REL)[e];
    __syncthreads();
    for (int unit = c.bid; unit < T / 64; unit += c.G) {
        const int hh = c.tid >> 6, t = unit * 64 + (c.tid & 63), g = hh >> 2;
        RowState s; row_init(s, proj + (size_t)t * PLD + PC_SQ + hh * 64); row_reset(s);
        const int s0 = t - 127 > 0 ? t - 127 : 0;
        for (int sp = s0; sp <= t; ++sp) { const float bias = tb[t5_bucket(t - sp) * 16 + 8 + hh];
            row_key_bf16(s, proj + (size_t)sp * PLD + PC_SK + g * 64, proj + (size_t)sp * PLD + PC_SV + g * 64, bias); }
        const float sink = inptr(c, I_SINK)[layer * 8 + hh]; const float mf = fmaxf(s.m, sink); const float corr = __expf(s.m - mf);
        const float den = s.l * corr + __expf(sink - mf); const float inv = corr / den;
        bf16_t* op = oswa + (size_t)t * 512 + hh * 64;
#pragma unroll
        for (int i = 0; i < 8; ++i) { u32x4 w; w.x = pk2(s.o[i * 8] * inv, s.o[i * 8 + 1] * inv); w.y = pk2(s.o[i * 8 + 2] * inv, s.o[i * 8 + 3] * inv);
            w.z = pk2(s.o[i * 8 + 4] * inv, s.o[i * 8 + 5] * inv); w.w = pk2(s.o[i * 8 + 6] * inv, s.o[i * 8 + 7] * inv); *(u32x4*)(op + i * 8) = w; }
    }
}

constexpr int RL = 65;
__device__ __forceinline__ float rwkv_mixed(const bf16_t* proj, const float* mu, int t, int col) {
    const float cur = bf2f(proj[(size_t)t * PLD + col]); const float prev = t > 0 ? bf2f(proj[(size_t)(t - 1) * PLD + col]) : 0.f;
    return cur + (prev - cur) * mu[col];
}
__device__ __forceinline__ void lora64(const Ctx& c, const LAS float* in, const float* W, const float* bias, LAS float* out, bool accum) {
    const int j = c.tid & 63, tg = (c.tid >> 6) * 8;
    float acc[8];
#pragma unroll
    for (int i = 0; i < 8; ++i) acc[i] = accum ? out[(tg + i) * RL + j] : (bias ? bias[j] : 0.f);
#pragma unroll 4
    for (int m = 0; m < 64; ++m) { const float w = W[(size_t)m * 512 + j];
#pragma unroll
        for (int i = 0; i < 8; ++i) acc[i] += in[(tg + i) * RL + m] * w; }
#pragma unroll
    for (int i = 0; i < 8; ++i) out[(tg + i) * RL + j] = acc[i];
}
struct RwkvLds { LAS float *R, *K, *V, *A, *B, *W, *G, *TMP; };
__device__ __forceinline__ RwkvLds rwkv_lds(LAS unsigned char* lds) {
    RwkvLds s; LAS float* p = (LAS float*)lds; constexpr int SZ = 64 * RL;
    s.R = p; s.K = p + SZ; s.V = p + 2 * SZ; s.A = p + 3 * SZ; s.B = p + 4 * SZ; s.W = p + 5 * SZ; s.G = p + 6 * SZ; s.TMP = p + 7 * SZ; return s;
}
template <bool LOGDECAY>
__device__ __forceinline__ void rwkv_prep(const Ctx& c, const Args& a, int layer, const bf16_t* proj, int t0, int h, const RwkvLds& s) {
    const float* mu = inptr(c, I_MU) + (size_t)layer * 1792;
    const int j = c.tid & 63, tg = c.tid >> 6;
#pragma unroll 2
    for (int i = 0; i < 8; ++i) { const int tt = tg * 8 + i; s.TMP[tt * RL + j] = tanhf(rwkv_mixed(proj, mu, t0 + tt, PC_ZW + j)); }
    __syncthreads();
    lora64(c, s.TMP, inptr(c, I_W2) + (size_t)layer * 64 * 512 + h * 64, inptr(c, I_W0) + layer * 512 + h * 64, s.W, false);
    __syncthreads();
#pragma unroll 2
    for (int i = 0; i < 8; ++i) { const int tt = tg * 8 + i; s.TMP[tt * RL + j] = rwkv_mixed(proj, mu, t0 + tt, PC_ZA + j); }
    __syncthreads();
    lora64(c, s.TMP, inptr(c, I_A2) + (size_t)layer * 64 * 512 + h * 64, inptr(c, I_A0) + layer * 512 + h * 64, s.B, false);
    __syncthreads();
#pragma unroll 2
    for (int i = 0; i < 8; ++i) { const int tt = tg * 8 + i; s.TMP[tt * RL + j] = sigmoidf_(rwkv_mixed(proj, mu, t0 + tt, PC_ZG + j)); }
    __syncthreads();
    lora64(c, s.TMP, inptr(c, I_G2) + (size_t)layer * 128 * 512 + h * 64, nullptr, s.G, false);
    __syncthreads();
#pragma unroll 2
    for (int i = 0; i < 8; ++i) { const int tt = tg * 8 + i; s.TMP[tt * RL + j] = sigmoidf_(rwkv_mixed(proj, mu, t0 + tt, PC_ZG + 64 + j)); }
    __syncthreads();
    lora64(c, s.TMP, inptr(c, I_G2) + ((size_t)layer * 128 + 64) * 512 + h * 64, nullptr, s.G, true);
    const float kkw = inptr(c, I_KK)[layer * 512 + h * 64 + j], kaw = inptr(c, I_KA)[layer * 512 + h * 64 + j];
#pragma unroll 1
    for (int i = 0; i < 8; ++i) { const int tt = tg * 8 + i, t = t0 + tt;
        const float r = rwkv_mixed(proj, mu, t, PC_R + h * 64 + j), k = rwkv_mixed(proj, mu, t, PC_K + h * 64 + j), v = rwkv_mixed(proj, mu, t, PC_V + h * 64 + j);
        const float wl = s.W[tt * RL + j], al = sigmoidf_(s.B[tt * RL + j]);
        const float sp = (-wl > 20.f) ? -wl : log1pf(__expf(-wl)); const float w = -sp - 0.5f; const float ew = __expf(w);
        float kk = k * kkw; const float n2 = wave_sum(kk * kk); kk = kk / fmaxf(sqrtf(n2), 1e-12f);
        s.R[tt * RL + j] = r; s.V[tt * RL + j] = v; s.K[tt * RL + j] = k * (1.0f + (al - 1.0f) * kaw);
        s.A[tt * RL + j] = -kk; s.B[tt * RL + j] = kk * al; s.W[tt * RL + j] = LOGDECAY ? -ew : __expf(-ew); }
    __syncthreads();
}
__device__ __forceinline__ void rwkv_post(const Ctx& c, const Args& a, int layer, int t0, int h, const RwkvLds& s, const LAS float* Y, bf16_t* orwkv) {
    const int i = c.lane, tg = c.wave;
    const float lnw = inptr(c, I_LNW)[layer * 512 + h * 64 + i], lnb = inptr(c, I_LNB)[layer * 512 + h * 64 + i], rk = inptr(c, I_RK)[layer * 512 + h * 64 + i];
#pragma unroll 1
    for (int q = 0; q < 8; ++q) { const int tt = tg * 8 + q; const float y = Y[tt * RL + i];
        const float mean = wave_sum(y) * (1.0f / 64.0f); const float d = y - mean; const float var = wave_sum(d * d) * (1.0f / 64.0f);
        const float bonus = wave_sum(s.R[tt * RL + i] * s.K[tt * RL + i] * rk);
        const float o = (d * rsqrtf(var + 64e-5f) * lnw + lnb + bonus * s.V[tt * RL + i]) * s.G[tt * RL + i];
        orwkv[(size_t)(t0 + tt) * 512 + h * 64 + i] = (bf16_t)f2bf(o); }
}
__device__ __forceinline__ void phase_rwkv_naive(const Ctx& c, const Args& a, int layer, const bf16_t* proj, bf16_t* orwkv) {
    if (c.bid >= 8) return;
    const int h = c.bid; const RwkvLds s = rwkv_lds(c.lds);
    float S[64];
#pragma unroll
    for (int j = 0; j < 64; ++j) S[j] = 0.f;
    for (int ch = 0; ch < T / 64; ++ch) {
        rwkv_prep<false>(c, a, layer, proj, ch * 64, h, s);
        if (c.wave == 0) {
            const int i = c.lane;
            for (int tt = 0; tt < 64; ++tt) {
                float sa = 0.f;
#pragma unroll
                for (int j = 0; j < 64; ++j) { sa += S[j] * s.A[tt * RL + j]; if ((j & 7) == 7) __builtin_amdgcn_sched_barrier(0); }
                const float vi = s.V[tt * RL + i]; float y = 0.f;
#pragma unroll
                for (int j = 0; j < 64; ++j) { S[j] = S[j] * s.W[tt * RL + j] + sa * s.B[tt * RL + j] + vi * s.K[tt * RL + j]; y += S[j] * s.R[tt * RL + j]; if ((j & 3) == 3) __builtin_amdgcn_sched_barrier(0); }
                s.TMP[tt * RL + i] = y;
            }
        }
        __syncthreads();
        rwkv_post(c, a, layer, ch * 64, h, s, s.TMP, orwkv);
        __syncthreads();
    }
}


__device__ __forceinline__ int kperm32(int jl) { return 8 * ((jl >> 2) & 3) + 4 * (jl >> 4) + (jl & 3); }
__device__ __forceinline__ f32x4 tile_mma64(const LAS unsigned char* A, const LAS unsigned char* B, int a, int b, int lane, f32x4 acc) {
    const int m = lane & 15, q = lane >> 4;
#pragma unroll
    for (int ks = 0; ks < 2; ++ks) {
        const bf16x8 af = *(const LAS bf16x8*)(A + (16 * a + m) * 144 + (32 * ks + 8 * q) * 2);
        const bf16x8 bf = *(const LAS bf16x8*)(B + (16 * b + m) * 144 + (32 * ks + 8 * q) * 2);
        acc = __builtin_amdgcn_mfma_f32_16x16x32_bf16(af, bf, acc, 0, 0, 0);
    }
    return acc;
}
__device__ __forceinline__ void lds_st_bf16(LAS unsigned char* base, int idx, float v) { *(LAS bf16_t*)(base + idx * 2) = (bf16_t)f2bf(v); }

__device__ __forceinline__ void phase_lora_a(const Ctx& c, const Args& a, int layer, const bf16_t* proj, bf16_t* alora) {
    const float* mu = inptr(c, I_MU) + (size_t)layer * 1792;
    const int sub = c.tid & 31, rloc = c.tid >> 5;
    for (int t = c.bid * 16 + rloc; t < T; t += c.G * 16) {
        const int col = PC_ZW + sub * 8; float cur[8], prv[8];
        unpack8(*(const u32x4*)(proj + (size_t)t * PLD + col), cur);
        if (t > 0) unpack8(*(const u32x4*)(proj + (size_t)(t - 1) * PLD + col), prv); else {
#pragma unroll
            for (int k = 0; k < 8; ++k) prv[k] = 0.f; }
        float o[8];
#pragma unroll
        for (int k = 0; k < 8; ++k) { const float v = cur[k] + (prv[k] - cur[k]) * mu[col + k]; o[k] = sub < 8 ? tanhf(v) : (sub < 16 ? v : sigmoidf_(v)); }
        u32x4 w; w.x = pk2(o[0], o[1]); w.y = pk2(o[2], o[3]); w.z = pk2(o[4], o[5]); w.w = pk2(o[6], o[7]);
        *(u32x4*)(alora + (size_t)t * 256 + sub * 8) = w;
    }
}

constexpr int RC_L = 0, RC_AL = 16640, RC_AAK = 0, RC_ARB = 9216, RC_ARK = 18432, RC_AAB = 33280, RC_P2T = 33280, RC_WC = 50688, RC_BS = 50944, RC_M = 52992;
constexpr int RC_AT = RC_M, RC_TINV = RC_M, RC_ATT = RC_M + 9216, RC_RT = RC_M + 2 * 9216, RC_BT = RC_M + 3 * 9216, RC_XT = RC_BT, RC_KT = RC_M + 4 * 9216, RC_P1T = RC_KT,
              RC_VT = RC_M + 5 * 9216, RC_BHT = RC_M + 6 * 9216, RC_KHT = RC_M + 7 * 9216;
constexpr int RC_XOFF = RC_M + 8 * 9216, RC_XTMP = RC_XOFF + 6144;
static_assert(RC_XTMP + 3 * 1088 <= LDS_MISC, "rwkv chunk LDS");

__device__ __forceinline__ void phase_rwkv_chunk(const Ctx& c, const Args& a, int layer, const bf16_t* proj, const bf16_t* wlb, const bf16_t* alb, bf16_t* rwu, float* bonusg) {
    LAS unsigned char* L = c.lds;
    LAS float* sL = (LAS float*)(L + RC_L); LAS float* sAL = (LAS float*)(L + RC_AL); LAS float* sAAB = (LAS float*)(L + RC_AAB);
    LAS float* sWC = (LAS float*)(L + RC_WC); LAS float* sBS = (LAS float*)(L + RC_BS);
    const float* mu = inptr(c, I_MU) + (size_t)layer * 1792;
    const int lane = c.lane, wave = c.wave, n = lane & 15, q = lane >> 4;
    for (int unit = c.bid; unit < 2048; unit += c.G) {
        const int ch = unit >> 3, h = unit & 7, t0 = ch * 64, j = lane;
        {
            const float w0 = inptr(c, I_W0)[layer * 512 + h * 64 + j], a0 = inptr(c, I_A0)[layer * 512 + h * 64 + j];
            bf16_t wraw[8], araw[8];
#pragma unroll
            for (int i = 0; i < 8; ++i) { const size_t gi = (size_t)(t0 + wave * 8 + i) * 512 + h * 64 + j; wraw[i] = wlb[gi]; araw[i] = alb[gi]; }
            float run = 0.f;
#pragma unroll
            for (int i = 0; i < 8; ++i) { const int tt = wave * 8 + i;
                const float wl = w0 + bf2f(wraw[i]); const float nx = -wl; const float sp = nx > 20.f ? nx : log1pf(__expf(nx)); const float ld = -__expf(-sp - 0.5f);
                run += ld; sL[tt * RL + j] = run; sAL[tt * RL + j] = sigmoidf_(a0 + bf2f(araw[i])); }
            sBS[wave * 64 + j] = run;
        }
        bf16_t rraw[9], kraw[9], vraw[9];
        {
#pragma unroll
            for (int i = 0; i < 9; ++i) { const int t = t0 + wave * 8 + i - 1; const bool ok = t >= 0; const size_t ro = (size_t)(ok ? t : 0) * PLD + h * 64 + j;
                rraw[i] = ok ? proj[ro + PC_R] : (bf16_t)0; kraw[i] = ok ? proj[ro + PC_K] : (bf16_t)0; vraw[i] = ok ? proj[ro + PC_V] : (bf16_t)0; }
        }
        __syncthreads();
        {
            float off = 0.f, tot = 0.f;
#pragma unroll
            for (int w2 = 0; w2 < 8; ++w2) { const float v = sBS[w2 * 64 + j]; tot += v; off += (w2 < wave) ? v : 0.f; }
            if (wave == 0) sWC[j] = __expf(tot);
            const float kkw = inptr(c, I_KK)[layer * 512 + h * 64 + j], kaw = inptr(c, I_KA)[layer * 512 + h * 64 + j], rk = inptr(c, I_RK)[layer * 512 + h * 64 + j];
            const float mur = mu[PC_R + h * 64 + j], muk = mu[PC_K + h * 64 + j], muv = mu[PC_V + h * 64 + j];
            float Lprev = off;
#pragma unroll
            for (int i = 0; i < 8; ++i) { const int tt = wave * 8 + i, t = t0 + tt;
                const float Lc = sL[tt * RL + j] + off, al = sAL[tt * RL + j];
                const float rc = bf2f(rraw[i + 1]), kc = bf2f(kraw[i + 1]), vc = bf2f(vraw[i + 1]);
                const float r = rc + (bf2f(rraw[i]) - rc) * mur, k = kc + (bf2f(kraw[i]) - kc) * muk, v = vc + (bf2f(vraw[i]) - vc) * muv;
                float kk = k * kkw; const float n2 = wave_sum(kk * kk); kk = kk / fmaxf(sqrtf(n2), 1e-12f);
                const float kp = k * (1.0f + (al - 1.0f) * kaw), av = -kk, bv = kk * al;
                const float eW = __expf(Lc), eWex = __expf(Lprev), eInv = __expf(-Lc), eC = __expf(tot - Lc);
                lds_st_bf16(L + RC_AT, tt * 72 + j, av * eWex); lds_st_bf16(L + RC_ATT, j * 72 + tt, av * eWex);
                lds_st_bf16(L + RC_RT, tt * 72 + j, r * eW); lds_st_bf16(L + RC_BT, tt * 72 + j, bv * eInv); lds_st_bf16(L + RC_KT, tt * 72 + j, kp * eInv);
                lds_st_bf16(L + RC_VT, j * 72 + tt, v); lds_st_bf16(L + RC_BHT, j * 72 + tt, bv * eC); lds_st_bf16(L + RC_KHT, j * 72 + tt, kp * eC);
                const float bon = wave_sum(r * kp * rk); if (lane == 0) bonusg[(size_t)t * 8 + h] = bon;
                Lprev = Lc; }
        }
        __syncthreads();
        for (int job = wave; job < 64; job += 8) {
            const int p = job >> 4, ta = (job >> 2) & 3, tb = job & 3;
            f32x4 acc = (f32x4){0.f, 0.f, 0.f, 0.f};
            if (ta >= tb) acc = tile_mma64(L + (p < 2 ? RC_AT : RC_RT), L + ((p & 1) ? RC_KT : RC_BT), ta, tb, lane, acc);
            LAS unsigned char* dst = L + (p == 1 ? RC_AAK : (p == 2 ? RC_ARB : RC_ARK));
#pragma unroll
            for (int r = 0; r < 4; ++r) { const int tt = 16 * ta + 4 * q + r, ss = 16 * tb + n; const bool keep = (p < 2) ? (ss < tt) : (ss <= tt); const float v = keep ? acc[r] : 0.f;
                if (p == 0) sAAB[tt * 68 + ss] = v; else lds_st_bf16(dst, tt * 72 + ss, v); }
        }
        __syncthreads();
        if (wave == 0) {
            const int blk = lane >> 4, cc = lane & 15; const LAS float* Ab = sAAB + (16 * blk) * 68 + 16 * blk; float xr[16];
#pragma unroll
            for (int tt = 0; tt < 16; ++tt) { float acc = (tt == cc) ? 1.f : 0.f;
#pragma unroll
                for (int ss = 0; ss < tt; ++ss) acc += Ab[tt * 68 + ss] * xr[ss];
                xr[tt] = acc; }
            asm volatile("s_waitcnt lgkmcnt(0)" ::: "memory");
#pragma unroll
            for (int tt = 0; tt < 16; ++tt) sAAB[(16 * blk + tt) * 68 + 16 * blk + cc] = xr[tt];
        } else {
            for (int job = wave - 1; job < 16; job += 7) { const int ta = job >> 2, tb = job & 3;
                const f32x4 acc = tile_mma64(L + RC_VT, L + RC_AAK, ta, tb, lane, (f32x4){0.f, 0.f, 0.f, 0.f});
#pragma unroll
                for (int r = 0; r < 4; ++r) lds_st_bf16(L + RC_XT, (16 * ta + 4 * q + r) * 72 + 16 * tb + n, acc[r]); }
        }
        __syncthreads();
        {
            LAS float* sXO = (LAS float*)(L + RC_XOFF); LAS float* sT = (LAS float*)(L + RC_XTMP) + wave * 272;
            const int rr = lane >> 2, c4 = (lane & 3) * 4;
#pragma unroll 1
            for (int lev = 1; lev <= 3; ++lev) {
                if (wave < 4 - lev) {
                    const int J = wave, I = wave + lev;
                    f32x4 tacc = (f32x4){0.f, 0.f, 0.f, 0.f};
                    for (int K = J; K < I; ++K) {
                        const LAS float* Ap = sAAB + (16 * I + rr) * 68 + 16 * K; const LAS float* Xp;
                        int xs;
                        if (K == J) { Xp = sAAB + (16 * J) * 68 + 16 * J + c4; xs = 68; }
                        else { const int d = K - J; const int bi = (d == 1) ? J : 3 + J; Xp = sXO + bi * 256 + c4; xs = 16; }
#pragma unroll
                        for (int k = 0; k < 16; ++k) { const float av = Ap[k]; const f32x4 xv = *(const LAS f32x4*)(Xp + k * xs); tacc += xv * av; }
                    }
                    *(LAS f32x4*)(sT + rr * 16 + c4) = tacc;
                    asm volatile("s_waitcnt lgkmcnt(0)" ::: "memory");
                    f32x4 xacc = (f32x4){0.f, 0.f, 0.f, 0.f};
                    const LAS float* Dp = sAAB + (16 * I + rr) * 68 + 16 * I;
#pragma unroll
                    for (int k = 0; k < 16; ++k) { const float dv = Dp[k]; const f32x4 tv = *(const LAS f32x4*)(sT + k * 16 + c4); xacc += tv * dv; }
                    const int bo = (lev == 1) ? J : (lev == 2 ? 3 + J : 5);
                    *(LAS f32x4*)(sXO + bo * 256 + rr * 16 + c4) = xacc;
                }
                __syncthreads();
            }
            for (int e = c.tid; e < 4096; e += 512) { const int tt = e >> 6, ss = e & 63, I = tt >> 4, J = ss >> 4; float v = 0.f;
                if (I == J) v = sAAB[tt * 68 + ss];
                else if (I > J) { const int d = I - J; const int bi = (d == 1) ? J : (d == 2 ? 3 + J : 5); v = sXO[bi * 256 + (tt & 15) * 16 + (ss & 15)]; }
                lds_st_bf16(L + RC_TINV, tt * 72 + ss, v); }
        }
        __syncthreads();
        for (int job = wave; job < 32; job += 8) { const int p = job >> 4, ta = (job >> 2) & 3, tb = job & 3;
            const f32x4 acc = tile_mma64(L + (p ? RC_XT : RC_ATT), L + RC_TINV, ta, tb, lane, (f32x4){0.f, 0.f, 0.f, 0.f});
#pragma unroll
            for (int r = 0; r < 4; ++r) lds_st_bf16(L + (p ? RC_P2T : RC_P1T), (16 * ta + 4 * q + r) * 72 + 16 * tb + n, acc[r]); }
        __syncthreads();
        bf16_t* ug = rwu + (size_t)unit * 16384;
        for (int job = wave; job < 64; job += 8) { const int p = job >> 4, ta = (job >> 2) & 3, tb = job & 3;
            f32x4 acc = (f32x4){0.f, 0.f, 0.f, 0.f};
            if (p == 0) { acc = tile_mma64(L + RC_ARB, L + RC_P1T, ta, tb, lane, acc);
#pragma unroll
                for (int r = 0; r < 4; ++r) { const int tt = 16 * ta + 4 * q + r, jj = 16 * tb + n; const float v = acc[r] + bf2f(*(const LAS bf16_t*)(L + RC_RT + (tt * 72 + jj) * 2));
                    ug[8192 + tt * 64 + (jj & 32) + kperm32(jj & 31)] = (bf16_t)f2bf(v); } }
            else if (p == 1) { acc = tile_mma64(L + RC_ARB, L + RC_P2T, ta, tb, lane, acc); acc = tile_mma64(L + RC_ARK, L + RC_VT, ta, tb, lane, acc);
                u32x2 w; w.x = pk2(acc[0], acc[1]); w.y = pk2(acc[2], acc[3]); *(u32x2*)(ug + 12288 + ((tb * 4 + ta) * 64 + lane) * 4) = w; }
            else if (p == 2) { acc = tile_mma64(L + RC_BHT, L + RC_P1T, ta, tb, lane, acc);
#pragma unroll
                for (int r = 0; r < 4; ++r) { const int jr = 16 * ta + 4 * q + r, jc = 16 * tb + n; const float v = acc[r] + (jr == jc ? sWC[jr] : 0.f);
                    ug[jr * 64 + (jc & 32) + kperm32(jc & 31)] = (bf16_t)f2bf(v); } }
            else { acc = tile_mma64(L + RC_BHT, L + RC_P2T, ta, tb, lane, acc); acc = tile_mma64(L + RC_KHT, L + RC_VT, ta, tb, lane, acc);
                u32x2 w; w.x = pk2(acc[0], acc[1]); w.y = pk2(acc[2], acc[3]); *(u32x2*)(ug + 4096 + ((tb * 4 + ta) * 64 + lane) * 4) = w; }
        }
        __syncthreads();
    }
}

#define RW_LOAD_SET(SET, UNIT) do { const bf16_t* ug_ = rwu + (size_t)(UNIT) * 16384; \
    _Pragma("unroll") for (int ta = 0; ta < 4; ++ta) { An[SET][ta][0] = *(const bf16x8*)(ug_ + (16 * ta + m) * 64 + 8 * q); An[SET][ta][1] = *(const bf16x8*)(ug_ + (16 * ta + m) * 64 + 32 + 8 * q); \
        Zn[SET][ta] = *(const u32x2*)(ug_ + 4096 + ((cq * 4 + ta) * 64 + lane) * 4); } } while (0)
template <int SM>
__device__ __forceinline__ void phase_rwkv_scan(const Ctx& c, const bf16_t* rwu, bf16_t* rws) {
    const int idx = c.bid; if (idx >= 32 || c.wave != 0) return;
    const int h = idx >> 2, cq = idx & 3, lane = c.lane, m = lane & 15, q = lane >> 4;
    bf16x8 Bhi[2], Blo[2];
#pragma unroll
    for (int s = 0; s < 2; ++s) { Bhi[s] = (bf16x8){0, 0, 0, 0, 0, 0, 0, 0}; Blo[s] = Bhi[s]; }
    bf16x8 An[2][4][2]; u32x2 Zn[2][4];
#pragma unroll
    for (int u = 0; u < 2; ++u) RW_LOAD_SET(u, u * 8 + h);
    if (SM == 1) {
        for (int ch = 0; ch < T / 64; ch += 8) {
#pragma unroll
            for (int uu = 0; uu < 8; ++uu) { const int u = uu & 3; const int unit = (ch + uu) * 8 + h;
                bf16_t* sg = rws + (size_t)unit * 4096 + cq * 1024 + lane * 8;
                *(bf16x8*)(sg) = Bhi[0]; *(bf16x8*)(sg + 512) = Bhi[1];
#pragma unroll
                for (int ta = 0; ta < 4; ++ta) { Bhi[0] = Bhi[0] ^ An[u][ta][0]; Bhi[1] = Bhi[1] ^ An[u][ta][1]; Bhi[0][0] ^= (short)Zn[u][ta].x; }
                RW_LOAD_SET(u, (ch + uu + 4 < T / 64) ? unit + 32 : unit); } }
        return;
    }
    for (int ch = 0; ch < T / 64; ch += 8) {
#pragma unroll
        for (int uu = 0; uu < 8; ++uu) {
            const int u = uu & 1;
            const int unit = (ch + uu) * 8 + h;
            bf16_t* sg = rws + (size_t)unit * 4096 + cq * 1024 + lane * 8;
            *(bf16x8*)(sg) = Bhi[0]; *(bf16x8*)(sg + 512) = Bhi[1];
            f32x4 acc[4];
#pragma unroll
            for (int ta = 0; ta < 4; ++ta) { const u32x2 z = Zn[u][ta];
                acc[ta] = (f32x4){__uint_as_float(z.x << 16), __uint_as_float(z.x & 0xffff0000u), __uint_as_float(z.y << 16), __uint_as_float(z.y & 0xffff0000u)};
#pragma unroll
                for (int s = 0; s < 2; ++s) { acc[ta] = __builtin_amdgcn_mfma_f32_16x16x32_bf16(An[u][ta][s], Bhi[s], acc[ta], 0, 0, 0); acc[ta] = __builtin_amdgcn_mfma_f32_16x16x32_bf16(An[u][ta][s], Blo[s], acc[ta], 0, 0, 0); } }
            if (SM == 0) RW_LOAD_SET(u, (ch + uu + 2 < T / 64) ? unit + 16 : unit);
#pragma unroll
            for (int s = 0; s < 2; ++s) { u32x4 hi, lo; float rem[8];
#pragma unroll
                for (int p = 0; p < 8; ++p) { const float v = acc[2 * s + (p >> 2)][p & 3]; const unsigned hb = f2bf(v); rem[p] = v - __uint_as_float(hb << 16); }
                hi.x = pk2(acc[2 * s][0], acc[2 * s][1]); hi.y = pk2(acc[2 * s][2], acc[2 * s][3]); hi.z = pk2(acc[2 * s + 1][0], acc[2 * s + 1][1]); hi.w = pk2(acc[2 * s + 1][2], acc[2 * s + 1][3]);
                lo.x = pk2(rem[0], rem[1]); lo.y = pk2(rem[2], rem[3]); lo.z = pk2(rem[4], rem[5]); lo.w = pk2(rem[6], rem[7]);
                Bhi[s] = __builtin_bit_cast(bf16x8, hi); Blo[s] = __builtin_bit_cast(bf16x8, lo); }
        }
    }
}
#undef RW_LOAD_SET

__device__ __forceinline__ void phase_rwkv_out(const Ctx& c, const Args& a, int layer, const bf16_t* proj, const bf16_t* rwu, const bf16_t* rws, const float* bonusg, bf16_t* orwkv) {
    const float* mu = inptr(c, I_MU) + (size_t)layer * 1792;
    const int lane = c.lane, m = lane & 15, q = lane >> 4;
    for (int unit = c.bid * 8 + c.wave; unit < 2048; unit += c.G * 8) {
        const int ch = unit >> 3, h = unit & 7, t0 = ch * 64; const bf16_t* ug = rwu + (size_t)unit * 16384; const bf16_t* sg = rws + (size_t)unit * 4096;
        bf16x8 Bf[4][2];
#pragma unroll
        for (int cq = 0; cq < 4; ++cq) { Bf[cq][0] = *(const bf16x8*)(sg + cq * 1024 + lane * 8); Bf[cq][1] = *(const bf16x8*)(sg + cq * 1024 + 512 + lane * 8); }
        float lnw[4], lnb[4];
#pragma unroll
        for (int cq = 0; cq < 4; ++cq) { lnw[cq] = inptr(c, I_LNW)[layer * 512 + h * 64 + 16 * cq + m]; lnb[cq] = inptr(c, I_LNB)[layer * 512 + h * 64 + 16 * cq + m]; }
#pragma unroll 1
        for (int ta = 0; ta < 4; ++ta) {
            const bf16x8 A0 = *(const bf16x8*)(ug + 8192 + (16 * ta + m) * 64 + 8 * q), A1 = *(const bf16x8*)(ug + 8192 + (16 * ta + m) * 64 + 32 + 8 * q);
            f32x4 y[4];
#pragma unroll
            for (int cq = 0; cq < 4; ++cq) { const u32x2 z = *(const u32x2*)(ug + 12288 + ((cq * 4 + ta) * 64 + lane) * 4);
                y[cq] = (f32x4){__uint_as_float(z.x << 16), __uint_as_float(z.x & 0xffff0000u), __uint_as_float(z.y << 16), __uint_as_float(z.y & 0xffff0000u)};
                y[cq] = __builtin_amdgcn_mfma_f32_16x16x32_bf16(A0, Bf[cq][0], y[cq], 0, 0, 0); y[cq] = __builtin_amdgcn_mfma_f32_16x16x32_bf16(A1, Bf[cq][1], y[cq], 0, 0, 0); }
#pragma unroll
            for (int r = 0; r < 4; ++r) { const int t = t0 + 16 * ta + 4 * q + r;
                float sm = y[0][r] + y[1][r] + y[2][r] + y[3][r];
                sm += __shfl_xor(sm, 1); sm += __shfl_xor(sm, 2); sm += __shfl_xor(sm, 4); sm += __shfl_xor(sm, 8);
                const float mean = sm * (1.0f / 64.0f); float d[4], vs = 0.f;
#pragma unroll
                for (int cq = 0; cq < 4; ++cq) { d[cq] = y[cq][r] - mean; vs += d[cq] * d[cq]; }
                vs += __shfl_xor(vs, 1); vs += __shfl_xor(vs, 2); vs += __shfl_xor(vs, 4); vs += __shfl_xor(vs, 8);
                const float rstd = rsqrtf(vs * (1.0f / 64.0f) + 64e-5f); const float bon = bonusg[(size_t)t * 8 + h];
#pragma unroll
                for (int cq = 0; cq < 4; ++cq) { const int col = h * 64 + 16 * cq + m; const float v = rwkv_mixed(proj, mu, t, PC_V + col);
                    bf16_t* op = orwkv + (size_t)t * 512 + col; const float g = bf2f(*op);
                    *op = (bf16_t)f2bf((d[cq] * rstd * lnw[cq] + lnb[cq] + bon * v) * g); } }
        }
    }
}


constexpr int AT_K = 0, AT_V = 9216, AT_SCORE = 18432  , AT_BIAS = 83968, AT_SELM = 100352, AT_LIST = 104448, AT_NLIST = 105472, AT_NEED = 105504;
__device__ __forceinline__ void vt_transpose(const Ctx& c, const bf16_t* proj, bf16_t* vt) {
    LAS bf16_t* tl = (LAS bf16_t*)c.lds;
    for (int it = c.bid; it < 3 * 2 * 256; it += c.G) {
        const int which = it / 512, g = (it >> 8) & 1, tt = it & 255;
        const int col = (which == 0 ? PC_VS : (which == 1 ? PC_VW : PC_SV)) + g * 64;
        { const int tok = c.tid >> 3, ch = c.tid & 7; const u32x4 w = *(const u32x4*)(proj + (size_t)(tt * 64 + tok) * PLD + col + ch * 8);
          *(LAS u32x4*)(tl + tok * 72 + ch * 8) = w; }
        __syncthreads();
        { const int d = c.tid >> 3, ch = c.tid & 7; unsigned short e[8];
#pragma unroll
          for (int k = 0; k < 8; ++k) e[k] = tl[(ch * 8 + k) * 72 + d];
          u32x4 w; w.x = e[0] | ((unsigned)e[1] << 16); w.y = e[2] | ((unsigned)e[3] << 16); w.z = e[4] | ((unsigned)e[5] << 16); w.w = e[6] | ((unsigned)e[7] << 16);
          *(u32x4*)(vt + ((size_t)(which * 2 + g) * 64 + d) * T + tt * 64 + ch * 8) = w; }
        __syncthreads();
    }
}

template <int MODE, int NQ>
__device__ __forceinline__ void phase_attn(const Ctx& c, const Args& a, int layer, const bf16_t* proj, const bf16_t* vtb, const bf16_t* kcb, const bf16_t* vctb,
                                           unsigned* sel, float* nsaacc, bf16_t* oout) {
    LAS unsigned char* L = c.lds;
    LAS float* sscore = (LAS float*)(L + AT_SCORE);
    LAS float* biasd = (LAS float*)(L + AT_BIAS);
    LAS unsigned* selm = (LAS unsigned*)(L + AT_SELM);
    LAS int* list = (LAS int*)(L + AT_LIST);
    LAS int* nlist = (LAS int*)(L + AT_NLIST);
    LAS unsigned* need = (LAS unsigned*)(L + AT_NEED);
    const int lane = c.lane, wave = c.wave, n = lane & 15, q = lane >> 4, hr = n & 3;
    constexpr int TW = 4 * NQ, TB = 8 * TW, NU = T / TB, TS = (MODE == 3) ? 4 : 1;
    for (int unit = c.bid; unit < 2 * NU; unit += c.G) {
        const int g = unit / NU, t0 = ((g == 0) ? (unit % NU) : (NU - 1 - unit % NU)) * TB, tw0 = t0 + wave * TW;
        __syncthreads();
        for (int e = c.tid; e < 4096; e += 512) { const int r = e >> 10, d = e & 1023; biasd[e] = inptr(c, I_REL)[t5_bucket(d) * 16 + (MODE == 0 ? 8 : 0) + g * 4 + r]; }
        if (MODE == 3) {
            if (c.tid < 8) need[c.tid] = 0u;
            __syncthreads();
            { const int tok = c.tid >> 3, w8 = c.tid & 7; const unsigned mw = sel[((size_t)(t0 + tok) * 2 + g) * 8 + w8]; selm[tok * 8 + w8] = mw; atomicOr((unsigned*)&need[w8], mw); }
            __syncthreads();
            if (c.tid < 256) { const int j = c.tid; const unsigned wd = need[j >> 5];
                if ((wd >> (j & 31)) & 1u) { int pos = __popc(wd & ((1u << (j & 31)) - 1u)); for (int w2 = 0; w2 < (j >> 5); ++w2) pos += __popc(need[w2]); list[pos] = j; } }
            if (c.tid == 0) { int cnt = 0; for (int w2 = 0; w2 < 8; ++w2) cnt += __popc(need[w2]); nlist[0] = cnt; }
        }
        __syncthreads();
        int ntiles, tile_lo = 0;
        if (MODE == 0) { ntiles = 2 + TB / 64; tile_lo = t0 - 128; }
        else if (MODE == 1) { ntiles = 8 + TB / 64; tile_lo = t0 - 512; }
        else if (MODE == 2) { const int cmax = (t0 + TB - 1 - 31) >> 4; ntiles = cmax < 0 ? 0 : (cmax >> 6) + 1; }
        else ntiles = nlist[0];
        const bf16_t* Ksrc; size_t kstride; const bf16_t* Vsrc; size_t vstride; int qcol;
        if (MODE == 0) { Ksrc = proj + PC_SK + g * 64; kstride = PLD; Vsrc = vtb + (size_t)(4 + g) * 64 * T; vstride = T; qcol = PC_SQ + g * 256; }
        else if (MODE == 1) { Ksrc = proj + PC_KW + g * 64; kstride = PLD; Vsrc = vtb + (size_t)(2 + g) * 64 * T; vstride = T; qcol = PC_NQ + g * 256; }
        else if (MODE == 2) { Ksrc = kcb + (size_t)g * 1024 * 64; kstride = 64; Vsrc = vctb + (size_t)g * 64 * 1024; vstride = 1024; qcol = PC_NQ + g * 256; }
        else { Ksrc = proj + PC_KS + g * 64; kstride = PLD; Vsrc = vtb + (size_t)(0 + g) * 64 * T; vstride = T; qcol = PC_NQ + g * 256; }
        bf16x8 Bq[NQ][2];
#pragma unroll
        for (int qd = 0; qd < NQ; ++qd) { const bf16_t* qp = proj + (size_t)(tw0 + 4 * qd + (n >> 2)) * PLD + qcol + hr * 64 + 8 * q;
            Bq[qd][0] = *(const bf16x8*)qp; Bq[qd][1] = *(const bf16x8*)(qp + 32); }
        const float bfar = biasd[hr * 1024 + 1023];
        float mrun[NQ], lrun[NQ]; f32x4 O[NQ][4];
#pragma unroll
        for (int qd = 0; qd < NQ; ++qd) { mrun[qd] = -1e30f; lrun[qd] = 0.f;
#pragma unroll
            for (int dt = 0; dt < 4; ++dt) O[qd][dt] = (f32x4){0.f, 0.f, 0.f, 0.f}; }
        float carry3[NQ]; for (int i = 0; i < NQ; ++i) carry3[i] = 0.f;
        const int npass = (MODE == 2) ? 2 : 1;
        for (int pass = 0; pass < npass; ++pass) {
            const bool do_pv = (MODE != 2) || pass == 1;
            float linv[NQ];
            if (MODE == 2 && pass == 1) {
#pragma unroll
                for (int qd = 0; qd < NQ; ++qd) { float mt = mrun[qd]; mt = fmaxf(mt, __shfl_xor(mt, 16)); mt = fmaxf(mt, __shfl_xor(mt, 32));
                    float lt = lrun[qd] * __expf(mrun[qd] - mt); lt += __shfl_xor(lt, 16); lt += __shfl_xor(lt, 32); mrun[qd] = mt; linv[qd] = lt > 0.f ? 1.0f / lt : 0.f; }
            }
#define AT_TILEPOS(ti) ((MODE == 3) ? list[ti] * 64 : (MODE == 2 ? (ti) * 64 : tile_lo + (ti) * 64))
#define AT_ISSUE(rd) do { _Pragma("unroll") for (int i_ = 0; i_ < TS; ++i_) { const int ti_ = (rd) * TS + i_; p0n[i_] = ti_ < ntiles ? AT_TILEPOS(ti_) : -1; \
        if (p0n[i_] >= 0) { kreg[i_] = *(const u32x4*)(Ksrc + (size_t)(p0n[i_] + (c.tid >> 3)) * kstride + (c.tid & 7) * 8); \
            if (do_pv) vreg[i_] = *(const u32x4*)(Vsrc + (size_t)(c.tid >> 3) * vstride + p0n[i_] + (c.tid & 7) * 8); } } } while (0)
            u32x4 kreg[TS], vreg[TS]; int p0n[TS];
            const int nrounds = (ntiles + TS - 1) / TS;
            if (nrounds > 0) AT_ISSUE(0);
            for (int rd = 0; rd < nrounds; ++rd) {
                int p0s[TS];
#pragma unroll
                for (int i = 0; i < TS; ++i) p0s[i] = p0n[i];
                __syncthreads();
#pragma unroll
                for (int i = 0; i < TS; ++i) if (p0s[i] >= 0) { *(LAS u32x4*)(L + AT_K + i * 18432 + (c.tid >> 3) * 144 + (c.tid & 7) * 16) = kreg[i];
                    if (do_pv) *(LAS u32x4*)(L + AT_V + i * 18432 + (c.tid >> 3) * 144 + (c.tid & 7) * 16) = vreg[i]; }
                if (rd + 1 < nrounds) AT_ISSUE(rd + 1);
                __syncthreads();
#pragma unroll
              for (int ts = 0; ts < TS; ++ts) {
                const int p0 = p0s[ts]; const int LK = AT_K + ts * 18432, LV = AT_V + ts * 18432;
                if (p0 < 0) continue;
                if (MODE == 0) { if (p0 > tw0 + TW - 1 || p0 + 63 < tw0 - 127) continue; }
                if (MODE == 1) { if (p0 > tw0 + TW - 1 || p0 + 63 < tw0 - 511) continue; }
                if (MODE == 2) { if (16 * p0 + 31 > tw0 + TW - 1) continue; }
                if (MODE == 3) { if (p0 > tw0 + TW - 1) continue; }
                const bool far = (MODE == 2) ? (tw0 - (16 * (p0 + 63) + 31) >= 790) : ((MODE == 3) ? (tw0 - (p0 + 63) >= 790) : false);
                const int jblk = p0 >> 6;
#pragma unroll
                for (int qd = 0; qd < NQ; ++qd) {
                    const int tq = tw0 + 4 * qd + (n >> 2);
                    bool colsel = true;
                    if (MODE == 3) { colsel = (selm[(wave * TW + 4 * qd + (n >> 2)) * 8 + (jblk >> 5)] >> (jblk & 31)) & 1u; if (__ballot(colsel) == 0ull) continue; }
                    {
                        f32x4 sc[4];
#pragma unroll
                        for (int kt = 0; kt < 4; ++kt) { sc[kt] = (f32x4){0.f, 0.f, 0.f, 0.f};
#pragma unroll
                            for (int ks = 0; ks < 2; ++ks) { const bf16x8 ak = *(const LAS bf16x8*)(L + LK + (16 * kt + n) * 144 + (32 * ks + 8 * q) * 2);
                                sc[kt] = __builtin_amdgcn_mfma_f32_16x16x32_bf16(ak, Bq[qd][ks], sc[kt], 0, 0, 0); } }
                        float mx = -1e30f;
                        if (far) {
#pragma unroll
                            for (int kt = 0; kt < 4; ++kt)
#pragma unroll
                                for (int r = 0; r < 4; ++r) { const float s2 = (MODE == 3 && !colsel) ? -1e30f : sc[kt][r] + bfar; sc[kt][r] = s2; mx = fmaxf(mx, s2); }
                        } else {
#pragma unroll
                        for (int kt = 0; kt < 4; ++kt)
#pragma unroll
                            for (int r = 0; r < 4; ++r) { const int kl = 16 * kt + 4 * q + r; int dist; bool v;
                                if (MODE == 2) { dist = tq - (16 * (p0 + kl) + 31); v = dist >= 0; }
                                else { dist = tq - (p0 + kl); v = dist >= 0; if (MODE == 0) v = v && dist < 128; if (MODE == 1) v = v && dist < 512; if (MODE == 3) v = v && colsel; }
                                const int di = dist < 0 ? 0 : (dist > 1023 ? 1023 : dist);
                                const float s2 = v ? sc[kt][r] + biasd[hr * 1024 + di] : -1e30f; sc[kt][r] = s2; mx = fmaxf(mx, s2); }
                        }
                        float p[4][4];
                        if (MODE == 2 && pass == 1) {
#pragma unroll
                            for (int kt = 0; kt < 4; ++kt)
#pragma unroll
                                for (int r = 0; r < 4; ++r) p[kt][r] = __expf(sc[kt][r] - mrun[qd]) * linv[qd];
                        } else if (MODE == 2) {
                            const float mn = fmaxf(mrun[qd], mx), corr = __expf(mrun[qd] - mn); mrun[qd] = mn; float ps = 0.f;
                            const float mne = mn < -1e29f ? 0.f : mn;
#pragma unroll
                            for (int kt = 0; kt < 4; ++kt)
#pragma unroll
                                for (int r = 0; r < 4; ++r) ps += __expf(sc[kt][r] - mne);
                            lrun[qd] = lrun[qd] * corr + ps;
                        } else {
                            if (__any(mx > mrun[qd])) {
                                mx = fmaxf(mx, __shfl_xor(mx, 16)); mx = fmaxf(mx, __shfl_xor(mx, 32));
                                const float mn = fmaxf(mrun[qd], mx), corr = __expf(mrun[qd] - mn); mrun[qd] = mn;
                                lrun[qd] *= corr;
#pragma unroll
                                for (int dt = 0; dt < 4; ++dt) O[qd][dt] = O[qd][dt] * corr;
                            }
                            const float mne = mrun[qd] < -1e29f ? 0.f : mrun[qd]; float ps = 0.f;
#pragma unroll
                            for (int kt = 0; kt < 4; ++kt)
#pragma unroll
                                for (int r = 0; r < 4; ++r) { p[kt][r] = __expf(sc[kt][r] - mne); ps += p[kt][r]; }
                            lrun[qd] += ps;
                        }
                        if (MODE == 2 && pass == 1) {
                            float i3prev = carry3[qd];
#pragma unroll
                            for (int kt = 0; kt < 4; ++kt) { float im[4];
#pragma unroll
                                for (int r = 0; r < 4; ++r) { float v = p[kt][r]; v += dpp_xor1(v); v += dpp_xor2(v); im[r] = v; }
                                const float same = __shfl(im[3], (lane + 48) & 63), prevt = __shfl(i3prev, (lane + 48) & 63);
                                const float pv3 = q > 0 ? same : prevt;
                                const int jg = (p0 + 16 * kt + 4 * q) >> 2;
                                if (hr == 0 && jg < 256) sscore[(tq - t0) * 256 + jg] = 2.0f * (im[0] + im[1] + im[2]) + im[3] + pv3;
                                i3prev = im[3]; }
                            carry3[qd] = i3prev;
                        }
                        if (do_pv) {
#pragma unroll
                            for (int st = 0; st < 2; ++st) {
                                u32x4 pw; pw.x = pk2(p[2 * st][0], p[2 * st][1]); pw.y = pk2(p[2 * st][2], p[2 * st][3]); pw.z = pk2(p[2 * st + 1][0], p[2 * st + 1][1]); pw.w = pk2(p[2 * st + 1][2], p[2 * st + 1][3]);
                                const bf16x8 pf = __builtin_bit_cast(bf16x8, pw);
#pragma unroll
                                for (int dt = 0; dt < 4; ++dt) { const LAS unsigned char* vp = L + LV + (16 * dt + n) * 144 + (32 * st + 4 * q) * 2;
                                    const u32x2 v0 = *(const LAS u32x2*)vp, v1 = *(const LAS u32x2*)(vp + 32); u32x4 vw; vw.x = v0.x; vw.y = v0.y; vw.z = v1.x; vw.w = v1.y;
                                    O[qd][dt] = __builtin_amdgcn_mfma_f32_16x16x32_bf16(__builtin_bit_cast(bf16x8, vw), pf, O[qd][dt], 0, 0, 0); } }
                        }
                        __builtin_amdgcn_sched_barrier(0);
                    }
                }
              }
            }
        }
#undef AT_ISSUE
#undef AT_TILEPOS
        if (MODE == 2) {
            __syncthreads();
#pragma unroll 1
            for (int tk = 0; tk < TW; ++tk) { const int t = tw0 + tk, cur = t >> 6; const LAS float* sp = sscore + (wave * TW + tk) * 256;
                unsigned key[4]; bool forced[4];
#pragma unroll
                for (int jj = 0; jj < 4; ++jj) { const int j = lane + 64 * jj; forced[jj] = (j == 0 || j == cur || j == cur - 1);
                    key[jj] = (!forced[jj] && j < cur - 1) ? __float_as_uint(sp[j]) + 1u : 0u; }
                const int nforced = cur >= 2 ? 3 : cur + 1;
                unsigned prefix = 0u; int remaining = 16 - nforced;
#pragma unroll 1
                for (int bit = 30; bit >= 0; --bit) { const unsigned test = prefix | (1u << bit); int cnt = 0;
#pragma unroll
                    for (int jj = 0; jj < 4; ++jj) cnt += __popcll(__ballot((key[jj] >> bit) == (test >> bit)));
                    if (cnt >= remaining) prefix = test; else remaining -= cnt; }
                int eqbase = 0;
#pragma unroll
                for (int jj = 0; jj < 4; ++jj) { const bool eq = key[jj] == prefix && key[jj] != 0u; const unsigned long long eb = __ballot(eq);
                    const int eqrank = eqbase + __popcll(eb & ((1ull << lane) - 1ull)); eqbase += __popcll(eb);
                    const bool on = forced[jj] || key[jj] > prefix || (eq && eqrank < remaining); const unsigned long long bl = __ballot(on);
                    if (lane == 0) { sel[((size_t)t * 2 + g) * 8 + 2 * jj] = (unsigned)bl; sel[((size_t)t * 2 + g) * 8 + 2 * jj + 1] = (unsigned)(bl >> 32); } }
            }
        }
#pragma unroll
        for (int qd = 0; qd < NQ; ++qd) {
            const int tq = tw0 + 4 * qd + (n >> 2), hh = g * 4 + hr;
            float scale;
            if (MODE == 2) scale = 1.0f;
            else { float lt = lrun[qd]; lt += __shfl_xor(lt, 16); lt += __shfl_xor(lt, 32);
                if (MODE == 0) { const float sink = inptr(c, I_SINK)[layer * 8 + hh]; const float mf = fmaxf(mrun[qd], sink), cr = __expf(mrun[qd] - mf); scale = cr / (lt * cr + __expf(sink - mf)); }
                else scale = lt > 0.f ? 1.0f / lt : 0.f; }
            if (MODE != 0) scale *= sigmoidf_(bf2f(proj[(size_t)tq * PLD + PC_GL + (MODE == 2 ? 0 : (MODE == 3 ? 8 : 16)) + hh]));
#pragma unroll
            for (int dt = 0; dt < 4; ++dt) { const f32x4 o = O[qd][dt] * scale; const int col = hh * 64 + 16 * dt + 4 * q;
                if (MODE == 0) { u32x2 w; w.x = pk2(o[0], o[1]); w.y = pk2(o[2], o[3]); *(u32x2*)(oout + (size_t)tq * 512 + col) = w; }
                else if (MODE == 2) *(f32x4*)(nsaacc + (size_t)tq * 512 + col) = o;
                else if (MODE == 1) { f32x4* ap = (f32x4*)(nsaacc + (size_t)tq * 512 + col); *ap = *ap + o; }
                else { const f32x4 t2 = *(const f32x4*)(nsaacc + (size_t)tq * 512 + col) + o; u32x2 w; w.x = pk2(t2[0], t2[1]); w.y = pk2(t2[2], t2[3]); *(u32x2*)(oout + (size_t)tq * 512 + col) = w; } }
        }
    }
}
__device__ __forceinline__ void phase_topk2(const Ctx& c, const float* scores, int* sel) {
    const int gw = c.bid * 8 + c.wave, NGW = c.G * 8;
    for (int item = gw; item < T * 2; item += NGW) {
        const int t = item >> 1, g = item & 1, cur = t >> 6;
        const float* sp = scores + ((size_t)g * T + t) * 256;
        float val[4];
#pragma unroll
        for (int jj = 0; jj < 4; ++jj) { const int j = c.lane + 64 * jj; float sc;
            if (j == 0 || j == cur || j == cur - 1) sc = 1e4f; else if (j > cur) sc = -1.0f; else sc = sp[j];
            val[jj] = sc; }
        for (int k = 0; k < 16; ++k) {
            float bv = val[0]; int bi = c.lane;
#pragma unroll
            for (int jj = 1; jj < 4; ++jj) if (val[jj] > bv) { bv = val[jj]; bi = c.lane + 64 * jj; }
#pragma unroll
            for (int o = 32; o >= 1; o >>= 1) { const float ov = __shfl_xor(bv, o); const int oi = __shfl_xor(bi, o); if (ov > bv || (ov == bv && oi < bi)) { bv = ov; bi = oi; } }
#pragma unroll
            for (int jj = 0; jj < 4; ++jj) if (bi == c.lane + 64 * jj) val[jj] = -3e38f;
            if (c.lane == 0) sel[(size_t)item * 16 + k] = bi;
        }
    }
}

#define wb ((bf16_t*)(ws + WS_WB))
#define xb ((bf16_t*)(ws + WS_XB))
#define rs ((float*)(ws + WS_RS))
#define kcb ((bf16_t*)(ws + WS_KCB))
#define vctb ((bf16_t*)(ws + WS_VCT))
#define vtb ((bf16_t*)(ws + WS_VT))
#define scores ((float*)(ws + WS_SCORES))
#define sel ((unsigned*)(ws + WS_SEL))
#define ml ((float*)(ws + WS_ML))
#define hidb ((bf16_t*)(ws + WS_HID))
#define proj ((bf16_t*)(ws + WS_PROJ))
#define gates ((bf16_t*)(ws + WS_GATES))
#define merged ((bf16_t*)(ws + WS_MERGED))
#define tmpb ((bf16_t*)(ws + WS_TMPB))
#define alora ((bf16_t*)(ws + WS_ALORA))
#define rwu ((bf16_t*)(ws + WS_RWU))
#define rws ((bf16_t*)(ws + WS_RWS))
#define bonusg ((float*)(ws + WS_BONUS))
#define nsaacc ((float*)(ws + WS_NSAACC))
#define obuf ((bf16_t*)(ws + WS_O))
#define act ((bf16_t*)(ws + WS_ACT))
#define tmpf ((bf16_t*)(ws + WS_TMPF))
constexpr int PH_PER_BATCH = 9, PH_PER_LAYER = 1 + 2 * PH_PER_BATCH + 3, PH_TOTAL = 1 + DEPTH * PH_PER_LAYER;

__global__ void __launch_bounds__(512, 2) fwd_kernel(Args args) {
    extern __shared__ __attribute__((aligned(16))) unsigned char lds_raw[];
    Ctx c0; c0.lds = (LAS unsigned char*)lds_raw; c0.tid = threadIdx.x; c0.lane = c0.tid & 63; c0.wave = __builtin_amdgcn_readfirstlane(c0.tid >> 6); c0.G = gridDim.x; c0.bid = blockIdx.x; const Ctx& c = c0;
    unsigned char* ws = args.ws;
    volatile LAS unsigned* misc = (volatile LAS unsigned*)(c.lds + LDS_MISC);
    if (c.tid < 4) misc[c.tid] = 0u;
    if (c.tid < 30) { const unsigned long long pv = (unsigned long long)args.in[c.tid & 31]; misc[16 + 2 * c.tid] = (unsigned)pv; misc[17 + 2 * c.tid] = (unsigned)(pv >> 32); }
    __syncthreads();
    XcdBarrier bar; bar.bar = (unsigned*)(ws + WS_CTL); bar.x = 0; bar.st = misc;
    const int lo = args.lo, hi = args.hi;
    const bool multi = (hi - lo) > 1;
    if (multi) bar = xcd_barrier_post((unsigned*)(ws + WS_CTL), misc);
    int gp = 0;
#ifndef ONLY_PH
#define ONLY_PH -1
#endif
#ifndef PHMASK
#define PHMASK 0xffffff
#endif
#ifndef REPMASK
#define REPMASK 0
#endif
#ifndef PR_SEL
#define PR_SEL 0
#endif
#ifndef PR_SWA
#define PR_SWA 0
#endif
#ifndef PR_CMP
#define PR_CMP 0
#endif
#ifndef PR_CHUNK
#define PR_CHUNK 0
#endif
#define PHASE_BEGIN(id) if (gp >= lo && gp < hi) { for (int rep_ = 0; rep_ < (((REPMASK >> (id)) & 1) ? 2 : 1); ++rep_) { if (rep_) __syncthreads(); \
    Ctx pc = c0; asm volatile("" : "+v"(pc.tid), "+s"(pc.bid)); pc.lane = pc.tid & 63; pc.wave = __builtin_amdgcn_readfirstlane(pc.tid >> 6); const Ctx& c = pc;
#define PHASE_END   } if (gp + 1 < hi) xcd_barrier(bar); } ++gp;
#define RELAUNDER() do { asm volatile("" : "+v"(pc.tid), "+s"(pc.bid)); pc.lane = pc.tid & 63; pc.wave = __builtin_amdgcn_readfirstlane(pc.tid >> 6); } while (0)

    float* x = args.out;
    PHASE_BEGIN(0) phase_init(c, inptr(c, I_X), x, xb, rs); PHASE_END

    for (int layer = 0; layer < DEPTH; ++layer) {
        PHASE_BEGIN(1) phase_cvt(c, args, layer, wb); PHASE_END
        for (int b = 0; b < NBATCH; ++b) {
            const int row0 = b * T;
            PHASE_BEGIN(2) {
                pg8::Gemm g{xb + (size_t)row0 * D, wb + WB_WIN, D, D, D}; pg8::Sched S; S.init(T / 256, NIN / 256, c.G, c.bid, 1, (size_t)256 * D * 2, 0, (size_t)256 * D * 2, 0);
                pg8::EpiInProj E{proj, gates, rs + row0}; pg8::gemm_phase(c.lds, c.tid, g, S, E); } PHASE_END
            PHASE_BEGIN(16) {
                { pg8::Gemm g{proj, wb + WB_W1T, 16 * PLD, 2048, 2048, (unsigned)PLD * 2}; pg8::Sched S; S.init(16, 1, c.G, c.bid, 1, 0, 0, 0, 0); S.mode = 1;
                  pg8::EpiCmp1 E{hidb, (const float*)(wb + WB_BH)}; pg8::gemm_phase(c.lds, c.tid, g, S, E); }
                RELAUNDER();
                if (c.bid >= 16) { Ctx cv = c; cv.bid = c.bid - 16; cv.G = c.G - 16; phase_lora_a(cv, args, layer, proj, alora); vt_transpose(cv, proj, vtb); } } PHASE_END
            PHASE_BEGIN(17) {
                { pg8::Gemm g{alora, wb + WB_LORA, 256, 256, 256}; pg8::Sched S; S.init(T / 256, 6, c.G, c.bid, 1, (unsigned)256 * 256 * 2, 0, (unsigned)256 * 256 * 2, 0);
                  pg8::EpiLora E{obuf}; pg8::gemm_phase(c.lds, c.tid, g, S, E); }
                RELAUNDER();
                { pg8::Gemm g{hidb, wb + WB_W2T, 256, 256, 256}; pg8::Sched S; S.init(16, 1, c.G, (c.bid + 16) % c.G, 1, (unsigned)256 * 256 * 2, 0, 0, 0); S.mode = 2;
                  pg8::EpiCmp2 E{kcb, vctb}; pg8::gemm_phase(c.lds, c.tid, g, S, E); } } PHASE_END
            PHASE_BEGIN(18) {
                for (int pr_ = 0; pr_ <= PR_CHUNK; ++pr_) { phase_rwkv_chunk(c, args, layer, proj, obuf + (size_t)T * 512, obuf + (size_t)2 * T * 512, rwu, bonusg);
                __syncthreads(); RELAUNDER(); }
                for (int pr_ = 0; pr_ <= PR_CMP; ++pr_) { phase_attn<2, 2>(c, args, layer, proj, vtb, kcb, vctb, sel, nsaacc, obuf + (size_t)T * 512); __syncthreads(); } } PHASE_END
            PHASE_BEGIN(19) {
                phase_rwkv_scan<0>(c, rwu, rws);
                RELAUNDER();
                if (c.bid >= 32) { Ctx cv = c; cv.bid = c.bid - 32; cv.G = c.G - 32;
                    phase_attn<1, 2>(cv, args, layer, proj, vtb, kcb, vctb, sel, nsaacc, obuf + (size_t)T * 512);
                    asm volatile("" : "+v"(cv.tid), "+s"(cv.bid)); cv.lane = cv.tid & 63; cv.wave = __builtin_amdgcn_readfirstlane(cv.tid >> 6);
                    for (int pr_ = 0; pr_ <= PR_SWA; ++pr_) { phase_attn<0, 2>(cv, args, layer, proj, vtb, kcb, vctb, sel, nsaacc, obuf + (size_t)2 * T * 512); __syncthreads(); } } } PHASE_END
            PHASE_BEGIN(9) {
                phase_rwkv_out(c, args, layer, proj, rwu, rws, bonusg, obuf);
                __syncthreads(); RELAUNDER();
                for (int pr_ = 0; pr_ <= PR_SEL; ++pr_) { phase_attn<3, 2>(c, args, layer, proj, vtb, kcb, vctb, sel, nsaacc, obuf + (size_t)T * 512); __syncthreads(); } } PHASE_END
            PHASE_BEGIN(10) {
                pg8::Gemm g{obuf, wb + WB_WBR, 512, 512, 512}; pg8::Sched S; S.init(T / 256, D / 256, c.G, c.bid, 3, (size_t)256 * 512 * 2, (size_t)T * 512 * 2, (size_t)256 * 512 * 2, (size_t)D * 512 * 2);
                pg8::EpiMerge E{gates, merged}; pg8::gemm_phase(c.lds, c.tid, g, S, E); } PHASE_END
            PHASE_BEGIN(11) {
                pg8::Gemm g{merged, wb + WB_WOUT, D, D, D}; pg8::Sched S; S.init(T / 256, D / 256, c.G, c.bid, 1, (size_t)256 * D * 2, 0, (size_t)256 * D * 2, 0);
                pg8::EpiStore E{tmpb, D}; pg8::gemm_phase(c.lds, c.tid, g, S, E); } PHASE_END
            PHASE_BEGIN(12) phase_norm_res(c, tmpb, inptr(c, I_NQM) + layer * D, x, xb, rs, row0, T); PHASE_END
        }
        PHASE_BEGIN(13) {
            pg8::Gemm g{xb, wb + WB_WGU, D, D, D}; pg8::Sched S; S.init(MROWS / 256, 2 * FFN / 256, c.G, c.bid, 1, (size_t)256 * D * 2, 0, (size_t)256 * D * 2, 0);
            pg8::EpiSwiGLU E{act, rs}; pg8::gemm_phase(c.lds, c.tid, g, S, E); } PHASE_END
        PHASE_BEGIN(14) {
            pg8::Gemm g{act, wb + WB_WDN, FFN, FFN, FFN}; pg8::Sched S; S.init(MROWS / 256, D / 256, c.G, c.bid, 1, (size_t)256 * FFN * 2, 0, (size_t)256 * FFN * 2, 0);
            pg8::EpiStore E{tmpf, D}; pg8::gemm_phase(c.lds, c.tid, g, S, E); } PHASE_END
        PHASE_BEGIN(15) phase_norm_res(c, tmpf, inptr(c, I_NQF) + layer * D, x, xb, rs, 0, MROWS); PHASE_END
    }
#undef PHASE_BEGIN
#undef PHASE_END
}

extern "C" void kernel_launch(void* const* d_in, const int* in_sizes, int n_in, void* d_out, int out_size, void* d_ws, size_t ws_size, hipStream_t stream) {
    static int grid = 0;
    if (grid == 0) {
        if (n_in != 30 || out_size != MROWS * D || ws_size < WS_END) { fprintf(stderr, "kernel_launch: unexpected shapes (n_in %d out %d ws %zu)\n", n_in, out_size, ws_size); grid = -1; return; }
        int dev = 0, cus = 0;
        if (hipGetDevice(&dev) != hipSuccess || hipDeviceGetAttribute(&cus, hipDeviceAttributeMultiprocessorCount, dev) != hipSuccess) { grid = -1; return; }
        if (hipFuncSetAttribute((const void*)fwd_kernel, hipFuncAttributeMaxDynamicSharedMemorySize, LDS_BYTES) != hipSuccess) { fprintf(stderr, "hipFuncSetAttribute failed\n"); grid = -1; return; }
        int per_cu = 0;
        if (hipOccupancyMaxActiveBlocksPerMultiprocessor(&per_cu, (const void*)fwd_kernel, 512, LDS_BYTES) != hipSuccess || per_cu < 1) { fprintf(stderr, "occupancy query: %d\n", per_cu); }
        (void)hipGetLastError();
        grid = cus;
    }
    if (grid < 0) return;
    (void)hipMemsetAsync((char*)d_ws + WS_CTL, 0, CTL_BYTES, stream);
    Args a{};
    for (int i = 0; i < 30; ++i) a.in[i] = (const float*)d_in[i];
    a.out = (float*)d_out; a.ws = (unsigned char*)d_ws;
#if MK_ONE_LAUNCH
    a.lo = 0; a.hi = PH_TOTAL;
    hipLaunchKernelGGL(fwd_kernel, dim3(grid), dim3(512), LDS_BYTES, stream, a);
#else
    for (int p = 0; p < PH_TOTAL; ++p) { a.lo = p; a.hi = p + 1; hipLaunchKernelGGL(fwd_kernel, dim3(grid), dim3(512), LDS_BYTES, stream, a); }
#endif
}
```

```cpp
#include <hip/hip_runtime.h>
#include <stdint.h>
#include <stdio.h>

#ifndef MK_ONE_LAUNCH
#define MK_ONE_LAUNCH 1
#endif

#define LAS __attribute__((address_space(3)))
typedef unsigned short bf16_t;
typedef short bf16x8 __attribute__((ext_vector_type(8)));
typedef float f32x4 __attribute__((ext_vector_type(4)));
typedef float f32x2 __attribute__((ext_vector_type(2)));
typedef unsigned u32x4 __attribute__((ext_vector_type(4)));
typedef unsigned u32x2 __attribute__((ext_vector_type(2)));

constexpr int D = 1024, NBATCH = 2, T = 16384, DEPTH = 4, MROWS = NBATCH * T;
constexpr int IN_COLS = 6936, FFN = 2816;
constexpr int PLD = 4096;
constexpr int PC_R = 0, PC_K = 512, PC_V = 1024, PC_ZW = 1536, PC_ZA = 1600, PC_ZG = 1664;
constexpr int PC_NQ = 1792, PC_KC = 2304, PC_VC = 2432, PC_KS = 2560, PC_VS = 2688, PC_KW = 2816, PC_VW = 2944, PC_GL = 3072;
constexpr int PC_SQ = 3328, PC_SK = 3840, PC_SV = 3968;
constexpr int NIN = 7168;
constexpr int NCMP = 1023;
constexpr float NORM_EPS = 1e-6f;

constexpr size_t MiB = 1u << 20;
constexpr size_t WS_CTL = 0, CTL_BYTES = 65536;
constexpr size_t WS_WB = 65536;
constexpr size_t WB_WIN = 0, WB_WBR = WB_WIN + (size_t)NIN * D, WB_WOUT = WB_WBR + (size_t)3 * D * 512, WB_WGU = WB_WOUT + (size_t)D * D,
                 WB_WDN = WB_WGU + (size_t)2 * FFN * D, WB_LORA = WB_WDN + (size_t)D * FFN, WB_W1T = WB_LORA + (size_t)1536 * 256, WB_W2T = WB_W1T + (size_t)2 * 256 * 2048,
                 WB_BH = WB_W2T + (size_t)2 * 256 * 256, WB_END = WB_BH + 1024;
static_assert(WS_WB + WB_END * 2 <= 38 * MiB + 786432, "weights");
constexpr size_t KiB = 1024;
constexpr size_t WS_XB = 38 * MiB + 768 * KiB;
constexpr size_t WS_CNT = 16384;
constexpr size_t WS_RS = WS_XB + 64 * MiB;
constexpr size_t WS_BONUS = WS_RS + 128 * KiB;
constexpr size_t WS_KCB = WS_BONUS + 512 * KiB;
constexpr size_t WS_VCT = WS_KCB + 256 * KiB;
constexpr size_t WS_STATS = WS_VCT + 256 * KiB;
constexpr size_t WS_SEL = WS_STATS;
constexpr size_t WS_HID = WS_SEL + 1 * MiB;
constexpr size_t WS_ML = WS_HID;
static_assert(WS_HID + 2 * MiB <= 107 * MiB, "small region");
constexpr size_t WS_ALORA = 107 * MiB;
constexpr size_t WS_VT = 115 * MiB;
constexpr size_t WS_BIG = 127 * MiB;
constexpr size_t WS_PROJ = WS_BIG;
constexpr size_t WS_GATES = WS_PROJ + 128 * MiB;
constexpr size_t WS_RWKVS = WS_GATES + 96 * MiB;
constexpr size_t WS_RWU = WS_RWKVS;
constexpr size_t WS_RWS = WS_RWKVS + 64 * MiB;
constexpr size_t WS_SCORES = WS_RWKVS;
constexpr size_t WS_MERGED = WS_RWKVS;
constexpr size_t WS_TMPB = WS_RWKVS + 32 * MiB;
constexpr size_t WS_NSAACC = WS_RWKVS + 80 * MiB;
constexpr size_t WS_O = WS_NSAACC + 32 * MiB;
constexpr size_t WS_END = WS_O + 48 * MiB;
constexpr size_t WS_ACT = WS_BIG;
constexpr size_t WS_TMPF = WS_BIG + 176 * MiB;
static_assert(WS_END <= 512 * MiB, "workspace");
static_assert(WS_TMPF + 64 * MiB <= WS_NSAACC, "ffn overlay");

constexpr int LDS_BYTES = 147456;
constexpr int LDS_MISC = 131072 + 8192;

__device__ __forceinline__ float* statp(unsigned char* ws, int row, int kind) {
    return (float*)(ws + WS_STATS + (kind >= 2 ? 524288 : 0)) + (size_t)row * 4; }
__device__ __forceinline__ unsigned* selp(unsigned char* ws, int t, int g) { return (unsigned*)(ws + WS_PROJ + (size_t)t * (PLD * 2) + 6272 + g * 32); }
__device__ __forceinline__ float bf2f(unsigned v) { return __uint_as_float(v << 16); }
typedef __bf16 bf16n2 __attribute__((ext_vector_type(2)));
__device__ __forceinline__ unsigned pk2(float lo, float hi) { const f32x2 f = {lo, hi}; const bf16n2 v = __builtin_convertvector(f, bf16n2); return __builtin_bit_cast(unsigned, v); }
__device__ __forceinline__ unsigned f2bf(float f) { return pk2(f, 0.f) & 0xffffu; }
__device__ __forceinline__ void unpack8(const u32x4 w, float (&f)[8]) {
    f[0] = __uint_as_float(w.x << 16); f[1] = __uint_as_float(w.x & 0xffff0000u); f[2] = __uint_as_float(w.y << 16); f[3] = __uint_as_float(w.y & 0xffff0000u);
    f[4] = __uint_as_float(w.z << 16); f[5] = __uint_as_float(w.z & 0xffff0000u); f[6] = __uint_as_float(w.w << 16); f[7] = __uint_as_float(w.w & 0xffff0000u);
}
#define DPPF(v, ctrl) __int_as_float(__builtin_amdgcn_update_dpp(0, __float_as_int(v), (ctrl), 0xf, 0xf, false))
__device__ __forceinline__ float row16_sum(float v) {
    v += DPPF(v, 0xB1); v += DPPF(v, 0x4E); v += DPPF(v, 0x141); v += DPPF(v, 0x140); return v;
}
__device__ __forceinline__ float wave_sum(float v) {
    v = row16_sum(v);
    const int iv = __float_as_int(v);
    return (__int_as_float(__builtin_amdgcn_readlane(iv, 0)) + __int_as_float(__builtin_amdgcn_readlane(iv, 16))) + (__int_as_float(__builtin_amdgcn_readlane(iv, 32)) + __int_as_float(__builtin_amdgcn_readlane(iv, 48)));
}
__device__ __forceinline__ float dpp_xor1(float v) { return __int_as_float(__builtin_amdgcn_update_dpp(0, __float_as_int(v), 0xB1, 0xf, 0xf, false)); }
__device__ __forceinline__ float dpp_xor2(float v) { return __int_as_float(__builtin_amdgcn_update_dpp(0, __float_as_int(v), 0x4E, 0xf, 0xf, false)); }
__device__ __forceinline__ float sigmoidf_(float x) { return __builtin_amdgcn_rcpf(1.0f + __expf(-x)); }
__device__ __forceinline__ int t5_bucket(int n) {
    if (n < 16) return n;
    int b = 16;
    b += (n >= 21); b += (n >= 27); b += (n >= 35); b += (n >= 46); b += (n >= 59); b += (n >= 77); b += (n >= 99); b += (n >= 128);
    b += (n >= 166); b += (n >= 216); b += (n >= 280); b += (n >= 363); b += (n >= 470); b += (n >= 609); b += (n >= 790);
    return b;
}

#define XB_TMO      128
#define XB_XCNT(j)  (256  + 64 * (j))
#define XB_XSUB(j)  (1280 + 64 * (j))
#define XB_XGEN(j)  (2304 + 64 * (j))
#define XB_TOP      3328
#define XB_TOPGEN   3392
#define XCD_BAR_WORDS 3456
#define XB_SPIN_CAP (1u << 22)
__device__ __forceinline__ unsigned xb_ld(unsigned* p)              { return __hip_atomic_load(p, __ATOMIC_RELAXED, __HIP_MEMORY_SCOPE_AGENT); }
__device__ __forceinline__ unsigned xb_add(unsigned* p, unsigned v) { return __hip_atomic_fetch_add(p, v, __ATOMIC_RELAXED, __HIP_MEMORY_SCOPE_AGENT); }
__device__ __forceinline__ unsigned xb_xcc_id() { return (unsigned)__builtin_amdgcn_s_getreg((3 << 11) | 20) & 0xFu; }
#define XB_SPIN(cond, bar) do { unsigned _sp = 0; while (cond) { __builtin_amdgcn_s_sleep(1); \
    if ((++_sp & 255u) == 0u) { if (xb_ld(&(bar)[XB_TMO])) break; if (_sp > XB_SPIN_CAP) { atomicAdd(&(bar)[XB_TMO], 1u); break; } } } } while (0)
struct XcdBarrier { unsigned* bar; unsigned x; volatile LAS unsigned* st; };
__device__ __forceinline__ XcdBarrier xcd_barrier_post(unsigned* bar, volatile LAS unsigned* st) {
    XcdBarrier b; b.bar = bar; b.x = xb_xcc_id(); b.st = st;
    if (threadIdx.x == 0) (void)xb_add(&bar[XB_XCNT(b.x)], 1u);
    return b;
}
__device__ __forceinline__ void xcd_barrier_complete(unsigned* bar, unsigned x, unsigned& nloc, unsigned& nx) {
    const unsigned G = gridDim.x * gridDim.y * gridDim.z;
    unsigned sum, cnt, mine, sp = 0u;
    for (;;) {
        sum = 0u; cnt = 0u; mine = 0u;
#pragma unroll
        for (unsigned j = 0; j < 16; ++j) { const unsigned c = xb_ld(&bar[XB_XCNT(j)]); sum += c; cnt += (c > 0u) ? 1u : 0u; mine = (j == x) ? c : mine; }
        if (sum == G) break;
        __builtin_amdgcn_s_sleep(1);
        if ((++sp & 255u) == 0u) { if (xb_ld(&bar[XB_TMO])) break; if (sp > XB_SPIN_CAP) { atomicAdd(&bar[XB_TMO], 1u); break; } }
    }
    nloc = mine > 0u ? mine : 1u; nx = cnt > 0u ? cnt : 1u;
}
__device__ __forceinline__ void xcd_barrier(const XcdBarrier& b) {
    asm volatile("s_waitcnt vmcnt(0)" ::: "memory");
    __syncthreads();
    if (threadIdx.x == 0) {
        unsigned* bar = b.bar;
        __builtin_amdgcn_s_waitcnt(0);
        unsigned nloc = b.st[0], nx = b.st[1];
        if (nloc == 0u) { xcd_barrier_complete(bar, b.x, nloc, nx); b.st[0] = nloc; b.st[1] = nx; }
        const unsigned old = xb_add(&bar[XB_XSUB(b.x)], 1u);
        const unsigned gen = old / nloc;
        if (old + 1u == (gen + 1u) * nloc) {
            __builtin_amdgcn_fence(__ATOMIC_RELEASE, "agent");
            asm volatile("s_waitcnt vmcnt(0)" ::: "memory");
            const unsigned og = xb_add(&bar[XB_TOP], 1u);
            const unsigned tg = og / nx;
            if (og + 1u == (tg + 1u) * nx) xb_add(&bar[XB_TOPGEN], 1u);
            else XB_SPIN(xb_ld(&bar[XB_TOPGEN]) == tg, bar);
            __builtin_amdgcn_fence(__ATOMIC_ACQUIRE, "agent");
            xb_add(&bar[XB_XGEN(b.x)], 1u);
            asm volatile("s_waitcnt vmcnt(0)" ::: "memory");
        } else {
            XB_SPIN(xb_ld(&bar[XB_XGEN(b.x)]) == gen, bar);
            __builtin_amdgcn_fence(__ATOMIC_ACQUIRE, "agent");
            asm volatile("s_waitcnt vmcnt(0)" ::: "memory");
        }
    }
    __syncthreads();
}

namespace pg8 {
constexpr int BM = 256, BK = 64, HALF = 128, HTB = HALF * BK * 2, STAGE_BYTES = 8 * HTB, NXCD = 8, WGM = 8;
__device__ __forceinline__ int lds_byte(int r, int c) { const int st = (r >> 4) * 2 + (c >> 5), rr = r & 15, cc = c & 31, ob = rr * 64 + cc * 2; return st * 1024 + (ob ^ (((ob >> 9) & 1) << 5)); }
__device__ __forceinline__ void stage_rc(int b, int& R, int& C) { const int st = b / 1024, sb = b % 1024, swz = sb ^ (((sb >> 9) & 1) << 5); R = (st >> 1) * 16 + swz / 64; C = (st & 1) * 32 + (swz % 64) / 2; }
__device__ __forceinline__ int perm32(int rho) { const int n = rho >> 4, i = rho & 15; return 8 * (i >> 2) + 4 * n + (i & 3); }

template <class E, class = void> struct epi_after_drain { static constexpr bool value = false; };
template <class E> struct epi_after_drain<E, decltype((void)E::AFTER_DRAIN)> { static constexpr bool value = E::AFTER_DRAIN; };
struct Unit { int pm, pn, sub; unsigned aoff, boff; };
struct Gemm { const bf16_t* A; const bf16_t* Bt; int lda, ldb, K; unsigned kstepA = 128; };
struct Sched {
    int nM, nN, nwg, G, c, nsub, mode = 0; unsigned a_row, a_sub, b_row, b_sub;
    __device__ __forceinline__ void init(int nM_, int nN_, int G_, int c_, int nsub_, unsigned a_row_, unsigned a_sub_, unsigned b_row_, unsigned b_sub_) {
        nM = nM_; nN = nN_; nwg = nM * nN; G = G_; c = c_; nsub = nsub_; a_row = a_row_; a_sub = a_sub_; b_row = b_row_; b_sub = b_sub_; }
    __device__ __forceinline__ bool next(int i, Unit& u) const {
        const int round = i / nsub; u.sub = i - round * nsub;
        const long L = (long)round * G + c; if (L >= nwg) return false;
        int wgid = (int)L; { const int q = nwg / NXCD, r = nwg % NXCD, xcd = wgid % NXCD, off = wgid / NXCD; wgid = (xcd < r ? xcd * (q + 1) : r * (q + 1) + (xcd - r) * q) + off; }
        const int nig = WGM * nN, gid = wgid / nig, fm = gid * WGM, gsz = (nM - fm) < WGM ? (nM - fm) : WGM;
        u.pm = fm + ((wgid % nig) % gsz); u.pn = (wgid % nig) / gsz;
        u.aoff = (unsigned)u.pm * a_row + (unsigned)u.sub * a_sub; u.boff = (unsigned)u.pn * b_row + (unsigned)u.sub * b_sub;
        if (mode == 1) { const int kv = u.pm >> 3, g = (u.pm >> 2) & 1, cp = u.pm & 3;
            u.aoff = (unsigned)(((size_t)cp * 256 * 16 * PLD + (kv ? PC_VC : PC_KC) + g * 64) * 2); u.boff = (unsigned)kv * (256u * 2048u * 2u); }
        if (mode == 2) { const int kv = u.pm >> 3; u.boff = (unsigned)kv * (256u * 256u * 2u); }
        return true;
    }
};

template <class Epi>
__device__ __forceinline__ void gemm_phase(LAS unsigned char* lds, const int tid, const Gemm g, const Sched& S, const Epi& E) {
    const int wid = __builtin_amdgcn_readfirstlane(tid >> 6), lane = tid & 63, wr = wid >> 2, wc = wid & 3, fr = lane & 15, fq = lane >> 4;
    const int K = g.K, nt = K / BK;
    unsigned voffA[2], voffB[2];
#pragma unroll
    for (int i = 0; i < 2; ++i) { int R, C; stage_rc(tid * 16 + i * 8192, R, C); const int Rb = Epi::PERM ? ((R & ~31) + perm32(R & 31)) : R;
        voffA[i] = (unsigned)(R * g.lda + C) * 2u; voffB[i] = (unsigned)(Rb * g.ldb + C) * 2u; }
    const size_t kstep = (size_t)(BK * 2), kstA = g.kstepA;
    const size_t hstepA = (size_t)HALF * g.lda * 2, hstepB = (size_t)HALF * g.ldb * 2;
    const unsigned ldsw = (unsigned)wid * 1024u;
    const int aoff = lds_byte(wr * 64 + fr, fq * 8), boff = lds_byte(wc * 32 + fr, fq * 8);
#define PG8_SA(b, h) (((b) * 2 + (h)) * HTB)
#define PG8_SB(b, h) ((4 + (b) * 2 + (h)) * HTB)
#define PG8_STAGE(bufoff, gbase, voff) do { _Pragma("unroll") for (int _i = 0; _i < 2; ++_i) \
        __builtin_amdgcn_global_load_lds((const unsigned*)((const char*)(gbase) + (voff)[_i]), (LAS unsigned*)(lds + (bufoff) + ldsw + _i * 8192), 16, 0, 0); } while (0)
#define PG8_LDA(dst, b, h) do { _Pragma("unroll") for (int m = 0; m < 4; ++m) _Pragma("unroll") for (int k = 0; k < 2; ++k) dst[m][k] = *(const LAS bf16x8*)(lds + PG8_SA(b, h) + aoff + m * 2048 + k * 1024); } while (0)
#define PG8_LDB(dst, b, h) do { _Pragma("unroll") for (int n = 0; n < 2; ++n) _Pragma("unroll") for (int k = 0; k < 2; ++k) dst[n][k] = *(const LAS bf16x8*)(lds + PG8_SB(b, h) + boff + n * 2048 + k * 1024); } while (0)
#define PG8_MMA(ai, bj, At, Bt) do { __builtin_amdgcn_s_setprio(1); _Pragma("unroll") for (int m = 0; m < 4; ++m) _Pragma("unroll") for (int n = 0; n < 2; ++n) _Pragma("unroll") for (int k = 0; k < 2; ++k) \
        acc[ai][bj][m][n] = __builtin_amdgcn_mfma_f32_16x16x32_bf16(Bt[n][k], At[m][k], acc[ai][bj][m][n], 0, 0, 0); __builtin_amdgcn_s_setprio(0); } while (0)
#define PG8_WAIT_V(n) asm volatile("s_waitcnt vmcnt(" #n ")" ::: "memory")
#define PG8_WAIT_L(n) asm volatile("s_waitcnt lgkmcnt(" #n ")" ::: "memory")
#define PG8_BAR __builtin_amdgcn_s_barrier()
#define PG8_SCHED __builtin_amdgcn_sched_barrier(0)
    Unit cur, nxt; int ui = 0;
    if (!S.next(0, cur)) return;
    f32x4 acc[2][2][4][2];
#pragma unroll
    for (int a = 0; a < 2; ++a)
#pragma unroll
        for (int b = 0; b < 2; ++b)
#pragma unroll
            for (int m = 0; m < 4; ++m)
#pragma unroll
                for (int n = 0; n < 2; ++n) acc[a][b][m][n] = (f32x4){0.f, 0.f, 0.f, 0.f};
    bf16x8 At[4][2], B0[2][2], B1[2][2];
    const char* cA = (const char*)g.A + cur.aoff; const char* cB = (const char*)g.Bt + cur.boff;
    PG8_STAGE(PG8_SB(0, 0), cB, voffB); PG8_STAGE(PG8_SA(0, 0), cA, voffA); PG8_STAGE(PG8_SB(0, 1), cB + hstepB, voffB); PG8_STAGE(PG8_SA(0, 1), cA + hstepA, voffA);
    if (wr == 1) PG8_BAR;
    PG8_WAIT_V(4); PG8_BAR;
    PG8_STAGE(PG8_SB(1, 0), cB + kstep, voffB); PG8_STAGE(PG8_SA(1, 0), cA + kstA, voffA); PG8_STAGE(PG8_SB(1, 1), cB + hstepB + kstep, voffB);
    PG8_WAIT_V(6); PG8_BAR;
    for (;;) {
        const bool has_next = S.next(ui + 1, nxt);
        const char* nA = has_next ? (const char*)g.A + nxt.aoff : cA; const char* nB = has_next ? (const char*)g.Bt + nxt.boff : cB;
        for (int t = 0; t < nt; t += 2) {
            const bool last = (t == nt - 2);
            const char* a1 = cA + (size_t)(t + 1) * kstA;
            const char* a2 = last ? nA : cA + (size_t)(t + 2) * kstA; const char* b2 = last ? nB : cB + (size_t)(t + 2) * kstep;
            const char* a3 = a2 + kstA; const char* b3 = b2 + kstep;
            PG8_LDB(B0, 0, 0); PG8_SCHED; PG8_LDA(At, 0, 0); PG8_STAGE(PG8_SA(1, 1), a1 + hstepA, voffA);
            PG8_WAIT_L(8); PG8_BAR; PG8_WAIT_L(0); PG8_MMA(0, 0, At, B0); PG8_BAR; PG8_SCHED;
            PG8_LDB(B1, 0, 1); PG8_STAGE(PG8_SB(0, 0), b2, voffB);
            PG8_BAR; PG8_WAIT_L(0); PG8_MMA(0, 1, At, B1); PG8_BAR;
            PG8_LDA(At, 0, 1); PG8_STAGE(PG8_SA(0, 0), a2, voffA);
            PG8_BAR; PG8_WAIT_L(0); PG8_MMA(1, 0, At, B0); PG8_BAR; PG8_SCHED;
            PG8_STAGE(PG8_SB(0, 1), b2 + hstepB, voffB);
            PG8_WAIT_V(6); PG8_BAR; PG8_MMA(1, 1, At, B1); PG8_BAR;
            PG8_LDB(B0, 1, 0); PG8_SCHED; PG8_LDA(At, 1, 0); PG8_STAGE(PG8_SA(0, 1), a2 + hstepA, voffA);
            PG8_WAIT_L(8); PG8_BAR; PG8_WAIT_L(0); PG8_MMA(0, 0, At, B0); PG8_BAR; PG8_SCHED;
            PG8_LDB(B1, 1, 1); PG8_STAGE(PG8_SB(1, 0), b3, voffB);
            PG8_BAR; PG8_WAIT_L(0); PG8_MMA(0, 1, At, B1); PG8_BAR;
            PG8_LDA(At, 1, 1); PG8_STAGE(PG8_SA(1, 0), a3, voffA);
            PG8_BAR; PG8_WAIT_L(0); PG8_MMA(1, 0, At, B0); PG8_BAR; PG8_SCHED;
            PG8_STAGE(PG8_SB(1, 1), b3 + hstepB, voffB);
            PG8_WAIT_V(6); PG8_BAR; PG8_MMA(1, 1, At, B1); PG8_BAR;
        }
        bool keep = false;
        if constexpr (!epi_after_drain<Epi>::value) keep = E(acc, cur, wr, wc, fr, fq);
        if (!has_next) break;
        if (!keep) {
#pragma unroll
            for (int a = 0; a < 2; ++a)
#pragma unroll
                for (int b = 0; b < 2; ++b)
#pragma unroll
                    for (int m = 0; m < 4; ++m)
#pragma unroll
                        for (int n = 0; n < 2; ++n) acc[a][b][m][n] = (f32x4){0.f, 0.f, 0.f, 0.f};
        }
        cur = nxt; cA = nA; cB = nB; ++ui;
    }
    PG8_WAIT_V(0);
    if (wr == 0) PG8_BAR;
    PG8_BAR;
    if constexpr (epi_after_drain<Epi>::value) (void)E(acc, cur, wr, wc, fr, fq);
#undef PG8_SA
#undef PG8_SB
#undef PG8_STAGE
#undef PG8_LDA
#undef PG8_LDB
#undef PG8_MMA
#undef PG8_WAIT_V
#undef PG8_WAIT_L
#undef PG8_BAR
#undef PG8_SCHED
}

struct EpiInProj {
    static constexpr bool PERM = true;
    bf16_t* proj; bf16_t* gates; unsigned char* ws; int row_base;
    __device__ __forceinline__ bool operator()(f32x4 (&acc)[2][2][4][2], const Unit& u, int wr, int wc, int fr, int fq) const {
        const int row0 = u.pm * BM + wr * 64 + fr; const bool is_gate = u.pn >= 16;
        bf16_t* base = is_gate ? gates + (u.pn - 16) * 256 : proj + u.pn * 256; const int ld = is_gate ? 3072 : PLD;
        const int col0 = wc * 32 + 8 * fq;
#pragma unroll
        for (int ai = 0; ai < 2; ++ai)
#pragma unroll
            for (int m = 0; m < 4; ++m) { const int row = row0 + ai * HALF + m * 16; const f32x4 pq = *(const f32x4*)statp(ws, row_base + row, 0);
                const float s = rsqrtf(((pq[0] + pq[1]) + (pq[2] + pq[3])) * (1.0f / D) + NORM_EPS); bf16_t* rowp = base + (size_t)row * ld + col0;
#pragma unroll
                for (int bj = 0; bj < 2; ++bj) { f32x4 v0 = acc[ai][bj][m][0] * s, v1 = acc[ai][bj][m][1] * s;
                    if (is_gate) {
#pragma unroll
                        for (int j = 0; j < 4; ++j) { v0[j] = sigmoidf_(v0[j]); v1[j] = sigmoidf_(v1[j]); } }
                    u32x4 w; w.x = pk2(v0[0], v0[1]); w.y = pk2(v0[2], v0[3]); w.z = pk2(v1[0], v1[1]); w.w = pk2(v1[2], v1[3]);
                    if (u.pn != 12 || col0 + bj * HALF < 64) *(u32x4*)(rowp + bj * HALF) = w; } }
        return false;
    }
};
struct EpiStore {
    static constexpr bool PERM = true;
    bf16_t* out; int ld;
    __device__ __forceinline__ bool operator()(f32x4 (&acc)[2][2][4][2], const Unit& u, int wr, int wc, int fr, int fq) const {
        const int row0 = u.pm * BM + wr * 64 + fr; const int col0 = u.pn * BM + wc * 32 + 8 * fq;
#pragma unroll
        for (int ai = 0; ai < 2; ++ai)
#pragma unroll
            for (int m = 0; m < 4; ++m) { bf16_t* rowp = out + (size_t)(row0 + ai * HALF + m * 16) * ld + col0;
#pragma unroll
                for (int bj = 0; bj < 2; ++bj) { const f32x4 v0 = acc[ai][bj][m][0], v1 = acc[ai][bj][m][1];
                    u32x4 w; w.x = pk2(v0[0], v0[1]); w.y = pk2(v0[2], v0[3]); w.z = pk2(v1[0], v1[1]); w.w = pk2(v1[2], v1[3]);
                    *(u32x4*)(rowp + bj * HALF) = w; } }
        return false;
    }
};
struct EpiCmp1 {
    static constexpr bool PERM = true;
    bf16_t* hid; const float* bh;
    __device__ __forceinline__ bool operator()(f32x4 (&acc)[2][2][4][2], const Unit& u, int wr, int wc, int fr, int fq) const {
        const int kv = u.pm >> 3; const int row0 = (u.pm & 7) * BM + wr * 64 + fr; const int col0 = wc * 32 + 8 * fq;
#pragma unroll
        for (int ai = 0; ai < 2; ++ai)
#pragma unroll
            for (int m = 0; m < 4; ++m) { bf16_t* rowp = hid + ((size_t)kv * 2048 + row0 + ai * HALF + m * 16) * 256 + col0;
#pragma unroll
                for (int bj = 0; bj < 2; ++bj) { float o[8];
#pragma unroll
                    for (int j = 0; j < 8; ++j) { const float x = acc[ai][bj][m][j >> 2][j & 3] + bh[kv * 256 + col0 + bj * HALF + j];
                        o[j] = x * sigmoidf_(1.5957691216f * (x + 0.044715f * x * x * x)); }
                    u32x4 w; w.x = pk2(o[0], o[1]); w.y = pk2(o[2], o[3]); w.z = pk2(o[4], o[5]); w.w = pk2(o[6], o[7]);
                    *(u32x4*)(rowp + bj * HALF) = w; } }
        return false;
    }
};
struct EpiCmp2 {
    static constexpr bool PERM = true;
    bf16_t* kcb; bf16_t* vct;
    __device__ __forceinline__ bool operator()(f32x4 (&acc)[2][2][4][2], const Unit& u, int wr, int wc, int fr, int fq) const {
        const int kv = u.pm >> 3; const int row0 = (u.pm & 7) * BM + wr * 64 + fr; const int col0 = wc * 32 + 8 * fq;
        if (col0 >= 64) return false;
#pragma unroll
        for (int ai = 0; ai < 2; ++ai)
#pragma unroll
            for (int m = 0; m < 4; ++m) { const int row = row0 + ai * HALF + m * 16, g = row >> 10, cc = row & 1023; const bool zr = cc == 1023; const f32x4 zz = (f32x4){0.f, 0.f, 0.f, 0.f};
                const f32x4 v0 = zr ? zz : acc[ai][0][m][0], v1 = zr ? zz : acc[ai][0][m][1];
                if (kv == 0) { u32x4 w; w.x = pk2(v0[0], v0[1]); w.y = pk2(v0[2], v0[3]); w.z = pk2(v1[0], v1[1]); w.w = pk2(v1[2], v1[3]); *(u32x4*)(kcb + ((size_t)g * 1024 + cc) * 64 + col0) = w; }
                else {
#pragma unroll
                    for (int j = 0; j < 4; ++j) { vct[((size_t)g * 64 + col0 + j) * 1024 + cc] = (bf16_t)f2bf(v0[j]); vct[((size_t)g * 64 + col0 + 4 + j) * 1024 + cc] = (bf16_t)f2bf(v1[j]); } } }
        return false;
    }
};
struct EpiLora {
    static constexpr bool PERM = true;
    bf16_t* obuf;
    __device__ __forceinline__ bool operator()(f32x4 (&acc)[2][2][4][2], const Unit& u, int wr, int wc, int fr, int fq) const {
        const int sel = u.pn >> 1; bf16_t* out = obuf + (size_t)(sel == 2 ? 0 : sel + 1) * T * 512;
        const int row0 = u.pm * BM + wr * 64 + fr; const int col0 = (u.pn & 1) * BM + wc * 32 + 8 * fq;
#pragma unroll
        for (int ai = 0; ai < 2; ++ai)
#pragma unroll
            for (int m = 0; m < 4; ++m) { bf16_t* rowp = out + (size_t)(row0 + ai * HALF + m * 16) * 512 + col0;
#pragma unroll
                for (int bj = 0; bj < 2; ++bj) { const f32x4 v0 = acc[ai][bj][m][0], v1 = acc[ai][bj][m][1];
                    u32x4 w; w.x = pk2(v0[0], v0[1]); w.y = pk2(v0[2], v0[3]); w.z = pk2(v1[0], v1[1]); w.w = pk2(v1[2], v1[3]);
                    *(u32x4*)(rowp + bj * HALF) = w; } }
        return false;
    }
};
struct EpiMerge {
    static constexpr bool PERM = true;
    const bf16_t* gates; bf16_t* merged;
    __device__ __forceinline__ bool operator()(f32x4 (&acc)[2][2][4][2], const Unit& u, int wr, int wc, int fr, int fq) const {
        const int row0 = u.pm * BM + wr * 64 + fr; const int col0 = u.pn * BM + wc * 32 + 8 * fq; const int sub = u.sub;
#pragma unroll
        for (int ai = 0; ai < 2; ++ai)
#pragma unroll
            for (int m = 0; m < 4; ++m) { const int row = row0 + ai * HALF + m * 16; const bf16_t* gp = gates + (size_t)row * 3072 + sub * 1024 + col0;
#pragma unroll
                for (int bj = 0; bj < 2; ++bj) {
                    float sc[8], sn[8]; unpack8(*(const u32x4*)(gp + bj * HALF), sc);
                    if (sub < 2) { unpack8(*(const u32x4*)(gp + 1024 + bj * HALF), sn);
#pragma unroll
                        for (int j = 0; j < 8; ++j) sc[j] = sc[j] * __builtin_amdgcn_rcpf(fmaxf(sn[j], 1e-30f)); }
                    f32x4 v0 = acc[ai][bj][m][0], v1 = acc[ai][bj][m][1];
#pragma unroll
                    for (int j = 0; j < 4; ++j) { v0[j] *= sc[j]; v1[j] *= sc[4 + j]; }
                    acc[ai][bj][m][0] = v0; acc[ai][bj][m][1] = v1;
                    if (sub == 2) { u32x4 w; w.x = pk2(v0[0], v0[1]); w.y = pk2(v0[2], v0[3]); w.z = pk2(v1[0], v1[1]); w.w = pk2(v1[2], v1[3]);
                        *(u32x4*)(merged + (size_t)row * D + col0 + bj * HALF) = w; } } }
        return sub != 2;
    }
};
struct EpiNorm {
    static constexpr bool PERM = true, AFTER_DRAIN = true;
    float* x; bf16_t* xb; const float* gain; unsigned char* ws; unsigned* cnt; int row_base, kind_next; unsigned target; LAS unsigned char* lds; int tid;
    __device__ __forceinline__ bool operator()(f32x4 (&acc)[2][2][4][2], const Unit& u, int wr, int wc, int fr, int fq) const {
        LAS float* P = (LAS float*)lds; LAS float* S = (LAS float*)(lds + 16384);
        const int lane = tid & 63, wid = __builtin_amdgcn_readfirstlane(tid >> 6);
        const int prow = row_base + u.pm * BM;
        const int col0 = u.pn * BM + wc * 32 + 8 * fq;
#pragma unroll
        for (int ai = 0; ai < 2; ++ai)
#pragma unroll
            for (int m = 0; m < 4; ++m) { float ps = 0.f;
#pragma unroll
                for (int bj = 0; bj < 2; ++bj) { const f32x4 v0 = acc[ai][bj][m][0], v1 = acc[ai][bj][m][1];
                    ps += (v0[0] * v0[0] + v0[1] * v0[1]) + (v0[2] * v0[2] + v0[3] * v0[3]) + (v1[0] * v1[0] + v1[1] * v1[1]) + (v1[2] * v1[2] + v1[3] * v1[3]); }
                P[(ai * HALF + wr * 64 + m * 16 + fr) * 16 + wc * 4 + fq] = ps; }
        asm volatile("s_waitcnt lgkmcnt(0)" ::: "memory"); __builtin_amdgcn_s_barrier(); asm volatile("" ::: "memory");
        if (tid < 256) { const f32x4 a0 = *(const LAS f32x4*)(P + tid * 16), a1 = *(const LAS f32x4*)(P + tid * 16 + 4), a2 = *(const LAS f32x4*)(P + tid * 16 + 8), a3 = *(const LAS f32x4*)(P + tid * 16 + 12);
            const float sm = (((a0[0] + a0[1]) + (a0[2] + a0[3])) + ((a1[0] + a1[1]) + (a1[2] + a1[3]))) + (((a2[0] + a2[1]) + (a2[2] + a2[3])) + ((a3[0] + a3[1]) + (a3[2] + a3[3])));
            __hip_atomic_store(statp(ws, prow + tid, 1 + (int)(target >> 4)) + u.pn, sm, __ATOMIC_RELAXED, __HIP_MEMORY_SCOPE_AGENT); }
        asm volatile("s_waitcnt vmcnt(0)" ::: "memory");
        unsigned* pcnt = cnt + 16 * (prow >> 8);
        if (tid < 256 && lane == 0) (void)__hip_atomic_fetch_add(pcnt, 1u, __ATOMIC_RELAXED, __HIP_MEMORY_SCOPE_AGENT);
        if (wid == 0) { unsigned spins = 0; while ((unsigned)__builtin_amdgcn_readfirstlane(__hip_atomic_load(pcnt, __ATOMIC_RELAXED, __HIP_MEMORY_SCOPE_AGENT)) < target) { __builtin_amdgcn_s_sleep(1); if (++spins > (1u << 20)) break; }
            __builtin_amdgcn_fence(__ATOMIC_ACQUIRE, "agent"); }
        asm volatile("s_waitcnt vmcnt(0) lgkmcnt(0)" ::: "memory"); __builtin_amdgcn_s_barrier(); asm volatile("" ::: "memory");
        if (tid < 256) { float* sp = statp(ws, prow + tid, 1 + (int)(target >> 4));
            const float t0 = __hip_atomic_load(sp, __ATOMIC_RELAXED, __HIP_MEMORY_SCOPE_AGENT), t1 = __hip_atomic_load(sp + 1, __ATOMIC_RELAXED, __HIP_MEMORY_SCOPE_AGENT),
                        t2 = __hip_atomic_load(sp + 2, __ATOMIC_RELAXED, __HIP_MEMORY_SCOPE_AGENT), t3 = __hip_atomic_load(sp + 3, __ATOMIC_RELAXED, __HIP_MEMORY_SCOPE_AGENT);
            S[tid] = rsqrtf(((t0 + t1) + (t2 + t3)) * (1.0f / D) + NORM_EPS); }
        asm volatile("s_waitcnt lgkmcnt(0)" ::: "memory"); __builtin_amdgcn_s_barrier(); asm volatile("" ::: "memory");
#pragma unroll
        for (int ai = 0; ai < 2; ++ai)
#pragma unroll
            for (int m = 0; m < 4; ++m) { const int rl = ai * HALF + wr * 64 + m * 16 + fr; const int row = prow + rl; const float rstd = S[rl]; float qs = 0.f;
#pragma unroll
                for (int bj = 0; bj < 2; ++bj) { const int col = col0 + bj * HALF; float* xp = x + (size_t)row * D + col; u32x4 w;
                    { f32x4 xa = *(const f32x4*)xp; const f32x4 ga = *(const f32x4*)(gain + col); xa += acc[ai][bj][m][0] * rstd * ga; *(f32x4*)xp = xa;
                      w.x = pk2(xa[0], xa[1]); w.y = pk2(xa[2], xa[3]); qs += (xa[0] * xa[0] + xa[1] * xa[1]) + (xa[2] * xa[2] + xa[3] * xa[3]); }
                    { f32x4 xc = *(const f32x4*)(xp + 4); const f32x4 gc = *(const f32x4*)(gain + col + 4); xc += acc[ai][bj][m][1] * rstd * gc; *(f32x4*)(xp + 4) = xc;
                      w.z = pk2(xc[0], xc[1]); w.w = pk2(xc[2], xc[3]); qs += (xc[0] * xc[0] + xc[1] * xc[1]) + (xc[2] * xc[2] + xc[3] * xc[3]); }
                    *(u32x4*)(xb + (size_t)row * D + col) = w; }
                P[rl * 16 + wc * 4 + fq] = qs; }
        asm volatile("s_waitcnt lgkmcnt(0)" ::: "memory"); __builtin_amdgcn_s_barrier(); asm volatile("" ::: "memory");
        if (tid < 256) { const f32x4 a0 = *(const LAS f32x4*)(P + tid * 16), a1 = *(const LAS f32x4*)(P + tid * 16 + 4), a2 = *(const LAS f32x4*)(P + tid * 16 + 8), a3 = *(const LAS f32x4*)(P + tid * 16 + 12);
            const float sm = (((a0[0] + a0[1]) + (a0[2] + a0[3])) + ((a1[0] + a1[1]) + (a1[2] + a1[3]))) + (((a2[0] + a2[1]) + (a2[2] + a2[3])) + ((a3[0] + a3[1]) + (a3[2] + a3[3])));
            __hip_atomic_store(statp(ws, prow + tid, kind_next) + u.pn, sm, __ATOMIC_RELAXED, __HIP_MEMORY_SCOPE_AGENT); }
        return false;
    }
};
struct EpiSwiGLU {
    static constexpr bool PERM = true;
    bf16_t* act; unsigned char* ws;
    __device__ __forceinline__ bool operator()(f32x4 (&acc)[2][2][4][2], const Unit& u, int wr, int wc, int fr, int fq) const {
        const int row0 = u.pm * BM + wr * 64 + fr; const int col0 = u.pn * HALF + wc * 32 + 8 * fq;
#pragma unroll
        for (int ai = 0; ai < 2; ++ai)
#pragma unroll
            for (int m = 0; m < 4; ++m) { const int row = row0 + ai * HALF + m * 16; const f32x4 pq = *(const f32x4*)statp(ws, row, 1);
                const float s = rsqrtf(((pq[0] + pq[1]) + (pq[2] + pq[3])) * (1.0f / D) + NORM_EPS);
                float o[8];
#pragma unroll
                for (int n = 0; n < 2; ++n)
#pragma unroll
                    for (int j = 0; j < 4; ++j) { const float gg = acc[ai][0][m][n][j] * s, uu = acc[ai][1][m][n][j] * s; o[n * 4 + j] = gg * sigmoidf_(gg) * uu; }
                u32x4 w; w.x = pk2(o[0], o[1]); w.y = pk2(o[2], o[3]); w.z = pk2(o[4], o[5]); w.w = pk2(o[6], o[7]);
                *(u32x4*)(act + (size_t)row * FFN + col0) = w; }
        return false;
    }
};
}

struct Args { const float* in[30]; float* out; unsigned char* ws; int lo, hi; };
enum { I_X = 0, I_NPM, I_NQM, I_NPF, I_NQF, I_WIN, I_MU, I_W0, I_W2, I_A0, I_A2, I_G2, I_KK, I_KA, I_RK, I_LNW, I_LNB, I_PEK, I_PEV, I_CKW1, I_CKW2, I_CVW1, I_CVW2, I_SINK, I_REL, I_WBR, I_WOUT, I_FG, I_FU, I_FD };

struct Ctx { LAS unsigned char* lds; int tid, lane, wave, G, bid; };
__device__ __forceinline__ const float* inptr(const Ctx& c, int i) {
    const volatile LAS unsigned* t = (const volatile LAS unsigned*)(c.lds + LDS_MISC + 64) + 2 * i;
    const unsigned lo = __builtin_amdgcn_readfirstlane(t[0]), hi = __builtin_amdgcn_readfirstlane(t[1]);
    return (const float*)(((unsigned long long)hi << 32) | lo);
}

__device__ __forceinline__ void phase_init(const Ctx& c, const float* x, float* xo, bf16_t* xb, unsigned char* wsb) {
    const int gw = c.bid * 8 + c.wave, NGW = c.G * 8;
    for (int row = gw; row < MROWS; row += NGW) {
        const float* xr = x + (size_t)row * D; float ss = 0.f;
#pragma unroll
        for (int j = 0; j < 2; ++j) { const int e = c.lane * 8 + 512 * j; const f32x4 a = *(const f32x4*)(xr + e), b = *(const f32x4*)(xr + e + 4);
            ss += a[0] * a[0] + a[1] * a[1] + a[2] * a[2] + a[3] * a[3] + b[0] * b[0] + b[1] * b[1] + b[2] * b[2] + b[3] * b[3];
            *(f32x4*)(xo + (size_t)row * D + e) = a; *(f32x4*)(xo + (size_t)row * D + e + 4) = b;
            u32x4 w; w.x = pk2(a[0], a[1]); w.y = pk2(a[2], a[3]); w.z = pk2(b[0], b[1]); w.w = pk2(b[2], b[3]); *(u32x4*)(xb + (size_t)row * D + e) = w; }
        ss = wave_sum(ss);
        if (c.lane < 4) __hip_atomic_store(statp(wsb, row, 0) + c.lane, c.lane == 0 ? ss : 0.f, __ATOMIC_RELAXED, __HIP_MEMORY_SCOPE_AGENT);
    }
}
__device__ __forceinline__ void phase_norm_res(const Ctx& c, const bf16_t* y, const float* gain, float* x, bf16_t* xb, float* rs, int row0, int nrows) {
    const int gw = c.bid * 8 + c.wave, NGW = c.G * 8;
    for (int r = gw; r < nrows; r += NGW) {
        const int row = row0 + r; float yv[16]; float ss = 0.f;
#pragma unroll
        for (int j = 0; j < 2; ++j) { float f[8]; unpack8(*(const u32x4*)(y + (size_t)r * D + c.lane * 8 + 512 * j), f);
#pragma unroll
            for (int k = 0; k < 8; ++k) { yv[j * 8 + k] = f[k]; ss += f[k] * f[k]; } }
        ss = wave_sum(ss); const float sc = rsqrtf(ss * (1.0f / D) + NORM_EPS); float s2 = 0.f;
#pragma unroll
        for (int j = 0; j < 2; ++j) { const int e = c.lane * 8 + 512 * j; float* xr = x + (size_t)row * D + e;
            f32x4 a = *(const f32x4*)xr, b = *(const f32x4*)(xr + 4); const f32x4 ga = *(const f32x4*)(gain + e), gb = *(const f32x4*)(gain + e + 4);
#pragma unroll
            for (int k = 0; k < 4; ++k) { a[k] += yv[j * 8 + k] * sc * ga[k]; b[k] += yv[j * 8 + 4 + k] * sc * gb[k]; s2 += a[k] * a[k] + b[k] * b[k]; }
            *(f32x4*)xr = a; *(f32x4*)(xr + 4) = b;
            u32x4 w; w.x = pk2(a[0], a[1]); w.y = pk2(a[2], a[3]); w.z = pk2(b[0], b[1]); w.w = pk2(b[2], b[3]); *(u32x4*)(xb + (size_t)row * D + e) = w; }
        s2 = wave_sum(s2);
        if (c.lane == 0) rs[row] = rsqrtf(s2 * (1.0f / D) + NORM_EPS);
    }
}

__device__ __forceinline__ void phase_cvt(const Ctx& c, const Args& a, int layer, bf16_t* wb) {
    LAS float* tile = (LAS float*)c.lds;
    constexpr int I0 = 16 * 112, I1 = 3 * 8 * 16, I2 = 16 * 16, I3 = 16 * 88, I4 = 44 * 16, I5 = 4 * 24, I6 = 2 * 32 * 4, I7 = 2 * 4 * 4, NIT = I0 + I1 + I2 + I3 + I4 + I5 + I6 + I7;
    for (int it = c.bid; it < NIT; it += c.G) {
        int r = it, kind, sub = 0, K, nblk; bf16_t* dst;
        if (r < I0) { kind = 0; K = D; nblk = 112; dst = wb + WB_WIN; }
        else if ((r -= I0) < I1) { kind = 1; sub = r / 128; r -= sub * 128; K = 512; nblk = 16; dst = wb + WB_WBR + (size_t)sub * D * 512; }
        else if ((r -= I1) < I2) { kind = 2; K = D; nblk = 16; dst = wb + WB_WOUT; }
        else if ((r -= I2) < I3) { kind = 3; K = D; nblk = 88; dst = wb + WB_WGU; }
        else if ((r -= I3) < I4) { kind = 4; K = FFN; nblk = 16; dst = wb + WB_WDN; }
        else if ((r -= I4) < I5) { kind = 5; K = 256; nblk = 24; dst = wb + WB_LORA; }
        else if ((r -= I5) < I6) { kind = 6; sub = r / 128; r -= sub * 128; K = 2048; nblk = 4; dst = wb + WB_W1T + (size_t)sub * 256 * 2048; }
        else { r -= I6; kind = 7; sub = r / 16; r -= sub * 16; K = 256; nblk = 4; dst = wb + WB_W2T + (size_t)sub * 256 * 256; }
        const int kb = r / nblk, nb = r % nblk, k0 = kb * 64, n0 = nb * 64;
        const float* src = nullptr; int ld = 0, nvalid = 64; float extra = 1.f; const float* gain = nullptr; bool kvalid = true;
        switch (kind) {
        case 0: { gain = inptr(c, I_NPM) + layer * D + k0; ld = IN_COLS;
            const int scol = n0 < 3096 ? n0 : n0 - 232; nvalid = (n0 < 3096) ? (3096 - n0 < 64 ? 3096 - n0 : 64) : (n0 < 3328 ? 0 : 64);
            if ((n0 >= PC_NQ && n0 < PC_NQ + 512) || (n0 >= PC_SQ && n0 < PC_SQ + 512)) extra = 0.125f;
            src = inptr(c, I_WIN) + ((size_t)layer * D + k0) * IN_COLS + scol; break; }
        case 1: src = inptr(c, I_WBR) + (((size_t)layer * 3 + sub) * 512 + k0) * D + n0; ld = D; break;
        case 2: src = inptr(c, I_WOUT) + ((size_t)layer * D + k0) * D + n0; ld = D; break;
        case 3: { gain = inptr(c, I_NPF) + layer * D + k0; ld = FFN; const int pn = n0 >> 8, rr = n0 & 255;
            src = inptr(c, rr < 128 ? I_FG : I_FU) + ((size_t)layer * D + k0) * FFN + pn * 128 + (rr & 127); break; }
        case 4: src = inptr(c, I_FD) + ((size_t)layer * FFN + k0) * D + n0; ld = D; break;
        case 5: { ld = 512;
            if (n0 < 512) { kvalid = k0 < 64; src = inptr(c, I_W2) + ((size_t)layer * 64 + k0) * 512 + n0; }
            else if (n0 < 1024) { kvalid = (k0 == 64); src = inptr(c, I_A2) + ((size_t)layer * 64 + (k0 - 64)) * 512 + n0 - 512; }
            else { kvalid = k0 >= 128; src = inptr(c, I_G2) + ((size_t)layer * 128 + (k0 - 128)) * 512 + n0 - 1024; }
            break; }
        case 6: src = inptr(c, sub ? I_CVW1 : I_CKW1) + ((size_t)layer * 2048 + k0) * 256 + n0; ld = 256; break;
        default: src = inptr(c, sub ? I_CVW2 : I_CKW2) + ((size_t)layer * 256 + k0) * 64 + n0; ld = 64; nvalid = n0 < 64 ? 64 : 0; break;
        }
#pragma unroll
        for (int i = 0; i < 8; ++i) { const int e = c.tid + 512 * i, kk = e >> 6, nn = e & 63; float v = 0.f;
            if (kvalid && nn < nvalid) { v = src[(size_t)kk * ld + nn] * extra; if (gain) v *= gain[kk]; }
            tile[kk * 65 + nn] = v; }
        __syncthreads();
        { const int nn = c.tid >> 3, kc = (c.tid & 7) * 8; u32x4 w;
          w.x = pk2(tile[(kc + 0) * 65 + nn], tile[(kc + 1) * 65 + nn]); w.y = pk2(tile[(kc + 2) * 65 + nn], tile[(kc + 3) * 65 + nn]);
          w.z = pk2(tile[(kc + 4) * 65 + nn], tile[(kc + 5) * 65 + nn]); w.w = pk2(tile[(kc + 6) * 65 + nn], tile[(kc + 7) * 65 + nn]);
          *(u32x4*)(dst + (size_t)(n0 + nn) * K + k0 + kc) = w; }
        __syncthreads();
    }
    if (c.bid == c.G - 1) {
        const int kv = c.tid >> 8, u = c.tid & 255; const float* w1 = inptr(c, kv ? I_CVW1 : I_CKW1) + (size_t)layer * 2048 * 256; const float* pe = inptr(c, kv ? I_PEV : I_PEK) + (size_t)layer * 2048;
        float acc = 0.f; for (int k = 0; k < 2048; ++k) acc += pe[k] * w1[(size_t)k * 256 + u];
        ((float*)(wb + WB_BH))[c.tid] = acc;
    }
}

struct RowState { float q[64]; float o[64]; float m, l; };
__device__ __forceinline__ void row_init(RowState& s, const bf16_t* qp) {
#pragma unroll
    for (int i = 0; i < 8; ++i) { float f[8]; unpack8(*(const u32x4*)(qp + i * 8), f);
#pragma unroll
        for (int k = 0; k < 8; ++k) s.q[i * 8 + k] = f[k]; }
}
__device__ __forceinline__ void row_reset(RowState& s) {
#pragma unroll
    for (int i = 0; i < 64; ++i) s.o[i] = 0.f;
    s.m = -1e30f; s.l = 0.f;
}
__device__ __forceinline__ void row_key_bf16(RowState& s, const bf16_t* kp, const bf16_t* vp, float bias) {
    float sc = bias;
#pragma unroll
    for (int i = 0; i < 8; ++i) { float f[8]; unpack8(*(const u32x4*)(kp + i * 8), f);
#pragma unroll
        for (int k = 0; k < 8; ++k) sc += s.q[i * 8 + k] * f[k];
        if ((i & 1) == 1) __builtin_amdgcn_sched_barrier(0); }
    const float mn = fmaxf(s.m, sc), corr = __expf(s.m - mn), p = __expf(sc - mn);
    s.l = s.l * corr + p; s.m = mn;
#pragma unroll
    for (int i = 0; i < 8; ++i) { float f[8]; unpack8(*(const u32x4*)(vp + i * 8), f);
#pragma unroll
        for (int k = 0; k < 8; ++k) s.o[i * 8 + k] = s.o[i * 8 + k] * corr + p * f[k];
        if ((i & 1) == 1) __builtin_amdgcn_sched_barrier(0); }
}
__device__ __forceinline__ void row_key_f32(RowState& s, const float* kp, const float* vp, float bias) {
    float sc = bias;
#pragma unroll
    for (int i = 0; i < 16; ++i) { const f32x4 f = *(const f32x4*)(kp + i * 4); sc += s.q[i * 4] * f[0] + s.q[i * 4 + 1] * f[1] + s.q[i * 4 + 2] * f[2] + s.q[i * 4 + 3] * f[3];
        if ((i & 3) == 3) __builtin_amdgcn_sched_barrier(0); }
    const float mn = fmaxf(s.m, sc), corr = __expf(s.m - mn), p = __expf(sc - mn);
    s.l = s.l * corr + p; s.m = mn;
#pragma unroll
    for (int i = 0; i < 16; ++i) { const f32x4 f = *(const f32x4*)(vp + i * 4);
#pragma unroll
        for (int k = 0; k < 4; ++k) s.o[i * 4 + k] = s.o[i * 4 + k] * corr + p * f[k];
        if ((i & 3) == 3) __builtin_amdgcn_sched_barrier(0); }
}

__device__ __forceinline__ float gelu_tanh(float x) { const float t = tanhf(0.7978845608028654f * (x + 0.044715f * x * x * x)); return 0.5f * x * (1.0f + t); }
__device__ __forceinline__ void phase_cmp1(const Ctx& c, const Args& a, int layer, const bf16_t* proj, float* hid) {
    for (int unit = c.bid; unit < 2048; unit += c.G) {
        const int kv = unit >> 10, g = (unit >> 9) & 1, cp = unit & 511; const int cc = cp * 2 + (c.tid >> 8), u = c.tid & 255;
        if (cc >= NCMP) continue;
        const float* w1 = a.in[kv ? I_CVW1 : I_CKW1] + (size_t)layer * 2048 * 256; const float* pe = a.in[kv ? I_PEV : I_PEK] + (size_t)layer * 32 * 64;
        const bf16_t* xp = proj + (size_t)(16 * cc) * PLD + (kv ? PC_VC : PC_KC) + g * 64;
        float acc = 0.f;
        for (int l = 0; l < 32; ++l) {
#pragma unroll
            for (int i = 0; i < 8; ++i) { float f[8]; unpack8(*(const u32x4*)(xp + (size_t)l * PLD + i * 8), f);
#pragma unroll
                for (int k = 0; k < 8; ++k) acc += (f[k] + pe[l * 64 + i * 8 + k]) * w1[(size_t)(l * 64 + i * 8 + k) * 256 + u]; }
        }
        hid[(((size_t)kv * 2 + g) * 1024 + cc) * 256 + u] = gelu_tanh(acc);
    }
}
__device__ __forceinline__ void phase_cmp2(const Ctx& c, const Args& a, int layer, const float* hid, bf16_t* kcb, bf16_t* vctb) {
    for (int unit = c.bid; unit < 512; unit += c.G) {
        const int kv = unit >> 8, g = (unit >> 7) & 1, cc = (unit & 127) * 8 + (c.tid >> 6), d = c.tid & 63;
        float acc = 0.f;
        if (cc < NCMP) { const float* w2 = a.in[kv ? I_CVW2 : I_CKW2] + (size_t)layer * 256 * 64; const float* hp = hid + (((size_t)kv * 2 + g) * 1024 + cc) * 256;
            for (int u = 0; u < 256; ++u) acc += hp[u] * w2[u * 64 + d]; }
        if (kv) vctb[((size_t)g * 64 + d) * 1024 + cc] = (bf16_t)f2bf(acc); else kcb[((size_t)g * 1024 + cc) * 64 + d] = (bf16_t)f2bf(acc);
    }
}
__device__ __forceinline__ void phase_nsa13(const Ctx& c, const Args& a, const bf16_t* proj, const float* kcmp, const float* vcmp, float* nsaacc, float* ml) {
    LAS float* tb = (LAS float*)c.lds;
    for (int e = c.tid; e < 512; e += 512) tb[e] = inptr(c, I_REL)[e];
    __syncthreads();
    for (int unit = c.bid; unit < T / 64; unit += c.G) {
        const int hh = c.tid >> 6, t = unit * 64 + (c.tid & 63), g = hh >> 2;
        RowState s; row_init(s, proj + (size_t)t * PLD + PC_NQ + hh * 64);
        const bf16_t* glp = proj + (size_t)t * PLD + PC_GL;
        const float g0 = sigmoidf_(bf2f(glp[hh])), g2 = sigmoidf_(bf2f(glp[16 + hh]));
        row_reset(s);
        const int nv = t >= 31 ? (t - 31) / 16 + 1 : 0;
        for (int cc = 0; cc < nv; ++cc) { const float bias = tb[t5_bucket(t - 16 * cc - 31) * 16 + hh];
            row_key_f32(s, kcmp + ((size_t)g * 1024 + cc) * 64, vcmp + ((size_t)g * 1024 + cc) * 64, bias); }
        ml[((size_t)t * 8 + hh) * 2] = s.m; ml[((size_t)t * 8 + hh) * 2 + 1] = s.l;
        float* op = nsaacc + (size_t)t * 512 + hh * 64;
        { const float inv = s.l > 0.f ? g0 / s.l : 0.f;
#pragma unroll
            for (int i = 0; i < 16; ++i) { f32x4 w; w[0] = s.o[i * 4] * inv; w[1] = s.o[i * 4 + 1] * inv; w[2] = s.o[i * 4 + 2] * inv; w[3] = s.o[i * 4 + 3] * inv; *(f32x4*)(op + i * 4) = w; } }
        row_reset(s);
        const int s0 = t - 511 > 0 ? t - 511 : 0;
        for (int sp = s0; sp <= t; ++sp) { const float bias = tb[t5_bucket(t - sp) * 16 + hh];
            row_key_bf16(s, proj + (size_t)sp * PLD + PC_KW + g * 64, proj + (size_t)sp * PLD + PC_VW + g * 64, bias); }
        { const float inv = s.l > 0.f ? g2 / s.l : 0.f;
#pragma unroll
            for (int i = 0; i < 16; ++i) { f32x4 w = *(const f32x4*)(op + i * 4); w[0] += s.o[i * 4] * inv; w[1] += s.o[i * 4 + 1] * inv; w[2] += s.o[i * 4 + 2] * inv; w[3] += s.o[i * 4 + 3] * inv; *(f32x4*)(op + i * 4) = w; } }
    }
}
__device__ __forceinline__ void phase_nsa_topk(const Ctx& c, const Args& a, const bf16_t* proj, const float* kcmp, const float* ml, int* sel) {
    LAS float* tb = (LAS float*)c.lds;
    LAS float* qs = (LAS float*)(c.lds + 4096) + c.wave * 256;
    LAS float* sv = (LAS float*)(c.lds + 16384) + c.wave * 256;
    for (int e = c.tid; e < 512; e += 512) tb[e] = inptr(c, I_REL)[e];
    __syncthreads();
    const int gw = c.bid * 8 + c.wave, NGW = c.G * 8;
    for (int item = gw; item < T * 2; item += NGW) {
        const int t = item >> 1, g = item & 1, cur = t >> 6;
        { const bf16_t* qp = proj + (size_t)t * PLD + PC_NQ + g * 256 + c.lane * 4; const u32x2 w = *(const u32x2*)qp;
          qs[c.lane * 4] = __uint_as_float(w.x << 16); qs[c.lane * 4 + 1] = __uint_as_float(w.x & 0xffff0000u); qs[c.lane * 4 + 2] = __uint_as_float(w.y << 16); qs[c.lane * 4 + 3] = __uint_as_float(w.y & 0xffff0000u); }
        float mr[4], il[4];
#pragma unroll
        for (int r = 0; r < 4; ++r) { mr[r] = ml[((size_t)t * 8 + g * 4 + r) * 2]; const float l = ml[((size_t)t * 8 + g * 4 + r) * 2 + 1]; il[r] = l > 0.f ? 1.0f / l : 0.f; }
        const int nv = t >= 31 ? (t - 31) / 16 + 1 : 0;
        asm volatile("s_waitcnt lgkmcnt(0)" ::: "memory");
#pragma unroll 1
        for (int jj = 0; jj < 4; ++jj) {
            const int j = c.lane + 64 * jj; float sc;
            if (j == 0 || j == cur || j == cur - 1) sc = 1e4f;
            else if (j > cur) sc = -1.0f;
            else { sc = 0.f;
#pragma unroll 1
                for (int o = 0; o < 5; ++o) { const int cc = 4 * j + o - 1; if (cc < 0 || cc >= nv) continue;
                    const float* kp = kcmp + ((size_t)g * 1024 + cc) * 64; float d0 = 0.f, d1 = 0.f, d2 = 0.f, d3 = 0.f;
#pragma unroll 4
                    for (int i = 0; i < 16; ++i) { const f32x4 f = *(const f32x4*)(kp + i * 4);
#pragma unroll
                        for (int k = 0; k < 4; ++k) { d0 += qs[i * 4 + k] * f[k]; d1 += qs[64 + i * 4 + k] * f[k]; d2 += qs[128 + i * 4 + k] * f[k]; d3 += qs[192 + i * 4 + k] * f[k]; } }
                    const int bk = t5_bucket(t - 16 * cc - 31) * 16 + g * 4;
                    const float imp = __expf(d0 + tb[bk] - mr[0]) * il[0] + __expf(d1 + tb[bk + 1] - mr[1]) * il[1] + __expf(d2 + tb[bk + 2] - mr[2]) * il[2] + __expf(d3 + tb[bk + 3] - mr[3]) * il[3];
                    sc += ((o == 0 || o == 4) ? 1.0f : 2.0f) * imp; }
            }
            sv[j] = sc;
        }
        asm volatile("s_waitcnt lgkmcnt(0)" ::: "memory");
        float val[4];
#pragma unroll
        for (int jj = 0; jj < 4; ++jj) val[jj] = sv[c.lane + 64 * jj];
        for (int k = 0; k < 16; ++k) {
            float bv = val[0]; int bi = c.lane;
#pragma unroll
            for (int jj = 1; jj < 4; ++jj) if (val[jj] > bv) { bv = val[jj]; bi = c.lane + 64 * jj; }
#pragma unroll
            for (int o = 32; o >= 1; o >>= 1) { const float ov = __shfl_xor(bv, o); const int oi = __shfl_xor(bi, o); if (ov > bv || (ov == bv && oi < bi)) { bv = ov; bi = oi; } }
#pragma unroll
            for (int jj = 0; jj < 4; ++jj) if (bi == c.lane + 64 * jj) val[jj] = -3e38f;
            if (c.lane == 0) sel[(size_t)item * 16 + k] = bi;
        }
    }
}
__device__ __forceinline__ void phase_nsa2(const Ctx& c, const Args& a, const bf16_t* proj, const int* sel, const float* nsaacc, bf16_t* onsa) {
    LAS float* tb = (LAS float*)c.lds;
    for (int e = c.tid; e < 512; e += 512) tb[e] = inptr(c, I_REL)[e];
    __syncthreads();
    for (int unit = c.bid; unit < T / 64; unit += c.G) {
        const int hh = c.tid >> 6, t = unit * 64 + (c.tid & 63), g = hh >> 2;
        RowState s; row_init(s, proj + (size_t)t * PLD + PC_NQ + hh * 64); row_reset(s);
        const float g1 = sigmoidf_(bf2f(proj[(size_t)t * PLD + PC_GL + 8 + hh]));
        for (int k = 0; k < 16; ++k) { const int j = sel[((size_t)t * 2 + g) * 16 + k];
            for (int p = 0; p < 64; ++p) { const int pos = j * 64 + p; if (pos > t) break;
                const float bias = tb[t5_bucket(t - pos) * 16 + hh];
                row_key_bf16(s, proj + (size_t)pos * PLD + PC_KS + g * 64, proj + (size_t)pos * PLD + PC_VS + g * 64, bias); } }
        const float inv = s.l > 0.f ? g1 / s.l : 0.f; const float* ap = nsaacc + (size_t)t * 512 + hh * 64; bf16_t* op = onsa + (size_t)t * 512 + hh * 64;
#pragma unroll
        for (int i = 0; i < 8; ++i) { const f32x4 x0 = *(const f32x4*)(ap + i * 8), x1 = *(const f32x4*)(ap + i * 8 + 4); u32x4 w;
            w.x = pk2(x0[0] + s.o[i * 8] * inv, x0[1] + s.o[i * 8 + 1] * inv); w.y = pk2(x0[2] + s.o[i * 8 + 2] * inv, x0[3] + s.o[i * 8 + 3] * inv);
            w.z = pk2(x1[0] + s.o[i * 8 + 4] * inv, x1[1] + s.o[i * 8 + 5] * inv); w.w = pk2(x1[2] + s.o[i * 8 + 6] * inv, x1[3] + s.o[i * 8 + 7] * inv);
            *(u32x4*)(op + i * 8) = w; }
    }
}
__device__ __forceinline__ void phase_swa(const Ctx& c, const Args& a, int layer, const bf16_t* proj, bf16_t* oswa) {
    LAS float* tb = (LAS float*)c.lds;
    for (int e = c.tid; e < 512; e += 512) tb[e] = inptr(c, I_REL)[e];
    __syncthreads();
    for (int unit = c.bid; unit < T / 64; unit += c.G) {
        const int hh = c.tid >> 6, t = unit * 64 + (c.tid & 63), g = hh >> 2;
        RowState s; row_init(s, proj + (size_t)t * PLD + PC_SQ + hh * 64); row_reset(s);
        const int s0 = t - 127 > 0 ? t - 127 : 0;
        for (int sp = s0; sp <= t; ++sp) { const float bias = tb[t5_bucket(t - sp) * 16 + 8 + hh];
            row_key_bf16(s, proj + (size_t)sp * PLD + PC_SK + g * 64, proj + (size_t)sp * PLD + PC_SV + g * 64, bias); }
        const float sink = inptr(c, I_SINK)[layer * 8 + hh]; const float mf = fmaxf(s.m, sink); const float corr = __expf(s.m - mf);
        const float den = s.l * corr + __expf(sink - mf); const float inv = corr / den;
        bf16_t* op = oswa + (size_t)t * 512 + hh * 64;
#pragma unroll
        for (int i = 0; i < 8; ++i) { u32x4 w; w.x = pk2(s.o[i * 8] * inv, s.o[i * 8 + 1] * inv); w.y = pk2(s.o[i * 8 + 2] * inv, s.o[i * 8 + 3] * inv);
            w.z = pk2(s.o[i * 8 + 4] * inv, s.o[i * 8 + 5] * inv); w.w = pk2(s.o[i * 8 + 6] * inv, s.o[i * 8 + 7] * inv); *(u32x4*)(op + i * 8) = w; }
    }
}

constexpr int RL = 65;
__device__ __forceinline__ float rwkv_mixed(const bf16_t* proj, const float* mu, int t, int col) {
    const float cur = bf2f(proj[(size_t)t * PLD + col]); const float prev = t > 0 ? bf2f(proj[(size_t)(t - 1) * PLD + col]) : 0.f;
    return cur + (prev - cur) * mu[col];
}
__device__ __forceinline__ void lora64(const Ctx& c, const LAS float* in, const float* W, const float* bias, LAS float* out, bool accum) {
    const int j = c.tid & 63, tg = (c.tid >> 6) * 8;
    float acc[8];
#pragma unroll
    for (int i = 0; i < 8; ++i) acc[i] = accum ? out[(tg + i) * RL + j] : (bias ? bias[j] : 0.f);
#pragma unroll 4
    for (int m = 0; m < 64; ++m) { const float w = W[(size_t)m * 512 + j];
#pragma unroll
        for (int i = 0; i < 8; ++i) acc[i] += in[(tg + i) * RL + m] * w; }
#pragma unroll
    for (int i = 0; i < 8; ++i) out[(tg + i) * RL + j] = acc[i];
}
struct RwkvLds { LAS float *R, *K, *V, *A, *B, *W, *G, *TMP; };
__device__ __forceinline__ RwkvLds rwkv_lds(LAS unsigned char* lds) {
    RwkvLds s; LAS float* p = (LAS float*)lds; constexpr int SZ = 64 * RL;
    s.R = p; s.K = p + SZ; s.V = p + 2 * SZ; s.A = p + 3 * SZ; s.B = p + 4 * SZ; s.W = p + 5 * SZ; s.G = p + 6 * SZ; s.TMP = p + 7 * SZ; return s;
}
template <bool LOGDECAY>
__device__ __forceinline__ void rwkv_prep(const Ctx& c, const Args& a, int layer, const bf16_t* proj, int t0, int h, const RwkvLds& s) {
    const float* mu = inptr(c, I_MU) + (size_t)layer * 1792;
    const int j = c.tid & 63, tg = c.tid >> 6;
#pragma unroll 2
    for (int i = 0; i < 8; ++i) { const int tt = tg * 8 + i; s.TMP[tt * RL + j] = tanhf(rwkv_mixed(proj, mu, t0 + tt, PC_ZW + j)); }
    __syncthreads();
    lora64(c, s.TMP, inptr(c, I_W2) + (size_t)layer * 64 * 512 + h * 64, inptr(c, I_W0) + layer * 512 + h * 64, s.W, false);
    __syncthreads();
#pragma unroll 2
    for (int i = 0; i < 8; ++i) { const int tt = tg * 8 + i; s.TMP[tt * RL + j] = rwkv_mixed(proj, mu, t0 + tt, PC_ZA + j); }
    __syncthreads();
    lora64(c, s.TMP, inptr(c, I_A2) + (size_t)layer * 64 * 512 + h * 64, inptr(c, I_A0) + layer * 512 + h * 64, s.B, false);
    __syncthreads();
#pragma unroll 2
    for (int i = 0; i < 8; ++i) { const int tt = tg * 8 + i; s.TMP[tt * RL + j] = sigmoidf_(rwkv_mixed(proj, mu, t0 + tt, PC_ZG + j)); }
    __syncthreads();
    lora64(c, s.TMP, inptr(c, I_G2) + (size_t)layer * 128 * 512 + h * 64, nullptr, s.G, false);
    __syncthreads();
#pragma unroll 2
    for (int i = 0; i < 8; ++i) { const int tt = tg * 8 + i; s.TMP[tt * RL + j] = sigmoidf_(rwkv_mixed(proj, mu, t0 + tt, PC_ZG + 64 + j)); }
    __syncthreads();
    lora64(c, s.TMP, inptr(c, I_G2) + ((size_t)layer * 128 + 64) * 512 + h * 64, nullptr, s.G, true);
    const float kkw = inptr(c, I_KK)[layer * 512 + h * 64 + j], kaw = inptr(c, I_KA)[layer * 512 + h * 64 + j];
#pragma unroll 1
    for (int i = 0; i < 8; ++i) { const int tt = tg * 8 + i, t = t0 + tt;
        const float r = rwkv_mixed(proj, mu, t, PC_R + h * 64 + j), k = rwkv_mixed(proj, mu, t, PC_K + h * 64 + j), v = rwkv_mixed(proj, mu, t, PC_V + h * 64 + j);
        const float wl = s.W[tt * RL + j], al = sigmoidf_(s.B[tt * RL + j]);
        const float sp = (-wl > 20.f) ? -wl : log1pf(__expf(-wl)); const float w = -sp - 0.5f; const float ew = __expf(w);
        float kk = k * kkw; const float n2 = wave_sum(kk * kk); kk = kk / fmaxf(sqrtf(n2), 1e-12f);
        s.R[tt * RL + j] = r; s.V[tt * RL + j] = v; s.K[tt * RL + j] = k * (1.0f + (al - 1.0f) * kaw);
        s.A[tt * RL + j] = -kk; s.B[tt * RL + j] = kk * al; s.W[tt * RL + j] = LOGDECAY ? -ew : __expf(-ew); }
    __syncthreads();
}
__device__ __forceinline__ void rwkv_post(const Ctx& c, const Args& a, int layer, int t0, int h, const RwkvLds& s, const LAS float* Y, bf16_t* orwkv) {
    const int i = c.lane, tg = c.wave;
    const float lnw = inptr(c, I_LNW)[layer * 512 + h * 64 + i], lnb = inptr(c, I_LNB)[layer * 512 + h * 64 + i], rk = inptr(c, I_RK)[layer * 512 + h * 64 + i];
#pragma unroll 1
    for (int q = 0; q < 8; ++q) { const int tt = tg * 8 + q; const float y = Y[tt * RL + i];
        const float mean = wave_sum(y) * (1.0f / 64.0f); const float d = y - mean; const float var = wave_sum(d * d) * (1.0f / 64.0f);
        const float bonus = wave_sum(s.R[tt * RL + i] * s.K[tt * RL + i] * rk);
        const float o = (d * rsqrtf(var + 64e-5f) * lnw + lnb + bonus * s.V[tt * RL + i]) * s.G[tt * RL + i];
        orwkv[(size_t)(t0 + tt) * 512 + h * 64 + i] = (bf16_t)f2bf(o); }
}
__device__ __forceinline__ void phase_rwkv_naive(const Ctx& c, const Args& a, int layer, const bf16_t* proj, bf16_t* orwkv) {
    if (c.bid >= 8) return;
    const int h = c.bid; const RwkvLds s = rwkv_lds(c.lds);
    float S[64];
#pragma unroll
    for (int j = 0; j < 64; ++j) S[j] = 0.f;
    for (int ch = 0; ch < T / 64; ++ch) {
        rwkv_prep<false>(c, a, layer, proj, ch * 64, h, s);
        if (c.wave == 0) {
            const int i = c.lane;
            for (int tt = 0; tt < 64; ++tt) {
                float sa = 0.f;
#pragma unroll
                for (int j = 0; j < 64; ++j) { sa += S[j] * s.A[tt * RL + j]; if ((j & 7) == 7) __builtin_amdgcn_sched_barrier(0); }
                const float vi = s.V[tt * RL + i]; float y = 0.f;
#pragma unroll
                for (int j = 0; j < 64; ++j) { S[j] = S[j] * s.W[tt * RL + j] + sa * s.B[tt * RL + j] + vi * s.K[tt * RL + j]; y += S[j] * s.R[tt * RL + j]; if ((j & 3) == 3) __builtin_amdgcn_sched_barrier(0); }
                s.TMP[tt * RL + i] = y;
            }
        }
        __syncthreads();
        rwkv_post(c, a, layer, ch * 64, h, s, s.TMP, orwkv);
        __syncthreads();
    }
}


__device__ __forceinline__ int kperm32(int jl) { return 8 * ((jl >> 2) & 3) + 4 * (jl >> 4) + (jl & 3); }
__device__ __forceinline__ f32x4 tile_mma64(const LAS unsigned char* A, const LAS unsigned char* B, int a, int b, int lane, f32x4 acc) {
    const int m = lane & 15, q = lane >> 4;
#pragma unroll
    for (int ks = 0; ks < 2; ++ks) {
        const bf16x8 af = *(const LAS bf16x8*)(A + (16 * a + m) * 144 + (32 * ks + 8 * q) * 2);
        const bf16x8 bf = *(const LAS bf16x8*)(B + (16 * b + m) * 144 + (32 * ks + 8 * q) * 2);
        acc = __builtin_amdgcn_mfma_f32_16x16x32_bf16(af, bf, acc, 0, 0, 0);
    }
    return acc;
}
__device__ __forceinline__ void lds_st_bf16(LAS unsigned char* base, int idx, float v) { *(LAS bf16_t*)(base + idx * 2) = (bf16_t)f2bf(v); }

__device__ __forceinline__ void phase_lora_a(const Ctx& c, const Args& a, int layer, const bf16_t* proj, bf16_t* alora) {
    const float* mu = inptr(c, I_MU) + (size_t)layer * 1792;
    const int sub = c.tid & 31, rloc = c.tid >> 5;
    for (int t = c.bid * 16 + rloc; t < T; t += c.G * 16) {
        const int col = PC_ZW + sub * 8; float cur[8], prv[8];
        unpack8(*(const u32x4*)(proj + (size_t)t * PLD + col), cur);
        if (t > 0) unpack8(*(const u32x4*)(proj + (size_t)(t - 1) * PLD + col), prv); else {
#pragma unroll
            for (int k = 0; k < 8; ++k) prv[k] = 0.f; }
        float o[8];
#pragma unroll
        for (int k = 0; k < 8; ++k) { const float v = cur[k] + (prv[k] - cur[k]) * mu[col + k]; o[k] = sub < 8 ? tanhf(v) : (sub < 16 ? v : sigmoidf_(v)); }
        u32x4 w; w.x = pk2(o[0], o[1]); w.y = pk2(o[2], o[3]); w.z = pk2(o[4], o[5]); w.w = pk2(o[6], o[7]);
        *(u32x4*)(alora + (size_t)t * 256 + sub * 8) = w;
    }
}

constexpr int RC_L = 0, RC_AL = 16640, RC_AAK = 0, RC_ARB = 9216, RC_ARK = 18432, RC_AAB = 33280, RC_P2T = 33280, RC_WC = 50688, RC_BS = 50944, RC_M = 52992;
constexpr int RC_AT = RC_M, RC_TINV = RC_M, RC_ATT = RC_M + 9216, RC_RT = RC_M + 2 * 9216, RC_BT = RC_M + 3 * 9216, RC_XT = RC_BT, RC_KT = RC_M + 4 * 9216, RC_P1T = RC_KT,
              RC_VT = RC_M + 5 * 9216, RC_BHT = RC_M + 6 * 9216, RC_KHT = RC_M + 7 * 9216;
constexpr int RC_XOFF = RC_M + 8 * 9216, RC_XTMP = RC_XOFF + 6144;
static_assert(RC_XTMP + 3 * 1088 <= LDS_MISC, "rwkv chunk LDS");

__device__ __forceinline__ void phase_rwkv_chunk(const Ctx& c, const Args& a, int layer, const bf16_t* proj, const bf16_t* wlb, const bf16_t* alb, bf16_t* rwu, float* bonusg) {
    LAS unsigned char* L = c.lds;
    LAS float* sL = (LAS float*)(L + RC_L); LAS float* sAL = (LAS float*)(L + RC_AL); LAS float* sAAB = (LAS float*)(L + RC_AAB);
    LAS float* sWC = (LAS float*)(L + RC_WC); LAS float* sBS = (LAS float*)(L + RC_BS);
    const float* mu = inptr(c, I_MU) + (size_t)layer * 1792;
    const int lane = c.lane, wave = c.wave, n = lane & 15, q = lane >> 4;
    for (int unit = c.bid; unit < 2048; unit += c.G) {
        const int ch = unit >> 3, h = unit & 7, t0 = ch * 64, j = lane;
        {
            const float w0 = inptr(c, I_W0)[layer * 512 + h * 64 + j], a0 = inptr(c, I_A0)[layer * 512 + h * 64 + j];
            bf16_t wraw[8], araw[8];
#pragma unroll
            for (int i = 0; i < 8; ++i) { const size_t gi = (size_t)(t0 + wave * 8 + i) * 512 + h * 64 + j; wraw[i] = wlb[gi]; araw[i] = alb[gi]; }
            float run = 0.f;
#pragma unroll
            for (int i = 0; i < 8; ++i) { const int tt = wave * 8 + i;
                const float wl = w0 + bf2f(wraw[i]); const float nx = -wl; const float sp = nx > 20.f ? nx : __logf(1.0f + __expf(nx)); const float ld = -__expf(-sp - 0.5f);
                run += ld; sL[tt * RL + j] = run; sAL[tt * RL + j] = sigmoidf_(a0 + bf2f(araw[i])); }
            sBS[wave * 64 + j] = run;
        }
        bf16_t rraw[9], kraw[9], vraw[9];
        {
#pragma unroll
            for (int i = 0; i < 9; ++i) { const int t = t0 + wave * 8 + i - 1; const bool ok = t >= 0; const size_t ro = (size_t)(ok ? t : 0) * PLD + h * 64 + j;
                rraw[i] = ok ? proj[ro + PC_R] : (bf16_t)0; kraw[i] = ok ? proj[ro + PC_K] : (bf16_t)0; vraw[i] = ok ? proj[ro + PC_V] : (bf16_t)0; }
        }
        __syncthreads();
        {
            float off = 0.f, tot = 0.f;
#pragma unroll
            for (int w2 = 0; w2 < 8; ++w2) { const float v = sBS[w2 * 64 + j]; tot += v; off += (w2 < wave) ? v : 0.f; }
            if (wave == 0) sWC[j] = __expf(tot);
            const float kkw = inptr(c, I_KK)[layer * 512 + h * 64 + j], kaw = inptr(c, I_KA)[layer * 512 + h * 64 + j], rk = inptr(c, I_RK)[layer * 512 + h * 64 + j];
            const float mur = mu[PC_R + h * 64 + j], muk = mu[PC_K + h * 64 + j], muv = mu[PC_V + h * 64 + j];
            float Lprev = off;
#pragma unroll
            for (int i = 0; i < 8; ++i) { const int tt = wave * 8 + i, t = t0 + tt;
                const float Lc = sL[tt * RL + j] + off, al = sAL[tt * RL + j];
                const float rc = bf2f(rraw[i + 1]), kc = bf2f(kraw[i + 1]), vc = bf2f(vraw[i + 1]);
                const float r = rc + (bf2f(rraw[i]) - rc) * mur, k = kc + (bf2f(kraw[i]) - kc) * muk, v = vc + (bf2f(vraw[i]) - vc) * muv;
                float kk = k * kkw; const float n2 = wave_sum(kk * kk); kk = kk / fmaxf(sqrtf(n2), 1e-12f);
                const float kp = k * (1.0f + (al - 1.0f) * kaw), av = -kk, bv = kk * al;
                const float eW = __expf(Lc), eWex = __expf(Lprev), eInv = __expf(-Lc), eC = __expf(tot - Lc);
                lds_st_bf16(L + RC_AT, tt * 72 + j, av * eWex); lds_st_bf16(L + RC_ATT, j * 72 + tt, av * eWex);
                lds_st_bf16(L + RC_RT, tt * 72 + j, r * eW); lds_st_bf16(L + RC_BT, tt * 72 + j, bv * eInv); lds_st_bf16(L + RC_KT, tt * 72 + j, kp * eInv);
                lds_st_bf16(L + RC_VT, j * 72 + tt, v); lds_st_bf16(L + RC_BHT, j * 72 + tt, bv * eC); lds_st_bf16(L + RC_KHT, j * 72 + tt, kp * eC);
                const float bon = wave_sum(r * kp * rk); if (lane == 0) bonusg[(size_t)t * 8 + h] = bon;
                Lprev = Lc; }
        }
        __syncthreads();
        for (int job = wave; job < 64; job += 8) {
            const int p = job >> 4, ta = (job >> 2) & 3, tb = job & 3;
            f32x4 acc = (f32x4){0.f, 0.f, 0.f, 0.f};
            if (ta >= tb) acc = tile_mma64(L + (p < 2 ? RC_AT : RC_RT), L + ((p & 1) ? RC_KT : RC_BT), ta, tb, lane, acc);
            LAS unsigned char* dst = L + (p == 1 ? RC_AAK : (p == 2 ? RC_ARB : RC_ARK));
#pragma unroll
            for (int r = 0; r < 4; ++r) { const int tt = 16 * ta + 4 * q + r, ss = 16 * tb + n; const bool keep = (p < 2) ? (ss < tt) : (ss <= tt); const float v = keep ? acc[r] : 0.f;
                if (p == 0) sAAB[tt * 68 + ss] = v; else lds_st_bf16(dst, tt * 72 + ss, v); }
        }
        __syncthreads();
        if (wave == 0) {
            const int blk = lane >> 4, cc = lane & 15; const LAS float* Ab = sAAB + (16 * blk) * 68 + 16 * blk; float xr[16];
#pragma unroll
            for (int tt = 0; tt < 16; ++tt) { float acc = (tt == cc) ? 1.f : 0.f;
#pragma unroll
                for (int ss = 0; ss < tt; ++ss) acc += Ab[tt * 68 + ss] * xr[ss];
                xr[tt] = acc; }
            asm volatile("s_waitcnt lgkmcnt(0)" ::: "memory");
#pragma unroll
            for (int tt = 0; tt < 16; ++tt) sAAB[(16 * blk + tt) * 68 + 16 * blk + cc] = xr[tt];
        } else {
            for (int job = wave - 1; job < 16; job += 7) { const int ta = job >> 2, tb = job & 3;
                const f32x4 acc = tile_mma64(L + RC_VT, L + RC_AAK, ta, tb, lane, (f32x4){0.f, 0.f, 0.f, 0.f});
#pragma unroll
                for (int r = 0; r < 4; ++r) lds_st_bf16(L + RC_XT, (16 * ta + 4 * q + r) * 72 + 16 * tb + n, acc[r]); }
        }
        __syncthreads();
        {
            LAS float* sXO = (LAS float*)(L + RC_XOFF); LAS float* sT = (LAS float*)(L + RC_XTMP) + wave * 272;
            const int rr = lane >> 2, c4 = (lane & 3) * 4;
#pragma unroll 1
            for (int lev = 1; lev <= 3; ++lev) {
                if (wave < 4 - lev) {
                    const int J = wave, I = wave + lev;
                    f32x4 tacc = (f32x4){0.f, 0.f, 0.f, 0.f};
                    for (int K = J; K < I; ++K) {
                        const LAS float* Ap = sAAB + (16 * I + rr) * 68 + 16 * K; const LAS float* Xp;
                        int xs;
                        if (K == J) { Xp = sAAB + (16 * J) * 68 + 16 * J + c4; xs = 68; }
                        else { const int d = K - J; const int bi = (d == 1) ? J : 3 + J; Xp = sXO + bi * 256 + c4; xs = 16; }
#pragma unroll
                        for (int k = 0; k < 16; ++k) { const float av = Ap[k]; const f32x4 xv = *(const LAS f32x4*)(Xp + k * xs); tacc += xv * av; }
                    }
                    *(LAS f32x4*)(sT + rr * 16 + c4) = tacc;
                    asm volatile("s_waitcnt lgkmcnt(0)" ::: "memory");
                    f32x4 xacc = (f32x4){0.f, 0.f, 0.f, 0.f};
                    const LAS float* Dp = sAAB + (16 * I + rr) * 68 + 16 * I;
#pragma unroll
                    for (int k = 0; k < 16; ++k) { const float dv = Dp[k]; const f32x4 tv = *(const LAS f32x4*)(sT + k * 16 + c4); xacc += tv * dv; }
                    const int bo = (lev == 1) ? J : (lev == 2 ? 3 + J : 5);
                    *(LAS f32x4*)(sXO + bo * 256 + rr * 16 + c4) = xacc;
                }
                __syncthreads();
            }
            for (int e = c.tid; e < 4096; e += 512) { const int tt = e >> 6, ss = e & 63, I = tt >> 4, J = ss >> 4; float v = 0.f;
                if (I == J) v = sAAB[tt * 68 + ss];
                else if (I > J) { const int d = I - J; const int bi = (d == 1) ? J : (d == 2 ? 3 + J : 5); v = sXO[bi * 256 + (tt & 15) * 16 + (ss & 15)]; }
                lds_st_bf16(L + RC_TINV, tt * 72 + ss, v); }
        }
        __syncthreads();
        for (int job = wave; job < 32; job += 8) { const int p = job >> 4, ta = (job >> 2) & 3, tb = job & 3;
            const f32x4 acc = tile_mma64(L + (p ? RC_XT : RC_ATT), L + RC_TINV, ta, tb, lane, (f32x4){0.f, 0.f, 0.f, 0.f});
#pragma unroll
            for (int r = 0; r < 4; ++r) lds_st_bf16(L + (p ? RC_P2T : RC_P1T), (16 * ta + 4 * q + r) * 72 + 16 * tb + n, acc[r]); }
        __syncthreads();
        bf16_t* ug = rwu + (size_t)unit * 16384;
        for (int job = wave; job < 64; job += 8) { const int p = job >> 4, ta = (job >> 2) & 3, tb = job & 3;
            f32x4 acc = (f32x4){0.f, 0.f, 0.f, 0.f};
            if (p == 0) { acc = tile_mma64(L + RC_ARB, L + RC_P1T, ta, tb, lane, acc);
#pragma unroll
                for (int r = 0; r < 4; ++r) { const int tt = 16 * ta + 4 * q + r, jj = 16 * tb + n; const float v = acc[r] + bf2f(*(const LAS bf16_t*)(L + RC_RT + (tt * 72 + jj) * 2));
                    ug[8192 + tt * 64 + (jj & 32) + kperm32(jj & 31)] = (bf16_t)f2bf(v); } }
            else if (p == 1) { acc = tile_mma64(L + RC_ARB, L + RC_P2T, ta, tb, lane, acc); acc = tile_mma64(L + RC_ARK, L + RC_VT, ta, tb, lane, acc);
                u32x2 w; w.x = pk2(acc[0], acc[1]); w.y = pk2(acc[2], acc[3]); *(u32x2*)(ug + 12288 + ((tb * 4 + ta) * 64 + lane) * 4) = w; }
            else if (p == 2) { acc = tile_mma64(L + RC_BHT, L + RC_P1T, ta, tb, lane, acc);
#pragma unroll
                for (int r = 0; r < 4; ++r) { const int jr = 16 * ta + 4 * q + r, jc = 16 * tb + n; const float v = acc[r] + (jr == jc ? sWC[jr] : 0.f);
                    ug[jr * 64 + (jc & 32) + kperm32(jc & 31)] = (bf16_t)f2bf(v); } }
            else { acc = tile_mma64(L + RC_BHT, L + RC_P2T, ta, tb, lane, acc); acc = tile_mma64(L + RC_KHT, L + RC_VT, ta, tb, lane, acc);
                u32x2 w; w.x = pk2(acc[0], acc[1]); w.y = pk2(acc[2], acc[3]); *(u32x2*)(ug + 4096 + ((tb * 4 + ta) * 64 + lane) * 4) = w; }
        }
        __syncthreads();
    }
}

#define RW_LOAD_SET(SET, UNIT) do { const bf16_t* ug_ = rwu + (size_t)(UNIT) * 16384; \
    _Pragma("unroll") for (int ta = 0; ta < 4; ++ta) { An[SET][ta][0] = *(const bf16x8*)(ug_ + (16 * ta + m) * 64 + 8 * q); An[SET][ta][1] = *(const bf16x8*)(ug_ + (16 * ta + m) * 64 + 32 + 8 * q); \
        Zn[SET][ta] = *(const u32x2*)(ug_ + 4096 + ((cq * 4 + ta) * 64 + lane) * 4); } } while (0)
template <int SM>
__device__ __forceinline__ void phase_rwkv_scan(const Ctx& c, const bf16_t* rwu, bf16_t* rws) {
    const int idx = c.bid; if (idx >= 32 || c.wave != 0) return;
    const int h = idx >> 2, cq = idx & 3, lane = c.lane, m = lane & 15, q = lane >> 4;
    bf16x8 Bhi[2], Blo[2];
#pragma unroll
    for (int s = 0; s < 2; ++s) { Bhi[s] = (bf16x8){0, 0, 0, 0, 0, 0, 0, 0}; Blo[s] = Bhi[s]; }
    bf16x8 An[2][4][2]; u32x2 Zn[2][4];
#pragma unroll
    for (int u = 0; u < 2; ++u) RW_LOAD_SET(u, u * 8 + h);
    if (SM == 1) {
        for (int ch = 0; ch < T / 64; ch += 8) {
#pragma unroll
            for (int uu = 0; uu < 8; ++uu) { const int u = uu & 3; const int unit = (ch + uu) * 8 + h;
                bf16_t* sg = rws + (size_t)unit * 4096 + cq * 1024 + lane * 8;
                *(bf16x8*)(sg) = Bhi[0]; *(bf16x8*)(sg + 512) = Bhi[1];
#pragma unroll
                for (int ta = 0; ta < 4; ++ta) { Bhi[0] = Bhi[0] ^ An[u][ta][0]; Bhi[1] = Bhi[1] ^ An[u][ta][1]; Bhi[0][0] ^= (short)Zn[u][ta].x; }
                RW_LOAD_SET(u, (ch + uu + 4 < T / 64) ? unit + 32 : unit); } }
        return;
    }
    for (int ch = 0; ch < T / 64; ch += 8) {
#pragma unroll
        for (int uu = 0; uu < 8; ++uu) {
            const int u = uu & 1;
            const int unit = (ch + uu) * 8 + h;
            bf16_t* sg = rws + (size_t)unit * 4096 + cq * 1024 + lane * 8;
            *(bf16x8*)(sg) = Bhi[0]; *(bf16x8*)(sg + 512) = Bhi[1];
            f32x4 acc[4];
#pragma unroll
            for (int ta = 0; ta < 4; ++ta) { const u32x2 z = Zn[u][ta];
                acc[ta] = (f32x4){__uint_as_float(z.x << 16), __uint_as_float(z.x & 0xffff0000u), __uint_as_float(z.y << 16), __uint_as_float(z.y & 0xffff0000u)};
#pragma unroll
                for (int s = 0; s < 2; ++s) { acc[ta] = __builtin_amdgcn_mfma_f32_16x16x32_bf16(An[u][ta][s], Bhi[s], acc[ta], 0, 0, 0); acc[ta] = __builtin_amdgcn_mfma_f32_16x16x32_bf16(An[u][ta][s], Blo[s], acc[ta], 0, 0, 0); } }
            if (SM == 0) RW_LOAD_SET(u, (ch + uu + 2 < T / 64) ? unit + 16 : unit);
#pragma unroll
            for (int s = 0; s < 2; ++s) { u32x4 hi, lo; float rem[8];
#pragma unroll
                for (int p = 0; p < 8; ++p) { const float v = acc[2 * s + (p >> 2)][p & 3]; const unsigned hb = f2bf(v); rem[p] = v - __uint_as_float(hb << 16); }
                hi.x = pk2(acc[2 * s][0], acc[2 * s][1]); hi.y = pk2(acc[2 * s][2], acc[2 * s][3]); hi.z = pk2(acc[2 * s + 1][0], acc[2 * s + 1][1]); hi.w = pk2(acc[2 * s + 1][2], acc[2 * s + 1][3]);
                lo.x = pk2(rem[0], rem[1]); lo.y = pk2(rem[2], rem[3]); lo.z = pk2(rem[4], rem[5]); lo.w = pk2(rem[6], rem[7]);
                Bhi[s] = __builtin_bit_cast(bf16x8, hi); Blo[s] = __builtin_bit_cast(bf16x8, lo); }
        }
    }
}
#undef RW_LOAD_SET

__device__ __forceinline__ void phase_rwkv_out(const Ctx& c, const Args& a, int layer, const bf16_t* proj, const bf16_t* rwu, const bf16_t* rws, const float* bonusg, bf16_t* orwkv) {
    const float* mu = inptr(c, I_MU) + (size_t)layer * 1792;
    const int lane = c.lane, m = lane & 15, q = lane >> 4;
    for (int unit = c.bid * 8 + c.wave; unit < 2048; unit += c.G * 8) {
        const int ch = unit >> 3, h = unit & 7, t0 = ch * 64; const bf16_t* ug = rwu + (size_t)unit * 16384; const bf16_t* sg = rws + (size_t)unit * 4096;
        bf16x8 Bf[4][2];
#pragma unroll
        for (int cq = 0; cq < 4; ++cq) { Bf[cq][0] = *(const bf16x8*)(sg + cq * 1024 + lane * 8); Bf[cq][1] = *(const bf16x8*)(sg + cq * 1024 + 512 + lane * 8); }
        float lnw[4], lnb[4];
#pragma unroll
        for (int cq = 0; cq < 4; ++cq) { lnw[cq] = inptr(c, I_LNW)[layer * 512 + h * 64 + 16 * cq + m]; lnb[cq] = inptr(c, I_LNB)[layer * 512 + h * 64 + 16 * cq + m]; }
#pragma unroll 1
        for (int ta = 0; ta < 4; ++ta) {
            const bf16x8 A0 = *(const bf16x8*)(ug + 8192 + (16 * ta + m) * 64 + 8 * q), A1 = *(const bf16x8*)(ug + 8192 + (16 * ta + m) * 64 + 32 + 8 * q);
            f32x4 y[4];
#pragma unroll
            for (int cq = 0; cq < 4; ++cq) { const u32x2 z = *(const u32x2*)(ug + 12288 + ((cq * 4 + ta) * 64 + lane) * 4);
                y[cq] = (f32x4){__uint_as_float(z.x << 16), __uint_as_float(z.x & 0xffff0000u), __uint_as_float(z.y << 16), __uint_as_float(z.y & 0xffff0000u)};
                y[cq] = __builtin_amdgcn_mfma_f32_16x16x32_bf16(A0, Bf[cq][0], y[cq], 0, 0, 0); y[cq] = __builtin_amdgcn_mfma_f32_16x16x32_bf16(A1, Bf[cq][1], y[cq], 0, 0, 0); }
#pragma unroll
            for (int r = 0; r < 4; ++r) { const int t = t0 + 16 * ta + 4 * q + r;
                float sm = row16_sum(y[0][r] + y[1][r] + y[2][r] + y[3][r]);
                const float mean = sm * (1.0f / 64.0f); float d[4], vs = 0.f;
#pragma unroll
                for (int cq = 0; cq < 4; ++cq) { d[cq] = y[cq][r] - mean; vs += d[cq] * d[cq]; }
                vs = row16_sum(vs);
                const float rstd = rsqrtf(vs * (1.0f / 64.0f) + 64e-5f); const float bon = bonusg[(size_t)t * 8 + h];
#pragma unroll
                for (int cq = 0; cq < 4; ++cq) { const int col = h * 64 + 16 * cq + m; const float v = rwkv_mixed(proj, mu, t, PC_V + col);
                    bf16_t* op = orwkv + (size_t)t * 512 + col; const float g = bf2f(*op);
                    *op = (bf16_t)f2bf((d[cq] * rstd * lnw[cq] + lnb[cq] + bon * v) * g); } }
        }
    }
}


constexpr int AT_K = 0, AT_V = 9216, AT_SCORE = 18432  , AT_BIAS = 83968, AT_SELM = 100352, AT_LIST = 104448, AT_NLIST = 105472, AT_NEED = 105504;
__device__ __forceinline__ void vt_transpose(const Ctx& c, const bf16_t* proj, bf16_t* vt) {
    LAS bf16_t* tl = (LAS bf16_t*)c.lds;
    for (int it = c.bid; it < 3 * 2 * 256; it += c.G) {
        const int which = it / 512, g = (it >> 8) & 1, tt = it & 255;
        const int col = (which == 0 ? PC_VS : (which == 1 ? PC_VW : PC_SV)) + g * 64;
        { const int tok = c.tid >> 3, ch = c.tid & 7; const u32x4 w = *(const u32x4*)(proj + (size_t)(tt * 64 + tok) * PLD + col + ch * 8);
          *(LAS u32x4*)(tl + tok * 72 + ch * 8) = w; }
        __syncthreads();
        { const int d = c.tid >> 3, ch = c.tid & 7; unsigned short e[8];
#pragma unroll
          for (int k = 0; k < 8; ++k) e[k] = tl[(ch * 8 + k) * 72 + d];
          u32x4 w; w.x = e[0] | ((unsigned)e[1] << 16); w.y = e[2] | ((unsigned)e[3] << 16); w.z = e[4] | ((unsigned)e[5] << 16); w.w = e[6] | ((unsigned)e[7] << 16);
          *(u32x4*)(vt + ((size_t)(which * 2 + g) * 64 + d) * T + tt * 64 + ch * 8) = w; }
        __syncthreads();
    }
}

template <int MODE, int NQ>
__device__ __forceinline__ void phase_attn(const Ctx& c, const Args& a, int layer, const bf16_t* proj, const bf16_t* vtb, const bf16_t* kcb, const bf16_t* vctb,
                                           unsigned* sel, float* nsaacc, bf16_t* oout) {
    LAS unsigned char* L = c.lds;
    LAS float* sscore = (LAS float*)(L + AT_SCORE);
    LAS float* biasd = (LAS float*)(L + AT_BIAS);
    LAS unsigned* selm = (LAS unsigned*)(L + AT_SELM);
    LAS int* list = (LAS int*)(L + AT_LIST);
    LAS int* nlist = (LAS int*)(L + AT_NLIST);
    LAS unsigned* need = (LAS unsigned*)(L + AT_NEED);
    const int lane = c.lane, wave = c.wave, n = lane & 15, q = lane >> 4, hr = n & 3;
    constexpr int TW = 4 * NQ, TB = 8 * TW, NU = T / TB, TS = (MODE == 3) ? 4 : 1;
    for (int unit = c.bid; unit < 2 * NU; unit += c.G) {
        const int g = unit / NU, t0 = ((g == 0) ? (unit % NU) : (NU - 1 - unit % NU)) * TB, tw0 = t0 + wave * TW;
        __syncthreads();
        for (int e = c.tid; e < 4096; e += 512) { const int r = e >> 10, d = e & 1023; biasd[e] = inptr(c, I_REL)[t5_bucket(d) * 16 + (MODE == 0 ? 8 : 0) + g * 4 + r]; }
        if (MODE == 3) {
            if (c.tid < 8) need[c.tid] = 0u;
            __syncthreads();
            { const int tok = c.tid >> 3, w8 = c.tid & 7; const unsigned mw = selp((unsigned char*)sel, t0 + tok, g)[w8]; selm[tok * 8 + w8] = mw; atomicOr((unsigned*)&need[w8], mw); }
            __syncthreads();
            if (c.tid < 256) { const int j = c.tid; const unsigned wd = need[j >> 5];
                if ((wd >> (j & 31)) & 1u) { int pos = __popc(wd & ((1u << (j & 31)) - 1u)); for (int w2 = 0; w2 < (j >> 5); ++w2) pos += __popc(need[w2]); list[pos] = j; } }
            if (c.tid == 0) { int cnt = 0; for (int w2 = 0; w2 < 8; ++w2) cnt += __popc(need[w2]); nlist[0] = cnt; }
        }
        __syncthreads();
        int ntiles, tile_lo = 0;
        if (MODE == 0) { ntiles = 2 + TB / 64; tile_lo = t0 - 128; }
        else if (MODE == 1) { ntiles = 8 + TB / 64; tile_lo = t0 - 512; }
        else if (MODE == 2) { const int cmax = (t0 + TB - 1 - 31) >> 4; ntiles = cmax < 0 ? 0 : (cmax >> 6) + 1; }
        else ntiles = nlist[0];
        const bf16_t* Ksrc; size_t kstride; const bf16_t* Vsrc; size_t vstride; int qcol;
        if (MODE == 0) { Ksrc = proj + PC_SK + g * 64; kstride = PLD; Vsrc = vtb + (size_t)(4 + g) * 64 * T; vstride = T; qcol = PC_SQ + g * 256; }
        else if (MODE == 1) { Ksrc = proj + PC_KW + g * 64; kstride = PLD; Vsrc = vtb + (size_t)(2 + g) * 64 * T; vstride = T; qcol = PC_NQ + g * 256; }
        else if (MODE == 2) { Ksrc = kcb + (size_t)g * 1024 * 64; kstride = 64; Vsrc = vctb + (size_t)g * 64 * 1024; vstride = 1024; qcol = PC_NQ + g * 256; }
        else { Ksrc = proj + PC_KS + g * 64; kstride = PLD; Vsrc = vtb + (size_t)(0 + g) * 64 * T; vstride = T; qcol = PC_NQ + g * 256; }
        bf16x8 Bq[NQ][2];
#pragma unroll
        for (int qd = 0; qd < NQ; ++qd) { const bf16_t* qp = proj + (size_t)(tw0 + 4 * qd + (n >> 2)) * PLD + qcol + hr * 64 + 8 * q;
            Bq[qd][0] = *(const bf16x8*)qp; Bq[qd][1] = *(const bf16x8*)(qp + 32); }
        const float bfar = biasd[hr * 1024 + 1023];
        float mrun[NQ], lrun[NQ]; f32x4 O[NQ][4];
#pragma unroll
        for (int qd = 0; qd < NQ; ++qd) { mrun[qd] = -1e30f; lrun[qd] = 0.f;
#pragma unroll
            for (int dt = 0; dt < 4; ++dt) O[qd][dt] = (f32x4){0.f, 0.f, 0.f, 0.f}; }
        float carry3[NQ]; for (int i = 0; i < NQ; ++i) carry3[i] = 0.f;
        const int npass = (MODE == 2) ? 2 : 1;
        for (int pass = 0; pass < npass; ++pass) {
            const bool do_pv = (MODE != 2) || pass == 1;
            float linv[NQ];
            if (MODE == 2 && pass == 1) {
#pragma unroll
                for (int qd = 0; qd < NQ; ++qd) { float mt = mrun[qd]; mt = fmaxf(mt, __shfl_xor(mt, 16)); mt = fmaxf(mt, __shfl_xor(mt, 32));
                    float lt = lrun[qd] * __expf(mrun[qd] - mt); lt += __shfl_xor(lt, 16); lt += __shfl_xor(lt, 32); mrun[qd] = mt; linv[qd] = lt > 0.f ? 1.0f / lt : 0.f; }
            }
#define AT_TILEPOS(ti) ((MODE == 3) ? list[ti] * 64 : (MODE == 2 ? (ti) * 64 : tile_lo + (ti) * 64))
#define AT_ISSUE(rd) do { _Pragma("unroll") for (int i_ = 0; i_ < TS; ++i_) { const int ti_ = (rd) * TS + i_; p0n[i_] = ti_ < ntiles ? AT_TILEPOS(ti_) : -1; \
        if (p0n[i_] >= 0) { kreg[i_] = *(const u32x4*)(Ksrc + (size_t)(p0n[i_] + (c.tid >> 3)) * kstride + (c.tid & 7) * 8); \
            if (do_pv) vreg[i_] = *(const u32x4*)(Vsrc + (size_t)(c.tid >> 3) * vstride + p0n[i_] + (c.tid & 7) * 8); } } } while (0)
            u32x4 kreg[TS], vreg[TS]; int p0n[TS];
            const int nrounds = (ntiles + TS - 1) / TS;
            if (nrounds > 0) AT_ISSUE(0);
            for (int rd = 0; rd < nrounds; ++rd) {
                int p0s[TS];
#pragma unroll
                for (int i = 0; i < TS; ++i) p0s[i] = p0n[i];
                __syncthreads();
#pragma unroll
                for (int i = 0; i < TS; ++i) if (p0s[i] >= 0) { *(LAS u32x4*)(L + AT_K + i * 18432 + (c.tid >> 3) * 144 + (c.tid & 7) * 16) = kreg[i];
                    if (do_pv) *(LAS u32x4*)(L + AT_V + i * 18432 + (c.tid >> 3) * 144 + (c.tid & 7) * 16) = vreg[i]; }
                if (rd + 1 < nrounds) AT_ISSUE(rd + 1);
                __syncthreads();
#pragma unroll
              for (int ts = 0; ts < TS; ++ts) {
                const int p0 = p0s[ts]; const int LK = AT_K + ts * 18432, LV = AT_V + ts * 18432;
                if (p0 < 0) continue;
                if (MODE == 0) { if (p0 > tw0 + TW - 1 || p0 + 63 < tw0 - 127) continue; }
                if (MODE == 1) { if (p0 > tw0 + TW - 1 || p0 + 63 < tw0 - 511) continue; }
                if (MODE == 2) { if (16 * p0 + 31 > tw0 + TW - 1) continue; }
                if (MODE == 3) { if (p0 > tw0 + TW - 1) continue; }
                const bool far = (MODE == 2) ? (tw0 - (16 * (p0 + 63) + 31) >= 790) : ((MODE == 3) ? (tw0 - (p0 + 63) >= 790) : false);
                const int jblk = p0 >> 6;
#pragma unroll
                for (int qd = 0; qd < NQ; ++qd) {
                    const int tq = tw0 + 4 * qd + (n >> 2);
                    bool colsel = true;
                    if (MODE == 3) { colsel = (selm[(wave * TW + 4 * qd + (n >> 2)) * 8 + (jblk >> 5)] >> (jblk & 31)) & 1u; if (__ballot(colsel) == 0ull) continue; }
                    {
                        f32x4 sc[4];
#pragma unroll
                        for (int kt = 0; kt < 4; ++kt) { sc[kt] = (f32x4){0.f, 0.f, 0.f, 0.f};
#pragma unroll
                            for (int ks = 0; ks < 2; ++ks) { const bf16x8 ak = *(const LAS bf16x8*)(L + LK + (16 * kt + n) * 144 + (32 * ks + 8 * q) * 2);
                                sc[kt] = __builtin_amdgcn_mfma_f32_16x16x32_bf16(ak, Bq[qd][ks], sc[kt], 0, 0, 0); } }
                        float mx = -1e30f;
                        if (far) {
#pragma unroll
                            for (int kt = 0; kt < 4; ++kt)
#pragma unroll
                                for (int r = 0; r < 4; ++r) { const float s2 = (MODE == 3 && !colsel) ? -1e30f : sc[kt][r] + bfar; sc[kt][r] = s2; mx = fmaxf(mx, s2); }
                        } else {
#pragma unroll
                        for (int kt = 0; kt < 4; ++kt)
#pragma unroll
                            for (int r = 0; r < 4; ++r) { const int kl = 16 * kt + 4 * q + r; int dist; bool v;
                                if (MODE == 2) { dist = tq - (16 * (p0 + kl) + 31); v = dist >= 0; }
                                else { dist = tq - (p0 + kl); v = dist >= 0; if (MODE == 0) v = v && dist < 128; if (MODE == 1) v = v && dist < 512; if (MODE == 3) v = v && colsel; }
                                const int di = dist < 0 ? 0 : (dist > 1023 ? 1023 : dist);
                                const float s2 = v ? sc[kt][r] + biasd[hr * 1024 + di] : -1e30f; sc[kt][r] = s2; mx = fmaxf(mx, s2); }
                        }
                        float p[4][4];
                        if (MODE == 2 && pass == 1) {
#pragma unroll
                            for (int kt = 0; kt < 4; ++kt)
#pragma unroll
                                for (int r = 0; r < 4; ++r) p[kt][r] = __expf(sc[kt][r] - mrun[qd]) * linv[qd];
                        } else if (MODE == 2) {
                            const float mn = fmaxf(mrun[qd], mx), corr = __expf(mrun[qd] - mn); mrun[qd] = mn; float ps = 0.f;
                            const float mne = mn < -1e29f ? 0.f : mn;
#pragma unroll
                            for (int kt = 0; kt < 4; ++kt)
#pragma unroll
                                for (int r = 0; r < 4; ++r) ps += __expf(sc[kt][r] - mne);
                            lrun[qd] = lrun[qd] * corr + ps;
                        } else {
                            if (__any(mx > mrun[qd])) {
                                mx = fmaxf(mx, __shfl_xor(mx, 16)); mx = fmaxf(mx, __shfl_xor(mx, 32));
                                const float mn = fmaxf(mrun[qd], mx), corr = __expf(mrun[qd] - mn); mrun[qd] = mn;
                                lrun[qd] *= corr;
#pragma unroll
                                for (int dt = 0; dt < 4; ++dt) O[qd][dt] = O[qd][dt] * corr;
                            }
                            const float mne = mrun[qd] < -1e29f ? 0.f : mrun[qd]; float ps = 0.f;
#pragma unroll
                            for (int kt = 0; kt < 4; ++kt)
#pragma unroll
                                for (int r = 0; r < 4; ++r) { p[kt][r] = __expf(sc[kt][r] - mne); ps += p[kt][r]; }
                            lrun[qd] += ps;
                        }
                        if (MODE == 2 && pass == 1) {
                            float i3prev = carry3[qd];
#pragma unroll
                            for (int kt = 0; kt < 4; ++kt) { float im[4];
#pragma unroll
                                for (int r = 0; r < 4; ++r) { float v = p[kt][r]; v += dpp_xor1(v); v += dpp_xor2(v); im[r] = v; }
                                const float same = __shfl(im[3], (lane + 48) & 63), prevt = __shfl(i3prev, (lane + 48) & 63);
                                const float pv3 = q > 0 ? same : prevt;
                                const int jg = (p0 + 16 * kt + 4 * q) >> 2;
                                if (hr == 0 && jg < 256) sscore[(tq - t0) * 256 + jg] = 2.0f * (im[0] + im[1] + im[2]) + im[3] + pv3;
                                i3prev = im[3]; }
                            carry3[qd] = i3prev;
                        }
                        if (do_pv) {
#pragma unroll
                            for (int st = 0; st < 2; ++st) {
                                u32x4 pw; pw.x = pk2(p[2 * st][0], p[2 * st][1]); pw.y = pk2(p[2 * st][2], p[2 * st][3]); pw.z = pk2(p[2 * st + 1][0], p[2 * st + 1][1]); pw.w = pk2(p[2 * st + 1][2], p[2 * st + 1][3]);
                                const bf16x8 pf = __builtin_bit_cast(bf16x8, pw);
#pragma unroll
                                for (int dt = 0; dt < 4; ++dt) { const LAS unsigned char* vp = L + LV + (16 * dt + n) * 144 + (32 * st + 4 * q) * 2;
                                    const u32x2 v0 = *(const LAS u32x2*)vp, v1 = *(const LAS u32x2*)(vp + 32); u32x4 vw; vw.x = v0.x; vw.y = v0.y; vw.z = v1.x; vw.w = v1.y;
                                    O[qd][dt] = __builtin_amdgcn_mfma_f32_16x16x32_bf16(__builtin_bit_cast(bf16x8, vw), pf, O[qd][dt], 0, 0, 0); } }
                        }
                    }
                }
              }
            }
        }
#undef AT_ISSUE
#undef AT_TILEPOS
        if (MODE == 2) {
            __syncthreads();
#pragma unroll 1
            for (int tk = 0; tk < TW; ++tk) { const int t = tw0 + tk, cur = t >> 6; const LAS float* sp = sscore + (wave * TW + tk) * 256;
                unsigned key[4]; bool forced[4];
#pragma unroll
                for (int jj = 0; jj < 4; ++jj) { const int j = lane + 64 * jj; forced[jj] = (j == 0 || j == cur || j == cur - 1);
                    key[jj] = (!forced[jj] && j < cur - 1) ? __float_as_uint(sp[j]) + 1u : 0u; }
                const int nforced = cur >= 2 ? 3 : cur + 1;
                unsigned prefix = 0u; int remaining = 16 - nforced;
#pragma unroll 1
                for (int bit = 30; bit >= 0; --bit) { const unsigned test = prefix | (1u << bit); int cnt = 0;
#pragma unroll
                    for (int jj = 0; jj < 4; ++jj) cnt += __popcll(__ballot((key[jj] >> bit) == (test >> bit)));
                    if (cnt >= remaining) prefix = test; else remaining -= cnt; }
                int eqbase = 0;
#pragma unroll
                for (int jj = 0; jj < 4; ++jj) { const bool eq = key[jj] == prefix && key[jj] != 0u; const unsigned long long eb = __ballot(eq);
                    const int eqrank = eqbase + __popcll(eb & ((1ull << lane) - 1ull)); eqbase += __popcll(eb);
                    const bool on = forced[jj] || key[jj] > prefix || (eq && eqrank < remaining); const unsigned long long bl = __ballot(on);
                    if (lane == 0) { unsigned* mp = selp((unsigned char*)sel, t, g); mp[2 * jj] = (unsigned)bl; mp[2 * jj + 1] = (unsigned)(bl >> 32); } }
            }
        }
#pragma unroll
        for (int qd = 0; qd < NQ; ++qd) {
            const int tq = tw0 + 4 * qd + (n >> 2), hh = g * 4 + hr;
            float scale;
            if (MODE == 2) scale = 1.0f;
            else { float lt = lrun[qd]; lt += __shfl_xor(lt, 16); lt += __shfl_xor(lt, 32);
                if (MODE == 0) { const float sink = inptr(c, I_SINK)[layer * 8 + hh]; const float mf = fmaxf(mrun[qd], sink), cr = __expf(mrun[qd] - mf); scale = cr / (lt * cr + __expf(sink - mf)); }
                else scale = lt > 0.f ? 1.0f / lt : 0.f; }
            if (MODE != 0) scale *= sigmoidf_(bf2f(proj[(size_t)tq * PLD + PC_GL + (MODE == 2 ? 0 : (MODE == 3 ? 8 : 16)) + hh]));
#pragma unroll
            for (int dt = 0; dt < 4; ++dt) { const f32x4 o = O[qd][dt] * scale; const int col = hh * 64 + 16 * dt + 4 * q;
                if (MODE == 0) { u32x2 w; w.x = pk2(o[0], o[1]); w.y = pk2(o[2], o[3]); *(u32x2*)(oout + (size_t)tq * 512 + col) = w; }
                else if (MODE == 2) *(f32x4*)(nsaacc + (size_t)tq * 512 + col) = o;
                else if (MODE == 1) { f32x4* ap = (f32x4*)(nsaacc + (size_t)tq * 512 + col); *ap = *ap + o; }
                else { const f32x4 t2 = *(const f32x4*)(nsaacc + (size_t)tq * 512 + col) + o; u32x2 w; w.x = pk2(t2[0], t2[1]); w.y = pk2(t2[2], t2[3]); *(u32x2*)(oout + (size_t)tq * 512 + col) = w; } }
        }
    }
}
__device__ __forceinline__ void phase_topk2(const Ctx& c, const float* scores, int* sel) {
    const int gw = c.bid * 8 + c.wave, NGW = c.G * 8;
    for (int item = gw; item < T * 2; item += NGW) {
        const int t = item >> 1, g = item & 1, cur = t >> 6;
        const float* sp = scores + ((size_t)g * T + t) * 256;
        float val[4];
#pragma unroll
        for (int jj = 0; jj < 4; ++jj) { const int j = c.lane + 64 * jj; float sc;
            if (j == 0 || j == cur || j == cur - 1) sc = 1e4f; else if (j > cur) sc = -1.0f; else sc = sp[j];
            val[jj] = sc; }
        for (int k = 0; k < 16; ++k) {
            float bv = val[0]; int bi = c.lane;
#pragma unroll
            for (int jj = 1; jj < 4; ++jj) if (val[jj] > bv) { bv = val[jj]; bi = c.lane + 64 * jj; }
#pragma unroll
            for (int o = 32; o >= 1; o >>= 1) { const float ov = __shfl_xor(bv, o); const int oi = __shfl_xor(bi, o); if (ov > bv || (ov == bv && oi < bi)) { bv = ov; bi = oi; } }
#pragma unroll
            for (int jj = 0; jj < 4; ++jj) if (bi == c.lane + 64 * jj) val[jj] = -3e38f;
            if (c.lane == 0) sel[(size_t)item * 16 + k] = bi;
        }
    }
}

#define wb ((bf16_t*)(ws + WS_WB))
#define xb ((bf16_t*)(ws + WS_XB))
#define cntp ((unsigned*)(ws + WS_CNT))
#define xres (args.out)
#define kcb ((bf16_t*)(ws + WS_KCB))
#define vctb ((bf16_t*)(ws + WS_VCT))
#define vtb ((bf16_t*)(ws + WS_VT))
#define scores ((float*)(ws + WS_SCORES))
#define sel ((unsigned*)ws)
#define ml ((float*)(ws + WS_ML))
#define hidb ((bf16_t*)(ws + WS_HID))
#define proj ((bf16_t*)(ws + WS_PROJ))
#define gates ((bf16_t*)(ws + WS_GATES))
#define merged ((bf16_t*)(ws + WS_MERGED))
#define tmpb ((bf16_t*)(ws + WS_TMPB))
#define alora ((bf16_t*)(ws + WS_ALORA))
#define rwu ((bf16_t*)(ws + WS_RWU))
#define rws ((bf16_t*)(ws + WS_RWS))
#define bonusg ((float*)(ws + WS_BONUS))
#define nsaacc ((float*)(ws + WS_NSAACC))
#define obuf ((bf16_t*)(ws + WS_O))
#define act ((bf16_t*)(ws + WS_ACT))
#define tmpf ((bf16_t*)(ws + WS_TMPF))
constexpr int PH_PER_BATCH = 8, PH_PER_LAYER = 1 + 2 * PH_PER_BATCH + 2, PH_TOTAL = 1 + DEPTH * PH_PER_LAYER;

__global__ void __launch_bounds__(512, 2) fwd_kernel(Args args) {
    extern __shared__ __attribute__((aligned(16))) unsigned char lds_raw[];
    Ctx c0; c0.lds = (LAS unsigned char*)lds_raw; c0.tid = threadIdx.x; c0.lane = c0.tid & 63; c0.wave = __builtin_amdgcn_readfirstlane(c0.tid >> 6); c0.G = gridDim.x; c0.bid = blockIdx.x; const Ctx& c = c0;
    unsigned char* ws = args.ws;
    volatile LAS unsigned* misc = (volatile LAS unsigned*)(c.lds + LDS_MISC);
    if (c.tid < 4) misc[c.tid] = 0u;
    if (c.tid < 30) { const unsigned long long pv = (unsigned long long)args.in[c.tid & 31]; misc[16 + 2 * c.tid] = (unsigned)pv; misc[17 + 2 * c.tid] = (unsigned)(pv >> 32); }
    __syncthreads();
    XcdBarrier bar; bar.bar = (unsigned*)(ws + WS_CTL); bar.x = 0; bar.st = misc;
    const int lo = args.lo, hi = args.hi;
    const bool multi = (hi - lo) > 1;
    if (multi) bar = xcd_barrier_post((unsigned*)(ws + WS_CTL), misc);
    int gp = 0;
#ifndef ONLY_PH
#define ONLY_PH -1
#endif
#ifndef PHMASK
#define PHMASK 0xffffff
#endif
#ifndef REPMASK
#define REPMASK 0
#endif
#ifndef PR_SEL
#define PR_SEL 0
#endif
#ifndef PR_SWA
#define PR_SWA 0
#endif
#ifndef PR_CMP
#define PR_CMP 0
#endif
#ifndef PR_CHUNK
#define PR_CHUNK 0
#endif
#define PHASE_BEGIN(id) if (gp >= lo && gp < hi) { for (int rep_ = 0; rep_ < (((REPMASK >> (id)) & 1) ? 2 : 1); ++rep_) { if (rep_) __syncthreads(); \
    Ctx pc = c0; asm volatile("" : "+v"(pc.tid), "+s"(pc.bid)); pc.lane = pc.tid & 63; pc.wave = __builtin_amdgcn_readfirstlane(pc.tid >> 6); const Ctx& c = pc;
#define PHASE_END   } if (gp + 1 < hi) xcd_barrier(bar); } ++gp;
#define RELAUNDER() do { asm volatile("" : "+v"(pc.tid), "+s"(pc.bid)); pc.lane = pc.tid & 63; pc.wave = __builtin_amdgcn_readfirstlane(pc.tid >> 6); } while (0)

    PHASE_BEGIN(0) phase_init(c, inptr(c, I_X), xres, xb, ws); PHASE_END

    for (int layer = 0; layer < DEPTH; ++layer) {
        PHASE_BEGIN(1) phase_cvt(c, args, layer, wb); PHASE_END
        for (int b = 0; b < NBATCH; ++b) {
            const int row0 = b * T;
            PHASE_BEGIN(2) {
                pg8::Gemm g{xb + (size_t)row0 * D, wb + WB_WIN, D, D, D}; pg8::Sched S; S.init(T / 256, NIN / 256, c.G, c.bid, 1, (size_t)256 * D * 2, 0, (size_t)256 * D * 2, 0);
                pg8::EpiInProj E{proj, gates, ws, row0}; pg8::gemm_phase(c.lds, c.tid, g, S, E); } PHASE_END
            PHASE_BEGIN(16) {
                { pg8::Gemm g{proj, wb + WB_W1T, 16 * PLD, 2048, 2048, (unsigned)PLD * 2}; pg8::Sched S; S.init(16, 1, c.G, c.bid, 1, 0, 0, 0, 0); S.mode = 1;
                  pg8::EpiCmp1 E{hidb, (const float*)(wb + WB_BH)}; pg8::gemm_phase(c.lds, c.tid, g, S, E); }
                RELAUNDER();
                if (c.bid >= 16) { Ctx cv = c; cv.bid = c.bid - 16; cv.G = c.G - 16; phase_lora_a(cv, args, layer, proj, alora); vt_transpose(cv, proj, vtb); } } PHASE_END
            PHASE_BEGIN(17) {
                { pg8::Gemm g{alora, wb + WB_LORA, 256, 256, 256}; pg8::Sched S; S.init(T / 256, 6, c.G, c.bid, 1, (unsigned)256 * 256 * 2, 0, (unsigned)256 * 256 * 2, 0);
                  pg8::EpiLora E{obuf}; pg8::gemm_phase(c.lds, c.tid, g, S, E); }
                RELAUNDER();
                { pg8::Gemm g{hidb, wb + WB_W2T, 256, 256, 256}; pg8::Sched S; S.init(16, 1, c.G, (c.bid + 16) % c.G, 1, (unsigned)256 * 256 * 2, 0, 0, 0); S.mode = 2;
                  pg8::EpiCmp2 E{kcb, vctb}; pg8::gemm_phase(c.lds, c.tid, g, S, E); } } PHASE_END
            PHASE_BEGIN(18) {
                for (int pr_ = 0; pr_ <= PR_CHUNK; ++pr_) { phase_rwkv_chunk(c, args, layer, proj, obuf + (size_t)T * 512, obuf + (size_t)2 * T * 512, rwu, bonusg);
                __syncthreads(); RELAUNDER(); }
                for (int pr_ = 0; pr_ <= PR_CMP; ++pr_) { phase_attn<2, 2>(c, args, layer, proj, vtb, kcb, vctb, sel, nsaacc, obuf + (size_t)T * 512); __syncthreads(); } } PHASE_END
            PHASE_BEGIN(19) {
                phase_rwkv_scan<0>(c, rwu, rws);
                RELAUNDER();
                if (c.bid >= 32) { Ctx cv = c; cv.bid = c.bid - 32; cv.G = c.G - 32;
                    phase_attn<1, 2>(cv, args, layer, proj, vtb, kcb, vctb, sel, nsaacc, obuf + (size_t)T * 512);
                    asm volatile("" : "+v"(cv.tid), "+s"(cv.bid)); cv.lane = cv.tid & 63; cv.wave = __builtin_amdgcn_readfirstlane(cv.tid >> 6);
                    for (int pr_ = 0; pr_ <= PR_SWA; ++pr_) { phase_attn<0, 2>(cv, args, layer, proj, vtb, kcb, vctb, sel, nsaacc, obuf + (size_t)2 * T * 512); __syncthreads(); } } } PHASE_END
            PHASE_BEGIN(9) {
                phase_rwkv_out(c, args, layer, proj, rwu, rws, bonusg, obuf);
                __syncthreads(); RELAUNDER();
                for (int pr_ = 0; pr_ <= PR_SEL; ++pr_) { phase_attn<3, 2>(c, args, layer, proj, vtb, kcb, vctb, sel, nsaacc, obuf + (size_t)T * 512); __syncthreads(); } } PHASE_END
            PHASE_BEGIN(10) {
                pg8::Gemm g{obuf, wb + WB_WBR, 512, 512, 512}; pg8::Sched S; S.init(T / 256, D / 256, c.G, c.bid, 3, (size_t)256 * 512 * 2, (size_t)T * 512 * 2, (size_t)256 * 512 * 2, (size_t)D * 512 * 2);
                pg8::EpiMerge E{gates, merged}; pg8::gemm_phase(c.lds, c.tid, g, S, E); } PHASE_END
            PHASE_BEGIN(11) {
                pg8::Gemm g{merged, wb + WB_WOUT, D, D, D}; pg8::Sched S; S.init(T / 256, D / 256, c.G, c.bid, 1, (unsigned)256 * D * 2, 0, (unsigned)256 * D * 2, 0);
                pg8::EpiNorm E{xres, xb, inptr(c, I_NQM) + layer * D, ws, cntp, row0, 1, 16u * (2u * layer + 1u), c.lds, c.tid}; pg8::gemm_phase(c.lds, c.tid, g, S, E); } PHASE_END
        }
        PHASE_BEGIN(13) {
            pg8::Gemm g{xb, wb + WB_WGU, D, D, D}; pg8::Sched S; S.init(MROWS / 256, 2 * FFN / 256, c.G, c.bid, 1, (size_t)256 * D * 2, 0, (size_t)256 * D * 2, 0);
            pg8::EpiSwiGLU E{act, ws}; pg8::gemm_phase(c.lds, c.tid, g, S, E); } PHASE_END
        PHASE_BEGIN(14) {
            { pg8::Gemm g{act, wb + WB_WDN, FFN, FFN, FFN}; pg8::Sched S; S.init(T / 256, D / 256, c.G, c.bid, 1, (unsigned)256 * FFN * 2, 0, (unsigned)256 * FFN * 2, 0);
              pg8::EpiNorm E{xres, xb, inptr(c, I_NQF) + layer * D, ws, cntp, 0, 0, 16u * (2u * layer + 2u), c.lds, c.tid}; pg8::gemm_phase(c.lds, c.tid, g, S, E); }
            __syncthreads(); RELAUNDER();
            { pg8::Gemm g{act + (size_t)T * FFN, wb + WB_WDN, FFN, FFN, FFN}; pg8::Sched S; S.init(T / 256, D / 256, c.G, c.bid, 1, (unsigned)256 * FFN * 2, 0, (unsigned)256 * FFN * 2, 0);
              pg8::EpiNorm E{xres, xb, inptr(c, I_NQF) + layer * D, ws, cntp, T, 0, 16u * (2u * layer + 2u), c.lds, c.tid}; pg8::gemm_phase(c.lds, c.tid, g, S, E); } } PHASE_END
    }
#undef PHASE_BEGIN
#undef PHASE_END
}

extern "C" void kernel_launch(void* const* d_in, const int* in_sizes, int n_in, void* d_out, int out_size, void* d_ws, size_t ws_size, hipStream_t stream) {
    static int grid = 0;
    if (grid == 0) {
        if (n_in != 30 || out_size != MROWS * D || ws_size < WS_END) { fprintf(stderr, "kernel_launch: unexpected shapes (n_in %d out %d ws %zu)\n", n_in, out_size, ws_size); grid = -1; return; }
        int dev = 0, cus = 0;
        if (hipGetDevice(&dev) != hipSuccess || hipDeviceGetAttribute(&cus, hipDeviceAttributeMultiprocessorCount, dev) != hipSuccess) { grid = -1; return; }
        if (hipFuncSetAttribute((const void*)fwd_kernel, hipFuncAttributeMaxDynamicSharedMemorySize, LDS_BYTES) != hipSuccess) { fprintf(stderr, "hipFuncSetAttribute failed\n"); grid = -1; return; }
        int per_cu = 0;
        if (hipOccupancyMaxActiveBlocksPerMultiprocessor(&per_cu, (const void*)fwd_kernel, 512, LDS_BYTES) != hipSuccess || per_cu < 1) { fprintf(stderr, "occupancy query: %d\n", per_cu); }
        (void)hipGetLastError();
        grid = cus;
    }
    if (grid < 0) return;
    (void)hipMemsetAsync((char*)d_ws + WS_CTL, 0, CTL_BYTES, stream);
    Args a{};
    for (int i = 0; i < 30; ++i) a.in[i] = (const float*)d_in[i];
    a.out = (float*)d_out; a.ws = (unsigned char*)d_ws;
#if MK_ONE_LAUNCH
    a.lo = 0; a.hi = PH_TOTAL;
    hipLaunchKernelGGL(fwd_kernel, dim3(grid), dim3(512), LDS_BYTES, stream, a);
#else
    for (int p = 0; p < PH_TOTAL; ++p) { a.lo = p; a.hi = p + 1; hipLaunchKernelGGL(fwd_kernel, dim3(grid), dim3(512), LDS_BYTES, stream, a); }
#endif
}
```

```cpp
#include <hip/hip_runtime.h>
#include <stdint.h>
#include <stdio.h>

#ifndef MK_ONE_LAUNCH
#define MK_ONE_LAUNCH 1
#endif

#define LAS __attribute__((address_space(3)))
typedef unsigned short bf16_t;
typedef short bf16x8 __attribute__((ext_vector_type(8)));
typedef float f32x4 __attribute__((ext_vector_type(4)));
typedef float f32x2 __attribute__((ext_vector_type(2)));
typedef unsigned u32x4 __attribute__((ext_vector_type(4)));
typedef unsigned u32x2 __attribute__((ext_vector_type(2)));

constexpr int D = 1024, NBATCH = 2, T = 16384, DEPTH = 4, MROWS = NBATCH * T;
constexpr int IN_COLS = 6936, FFN = 2816;
constexpr int PLD = 4096;
constexpr int PC_R = 0, PC_K = 512, PC_V = 1024, PC_ZW = 1536, PC_ZA = 1600, PC_ZG = 1664;
constexpr int PC_NQ = 1792, PC_KC = 2304, PC_VC = 2432, PC_KS = 2560, PC_VS = 2688, PC_KW = 2816, PC_VW = 2944, PC_GL = 3072;
constexpr int PC_SQ = 3328, PC_SK = 3840, PC_SV = 3968;
constexpr int NIN = 7168;
constexpr int NCMP = 1023;
constexpr float NORM_EPS = 1e-6f;

constexpr size_t MiB = 1u << 20;
constexpr size_t WS_CTL = 0, CTL_BYTES = 65536;
constexpr size_t WS_WB = 65536;
constexpr size_t WB_WIN = 0, WB_WBR = WB_WIN + (size_t)NIN * D, WB_WOUT = WB_WBR + (size_t)3 * D * 512, WB_WGU = WB_WOUT + (size_t)D * D,
                 WB_WDN = WB_WGU + (size_t)2 * FFN * D, WB_LORA = WB_WDN + (size_t)D * FFN, WB_W1T = WB_LORA + (size_t)1536 * 256, WB_W2T = WB_W1T + (size_t)2 * 256 * 2048,
                 WB_BH = WB_W2T + (size_t)2 * 256 * 256, WB_END = WB_BH + 1024;
static_assert(WS_WB + WB_END * 2 <= 38 * MiB + 786432, "weights");
constexpr size_t KiB = 1024;
constexpr size_t WS_XB = 38 * MiB + 768 * KiB;
constexpr size_t WS_CNT = 16384;
constexpr size_t WS_RS = WS_XB + 64 * MiB;
constexpr size_t WS_BONUS = WS_RS + 128 * KiB;
constexpr size_t WS_KCB = WS_BONUS + 512 * KiB;
constexpr size_t WS_VCT = WS_KCB + 256 * KiB;
constexpr size_t WS_STATS = WS_VCT + 256 * KiB;
constexpr size_t WS_SEL = WS_STATS;
constexpr size_t WS_HID = WS_SEL + 1 * MiB;
constexpr size_t WS_ML = WS_HID;
static_assert(WS_HID + 2 * MiB <= 107 * MiB, "small region");
constexpr size_t WS_ALORA = 107 * MiB;
constexpr size_t WS_VT = 115 * MiB;
constexpr size_t WS_BIG = 127 * MiB;
constexpr size_t WS_PROJ = WS_BIG;
constexpr size_t WS_GATES = WS_PROJ + 128 * MiB;
constexpr size_t WS_RWKVS = WS_GATES + 96 * MiB;
constexpr size_t WS_RWU = WS_RWKVS;
constexpr size_t WS_RWS = WS_RWKVS + 64 * MiB;
constexpr size_t WS_SCORES = WS_RWKVS;
constexpr size_t WS_MERGED = WS_RWKVS;
constexpr size_t WS_TMPB = WS_RWKVS + 32 * MiB;
constexpr size_t WS_NSAACC = WS_RWKVS + 80 * MiB;
constexpr size_t WS_O = WS_NSAACC + 32 * MiB;
constexpr size_t WS_END = WS_O + 48 * MiB;
constexpr size_t WS_ACT = WS_BIG;
constexpr size_t WS_TMPF = WS_BIG + 176 * MiB;
static_assert(WS_END <= 512 * MiB, "workspace");
static_assert(WS_TMPF + 64 * MiB <= WS_NSAACC, "ffn overlay");

constexpr int LDS_BYTES = 147456;
constexpr int LDS_MISC = 131072 + 8192;

__device__ __forceinline__ float* statp(unsigned char* ws, int row, int kind) {
    return (float*)(ws + WS_STATS + (kind >= 2 ? 524288 : 0)) + (size_t)row * 4; }
__device__ __forceinline__ unsigned* selp(unsigned char* ws, int t, int g) { return (unsigned*)(ws + WS_PROJ + (size_t)t * (PLD * 2) + 6272 + g * 32); }
__device__ __forceinline__ float bf2f(unsigned v) { return __uint_as_float(v << 16); }
typedef __bf16 bf16n2 __attribute__((ext_vector_type(2)));
__device__ __forceinline__ unsigned pk2(float lo, float hi) { const f32x2 f = {lo, hi}; const bf16n2 v = __builtin_convertvector(f, bf16n2); return __builtin_bit_cast(unsigned, v); }
__device__ __forceinline__ unsigned f2bf(float f) { return pk2(f, 0.f) & 0xffffu; }
__device__ __forceinline__ void unpack8(const u32x4 w, float (&f)[8]) {
    f[0] = __uint_as_float(w.x << 16); f[1] = __uint_as_float(w.x & 0xffff0000u); f[2] = __uint_as_float(w.y << 16); f[3] = __uint_as_float(w.y & 0xffff0000u);
    f[4] = __uint_as_float(w.z << 16); f[5] = __uint_as_float(w.z & 0xffff0000u); f[6] = __uint_as_float(w.w << 16); f[7] = __uint_as_float(w.w & 0xffff0000u);
}
#define DPPF(v, ctrl) __int_as_float(__builtin_amdgcn_update_dpp(0, __float_as_int(v), (ctrl), 0xf, 0xf, false))
__device__ __forceinline__ float row16_sum(float v) {
    v += DPPF(v, 0xB1); v += DPPF(v, 0x4E); v += DPPF(v, 0x141); v += DPPF(v, 0x140); return v;
}
__device__ __forceinline__ float wave_sum(float v) {
    v = row16_sum(v);
    const int iv = __float_as_int(v);
    return (__int_as_float(__builtin_amdgcn_readlane(iv, 0)) + __int_as_float(__builtin_amdgcn_readlane(iv, 16))) + (__int_as_float(__builtin_amdgcn_readlane(iv, 32)) + __int_as_float(__builtin_amdgcn_readlane(iv, 48)));
}
__device__ __forceinline__ float dpp_xor1(float v) { return __int_as_float(__builtin_amdgcn_update_dpp(0, __float_as_int(v), 0xB1, 0xf, 0xf, false)); }
__device__ __forceinline__ float dpp_xor2(float v) { return __int_as_float(__builtin_amdgcn_update_dpp(0, __float_as_int(v), 0x4E, 0xf, 0xf, false)); }
__device__ __forceinline__ float sigmoidf_(float x) { return __builtin_amdgcn_rcpf(1.0f + __expf(-x)); }
__device__ __forceinline__ int t5_bucket(int n) {
    if (n < 16) return n;
    int b = 16;
    b += (n >= 21); b += (n >= 27); b += (n >= 35); b += (n >= 46); b += (n >= 59); b += (n >= 77); b += (n >= 99); b += (n >= 128);
    b += (n >= 166); b += (n >= 216); b += (n >= 280); b += (n >= 363); b += (n >= 470); b += (n >= 609); b += (n >= 790);
    return b;
}

#define XB_TMO      128
#define XB_XCNT(j)  (256  + 64 * (j))
#define XB_XSUB(j)  (1280 + 64 * (j))
#define XB_XGEN(j)  (2304 + 64 * (j))
#define XB_TOP      3328
#define XB_TOPGEN   3392
#define XCD_BAR_WORDS 3456
#define XB_SPIN_CAP (1u << 22)
__device__ __forceinline__ unsigned xb_ld(unsigned* p)              { return __hip_atomic_load(p, __ATOMIC_RELAXED, __HIP_MEMORY_SCOPE_AGENT); }
__device__ __forceinline__ unsigned xb_add(unsigned* p, unsigned v) { return __hip_atomic_fetch_add(p, v, __ATOMIC_RELAXED, __HIP_MEMORY_SCOPE_AGENT); }
__device__ __forceinline__ unsigned xb_xcc_id() { return (unsigned)__builtin_amdgcn_s_getreg((3 << 11) | 20) & 0xFu; }
#define XB_SPIN(cond, bar) do { unsigned _sp = 0; while (cond) { __builtin_amdgcn_s_sleep(1); \
    if ((++_sp & 255u) == 0u) { if (xb_ld(&(bar)[XB_TMO])) break; if (_sp > XB_SPIN_CAP) { atomicAdd(&(bar)[XB_TMO], 1u); break; } } } } while (0)
struct XcdBarrier { unsigned* bar; unsigned x; volatile LAS unsigned* st; };
__device__ __forceinline__ XcdBarrier xcd_barrier_post(unsigned* bar, volatile LAS unsigned* st) {
    XcdBarrier b; b.bar = bar; b.x = xb_xcc_id(); b.st = st;
    if (threadIdx.x == 0) (void)xb_add(&bar[XB_XCNT(b.x)], 1u);
    return b;
}
__device__ __forceinline__ void xcd_barrier_complete(unsigned* bar, unsigned x, unsigned& nloc, unsigned& nx) {
    const unsigned G = gridDim.x * gridDim.y * gridDim.z;
    unsigned sum, cnt, mine, sp = 0u;
    for (;;) {
        sum = 0u; cnt = 0u; mine = 0u;
#pragma unroll
        for (unsigned j = 0; j < 16; ++j) { const unsigned c = xb_ld(&bar[XB_XCNT(j)]); sum += c; cnt += (c > 0u) ? 1u : 0u; mine = (j == x) ? c : mine; }
        if (sum == G) break;
        __builtin_amdgcn_s_sleep(1);
        if ((++sp & 255u) == 0u) { if (xb_ld(&bar[XB_TMO])) break; if (sp > XB_SPIN_CAP) { atomicAdd(&bar[XB_TMO], 1u); break; } }
    }
    nloc = mine > 0u ? mine : 1u; nx = cnt > 0u ? cnt : 1u;
}
__device__ __forceinline__ void xcd_barrier(const XcdBarrier& b) {
    asm volatile("s_waitcnt vmcnt(0)" ::: "memory");
    __syncthreads();
    if (threadIdx.x == 0) {
        unsigned* bar = b.bar;
        __builtin_amdgcn_s_waitcnt(0);
        unsigned nloc = b.st[0], nx = b.st[1];
        if (nloc == 0u) { xcd_barrier_complete(bar, b.x, nloc, nx); b.st[0] = nloc; b.st[1] = nx; }
        const unsigned old = xb_add(&bar[XB_XSUB(b.x)], 1u);
        const unsigned gen = old / nloc;
        if (old + 1u == (gen + 1u) * nloc) {
            __builtin_amdgcn_fence(__ATOMIC_RELEASE, "agent");
            asm volatile("s_waitcnt vmcnt(0)" ::: "memory");
            const unsigned og = xb_add(&bar[XB_TOP], 1u);
            const unsigned tg = og / nx;
            if (og + 1u == (tg + 1u) * nx) xb_add(&bar[XB_TOPGEN], 1u);
            else XB_SPIN(xb_ld(&bar[XB_TOPGEN]) == tg, bar);
            __builtin_amdgcn_fence(__ATOMIC_ACQUIRE, "agent");
            xb_add(&bar[XB_XGEN(b.x)], 1u);
            asm volatile("s_waitcnt vmcnt(0)" ::: "memory");
        } else {
            XB_SPIN(xb_ld(&bar[XB_XGEN(b.x)]) == gen, bar);
            __builtin_amdgcn_fence(__ATOMIC_ACQUIRE, "agent");
            asm volatile("s_waitcnt vmcnt(0)" ::: "memory");
        }
    }
    __syncthreads();
}

namespace pg8 {
constexpr int BM = 256, BK = 64, HALF = 128, HTB = HALF * BK * 2, STAGE_BYTES = 8 * HTB, NXCD = 8, WGM = 8;
__device__ __forceinline__ int lds_byte(int r, int c) { const int st = (r >> 4) * 2 + (c >> 5), rr = r & 15, cc = c & 31, ob = rr * 64 + cc * 2; return st * 1024 + (ob ^ (((ob >> 9) & 1) << 5)); }
__device__ __forceinline__ void stage_rc(int b, int& R, int& C) { const int st = b / 1024, sb = b % 1024, swz = sb ^ (((sb >> 9) & 1) << 5); R = (st >> 1) * 16 + swz / 64; C = (st & 1) * 32 + (swz % 64) / 2; }
__device__ __forceinline__ int perm32(int rho) { const int n = rho >> 4, i = rho & 15; return 8 * (i >> 2) + 4 * n + (i & 3); }

template <class E, class = void> struct epi_after_drain { static constexpr bool value = false; };
template <class E> struct epi_after_drain<E, decltype((void)E::AFTER_DRAIN)> { static constexpr bool value = E::AFTER_DRAIN; };
struct Unit { int pm, pn, sub; unsigned aoff, boff; };
struct Gemm { const bf16_t* A; const bf16_t* Bt; int lda, ldb, K; unsigned kstepA = 128; };
struct Sched {
    int nM, nN, nwg, G, c, nsub, mode = 0; unsigned a_row, a_sub, b_row, b_sub;
    __device__ __forceinline__ void init(int nM_, int nN_, int G_, int c_, int nsub_, unsigned a_row_, unsigned a_sub_, unsigned b_row_, unsigned b_sub_) {
        nM = nM_; nN = nN_; nwg = nM * nN; G = G_; c = c_; nsub = nsub_; a_row = a_row_; a_sub = a_sub_; b_row = b_row_; b_sub = b_sub_; }
    __device__ __forceinline__ bool next(int i, Unit& u) const {
        const int round = i / nsub; u.sub = i - round * nsub;
        const long L = (long)round * G + c; if (L >= nwg) return false;
        int wgid = (int)L; { const int q = nwg / NXCD, r = nwg % NXCD, xcd = wgid % NXCD, off = wgid / NXCD; wgid = (xcd < r ? xcd * (q + 1) : r * (q + 1) + (xcd - r) * q) + off; }
        const int nig = WGM * nN, gid = wgid / nig, fm = gid * WGM, gsz = (nM - fm) < WGM ? (nM - fm) : WGM;
        u.pm = fm + ((wgid % nig) % gsz); u.pn = (wgid % nig) / gsz;
        u.aoff = (unsigned)u.pm * a_row + (unsigned)u.sub * a_sub; u.boff = (unsigned)u.pn * b_row + (unsigned)u.sub * b_sub;
        if (mode == 1) { const int kv = u.pm >> 3, g = (u.pm >> 2) & 1, cp = u.pm & 3;
            u.aoff = (unsigned)(((size_t)cp * 256 * 16 * PLD + (kv ? PC_VC : PC_KC) + g * 64) * 2); u.boff = (unsigned)kv * (256u * 2048u * 2u); }
        if (mode == 2) { const int kv = u.pm >> 3; u.boff = (unsigned)kv * (256u * 256u * 2u); }
        return true;
    }
};

template <class Epi>
__device__ __forceinline__ void gemm_phase(LAS unsigned char* lds, const int tid, const Gemm g, const Sched& S, const Epi& E) {
    const int wid = __builtin_amdgcn_readfirstlane(tid >> 6), lane = tid & 63, wr = wid >> 2, wc = wid & 3, fr = lane & 15, fq = lane >> 4;
    const int K = g.K, nt = K / BK;
    unsigned voffA[2], voffB[2];
#pragma unroll
    for (int i = 0; i < 2; ++i) { int R, C; stage_rc(tid * 16 + i * 8192, R, C); const int Rb = Epi::PERM ? ((R & ~31) + perm32(R & 31)) : R;
        voffA[i] = (unsigned)(R * g.lda + C) * 2u; voffB[i] = (unsigned)(Rb * g.ldb + C) * 2u; }
    const size_t kstep = (size_t)(BK * 2), kstA = g.kstepA;
    const size_t hstepA = (size_t)HALF * g.lda * 2, hstepB = (size_t)HALF * g.ldb * 2;
    const unsigned ldsw = (unsigned)wid * 1024u;
    const int aoff = lds_byte(wr * 64 + fr, fq * 8), boff = lds_byte(wc * 32 + fr, fq * 8);
#define PG8_SA(b, h) (((b) * 2 + (h)) * HTB)
#define PG8_SB(b, h) ((4 + (b) * 2 + (h)) * HTB)
#define PG8_STAGE(bufoff, gbase, voff) do { _Pragma("unroll") for (int _i = 0; _i < 2; ++_i) \
        __builtin_amdgcn_global_load_lds((const unsigned*)((const char*)(gbase) + (voff)[_i]), (LAS unsigned*)(lds + (bufoff) + ldsw + _i * 8192), 16, 0, 0); } while (0)
#define PG8_LDA(dst, b, h) do { _Pragma("unroll") for (int m = 0; m < 4; ++m) _Pragma("unroll") for (int k = 0; k < 2; ++k) dst[m][k] = *(const LAS bf16x8*)(lds + PG8_SA(b, h) + aoff + m * 2048 + k * 1024); } while (0)
#define PG8_LDB(dst, b, h) do { _Pragma("unroll") for (int n = 0; n < 2; ++n) _Pragma("unroll") for (int k = 0; k < 2; ++k) dst[n][k] = *(const LAS bf16x8*)(lds + PG8_SB(b, h) + boff + n * 2048 + k * 1024); } while (0)
#define PG8_MMA(ai, bj, At, Bt) do { __builtin_amdgcn_s_setprio(1); _Pragma("unroll") for (int m = 0; m < 4; ++m) _Pragma("unroll") for (int n = 0; n < 2; ++n) _Pragma("unroll") for (int k = 0; k < 2; ++k) \
        acc[ai][bj][m][n] = __builtin_amdgcn_mfma_f32_16x16x32_bf16(Bt[n][k], At[m][k], acc[ai][bj][m][n], 0, 0, 0); __builtin_amdgcn_s_setprio(0); } while (0)
#define PG8_WAIT_V(n) asm volatile("s_waitcnt vmcnt(" #n ")" ::: "memory")
#define PG8_WAIT_L(n) asm volatile("s_waitcnt lgkmcnt(" #n ")" ::: "memory")
#define PG8_BAR __builtin_amdgcn_s_barrier()
#define PG8_SCHED __builtin_amdgcn_sched_barrier(0)
    Unit cur, nxt; int ui = 0;
    if (!S.next(0, cur)) return;
    f32x4 acc[2][2][4][2];
#pragma unroll
    for (int a = 0; a < 2; ++a)
#pragma unroll
        for (int b = 0; b < 2; ++b)
#pragma unroll
            for (int m = 0; m < 4; ++m)
#pragma unroll
                for (int n = 0; n < 2; ++n) acc[a][b][m][n] = (f32x4){0.f, 0.f, 0.f, 0.f};
    bf16x8 At[4][2], B0[2][2], B1[2][2];
    const char* cA = (const char*)g.A + cur.aoff; const char* cB = (const char*)g.Bt + cur.boff;
    PG8_STAGE(PG8_SB(0, 0), cB, voffB); PG8_STAGE(PG8_SA(0, 0), cA, voffA); PG8_STAGE(PG8_SB(0, 1), cB + hstepB, voffB); PG8_STAGE(PG8_SA(0, 1), cA + hstepA, voffA);
    if (wr == 1) PG8_BAR;
    PG8_WAIT_V(4); PG8_BAR;
    PG8_STAGE(PG8_SB(1, 0), cB + kstep, voffB); PG8_STAGE(PG8_SA(1, 0), cA + kstA, voffA); PG8_STAGE(PG8_SB(1, 1), cB + hstepB + kstep, voffB);
    PG8_WAIT_V(6); PG8_BAR;
    for (;;) {
        const bool has_next = S.next(ui + 1, nxt);
        const char* nA = has_next ? (const char*)g.A + nxt.aoff : cA; const char* nB = has_next ? (const char*)g.Bt + nxt.boff : cB;
        for (int t = 0; t < nt; t += 2) {
            const bool last = (t == nt - 2);
            const char* a1 = cA + (size_t)(t + 1) * kstA;
            const char* a2 = last ? nA : cA + (size_t)(t + 2) * kstA; const char* b2 = last ? nB : cB + (size_t)(t + 2) * kstep;
            const char* a3 = a2 + kstA; const char* b3 = b2 + kstep;
            PG8_LDB(B0, 0, 0); PG8_SCHED; PG8_LDA(At, 0, 0); PG8_STAGE(PG8_SA(1, 1), a1 + hstepA, voffA);
            PG8_WAIT_L(8); PG8_BAR; PG8_WAIT_L(0); PG8_MMA(0, 0, At, B0); PG8_BAR; PG8_SCHED;
            PG8_LDB(B1, 0, 1); PG8_STAGE(PG8_SB(0, 0), b2, voffB);
            PG8_BAR; PG8_WAIT_L(0); PG8_MMA(0, 1, At, B1); PG8_BAR;
            PG8_LDA(At, 0, 1); PG8_STAGE(PG8_SA(0, 0), a2, voffA);
            PG8_BAR; PG8_WAIT_L(0); PG8_MMA(1, 0, At, B0); PG8_BAR; PG8_SCHED;
            PG8_STAGE(PG8_SB(0, 1), b2 + hstepB, voffB);
            PG8_WAIT_V(6); PG8_BAR; PG8_MMA(1, 1, At, B1); PG8_BAR;
            PG8_LDB(B0, 1, 0); PG8_SCHED; PG8_LDA(At, 1, 0); PG8_STAGE(PG8_SA(0, 1), a2 + hstepA, voffA);
            PG8_WAIT_L(8); PG8_BAR; PG8_WAIT_L(0); PG8_MMA(0, 0, At, B0); PG8_BAR; PG8_SCHED;
            PG8_LDB(B1, 1, 1); PG8_STAGE(PG8_SB(1, 0), b3, voffB);
            PG8_BAR; PG8_WAIT_L(0); PG8_MMA(0, 1, At, B1); PG8_BAR;
            PG8_LDA(At, 1, 1); PG8_STAGE(PG8_SA(1, 0), a3, voffA);
            PG8_BAR; PG8_WAIT_L(0); PG8_MMA(1, 0, At, B0); PG8_BAR; PG8_SCHED;
            PG8_STAGE(PG8_SB(1, 1), b3 + hstepB, voffB);
            PG8_WAIT_V(6); PG8_BAR; PG8_MMA(1, 1, At, B1); PG8_BAR;
        }
        bool keep = false;
        if constexpr (!epi_after_drain<Epi>::value) keep = E(acc, cur, wr, wc, fr, fq);
        if (!has_next) break;
        if (!keep) {
#pragma unroll
            for (int a = 0; a < 2; ++a)
#pragma unroll
                for (int b = 0; b < 2; ++b)
#pragma unroll
                    for (int m = 0; m < 4; ++m)
#pragma unroll
                        for (int n = 0; n < 2; ++n) acc[a][b][m][n] = (f32x4){0.f, 0.f, 0.f, 0.f};
        }
        cur = nxt; cA = nA; cB = nB; ++ui;
    }
    PG8_WAIT_V(0);
    if (wr == 0) PG8_BAR;
    PG8_BAR;
    if constexpr (epi_after_drain<Epi>::value) (void)E(acc, cur, wr, wc, fr, fq);
#undef PG8_SA
#undef PG8_SB
#undef PG8_STAGE
#undef PG8_LDA
#undef PG8_LDB
#undef PG8_MMA
#undef PG8_WAIT_V
#undef PG8_WAIT_L
#undef PG8_BAR
#undef PG8_SCHED
}

struct EpiInProj {
    static constexpr bool PERM = true;
    bf16_t* proj; bf16_t* gates; unsigned char* ws; int row_base;
    __device__ __forceinline__ bool operator()(f32x4 (&acc)[2][2][4][2], const Unit& u, int wr, int wc, int fr, int fq) const {
        const int row0 = u.pm * BM + wr * 64 + fr; const bool is_gate = u.pn >= 16;
        bf16_t* base = is_gate ? gates + (u.pn - 16) * 256 : proj + u.pn * 256; const int ld = is_gate ? 3072 : PLD;
        const int col0 = wc * 32 + 8 * fq;
#pragma unroll
        for (int ai = 0; ai < 2; ++ai)
#pragma unroll
            for (int m = 0; m < 4; ++m) { const int row = row0 + ai * HALF + m * 16; const f32x4 pq = *(const f32x4*)statp(ws, row_base + row, 0);
                const float s = rsqrtf(((pq[0] + pq[1]) + (pq[2] + pq[3])) * (1.0f / D) + NORM_EPS); bf16_t* rowp = base + (size_t)row * ld + col0;
#pragma unroll
                for (int bj = 0; bj < 2; ++bj) { f32x4 v0 = acc[ai][bj][m][0] * s, v1 = acc[ai][bj][m][1] * s;
                    if (is_gate) {
#pragma unroll
                        for (int j = 0; j < 4; ++j) { v0[j] = sigmoidf_(v0[j]); v1[j] = sigmoidf_(v1[j]); } }
                    u32x4 w; w.x = pk2(v0[0], v0[1]); w.y = pk2(v0[2], v0[3]); w.z = pk2(v1[0], v1[1]); w.w = pk2(v1[2], v1[3]);
                    if (u.pn != 12 || col0 + bj * HALF < 64) *(u32x4*)(rowp + bj * HALF) = w; } }
        return false;
    }
};
struct EpiStore {
    static constexpr bool PERM = true;
    bf16_t* out; int ld;
    __device__ __forceinline__ bool operator()(f32x4 (&acc)[2][2][4][2], const Unit& u, int wr, int wc, int fr, int fq) const {
        const int row0 = u.pm * BM + wr * 64 + fr; const int col0 = u.pn * BM + wc * 32 + 8 * fq;
#pragma unroll
        for (int ai = 0; ai < 2; ++ai)
#pragma unroll
            for (int m = 0; m < 4; ++m) { bf16_t* rowp = out + (size_t)(row0 + ai * HALF + m * 16) * ld + col0;
#pragma unroll
                for (int bj = 0; bj < 2; ++bj) { const f32x4 v0 = acc[ai][bj][m][0], v1 = acc[ai][bj][m][1];
                    u32x4 w; w.x = pk2(v0[0], v0[1]); w.y = pk2(v0[2], v0[3]); w.z = pk2(v1[0], v1[1]); w.w = pk2(v1[2], v1[3]);
                    *(u32x4*)(rowp + bj * HALF) = w; } }
        return false;
    }
};
struct EpiCmp1 {
    static constexpr bool PERM = true;
    bf16_t* hid; const float* bh;
    __device__ __forceinline__ bool operator()(f32x4 (&acc)[2][2][4][2], const Unit& u, int wr, int wc, int fr, int fq) const {
        const int kv = u.pm >> 3; const int row0 = (u.pm & 7) * BM + wr * 64 + fr; const int col0 = wc * 32 + 8 * fq;
#pragma unroll
        for (int ai = 0; ai < 2; ++ai)
#pragma unroll
            for (int m = 0; m < 4; ++m) { bf16_t* rowp = hid + ((size_t)kv * 2048 + row0 + ai * HALF + m * 16) * 256 + col0;
#pragma unroll
                for (int bj = 0; bj < 2; ++bj) { float o[8];
#pragma unroll
                    for (int j = 0; j < 8; ++j) { const float x = acc[ai][bj][m][j >> 2][j & 3] + bh[kv * 256 + col0 + bj * HALF + j];
                        o[j] = x * sigmoidf_(1.5957691216f * (x + 0.044715f * x * x * x)); }
                    u32x4 w; w.x = pk2(o[0], o[1]); w.y = pk2(o[2], o[3]); w.z = pk2(o[4], o[5]); w.w = pk2(o[6], o[7]);
                    *(u32x4*)(rowp + bj * HALF) = w; } }
        return false;
    }
};
struct EpiCmp2 {
    static constexpr bool PERM = true;
    bf16_t* kcb; bf16_t* vct;
    __device__ __forceinline__ bool operator()(f32x4 (&acc)[2][2][4][2], const Unit& u, int wr, int wc, int fr, int fq) const {
        const int kv = u.pm >> 3; const int row0 = (u.pm & 7) * BM + wr * 64 + fr; const int col0 = wc * 32 + 8 * fq;
        if (col0 >= 64) return false;
#pragma unroll
        for (int ai = 0; ai < 2; ++ai)
#pragma unroll
            for (int m = 0; m < 4; ++m) { const int row = row0 + ai * HALF + m * 16, g = row >> 10, cc = row & 1023; const bool zr = cc == 1023; const f32x4 zz = (f32x4){0.f, 0.f, 0.f, 0.f};
                const f32x4 v0 = zr ? zz : acc[ai][0][m][0], v1 = zr ? zz : acc[ai][0][m][1];
                if (kv == 0) { u32x4 w; w.x = pk2(v0[0], v0[1]); w.y = pk2(v0[2], v0[3]); w.z = pk2(v1[0], v1[1]); w.w = pk2(v1[2], v1[3]); *(u32x4*)(kcb + ((size_t)g * 1024 + cc) * 64 + col0) = w; }
                else {
#pragma unroll
                    for (int j = 0; j < 4; ++j) { vct[((size_t)g * 64 + col0 + j) * 1024 + cc] = (bf16_t)f2bf(v0[j]); vct[((size_t)g * 64 + col0 + 4 + j) * 1024 + cc] = (bf16_t)f2bf(v1[j]); } } }
        return false;
    }
};
struct EpiLora {
    static constexpr bool PERM = true;
    bf16_t* obuf;
    __device__ __forceinline__ bool operator()(f32x4 (&acc)[2][2][4][2], const Unit& u, int wr, int wc, int fr, int fq) const {
        const int sel = u.pn >> 1; bf16_t* out = obuf + (size_t)(sel == 2 ? 0 : sel + 1) * T * 512;
        const int row0 = u.pm * BM + wr * 64 + fr; const int col0 = (u.pn & 1) * BM + wc * 32 + 8 * fq;
#pragma unroll
        for (int ai = 0; ai < 2; ++ai)
#pragma unroll
            for (int m = 0; m < 4; ++m) { bf16_t* rowp = out + (size_t)(row0 + ai * HALF + m * 16) * 512 + col0;
#pragma unroll
                for (int bj = 0; bj < 2; ++bj) { const f32x4 v0 = acc[ai][bj][m][0], v1 = acc[ai][bj][m][1];
                    u32x4 w; w.x = pk2(v0[0], v0[1]); w.y = pk2(v0[2], v0[3]); w.z = pk2(v1[0], v1[1]); w.w = pk2(v1[2], v1[3]);
                    *(u32x4*)(rowp + bj * HALF) = w; } }
        return false;
    }
};
struct EpiMerge {
    static constexpr bool PERM = true;
    const bf16_t* gates; bf16_t* merged;
    __device__ __forceinline__ bool operator()(f32x4 (&acc)[2][2][4][2], const Unit& u, int wr, int wc, int fr, int fq) const {
        const int row0 = u.pm * BM + wr * 64 + fr; const int col0 = u.pn * BM + wc * 32 + 8 * fq; const int sub = u.sub;
#pragma unroll
        for (int ai = 0; ai < 2; ++ai)
#pragma unroll
            for (int m = 0; m < 4; ++m) { const int row = row0 + ai * HALF + m * 16; const bf16_t* gp = gates + (size_t)row * 3072 + sub * 1024 + col0;
#pragma unroll
                for (int bj = 0; bj < 2; ++bj) {
                    float sc[8], sn[8]; unpack8(*(const u32x4*)(gp + bj * HALF), sc);
                    if (sub < 2) { unpack8(*(const u32x4*)(gp + 1024 + bj * HALF), sn);
#pragma unroll
                        for (int j = 0; j < 8; ++j) sc[j] = sc[j] * __builtin_amdgcn_rcpf(fmaxf(sn[j], 1e-30f)); }
                    f32x4 v0 = acc[ai][bj][m][0], v1 = acc[ai][bj][m][1];
#pragma unroll
                    for (int j = 0; j < 4; ++j) { v0[j] *= sc[j]; v1[j] *= sc[4 + j]; }
                    acc[ai][bj][m][0] = v0; acc[ai][bj][m][1] = v1;
                    if (sub == 2) { u32x4 w; w.x = pk2(v0[0], v0[1]); w.y = pk2(v0[2], v0[3]); w.z = pk2(v1[0], v1[1]); w.w = pk2(v1[2], v1[3]);
                        *(u32x4*)(merged + (size_t)row * D + col0 + bj * HALF) = w; } } }
        return sub != 2;
    }
};
struct EpiNorm {
    static constexpr bool PERM = true, AFTER_DRAIN = true;
    float* x; bf16_t* xb; const float* gain; unsigned char* ws; unsigned* cnt; int row_base, kind_next; unsigned target; LAS unsigned char* lds; int tid;
    __device__ __forceinline__ bool operator()(f32x4 (&acc)[2][2][4][2], const Unit& u, int wr, int wc, int fr, int fq) const {
        LAS float* P = (LAS float*)lds; LAS float* S = (LAS float*)(lds + 16384);
        const int lane = tid & 63, wid = __builtin_amdgcn_readfirstlane(tid >> 6);
        const int prow = row_base + u.pm * BM;
        const int col0 = u.pn * BM + wc * 32 + 8 * fq;
#pragma unroll
        for (int ai = 0; ai < 2; ++ai)
#pragma unroll
            for (int m = 0; m < 4; ++m) { float ps = 0.f;
#pragma unroll
                for (int bj = 0; bj < 2; ++bj) { const f32x4 v0 = acc[ai][bj][m][0], v1 = acc[ai][bj][m][1];
                    ps += (v0[0] * v0[0] + v0[1] * v0[1]) + (v0[2] * v0[2] + v0[3] * v0[3]) + (v1[0] * v1[0] + v1[1] * v1[1]) + (v1[2] * v1[2] + v1[3] * v1[3]); }
                P[(ai * HALF + wr * 64 + m * 16 + fr) * 16 + wc * 4 + fq] = ps; }
        asm volatile("s_waitcnt lgkmcnt(0)" ::: "memory"); __builtin_amdgcn_s_barrier(); asm volatile("" ::: "memory");
        if (tid < 256) { const f32x4 a0 = *(const LAS f32x4*)(P + tid * 16), a1 = *(const LAS f32x4*)(P + tid * 16 + 4), a2 = *(const LAS f32x4*)(P + tid * 16 + 8), a3 = *(const LAS f32x4*)(P + tid * 16 + 12);
            const float sm = (((a0[0] + a0[1]) + (a0[2] + a0[3])) + ((a1[0] + a1[1]) + (a1[2] + a1[3]))) + (((a2[0] + a2[1]) + (a2[2] + a2[3])) + ((a3[0] + a3[1]) + (a3[2] + a3[3])));
            __hip_atomic_store(statp(ws, prow + tid, 1 + (int)(target >> 4)) + u.pn, sm, __ATOMIC_RELAXED, __HIP_MEMORY_SCOPE_AGENT); }
        asm volatile("s_waitcnt vmcnt(0)" ::: "memory");
        unsigned* pcnt = cnt + 16 * (prow >> 8);
        if (tid < 256 && lane == 0) (void)__hip_atomic_fetch_add(pcnt, 1u, __ATOMIC_RELAXED, __HIP_MEMORY_SCOPE_AGENT);
        if (wid == 0) { unsigned spins = 0; while ((unsigned)__builtin_amdgcn_readfirstlane(__hip_atomic_load(pcnt, __ATOMIC_RELAXED, __HIP_MEMORY_SCOPE_AGENT)) < target) { __builtin_amdgcn_s_sleep(1); if (++spins > (1u << 20)) break; }
            __builtin_amdgcn_fence(__ATOMIC_ACQUIRE, "agent"); }
        asm volatile("s_waitcnt vmcnt(0) lgkmcnt(0)" ::: "memory"); __builtin_amdgcn_s_barrier(); asm volatile("" ::: "memory");
        if (tid < 256) { float* sp = statp(ws, prow + tid, 1 + (int)(target >> 4));
            const float t0 = __hip_atomic_load(sp, __ATOMIC_RELAXED, __HIP_MEMORY_SCOPE_AGENT), t1 = __hip_atomic_load(sp + 1, __ATOMIC_RELAXED, __HIP_MEMORY_SCOPE_AGENT),
                        t2 = __hip_atomic_load(sp + 2, __ATOMIC_RELAXED, __HIP_MEMORY_SCOPE_AGENT), t3 = __hip_atomic_load(sp + 3, __ATOMIC_RELAXED, __HIP_MEMORY_SCOPE_AGENT);
            S[tid] = rsqrtf(((t0 + t1) + (t2 + t3)) * (1.0f / D) + NORM_EPS); }
        asm volatile("s_waitcnt lgkmcnt(0)" ::: "memory"); __builtin_amdgcn_s_barrier(); asm volatile("" ::: "memory");
#pragma unroll
        for (int ai = 0; ai < 2; ++ai)
#pragma unroll
            for (int m = 0; m < 4; ++m) { const int rl = ai * HALF + wr * 64 + m * 16 + fr; const int row = prow + rl; const float rstd = S[rl]; float qs = 0.f;
#pragma unroll
                for (int bj = 0; bj < 2; ++bj) { const int col = col0 + bj * HALF; float* xp = x + (size_t)row * D + col; u32x4 w;
                    { f32x4 xa = *(const f32x4*)xp; const f32x4 ga = *(const f32x4*)(gain + col); xa += acc[ai][bj][m][0] * rstd * ga; *(f32x4*)xp = xa;
                      w.x = pk2(xa[0], xa[1]); w.y = pk2(xa[2], xa[3]); qs += (xa[0] * xa[0] + xa[1] * xa[1]) + (xa[2] * xa[2] + xa[3] * xa[3]); }
                    { f32x4 xc = *(const f32x4*)(xp + 4); const f32x4 gc = *(const f32x4*)(gain + col + 4); xc += acc[ai][bj][m][1] * rstd * gc; *(f32x4*)(xp + 4) = xc;
                      w.z = pk2(xc[0], xc[1]); w.w = pk2(xc[2], xc[3]); qs += (xc[0] * xc[0] + xc[1] * xc[1]) + (xc[2] * xc[2] + xc[3] * xc[3]); }
                    *(u32x4*)(xb + (size_t)row * D + col) = w; }
                P[rl * 16 + wc * 4 + fq] = qs; }
        asm volatile("s_waitcnt lgkmcnt(0)" ::: "memory"); __builtin_amdgcn_s_barrier(); asm volatile("" ::: "memory");
        if (tid < 256) { const f32x4 a0 = *(const LAS f32x4*)(P + tid * 16), a1 = *(const LAS f32x4*)(P + tid * 16 + 4), a2 = *(const LAS f32x4*)(P + tid * 16 + 8), a3 = *(const LAS f32x4*)(P + tid * 16 + 12);
            const float sm = (((a0[0] + a0[1]) + (a0[2] + a0[3])) + ((a1[0] + a1[1]) + (a1[2] + a1[3]))) + (((a2[0] + a2[1]) + (a2[2] + a2[3])) + ((a3[0] + a3[1]) + (a3[2] + a3[3])));
            __hip_atomic_store(statp(ws, prow + tid, kind_next) + u.pn, sm, __ATOMIC_RELAXED, __HIP_MEMORY_SCOPE_AGENT); }
        return false;
    }
};
struct EpiSwiGLU {
    static constexpr bool PERM = true;
    bf16_t* act; unsigned char* ws;
    __device__ __forceinline__ bool operator()(f32x4 (&acc)[2][2][4][2], const Unit& u, int wr, int wc, int fr, int fq) const {
        const int row0 = u.pm * BM + wr * 64 + fr; const int col0 = u.pn * HALF + wc * 32 + 8 * fq;
#pragma unroll
        for (int ai = 0; ai < 2; ++ai)
#pragma unroll
            for (int m = 0; m < 4; ++m) { const int row = row0 + ai * HALF + m * 16; const f32x4 pq = *(const f32x4*)statp(ws, row, 1);
                const float s = rsqrtf(((pq[0] + pq[1]) + (pq[2] + pq[3])) * (1.0f / D) + NORM_EPS);
                float o[8];
#pragma unroll
                for (int n = 0; n < 2; ++n)
#pragma unroll
                    for (int j = 0; j < 4; ++j) { const float gg = acc[ai][0][m][n][j] * s, uu = acc[ai][1][m][n][j] * s; o[n * 4 + j] = gg * sigmoidf_(gg) * uu; }
                u32x4 w; w.x = pk2(o[0], o[1]); w.y = pk2(o[2], o[3]); w.z = pk2(o[4], o[5]); w.w = pk2(o[6], o[7]);
                *(u32x4*)(act + (size_t)row * FFN + col0) = w; }
        return false;
    }
};
}

struct Args { const float* in[30]; float* out; unsigned char* ws; int lo, hi; };
enum { I_X = 0, I_NPM, I_NQM, I_NPF, I_NQF, I_WIN, I_MU, I_W0, I_W2, I_A0, I_A2, I_G2, I_KK, I_KA, I_RK, I_LNW, I_LNB, I_PEK, I_PEV, I_CKW1, I_CKW2, I_CVW1, I_CVW2, I_SINK, I_REL, I_WBR, I_WOUT, I_FG, I_FU, I_FD };

struct Ctx { LAS unsigned char* lds; int tid, lane, wave, G, bid; };
__device__ __forceinline__ const float* inptr(const Ctx& c, int i) {
    const volatile LAS unsigned* t = (const volatile LAS unsigned*)(c.lds + LDS_MISC + 64) + 2 * i;
    const unsigned lo = __builtin_amdgcn_readfirstlane(t[0]), hi = __builtin_amdgcn_readfirstlane(t[1]);
    return (const float*)(((unsigned long long)hi << 32) | lo);
}

__device__ __forceinline__ void phase_init(const Ctx& c, const float* x, float* xo, bf16_t* xb, unsigned char* wsb) {
    const int gw = c.bid * 8 + c.wave, NGW = c.G * 8;
    for (int row = gw; row < MROWS; row += NGW) {
        const float* xr = x + (size_t)row * D; float ss = 0.f;
#pragma unroll
        for (int j = 0; j < 2; ++j) { const int e = c.lane * 8 + 512 * j; const f32x4 a = *(const f32x4*)(xr + e), b = *(const f32x4*)(xr + e + 4);
            ss += a[0] * a[0] + a[1] * a[1] + a[2] * a[2] + a[3] * a[3] + b[0] * b[0] + b[1] * b[1] + b[2] * b[2] + b[3] * b[3];
            *(f32x4*)(xo + (size_t)row * D + e) = a; *(f32x4*)(xo + (size_t)row * D + e + 4) = b;
            u32x4 w; w.x = pk2(a[0], a[1]); w.y = pk2(a[2], a[3]); w.z = pk2(b[0], b[1]); w.w = pk2(b[2], b[3]); *(u32x4*)(xb + (size_t)row * D + e) = w; }
        ss = wave_sum(ss);
        if (c.lane < 4) __hip_atomic_store(statp(wsb, row, 0) + c.lane, c.lane == 0 ? ss : 0.f, __ATOMIC_RELAXED, __HIP_MEMORY_SCOPE_AGENT);
    }
}
__device__ __forceinline__ void phase_norm_res(const Ctx& c, const bf16_t* y, const float* gain, float* x, bf16_t* xb, float* rs, int row0, int nrows) {
    const int gw = c.bid * 8 + c.wave, NGW = c.G * 8;
    for (int r = gw; r < nrows; r += NGW) {
        const int row = row0 + r; float yv[16]; float ss = 0.f;
#pragma unroll
        for (int j = 0; j < 2; ++j) { float f[8]; unpack8(*(const u32x4*)(y + (size_t)r * D + c.lane * 8 + 512 * j), f);
#pragma unroll
            for (int k = 0; k < 8; ++k) { yv[j * 8 + k] = f[k]; ss += f[k] * f[k]; } }
        ss = wave_sum(ss); const float sc = rsqrtf(ss * (1.0f / D) + NORM_EPS); float s2 = 0.f;
#pragma unroll
        for (int j = 0; j < 2; ++j) { const int e = c.lane * 8 + 512 * j; float* xr = x + (size_t)row * D + e;
            f32x4 a = *(const f32x4*)xr, b = *(const f32x4*)(xr + 4); const f32x4 ga = *(const f32x4*)(gain + e), gb = *(const f32x4*)(gain + e + 4);
#pragma unroll
            for (int k = 0; k < 4; ++k) { a[k] += yv[j * 8 + k] * sc * ga[k]; b[k] += yv[j * 8 + 4 + k] * sc * gb[k]; s2 += a[k] * a[k] + b[k] * b[k]; }
            *(f32x4*)xr = a; *(f32x4*)(xr + 4) = b;
            u32x4 w; w.x = pk2(a[0], a[1]); w.y = pk2(a[2], a[3]); w.z = pk2(b[0], b[1]); w.w = pk2(b[2], b[3]); *(u32x4*)(xb + (size_t)row * D + e) = w; }
        s2 = wave_sum(s2);
        if (c.lane == 0) rs[row] = rsqrtf(s2 * (1.0f / D) + NORM_EPS);
    }
}

struct CvtTile { const float* src; const float* gain; bf16_t* dst; int ld, nvalid, K, k0, n0; float extra; bool kvalid; };
__device__ __forceinline__ CvtTile cvt_describe(const Ctx& c, int layer, bf16_t* wb, int it) {
    constexpr int I0 = 16 * 112, I1 = 3 * 8 * 16, I2 = 16 * 16, I3 = 16 * 88, I4 = 44 * 16, I5 = 4 * 24, I6 = 2 * 32 * 4;
    int r = it, kind, sub = 0, K, nblk; bf16_t* dst;
    if (r < I0) { kind = 0; K = D; nblk = 112; dst = wb + WB_WIN; }
    else if ((r -= I0) < I1) { kind = 1; sub = r / 128; r -= sub * 128; K = 512; nblk = 16; dst = wb + WB_WBR + (size_t)sub * D * 512; }
    else if ((r -= I1) < I2) { kind = 2; K = D; nblk = 16; dst = wb + WB_WOUT; }
    else if ((r -= I2) < I3) { kind = 3; K = D; nblk = 88; dst = wb + WB_WGU; }
    else if ((r -= I3) < I4) { kind = 4; K = FFN; nblk = 16; dst = wb + WB_WDN; }
    else if ((r -= I4) < I5) { kind = 5; K = 256; nblk = 24; dst = wb + WB_LORA; }
    else if ((r -= I5) < I6) { kind = 6; sub = r / 128; r -= sub * 128; K = 2048; nblk = 4; dst = wb + WB_W1T + (size_t)sub * 256 * 2048; }
    else { r -= I6; kind = 7; sub = r / 16; r -= sub * 16; K = 256; nblk = 4; dst = wb + WB_W2T + (size_t)sub * 256 * 256; }
    const int kb = r / nblk, nb = r % nblk, k0 = kb * 64, n0 = nb * 64;
    CvtTile t; t.src = nullptr; t.gain = nullptr; t.dst = dst; t.ld = 0; t.nvalid = 64; t.K = K; t.k0 = k0; t.n0 = n0; t.extra = 1.f; t.kvalid = true;
    switch (kind) {
    case 0: { t.gain = inptr(c, I_NPM) + layer * D + k0; t.ld = IN_COLS;
        const int scol = n0 < 3096 ? n0 : n0 - 232; t.nvalid = (n0 < 3096) ? (3096 - n0 < 64 ? 3096 - n0 : 64) : (n0 < 3328 ? 0 : 64);
        if ((n0 >= PC_NQ && n0 < PC_NQ + 512) || (n0 >= PC_SQ && n0 < PC_SQ + 512)) t.extra = 0.125f;
        t.src = inptr(c, I_WIN) + ((size_t)layer * D + k0) * IN_COLS + scol; break; }
    case 1: t.src = inptr(c, I_WBR) + (((size_t)layer * 3 + sub) * 512 + k0) * D + n0; t.ld = D; break;
    case 2: t.src = inptr(c, I_WOUT) + ((size_t)layer * D + k0) * D + n0; t.ld = D; break;
    case 3: { t.gain = inptr(c, I_NPF) + layer * D + k0; t.ld = FFN; const int pn = n0 >> 8, rr = n0 & 255;
        t.src = inptr(c, rr < 128 ? I_FG : I_FU) + ((size_t)layer * D + k0) * FFN + pn * 128 + (rr & 127); break; }
    case 4: t.src = inptr(c, I_FD) + ((size_t)layer * FFN + k0) * D + n0; t.ld = D; break;
    case 5: { t.ld = 512;
        if (n0 < 512) { t.kvalid = k0 < 64; t.src = inptr(c, I_W2) + ((size_t)layer * 64 + k0) * 512 + n0; }
        else if (n0 < 1024) { t.kvalid = (k0 == 64); t.src = inptr(c, I_A2) + ((size_t)layer * 64 + (k0 - 64)) * 512 + n0 - 512; }
        else { t.kvalid = k0 >= 128; t.src = inptr(c, I_G2) + ((size_t)layer * 128 + (k0 - 128)) * 512 + n0 - 1024; }
        break; }
    case 6: t.src = inptr(c, sub ? I_CVW1 : I_CKW1) + ((size_t)layer * 2048 + k0) * 256 + n0; t.ld = 256; break;
    default: t.src = inptr(c, sub ? I_CVW2 : I_CKW2) + ((size_t)layer * 256 + k0) * 64 + n0; t.ld = 64; t.nvalid = n0 < 64 ? 64 : 0; break;
    }
    return t;
}
__device__ __forceinline__ void phase_cvt(const Ctx& c, const Args& a, int layer, bf16_t* wb) {
    LAS float* tile = (LAS float*)c.lds;
    constexpr int NIT = 16 * 112 + 3 * 8 * 16 + 16 * 16 + 16 * 88 + 44 * 16 + 4 * 24 + 2 * 32 * 4 + 2 * 4 * 4;
    for (int it = c.bid; it < NIT; it += 2 * c.G) {
        const int it2 = it + c.G; const bool two = it2 < NIT;
        const CvtTile t0 = cvt_describe(c, layer, wb, it), t1 = cvt_describe(c, layer, wb, two ? it2 : it);
        float v0[8], v1[8];
#pragma unroll
        for (int i = 0; i < 8; ++i) { const int e = c.tid + 512 * i, kk = e >> 6, nn = e & 63;
            v0[i] = (t0.kvalid && nn < t0.nvalid) ? t0.src[(size_t)kk * t0.ld + nn] : 0.f;
            v1[i] = (two && t1.kvalid && nn < t1.nvalid) ? t1.src[(size_t)kk * t1.ld + nn] : 0.f; }
#pragma unroll
        for (int i = 0; i < 8; ++i) { const int e = c.tid + 512 * i, kk = e >> 6, nn = e & 63;
            tile[kk * 65 + nn] = v0[i] * t0.extra * (t0.gain ? t0.gain[kk] : 1.f); tile[4160 + kk * 65 + nn] = v1[i] * t1.extra * (t1.gain ? t1.gain[kk] : 1.f); }
        __syncthreads();
        { const int nn = c.tid >> 3, kc = (c.tid & 7) * 8; u32x4 w;
          w.x = pk2(tile[(kc + 0) * 65 + nn], tile[(kc + 1) * 65 + nn]); w.y = pk2(tile[(kc + 2) * 65 + nn], tile[(kc + 3) * 65 + nn]);
          w.z = pk2(tile[(kc + 4) * 65 + nn], tile[(kc + 5) * 65 + nn]); w.w = pk2(tile[(kc + 6) * 65 + nn], tile[(kc + 7) * 65 + nn]);
          *(u32x4*)(t0.dst + (size_t)(t0.n0 + nn) * t0.K + t0.k0 + kc) = w;
          if (two) { const LAS float* tl = tile + 4160;
            w.x = pk2(tl[(kc + 0) * 65 + nn], tl[(kc + 1) * 65 + nn]); w.y = pk2(tl[(kc + 2) * 65 + nn], tl[(kc + 3) * 65 + nn]);
            w.z = pk2(tl[(kc + 4) * 65 + nn], tl[(kc + 5) * 65 + nn]); w.w = pk2(tl[(kc + 6) * 65 + nn], tl[(kc + 7) * 65 + nn]);
            *(u32x4*)(t1.dst + (size_t)(t1.n0 + nn) * t1.K + t1.k0 + kc) = w; } }
        __syncthreads();
    }
    if (c.bid == c.G - 1) {
        const int kv = c.tid >> 8, u = c.tid & 255; const float* w1 = inptr(c, kv ? I_CVW1 : I_CKW1) + (size_t)layer * 2048 * 256; const float* pe = inptr(c, kv ? I_PEV : I_PEK) + (size_t)layer * 2048;
        float acc = 0.f; for (int k = 0; k < 2048; ++k) acc += pe[k] * w1[(size_t)k * 256 + u];
        ((float*)(wb + WB_BH))[c.tid] = acc;
    }
}

struct RowState { float q[64]; float o[64]; float m, l; };
__device__ __forceinline__ void row_init(RowState& s, const bf16_t* qp) {
#pragma unroll
    for (int i = 0; i < 8; ++i) { float f[8]; unpack8(*(const u32x4*)(qp + i * 8), f);
#pragma unroll
        for (int k = 0; k < 8; ++k) s.q[i * 8 + k] = f[k]; }
}
__device__ __forceinline__ void row_reset(RowState& s) {
#pragma unroll
    for (int i = 0; i < 64; ++i) s.o[i] = 0.f;
    s.m = -1e30f; s.l = 0.f;
}
__device__ __forceinline__ void row_key_bf16(RowState& s, const bf16_t* kp, const bf16_t* vp, float bias) {
    float sc = bias;
#pragma unroll
    for (int i = 0; i < 8; ++i) { float f[8]; unpack8(*(const u32x4*)(kp + i * 8), f);
#pragma unroll
        for (int k = 0; k < 8; ++k) sc += s.q[i * 8 + k] * f[k];
        if ((i & 1) == 1) __builtin_amdgcn_sched_barrier(0); }
    const float mn = fmaxf(s.m, sc), corr = __expf(s.m - mn), p = __expf(sc - mn);
    s.l = s.l * corr + p; s.m = mn;
#pragma unroll
    for (int i = 0; i < 8; ++i) { float f[8]; unpack8(*(const u32x4*)(vp + i * 8), f);
#pragma unroll
        for (int k = 0; k < 8; ++k) s.o[i * 8 + k] = s.o[i * 8 + k] * corr + p * f[k];
        if ((i & 1) == 1) __builtin_amdgcn_sched_barrier(0); }
}
__device__ __forceinline__ void row_key_f32(RowState& s, const float* kp, const float* vp, float bias) {
    float sc = bias;
#pragma unroll
    for (int i = 0; i < 16; ++i) { const f32x4 f = *(const f32x4*)(kp + i * 4); sc += s.q[i * 4] * f[0] + s.q[i * 4 + 1] * f[1] + s.q[i * 4 + 2] * f[2] + s.q[i * 4 + 3] * f[3];
        if ((i & 3) == 3) __builtin_amdgcn_sched_barrier(0); }
    const float mn = fmaxf(s.m, sc), corr = __expf(s.m - mn), p = __expf(sc - mn);
    s.l = s.l * corr + p; s.m = mn;
#pragma unroll
    for (int i = 0; i < 16; ++i) { const f32x4 f = *(const f32x4*)(vp + i * 4);
#pragma unroll
        for (int k = 0; k < 4; ++k) s.o[i * 4 + k] = s.o[i * 4 + k] * corr + p * f[k];
        if ((i & 3) == 3) __builtin_amdgcn_sched_barrier(0); }
}

__device__ __forceinline__ float gelu_tanh(float x) { const float t = tanhf(0.7978845608028654f * (x + 0.044715f * x * x * x)); return 0.5f * x * (1.0f + t); }
__device__ __forceinline__ void phase_cmp1(const Ctx& c, const Args& a, int layer, const bf16_t* proj, float* hid) {
    for (int unit = c.bid; unit < 2048; unit += c.G) {
        const int kv = unit >> 10, g = (unit >> 9) & 1, cp = unit & 511; const int cc = cp * 2 + (c.tid >> 8), u = c.tid & 255;
        if (cc >= NCMP) continue;
        const float* w1 = a.in[kv ? I_CVW1 : I_CKW1] + (size_t)layer * 2048 * 256; const float* pe = a.in[kv ? I_PEV : I_PEK] + (size_t)layer * 32 * 64;
        const bf16_t* xp = proj + (size_t)(16 * cc) * PLD + (kv ? PC_VC : PC_KC) + g * 64;
        float acc = 0.f;
        for (int l = 0; l < 32; ++l) {
#pragma unroll
            for (int i = 0; i < 8; ++i) { float f[8]; unpack8(*(const u32x4*)(xp + (size_t)l * PLD + i * 8), f);
#pragma unroll
                for (int k = 0; k < 8; ++k) acc += (f[k] + pe[l * 64 + i * 8 + k]) * w1[(size_t)(l * 64 + i * 8 + k) * 256 + u]; }
        }
        hid[(((size_t)kv * 2 + g) * 1024 + cc) * 256 + u] = gelu_tanh(acc);
    }
}
__device__ __forceinline__ void phase_cmp2(const Ctx& c, const Args& a, int layer, const float* hid, bf16_t* kcb, bf16_t* vctb) {
    for (int unit = c.bid; unit < 512; unit += c.G) {
        const int kv = unit >> 8, g = (unit >> 7) & 1, cc = (unit & 127) * 8 + (c.tid >> 6), d = c.tid & 63;
        float acc = 0.f;
        if (cc < NCMP) { const float* w2 = a.in[kv ? I_CVW2 : I_CKW2] + (size_t)layer * 256 * 64; const float* hp = hid + (((size_t)kv * 2 + g) * 1024 + cc) * 256;
            for (int u = 0; u < 256; ++u) acc += hp[u] * w2[u * 64 + d]; }
        if (kv) vctb[((size_t)g * 64 + d) * 1024 + cc] = (bf16_t)f2bf(acc); else kcb[((size_t)g * 1024 + cc) * 64 + d] = (bf16_t)f2bf(acc);
    }
}
__device__ __forceinline__ void phase_nsa13(const Ctx& c, const Args& a, const bf16_t* proj, const float* kcmp, const float* vcmp, float* nsaacc, float* ml) {
    LAS float* tb = (LAS float*)c.lds;
    for (int e = c.tid; e < 512; e += 512) tb[e] = inptr(c, I_REL)[e];
    __syncthreads();
    for (int unit = c.bid; unit < T / 64; unit += c.G) {
        const int hh = c.tid >> 6, t = unit * 64 + (c.tid & 63), g = hh >> 2;
        RowState s; row_init(s, proj + (size_t)t * PLD + PC_NQ + hh * 64);
        const bf16_t* glp = proj + (size_t)t * PLD + PC_GL;
        const float g0 = sigmoidf_(bf2f(glp[hh])), g2 = sigmoidf_(bf2f(glp[16 + hh]));
        row_reset(s);
        const int nv = t >= 31 ? (t - 31) / 16 + 1 : 0;
        for (int cc = 0; cc < nv; ++cc) { const float bias = tb[t5_bucket(t - 16 * cc - 31) * 16 + hh];
            row_key_f32(s, kcmp + ((size_t)g * 1024 + cc) * 64, vcmp + ((size_t)g * 1024 + cc) * 64, bias); }
        ml[((size_t)t * 8 + hh) * 2] = s.m; ml[((size_t)t * 8 + hh) * 2 + 1] = s.l;
        float* op = nsaacc + (size_t)t * 512 + hh * 64;
        { const float inv = s.l > 0.f ? g0 / s.l : 0.f;
#pragma unroll
            for (int i = 0; i < 16; ++i) { f32x4 w; w[0] = s.o[i * 4] * inv; w[1] = s.o[i * 4 + 1] * inv; w[2] = s.o[i * 4 + 2] * inv; w[3] = s.o[i * 4 + 3] * inv; *(f32x4*)(op + i * 4) = w; } }
        row_reset(s);
        const int s0 = t - 511 > 0 ? t - 511 : 0;
        for (int sp = s0; sp <= t; ++sp) { const float bias = tb[t5_bucket(t - sp) * 16 + hh];
            row_key_bf16(s, proj + (size_t)sp * PLD + PC_KW + g * 64, proj + (size_t)sp * PLD + PC_VW + g * 64, bias); }
        { const float inv = s.l > 0.f ? g2 / s.l : 0.f;
#pragma unroll
            for (int i = 0; i < 16; ++i) { f32x4 w = *(const f32x4*)(op + i * 4); w[0] += s.o[i * 4] * inv; w[1] += s.o[i * 4 + 1] * inv; w[2] += s.o[i * 4 + 2] * inv; w[3] += s.o[i * 4 + 3] * inv; *(f32x4*)(op + i * 4) = w; } }
    }
}
__device__ __forceinline__ void phase_nsa_topk(const Ctx& c, const Args& a, const bf16_t* proj, const float* kcmp, const float* ml, int* sel) {
    LAS float* tb = (LAS float*)c.lds;
    LAS float* qs = (LAS float*)(c.lds + 4096) + c.wave * 256;
    LAS float* sv = (LAS float*)(c.lds + 16384) + c.wave * 256;
    for (int e = c.tid; e < 512; e += 512) tb[e] = inptr(c, I_REL)[e];
    __syncthreads();
    const int gw = c.bid * 8 + c.wave, NGW = c.G * 8;
    for (int item = gw; item < T * 2; item += NGW) {
        const int t = item >> 1, g = item & 1, cur = t >> 6;
        { const bf16_t* qp = proj + (size_t)t * PLD + PC_NQ + g * 256 + c.lane * 4; const u32x2 w = *(const u32x2*)qp;
          qs[c.lane * 4] = __uint_as_float(w.x << 16); qs[c.lane * 4 + 1] = __uint_as_float(w.x & 0xffff0000u); qs[c.lane * 4 + 2] = __uint_as_float(w.y << 16); qs[c.lane * 4 + 3] = __uint_as_float(w.y & 0xffff0000u); }
        float mr[4], il[4];
#pragma unroll
        for (int r = 0; r < 4; ++r) { mr[r] = ml[((size_t)t * 8 + g * 4 + r) * 2]; const float l = ml[((size_t)t * 8 + g * 4 + r) * 2 + 1]; il[r] = l > 0.f ? 1.0f / l : 0.f; }
        const int nv = t >= 31 ? (t - 31) / 16 + 1 : 0;
        asm volatile("s_waitcnt lgkmcnt(0)" ::: "memory");
#pragma unroll 1
        for (int jj = 0; jj < 4; ++jj) {
            const int j = c.lane + 64 * jj; float sc;
            if (j == 0 || j == cur || j == cur - 1) sc = 1e4f;
            else if (j > cur) sc = -1.0f;
            else { sc = 0.f;
#pragma unroll 1
                for (int o = 0; o < 5; ++o) { const int cc = 4 * j + o - 1; if (cc < 0 || cc >= nv) continue;
                    const float* kp = kcmp + ((size_t)g * 1024 + cc) * 64; float d0 = 0.f, d1 = 0.f, d2 = 0.f, d3 = 0.f;
#pragma unroll 4
                    for (int i = 0; i < 16; ++i) { const f32x4 f = *(const f32x4*)(kp + i * 4);
#pragma unroll
                        for (int k = 0; k < 4; ++k) { d0 += qs[i * 4 + k] * f[k]; d1 += qs[64 + i * 4 + k] * f[k]; d2 += qs[128 + i * 4 + k] * f[k]; d3 += qs[192 + i * 4 + k] * f[k]; } }
                    const int bk = t5_bucket(t - 16 * cc - 31) * 16 + g * 4;
                    const float imp = __expf(d0 + tb[bk] - mr[0]) * il[0] + __expf(d1 + tb[bk + 1] - mr[1]) * il[1] + __expf(d2 + tb[bk + 2] - mr[2]) * il[2] + __expf(d3 + tb[bk + 3] - mr[3]) * il[3];
                    sc += ((o == 0 || o == 4) ? 1.0f : 2.0f) * imp; }
            }
            sv[j] = sc;
        }
        asm volatile("s_waitcnt lgkmcnt(0)" ::: "memory");
        float val[4];
#pragma unroll
        for (int jj = 0; jj < 4; ++jj) val[jj] = sv[c.lane + 64 * jj];
        for (int k = 0; k < 16; ++k) {
            float bv = val[0]; int bi = c.lane;
#pragma unroll
            for (int jj = 1; jj < 4; ++jj) if (val[jj] > bv) { bv = val[jj]; bi = c.lane + 64 * jj; }
#pragma unroll
            for (int o = 32; o >= 1; o >>= 1) { const float ov = __shfl_xor(bv, o); const int oi = __shfl_xor(bi, o); if (ov > bv || (ov == bv && oi < bi)) { bv = ov; bi = oi; } }
#pragma unroll
            for (int jj = 0; jj < 4; ++jj) if (bi == c.lane + 64 * jj) val[jj] = -3e38f;
            if (c.lane == 0) sel[(size_t)item * 16 + k] = bi;
        }
    }
}
__device__ __forceinline__ void phase_nsa2(const Ctx& c, const Args& a, const bf16_t* proj, const int* sel, const float* nsaacc, bf16_t* onsa) {
    LAS float* tb = (LAS float*)c.lds;
    for (int e = c.tid; e < 512; e += 512) tb[e] = inptr(c, I_REL)[e];
    __syncthreads();
    for (int unit = c.bid; unit < T / 64; unit += c.G) {
        const int hh = c.tid >> 6, t = unit * 64 + (c.tid & 63), g = hh >> 2;
        RowState s; row_init(s, proj + (size_t)t * PLD + PC_NQ + hh * 64); row_reset(s);
        const float g1 = sigmoidf_(bf2f(proj[(size_t)t * PLD + PC_GL + 8 + hh]));
        for (int k = 0; k < 16; ++k) { const int j = sel[((size_t)t * 2 + g) * 16 + k];
            for (int p = 0; p < 64; ++p) { const int pos = j * 64 + p; if (pos > t) break;
                const float bias = tb[t5_bucket(t - pos) * 16 + hh];
                row_key_bf16(s, proj + (size_t)pos * PLD + PC_KS + g * 64, proj + (size_t)pos * PLD + PC_VS + g * 64, bias); } }
        const float inv = s.l > 0.f ? g1 / s.l : 0.f; const float* ap = nsaacc + (size_t)t * 512 + hh * 64; bf16_t* op = onsa + (size_t)t * 512 + hh * 64;
#pragma unroll
        for (int i = 0; i < 8; ++i) { const f32x4 x0 = *(const f32x4*)(ap + i * 8), x1 = *(const f32x4*)(ap + i * 8 + 4); u32x4 w;
            w.x = pk2(x0[0] + s.o[i * 8] * inv, x0[1] + s.o[i * 8 + 1] * inv); w.y = pk2(x0[2] + s.o[i * 8 + 2] * inv, x0[3] + s.o[i * 8 + 3] * inv);
            w.z = pk2(x1[0] + s.o[i * 8 + 4] * inv, x1[1] + s.o[i * 8 + 5] * inv); w.w = pk2(x1[2] + s.o[i * 8 + 6] * inv, x1[3] + s.o[i * 8 + 7] * inv);
            *(u32x4*)(op + i * 8) = w; }
    }
}
__device__ __forceinline__ void phase_swa(const Ctx& c, const Args& a, int layer, const bf16_t* proj, bf16_t* oswa) {
    LAS float* tb = (LAS float*)c.lds;
    for (int e = c.tid; e < 512; e += 512) tb[e] = inptr(c, I_REL)[e];
    __syncthreads();
    for (int unit = c.bid; unit < T / 64; unit += c.G) {
        const int hh = c.tid >> 6, t = unit * 64 + (c.tid & 63), g = hh >> 2;
        RowState s; row_init(s, proj + (size_t)t * PLD + PC_SQ + hh * 64); row_reset(s);
        const int s0 = t - 127 > 0 ? t - 127 : 0;
        for (int sp = s0; sp <= t; ++sp) { const float bias = tb[t5_bucket(t - sp) * 16 + 8 + hh];
            row_key_bf16(s, proj + (size_t)sp * PLD + PC_SK + g * 64, proj + (size_t)sp * PLD + PC_SV + g * 64, bias); }
        const float sink = inptr(c, I_SINK)[layer * 8 + hh]; const float mf = fmaxf(s.m, sink); const float corr = __expf(s.m - mf);
        const float den = s.l * corr + __expf(sink - mf); const float inv = corr / den;
        bf16_t* op = oswa + (size_t)t * 512 + hh * 64;
#pragma unroll
        for (int i = 0; i < 8; ++i) { u32x4 w; w.x = pk2(s.o[i * 8] * inv, s.o[i * 8 + 1] * inv); w.y = pk2(s.o[i * 8 + 2] * inv, s.o[i * 8 + 3] * inv);
            w.z = pk2(s.o[i * 8 + 4] * inv, s.o[i * 8 + 5] * inv); w.w = pk2(s.o[i * 8 + 6] * inv, s.o[i * 8 + 7] * inv); *(u32x4*)(op + i * 8) = w; }
    }
}

constexpr int RL = 65;
__device__ __forceinline__ float rwkv_mixed(const bf16_t* proj, const float* mu, int t, int col) {
    const float cur = bf2f(proj[(size_t)t * PLD + col]); const float prev = t > 0 ? bf2f(proj[(size_t)(t - 1) * PLD + col]) : 0.f;
    return cur + (prev - cur) * mu[col];
}
__device__ __forceinline__ void lora64(const Ctx& c, const LAS float* in, const float* W, const float* bias, LAS float* out, bool accum) {
    const int j = c.tid & 63, tg = (c.tid >> 6) * 8;
    float acc[8];
#pragma unroll
    for (int i = 0; i < 8; ++i) acc[i] = accum ? out[(tg + i) * RL + j] : (bias ? bias[j] : 0.f);
#pragma unroll 4
    for (int m = 0; m < 64; ++m) { const float w = W[(size_t)m * 512 + j];
#pragma unroll
        for (int i = 0; i < 8; ++i) acc[i] += in[(tg + i) * RL + m] * w; }
#pragma unroll
    for (int i = 0; i < 8; ++i) out[(tg + i) * RL + j] = acc[i];
}
struct RwkvLds { LAS float *R, *K, *V, *A, *B, *W, *G, *TMP; };
__device__ __forceinline__ RwkvLds rwkv_lds(LAS unsigned char* lds) {
    RwkvLds s; LAS float* p = (LAS float*)lds; constexpr int SZ = 64 * RL;
    s.R = p; s.K = p + SZ; s.V = p + 2 * SZ; s.A = p + 3 * SZ; s.B = p + 4 * SZ; s.W = p + 5 * SZ; s.G = p + 6 * SZ; s.TMP = p + 7 * SZ; return s;
}
template <bool LOGDECAY>
__device__ __forceinline__ void rwkv_prep(const Ctx& c, const Args& a, int layer, const bf16_t* proj, int t0, int h, const RwkvLds& s) {
    const float* mu = inptr(c, I_MU) + (size_t)layer * 1792;
    const int j = c.tid & 63, tg = c.tid >> 6;
#pragma unroll 2
    for (int i = 0; i < 8; ++i) { const int tt = tg * 8 + i; s.TMP[tt * RL + j] = tanhf(rwkv_mixed(proj, mu, t0 + tt, PC_ZW + j)); }
    __syncthreads();
    lora64(c, s.TMP, inptr(c, I_W2) + (size_t)layer * 64 * 512 + h * 64, inptr(c, I_W0) + layer * 512 + h * 64, s.W, false);
    __syncthreads();
#pragma unroll 2
    for (int i = 0; i < 8; ++i) { const int tt = tg * 8 + i; s.TMP[tt * RL + j] = rwkv_mixed(proj, mu, t0 + tt, PC_ZA + j); }
    __syncthreads();
    lora64(c, s.TMP, inptr(c, I_A2) + (size_t)layer * 64 * 512 + h * 64, inptr(c, I_A0) + layer * 512 + h * 64, s.B, false);
    __syncthreads();
#pragma unroll 2
    for (int i = 0; i < 8; ++i) { const int tt = tg * 8 + i; s.TMP[tt * RL + j] = sigmoidf_(rwkv_mixed(proj, mu, t0 + tt, PC_ZG + j)); }
    __syncthreads();
    lora64(c, s.TMP, inptr(c, I_G2) + (size_t)layer * 128 * 512 + h * 64, nullptr, s.G, false);
    __syncthreads();
#pragma unroll 2
    for (int i = 0; i < 8; ++i) { const int tt = tg * 8 + i; s.TMP[tt * RL + j] = sigmoidf_(rwkv_mixed(proj, mu, t0 + tt, PC_ZG + 64 + j)); }
    __syncthreads();
    lora64(c, s.TMP, inptr(c, I_G2) + ((size_t)layer * 128 + 64) * 512 + h * 64, nullptr, s.G, true);
    const float kkw = inptr(c, I_KK)[layer * 512 + h * 64 + j], kaw = inptr(c, I_KA)[layer * 512 + h * 64 + j];
#pragma unroll 1
    for (int i = 0; i < 8; ++i) { const int tt = tg * 8 + i, t = t0 + tt;
        const float r = rwkv_mixed(proj, mu, t, PC_R + h * 64 + j), k = rwkv_mixed(proj, mu, t, PC_K + h * 64 + j), v = rwkv_mixed(proj, mu, t, PC_V + h * 64 + j);
        const float wl = s.W[tt * RL + j], al = sigmoidf_(s.B[tt * RL + j]);
        const float sp = (-wl > 20.f) ? -wl : log1pf(__expf(-wl)); const float w = -sp - 0.5f; const float ew = __expf(w);
        float kk = k * kkw; const float n2 = wave_sum(kk * kk); kk = kk / fmaxf(sqrtf(n2), 1e-12f);
        s.R[tt * RL + j] = r; s.V[tt * RL + j] = v; s.K[tt * RL + j] = k * (1.0f + (al - 1.0f) * kaw);
        s.A[tt * RL + j] = -kk; s.B[tt * RL + j] = kk * al; s.W[tt * RL + j] = LOGDECAY ? -ew : __expf(-ew); }
    __syncthreads();
}
__device__ __forceinline__ void rwkv_post(const Ctx& c, const Args& a, int layer, int t0, int h, const RwkvLds& s, const LAS float* Y, bf16_t* orwkv) {
    const int i = c.lane, tg = c.wave;
    const float lnw = inptr(c, I_LNW)[layer * 512 + h * 64 + i], lnb = inptr(c, I_LNB)[layer * 512 + h * 64 + i], rk = inptr(c, I_RK)[layer * 512 + h * 64 + i];
#pragma unroll 1
    for (int q = 0; q < 8; ++q) { const int tt = tg * 8 + q; const float y = Y[tt * RL + i];
        const float mean = wave_sum(y) * (1.0f / 64.0f); const float d = y - mean; const float var = wave_sum(d * d) * (1.0f / 64.0f);
        const float bonus = wave_sum(s.R[tt * RL + i] * s.K[tt * RL + i] * rk);
        const float o = (d * rsqrtf(var + 64e-5f) * lnw + lnb + bonus * s.V[tt * RL + i]) * s.G[tt * RL + i];
        orwkv[(size_t)(t0 + tt) * 512 + h * 64 + i] = (bf16_t)f2bf(o); }
}
__device__ __forceinline__ void phase_rwkv_naive(const Ctx& c, const Args& a, int layer, const bf16_t* proj, bf16_t* orwkv) {
    if (c.bid >= 8) return;
    const int h = c.bid; const RwkvLds s = rwkv_lds(c.lds);
    float S[64];
#pragma unroll
    for (int j = 0; j < 64; ++j) S[j] = 0.f;
    for (int ch = 0; ch < T / 64; ++ch) {
        rwkv_prep<false>(c, a, layer, proj, ch * 64, h, s);
        if (c.wave == 0) {
            const int i = c.lane;
            for (int tt = 0; tt < 64; ++tt) {
                float sa = 0.f;
#pragma unroll
                for (int j = 0; j < 64; ++j) { sa += S[j] * s.A[tt * RL + j]; if ((j & 7) == 7) __builtin_amdgcn_sched_barrier(0); }
                const float vi = s.V[tt * RL + i]; float y = 0.f;
#pragma unroll
                for (int j = 0; j < 64; ++j) { S[j] = S[j] * s.W[tt * RL + j] + sa * s.B[tt * RL + j] + vi * s.K[tt * RL + j]; y += S[j] * s.R[tt * RL + j]; if ((j & 3) == 3) __builtin_amdgcn_sched_barrier(0); }
                s.TMP[tt * RL + i] = y;
            }
        }
        __syncthreads();
        rwkv_post(c, a, layer, ch * 64, h, s, s.TMP, orwkv);
        __syncthreads();
    }
}


__device__ __forceinline__ int kperm32(int jl) { return 8 * ((jl >> 2) & 3) + 4 * (jl >> 4) + (jl & 3); }
__device__ __forceinline__ f32x4 tile_mma64(const LAS unsigned char* A, const LAS unsigned char* B, int a, int b, int lane, f32x4 acc) {
    const int m = lane & 15, q = lane >> 4;
#pragma unroll
    for (int ks = 0; ks < 2; ++ks) {
        const bf16x8 af = *(const LAS bf16x8*)(A + (16 * a + m) * 144 + (32 * ks + 8 * q) * 2);
        const bf16x8 bf = *(const LAS bf16x8*)(B + (16 * b + m) * 144 + (32 * ks + 8 * q) * 2);
        acc = __builtin_amdgcn_mfma_f32_16x16x32_bf16(af, bf, acc, 0, 0, 0);
    }
    return acc;
}
__device__ __forceinline__ void lds_st_bf16(LAS unsigned char* base, int idx, float v) { *(LAS bf16_t*)(base + idx * 2) = (bf16_t)f2bf(v); }

__device__ __forceinline__ void phase_lora_a(const Ctx& c, const Args& a, int layer, const bf16_t* proj, bf16_t* alora) {
    const float* mu = inptr(c, I_MU) + (size_t)layer * 1792;
    const int sub = c.tid & 31, rloc = c.tid >> 5;
    for (int t = c.bid * 16 + rloc; t < T; t += c.G * 16) {
        const int col = PC_ZW + sub * 8; float cur[8], prv[8];
        unpack8(*(const u32x4*)(proj + (size_t)t * PLD + col), cur);
        if (t > 0) unpack8(*(const u32x4*)(proj + (size_t)(t - 1) * PLD + col), prv); else {
#pragma unroll
            for (int k = 0; k < 8; ++k) prv[k] = 0.f; }
        float o[8];
#pragma unroll
        for (int k = 0; k < 8; ++k) { const float v = cur[k] + (prv[k] - cur[k]) * mu[col + k]; o[k] = sub < 8 ? tanhf(v) : (sub < 16 ? v : sigmoidf_(v)); }
        u32x4 w; w.x = pk2(o[0], o[1]); w.y = pk2(o[2], o[3]); w.z = pk2(o[4], o[5]); w.w = pk2(o[6], o[7]);
        *(u32x4*)(alora + (size_t)t * 256 + sub * 8) = w;
    }
}

constexpr int RC_L = 0, RC_AL = 16640, RC_AAK = 0, RC_ARB = 9216, RC_ARK = 18432, RC_AAB = 33280, RC_P2T = 33280, RC_WC = 50688, RC_BS = 50944, RC_M = 52992;
constexpr int RC_AT = RC_M, RC_TINV = RC_M, RC_ATT = RC_M + 9216, RC_RT = RC_M + 2 * 9216, RC_BT = RC_M + 3 * 9216, RC_XT = RC_BT, RC_KT = RC_M + 4 * 9216, RC_P1T = RC_KT,
              RC_VT = RC_M + 5 * 9216, RC_BHT = RC_M + 6 * 9216, RC_KHT = RC_M + 7 * 9216;
constexpr int RC_XOFF = RC_M + 8 * 9216, RC_XTMP = RC_XOFF + 6144;
static_assert(RC_XTMP + 3 * 1088 <= LDS_MISC, "rwkv chunk LDS");

__device__ __forceinline__ void phase_rwkv_chunk(const Ctx& c, const Args& a, int layer, const bf16_t* proj, const bf16_t* wlb, const bf16_t* alb, bf16_t* rwu, float* bonusg) {
    LAS unsigned char* L = c.lds;
    LAS float* sL = (LAS float*)(L + RC_L); LAS float* sAL = (LAS float*)(L + RC_AL); LAS float* sAAB = (LAS float*)(L + RC_AAB);
    LAS float* sWC = (LAS float*)(L + RC_WC); LAS float* sBS = (LAS float*)(L + RC_BS);
    const float* mu = inptr(c, I_MU) + (size_t)layer * 1792;
    const int lane = c.lane, wave = c.wave, n = lane & 15, q = lane >> 4;
    for (int unit = c.bid; unit < 2048; unit += c.G) {
        const int ch = unit >> 3, h = unit & 7, t0 = ch * 64, j = lane;
        {
            const float w0 = inptr(c, I_W0)[layer * 512 + h * 64 + j], a0 = inptr(c, I_A0)[layer * 512 + h * 64 + j];
            bf16_t wraw[8], araw[8];
#pragma unroll
            for (int i = 0; i < 8; ++i) { const size_t gi = (size_t)(t0 + wave * 8 + i) * 512 + h * 64 + j; wraw[i] = wlb[gi]; araw[i] = alb[gi]; }
            float run = 0.f;
#pragma unroll
            for (int i = 0; i < 8; ++i) { const int tt = wave * 8 + i;
                const float wl = w0 + bf2f(wraw[i]); const float nx = -wl; const float sp = nx > 20.f ? nx : __logf(1.0f + __expf(nx)); const float ld = -__expf(-sp - 0.5f);
                run += ld; sL[tt * RL + j] = run; sAL[tt * RL + j] = sigmoidf_(a0 + bf2f(araw[i])); }
            sBS[wave * 64 + j] = run;
        }
        bf16_t rraw[9], kraw[9], vraw[9];
        {
#pragma unroll
            for (int i = 0; i < 9; ++i) { const int t = t0 + wave * 8 + i - 1; const bool ok = t >= 0; const size_t ro = (size_t)(ok ? t : 0) * PLD + h * 64 + j;
                rraw[i] = ok ? proj[ro + PC_R] : (bf16_t)0; kraw[i] = ok ? proj[ro + PC_K] : (bf16_t)0; vraw[i] = ok ? proj[ro + PC_V] : (bf16_t)0; }
        }
        __syncthreads();
        {
            float off = 0.f, tot = 0.f;
#pragma unroll
            for (int w2 = 0; w2 < 8; ++w2) { const float v = sBS[w2 * 64 + j]; tot += v; off += (w2 < wave) ? v : 0.f; }
            if (wave == 0) sWC[j] = __expf(tot);
            const float kkw = inptr(c, I_KK)[layer * 512 + h * 64 + j], kaw = inptr(c, I_KA)[layer * 512 + h * 64 + j], rk = inptr(c, I_RK)[layer * 512 + h * 64 + j];
            const float mur = mu[PC_R + h * 64 + j], muk = mu[PC_K + h * 64 + j], muv = mu[PC_V + h * 64 + j];
            float Lprev = off;
#pragma unroll
            for (int i = 0; i < 8; ++i) { const int tt = wave * 8 + i, t = t0 + tt;
                const float Lc = sL[tt * RL + j] + off, al = sAL[tt * RL + j];
                const float rc = bf2f(rraw[i + 1]), kc = bf2f(kraw[i + 1]), vc = bf2f(vraw[i + 1]);
                const float r = rc + (bf2f(rraw[i]) - rc) * mur, k = kc + (bf2f(kraw[i]) - kc) * muk, v = vc + (bf2f(vraw[i]) - vc) * muv;
                float kk = k * kkw; const float n2 = wave_sum(kk * kk); kk = kk / fmaxf(sqrtf(n2), 1e-12f);
                const float kp = k * (1.0f + (al - 1.0f) * kaw), av = -kk, bv = kk * al;
                const float eW = __expf(Lc), eWex = __expf(Lprev), eInv = __expf(-Lc), eC = __expf(tot - Lc);
                lds_st_bf16(L + RC_AT, tt * 72 + j, av * eWex); lds_st_bf16(L + RC_ATT, j * 72 + tt, av * eWex);
                lds_st_bf16(L + RC_RT, tt * 72 + j, r * eW); lds_st_bf16(L + RC_BT, tt * 72 + j, bv * eInv); lds_st_bf16(L + RC_KT, tt * 72 + j, kp * eInv);
                lds_st_bf16(L + RC_VT, j * 72 + tt, v); lds_st_bf16(L + RC_BHT, j * 72 + tt, bv * eC); lds_st_bf16(L + RC_KHT, j * 72 + tt, kp * eC);
                const float bon = wave_sum(r * kp * rk); if (lane == 0) bonusg[(size_t)t * 8 + h] = bon;
                Lprev = Lc; }
        }
        __syncthreads();
        for (int job = wave; job < 64; job += 8) {
            const int p = job >> 4, ta = (job >> 2) & 3, tb = job & 3;
            f32x4 acc = (f32x4){0.f, 0.f, 0.f, 0.f};
            if (ta >= tb) acc = tile_mma64(L + (p < 2 ? RC_AT : RC_RT), L + ((p & 1) ? RC_KT : RC_BT), ta, tb, lane, acc);
            LAS unsigned char* dst = L + (p == 1 ? RC_AAK : (p == 2 ? RC_ARB : RC_ARK));
#pragma unroll
            for (int r = 0; r < 4; ++r) { const int tt = 16 * ta + 4 * q + r, ss = 16 * tb + n; const bool keep = (p < 2) ? (ss < tt) : (ss <= tt); const float v = keep ? acc[r] : 0.f;
                if (p == 0) sAAB[tt * 68 + ss] = v; else lds_st_bf16(dst, tt * 72 + ss, v); }
        }
        __syncthreads();
        if (wave == 0) {
            const int blk = lane >> 4, cc = lane & 15; const LAS float* Ab = sAAB + (16 * blk) * 68 + 16 * blk; float xr[16];
#pragma unroll
            for (int tt = 0; tt < 16; ++tt) { float acc = (tt == cc) ? 1.f : 0.f;
#pragma unroll
                for (int ss = 0; ss < tt; ++ss) acc += Ab[tt * 68 + ss] * xr[ss];
                xr[tt] = acc; }
            asm volatile("s_waitcnt lgkmcnt(0)" ::: "memory");
#pragma unroll
            for (int tt = 0; tt < 16; ++tt) sAAB[(16 * blk + tt) * 68 + 16 * blk + cc] = xr[tt];
        } else {
            for (int job = wave - 1; job < 16; job += 7) { const int ta = job >> 2, tb = job & 3;
                const f32x4 acc = tile_mma64(L + RC_VT, L + RC_AAK, ta, tb, lane, (f32x4){0.f, 0.f, 0.f, 0.f});
#pragma unroll
                for (int r = 0; r < 4; ++r) lds_st_bf16(L + RC_XT, (16 * ta + 4 * q + r) * 72 + 16 * tb + n, acc[r]); }
        }
        __syncthreads();
        {
            LAS float* sXO = (LAS float*)(L + RC_XOFF); LAS float* sT = (LAS float*)(L + RC_XTMP) + wave * 272;
            const int rr = lane >> 2, c4 = (lane & 3) * 4;
#pragma unroll 1
            for (int lev = 1; lev <= 3; ++lev) {
                if (wave < 4 - lev) {
                    const int J = wave, I = wave + lev;
                    f32x4 tacc = (f32x4){0.f, 0.f, 0.f, 0.f};
                    for (int K = J; K < I; ++K) {
                        const LAS float* Ap = sAAB + (16 * I + rr) * 68 + 16 * K; const LAS float* Xp;
                        int xs;
                        if (K == J) { Xp = sAAB + (16 * J) * 68 + 16 * J + c4; xs = 68; }
                        else { const int d = K - J; const int bi = (d == 1) ? J : 3 + J; Xp = sXO + bi * 256 + c4; xs = 16; }
#pragma unroll
                        for (int k = 0; k < 16; ++k) { const float av = Ap[k]; const f32x4 xv = *(const LAS f32x4*)(Xp + k * xs); tacc += xv * av; }
                    }
                    *(LAS f32x4*)(sT + rr * 16 + c4) = tacc;
                    asm volatile("s_waitcnt lgkmcnt(0)" ::: "memory");
                    f32x4 xacc = (f32x4){0.f, 0.f, 0.f, 0.f};
                    const LAS float* Dp = sAAB + (16 * I + rr) * 68 + 16 * I;
#pragma unroll
                    for (int k = 0; k < 16; ++k) { const float dv = Dp[k]; const f32x4 tv = *(const LAS f32x4*)(sT + k * 16 + c4); xacc += tv * dv; }
                    const int bo = (lev == 1) ? J : (lev == 2 ? 3 + J : 5);
                    *(LAS f32x4*)(sXO + bo * 256 + rr * 16 + c4) = xacc;
                }
                __syncthreads();
            }
            for (int e = c.tid; e < 4096; e += 512) { const int tt = e >> 6, ss = e & 63, I = tt >> 4, J = ss >> 4; float v = 0.f;
                if (I == J) v = sAAB[tt * 68 + ss];
                else if (I > J) { const int d = I - J; const int bi = (d == 1) ? J : (d == 2 ? 3 + J : 5); v = sXO[bi * 256 + (tt & 15) * 16 + (ss & 15)]; }
                lds_st_bf16(L + RC_TINV, tt * 72 + ss, v); }
        }
        __syncthreads();
        for (int job = wave; job < 32; job += 8) { const int p = job >> 4, ta = (job >> 2) & 3, tb = job & 3;
            const f32x4 acc = tile_mma64(L + (p ? RC_XT : RC_ATT), L + RC_TINV, ta, tb, lane, (f32x4){0.f, 0.f, 0.f, 0.f});
#pragma unroll
            for (int r = 0; r < 4; ++r) lds_st_bf16(L + (p ? RC_P2T : RC_P1T), (16 * ta + 4 * q + r) * 72 + 16 * tb + n, acc[r]); }
        __syncthreads();
        bf16_t* ug = rwu + (size_t)unit * 16384;
        for (int job = wave; job < 64; job += 8) { const int p = job >> 4, ta = (job >> 2) & 3, tb = job & 3;
            f32x4 acc = (f32x4){0.f, 0.f, 0.f, 0.f};
            if (p == 0) { acc = tile_mma64(L + RC_ARB, L + RC_P1T, ta, tb, lane, acc);
#pragma unroll
                for (int r = 0; r < 4; ++r) { const int tt = 16 * ta + 4 * q + r, jj = 16 * tb + n; const float v = acc[r] + bf2f(*(const LAS bf16_t*)(L + RC_RT + (tt * 72 + jj) * 2));
                    ug[8192 + tt * 64 + (jj & 32) + kperm32(jj & 31)] = (bf16_t)f2bf(v); } }
            else if (p == 1) { acc = tile_mma64(L + RC_ARB, L + RC_P2T, ta, tb, lane, acc); acc = tile_mma64(L + RC_ARK, L + RC_VT, ta, tb, lane, acc);
                u32x2 w; w.x = pk2(acc[0], acc[1]); w.y = pk2(acc[2], acc[3]); *(u32x2*)(ug + 12288 + ((tb * 4 + ta) * 64 + lane) * 4) = w; }
            else if (p == 2) { acc = tile_mma64(L + RC_BHT, L + RC_P1T, ta, tb, lane, acc);
#pragma unroll
                for (int r = 0; r < 4; ++r) { const int jr = 16 * ta + 4 * q + r, jc = 16 * tb + n; const float v = acc[r] + (jr == jc ? sWC[jr] : 0.f);
                    ug[jr * 64 + (jc & 32) + kperm32(jc & 31)] = (bf16_t)f2bf(v); } }
            else { acc = tile_mma64(L + RC_BHT, L + RC_P2T, ta, tb, lane, acc); acc = tile_mma64(L + RC_KHT, L + RC_VT, ta, tb, lane, acc);
                u32x2 w; w.x = pk2(acc[0], acc[1]); w.y = pk2(acc[2], acc[3]); *(u32x2*)(ug + 4096 + ((tb * 4 + ta) * 64 + lane) * 4) = w; }
        }
        __syncthreads();
    }
}

#define RW_LOAD_SET(SET, UNIT) do { const bf16_t* ug_ = rwu + (size_t)(UNIT) * 16384; \
    _Pragma("unroll") for (int ta = 0; ta < 4; ++ta) { An[SET][ta][0] = *(const bf16x8*)(ug_ + (16 * ta + m) * 64 + 8 * q); An[SET][ta][1] = *(const bf16x8*)(ug_ + (16 * ta + m) * 64 + 32 + 8 * q); \
        Zn[SET][ta] = *(const u32x2*)(ug_ + 4096 + ((cq * 4 + ta) * 64 + lane) * 4); } } while (0)
template <int SM>
__device__ __forceinline__ void phase_rwkv_scan(const Ctx& c, const bf16_t* rwu, bf16_t* rws) {
    const int idx = c.bid; if (idx >= 32 || c.wave != 0) return;
    const int h = idx >> 2, cq = idx & 3, lane = c.lane, m = lane & 15, q = lane >> 4;
    bf16x8 Bhi[2], Blo[2];
#pragma unroll
    for (int s = 0; s < 2; ++s) { Bhi[s] = (bf16x8){0, 0, 0, 0, 0, 0, 0, 0}; Blo[s] = Bhi[s]; }
    bf16x8 An[2][4][2]; u32x2 Zn[2][4];
#pragma unroll
    for (int u = 0; u < 2; ++u) RW_LOAD_SET(u, u * 8 + h);
    if (SM == 1) {
        for (int ch = 0; ch < T / 64; ch += 8) {
#pragma unroll
            for (int uu = 0; uu < 8; ++uu) { const int u = uu & 3; const int unit = (ch + uu) * 8 + h;
                bf16_t* sg = rws + (size_t)unit * 4096 + cq * 1024 + lane * 8;
                *(bf16x8*)(sg) = Bhi[0]; *(bf16x8*)(sg + 512) = Bhi[1];
#pragma unroll
                for (int ta = 0; ta < 4; ++ta) { Bhi[0] = Bhi[0] ^ An[u][ta][0]; Bhi[1] = Bhi[1] ^ An[u][ta][1]; Bhi[0][0] ^= (short)Zn[u][ta].x; }
                RW_LOAD_SET(u, (ch + uu + 4 < T / 64) ? unit + 32 : unit); } }
        return;
    }
    for (int ch = 0; ch < T / 64; ch += 8) {
#pragma unroll
        for (int uu = 0; uu < 8; ++uu) {
            const int u = uu & 1;
            const int unit = (ch + uu) * 8 + h;
            bf16_t* sg = rws + (size_t)unit * 4096 + cq * 1024 + lane * 8;
            *(bf16x8*)(sg) = Bhi[0]; *(bf16x8*)(sg + 512) = Bhi[1];
            f32x4 acc[4];
#pragma unroll
            for (int ta = 0; ta < 4; ++ta) { const u32x2 z = Zn[u][ta];
                acc[ta] = (f32x4){__uint_as_float(z.x << 16), __uint_as_float(z.x & 0xffff0000u), __uint_as_float(z.y << 16), __uint_as_float(z.y & 0xffff0000u)};
#pragma unroll
                for (int s = 0; s < 2; ++s) { acc[ta] = __builtin_amdgcn_mfma_f32_16x16x32_bf16(An[u][ta][s], Bhi[s], acc[ta], 0, 0, 0); acc[ta] = __builtin_amdgcn_mfma_f32_16x16x32_bf16(An[u][ta][s], Blo[s], acc[ta], 0, 0, 0); } }
            if (SM == 0) RW_LOAD_SET(u, (ch + uu + 2 < T / 64) ? unit + 16 : unit);
#pragma unroll
            for (int s = 0; s < 2; ++s) { u32x4 hi, lo; float rem[8];
#pragma unroll
                for (int p = 0; p < 8; ++p) { const float v = acc[2 * s + (p >> 2)][p & 3]; const unsigned hb = f2bf(v); rem[p] = v - __uint_as_float(hb << 16); }
                hi.x = pk2(acc[2 * s][0], acc[2 * s][1]); hi.y = pk2(acc[2 * s][2], acc[2 * s][3]); hi.z = pk2(acc[2 * s + 1][0], acc[2 * s + 1][1]); hi.w = pk2(acc[2 * s + 1][2], acc[2 * s + 1][3]);
                lo.x = pk2(rem[0], rem[1]); lo.y = pk2(rem[2], rem[3]); lo.z = pk2(rem[4], rem[5]); lo.w = pk2(rem[6], rem[7]);
                Bhi[s] = __builtin_bit_cast(bf16x8, hi); Blo[s] = __builtin_bit_cast(bf16x8, lo); }
        }
    }
}
#undef RW_LOAD_SET

__device__ __forceinline__ void phase_rwkv_out(const Ctx& c, const Args& a, int layer, const bf16_t* proj, const bf16_t* rwu, const bf16_t* rws, const float* bonusg, bf16_t* orwkv) {
    const float* mu = inptr(c, I_MU) + (size_t)layer * 1792;
    const int lane = c.lane, m = lane & 15, q = lane >> 4;
    for (int unit = c.bid * 8 + c.wave; unit < 2048; unit += c.G * 8) {
        const int ch = unit >> 3, h = unit & 7, t0 = ch * 64; const bf16_t* ug = rwu + (size_t)unit * 16384; const bf16_t* sg = rws + (size_t)unit * 4096;
        bf16x8 Bf[4][2];
#pragma unroll
        for (int cq = 0; cq < 4; ++cq) { Bf[cq][0] = *(const bf16x8*)(sg + cq * 1024 + lane * 8); Bf[cq][1] = *(const bf16x8*)(sg + cq * 1024 + 512 + lane * 8); }
        float lnw[4], lnb[4];
#pragma unroll
        for (int cq = 0; cq < 4; ++cq) { lnw[cq] = inptr(c, I_LNW)[layer * 512 + h * 64 + 16 * cq + m]; lnb[cq] = inptr(c, I_LNB)[layer * 512 + h * 64 + 16 * cq + m]; }
#pragma unroll 1
        for (int ta = 0; ta < 4; ++ta) {
            const bf16x8 A0 = *(const bf16x8*)(ug + 8192 + (16 * ta + m) * 64 + 8 * q), A1 = *(const bf16x8*)(ug + 8192 + (16 * ta + m) * 64 + 32 + 8 * q);
            f32x4 y[4];
#pragma unroll
            for (int cq = 0; cq < 4; ++cq) { const u32x2 z = *(const u32x2*)(ug + 12288 + ((cq * 4 + ta) * 64 + lane) * 4);
                y[cq] = (f32x4){__uint_as_float(z.x << 16), __uint_as_float(z.x & 0xffff0000u), __uint_as_float(z.y << 16), __uint_as_float(z.y & 0xffff0000u)};
                y[cq] = __builtin_amdgcn_mfma_f32_16x16x32_bf16(A0, Bf[cq][0], y[cq], 0, 0, 0); y[cq] = __builtin_amdgcn_mfma_f32_16x16x32_bf16(A1, Bf[cq][1], y[cq], 0, 0, 0); }
#pragma unroll
            for (int r = 0; r < 4; ++r) { const int t = t0 + 16 * ta + 4 * q + r;
                float sm = row16_sum(y[0][r] + y[1][r] + y[2][r] + y[3][r]);
                const float mean = sm * (1.0f / 64.0f); float d[4], vs = 0.f;
#pragma unroll
                for (int cq = 0; cq < 4; ++cq) { d[cq] = y[cq][r] - mean; vs += d[cq] * d[cq]; }
                vs = row16_sum(vs);
                const float rstd = rsqrtf(vs * (1.0f / 64.0f) + 64e-5f); const float bon = bonusg[(size_t)t * 8 + h];
#pragma unroll
                for (int cq = 0; cq < 4; ++cq) { const int col = h * 64 + 16 * cq + m; const float v = rwkv_mixed(proj, mu, t, PC_V + col);
                    bf16_t* op = orwkv + (size_t)t * 512 + col; const float g = bf2f(*op);
                    *op = (bf16_t)f2bf((d[cq] * rstd * lnw[cq] + lnb[cq] + bon * v) * g); } }
        }
    }
}


constexpr int AT_K = 0, AT_V = 9216, AT_SCORE = 18432  , AT_BIAS = 83968, AT_SELM = 100352, AT_LIST = 104448, AT_NLIST = 105472, AT_NEED = 105504;
__device__ __forceinline__ void vt_transpose(const Ctx& c, const bf16_t* proj, bf16_t* vt) {
    LAS bf16_t* tl = (LAS bf16_t*)c.lds;
    for (int it = c.bid; it < 3 * 2 * 256; it += c.G) {
        const int which = it / 512, g = (it >> 8) & 1, tt = it & 255;
        const int col = (which == 0 ? PC_VS : (which == 1 ? PC_VW : PC_SV)) + g * 64;
        { const int tok = c.tid >> 3, ch = c.tid & 7; const u32x4 w = *(const u32x4*)(proj + (size_t)(tt * 64 + tok) * PLD + col + ch * 8);
          *(LAS u32x4*)(tl + tok * 72 + ch * 8) = w; }
        __syncthreads();
        { const int d = c.tid >> 3, ch = c.tid & 7; unsigned short e[8];
#pragma unroll
          for (int k = 0; k < 8; ++k) e[k] = tl[(ch * 8 + k) * 72 + d];
          u32x4 w; w.x = e[0] | ((unsigned)e[1] << 16); w.y = e[2] | ((unsigned)e[3] << 16); w.z = e[4] | ((unsigned)e[5] << 16); w.w = e[6] | ((unsigned)e[7] << 16);
          *(u32x4*)(vt + ((size_t)(which * 2 + g) * 64 + d) * T + tt * 64 + ch * 8) = w; }
        __syncthreads();
    }
}

template <int MODE, int NQ, int DBG = 0>
__device__ __forceinline__ void phase_attn(const Ctx& c, const Args& a, int layer, const bf16_t* proj, const bf16_t* vtb, const bf16_t* kcb, const bf16_t* vctb,
                                           unsigned* sel, float* nsaacc, bf16_t* oout) {
    LAS unsigned char* L = c.lds;
    LAS float* sscore = (LAS float*)(L + AT_SCORE);
    LAS float* biasd = (LAS float*)(L + AT_BIAS);
    LAS unsigned* selm = (LAS unsigned*)(L + AT_SELM);
    LAS int* list = (LAS int*)(L + AT_LIST);
    LAS int* nlist = (LAS int*)(L + AT_NLIST);
    LAS unsigned* need = (LAS unsigned*)(L + AT_NEED);
    const int lane = c.lane, wave = c.wave, n = lane & 15, q = lane >> 4, hr = n & 3;
    constexpr int TW = 4 * NQ, TB = 8 * TW, NU = T / TB, TS = (MODE == 3) ? 4 : 1;
    for (int unit = c.bid; unit < 2 * NU; unit += c.G) {
        const int g = unit / NU, t0 = ((g == 0) ? (unit % NU) : (NU - 1 - unit % NU)) * TB, tw0 = t0 + wave * TW;
        __syncthreads();
        for (int e = c.tid; e < 4096; e += 512) { const int r = e >> 10, d = e & 1023; biasd[e] = inptr(c, I_REL)[t5_bucket(d) * 16 + (MODE == 0 ? 8 : 0) + g * 4 + r]; }
        if (MODE == 3) {
            if (c.tid < 8) need[c.tid] = 0u;
            __syncthreads();
            { const int tok = c.tid >> 3, w8 = c.tid & 7; const unsigned mw = selp((unsigned char*)sel, t0 + tok, g)[w8]; selm[tok * 8 + w8] = mw; atomicOr((unsigned*)&need[w8], mw); }
            __syncthreads();
            if (c.tid < 256) { const int j = c.tid; const unsigned wd = need[j >> 5];
                if ((wd >> (j & 31)) & 1u) { int pos = __popc(wd & ((1u << (j & 31)) - 1u)); for (int w2 = 0; w2 < (j >> 5); ++w2) pos += __popc(need[w2]); list[pos] = j; } }
            if (c.tid == 0) { int cnt = 0; for (int w2 = 0; w2 < 8; ++w2) cnt += __popc(need[w2]); nlist[0] = cnt; }
        }
        __syncthreads();
        int ntiles, tile_lo = 0;
        if (MODE == 0) { ntiles = 2 + TB / 64; tile_lo = t0 - 128; }
        else if (MODE == 1) { ntiles = 8 + TB / 64; tile_lo = t0 - 512; }
        else if (MODE == 2) { const int cmax = (t0 + TB - 1 - 31) >> 4; ntiles = cmax < 0 ? 0 : (cmax >> 6) + 1; }
        else ntiles = nlist[0];
        const bf16_t* Ksrc; size_t kstride; const bf16_t* Vsrc; size_t vstride; int qcol;
        if (MODE == 0) { Ksrc = proj + PC_SK + g * 64; kstride = PLD; Vsrc = vtb + (size_t)(4 + g) * 64 * T; vstride = T; qcol = PC_SQ + g * 256; }
        else if (MODE == 1) { Ksrc = proj + PC_KW + g * 64; kstride = PLD; Vsrc = vtb + (size_t)(2 + g) * 64 * T; vstride = T; qcol = PC_NQ + g * 256; }
        else if (MODE == 2) { Ksrc = kcb + (size_t)g * 1024 * 64; kstride = 64; Vsrc = vctb + (size_t)g * 64 * 1024; vstride = 1024; qcol = PC_NQ + g * 256; }
        else { Ksrc = proj + PC_KS + g * 64; kstride = PLD; Vsrc = vtb + (size_t)(0 + g) * 64 * T; vstride = T; qcol = PC_NQ + g * 256; }
        bf16x8 Bq[NQ][2];
#pragma unroll
        for (int qd = 0; qd < NQ; ++qd) { const bf16_t* qp = proj + (size_t)(tw0 + 4 * qd + (n >> 2)) * PLD + qcol + hr * 64 + 8 * q;
            Bq[qd][0] = *(const bf16x8*)qp; Bq[qd][1] = *(const bf16x8*)(qp + 32); }
        const float bfar = biasd[hr * 1024 + 1023];
        float mrun[NQ], lrun[NQ]; f32x4 O[NQ][4];
#pragma unroll
        for (int qd = 0; qd < NQ; ++qd) { mrun[qd] = -1e30f; lrun[qd] = 0.f;
#pragma unroll
            for (int dt = 0; dt < 4; ++dt) O[qd][dt] = (f32x4){0.f, 0.f, 0.f, 0.f}; }
        float carry3[NQ]; for (int i = 0; i < NQ; ++i) carry3[i] = 0.f;
        const int npass = (MODE == 2) ? 2 : 1;
        for (int pass = 0; pass < npass; ++pass) {
            const bool do_pv = (MODE != 2) || pass == 1;
            float linv[NQ];
            if (MODE == 2 && pass == 1) {
#pragma unroll
                for (int qd = 0; qd < NQ; ++qd) { float mt = mrun[qd]; mt = fmaxf(mt, __shfl_xor(mt, 16)); mt = fmaxf(mt, __shfl_xor(mt, 32));
                    float lt = lrun[qd] * __expf(mrun[qd] - mt); lt += __shfl_xor(lt, 16); lt += __shfl_xor(lt, 32); mrun[qd] = mt; linv[qd] = lt > 0.f ? 1.0f / lt : 0.f; }
            }
#define AT_TILEPOS(ti) ((MODE == 3) ? list[ti] * 64 : (MODE == 2 ? (ti) * 64 : tile_lo + (ti) * 64))
#define AT_ISSUE(rd) do { _Pragma("unroll") for (int i_ = 0; i_ < TS; ++i_) { const int ti_ = (rd) * TS + i_; p0n[i_] = ti_ < ntiles ? AT_TILEPOS(ti_) : -1; \
        if (p0n[i_] >= 0) { kreg[i_] = *(const u32x4*)(Ksrc + (size_t)(p0n[i_] + (c.tid >> 3)) * kstride + (c.tid & 7) * 8); \
            if (do_pv) vreg[i_] = *(const u32x4*)(Vsrc + (size_t)(c.tid >> 3) * vstride + p0n[i_] + (c.tid & 7) * 8); } } } while (0)
            u32x4 kreg[TS], vreg[TS]; int p0n[TS];
            const int nrounds = (ntiles + TS - 1) / TS;
            if (nrounds > 0) AT_ISSUE(0);
            for (int rd = 0; rd < nrounds; ++rd) {
                int p0s[TS];
#pragma unroll
                for (int i = 0; i < TS; ++i) p0s[i] = p0n[i];
                __syncthreads();
#pragma unroll
                for (int i = 0; i < TS; ++i) if (p0s[i] >= 0) { *(LAS u32x4*)(L + AT_K + i * 18432 + (c.tid >> 3) * 144 + (c.tid & 7) * 16) = kreg[i];
                    if (do_pv) *(LAS u32x4*)(L + AT_V + i * 18432 + (c.tid >> 3) * 144 + (c.tid & 7) * 16) = vreg[i]; }
                if (rd + 1 < nrounds) AT_ISSUE(rd + 1);
                __syncthreads();
#pragma unroll
              for (int ts = 0; ts < TS; ++ts) {
                const int p0 = p0s[ts]; const int LK = AT_K + ts * 18432, LV = AT_V + ts * 18432;
                if (p0 < 0) continue;
                if (MODE == 0) { if (p0 > tw0 + TW - 1 || p0 + 63 < tw0 - 127) continue; }
                if (MODE == 1) { if (p0 > tw0 + TW - 1 || p0 + 63 < tw0 - 511) continue; }
                if (MODE == 2) { if (16 * p0 + 31 > tw0 + TW - 1) continue; }
                if (MODE == 3) { if (p0 > tw0 + TW - 1) continue; }
                const bool far = (MODE == 2) ? (tw0 - (16 * (p0 + 63) + 31) >= 790) : ((MODE == 3) ? (tw0 - (p0 + 63) >= 790) : false);
                const int jblk = p0 >> 6;
                bf16x8 akf[4][2]; bf16x8 avf[2][4];
                if (MODE != 3) {
#pragma unroll
                    for (int kt = 0; kt < 4; ++kt)
#pragma unroll
                        for (int ks = 0; ks < 2; ++ks) akf[kt][ks] = *(const LAS bf16x8*)(L + LK + (16 * kt + n) * 144 + (32 * ks + 8 * q) * 2);
                    if (do_pv) {
#pragma unroll
                        for (int st = 0; st < 2; ++st)
#pragma unroll
                            for (int dt = 0; dt < 4; ++dt) { const LAS unsigned char* vp = L + LV + (16 * dt + n) * 144 + (32 * st + 4 * q) * 2;
                                const u32x2 v0 = *(const LAS u32x2*)vp, v1 = *(const LAS u32x2*)(vp + 32); u32x4 vw; vw.x = v0.x; vw.y = v0.y; vw.z = v1.x; vw.w = v1.y; avf[st][dt] = __builtin_bit_cast(bf16x8, vw); } }
                }
                unsigned tokmask = 0u;
                if (MODE == 3) { tokmask = (unsigned)__ballot(lane < TW && ((selm[(wave * TW + (lane & (TW - 1))) * 8 + (jblk >> 5)] >> (jblk & 31)) & 1u)); if (tokmask == 0u) continue; }
#pragma unroll
                for (int qd = 0; qd < NQ; ++qd) {
                    const int tq = tw0 + 4 * qd + (n >> 2);
                    if (DBG == 3) continue;
                    bool colsel = true;
                    if (MODE == 3) { colsel = (tokmask >> (4 * qd + (n >> 2))) & 1u; if (((tokmask >> (4 * qd)) & 0xfu) == 0u) continue; }
                    {
                        f32x4 sc[4];
#pragma unroll
                        for (int kt = 0; kt < 4; ++kt) { sc[kt] = (f32x4){0.f, 0.f, 0.f, 0.f};
#pragma unroll
                            for (int ks = 0; ks < 2; ++ks) { const bf16x8 ak = (MODE != 3) ? akf[kt][ks] : *(const LAS bf16x8*)(L + LK + (16 * kt + n) * 144 + (32 * ks + 8 * q) * 2);
                                sc[kt] = __builtin_amdgcn_mfma_f32_16x16x32_bf16(ak, Bq[qd][ks], sc[kt], 0, 0, 0); } }
                        float mx = -1e30f;
                        if (far) {
#pragma unroll
                            for (int kt = 0; kt < 4; ++kt)
#pragma unroll
                                for (int r = 0; r < 4; ++r) { const float s2 = (MODE == 3 && !colsel) ? -1e30f : sc[kt][r] + bfar; sc[kt][r] = s2; mx = fmaxf(mx, s2); }
                        } else {
#pragma unroll
                        for (int kt = 0; kt < 4; ++kt)
#pragma unroll
                            for (int r = 0; r < 4; ++r) { const int kl = 16 * kt + 4 * q + r; int dist; bool v;
                                if (MODE == 2) { dist = tq - (16 * (p0 + kl) + 31); v = dist >= 0; }
                                else { dist = tq - (p0 + kl); v = dist >= 0; if (MODE == 0) v = v && dist < 128; if (MODE == 1) v = v && dist < 512; if (MODE == 3) v = v && colsel; }
                                const int di = dist < 0 ? 0 : (dist > 1023 ? 1023 : dist);
                                const float s2 = v ? sc[kt][r] + biasd[hr * 1024 + di] : -1e30f; sc[kt][r] = s2; mx = fmaxf(mx, s2); }
                        }
                        float p[4][4];
                        if (MODE == 2 && pass == 1) {
#pragma unroll
                            for (int kt = 0; kt < 4; ++kt)
#pragma unroll
                                for (int r = 0; r < 4; ++r) p[kt][r] = __expf(sc[kt][r] - mrun[qd]) * linv[qd];
                        } else if (MODE == 2) {
                            const float mn = fmaxf(mrun[qd], mx), corr = __expf(mrun[qd] - mn); mrun[qd] = mn; float ps = 0.f;
                            const float mne = mn < -1e29f ? 0.f : mn;
#pragma unroll
                            for (int kt = 0; kt < 4; ++kt)
#pragma unroll
                                for (int r = 0; r < 4; ++r) ps += __expf(sc[kt][r] - mne);
                            lrun[qd] = lrun[qd] * corr + ps;
                        } else {
                            if (__any(mx > mrun[qd])) {
                                mx = fmaxf(mx, __shfl_xor(mx, 16)); mx = fmaxf(mx, __shfl_xor(mx, 32));
                                const float mn = fmaxf(mrun[qd], mx), corr = __expf(mrun[qd] - mn); mrun[qd] = mn;
                                lrun[qd] *= corr;
#pragma unroll
                                for (int dt = 0; dt < 4; ++dt) O[qd][dt] = O[qd][dt] * corr;
                            }
                            const float mne = mrun[qd] < -1e29f ? 0.f : mrun[qd]; float ps = 0.f;
#pragma unroll
                            for (int kt = 0; kt < 4; ++kt)
#pragma unroll
                                for (int r = 0; r < 4; ++r) { p[kt][r] = (DBG == 2) ? sc[kt][r] - mne : __expf(sc[kt][r] - mne); ps += p[kt][r]; }
                            lrun[qd] += ps;
                        }
                        if (MODE == 2 && pass == 1) {
                            float i3prev = carry3[qd];
#pragma unroll
                            for (int kt = 0; kt < 4; ++kt) { float im[4];
#pragma unroll
                                for (int r = 0; r < 4; ++r) { float v = p[kt][r]; v += dpp_xor1(v); v += dpp_xor2(v); im[r] = v; }
                                const float same = __shfl(im[3], (lane + 48) & 63), prevt = __shfl(i3prev, (lane + 48) & 63);
                                const float pv3 = q > 0 ? same : prevt;
                                const int jg = (p0 + 16 * kt + 4 * q) >> 2;
                                if (hr == 0 && jg < 256) sscore[(tq - t0) * 256 + jg] = 2.0f * (im[0] + im[1] + im[2]) + im[3] + pv3;
                                i3prev = im[3]; }
                            carry3[qd] = i3prev;
                        }
                        if (do_pv && DBG != 1) {
#pragma unroll
                            for (int st = 0; st < 2; ++st) {
                                u32x4 pw; pw.x = pk2(p[2 * st][0], p[2 * st][1]); pw.y = pk2(p[2 * st][2], p[2 * st][3]); pw.z = pk2(p[2 * st + 1][0], p[2 * st + 1][1]); pw.w = pk2(p[2 * st + 1][2], p[2 * st + 1][3]);
                                const bf16x8 pf = __builtin_bit_cast(bf16x8, pw);
#pragma unroll
                                for (int dt = 0; dt < 4; ++dt) { bf16x8 av;
                                    if (MODE != 3) av = avf[st][dt];
                                    else { const LAS unsigned char* vp = L + LV + (16 * dt + n) * 144 + (32 * st + 4 * q) * 2;
                                        const u32x2 v0 = *(const LAS u32x2*)vp, v1 = *(const LAS u32x2*)(vp + 32); u32x4 vw; vw.x = v0.x; vw.y = v0.y; vw.z = v1.x; vw.w = v1.y; av = __builtin_bit_cast(bf16x8, vw); }
                                    O[qd][dt] = __builtin_amdgcn_mfma_f32_16x16x32_bf16(av, pf, O[qd][dt], 0, 0, 0); } }
                        }
                    }
                }
              }
            }
        }
#undef AT_ISSUE
#undef AT_TILEPOS
        if (MODE == 2) {
            __syncthreads();
#pragma unroll 1
            for (int tk = 0; tk < TW; ++tk) { const int t = tw0 + tk, cur = t >> 6; const LAS float* sp = sscore + (wave * TW + tk) * 256;
                unsigned key[4]; bool forced[4];
#pragma unroll
                for (int jj = 0; jj < 4; ++jj) { const int j = lane + 64 * jj; forced[jj] = (j == 0 || j == cur || j == cur - 1);
                    key[jj] = (!forced[jj] && j < cur - 1) ? __float_as_uint(sp[j]) + 1u : 0u; }
                const int nforced = cur >= 2 ? 3 : cur + 1;
                unsigned prefix = 0u; int remaining = 16 - nforced;
#pragma unroll 1
                for (int bit = 30; bit >= 0; --bit) { const unsigned test = prefix | (1u << bit); int cnt = 0;
#pragma unroll
                    for (int jj = 0; jj < 4; ++jj) cnt += __popcll(__ballot((key[jj] >> bit) == (test >> bit)));
                    if (cnt >= remaining) prefix = test; else remaining -= cnt; }
                int eqbase = 0;
#pragma unroll
                for (int jj = 0; jj < 4; ++jj) { const bool eq = key[jj] == prefix && key[jj] != 0u; const unsigned long long eb = __ballot(eq);
                    const int eqrank = eqbase + __popcll(eb & ((1ull << lane) - 1ull)); eqbase += __popcll(eb);
                    const bool on = forced[jj] || key[jj] > prefix || (eq && eqrank < remaining); const unsigned long long bl = __ballot(on);
                    if (lane == 0) { unsigned* mp = selp((unsigned char*)sel, t, g); mp[2 * jj] = (unsigned)bl; mp[2 * jj + 1] = (unsigned)(bl >> 32); } }
            }
        }
#pragma unroll
        for (int qd = 0; qd < NQ; ++qd) {
            const int tq = tw0 + 4 * qd + (n >> 2), hh = g * 4 + hr;
            float scale;
            if (MODE == 2) scale = 1.0f;
            else { float lt = lrun[qd]; lt += __shfl_xor(lt, 16); lt += __shfl_xor(lt, 32);
                if (MODE == 0) { const float sink = inptr(c, I_SINK)[layer * 8 + hh]; const float mf = fmaxf(mrun[qd], sink), cr = __expf(mrun[qd] - mf); scale = cr / (lt * cr + __expf(sink - mf)); }
                else scale = lt > 0.f ? 1.0f / lt : 0.f; }
            if (MODE != 0) scale *= sigmoidf_(bf2f(proj[(size_t)tq * PLD + PC_GL + (MODE == 2 ? 0 : (MODE == 3 ? 8 : 16)) + hh]));
#pragma unroll
            for (int dt = 0; dt < 4; ++dt) { const f32x4 o = O[qd][dt] * scale; const int col = hh * 64 + 16 * dt + 4 * q;
                if (MODE == 0) { u32x2 w; w.x = pk2(o[0], o[1]); w.y = pk2(o[2], o[3]); *(u32x2*)(oout + (size_t)tq * 512 + col) = w; }
                else if (MODE == 2) *(f32x4*)(nsaacc + (size_t)tq * 512 + col) = o;
                else if (MODE == 1) { f32x4* ap = (f32x4*)(nsaacc + (size_t)tq * 512 + col); *ap = *ap + o; }
                else { const f32x4 t2 = *(const f32x4*)(nsaacc + (size_t)tq * 512 + col) + o; u32x2 w; w.x = pk2(t2[0], t2[1]); w.y = pk2(t2[2], t2[3]); *(u32x2*)(oout + (size_t)tq * 512 + col) = w; } }
        }
    }
}
__device__ __forceinline__ void phase_topk2(const Ctx& c, const float* scores, int* sel) {
    const int gw = c.bid * 8 + c.wave, NGW = c.G * 8;
    for (int item = gw; item < T * 2; item += NGW) {
        const int t = item >> 1, g = item & 1, cur = t >> 6;
        const float* sp = scores + ((size_t)g * T + t) * 256;
        float val[4];
#pragma unroll
        for (int jj = 0; jj < 4; ++jj) { const int j = c.lane + 64 * jj; float sc;
            if (j == 0 || j == cur || j == cur - 1) sc = 1e4f; else if (j > cur) sc = -1.0f; else sc = sp[j];
            val[jj] = sc; }
        for (int k = 0; k < 16; ++k) {
            float bv = val[0]; int bi = c.lane;
#pragma unroll
            for (int jj = 1; jj < 4; ++jj) if (val[jj] > bv) { bv = val[jj]; bi = c.lane + 64 * jj; }
#pragma unroll
            for (int o = 32; o >= 1; o >>= 1) { const float ov = __shfl_xor(bv, o); const int oi = __shfl_xor(bi, o); if (ov > bv || (ov == bv && oi < bi)) { bv = ov; bi = oi; } }
#pragma unroll
            for (int jj = 0; jj < 4; ++jj) if (bi == c.lane + 64 * jj) val[jj] = -3e38f;
            if (c.lane == 0) sel[(size_t)item * 16 + k] = bi;
        }
    }
}

#define wb ((bf16_t*)(ws + WS_WB))
#define xb ((bf16_t*)(ws + WS_XB))
#define cntp ((unsigned*)(ws + WS_CNT))
#define xres (args.out)
#define kcb ((bf16_t*)(ws + WS_KCB))
#define vctb ((bf16_t*)(ws + WS_VCT))
#define vtb ((bf16_t*)(ws + WS_VT))
#define scores ((float*)(ws + WS_SCORES))
#define sel ((unsigned*)ws)
#define ml ((float*)(ws + WS_ML))
#define hidb ((bf16_t*)(ws + WS_HID))
#define proj ((bf16_t*)(ws + WS_PROJ))
#define gates ((bf16_t*)(ws + WS_GATES))
#define merged ((bf16_t*)(ws + WS_MERGED))
#define tmpb ((bf16_t*)(ws + WS_TMPB))
#define alora ((bf16_t*)(ws + WS_ALORA))
#define rwu ((bf16_t*)(ws + WS_RWU))
#define rws ((bf16_t*)(ws + WS_RWS))
#define bonusg ((float*)(ws + WS_BONUS))
#define nsaacc ((float*)(ws + WS_NSAACC))
#define obuf ((bf16_t*)(ws + WS_O))
#define act ((bf16_t*)(ws + WS_ACT))
#define tmpf ((bf16_t*)(ws + WS_TMPF))
constexpr int PH_PER_BATCH = 8, PH_PER_LAYER = 1 + 2 * PH_PER_BATCH + 2, PH_TOTAL = 1 + DEPTH * PH_PER_LAYER;

__global__ void __launch_bounds__(512, 2) fwd_kernel(Args args) {
    extern __shared__ __attribute__((aligned(16))) unsigned char lds_raw[];
    Ctx c0; c0.lds = (LAS unsigned char*)lds_raw; c0.tid = threadIdx.x; c0.lane = c0.tid & 63; c0.wave = __builtin_amdgcn_readfirstlane(c0.tid >> 6); c0.G = gridDim.x; c0.bid = blockIdx.x; const Ctx& c = c0;
    unsigned char* ws = args.ws;
    volatile LAS unsigned* misc = (volatile LAS unsigned*)(c.lds + LDS_MISC);
    if (c.tid < 4) misc[c.tid] = 0u;
    if (c.tid < 30) { const unsigned long long pv = (unsigned long long)args.in[c.tid & 31]; misc[16 + 2 * c.tid] = (unsigned)pv; misc[17 + 2 * c.tid] = (unsigned)(pv >> 32); }
    __syncthreads();
    XcdBarrier bar; bar.bar = (unsigned*)(ws + WS_CTL); bar.x = 0; bar.st = misc;
    const int lo = args.lo, hi = args.hi;
    const bool multi = (hi - lo) > 1;
    if (multi) bar = xcd_barrier_post((unsigned*)(ws + WS_CTL), misc);
    int gp = 0;
#ifndef ONLY_PH
#define ONLY_PH -1
#endif
#ifndef PHMASK
#define PHMASK 0xffffff
#endif
#ifndef REPMASK
#define REPMASK 0
#endif
#ifndef PR_SEL
#define PR_SEL 0
#endif
#ifndef PR_SWA
#define PR_SWA 0
#endif
#ifndef PR_CMP
#define PR_CMP 0
#endif
#ifndef PR_CHUNK
#define PR_CHUNK 0
#endif
#define PHASE_BEGIN(id) if (gp >= lo && gp < hi) { for (int rep_ = 0; rep_ < (((REPMASK >> (id)) & 1) ? 2 : 1); ++rep_) { if (rep_) __syncthreads(); \
    Ctx pc = c0; asm volatile("" : "+v"(pc.tid), "+s"(pc.bid)); pc.lane = pc.tid & 63; pc.wave = __builtin_amdgcn_readfirstlane(pc.tid >> 6); const Ctx& c = pc;
#define PHASE_END   } if (gp + 1 < hi) xcd_barrier(bar); } ++gp;
#define RELAUNDER() do { asm volatile("" : "+v"(pc.tid), "+s"(pc.bid)); pc.lane = pc.tid & 63; pc.wave = __builtin_amdgcn_readfirstlane(pc.tid >> 6); } while (0)

    PHASE_BEGIN(0) phase_init(c, inptr(c, I_X), xres, xb, ws); PHASE_END

    for (int layer = 0; layer < DEPTH; ++layer) {
        PHASE_BEGIN(1) phase_cvt(c, args, layer, wb); PHASE_END
        for (int b = 0; b < NBATCH; ++b) {
            const int row0 = b * T;
            PHASE_BEGIN(2) {
                pg8::Gemm g{xb + (size_t)row0 * D, wb + WB_WIN, D, D, D}; pg8::Sched S; S.init(T / 256, NIN / 256, c.G, c.bid, 1, (size_t)256 * D * 2, 0, (size_t)256 * D * 2, 0);
                pg8::EpiInProj E{proj, gates, ws, row0}; pg8::gemm_phase(c.lds, c.tid, g, S, E); } PHASE_END
            PHASE_BEGIN(16) {
                { pg8::Gemm g{proj, wb + WB_W1T, 16 * PLD, 2048, 2048, (unsigned)PLD * 2}; pg8::Sched S; S.init(16, 1, c.G, c.bid, 1, 0, 0, 0, 0); S.mode = 1;
                  pg8::EpiCmp1 E{hidb, (const float*)(wb + WB_BH)}; pg8::gemm_phase(c.lds, c.tid, g, S, E); }
                RELAUNDER();
                if (c.bid >= 16) { Ctx cv = c; cv.bid = c.bid - 16; cv.G = c.G - 16; phase_lora_a(cv, args, layer, proj, alora); vt_transpose(cv, proj, vtb); } } PHASE_END
            PHASE_BEGIN(17) {
                { pg8::Gemm g{alora, wb + WB_LORA, 256, 256, 256}; pg8::Sched S; S.init(T / 256, 6, c.G, c.bid, 1, (unsigned)256 * 256 * 2, 0, (unsigned)256 * 256 * 2, 0);
                  pg8::EpiLora E{obuf}; pg8::gemm_phase(c.lds, c.tid, g, S, E); }
                RELAUNDER();
                { pg8::Gemm g{hidb, wb + WB_W2T, 256, 256, 256}; pg8::Sched S; S.init(16, 1, c.G, (c.bid + 16) % c.G, 1, (unsigned)256 * 256 * 2, 0, 0, 0); S.mode = 2;
                  pg8::EpiCmp2 E{kcb, vctb}; pg8::gemm_phase(c.lds, c.tid, g, S, E); } } PHASE_END
            PHASE_BEGIN(18) {
                for (int pr_ = 0; pr_ <= PR_CHUNK; ++pr_) { phase_rwkv_chunk(c, args, layer, proj, obuf + (size_t)T * 512, obuf + (size_t)2 * T * 512, rwu, bonusg);
                __syncthreads(); RELAUNDER(); }
                for (int pr_ = 0; pr_ <= PR_CMP; ++pr_) { phase_attn<2, 2>(c, args, layer, proj, vtb, kcb, vctb, sel, nsaacc, obuf + (size_t)T * 512); __syncthreads(); } } PHASE_END
            PHASE_BEGIN(19) {
                phase_rwkv_scan<0>(c, rwu, rws);
                RELAUNDER();
                if (c.bid >= 32) { Ctx cv = c; cv.bid = c.bid - 32; cv.G = c.G - 32;
                    phase_attn<1, 2>(cv, args, layer, proj, vtb, kcb, vctb, sel, nsaacc, obuf + (size_t)T * 512);
                    asm volatile("" : "+v"(cv.tid), "+s"(cv.bid)); cv.lane = cv.tid & 63; cv.wave = __builtin_amdgcn_readfirstlane(cv.tid >> 6);
                    for (int pr_ = 0; pr_ <= PR_SWA; ++pr_) { phase_attn<0, 2>(cv, args, layer, proj, vtb, kcb, vctb, sel, nsaacc, obuf + (size_t)2 * T * 512); __syncthreads(); } } } PHASE_END
            PHASE_BEGIN(9) {
                phase_rwkv_out(c, args, layer, proj, rwu, rws, bonusg, obuf);
                __syncthreads(); RELAUNDER();
                #if PR_SEL > 1
                { phase_attn<3, 2, PR_SEL - 1>(c, args, layer, proj, vtb, kcb, vctb, sel, nsaacc, obuf + (size_t)T * 512); __syncthreads(); }
#endif
                for (int pr_ = 0; pr_ <= (PR_SEL == 1 ? 1 : 0); ++pr_) { phase_attn<3, 2>(c, args, layer, proj, vtb, kcb, vctb, sel, nsaacc, obuf + (size_t)T * 512); __syncthreads(); } } PHASE_END
            PHASE_BEGIN(10) {
                pg8::Gemm g{obuf, wb + WB_WBR, 512, 512, 512}; pg8::Sched S; S.init(T / 256, D / 256, c.G, c.bid, 3, (size_t)256 * 512 * 2, (size_t)T * 512 * 2, (size_t)256 * 512 * 2, (size_t)D * 512 * 2);
                pg8::EpiMerge E{gates, merged}; pg8::gemm_phase(c.lds, c.tid, g, S, E); } PHASE_END
            PHASE_BEGIN(11) {
                pg8::Gemm g{merged, wb + WB_WOUT, D, D, D}; pg8::Sched S; S.init(T / 256, D / 256, c.G, c.bid, 1, (unsigned)256 * D * 2, 0, (unsigned)256 * D * 2, 0);
                pg8::EpiNorm E{xres, xb, inptr(c, I_NQM) + layer * D, ws, cntp, row0, 1, 16u * (2u * layer + 1u), c.lds, c.tid}; pg8::gemm_phase(c.lds, c.tid, g, S, E); } PHASE_END
        }
        PHASE_BEGIN(13) {
            pg8::Gemm g{xb, wb + WB_WGU, D, D, D}; pg8::Sched S; S.init(MROWS / 256, 2 * FFN / 256, c.G, c.bid, 1, (size_t)256 * D * 2, 0, (size_t)256 * D * 2, 0);
            pg8::EpiSwiGLU E{act, ws}; pg8::gemm_phase(c.lds, c.tid, g, S, E); } PHASE_END
        PHASE_BEGIN(14) {
            { pg8::Gemm g{act, wb + WB_WDN, FFN, FFN, FFN}; pg8::Sched S; S.init(T / 256, D / 256, c.G, c.bid, 1, (unsigned)256 * FFN * 2, 0, (unsigned)256 * FFN * 2, 0);
              pg8::EpiNorm E{xres, xb, inptr(c, I_NQF) + layer * D, ws, cntp, 0, 0, 16u * (2u * layer + 2u), c.lds, c.tid}; pg8::gemm_phase(c.lds, c.tid, g, S, E); }
            __syncthreads(); RELAUNDER();
            { pg8::Gemm g{act + (size_t)T * FFN, wb + WB_WDN, FFN, FFN, FFN}; pg8::Sched S; S.init(T / 256, D / 256, c.G, c.bid, 1, (unsigned)256 * FFN * 2, 0, (unsigned)256 * FFN * 2, 0);
              pg8::EpiNorm E{xres, xb, inptr(c, I_NQF) + layer * D, ws, cntp, T, 0, 16u * (2u * layer + 2u), c.lds, c.tid}; pg8::gemm_phase(c.lds, c.tid, g, S, E); } } PHASE_END
    }
#undef PHASE_BEGIN
#undef PHASE_END
}

extern "C" void kernel_launch(void* const* d_in, const int* in_sizes, int n_in, void* d_out, int out_size, void* d_ws, size_t ws_size, hipStream_t stream) {
    static int grid = 0;
    if (grid == 0) {
        if (n_in != 30 || out_size != MROWS * D || ws_size < WS_END) { fprintf(stderr, "kernel_launch: unexpected shapes (n_in %d out %d ws %zu)\n", n_in, out_size, ws_size); grid = -1; return; }
        int dev = 0, cus = 0;
        if (hipGetDevice(&dev) != hipSuccess || hipDeviceGetAttribute(&cus, hipDeviceAttributeMultiprocessorCount, dev) != hipSuccess) { grid = -1; return; }
        if (hipFuncSetAttribute((const void*)fwd_kernel, hipFuncAttributeMaxDynamicSharedMemorySize, LDS_BYTES) != hipSuccess) { fprintf(stderr, "hipFuncSetAttribute failed\n"); grid = -1; return; }
        int per_cu = 0;
        if (hipOccupancyMaxActiveBlocksPerMultiprocessor(&per_cu, (const void*)fwd_kernel, 512, LDS_BYTES) != hipSuccess || per_cu < 1) { fprintf(stderr, "occupancy query: %d\n", per_cu); }
        (void)hipGetLastError();
        grid = cus;
    }
    if (grid < 0) return;
    (void)hipMemsetAsync((char*)d_ws + WS_CTL, 0, CTL_BYTES, stream);
    Args a{};
    for (int i = 0; i < 30; ++i) a.in[i] = (const float*)d_in[i];
    a.out = (float*)d_out; a.ws = (unsigned char*)d_ws;
#if MK_ONE_LAUNCH
    a.lo = 0; a.hi = PH_TOTAL;
    hipLaunchKernelGGL(fwd_kernel, dim3(grid), dim3(512), LDS_BYTES, stream, a);
#else
    for (int p = 0; p < PH_TOTAL; ++p) { a.lo = p; a.hi = p + 1; hipLaunchKernelGGL(fwd_kernel, dim3(grid), dim3(512), LDS_BYTES, stream, a); }
#endif
}
```

```cpp
#include <hip/hip_runtime.h>
#include <stdint.h>
#include <stdio.h>

#ifndef MK_ONE_LAUNCH
#define MK_ONE_LAUNCH 1
#endif

#define LAS __attribute__((address_space(3)))
typedef unsigned short bf16_t;
typedef short bf16x8 __attribute__((ext_vector_type(8)));
typedef float f32x4 __attribute__((ext_vector_type(4)));
typedef float f32x2 __attribute__((ext_vector_type(2)));
typedef unsigned u32x4 __attribute__((ext_vector_type(4)));
typedef unsigned u32x2 __attribute__((ext_vector_type(2)));

constexpr int D = 1024, NBATCH = 2, T = 16384, DEPTH = 4, MROWS = NBATCH * T;
constexpr int IN_COLS = 6936, FFN = 2816;
constexpr int PLD = 4096;
constexpr int PC_R = 0, PC_K = 512, PC_V = 1024, PC_ZW = 1536, PC_ZA = 1600, PC_ZG = 1664;
constexpr int PC_NQ = 1792, PC_KC = 2304, PC_VC = 2432, PC_KS = 2560, PC_VS = 2688, PC_KW = 2816, PC_VW = 2944, PC_GL = 3072;
constexpr int PC_SQ = 3328, PC_SK = 3840, PC_SV = 3968;
constexpr int NIN = 7168;
constexpr int NCMP = 1023;
constexpr float NORM_EPS = 1e-6f;

constexpr size_t MiB = 1u << 20;
constexpr size_t WS_CTL = 0, CTL_BYTES = 65536;
constexpr size_t WS_WB = 65536;
constexpr size_t WB_WIN = 0, WB_WBR = WB_WIN + (size_t)NIN * D, WB_WOUT = WB_WBR + (size_t)3 * D * 512, WB_WGU = WB_WOUT + (size_t)D * D,
                 WB_WDN = WB_WGU + (size_t)2 * FFN * D, WB_LORA = WB_WDN + (size_t)D * FFN, WB_W1T = WB_LORA + (size_t)1536 * 256, WB_W2T = WB_W1T + (size_t)2 * 256 * 2048,
                 WB_BH = WB_W2T + (size_t)2 * 256 * 256, WB_END = WB_BH + 1024;
static_assert(WS_WB + WB_END * 2 <= 38 * MiB + 786432, "weights");
constexpr size_t KiB = 1024;
constexpr size_t WS_XB = 38 * MiB + 768 * KiB;
constexpr size_t WS_CNT = 16384;
constexpr size_t WS_RS = WS_XB + 64 * MiB;
constexpr size_t WS_BONUS = WS_RS + 128 * KiB;
constexpr size_t WS_KCB = WS_BONUS + 512 * KiB;
constexpr size_t WS_VCT = WS_KCB + 256 * KiB;
constexpr size_t WS_STATS = WS_VCT + 256 * KiB;
constexpr size_t WS_SEL = WS_STATS;
constexpr size_t WS_HID = WS_SEL + 1 * MiB;
constexpr size_t WS_ML = WS_HID;
static_assert(WS_HID + 2 * MiB <= 107 * MiB, "small region");
constexpr size_t WS_ALORA = 107 * MiB;
constexpr size_t WS_VT = 115 * MiB;
constexpr size_t WS_BIG = 127 * MiB;
constexpr size_t WS_PROJ = WS_BIG;
constexpr size_t WS_GATES = WS_PROJ + 128 * MiB;
constexpr size_t WS_RWKVS = WS_GATES + 96 * MiB;
constexpr size_t WS_RWU = WS_RWKVS;
constexpr size_t WS_RWS = WS_RWKVS + 64 * MiB;
constexpr size_t WS_SCORES = WS_RWKVS;
constexpr size_t WS_MERGED = WS_RWKVS;
constexpr size_t WS_TMPB = WS_RWKVS + 32 * MiB;
constexpr size_t WS_NSAACC = WS_RWKVS + 80 * MiB;
constexpr size_t WS_O = WS_NSAACC + 32 * MiB;
constexpr size_t WS_END = WS_O + 48 * MiB;
constexpr size_t WS_ACT = WS_BIG;
constexpr size_t WS_TMPF = WS_BIG + 176 * MiB;
static_assert(WS_END <= 512 * MiB, "workspace");
static_assert(WS_TMPF + 64 * MiB <= WS_NSAACC, "ffn overlay");

constexpr int LDS_BYTES = 147456;
constexpr int LDS_MISC = 131072 + 8192;

__device__ __forceinline__ float* statp(unsigned char* ws, int row, int kind) {
    return (float*)(ws + WS_STATS + (kind >= 2 ? 524288 : 0)) + (size_t)row * 4; }
__device__ __forceinline__ unsigned* selp(unsigned char* ws, int t, int g) { return (unsigned*)(ws + WS_PROJ + (size_t)t * (PLD * 2) + 6272 + g * 32); }
__device__ __forceinline__ float bf2f(unsigned v) { return __uint_as_float(v << 16); }
typedef __bf16 bf16n2 __attribute__((ext_vector_type(2)));
__device__ __forceinline__ unsigned pk2(float lo, float hi) { const f32x2 f = {lo, hi}; const bf16n2 v = __builtin_convertvector(f, bf16n2); return __builtin_bit_cast(unsigned, v); }
__device__ __forceinline__ unsigned f2bf(float f) { return pk2(f, 0.f) & 0xffffu; }
__device__ __forceinline__ void unpack8(const u32x4 w, float (&f)[8]) {
    f[0] = __uint_as_float(w.x << 16); f[1] = __uint_as_float(w.x & 0xffff0000u); f[2] = __uint_as_float(w.y << 16); f[3] = __uint_as_float(w.y & 0xffff0000u);
    f[4] = __uint_as_float(w.z << 16); f[5] = __uint_as_float(w.z & 0xffff0000u); f[6] = __uint_as_float(w.w << 16); f[7] = __uint_as_float(w.w & 0xffff0000u);
}
#define DPPF(v, ctrl) __int_as_float(__builtin_amdgcn_update_dpp(0, __float_as_int(v), (ctrl), 0xf, 0xf, false))
__device__ __forceinline__ float row16_sum(float v) {
    v += DPPF(v, 0xB1); v += DPPF(v, 0x4E); v += DPPF(v, 0x141); v += DPPF(v, 0x140); return v;
}
__device__ __forceinline__ float wave_sum(float v) {
    v = row16_sum(v);
    const int iv = __float_as_int(v);
    return (__int_as_float(__builtin_amdgcn_readlane(iv, 0)) + __int_as_float(__builtin_amdgcn_readlane(iv, 16))) + (__int_as_float(__builtin_amdgcn_readlane(iv, 32)) + __int_as_float(__builtin_amdgcn_readlane(iv, 48)));
}
__device__ __forceinline__ float dpp_xor1(float v) { return __int_as_float(__builtin_amdgcn_update_dpp(0, __float_as_int(v), 0xB1, 0xf, 0xf, false)); }
__device__ __forceinline__ float dpp_xor2(float v) { return __int_as_float(__builtin_amdgcn_update_dpp(0, __float_as_int(v), 0x4E, 0xf, 0xf, false)); }
__device__ __forceinline__ float sigmoidf_(float x) { return __builtin_amdgcn_rcpf(1.0f + __expf(-x)); }
__device__ __forceinline__ int t5_bucket(int n) {
    if (n < 16) return n;
    int b = 16;
    b += (n >= 21); b += (n >= 27); b += (n >= 35); b += (n >= 46); b += (n >= 59); b += (n >= 77); b += (n >= 99); b += (n >= 128);
    b += (n >= 166); b += (n >= 216); b += (n >= 280); b += (n >= 363); b += (n >= 470); b += (n >= 609); b += (n >= 790);
    return b;
}

#define XB_TMO      128
#define XB_XCNT(j)  (256  + 64 * (j))
#define XB_XSUB(j)  (1280 + 64 * (j))
#define XB_XGEN(j)  (2304 + 64 * (j))
#define XB_TOP      3328
#define XB_TOPGEN   3392
#define XCD_BAR_WORDS 3456
#define XB_SPIN_CAP (1u << 22)
__device__ __forceinline__ unsigned xb_ld(unsigned* p)              { return __hip_atomic_load(p, __ATOMIC_RELAXED, __HIP_MEMORY_SCOPE_AGENT); }
__device__ __forceinline__ unsigned xb_add(unsigned* p, unsigned v) { return __hip_atomic_fetch_add(p, v, __ATOMIC_RELAXED, __HIP_MEMORY_SCOPE_AGENT); }
__device__ __forceinline__ unsigned xb_xcc_id() { return (unsigned)__builtin_amdgcn_s_getreg((3 << 11) | 20) & 0xFu; }
#define XB_SPIN(cond, bar) do { unsigned _sp = 0; while (cond) { __builtin_amdgcn_s_sleep(1); \
    if ((++_sp & 255u) == 0u) { if (xb_ld(&(bar)[XB_TMO])) break; if (_sp > XB_SPIN_CAP) { atomicAdd(&(bar)[XB_TMO], 1u); break; } } } } while (0)
struct XcdBarrier { unsigned* bar; unsigned x; volatile LAS unsigned* st; };
__device__ __forceinline__ XcdBarrier xcd_barrier_post(unsigned* bar, volatile LAS unsigned* st) {
    XcdBarrier b; b.bar = bar; b.x = xb_xcc_id(); b.st = st;
    if (threadIdx.x == 0) (void)xb_add(&bar[XB_XCNT(b.x)], 1u);
    return b;
}
__device__ __forceinline__ void xcd_barrier_complete(unsigned* bar, unsigned x, unsigned& nloc, unsigned& nx) {
    const unsigned G = gridDim.x * gridDim.y * gridDim.z;
    unsigned sum, cnt, mine, sp = 0u;
    for (;;) {
        sum = 0u; cnt = 0u; mine = 0u;
#pragma unroll
        for (unsigned j = 0; j < 16; ++j) { const unsigned c = xb_ld(&bar[XB_XCNT(j)]); sum += c; cnt += (c > 0u) ? 1u : 0u; mine = (j == x) ? c : mine; }
        if (sum == G) break;
        __builtin_amdgcn_s_sleep(1);
        if ((++sp & 255u) == 0u) { if (xb_ld(&bar[XB_TMO])) break; if (sp > XB_SPIN_CAP) { atomicAdd(&bar[XB_TMO], 1u); break; } }
    }
    nloc = mine > 0u ? mine : 1u; nx = cnt > 0u ? cnt : 1u;
}
__device__ __forceinline__ void xcd_barrier(const XcdBarrier& b) {
    asm volatile("s_waitcnt vmcnt(0)" ::: "memory");
    __syncthreads();
    if (threadIdx.x == 0) {
        unsigned* bar = b.bar;
        __builtin_amdgcn_s_waitcnt(0);
        unsigned nloc = b.st[0], nx = b.st[1];
        if (nloc == 0u) { xcd_barrier_complete(bar, b.x, nloc, nx); b.st[0] = nloc; b.st[1] = nx; }
        const unsigned old = xb_add(&bar[XB_XSUB(b.x)], 1u);
        const unsigned gen = old / nloc;
        if (old + 1u == (gen + 1u) * nloc) {
            __builtin_amdgcn_fence(__ATOMIC_RELEASE, "agent");
            asm volatile("s_waitcnt vmcnt(0)" ::: "memory");
            const unsigned og = xb_add(&bar[XB_TOP], 1u);
            const unsigned tg = og / nx;
            if (og + 1u == (tg + 1u) * nx) xb_add(&bar[XB_TOPGEN], 1u);
            else XB_SPIN(xb_ld(&bar[XB_TOPGEN]) == tg, bar);
            __builtin_amdgcn_fence(__ATOMIC_ACQUIRE, "agent");
            xb_add(&bar[XB_XGEN(b.x)], 1u);
            asm volatile("s_waitcnt vmcnt(0)" ::: "memory");
        } else {
            XB_SPIN(xb_ld(&bar[XB_XGEN(b.x)]) == gen, bar);
            __builtin_amdgcn_fence(__ATOMIC_ACQUIRE, "agent");
            asm volatile("s_waitcnt vmcnt(0)" ::: "memory");
        }
    }
    __syncthreads();
}

namespace pg8 {
constexpr int BM = 256, BK = 64, HALF = 128, HTB = HALF * BK * 2, STAGE_BYTES = 8 * HTB, NXCD = 8, WGM = 8;
__device__ __forceinline__ int lds_byte(int r, int c) { const int st = (r >> 4) * 2 + (c >> 5), rr = r & 15, cc = c & 31, ob = rr * 64 + cc * 2; return st * 1024 + (ob ^ (((ob >> 9) & 1) << 5)); }
__device__ __forceinline__ void stage_rc(int b, int& R, int& C) { const int st = b / 1024, sb = b % 1024, swz = sb ^ (((sb >> 9) & 1) << 5); R = (st >> 1) * 16 + swz / 64; C = (st & 1) * 32 + (swz % 64) / 2; }
__device__ __forceinline__ int perm32(int rho) { const int n = rho >> 4, i = rho & 15; return 8 * (i >> 2) + 4 * n + (i & 3); }

template <class E, class = void> struct epi_after_drain { static constexpr bool value = false; };
template <class E> struct epi_after_drain<E, decltype((void)E::AFTER_DRAIN)> { static constexpr bool value = E::AFTER_DRAIN; };
struct Unit { int pm, pn, sub; unsigned aoff, boff; };
struct Gemm { const bf16_t* A; const bf16_t* Bt; int lda, ldb, K; unsigned kstepA = 128; };
struct Sched {
    int nM, nN, nwg, G, c, nsub, mode = 0; unsigned a_row, a_sub, b_row, b_sub;
    __device__ __forceinline__ void init(int nM_, int nN_, int G_, int c_, int nsub_, unsigned a_row_, unsigned a_sub_, unsigned b_row_, unsigned b_sub_) {
        nM = nM_; nN = nN_; nwg = nM * nN; G = G_; c = c_; nsub = nsub_; a_row = a_row_; a_sub = a_sub_; b_row = b_row_; b_sub = b_sub_; }
    __device__ __forceinline__ bool next(int i, Unit& u) const {
        const int round = i / nsub; u.sub = i - round * nsub;
        const long L = (long)round * G + c; if (L >= nwg) return false;
        int wgid = (int)L; { const int q = nwg / NXCD, r = nwg % NXCD, xcd = wgid % NXCD, off = wgid / NXCD; wgid = (xcd < r ? xcd * (q + 1) : r * (q + 1) + (xcd - r) * q) + off; }
        const int nig = WGM * nN, gid = wgid / nig, fm = gid * WGM, gsz = (nM - fm) < WGM ? (nM - fm) : WGM;
        u.pm = fm + ((wgid % nig) % gsz); u.pn = (wgid % nig) / gsz;
        u.aoff = (unsigned)u.pm * a_row + (unsigned)u.sub * a_sub; u.boff = (unsigned)u.pn * b_row + (unsigned)u.sub * b_sub;
        if (mode == 1) { const int kv = u.pm >> 3, g = (u.pm >> 2) & 1, cp = u.pm & 3;
            u.aoff = (unsigned)(((size_t)cp * 256 * 16 * PLD + (kv ? PC_VC : PC_KC) + g * 64) * 2); u.boff = (unsigned)kv * (256u * 2048u * 2u); }
        if (mode == 2) { const int kv = u.pm >> 3; u.boff = (unsigned)kv * (256u * 256u * 2u); }
        return true;
    }
};

template <class Epi>
__device__ __forceinline__ void gemm_phase(LAS unsigned char* lds, const int tid, const Gemm g, const Sched& S, const Epi& E) {
    const int wid = __builtin_amdgcn_readfirstlane(tid >> 6), lane = tid & 63, wr = wid >> 2, wc = wid & 3, fr = lane & 15, fq = lane >> 4;
    const int K = g.K, nt = K / BK;
    unsigned voffA[2], voffB[2];
#pragma unroll
    for (int i = 0; i < 2; ++i) { int R, C; stage_rc(tid * 16 + i * 8192, R, C); const int Rb = Epi::PERM ? ((R & ~31) + perm32(R & 31)) : R;
        voffA[i] = (unsigned)(R * g.lda + C) * 2u; voffB[i] = (unsigned)(Rb * g.ldb + C) * 2u; }
    const size_t kstep = (size_t)(BK * 2), kstA = g.kstepA;
    const size_t hstepA = (size_t)HALF * g.lda * 2, hstepB = (size_t)HALF * g.ldb * 2;
    const unsigned ldsw = (unsigned)wid * 1024u;
    const int aoff = lds_byte(wr * 64 + fr, fq * 8), boff = lds_byte(wc * 32 + fr, fq * 8);
#define PG8_SA(b, h) (((b) * 2 + (h)) * HTB)
#define PG8_SB(b, h) ((4 + (b) * 2 + (h)) * HTB)
#define PG8_STAGE(bufoff, gbase, voff) do { _Pragma("unroll") for (int _i = 0; _i < 2; ++_i) \
        __builtin_amdgcn_global_load_lds((const unsigned*)((const char*)(gbase) + (voff)[_i]), (LAS unsigned*)(lds + (bufoff) + ldsw + _i * 8192), 16, 0, 0); } while (0)
#define PG8_LDA(dst, b, h) do { _Pragma("unroll") for (int m = 0; m < 4; ++m) _Pragma("unroll") for (int k = 0; k < 2; ++k) dst[m][k] = *(const LAS bf16x8*)(lds + PG8_SA(b, h) + aoff + m * 2048 + k * 1024); } while (0)
#define PG8_LDB(dst, b, h) do { _Pragma("unroll") for (int n = 0; n < 2; ++n) _Pragma("unroll") for (int k = 0; k < 2; ++k) dst[n][k] = *(const LAS bf16x8*)(lds + PG8_SB(b, h) + boff + n * 2048 + k * 1024); } while (0)
#define PG8_MMA(ai, bj, At, Bt) do { __builtin_amdgcn_s_setprio(1); _Pragma("unroll") for (int m = 0; m < 4; ++m) _Pragma("unroll") for (int n = 0; n < 2; ++n) _Pragma("unroll") for (int k = 0; k < 2; ++k) \
        acc[ai][bj][m][n] = __builtin_amdgcn_mfma_f32_16x16x32_bf16(Bt[n][k], At[m][k], acc[ai][bj][m][n], 0, 0, 0); __builtin_amdgcn_s_setprio(0); } while (0)
#define PG8_WAIT_V(n) asm volatile("s_waitcnt vmcnt(" #n ")" ::: "memory")
#define PG8_WAIT_L(n) asm volatile("s_waitcnt lgkmcnt(" #n ")" ::: "memory")
#define PG8_BAR __builtin_amdgcn_s_barrier()
#define PG8_SCHED __builtin_amdgcn_sched_barrier(0)
    Unit cur, nxt; int ui = 0;
    if (!S.next(0, cur)) return;
    f32x4 acc[2][2][4][2];
#pragma unroll
    for (int a = 0; a < 2; ++a)
#pragma unroll
        for (int b = 0; b < 2; ++b)
#pragma unroll
            for (int m = 0; m < 4; ++m)
#pragma unroll
                for (int n = 0; n < 2; ++n) acc[a][b][m][n] = (f32x4){0.f, 0.f, 0.f, 0.f};
    bf16x8 At[4][2], B0[2][2], B1[2][2];
    const char* cA = (const char*)g.A + cur.aoff; const char* cB = (const char*)g.Bt + cur.boff;
    PG8_STAGE(PG8_SB(0, 0), cB, voffB); PG8_STAGE(PG8_SA(0, 0), cA, voffA); PG8_STAGE(PG8_SB(0, 1), cB + hstepB, voffB); PG8_STAGE(PG8_SA(0, 1), cA + hstepA, voffA);
    if (wr == 1) PG8_BAR;
    PG8_WAIT_V(4); PG8_BAR;
    PG8_STAGE(PG8_SB(1, 0), cB + kstep, voffB); PG8_STAGE(PG8_SA(1, 0), cA + kstA, voffA); PG8_STAGE(PG8_SB(1, 1), cB + hstepB + kstep, voffB);
    PG8_WAIT_V(6); PG8_BAR;
    for (;;) {
        const bool has_next = S.next(ui + 1, nxt);
        const char* nA = has_next ? (const char*)g.A + nxt.aoff : cA; const char* nB = has_next ? (const char*)g.Bt + nxt.boff : cB;
        for (int t = 0; t < nt; t += 2) {
            const bool last = (t == nt - 2);
            const char* a1 = cA + (size_t)(t + 1) * kstA;
            const char* a2 = last ? nA : cA + (size_t)(t + 2) * kstA; const char* b2 = last ? nB : cB + (size_t)(t + 2) * kstep;
            const char* a3 = a2 + kstA; const char* b3 = b2 + kstep;
            PG8_LDB(B0, 0, 0); PG8_SCHED; PG8_LDA(At, 0, 0); PG8_STAGE(PG8_SA(1, 1), a1 + hstepA, voffA);
            PG8_WAIT_L(8); PG8_BAR; PG8_WAIT_L(0); PG8_MMA(0, 0, At, B0); PG8_BAR; PG8_SCHED;
            PG8_LDB(B1, 0, 1); PG8_STAGE(PG8_SB(0, 0), b2, voffB);
            PG8_BAR; PG8_WAIT_L(0); PG8_MMA(0, 1, At, B1); PG8_BAR;
            PG8_LDA(At, 0, 1); PG8_STAGE(PG8_SA(0, 0), a2, voffA);
            PG8_BAR; PG8_WAIT_L(0); PG8_MMA(1, 0, At, B0); PG8_BAR; PG8_SCHED;
            PG8_STAGE(PG8_SB(0, 1), b2 + hstepB, voffB);
            PG8_WAIT_V(6); PG8_BAR; PG8_MMA(1, 1, At, B1); PG8_BAR;
            PG8_LDB(B0, 1, 0); PG8_SCHED; PG8_LDA(At, 1, 0); PG8_STAGE(PG8_SA(0, 1), a2 + hstepA, voffA);
            PG8_WAIT_L(8); PG8_BAR; PG8_WAIT_L(0); PG8_MMA(0, 0, At, B0); PG8_BAR; PG8_SCHED;
            PG8_LDB(B1, 1, 1); PG8_STAGE(PG8_SB(1, 0), b3, voffB);
            PG8_BAR; PG8_WAIT_L(0); PG8_MMA(0, 1, At, B1); PG8_BAR;
            PG8_LDA(At, 1, 1); PG8_STAGE(PG8_SA(1, 0), a3, voffA);
            PG8_BAR; PG8_WAIT_L(0); PG8_MMA(1, 0, At, B0); PG8_BAR; PG8_SCHED;
            PG8_STAGE(PG8_SB(1, 1), b3 + hstepB, voffB);
            PG8_WAIT_V(6); PG8_BAR; PG8_MMA(1, 1, At, B1); PG8_BAR;
        }
        bool keep = false;
        if constexpr (!epi_after_drain<Epi>::value) keep = E(acc, cur, wr, wc, fr, fq);
        if (!has_next) break;
        if (!keep) {
#pragma unroll
            for (int a = 0; a < 2; ++a)
#pragma unroll
                for (int b = 0; b < 2; ++b)
#pragma unroll
                    for (int m = 0; m < 4; ++m)
#pragma unroll
                        for (int n = 0; n < 2; ++n) acc[a][b][m][n] = (f32x4){0.f, 0.f, 0.f, 0.f};
        }
        cur = nxt; cA = nA; cB = nB; ++ui;
    }
    PG8_WAIT_V(0);
    if (wr == 0) PG8_BAR;
    PG8_BAR;
    if constexpr (epi_after_drain<Epi>::value) (void)E(acc, cur, wr, wc, fr, fq);
#undef PG8_SA
#undef PG8_SB
#undef PG8_STAGE
#undef PG8_LDA
#undef PG8_LDB
#undef PG8_MMA
#undef PG8_WAIT_V
#undef PG8_WAIT_L
#undef PG8_BAR
#undef PG8_SCHED
}

struct EpiInProj {
    static constexpr bool PERM = true;
    bf16_t* proj; bf16_t* gates; unsigned char* ws; int row_base;
    __device__ __forceinline__ bool operator()(f32x4 (&acc)[2][2][4][2], const Unit& u, int wr, int wc, int fr, int fq) const {
        const int row0 = u.pm * BM + wr * 64 + fr; const bool is_gate = u.pn >= 16;
        bf16_t* base = is_gate ? gates + (u.pn - 16) * 256 : proj + u.pn * 256; const int ld = is_gate ? 3072 : PLD;
        const int col0 = wc * 32 + 8 * fq;
        float sv[2][4];
        { f32x4 pq[2][4];
#pragma unroll
          for (int ai = 0; ai < 2; ++ai)
#pragma unroll
            for (int m = 0; m < 4; ++m) pq[ai][m] = *(const f32x4*)statp(ws, row_base + row0 + ai * HALF + m * 16, 0);
#pragma unroll
          for (int ai = 0; ai < 2; ++ai)
#pragma unroll
            for (int m = 0; m < 4; ++m) sv[ai][m] = rsqrtf(((pq[ai][m][0] + pq[ai][m][1]) + (pq[ai][m][2] + pq[ai][m][3])) * (1.0f / D) + NORM_EPS); }
#pragma unroll
        for (int ai = 0; ai < 2; ++ai)
#pragma unroll
            for (int m = 0; m < 4; ++m) { const int row = row0 + ai * HALF + m * 16;
                const float s = sv[ai][m]; bf16_t* rowp = base + (size_t)row * ld + col0;
#pragma unroll
                for (int bj = 0; bj < 2; ++bj) { f32x4 v0 = acc[ai][bj][m][0] * s, v1 = acc[ai][bj][m][1] * s;
                    if (is_gate) {
#pragma unroll
                        for (int j = 0; j < 4; ++j) { v0[j] = sigmoidf_(v0[j]); v1[j] = sigmoidf_(v1[j]); } }
                    u32x4 w; w.x = pk2(v0[0], v0[1]); w.y = pk2(v0[2], v0[3]); w.z = pk2(v1[0], v1[1]); w.w = pk2(v1[2], v1[3]);
                    if (u.pn != 12 || col0 + bj * HALF < 64) *(u32x4*)(rowp + bj * HALF) = w; } }
        return false;
    }
};
struct EpiStore {
    static constexpr bool PERM = true;
    bf16_t* out; int ld;
    __device__ __forceinline__ bool operator()(f32x4 (&acc)[2][2][4][2], const Unit& u, int wr, int wc, int fr, int fq) const {
        const int row0 = u.pm * BM + wr * 64 + fr; const int col0 = u.pn * BM + wc * 32 + 8 * fq;
#pragma unroll
        for (int ai = 0; ai < 2; ++ai)
#pragma unroll
            for (int m = 0; m < 4; ++m) { bf16_t* rowp = out + (size_t)(row0 + ai * HALF + m * 16) * ld + col0;
#pragma unroll
                for (int bj = 0; bj < 2; ++bj) { const f32x4 v0 = acc[ai][bj][m][0], v1 = acc[ai][bj][m][1];
                    u32x4 w; w.x = pk2(v0[0], v0[1]); w.y = pk2(v0[2], v0[3]); w.z = pk2(v1[0], v1[1]); w.w = pk2(v1[2], v1[3]);
                    *(u32x4*)(rowp + bj * HALF) = w; } }
        return false;
    }
};
struct EpiCmp1 {
    static constexpr bool PERM = true;
    bf16_t* hid; const float* bh;
    __device__ __forceinline__ bool operator()(f32x4 (&acc)[2][2][4][2], const Unit& u, int wr, int wc, int fr, int fq) const {
        const int kv = u.pm >> 3; const int row0 = (u.pm & 7) * BM + wr * 64 + fr; const int col0 = wc * 32 + 8 * fq;
#pragma unroll
        for (int ai = 0; ai < 2; ++ai)
#pragma unroll
            for (int m = 0; m < 4; ++m) { bf16_t* rowp = hid + ((size_t)kv * 2048 + row0 + ai * HALF + m * 16) * 256 + col0;
#pragma unroll
                for (int bj = 0; bj < 2; ++bj) { float o[8];
#pragma unroll
                    for (int j = 0; j < 8; ++j) { const float x = acc[ai][bj][m][j >> 2][j & 3] + bh[kv * 256 + col0 + bj * HALF + j];
                        o[j] = x * sigmoidf_(1.5957691216f * (x + 0.044715f * x * x * x)); }
                    u32x4 w; w.x = pk2(o[0], o[1]); w.y = pk2(o[2], o[3]); w.z = pk2(o[4], o[5]); w.w = pk2(o[6], o[7]);
                    *(u32x4*)(rowp + bj * HALF) = w; } }
        return false;
    }
};
struct EpiCmp2 {
    static constexpr bool PERM = true;
    bf16_t* kcb; bf16_t* vct;
    __device__ __forceinline__ bool operator()(f32x4 (&acc)[2][2][4][2], const Unit& u, int wr, int wc, int fr, int fq) const {
        const int kv = u.pm >> 3; const int row0 = (u.pm & 7) * BM + wr * 64 + fr; const int col0 = wc * 32 + 8 * fq;
        if (col0 >= 64) return false;
#pragma unroll
        for (int ai = 0; ai < 2; ++ai)
#pragma unroll
            for (int m = 0; m < 4; ++m) { const int row = row0 + ai * HALF + m * 16, g = row >> 10, cc = row & 1023; const bool zr = cc == 1023; const f32x4 zz = (f32x4){0.f, 0.f, 0.f, 0.f};
                const f32x4 v0 = zr ? zz : acc[ai][0][m][0], v1 = zr ? zz : acc[ai][0][m][1];
                if (kv == 0) { u32x4 w; w.x = pk2(v0[0], v0[1]); w.y = pk2(v0[2], v0[3]); w.z = pk2(v1[0], v1[1]); w.w = pk2(v1[2], v1[3]); *(u32x4*)(kcb + ((size_t)g * 1024 + cc) * 64 + col0) = w; }
                else {
#pragma unroll
                    for (int j = 0; j < 4; ++j) { vct[((size_t)g * 64 + col0 + j) * 1024 + cc] = (bf16_t)f2bf(v0[j]); vct[((size_t)g * 64 + col0 + 4 + j) * 1024 + cc] = (bf16_t)f2bf(v1[j]); } } }
        return false;
    }
};
struct EpiLora {
    static constexpr bool PERM = true;
    bf16_t* obuf;
    __device__ __forceinline__ bool operator()(f32x4 (&acc)[2][2][4][2], const Unit& u, int wr, int wc, int fr, int fq) const {
        const int sel = u.pn >> 1; bf16_t* out = obuf + (size_t)(sel == 2 ? 0 : sel + 1) * T * 512;
        const int row0 = u.pm * BM + wr * 64 + fr; const int col0 = (u.pn & 1) * BM + wc * 32 + 8 * fq;
#pragma unroll
        for (int ai = 0; ai < 2; ++ai)
#pragma unroll
            for (int m = 0; m < 4; ++m) { bf16_t* rowp = out + (size_t)(row0 + ai * HALF + m * 16) * 512 + col0;
#pragma unroll
                for (int bj = 0; bj < 2; ++bj) { const f32x4 v0 = acc[ai][bj][m][0], v1 = acc[ai][bj][m][1];
                    u32x4 w; w.x = pk2(v0[0], v0[1]); w.y = pk2(v0[2], v0[3]); w.z = pk2(v1[0], v1[1]); w.w = pk2(v1[2], v1[3]);
                    *(u32x4*)(rowp + bj * HALF) = w; } }
        return false;
    }
};
struct EpiMerge {
    static constexpr bool PERM = true;
    const bf16_t* gates; bf16_t* merged;
    __device__ __forceinline__ bool operator()(f32x4 (&acc)[2][2][4][2], const Unit& u, int wr, int wc, int fr, int fq) const {
        const int row0 = u.pm * BM + wr * 64 + fr; const int col0 = u.pn * BM + wc * 32 + 8 * fq; const int sub = u.sub;
#pragma unroll
        for (int ai = 0; ai < 2; ++ai) {
                u32x4 gc[4][2], gn[4][2];
#pragma unroll
                for (int m = 0; m < 4; ++m) { const int row = row0 + ai * HALF + m * 16; const bf16_t* gp = gates + (size_t)row * 3072 + sub * 1024 + col0;
#pragma unroll
                    for (int bj = 0; bj < 2; ++bj) { gc[m][bj] = *(const u32x4*)(gp + bj * HALF); gn[m][bj] = (sub < 2) ? *(const u32x4*)(gp + 1024 + bj * HALF) : gc[m][bj]; } }
#pragma unroll
                for (int m = 0; m < 4; ++m) { const int row = row0 + ai * HALF + m * 16;
#pragma unroll
                    for (int bj = 0; bj < 2; ++bj) {
                        float sc[8], sn[8]; unpack8(gc[m][bj], sc);
                        if (sub < 2) { unpack8(gn[m][bj], sn);
#pragma unroll
                            for (int j = 0; j < 8; ++j) sc[j] = sc[j] * __builtin_amdgcn_rcpf(fmaxf(sn[j], 1e-30f)); }
                        f32x4 v0 = acc[ai][bj][m][0], v1 = acc[ai][bj][m][1];
#pragma unroll
                        for (int j = 0; j < 4; ++j) { v0[j] *= sc[j]; v1[j] *= sc[4 + j]; }
                        acc[ai][bj][m][0] = v0; acc[ai][bj][m][1] = v1;
                        if (sub == 2) { u32x4 w; w.x = pk2(v0[0], v0[1]); w.y = pk2(v0[2], v0[3]); w.z = pk2(v1[0], v1[1]); w.w = pk2(v1[2], v1[3]);
                            *(u32x4*)(merged + (size_t)row * D + col0 + bj * HALF) = w; } } }
                __builtin_amdgcn_sched_barrier(0);
        }
        return sub != 2;
    }
};
struct EpiNorm {
    static constexpr bool PERM = true, AFTER_DRAIN = true;
    float* x; bf16_t* xb; const float* gain; unsigned char* ws; unsigned* cnt; int row_base, kind_next; unsigned target; LAS unsigned char* lds; int tid;
    __device__ __forceinline__ bool operator()(f32x4 (&acc)[2][2][4][2], const Unit& u, int wr, int wc, int fr, int fq) const {
        LAS float* P = (LAS float*)lds; LAS float* S = (LAS float*)(lds + 16384);
        const int lane = tid & 63, wid = __builtin_amdgcn_readfirstlane(tid >> 6);
        const int prow = row_base + u.pm * BM;
        const int col0 = u.pn * BM + wc * 32 + 8 * fq;
#pragma unroll
        for (int ai = 0; ai < 2; ++ai)
#pragma unroll
            for (int m = 0; m < 4; ++m) { float ps = 0.f;
#pragma unroll
                for (int bj = 0; bj < 2; ++bj) { const f32x4 v0 = acc[ai][bj][m][0], v1 = acc[ai][bj][m][1];
                    ps += (v0[0] * v0[0] + v0[1] * v0[1]) + (v0[2] * v0[2] + v0[3] * v0[3]) + (v1[0] * v1[0] + v1[1] * v1[1]) + (v1[2] * v1[2] + v1[3] * v1[3]); }
                P[(ai * HALF + wr * 64 + m * 16 + fr) * 16 + wc * 4 + fq] = ps; }
        asm volatile("s_waitcnt lgkmcnt(0)" ::: "memory"); __builtin_amdgcn_s_barrier(); asm volatile("" ::: "memory");
        if (tid < 256) { const f32x4 a0 = *(const LAS f32x4*)(P + tid * 16), a1 = *(const LAS f32x4*)(P + tid * 16 + 4), a2 = *(const LAS f32x4*)(P + tid * 16 + 8), a3 = *(const LAS f32x4*)(P + tid * 16 + 12);
            const float sm = (((a0[0] + a0[1]) + (a0[2] + a0[3])) + ((a1[0] + a1[1]) + (a1[2] + a1[3]))) + (((a2[0] + a2[1]) + (a2[2] + a2[3])) + ((a3[0] + a3[1]) + (a3[2] + a3[3])));
            __hip_atomic_store(statp(ws, prow + tid, 1 + (int)(target >> 4)) + u.pn, sm, __ATOMIC_RELAXED, __HIP_MEMORY_SCOPE_AGENT); }
        asm volatile("s_waitcnt vmcnt(0)" ::: "memory");
        unsigned* pcnt = cnt + 16 * (prow >> 8);
        if (tid < 256 && lane == 0) (void)__hip_atomic_fetch_add(pcnt, 1u, __ATOMIC_RELAXED, __HIP_MEMORY_SCOPE_AGENT);
        if (wid == 0) { unsigned spins = 0; while ((unsigned)__builtin_amdgcn_readfirstlane(__hip_atomic_load(pcnt, __ATOMIC_RELAXED, __HIP_MEMORY_SCOPE_AGENT)) < target) { __builtin_amdgcn_s_sleep(1); if (++spins > (1u << 20)) break; }
            __builtin_amdgcn_fence(__ATOMIC_ACQUIRE, "agent"); }
        asm volatile("s_waitcnt vmcnt(0) lgkmcnt(0)" ::: "memory"); __builtin_amdgcn_s_barrier(); asm volatile("" ::: "memory");
        if (tid < 256) { float* sp = statp(ws, prow + tid, 1 + (int)(target >> 4));
            const float t0 = __hip_atomic_load(sp, __ATOMIC_RELAXED, __HIP_MEMORY_SCOPE_AGENT), t1 = __hip_atomic_load(sp + 1, __ATOMIC_RELAXED, __HIP_MEMORY_SCOPE_AGENT),
                        t2 = __hip_atomic_load(sp + 2, __ATOMIC_RELAXED, __HIP_MEMORY_SCOPE_AGENT), t3 = __hip_atomic_load(sp + 3, __ATOMIC_RELAXED, __HIP_MEMORY_SCOPE_AGENT);
            S[tid] = rsqrtf(((t0 + t1) + (t2 + t3)) * (1.0f / D) + NORM_EPS); }
        asm volatile("s_waitcnt lgkmcnt(0)" ::: "memory"); __builtin_amdgcn_s_barrier(); asm volatile("" ::: "memory");
        f32x4 gv[2][2];
#pragma unroll
        for (int bj = 0; bj < 2; ++bj) { gv[bj][0] = *(const f32x4*)(gain + col0 + bj * HALF); gv[bj][1] = *(const f32x4*)(gain + col0 + bj * HALF + 4); }
#pragma unroll
        for (int ai = 0; ai < 2; ++ai)
#pragma unroll
            for (int mp = 0; mp < 2; ++mp) {
                f32x4 xv[2][2][2];
#pragma unroll
                for (int mi = 0; mi < 2; ++mi) { const int row = prow + ai * HALF + wr * 64 + (2 * mp + mi) * 16 + fr;
#pragma unroll
                    for (int bj = 0; bj < 2; ++bj) { const float* xp = x + (size_t)row * D + col0 + bj * HALF; xv[mi][bj][0] = *(const f32x4*)xp; xv[mi][bj][1] = *(const f32x4*)(xp + 4); } }
#pragma unroll
                for (int mi = 0; mi < 2; ++mi) { const int m = 2 * mp + mi; const int rl = ai * HALF + wr * 64 + m * 16 + fr; const int row = prow + rl; const float rstd = S[rl]; float qs = 0.f;
#pragma unroll
                    for (int bj = 0; bj < 2; ++bj) { const int col = col0 + bj * HALF; float* xp = x + (size_t)row * D + col; u32x4 w;
                        { f32x4 xa = xv[mi][bj][0]; xa += acc[ai][bj][m][0] * rstd * gv[bj][0]; *(f32x4*)xp = xa;
                          w.x = pk2(xa[0], xa[1]); w.y = pk2(xa[2], xa[3]); qs += (xa[0] * xa[0] + xa[1] * xa[1]) + (xa[2] * xa[2] + xa[3] * xa[3]); }
                        { f32x4 xc = xv[mi][bj][1]; xc += acc[ai][bj][m][1] * rstd * gv[bj][1]; *(f32x4*)(xp + 4) = xc;
                          w.z = pk2(xc[0], xc[1]); w.w = pk2(xc[2], xc[3]); qs += (xc[0] * xc[0] + xc[1] * xc[1]) + (xc[2] * xc[2] + xc[3] * xc[3]); }
                        *(u32x4*)(xb + (size_t)row * D + col) = w; }
                    P[rl * 16 + wc * 4 + fq] = qs; }
                __builtin_amdgcn_sched_barrier(0);
            }
        asm volatile("s_waitcnt lgkmcnt(0)" ::: "memory"); __builtin_amdgcn_s_barrier(); asm volatile("" ::: "memory");
        if (tid < 256) { const f32x4 a0 = *(const LAS f32x4*)(P + tid * 16), a1 = *(const LAS f32x4*)(P + tid * 16 + 4), a2 = *(const LAS f32x4*)(P + tid * 16 + 8), a3 = *(const LAS f32x4*)(P + tid * 16 + 12);
            const float sm = (((a0[0] + a0[1]) + (a0[2] + a0[3])) + ((a1[0] + a1[1]) + (a1[2] + a1[3]))) + (((a2[0] + a2[1]) + (a2[2] + a2[3])) + ((a3[0] + a3[1]) + (a3[2] + a3[3])));
            __hip_atomic_store(statp(ws, prow + tid, kind_next) + u.pn, sm, __ATOMIC_RELAXED, __HIP_MEMORY_SCOPE_AGENT); }
        return false;
    }
};
struct EpiSwiGLU {
    static constexpr bool PERM = true;
    bf16_t* act; unsigned char* ws;
    __device__ __forceinline__ bool operator()(f32x4 (&acc)[2][2][4][2], const Unit& u, int wr, int wc, int fr, int fq) const {
        const int row0 = u.pm * BM + wr * 64 + fr; const int col0 = u.pn * HALF + wc * 32 + 8 * fq;
        float sv[2][4];
        { f32x4 pq[2][4];
#pragma unroll
          for (int ai = 0; ai < 2; ++ai)
#pragma unroll
            for (int m = 0; m < 4; ++m) pq[ai][m] = *(const f32x4*)statp(ws, row0 + ai * HALF + m * 16, 1);
#pragma unroll
          for (int ai = 0; ai < 2; ++ai)
#pragma unroll
            for (int m = 0; m < 4; ++m) sv[ai][m] = rsqrtf(((pq[ai][m][0] + pq[ai][m][1]) + (pq[ai][m][2] + pq[ai][m][3])) * (1.0f / D) + NORM_EPS); }
#pragma unroll
        for (int ai = 0; ai < 2; ++ai)
#pragma unroll
            for (int m = 0; m < 4; ++m) { const int row = row0 + ai * HALF + m * 16;
                const float s = sv[ai][m];
                float o[8];
#pragma unroll
                for (int n = 0; n < 2; ++n)
#pragma unroll
                    for (int j = 0; j < 4; ++j) { const float gg = acc[ai][0][m][n][j] * s, uu = acc[ai][1][m][n][j] * s; o[n * 4 + j] = gg * sigmoidf_(gg) * uu; }
                u32x4 w; w.x = pk2(o[0], o[1]); w.y = pk2(o[2], o[3]); w.z = pk2(o[4], o[5]); w.w = pk2(o[6], o[7]);
                *(u32x4*)(act + (size_t)row * FFN + col0) = w; }
        return false;
    }
};
}

struct Args { const float* in[30]; float* out; unsigned char* ws; int lo, hi; };
enum { I_X = 0, I_NPM, I_NQM, I_NPF, I_NQF, I_WIN, I_MU, I_W0, I_W2, I_A0, I_A2, I_G2, I_KK, I_KA, I_RK, I_LNW, I_LNB, I_PEK, I_PEV, I_CKW1, I_CKW2, I_CVW1, I_CVW2, I_SINK, I_REL, I_WBR, I_WOUT, I_FG, I_FU, I_FD };

struct Ctx { LAS unsigned char* lds; int tid, lane, wave, G, bid; };
__device__ __forceinline__ const float* inptr(const Ctx& c, int i) {
    const volatile LAS unsigned* t = (const volatile LAS unsigned*)(c.lds + LDS_MISC + 64) + 2 * i;
    const unsigned lo = __builtin_amdgcn_readfirstlane(t[0]), hi = __builtin_amdgcn_readfirstlane(t[1]);
    return (const float*)(((unsigned long long)hi << 32) | lo);
}

__device__ __forceinline__ void phase_init(const Ctx& c, const float* x, float* xo, bf16_t* xb, unsigned char* wsb) {
    const int gw = c.bid * 8 + c.wave, NGW = c.G * 8;
    for (int row = gw; row < MROWS; row += NGW) {
        const float* xr = x + (size_t)row * D; float ss = 0.f;
#pragma unroll
        for (int j = 0; j < 2; ++j) { const int e = c.lane * 8 + 512 * j; const f32x4 a = *(const f32x4*)(xr + e), b = *(const f32x4*)(xr + e + 4);
            ss += a[0] * a[0] + a[1] * a[1] + a[2] * a[2] + a[3] * a[3] + b[0] * b[0] + b[1] * b[1] + b[2] * b[2] + b[3] * b[3];
            *(f32x4*)(xo + (size_t)row * D + e) = a; *(f32x4*)(xo + (size_t)row * D + e + 4) = b;
            u32x4 w; w.x = pk2(a[0], a[1]); w.y = pk2(a[2], a[3]); w.z = pk2(b[0], b[1]); w.w = pk2(b[2], b[3]); *(u32x4*)(xb + (size_t)row * D + e) = w; }
        ss = wave_sum(ss);
        if (c.lane < 4) __hip_atomic_store(statp(wsb, row, 0) + c.lane, c.lane == 0 ? ss : 0.f, __ATOMIC_RELAXED, __HIP_MEMORY_SCOPE_AGENT);
    }
}
__device__ __forceinline__ void phase_norm_res(const Ctx& c, const bf16_t* y, const float* gain, float* x, bf16_t* xb, float* rs, int row0, int nrows) {
    const int gw = c.bid * 8 + c.wave, NGW = c.G * 8;
    for (int r = gw; r < nrows; r += NGW) {
        const int row = row0 + r; float yv[16]; float ss = 0.f;
#pragma unroll
        for (int j = 0; j < 2; ++j) { float f[8]; unpack8(*(const u32x4*)(y + (size_t)r * D + c.lane * 8 + 512 * j), f);
#pragma unroll
            for (int k = 0; k < 8; ++k) { yv[j * 8 + k] = f[k]; ss += f[k] * f[k]; } }
        ss = wave_sum(ss); const float sc = rsqrtf(ss * (1.0f / D) + NORM_EPS); float s2 = 0.f;
#pragma unroll
        for (int j = 0; j < 2; ++j) { const int e = c.lane * 8 + 512 * j; float* xr = x + (size_t)row * D + e;
            f32x4 a = *(const f32x4*)xr, b = *(const f32x4*)(xr + 4); const f32x4 ga = *(const f32x4*)(gain + e), gb = *(const f32x4*)(gain + e + 4);
#pragma unroll
            for (int k = 0; k < 4; ++k) { a[k] += yv[j * 8 + k] * sc * ga[k]; b[k] += yv[j * 8 + 4 + k] * sc * gb[k]; s2 += a[k] * a[k] + b[k] * b[k]; }
            *(f32x4*)xr = a; *(f32x4*)(xr + 4) = b;
            u32x4 w; w.x = pk2(a[0], a[1]); w.y = pk2(a[2], a[3]); w.z = pk2(b[0], b[1]); w.w = pk2(b[2], b[3]); *(u32x4*)(xb + (size_t)row * D + e) = w; }
        s2 = wave_sum(s2);
        if (c.lane == 0) rs[row] = rsqrtf(s2 * (1.0f / D) + NORM_EPS);
    }
}

struct CvtTile { const float* src; const float* gain; bf16_t* dst; int ld, nvalid, K, k0, n0; float extra; bool kvalid; };
__device__ __forceinline__ CvtTile cvt_describe(const Ctx& c, int layer, bf16_t* wb, int it) {
    constexpr int I0 = 16 * 112, I1 = 3 * 8 * 16, I2 = 16 * 16, I3 = 16 * 88, I4 = 44 * 16, I5 = 4 * 24, I6 = 2 * 32 * 4;
    int r = it, kind, sub = 0, K, nblk; bf16_t* dst;
    if (r < I0) { kind = 0; K = D; nblk = 112; dst = wb + WB_WIN; }
    else if ((r -= I0) < I1) { kind = 1; sub = r / 128; r -= sub * 128; K = 512; nblk = 16; dst = wb + WB_WBR + (size_t)sub * D * 512; }
    else if ((r -= I1) < I2) { kind = 2; K = D; nblk = 16; dst = wb + WB_WOUT; }
    else if ((r -= I2) < I3) { kind = 3; K = D; nblk = 88; dst = wb + WB_WGU; }
    else if ((r -= I3) < I4) { kind = 4; K = FFN; nblk = 16; dst = wb + WB_WDN; }
    else if ((r -= I4) < I5) { kind = 5; K = 256; nblk = 24; dst = wb + WB_LORA; }
    else if ((r -= I5) < I6) { kind = 6; sub = r / 128; r -= sub * 128; K = 2048; nblk = 4; dst = wb + WB_W1T + (size_t)sub * 256 * 2048; }
    else { r -= I6; kind = 7; sub = r / 16; r -= sub * 16; K = 256; nblk = 4; dst = wb + WB_W2T + (size_t)sub * 256 * 256; }
    const int kb = r / nblk, nb = r % nblk, k0 = kb * 64, n0 = nb * 64;
    CvtTile t; t.src = nullptr; t.gain = nullptr; t.dst = dst; t.ld = 0; t.nvalid = 64; t.K = K; t.k0 = k0; t.n0 = n0; t.extra = 1.f; t.kvalid = true;
    switch (kind) {
    case 0: { t.gain = inptr(c, I_NPM) + layer * D + k0; t.ld = IN_COLS;
        const int scol = n0 < 3096 ? n0 : n0 - 232; t.nvalid = (n0 < 3096) ? (3096 - n0 < 64 ? 3096 - n0 : 64) : (n0 < 3328 ? 0 : 64);
        if ((n0 >= PC_NQ && n0 < PC_NQ + 512) || (n0 >= PC_SQ && n0 < PC_SQ + 512)) t.extra = 0.125f;
        t.src = inptr(c, I_WIN) + ((size_t)layer * D + k0) * IN_COLS + scol; break; }
    case 1: t.src = inptr(c, I_WBR) + (((size_t)layer * 3 + sub) * 512 + k0) * D + n0; t.ld = D; break;
    case 2: t.src = inptr(c, I_WOUT) + ((size_t)layer * D + k0) * D + n0; t.ld = D; break;
    case 3: { t.gain = inptr(c, I_NPF) + layer * D + k0; t.ld = FFN; const int pn = n0 >> 8, rr = n0 & 255;
        t.src = inptr(c, rr < 128 ? I_FG : I_FU) + ((size_t)layer * D + k0) * FFN + pn * 128 + (rr & 127); break; }
    case 4: t.src = inptr(c, I_FD) + ((size_t)layer * FFN + k0) * D + n0; t.ld = D; break;
    case 5: { t.ld = 512;
        if (n0 < 512) { t.kvalid = k0 < 64; t.src = inptr(c, I_W2) + ((size_t)layer * 64 + k0) * 512 + n0; }
        else if (n0 < 1024) { t.kvalid = (k0 == 64); t.src = inptr(c, I_A2) + ((size_t)layer * 64 + (k0 - 64)) * 512 + n0 - 512; }
        else { t.kvalid = k0 >= 128; t.src = inptr(c, I_G2) + ((size_t)layer * 128 + (k0 - 128)) * 512 + n0 - 1024; }
        break; }
    case 6: t.src = inptr(c, sub ? I_CVW1 : I_CKW1) + ((size_t)layer * 2048 + k0) * 256 + n0; t.ld = 256; break;
    default: t.src = inptr(c, sub ? I_CVW2 : I_CKW2) + ((size_t)layer * 256 + k0) * 64 + n0; t.ld = 64; t.nvalid = n0 < 64 ? 64 : 0; break;
    }
    return t;
}
__device__ __forceinline__ void phase_cvt(const Ctx& c, const Args& a, int layer, bf16_t* wb) {
    LAS float* tile = (LAS float*)c.lds;
    constexpr int NIT = 16 * 112 + 3 * 8 * 16 + 16 * 16 + 16 * 88 + 44 * 16 + 4 * 24 + 2 * 32 * 4 + 2 * 4 * 4;
    for (int it = c.bid; it < NIT; it += 2 * c.G) {
        const int it2 = it + c.G; const bool two = it2 < NIT;
        const CvtTile t0 = cvt_describe(c, layer, wb, it), t1 = cvt_describe(c, layer, wb, two ? it2 : it);
        float v0[8], v1[8];
#pragma unroll
        for (int i = 0; i < 8; ++i) { const int e = c.tid + 512 * i, kk = e >> 6, nn = e & 63;
            v0[i] = (t0.kvalid && nn < t0.nvalid) ? t0.src[(size_t)kk * t0.ld + nn] : 0.f;
            v1[i] = (two && t1.kvalid && nn < t1.nvalid) ? t1.src[(size_t)kk * t1.ld + nn] : 0.f; }
#pragma unroll
        for (int i = 0; i < 8; ++i) { const int e = c.tid + 512 * i, kk = e >> 6, nn = e & 63;
            tile[kk * 65 + nn] = v0[i] * t0.extra * (t0.gain ? t0.gain[kk] : 1.f); tile[4160 + kk * 65 + nn] = v1[i] * t1.extra * (t1.gain ? t1.gain[kk] : 1.f); }
        __syncthreads();
        { const int nn = c.tid >> 3, kc = (c.tid & 7) * 8; u32x4 w;
          w.x = pk2(tile[(kc + 0) * 65 + nn], tile[(kc + 1) * 65 + nn]); w.y = pk2(tile[(kc + 2) * 65 + nn], tile[(kc + 3) * 65 + nn]);
          w.z = pk2(tile[(kc + 4) * 65 + nn], tile[(kc + 5) * 65 + nn]); w.w = pk2(tile[(kc + 6) * 65 + nn], tile[(kc + 7) * 65 + nn]);
          *(u32x4*)(t0.dst + (size_t)(t0.n0 + nn) * t0.K + t0.k0 + kc) = w;
          if (two) { const LAS float* tl = tile + 4160;
            w.x = pk2(tl[(kc + 0) * 65 + nn], tl[(kc + 1) * 65 + nn]); w.y = pk2(tl[(kc + 2) * 65 + nn], tl[(kc + 3) * 65 + nn]);
            w.z = pk2(tl[(kc + 4) * 65 + nn], tl[(kc + 5) * 65 + nn]); w.w = pk2(tl[(kc + 6) * 65 + nn], tl[(kc + 7) * 65 + nn]);
            *(u32x4*)(t1.dst + (size_t)(t1.n0 + nn) * t1.K + t1.k0 + kc) = w; } }
        __syncthreads();
    }
    if (c.bid == c.G - 1) {
        const int kv = c.tid >> 8, u = c.tid & 255; const float* w1 = inptr(c, kv ? I_CVW1 : I_CKW1) + (size_t)layer * 2048 * 256; const float* pe = inptr(c, kv ? I_PEV : I_PEK) + (size_t)layer * 2048;
        float acc = 0.f; for (int k = 0; k < 2048; ++k) acc += pe[k] * w1[(size_t)k * 256 + u];
        ((float*)(wb + WB_BH))[c.tid] = acc;
    }
}

struct RowState { float q[64]; float o[64]; float m, l; };
__device__ __forceinline__ void row_init(RowState& s, const bf16_t* qp) {
#pragma unroll
    for (int i = 0; i < 8; ++i) { float f[8]; unpack8(*(const u32x4*)(qp + i * 8), f);
#pragma unroll
        for (int k = 0; k < 8; ++k) s.q[i * 8 + k] = f[k]; }
}
__device__ __forceinline__ void row_reset(RowState& s) {
#pragma unroll
    for (int i = 0; i < 64; ++i) s.o[i] = 0.f;
    s.m = -1e30f; s.l = 0.f;
}
__device__ __forceinline__ void row_key_bf16(RowState& s, const bf16_t* kp, const bf16_t* vp, float bias) {
    float sc = bias;
#pragma unroll
    for (int i = 0; i < 8; ++i) { float f[8]; unpack8(*(const u32x4*)(kp + i * 8), f);
#pragma unroll
        for (int k = 0; k < 8; ++k) sc += s.q[i * 8 + k] * f[k];
        if ((i & 1) == 1) __builtin_amdgcn_sched_barrier(0); }
    const float mn = fmaxf(s.m, sc), corr = __expf(s.m - mn), p = __expf(sc - mn);
    s.l = s.l * corr + p; s.m = mn;
#pragma unroll
    for (int i = 0; i < 8; ++i) { float f[8]; unpack8(*(const u32x4*)(vp + i * 8), f);
#pragma unroll
        for (int k = 0; k < 8; ++k) s.o[i * 8 + k] = s.o[i * 8 + k] * corr + p * f[k];
        if ((i & 1) == 1) __builtin_amdgcn_sched_barrier(0); }
}
__device__ __forceinline__ void row_key_f32(RowState& s, const float* kp, const float* vp, float bias) {
    float sc = bias;
#pragma unroll
    for (int i = 0; i < 16; ++i) { const f32x4 f = *(const f32x4*)(kp + i * 4); sc += s.q[i * 4] * f[0] + s.q[i * 4 + 1] * f[1] + s.q[i * 4 + 2] * f[2] + s.q[i * 4 + 3] * f[3];
        if ((i & 3) == 3) __builtin_amdgcn_sched_barrier(0); }
    const float mn = fmaxf(s.m, sc), corr = __expf(s.m - mn), p = __expf(sc - mn);
    s.l = s.l * corr + p; s.m = mn;
#pragma unroll
    for (int i = 0; i < 16; ++i) { const f32x4 f = *(const f32x4*)(vp + i * 4);
#pragma unroll
        for (int k = 0; k < 4; ++k) s.o[i * 4 + k] = s.o[i * 4 + k] * corr + p * f[k];
        if ((i & 3) == 3) __builtin_amdgcn_sched_barrier(0); }
}

__device__ __forceinline__ float gelu_tanh(float x) { const float t = tanhf(0.7978845608028654f * (x + 0.044715f * x * x * x)); return 0.5f * x * (1.0f + t); }
__device__ __forceinline__ void phase_cmp1(const Ctx& c, const Args& a, int layer, const bf16_t* proj, float* hid) {
    for (int unit = c.bid; unit < 2048; unit += c.G) {
        const int kv = unit >> 10, g = (unit >> 9) & 1, cp = unit & 511; const int cc = cp * 2 + (c.tid >> 8), u = c.tid & 255;
        if (cc >= NCMP) continue;
        const float* w1 = a.in[kv ? I_CVW1 : I_CKW1] + (size_t)layer * 2048 * 256; const float* pe = a.in[kv ? I_PEV : I_PEK] + (size_t)layer * 32 * 64;
        const bf16_t* xp = proj + (size_t)(16 * cc) * PLD + (kv ? PC_VC : PC_KC) + g * 64;
        float acc = 0.f;
        for (int l = 0; l < 32; ++l) {
#pragma unroll
            for (int i = 0; i < 8; ++i) { float f[8]; unpack8(*(const u32x4*)(xp + (size_t)l * PLD + i * 8), f);
#pragma unroll
                for (int k = 0; k < 8; ++k) acc += (f[k] + pe[l * 64 + i * 8 + k]) * w1[(size_t)(l * 64 + i * 8 + k) * 256 + u]; }
        }
        hid[(((size_t)kv * 2 + g) * 1024 + cc) * 256 + u] = gelu_tanh(acc);
    }
}
__device__ __forceinline__ void phase_cmp2(const Ctx& c, const Args& a, int layer, const float* hid, bf16_t* kcb, bf16_t* vctb) {
    for (int unit = c.bid; unit < 512; unit += c.G) {
        const int kv = unit >> 8, g = (unit >> 7) & 1, cc = (unit & 127) * 8 + (c.tid >> 6), d = c.tid & 63;
        float acc = 0.f;
        if (cc < NCMP) { const float* w2 = a.in[kv ? I_CVW2 : I_CKW2] + (size_t)layer * 256 * 64; const float* hp = hid + (((size_t)kv * 2 + g) * 1024 + cc) * 256;
            for (int u = 0; u < 256; ++u) acc += hp[u] * w2[u * 64 + d]; }
        if (kv) vctb[((size_t)g * 64 + d) * 1024 + cc] = (bf16_t)f2bf(acc); else kcb[((size_t)g * 1024 + cc) * 64 + d] = (bf16_t)f2bf(acc);
    }
}
__device__ __forceinline__ void phase_nsa13(const Ctx& c, const Args& a, const bf16_t* proj, const float* kcmp, const float* vcmp, float* nsaacc, float* ml) {
    LAS float* tb = (LAS float*)c.lds;
    for (int e = c.tid; e < 512; e += 512) tb[e] = inptr(c, I_REL)[e];
    __syncthreads();
    for (int unit = c.bid; unit < T / 64; unit += c.G) {
        const int hh = c.tid >> 6, t = unit * 64 + (c.tid & 63), g = hh >> 2;
        RowState s; row_init(s, proj + (size_t)t * PLD + PC_NQ + hh * 64);
        const bf16_t* glp = proj + (size_t)t * PLD + PC_GL;
        const float g0 = sigmoidf_(bf2f(glp[hh])), g2 = sigmoidf_(bf2f(glp[16 + hh]));
        row_reset(s);
        const int nv = t >= 31 ? (t - 31) / 16 + 1 : 0;
        for (int cc = 0; cc < nv; ++cc) { const float bias = tb[t5_bucket(t - 16 * cc - 31) * 16 + hh];
            row_key_f32(s, kcmp + ((size_t)g * 1024 + cc) * 64, vcmp + ((size_t)g * 1024 + cc) * 64, bias); }
        ml[((size_t)t * 8 + hh) * 2] = s.m; ml[((size_t)t * 8 + hh) * 2 + 1] = s.l;
        float* op = nsaacc + (size_t)t * 512 + hh * 64;
        { const float inv = s.l > 0.f ? g0 / s.l : 0.f;
#pragma unroll
            for (int i = 0; i < 16; ++i) { f32x4 w; w[0] = s.o[i * 4] * inv; w[1] = s.o[i * 4 + 1] * inv; w[2] = s.o[i * 4 + 2] * inv; w[3] = s.o[i * 4 + 3] * inv; *(f32x4*)(op + i * 4) = w; } }
        row_reset(s);
        const int s0 = t - 511 > 0 ? t - 511 : 0;
        for (int sp = s0; sp <= t; ++sp) { const float bias = tb[t5_bucket(t - sp) * 16 + hh];
            row_key_bf16(s, proj + (size_t)sp * PLD + PC_KW + g * 64, proj + (size_t)sp * PLD + PC_VW + g * 64, bias); }
        { const float inv = s.l > 0.f ? g2 / s.l : 0.f;
#pragma unroll
            for (int i = 0; i < 16; ++i) { f32x4 w = *(const f32x4*)(op + i * 4); w[0] += s.o[i * 4] * inv; w[1] += s.o[i * 4 + 1] * inv; w[2] += s.o[i * 4 + 2] * inv; w[3] += s.o[i * 4 + 3] * inv; *(f32x4*)(op + i * 4) = w; } }
    }
}
__device__ __forceinline__ void phase_nsa_topk(const Ctx& c, const Args& a, const bf16_t* proj, const float* kcmp, const float* ml, int* sel) {
    LAS float* tb = (LAS float*)c.lds;
    LAS float* qs = (LAS float*)(c.lds + 4096) + c.wave * 256;
    LAS float* sv = (LAS float*)(c.lds + 16384) + c.wave * 256;
    for (int e = c.tid; e < 512; e += 512) tb[e] = inptr(c, I_REL)[e];
    __syncthreads();
    const int gw = c.bid * 8 + c.wave, NGW = c.G * 8;
    for (int item = gw; item < T * 2; item += NGW) {
        const int t = item >> 1, g = item & 1, cur = t >> 6;
        { const bf16_t* qp = proj + (size_t)t * PLD + PC_NQ + g * 256 + c.lane * 4; const u32x2 w = *(const u32x2*)qp;
          qs[c.lane * 4] = __uint_as_float(w.x << 16); qs[c.lane * 4 + 1] = __uint_as_float(w.x & 0xffff0000u); qs[c.lane * 4 + 2] = __uint_as_float(w.y << 16); qs[c.lane * 4 + 3] = __uint_as_float(w.y & 0xffff0000u); }
        float mr[4], il[4];
#pragma unroll
        for (int r = 0; r < 4; ++r) { mr[r] = ml[((size_t)t * 8 + g * 4 + r) * 2]; const float l = ml[((size_t)t * 8 + g * 4 + r) * 2 + 1]; il[r] = l > 0.f ? 1.0f / l : 0.f; }
        const int nv = t >= 31 ? (t - 31) / 16 + 1 : 0;
        asm volatile("s_waitcnt lgkmcnt(0)" ::: "memory");
#pragma unroll 1
        for (int jj = 0; jj < 4; ++jj) {
            const int j = c.lane + 64 * jj; float sc;
            if (j == 0 || j == cur || j == cur - 1) sc = 1e4f;
            else if (j > cur) sc = -1.0f;
            else { sc = 0.f;
#pragma unroll 1
                for (int o = 0; o < 5; ++o) { const int cc = 4 * j + o - 1; if (cc < 0 || cc >= nv) continue;
                    const float* kp = kcmp + ((size_t)g * 1024 + cc) * 64; float d0 = 0.f, d1 = 0.f, d2 = 0.f, d3 = 0.f;
#pragma unroll 4
                    for (int i = 0; i < 16; ++i) { const f32x4 f = *(const f32x4*)(kp + i * 4);
#pragma unroll
                        for (int k = 0; k < 4; ++k) { d0 += qs[i * 4 + k] * f[k]; d1 += qs[64 + i * 4 + k] * f[k]; d2 += qs[128 + i * 4 + k] * f[k]; d3 += qs[192 + i * 4 + k] * f[k]; } }
                    const int bk = t5_bucket(t - 16 * cc - 31) * 16 + g * 4;
                    const float imp = __expf(d0 + tb[bk] - mr[0]) * il[0] + __expf(d1 + tb[bk + 1] - mr[1]) * il[1] + __expf(d2 + tb[bk + 2] - mr[2]) * il[2] + __expf(d3 + tb[bk + 3] - mr[3]) * il[3];
                    sc += ((o == 0 || o == 4) ? 1.0f : 2.0f) * imp; }
            }
            sv[j] = sc;
        }
        asm volatile("s_waitcnt lgkmcnt(0)" ::: "memory");
        float val[4];
#pragma unroll
        for (int jj = 0; jj < 4; ++jj) val[jj] = sv[c.lane + 64 * jj];
        for (int k = 0; k < 16; ++k) {
            float bv = val[0]; int bi = c.lane;
#pragma unroll
            for (int jj = 1; jj < 4; ++jj) if (val[jj] > bv) { bv = val[jj]; bi = c.lane + 64 * jj; }
#pragma unroll
            for (int o = 32; o >= 1; o >>= 1) { const float ov = __shfl_xor(bv, o); const int oi = __shfl_xor(bi, o); if (ov > bv || (ov == bv && oi < bi)) { bv = ov; bi = oi; } }
#pragma unroll
            for (int jj = 0; jj < 4; ++jj) if (bi == c.lane + 64 * jj) val[jj] = -3e38f;
            if (c.lane == 0) sel[(size_t)item * 16 + k] = bi;
        }
    }
}
__device__ __forceinline__ void phase_nsa2(const Ctx& c, const Args& a, const bf16_t* proj, const int* sel, const float* nsaacc, bf16_t* onsa) {
    LAS float* tb = (LAS float*)c.lds;
    for (int e = c.tid; e < 512; e += 512) tb[e] = inptr(c, I_REL)[e];
    __syncthreads();
    for (int unit = c.bid; unit < T / 64; unit += c.G) {
        const int hh = c.tid >> 6, t = unit * 64 + (c.tid & 63), g = hh >> 2;
        RowState s; row_init(s, proj + (size_t)t * PLD + PC_NQ + hh * 64); row_reset(s);
        const float g1 = sigmoidf_(bf2f(proj[(size_t)t * PLD + PC_GL + 8 + hh]));
        for (int k = 0; k < 16; ++k) { const int j = sel[((size_t)t * 2 + g) * 16 + k];
            for (int p = 0; p < 64; ++p) { const int pos = j * 64 + p; if (pos > t) break;
                const float bias = tb[t5_bucket(t - pos) * 16 + hh];
                row_key_bf16(s, proj + (size_t)pos * PLD + PC_KS + g * 64, proj + (size_t)pos * PLD + PC_VS + g * 64, bias); } }
        const float inv = s.l > 0.f ? g1 / s.l : 0.f; const float* ap = nsaacc + (size_t)t * 512 + hh * 64; bf16_t* op = onsa + (size_t)t * 512 + hh * 64;
#pragma unroll
        for (int i = 0; i < 8; ++i) { const f32x4 x0 = *(const f32x4*)(ap + i * 8), x1 = *(const f32x4*)(ap + i * 8 + 4); u32x4 w;
            w.x = pk2(x0[0] + s.o[i * 8] * inv, x0[1] + s.o[i * 8 + 1] * inv); w.y = pk2(x0[2] + s.o[i * 8 + 2] * inv, x0[3] + s.o[i * 8 + 3] * inv);
            w.z = pk2(x1[0] + s.o[i * 8 + 4] * inv, x1[1] + s.o[i * 8 + 5] * inv); w.w = pk2(x1[2] + s.o[i * 8 + 6] * inv, x1[3] + s.o[i * 8 + 7] * inv);
            *(u32x4*)(op + i * 8) = w; }
    }
}
__device__ __forceinline__ void phase_swa(const Ctx& c, const Args& a, int layer, const bf16_t* proj, bf16_t* oswa) {
    LAS float* tb = (LAS float*)c.lds;
    for (int e = c.tid; e < 512; e += 512) tb[e] = inptr(c, I_REL)[e];
    __syncthreads();
    for (int unit = c.bid; unit < T / 64; unit += c.G) {
        const int hh = c.tid >> 6, t = unit * 64 + (c.tid & 63), g = hh >> 2;
        RowState s; row_init(s, proj + (size_t)t * PLD + PC_SQ + hh * 64); row_reset(s);
        const int s0 = t - 127 > 0 ? t - 127 : 0;
        for (int sp = s0; sp <= t; ++sp) { const float bias = tb[t5_bucket(t - sp) * 16 + 8 + hh];
            row_key_bf16(s, proj + (size_t)sp * PLD + PC_SK + g * 64, proj + (size_t)sp * PLD + PC_SV + g * 64, bias); }
        const float sink = inptr(c, I_SINK)[layer * 8 + hh]; const float mf = fmaxf(s.m, sink); const float corr = __expf(s.m - mf);
        const float den = s.l * corr + __expf(sink - mf); const float inv = corr / den;
        bf16_t* op = oswa + (size_t)t * 512 + hh * 64;
#pragma unroll
        for (int i = 0; i < 8; ++i) { u32x4 w; w.x = pk2(s.o[i * 8] * inv, s.o[i * 8 + 1] * inv); w.y = pk2(s.o[i * 8 + 2] * inv, s.o[i * 8 + 3] * inv);
            w.z = pk2(s.o[i * 8 + 4] * inv, s.o[i * 8 + 5] * inv); w.w = pk2(s.o[i * 8 + 6] * inv, s.o[i * 8 + 7] * inv); *(u32x4*)(op + i * 8) = w; }
    }
}

constexpr int RL = 65;
__device__ __forceinline__ float rwkv_mixed(const bf16_t* proj, const float* mu, int t, int col) {
    const float cur = bf2f(proj[(size_t)t * PLD + col]); const float prev = t > 0 ? bf2f(proj[(size_t)(t - 1) * PLD + col]) : 0.f;
    return cur + (prev - cur) * mu[col];
}
__device__ __forceinline__ void lora64(const Ctx& c, const LAS float* in, const float* W, const float* bias, LAS float* out, bool accum) {
    const int j = c.tid & 63, tg = (c.tid >> 6) * 8;
    float acc[8];
#pragma unroll
    for (int i = 0; i < 8; ++i) acc[i] = accum ? out[(tg + i) * RL + j] : (bias ? bias[j] : 0.f);
#pragma unroll 4
    for (int m = 0; m < 64; ++m) { const float w = W[(size_t)m * 512 + j];
#pragma unroll
        for (int i = 0; i < 8; ++i) acc[i] += in[(tg + i) * RL + m] * w; }
#pragma unroll
    for (int i = 0; i < 8; ++i) out[(tg + i) * RL + j] = acc[i];
}
struct RwkvLds { LAS float *R, *K, *V, *A, *B, *W, *G, *TMP; };
__device__ __forceinline__ RwkvLds rwkv_lds(LAS unsigned char* lds) {
    RwkvLds s; LAS float* p = (LAS float*)lds; constexpr int SZ = 64 * RL;
    s.R = p; s.K = p + SZ; s.V = p + 2 * SZ; s.A = p + 3 * SZ; s.B = p + 4 * SZ; s.W = p + 5 * SZ; s.G = p + 6 * SZ; s.TMP = p + 7 * SZ; return s;
}
template <bool LOGDECAY>
__device__ __forceinline__ void rwkv_prep(const Ctx& c, const Args& a, int layer, const bf16_t* proj, int t0, int h, const RwkvLds& s) {
    const float* mu = inptr(c, I_MU) + (size_t)layer * 1792;
    const int j = c.tid & 63, tg = c.tid >> 6;
#pragma unroll 2
    for (int i = 0; i < 8; ++i) { const int tt = tg * 8 + i; s.TMP[tt * RL + j] = tanhf(rwkv_mixed(proj, mu, t0 + tt, PC_ZW + j)); }
    __syncthreads();
    lora64(c, s.TMP, inptr(c, I_W2) + (size_t)layer * 64 * 512 + h * 64, inptr(c, I_W0) + layer * 512 + h * 64, s.W, false);
    __syncthreads();
#pragma unroll 2
    for (int i = 0; i < 8; ++i) { const int tt = tg * 8 + i; s.TMP[tt * RL + j] = rwkv_mixed(proj, mu, t0 + tt, PC_ZA + j); }
    __syncthreads();
    lora64(c, s.TMP, inptr(c, I_A2) + (size_t)layer * 64 * 512 + h * 64, inptr(c, I_A0) + layer * 512 + h * 64, s.B, false);
    __syncthreads();
#pragma unroll 2
    for (int i = 0; i < 8; ++i) { const int tt = tg * 8 + i; s.TMP[tt * RL + j] = sigmoidf_(rwkv_mixed(proj, mu, t0 + tt, PC_ZG + j)); }
    __syncthreads();
    lora64(c, s.TMP, inptr(c, I_G2) + (size_t)layer * 128 * 512 + h * 64, nullptr, s.G, false);
    __syncthreads();
#pragma unroll 2
    for (int i = 0; i < 8; ++i) { const int tt = tg * 8 + i; s.TMP[tt * RL + j] = sigmoidf_(rwkv_mixed(proj, mu, t0 + tt, PC_ZG + 64 + j)); }
    __syncthreads();
    lora64(c, s.TMP, inptr(c, I_G2) + ((size_t)layer * 128 + 64) * 512 + h * 64, nullptr, s.G, true);
    const float kkw = inptr(c, I_KK)[layer * 512 + h * 64 + j], kaw = inptr(c, I_KA)[layer * 512 + h * 64 + j];
#pragma unroll 1
    for (int i = 0; i < 8; ++i) { const int tt = tg * 8 + i, t = t0 + tt;
        const float r = rwkv_mixed(proj, mu, t, PC_R + h * 64 + j), k = rwkv_mixed(proj, mu, t, PC_K + h * 64 + j), v = rwkv_mixed(proj, mu, t, PC_V + h * 64 + j);
        const float wl = s.W[tt * RL + j], al = sigmoidf_(s.B[tt * RL + j]);
        const float sp = (-wl > 20.f) ? -wl : log1pf(__expf(-wl)); const float w = -sp - 0.5f; const float ew = __expf(w);
        float kk = k * kkw; const float n2 = wave_sum(kk * kk); kk = kk / fmaxf(sqrtf(n2), 1e-12f);
        s.R[tt * RL + j] = r; s.V[tt * RL + j] = v; s.K[tt * RL + j] = k * (1.0f + (al - 1.0f) * kaw);
        s.A[tt * RL + j] = -kk; s.B[tt * RL + j] = kk * al; s.W[tt * RL + j] = LOGDECAY ? -ew : __expf(-ew); }
    __syncthreads();
}
__device__ __forceinline__ void rwkv_post(const Ctx& c, const Args& a, int layer, int t0, int h, const RwkvLds& s, const LAS float* Y, bf16_t* orwkv) {
    const int i = c.lane, tg = c.wave;
    const float lnw = inptr(c, I_LNW)[layer * 512 + h * 64 + i], lnb = inptr(c, I_LNB)[layer * 512 + h * 64 + i], rk = inptr(c, I_RK)[layer * 512 + h * 64 + i];
#pragma unroll 1
    for (int q = 0; q < 8; ++q) { const int tt = tg * 8 + q; const float y = Y[tt * RL + i];
        const float mean = wave_sum(y) * (1.0f / 64.0f); const float d = y - mean; const float var = wave_sum(d * d) * (1.0f / 64.0f);
        const float bonus = wave_sum(s.R[tt * RL + i] * s.K[tt * RL + i] * rk);
        const float o = (d * rsqrtf(var + 64e-5f) * lnw + lnb + bonus * s.V[tt * RL + i]) * s.G[tt * RL + i];
        orwkv[(size_t)(t0 + tt) * 512 + h * 64 + i] = (bf16_t)f2bf(o); }
}
__device__ __forceinline__ void phase_rwkv_naive(const Ctx& c, const Args& a, int layer, const bf16_t* proj, bf16_t* orwkv) {
    if (c.bid >= 8) return;
    const int h = c.bid; const RwkvLds s = rwkv_lds(c.lds);
    float S[64];
#pragma unroll
    for (int j = 0; j < 64; ++j) S[j] = 0.f;
    for (int ch = 0; ch < T / 64; ++ch) {
        rwkv_prep<false>(c, a, layer, proj, ch * 64, h, s);
        if (c.wave == 0) {
            const int i = c.lane;
            for (int tt = 0; tt < 64; ++tt) {
                float sa = 0.f;
#pragma unroll
                for (int j = 0; j < 64; ++j) { sa += S[j] * s.A[tt * RL + j]; if ((j & 7) == 7) __builtin_amdgcn_sched_barrier(0); }
                const float vi = s.V[tt * RL + i]; float y = 0.f;
#pragma unroll
                for (int j = 0; j < 64; ++j) { S[j] = S[j] * s.W[tt * RL + j] + sa * s.B[tt * RL + j] + vi * s.K[tt * RL + j]; y += S[j] * s.R[tt * RL + j]; if ((j & 3) == 3) __builtin_amdgcn_sched_barrier(0); }
                s.TMP[tt * RL + i] = y;
            }
        }
        __syncthreads();
        rwkv_post(c, a, layer, ch * 64, h, s, s.TMP, orwkv);
        __syncthreads();
    }
}


__device__ __forceinline__ int kperm32(int jl) { return 8 * ((jl >> 2) & 3) + 4 * (jl >> 4) + (jl & 3); }
__device__ __forceinline__ f32x4 tile_mma64(const LAS unsigned char* A, const LAS unsigned char* B, int a, int b, int lane, f32x4 acc) {
    const int m = lane & 15, q = lane >> 4;
#pragma unroll
    for (int ks = 0; ks < 2; ++ks) {
        const bf16x8 af = *(const LAS bf16x8*)(A + (16 * a + m) * 144 + (32 * ks + 8 * q) * 2);
        const bf16x8 bf = *(const LAS bf16x8*)(B + (16 * b + m) * 144 + (32 * ks + 8 * q) * 2);
        acc = __builtin_amdgcn_mfma_f32_16x16x32_bf16(af, bf, acc, 0, 0, 0);
    }
    return acc;
}
__device__ __forceinline__ void lds_st_bf16(LAS unsigned char* base, int idx, float v) { *(LAS bf16_t*)(base + idx * 2) = (bf16_t)f2bf(v); }

__device__ __forceinline__ void phase_lora_a(const Ctx& c, const Args& a, int layer, const bf16_t* proj, bf16_t* alora) {
    const float* mu = inptr(c, I_MU) + (size_t)layer * 1792;
    const int sub = c.tid & 31, rloc = c.tid >> 5;
    for (int t = c.bid * 16 + rloc; t < T; t += c.G * 16) {
        const int col = PC_ZW + sub * 8; float cur[8], prv[8];
        unpack8(*(const u32x4*)(proj + (size_t)t * PLD + col), cur);
        if (t > 0) unpack8(*(const u32x4*)(proj + (size_t)(t - 1) * PLD + col), prv); else {
#pragma unroll
            for (int k = 0; k < 8; ++k) prv[k] = 0.f; }
        float o[8];
#pragma unroll
        for (int k = 0; k < 8; ++k) { const float v = cur[k] + (prv[k] - cur[k]) * mu[col + k]; o[k] = sub < 8 ? tanhf(v) : (sub < 16 ? v : sigmoidf_(v)); }
        u32x4 w; w.x = pk2(o[0], o[1]); w.y = pk2(o[2], o[3]); w.z = pk2(o[4], o[5]); w.w = pk2(o[6], o[7]);
        *(u32x4*)(alora + (size_t)t * 256 + sub * 8) = w;
    }
}

constexpr int RC_L = 0, RC_AL = 16640, RC_AAK = 0, RC_ARB = 9216, RC_ARK = 18432, RC_AAB = 33280, RC_P2T = 33280, RC_WC = 50688, RC_BS = 50944, RC_M = 52992;
constexpr int RC_AT = RC_M, RC_TINV = RC_M, RC_ATT = RC_M + 9216, RC_RT = RC_M + 2 * 9216, RC_BT = RC_M + 3 * 9216, RC_XT = RC_BT, RC_KT = RC_M + 4 * 9216, RC_P1T = RC_KT,
              RC_VT = RC_M + 5 * 9216, RC_BHT = RC_M + 6 * 9216, RC_KHT = RC_M + 7 * 9216;
constexpr int RC_XOFF = RC_M + 8 * 9216, RC_XTMP = RC_XOFF + 6144;
static_assert(RC_XTMP + 3 * 1088 <= LDS_MISC, "rwkv chunk LDS");

__device__ __forceinline__ void phase_rwkv_chunk(const Ctx& c, const Args& a, int layer, const bf16_t* proj, const bf16_t* wlb, const bf16_t* alb, bf16_t* rwu, float* bonusg) {
    LAS unsigned char* L = c.lds;
    LAS float* sL = (LAS float*)(L + RC_L); LAS float* sAL = (LAS float*)(L + RC_AL); LAS float* sAAB = (LAS float*)(L + RC_AAB);
    LAS float* sWC = (LAS float*)(L + RC_WC); LAS float* sBS = (LAS float*)(L + RC_BS);
    const float* mu = inptr(c, I_MU) + (size_t)layer * 1792;
    const int lane = c.lane, wave = c.wave, n = lane & 15, q = lane >> 4;
    for (int unit = c.bid; unit < 2048; unit += c.G) {
        const int ch = unit >> 3, h = unit & 7, t0 = ch * 64, j = lane;
        {
            const float w0 = inptr(c, I_W0)[layer * 512 + h * 64 + j], a0 = inptr(c, I_A0)[layer * 512 + h * 64 + j];
            bf16_t wraw[8], araw[8];
#pragma unroll
            for (int i = 0; i < 8; ++i) { const size_t gi = (size_t)(t0 + wave * 8 + i) * 512 + h * 64 + j; wraw[i] = wlb[gi]; araw[i] = alb[gi]; }
            float run = 0.f;
#pragma unroll
            for (int i = 0; i < 8; ++i) { const int tt = wave * 8 + i;
                const float wl = w0 + bf2f(wraw[i]); const float nx = -wl; const float sp = nx > 20.f ? nx : __logf(1.0f + __expf(nx)); const float ld = -__expf(-sp - 0.5f);
                run += ld; sL[tt * RL + j] = run; sAL[tt * RL + j] = sigmoidf_(a0 + bf2f(araw[i])); }
            sBS[wave * 64 + j] = run;
        }
        bf16_t rraw[9], kraw[9], vraw[9];
        {
#pragma unroll
            for (int i = 0; i < 9; ++i) { const int t = t0 + wave * 8 + i - 1; const bool ok = t >= 0; const size_t ro = (size_t)(ok ? t : 0) * PLD + h * 64 + j;
                rraw[i] = ok ? proj[ro + PC_R] : (bf16_t)0; kraw[i] = ok ? proj[ro + PC_K] : (bf16_t)0; vraw[i] = ok ? proj[ro + PC_V] : (bf16_t)0; }
        }
        __syncthreads();
        {
            float off = 0.f, tot = 0.f;
#pragma unroll
            for (int w2 = 0; w2 < 8; ++w2) { const float v = sBS[w2 * 64 + j]; tot += v; off += (w2 < wave) ? v : 0.f; }
            if (wave == 0) sWC[j] = __expf(tot);
            const float kkw = inptr(c, I_KK)[layer * 512 + h * 64 + j], kaw = inptr(c, I_KA)[layer * 512 + h * 64 + j], rk = inptr(c, I_RK)[layer * 512 + h * 64 + j];
            const float mur = mu[PC_R + h * 64 + j], muk = mu[PC_K + h * 64 + j], muv = mu[PC_V + h * 64 + j];
            float Lprev = off; float eWprev = __expf(off); const float eTot = __expf(tot);
#pragma unroll
            for (int i = 0; i < 8; ++i) { const int tt = wave * 8 + i, t = t0 + tt;
                const float Lc = sL[tt * RL + j] + off, al = sAL[tt * RL + j];
                const float rc = bf2f(rraw[i + 1]), kc = bf2f(kraw[i + 1]), vc = bf2f(vraw[i + 1]);
                const float r = rc + (bf2f(rraw[i]) - rc) * mur, k = kc + (bf2f(kraw[i]) - kc) * muk, v = vc + (bf2f(vraw[i]) - vc) * muv;
                float kk = k * kkw; const float n2 = wave_sum(kk * kk); kk = kk / fmaxf(sqrtf(n2), 1e-12f);
                const float kp = k * (1.0f + (al - 1.0f) * kaw), av = -kk, bv = kk * al;
                const float eW = __expf(Lc), eInv = __builtin_amdgcn_rcpf(eW), eC = eTot * eInv; const float eWex = eWprev; eWprev = eW;
                lds_st_bf16(L + RC_AT, tt * 72 + j, av * eWex); lds_st_bf16(L + RC_ATT, j * 72 + tt, av * eWex);
                lds_st_bf16(L + RC_RT, tt * 72 + j, r * eW); lds_st_bf16(L + RC_BT, tt * 72 + j, bv * eInv); lds_st_bf16(L + RC_KT, tt * 72 + j, kp * eInv);
                lds_st_bf16(L + RC_VT, j * 72 + tt, v); lds_st_bf16(L + RC_BHT, j * 72 + tt, bv * eC); lds_st_bf16(L + RC_KHT, j * 72 + tt, kp * eC);
                const float bon = wave_sum(r * kp * rk); if (lane == 0) bonusg[(size_t)t * 8 + h] = bon;
                Lprev = Lc; }
        }
        __syncthreads();
        for (int job = wave; job < 64; job += 8) {
            const int p = job >> 4, ta = (job >> 2) & 3, tb = job & 3;
            f32x4 acc = (f32x4){0.f, 0.f, 0.f, 0.f};
            if (ta >= tb) acc = tile_mma64(L + (p < 2 ? RC_AT : RC_RT), L + ((p & 1) ? RC_KT : RC_BT), ta, tb, lane, acc);
            LAS unsigned char* dst = L + (p == 1 ? RC_AAK : (p == 2 ? RC_ARB : RC_ARK));
#pragma unroll
            for (int r = 0; r < 4; ++r) { const int tt = 16 * ta + 4 * q + r, ss = 16 * tb + n; const bool keep = (p < 2) ? (ss < tt) : (ss <= tt); const float v = keep ? acc[r] : 0.f;
                if (p == 0) sAAB[tt * 68 + ss] = v; else lds_st_bf16(dst, tt * 72 + ss, v); }
        }
        __syncthreads();
        if (wave == 0) {
            const int blk = lane >> 4, cc = lane & 15; const LAS float* Ab = sAAB + (16 * blk) * 68 + 16 * blk; float xr[16];
#pragma unroll
            for (int tt = 0; tt < 16; ++tt) { float acc = (tt == cc) ? 1.f : 0.f;
#pragma unroll
                for (int ss = 0; ss < tt; ++ss) acc += Ab[tt * 68 + ss] * xr[ss];
                xr[tt] = acc; }
            asm volatile("s_waitcnt lgkmcnt(0)" ::: "memory");
#pragma unroll
            for (int tt = 0; tt < 16; ++tt) sAAB[(16 * blk + tt) * 68 + 16 * blk + cc] = xr[tt];
        } else {
            for (int job = wave - 1; job < 16; job += 7) { const int ta = job >> 2, tb = job & 3;
                const f32x4 acc = tile_mma64(L + RC_VT, L + RC_AAK, ta, tb, lane, (f32x4){0.f, 0.f, 0.f, 0.f});
#pragma unroll
                for (int r = 0; r < 4; ++r) lds_st_bf16(L + RC_XT, (16 * ta + 4 * q + r) * 72 + 16 * tb + n, acc[r]); }
        }
        __syncthreads();
        {
            LAS float* sXO = (LAS float*)(L + RC_XOFF); LAS float* sT = (LAS float*)(L + RC_XTMP) + wave * 272;
            const int rr = lane >> 2, c4 = (lane & 3) * 4;
#pragma unroll 1
            for (int lev = 1; lev <= 3; ++lev) {
                if (wave < 4 - lev) {
                    const int J = wave, I = wave + lev;
                    f32x4 tacc = (f32x4){0.f, 0.f, 0.f, 0.f};
                    for (int K = J; K < I; ++K) {
                        const LAS float* Ap = sAAB + (16 * I + rr) * 68 + 16 * K; const LAS float* Xp;
                        int xs;
                        if (K == J) { Xp = sAAB + (16 * J) * 68 + 16 * J + c4; xs = 68; }
                        else { const int d = K - J; const int bi = (d == 1) ? J : 3 + J; Xp = sXO + bi * 256 + c4; xs = 16; }
#pragma unroll
                        for (int k = 0; k < 16; ++k) { const float av = Ap[k]; const f32x4 xv = *(const LAS f32x4*)(Xp + k * xs); tacc += xv * av; }
                    }
                    *(LAS f32x4*)(sT + rr * 16 + c4) = tacc;
                    asm volatile("s_waitcnt lgkmcnt(0)" ::: "memory");
                    f32x4 xacc = (f32x4){0.f, 0.f, 0.f, 0.f};
                    const LAS float* Dp = sAAB + (16 * I + rr) * 68 + 16 * I;
#pragma unroll
                    for (int k = 0; k < 16; ++k) { const float dv = Dp[k]; const f32x4 tv = *(const LAS f32x4*)(sT + k * 16 + c4); xacc += tv * dv; }
                    const int bo = (lev == 1) ? J : (lev == 2 ? 3 + J : 5);
                    *(LAS f32x4*)(sXO + bo * 256 + rr * 16 + c4) = xacc;
                }
                __syncthreads();
            }
            for (int e = c.tid; e < 4096; e += 512) { const int tt = e >> 6, ss = e & 63, I = tt >> 4, J = ss >> 4; float v = 0.f;
                if (I == J) v = sAAB[tt * 68 + ss];
                else if (I > J) { const int d = I - J; const int bi = (d == 1) ? J : (d == 2 ? 3 + J : 5); v = sXO[bi * 256 + (tt & 15) * 16 + (ss & 15)]; }
                lds_st_bf16(L + RC_TINV, tt * 72 + ss, v); }
        }
        __syncthreads();
        for (int job = wave; job < 32; job += 8) { const int p = job >> 4, ta = (job >> 2) & 3, tb = job & 3;
            const f32x4 acc = tile_mma64(L + (p ? RC_XT : RC_ATT), L + RC_TINV, ta, tb, lane, (f32x4){0.f, 0.f, 0.f, 0.f});
#pragma unroll
            for (int r = 0; r < 4; ++r) lds_st_bf16(L + (p ? RC_P2T : RC_P1T), (16 * ta + 4 * q + r) * 72 + 16 * tb + n, acc[r]); }
        __syncthreads();
        bf16_t* ug = rwu + (size_t)unit * 16384;
        for (int job = wave; job < 64; job += 8) { const int p = job >> 4, ta = (job >> 2) & 3, tb = job & 3;
            f32x4 acc = (f32x4){0.f, 0.f, 0.f, 0.f};
            if (p == 0) { acc = tile_mma64(L + RC_ARB, L + RC_P1T, ta, tb, lane, acc);
#pragma unroll
                for (int r = 0; r < 4; ++r) { const int tt = 16 * ta + 4 * q + r, jj = 16 * tb + n; const float v = acc[r] + bf2f(*(const LAS bf16_t*)(L + RC_RT + (tt * 72 + jj) * 2));
                    ug[8192 + tt * 64 + (jj & 32) + kperm32(jj & 31)] = (bf16_t)f2bf(v); } }
            else if (p == 1) { acc = tile_mma64(L + RC_ARB, L + RC_P2T, ta, tb, lane, acc); acc = tile_mma64(L + RC_ARK, L + RC_VT, ta, tb, lane, acc);
                u32x2 w; w.x = pk2(acc[0], acc[1]); w.y = pk2(acc[2], acc[3]); *(u32x2*)(ug + 12288 + ((tb * 4 + ta) * 64 + lane) * 4) = w; }
            else if (p == 2) { acc = tile_mma64(L + RC_BHT, L + RC_P1T, ta, tb, lane, acc);
#pragma unroll
                for (int r = 0; r < 4; ++r) { const int jr = 16 * ta + 4 * q + r, jc = 16 * tb + n; const float v = acc[r] + (jr == jc ? sWC[jr] : 0.f);
                    ug[jr * 64 + (jc & 32) + kperm32(jc & 31)] = (bf16_t)f2bf(v); } }
            else { acc = tile_mma64(L + RC_BHT, L + RC_P2T, ta, tb, lane, acc); acc = tile_mma64(L + RC_KHT, L + RC_VT, ta, tb, lane, acc);
                u32x2 w; w.x = pk2(acc[0], acc[1]); w.y = pk2(acc[2], acc[3]); *(u32x2*)(ug + 4096 + ((tb * 4 + ta) * 64 + lane) * 4) = w; }
        }
        __syncthreads();
    }
}

#define RW_LOAD_SET(SET, UNIT) do { const bf16_t* ug_ = rwu + (size_t)(UNIT) * 16384; \
    _Pragma("unroll") for (int ta = 0; ta < 4; ++ta) { An[SET][ta][0] = *(const bf16x8*)(ug_ + (16 * ta + m) * 64 + 8 * q); An[SET][ta][1] = *(const bf16x8*)(ug_ + (16 * ta + m) * 64 + 32 + 8 * q); \
        Zn[SET][ta] = *(const u32x2*)(ug_ + 4096 + ((cq * 4 + ta) * 64 + lane) * 4); } } while (0)
template <int SM>
__device__ __forceinline__ void phase_rwkv_scan(const Ctx& c, const bf16_t* rwu, bf16_t* rws) {
    const int idx = c.bid; if (idx >= 32 || c.wave != 0) return;
    const int h = idx >> 2, cq = idx & 3, lane = c.lane, m = lane & 15, q = lane >> 4;
    bf16x8 Bhi[2], Blo[2];
#pragma unroll
    for (int s = 0; s < 2; ++s) { Bhi[s] = (bf16x8){0, 0, 0, 0, 0, 0, 0, 0}; Blo[s] = Bhi[s]; }
    bf16x8 An[2][4][2]; u32x2 Zn[2][4];
#pragma unroll
    for (int u = 0; u < 2; ++u) RW_LOAD_SET(u, u * 8 + h);
    if (SM == 1) {
        for (int ch = 0; ch < T / 64; ch += 8) {
#pragma unroll
            for (int uu = 0; uu < 8; ++uu) { const int u = uu & 3; const int unit = (ch + uu) * 8 + h;
                bf16_t* sg = rws + (size_t)unit * 4096 + cq * 1024 + lane * 8;
                *(bf16x8*)(sg) = Bhi[0]; *(bf16x8*)(sg + 512) = Bhi[1];
#pragma unroll
                for (int ta = 0; ta < 4; ++ta) { Bhi[0] = Bhi[0] ^ An[u][ta][0]; Bhi[1] = Bhi[1] ^ An[u][ta][1]; Bhi[0][0] ^= (short)Zn[u][ta].x; }
                RW_LOAD_SET(u, (ch + uu + 4 < T / 64) ? unit + 32 : unit); } }
        return;
    }
    for (int ch = 0; ch < T / 64; ch += 8) {
#pragma unroll
        for (int uu = 0; uu < 8; ++uu) {
            const int u = uu & 1;
            const int unit = (ch + uu) * 8 + h;
            bf16_t* sg = rws + (size_t)unit * 4096 + cq * 1024 + lane * 8;
            *(bf16x8*)(sg) = Bhi[0]; *(bf16x8*)(sg + 512) = Bhi[1];
            f32x4 acc[4];
#pragma unroll
            for (int ta = 0; ta < 4; ++ta) { const u32x2 z = Zn[u][ta];
                acc[ta] = (f32x4){__uint_as_float(z.x << 16), __uint_as_float(z.x & 0xffff0000u), __uint_as_float(z.y << 16), __uint_as_float(z.y & 0xffff0000u)};
#pragma unroll
                for (int s = 0; s < 2; ++s) { acc[ta] = __builtin_amdgcn_mfma_f32_16x16x32_bf16(An[u][ta][s], Bhi[s], acc[ta], 0, 0, 0); acc[ta] = __builtin_amdgcn_mfma_f32_16x16x32_bf16(An[u][ta][s], Blo[s], acc[ta], 0, 0, 0); } }
            if (SM == 0) RW_LOAD_SET(u, (ch + uu + 2 < T / 64) ? unit + 16 : unit);
#pragma unroll
            for (int s = 0; s < 2; ++s) { u32x4 hi, lo; float rem[8];
#pragma unroll
                for (int p = 0; p < 8; ++p) { const float v = acc[2 * s + (p >> 2)][p & 3]; const unsigned hb = f2bf(v); rem[p] = v - __uint_as_float(hb << 16); }
                hi.x = pk2(acc[2 * s][0], acc[2 * s][1]); hi.y = pk2(acc[2 * s][2], acc[2 * s][3]); hi.z = pk2(acc[2 * s + 1][0], acc[2 * s + 1][1]); hi.w = pk2(acc[2 * s + 1][2], acc[2 * s + 1][3]);
                lo.x = pk2(rem[0], rem[1]); lo.y = pk2(rem[2], rem[3]); lo.z = pk2(rem[4], rem[5]); lo.w = pk2(rem[6], rem[7]);
                Bhi[s] = __builtin_bit_cast(bf16x8, hi); Blo[s] = __builtin_bit_cast(bf16x8, lo); }
        }
    }
}
#undef RW_LOAD_SET

__device__ __forceinline__ void phase_rwkv_out(const Ctx& c, const Args& a, int layer, const bf16_t* proj, const bf16_t* rwu, const bf16_t* rws, const float* bonusg, bf16_t* orwkv) {
    const float* mu = inptr(c, I_MU) + (size_t)layer * 1792;
    const int lane = c.lane, m = lane & 15, q = lane >> 4;
    for (int unit = c.bid * 8 + c.wave; unit < 2048; unit += c.G * 8) {
        const int ch = unit >> 3, h = unit & 7, t0 = ch * 64; const bf16_t* ug = rwu + (size_t)unit * 16384; const bf16_t* sg = rws + (size_t)unit * 4096;
        bf16x8 Bf[4][2];
#pragma unroll
        for (int cq = 0; cq < 4; ++cq) { Bf[cq][0] = *(const bf16x8*)(sg + cq * 1024 + lane * 8); Bf[cq][1] = *(const bf16x8*)(sg + cq * 1024 + 512 + lane * 8); }
        float lnw[4], lnb[4];
#pragma unroll
        for (int cq = 0; cq < 4; ++cq) { lnw[cq] = inptr(c, I_LNW)[layer * 512 + h * 64 + 16 * cq + m]; lnb[cq] = inptr(c, I_LNB)[layer * 512 + h * 64 + 16 * cq + m]; }
        float muv[4];
#pragma unroll
        for (int cq = 0; cq < 4; ++cq) muv[cq] = mu[PC_V + h * 64 + 16 * cq + m];
#pragma unroll 1
        for (int ta = 0; ta < 4; ++ta) {
            const bf16x8 A0 = *(const bf16x8*)(ug + 8192 + (16 * ta + m) * 64 + 8 * q), A1 = *(const bf16x8*)(ug + 8192 + (16 * ta + m) * 64 + 32 + 8 * q);
            f32x4 y[4];
#pragma unroll
            for (int cq = 0; cq < 4; ++cq) { const u32x2 z = *(const u32x2*)(ug + 12288 + ((cq * 4 + ta) * 64 + lane) * 4);
                y[cq] = (f32x4){__uint_as_float(z.x << 16), __uint_as_float(z.x & 0xffff0000u), __uint_as_float(z.y << 16), __uint_as_float(z.y & 0xffff0000u)};
                y[cq] = __builtin_amdgcn_mfma_f32_16x16x32_bf16(A0, Bf[cq][0], y[cq], 0, 0, 0); y[cq] = __builtin_amdgcn_mfma_f32_16x16x32_bf16(A1, Bf[cq][1], y[cq], 0, 0, 0); }
            bf16_t vcur[4][4], vprv[4][4], graw[4][4]; float bonv[4];
#pragma unroll
            for (int r = 0; r < 4; ++r) { const int t = t0 + 16 * ta + 4 * q + r; bonv[r] = bonusg[(size_t)t * 8 + h];
#pragma unroll
                for (int cq = 0; cq < 4; ++cq) { const int col = h * 64 + 16 * cq + m; vcur[r][cq] = proj[(size_t)t * PLD + PC_V + col];
                    vprv[r][cq] = t > 0 ? proj[(size_t)(t - 1) * PLD + PC_V + col] : (bf16_t)0; graw[r][cq] = orwkv[(size_t)t * 512 + col]; } }
#pragma unroll
            for (int r = 0; r < 4; ++r) { const int t = t0 + 16 * ta + 4 * q + r;
                float sm = row16_sum(y[0][r] + y[1][r] + y[2][r] + y[3][r]);
                const float mean = sm * (1.0f / 64.0f); float d[4], vs = 0.f;
#pragma unroll
                for (int cq = 0; cq < 4; ++cq) { d[cq] = y[cq][r] - mean; vs += d[cq] * d[cq]; }
                vs = row16_sum(vs);
                const float rstd = rsqrtf(vs * (1.0f / 64.0f) + 64e-5f); const float bon = bonv[r];
#pragma unroll
                for (int cq = 0; cq < 4; ++cq) { const int col = h * 64 + 16 * cq + m; const float vc = bf2f(vcur[r][cq]); const float v = vc + (bf2f(vprv[r][cq]) - vc) * muv[cq];
                    orwkv[(size_t)t * 512 + col] = (bf16_t)f2bf((d[cq] * rstd * lnw[cq] + lnb[cq] + bon * v) * bf2f(graw[r][cq])); } }
        }
    }
}


constexpr int AT_K = 0, AT_V = 9216, AT_SCORE = 18432  , AT_BIAS = 83968, AT_SELM = 100352, AT_LIST = 104448, AT_NLIST = 105472, AT_NEED = 105504, AT_REL = 105600  ;
__device__ __forceinline__ void vt_transpose(const Ctx& c, const bf16_t* proj, bf16_t* vt) {
    LAS bf16_t* tl = (LAS bf16_t*)c.lds;
    for (int it = c.bid; it < 3 * 2 * 256; it += c.G) {
        const int which = it / 512, g = (it >> 8) & 1, tt = it & 255;
        const int col = (which == 0 ? PC_VS : (which == 1 ? PC_VW : PC_SV)) + g * 64;
        { const int tok = c.tid >> 3, ch = c.tid & 7; const u32x4 w = *(const u32x4*)(proj + (size_t)(tt * 64 + tok) * PLD + col + ch * 8);
          *(LAS u32x4*)(tl + tok * 72 + ch * 8) = w; }
        __syncthreads();
        { const int d = c.tid >> 3, ch = c.tid & 7; unsigned short e[8];
#pragma unroll
          for (int k = 0; k < 8; ++k) e[k] = tl[(ch * 8 + k) * 72 + d];
          u32x4 w; w.x = e[0] | ((unsigned)e[1] << 16); w.y = e[2] | ((unsigned)e[3] << 16); w.z = e[4] | ((unsigned)e[5] << 16); w.w = e[6] | ((unsigned)e[7] << 16);
          *(u32x4*)(vt + ((size_t)(which * 2 + g) * 64 + d) * T + tt * 64 + ch * 8) = w; }
        __syncthreads();
    }
}

template <int MODE, int NQ, int DBG = 0>
__device__ __forceinline__ void phase_attn(const Ctx& c, const Args& a, int layer, const bf16_t* proj, const bf16_t* vtb, const bf16_t* kcb, const bf16_t* vctb,
                                           unsigned* sel, float* nsaacc, bf16_t* oout) {
    LAS unsigned char* L = c.lds;
    LAS float* sscore = (LAS float*)(L + AT_SCORE);
    LAS float* biasd = (LAS float*)(L + AT_BIAS);
    LAS unsigned* selm = (LAS unsigned*)(L + AT_SELM);
    LAS int* list = (LAS int*)(L + AT_LIST);
    LAS int* nlist = (LAS int*)(L + AT_NLIST);
    LAS unsigned* need = (LAS unsigned*)(L + AT_NEED);
    const int lane = c.lane, wave = c.wave, n = lane & 15, q = lane >> 4, hr = n & 3;
    LAS float* reltab = (LAS float*)(L + AT_REL);
    __syncthreads();
    reltab[c.tid] = inptr(c, I_REL)[c.tid];
    constexpr int TW = 4 * NQ, TB = 8 * TW, NU = T / TB, TS = (MODE == 3) ? 4 : 1;
    for (int unit = c.bid; unit < 2 * NU; unit += c.G) {
        const int g = unit / NU, t0 = ((g == 0) ? (unit % NU) : (NU - 1 - unit % NU)) * TB, tw0 = t0 + wave * TW;
        __syncthreads();
        for (int e = c.tid; e < 4096; e += 512) { const int r = e >> 10, d = e & 1023; biasd[e] = reltab[t5_bucket(d) * 16 + (MODE == 0 ? 8 : 0) + g * 4 + r]; }
        if (MODE == 3) {
            if (c.tid < 8) need[c.tid] = 0u;
            __syncthreads();
            { const int tok = c.tid >> 3, w8 = c.tid & 7; const unsigned mw = selp((unsigned char*)sel, t0 + tok, g)[w8]; selm[tok * 8 + w8] = mw; atomicOr((unsigned*)&need[w8], mw); }
            __syncthreads();
            if (c.tid < 256) { const int j = c.tid; const unsigned wd = need[j >> 5];
                if ((wd >> (j & 31)) & 1u) { int pos = __popc(wd & ((1u << (j & 31)) - 1u)); for (int w2 = 0; w2 < (j >> 5); ++w2) pos += __popc(need[w2]); list[pos] = j; } }
            if (c.tid == 0) { int cnt = 0; for (int w2 = 0; w2 < 8; ++w2) cnt += __popc(need[w2]); nlist[0] = cnt; }
        }
        __syncthreads();
        int ntiles, tile_lo = 0;
        if (MODE == 0) { ntiles = 2 + TB / 64; tile_lo = t0 - 128; }
        else if (MODE == 1) { ntiles = 8 + TB / 64; tile_lo = t0 - 512; }
        else if (MODE == 2) { const int cmax = (t0 + TB - 1 - 31) >> 4; ntiles = cmax < 0 ? 0 : (cmax >> 6) + 1; }
        else ntiles = nlist[0];
        const bf16_t* Ksrc; size_t kstride; const bf16_t* Vsrc; size_t vstride; int qcol;
        if (MODE == 0) { Ksrc = proj + PC_SK + g * 64; kstride = PLD; Vsrc = vtb + (size_t)(4 + g) * 64 * T; vstride = T; qcol = PC_SQ + g * 256; }
        else if (MODE == 1) { Ksrc = proj + PC_KW + g * 64; kstride = PLD; Vsrc = vtb + (size_t)(2 + g) * 64 * T; vstride = T; qcol = PC_NQ + g * 256; }
        else if (MODE == 2) { Ksrc = kcb + (size_t)g * 1024 * 64; kstride = 64; Vsrc = vctb + (size_t)g * 64 * 1024; vstride = 1024; qcol = PC_NQ + g * 256; }
        else { Ksrc = proj + PC_KS + g * 64; kstride = PLD; Vsrc = vtb + (size_t)(0 + g) * 64 * T; vstride = T; qcol = PC_NQ + g * 256; }
        bf16x8 Bq[NQ][2];
#pragma unroll
        for (int qd = 0; qd < NQ; ++qd) { const bf16_t* qp = proj + (size_t)(tw0 + 4 * qd + (n >> 2)) * PLD + qcol + hr * 64 + 8 * q;
            Bq[qd][0] = *(const bf16x8*)qp; Bq[qd][1] = *(const bf16x8*)(qp + 32); }
        const float bfar = biasd[hr * 1024 + 1023];
        float mrun[NQ], lrun[NQ]; f32x4 O[NQ][4];
#pragma unroll
        for (int qd = 0; qd < NQ; ++qd) { mrun[qd] = -1e30f; lrun[qd] = 0.f;
#pragma unroll
            for (int dt = 0; dt < 4; ++dt) O[qd][dt] = (f32x4){0.f, 0.f, 0.f, 0.f}; }
        float carry3[NQ]; for (int i = 0; i < NQ; ++i) carry3[i] = 0.f;
        const int npass = (MODE == 2) ? 2 : 1;
        for (int pass = 0; pass < npass; ++pass) {
            const bool do_pv = (MODE != 2) || pass == 1;
            float linv[NQ];
            if (MODE == 2 && pass == 1) {
#pragma unroll
                for (int qd = 0; qd < NQ; ++qd) { float mt = mrun[qd]; mt = fmaxf(mt, __shfl_xor(mt, 16)); mt = fmaxf(mt, __shfl_xor(mt, 32));
                    float lt = lrun[qd] * __expf(mrun[qd] - mt); lt += __shfl_xor(lt, 16); lt += __shfl_xor(lt, 32); mrun[qd] = mt; linv[qd] = lt > 0.f ? 1.0f / lt : 0.f; }
            }
#define AT_TILEPOS(ti) ((MODE == 3) ? list[ti] * 64 : (MODE == 2 ? (ti) * 64 : tile_lo + (ti) * 64))
#define AT_ISSUE(rd) do { _Pragma("unroll") for (int i_ = 0; i_ < TS; ++i_) { const int ti_ = (rd) * TS + i_; p0n[i_] = ti_ < ntiles ? AT_TILEPOS(ti_) : -1; \
        if (p0n[i_] >= 0) { kreg[i_] = *(const u32x4*)(Ksrc + (size_t)(p0n[i_] + (c.tid >> 3)) * kstride + (c.tid & 7) * 8); \
            if (do_pv) vreg[i_] = *(const u32x4*)(Vsrc + (size_t)(c.tid >> 3) * vstride + p0n[i_] + (c.tid & 7) * 8); } } } while (0)
            u32x4 kreg[TS], vreg[TS]; int p0n[TS];
            const int nrounds = (ntiles + TS - 1) / TS;
            if (nrounds > 0) AT_ISSUE(0);
            for (int rd = 0; rd < nrounds; ++rd) {
                int p0s[TS];
#pragma unroll
                for (int i = 0; i < TS; ++i) p0s[i] = p0n[i];
                __syncthreads();
#pragma unroll
                for (int i = 0; i < TS; ++i) if (p0s[i] >= 0) { *(LAS u32x4*)(L + AT_K + i * 18432 + (c.tid >> 3) * 144 + (c.tid & 7) * 16) = kreg[i];
                    if (do_pv) *(LAS u32x4*)(L + AT_V + i * 18432 + (c.tid >> 3) * 144 + (c.tid & 7) * 16) = vreg[i]; }
                if (rd + 1 < nrounds) AT_ISSUE(rd + 1);
                __syncthreads();
#pragma unroll
              for (int ts = 0; ts < TS; ++ts) {
                const int p0 = p0s[ts]; const int LK = AT_K + ts * 18432, LV = AT_V + ts * 18432;
                if (p0 < 0) continue;
                if (MODE == 0) { if (p0 > tw0 + TW - 1 || p0 + 63 < tw0 - 127) continue; }
                if (MODE == 1) { if (p0 > tw0 + TW - 1 || p0 + 63 < tw0 - 511) continue; }
                if (MODE == 2) { if (16 * p0 + 31 > tw0 + TW - 1) continue; }
                if (MODE == 3) { if (p0 > tw0 + TW - 1) continue; }
                const bool far = (MODE == 2) ? (tw0 - (16 * (p0 + 63) + 31) >= 790) : ((MODE == 3) ? (tw0 - (p0 + 63) >= 790) : false);
                const int jblk = p0 >> 6;
                bf16x8 akf[4][2]; bf16x8 avf[2][4];
                if (MODE != 3) {
#pragma unroll
                    for (int kt = 0; kt < 4; ++kt)
#pragma unroll
                        for (int ks = 0; ks < 2; ++ks) akf[kt][ks] = *(const LAS bf16x8*)(L + LK + (16 * kt + n) * 144 + (32 * ks + 8 * q) * 2);
                    if (do_pv) {
#pragma unroll
                        for (int st = 0; st < 2; ++st)
#pragma unroll
                            for (int dt = 0; dt < 4; ++dt) { const LAS unsigned char* vp = L + LV + (16 * dt + n) * 144 + (32 * st + 4 * q) * 2;
                                const u32x2 v0 = *(const LAS u32x2*)vp, v1 = *(const LAS u32x2*)(vp + 32); u32x4 vw; vw.x = v0.x; vw.y = v0.y; vw.z = v1.x; vw.w = v1.y; avf[st][dt] = __builtin_bit_cast(bf16x8, vw); } }
                }
                unsigned tokmask = 0u;
                if (MODE == 3) { tokmask = (unsigned)__ballot(lane < TW && ((selm[(wave * TW + (lane & (TW - 1))) * 8 + (jblk >> 5)] >> (jblk & 31)) & 1u)); if (tokmask == 0u) continue; }
#pragma unroll
                for (int qd = 0; qd < NQ; ++qd) {
                    const int tq = tw0 + 4 * qd + (n >> 2);
                    if (DBG == 3) continue;
                    bool colsel = true;
                    if (MODE == 3) { colsel = (tokmask >> (4 * qd + (n >> 2))) & 1u; if (((tokmask >> (4 * qd)) & 0xfu) == 0u) continue; }
                    {
                        f32x4 sc[4];
#pragma unroll
                        for (int kt = 0; kt < 4; ++kt) { sc[kt] = (f32x4){0.f, 0.f, 0.f, 0.f};
#pragma unroll
                            for (int ks = 0; ks < 2; ++ks) { const bf16x8 ak = (MODE != 3) ? akf[kt][ks] : *(const LAS bf16x8*)(L + LK + (16 * kt + n) * 144 + (32 * ks + 8 * q) * 2);
                                sc[kt] = __builtin_amdgcn_mfma_f32_16x16x32_bf16(ak, Bq[qd][ks], sc[kt], 0, 0, 0); } }
                        float mx = -1e30f;
                        if (far) {
#pragma unroll
                            for (int kt = 0; kt < 4; ++kt)
#pragma unroll
                                for (int r = 0; r < 4; ++r) { const float s2 = (MODE == 3 && !colsel) ? -1e30f : sc[kt][r] + bfar; sc[kt][r] = s2; mx = fmaxf(mx, s2); }
                        } else {
#pragma unroll
                        for (int kt = 0; kt < 4; ++kt)
#pragma unroll
                            for (int r = 0; r < 4; ++r) { const int kl = 16 * kt + 4 * q + r; int dist; bool v;
                                if (MODE == 2) { dist = tq - (16 * (p0 + kl) + 31); v = dist >= 0; }
                                else { dist = tq - (p0 + kl); v = dist >= 0; if (MODE == 0) v = v && dist < 128; if (MODE == 1) v = v && dist < 512; if (MODE == 3) v = v && colsel; }
                                const int di = dist < 0 ? 0 : (dist > 1023 ? 1023 : dist);
                                const float s2 = v ? sc[kt][r] + biasd[hr * 1024 + di] : -1e30f; sc[kt][r] = s2; mx = fmaxf(mx, s2); }
                        }
                        float p[4][4];
                        if (MODE == 2 && pass == 1) {
#pragma unroll
                            for (int kt = 0; kt < 4; ++kt)
#pragma unroll
                                for (int r = 0; r < 4; ++r) p[kt][r] = __expf(sc[kt][r] - mrun[qd]) * linv[qd];
                        } else if (MODE == 2) {
                            const float mn = fmaxf(mrun[qd], mx), corr = __expf(mrun[qd] - mn); mrun[qd] = mn; float ps = 0.f;
                            const float mne = mn < -1e29f ? 0.f : mn;
#pragma unroll
                            for (int kt = 0; kt < 4; ++kt)
#pragma unroll
                                for (int r = 0; r < 4; ++r) ps += __expf(sc[kt][r] - mne);
                            lrun[qd] = lrun[qd] * corr + ps;
                        } else {
                            if (__any(mx > mrun[qd])) {
                                mx = fmaxf(mx, __shfl_xor(mx, 16)); mx = fmaxf(mx, __shfl_xor(mx, 32));
                                const float mn = fmaxf(mrun[qd], mx), corr = __expf(mrun[qd] - mn); mrun[qd] = mn;
                                lrun[qd] *= corr;
#pragma unroll
                                for (int dt = 0; dt < 4; ++dt) O[qd][dt] = O[qd][dt] * corr;
                            }
                            const float mne = mrun[qd] < -1e29f ? 0.f : mrun[qd]; float ps = 0.f;
#pragma unroll
                            for (int kt = 0; kt < 4; ++kt)
#pragma unroll
                                for (int r = 0; r < 4; ++r) { p[kt][r] = (DBG == 2) ? sc[kt][r] - mne : __expf(sc[kt][r] - mne); ps += p[kt][r]; }
                            lrun[qd] += ps;
                        }
                        if (MODE == 2 && pass == 1) {
                            float i3prev = carry3[qd];
#pragma unroll
                            for (int kt = 0; kt < 4; ++kt) { float im[4];
#pragma unroll
                                for (int r = 0; r < 4; ++r) { float v = p[kt][r]; v += dpp_xor1(v); v += dpp_xor2(v); im[r] = v; }
                                const float same = __shfl(im[3], (lane + 48) & 63), prevt = __shfl(i3prev, (lane + 48) & 63);
                                const float pv3 = q > 0 ? same : prevt;
                                const int jg = (p0 + 16 * kt + 4 * q) >> 2;
                                if (hr == 0 && jg < 256) sscore[(tq - t0) * 256 + jg] = 2.0f * (im[0] + im[1] + im[2]) + im[3] + pv3;
                                i3prev = im[3]; }
                            carry3[qd] = i3prev;
                        }
                        if (do_pv && DBG != 1) {
#pragma unroll
                            for (int st = 0; st < 2; ++st) {
                                u32x4 pw; pw.x = pk2(p[2 * st][0], p[2 * st][1]); pw.y = pk2(p[2 * st][2], p[2 * st][3]); pw.z = pk2(p[2 * st + 1][0], p[2 * st + 1][1]); pw.w = pk2(p[2 * st + 1][2], p[2 * st + 1][3]);
                                const bf16x8 pf = __builtin_bit_cast(bf16x8, pw);
#pragma unroll
                                for (int dt = 0; dt < 4; ++dt) { bf16x8 av;
                                    if (MODE != 3) av = avf[st][dt];
                                    else { const LAS unsigned char* vp = L + LV + (16 * dt + n) * 144 + (32 * st + 4 * q) * 2;
                                        const u32x2 v0 = *(const LAS u32x2*)vp, v1 = *(const LAS u32x2*)(vp + 32); u32x4 vw; vw.x = v0.x; vw.y = v0.y; vw.z = v1.x; vw.w = v1.y; av = __builtin_bit_cast(bf16x8, vw); }
                                    O[qd][dt] = __builtin_amdgcn_mfma_f32_16x16x32_bf16(av, pf, O[qd][dt], 0, 0, 0); } }
                        }
                    }
                }
              }
            }
        }
#undef AT_ISSUE
#undef AT_TILEPOS
        if (MODE == 2) {
            __syncthreads();
#pragma unroll 1
            for (int tk = 0; tk < TW; ++tk) { const int t = tw0 + tk, cur = t >> 6; const LAS float* sp = sscore + (wave * TW + tk) * 256;
                unsigned key[4]; bool forced[4];
#pragma unroll
                for (int jj = 0; jj < 4; ++jj) { const int j = lane + 64 * jj; forced[jj] = (j == 0 || j == cur || j == cur - 1);
                    key[jj] = (!forced[jj] && j < cur - 1) ? __float_as_uint(sp[j]) + 1u : 0u; }
                const int nforced = cur >= 2 ? 3 : cur + 1;
                unsigned prefix = 0u; int remaining = 16 - nforced;
#pragma unroll 1
                for (int bit = 30; bit >= 0; --bit) { const unsigned test = prefix | (1u << bit); int cnt = 0;
#pragma unroll
                    for (int jj = 0; jj < 4; ++jj) cnt += __popcll(__ballot((key[jj] >> bit) == (test >> bit)));
                    if (cnt >= remaining) prefix = test; else remaining -= cnt; }
                int eqbase = 0;
#pragma unroll
                for (int jj = 0; jj < 4; ++jj) { const bool eq = key[jj] == prefix && key[jj] != 0u; const unsigned long long eb = __ballot(eq);
                    const int eqrank = eqbase + __popcll(eb & ((1ull << lane) - 1ull)); eqbase += __popcll(eb);
                    const bool on = forced[jj] || key[jj] > prefix || (eq && eqrank < remaining); const unsigned long long bl = __ballot(on);
                    if (lane == 0) { unsigned* mp = selp((unsigned char*)sel, t, g); mp[2 * jj] = (unsigned)bl; mp[2 * jj + 1] = (unsigned)(bl >> 32); } }
            }
        }
#pragma unroll
        for (int qd = 0; qd < NQ; ++qd) {
            const int tq = tw0 + 4 * qd + (n >> 2), hh = g * 4 + hr;
            float scale;
            if (MODE == 2) scale = 1.0f;
            else { float lt = lrun[qd]; lt += __shfl_xor(lt, 16); lt += __shfl_xor(lt, 32);
                if (MODE == 0) { const float sink = inptr(c, I_SINK)[layer * 8 + hh]; const float mf = fmaxf(mrun[qd], sink), cr = __expf(mrun[qd] - mf); scale = cr / (lt * cr + __expf(sink - mf)); }
                else scale = lt > 0.f ? 1.0f / lt : 0.f; }
            if (MODE != 0) scale *= sigmoidf_(bf2f(proj[(size_t)tq * PLD + PC_GL + (MODE == 2 ? 0 : (MODE == 3 ? 8 : 16)) + hh]));
#pragma unroll
            for (int dt = 0; dt < 4; ++dt) { const f32x4 o = O[qd][dt] * scale; const int col = hh * 64 + 16 * dt + 4 * q;
                if (MODE == 0) { u32x2 w; w.x = pk2(o[0], o[1]); w.y = pk2(o[2], o[3]); *(u32x2*)(oout + (size_t)tq * 512 + col) = w; }
                else if (MODE == 2) *(f32x4*)(nsaacc + (size_t)tq * 512 + col) = o;
                else if (MODE == 1) { f32x4* ap = (f32x4*)(nsaacc + (size_t)tq * 512 + col); *ap = *ap + o; }
                else { const f32x4 t2 = *(const f32x4*)(nsaacc + (size_t)tq * 512 + col) + o; u32x2 w; w.x = pk2(t2[0], t2[1]); w.y = pk2(t2[2], t2[3]); *(u32x2*)(oout + (size_t)tq * 512 + col) = w; } }
        }
    }
}
__device__ __forceinline__ void phase_topk2(const Ctx& c, const float* scores, int* sel) {
    const int gw = c.bid * 8 + c.wave, NGW = c.G * 8;
    for (int item = gw; item < T * 2; item += NGW) {
        const int t = item >> 1, g = item & 1, cur = t >> 6;
        const float* sp = scores + ((size_t)g * T + t) * 256;
        float val[4];
#pragma unroll
        for (int jj = 0; jj < 4; ++jj) { const int j = c.lane + 64 * jj; float sc;
            if (j == 0 || j == cur || j == cur - 1) sc = 1e4f; else if (j > cur) sc = -1.0f; else sc = sp[j];
            val[jj] = sc; }
        for (int k = 0; k < 16; ++k) {
            float bv = val[0]; int bi = c.lane;
#pragma unroll
            for (int jj = 1; jj < 4; ++jj) if (val[jj] > bv) { bv = val[jj]; bi = c.lane + 64 * jj; }
#pragma unroll
            for (int o = 32; o >= 1; o >>= 1) { const float ov = __shfl_xor(bv, o); const int oi = __shfl_xor(bi, o); if (ov > bv || (ov == bv && oi < bi)) { bv = ov; bi = oi; } }
#pragma unroll
            for (int jj = 0; jj < 4; ++jj) if (bi == c.lane + 64 * jj) val[jj] = -3e38f;
            if (c.lane == 0) sel[(size_t)item * 16 + k] = bi;
        }
    }
}

#define wb ((bf16_t*)(ws + WS_WB))
#define xb ((bf16_t*)(ws + WS_XB))
#define cntp ((unsigned*)(ws + WS_CNT))
#define xres (args.out)
#define kcb ((bf16_t*)(ws + WS_KCB))
#define vctb ((bf16_t*)(ws + WS_VCT))
#define vtb ((bf16_t*)(ws + WS_VT))
#define scores ((float*)(ws + WS_SCORES))
#define sel ((unsigned*)ws)
#define ml ((float*)(ws + WS_ML))
#define hidb ((bf16_t*)(ws + WS_HID))
#define proj ((bf16_t*)(ws + WS_PROJ))
#define gates ((bf16_t*)(ws + WS_GATES))
#define merged ((bf16_t*)(ws + WS_MERGED))
#define tmpb ((bf16_t*)(ws + WS_TMPB))
#define alora ((bf16_t*)(ws + WS_ALORA))
#define rwu ((bf16_t*)(ws + WS_RWU))
#define rws ((bf16_t*)(ws + WS_RWS))
#define bonusg ((float*)(ws + WS_BONUS))
#define nsaacc ((float*)(ws + WS_NSAACC))
#define obuf ((bf16_t*)(ws + WS_O))
#define act ((bf16_t*)(ws + WS_ACT))
#define tmpf ((bf16_t*)(ws + WS_TMPF))
constexpr int PH_PER_BATCH = 8, PH_PER_LAYER = 1 + 2 * PH_PER_BATCH + 2, PH_TOTAL = 1 + DEPTH * PH_PER_LAYER;

__global__ void __launch_bounds__(512, 2) fwd_kernel(Args args) {
    extern __shared__ __attribute__((aligned(16))) unsigned char lds_raw[];
    Ctx c0; c0.lds = (LAS unsigned char*)lds_raw; c0.tid = threadIdx.x; c0.lane = c0.tid & 63; c0.wave = __builtin_amdgcn_readfirstlane(c0.tid >> 6); c0.G = gridDim.x; c0.bid = blockIdx.x; const Ctx& c = c0;
    unsigned char* ws = args.ws;
    volatile LAS unsigned* misc = (volatile LAS unsigned*)(c.lds + LDS_MISC);
    if (c.tid < 4) misc[c.tid] = 0u;
    if (c.tid < 30) { const unsigned long long pv = (unsigned long long)args.in[c.tid & 31]; misc[16 + 2 * c.tid] = (unsigned)pv; misc[17 + 2 * c.tid] = (unsigned)(pv >> 32); }
    __syncthreads();
    XcdBarrier bar; bar.bar = (unsigned*)(ws + WS_CTL); bar.x = 0; bar.st = misc;
    const int lo = args.lo, hi = args.hi;
    const bool multi = (hi - lo) > 1;
    if (multi) bar = xcd_barrier_post((unsigned*)(ws + WS_CTL), misc);
    int gp = 0;
#ifndef ONLY_PH
#define ONLY_PH -1
#endif
#ifndef PHMASK
#define PHMASK 0xffffff
#endif
#ifndef REPMASK
#define REPMASK 0
#endif
#ifndef PR_SEL
#define PR_SEL 0
#endif
#ifndef PR_SWA
#define PR_SWA 0
#endif
#ifndef PR_CMP
#define PR_CMP 0
#endif
#ifndef PR_CHUNK
#define PR_CHUNK 0
#endif
#define PHASE_BEGIN(id) if (gp >= lo && gp < hi) { for (int rep_ = 0; rep_ < (((REPMASK >> (id)) & 1) ? 2 : 1); ++rep_) { if (rep_) __syncthreads(); \
    Ctx pc = c0; asm volatile("" : "+v"(pc.tid), "+s"(pc.bid)); pc.lane = pc.tid & 63; pc.wave = __builtin_amdgcn_readfirstlane(pc.tid >> 6); const Ctx& c = pc;
#define PHASE_END   } if (gp + 1 < hi) xcd_barrier(bar); } ++gp;
#define RELAUNDER() do { asm volatile("" : "+v"(pc.tid), "+s"(pc.bid)); pc.lane = pc.tid & 63; pc.wave = __builtin_amdgcn_readfirstlane(pc.tid >> 6); } while (0)

    PHASE_BEGIN(0) phase_init(c, inptr(c, I_X), xres, xb, ws); PHASE_END

    for (int layer = 0; layer < DEPTH; ++layer) {
        PHASE_BEGIN(1) phase_cvt(c, args, layer, wb); PHASE_END
        for (int b = 0; b < NBATCH; ++b) {
            const int row0 = b * T;
            PHASE_BEGIN(2) {
                pg8::Gemm g{xb + (size_t)row0 * D, wb + WB_WIN, D, D, D}; pg8::Sched S; S.init(T / 256, NIN / 256, c.G, c.bid, 1, (size_t)256 * D * 2, 0, (size_t)256 * D * 2, 0);
                pg8::EpiInProj E{proj, gates, ws, row0}; pg8::gemm_phase(c.lds, c.tid, g, S, E); } PHASE_END
            PHASE_BEGIN(16) {
                { pg8::Gemm g{proj, wb + WB_W1T, 16 * PLD, 2048, 2048, (unsigned)PLD * 2}; pg8::Sched S; S.init(16, 1, c.G, c.bid, 1, 0, 0, 0, 0); S.mode = 1;
                  pg8::EpiCmp1 E{hidb, (const float*)(wb + WB_BH)}; pg8::gemm_phase(c.lds, c.tid, g, S, E); }
                RELAUNDER();
                if (c.bid >= 16) { Ctx cv = c; cv.bid = c.bid - 16; cv.G = c.G - 16; phase_lora_a(cv, args, layer, proj, alora); vt_transpose(cv, proj, vtb); } } PHASE_END
            PHASE_BEGIN(17) {
                { pg8::Gemm g{alora, wb + WB_LORA, 256, 256, 256}; pg8::Sched S; S.init(T / 256, 6, c.G, c.bid, 1, (unsigned)256 * 256 * 2, 0, (unsigned)256 * 256 * 2, 0);
                  pg8::EpiLora E{obuf}; pg8::gemm_phase(c.lds, c.tid, g, S, E); }
                RELAUNDER();
                { pg8::Gemm g{hidb, wb + WB_W2T, 256, 256, 256}; pg8::Sched S; S.init(16, 1, c.G, (c.bid + 16) % c.G, 1, (unsigned)256 * 256 * 2, 0, 0, 0); S.mode = 2;
                  pg8::EpiCmp2 E{kcb, vctb}; pg8::gemm_phase(c.lds, c.tid, g, S, E); } } PHASE_END
            PHASE_BEGIN(18) {
                for (int pr_ = 0; pr_ <= PR_CHUNK; ++pr_) { phase_rwkv_chunk(c, args, layer, proj, obuf + (size_t)T * 512, obuf + (size_t)2 * T * 512, rwu, bonusg);
                __syncthreads(); RELAUNDER(); }
                for (int pr_ = 0; pr_ <= PR_CMP; ++pr_) { phase_attn<2, 2>(c, args, layer, proj, vtb, kcb, vctb, sel, nsaacc, obuf + (size_t)T * 512); __syncthreads(); } } PHASE_END
            PHASE_BEGIN(19) {
                phase_rwkv_scan<0>(c, rwu, rws);
                RELAUNDER();
                if (c.bid >= 32) { Ctx cv = c; cv.bid = c.bid - 32; cv.G = c.G - 32;
                    phase_attn<1, 2>(cv, args, layer, proj, vtb, kcb, vctb, sel, nsaacc, obuf + (size_t)T * 512);
                    asm volatile("" : "+v"(cv.tid), "+s"(cv.bid)); cv.lane = cv.tid & 63; cv.wave = __builtin_amdgcn_readfirstlane(cv.tid >> 6);
                    for (int pr_ = 0; pr_ <= PR_SWA; ++pr_) { phase_attn<0, 2>(cv, args, layer, proj, vtb, kcb, vctb, sel, nsaacc, obuf + (size_t)2 * T * 512); __syncthreads(); } } } PHASE_END
            PHASE_BEGIN(9) {
                phase_rwkv_out(c, args, layer, proj, rwu, rws, bonusg, obuf);
                __syncthreads(); RELAUNDER();
                #if PR_SEL > 1
                { phase_attn<3, 2, PR_SEL - 1>(c, args, layer, proj, vtb, kcb, vctb, sel, nsaacc, obuf + (size_t)T * 512); __syncthreads(); }
#endif
                for (int pr_ = 0; pr_ <= (PR_SEL == 1 ? 1 : 0); ++pr_) { phase_attn<3, 2>(c, args, layer, proj, vtb, kcb, vctb, sel, nsaacc, obuf + (size_t)T * 512); __syncthreads(); } } PHASE_END
            PHASE_BEGIN(10) {
                pg8::Gemm g{obuf, wb + WB_WBR, 512, 512, 512}; pg8::Sched S; S.init(T / 256, D / 256, c.G, c.bid, 3, (size_t)256 * 512 * 2, (size_t)T * 512 * 2, (size_t)256 * 512 * 2, (size_t)D * 512 * 2);
                pg8::EpiMerge E{gates, merged}; pg8::gemm_phase(c.lds, c.tid, g, S, E); } PHASE_END
            PHASE_BEGIN(11) {
                pg8::Gemm g{merged, wb + WB_WOUT, D, D, D}; pg8::Sched S; S.init(T / 256, D / 256, c.G, c.bid, 1, (unsigned)256 * D * 2, 0, (unsigned)256 * D * 2, 0);
                pg8::EpiNorm E{xres, xb, inptr(c, I_NQM) + layer * D, ws, cntp, row0, 1, 16u * (2u * layer + 1u), c.lds, c.tid}; pg8::gemm_phase(c.lds, c.tid, g, S, E); } PHASE_END
        }
        PHASE_BEGIN(13) {
            pg8::Gemm g{xb, wb + WB_WGU, D, D, D}; pg8::Sched S; S.init(MROWS / 256, 2 * FFN / 256, c.G, c.bid, 1, (size_t)256 * D * 2, 0, (size_t)256 * D * 2, 0);
            pg8::EpiSwiGLU E{act, ws}; pg8::gemm_phase(c.lds, c.tid, g, S, E); } PHASE_END
        PHASE_BEGIN(14) {
            { pg8::Gemm g{act, wb + WB_WDN, FFN, FFN, FFN}; pg8::Sched S; S.init(T / 256, D / 256, c.G, c.bid, 1, (unsigned)256 * FFN * 2, 0, (unsigned)256 * FFN * 2, 0);
              pg8::EpiNorm E{xres, xb, inptr(c, I_NQF) + layer * D, ws, cntp, 0, 0, 16u * (2u * layer + 2u), c.lds, c.tid}; pg8::gemm_phase(c.lds, c.tid, g, S, E); }
            __syncthreads(); RELAUNDER();
            { pg8::Gemm g{act + (size_t)T * FFN, wb + WB_WDN, FFN, FFN, FFN}; pg8::Sched S; S.init(T / 256, D / 256, c.G, c.bid, 1, (unsigned)256 * FFN * 2, 0, (unsigned)256 * FFN * 2, 0);
              pg8::EpiNorm E{xres, xb, inptr(c, I_NQF) + layer * D, ws, cntp, T, 0, 16u * (2u * layer + 2u), c.lds, c.tid}; pg8::gemm_phase(c.lds, c.tid, g, S, E); } } PHASE_END
    }
#undef PHASE_BEGIN
#undef PHASE_END
}

extern "C" void kernel_launch(void* const* d_in, const int* in_sizes, int n_in, void* d_out, int out_size, void* d_ws, size_t ws_size, hipStream_t stream) {
    static int grid = 0;
    if (grid == 0) {
        if (n_in != 30 || out_size != MROWS * D || ws_size < WS_END) { fprintf(stderr, "kernel_launch: unexpected shapes (n_in %d out %d ws %zu)\n", n_in, out_size, ws_size); grid = -1; return; }
        int dev = 0, cus = 0;
        if (hipGetDevice(&dev) != hipSuccess || hipDeviceGetAttribute(&cus, hipDeviceAttributeMultiprocessorCount, dev) != hipSuccess) { grid = -1; return; }
        if (hipFuncSetAttribute((const void*)fwd_kernel, hipFuncAttributeMaxDynamicSharedMemorySize, LDS_BYTES) != hipSuccess) { fprintf(stderr, "hipFuncSetAttribute failed\n"); grid = -1; return; }
        int per_cu = 0;
        if (hipOccupancyMaxActiveBlocksPerMultiprocessor(&per_cu, (const void*)fwd_kernel, 512, LDS_BYTES) != hipSuccess || per_cu < 1) { fprintf(stderr, "occupancy query: %d\n", per_cu); }
        (void)hipGetLastError();
        grid = cus;
    }
    if (grid < 0) return;
    (void)hipMemsetAsync((char*)d_ws + WS_CTL, 0, CTL_BYTES, stream);
    Args a{};
    for (int i = 0; i < 30; ++i) a.in[i] = (const float*)d_in[i];
    a.out = (float*)d_out; a.ws = (unsigned char*)d_ws;
#if MK_ONE_LAUNCH
    a.lo = 0; a.hi = PH_TOTAL;
    hipLaunchKernelGGL(fwd_kernel, dim3(grid), dim3(512), LDS_BYTES, stream, a);
#else
    for (int p = 0; p < PH_TOTAL; ++p) { a.lo = p; a.hi = p + 1; hipLaunchKernelGGL(fwd_kernel, dim3(grid), dim3(512), LDS_BYTES, stream, a); }
#endif
}
```

```cpp
#include <hip/hip_runtime.h>
#include <stdint.h>
#include <stdio.h>

#ifndef MK_ONE_LAUNCH
#define MK_ONE_LAUNCH 1
#endif

#define LAS __attribute__((address_space(3)))
typedef unsigned short bf16_t;
typedef short bf16x8 __attribute__((ext_vector_type(8)));
typedef float f32x4 __attribute__((ext_vector_type(4)));
typedef float f32x2 __attribute__((ext_vector_type(2)));
typedef unsigned u32x4 __attribute__((ext_vector_type(4)));
typedef unsigned u32x2 __attribute__((ext_vector_type(2)));

constexpr int D = 1024, NBATCH = 2, T = 16384, DEPTH = 4, MROWS = NBATCH * T;
constexpr int IN_COLS = 6936, FFN = 2816;
constexpr int PLD = 4096;
constexpr int PC_R = 0, PC_K = 512, PC_V = 1024, PC_ZW = 1536, PC_ZA = 1600, PC_ZG = 1664;
constexpr int PC_NQ = 1792, PC_KC = 2304, PC_VC = 2432, PC_KS = 2560, PC_VS = 2688, PC_KW = 2816, PC_VW = 2944, PC_GL = 3072;
constexpr int PC_SQ = 3328, PC_SK = 3840, PC_SV = 3968;
constexpr int NIN = 7168;
constexpr int NCMP = 1023;
constexpr float NORM_EPS = 1e-6f;

constexpr size_t MiB = 1u << 20;
constexpr size_t WS_CTL = 0, CTL_BYTES = 65536;
constexpr size_t WS_WB = 65536;
constexpr size_t WB_WIN = 0, WB_WBR = WB_WIN + (size_t)NIN * D, WB_WOUT = WB_WBR + (size_t)3 * D * 512, WB_WGU = WB_WOUT + (size_t)D * D,
                 WB_WDN = WB_WGU + (size_t)2 * FFN * D, WB_LORA = WB_WDN + (size_t)D * FFN, WB_W1T = WB_LORA + (size_t)1536 * 256, WB_W2T = WB_W1T + (size_t)2 * 256 * 2048,
                 WB_BH = WB_W2T + (size_t)2 * 256 * 256, WB_END = WB_BH + 1024;
static_assert(WS_WB + WB_END * 2 <= 38 * MiB + 786432, "weights");
constexpr size_t KiB = 1024;
constexpr size_t WS_XB = 38 * MiB + 768 * KiB;
constexpr size_t WS_CNT = 16384;
constexpr size_t WS_RS = WS_XB + 64 * MiB;
constexpr size_t WS_BONUS = WS_RS + 128 * KiB;
constexpr size_t WS_KCB = WS_BONUS + 512 * KiB;
constexpr size_t WS_VCT = WS_KCB + 256 * KiB;
constexpr size_t WS_STATS = WS_VCT + 256 * KiB;
constexpr size_t WS_SEL = WS_STATS;
constexpr size_t WS_HID = WS_SEL + 1 * MiB;
constexpr size_t WS_ML = WS_HID;
static_assert(WS_HID + 2 * MiB <= 107 * MiB, "small region");
constexpr size_t WS_ALORA = 107 * MiB;
constexpr size_t WS_VT = 115 * MiB;
constexpr size_t WS_BIG = 127 * MiB;
constexpr size_t WS_PROJ = WS_BIG;
constexpr size_t WS_GATES = WS_PROJ + 128 * MiB;
constexpr size_t WS_RWKVS = WS_GATES + 96 * MiB;
constexpr size_t WS_RWU = WS_RWKVS;
constexpr size_t WS_RWS = WS_RWKVS + 64 * MiB;
constexpr size_t WS_SCORES = WS_RWKVS;
constexpr size_t WS_MERGED = WS_RWKVS;
constexpr size_t WS_TMPB = WS_RWKVS + 32 * MiB;
constexpr size_t WS_NSAACC = WS_RWKVS + 80 * MiB;
constexpr size_t WS_O = WS_NSAACC + 32 * MiB;
constexpr size_t WS_END = WS_O + 48 * MiB;
constexpr size_t WS_ACT = WS_BIG;
constexpr size_t WS_TMPF = WS_BIG + 176 * MiB;
static_assert(WS_END <= 512 * MiB, "workspace");
static_assert(WS_TMPF + 64 * MiB <= WS_NSAACC, "ffn overlay");

constexpr int LDS_BYTES = 147456;
constexpr int LDS_MISC = 131072 + 8192;

__device__ __forceinline__ float* statp(unsigned char* ws, int row, int kind) {
    return (float*)(ws + WS_STATS + (kind >= 2 ? 524288 : 0)) + (size_t)row * 4; }
__device__ __forceinline__ unsigned* selp(unsigned char* ws, int t, int g) { return (unsigned*)(ws + WS_PROJ + (size_t)t * (PLD * 2) + 6272 + g * 32); }
__device__ __forceinline__ float bf2f(unsigned v) { return __uint_as_float(v << 16); }
typedef __bf16 bf16n2 __attribute__((ext_vector_type(2)));
__device__ __forceinline__ unsigned pk2(float lo, float hi) { const f32x2 f = {lo, hi}; const bf16n2 v = __builtin_convertvector(f, bf16n2); return __builtin_bit_cast(unsigned, v); }
__device__ __forceinline__ unsigned f2bf(float f) { return pk2(f, 0.f) & 0xffffu; }
__device__ __forceinline__ void unpack8(const u32x4 w, float (&f)[8]) {
    f[0] = __uint_as_float(w.x << 16); f[1] = __uint_as_float(w.x & 0xffff0000u); f[2] = __uint_as_float(w.y << 16); f[3] = __uint_as_float(w.y & 0xffff0000u);
    f[4] = __uint_as_float(w.z << 16); f[5] = __uint_as_float(w.z & 0xffff0000u); f[6] = __uint_as_float(w.w << 16); f[7] = __uint_as_float(w.w & 0xffff0000u);
}
#define DPPF(v, ctrl) __int_as_float(__builtin_amdgcn_update_dpp(0, __float_as_int(v), (ctrl), 0xf, 0xf, false))
__device__ __forceinline__ float row16_sum(float v) {
    v += DPPF(v, 0xB1); v += DPPF(v, 0x4E); v += DPPF(v, 0x141); v += DPPF(v, 0x140); return v;
}
__device__ __forceinline__ float wave_sum(float v) {
    v = row16_sum(v);
    const int iv = __float_as_int(v);
    return (__int_as_float(__builtin_amdgcn_readlane(iv, 0)) + __int_as_float(__builtin_amdgcn_readlane(iv, 16))) + (__int_as_float(__builtin_amdgcn_readlane(iv, 32)) + __int_as_float(__builtin_amdgcn_readlane(iv, 48)));
}
__device__ __forceinline__ float dpp_xor1(float v) { return __int_as_float(__builtin_amdgcn_update_dpp(0, __float_as_int(v), 0xB1, 0xf, 0xf, false)); }
__device__ __forceinline__ float dpp_xor2(float v) { return __int_as_float(__builtin_amdgcn_update_dpp(0, __float_as_int(v), 0x4E, 0xf, 0xf, false)); }
__device__ __forceinline__ float sigmoidf_(float x) { return __builtin_amdgcn_rcpf(1.0f + __expf(-x)); }
__device__ __forceinline__ int t5_bucket(int n) {
    if (n < 16) return n;
    int b = 16;
    b += (n >= 21); b += (n >= 27); b += (n >= 35); b += (n >= 46); b += (n >= 59); b += (n >= 77); b += (n >= 99); b += (n >= 128);
    b += (n >= 166); b += (n >= 216); b += (n >= 280); b += (n >= 363); b += (n >= 470); b += (n >= 609); b += (n >= 790);
    return b;
}

#define XB_TMO      128
#define XB_XCNT(j)  (256  + 64 * (j))
#define XB_XSUB(j)  (1280 + 64 * (j))
#define XB_XGEN(j)  (2304 + 64 * (j))
#define XB_TOP      3328
#define XB_TOPGEN   3392
#define XCD_BAR_WORDS 3456
#define XB_SPIN_CAP (1u << 22)
__device__ __forceinline__ unsigned xb_ld(unsigned* p)              { return __hip_atomic_load(p, __ATOMIC_RELAXED, __HIP_MEMORY_SCOPE_AGENT); }
__device__ __forceinline__ unsigned xb_add(unsigned* p, unsigned v) { return __hip_atomic_fetch_add(p, v, __ATOMIC_RELAXED, __HIP_MEMORY_SCOPE_AGENT); }
__device__ __forceinline__ unsigned xb_xcc_id() { return (unsigned)__builtin_amdgcn_s_getreg((3 << 11) | 20) & 0xFu; }
#define XB_SPIN(cond, bar) do { unsigned _sp = 0; while (cond) { __builtin_amdgcn_s_sleep(1); \
    if ((++_sp & 255u) == 0u) { if (xb_ld(&(bar)[XB_TMO])) break; if (_sp > XB_SPIN_CAP) { atomicAdd(&(bar)[XB_TMO], 1u); break; } } } } while (0)
struct XcdBarrier { unsigned* bar; unsigned x; volatile LAS unsigned* st; };
__device__ __forceinline__ XcdBarrier xcd_barrier_post(unsigned* bar, volatile LAS unsigned* st) {
    XcdBarrier b; b.bar = bar; b.x = xb_xcc_id(); b.st = st;
    if (threadIdx.x == 0) (void)xb_add(&bar[XB_XCNT(b.x)], 1u);
    return b;
}
__device__ __forceinline__ void xcd_barrier_complete(unsigned* bar, unsigned x, unsigned& nloc, unsigned& nx) {
    const unsigned G = gridDim.x * gridDim.y * gridDim.z;
    unsigned sum, cnt, mine, sp = 0u;
    for (;;) {
        sum = 0u; cnt = 0u; mine = 0u;
#pragma unroll
        for (unsigned j = 0; j < 16; ++j) { const unsigned c = xb_ld(&bar[XB_XCNT(j)]); sum += c; cnt += (c > 0u) ? 1u : 0u; mine = (j == x) ? c : mine; }
        if (sum == G) break;
        __builtin_amdgcn_s_sleep(1);
        if ((++sp & 255u) == 0u) { if (xb_ld(&bar[XB_TMO])) break; if (sp > XB_SPIN_CAP) { atomicAdd(&bar[XB_TMO], 1u); break; } }
    }
    nloc = mine > 0u ? mine : 1u; nx = cnt > 0u ? cnt : 1u;
}
__device__ __forceinline__ void xcd_barrier(const XcdBarrier& b) {
    asm volatile("s_waitcnt vmcnt(0)" ::: "memory");
    __syncthreads();
    if (threadIdx.x == 0) {
        unsigned* bar = b.bar;
        __builtin_amdgcn_s_waitcnt(0);
        unsigned nloc = b.st[0], nx = b.st[1];
        if (nloc == 0u) { xcd_barrier_complete(bar, b.x, nloc, nx); b.st[0] = nloc; b.st[1] = nx; }
        const unsigned old = xb_add(&bar[XB_XSUB(b.x)], 1u);
        const unsigned gen = old / nloc;
        if (old + 1u == (gen + 1u) * nloc) {
            __builtin_amdgcn_fence(__ATOMIC_RELEASE, "agent");
            asm volatile("s_waitcnt vmcnt(0)" ::: "memory");
            const unsigned og = xb_add(&bar[XB_TOP], 1u);
            const unsigned tg = og / nx;
            if (og + 1u == (tg + 1u) * nx) xb_add(&bar[XB_TOPGEN], 1u);
            else XB_SPIN(xb_ld(&bar[XB_TOPGEN]) == tg, bar);
            __builtin_amdgcn_fence(__ATOMIC_ACQUIRE, "agent");
            xb_add(&bar[XB_XGEN(b.x)], 1u);
            asm volatile("s_waitcnt vmcnt(0)" ::: "memory");
        } else {
            XB_SPIN(xb_ld(&bar[XB_XGEN(b.x)]) == gen, bar);
            __builtin_amdgcn_fence(__ATOMIC_ACQUIRE, "agent");
            asm volatile("s_waitcnt vmcnt(0)" ::: "memory");
        }
    }
    __syncthreads();
}

namespace pg8 {
constexpr int BM = 256, BK = 64, HALF = 128, HTB = HALF * BK * 2, STAGE_BYTES = 8 * HTB, NXCD = 8, WGM = 8;
__device__ __forceinline__ int lds_byte(int r, int c) { const int st = (r >> 4) * 2 + (c >> 5), rr = r & 15, cc = c & 31, ob = rr * 64 + cc * 2; return st * 1024 + (ob ^ (((ob >> 9) & 1) << 5)); }
__device__ __forceinline__ void stage_rc(int b, int& R, int& C) { const int st = b / 1024, sb = b % 1024, swz = sb ^ (((sb >> 9) & 1) << 5); R = (st >> 1) * 16 + swz / 64; C = (st & 1) * 32 + (swz % 64) / 2; }
__device__ __forceinline__ int perm32(int rho) { const int n = rho >> 4, i = rho & 15; return 8 * (i >> 2) + 4 * n + (i & 3); }

template <class E, class = void> struct epi_after_drain { static constexpr bool value = false; };
template <class E> struct epi_after_drain<E, decltype((void)E::AFTER_DRAIN)> { static constexpr bool value = E::AFTER_DRAIN; };
struct Unit { int pm, pn, sub; unsigned aoff, boff; };
struct Gemm { const bf16_t* A; const bf16_t* Bt; int lda, ldb, K; unsigned kstepA = 128; };
struct Sched {
    int nM, nN, nwg, G, c, nsub, mode = 0; unsigned a_row, a_sub, b_row, b_sub;
    __device__ __forceinline__ void init(int nM_, int nN_, int G_, int c_, int nsub_, unsigned a_row_, unsigned a_sub_, unsigned b_row_, unsigned b_sub_) {
        nM = nM_; nN = nN_; nwg = nM * nN; G = G_; c = c_; nsub = nsub_; a_row = a_row_; a_sub = a_sub_; b_row = b_row_; b_sub = b_sub_; }
    __device__ __forceinline__ bool next(int i, Unit& u) const {
        const int round = i / nsub; u.sub = i - round * nsub;
        const long L = (long)round * G + c; if (L >= nwg) return false;
        int wgid = (int)L; { const int q = nwg / NXCD, r = nwg % NXCD, xcd = wgid % NXCD, off = wgid / NXCD; wgid = (xcd < r ? xcd * (q + 1) : r * (q + 1) + (xcd - r) * q) + off; }
        const int nig = WGM * nN, gid = wgid / nig, fm = gid * WGM, gsz = (nM - fm) < WGM ? (nM - fm) : WGM;
        u.pm = fm + ((wgid % nig) % gsz); u.pn = (wgid % nig) / gsz;
        u.aoff = (unsigned)u.pm * a_row + (unsigned)u.sub * a_sub; u.boff = (unsigned)u.pn * b_row + (unsigned)u.sub * b_sub;
        if (mode == 1) { const int kv = u.pm >> 3, g = (u.pm >> 2) & 1, cp = u.pm & 3;
            u.aoff = (unsigned)(((size_t)cp * 256 * 16 * PLD + (kv ? PC_VC : PC_KC) + g * 64) * 2); u.boff = (unsigned)kv * (256u * 2048u * 2u); }
        if (mode == 2) { const int kv = u.pm >> 3; u.boff = (unsigned)kv * (256u * 256u * 2u); }
        return true;
    }
};

template <class Epi>
__device__ __forceinline__ void gemm_phase(LAS unsigned char* lds, const int tid, const Gemm g, const Sched& S, const Epi& E) {
    const int wid = __builtin_amdgcn_readfirstlane(tid >> 6), lane = tid & 63, wr = wid >> 2, wc = wid & 3, fr = lane & 15, fq = lane >> 4;
    const int K = g.K, nt = K / BK;
    unsigned voffA[2], voffB[2];
#pragma unroll
    for (int i = 0; i < 2; ++i) { int R, C; stage_rc(tid * 16 + i * 8192, R, C); const int Rb = Epi::PERM ? ((R & ~31) + perm32(R & 31)) : R;
        voffA[i] = (unsigned)(R * g.lda + C) * 2u; voffB[i] = (unsigned)(Rb * g.ldb + C) * 2u; }
    const size_t kstep = (size_t)(BK * 2), kstA = g.kstepA;
    const size_t hstepA = (size_t)HALF * g.lda * 2, hstepB = (size_t)HALF * g.ldb * 2;
    const unsigned ldsw = (unsigned)wid * 1024u;
    const int aoff = lds_byte(wr * 64 + fr, fq * 8), boff = lds_byte(wc * 32 + fr, fq * 8);
#define PG8_SA(b, h) (((b) * 2 + (h)) * HTB)
#define PG8_SB(b, h) ((4 + (b) * 2 + (h)) * HTB)
#define PG8_STAGE(bufoff, gbase, voff) do { _Pragma("unroll") for (int _i = 0; _i < 2; ++_i) \
        __builtin_amdgcn_global_load_lds((const unsigned*)((const char*)(gbase) + (voff)[_i]), (LAS unsigned*)(lds + (bufoff) + ldsw + _i * 8192), 16, 0, 0); } while (0)
#define PG8_LDA(dst, b, h) do { _Pragma("unroll") for (int m = 0; m < 4; ++m) _Pragma("unroll") for (int k = 0; k < 2; ++k) dst[m][k] = *(const LAS bf16x8*)(lds + PG8_SA(b, h) + aoff + m * 2048 + k * 1024); } while (0)
#define PG8_LDB(dst, b, h) do { _Pragma("unroll") for (int n = 0; n < 2; ++n) _Pragma("unroll") for (int k = 0; k < 2; ++k) dst[n][k] = *(const LAS bf16x8*)(lds + PG8_SB(b, h) + boff + n * 2048 + k * 1024); } while (0)
#define PG8_MMA(ai, bj, At, Bt) do { __builtin_amdgcn_s_setprio(1); _Pragma("unroll") for (int m = 0; m < 4; ++m) _Pragma("unroll") for (int n = 0; n < 2; ++n) _Pragma("unroll") for (int k = 0; k < 2; ++k) \
        acc[ai][bj][m][n] = __builtin_amdgcn_mfma_f32_16x16x32_bf16(Bt[n][k], At[m][k], acc[ai][bj][m][n], 0, 0, 0); __builtin_amdgcn_s_setprio(0); } while (0)
#define PG8_WAIT_V(n) asm volatile("s_waitcnt vmcnt(" #n ")" ::: "memory")
#define PG8_WAIT_L(n) asm volatile("s_waitcnt lgkmcnt(" #n ")" ::: "memory")
#define PG8_BAR __builtin_amdgcn_s_barrier()
#define PG8_SCHED __builtin_amdgcn_sched_barrier(0)
    Unit cur, nxt; int ui = 0;
    if (!S.next(0, cur)) return;
    f32x4 acc[2][2][4][2];
#pragma unroll
    for (int a = 0; a < 2; ++a)
#pragma unroll
        for (int b = 0; b < 2; ++b)
#pragma unroll
            for (int m = 0; m < 4; ++m)
#pragma unroll
                for (int n = 0; n < 2; ++n) acc[a][b][m][n] = (f32x4){0.f, 0.f, 0.f, 0.f};
    bf16x8 At[4][2], B0[2][2], B1[2][2];
    const char* cA = (const char*)g.A + cur.aoff; const char* cB = (const char*)g.Bt + cur.boff;
    PG8_STAGE(PG8_SB(0, 0), cB, voffB); PG8_STAGE(PG8_SA(0, 0), cA, voffA); PG8_STAGE(PG8_SB(0, 1), cB + hstepB, voffB); PG8_STAGE(PG8_SA(0, 1), cA + hstepA, voffA);
    if (wr == 1) PG8_BAR;
    PG8_WAIT_V(4); PG8_BAR;
    PG8_STAGE(PG8_SB(1, 0), cB + kstep, voffB); PG8_STAGE(PG8_SA(1, 0), cA + kstA, voffA); PG8_STAGE(PG8_SB(1, 1), cB + hstepB + kstep, voffB);
    PG8_WAIT_V(6); PG8_BAR;
    for (;;) {
        const bool has_next = S.next(ui + 1, nxt);
        const char* nA = has_next ? (const char*)g.A + nxt.aoff : cA; const char* nB = has_next ? (const char*)g.Bt + nxt.boff : cB;
        for (int t = 0; t < nt; t += 2) {
            const bool last = (t == nt - 2);
            const char* a1 = cA + (size_t)(t + 1) * kstA;
            const char* a2 = last ? nA : cA + (size_t)(t + 2) * kstA; const char* b2 = last ? nB : cB + (size_t)(t + 2) * kstep;
            const char* a3 = a2 + kstA; const char* b3 = b2 + kstep;
            PG8_LDB(B0, 0, 0); PG8_SCHED; PG8_LDA(At, 0, 0); PG8_STAGE(PG8_SA(1, 1), a1 + hstepA, voffA);
            PG8_WAIT_L(8); PG8_BAR; PG8_WAIT_L(0); PG8_MMA(0, 0, At, B0); PG8_BAR; PG8_SCHED;
            PG8_LDB(B1, 0, 1); PG8_STAGE(PG8_SB(0, 0), b2, voffB);
            PG8_BAR; PG8_WAIT_L(0); PG8_MMA(0, 1, At, B1); PG8_BAR;
            PG8_LDA(At, 0, 1); PG8_STAGE(PG8_SA(0, 0), a2, voffA);
            PG8_BAR; PG8_WAIT_L(0); PG8_MMA(1, 0, At, B0); PG8_BAR; PG8_SCHED;
            PG8_STAGE(PG8_SB(0, 1), b2 + hstepB, voffB);
            PG8_WAIT_V(6); PG8_BAR; PG8_MMA(1, 1, At, B1); PG8_BAR;
            PG8_LDB(B0, 1, 0); PG8_SCHED; PG8_LDA(At, 1, 0); PG8_STAGE(PG8_SA(0, 1), a2 + hstepA, voffA);
            PG8_WAIT_L(8); PG8_BAR; PG8_WAIT_L(0); PG8_MMA(0, 0, At, B0); PG8_BAR; PG8_SCHED;
            PG8_LDB(B1, 1, 1); PG8_STAGE(PG8_SB(1, 0), b3, voffB);
            PG8_BAR; PG8_WAIT_L(0); PG8_MMA(0, 1, At, B1); PG8_BAR;
            PG8_LDA(At, 1, 1); PG8_STAGE(PG8_SA(1, 0), a3, voffA);
            PG8_BAR; PG8_WAIT_L(0); PG8_MMA(1, 0, At, B0); PG8_BAR; PG8_SCHED;
            PG8_STAGE(PG8_SB(1, 1), b3 + hstepB, voffB);
            PG8_WAIT_V(6); PG8_BAR; PG8_MMA(1, 1, At, B1); PG8_BAR;
        }
        bool keep = false;
        if constexpr (!epi_after_drain<Epi>::value) keep = E(acc, cur, wr, wc, fr, fq);
        if (!has_next) break;
        if (!keep) {
#pragma unroll
            for (int a = 0; a < 2; ++a)
#pragma unroll
                for (int b = 0; b < 2; ++b)
#pragma unroll
                    for (int m = 0; m < 4; ++m)
#pragma unroll
                        for (int n = 0; n < 2; ++n) acc[a][b][m][n] = (f32x4){0.f, 0.f, 0.f, 0.f};
        }
        cur = nxt; cA = nA; cB = nB; ++ui;
    }
    PG8_WAIT_V(0);
    if (wr == 0) PG8_BAR;
    PG8_BAR;
    if constexpr (epi_after_drain<Epi>::value) (void)E(acc, cur, wr, wc, fr, fq);
#undef PG8_SA
#undef PG8_SB
#undef PG8_STAGE
#undef PG8_LDA
#undef PG8_LDB
#undef PG8_MMA
#undef PG8_WAIT_V
#undef PG8_WAIT_L
#undef PG8_BAR
#undef PG8_SCHED
}

struct EpiInProj {
    static constexpr bool PERM = true;
    bf16_t* proj; bf16_t* gates; unsigned char* ws; int row_base;
    __device__ __forceinline__ bool operator()(f32x4 (&acc)[2][2][4][2], const Unit& u, int wr, int wc, int fr, int fq) const {
        const int row0 = u.pm * BM + wr * 64 + fr; const bool is_gate = u.pn >= 16;
        bf16_t* base = is_gate ? gates + (u.pn - 16) * 256 : proj + u.pn * 256; const int ld = is_gate ? 3072 : PLD;
        const int col0 = wc * 32 + 8 * fq;
        float sv[2][4];
        { f32x4 pq[2][4];
#pragma unroll
          for (int ai = 0; ai < 2; ++ai)
#pragma unroll
            for (int m = 0; m < 4; ++m) pq[ai][m] = *(const f32x4*)statp(ws, row_base + row0 + ai * HALF + m * 16, 0);
#pragma unroll
          for (int ai = 0; ai < 2; ++ai)
#pragma unroll
            for (int m = 0; m < 4; ++m) sv[ai][m] = rsqrtf(((pq[ai][m][0] + pq[ai][m][1]) + (pq[ai][m][2] + pq[ai][m][3])) * (1.0f / D) + NORM_EPS); }
#pragma unroll
        for (int ai = 0; ai < 2; ++ai)
#pragma unroll
            for (int m = 0; m < 4; ++m) { const int row = row0 + ai * HALF + m * 16;
                const float s = sv[ai][m]; bf16_t* rowp = base + (size_t)row * ld + col0;
#pragma unroll
                for (int bj = 0; bj < 2; ++bj) { f32x4 v0 = acc[ai][bj][m][0] * s, v1 = acc[ai][bj][m][1] * s;
                    if (is_gate) {
#pragma unroll
                        for (int j = 0; j < 4; ++j) { v0[j] = sigmoidf_(v0[j]); v1[j] = sigmoidf_(v1[j]); } }
                    u32x4 w; w.x = pk2(v0[0], v0[1]); w.y = pk2(v0[2], v0[3]); w.z = pk2(v1[0], v1[1]); w.w = pk2(v1[2], v1[3]);
                    if (u.pn != 12 || col0 + bj * HALF < 64) *(u32x4*)(rowp + bj * HALF) = w; } }
        return false;
    }
};
struct EpiStore {
    static constexpr bool PERM = true;
    bf16_t* out; int ld;
    __device__ __forceinline__ bool operator()(f32x4 (&acc)[2][2][4][2], const Unit& u, int wr, int wc, int fr, int fq) const {
        const int row0 = u.pm * BM + wr * 64 + fr; const int col0 = u.pn * BM + wc * 32 + 8 * fq;
#pragma unroll
        for (int ai = 0; ai < 2; ++ai)
#pragma unroll
            for (int m = 0; m < 4; ++m) { bf16_t* rowp = out + (size_t)(row0 + ai * HALF + m * 16) * ld + col0;
#pragma unroll
                for (int bj = 0; bj < 2; ++bj) { const f32x4 v0 = acc[ai][bj][m][0], v1 = acc[ai][bj][m][1];
                    u32x4 w; w.x = pk2(v0[0], v0[1]); w.y = pk2(v0[2], v0[3]); w.z = pk2(v1[0], v1[1]); w.w = pk2(v1[2], v1[3]);
                    *(u32x4*)(rowp + bj * HALF) = w; } }
        return false;
    }
};
struct EpiCmp1 {
    static constexpr bool PERM = true;
    bf16_t* hid; const float* bh;
    __device__ __forceinline__ bool operator()(f32x4 (&acc)[2][2][4][2], const Unit& u, int wr, int wc, int fr, int fq) const {
        const int kv = u.pm >> 3; const int row0 = (u.pm & 7) * BM + wr * 64 + fr; const int col0 = wc * 32 + 8 * fq;
#pragma unroll
        for (int ai = 0; ai < 2; ++ai)
#pragma unroll
            for (int m = 0; m < 4; ++m) { bf16_t* rowp = hid + ((size_t)kv * 2048 + row0 + ai * HALF + m * 16) * 256 + col0;
#pragma unroll
                for (int bj = 0; bj < 2; ++bj) { float o[8];
#pragma unroll
                    for (int j = 0; j < 8; ++j) { const float x = acc[ai][bj][m][j >> 2][j & 3] + bh[kv * 256 + col0 + bj * HALF + j];
                        o[j] = x * sigmoidf_(1.5957691216f * (x + 0.044715f * x * x * x)); }
                    u32x4 w; w.x = pk2(o[0], o[1]); w.y = pk2(o[2], o[3]); w.z = pk2(o[4], o[5]); w.w = pk2(o[6], o[7]);
                    *(u32x4*)(rowp + bj * HALF) = w; } }
        return false;
    }
};
struct EpiCmp2 {
    static constexpr bool PERM = true;
    bf16_t* kcb; bf16_t* vct;
    __device__ __forceinline__ bool operator()(f32x4 (&acc)[2][2][4][2], const Unit& u, int wr, int wc, int fr, int fq) const {
        const int kv = u.pm >> 3; const int row0 = (u.pm & 7) * BM + wr * 64 + fr; const int col0 = wc * 32 + 8 * fq;
        if (col0 >= 64) return false;
#pragma unroll
        for (int ai = 0; ai < 2; ++ai)
#pragma unroll
            for (int m = 0; m < 4; ++m) { const int row = row0 + ai * HALF + m * 16, g = row >> 10, cc = row & 1023; const bool zr = cc == 1023; const f32x4 zz = (f32x4){0.f, 0.f, 0.f, 0.f};
                const f32x4 v0 = zr ? zz : acc[ai][0][m][0], v1 = zr ? zz : acc[ai][0][m][1];
                if (kv == 0) { u32x4 w; w.x = pk2(v0[0], v0[1]); w.y = pk2(v0[2], v0[3]); w.z = pk2(v1[0], v1[1]); w.w = pk2(v1[2], v1[3]); *(u32x4*)(kcb + ((size_t)g * 1024 + cc) * 64 + col0) = w; }
                else {
#pragma unroll
                    for (int j = 0; j < 4; ++j) { vct[((size_t)g * 64 + col0 + j) * 1024 + cc] = (bf16_t)f2bf(v0[j]); vct[((size_t)g * 64 + col0 + 4 + j) * 1024 + cc] = (bf16_t)f2bf(v1[j]); } } }
        return false;
    }
};
struct EpiLora {
    static constexpr bool PERM = true;
    bf16_t* obuf;
    __device__ __forceinline__ bool operator()(f32x4 (&acc)[2][2][4][2], const Unit& u, int wr, int wc, int fr, int fq) const {
        const int sel = u.pn >> 1; bf16_t* out = obuf + (size_t)(sel == 2 ? 0 : sel + 1) * T * 512;
        const int row0 = u.pm * BM + wr * 64 + fr; const int col0 = (u.pn & 1) * BM + wc * 32 + 8 * fq;
#pragma unroll
        for (int ai = 0; ai < 2; ++ai)
#pragma unroll
            for (int m = 0; m < 4; ++m) { bf16_t* rowp = out + (size_t)(row0 + ai * HALF + m * 16) * 512 + col0;
#pragma unroll
                for (int bj = 0; bj < 2; ++bj) { const f32x4 v0 = acc[ai][bj][m][0], v1 = acc[ai][bj][m][1];
                    u32x4 w; w.x = pk2(v0[0], v0[1]); w.y = pk2(v0[2], v0[3]); w.z = pk2(v1[0], v1[1]); w.w = pk2(v1[2], v1[3]);
                    *(u32x4*)(rowp + bj * HALF) = w; } }
        return false;
    }
};
struct EpiMerge {
    static constexpr bool PERM = true;
    const bf16_t* gates; bf16_t* merged;
    __device__ __forceinline__ bool operator()(f32x4 (&acc)[2][2][4][2], const Unit& u, int wr, int wc, int fr, int fq) const {
        const int row0 = u.pm * BM + wr * 64 + fr; const int col0 = u.pn * BM + wc * 32 + 8 * fq; const int sub = u.sub;
#pragma unroll
        for (int ai = 0; ai < 2; ++ai) {
                u32x4 gc[4][2], gn[4][2];
#pragma unroll
                for (int m = 0; m < 4; ++m) { const int row = row0 + ai * HALF + m * 16; const bf16_t* gp = gates + (size_t)row * 3072 + sub * 1024 + col0;
#pragma unroll
                    for (int bj = 0; bj < 2; ++bj) { gc[m][bj] = *(const u32x4*)(gp + bj * HALF); gn[m][bj] = (sub < 2) ? *(const u32x4*)(gp + 1024 + bj * HALF) : gc[m][bj]; } }
#pragma unroll
                for (int m = 0; m < 4; ++m) { const int row = row0 + ai * HALF + m * 16;
#pragma unroll
                    for (int bj = 0; bj < 2; ++bj) {
                        float sc[8], sn[8]; unpack8(gc[m][bj], sc);
                        if (sub < 2) { unpack8(gn[m][bj], sn);
#pragma unroll
                            for (int j = 0; j < 8; ++j) sc[j] = sc[j] * __builtin_amdgcn_rcpf(fmaxf(sn[j], 1e-30f)); }
                        f32x4 v0 = acc[ai][bj][m][0], v1 = acc[ai][bj][m][1];
#pragma unroll
                        for (int j = 0; j < 4; ++j) { v0[j] *= sc[j]; v1[j] *= sc[4 + j]; }
                        acc[ai][bj][m][0] = v0; acc[ai][bj][m][1] = v1;
                        if (sub == 2) { u32x4 w; w.x = pk2(v0[0], v0[1]); w.y = pk2(v0[2], v0[3]); w.z = pk2(v1[0], v1[1]); w.w = pk2(v1[2], v1[3]);
                            *(u32x4*)(merged + (size_t)row * D + col0 + bj * HALF) = w; } } }
                __builtin_amdgcn_sched_barrier(0);
        }
        return sub != 2;
    }
};
struct EpiNorm {
    static constexpr bool PERM = true, AFTER_DRAIN = true;
    float* x; bf16_t* xb; const float* gain; unsigned char* ws; unsigned* cnt; int row_base, kind_next; unsigned target; LAS unsigned char* lds; int tid;
    __device__ __forceinline__ bool operator()(f32x4 (&acc)[2][2][4][2], const Unit& u, int wr, int wc, int fr, int fq) const {
        LAS float* P = (LAS float*)lds; LAS float* S = (LAS float*)(lds + 16384);
        const int lane = tid & 63, wid = __builtin_amdgcn_readfirstlane(tid >> 6);
        const int prow = row_base + u.pm * BM;
        const int col0 = u.pn * BM + wc * 32 + 8 * fq;
#pragma unroll
        for (int ai = 0; ai < 2; ++ai)
#pragma unroll
            for (int m = 0; m < 4; ++m) { float ps = 0.f;
#pragma unroll
                for (int bj = 0; bj < 2; ++bj) { const f32x4 v0 = acc[ai][bj][m][0], v1 = acc[ai][bj][m][1];
                    ps += (v0[0] * v0[0] + v0[1] * v0[1]) + (v0[2] * v0[2] + v0[3] * v0[3]) + (v1[0] * v1[0] + v1[1] * v1[1]) + (v1[2] * v1[2] + v1[3] * v1[3]); }
                P[(ai * HALF + wr * 64 + m * 16 + fr) * 16 + wc * 4 + fq] = ps; }
        asm volatile("s_waitcnt lgkmcnt(0)" ::: "memory"); __builtin_amdgcn_s_barrier(); asm volatile("" ::: "memory");
        if (tid < 256) { const f32x4 a0 = *(const LAS f32x4*)(P + tid * 16), a1 = *(const LAS f32x4*)(P + tid * 16 + 4), a2 = *(const LAS f32x4*)(P + tid * 16 + 8), a3 = *(const LAS f32x4*)(P + tid * 16 + 12);
            const float sm = (((a0[0] + a0[1]) + (a0[2] + a0[3])) + ((a1[0] + a1[1]) + (a1[2] + a1[3]))) + (((a2[0] + a2[1]) + (a2[2] + a2[3])) + ((a3[0] + a3[1]) + (a3[2] + a3[3])));
            __hip_atomic_store(statp(ws, prow + tid, 1 + (int)(target >> 4)) + u.pn, sm, __ATOMIC_RELAXED, __HIP_MEMORY_SCOPE_AGENT); }
        asm volatile("s_waitcnt vmcnt(0)" ::: "memory");
        unsigned* pcnt = cnt + 16 * (prow >> 8);
        if (tid < 256 && lane == 0) (void)__hip_atomic_fetch_add(pcnt, 1u, __ATOMIC_RELAXED, __HIP_MEMORY_SCOPE_AGENT);
        if (wid == 0) { unsigned spins = 0; while ((unsigned)__builtin_amdgcn_readfirstlane(__hip_atomic_load(pcnt, __ATOMIC_RELAXED, __HIP_MEMORY_SCOPE_AGENT)) < target) { __builtin_amdgcn_s_sleep(1); if (++spins > (1u << 20)) break; }
            __builtin_amdgcn_fence(__ATOMIC_ACQUIRE, "agent"); }
        asm volatile("s_waitcnt vmcnt(0) lgkmcnt(0)" ::: "memory"); __builtin_amdgcn_s_barrier(); asm volatile("" ::: "memory");
        if (tid < 256) { float* sp = statp(ws, prow + tid, 1 + (int)(target >> 4));
            const float t0 = __hip_atomic_load(sp, __ATOMIC_RELAXED, __HIP_MEMORY_SCOPE_AGENT), t1 = __hip_atomic_load(sp + 1, __ATOMIC_RELAXED, __HIP_MEMORY_SCOPE_AGENT),
                        t2 = __hip_atomic_load(sp + 2, __ATOMIC_RELAXED, __HIP_MEMORY_SCOPE_AGENT), t3 = __hip_atomic_load(sp + 3, __ATOMIC_RELAXED, __HIP_MEMORY_SCOPE_AGENT);
            S[tid] = rsqrtf(((t0 + t1) + (t2 + t3)) * (1.0f / D) + NORM_EPS); }
        asm volatile("s_waitcnt lgkmcnt(0)" ::: "memory"); __builtin_amdgcn_s_barrier(); asm volatile("" ::: "memory");
        f32x4 gv[2][2];
#pragma unroll
        for (int bj = 0; bj < 2; ++bj) { gv[bj][0] = *(const f32x4*)(gain + col0 + bj * HALF); gv[bj][1] = *(const f32x4*)(gain + col0 + bj * HALF + 4); }
#pragma unroll
        for (int ai = 0; ai < 2; ++ai)
#pragma unroll
            for (int mp = 0; mp < 2; ++mp) {
                f32x4 xv[2][2][2];
#pragma unroll
                for (int mi = 0; mi < 2; ++mi) { const int row = prow + ai * HALF + wr * 64 + (2 * mp + mi) * 16 + fr;
#pragma unroll
                    for (int bj = 0; bj < 2; ++bj) { const float* xp = x + (size_t)row * D + col0 + bj * HALF; xv[mi][bj][0] = *(const f32x4*)xp; xv[mi][bj][1] = *(const f32x4*)(xp + 4); } }
#pragma unroll
                for (int mi = 0; mi < 2; ++mi) { const int m = 2 * mp + mi; const int rl = ai * HALF + wr * 64 + m * 16 + fr; const int row = prow + rl; const float rstd = S[rl]; float qs = 0.f;
#pragma unroll
                    for (int bj = 0; bj < 2; ++bj) { const int col = col0 + bj * HALF; float* xp = x + (size_t)row * D + col; u32x4 w;
                        { f32x4 xa = xv[mi][bj][0]; xa += acc[ai][bj][m][0] * rstd * gv[bj][0]; *(f32x4*)xp = xa;
                          w.x = pk2(xa[0], xa[1]); w.y = pk2(xa[2], xa[3]); qs += (xa[0] * xa[0] + xa[1] * xa[1]) + (xa[2] * xa[2] + xa[3] * xa[3]); }
                        { f32x4 xc = xv[mi][bj][1]; xc += acc[ai][bj][m][1] * rstd * gv[bj][1]; *(f32x4*)(xp + 4) = xc;
                          w.z = pk2(xc[0], xc[1]); w.w = pk2(xc[2], xc[3]); qs += (xc[0] * xc[0] + xc[1] * xc[1]) + (xc[2] * xc[2] + xc[3] * xc[3]); }
                        *(u32x4*)(xb + (size_t)row * D + col) = w; }
                    P[rl * 16 + wc * 4 + fq] = qs; }
                __builtin_amdgcn_sched_barrier(0);
            }
        asm volatile("s_waitcnt lgkmcnt(0)" ::: "memory"); __builtin_amdgcn_s_barrier(); asm volatile("" ::: "memory");
        if (tid < 256) { const f32x4 a0 = *(const LAS f32x4*)(P + tid * 16), a1 = *(const LAS f32x4*)(P + tid * 16 + 4), a2 = *(const LAS f32x4*)(P + tid * 16 + 8), a3 = *(const LAS f32x4*)(P + tid * 16 + 12);
            const float sm = (((a0[0] + a0[1]) + (a0[2] + a0[3])) + ((a1[0] + a1[1]) + (a1[2] + a1[3]))) + (((a2[0] + a2[1]) + (a2[2] + a2[3])) + ((a3[0] + a3[1]) + (a3[2] + a3[3])));
            __hip_atomic_store(statp(ws, prow + tid, kind_next) + u.pn, sm, __ATOMIC_RELAXED, __HIP_MEMORY_SCOPE_AGENT); }
        return false;
    }
};
struct EpiSwiGLU {
    static constexpr bool PERM = true;
    bf16_t* act; unsigned char* ws;
    __device__ __forceinline__ bool operator()(f32x4 (&acc)[2][2][4][2], const Unit& u, int wr, int wc, int fr, int fq) const {
        const int row0 = u.pm * BM + wr * 64 + fr; const int col0 = u.pn * HALF + wc * 32 + 8 * fq;
        float sv[2][4];
        { f32x4 pq[2][4];
#pragma unroll
          for (int ai = 0; ai < 2; ++ai)
#pragma unroll
            for (int m = 0; m < 4; ++m) pq[ai][m] = *(const f32x4*)statp(ws, row0 + ai * HALF + m * 16, 1);
#pragma unroll
          for (int ai = 0; ai < 2; ++ai)
#pragma unroll
            for (int m = 0; m < 4; ++m) sv[ai][m] = rsqrtf(((pq[ai][m][0] + pq[ai][m][1]) + (pq[ai][m][2] + pq[ai][m][3])) * (1.0f / D) + NORM_EPS); }
#pragma unroll
        for (int ai = 0; ai < 2; ++ai)
#pragma unroll
            for (int m = 0; m < 4; ++m) { const int row = row0 + ai * HALF + m * 16;
                const float s = sv[ai][m];
                float o[8];
#pragma unroll
                for (int n = 0; n < 2; ++n)
#pragma unroll
                    for (int j = 0; j < 4; ++j) { const float gg = acc[ai][0][m][n][j] * s, uu = acc[ai][1][m][n][j] * s; o[n * 4 + j] = gg * sigmoidf_(gg) * uu; }
                u32x4 w; w.x = pk2(o[0], o[1]); w.y = pk2(o[2], o[3]); w.z = pk2(o[4], o[5]); w.w = pk2(o[6], o[7]);
                *(u32x4*)(act + (size_t)row * FFN + col0) = w; }
        return false;
    }
};
}

struct Args { const float* in[30]; float* out; unsigned char* ws; int lo, hi; };
enum { I_X = 0, I_NPM, I_NQM, I_NPF, I_NQF, I_WIN, I_MU, I_W0, I_W2, I_A0, I_A2, I_G2, I_KK, I_KA, I_RK, I_LNW, I_LNB, I_PEK, I_PEV, I_CKW1, I_CKW2, I_CVW1, I_CVW2, I_SINK, I_REL, I_WBR, I_WOUT, I_FG, I_FU, I_FD };

struct Ctx { LAS unsigned char* lds; int tid, lane, wave, G, bid; };
__device__ __forceinline__ const float* inptr(const Ctx& c, int i) {
    const volatile LAS unsigned* t = (const volatile LAS unsigned*)(c.lds + LDS_MISC + 64) + 2 * i;
    const unsigned lo = __builtin_amdgcn_readfirstlane(t[0]), hi = __builtin_amdgcn_readfirstlane(t[1]);
    return (const float*)(((unsigned long long)hi << 32) | lo);
}

__device__ __forceinline__ void phase_init(const Ctx& c, const float* x, float* xo, bf16_t* xb, unsigned char* wsb) {
    const int gw = c.bid * 8 + c.wave, NGW = c.G * 8;
    for (int row = gw; row < MROWS; row += NGW) {
        const float* xr = x + (size_t)row * D; float ss = 0.f;
#pragma unroll
        for (int j = 0; j < 2; ++j) { const int e = c.lane * 8 + 512 * j; const f32x4 a = *(const f32x4*)(xr + e), b = *(const f32x4*)(xr + e + 4);
            ss += a[0] * a[0] + a[1] * a[1] + a[2] * a[2] + a[3] * a[3] + b[0] * b[0] + b[1] * b[1] + b[2] * b[2] + b[3] * b[3];
            *(f32x4*)(xo + (size_t)row * D + e) = a; *(f32x4*)(xo + (size_t)row * D + e + 4) = b;
            u32x4 w; w.x = pk2(a[0], a[1]); w.y = pk2(a[2], a[3]); w.z = pk2(b[0], b[1]); w.w = pk2(b[2], b[3]); *(u32x4*)(xb + (size_t)row * D + e) = w; }
        ss = wave_sum(ss);
        if (c.lane < 4) __hip_atomic_store(statp(wsb, row, 0) + c.lane, c.lane == 0 ? ss : 0.f, __ATOMIC_RELAXED, __HIP_MEMORY_SCOPE_AGENT);
    }
}
struct CvtTile { const float* src; const float* gain; bf16_t* dst; int ld, nvalid, K, k0, n0; float extra; bool kvalid; };
__device__ __forceinline__ CvtTile cvt_describe(const Ctx& c, int layer, bf16_t* wb, int it) {
    constexpr int I0 = 16 * 112, I1 = 3 * 8 * 16, I2 = 16 * 16, I3 = 16 * 88, I4 = 44 * 16, I5 = 4 * 24, I6 = 2 * 32 * 4;
    int r = it, kind, sub = 0, K, nblk; bf16_t* dst;
    if (r < I0) { kind = 0; K = D; nblk = 112; dst = wb + WB_WIN; }
    else if ((r -= I0) < I1) { kind = 1; sub = r / 128; r -= sub * 128; K = 512; nblk = 16; dst = wb + WB_WBR + (size_t)sub * D * 512; }
    else if ((r -= I1) < I2) { kind = 2; K = D; nblk = 16; dst = wb + WB_WOUT; }
    else if ((r -= I2) < I3) { kind = 3; K = D; nblk = 88; dst = wb + WB_WGU; }
    else if ((r -= I3) < I4) { kind = 4; K = FFN; nblk = 16; dst = wb + WB_WDN; }
    else if ((r -= I4) < I5) { kind = 5; K = 256; nblk = 24; dst = wb + WB_LORA; }
    else if ((r -= I5) < I6) { kind = 6; sub = r / 128; r -= sub * 128; K = 2048; nblk = 4; dst = wb + WB_W1T + (size_t)sub * 256 * 2048; }
    else { r -= I6; kind = 7; sub = r / 16; r -= sub * 16; K = 256; nblk = 4; dst = wb + WB_W2T + (size_t)sub * 256 * 256; }
    const int kb = r / nblk, nb = r % nblk, k0 = kb * 64, n0 = nb * 64;
    CvtTile t; t.src = nullptr; t.gain = nullptr; t.dst = dst; t.ld = 0; t.nvalid = 64; t.K = K; t.k0 = k0; t.n0 = n0; t.extra = 1.f; t.kvalid = true;
    switch (kind) {
    case 0: { t.gain = inptr(c, I_NPM) + layer * D + k0; t.ld = IN_COLS;
        const int scol = n0 < 3096 ? n0 : n0 - 232; t.nvalid = (n0 < 3096) ? (3096 - n0 < 64 ? 3096 - n0 : 64) : (n0 < 3328 ? 0 : 64);
        if ((n0 >= PC_NQ && n0 < PC_NQ + 512) || (n0 >= PC_SQ && n0 < PC_SQ + 512)) t.extra = 0.125f;
        t.src = inptr(c, I_WIN) + ((size_t)layer * D + k0) * IN_COLS + scol; break; }
    case 1: t.src = inptr(c, I_WBR) + (((size_t)layer * 3 + sub) * 512 + k0) * D + n0; t.ld = D; break;
    case 2: t.src = inptr(c, I_WOUT) + ((size_t)layer * D + k0) * D + n0; t.ld = D; break;
    case 3: { t.gain = inptr(c, I_NPF) + layer * D + k0; t.ld = FFN; const int pn = n0 >> 8, rr = n0 & 255;
        t.src = inptr(c, rr < 128 ? I_FG : I_FU) + ((size_t)layer * D + k0) * FFN + pn * 128 + (rr & 127); break; }
    case 4: t.src = inptr(c, I_FD) + ((size_t)layer * FFN + k0) * D + n0; t.ld = D; break;
    case 5: { t.ld = 512;
        if (n0 < 512) { t.kvalid = k0 < 64; t.src = inptr(c, I_W2) + ((size_t)layer * 64 + k0) * 512 + n0; }
        else if (n0 < 1024) { t.kvalid = (k0 == 64); t.src = inptr(c, I_A2) + ((size_t)layer * 64 + (k0 - 64)) * 512 + n0 - 512; }
        else { t.kvalid = k0 >= 128; t.src = inptr(c, I_G2) + ((size_t)layer * 128 + (k0 - 128)) * 512 + n0 - 1024; }
        break; }
    case 6: t.src = inptr(c, sub ? I_CVW1 : I_CKW1) + ((size_t)layer * 2048 + k0) * 256 + n0; t.ld = 256; break;
    default: t.src = inptr(c, sub ? I_CVW2 : I_CKW2) + ((size_t)layer * 256 + k0) * 64 + n0; t.ld = 64; t.nvalid = n0 < 64 ? 64 : 0; break;
    }
    return t;
}
__device__ __forceinline__ void phase_cvt(const Ctx& c, const Args& a, int layer, bf16_t* wb) {
    LAS float* tile = (LAS float*)c.lds;
    constexpr int NIT = 16 * 112 + 3 * 8 * 16 + 16 * 16 + 16 * 88 + 44 * 16 + 4 * 24 + 2 * 32 * 4 + 2 * 4 * 4;
    for (int it = c.bid; it < NIT; it += 2 * c.G) {
        const int it2 = it + c.G; const bool two = it2 < NIT;
        const CvtTile t0 = cvt_describe(c, layer, wb, it), t1 = cvt_describe(c, layer, wb, two ? it2 : it);
        float v0[8], v1[8];
#pragma unroll
        for (int i = 0; i < 8; ++i) { const int e = c.tid + 512 * i, kk = e >> 6, nn = e & 63;
            v0[i] = (t0.kvalid && nn < t0.nvalid) ? t0.src[(size_t)kk * t0.ld + nn] : 0.f;
            v1[i] = (two && t1.kvalid && nn < t1.nvalid) ? t1.src[(size_t)kk * t1.ld + nn] : 0.f; }
#pragma unroll
        for (int i = 0; i < 8; ++i) { const int e = c.tid + 512 * i, kk = e >> 6, nn = e & 63;
            tile[kk * 65 + nn] = v0[i] * t0.extra * (t0.gain ? t0.gain[kk] : 1.f); tile[4160 + kk * 65 + nn] = v1[i] * t1.extra * (t1.gain ? t1.gain[kk] : 1.f); }
        __syncthreads();
        { const int nn = c.tid >> 3, kc = (c.tid & 7) * 8; u32x4 w;
          w.x = pk2(tile[(kc + 0) * 65 + nn], tile[(kc + 1) * 65 + nn]); w.y = pk2(tile[(kc + 2) * 65 + nn], tile[(kc + 3) * 65 + nn]);
          w.z = pk2(tile[(kc + 4) * 65 + nn], tile[(kc + 5) * 65 + nn]); w.w = pk2(tile[(kc + 6) * 65 + nn], tile[(kc + 7) * 65 + nn]);
          *(u32x4*)(t0.dst + (size_t)(t0.n0 + nn) * t0.K + t0.k0 + kc) = w;
          if (two) { const LAS float* tl = tile + 4160;
            w.x = pk2(tl[(kc + 0) * 65 + nn], tl[(kc + 1) * 65 + nn]); w.y = pk2(tl[(kc + 2) * 65 + nn], tl[(kc + 3) * 65 + nn]);
            w.z = pk2(tl[(kc + 4) * 65 + nn], tl[(kc + 5) * 65 + nn]); w.w = pk2(tl[(kc + 6) * 65 + nn], tl[(kc + 7) * 65 + nn]);
            *(u32x4*)(t1.dst + (size_t)(t1.n0 + nn) * t1.K + t1.k0 + kc) = w; } }
        __syncthreads();
    }
    if (c.bid == c.G - 1) {
        const int kv = c.tid >> 8, u = c.tid & 255; const float* w1 = inptr(c, kv ? I_CVW1 : I_CKW1) + (size_t)layer * 2048 * 256; const float* pe = inptr(c, kv ? I_PEV : I_PEK) + (size_t)layer * 2048;
        float acc = 0.f; for (int k = 0; k < 2048; ++k) acc += pe[k] * w1[(size_t)k * 256 + u];
        ((float*)(wb + WB_BH))[c.tid] = acc;
    }
}

constexpr int RL = 65;
__device__ __forceinline__ float rwkv_mixed(const bf16_t* proj, const float* mu, int t, int col) {
    const float cur = bf2f(proj[(size_t)t * PLD + col]); const float prev = t > 0 ? bf2f(proj[(size_t)(t - 1) * PLD + col]) : 0.f;
    return cur + (prev - cur) * mu[col];
}
__device__ __forceinline__ int kperm32(int jl) { return 8 * ((jl >> 2) & 3) + 4 * (jl >> 4) + (jl & 3); }
__device__ __forceinline__ f32x4 tile_mma64(const LAS unsigned char* A, const LAS unsigned char* B, int a, int b, int lane, f32x4 acc) {
    const int m = lane & 15, q = lane >> 4;
#pragma unroll
    for (int ks = 0; ks < 2; ++ks) {
        const bf16x8 af = *(const LAS bf16x8*)(A + (16 * a + m) * 144 + (32 * ks + 8 * q) * 2);
        const bf16x8 bf = *(const LAS bf16x8*)(B + (16 * b + m) * 144 + (32 * ks + 8 * q) * 2);
        acc = __builtin_amdgcn_mfma_f32_16x16x32_bf16(af, bf, acc, 0, 0, 0);
    }
    return acc;
}
__device__ __forceinline__ void lds_st_bf16(LAS unsigned char* base, int idx, float v) { *(LAS bf16_t*)(base + idx * 2) = (bf16_t)f2bf(v); }

__device__ __forceinline__ void phase_lora_a(const Ctx& c, const Args& a, int layer, const bf16_t* proj, bf16_t* alora) {
    const float* mu = inptr(c, I_MU) + (size_t)layer * 1792;
    const int sub = c.tid & 31, rloc = c.tid >> 5;
    for (int t = c.bid * 16 + rloc; t < T; t += c.G * 16) {
        const int col = PC_ZW + sub * 8; float cur[8], prv[8];
        unpack8(*(const u32x4*)(proj + (size_t)t * PLD + col), cur);
        if (t > 0) unpack8(*(const u32x4*)(proj + (size_t)(t - 1) * PLD + col), prv); else {
#pragma unroll
            for (int k = 0; k < 8; ++k) prv[k] = 0.f; }
        float o[8];
#pragma unroll
        for (int k = 0; k < 8; ++k) { const float v = cur[k] + (prv[k] - cur[k]) * mu[col + k]; o[k] = sub < 8 ? tanhf(v) : (sub < 16 ? v : sigmoidf_(v)); }
        u32x4 w; w.x = pk2(o[0], o[1]); w.y = pk2(o[2], o[3]); w.z = pk2(o[4], o[5]); w.w = pk2(o[6], o[7]);
        *(u32x4*)(alora + (size_t)t * 256 + sub * 8) = w;
    }
}

constexpr int RC_L = 0, RC_AL = 16640, RC_AAK = 0, RC_ARB = 9216, RC_ARK = 18432, RC_AAB = 33280, RC_P2T = 33280, RC_WC = 50688, RC_BS = 50944, RC_M = 52992;
constexpr int RC_AT = RC_M, RC_TINV = RC_M, RC_ATT = RC_M + 9216, RC_RT = RC_M + 2 * 9216, RC_BT = RC_M + 3 * 9216, RC_XT = RC_BT, RC_KT = RC_M + 4 * 9216, RC_P1T = RC_KT,
              RC_VT = RC_M + 5 * 9216, RC_BHT = RC_M + 6 * 9216, RC_KHT = RC_M + 7 * 9216;
constexpr int RC_XOFF = RC_M + 8 * 9216, RC_XTMP = RC_XOFF + 6144;
static_assert(RC_XTMP + 3 * 1088 <= LDS_MISC, "rwkv chunk LDS");

__device__ __forceinline__ void phase_rwkv_chunk(const Ctx& c, const Args& a, int layer, const bf16_t* proj, const bf16_t* wlb, const bf16_t* alb, bf16_t* rwu, float* bonusg) {
    LAS unsigned char* L = c.lds;
    LAS float* sL = (LAS float*)(L + RC_L); LAS float* sAL = (LAS float*)(L + RC_AL); LAS float* sAAB = (LAS float*)(L + RC_AAB);
    LAS float* sWC = (LAS float*)(L + RC_WC); LAS float* sBS = (LAS float*)(L + RC_BS);
    const float* mu = inptr(c, I_MU) + (size_t)layer * 1792;
    const int lane = c.lane, wave = c.wave, n = lane & 15, q = lane >> 4;
    for (int unit = c.bid; unit < 2048; unit += c.G) {
        const int ch = unit >> 3, h = unit & 7, t0 = ch * 64, j = lane;
        {
            const float w0 = inptr(c, I_W0)[layer * 512 + h * 64 + j], a0 = inptr(c, I_A0)[layer * 512 + h * 64 + j];
            bf16_t wraw[8], araw[8];
#pragma unroll
            for (int i = 0; i < 8; ++i) { const size_t gi = (size_t)(t0 + wave * 8 + i) * 512 + h * 64 + j; wraw[i] = wlb[gi]; araw[i] = alb[gi]; }
            float run = 0.f;
#pragma unroll
            for (int i = 0; i < 8; ++i) { const int tt = wave * 8 + i;
                const float wl = w0 + bf2f(wraw[i]); const float nx = -wl; const float sp = nx > 20.f ? nx : __logf(1.0f + __expf(nx)); const float ld = -__expf(-sp - 0.5f);
                run += ld; sL[tt * RL + j] = run; sAL[tt * RL + j] = sigmoidf_(a0 + bf2f(araw[i])); }
            sBS[wave * 64 + j] = run;
        }
        bf16_t rraw[9], kraw[9], vraw[9];
        {
#pragma unroll
            for (int i = 0; i < 9; ++i) { const int t = t0 + wave * 8 + i - 1; const bool ok = t >= 0; const size_t ro = (size_t)(ok ? t : 0) * PLD + h * 64 + j;
                rraw[i] = ok ? proj[ro + PC_R] : (bf16_t)0; kraw[i] = ok ? proj[ro + PC_K] : (bf16_t)0; vraw[i] = ok ? proj[ro + PC_V] : (bf16_t)0; }
        }
        __syncthreads();
        {
            float off = 0.f, tot = 0.f;
#pragma unroll
            for (int w2 = 0; w2 < 8; ++w2) { const float v = sBS[w2 * 64 + j]; tot += v; off += (w2 < wave) ? v : 0.f; }
            if (wave == 0) sWC[j] = __expf(tot);
            const float kkw = inptr(c, I_KK)[layer * 512 + h * 64 + j], kaw = inptr(c, I_KA)[layer * 512 + h * 64 + j], rk = inptr(c, I_RK)[layer * 512 + h * 64 + j];
            const float mur = mu[PC_R + h * 64 + j], muk = mu[PC_K + h * 64 + j], muv = mu[PC_V + h * 64 + j];
            float Lprev = off; float eWprev = __expf(off); const float eTot = __expf(tot);
#pragma unroll
            for (int i = 0; i < 8; ++i) { const int tt = wave * 8 + i, t = t0 + tt;
                const float Lc = sL[tt * RL + j] + off, al = sAL[tt * RL + j];
                const float rc = bf2f(rraw[i + 1]), kc = bf2f(kraw[i + 1]), vc = bf2f(vraw[i + 1]);
                const float r = rc + (bf2f(rraw[i]) - rc) * mur, k = kc + (bf2f(kraw[i]) - kc) * muk, v = vc + (bf2f(vraw[i]) - vc) * muv;
                float kk = k * kkw; const float n2 = wave_sum(kk * kk); kk = kk / fmaxf(sqrtf(n2), 1e-12f);
                const float kp = k * (1.0f + (al - 1.0f) * kaw), av = -kk, bv = kk * al;
                const float eW = __expf(Lc), eInv = __builtin_amdgcn_rcpf(eW), eC = eTot * eInv; const float eWex = eWprev; eWprev = eW;
                lds_st_bf16(L + RC_AT, tt * 72 + j, av * eWex); lds_st_bf16(L + RC_ATT, j * 72 + tt, av * eWex);
                lds_st_bf16(L + RC_RT, tt * 72 + j, r * eW); lds_st_bf16(L + RC_BT, tt * 72 + j, bv * eInv); lds_st_bf16(L + RC_KT, tt * 72 + j, kp * eInv);
                lds_st_bf16(L + RC_VT, j * 72 + tt, v); lds_st_bf16(L + RC_BHT, j * 72 + tt, bv * eC); lds_st_bf16(L + RC_KHT, j * 72 + tt, kp * eC);
                const float bon = wave_sum(r * kp * rk); if (lane == 0) bonusg[(size_t)t * 8 + h] = bon;
                Lprev = Lc; }
        }
        __syncthreads();
        for (int job = wave; job < 64; job += 8) {
            const int p = job >> 4, ta = (job >> 2) & 3, tb = job & 3;
            f32x4 acc = (f32x4){0.f, 0.f, 0.f, 0.f};
            if (ta >= tb) acc = tile_mma64(L + (p < 2 ? RC_AT : RC_RT), L + ((p & 1) ? RC_KT : RC_BT), ta, tb, lane, acc);
            LAS unsigned char* dst = L + (p == 1 ? RC_AAK : (p == 2 ? RC_ARB : RC_ARK));
#pragma unroll
            for (int r = 0; r < 4; ++r) { const int tt = 16 * ta + 4 * q + r, ss = 16 * tb + n; const bool keep = (p < 2) ? (ss < tt) : (ss <= tt); const float v = keep ? acc[r] : 0.f;
                if (p == 0) sAAB[tt * 68 + ss] = v; else lds_st_bf16(dst, tt * 72 + ss, v); }
        }
        __syncthreads();
        if (wave == 0) {
            const int blk = lane >> 4, cc = lane & 15; const LAS float* Ab = sAAB + (16 * blk) * 68 + 16 * blk; float xr[16];
#pragma unroll
            for (int tt = 0; tt < 16; ++tt) { float acc = (tt == cc) ? 1.f : 0.f;
#pragma unroll
                for (int ss = 0; ss < tt; ++ss) acc += Ab[tt * 68 + ss] * xr[ss];
                xr[tt] = acc; }
            asm volatile("s_waitcnt lgkmcnt(0)" ::: "memory");
#pragma unroll
            for (int tt = 0; tt < 16; ++tt) sAAB[(16 * blk + tt) * 68 + 16 * blk + cc] = xr[tt];
        } else {
            for (int job = wave - 1; job < 16; job += 7) { const int ta = job >> 2, tb = job & 3;
                const f32x4 acc = tile_mma64(L + RC_VT, L + RC_AAK, ta, tb, lane, (f32x4){0.f, 0.f, 0.f, 0.f});
#pragma unroll
                for (int r = 0; r < 4; ++r) lds_st_bf16(L + RC_XT, (16 * ta + 4 * q + r) * 72 + 16 * tb + n, acc[r]); }
        }
        __syncthreads();
        {
            LAS float* sXO = (LAS float*)(L + RC_XOFF); LAS float* sT = (LAS float*)(L + RC_XTMP) + wave * 272;
            const int rr = lane >> 2, c4 = (lane & 3) * 4;
#pragma unroll 1
            for (int lev = 1; lev <= 3; ++lev) {
                if (wave < 4 - lev) {
                    const int J = wave, I = wave + lev;
                    f32x4 tacc = (f32x4){0.f, 0.f, 0.f, 0.f};
                    for (int K = J; K < I; ++K) {
                        const LAS float* Ap = sAAB + (16 * I + rr) * 68 + 16 * K; const LAS float* Xp;
                        int xs;
                        if (K == J) { Xp = sAAB + (16 * J) * 68 + 16 * J + c4; xs = 68; }
                        else { const int d = K - J; const int bi = (d == 1) ? J : 3 + J; Xp = sXO + bi * 256 + c4; xs = 16; }
#pragma unroll
                        for (int k = 0; k < 16; ++k) { const float av = Ap[k]; const f32x4 xv = *(const LAS f32x4*)(Xp + k * xs); tacc += xv * av; }
                    }
                    *(LAS f32x4*)(sT + rr * 16 + c4) = tacc;
                    asm volatile("s_waitcnt lgkmcnt(0)" ::: "memory");
                    f32x4 xacc = (f32x4){0.f, 0.f, 0.f, 0.f};
                    const LAS float* Dp = sAAB + (16 * I + rr) * 68 + 16 * I;
#pragma unroll
                    for (int k = 0; k < 16; ++k) { const float dv = Dp[k]; const f32x4 tv = *(const LAS f32x4*)(sT + k * 16 + c4); xacc += tv * dv; }
                    const int bo = (lev == 1) ? J : (lev == 2 ? 3 + J : 5);
                    *(LAS f32x4*)(sXO + bo * 256 + rr * 16 + c4) = xacc;
                }
                __syncthreads();
            }
            for (int e = c.tid; e < 4096; e += 512) { const int tt = e >> 6, ss = e & 63, I = tt >> 4, J = ss >> 4; float v = 0.f;
                if (I == J) v = sAAB[tt * 68 + ss];
                else if (I > J) { const int d = I - J; const int bi = (d == 1) ? J : (d == 2 ? 3 + J : 5); v = sXO[bi * 256 + (tt & 15) * 16 + (ss & 15)]; }
                lds_st_bf16(L + RC_TINV, tt * 72 + ss, v); }
        }
        __syncthreads();
        for (int job = wave; job < 32; job += 8) { const int p = job >> 4, ta = (job >> 2) & 3, tb = job & 3;
            const f32x4 acc = tile_mma64(L + (p ? RC_XT : RC_ATT), L + RC_TINV, ta, tb, lane, (f32x4){0.f, 0.f, 0.f, 0.f});
#pragma unroll
            for (int r = 0; r < 4; ++r) lds_st_bf16(L + (p ? RC_P2T : RC_P1T), (16 * ta + 4 * q + r) * 72 + 16 * tb + n, acc[r]); }
        __syncthreads();
        bf16_t* ug = rwu + (size_t)unit * 16384;
        for (int job = wave; job < 64; job += 8) { const int p = job >> 4, ta = (job >> 2) & 3, tb = job & 3;
            f32x4 acc = (f32x4){0.f, 0.f, 0.f, 0.f};
            if (p == 0) { acc = tile_mma64(L + RC_ARB, L + RC_P1T, ta, tb, lane, acc);
#pragma unroll
                for (int r = 0; r < 4; ++r) { const int tt = 16 * ta + 4 * q + r, jj = 16 * tb + n; const float v = acc[r] + bf2f(*(const LAS bf16_t*)(L + RC_RT + (tt * 72 + jj) * 2));
                    ug[8192 + tt * 64 + (jj & 32) + kperm32(jj & 31)] = (bf16_t)f2bf(v); } }
            else if (p == 1) { acc = tile_mma64(L + RC_ARB, L + RC_P2T, ta, tb, lane, acc); acc = tile_mma64(L + RC_ARK, L + RC_VT, ta, tb, lane, acc);
                u32x2 w; w.x = pk2(acc[0], acc[1]); w.y = pk2(acc[2], acc[3]); *(u32x2*)(ug + 12288 + ((tb * 4 + ta) * 64 + lane) * 4) = w; }
            else if (p == 2) { acc = tile_mma64(L + RC_BHT, L + RC_P1T, ta, tb, lane, acc);
#pragma unroll
                for (int r = 0; r < 4; ++r) { const int jr = 16 * ta + 4 * q + r, jc = 16 * tb + n; const float v = acc[r] + (jr == jc ? sWC[jr] : 0.f);
                    ug[jr * 64 + (jc & 32) + kperm32(jc & 31)] = (bf16_t)f2bf(v); } }
            else { acc = tile_mma64(L + RC_BHT, L + RC_P2T, ta, tb, lane, acc); acc = tile_mma64(L + RC_KHT, L + RC_VT, ta, tb, lane, acc);
                u32x2 w; w.x = pk2(acc[0], acc[1]); w.y = pk2(acc[2], acc[3]); *(u32x2*)(ug + 4096 + ((tb * 4 + ta) * 64 + lane) * 4) = w; }
        }
        __syncthreads();
    }
}

#define RW_LOAD_SET(SET, UNIT) do { const bf16_t* ug_ = rwu + (size_t)(UNIT) * 16384; \
    _Pragma("unroll") for (int ta = 0; ta < 4; ++ta) { An[SET][ta][0] = *(const bf16x8*)(ug_ + (16 * ta + m) * 64 + 8 * q); An[SET][ta][1] = *(const bf16x8*)(ug_ + (16 * ta + m) * 64 + 32 + 8 * q); \
        Zn[SET][ta] = *(const u32x2*)(ug_ + 4096 + ((cq * 4 + ta) * 64 + lane) * 4); } } while (0)
template <int SM>
__device__ __forceinline__ void phase_rwkv_scan(const Ctx& c, const bf16_t* rwu, bf16_t* rws) {
    const int idx = c.bid; if (idx >= 32 || c.wave != 0) return;
    const int h = idx >> 2, cq = idx & 3, lane = c.lane, m = lane & 15, q = lane >> 4;
    bf16x8 Bhi[2], Blo[2];
#pragma unroll
    for (int s = 0; s < 2; ++s) { Bhi[s] = (bf16x8){0, 0, 0, 0, 0, 0, 0, 0}; Blo[s] = Bhi[s]; }
    bf16x8 An[2][4][2]; u32x2 Zn[2][4];
#pragma unroll
    for (int u = 0; u < 2; ++u) RW_LOAD_SET(u, u * 8 + h);
    if (SM == 1) {
        for (int ch = 0; ch < T / 64; ch += 8) {
#pragma unroll
            for (int uu = 0; uu < 8; ++uu) { const int u = uu & 3; const int unit = (ch + uu) * 8 + h;
                bf16_t* sg = rws + (size_t)unit * 4096 + cq * 1024 + lane * 8;
                *(bf16x8*)(sg) = Bhi[0]; *(bf16x8*)(sg + 512) = Bhi[1];
#pragma unroll
                for (int ta = 0; ta < 4; ++ta) { Bhi[0] = Bhi[0] ^ An[u][ta][0]; Bhi[1] = Bhi[1] ^ An[u][ta][1]; Bhi[0][0] ^= (short)Zn[u][ta].x; }
                RW_LOAD_SET(u, (ch + uu + 4 < T / 64) ? unit + 32 : unit); } }
        return;
    }
    for (int ch = 0; ch < T / 64; ch += 8) {
#pragma unroll
        for (int uu = 0; uu < 8; ++uu) {
            const int u = uu & 1;
            const int unit = (ch + uu) * 8 + h;
            bf16_t* sg = rws + (size_t)unit * 4096 + cq * 1024 + lane * 8;
            *(bf16x8*)(sg) = Bhi[0]; *(bf16x8*)(sg + 512) = Bhi[1];
            f32x4 acc[4];
#pragma unroll
            for (int ta = 0; ta < 4; ++ta) { const u32x2 z = Zn[u][ta];
                acc[ta] = (f32x4){__uint_as_float(z.x << 16), __uint_as_float(z.x & 0xffff0000u), __uint_as_float(z.y << 16), __uint_as_float(z.y & 0xffff0000u)};
#pragma unroll
                for (int s = 0; s < 2; ++s) { acc[ta] = __builtin_amdgcn_mfma_f32_16x16x32_bf16(An[u][ta][s], Bhi[s], acc[ta], 0, 0, 0); acc[ta] = __builtin_amdgcn_mfma_f32_16x16x32_bf16(An[u][ta][s], Blo[s], acc[ta], 0, 0, 0); } }
            if (SM == 0) RW_LOAD_SET(u, (ch + uu + 2 < T / 64) ? unit + 16 : unit);
#pragma unroll
            for (int s = 0; s < 2; ++s) { u32x4 hi, lo; float rem[8];
#pragma unroll
                for (int p = 0; p < 8; ++p) { const float v = acc[2 * s + (p >> 2)][p & 3]; const unsigned hb = f2bf(v); rem[p] = v - __uint_as_float(hb << 16); }
                hi.x = pk2(acc[2 * s][0], acc[2 * s][1]); hi.y = pk2(acc[2 * s][2], acc[2 * s][3]); hi.z = pk2(acc[2 * s + 1][0], acc[2 * s + 1][1]); hi.w = pk2(acc[2 * s + 1][2], acc[2 * s + 1][3]);
                lo.x = pk2(rem[0], rem[1]); lo.y = pk2(rem[2], rem[3]); lo.z = pk2(rem[4], rem[5]); lo.w = pk2(rem[6], rem[7]);
                Bhi[s] = __builtin_bit_cast(bf16x8, hi); Blo[s] = __builtin_bit_cast(bf16x8, lo); }
        }
    }
}
#undef RW_LOAD_SET

__device__ __forceinline__ void phase_rwkv_out(const Ctx& c, const Args& a, int layer, const bf16_t* proj, const bf16_t* rwu, const bf16_t* rws, const float* bonusg, bf16_t* orwkv) {
    const float* mu = inptr(c, I_MU) + (size_t)layer * 1792;
    const int lane = c.lane, m = lane & 15, q = lane >> 4;
    for (int unit = c.bid * 8 + c.wave; unit < 2048; unit += c.G * 8) {
        const int ch = unit >> 3, h = unit & 7, t0 = ch * 64; const bf16_t* ug = rwu + (size_t)unit * 16384; const bf16_t* sg = rws + (size_t)unit * 4096;
        bf16x8 Bf[4][2];
#pragma unroll
        for (int cq = 0; cq < 4; ++cq) { Bf[cq][0] = *(const bf16x8*)(sg + cq * 1024 + lane * 8); Bf[cq][1] = *(const bf16x8*)(sg + cq * 1024 + 512 + lane * 8); }
        float lnw[4], lnb[4];
#pragma unroll
        for (int cq = 0; cq < 4; ++cq) { lnw[cq] = inptr(c, I_LNW)[layer * 512 + h * 64 + 16 * cq + m]; lnb[cq] = inptr(c, I_LNB)[layer * 512 + h * 64 + 16 * cq + m]; }
        float muv[4];
#pragma unroll
        for (int cq = 0; cq < 4; ++cq) muv[cq] = mu[PC_V + h * 64 + 16 * cq + m];
#pragma unroll 1
        for (int ta = 0; ta < 4; ++ta) {
            const bf16x8 A0 = *(const bf16x8*)(ug + 8192 + (16 * ta + m) * 64 + 8 * q), A1 = *(const bf16x8*)(ug + 8192 + (16 * ta + m) * 64 + 32 + 8 * q);
            f32x4 y[4];
#pragma unroll
            for (int cq = 0; cq < 4; ++cq) { const u32x2 z = *(const u32x2*)(ug + 12288 + ((cq * 4 + ta) * 64 + lane) * 4);
                y[cq] = (f32x4){__uint_as_float(z.x << 16), __uint_as_float(z.x & 0xffff0000u), __uint_as_float(z.y << 16), __uint_as_float(z.y & 0xffff0000u)};
                y[cq] = __builtin_amdgcn_mfma_f32_16x16x32_bf16(A0, Bf[cq][0], y[cq], 0, 0, 0); y[cq] = __builtin_amdgcn_mfma_f32_16x16x32_bf16(A1, Bf[cq][1], y[cq], 0, 0, 0); }
            bf16_t vcur[4][4], vprv[4][4], graw[4][4]; float bonv[4];
#pragma unroll
            for (int r = 0; r < 4; ++r) { const int t = t0 + 16 * ta + 4 * q + r; bonv[r] = bonusg[(size_t)t * 8 + h];
#pragma unroll
                for (int cq = 0; cq < 4; ++cq) { const int col = h * 64 + 16 * cq + m; vcur[r][cq] = proj[(size_t)t * PLD + PC_V + col];
                    vprv[r][cq] = t > 0 ? proj[(size_t)(t - 1) * PLD + PC_V + col] : (bf16_t)0; graw[r][cq] = orwkv[(size_t)t * 512 + col]; } }
#pragma unroll
            for (int r = 0; r < 4; ++r) { const int t = t0 + 16 * ta + 4 * q + r;
                float sm = row16_sum(y[0][r] + y[1][r] + y[2][r] + y[3][r]);
                const float mean = sm * (1.0f / 64.0f); float d[4], vs = 0.f;
#pragma unroll
                for (int cq = 0; cq < 4; ++cq) { d[cq] = y[cq][r] - mean; vs += d[cq] * d[cq]; }
                vs = row16_sum(vs);
                const float rstd = rsqrtf(vs * (1.0f / 64.0f) + 64e-5f); const float bon = bonv[r];
#pragma unroll
                for (int cq = 0; cq < 4; ++cq) { const int col = h * 64 + 16 * cq + m; const float vc = bf2f(vcur[r][cq]); const float v = vc + (bf2f(vprv[r][cq]) - vc) * muv[cq];
                    orwkv[(size_t)t * 512 + col] = (bf16_t)f2bf((d[cq] * rstd * lnw[cq] + lnb[cq] + bon * v) * bf2f(graw[r][cq])); } }
        }
    }
}


constexpr int AT_K = 0, AT_V = 9216, AT_SCORE = 18432  , AT_BIAS = 83968, AT_SELM = 100352, AT_LIST = 104448, AT_NLIST = 105472, AT_NEED = 105504, AT_REL = 105600  ;
__device__ __forceinline__ void vt_transpose(const Ctx& c, const bf16_t* proj, bf16_t* vt) {
    LAS bf16_t* tl = (LAS bf16_t*)c.lds;
    for (int it = c.bid; it < 3 * 2 * 256; it += c.G) {
        const int which = it / 512, g = (it >> 8) & 1, tt = it & 255;
        const int col = (which == 0 ? PC_VS : (which == 1 ? PC_VW : PC_SV)) + g * 64;
        { const int tok = c.tid >> 3, ch = c.tid & 7; const u32x4 w = *(const u32x4*)(proj + (size_t)(tt * 64 + tok) * PLD + col + ch * 8);
          *(LAS u32x4*)(tl + tok * 72 + ch * 8) = w; }
        __syncthreads();
        { const int d = c.tid >> 3, ch = c.tid & 7; unsigned short e[8];
#pragma unroll
          for (int k = 0; k < 8; ++k) e[k] = tl[(ch * 8 + k) * 72 + d];
          u32x4 w; w.x = e[0] | ((unsigned)e[1] << 16); w.y = e[2] | ((unsigned)e[3] << 16); w.z = e[4] | ((unsigned)e[5] << 16); w.w = e[6] | ((unsigned)e[7] << 16);
          *(u32x4*)(vt + ((size_t)(which * 2 + g) * 64 + d) * T + tt * 64 + ch * 8) = w; }
        __syncthreads();
    }
}

template <int MODE, int NQ, int DBG = 0>
__device__ __forceinline__ void phase_attn(const Ctx& c, const Args& a, int layer, const bf16_t* proj, const bf16_t* vtb, const bf16_t* kcb, const bf16_t* vctb,
                                           unsigned* sel, float* nsaacc, bf16_t* oout) {
    LAS unsigned char* L = c.lds;
    LAS float* sscore = (LAS float*)(L + AT_SCORE);
    LAS float* biasd = (LAS float*)(L + AT_BIAS);
    LAS unsigned* selm = (LAS unsigned*)(L + AT_SELM);
    LAS int* list = (LAS int*)(L + AT_LIST);
    LAS int* nlist = (LAS int*)(L + AT_NLIST);
    LAS unsigned* need = (LAS unsigned*)(L + AT_NEED);
    const int lane = c.lane, wave = c.wave, n = lane & 15, q = lane >> 4, hr = n & 3;
    LAS float* reltab = (LAS float*)(L + AT_REL);
    __syncthreads();
    reltab[c.tid] = inptr(c, I_REL)[c.tid];
    constexpr int TW = 4 * NQ, TB = 8 * TW, NU = T / TB, TS = (MODE == 3) ? 4 : 1;
    for (int unit = c.bid; unit < 2 * NU; unit += c.G) {
        const int g = unit / NU, t0 = ((g == 0) ? (unit % NU) : (NU - 1 - unit % NU)) * TB, tw0 = t0 + wave * TW;
        __syncthreads();
        for (int e = c.tid; e < 4096; e += 512) { const int r = e >> 10, d = e & 1023; biasd[e] = reltab[t5_bucket(d) * 16 + (MODE == 0 ? 8 : 0) + g * 4 + r]; }
        if (MODE == 3) {
            if (c.tid < 8) need[c.tid] = 0u;
            __syncthreads();
            { const int tok = c.tid >> 3, w8 = c.tid & 7; const unsigned mw = selp((unsigned char*)sel, t0 + tok, g)[w8]; selm[tok * 8 + w8] = mw; atomicOr((unsigned*)&need[w8], mw); }
            __syncthreads();
            if (c.tid < 256) { const int j = c.tid; const unsigned wd = need[j >> 5];
                if ((wd >> (j & 31)) & 1u) { int pos = __popc(wd & ((1u << (j & 31)) - 1u)); for (int w2 = 0; w2 < (j >> 5); ++w2) pos += __popc(need[w2]); list[pos] = j; } }
            if (c.tid == 0) { int cnt = 0; for (int w2 = 0; w2 < 8; ++w2) cnt += __popc(need[w2]); nlist[0] = cnt; }
        }
        __syncthreads();
        int ntiles, tile_lo = 0;
        if (MODE == 0) { ntiles = 2 + TB / 64; tile_lo = t0 - 128; }
        else if (MODE == 1) { ntiles = 8 + TB / 64; tile_lo = t0 - 512; }
        else if (MODE == 2) { const int cmax = (t0 + TB - 1 - 31) >> 4; ntiles = cmax < 0 ? 0 : (cmax >> 6) + 1; }
        else ntiles = nlist[0];
        const bf16_t* Ksrc; size_t kstride; const bf16_t* Vsrc; size_t vstride; int qcol;
        if (MODE == 0) { Ksrc = proj + PC_SK + g * 64; kstride = PLD; Vsrc = vtb + (size_t)(4 + g) * 64 * T; vstride = T; qcol = PC_SQ + g * 256; }
        else if (MODE == 1) { Ksrc = proj + PC_KW + g * 64; kstride = PLD; Vsrc = vtb + (size_t)(2 + g) * 64 * T; vstride = T; qcol = PC_NQ + g * 256; }
        else if (MODE == 2) { Ksrc = kcb + (size_t)g * 1024 * 64; kstride = 64; Vsrc = vctb + (size_t)g * 64 * 1024; vstride = 1024; qcol = PC_NQ + g * 256; }
        else { Ksrc = proj + PC_KS + g * 64; kstride = PLD; Vsrc = vtb + (size_t)(0 + g) * 64 * T; vstride = T; qcol = PC_NQ + g * 256; }
        bf16x8 Bq[NQ][2];
#pragma unroll
        for (int qd = 0; qd < NQ; ++qd) { const bf16_t* qp = proj + (size_t)(tw0 + 4 * qd + (n >> 2)) * PLD + qcol + hr * 64 + 8 * q;
            Bq[qd][0] = *(const bf16x8*)qp; Bq[qd][1] = *(const bf16x8*)(qp + 32); }
        const float bfar = biasd[hr * 1024 + 1023];
        float mrun[NQ], lrun[NQ]; f32x4 O[NQ][4];
#pragma unroll
        for (int qd = 0; qd < NQ; ++qd) { mrun[qd] = -1e30f; lrun[qd] = 0.f;
#pragma unroll
            for (int dt = 0; dt < 4; ++dt) O[qd][dt] = (f32x4){0.f, 0.f, 0.f, 0.f}; }
        float carry3[NQ]; for (int i = 0; i < NQ; ++i) carry3[i] = 0.f;
        const int npass = (MODE == 2) ? 2 : 1;
        for (int pass = 0; pass < npass; ++pass) {
            const bool do_pv = (MODE != 2) || pass == 1;
            float linv[NQ];
            if (MODE == 2 && pass == 1) {
#pragma unroll
                for (int qd = 0; qd < NQ; ++qd) { float mt = mrun[qd]; mt = fmaxf(mt, __shfl_xor(mt, 16)); mt = fmaxf(mt, __shfl_xor(mt, 32));
                    float lt = lrun[qd] * __expf(mrun[qd] - mt); lt += __shfl_xor(lt, 16); lt += __shfl_xor(lt, 32); mrun[qd] = mt; linv[qd] = lt > 0.f ? 1.0f / lt : 0.f; }
            }
#define AT_TILEPOS(ti) ((MODE == 3) ? list[ti] * 64 : (MODE == 2 ? (ti) * 64 : tile_lo + (ti) * 64))
#define AT_ISSUE(rd) do { _Pragma("unroll") for (int i_ = 0; i_ < TS; ++i_) { const int ti_ = (rd) * TS + i_; p0n[i_] = ti_ < ntiles ? AT_TILEPOS(ti_) : -1; \
        if (p0n[i_] >= 0) { kreg[i_] = *(const u32x4*)(Ksrc + (size_t)(p0n[i_] + (c.tid >> 3)) * kstride + (c.tid & 7) * 8); \
            if (do_pv) vreg[i_] = *(const u32x4*)(Vsrc + (size_t)(c.tid >> 3) * vstride + p0n[i_] + (c.tid & 7) * 8); } } } while (0)
            u32x4 kreg[TS], vreg[TS]; int p0n[TS];
            const int nrounds = (ntiles + TS - 1) / TS;
            if (nrounds > 0) AT_ISSUE(0);
            for (int rd = 0; rd < nrounds; ++rd) {
                int p0s[TS];
#pragma unroll
                for (int i = 0; i < TS; ++i) p0s[i] = p0n[i];
                __syncthreads();
#pragma unroll
                for (int i = 0; i < TS; ++i) if (p0s[i] >= 0) { *(LAS u32x4*)(L + AT_K + i * 18432 + (c.tid >> 3) * 144 + (c.tid & 7) * 16) = kreg[i];
                    if (do_pv) *(LAS u32x4*)(L + AT_V + i * 18432 + (c.tid >> 3) * 144 + (c.tid & 7) * 16) = vreg[i]; }
                if (rd + 1 < nrounds) AT_ISSUE(rd + 1);
                __syncthreads();
#pragma unroll
              for (int ts = 0; ts < TS; ++ts) {
                const int p0 = p0s[ts]; const int LK = AT_K + ts * 18432, LV = AT_V + ts * 18432;
                if (p0 < 0) continue;
                if (MODE == 0) { if (p0 > tw0 + TW - 1 || p0 + 63 < tw0 - 127) continue; }
                if (MODE == 1) { if (p0 > tw0 + TW - 1 || p0 + 63 < tw0 - 511) continue; }
                if (MODE == 2) { if (16 * p0 + 31 > tw0 + TW - 1) continue; }
                if (MODE == 3) { if (p0 > tw0 + TW - 1) continue; }
                const bool far = (MODE == 2) ? (tw0 - (16 * (p0 + 63) + 31) >= 790) : ((MODE == 3) ? (tw0 - (p0 + 63) >= 790) : false);
                const int jblk = p0 >> 6;
                bf16x8 akf[4][2]; bf16x8 avf[2][4];
                if (MODE != 3) {
#pragma unroll
                    for (int kt = 0; kt < 4; ++kt)
#pragma unroll
                        for (int ks = 0; ks < 2; ++ks) akf[kt][ks] = *(const LAS bf16x8*)(L + LK + (16 * kt + n) * 144 + (32 * ks + 8 * q) * 2);
                    if (do_pv) {
#pragma unroll
                        for (int st = 0; st < 2; ++st)
#pragma unroll
                            for (int dt = 0; dt < 4; ++dt) { const LAS unsigned char* vp = L + LV + (16 * dt + n) * 144 + (32 * st + 4 * q) * 2;
                                const u32x2 v0 = *(const LAS u32x2*)vp, v1 = *(const LAS u32x2*)(vp + 32); u32x4 vw; vw.x = v0.x; vw.y = v0.y; vw.z = v1.x; vw.w = v1.y; avf[st][dt] = __builtin_bit_cast(bf16x8, vw); } }
                }
                unsigned tokmask = 0u;
                if (MODE == 3) { tokmask = (unsigned)__ballot(lane < TW && ((selm[(wave * TW + (lane & (TW - 1))) * 8 + (jblk >> 5)] >> (jblk & 31)) & 1u)); if (tokmask == 0u) continue; }
#pragma unroll
                for (int qd = 0; qd < NQ; ++qd) {
                    const int tq = tw0 + 4 * qd + (n >> 2);
                    if (DBG == 3) continue;
                    bool colsel = true;
                    if (MODE == 3) { colsel = (tokmask >> (4 * qd + (n >> 2))) & 1u; if (((tokmask >> (4 * qd)) & 0xfu) == 0u) continue; }
                    {
                        f32x4 sc[4];
#pragma unroll
                        for (int kt = 0; kt < 4; ++kt) { sc[kt] = (f32x4){0.f, 0.f, 0.f, 0.f};
#pragma unroll
                            for (int ks = 0; ks < 2; ++ks) { const bf16x8 ak = (MODE != 3) ? akf[kt][ks] : *(const LAS bf16x8*)(L + LK + (16 * kt + n) * 144 + (32 * ks + 8 * q) * 2);
                                sc[kt] = __builtin_amdgcn_mfma_f32_16x16x32_bf16(ak, Bq[qd][ks], sc[kt], 0, 0, 0); } }
                        float mx = -1e30f;
                        if (far) {
#pragma unroll
                            for (int kt = 0; kt < 4; ++kt)
#pragma unroll
                                for (int r = 0; r < 4; ++r) { const float s2 = (MODE == 3 && !colsel) ? -1e30f : sc[kt][r] + bfar; sc[kt][r] = s2; mx = fmaxf(mx, s2); }
                        } else {
#pragma unroll
                        for (int kt = 0; kt < 4; ++kt)
#pragma unroll
                            for (int r = 0; r < 4; ++r) { const int kl = 16 * kt + 4 * q + r; int dist; bool v;
                                if (MODE == 2) { dist = tq - (16 * (p0 + kl) + 31); v = dist >= 0; }
                                else { dist = tq - (p0 + kl); v = dist >= 0; if (MODE == 0) v = v && dist < 128; if (MODE == 1) v = v && dist < 512; if (MODE == 3) v = v && colsel; }
                                const int di = dist < 0 ? 0 : (dist > 1023 ? 1023 : dist);
                                const float s2 = v ? sc[kt][r] + biasd[hr * 1024 + di] : -1e30f; sc[kt][r] = s2; mx = fmaxf(mx, s2); }
                        }
                        float p[4][4];
                        if (MODE == 2 && pass == 1) {
#pragma unroll
                            for (int kt = 0; kt < 4; ++kt)
#pragma unroll
                                for (int r = 0; r < 4; ++r) p[kt][r] = __expf(sc[kt][r] - mrun[qd]) * linv[qd];
                        } else if (MODE == 2) {
                            const float mn = fmaxf(mrun[qd], mx), corr = __expf(mrun[qd] - mn); mrun[qd] = mn; float ps = 0.f;
                            const float mne = mn < -1e29f ? 0.f : mn;
#pragma unroll
                            for (int kt = 0; kt < 4; ++kt)
#pragma unroll
                                for (int r = 0; r < 4; ++r) ps += __expf(sc[kt][r] - mne);
                            lrun[qd] = lrun[qd] * corr + ps;
                        } else {
                            if (__any(mx > mrun[qd])) {
                                mx = fmaxf(mx, __shfl_xor(mx, 16)); mx = fmaxf(mx, __shfl_xor(mx, 32));
                                const float mn = fmaxf(mrun[qd], mx), corr = __expf(mrun[qd] - mn); mrun[qd] = mn;
                                lrun[qd] *= corr;
#pragma unroll
                                for (int dt = 0; dt < 4; ++dt) O[qd][dt] = O[qd][dt] * corr;
                            }
                            const float mne = mrun[qd] < -1e29f ? 0.f : mrun[qd]; float ps = 0.f;
#pragma unroll
                            for (int kt = 0; kt < 4; ++kt)
#pragma unroll
                                for (int r = 0; r < 4; ++r) { p[kt][r] = (DBG == 2) ? sc[kt][r] - mne : __expf(sc[kt][r] - mne); ps += p[kt][r]; }
                            lrun[qd] += ps;
                        }
                        if (MODE == 2 && pass == 1) {
                            float i3prev = carry3[qd];
#pragma unroll
                            for (int kt = 0; kt < 4; ++kt) { float im[4];
#pragma unroll
                                for (int r = 0; r < 4; ++r) { float v = p[kt][r]; v += dpp_xor1(v); v += dpp_xor2(v); im[r] = v; }
                                const float same = __shfl(im[3], (lane + 48) & 63), prevt = __shfl(i3prev, (lane + 48) & 63);
                                const float pv3 = q > 0 ? same : prevt;
                                const int jg = (p0 + 16 * kt + 4 * q) >> 2;
                                if (hr == 0 && jg < 256) sscore[(tq - t0) * 256 + jg] = 2.0f * (im[0] + im[1] + im[2]) + im[3] + pv3;
                                i3prev = im[3]; }
                            carry3[qd] = i3prev;
                        }
                        if (do_pv && DBG != 1) {
#pragma unroll
                            for (int st = 0; st < 2; ++st) {
                                u32x4 pw; pw.x = pk2(p[2 * st][0], p[2 * st][1]); pw.y = pk2(p[2 * st][2], p[2 * st][3]); pw.z = pk2(p[2 * st + 1][0], p[2 * st + 1][1]); pw.w = pk2(p[2 * st + 1][2], p[2 * st + 1][3]);
                                const bf16x8 pf = __builtin_bit_cast(bf16x8, pw);
#pragma unroll
                                for (int dt = 0; dt < 4; ++dt) { bf16x8 av;
                                    if (MODE != 3) av = avf[st][dt];
                                    else { const LAS unsigned char* vp = L + LV + (16 * dt + n) * 144 + (32 * st + 4 * q) * 2;
                                        const u32x2 v0 = *(const LAS u32x2*)vp, v1 = *(const LAS u32x2*)(vp + 32); u32x4 vw; vw.x = v0.x; vw.y = v0.y; vw.z = v1.x; vw.w = v1.y; av = __builtin_bit_cast(bf16x8, vw); }
                                    O[qd][dt] = __builtin_amdgcn_mfma_f32_16x16x32_bf16(av, pf, O[qd][dt], 0, 0, 0); } }
                        }
                    }
                }
              }
            }
        }
#undef AT_ISSUE
#undef AT_TILEPOS
        if (MODE == 2) {
            __syncthreads();
#pragma unroll 1
            for (int tk = 0; tk < TW; ++tk) { const int t = tw0 + tk, cur = t >> 6; const LAS float* sp = sscore + (wave * TW + tk) * 256;
                unsigned key[4]; bool forced[4];
#pragma unroll
                for (int jj = 0; jj < 4; ++jj) { const int j = lane + 64 * jj; forced[jj] = (j == 0 || j == cur || j == cur - 1);
                    key[jj] = (!forced[jj] && j < cur - 1) ? __float_as_uint(sp[j]) + 1u : 0u; }
                const int nforced = cur >= 2 ? 3 : cur + 1;
                unsigned prefix = 0u; int remaining = 16 - nforced;
#pragma unroll 1
                for (int bit = 30; bit >= 0; --bit) { const unsigned test = prefix | (1u << bit); int cnt = 0;
#pragma unroll
                    for (int jj = 0; jj < 4; ++jj) cnt += __popcll(__ballot((key[jj] >> bit) == (test >> bit)));
                    if (cnt >= remaining) prefix = test; else remaining -= cnt; }
                int eqbase = 0;
#pragma unroll
                for (int jj = 0; jj < 4; ++jj) { const bool eq = key[jj] == prefix && key[jj] != 0u; const unsigned long long eb = __ballot(eq);
                    const int eqrank = eqbase + __popcll(eb & ((1ull << lane) - 1ull)); eqbase += __popcll(eb);
                    const bool on = forced[jj] || key[jj] > prefix || (eq && eqrank < remaining); const unsigned long long bl = __ballot(on);
                    if (lane == 0) { unsigned* mp = selp((unsigned char*)sel, t, g); mp[2 * jj] = (unsigned)bl; mp[2 * jj + 1] = (unsigned)(bl >> 32); } }
            }
        }
#pragma unroll
        for (int qd = 0; qd < NQ; ++qd) {
            const int tq = tw0 + 4 * qd + (n >> 2), hh = g * 4 + hr;
            float scale;
            if (MODE == 2) scale = 1.0f;
            else { float lt = lrun[qd]; lt += __shfl_xor(lt, 16); lt += __shfl_xor(lt, 32);
                if (MODE == 0) { const float sink = inptr(c, I_SINK)[layer * 8 + hh]; const float mf = fmaxf(mrun[qd], sink), cr = __expf(mrun[qd] - mf); scale = cr / (lt * cr + __expf(sink - mf)); }
                else scale = lt > 0.f ? 1.0f / lt : 0.f; }
            if (MODE != 0) scale *= sigmoidf_(bf2f(proj[(size_t)tq * PLD + PC_GL + (MODE == 2 ? 0 : (MODE == 3 ? 8 : 16)) + hh]));
#pragma unroll
            for (int dt = 0; dt < 4; ++dt) { const f32x4 o = O[qd][dt] * scale; const int col = hh * 64 + 16 * dt + 4 * q;
                if (MODE == 0) { u32x2 w; w.x = pk2(o[0], o[1]); w.y = pk2(o[2], o[3]); *(u32x2*)(oout + (size_t)tq * 512 + col) = w; }
                else if (MODE == 2) *(f32x4*)(nsaacc + (size_t)tq * 512 + col) = o;
                else if (MODE == 1) { f32x4* ap = (f32x4*)(nsaacc + (size_t)tq * 512 + col); *ap = *ap + o; }
                else { const f32x4 t2 = *(const f32x4*)(nsaacc + (size_t)tq * 512 + col) + o; u32x2 w; w.x = pk2(t2[0], t2[1]); w.y = pk2(t2[2], t2[3]); *(u32x2*)(oout + (size_t)tq * 512 + col) = w; } }
        }
    }
}
#define wb ((bf16_t*)(ws + WS_WB))
#define xb ((bf16_t*)(ws + WS_XB))
#define cntp ((unsigned*)(ws + WS_CNT))
#define xres (args.out)
#define kcb ((bf16_t*)(ws + WS_KCB))
#define vctb ((bf16_t*)(ws + WS_VCT))
#define vtb ((bf16_t*)(ws + WS_VT))
#define scores ((float*)(ws + WS_SCORES))
#define sel ((unsigned*)ws)
#define ml ((float*)(ws + WS_ML))
#define hidb ((bf16_t*)(ws + WS_HID))
#define proj ((bf16_t*)(ws + WS_PROJ))
#define gates ((bf16_t*)(ws + WS_GATES))
#define merged ((bf16_t*)(ws + WS_MERGED))
#define tmpb ((bf16_t*)(ws + WS_TMPB))
#define alora ((bf16_t*)(ws + WS_ALORA))
#define rwu ((bf16_t*)(ws + WS_RWU))
#define rws ((bf16_t*)(ws + WS_RWS))
#define bonusg ((float*)(ws + WS_BONUS))
#define nsaacc ((float*)(ws + WS_NSAACC))
#define obuf ((bf16_t*)(ws + WS_O))
#define act ((bf16_t*)(ws + WS_ACT))
#define tmpf ((bf16_t*)(ws + WS_TMPF))
constexpr int PH_PER_BATCH = 8, PH_PER_LAYER = 1 + 2 * PH_PER_BATCH + 2, PH_TOTAL = 1 + DEPTH * PH_PER_LAYER;

__global__ void __launch_bounds__(512, 2) fwd_kernel(Args args) {
    extern __shared__ __attribute__((aligned(16))) unsigned char lds_raw[];
    Ctx c0; c0.lds = (LAS unsigned char*)lds_raw; c0.tid = threadIdx.x; c0.lane = c0.tid & 63; c0.wave = __builtin_amdgcn_readfirstlane(c0.tid >> 6); c0.G = gridDim.x; c0.bid = blockIdx.x; const Ctx& c = c0;
    unsigned char* ws = args.ws;
    volatile LAS unsigned* misc = (volatile LAS unsigned*)(c.lds + LDS_MISC);
    if (c.tid < 4) misc[c.tid] = 0u;
    if (c.tid < 30) { const unsigned long long pv = (unsigned long long)args.in[c.tid & 31]; misc[16 + 2 * c.tid] = (unsigned)pv; misc[17 + 2 * c.tid] = (unsigned)(pv >> 32); }
    __syncthreads();
    XcdBarrier bar; bar.bar = (unsigned*)(ws + WS_CTL); bar.x = 0; bar.st = misc;
    const int lo = args.lo, hi = args.hi;
    const bool multi = (hi - lo) > 1;
    if (multi) bar = xcd_barrier_post((unsigned*)(ws + WS_CTL), misc);
    int gp = 0;
#ifndef ONLY_PH
#define ONLY_PH -1
#endif
#ifndef PHMASK
#define PHMASK 0xffffff
#endif
#ifndef REPMASK
#define REPMASK 0
#endif
#ifndef PR_SEL
#define PR_SEL 0
#endif
#ifndef PR_SWA
#define PR_SWA 0
#endif
#ifndef PR_CMP
#define PR_CMP 0
#endif
#ifndef PR_CHUNK
#define PR_CHUNK 0
#endif
#define PHASE_BEGIN(id) if (gp >= lo && gp < hi) { for (int rep_ = 0; rep_ < (((REPMASK >> (id)) & 1) ? 2 : 1); ++rep_) { if (rep_) __syncthreads(); \
    Ctx pc = c0; asm volatile("" : "+v"(pc.tid), "+s"(pc.bid)); pc.lane = pc.tid & 63; pc.wave = __builtin_amdgcn_readfirstlane(pc.tid >> 6); const Ctx& c = pc;
#define PHASE_END   } if (gp + 1 < hi) xcd_barrier(bar); } ++gp;
#define RELAUNDER() do { asm volatile("" : "+v"(pc.tid), "+s"(pc.bid)); pc.lane = pc.tid & 63; pc.wave = __builtin_amdgcn_readfirstlane(pc.tid >> 6); } while (0)

    PHASE_BEGIN(0) phase_init(c, inptr(c, I_X), xres, xb, ws); PHASE_END

    for (int layer = 0; layer < DEPTH; ++layer) {
        PHASE_BEGIN(1) phase_cvt(c, args, layer, wb); PHASE_END
        for (int b = 0; b < NBATCH; ++b) {
            const int row0 = b * T;
            PHASE_BEGIN(2) {
                pg8::Gemm g{xb + (size_t)row0 * D, wb + WB_WIN, D, D, D}; pg8::Sched S; S.init(T / 256, NIN / 256, c.G, c.bid, 1, (size_t)256 * D * 2, 0, (size_t)256 * D * 2, 0);
                pg8::EpiInProj E{proj, gates, ws, row0}; pg8::gemm_phase(c.lds, c.tid, g, S, E); } PHASE_END
            PHASE_BEGIN(16) {
                { pg8::Gemm g{proj, wb + WB_W1T, 16 * PLD, 2048, 2048, (unsigned)PLD * 2}; pg8::Sched S; S.init(16, 1, c.G, c.bid, 1, 0, 0, 0, 0); S.mode = 1;
                  pg8::EpiCmp1 E{hidb, (const float*)(wb + WB_BH)}; pg8::gemm_phase(c.lds, c.tid, g, S, E); }
                RELAUNDER();
                if (c.bid >= 16) { Ctx cv = c; cv.bid = c.bid - 16; cv.G = c.G - 16; phase_lora_a(cv, args, layer, proj, alora); vt_transpose(cv, proj, vtb); } } PHASE_END
            PHASE_BEGIN(17) {
                { pg8::Gemm g{alora, wb + WB_LORA, 256, 256, 256}; pg8::Sched S; S.init(T / 256, 6, c.G, c.bid, 1, (unsigned)256 * 256 * 2, 0, (unsigned)256 * 256 * 2, 0);
                  pg8::EpiLora E{obuf}; pg8::gemm_phase(c.lds, c.tid, g, S, E); }
                RELAUNDER();
                { pg8::Gemm g{hidb, wb + WB_W2T, 256, 256, 256}; pg8::Sched S; S.init(16, 1, c.G, (c.bid + 16) % c.G, 1, (unsigned)256 * 256 * 2, 0, 0, 0); S.mode = 2;
                  pg8::EpiCmp2 E{kcb, vctb}; pg8::gemm_phase(c.lds, c.tid, g, S, E); } } PHASE_END
            PHASE_BEGIN(18) {
                for (int pr_ = 0; pr_ <= PR_CHUNK; ++pr_) { phase_rwkv_chunk(c, args, layer, proj, obuf + (size_t)T * 512, obuf + (size_t)2 * T * 512, rwu, bonusg);
                __syncthreads(); RELAUNDER(); }
                for (int pr_ = 0; pr_ <= PR_CMP; ++pr_) { phase_attn<2, 2>(c, args, layer, proj, vtb, kcb, vctb, sel, nsaacc, obuf + (size_t)T * 512); __syncthreads(); } } PHASE_END
            PHASE_BEGIN(19) {
                phase_rwkv_scan<0>(c, rwu, rws);
                RELAUNDER();
                if (c.bid >= 32) { Ctx cv = c; cv.bid = c.bid - 32; cv.G = c.G - 32;
                    phase_attn<1, 2>(cv, args, layer, proj, vtb, kcb, vctb, sel, nsaacc, obuf + (size_t)T * 512);
                    asm volatile("" : "+v"(cv.tid), "+s"(cv.bid)); cv.lane = cv.tid & 63; cv.wave = __builtin_amdgcn_readfirstlane(cv.tid >> 6);
                    for (int pr_ = 0; pr_ <= PR_SWA; ++pr_) { phase_attn<0, 2>(cv, args, layer, proj, vtb, kcb, vctb, sel, nsaacc, obuf + (size_t)2 * T * 512); __syncthreads(); } } } PHASE_END
            PHASE_BEGIN(9) {
                phase_rwkv_out(c, args, layer, proj, rwu, rws, bonusg, obuf);
                __syncthreads(); RELAUNDER();
                #if PR_SEL > 1
                { phase_attn<3, 2, PR_SEL - 1>(c, args, layer, proj, vtb, kcb, vctb, sel, nsaacc, obuf + (size_t)T * 512); __syncthreads(); }
#endif
                for (int pr_ = 0; pr_ <= (PR_SEL == 1 ? 1 : 0); ++pr_) { phase_attn<3, 2>(c, args, layer, proj, vtb, kcb, vctb, sel, nsaacc, obuf + (size_t)T * 512); __syncthreads(); } } PHASE_END
            PHASE_BEGIN(10) {
                pg8::Gemm g{obuf, wb + WB_WBR, 512, 512, 512}; pg8::Sched S; S.init(T / 256, D / 256, c.G, c.bid, 3, (size_t)256 * 512 * 2, (size_t)T * 512 * 2, (size_t)256 * 512 * 2, (size_t)D * 512 * 2);
                pg8::EpiMerge E{gates, merged}; pg8::gemm_phase(c.lds, c.tid, g, S, E); } PHASE_END
            PHASE_BEGIN(11) {
                pg8::Gemm g{merged, wb + WB_WOUT, D, D, D}; pg8::Sched S; S.init(T / 256, D / 256, c.G, c.bid, 1, (unsigned)256 * D * 2, 0, (unsigned)256 * D * 2, 0);
                pg8::EpiNorm E{xres, xb, inptr(c, I_NQM) + layer * D, ws, cntp, row0, 1, 16u * (2u * layer + 1u), c.lds, c.tid}; pg8::gemm_phase(c.lds, c.tid, g, S, E); } PHASE_END
        }
        PHASE_BEGIN(13) {
            pg8::Gemm g{xb, wb + WB_WGU, D, D, D}; pg8::Sched S; S.init(MROWS / 256, 2 * FFN / 256, c.G, c.bid, 1, (size_t)256 * D * 2, 0, (size_t)256 * D * 2, 0);
            pg8::EpiSwiGLU E{act, ws}; pg8::gemm_phase(c.lds, c.tid, g, S, E); } PHASE_END
        PHASE_BEGIN(14) {
            { pg8::Gemm g{act, wb + WB_WDN, FFN, FFN, FFN}; pg8::Sched S; S.init(T / 256, D / 256, c.G, c.bid, 1, (unsigned)256 * FFN * 2, 0, (unsigned)256 * FFN * 2, 0);
              pg8::EpiNorm E{xres, xb, inptr(c, I_NQF) + layer * D, ws, cntp, 0, 0, 16u * (2u * layer + 2u), c.lds, c.tid}; pg8::gemm_phase(c.lds, c.tid, g, S, E); }
            __syncthreads(); RELAUNDER();
            { pg8::Gemm g{act + (size_t)T * FFN, wb + WB_WDN, FFN, FFN, FFN}; pg8::Sched S; S.init(T / 256, D / 256, c.G, c.bid, 1, (unsigned)256 * FFN * 2, 0, (unsigned)256 * FFN * 2, 0);
              pg8::EpiNorm E{xres, xb, inptr(c, I_NQF) + layer * D, ws, cntp, T, 0, 16u * (2u * layer + 2u), c.lds, c.tid}; pg8::gemm_phase(c.lds, c.tid, g, S, E); } } PHASE_END
    }
#undef PHASE_BEGIN
#undef PHASE_END
}

extern "C" void kernel_launch(void* const* d_in, const int* in_sizes, int n_in, void* d_out, int out_size, void* d_ws, size_t ws_size, hipStream_t stream) {
    static int grid = 0;
    if (grid == 0) {
        if (n_in != 30 || out_size != MROWS * D || ws_size < WS_END) { fprintf(stderr, "kernel_launch: unexpected shapes (n_in %d out %d ws %zu)\n", n_in, out_size, ws_size); grid = -1; return; }
        int dev = 0, cus = 0;
        if (hipGetDevice(&dev) != hipSuccess || hipDeviceGetAttribute(&cus, hipDeviceAttributeMultiprocessorCount, dev) != hipSuccess) { grid = -1; return; }
        if (hipFuncSetAttribute((const void*)fwd_kernel, hipFuncAttributeMaxDynamicSharedMemorySize, LDS_BYTES) != hipSuccess) { fprintf(stderr, "hipFuncSetAttribute failed\n"); grid = -1; return; }
        int per_cu = 0;
        if (hipOccupancyMaxActiveBlocksPerMultiprocessor(&per_cu, (const void*)fwd_kernel, 512, LDS_BYTES) != hipSuccess || per_cu < 1) { fprintf(stderr, "occupancy query: %d\n", per_cu); }
        (void)hipGetLastError();
        grid = cus;
    }
    if (grid < 0) return;
    (void)hipMemsetAsync((char*)d_ws + WS_CTL, 0, CTL_BYTES, stream);
    Args a{};
    for (int i = 0; i < 30; ++i) a.in[i] = (const float*)d_in[i];
    a.out = (float*)d_out; a.ws = (unsigned char*)d_ws;
#if MK_ONE_LAUNCH
    a.lo = 0; a.hi = PH_TOTAL;
    hipLaunchKernelGGL(fwd_kernel, dim3(grid), dim3(512), LDS_BYTES, stream, a);
#else
    for (int p = 0; p < PH_TOTAL; ++p) { a.lo = p; a.hi = p + 1; hipLaunchKernelGGL(fwd_kernel, dim3(grid), dim3(512), LDS_BYTES, stream, a); }
#endif
}
```

```cpp
#include <hip/hip_runtime.h>
#include <stdint.h>
#include <stdio.h>

#ifndef MK_ONE_LAUNCH
#define MK_ONE_LAUNCH 1
#endif

#define LAS __attribute__((address_space(3)))
typedef unsigned short bf16_t;
typedef short bf16x8 __attribute__((ext_vector_type(8)));
typedef float f32x4 __attribute__((ext_vector_type(4)));
typedef float f32x2 __attribute__((ext_vector_type(2)));
typedef unsigned u32x4 __attribute__((ext_vector_type(4)));
typedef unsigned u32x2 __attribute__((ext_vector_type(2)));

constexpr int D = 1024, NBATCH = 2, T = 16384, DEPTH = 4, MROWS = NBATCH * T;
constexpr int IN_COLS = 6936, FFN = 2816;
constexpr int PLD = 4096;
constexpr int PC_R = 0, PC_K = 512, PC_V = 1024, PC_ZW = 1536, PC_ZA = 1600, PC_ZG = 1664;
constexpr int PC_NQ = 1792, PC_KC = 2304, PC_VC = 2432, PC_KS = 2560, PC_VS = 2688, PC_KW = 2816, PC_VW = 2944, PC_GL = 3072;
constexpr int PC_SQ = 3328, PC_SK = 3840, PC_SV = 3968;
constexpr int NIN = 7168;
constexpr int NCMP = 1023;
constexpr float NORM_EPS = 1e-6f;

constexpr size_t MiB = 1u << 20;
constexpr size_t WS_CTL = 0, CTL_BYTES = 65536;
constexpr size_t WS_WB = 65536;
constexpr size_t WB_WIN = 0, WB_WBR = WB_WIN + (size_t)NIN * D, WB_WOUT = WB_WBR + (size_t)3 * D * 512, WB_WGU = WB_WOUT + (size_t)D * D,
                 WB_WDN = WB_WGU + (size_t)2 * FFN * D, WB_LORA = WB_WDN + (size_t)D * FFN, WB_W1T = WB_LORA + (size_t)1536 * 256, WB_W2T = WB_W1T + (size_t)2 * 256 * 2048,
                 WB_BH = WB_W2T + (size_t)2 * 256 * 256, WB_END = WB_BH + 1024;
static_assert(WS_WB + WB_END * 2 <= 38 * MiB + 786432, "weights");
constexpr size_t KiB = 1024;
constexpr size_t WS_XB = 38 * MiB + 768 * KiB;
constexpr size_t WS_CNT = 16384;
constexpr size_t WS_RS = WS_XB + 64 * MiB;
constexpr size_t WS_BONUS = WS_RS + 128 * KiB;
constexpr size_t WS_KCB = WS_BONUS + 512 * KiB;
constexpr size_t WS_VCT = WS_KCB + 256 * KiB;
constexpr size_t WS_STATS = WS_VCT + 256 * KiB;
constexpr size_t WS_SEL = WS_STATS;
constexpr size_t WS_HID = WS_SEL + 1 * MiB;
constexpr size_t WS_ML = WS_HID;
static_assert(WS_HID + 2 * MiB <= 107 * MiB, "small region");
constexpr size_t WS_ALORA = 107 * MiB;
constexpr size_t WS_VT = 115 * MiB;
constexpr size_t WS_BIG = 127 * MiB;
constexpr size_t WS_PROJ = WS_BIG;
constexpr size_t WS_GATES = WS_PROJ + 128 * MiB;
constexpr size_t WS_RWKVS = WS_GATES + 96 * MiB;
constexpr size_t WS_RWU = WS_RWKVS;
constexpr size_t WS_RWS = WS_RWKVS + 64 * MiB;
constexpr size_t WS_SCORES = WS_RWKVS;
constexpr size_t WS_MERGED = WS_RWKVS;
constexpr size_t WS_TMPB = WS_RWKVS + 32 * MiB;
constexpr size_t WS_NSAACC = WS_RWKVS + 80 * MiB;
constexpr size_t WS_O = WS_NSAACC + 32 * MiB;
constexpr size_t WS_END = WS_O + 48 * MiB;
constexpr size_t WS_ACT = WS_BIG;
constexpr size_t WS_TMPF = WS_BIG + 176 * MiB;
static_assert(WS_END <= 512 * MiB, "workspace");
static_assert(WS_TMPF + 64 * MiB <= WS_NSAACC, "ffn overlay");

constexpr int LDS_BYTES = 147456;
constexpr int LDS_MISC = 131072 + 8192;

__device__ __forceinline__ float* statp(unsigned char* ws, int row, int kind) {
    return (float*)(ws + WS_STATS + (kind >= 2 ? 524288 : 0)) + (size_t)row * 4; }
__device__ __forceinline__ unsigned* selp(unsigned char* ws, int t, int g) { return (unsigned*)(ws + WS_PROJ + (size_t)t * (PLD * 2) + 6272 + g * 32); }
__device__ __forceinline__ float bf2f(unsigned v) { return __uint_as_float(v << 16); }
typedef __bf16 bf16n2 __attribute__((ext_vector_type(2)));
__device__ __forceinline__ unsigned pk2(float lo, float hi) { const f32x2 f = {lo, hi}; const bf16n2 v = __builtin_convertvector(f, bf16n2); return __builtin_bit_cast(unsigned, v); }
__device__ __forceinline__ unsigned f2bf(float f) { return pk2(f, 0.f) & 0xffffu; }
__device__ __forceinline__ void unpack8(const u32x4 w, float (&f)[8]) {
    f[0] = __uint_as_float(w.x << 16); f[1] = __uint_as_float(w.x & 0xffff0000u); f[2] = __uint_as_float(w.y << 16); f[3] = __uint_as_float(w.y & 0xffff0000u);
    f[4] = __uint_as_float(w.z << 16); f[5] = __uint_as_float(w.z & 0xffff0000u); f[6] = __uint_as_float(w.w << 16); f[7] = __uint_as_float(w.w & 0xffff0000u);
}
#define DPPF(v, ctrl) __int_as_float(__builtin_amdgcn_update_dpp(0, __float_as_int(v), (ctrl), 0xf, 0xf, false))
__device__ __forceinline__ float row16_sum(float v) {
    v += DPPF(v, 0xB1); v += DPPF(v, 0x4E); v += DPPF(v, 0x141); v += DPPF(v, 0x140); return v;
}
__device__ __forceinline__ float wave_sum(float v) {
    v = row16_sum(v);
    const int iv = __float_as_int(v);
    return (__int_as_float(__builtin_amdgcn_readlane(iv, 0)) + __int_as_float(__builtin_amdgcn_readlane(iv, 16))) + (__int_as_float(__builtin_amdgcn_readlane(iv, 32)) + __int_as_float(__builtin_amdgcn_readlane(iv, 48)));
}
__device__ __forceinline__ float dpp_xor1(float v) { return __int_as_float(__builtin_amdgcn_update_dpp(0, __float_as_int(v), 0xB1, 0xf, 0xf, false)); }
__device__ __forceinline__ float dpp_xor2(float v) { return __int_as_float(__builtin_amdgcn_update_dpp(0, __float_as_int(v), 0x4E, 0xf, 0xf, false)); }
__device__ __forceinline__ float sigmoidf_(float x) { return __builtin_amdgcn_rcpf(1.0f + __expf(-x)); }
__device__ __forceinline__ int t5_bucket(int n) {
    if (n < 16) return n;
    int b = 16;
    b += (n >= 21); b += (n >= 27); b += (n >= 35); b += (n >= 46); b += (n >= 59); b += (n >= 77); b += (n >= 99); b += (n >= 128);
    b += (n >= 166); b += (n >= 216); b += (n >= 280); b += (n >= 363); b += (n >= 470); b += (n >= 609); b += (n >= 790);
    return b;
}

#define XB_TMO      128
#define XB_XCNT(j)  (256  + 64 * (j))
#define XB_XSUB(j)  (1280 + 64 * (j))
#define XB_XGEN(j)  (2304 + 64 * (j))
#define XB_TOP      3328
#define XB_TOPGEN   3392
#define XCD_BAR_WORDS 3456
#define XB_SPIN_CAP (1u << 22)
__device__ __forceinline__ unsigned xb_ld(unsigned* p)              { return __hip_atomic_load(p, __ATOMIC_RELAXED, __HIP_MEMORY_SCOPE_AGENT); }
__device__ __forceinline__ unsigned xb_add(unsigned* p, unsigned v) { return __hip_atomic_fetch_add(p, v, __ATOMIC_RELAXED, __HIP_MEMORY_SCOPE_AGENT); }
__device__ __forceinline__ unsigned xb_xcc_id() { return (unsigned)__builtin_amdgcn_s_getreg((3 << 11) | 20) & 0xFu; }
#define XB_SPIN(cond, bar) do { unsigned _sp = 0; while (cond) { __builtin_amdgcn_s_sleep(1); \
    if ((++_sp & 255u) == 0u) { if (xb_ld(&(bar)[XB_TMO])) break; if (_sp > XB_SPIN_CAP) { atomicAdd(&(bar)[XB_TMO], 1u); break; } } } } while (0)
struct XcdBarrier { unsigned* bar; unsigned x; volatile LAS unsigned* st; };
__device__ __forceinline__ XcdBarrier xcd_barrier_post(unsigned* bar, volatile LAS unsigned* st) {
    XcdBarrier b; b.bar = bar; b.x = xb_xcc_id(); b.st = st;
    if (threadIdx.x == 0) (void)xb_add(&bar[XB_XCNT(b.x)], 1u);
    return b;
}
__device__ __forceinline__ void xcd_barrier_complete(unsigned* bar, unsigned x, unsigned& nloc, unsigned& nx) {
    const unsigned G = gridDim.x * gridDim.y * gridDim.z;
    unsigned sum, cnt, mine, sp = 0u;
    for (;;) {
        sum = 0u; cnt = 0u; mine = 0u;
#pragma unroll
        for (unsigned j = 0; j < 16; ++j) { const unsigned c = xb_ld(&bar[XB_XCNT(j)]); sum += c; cnt += (c > 0u) ? 1u : 0u; mine = (j == x) ? c : mine; }
        if (sum == G) break;
        __builtin_amdgcn_s_sleep(1);
        if ((++sp & 255u) == 0u) { if (xb_ld(&bar[XB_TMO])) break; if (sp > XB_SPIN_CAP) { atomicAdd(&bar[XB_TMO], 1u); break; } }
    }
    nloc = mine > 0u ? mine : 1u; nx = cnt > 0u ? cnt : 1u;
}
__device__ __forceinline__ void xcd_barrier(const XcdBarrier& b) {
    asm volatile("s_waitcnt vmcnt(0)" ::: "memory");
    __syncthreads();
    if (threadIdx.x == 0) {
        unsigned* bar = b.bar;
        __builtin_amdgcn_s_waitcnt(0);
        unsigned nloc = b.st[0], nx = b.st[1];
        if (nloc == 0u) { xcd_barrier_complete(bar, b.x, nloc, nx); b.st[0] = nloc; b.st[1] = nx; }
        const unsigned old = xb_add(&bar[XB_XSUB(b.x)], 1u);
        const unsigned gen = old / nloc;
        if (old + 1u == (gen + 1u) * nloc) {
            __builtin_amdgcn_fence(__ATOMIC_RELEASE, "agent");
            asm volatile("s_waitcnt vmcnt(0)" ::: "memory");
            const unsigned og = xb_add(&bar[XB_TOP], 1u);
            const unsigned tg = og / nx;
            if (og + 1u == (tg + 1u) * nx) xb_add(&bar[XB_TOPGEN], 1u);
            else XB_SPIN(xb_ld(&bar[XB_TOPGEN]) == tg, bar);
            __builtin_amdgcn_fence(__ATOMIC_ACQUIRE, "agent");
            xb_add(&bar[XB_XGEN(b.x)], 1u);
            asm volatile("s_waitcnt vmcnt(0)" ::: "memory");
        } else {
            XB_SPIN(xb_ld(&bar[XB_XGEN(b.x)]) == gen, bar);
            __builtin_amdgcn_fence(__ATOMIC_ACQUIRE, "agent");
            asm volatile("s_waitcnt vmcnt(0)" ::: "memory");
        }
    }
    __syncthreads();
}

namespace pg8 {
constexpr int BM = 256, BK = 64, HALF = 128, HTB = HALF * BK * 2, STAGE_BYTES = 8 * HTB, NXCD = 8, WGM = 8;
__device__ __forceinline__ int lds_byte(int r, int c) { const int st = (r >> 4) * 2 + (c >> 5), rr = r & 15, cc = c & 31, ob = rr * 64 + cc * 2; return st * 1024 + (ob ^ (((ob >> 9) & 1) << 5)); }
__device__ __forceinline__ void stage_rc(int b, int& R, int& C) { const int st = b / 1024, sb = b % 1024, swz = sb ^ (((sb >> 9) & 1) << 5); R = (st >> 1) * 16 + swz / 64; C = (st & 1) * 32 + (swz % 64) / 2; }
__device__ __forceinline__ int perm32(int rho) { const int n = rho >> 4, i = rho & 15; return 8 * (i >> 2) + 4 * n + (i & 3); }

template <class E, class = void> struct epi_after_drain { static constexpr bool value = false; };
template <class E> struct epi_after_drain<E, decltype((void)E::AFTER_DRAIN)> { static constexpr bool value = E::AFTER_DRAIN; };
struct Unit { int pm, pn, sub; unsigned aoff, boff; };
struct Gemm { const bf16_t* A; const bf16_t* Bt; int lda, ldb, K; unsigned kstepA = 128; };
struct Sched {
    int nM, nN, nwg, G, c, nsub, mode = 0; unsigned a_row, a_sub, b_row, b_sub;
    __device__ __forceinline__ void init(int nM_, int nN_, int G_, int c_, int nsub_, unsigned a_row_, unsigned a_sub_, unsigned b_row_, unsigned b_sub_) {
        nM = nM_; nN = nN_; nwg = nM * nN; G = G_; c = c_; nsub = nsub_; a_row = a_row_; a_sub = a_sub_; b_row = b_row_; b_sub = b_sub_; }
    __device__ __forceinline__ bool next(int i, Unit& u) const {
        const int round = i / nsub; u.sub = i - round * nsub;
        const long L = (long)round * G + c; if (L >= nwg) return false;
        int wgid = (int)L; { const int q = nwg / NXCD, r = nwg % NXCD, xcd = wgid % NXCD, off = wgid / NXCD; wgid = (xcd < r ? xcd * (q + 1) : r * (q + 1) + (xcd - r) * q) + off; }
        const int nig = WGM * nN, gid = wgid / nig, fm = gid * WGM, gsz = (nM - fm) < WGM ? (nM - fm) : WGM;
        u.pm = fm + ((wgid % nig) % gsz); u.pn = (wgid % nig) / gsz;
        u.aoff = (unsigned)u.pm * a_row + (unsigned)u.sub * a_sub; u.boff = (unsigned)u.pn * b_row + (unsigned)u.sub * b_sub;
        if (mode == 1) { const int kv = u.pm >> 3, g = (u.pm >> 2) & 1, cp = u.pm & 3;
            u.aoff = (unsigned)(((size_t)cp * 256 * 16 * PLD + (kv ? PC_VC : PC_KC) + g * 64) * 2); u.boff = (unsigned)kv * (256u * 2048u * 2u); }
        if (mode == 2) { const int kv = u.pm >> 3; u.boff = (unsigned)kv * (256u * 256u * 2u); }
        return true;
    }
};

template <class Epi>
__device__ __forceinline__ void gemm_phase(LAS unsigned char* lds, const int tid, const Gemm g, const Sched& S, const Epi& E) {
    const int wid = __builtin_amdgcn_readfirstlane(tid >> 6), lane = tid & 63, wr = wid >> 2, wc = wid & 3, fr = lane & 15, fq = lane >> 4;
    const int K = g.K, nt = K / BK;
    unsigned voffA[2], voffB[2];
#pragma unroll
    for (int i = 0; i < 2; ++i) { int R, C; stage_rc(tid * 16 + i * 8192, R, C); const int Rb = Epi::PERM ? ((R & ~31) + perm32(R & 31)) : R;
        voffA[i] = (unsigned)(R * g.lda + C) * 2u; voffB[i] = (unsigned)(Rb * g.ldb + C) * 2u; }
    const size_t kstep = (size_t)(BK * 2), kstA = g.kstepA;
    const size_t hstepA = (size_t)HALF * g.lda * 2, hstepB = (size_t)HALF * g.ldb * 2;
    const unsigned ldsw = (unsigned)wid * 1024u;
    const int aoff = lds_byte(wr * 64 + fr, fq * 8), boff = lds_byte(wc * 32 + fr, fq * 8);
#define PG8_SA(b, h) (((b) * 2 + (h)) * HTB)
#define PG8_SB(b, h) ((4 + (b) * 2 + (h)) * HTB)
#define PG8_STAGE(bufoff, gbase, voff) do { _Pragma("unroll") for (int _i = 0; _i < 2; ++_i) \
        __builtin_amdgcn_global_load_lds((const unsigned*)((const char*)(gbase) + (voff)[_i]), (LAS unsigned*)(lds + (bufoff) + ldsw + _i * 8192), 16, 0, 0); } while (0)
#define PG8_LDA(dst, b, h) do { _Pragma("unroll") for (int m = 0; m < 4; ++m) _Pragma("unroll") for (int k = 0; k < 2; ++k) dst[m][k] = *(const LAS bf16x8*)(lds + PG8_SA(b, h) + aoff + m * 2048 + k * 1024); } while (0)
#define PG8_LDB(dst, b, h) do { _Pragma("unroll") for (int n = 0; n < 2; ++n) _Pragma("unroll") for (int k = 0; k < 2; ++k) dst[n][k] = *(const LAS bf16x8*)(lds + PG8_SB(b, h) + boff + n * 2048 + k * 1024); } while (0)
#define PG8_MMA(ai, bj, At, Bt) do { __builtin_amdgcn_s_setprio(1); _Pragma("unroll") for (int m = 0; m < 4; ++m) _Pragma("unroll") for (int n = 0; n < 2; ++n) _Pragma("unroll") for (int k = 0; k < 2; ++k) \
        acc[ai][bj][m][n] = __builtin_amdgcn_mfma_f32_16x16x32_bf16(Bt[n][k], At[m][k], acc[ai][bj][m][n], 0, 0, 0); __builtin_amdgcn_s_setprio(0); } while (0)
#define PG8_WAIT_V(n) asm volatile("s_waitcnt vmcnt(" #n ")" ::: "memory")
#define PG8_WAIT_L(n) asm volatile("s_waitcnt lgkmcnt(" #n ")" ::: "memory")
#define PG8_BAR __builtin_amdgcn_s_barrier()
#define PG8_SCHED __builtin_amdgcn_sched_barrier(0)
    Unit cur, nxt; int ui = 0;
    if (!S.next(0, cur)) return;
    f32x4 acc[2][2][4][2];
#pragma unroll
    for (int a = 0; a < 2; ++a)
#pragma unroll
        for (int b = 0; b < 2; ++b)
#pragma unroll
            for (int m = 0; m < 4; ++m)
#pragma unroll
                for (int n = 0; n < 2; ++n) acc[a][b][m][n] = (f32x4){0.f, 0.f, 0.f, 0.f};
    bf16x8 At[4][2], B0[2][2], B1[2][2];
    const char* cA = (const char*)g.A + cur.aoff; const char* cB = (const char*)g.Bt + cur.boff;
    PG8_STAGE(PG8_SB(0, 0), cB, voffB); PG8_STAGE(PG8_SA(0, 0), cA, voffA); PG8_STAGE(PG8_SB(0, 1), cB + hstepB, voffB); PG8_STAGE(PG8_SA(0, 1), cA + hstepA, voffA);
    if (wr == 1) PG8_BAR;
    PG8_WAIT_V(4); PG8_BAR;
    PG8_STAGE(PG8_SB(1, 0), cB + kstep, voffB); PG8_STAGE(PG8_SA(1, 0), cA + kstA, voffA); PG8_STAGE(PG8_SB(1, 1), cB + hstepB + kstep, voffB);
    PG8_WAIT_V(6); PG8_BAR;
    for (;;) {
        const bool has_next = S.next(ui + 1, nxt);
        const char* nA = has_next ? (const char*)g.A + nxt.aoff : cA; const char* nB = has_next ? (const char*)g.Bt + nxt.boff : cB;
        for (int t = 0; t < nt; t += 2) {
            const bool last = (t == nt - 2);
            const char* a1 = cA + (size_t)(t + 1) * kstA;
            const char* a2 = last ? nA : cA + (size_t)(t + 2) * kstA; const char* b2 = last ? nB : cB + (size_t)(t + 2) * kstep;
            const char* a3 = a2 + kstA; const char* b3 = b2 + kstep;
            PG8_LDB(B0, 0, 0); PG8_SCHED; PG8_LDA(At, 0, 0); PG8_STAGE(PG8_SA(1, 1), a1 + hstepA, voffA);
            PG8_WAIT_L(8); PG8_BAR; PG8_WAIT_L(0); PG8_MMA(0, 0, At, B0); PG8_BAR; PG8_SCHED;
            PG8_LDB(B1, 0, 1); PG8_STAGE(PG8_SB(0, 0), b2, voffB);
            PG8_BAR; PG8_WAIT_L(0); PG8_MMA(0, 1, At, B1); PG8_BAR;
            PG8_LDA(At, 0, 1); PG8_STAGE(PG8_SA(0, 0), a2, voffA);
            PG8_BAR; PG8_WAIT_L(0); PG8_MMA(1, 0, At, B0); PG8_BAR; PG8_SCHED;
            PG8_STAGE(PG8_SB(0, 1), b2 + hstepB, voffB);
            PG8_WAIT_V(6); PG8_BAR; PG8_MMA(1, 1, At, B1); PG8_BAR;
            PG8_LDB(B0, 1, 0); PG8_SCHED; PG8_LDA(At, 1, 0); PG8_STAGE(PG8_SA(0, 1), a2 + hstepA, voffA);
            PG8_WAIT_L(8); PG8_BAR; PG8_WAIT_L(0); PG8_MMA(0, 0, At, B0); PG8_BAR; PG8_SCHED;
            PG8_LDB(B1, 1, 1); PG8_STAGE(PG8_SB(1, 0), b3, voffB);
            PG8_BAR; PG8_WAIT_L(0); PG8_MMA(0, 1, At, B1); PG8_BAR;
            PG8_LDA(At, 1, 1); PG8_STAGE(PG8_SA(1, 0), a3, voffA);
            PG8_BAR; PG8_WAIT_L(0); PG8_MMA(1, 0, At, B0); PG8_BAR; PG8_SCHED;
            PG8_STAGE(PG8_SB(1, 1), b3 + hstepB, voffB);
            PG8_WAIT_V(6); PG8_BAR; PG8_MMA(1, 1, At, B1); PG8_BAR;
        }
        bool keep = false;
        if constexpr (!epi_after_drain<Epi>::value) keep = E(acc, cur, wr, wc, fr, fq);
        if (!has_next) break;
        if (!keep) {
#pragma unroll
            for (int a = 0; a < 2; ++a)
#pragma unroll
                for (int b = 0; b < 2; ++b)
#pragma unroll
                    for (int m = 0; m < 4; ++m)
#pragma unroll
                        for (int n = 0; n < 2; ++n) acc[a][b][m][n] = (f32x4){0.f, 0.f, 0.f, 0.f};
        }
        cur = nxt; cA = nA; cB = nB; ++ui;
    }
    PG8_WAIT_V(0);
    if (wr == 0) PG8_BAR;
    PG8_BAR;
    if constexpr (epi_after_drain<Epi>::value) (void)E(acc, cur, wr, wc, fr, fq);
#undef PG8_SA
#undef PG8_SB
#undef PG8_STAGE
#undef PG8_LDA
#undef PG8_LDB
#undef PG8_MMA
#undef PG8_WAIT_V
#undef PG8_WAIT_L
#undef PG8_BAR
#undef PG8_SCHED
}

struct EpiInProj {
    static constexpr bool PERM = true;
    bf16_t* proj; bf16_t* gates; unsigned char* ws; int row_base;
    __device__ __forceinline__ bool operator()(f32x4 (&acc)[2][2][4][2], const Unit& u, int wr, int wc, int fr, int fq) const {
        const int row0 = u.pm * BM + wr * 64 + fr; const bool is_gate = u.pn >= 16;
        bf16_t* base = is_gate ? gates + (u.pn - 16) * 256 : proj + u.pn * 256; const int ld = is_gate ? 3072 : PLD;
        const int col0 = wc * 32 + 8 * fq;
        float sv[2][4];
        { f32x4 pq[2][4];
#pragma unroll
          for (int ai = 0; ai < 2; ++ai)
#pragma unroll
            for (int m = 0; m < 4; ++m) pq[ai][m] = *(const f32x4*)statp(ws, row_base + row0 + ai * HALF + m * 16, 0);
#pragma unroll
          for (int ai = 0; ai < 2; ++ai)
#pragma unroll
            for (int m = 0; m < 4; ++m) sv[ai][m] = rsqrtf(((pq[ai][m][0] + pq[ai][m][1]) + (pq[ai][m][2] + pq[ai][m][3])) * (1.0f / D) + NORM_EPS); }
#pragma unroll
        for (int ai = 0; ai < 2; ++ai)
#pragma unroll
            for (int m = 0; m < 4; ++m) { const int row = row0 + ai * HALF + m * 16;
                const float s = sv[ai][m]; bf16_t* rowp = base + (size_t)row * ld + col0;
#pragma unroll
                for (int bj = 0; bj < 2; ++bj) { f32x4 v0 = acc[ai][bj][m][0] * s, v1 = acc[ai][bj][m][1] * s;
                    if (is_gate) {
#pragma unroll
                        for (int j = 0; j < 4; ++j) { v0[j] = sigmoidf_(v0[j]); v1[j] = sigmoidf_(v1[j]); } }
                    u32x4 w; w.x = pk2(v0[0], v0[1]); w.y = pk2(v0[2], v0[3]); w.z = pk2(v1[0], v1[1]); w.w = pk2(v1[2], v1[3]);
                    if (u.pn != 12 || col0 + bj * HALF < 64) *(u32x4*)(rowp + bj * HALF) = w; } }
        return false;
    }
};
struct EpiStore {
    static constexpr bool PERM = true;
    bf16_t* out; int ld;
    __device__ __forceinline__ bool operator()(f32x4 (&acc)[2][2][4][2], const Unit& u, int wr, int wc, int fr, int fq) const {
        const int row0 = u.pm * BM + wr * 64 + fr; const int col0 = u.pn * BM + wc * 32 + 8 * fq;
#pragma unroll
        for (int ai = 0; ai < 2; ++ai)
#pragma unroll
            for (int m = 0; m < 4; ++m) { bf16_t* rowp = out + (size_t)(row0 + ai * HALF + m * 16) * ld + col0;
#pragma unroll
                for (int bj = 0; bj < 2; ++bj) { const f32x4 v0 = acc[ai][bj][m][0], v1 = acc[ai][bj][m][1];
                    u32x4 w; w.x = pk2(v0[0], v0[1]); w.y = pk2(v0[2], v0[3]); w.z = pk2(v1[0], v1[1]); w.w = pk2(v1[2], v1[3]);
                    *(u32x4*)(rowp + bj * HALF) = w; } }
        return false;
    }
};
struct EpiCmp1 {
    static constexpr bool PERM = true;
    bf16_t* hid; const float* bh;
    __device__ __forceinline__ bool operator()(f32x4 (&acc)[2][2][4][2], const Unit& u, int wr, int wc, int fr, int fq) const {
        const int kv = u.pm >> 3; const int row0 = (u.pm & 7) * BM + wr * 64 + fr; const int col0 = wc * 32 + 8 * fq;
#pragma unroll
        for (int ai = 0; ai < 2; ++ai)
#pragma unroll
            for (int m = 0; m < 4; ++m) { bf16_t* rowp = hid + ((size_t)kv * 2048 + row0 + ai * HALF + m * 16) * 256 + col0;
#pragma unroll
                for (int bj = 0; bj < 2; ++bj) { float o[8];
#pragma unroll
                    for (int j = 0; j < 8; ++j) { const float x = acc[ai][bj][m][j >> 2][j & 3] + bh[kv * 256 + col0 + bj * HALF + j];
                        o[j] = x * sigmoidf_(1.5957691216f * (x + 0.044715f * x * x * x)); }
                    u32x4 w; w.x = pk2(o[0], o[1]); w.y = pk2(o[2], o[3]); w.z = pk2(o[4], o[5]); w.w = pk2(o[6], o[7]);
                    *(u32x4*)(rowp + bj * HALF) = w; } }
        return false;
    }
};
struct EpiCmp2 {
    static constexpr bool PERM = true;
    bf16_t* kcb; bf16_t* vct;
    __device__ __forceinline__ bool operator()(f32x4 (&acc)[2][2][4][2], const Unit& u, int wr, int wc, int fr, int fq) const {
        const int kv = u.pm >> 3; const int row0 = (u.pm & 7) * BM + wr * 64 + fr; const int col0 = wc * 32 + 8 * fq;
        if (col0 >= 64) return false;
#pragma unroll
        for (int ai = 0; ai < 2; ++ai)
#pragma unroll
            for (int m = 0; m < 4; ++m) { const int row = row0 + ai * HALF + m * 16, g = row >> 10, cc = row & 1023; const bool zr = cc == 1023; const f32x4 zz = (f32x4){0.f, 0.f, 0.f, 0.f};
                const f32x4 v0 = zr ? zz : acc[ai][0][m][0], v1 = zr ? zz : acc[ai][0][m][1];
                if (kv == 0) { u32x4 w; w.x = pk2(v0[0], v0[1]); w.y = pk2(v0[2], v0[3]); w.z = pk2(v1[0], v1[1]); w.w = pk2(v1[2], v1[3]); *(u32x4*)(kcb + ((size_t)g * 1024 + cc) * 64 + col0) = w; }
                else {
#pragma unroll
                    for (int j = 0; j < 4; ++j) { vct[((size_t)g * 64 + col0 + j) * 1024 + cc] = (bf16_t)f2bf(v0[j]); vct[((size_t)g * 64 + col0 + 4 + j) * 1024 + cc] = (bf16_t)f2bf(v1[j]); } } }
        return false;
    }
};
struct EpiLora {
    static constexpr bool PERM = true;
    bf16_t* obuf;
    __device__ __forceinline__ bool operator()(f32x4 (&acc)[2][2][4][2], const Unit& u, int wr, int wc, int fr, int fq) const {
        const int sel = u.pn >> 1; bf16_t* out = obuf + (size_t)(sel == 2 ? 0 : sel + 1) * T * 512;
        const int row0 = u.pm * BM + wr * 64 + fr; const int col0 = (u.pn & 1) * BM + wc * 32 + 8 * fq;
#pragma unroll
        for (int ai = 0; ai < 2; ++ai)
#pragma unroll
            for (int m = 0; m < 4; ++m) { bf16_t* rowp = out + (size_t)(row0 + ai * HALF + m * 16) * 512 + col0;
#pragma unroll
                for (int bj = 0; bj < 2; ++bj) { const f32x4 v0 = acc[ai][bj][m][0], v1 = acc[ai][bj][m][1];
                    u32x4 w; w.x = pk2(v0[0], v0[1]); w.y = pk2(v0[2], v0[3]); w.z = pk2(v1[0], v1[1]); w.w = pk2(v1[2], v1[3]);
                    *(u32x4*)(rowp + bj * HALF) = w; } }
        return false;
    }
};
struct EpiMerge {
    static constexpr bool PERM = true;
    const bf16_t* gates; bf16_t* merged;
    __device__ __forceinline__ bool operator()(f32x4 (&acc)[2][2][4][2], const Unit& u, int wr, int wc, int fr, int fq) const {
        const int row0 = u.pm * BM + wr * 64 + fr; const int col0 = u.pn * BM + wc * 32 + 8 * fq; const int sub = u.sub;
#pragma unroll
        for (int ai = 0; ai < 2; ++ai) {
                u32x4 gc[4][2], gn[4][2];
#pragma unroll
                for (int m = 0; m < 4; ++m) { const int row = row0 + ai * HALF + m * 16; const bf16_t* gp = gates + (size_t)row * 3072 + sub * 1024 + col0;
#pragma unroll
                    for (int bj = 0; bj < 2; ++bj) { gc[m][bj] = *(const u32x4*)(gp + bj * HALF); gn[m][bj] = (sub < 2) ? *(const u32x4*)(gp + 1024 + bj * HALF) : gc[m][bj]; } }
#pragma unroll
                for (int m = 0; m < 4; ++m) { const int row = row0 + ai * HALF + m * 16;
#pragma unroll
                    for (int bj = 0; bj < 2; ++bj) {
                        float sc[8], sn[8]; unpack8(gc[m][bj], sc);
                        if (sub < 2) { unpack8(gn[m][bj], sn);
#pragma unroll
                            for (int j = 0; j < 8; ++j) sc[j] = sc[j] * __builtin_amdgcn_rcpf(fmaxf(sn[j], 1e-30f)); }
                        f32x4 v0 = acc[ai][bj][m][0], v1 = acc[ai][bj][m][1];
#pragma unroll
                        for (int j = 0; j < 4; ++j) { v0[j] *= sc[j]; v1[j] *= sc[4 + j]; }
                        acc[ai][bj][m][0] = v0; acc[ai][bj][m][1] = v1;
                        if (sub == 2) { u32x4 w; w.x = pk2(v0[0], v0[1]); w.y = pk2(v0[2], v0[3]); w.z = pk2(v1[0], v1[1]); w.w = pk2(v1[2], v1[3]);
                            *(u32x4*)(merged + (size_t)row * D + col0 + bj * HALF) = w; } } }
                __builtin_amdgcn_sched_barrier(0);
        }
        return sub != 2;
    }
};
struct EpiNorm {
    static constexpr bool PERM = true, AFTER_DRAIN = true;
    float* x; bf16_t* xb; const float* gain; unsigned char* ws; unsigned* cnt; int row_base, kind_next; unsigned target; LAS unsigned char* lds; int tid;
    __device__ __forceinline__ bool operator()(f32x4 (&acc)[2][2][4][2], const Unit& u, int wr, int wc, int fr, int fq) const {
        LAS float* P = (LAS float*)lds; LAS float* S = (LAS float*)(lds + 16384);
        const int lane = tid & 63, wid = __builtin_amdgcn_readfirstlane(tid >> 6);
        const int prow = row_base + u.pm * BM;
        const int col0 = u.pn * BM + wc * 32 + 8 * fq;
#pragma unroll
        for (int ai = 0; ai < 2; ++ai)
#pragma unroll
            for (int m = 0; m < 4; ++m) { float ps = 0.f;
#pragma unroll
                for (int bj = 0; bj < 2; ++bj) { const f32x4 v0 = acc[ai][bj][m][0], v1 = acc[ai][bj][m][1];
                    ps += (v0[0] * v0[0] + v0[1] * v0[1]) + (v0[2] * v0[2] + v0[3] * v0[3]) + (v1[0] * v1[0] + v1[1] * v1[1]) + (v1[2] * v1[2] + v1[3] * v1[3]); }
                P[(ai * HALF + wr * 64 + m * 16 + fr) * 16 + wc * 4 + fq] = ps; }
        asm volatile("s_waitcnt lgkmcnt(0)" ::: "memory"); __builtin_amdgcn_s_barrier(); asm volatile("" ::: "memory");
        if (tid < 256) { const f32x4 a0 = *(const LAS f32x4*)(P + tid * 16), a1 = *(const LAS f32x4*)(P + tid * 16 + 4), a2 = *(const LAS f32x4*)(P + tid * 16 + 8), a3 = *(const LAS f32x4*)(P + tid * 16 + 12);
            const float sm = (((a0[0] + a0[1]) + (a0[2] + a0[3])) + ((a1[0] + a1[1]) + (a1[2] + a1[3]))) + (((a2[0] + a2[1]) + (a2[2] + a2[3])) + ((a3[0] + a3[1]) + (a3[2] + a3[3])));
            __hip_atomic_store(statp(ws, prow + tid, 1 + (int)(target >> 4)) + u.pn, sm, __ATOMIC_RELAXED, __HIP_MEMORY_SCOPE_AGENT); }
        asm volatile("s_waitcnt vmcnt(0)" ::: "memory");
        unsigned* pcnt = cnt + 16 * (prow >> 8);
        if (tid < 256 && lane == 0) (void)__hip_atomic_fetch_add(pcnt, 1u, __ATOMIC_RELAXED, __HIP_MEMORY_SCOPE_AGENT);
        if (wid == 0) { unsigned spins = 0; while ((unsigned)__builtin_amdgcn_readfirstlane(__hip_atomic_load(pcnt, __ATOMIC_RELAXED, __HIP_MEMORY_SCOPE_AGENT)) < target) { __builtin_amdgcn_s_sleep(1); if (++spins > (1u << 20)) break; }
            __builtin_amdgcn_fence(__ATOMIC_ACQUIRE, "agent"); }
        asm volatile("s_waitcnt vmcnt(0) lgkmcnt(0)" ::: "memory"); __builtin_amdgcn_s_barrier(); asm volatile("" ::: "memory");
        if (tid < 256) { float* sp = statp(ws, prow + tid, 1 + (int)(target >> 4));
            const float t0 = __hip_atomic_load(sp, __ATOMIC_RELAXED, __HIP_MEMORY_SCOPE_AGENT), t1 = __hip_atomic_load(sp + 1, __ATOMIC_RELAXED, __HIP_MEMORY_SCOPE_AGENT),
                        t2 = __hip_atomic_load(sp + 2, __ATOMIC_RELAXED, __HIP_MEMORY_SCOPE_AGENT), t3 = __hip_atomic_load(sp + 3, __ATOMIC_RELAXED, __HIP_MEMORY_SCOPE_AGENT);
            S[tid] = rsqrtf(((t0 + t1) + (t2 + t3)) * (1.0f / D) + NORM_EPS); }
        asm volatile("s_waitcnt lgkmcnt(0)" ::: "memory"); __builtin_amdgcn_s_barrier(); asm volatile("" ::: "memory");
        f32x4 gv[2][2];
#pragma unroll
        for (int bj = 0; bj < 2; ++bj) { gv[bj][0] = *(const f32x4*)(gain + col0 + bj * HALF); gv[bj][1] = *(const f32x4*)(gain + col0 + bj * HALF + 4); }
#pragma unroll
        for (int ai = 0; ai < 2; ++ai)
#pragma unroll
            for (int mp = 0; mp < 2; ++mp) {
                f32x4 xv[2][2][2];
#pragma unroll
                for (int mi = 0; mi < 2; ++mi) { const int row = prow + ai * HALF + wr * 64 + (2 * mp + mi) * 16 + fr;
#pragma unroll
                    for (int bj = 0; bj < 2; ++bj) { const float* xp = x + (size_t)row * D + col0 + bj * HALF; xv[mi][bj][0] = *(const f32x4*)xp; xv[mi][bj][1] = *(const f32x4*)(xp + 4); } }
#pragma unroll
                for (int mi = 0; mi < 2; ++mi) { const int m = 2 * mp + mi; const int rl = ai * HALF + wr * 64 + m * 16 + fr; const int row = prow + rl; const float rstd = S[rl]; float qs = 0.f;
#pragma unroll
                    for (int bj = 0; bj < 2; ++bj) { const int col = col0 + bj * HALF; float* xp = x + (size_t)row * D + col; u32x4 w;
                        { f32x4 xa = xv[mi][bj][0]; xa += acc[ai][bj][m][0] * rstd * gv[bj][0]; *(f32x4*)xp = xa;
                          w.x = pk2(xa[0], xa[1]); w.y = pk2(xa[2], xa[3]); qs += (xa[0] * xa[0] + xa[1] * xa[1]) + (xa[2] * xa[2] + xa[3] * xa[3]); }
                        { f32x4 xc = xv[mi][bj][1]; xc += acc[ai][bj][m][1] * rstd * gv[bj][1]; *(f32x4*)(xp + 4) = xc;
                          w.z = pk2(xc[0], xc[1]); w.w = pk2(xc[2], xc[3]); qs += (xc[0] * xc[0] + xc[1] * xc[1]) + (xc[2] * xc[2] + xc[3] * xc[3]); }
                        *(u32x4*)(xb + (size_t)row * D + col) = w; }
                    P[rl * 16 + wc * 4 + fq] = qs; }
                __builtin_amdgcn_sched_barrier(0);
            }
        asm volatile("s_waitcnt lgkmcnt(0)" ::: "memory"); __builtin_amdgcn_s_barrier(); asm volatile("" ::: "memory");
        if (tid < 256) { const f32x4 a0 = *(const LAS f32x4*)(P + tid * 16), a1 = *(const LAS f32x4*)(P + tid * 16 + 4), a2 = *(const LAS f32x4*)(P + tid * 16 + 8), a3 = *(const LAS f32x4*)(P + tid * 16 + 12);
            const float sm = (((a0[0] + a0[1]) + (a0[2] + a0[3])) + ((a1[0] + a1[1]) + (a1[2] + a1[3]))) + (((a2[0] + a2[1]) + (a2[2] + a2[3])) + ((a3[0] + a3[1]) + (a3[2] + a3[3])));
            __hip_atomic_store(statp(ws, prow + tid, kind_next) + u.pn, sm, __ATOMIC_RELAXED, __HIP_MEMORY_SCOPE_AGENT); }
        return false;
    }
};
struct EpiSwiGLU {
    static constexpr bool PERM = true;
    bf16_t* act; unsigned char* ws;
    __device__ __forceinline__ bool operator()(f32x4 (&acc)[2][2][4][2], const Unit& u, int wr, int wc, int fr, int fq) const {
        const int row0 = u.pm * BM + wr * 64 + fr; const int col0 = u.pn * HALF + wc * 32 + 8 * fq;
        float sv[2][4];
        { f32x4 pq[2][4];
#pragma unroll
          for (int ai = 0; ai < 2; ++ai)
#pragma unroll
            for (int m = 0; m < 4; ++m) pq[ai][m] = *(const f32x4*)statp(ws, row0 + ai * HALF + m * 16, 1);
#pragma unroll
          for (int ai = 0; ai < 2; ++ai)
#pragma unroll
            for (int m = 0; m < 4; ++m) sv[ai][m] = rsqrtf(((pq[ai][m][0] + pq[ai][m][1]) + (pq[ai][m][2] + pq[ai][m][3])) * (1.0f / D) + NORM_EPS); }
#pragma unroll
        for (int ai = 0; ai < 2; ++ai)
#pragma unroll
            for (int m = 0; m < 4; ++m) { const int row = row0 + ai * HALF + m * 16;
                const float s = sv[ai][m];
                float o[8];
#pragma unroll
                for (int n = 0; n < 2; ++n)
#pragma unroll
                    for (int j = 0; j < 4; ++j) { const float gg = acc[ai][0][m][n][j] * s, uu = acc[ai][1][m][n][j] * s; o[n * 4 + j] = gg * sigmoidf_(gg) * uu; }
                u32x4 w; w.x = pk2(o[0], o[1]); w.y = pk2(o[2], o[3]); w.z = pk2(o[4], o[5]); w.w = pk2(o[6], o[7]);
                *(u32x4*)(act + (size_t)row * FFN + col0) = w; }
        return false;
    }
};
}

struct Args { const float* in[30]; float* out; unsigned char* ws; int lo, hi; };
enum { I_X = 0, I_NPM, I_NQM, I_NPF, I_NQF, I_WIN, I_MU, I_W0, I_W2, I_A0, I_A2, I_G2, I_KK, I_KA, I_RK, I_LNW, I_LNB, I_PEK, I_PEV, I_CKW1, I_CKW2, I_CVW1, I_CVW2, I_SINK, I_REL, I_WBR, I_WOUT, I_FG, I_FU, I_FD };

struct Ctx { LAS unsigned char* lds; int tid, lane, wave, G, bid; };
__device__ __forceinline__ const float* inptr(const Ctx& c, int i) {
    const volatile LAS unsigned* t = (const volatile LAS unsigned*)(c.lds + LDS_MISC + 64) + 2 * i;
    const unsigned lo = __builtin_amdgcn_readfirstlane(t[0]), hi = __builtin_amdgcn_readfirstlane(t[1]);
    return (const float*)(((unsigned long long)hi << 32) | lo);
}

__device__ __forceinline__ void phase_init(const Ctx& c, const float* x, float* xo, bf16_t* xb, unsigned char* wsb) {
    const int gw = c.bid * 8 + c.wave, NGW = c.G * 8;
    for (int row = gw; row < MROWS; row += NGW) {
        const float* xr = x + (size_t)row * D; float ss = 0.f;
#pragma unroll
        for (int j = 0; j < 2; ++j) { const int e = c.lane * 8 + 512 * j; const f32x4 a = *(const f32x4*)(xr + e), b = *(const f32x4*)(xr + e + 4);
            ss += a[0] * a[0] + a[1] * a[1] + a[2] * a[2] + a[3] * a[3] + b[0] * b[0] + b[1] * b[1] + b[2] * b[2] + b[3] * b[3];
            *(f32x4*)(xo + (size_t)row * D + e) = a; *(f32x4*)(xo + (size_t)row * D + e + 4) = b;
            u32x4 w; w.x = pk2(a[0], a[1]); w.y = pk2(a[2], a[3]); w.z = pk2(b[0], b[1]); w.w = pk2(b[2], b[3]); *(u32x4*)(xb + (size_t)row * D + e) = w; }
        ss = wave_sum(ss);
        if (c.lane < 4) __hip_atomic_store(statp(wsb, row, 0) + c.lane, c.lane == 0 ? ss : 0.f, __ATOMIC_RELAXED, __HIP_MEMORY_SCOPE_AGENT);
    }
}
struct CvtTile { const float* src; const float* gain; bf16_t* dst; int ld, nvalid, K, k0, n0; float extra; bool kvalid; };
__device__ __forceinline__ CvtTile cvt_describe(const Ctx& c, int layer, bf16_t* wb, int it) {
    constexpr int I0 = 16 * 112, I1 = 3 * 8 * 16, I2 = 16 * 16, I3 = 16 * 88, I4 = 44 * 16, I5 = 4 * 24, I6 = 2 * 32 * 4;
    int r = it, kind, sub = 0, K, nblk; bf16_t* dst;
    if (r < I0) { kind = 0; K = D; nblk = 112; dst = wb + WB_WIN; }
    else if ((r -= I0) < I1) { kind = 1; sub = r / 128; r -= sub * 128; K = 512; nblk = 16; dst = wb + WB_WBR + (size_t)sub * D * 512; }
    else if ((r -= I1) < I2) { kind = 2; K = D; nblk = 16; dst = wb + WB_WOUT; }
    else if ((r -= I2) < I3) { kind = 3; K = D; nblk = 88; dst = wb + WB_WGU; }
    else if ((r -= I3) < I4) { kind = 4; K = FFN; nblk = 16; dst = wb + WB_WDN; }
    else if ((r -= I4) < I5) { kind = 5; K = 256; nblk = 24; dst = wb + WB_LORA; }
    else if ((r -= I5) < I6) { kind = 6; sub = r / 128; r -= sub * 128; K = 2048; nblk = 4; dst = wb + WB_W1T + (size_t)sub * 256 * 2048; }
    else { r -= I6; kind = 7; sub = r / 16; r -= sub * 16; K = 256; nblk = 4; dst = wb + WB_W2T + (size_t)sub * 256 * 256; }
    const int kb = r / nblk, nb = r % nblk, k0 = kb * 64, n0 = nb * 64;
    CvtTile t; t.src = nullptr; t.gain = nullptr; t.dst = dst; t.ld = 0; t.nvalid = 64; t.K = K; t.k0 = k0; t.n0 = n0; t.extra = 1.f; t.kvalid = true;
    switch (kind) {
    case 0: { t.gain = inptr(c, I_NPM) + layer * D + k0; t.ld = IN_COLS;
        const int scol = n0 < 3096 ? n0 : n0 - 232; t.nvalid = (n0 < 3096) ? (3096 - n0 < 64 ? 3096 - n0 : 64) : (n0 < 3328 ? 0 : 64);
        if ((n0 >= PC_NQ && n0 < PC_NQ + 512) || (n0 >= PC_SQ && n0 < PC_SQ + 512)) t.extra = 0.125f;
        t.src = inptr(c, I_WIN) + ((size_t)layer * D + k0) * IN_COLS + scol; break; }
    case 1: t.src = inptr(c, I_WBR) + (((size_t)layer * 3 + sub) * 512 + k0) * D + n0; t.ld = D; break;
    case 2: t.src = inptr(c, I_WOUT) + ((size_t)layer * D + k0) * D + n0; t.ld = D; break;
    case 3: { t.gain = inptr(c, I_NPF) + layer * D + k0; t.ld = FFN; const int pn = n0 >> 8, rr = n0 & 255;
        t.src = inptr(c, rr < 128 ? I_FG : I_FU) + ((size_t)layer * D + k0) * FFN + pn * 128 + (rr & 127); break; }
    case 4: t.src = inptr(c, I_FD) + ((size_t)layer * FFN + k0) * D + n0; t.ld = D; break;
    case 5: { t.ld = 512;
        if (n0 < 512) { t.kvalid = k0 < 64; t.src = inptr(c, I_W2) + ((size_t)layer * 64 + k0) * 512 + n0; }
        else if (n0 < 1024) { t.kvalid = (k0 == 64); t.src = inptr(c, I_A2) + ((size_t)layer * 64 + (k0 - 64)) * 512 + n0 - 512; }
        else { t.kvalid = k0 >= 128; t.src = inptr(c, I_G2) + ((size_t)layer * 128 + (k0 - 128)) * 512 + n0 - 1024; }
        break; }
    case 6: t.src = inptr(c, sub ? I_CVW1 : I_CKW1) + ((size_t)layer * 2048 + k0) * 256 + n0; t.ld = 256; break;
    default: t.src = inptr(c, sub ? I_CVW2 : I_CKW2) + ((size_t)layer * 256 + k0) * 64 + n0; t.ld = 64; t.nvalid = n0 < 64 ? 64 : 0; break;
    }
    return t;
}
__device__ __forceinline__ void phase_cvt(const Ctx& c, const Args& a, int layer, bf16_t* wb) {
    LAS float* tile = (LAS float*)c.lds;
    constexpr int NIT = 16 * 112 + 3 * 8 * 16 + 16 * 16 + 16 * 88 + 44 * 16 + 4 * 24 + 2 * 32 * 4 + 2 * 4 * 4;
    for (int it = c.bid; it < NIT; it += 2 * c.G) {
        const int it2 = it + c.G; const bool two = it2 < NIT;
        const CvtTile t0 = cvt_describe(c, layer, wb, it), t1 = cvt_describe(c, layer, wb, two ? it2 : it);
        float v0[8], v1[8];
#pragma unroll
        for (int i = 0; i < 8; ++i) { const int e = c.tid + 512 * i, kk = e >> 6, nn = e & 63;
            v0[i] = (t0.kvalid && nn < t0.nvalid) ? t0.src[(size_t)kk * t0.ld + nn] : 0.f;
            v1[i] = (two && t1.kvalid && nn < t1.nvalid) ? t1.src[(size_t)kk * t1.ld + nn] : 0.f; }
#pragma unroll
        for (int i = 0; i < 8; ++i) { const int e = c.tid + 512 * i, kk = e >> 6, nn = e & 63;
            tile[kk * 65 + nn] = v0[i] * t0.extra * (t0.gain ? t0.gain[kk] : 1.f); tile[4160 + kk * 65 + nn] = v1[i] * t1.extra * (t1.gain ? t1.gain[kk] : 1.f); }
        __syncthreads();
        { const int nn = c.tid >> 3, kc = (c.tid & 7) * 8; u32x4 w;
          w.x = pk2(tile[(kc + 0) * 65 + nn], tile[(kc + 1) * 65 + nn]); w.y = pk2(tile[(kc + 2) * 65 + nn], tile[(kc + 3) * 65 + nn]);
          w.z = pk2(tile[(kc + 4) * 65 + nn], tile[(kc + 5) * 65 + nn]); w.w = pk2(tile[(kc + 6) * 65 + nn], tile[(kc + 7) * 65 + nn]);
          *(u32x4*)(t0.dst + (size_t)(t0.n0 + nn) * t0.K + t0.k0 + kc) = w;
          if (two) { const LAS float* tl = tile + 4160;
            w.x = pk2(tl[(kc + 0) * 65 + nn], tl[(kc + 1) * 65 + nn]); w.y = pk2(tl[(kc + 2) * 65 + nn], tl[(kc + 3) * 65 + nn]);
            w.z = pk2(tl[(kc + 4) * 65 + nn], tl[(kc + 5) * 65 + nn]); w.w = pk2(tl[(kc + 6) * 65 + nn], tl[(kc + 7) * 65 + nn]);
            *(u32x4*)(t1.dst + (size_t)(t1.n0 + nn) * t1.K + t1.k0 + kc) = w; } }
        __syncthreads();
    }
    if (c.bid == c.G - 1) {
        const int kv = c.tid >> 8, u = c.tid & 255; const float* w1 = inptr(c, kv ? I_CVW1 : I_CKW1) + (size_t)layer * 2048 * 256; const float* pe = inptr(c, kv ? I_PEV : I_PEK) + (size_t)layer * 2048;
        float acc = 0.f; for (int k = 0; k < 2048; ++k) acc += pe[k] * w1[(size_t)k * 256 + u];
        ((float*)(wb + WB_BH))[c.tid] = acc;
    }
}

constexpr int RL = 65;
__device__ __forceinline__ float rwkv_mixed(const bf16_t* proj, const float* mu, int t, int col) {
    const float cur = bf2f(proj[(size_t)t * PLD + col]); const float prev = t > 0 ? bf2f(proj[(size_t)(t - 1) * PLD + col]) : 0.f;
    return cur + (prev - cur) * mu[col];
}
__device__ __forceinline__ int kperm32(int jl) { return 8 * ((jl >> 2) & 3) + 4 * (jl >> 4) + (jl & 3); }
__device__ __forceinline__ f32x4 tile_mma64(const LAS unsigned char* A, const LAS unsigned char* B, int a, int b, int lane, f32x4 acc) {
    const int m = lane & 15, q = lane >> 4;
#pragma unroll
    for (int ks = 0; ks < 2; ++ks) {
        const bf16x8 af = *(const LAS bf16x8*)(A + (16 * a + m) * 144 + (32 * ks + 8 * q) * 2);
        const bf16x8 bf = *(const LAS bf16x8*)(B + (16 * b + m) * 144 + (32 * ks + 8 * q) * 2);
        acc = __builtin_amdgcn_mfma_f32_16x16x32_bf16(af, bf, acc, 0, 0, 0);
    }
    return acc;
}
__device__ __forceinline__ void lds_st_bf16(LAS unsigned char* base, int idx, float v) { *(LAS bf16_t*)(base + idx * 2) = (bf16_t)f2bf(v); }

__device__ __forceinline__ void phase_lora_a(const Ctx& c, const Args& a, int layer, const bf16_t* proj, bf16_t* alora) {
    const float* mu = inptr(c, I_MU) + (size_t)layer * 1792;
    const int sub = c.tid & 31, rloc = c.tid >> 5;
    for (int t = c.bid * 16 + rloc; t < T; t += c.G * 16) {
        const int col = PC_ZW + sub * 8; float cur[8], prv[8];
        unpack8(*(const u32x4*)(proj + (size_t)t * PLD + col), cur);
        if (t > 0) unpack8(*(const u32x4*)(proj + (size_t)(t - 1) * PLD + col), prv); else {
#pragma unroll
            for (int k = 0; k < 8; ++k) prv[k] = 0.f; }
        float o[8];
#pragma unroll
        for (int k = 0; k < 8; ++k) { const float v = cur[k] + (prv[k] - cur[k]) * mu[col + k]; o[k] = sub < 8 ? tanhf(v) : (sub < 16 ? v : sigmoidf_(v)); }
        u32x4 w; w.x = pk2(o[0], o[1]); w.y = pk2(o[2], o[3]); w.z = pk2(o[4], o[5]); w.w = pk2(o[6], o[7]);
        *(u32x4*)(alora + (size_t)t * 256 + sub * 8) = w;
    }
}

constexpr int RC_L = 0, RC_AL = 16640, RC_AAK = 0, RC_ARB = 9216, RC_ARK = 18432, RC_AAB = 33280, RC_P2T = 33280, RC_WC = 50688, RC_BS = 50944, RC_M = 52992;
constexpr int RC_AT = RC_M, RC_TINV = RC_M, RC_ATT = RC_M + 9216, RC_RT = RC_M + 2 * 9216, RC_BT = RC_M + 3 * 9216, RC_XT = RC_BT, RC_KT = RC_M + 4 * 9216, RC_P1T = RC_KT,
              RC_VT = RC_M + 5 * 9216, RC_BHT = RC_M + 6 * 9216, RC_KHT = RC_M + 7 * 9216;
constexpr int RC_XOFF = RC_M + 8 * 9216, RC_XTMP = RC_XOFF + 6144;
static_assert(RC_XTMP + 3 * 1088 <= LDS_MISC, "rwkv chunk LDS");

__device__ __forceinline__ void phase_rwkv_chunk(const Ctx& c, const Args& a, int layer, const bf16_t* proj, const bf16_t* wlb, const bf16_t* alb, bf16_t* rwu, float* bonusg) {
    LAS unsigned char* L = c.lds;
    LAS float* sL = (LAS float*)(L + RC_L); LAS float* sAL = (LAS float*)(L + RC_AL); LAS float* sAAB = (LAS float*)(L + RC_AAB);
    LAS float* sWC = (LAS float*)(L + RC_WC); LAS float* sBS = (LAS float*)(L + RC_BS);
    const float* mu = inptr(c, I_MU) + (size_t)layer * 1792;
    const int lane = c.lane, wave = c.wave, n = lane & 15, q = lane >> 4;
    for (int unit = c.bid; unit < 2048; unit += c.G) {
        const int ch = unit >> 3, h = unit & 7, t0 = ch * 64, j = lane;
        {
            const float w0 = inptr(c, I_W0)[layer * 512 + h * 64 + j], a0 = inptr(c, I_A0)[layer * 512 + h * 64 + j];
            bf16_t wraw[8], araw[8];
#pragma unroll
            for (int i = 0; i < 8; ++i) { const size_t gi = (size_t)(t0 + wave * 8 + i) * 512 + h * 64 + j; wraw[i] = wlb[gi]; araw[i] = alb[gi]; }
            float run = 0.f;
#pragma unroll
            for (int i = 0; i < 8; ++i) { const int tt = wave * 8 + i;
                const float wl = w0 + bf2f(wraw[i]); const float nx = -wl; const float sp = nx > 20.f ? nx : __logf(1.0f + __expf(nx)); const float ld = -__expf(-sp - 0.5f);
                run += ld; sL[tt * RL + j] = run; sAL[tt * RL + j] = sigmoidf_(a0 + bf2f(araw[i])); }
            sBS[wave * 64 + j] = run;
        }
        bf16_t rraw[9], kraw[9], vraw[9];
        {
#pragma unroll
            for (int i = 0; i < 9; ++i) { const int t = t0 + wave * 8 + i - 1; const bool ok = t >= 0; const size_t ro = (size_t)(ok ? t : 0) * PLD + h * 64 + j;
                rraw[i] = ok ? proj[ro + PC_R] : (bf16_t)0; kraw[i] = ok ? proj[ro + PC_K] : (bf16_t)0; vraw[i] = ok ? proj[ro + PC_V] : (bf16_t)0; }
        }
        __syncthreads();
        {
            float off = 0.f, tot = 0.f;
#pragma unroll
            for (int w2 = 0; w2 < 8; ++w2) { const float v = sBS[w2 * 64 + j]; tot += v; off += (w2 < wave) ? v : 0.f; }
            if (wave == 0) sWC[j] = __expf(tot);
            const float kkw = inptr(c, I_KK)[layer * 512 + h * 64 + j], kaw = inptr(c, I_KA)[layer * 512 + h * 64 + j], rk = inptr(c, I_RK)[layer * 512 + h * 64 + j];
            const float mur = mu[PC_R + h * 64 + j], muk = mu[PC_K + h * 64 + j], muv = mu[PC_V + h * 64 + j];
            float Lprev = off; float eWprev = __expf(off); const float eTot = __expf(tot);
#pragma unroll
            for (int i = 0; i < 8; ++i) { const int tt = wave * 8 + i, t = t0 + tt;
                const float Lc = sL[tt * RL + j] + off, al = sAL[tt * RL + j];
                const float rc = bf2f(rraw[i + 1]), kc = bf2f(kraw[i + 1]), vc = bf2f(vraw[i + 1]);
                const float r = rc + (bf2f(rraw[i]) - rc) * mur, k = kc + (bf2f(kraw[i]) - kc) * muk, v = vc + (bf2f(vraw[i]) - vc) * muv;
                float kk = k * kkw; const float n2 = wave_sum(kk * kk); kk = kk / fmaxf(sqrtf(n2), 1e-12f);
                const float kp = k * (1.0f + (al - 1.0f) * kaw), av = -kk, bv = kk * al;
                const float eW = __expf(Lc), eInv = __builtin_amdgcn_rcpf(eW), eC = eTot * eInv; const float eWex = eWprev; eWprev = eW;
                lds_st_bf16(L + RC_AT, tt * 72 + j, av * eWex); lds_st_bf16(L + RC_ATT, j * 72 + tt, av * eWex);
                lds_st_bf16(L + RC_RT, tt * 72 + j, r * eW); lds_st_bf16(L + RC_BT, tt * 72 + j, bv * eInv); lds_st_bf16(L + RC_KT, tt * 72 + j, kp * eInv);
                lds_st_bf16(L + RC_VT, j * 72 + tt, v); lds_st_bf16(L + RC_BHT, j * 72 + tt, bv * eC); lds_st_bf16(L + RC_KHT, j * 72 + tt, kp * eC);
                const float bon = wave_sum(r * kp * rk); if (lane == 0) bonusg[(size_t)t * 8 + h] = bon;
                Lprev = Lc; }
        }
        __syncthreads();
        for (int job = wave; job < 64; job += 8) {
            const int p = job >> 4, ta = (job >> 2) & 3, tb = job & 3;
            f32x4 acc = (f32x4){0.f, 0.f, 0.f, 0.f};
            if (ta >= tb) acc = tile_mma64(L + (p < 2 ? RC_AT : RC_RT), L + ((p & 1) ? RC_KT : RC_BT), ta, tb, lane, acc);
            LAS unsigned char* dst = L + (p == 1 ? RC_AAK : (p == 2 ? RC_ARB : RC_ARK));
#pragma unroll
            for (int r = 0; r < 4; ++r) { const int tt = 16 * ta + 4 * q + r, ss = 16 * tb + n; const bool keep = (p < 2) ? (ss < tt) : (ss <= tt); const float v = keep ? acc[r] : 0.f;
                if (p == 0) sAAB[tt * 68 + ss] = v; else lds_st_bf16(dst, tt * 72 + ss, v); }
        }
        __syncthreads();
        if (wave == 0) {
            const int blk = lane >> 4, cc = lane & 15; const LAS float* Ab = sAAB + (16 * blk) * 68 + 16 * blk; float xr[16];
#pragma unroll
            for (int tt = 0; tt < 16; ++tt) { float acc = (tt == cc) ? 1.f : 0.f;
#pragma unroll
                for (int ss = 0; ss < tt; ++ss) acc += Ab[tt * 68 + ss] * xr[ss];
                xr[tt] = acc; }
            asm volatile("s_waitcnt lgkmcnt(0)" ::: "memory");
#pragma unroll
            for (int tt = 0; tt < 16; ++tt) sAAB[(16 * blk + tt) * 68 + 16 * blk + cc] = xr[tt];
        } else {
            for (int job = wave - 1; job < 16; job += 7) { const int ta = job >> 2, tb = job & 3;
                const f32x4 acc = tile_mma64(L + RC_VT, L + RC_AAK, ta, tb, lane, (f32x4){0.f, 0.f, 0.f, 0.f});
#pragma unroll
                for (int r = 0; r < 4; ++r) lds_st_bf16(L + RC_XT, (16 * ta + 4 * q + r) * 72 + 16 * tb + n, acc[r]); }
        }
        __syncthreads();
        {
            LAS float* sXO = (LAS float*)(L + RC_XOFF); LAS float* sT = (LAS float*)(L + RC_XTMP) + wave * 272;
            const int rr = lane >> 2, c4 = (lane & 3) * 4;
#pragma unroll 1
            for (int lev = 1; lev <= 3; ++lev) {
                if (wave < 4 - lev) {
                    const int J = wave, I = wave + lev;
                    f32x4 tacc = (f32x4){0.f, 0.f, 0.f, 0.f};
                    for (int K = J; K < I; ++K) {
                        const LAS float* Ap = sAAB + (16 * I + rr) * 68 + 16 * K; const LAS float* Xp;
                        int xs;
                        if (K == J) { Xp = sAAB + (16 * J) * 68 + 16 * J + c4; xs = 68; }
                        else { const int d = K - J; const int bi = (d == 1) ? J : 3 + J; Xp = sXO + bi * 256 + c4; xs = 16; }
#pragma unroll
                        for (int k = 0; k < 16; ++k) { const float av = Ap[k]; const f32x4 xv = *(const LAS f32x4*)(Xp + k * xs); tacc += xv * av; }
                    }
                    *(LAS f32x4*)(sT + rr * 16 + c4) = tacc;
                    asm volatile("s_waitcnt lgkmcnt(0)" ::: "memory");
                    f32x4 xacc = (f32x4){0.f, 0.f, 0.f, 0.f};
                    const LAS float* Dp = sAAB + (16 * I + rr) * 68 + 16 * I;
#pragma unroll
                    for (int k = 0; k < 16; ++k) { const float dv = Dp[k]; const f32x4 tv = *(const LAS f32x4*)(sT + k * 16 + c4); xacc += tv * dv; }
                    const int bo = (lev == 1) ? J : (lev == 2 ? 3 + J : 5);
                    *(LAS f32x4*)(sXO + bo * 256 + rr * 16 + c4) = xacc;
                }
                __syncthreads();
            }
            for (int e = c.tid; e < 4096; e += 512) { const int tt = e >> 6, ss = e & 63, I = tt >> 4, J = ss >> 4; float v = 0.f;
                if (I == J) v = sAAB[tt * 68 + ss];
                else if (I > J) { const int d = I - J; const int bi = (d == 1) ? J : (d == 2 ? 3 + J : 5); v = sXO[bi * 256 + (tt & 15) * 16 + (ss & 15)]; }
                lds_st_bf16(L + RC_TINV, tt * 72 + ss, v); }
        }
        __syncthreads();
        for (int job = wave; job < 32; job += 8) { const int p = job >> 4, ta = (job >> 2) & 3, tb = job & 3;
            const f32x4 acc = tile_mma64(L + (p ? RC_XT : RC_ATT), L + RC_TINV, ta, tb, lane, (f32x4){0.f, 0.f, 0.f, 0.f});
#pragma unroll
            for (int r = 0; r < 4; ++r) lds_st_bf16(L + (p ? RC_P2T : RC_P1T), (16 * ta + 4 * q + r) * 72 + 16 * tb + n, acc[r]); }
        __syncthreads();
        bf16_t* ug = rwu + (size_t)unit * 16384;
        for (int job = wave; job < 64; job += 8) { const int p = job >> 4, ta = (job >> 2) & 3, tb = job & 3;
            f32x4 acc = (f32x4){0.f, 0.f, 0.f, 0.f};
            if (p == 0) { acc = tile_mma64(L + RC_ARB, L + RC_P1T, ta, tb, lane, acc);
#pragma unroll
                for (int r = 0; r < 4; ++r) { const int tt = 16 * ta + 4 * q + r, jj = 16 * tb + n; const float v = acc[r] + bf2f(*(const LAS bf16_t*)(L + RC_RT + (tt * 72 + jj) * 2));
                    ug[8192 + tt * 64 + (jj & 32) + kperm32(jj & 31)] = (bf16_t)f2bf(v); } }
            else if (p == 1) { acc = tile_mma64(L + RC_ARB, L + RC_P2T, ta, tb, lane, acc); acc = tile_mma64(L + RC_ARK, L + RC_VT, ta, tb, lane, acc);
                u32x2 w; w.x = pk2(acc[0], acc[1]); w.y = pk2(acc[2], acc[3]); *(u32x2*)(ug + 12288 + ((tb * 4 + ta) * 64 + lane) * 4) = w; }
            else if (p == 2) { acc = tile_mma64(L + RC_BHT, L + RC_P1T, ta, tb, lane, acc);
#pragma unroll
                for (int r = 0; r < 4; ++r) { const int jr = 16 * ta + 4 * q + r, jc = 16 * tb + n; const float v = acc[r] + (jr == jc ? sWC[jr] : 0.f);
                    ug[jr * 64 + (jc & 32) + kperm32(jc & 31)] = (bf16_t)f2bf(v); } }
            else { acc = tile_mma64(L + RC_BHT, L + RC_P2T, ta, tb, lane, acc); acc = tile_mma64(L + RC_KHT, L + RC_VT, ta, tb, lane, acc);
                u32x2 w; w.x = pk2(acc[0], acc[1]); w.y = pk2(acc[2], acc[3]); *(u32x2*)(ug + 4096 + ((tb * 4 + ta) * 64 + lane) * 4) = w; }
        }
        __syncthreads();
    }
}

#define RW_LOAD_SET(SET, UNIT) do { const bf16_t* ug_ = rwu + (size_t)(UNIT) * 16384; \
    _Pragma("unroll") for (int ta = 0; ta < 4; ++ta) { An[SET][ta][0] = *(const bf16x8*)(ug_ + (16 * ta + m) * 64 + 8 * q); An[SET][ta][1] = *(const bf16x8*)(ug_ + (16 * ta + m) * 64 + 32 + 8 * q); \
        Zn[SET][ta] = *(const u32x2*)(ug_ + 4096 + ((cq * 4 + ta) * 64 + lane) * 4); } } while (0)
template <int SM>
__device__ __forceinline__ void phase_rwkv_scan(const Ctx& c, const bf16_t* rwu, bf16_t* rws) {
    const int idx = c.bid; if (idx >= 32 || c.wave != 0) return;
    const int h = idx >> 2, cq = idx & 3, lane = c.lane, m = lane & 15, q = lane >> 4;
    bf16x8 Bhi[2], Blo[2];
#pragma unroll
    for (int s = 0; s < 2; ++s) { Bhi[s] = (bf16x8){0, 0, 0, 0, 0, 0, 0, 0}; Blo[s] = Bhi[s]; }
    bf16x8 An[2][4][2]; u32x2 Zn[2][4];
#pragma unroll
    for (int u = 0; u < 2; ++u) RW_LOAD_SET(u, u * 8 + h);
    if (SM == 1) {
        for (int ch = 0; ch < T / 64; ch += 8) {
#pragma unroll
            for (int uu = 0; uu < 8; ++uu) { const int u = uu & 3; const int unit = (ch + uu) * 8 + h;
                bf16_t* sg = rws + (size_t)unit * 4096 + cq * 1024 + lane * 8;
                *(bf16x8*)(sg) = Bhi[0]; *(bf16x8*)(sg + 512) = Bhi[1];
#pragma unroll
                for (int ta = 0; ta < 4; ++ta) { Bhi[0] = Bhi[0] ^ An[u][ta][0]; Bhi[1] = Bhi[1] ^ An[u][ta][1]; Bhi[0][0] ^= (short)Zn[u][ta].x; }
                RW_LOAD_SET(u, (ch + uu + 4 < T / 64) ? unit + 32 : unit); } }
        return;
    }
    for (int ch = 0; ch < T / 64; ch += 8) {
#pragma unroll
        for (int uu = 0; uu < 8; ++uu) {
            const int u = uu & 1;
            const int unit = (ch + uu) * 8 + h;
            bf16_t* sg = rws + (size_t)unit * 4096 + cq * 1024 + lane * 8;
            *(bf16x8*)(sg) = Bhi[0]; *(bf16x8*)(sg + 512) = Bhi[1];
            f32x4 acc[4];
#pragma unroll
            for (int ta = 0; ta < 4; ++ta) { const u32x2 z = Zn[u][ta];
                acc[ta] = (f32x4){__uint_as_float(z.x << 16), __uint_as_float(z.x & 0xffff0000u), __uint_as_float(z.y << 16), __uint_as_float(z.y & 0xffff0000u)};
#pragma unroll
                for (int s = 0; s < 2; ++s) { acc[ta] = __builtin_amdgcn_mfma_f32_16x16x32_bf16(An[u][ta][s], Bhi[s], acc[ta], 0, 0, 0); acc[ta] = __builtin_amdgcn_mfma_f32_16x16x32_bf16(An[u][ta][s], Blo[s], acc[ta], 0, 0, 0); } }
            if (SM == 0) RW_LOAD_SET(u, (ch + uu + 2 < T / 64) ? unit + 16 : unit);
#pragma unroll
            for (int s = 0; s < 2; ++s) { u32x4 hi, lo; float rem[8];
#pragma unroll
                for (int p = 0; p < 8; ++p) { const float v = acc[2 * s + (p >> 2)][p & 3]; const unsigned hb = f2bf(v); rem[p] = v - __uint_as_float(hb << 16); }
                hi.x = pk2(acc[2 * s][0], acc[2 * s][1]); hi.y = pk2(acc[2 * s][2], acc[2 * s][3]); hi.z = pk2(acc[2 * s + 1][0], acc[2 * s + 1][1]); hi.w = pk2(acc[2 * s + 1][2], acc[2 * s + 1][3]);
                lo.x = pk2(rem[0], rem[1]); lo.y = pk2(rem[2], rem[3]); lo.z = pk2(rem[4], rem[5]); lo.w = pk2(rem[6], rem[7]);
                Bhi[s] = __builtin_bit_cast(bf16x8, hi); Blo[s] = __builtin_bit_cast(bf16x8, lo); }
        }
    }
}
#undef RW_LOAD_SET

__device__ __forceinline__ void phase_rwkv_out(const Ctx& c, const Args& a, int layer, const bf16_t* proj, const bf16_t* rwu, const bf16_t* rws, const float* bonusg, bf16_t* orwkv) {
    const float* mu = inptr(c, I_MU) + (size_t)layer * 1792;
    const int lane = c.lane, m = lane & 15, q = lane >> 4;
    for (int unit = c.bid * 8 + c.wave; unit < 2048; unit += c.G * 8) {
        const int ch = unit >> 3, h = unit & 7, t0 = ch * 64; const bf16_t* ug = rwu + (size_t)unit * 16384; const bf16_t* sg = rws + (size_t)unit * 4096;
        bf16x8 Bf[4][2];
#pragma unroll
        for (int cq = 0; cq < 4; ++cq) { Bf[cq][0] = *(const bf16x8*)(sg + cq * 1024 + lane * 8); Bf[cq][1] = *(const bf16x8*)(sg + cq * 1024 + 512 + lane * 8); }
        float lnw[4], lnb[4];
#pragma unroll
        for (int cq = 0; cq < 4; ++cq) { lnw[cq] = inptr(c, I_LNW)[layer * 512 + h * 64 + 16 * cq + m]; lnb[cq] = inptr(c, I_LNB)[layer * 512 + h * 64 + 16 * cq + m]; }
        float muv[4];
#pragma unroll
        for (int cq = 0; cq < 4; ++cq) muv[cq] = mu[PC_V + h * 64 + 16 * cq + m];
#pragma unroll 1
        for (int ta = 0; ta < 4; ++ta) {
            const bf16x8 A0 = *(const bf16x8*)(ug + 8192 + (16 * ta + m) * 64 + 8 * q), A1 = *(const bf16x8*)(ug + 8192 + (16 * ta + m) * 64 + 32 + 8 * q);
            f32x4 y[4];
#pragma unroll
            for (int cq = 0; cq < 4; ++cq) { const u32x2 z = *(const u32x2*)(ug + 12288 + ((cq * 4 + ta) * 64 + lane) * 4);
                y[cq] = (f32x4){__uint_as_float(z.x << 16), __uint_as_float(z.x & 0xffff0000u), __uint_as_float(z.y << 16), __uint_as_float(z.y & 0xffff0000u)};
                y[cq] = __builtin_amdgcn_mfma_f32_16x16x32_bf16(A0, Bf[cq][0], y[cq], 0, 0, 0); y[cq] = __builtin_amdgcn_mfma_f32_16x16x32_bf16(A1, Bf[cq][1], y[cq], 0, 0, 0); }
            bf16_t vcur[4][4], vprv[4][4], graw[4][4]; float bonv[4];
#pragma unroll
            for (int r = 0; r < 4; ++r) { const int t = t0 + 16 * ta + 4 * q + r; bonv[r] = bonusg[(size_t)t * 8 + h];
#pragma unroll
                for (int cq = 0; cq < 4; ++cq) { const int col = h * 64 + 16 * cq + m; vcur[r][cq] = proj[(size_t)t * PLD + PC_V + col];
                    vprv[r][cq] = t > 0 ? proj[(size_t)(t - 1) * PLD + PC_V + col] : (bf16_t)0; graw[r][cq] = orwkv[(size_t)t * 512 + col]; } }
#pragma unroll
            for (int r = 0; r < 4; ++r) { const int t = t0 + 16 * ta + 4 * q + r;
                float sm = row16_sum(y[0][r] + y[1][r] + y[2][r] + y[3][r]);
                const float mean = sm * (1.0f / 64.0f); float d[4], vs = 0.f;
#pragma unroll
                for (int cq = 0; cq < 4; ++cq) { d[cq] = y[cq][r] - mean; vs += d[cq] * d[cq]; }
                vs = row16_sum(vs);
                const float rstd = rsqrtf(vs * (1.0f / 64.0f) + 64e-5f); const float bon = bonv[r];
#pragma unroll
                for (int cq = 0; cq < 4; ++cq) { const int col = h * 64 + 16 * cq + m; const float vc = bf2f(vcur[r][cq]); const float v = vc + (bf2f(vprv[r][cq]) - vc) * muv[cq];
                    orwkv[(size_t)t * 512 + col] = (bf16_t)f2bf((d[cq] * rstd * lnw[cq] + lnb[cq] + bon * v) * bf2f(graw[r][cq])); } }
        }
    }
}


constexpr int AT_K = 0, AT_V = 9216, AT_SCORE = 18432  , AT_BIAS = 110592, AT_SELM = 126976, AT_LIST = 129024, AT_NLIST = 130048, AT_NEED = 130080, AT_REL = 130176  ;
__device__ __forceinline__ void vt_transpose(const Ctx& c, const bf16_t* proj, bf16_t* vt) {
    LAS bf16_t* tl = (LAS bf16_t*)c.lds;
    for (int it = c.bid; it < 3 * 2 * 256; it += c.G) {
        const int which = it / 512, g = (it >> 8) & 1, tt = it & 255;
        const int col = (which == 0 ? PC_VS : (which == 1 ? PC_VW : PC_SV)) + g * 64;
        { const int tok = c.tid >> 3, ch = c.tid & 7; const u32x4 w = *(const u32x4*)(proj + (size_t)(tt * 64 + tok) * PLD + col + ch * 8);
          *(LAS u32x4*)(tl + tok * 72 + ch * 8) = w; }
        __syncthreads();
        { const int d = c.tid >> 3, ch = c.tid & 7; unsigned short e[8];
#pragma unroll
          for (int k = 0; k < 8; ++k) e[k] = tl[(ch * 8 + k) * 72 + d];
          u32x4 w; w.x = e[0] | ((unsigned)e[1] << 16); w.y = e[2] | ((unsigned)e[3] << 16); w.z = e[4] | ((unsigned)e[5] << 16); w.w = e[6] | ((unsigned)e[7] << 16);
          *(u32x4*)(vt + ((size_t)(which * 2 + g) * 64 + d) * T + tt * 64 + ch * 8) = w; }
        __syncthreads();
    }
}

template <int MODE, int NQ, int DBG = 0>
__device__ __forceinline__ void phase_attn(const Ctx& c, const Args& a, int layer, const bf16_t* proj, const bf16_t* vtb, const bf16_t* kcb, const bf16_t* vctb,
                                           unsigned* sel, float* nsaacc, bf16_t* oout) {
    LAS unsigned char* L = c.lds;
    LAS float* sscore = (LAS float*)(L + AT_SCORE);
    LAS float* biasd = (LAS float*)(L + AT_BIAS);
    LAS unsigned* selm = (LAS unsigned*)(L + AT_SELM);
    LAS int* list = (LAS int*)(L + AT_LIST);
    LAS int* nlist = (LAS int*)(L + AT_NLIST);
    LAS unsigned* need = (LAS unsigned*)(L + AT_NEED);
    const int lane = c.lane, wave = c.wave, n = lane & 15, q = lane >> 4, hr = n & 3;
    LAS float* reltab = (LAS float*)(L + AT_REL);
    __syncthreads();
    reltab[c.tid] = inptr(c, I_REL)[c.tid];
    constexpr int TW = 4 * NQ, TB = 8 * TW, NU = T / TB, TS = (MODE == 3) ? 6 : 1;
    for (int unit = c.bid; unit < 2 * NU; unit += c.G) {
        const int g = unit / NU, t0 = ((g == 0) ? (unit % NU) : (NU - 1 - unit % NU)) * TB, tw0 = t0 + wave * TW;
        __syncthreads();
        for (int e = c.tid; e < 4096; e += 512) { const int r = e >> 10, d = e & 1023; biasd[e] = reltab[t5_bucket(d) * 16 + (MODE == 0 ? 8 : 0) + g * 4 + r]; }
        if (MODE == 3) {
            if (c.tid < 8) need[c.tid] = 0u;
            __syncthreads();
            { const int tok = c.tid >> 3, w8 = c.tid & 7; const unsigned mw = selp((unsigned char*)sel, t0 + tok, g)[w8]; selm[tok * 8 + w8] = mw; atomicOr((unsigned*)&need[w8], mw); }
            __syncthreads();
            if (c.tid < 256) { const int j = c.tid; const unsigned wd = need[j >> 5];
                if ((wd >> (j & 31)) & 1u) { int pos = __popc(wd & ((1u << (j & 31)) - 1u)); for (int w2 = 0; w2 < (j >> 5); ++w2) pos += __popc(need[w2]); list[pos] = j; } }
            if (c.tid == 0) { int cnt = 0; for (int w2 = 0; w2 < 8; ++w2) cnt += __popc(need[w2]); nlist[0] = cnt; }
        }
        __syncthreads();
        int ntiles, tile_lo = 0;
        if (MODE == 0) { ntiles = 2 + TB / 64; tile_lo = t0 - 128; }
        else if (MODE == 1) { ntiles = 8 + TB / 64; tile_lo = t0 - 512; }
        else if (MODE == 2) { const int cmax = (t0 + TB - 1 - 31) >> 4; ntiles = cmax < 0 ? 0 : (cmax >> 6) + 1; }
        else ntiles = nlist[0];
        const bf16_t* Ksrc; size_t kstride; const bf16_t* Vsrc; size_t vstride; int qcol;
        if (MODE == 0) { Ksrc = proj + PC_SK + g * 64; kstride = PLD; Vsrc = vtb + (size_t)(4 + g) * 64 * T; vstride = T; qcol = PC_SQ + g * 256; }
        else if (MODE == 1) { Ksrc = proj + PC_KW + g * 64; kstride = PLD; Vsrc = vtb + (size_t)(2 + g) * 64 * T; vstride = T; qcol = PC_NQ + g * 256; }
        else if (MODE == 2) { Ksrc = kcb + (size_t)g * 1024 * 64; kstride = 64; Vsrc = vctb + (size_t)g * 64 * 1024; vstride = 1024; qcol = PC_NQ + g * 256; }
        else { Ksrc = proj + PC_KS + g * 64; kstride = PLD; Vsrc = vtb + (size_t)(0 + g) * 64 * T; vstride = T; qcol = PC_NQ + g * 256; }
        bf16x8 Bq[NQ][2];
#pragma unroll
        for (int qd = 0; qd < NQ; ++qd) { const bf16_t* qp = proj + (size_t)(tw0 + 4 * qd + (n >> 2)) * PLD + qcol + hr * 64 + 8 * q;
            Bq[qd][0] = *(const bf16x8*)qp; Bq[qd][1] = *(const bf16x8*)(qp + 32); }
        const float bfar = biasd[hr * 1024 + 1023];
        float mrun[NQ], lrun[NQ]; f32x4 O[NQ][4];
#pragma unroll
        for (int qd = 0; qd < NQ; ++qd) { mrun[qd] = -1e30f; lrun[qd] = 0.f;
#pragma unroll
            for (int dt = 0; dt < 4; ++dt) O[qd][dt] = (f32x4){0.f, 0.f, 0.f, 0.f}; }
        float carry3[NQ]; for (int i = 0; i < NQ; ++i) carry3[i] = 0.f;
        const int npass = (MODE == 2) ? 2 : 1;
        for (int pass = 0; pass < npass; ++pass) {
            const bool do_pv = (MODE != 2) || pass == 1;
            float linv[NQ];
            if (MODE == 2 && pass == 1) {
#pragma unroll
                for (int qd = 0; qd < NQ; ++qd) { float mt = mrun[qd]; mt = fmaxf(mt, __shfl_xor(mt, 16)); mt = fmaxf(mt, __shfl_xor(mt, 32));
                    float lt = lrun[qd] * __expf(mrun[qd] - mt); lt += __shfl_xor(lt, 16); lt += __shfl_xor(lt, 32); mrun[qd] = mt; linv[qd] = lt > 0.f ? 1.0f / lt : 0.f; }
            }
#define AT_TILEPOS(ti) ((MODE == 3) ? list[ti] * 64 : (MODE == 2 ? (ti) * 64 : tile_lo + (ti) * 64))
#define AT_ISSUE(rd) do { _Pragma("unroll") for (int i_ = 0; i_ < TS; ++i_) { const int ti_ = (rd) * TS + i_; p0n[i_] = ti_ < ntiles ? AT_TILEPOS(ti_) : -1; \
        if (p0n[i_] >= 0) { kreg[i_] = *(const u32x4*)(Ksrc + (size_t)(p0n[i_] + (c.tid >> 3)) * kstride + (c.tid & 7) * 8); \
            if (do_pv) vreg[i_] = *(const u32x4*)(Vsrc + (size_t)(c.tid >> 3) * vstride + p0n[i_] + (c.tid & 7) * 8); } } } while (0)
            u32x4 kreg[TS], vreg[TS]; int p0n[TS];
            const int nrounds = (ntiles + TS - 1) / TS;
            if (nrounds > 0) AT_ISSUE(0);
            for (int rd = 0; rd < nrounds; ++rd) {
                int p0s[TS];
#pragma unroll
                for (int i = 0; i < TS; ++i) p0s[i] = p0n[i];
                __syncthreads();
#pragma unroll
                for (int i = 0; i < TS; ++i) if (p0s[i] >= 0) { *(LAS u32x4*)(L + AT_K + i * 18432 + (c.tid >> 3) * 144 + (c.tid & 7) * 16) = kreg[i];
                    if (do_pv) *(LAS u32x4*)(L + AT_V + i * 18432 + (c.tid >> 3) * 144 + (c.tid & 7) * 16) = vreg[i]; }
                if (rd + 1 < nrounds) AT_ISSUE(rd + 1);
                __syncthreads();
#pragma unroll
              for (int ts = 0; ts < TS; ++ts) {
                const int p0 = p0s[ts]; const int LK = AT_K + ts * 18432, LV = AT_V + ts * 18432;
                if (p0 < 0) continue;
                if (MODE == 0) { if (p0 > tw0 + TW - 1 || p0 + 63 < tw0 - 127) continue; }
                if (MODE == 1) { if (p0 > tw0 + TW - 1 || p0 + 63 < tw0 - 511) continue; }
                if (MODE == 2) { if (16 * p0 + 31 > tw0 + TW - 1) continue; }
                if (MODE == 3) { if (p0 > tw0 + TW - 1) continue; }
                const bool far = (MODE == 2) ? (tw0 - (16 * (p0 + 63) + 31) >= 790) : ((MODE == 3) ? (tw0 - (p0 + 63) >= 790) : false);
                const int jblk = p0 >> 6;
                bf16x8 akf[4][2]; bf16x8 avf[2][4];
                if (MODE != 3) {
#pragma unroll
                    for (int kt = 0; kt < 4; ++kt)
#pragma unroll
                        for (int ks = 0; ks < 2; ++ks) akf[kt][ks] = *(const LAS bf16x8*)(L + LK + (16 * kt + n) * 144 + (32 * ks + 8 * q) * 2);
                    if (do_pv) {
#pragma unroll
                        for (int st = 0; st < 2; ++st)
#pragma unroll
                            for (int dt = 0; dt < 4; ++dt) { const LAS unsigned char* vp = L + LV + (16 * dt + n) * 144 + (32 * st + 4 * q) * 2;
                                const u32x2 v0 = *(const LAS u32x2*)vp, v1 = *(const LAS u32x2*)(vp + 32); u32x4 vw; vw.x = v0.x; vw.y = v0.y; vw.z = v1.x; vw.w = v1.y; avf[st][dt] = __builtin_bit_cast(bf16x8, vw); } }
                }
                unsigned tokmask = 0u;
                if (MODE == 3) { tokmask = (unsigned)__ballot(lane < TW && ((selm[(wave * TW + (lane & (TW - 1))) * 8 + (jblk >> 5)] >> (jblk & 31)) & 1u)); if (tokmask == 0u) continue; }
#pragma unroll
                for (int qd = 0; qd < NQ; ++qd) {
                    const int tq = tw0 + 4 * qd + (n >> 2);
                    if (DBG == 3) continue;
                    bool colsel = true;
                    if (MODE == 3) { colsel = (tokmask >> (4 * qd + (n >> 2))) & 1u; if (((tokmask >> (4 * qd)) & 0xfu) == 0u) continue; }
                    {
                        f32x4 sc[4];
#pragma unroll
                        for (int kt = 0; kt < 4; ++kt) { sc[kt] = (f32x4){0.f, 0.f, 0.f, 0.f};
#pragma unroll
                            for (int ks = 0; ks < 2; ++ks) { const bf16x8 ak = (MODE != 3) ? akf[kt][ks] : *(const LAS bf16x8*)(L + LK + (16 * kt + n) * 144 + (32 * ks + 8 * q) * 2);
                                sc[kt] = __builtin_amdgcn_mfma_f32_16x16x32_bf16(ak, Bq[qd][ks], sc[kt], 0, 0, 0); } }
                        float mx = -1e30f;
                        if (far) {
#pragma unroll
                            for (int kt = 0; kt < 4; ++kt)
#pragma unroll
                                for (int r = 0; r < 4; ++r) { const float s2 = (MODE == 3 && !colsel) ? -1e30f : sc[kt][r] + bfar; sc[kt][r] = s2; mx = fmaxf(mx, s2); }
                        } else {
#pragma unroll
                        for (int kt = 0; kt < 4; ++kt)
#pragma unroll
                            for (int r = 0; r < 4; ++r) { const int kl = 16 * kt + 4 * q + r; int dist; bool v;
                                if (MODE == 2) { dist = tq - (16 * (p0 + kl) + 31); v = dist >= 0; }
                                else { dist = tq - (p0 + kl); v = dist >= 0; if (MODE == 0) v = v && dist < 128; if (MODE == 1) v = v && dist < 512; if (MODE == 3) v = v && colsel; }
                                const int di = dist < 0 ? 0 : (dist > 1023 ? 1023 : dist);
                                const float s2 = v ? sc[kt][r] + biasd[hr * 1024 + di] : -1e30f; sc[kt][r] = s2; mx = fmaxf(mx, s2); }
                        }
                        float p[4][4];
                        if (MODE == 2 && pass == 1) {
#pragma unroll
                            for (int kt = 0; kt < 4; ++kt)
#pragma unroll
                                for (int r = 0; r < 4; ++r) p[kt][r] = __expf(sc[kt][r] - mrun[qd]) * linv[qd];
                        } else if (MODE == 2) {
                            const float mn = fmaxf(mrun[qd], mx), corr = __expf(mrun[qd] - mn); mrun[qd] = mn; float ps = 0.f;
                            const float mne = mn < -1e29f ? 0.f : mn;
#pragma unroll
                            for (int kt = 0; kt < 4; ++kt)
#pragma unroll
                                for (int r = 0; r < 4; ++r) ps += __expf(sc[kt][r] - mne);
                            lrun[qd] = lrun[qd] * corr + ps;
                        } else {
                            if (__any(mx > mrun[qd])) {
                                mx = fmaxf(mx, __shfl_xor(mx, 16)); mx = fmaxf(mx, __shfl_xor(mx, 32));
                                const float mn = fmaxf(mrun[qd], mx), corr = __expf(mrun[qd] - mn); mrun[qd] = mn;
                                lrun[qd] *= corr;
#pragma unroll
                                for (int dt = 0; dt < 4; ++dt) O[qd][dt] = O[qd][dt] * corr;
                            }
                            const float mne = mrun[qd] < -1e29f ? 0.f : mrun[qd]; float ps = 0.f;
#pragma unroll
                            for (int kt = 0; kt < 4; ++kt)
#pragma unroll
                                for (int r = 0; r < 4; ++r) { p[kt][r] = (DBG == 2) ? sc[kt][r] - mne : __expf(sc[kt][r] - mne); ps += p[kt][r]; }
                            lrun[qd] += ps;
                        }
                        if (MODE == 2 && pass == 1) {
                            float i3prev = carry3[qd];
#pragma unroll
                            for (int kt = 0; kt < 4; ++kt) { float im[4];
#pragma unroll
                                for (int r = 0; r < 4; ++r) { float v = p[kt][r]; v += dpp_xor1(v); v += dpp_xor2(v); im[r] = v; }
                                const float same = __shfl(im[3], (lane + 48) & 63), prevt = __shfl(i3prev, (lane + 48) & 63);
                                const float pv3 = q > 0 ? same : prevt;
                                const int jg = (p0 + 16 * kt + 4 * q) >> 2;
                                if (hr == 0 && jg < 256) sscore[(tq - t0) * 256 + jg] = 2.0f * (im[0] + im[1] + im[2]) + im[3] + pv3;
                                i3prev = im[3]; }
                            carry3[qd] = i3prev;
                        }
                        if (do_pv && DBG != 1) {
#pragma unroll
                            for (int st = 0; st < 2; ++st) {
                                u32x4 pw; pw.x = pk2(p[2 * st][0], p[2 * st][1]); pw.y = pk2(p[2 * st][2], p[2 * st][3]); pw.z = pk2(p[2 * st + 1][0], p[2 * st + 1][1]); pw.w = pk2(p[2 * st + 1][2], p[2 * st + 1][3]);
                                const bf16x8 pf = __builtin_bit_cast(bf16x8, pw);
#pragma unroll
                                for (int dt = 0; dt < 4; ++dt) { bf16x8 av;
                                    if (MODE != 3) av = avf[st][dt];
                                    else { const LAS unsigned char* vp = L + LV + (16 * dt + n) * 144 + (32 * st + 4 * q) * 2;
                                        const u32x2 v0 = *(const LAS u32x2*)vp, v1 = *(const LAS u32x2*)(vp + 32); u32x4 vw; vw.x = v0.x; vw.y = v0.y; vw.z = v1.x; vw.w = v1.y; av = __builtin_bit_cast(bf16x8, vw); }
                                    O[qd][dt] = __builtin_amdgcn_mfma_f32_16x16x32_bf16(av, pf, O[qd][dt], 0, 0, 0); } }
                        }
                    }
                }
              }
            }
        }
#undef AT_ISSUE
#undef AT_TILEPOS
        if (MODE == 2) {
            __syncthreads();
#pragma unroll 1
            for (int tk = 0; tk < TW; ++tk) { const int t = tw0 + tk, cur = t >> 6; const LAS float* sp = sscore + (wave * TW + tk) * 256;
                unsigned key[4]; bool forced[4];
#pragma unroll
                for (int jj = 0; jj < 4; ++jj) { const int j = lane + 64 * jj; forced[jj] = (j == 0 || j == cur || j == cur - 1);
                    key[jj] = (!forced[jj] && j < cur - 1) ? __float_as_uint(sp[j]) + 1u : 0u; }
                const int nforced = cur >= 2 ? 3 : cur + 1;
                unsigned prefix = 0u; int remaining = 16 - nforced;
#pragma unroll 1
                for (int bit = 30; bit >= 0; --bit) { const unsigned test = prefix | (1u << bit); int cnt = 0;
#pragma unroll
                    for (int jj = 0; jj < 4; ++jj) cnt += __popcll(__ballot((key[jj] >> bit) == (test >> bit)));
                    if (cnt >= remaining) prefix = test; else remaining -= cnt; }
                int eqbase = 0;
#pragma unroll
                for (int jj = 0; jj < 4; ++jj) { const bool eq = key[jj] == prefix && key[jj] != 0u; const unsigned long long eb = __ballot(eq);
                    const int eqrank = eqbase + __popcll(eb & ((1ull << lane) - 1ull)); eqbase += __popcll(eb);
                    const bool on = forced[jj] || key[jj] > prefix || (eq && eqrank < remaining); const unsigned long long bl = __ballot(on);
                    if (lane == 0) { unsigned* mp = selp((unsigned char*)sel, t, g); mp[2 * jj] = (unsigned)bl; mp[2 * jj + 1] = (unsigned)(bl >> 32); } }
            }
        }
#pragma unroll
        for (int qd = 0; qd < NQ; ++qd) {
            const int tq = tw0 + 4 * qd + (n >> 2), hh = g * 4 + hr;
            float scale;
            if (MODE == 2) scale = 1.0f;
            else { float lt = lrun[qd]; lt += __shfl_xor(lt, 16); lt += __shfl_xor(lt, 32);
                if (MODE == 0) { const float sink = inptr(c, I_SINK)[layer * 8 + hh]; const float mf = fmaxf(mrun[qd], sink), cr = __expf(mrun[qd] - mf); scale = cr / (lt * cr + __expf(sink - mf)); }
                else scale = lt > 0.f ? 1.0f / lt : 0.f; }
            if (MODE != 0) scale *= sigmoidf_(bf2f(proj[(size_t)tq * PLD + PC_GL + (MODE == 2 ? 0 : (MODE == 3 ? 8 : 16)) + hh]));
#pragma unroll
            for (int dt = 0; dt < 4; ++dt) { const f32x4 o = O[qd][dt] * scale; const int col = hh * 64 + 16 * dt + 4 * q;
                if (MODE == 0) { u32x2 w; w.x = pk2(o[0], o[1]); w.y = pk2(o[2], o[3]); *(u32x2*)(oout + (size_t)tq * 512 + col) = w; }
                else if (MODE == 2) *(f32x4*)(nsaacc + (size_t)tq * 512 + col) = o;
                else if (MODE == 1) { f32x4* ap = (f32x4*)(nsaacc + (size_t)tq * 512 + col); *ap = *ap + o; }
                else { const f32x4 t2 = *(const f32x4*)(nsaacc + (size_t)tq * 512 + col) + o; u32x2 w; w.x = pk2(t2[0], t2[1]); w.y = pk2(t2[2], t2[3]); *(u32x2*)(oout + (size_t)tq * 512 + col) = w; } }
        }
    }
}
#define wb ((bf16_t*)(ws + WS_WB))
#define xb ((bf16_t*)(ws + WS_XB))
#define cntp ((unsigned*)(ws + WS_CNT))
#define xres (args.out)
#define kcb ((bf16_t*)(ws + WS_KCB))
#define vctb ((bf16_t*)(ws + WS_VCT))
#define vtb ((bf16_t*)(ws + WS_VT))
#define scores ((float*)(ws + WS_SCORES))
#define sel ((unsigned*)ws)
#define ml ((float*)(ws + WS_ML))
#define hidb ((bf16_t*)(ws + WS_HID))
#define proj ((bf16_t*)(ws + WS_PROJ))
#define gates ((bf16_t*)(ws + WS_GATES))
#define merged ((bf16_t*)(ws + WS_MERGED))
#define tmpb ((bf16_t*)(ws + WS_TMPB))
#define alora ((bf16_t*)(ws + WS_ALORA))
#define rwu ((bf16_t*)(ws + WS_RWU))
#define rws ((bf16_t*)(ws + WS_RWS))
#define bonusg ((float*)(ws + WS_BONUS))
#define nsaacc ((float*)(ws + WS_NSAACC))
#define obuf ((bf16_t*)(ws + WS_O))
#define act ((bf16_t*)(ws + WS_ACT))
#define tmpf ((bf16_t*)(ws + WS_TMPF))
constexpr int PH_PER_BATCH = 8, PH_PER_LAYER = 1 + 2 * PH_PER_BATCH + 2, PH_TOTAL = 1 + DEPTH * PH_PER_LAYER;

__global__ void __launch_bounds__(512, 2) fwd_kernel(Args args) {
    extern __shared__ __attribute__((aligned(16))) unsigned char lds_raw[];
    Ctx c0; c0.lds = (LAS unsigned char*)lds_raw; c0.tid = threadIdx.x; c0.lane = c0.tid & 63; c0.wave = __builtin_amdgcn_readfirstlane(c0.tid >> 6); c0.G = gridDim.x; c0.bid = blockIdx.x; const Ctx& c = c0;
    unsigned char* ws = args.ws;
    volatile LAS unsigned* misc = (volatile LAS unsigned*)(c.lds + LDS_MISC);
    if (c.tid < 4) misc[c.tid] = 0u;
    if (c.tid < 30) { const unsigned long long pv = (unsigned long long)args.in[c.tid & 31]; misc[16 + 2 * c.tid] = (unsigned)pv; misc[17 + 2 * c.tid] = (unsigned)(pv >> 32); }
    __syncthreads();
    XcdBarrier bar; bar.bar = (unsigned*)(ws + WS_CTL); bar.x = 0; bar.st = misc;
    const int lo = args.lo, hi = args.hi;
    const bool multi = (hi - lo) > 1;
    if (multi) bar = xcd_barrier_post((unsigned*)(ws + WS_CTL), misc);
    int gp = 0;
#ifndef ONLY_PH
#define ONLY_PH -1
#endif
#ifndef PHMASK
#define PHMASK 0xffffff
#endif
#ifndef REPMASK
#define REPMASK 0
#endif
#ifndef PR_SEL
#define PR_SEL 0
#endif
#ifndef PR_SWA
#define PR_SWA 0
#endif
#ifndef PR_CMP
#define PR_CMP 0
#endif
#ifndef PR_CHUNK
#define PR_CHUNK 0
#endif
#define PHASE_BEGIN(id) if (gp >= lo && gp < hi) { for (int rep_ = 0; rep_ < (((REPMASK >> (id)) & 1) ? 2 : 1); ++rep_) { if (rep_) __syncthreads(); \
    Ctx pc = c0; asm volatile("" : "+v"(pc.tid), "+s"(pc.bid)); pc.lane = pc.tid & 63; pc.wave = __builtin_amdgcn_readfirstlane(pc.tid >> 6); const Ctx& c = pc;
#define PHASE_END   } if (gp + 1 < hi) xcd_barrier(bar); } ++gp;
#define RELAUNDER() do { asm volatile("" : "+v"(pc.tid), "+s"(pc.bid)); pc.lane = pc.tid & 63; pc.wave = __builtin_amdgcn_readfirstlane(pc.tid >> 6); } while (0)

    PHASE_BEGIN(0) phase_init(c, inptr(c, I_X), xres, xb, ws); PHASE_END

    for (int layer = 0; layer < DEPTH; ++layer) {
        PHASE_BEGIN(1) phase_cvt(c, args, layer, wb); PHASE_END
        for (int b = 0; b < NBATCH; ++b) {
            const int row0 = b * T;
            PHASE_BEGIN(2) {
                pg8::Gemm g{xb + (size_t)row0 * D, wb + WB_WIN, D, D, D}; pg8::Sched S; S.init(T / 256, NIN / 256, c.G, c.bid, 1, (size_t)256 * D * 2, 0, (size_t)256 * D * 2, 0);
                pg8::EpiInProj E{proj, gates, ws, row0}; pg8::gemm_phase(c.lds, c.tid, g, S, E); } PHASE_END
            PHASE_BEGIN(16) {
                { pg8::Gemm g{proj, wb + WB_W1T, 16 * PLD, 2048, 2048, (unsigned)PLD * 2}; pg8::Sched S; S.init(16, 1, c.G, c.bid, 1, 0, 0, 0, 0); S.mode = 1;
                  pg8::EpiCmp1 E{hidb, (const float*)(wb + WB_BH)}; pg8::gemm_phase(c.lds, c.tid, g, S, E); }
                RELAUNDER();
                if (c.bid >= 16) { Ctx cv = c; cv.bid = c.bid - 16; cv.G = c.G - 16; phase_lora_a(cv, args, layer, proj, alora); vt_transpose(cv, proj, vtb); } } PHASE_END
            PHASE_BEGIN(17) {
                { pg8::Gemm g{alora, wb + WB_LORA, 256, 256, 256}; pg8::Sched S; S.init(T / 256, 6, c.G, c.bid, 1, (unsigned)256 * 256 * 2, 0, (unsigned)256 * 256 * 2, 0);
                  pg8::EpiLora E{obuf}; pg8::gemm_phase(c.lds, c.tid, g, S, E); }
                RELAUNDER();
                { pg8::Gemm g{hidb, wb + WB_W2T, 256, 256, 256}; pg8::Sched S; S.init(16, 1, c.G, (c.bid + 16) % c.G, 1, (unsigned)256 * 256 * 2, 0, 0, 0); S.mode = 2;
                  pg8::EpiCmp2 E{kcb, vctb}; pg8::gemm_phase(c.lds, c.tid, g, S, E); } } PHASE_END
            PHASE_BEGIN(18) {
                for (int pr_ = 0; pr_ <= PR_CHUNK; ++pr_) { phase_rwkv_chunk(c, args, layer, proj, obuf + (size_t)T * 512, obuf + (size_t)2 * T * 512, rwu, bonusg);
                __syncthreads(); RELAUNDER(); }
                for (int pr_ = 0; pr_ <= PR_CMP; ++pr_) { phase_attn<2, 2>(c, args, layer, proj, vtb, kcb, vctb, sel, nsaacc, obuf + (size_t)T * 512); __syncthreads(); } } PHASE_END
            PHASE_BEGIN(19) {
                phase_rwkv_scan<0>(c, rwu, rws);
                RELAUNDER();
                if (c.bid >= 32) { Ctx cv = c; cv.bid = c.bid - 32; cv.G = c.G - 32;
                    phase_attn<1, 2>(cv, args, layer, proj, vtb, kcb, vctb, sel, nsaacc, obuf + (size_t)T * 512);
                    asm volatile("" : "+v"(cv.tid), "+s"(cv.bid)); cv.lane = cv.tid & 63; cv.wave = __builtin_amdgcn_readfirstlane(cv.tid >> 6);
                    for (int pr_ = 0; pr_ <= PR_SWA; ++pr_) { phase_attn<0, 2>(cv, args, layer, proj, vtb, kcb, vctb, sel, nsaacc, obuf + (size_t)2 * T * 512); __syncthreads(); } } } PHASE_END
            PHASE_BEGIN(9) {
                phase_rwkv_out(c, args, layer, proj, rwu, rws, bonusg, obuf);
                __syncthreads(); RELAUNDER();
                #if PR_SEL > 1
                { phase_attn<3, 2, PR_SEL - 1>(c, args, layer, proj, vtb, kcb, vctb, sel, nsaacc, obuf + (size_t)T * 512); __syncthreads(); }
#endif
                for (int pr_ = 0; pr_ <= (PR_SEL == 1 ? 1 : 0); ++pr_) { phase_attn<3, 2>(c, args, layer, proj, vtb, kcb, vctb, sel, nsaacc, obuf + (size_t)T * 512); __syncthreads(); } } PHASE_END
            PHASE_BEGIN(10) {
                pg8::Gemm g{obuf, wb + WB_WBR, 512, 512, 512}; pg8::Sched S; S.init(T / 256, D / 256, c.G, c.bid, 3, (size_t)256 * 512 * 2, (size_t)T * 512 * 2, (size_t)256 * 512 * 2, (size_t)D * 512 * 2);
                pg8::EpiMerge E{gates, merged}; pg8::gemm_phase(c.lds, c.tid, g, S, E); } PHASE_END
            PHASE_BEGIN(11) {
                pg8::Gemm g{merged, wb + WB_WOUT, D, D, D}; pg8::Sched S; S.init(T / 256, D / 256, c.G, c.bid, 1, (unsigned)256 * D * 2, 0, (unsigned)256 * D * 2, 0);
                pg8::EpiNorm E{xres, xb, inptr(c, I_NQM) + layer * D, ws, cntp, row0, 1, 16u * (2u * layer + 1u), c.lds, c.tid}; pg8::gemm_phase(c.lds, c.tid, g, S, E); } PHASE_END
        }
        PHASE_BEGIN(13) {
            pg8::Gemm g{xb, wb + WB_WGU, D, D, D}; pg8::Sched S; S.init(MROWS / 256, 2 * FFN / 256, c.G, c.bid, 1, (size_t)256 * D * 2, 0, (size_t)256 * D * 2, 0);
            pg8::EpiSwiGLU E{act, ws}; pg8::gemm_phase(c.lds, c.tid, g, S, E); } PHASE_END
        PHASE_BEGIN(14) {
            { pg8::Gemm g{act, wb + WB_WDN, FFN, FFN, FFN}; pg8::Sched S; S.init(T / 256, D / 256, c.G, c.bid, 1, (unsigned)256 * FFN * 2, 0, (unsigned)256 * FFN * 2, 0);
              pg8::EpiNorm E{xres, xb, inptr(c, I_NQF) + layer * D, ws, cntp, 0, 0, 16u * (2u * layer + 2u), c.lds, c.tid}; pg8::gemm_phase(c.lds, c.tid, g, S, E); }
            __syncthreads(); RELAUNDER();
            { pg8::Gemm g{act + (size_t)T * FFN, wb + WB_WDN, FFN, FFN, FFN}; pg8::Sched S; S.init(T / 256, D / 256, c.G, c.bid, 1, (unsigned)256 * FFN * 2, 0, (unsigned)256 * FFN * 2, 0);
              pg8::EpiNorm E{xres, xb, inptr(c, I_NQF) + layer * D, ws, cntp, T, 0, 16u * (2u * layer + 2u), c.lds, c.tid}; pg8::gemm_phase(c.lds, c.tid, g, S, E); } } PHASE_END
    }
#undef PHASE_BEGIN
#undef PHASE_END
}

extern "C" void kernel_launch(void* const* d_in, const int* in_sizes, int n_in, void* d_out, int out_size, void* d_ws, size_t ws_size, hipStream_t stream) {
    static int grid = 0;
    if (grid == 0) {
        if (n_in != 30 || out_size != MROWS * D || ws_size < WS_END) { fprintf(stderr, "kernel_launch: unexpected shapes (n_in %d out %d ws %zu)\n", n_in, out_size, ws_size); grid = -1; return; }
        int dev = 0, cus = 0;
        if (hipGetDevice(&dev) != hipSuccess || hipDeviceGetAttribute(&cus, hipDeviceAttributeMultiprocessorCount, dev) != hipSuccess) { grid = -1; return; }
        if (hipFuncSetAttribute((const void*)fwd_kernel, hipFuncAttributeMaxDynamicSharedMemorySize, LDS_BYTES) != hipSuccess) { fprintf(stderr, "hipFuncSetAttribute failed\n"); grid = -1; return; }
        int per_cu = 0;
        if (hipOccupancyMaxActiveBlocksPerMultiprocessor(&per_cu, (const void*)fwd_kernel, 512, LDS_BYTES) != hipSuccess || per_cu < 1) { fprintf(stderr, "occupancy query: %d\n", per_cu); }
        (void)hipGetLastError();
        grid = cus;
    }
    if (grid < 0) return;
    (void)hipMemsetAsync((char*)d_ws + WS_CTL, 0, CTL_BYTES, stream);
    Args a{};
    for (int i = 0; i < 30; ++i) a.in[i] = (const float*)d_in[i];
    a.out = (float*)d_out; a.ws = (unsigned char*)d_ws;
#if MK_ONE_LAUNCH
    a.lo = 0; a.hi = PH_TOTAL;
    hipLaunchKernelGGL(fwd_kernel, dim3(grid), dim3(512), LDS_BYTES, stream, a);
#else
    for (int p = 0; p < PH_TOTAL; ++p) { a.lo = p; a.hi = p + 1; hipLaunchKernelGGL(fwd_kernel, dim3(grid), dim3(512), LDS_BYTES, stream, a); }
#endif
}
```

```cpp
#include <hip/hip_runtime.h>
#include <stdint.h>
#include <stdio.h>

#ifndef MK_ONE_LAUNCH
#define MK_ONE_LAUNCH 1
#endif

#define LAS __attribute__((address_space(3)))
typedef unsigned short bf16_t;
typedef short bf16x8 __attribute__((ext_vector_type(8)));
typedef float f32x4 __attribute__((ext_vector_type(4)));
typedef float f32x2 __attribute__((ext_vector_type(2)));
typedef unsigned u32x4 __attribute__((ext_vector_type(4)));
typedef unsigned u32x2 __attribute__((ext_vector_type(2)));

constexpr int D = 1024, NBATCH = 2, T = 16384, DEPTH = 4, MROWS = NBATCH * T;
constexpr int IN_COLS = 6936, FFN = 2816;
constexpr int PLD = 4096;
constexpr int PC_R = 0, PC_K = 512, PC_V = 1024, PC_ZW = 1536, PC_ZA = 1600, PC_ZG = 1664;
constexpr int PC_NQ = 1792, PC_KC = 2304, PC_VC = 2432, PC_KS = 2560, PC_VS = 2688, PC_KW = 2816, PC_VW = 2944, PC_GL = 3072;
constexpr int PC_SQ = 3328, PC_SK = 3840, PC_SV = 3968;
constexpr int NIN = 7168;
constexpr int NCMP = 1023;
constexpr float NORM_EPS = 1e-6f;

constexpr size_t MiB = 1u << 20;
constexpr size_t WS_CTL = 0, CTL_BYTES = 65536;
constexpr size_t WS_WB = 65536;
constexpr size_t WB_WIN = 0, WB_WBR = WB_WIN + (size_t)NIN * D, WB_WOUT = WB_WBR + (size_t)3 * D * 512, WB_WGU = WB_WOUT + (size_t)D * D,
                 WB_WDN = WB_WGU + (size_t)2 * FFN * D, WB_LORA = WB_WDN + (size_t)D * FFN, WB_W1T = WB_LORA + (size_t)1536 * 256, WB_W2T = WB_W1T + (size_t)2 * 256 * 2048,
                 WB_BH = WB_W2T + (size_t)2 * 256 * 256, WB_END = WB_BH + 1024;
static_assert(WS_WB + WB_END * 2 <= 38 * MiB + 786432, "weights");
constexpr size_t KiB = 1024;
constexpr size_t WS_XB = 38 * MiB + 768 * KiB;
constexpr size_t WS_CNT = 16384;
constexpr size_t WS_RS = WS_XB + 64 * MiB;
constexpr size_t WS_BONUS = WS_RS + 128 * KiB;
constexpr size_t WS_KCB = WS_BONUS + 512 * KiB;
constexpr size_t WS_VCT = WS_KCB + 256 * KiB;
constexpr size_t WS_STATS = WS_VCT + 256 * KiB;
constexpr size_t WS_SEL = WS_STATS;
constexpr size_t WS_HID = WS_SEL + 1 * MiB;
constexpr size_t WS_ML = WS_HID;
static_assert(WS_HID + 2 * MiB <= 107 * MiB, "small region");
constexpr size_t WS_ALORA = 107 * MiB;
constexpr size_t WS_VT = 115 * MiB;
constexpr size_t WS_BIG = 127 * MiB;
constexpr size_t WS_PROJ = WS_BIG;
constexpr size_t WS_GATES = WS_PROJ + 128 * MiB;
constexpr size_t WS_RWKVS = WS_GATES + 96 * MiB;
constexpr size_t WS_RWU = WS_RWKVS;
constexpr size_t WS_RWS = WS_RWKVS + 64 * MiB;
constexpr size_t WS_SCORES = WS_RWKVS;
constexpr size_t WS_MERGED = WS_RWKVS;
constexpr size_t WS_TMPB = WS_RWKVS + 32 * MiB;
constexpr size_t WS_NSAACC = WS_RWKVS + 80 * MiB;
constexpr size_t WS_O = WS_NSAACC + 32 * MiB;
constexpr size_t WS_END = WS_O + 48 * MiB;
constexpr size_t WS_ACT = WS_BIG;
constexpr size_t WS_TMPF = WS_BIG + 176 * MiB;
static_assert(WS_END <= 512 * MiB, "workspace");
static_assert(WS_TMPF + 64 * MiB <= WS_NSAACC, "ffn overlay");

constexpr int LDS_BYTES = 147456;
constexpr int LDS_MISC = 131072 + 8192;

__device__ __forceinline__ float* statp(unsigned char* ws, int row, int kind) {
    return (float*)(ws + WS_STATS + (kind >= 2 ? 524288 : 0)) + (size_t)row * 4; }
__device__ __forceinline__ unsigned* selp(unsigned char* ws, int t, int g) { return (unsigned*)(ws + WS_PROJ + (size_t)t * (PLD * 2) + 6272 + g * 32); }
__device__ __forceinline__ float bf2f(unsigned v) { return __uint_as_float(v << 16); }
typedef __bf16 bf16n2 __attribute__((ext_vector_type(2)));
__device__ __forceinline__ unsigned pk2(float lo, float hi) { const f32x2 f = {lo, hi}; const bf16n2 v = __builtin_convertvector(f, bf16n2); return __builtin_bit_cast(unsigned, v); }
__device__ __forceinline__ unsigned f2bf(float f) { return pk2(f, 0.f) & 0xffffu; }
__device__ __forceinline__ void unpack8(const u32x4 w, float (&f)[8]) {
    f[0] = __uint_as_float(w.x << 16); f[1] = __uint_as_float(w.x & 0xffff0000u); f[2] = __uint_as_float(w.y << 16); f[3] = __uint_as_float(w.y & 0xffff0000u);
    f[4] = __uint_as_float(w.z << 16); f[5] = __uint_as_float(w.z & 0xffff0000u); f[6] = __uint_as_float(w.w << 16); f[7] = __uint_as_float(w.w & 0xffff0000u);
}
#define DPPF(v, ctrl) __int_as_float(__builtin_amdgcn_update_dpp(0, __float_as_int(v), (ctrl), 0xf, 0xf, false))
__device__ __forceinline__ float row16_sum(float v) {
    v += DPPF(v, 0xB1); v += DPPF(v, 0x4E); v += DPPF(v, 0x141); v += DPPF(v, 0x140); return v;
}
__device__ __forceinline__ float wave_sum(float v) {
    v = row16_sum(v);
    const int iv = __float_as_int(v);
    return (__int_as_float(__builtin_amdgcn_readlane(iv, 0)) + __int_as_float(__builtin_amdgcn_readlane(iv, 16))) + (__int_as_float(__builtin_amdgcn_readlane(iv, 32)) + __int_as_float(__builtin_amdgcn_readlane(iv, 48)));
}
__device__ __forceinline__ float dpp_xor1(float v) { return __int_as_float(__builtin_amdgcn_update_dpp(0, __float_as_int(v), 0xB1, 0xf, 0xf, false)); }
__device__ __forceinline__ float dpp_xor2(float v) { return __int_as_float(__builtin_amdgcn_update_dpp(0, __float_as_int(v), 0x4E, 0xf, 0xf, false)); }
__device__ __forceinline__ float sigmoidf_(float x) { return __builtin_amdgcn_rcpf(1.0f + __expf(-x)); }
__device__ __forceinline__ int t5_bucket(int n) {
    if (n < 16) return n;
    int b = 16;
    b += (n >= 21); b += (n >= 27); b += (n >= 35); b += (n >= 46); b += (n >= 59); b += (n >= 77); b += (n >= 99); b += (n >= 128);
    b += (n >= 166); b += (n >= 216); b += (n >= 280); b += (n >= 363); b += (n >= 470); b += (n >= 609); b += (n >= 790);
    return b;
}

#define XB_TMO      128
#define XB_XCNT(j)  (256  + 64 * (j))
#define XB_XSUB(j)  (1280 + 64 * (j))
#define XB_XGEN(j)  (2304 + 64 * (j))
#define XB_TOP      3328
#define XB_TOPGEN   3392
#define XCD_BAR_WORDS 3456
#define XB_SPIN_CAP (1u << 22)
__device__ __forceinline__ unsigned xb_ld(unsigned* p)              { return __hip_atomic_load(p, __ATOMIC_RELAXED, __HIP_MEMORY_SCOPE_AGENT); }
__device__ __forceinline__ unsigned xb_add(unsigned* p, unsigned v) { return __hip_atomic_fetch_add(p, v, __ATOMIC_RELAXED, __HIP_MEMORY_SCOPE_AGENT); }
__device__ __forceinline__ unsigned xb_xcc_id() { return (unsigned)__builtin_amdgcn_s_getreg((3 << 11) | 20) & 0xFu; }
#define XB_SPIN(cond, bar) do { unsigned _sp = 0; while (cond) { __builtin_amdgcn_s_sleep(1); \
    if ((++_sp & 255u) == 0u) { if (xb_ld(&(bar)[XB_TMO])) break; if (_sp > XB_SPIN_CAP) { atomicAdd(&(bar)[XB_TMO], 1u); break; } } } } while (0)
struct XcdBarrier { unsigned* bar; unsigned x; volatile LAS unsigned* st; };
__device__ __forceinline__ XcdBarrier xcd_barrier_post(unsigned* bar, volatile LAS unsigned* st) {
    XcdBarrier b; b.bar = bar; b.x = xb_xcc_id(); b.st = st;
    if (threadIdx.x == 0) (void)xb_add(&bar[XB_XCNT(b.x)], 1u);
    return b;
}
__device__ __forceinline__ void xcd_barrier_complete(unsigned* bar, unsigned x, unsigned& nloc, unsigned& nx) {
    const unsigned G = gridDim.x * gridDim.y * gridDim.z;
    unsigned sum, cnt, mine, sp = 0u;
    for (;;) {
        sum = 0u; cnt = 0u; mine = 0u;
#pragma unroll
        for (unsigned j = 0; j < 16; ++j) { const unsigned c = xb_ld(&bar[XB_XCNT(j)]); sum += c; cnt += (c > 0u) ? 1u : 0u; mine = (j == x) ? c : mine; }
        if (sum == G) break;
        __builtin_amdgcn_s_sleep(1);
        if ((++sp & 255u) == 0u) { if (xb_ld(&bar[XB_TMO])) break; if (sp > XB_SPIN_CAP) { atomicAdd(&bar[XB_TMO], 1u); break; } }
    }
    nloc = mine > 0u ? mine : 1u; nx = cnt > 0u ? cnt : 1u;
}
__device__ __forceinline__ void xcd_barrier(const XcdBarrier& b) {
    asm volatile("s_waitcnt vmcnt(0)" ::: "memory");
    __syncthreads();
    if (threadIdx.x == 0) {
        unsigned* bar = b.bar;
        __builtin_amdgcn_s_waitcnt(0);
        unsigned nloc = b.st[0], nx = b.st[1];
        if (nloc == 0u) { xcd_barrier_complete(bar, b.x, nloc, nx); b.st[0] = nloc; b.st[1] = nx; }
        const unsigned old = xb_add(&bar[XB_XSUB(b.x)], 1u);
        const unsigned gen = old / nloc;
        if (old + 1u == (gen + 1u) * nloc) {
            __builtin_amdgcn_fence(__ATOMIC_RELEASE, "agent");
            asm volatile("s_waitcnt vmcnt(0)" ::: "memory");
            const unsigned og = xb_add(&bar[XB_TOP], 1u);
            const unsigned tg = og / nx;
            if (og + 1u == (tg + 1u) * nx) xb_add(&bar[XB_TOPGEN], 1u);
            else XB_SPIN(xb_ld(&bar[XB_TOPGEN]) == tg, bar);
            __builtin_amdgcn_fence(__ATOMIC_ACQUIRE, "agent");
            xb_add(&bar[XB_XGEN(b.x)], 1u);
            asm volatile("s_waitcnt vmcnt(0)" ::: "memory");
        } else {
            XB_SPIN(xb_ld(&bar[XB_XGEN(b.x)]) == gen, bar);
            __builtin_amdgcn_fence(__ATOMIC_ACQUIRE, "agent");
            asm volatile("s_waitcnt vmcnt(0)" ::: "memory");
        }
    }
    __syncthreads();
}

namespace pg8 {
constexpr int BM = 256, BK = 64, HALF = 128, HTB = HALF * BK * 2, STAGE_BYTES = 8 * HTB, NXCD = 8, WGM = 8;
__device__ __forceinline__ int lds_byte(int r, int c) { const int st = (r >> 4) * 2 + (c >> 5), rr = r & 15, cc = c & 31, ob = rr * 64 + cc * 2; return st * 1024 + (ob ^ (((ob >> 9) & 1) << 5)); }
__device__ __forceinline__ void stage_rc(int b, int& R, int& C) { const int st = b / 1024, sb = b % 1024, swz = sb ^ (((sb >> 9) & 1) << 5); R = (st >> 1) * 16 + swz / 64; C = (st & 1) * 32 + (swz % 64) / 2; }
__device__ __forceinline__ int perm32(int rho) { const int n = rho >> 4, i = rho & 15; return 8 * (i >> 2) + 4 * n + (i & 3); }

template <class E, class = void> struct epi_after_drain { static constexpr bool value = false; };
template <class E> struct epi_after_drain<E, decltype((void)E::AFTER_DRAIN)> { static constexpr bool value = E::AFTER_DRAIN; };
struct Unit { int pm, pn, sub; unsigned aoff, boff; };
struct Gemm { const bf16_t* A; const bf16_t* Bt; int lda, ldb, K; unsigned kstepA = 128; };
struct Sched {
    int nM, nN, nwg, G, c, nsub, mode = 0; unsigned a_row, a_sub, b_row, b_sub;
    __device__ __forceinline__ void init(int nM_, int nN_, int G_, int c_, int nsub_, unsigned a_row_, unsigned a_sub_, unsigned b_row_, unsigned b_sub_) {
        nM = nM_; nN = nN_; nwg = nM * nN; G = G_; c = c_; nsub = nsub_; a_row = a_row_; a_sub = a_sub_; b_row = b_row_; b_sub = b_sub_; }
    __device__ __forceinline__ bool next(int i, Unit& u) const {
        const int round = i / nsub; u.sub = i - round * nsub;
        const long L = (long)round * G + c; if (L >= nwg) return false;
        int wgid = (int)L; { const int q = nwg / NXCD, r = nwg % NXCD, xcd = wgid % NXCD, off = wgid / NXCD; wgid = (xcd < r ? xcd * (q + 1) : r * (q + 1) + (xcd - r) * q) + off; }
        const int nig = WGM * nN, gid = wgid / nig, fm = gid * WGM, gsz = (nM - fm) < WGM ? (nM - fm) : WGM;
        u.pm = fm + ((wgid % nig) % gsz); u.pn = (wgid % nig) / gsz;
        u.aoff = (unsigned)u.pm * a_row + (unsigned)u.sub * a_sub; u.boff = (unsigned)u.pn * b_row + (unsigned)u.sub * b_sub;
        if (mode == 1) { const int kv = u.pm >> 3, g = (u.pm >> 2) & 1, cp = u.pm & 3;
            u.aoff = (unsigned)(((size_t)cp * 256 * 16 * PLD + (kv ? PC_VC : PC_KC) + g * 64) * 2); u.boff = (unsigned)kv * (256u * 2048u * 2u); }
        if (mode == 2) { const int kv = u.pm >> 3; u.boff = (unsigned)kv * (256u * 256u * 2u); }
        return true;
    }
};

template <class Epi>
__device__ __forceinline__ void gemm_phase(LAS unsigned char* lds, const int tid, const Gemm g, const Sched& S, const Epi& E) {
    const int wid = __builtin_amdgcn_readfirstlane(tid >> 6), lane = tid & 63, wr = wid >> 2, wc = wid & 3, fr = lane & 15, fq = lane >> 4;
    const int K = g.K, nt = K / BK;
    unsigned voffA[2], voffB[2];
#pragma unroll
    for (int i = 0; i < 2; ++i) { int R, C; stage_rc(tid * 16 + i * 8192, R, C); const int Rb = Epi::PERM ? ((R & ~31) + perm32(R & 31)) : R;
        voffA[i] = (unsigned)(R * g.lda + C) * 2u; voffB[i] = (unsigned)(Rb * g.ldb + C) * 2u; }
    const size_t kstep = (size_t)(BK * 2), kstA = g.kstepA;
    const size_t hstepA = (size_t)HALF * g.lda * 2, hstepB = (size_t)HALF * g.ldb * 2;
    const unsigned ldsw = (unsigned)wid * 1024u;
    const int aoff = lds_byte(wr * 64 + fr, fq * 8), boff = lds_byte(wc * 32 + fr, fq * 8);
#define PG8_SA(b, h) (((b) * 2 + (h)) * HTB)
#define PG8_SB(b, h) ((4 + (b) * 2 + (h)) * HTB)
#define PG8_STAGE(bufoff, gbase, voff) do { _Pragma("unroll") for (int _i = 0; _i < 2; ++_i) \
        __builtin_amdgcn_global_load_lds((const unsigned*)((const char*)(gbase) + (voff)[_i]), (LAS unsigned*)(lds + (bufoff) + ldsw + _i * 8192), 16, 0, 0); } while (0)
#define PG8_LDA(dst, b, h) do { _Pragma("unroll") for (int m = 0; m < 4; ++m) _Pragma("unroll") for (int k = 0; k < 2; ++k) dst[m][k] = *(const LAS bf16x8*)(lds + PG8_SA(b, h) + aoff + m * 2048 + k * 1024); } while (0)
#define PG8_LDB(dst, b, h) do { _Pragma("unroll") for (int n = 0; n < 2; ++n) _Pragma("unroll") for (int k = 0; k < 2; ++k) dst[n][k] = *(const LAS bf16x8*)(lds + PG8_SB(b, h) + boff + n * 2048 + k * 1024); } while (0)
#define PG8_MMA(ai, bj, At, Bt) do { __builtin_amdgcn_s_setprio(1); _Pragma("unroll") for (int m = 0; m < 4; ++m) _Pragma("unroll") for (int n = 0; n < 2; ++n) _Pragma("unroll") for (int k = 0; k < 2; ++k) \
        acc[ai][bj][m][n] = __builtin_amdgcn_mfma_f32_16x16x32_bf16(Bt[n][k], At[m][k], acc[ai][bj][m][n], 0, 0, 0); __builtin_amdgcn_s_setprio(0); } while (0)
#define PG8_WAIT_V(n) asm volatile("s_waitcnt vmcnt(" #n ")" ::: "memory")
#define PG8_WAIT_L(n) asm volatile("s_waitcnt lgkmcnt(" #n ")" ::: "memory")
#define PG8_BAR __builtin_amdgcn_s_barrier()
#define PG8_SCHED __builtin_amdgcn_sched_barrier(0)
    Unit cur, nxt; int ui = 0;
    if (!S.next(0, cur)) return;
    f32x4 acc[2][2][4][2];
#pragma unroll
    for (int a = 0; a < 2; ++a)
#pragma unroll
        for (int b = 0; b < 2; ++b)
#pragma unroll
            for (int m = 0; m < 4; ++m)
#pragma unroll
                for (int n = 0; n < 2; ++n) acc[a][b][m][n] = (f32x4){0.f, 0.f, 0.f, 0.f};
    bf16x8 At[4][2], B0[2][2], B1[2][2];
    const char* cA = (const char*)g.A + cur.aoff; const char* cB = (const char*)g.Bt + cur.boff;
    PG8_STAGE(PG8_SB(0, 0), cB, voffB); PG8_STAGE(PG8_SA(0, 0), cA, voffA); PG8_STAGE(PG8_SB(0, 1), cB + hstepB, voffB); PG8_STAGE(PG8_SA(0, 1), cA + hstepA, voffA);
    if (wr == 1) PG8_BAR;
    PG8_WAIT_V(4); PG8_BAR;
    PG8_STAGE(PG8_SB(1, 0), cB + kstep, voffB); PG8_STAGE(PG8_SA(1, 0), cA + kstA, voffA); PG8_STAGE(PG8_SB(1, 1), cB + hstepB + kstep, voffB);
    PG8_WAIT_V(6); PG8_BAR;
    for (;;) {
        const bool has_next = S.next(ui + 1, nxt);
        const char* nA = has_next ? (const char*)g.A + nxt.aoff : cA; const char* nB = has_next ? (const char*)g.Bt + nxt.boff : cB;
        for (int t = 0; t < nt; t += 2) {
            const bool last = (t == nt - 2);
            const char* a1 = cA + (size_t)(t + 1) * kstA;
            const char* a2 = last ? nA : cA + (size_t)(t + 2) * kstA; const char* b2 = last ? nB : cB + (size_t)(t + 2) * kstep;
            const char* a3 = a2 + kstA; const char* b3 = b2 + kstep;
            PG8_LDB(B0, 0, 0); PG8_SCHED; PG8_LDA(At, 0, 0); PG8_STAGE(PG8_SA(1, 1), a1 + hstepA, voffA);
            PG8_WAIT_L(8); PG8_BAR; PG8_WAIT_L(0); PG8_MMA(0, 0, At, B0); PG8_BAR; PG8_SCHED;
            PG8_LDB(B1, 0, 1); PG8_STAGE(PG8_SB(0, 0), b2, voffB);
            PG8_BAR; PG8_WAIT_L(0); PG8_MMA(0, 1, At, B1); PG8_BAR;
            PG8_LDA(At, 0, 1); PG8_STAGE(PG8_SA(0, 0), a2, voffA);
            PG8_BAR; PG8_WAIT_L(0); PG8_MMA(1, 0, At, B0); PG8_BAR; PG8_SCHED;
            PG8_STAGE(PG8_SB(0, 1), b2 + hstepB, voffB);
            PG8_WAIT_V(6); PG8_BAR; PG8_MMA(1, 1, At, B1); PG8_BAR;
            PG8_LDB(B0, 1, 0); PG8_SCHED; PG8_LDA(At, 1, 0); PG8_STAGE(PG8_SA(0, 1), a2 + hstepA, voffA);
            PG8_WAIT_L(8); PG8_BAR; PG8_WAIT_L(0); PG8_MMA(0, 0, At, B0); PG8_BAR; PG8_SCHED;
            PG8_LDB(B1, 1, 1); PG8_STAGE(PG8_SB(1, 0), b3, voffB);
            PG8_BAR; PG8_WAIT_L(0); PG8_MMA(0, 1, At, B1); PG8_BAR;
            PG8_LDA(At, 1, 1); PG8_STAGE(PG8_SA(1, 0), a3, voffA);
            PG8_BAR; PG8_WAIT_L(0); PG8_MMA(1, 0, At, B0); PG8_BAR; PG8_SCHED;
            PG8_STAGE(PG8_SB(1, 1), b3 + hstepB, voffB);
            PG8_WAIT_V(6); PG8_BAR; PG8_MMA(1, 1, At, B1); PG8_BAR;
        }
        bool keep = false;
        if constexpr (!epi_after_drain<Epi>::value) keep = E(acc, cur, wr, wc, fr, fq);
        if (!has_next) break;
        if (!keep) {
#pragma unroll
            for (int a = 0; a < 2; ++a)
#pragma unroll
                for (int b = 0; b < 2; ++b)
#pragma unroll
                    for (int m = 0; m < 4; ++m)
#pragma unroll
                        for (int n = 0; n < 2; ++n) acc[a][b][m][n] = (f32x4){0.f, 0.f, 0.f, 0.f};
        }
        cur = nxt; cA = nA; cB = nB; ++ui;
    }
    PG8_WAIT_V(0);
    if (wr == 0) PG8_BAR;
    PG8_BAR;
    if constexpr (epi_after_drain<Epi>::value) (void)E(acc, cur, wr, wc, fr, fq);
#undef PG8_SA
#undef PG8_SB
#undef PG8_STAGE
#undef PG8_LDA
#undef PG8_LDB
#undef PG8_MMA
#undef PG8_WAIT_V
#undef PG8_WAIT_L
#undef PG8_BAR
#undef PG8_SCHED
}

struct EpiInProj {
    static constexpr bool PERM = true;
    bf16_t* proj; bf16_t* gates; unsigned char* ws; int row_base;
    __device__ __forceinline__ bool operator()(f32x4 (&acc)[2][2][4][2], const Unit& u, int wr, int wc, int fr, int fq) const {
        const int row0 = u.pm * BM + wr * 64 + fr; const bool is_gate = u.pn >= 16;
        bf16_t* base = is_gate ? gates + (u.pn - 16) * 256 : proj + u.pn * 256; const int ld = is_gate ? 3072 : PLD;
        const int col0 = wc * 32 + 8 * fq;
        float sv[2][4];
        { f32x4 pq[2][4];
#pragma unroll
          for (int ai = 0; ai < 2; ++ai)
#pragma unroll
            for (int m = 0; m < 4; ++m) pq[ai][m] = *(const f32x4*)statp(ws, row_base + row0 + ai * HALF + m * 16, 0);
#pragma unroll
          for (int ai = 0; ai < 2; ++ai)
#pragma unroll
            for (int m = 0; m < 4; ++m) sv[ai][m] = rsqrtf(((pq[ai][m][0] + pq[ai][m][1]) + (pq[ai][m][2] + pq[ai][m][3])) * (1.0f / D) + NORM_EPS); }
#pragma unroll
        for (int ai = 0; ai < 2; ++ai)
#pragma unroll
            for (int m = 0; m < 4; ++m) { const int row = row0 + ai * HALF + m * 16;
                const float s = sv[ai][m]; bf16_t* rowp = base + (size_t)row * ld + col0;
#pragma unroll
                for (int bj = 0; bj < 2; ++bj) { f32x4 v0 = acc[ai][bj][m][0] * s, v1 = acc[ai][bj][m][1] * s;
                    if (is_gate) {
#pragma unroll
                        for (int j = 0; j < 4; ++j) { v0[j] = sigmoidf_(v0[j]); v1[j] = sigmoidf_(v1[j]); } }
                    u32x4 w; w.x = pk2(v0[0], v0[1]); w.y = pk2(v0[2], v0[3]); w.z = pk2(v1[0], v1[1]); w.w = pk2(v1[2], v1[3]);
                    if (u.pn != 12 || col0 + bj * HALF < 64) *(u32x4*)(rowp + bj * HALF) = w; } }
        return false;
    }
};
struct EpiStore {
    static constexpr bool PERM = true;
    bf16_t* out; int ld;
    __device__ __forceinline__ bool operator()(f32x4 (&acc)[2][2][4][2], const Unit& u, int wr, int wc, int fr, int fq) const {
        const int row0 = u.pm * BM + wr * 64 + fr; const int col0 = u.pn * BM + wc * 32 + 8 * fq;
#pragma unroll
        for (int ai = 0; ai < 2; ++ai)
#pragma unroll
            for (int m = 0; m < 4; ++m) { bf16_t* rowp = out + (size_t)(row0 + ai * HALF + m * 16) * ld + col0;
#pragma unroll
                for (int bj = 0; bj < 2; ++bj) { const f32x4 v0 = acc[ai][bj][m][0], v1 = acc[ai][bj][m][1];
                    u32x4 w; w.x = pk2(v0[0], v0[1]); w.y = pk2(v0[2], v0[3]); w.z = pk2(v1[0], v1[1]); w.w = pk2(v1[2], v1[3]);
                    *(u32x4*)(rowp + bj * HALF) = w; } }
        return false;
    }
};
struct EpiCmp1 {
    static constexpr bool PERM = true;
    bf16_t* hid; const float* bh;
    __device__ __forceinline__ bool operator()(f32x4 (&acc)[2][2][4][2], const Unit& u, int wr, int wc, int fr, int fq) const {
        const int kv = u.pm >> 3; const int row0 = (u.pm & 7) * BM + wr * 64 + fr; const int col0 = wc * 32 + 8 * fq;
#pragma unroll
        for (int ai = 0; ai < 2; ++ai)
#pragma unroll
            for (int m = 0; m < 4; ++m) { bf16_t* rowp = hid + ((size_t)kv * 2048 + row0 + ai * HALF + m * 16) * 256 + col0;
#pragma unroll
                for (int bj = 0; bj < 2; ++bj) { float o[8];
#pragma unroll
                    for (int j = 0; j < 8; ++j) { const float x = acc[ai][bj][m][j >> 2][j & 3] + bh[kv * 256 + col0 + bj * HALF + j];
                        o[j] = x * sigmoidf_(1.5957691216f * (x + 0.044715f * x * x * x)); }
                    u32x4 w; w.x = pk2(o[0], o[1]); w.y = pk2(o[2], o[3]); w.z = pk2(o[4], o[5]); w.w = pk2(o[6], o[7]);
                    *(u32x4*)(rowp + bj * HALF) = w; } }
        return false;
    }
};
struct EpiCmp2 {
    static constexpr bool PERM = true;
    bf16_t* kcb; bf16_t* vct;
    __device__ __forceinline__ bool operator()(f32x4 (&acc)[2][2][4][2], const Unit& u, int wr, int wc, int fr, int fq) const {
        const int kv = u.pm >> 3; const int row0 = (u.pm & 7) * BM + wr * 64 + fr; const int col0 = wc * 32 + 8 * fq;
        if (col0 >= 64) return false;
#pragma unroll
        for (int ai = 0; ai < 2; ++ai)
#pragma unroll
            for (int m = 0; m < 4; ++m) { const int row = row0 + ai * HALF + m * 16, g = row >> 10, cc = row & 1023; const bool zr = cc == 1023; const f32x4 zz = (f32x4){0.f, 0.f, 0.f, 0.f};
                const f32x4 v0 = zr ? zz : acc[ai][0][m][0], v1 = zr ? zz : acc[ai][0][m][1];
                if (kv == 0) { u32x4 w; w.x = pk2(v0[0], v0[1]); w.y = pk2(v0[2], v0[3]); w.z = pk2(v1[0], v1[1]); w.w = pk2(v1[2], v1[3]); *(u32x4*)(kcb + ((size_t)g * 1024 + cc) * 64 + col0) = w; }
                else {
#pragma unroll
                    for (int j = 0; j < 4; ++j) { vct[((size_t)g * 64 + col0 + j) * 1024 + cc] = (bf16_t)f2bf(v0[j]); vct[((size_t)g * 64 + col0 + 4 + j) * 1024 + cc] = (bf16_t)f2bf(v1[j]); } } }
        return false;
    }
};
struct EpiLora {
    static constexpr bool PERM = true;
    bf16_t* obuf;
    __device__ __forceinline__ bool operator()(f32x4 (&acc)[2][2][4][2], const Unit& u, int wr, int wc, int fr, int fq) const {
        const int sel = u.pn >> 1; bf16_t* out = obuf + (size_t)(sel == 2 ? 0 : sel + 1) * T * 512;
        const int row0 = u.pm * BM + wr * 64 + fr; const int col0 = (u.pn & 1) * BM + wc * 32 + 8 * fq;
#pragma unroll
        for (int ai = 0; ai < 2; ++ai)
#pragma unroll
            for (int m = 0; m < 4; ++m) { bf16_t* rowp = out + (size_t)(row0 + ai * HALF + m * 16) * 512 + col0;
#pragma unroll
                for (int bj = 0; bj < 2; ++bj) { const f32x4 v0 = acc[ai][bj][m][0], v1 = acc[ai][bj][m][1];
                    u32x4 w; w.x = pk2(v0[0], v0[1]); w.y = pk2(v0[2], v0[3]); w.z = pk2(v1[0], v1[1]); w.w = pk2(v1[2], v1[3]);
                    *(u32x4*)(rowp + bj * HALF) = w; } }
        return false;
    }
};
struct EpiMerge {
    static constexpr bool PERM = true;
    const bf16_t* gates; bf16_t* merged;
    __device__ __forceinline__ bool operator()(f32x4 (&acc)[2][2][4][2], const Unit& u, int wr, int wc, int fr, int fq) const {
        const int row0 = u.pm * BM + wr * 64 + fr; const int col0 = u.pn * BM + wc * 32 + 8 * fq; const int sub = u.sub;
#pragma unroll
        for (int ai = 0; ai < 2; ++ai) {
                u32x4 gc[4][2], gn[4][2];
#pragma unroll
                for (int m = 0; m < 4; ++m) { const int row = row0 + ai * HALF + m * 16; const bf16_t* gp = gates + (size_t)row * 3072 + sub * 1024 + col0;
#pragma unroll
                    for (int bj = 0; bj < 2; ++bj) { gc[m][bj] = *(const u32x4*)(gp + bj * HALF); gn[m][bj] = (sub < 2) ? *(const u32x4*)(gp + 1024 + bj * HALF) : gc[m][bj]; } }
#pragma unroll
                for (int m = 0; m < 4; ++m) { const int row = row0 + ai * HALF + m * 16;
#pragma unroll
                    for (int bj = 0; bj < 2; ++bj) {
                        float sc[8], sn[8]; unpack8(gc[m][bj], sc);
                        if (sub < 2) { unpack8(gn[m][bj], sn);
#pragma unroll
                            for (int j = 0; j < 8; ++j) sc[j] = sc[j] * __builtin_amdgcn_rcpf(fmaxf(sn[j], 1e-30f)); }
                        f32x4 v0 = acc[ai][bj][m][0], v1 = acc[ai][bj][m][1];
#pragma unroll
                        for (int j = 0; j < 4; ++j) { v0[j] *= sc[j]; v1[j] *= sc[4 + j]; }
                        acc[ai][bj][m][0] = v0; acc[ai][bj][m][1] = v1;
                        if (sub == 2) { u32x4 w; w.x = pk2(v0[0], v0[1]); w.y = pk2(v0[2], v0[3]); w.z = pk2(v1[0], v1[1]); w.w = pk2(v1[2], v1[3]);
                            *(u32x4*)(merged + (size_t)row * D + col0 + bj * HALF) = w; } } }
                __builtin_amdgcn_sched_barrier(0);
        }
        return sub != 2;
    }
};
struct EpiNorm {
    static constexpr bool PERM = true, AFTER_DRAIN = true;
    float* x; bf16_t* xb; const float* gain; unsigned char* ws; unsigned* cnt; int row_base, kind_next; unsigned target; LAS unsigned char* lds; int tid;
    __device__ __forceinline__ bool operator()(f32x4 (&acc)[2][2][4][2], const Unit& u, int wr, int wc, int fr, int fq) const {
        LAS float* P = (LAS float*)lds; LAS float* S = (LAS float*)(lds + 16384);
        const int lane = tid & 63, wid = __builtin_amdgcn_readfirstlane(tid >> 6);
        const int prow = row_base + u.pm * BM;
        const int col0 = u.pn * BM + wc * 32 + 8 * fq;
#pragma unroll
        for (int ai = 0; ai < 2; ++ai)
#pragma unroll
            for (int m = 0; m < 4; ++m) { float ps = 0.f;
#pragma unroll
                for (int bj = 0; bj < 2; ++bj) { const f32x4 v0 = acc[ai][bj][m][0], v1 = acc[ai][bj][m][1];
                    ps += (v0[0] * v0[0] + v0[1] * v0[1]) + (v0[2] * v0[2] + v0[3] * v0[3]) + (v1[0] * v1[0] + v1[1] * v1[1]) + (v1[2] * v1[2] + v1[3] * v1[3]); }
                P[(ai * HALF + wr * 64 + m * 16 + fr) * 16 + wc * 4 + fq] = ps; }
        asm volatile("s_waitcnt lgkmcnt(0)" ::: "memory"); __builtin_amdgcn_s_barrier(); asm volatile("" ::: "memory");
        if (tid < 256) { const f32x4 a0 = *(const LAS f32x4*)(P + tid * 16), a1 = *(const LAS f32x4*)(P + tid * 16 + 4), a2 = *(const LAS f32x4*)(P + tid * 16 + 8), a3 = *(const LAS f32x4*)(P + tid * 16 + 12);
            const float sm = (((a0[0] + a0[1]) + (a0[2] + a0[3])) + ((a1[0] + a1[1]) + (a1[2] + a1[3]))) + (((a2[0] + a2[1]) + (a2[2] + a2[3])) + ((a3[0] + a3[1]) + (a3[2] + a3[3])));
            __hip_atomic_store(statp(ws, prow + tid, 1 + (int)(target >> 4)) + u.pn, sm, __ATOMIC_RELAXED, __HIP_MEMORY_SCOPE_AGENT); }
        asm volatile("s_waitcnt vmcnt(0)" ::: "memory");
        unsigned* pcnt = cnt + 16 * (prow >> 8);
        if (tid < 256 && lane == 0) (void)__hip_atomic_fetch_add(pcnt, 1u, __ATOMIC_RELAXED, __HIP_MEMORY_SCOPE_AGENT);
        if (wid == 0) { unsigned spins = 0; while ((unsigned)__builtin_amdgcn_readfirstlane(__hip_atomic_load(pcnt, __ATOMIC_RELAXED, __HIP_MEMORY_SCOPE_AGENT)) < target) { __builtin_amdgcn_s_sleep(1); if (++spins > (1u << 20)) break; }
            __builtin_amdgcn_fence(__ATOMIC_ACQUIRE, "agent"); }
        asm volatile("s_waitcnt vmcnt(0) lgkmcnt(0)" ::: "memory"); __builtin_amdgcn_s_barrier(); asm volatile("" ::: "memory");
        if (tid < 256) { float* sp = statp(ws, prow + tid, 1 + (int)(target >> 4));
            const float t0 = __hip_atomic_load(sp, __ATOMIC_RELAXED, __HIP_MEMORY_SCOPE_AGENT), t1 = __hip_atomic_load(sp + 1, __ATOMIC_RELAXED, __HIP_MEMORY_SCOPE_AGENT),
                        t2 = __hip_atomic_load(sp + 2, __ATOMIC_RELAXED, __HIP_MEMORY_SCOPE_AGENT), t3 = __hip_atomic_load(sp + 3, __ATOMIC_RELAXED, __HIP_MEMORY_SCOPE_AGENT);
            S[tid] = rsqrtf(((t0 + t1) + (t2 + t3)) * (1.0f / D) + NORM_EPS); }
        asm volatile("s_waitcnt lgkmcnt(0)" ::: "memory"); __builtin_amdgcn_s_barrier(); asm volatile("" ::: "memory");
        f32x4 gv[2][2];
#pragma unroll
        for (int bj = 0; bj < 2; ++bj) { gv[bj][0] = *(const f32x4*)(gain + col0 + bj * HALF); gv[bj][1] = *(const f32x4*)(gain + col0 + bj * HALF + 4); }
#pragma unroll
        for (int ai = 0; ai < 2; ++ai)
#pragma unroll
            for (int mp = 0; mp < 2; ++mp) {
                f32x4 xv[2][2][2];
#pragma unroll
                for (int mi = 0; mi < 2; ++mi) { const int row = prow + ai * HALF + wr * 64 + (2 * mp + mi) * 16 + fr;
#pragma unroll
                    for (int bj = 0; bj < 2; ++bj) { const float* xp = x + (size_t)row * D + col0 + bj * HALF; xv[mi][bj][0] = *(const f32x4*)xp; xv[mi][bj][1] = *(const f32x4*)(xp + 4); } }
#pragma unroll
                for (int mi = 0; mi < 2; ++mi) { const int m = 2 * mp + mi; const int rl = ai * HALF + wr * 64 + m * 16 + fr; const int row = prow + rl; const float rstd = S[rl]; float qs = 0.f;
#pragma unroll
                    for (int bj = 0; bj < 2; ++bj) { const int col = col0 + bj * HALF; float* xp = x + (size_t)row * D + col; u32x4 w;
                        { f32x4 xa = xv[mi][bj][0]; xa += acc[ai][bj][m][0] * rstd * gv[bj][0]; *(f32x4*)xp = xa;
                          w.x = pk2(xa[0], xa[1]); w.y = pk2(xa[2], xa[3]); qs += (xa[0] * xa[0] + xa[1] * xa[1]) + (xa[2] * xa[2] + xa[3] * xa[3]); }
                        { f32x4 xc = xv[mi][bj][1]; xc += acc[ai][bj][m][1] * rstd * gv[bj][1]; *(f32x4*)(xp + 4) = xc;
                          w.z = pk2(xc[0], xc[1]); w.w = pk2(xc[2], xc[3]); qs += (xc[0] * xc[0] + xc[1] * xc[1]) + (xc[2] * xc[2] + xc[3] * xc[3]); }
                        *(u32x4*)(xb + (size_t)row * D + col) = w; }
                    P[rl * 16 + wc * 4 + fq] = qs; }
                __builtin_amdgcn_sched_barrier(0);
            }
        asm volatile("s_waitcnt lgkmcnt(0)" ::: "memory"); __builtin_amdgcn_s_barrier(); asm volatile("" ::: "memory");
        if (tid < 256) { const f32x4 a0 = *(const LAS f32x4*)(P + tid * 16), a1 = *(const LAS f32x4*)(P + tid * 16 + 4), a2 = *(const LAS f32x4*)(P + tid * 16 + 8), a3 = *(const LAS f32x4*)(P + tid * 16 + 12);
            const float sm = (((a0[0] + a0[1]) + (a0[2] + a0[3])) + ((a1[0] + a1[1]) + (a1[2] + a1[3]))) + (((a2[0] + a2[1]) + (a2[2] + a2[3])) + ((a3[0] + a3[1]) + (a3[2] + a3[3])));
            __hip_atomic_store(statp(ws, prow + tid, kind_next) + u.pn, sm, __ATOMIC_RELAXED, __HIP_MEMORY_SCOPE_AGENT); }
        return false;
    }
};
struct EpiSwiGLU {
    static constexpr bool PERM = true;
    bf16_t* act; unsigned char* ws;
    __device__ __forceinline__ bool operator()(f32x4 (&acc)[2][2][4][2], const Unit& u, int wr, int wc, int fr, int fq) const {
        const int row0 = u.pm * BM + wr * 64 + fr; const int col0 = u.pn * HALF + wc * 32 + 8 * fq;
        float sv[2][4];
        { f32x4 pq[2][4];
#pragma unroll
          for (int ai = 0; ai < 2; ++ai)
#pragma unroll
            for (int m = 0; m < 4; ++m) pq[ai][m] = *(const f32x4*)statp(ws, row0 + ai * HALF + m * 16, 1);
#pragma unroll
          for (int ai = 0; ai < 2; ++ai)
#pragma unroll
            for (int m = 0; m < 4; ++m) sv[ai][m] = rsqrtf(((pq[ai][m][0] + pq[ai][m][1]) + (pq[ai][m][2] + pq[ai][m][3])) * (1.0f / D) + NORM_EPS); }
#pragma unroll
        for (int ai = 0; ai < 2; ++ai)
#pragma unroll
            for (int m = 0; m < 4; ++m) { const int row = row0 + ai * HALF + m * 16;
                const float s = sv[ai][m];
                float o[8];
#pragma unroll
                for (int n = 0; n < 2; ++n)
#pragma unroll
                    for (int j = 0; j < 4; ++j) { const float gg = acc[ai][0][m][n][j] * s, uu = acc[ai][1][m][n][j] * s; o[n * 4 + j] = gg * sigmoidf_(gg) * uu; }
                u32x4 w; w.x = pk2(o[0], o[1]); w.y = pk2(o[2], o[3]); w.z = pk2(o[4], o[5]); w.w = pk2(o[6], o[7]);
                *(u32x4*)(act + (size_t)row * FFN + col0) = w; }
        return false;
    }
};
}

struct Args { const float* in[30]; float* out; unsigned char* ws; int lo, hi; };
enum { I_X = 0, I_NPM, I_NQM, I_NPF, I_NQF, I_WIN, I_MU, I_W0, I_W2, I_A0, I_A2, I_G2, I_KK, I_KA, I_RK, I_LNW, I_LNB, I_PEK, I_PEV, I_CKW1, I_CKW2, I_CVW1, I_CVW2, I_SINK, I_REL, I_WBR, I_WOUT, I_FG, I_FU, I_FD };

struct Ctx { LAS unsigned char* lds; int tid, lane, wave, G, bid; };
__device__ __forceinline__ const float* inptr(const Ctx& c, int i) {
    const volatile LAS unsigned* t = (const volatile LAS unsigned*)(c.lds + LDS_MISC + 64) + 2 * i;
    const unsigned lo = __builtin_amdgcn_readfirstlane(t[0]), hi = __builtin_amdgcn_readfirstlane(t[1]);
    return (const float*)(((unsigned long long)hi << 32) | lo);
}

__device__ __forceinline__ void phase_init(const Ctx& c, const float* x, float* xo, bf16_t* xb, unsigned char* wsb) {
    const int gw = c.bid * 8 + c.wave, NGW = c.G * 8;
    for (int row = gw; row < MROWS; row += NGW) {
        const float* xr = x + (size_t)row * D; float ss = 0.f;
#pragma unroll
        for (int j = 0; j < 2; ++j) { const int e = c.lane * 8 + 512 * j; const f32x4 a = *(const f32x4*)(xr + e), b = *(const f32x4*)(xr + e + 4);
            ss += a[0] * a[0] + a[1] * a[1] + a[2] * a[2] + a[3] * a[3] + b[0] * b[0] + b[1] * b[1] + b[2] * b[2] + b[3] * b[3];
            *(f32x4*)(xo + (size_t)row * D + e) = a; *(f32x4*)(xo + (size_t)row * D + e + 4) = b;
            u32x4 w; w.x = pk2(a[0], a[1]); w.y = pk2(a[2], a[3]); w.z = pk2(b[0], b[1]); w.w = pk2(b[2], b[3]); *(u32x4*)(xb + (size_t)row * D + e) = w; }
        ss = wave_sum(ss);
        if (c.lane < 4) __hip_atomic_store(statp(wsb, row, 0) + c.lane, c.lane == 0 ? ss : 0.f, __ATOMIC_RELAXED, __HIP_MEMORY_SCOPE_AGENT);
    }
}
struct CvtTile { const float* src; const float* gain; bf16_t* dst; int ld, nvalid, K, k0, n0; float extra; bool kvalid; };
__device__ __forceinline__ CvtTile cvt_describe(const Ctx& c, int layer, bf16_t* wb, int it) {
    constexpr int I0 = 16 * 112, I1 = 3 * 8 * 16, I2 = 16 * 16, I3 = 16 * 88, I4 = 44 * 16, I5 = 4 * 24, I6 = 2 * 32 * 4;
    int r = it, kind, sub = 0, K, nblk; bf16_t* dst;
    if (r < I0) { kind = 0; K = D; nblk = 112; dst = wb + WB_WIN; }
    else if ((r -= I0) < I1) { kind = 1; sub = r / 128; r -= sub * 128; K = 512; nblk = 16; dst = wb + WB_WBR + (size_t)sub * D * 512; }
    else if ((r -= I1) < I2) { kind = 2; K = D; nblk = 16; dst = wb + WB_WOUT; }
    else if ((r -= I2) < I3) { kind = 3; K = D; nblk = 88; dst = wb + WB_WGU; }
    else if ((r -= I3) < I4) { kind = 4; K = FFN; nblk = 16; dst = wb + WB_WDN; }
    else if ((r -= I4) < I5) { kind = 5; K = 256; nblk = 24; dst = wb + WB_LORA; }
    else if ((r -= I5) < I6) { kind = 6; sub = r / 128; r -= sub * 128; K = 2048; nblk = 4; dst = wb + WB_W1T + (size_t)sub * 256 * 2048; }
    else { r -= I6; kind = 7; sub = r / 16; r -= sub * 16; K = 256; nblk = 4; dst = wb + WB_W2T + (size_t)sub * 256 * 256; }
    const int kb = r / nblk, nb = r % nblk, k0 = kb * 64, n0 = nb * 64;
    CvtTile t; t.src = nullptr; t.gain = nullptr; t.dst = dst; t.ld = 0; t.nvalid = 64; t.K = K; t.k0 = k0; t.n0 = n0; t.extra = 1.f; t.kvalid = true;
    switch (kind) {
    case 0: { t.gain = inptr(c, I_NPM) + layer * D + k0; t.ld = IN_COLS;
        const int scol = n0 < 3096 ? n0 : n0 - 232; t.nvalid = (n0 < 3096) ? (3096 - n0 < 64 ? 3096 - n0 : 64) : (n0 < 3328 ? 0 : 64);
        if ((n0 >= PC_NQ && n0 < PC_NQ + 512) || (n0 >= PC_SQ && n0 < PC_SQ + 512)) t.extra = 0.125f;
        t.src = inptr(c, I_WIN) + ((size_t)layer * D + k0) * IN_COLS + scol; break; }
    case 1: t.src = inptr(c, I_WBR) + (((size_t)layer * 3 + sub) * 512 + k0) * D + n0; t.ld = D; break;
    case 2: t.src = inptr(c, I_WOUT) + ((size_t)layer * D + k0) * D + n0; t.ld = D; break;
    case 3: { t.gain = inptr(c, I_NPF) + layer * D + k0; t.ld = FFN; const int pn = n0 >> 8, rr = n0 & 255;
        t.src = inptr(c, rr < 128 ? I_FG : I_FU) + ((size_t)layer * D + k0) * FFN + pn * 128 + (rr & 127); break; }
    case 4: t.src = inptr(c, I_FD) + ((size_t)layer * FFN + k0) * D + n0; t.ld = D; break;
    case 5: { t.ld = 512;
        if (n0 < 512) { t.kvalid = k0 < 64; t.src = inptr(c, I_W2) + ((size_t)layer * 64 + k0) * 512 + n0; }
        else if (n0 < 1024) { t.kvalid = (k0 == 64); t.src = inptr(c, I_A2) + ((size_t)layer * 64 + (k0 - 64)) * 512 + n0 - 512; }
        else { t.kvalid = k0 >= 128; t.src = inptr(c, I_G2) + ((size_t)layer * 128 + (k0 - 128)) * 512 + n0 - 1024; }
        break; }
    case 6: t.src = inptr(c, sub ? I_CVW1 : I_CKW1) + ((size_t)layer * 2048 + k0) * 256 + n0; t.ld = 256; break;
    default: t.src = inptr(c, sub ? I_CVW2 : I_CKW2) + ((size_t)layer * 256 + k0) * 64 + n0; t.ld = 64; t.nvalid = n0 < 64 ? 64 : 0; break;
    }
    return t;
}
__device__ __forceinline__ void phase_cvt(const Ctx& c, const Args& a, int layer, bf16_t* wb) {
    LAS float* tile = (LAS float*)c.lds;
    constexpr int NIT = 16 * 112 + 3 * 8 * 16 + 16 * 16 + 16 * 88 + 44 * 16 + 4 * 24 + 2 * 32 * 4 + 2 * 4 * 4;
    for (int it = c.bid; it < NIT; it += 2 * c.G) {
        const int it2 = it + c.G; const bool two = it2 < NIT;
        const CvtTile t0 = cvt_describe(c, layer, wb, it), t1 = cvt_describe(c, layer, wb, two ? it2 : it);
        float v0[8], v1[8];
#pragma unroll
        for (int i = 0; i < 8; ++i) { const int e = c.tid + 512 * i, kk = e >> 6, nn = e & 63;
            v0[i] = (t0.kvalid && nn < t0.nvalid) ? t0.src[(size_t)kk * t0.ld + nn] : 0.f;
            v1[i] = (two && t1.kvalid && nn < t1.nvalid) ? t1.src[(size_t)kk * t1.ld + nn] : 0.f; }
#pragma unroll
        for (int i = 0; i < 8; ++i) { const int e = c.tid + 512 * i, kk = e >> 6, nn = e & 63;
            tile[kk * 65 + nn] = v0[i] * t0.extra * (t0.gain ? t0.gain[kk] : 1.f); tile[4160 + kk * 65 + nn] = v1[i] * t1.extra * (t1.gain ? t1.gain[kk] : 1.f); }
        __syncthreads();
        { const int nn = c.tid >> 3, kc = (c.tid & 7) * 8; u32x4 w;
          w.x = pk2(tile[(kc + 0) * 65 + nn], tile[(kc + 1) * 65 + nn]); w.y = pk2(tile[(kc + 2) * 65 + nn], tile[(kc + 3) * 65 + nn]);
          w.z = pk2(tile[(kc + 4) * 65 + nn], tile[(kc + 5) * 65 + nn]); w.w = pk2(tile[(kc + 6) * 65 + nn], tile[(kc + 7) * 65 + nn]);
          *(u32x4*)(t0.dst + (size_t)(t0.n0 + nn) * t0.K + t0.k0 + kc) = w;
          if (two) { const LAS float* tl = tile + 4160;
            w.x = pk2(tl[(kc + 0) * 65 + nn], tl[(kc + 1) * 65 + nn]); w.y = pk2(tl[(kc + 2) * 65 + nn], tl[(kc + 3) * 65 + nn]);
            w.z = pk2(tl[(kc + 4) * 65 + nn], tl[(kc + 5) * 65 + nn]); w.w = pk2(tl[(kc + 6) * 65 + nn], tl[(kc + 7) * 65 + nn]);
            *(u32x4*)(t1.dst + (size_t)(t1.n0 + nn) * t1.K + t1.k0 + kc) = w; } }
        __syncthreads();
    }
    if (c.bid == c.G - 1) {
        const int kv = c.tid >> 8, u = c.tid & 255; const float* w1 = inptr(c, kv ? I_CVW1 : I_CKW1) + (size_t)layer * 2048 * 256; const float* pe = inptr(c, kv ? I_PEV : I_PEK) + (size_t)layer * 2048;
        float acc = 0.f; for (int k = 0; k < 2048; ++k) acc += pe[k] * w1[(size_t)k * 256 + u];
        ((float*)(wb + WB_BH))[c.tid] = acc;
    }
}

constexpr int RL = 65;
__device__ __forceinline__ float rwkv_mixed(const bf16_t* proj, const float* mu, int t, int col) {
    const float cur = bf2f(proj[(size_t)t * PLD + col]); const float prev = t > 0 ? bf2f(proj[(size_t)(t - 1) * PLD + col]) : 0.f;
    return cur + (prev - cur) * mu[col];
}
__device__ __forceinline__ int kperm32(int jl) { return 8 * ((jl >> 2) & 3) + 4 * (jl >> 4) + (jl & 3); }
__device__ __forceinline__ f32x4 tile_mma64(const LAS unsigned char* A, const LAS unsigned char* B, int a, int b, int lane, f32x4 acc) {
    const int m = lane & 15, q = lane >> 4;
#pragma unroll
    for (int ks = 0; ks < 2; ++ks) {
        const bf16x8 af = *(const LAS bf16x8*)(A + (16 * a + m) * 144 + (32 * ks + 8 * q) * 2);
        const bf16x8 bf = *(const LAS bf16x8*)(B + (16 * b + m) * 144 + (32 * ks + 8 * q) * 2);
        acc = __builtin_amdgcn_mfma_f32_16x16x32_bf16(af, bf, acc, 0, 0, 0);
    }
    return acc;
}
__device__ __forceinline__ void lds_st_bf16(LAS unsigned char* base, int idx, float v) { *(LAS bf16_t*)(base + idx * 2) = (bf16_t)f2bf(v); }

__device__ __forceinline__ void phase_lora_a(const Ctx& c, const Args& a, int layer, const bf16_t* proj, bf16_t* alora) {
    const float* mu = inptr(c, I_MU) + (size_t)layer * 1792;
    const int sub = c.tid & 31, rloc = c.tid >> 5;
    for (int t = c.bid * 16 + rloc; t < T; t += c.G * 16) {
        const int col = PC_ZW + sub * 8; float cur[8], prv[8];
        unpack8(*(const u32x4*)(proj + (size_t)t * PLD + col), cur);
        if (t > 0) unpack8(*(const u32x4*)(proj + (size_t)(t - 1) * PLD + col), prv); else {
#pragma unroll
            for (int k = 0; k < 8; ++k) prv[k] = 0.f; }
        float o[8];
#pragma unroll
        for (int k = 0; k < 8; ++k) { const float v = cur[k] + (prv[k] - cur[k]) * mu[col + k]; o[k] = sub < 8 ? tanhf(v) : (sub < 16 ? v : sigmoidf_(v)); }
        u32x4 w; w.x = pk2(o[0], o[1]); w.y = pk2(o[2], o[3]); w.z = pk2(o[4], o[5]); w.w = pk2(o[6], o[7]);
        *(u32x4*)(alora + (size_t)t * 256 + sub * 8) = w;
    }
}

constexpr int RC_L = 0, RC_AL = 16640, RC_AAK = 0, RC_ARB = 9216, RC_ARK = 18432, RC_AAB = 33280, RC_P2T = 33280, RC_WC = 50688, RC_BS = 50944, RC_M = 52992;
constexpr int RC_AT = RC_M, RC_TINV = RC_M, RC_ATT = RC_M + 9216, RC_RT = RC_M + 2 * 9216, RC_BT = RC_M + 3 * 9216, RC_XT = RC_BT, RC_KT = RC_M + 4 * 9216, RC_P1T = RC_KT,
              RC_VT = RC_M + 5 * 9216, RC_BHT = RC_M + 6 * 9216, RC_KHT = RC_M + 7 * 9216;
constexpr int RC_XOFF = RC_M + 8 * 9216, RC_XTMP = RC_XOFF + 6144;
static_assert(RC_XTMP + 3 * 1088 <= LDS_MISC, "rwkv chunk LDS");

__device__ __forceinline__ void phase_rwkv_chunk(const Ctx& c, const Args& a, int layer, const bf16_t* proj, const bf16_t* wlb, const bf16_t* alb, bf16_t* rwu, float* bonusg) {
    LAS unsigned char* L = c.lds;
    LAS float* sL = (LAS float*)(L + RC_L); LAS float* sAL = (LAS float*)(L + RC_AL); LAS float* sAAB = (LAS float*)(L + RC_AAB);
    LAS float* sWC = (LAS float*)(L + RC_WC); LAS float* sBS = (LAS float*)(L + RC_BS);
    const float* mu = inptr(c, I_MU) + (size_t)layer * 1792;
    const int lane = c.lane, wave = c.wave, n = lane & 15, q = lane >> 4;
    for (int unit = c.bid; unit < 2048; unit += c.G) {
        const int ch = unit >> 3, h = unit & 7, t0 = ch * 64, j = lane;
        {
            const float w0 = inptr(c, I_W0)[layer * 512 + h * 64 + j], a0 = inptr(c, I_A0)[layer * 512 + h * 64 + j];
            bf16_t wraw[8], araw[8];
#pragma unroll
            for (int i = 0; i < 8; ++i) { const size_t gi = (size_t)(t0 + wave * 8 + i) * 512 + h * 64 + j; wraw[i] = wlb[gi]; araw[i] = alb[gi]; }
            float run = 0.f;
#pragma unroll
            for (int i = 0; i < 8; ++i) { const int tt = wave * 8 + i;
                const float wl = w0 + bf2f(wraw[i]); const float nx = -wl; const float sp = nx > 20.f ? nx : __logf(1.0f + __expf(nx)); const float ld = -__expf(-sp - 0.5f);
                run += ld; sL[tt * RL + j] = run; sAL[tt * RL + j] = sigmoidf_(a0 + bf2f(araw[i])); }
            sBS[wave * 64 + j] = run;
        }
        bf16_t rraw[9], kraw[9], vraw[9];
        {
#pragma unroll
            for (int i = 0; i < 9; ++i) { const int t = t0 + wave * 8 + i - 1; const bool ok = t >= 0; const size_t ro = (size_t)(ok ? t : 0) * PLD + h * 64 + j;
                rraw[i] = ok ? proj[ro + PC_R] : (bf16_t)0; kraw[i] = ok ? proj[ro + PC_K] : (bf16_t)0; vraw[i] = ok ? proj[ro + PC_V] : (bf16_t)0; }
        }
        __syncthreads();
        {
            float off = 0.f, tot = 0.f;
#pragma unroll
            for (int w2 = 0; w2 < 8; ++w2) { const float v = sBS[w2 * 64 + j]; tot += v; off += (w2 < wave) ? v : 0.f; }
            if (wave == 0) sWC[j] = __expf(tot);
            const float kkw = inptr(c, I_KK)[layer * 512 + h * 64 + j], kaw = inptr(c, I_KA)[layer * 512 + h * 64 + j], rk = inptr(c, I_RK)[layer * 512 + h * 64 + j];
            const float mur = mu[PC_R + h * 64 + j], muk = mu[PC_K + h * 64 + j], muv = mu[PC_V + h * 64 + j];
            float Lprev = off; float eWprev = __expf(off); const float eTot = __expf(tot);
#pragma unroll
            for (int i = 0; i < 8; ++i) { const int tt = wave * 8 + i, t = t0 + tt;
                const float Lc = sL[tt * RL + j] + off, al = sAL[tt * RL + j];
                const float rc = bf2f(rraw[i + 1]), kc = bf2f(kraw[i + 1]), vc = bf2f(vraw[i + 1]);
                const float r = rc + (bf2f(rraw[i]) - rc) * mur, k = kc + (bf2f(kraw[i]) - kc) * muk, v = vc + (bf2f(vraw[i]) - vc) * muv;
                float kk = k * kkw; const float n2 = wave_sum(kk * kk); kk = kk / fmaxf(sqrtf(n2), 1e-12f);
                const float kp = k * (1.0f + (al - 1.0f) * kaw), av = -kk, bv = kk * al;
                const float eW = __expf(Lc), eInv = __builtin_amdgcn_rcpf(eW), eC = eTot * eInv; const float eWex = eWprev; eWprev = eW;
                lds_st_bf16(L + RC_AT, tt * 72 + j, av * eWex); lds_st_bf16(L + RC_ATT, j * 72 + tt, av * eWex);
                lds_st_bf16(L + RC_RT, tt * 72 + j, r * eW); lds_st_bf16(L + RC_BT, tt * 72 + j, bv * eInv); lds_st_bf16(L + RC_KT, tt * 72 + j, kp * eInv);
                lds_st_bf16(L + RC_VT, j * 72 + tt, v); lds_st_bf16(L + RC_BHT, j * 72 + tt, bv * eC); lds_st_bf16(L + RC_KHT, j * 72 + tt, kp * eC);
                const float bon = wave_sum(r * kp * rk); if (lane == 0) bonusg[(size_t)t * 8 + h] = bon;
                Lprev = Lc; }
        }
        __syncthreads();
        for (int job = wave; job < 64; job += 8) {
            const int p = job >> 4, ta = (job >> 2) & 3, tb = job & 3;
            f32x4 acc = (f32x4){0.f, 0.f, 0.f, 0.f};
            if (ta >= tb) acc = tile_mma64(L + (p < 2 ? RC_AT : RC_RT), L + ((p & 1) ? RC_KT : RC_BT), ta, tb, lane, acc);
            LAS unsigned char* dst = L + (p == 1 ? RC_AAK : (p == 2 ? RC_ARB : RC_ARK));
#pragma unroll
            for (int r = 0; r < 4; ++r) { const int tt = 16 * ta + 4 * q + r, ss = 16 * tb + n; const bool keep = (p < 2) ? (ss < tt) : (ss <= tt); const float v = keep ? acc[r] : 0.f;
                if (p == 0) sAAB[tt * 68 + ss] = v; else lds_st_bf16(dst, tt * 72 + ss, v); }
        }
        __syncthreads();
        if (wave == 0) {
            const int blk = lane >> 4, cc = lane & 15; const LAS float* Ab = sAAB + (16 * blk) * 68 + 16 * blk; float xr[16];
#pragma unroll
            for (int tt = 0; tt < 16; ++tt) { float acc = (tt == cc) ? 1.f : 0.f;
#pragma unroll
                for (int ss = 0; ss < tt; ++ss) acc += Ab[tt * 68 + ss] * xr[ss];
                xr[tt] = acc; }
            asm volatile("s_waitcnt lgkmcnt(0)" ::: "memory");
#pragma unroll
            for (int tt = 0; tt < 16; ++tt) sAAB[(16 * blk + tt) * 68 + 16 * blk + cc] = xr[tt];
        } else {
            for (int job = wave - 1; job < 16; job += 7) { const int ta = job >> 2, tb = job & 3;
                const f32x4 acc = tile_mma64(L + RC_VT, L + RC_AAK, ta, tb, lane, (f32x4){0.f, 0.f, 0.f, 0.f});
#pragma unroll
                for (int r = 0; r < 4; ++r) lds_st_bf16(L + RC_XT, (16 * ta + 4 * q + r) * 72 + 16 * tb + n, acc[r]); }
        }
        __syncthreads();
        {
            LAS float* sXO = (LAS float*)(L + RC_XOFF); LAS float* sT = (LAS float*)(L + RC_XTMP) + wave * 272;
            const int rr = lane >> 2, c4 = (lane & 3) * 4;
#pragma unroll 1
            for (int lev = 1; lev <= 3; ++lev) {
                if (wave < 4 - lev) {
                    const int J = wave, I = wave + lev;
                    f32x4 tacc = (f32x4){0.f, 0.f, 0.f, 0.f};
                    for (int K = J; K < I; ++K) {
                        const LAS float* Ap = sAAB + (16 * I + rr) * 68 + 16 * K; const LAS float* Xp;
                        int xs;
                        if (K == J) { Xp = sAAB + (16 * J) * 68 + 16 * J + c4; xs = 68; }
                        else { const int d = K - J; const int bi = (d == 1) ? J : 3 + J; Xp = sXO + bi * 256 + c4; xs = 16; }
#pragma unroll
                        for (int k = 0; k < 16; ++k) { const float av = Ap[k]; const f32x4 xv = *(const LAS f32x4*)(Xp + k * xs); tacc += xv * av; }
                    }
                    *(LAS f32x4*)(sT + rr * 16 + c4) = tacc;
                    asm volatile("s_waitcnt lgkmcnt(0)" ::: "memory");
                    f32x4 xacc = (f32x4){0.f, 0.f, 0.f, 0.f};
                    const LAS float* Dp = sAAB + (16 * I + rr) * 68 + 16 * I;
#pragma unroll
                    for (int k = 0; k < 16; ++k) { const float dv = Dp[k]; const f32x4 tv = *(const LAS f32x4*)(sT + k * 16 + c4); xacc += tv * dv; }
                    const int bo = (lev == 1) ? J : (lev == 2 ? 3 + J : 5);
                    *(LAS f32x4*)(sXO + bo * 256 + rr * 16 + c4) = xacc;
                }
                __syncthreads();
            }
            for (int e = c.tid; e < 4096; e += 512) { const int tt = e >> 6, ss = e & 63, I = tt >> 4, J = ss >> 4; float v = 0.f;
                if (I == J) v = sAAB[tt * 68 + ss];
                else if (I > J) { const int d = I - J; const int bi = (d == 1) ? J : (d == 2 ? 3 + J : 5); v = sXO[bi * 256 + (tt & 15) * 16 + (ss & 15)]; }
                lds_st_bf16(L + RC_TINV, tt * 72 + ss, v); }
        }
        __syncthreads();
        for (int job = wave; job < 32; job += 8) { const int p = job >> 4, ta = (job >> 2) & 3, tb = job & 3;
            const f32x4 acc = tile_mma64(L + (p ? RC_XT : RC_ATT), L + RC_TINV, ta, tb, lane, (f32x4){0.f, 0.f, 0.f, 0.f});
#pragma unroll
            for (int r = 0; r < 4; ++r) lds_st_bf16(L + (p ? RC_P2T : RC_P1T), (16 * ta + 4 * q + r) * 72 + 16 * tb + n, acc[r]); }
        __syncthreads();
        bf16_t* ug = rwu + (size_t)unit * 16384;
        for (int job = wave; job < 64; job += 8) { const int p = job >> 4, ta = (job >> 2) & 3, tb = job & 3;
            f32x4 acc = (f32x4){0.f, 0.f, 0.f, 0.f};
            if (p == 0) { acc = tile_mma64(L + RC_ARB, L + RC_P1T, ta, tb, lane, acc);
#pragma unroll
                for (int r = 0; r < 4; ++r) { const int tt = 16 * ta + 4 * q + r, jj = 16 * tb + n; const float v = acc[r] + bf2f(*(const LAS bf16_t*)(L + RC_RT + (tt * 72 + jj) * 2));
                    ug[8192 + tt * 64 + (jj & 32) + kperm32(jj & 31)] = (bf16_t)f2bf(v); } }
            else if (p == 1) { acc = tile_mma64(L + RC_ARB, L + RC_P2T, ta, tb, lane, acc); acc = tile_mma64(L + RC_ARK, L + RC_VT, ta, tb, lane, acc);
                u32x2 w; w.x = pk2(acc[0], acc[1]); w.y = pk2(acc[2], acc[3]); *(u32x2*)(ug + 12288 + ((tb * 4 + ta) * 64 + lane) * 4) = w; }
            else if (p == 2) { acc = tile_mma64(L + RC_BHT, L + RC_P1T, ta, tb, lane, acc);
#pragma unroll
                for (int r = 0; r < 4; ++r) { const int jr = 16 * ta + 4 * q + r, jc = 16 * tb + n; const float v = acc[r] + (jr == jc ? sWC[jr] : 0.f);
                    ug[jr * 64 + (jc & 32) + kperm32(jc & 31)] = (bf16_t)f2bf(v); } }
            else { acc = tile_mma64(L + RC_BHT, L + RC_P2T, ta, tb, lane, acc); acc = tile_mma64(L + RC_KHT, L + RC_VT, ta, tb, lane, acc);
                u32x2 w; w.x = pk2(acc[0], acc[1]); w.y = pk2(acc[2], acc[3]); *(u32x2*)(ug + 4096 + ((tb * 4 + ta) * 64 + lane) * 4) = w; }
        }
        __syncthreads();
    }
}

#define RW_LOAD_SET(SET, UNIT) do { const bf16_t* ug_ = rwu + (size_t)(UNIT) * 16384; \
    _Pragma("unroll") for (int ta = 0; ta < 4; ++ta) { An[SET][ta][0] = *(const bf16x8*)(ug_ + (16 * ta + m) * 64 + 8 * q); An[SET][ta][1] = *(const bf16x8*)(ug_ + (16 * ta + m) * 64 + 32 + 8 * q); \
        Zn[SET][ta] = *(const u32x2*)(ug_ + 4096 + ((cq * 4 + ta) * 64 + lane) * 4); } } while (0)
template <int SM>
__device__ __forceinline__ void phase_rwkv_scan(const Ctx& c, const bf16_t* rwu, bf16_t* rws) {
    const int idx = c.bid; if (idx >= 32 || c.wave != 0) return;
    const int h = idx >> 2, cq = idx & 3, lane = c.lane, m = lane & 15, q = lane >> 4;
    bf16x8 Bhi[2], Blo[2];
#pragma unroll
    for (int s = 0; s < 2; ++s) { Bhi[s] = (bf16x8){0, 0, 0, 0, 0, 0, 0, 0}; Blo[s] = Bhi[s]; }
    bf16x8 An[2][4][2]; u32x2 Zn[2][4];
#pragma unroll
    for (int u = 0; u < 2; ++u) RW_LOAD_SET(u, u * 8 + h);
    if (SM == 1) {
        for (int ch = 0; ch < T / 64; ch += 8) {
#pragma unroll
            for (int uu = 0; uu < 8; ++uu) { const int u = uu & 3; const int unit = (ch + uu) * 8 + h;
                bf16_t* sg = rws + (size_t)unit * 4096 + cq * 1024 + lane * 8;
                *(bf16x8*)(sg) = Bhi[0]; *(bf16x8*)(sg + 512) = Bhi[1];
#pragma unroll
                for (int ta = 0; ta < 4; ++ta) { Bhi[0] = Bhi[0] ^ An[u][ta][0]; Bhi[1] = Bhi[1] ^ An[u][ta][1]; Bhi[0][0] ^= (short)Zn[u][ta].x; }
                RW_LOAD_SET(u, (ch + uu + 4 < T / 64) ? unit + 32 : unit); } }
        return;
    }
    for (int ch = 0; ch < T / 64; ch += 8) {
#pragma unroll
        for (int uu = 0; uu < 8; ++uu) {
            const int u = uu & 1;
            const int unit = (ch + uu) * 8 + h;
            bf16_t* sg = rws + (size_t)unit * 4096 + cq * 1024 + lane * 8;
            *(bf16x8*)(sg) = Bhi[0]; *(bf16x8*)(sg + 512) = Bhi[1];
            f32x4 acc[4];
#pragma unroll
            for (int ta = 0; ta < 4; ++ta) { const u32x2 z = Zn[u][ta];
                acc[ta] = (f32x4){__uint_as_float(z.x << 16), __uint_as_float(z.x & 0xffff0000u), __uint_as_float(z.y << 16), __uint_as_float(z.y & 0xffff0000u)};
#pragma unroll
                for (int s = 0; s < 2; ++s) { acc[ta] = __builtin_amdgcn_mfma_f32_16x16x32_bf16(An[u][ta][s], Bhi[s], acc[ta], 0, 0, 0); acc[ta] = __builtin_amdgcn_mfma_f32_16x16x32_bf16(An[u][ta][s], Blo[s], acc[ta], 0, 0, 0); } }
            if (SM == 0) RW_LOAD_SET(u, (ch + uu + 2 < T / 64) ? unit + 16 : unit);
#pragma unroll
            for (int s = 0; s < 2; ++s) { u32x4 hi, lo; float rem[8];
#pragma unroll
                for (int p = 0; p < 8; ++p) { const float v = acc[2 * s + (p >> 2)][p & 3]; const unsigned hb = f2bf(v); rem[p] = v - __uint_as_float(hb << 16); }
                hi.x = pk2(acc[2 * s][0], acc[2 * s][1]); hi.y = pk2(acc[2 * s][2], acc[2 * s][3]); hi.z = pk2(acc[2 * s + 1][0], acc[2 * s + 1][1]); hi.w = pk2(acc[2 * s + 1][2], acc[2 * s + 1][3]);
                lo.x = pk2(rem[0], rem[1]); lo.y = pk2(rem[2], rem[3]); lo.z = pk2(rem[4], rem[5]); lo.w = pk2(rem[6], rem[7]);
                Bhi[s] = __builtin_bit_cast(bf16x8, hi); Blo[s] = __builtin_bit_cast(bf16x8, lo); }
        }
    }
}
#undef RW_LOAD_SET

__device__ __forceinline__ void phase_rwkv_out(const Ctx& c, const Args& a, int layer, const bf16_t* proj, const bf16_t* rwu, const bf16_t* rws, const float* bonusg, bf16_t* orwkv) {
    const float* mu = inptr(c, I_MU) + (size_t)layer * 1792;
    const int lane = c.lane, m = lane & 15, q = lane >> 4;
    for (int unit = c.bid * 8 + c.wave; unit < 2048; unit += c.G * 8) {
        const int ch = unit >> 3, h = unit & 7, t0 = ch * 64; const bf16_t* ug = rwu + (size_t)unit * 16384; const bf16_t* sg = rws + (size_t)unit * 4096;
        bf16x8 Bf[4][2];
#pragma unroll
        for (int cq = 0; cq < 4; ++cq) { Bf[cq][0] = *(const bf16x8*)(sg + cq * 1024 + lane * 8); Bf[cq][1] = *(const bf16x8*)(sg + cq * 1024 + 512 + lane * 8); }
        float lnw[4], lnb[4];
#pragma unroll
        for (int cq = 0; cq < 4; ++cq) { lnw[cq] = inptr(c, I_LNW)[layer * 512 + h * 64 + 16 * cq + m]; lnb[cq] = inptr(c, I_LNB)[layer * 512 + h * 64 + 16 * cq + m]; }
        float muv[4];
#pragma unroll
        for (int cq = 0; cq < 4; ++cq) muv[cq] = mu[PC_V + h * 64 + 16 * cq + m];
#pragma unroll 1
        for (int ta = 0; ta < 4; ++ta) {
            const bf16x8 A0 = *(const bf16x8*)(ug + 8192 + (16 * ta + m) * 64 + 8 * q), A1 = *(const bf16x8*)(ug + 8192 + (16 * ta + m) * 64 + 32 + 8 * q);
            f32x4 y[4];
#pragma unroll
            for (int cq = 0; cq < 4; ++cq) { const u32x2 z = *(const u32x2*)(ug + 12288 + ((cq * 4 + ta) * 64 + lane) * 4);
                y[cq] = (f32x4){__uint_as_float(z.x << 16), __uint_as_float(z.x & 0xffff0000u), __uint_as_float(z.y << 16), __uint_as_float(z.y & 0xffff0000u)};
                y[cq] = __builtin_amdgcn_mfma_f32_16x16x32_bf16(A0, Bf[cq][0], y[cq], 0, 0, 0); y[cq] = __builtin_amdgcn_mfma_f32_16x16x32_bf16(A1, Bf[cq][1], y[cq], 0, 0, 0); }
            bf16_t vcur[4][4], vprv[4][4], graw[4][4]; float bonv[4];
#pragma unroll
            for (int r = 0; r < 4; ++r) { const int t = t0 + 16 * ta + 4 * q + r; bonv[r] = bonusg[(size_t)t * 8 + h];
#pragma unroll
                for (int cq = 0; cq < 4; ++cq) { const int col = h * 64 + 16 * cq + m; vcur[r][cq] = proj[(size_t)t * PLD + PC_V + col];
                    vprv[r][cq] = t > 0 ? proj[(size_t)(t - 1) * PLD + PC_V + col] : (bf16_t)0; graw[r][cq] = orwkv[(size_t)t * 512 + col]; } }
#pragma unroll
            for (int r = 0; r < 4; ++r) { const int t = t0 + 16 * ta + 4 * q + r;
                float sm = row16_sum(y[0][r] + y[1][r] + y[2][r] + y[3][r]);
                const float mean = sm * (1.0f / 64.0f); float d[4], vs = 0.f;
#pragma unroll
                for (int cq = 0; cq < 4; ++cq) { d[cq] = y[cq][r] - mean; vs += d[cq] * d[cq]; }
                vs = row16_sum(vs);
                const float rstd = rsqrtf(vs * (1.0f / 64.0f) + 64e-5f); const float bon = bonv[r];
#pragma unroll
                for (int cq = 0; cq < 4; ++cq) { const int col = h * 64 + 16 * cq + m; const float vc = bf2f(vcur[r][cq]); const float v = vc + (bf2f(vprv[r][cq]) - vc) * muv[cq];
                    orwkv[(size_t)t * 512 + col] = (bf16_t)f2bf((d[cq] * rstd * lnw[cq] + lnb[cq] + bon * v) * bf2f(graw[r][cq])); } }
        }
    }
}


constexpr int AT_K = 0, AT_V = 9216, AT_SCORE = 18432  , AT_UNUSED = 0;
__device__ __forceinline__ void vt_transpose(const Ctx& c, const bf16_t* proj, bf16_t* vt) {
    LAS bf16_t* tl = (LAS bf16_t*)c.lds;
    for (int it = c.bid; it < 3 * 2 * 256; it += c.G) {
        const int which = it / 512, g = (it >> 8) & 1, tt = it & 255;
        const int col = (which == 0 ? PC_VS : (which == 1 ? PC_VW : PC_SV)) + g * 64;
        { const int tok = c.tid >> 3, ch = c.tid & 7; const u32x4 w = *(const u32x4*)(proj + (size_t)(tt * 64 + tok) * PLD + col + ch * 8);
          *(LAS u32x4*)(tl + tok * 72 + ch * 8) = w; }
        __syncthreads();
        { const int d = c.tid >> 3, ch = c.tid & 7; unsigned short e[8];
#pragma unroll
          for (int k = 0; k < 8; ++k) e[k] = tl[(ch * 8 + k) * 72 + d];
          u32x4 w; w.x = e[0] | ((unsigned)e[1] << 16); w.y = e[2] | ((unsigned)e[3] << 16); w.z = e[4] | ((unsigned)e[5] << 16); w.w = e[6] | ((unsigned)e[7] << 16);
          *(u32x4*)(vt + ((size_t)(which * 2 + g) * 64 + d) * T + tt * 64 + ch * 8) = w; }
        __syncthreads();
    }
}

template <int MODE, int NQ, int DBG = 0>
__device__ __forceinline__ void phase_attn(const Ctx& c, const Args& a, int layer, const bf16_t* proj, const bf16_t* vtb, const bf16_t* kcb, const bf16_t* vctb,
                                           unsigned* sel, float* nsaacc, bf16_t* oout) {
    LAS unsigned char* L = c.lds;
    LAS float* sscore = (LAS float*)(L + AT_SCORE);
    constexpr int NT = (MODE == 2) ? 2856 : 1160, DOFF = (MODE == 2) ? 1823 : 1023;
    constexpr int A_BIAS = (MODE == 2) ? 83968 : 110592, A_SELM = A_BIAS + 16 * NT, A_LIST = A_SELM + 2048, A_NLIST = A_LIST + 1024, A_NEED = A_NLIST + 32, A_REL = A_NEED + 96;
    static_assert(A_REL + 2048 <= LDS_MISC, "attention LDS map");
    LAS float* biasd = (LAS float*)(L + A_BIAS);
    LAS unsigned* selm = (LAS unsigned*)(L + A_SELM);
    LAS int* list = (LAS int*)(L + A_LIST);
    LAS int* nlist = (LAS int*)(L + A_NLIST);
    LAS unsigned* need = (LAS unsigned*)(L + A_NEED);
    const int lane = c.lane, wave = c.wave, n = lane & 15, q = lane >> 4, hr = n & 3;
    LAS float* reltab = (LAS float*)(L + A_REL);
    __syncthreads();
    reltab[c.tid] = inptr(c, I_REL)[c.tid];
    constexpr int TW = 4 * NQ, TB = 8 * TW, NU = T / TB, TS = (MODE == 3) ? 6 : 1;
    for (int unit = c.bid; unit < 2 * NU; unit += c.G) {
        const int g = unit / NU, t0 = ((g == 0) ? (unit % NU) : (NU - 1 - unit % NU)) * TB, tw0 = t0 + wave * TW;
        __syncthreads();
        for (int e = c.tid; e < 4 * NT; e += 512) { const int r = e / NT, dist = DOFF - (e - r * NT); const bool vis = dist >= 0 && (MODE != 0 || dist < 128) && (MODE != 1 || dist < 512);
            biasd[e] = vis ? reltab[t5_bucket(dist > 1023 ? 1023 : dist) * 16 + (MODE == 0 ? 8 : 0) + g * 4 + r] : -1e30f; }
        if (MODE == 3) {
            if (c.tid < 8) need[c.tid] = 0u;
            __syncthreads();
            { const int tok = c.tid >> 3, w8 = c.tid & 7; const unsigned mw = selp((unsigned char*)sel, t0 + tok, g)[w8]; selm[tok * 8 + w8] = mw; atomicOr((unsigned*)&need[w8], mw); }
            __syncthreads();
            if (c.tid < 256) { const int j = c.tid; const unsigned wd = need[j >> 5];
                if ((wd >> (j & 31)) & 1u) { int pos = __popc(wd & ((1u << (j & 31)) - 1u)); for (int w2 = 0; w2 < (j >> 5); ++w2) pos += __popc(need[w2]); list[pos] = j; } }
            if (c.tid == 0) { int cnt = 0; for (int w2 = 0; w2 < 8; ++w2) cnt += __popc(need[w2]); nlist[0] = cnt; }
        }
        __syncthreads();
        int ntiles, tile_lo = 0;
        if (MODE == 0) { ntiles = 2 + TB / 64; tile_lo = t0 - 128; }
        else if (MODE == 1) { ntiles = 8 + TB / 64; tile_lo = t0 - 512; }
        else if (MODE == 2) { const int cmax = (t0 + TB - 1 - 31) >> 4; ntiles = cmax < 0 ? 0 : (cmax >> 6) + 1; }
        else ntiles = nlist[0];
        const bf16_t* Ksrc; size_t kstride; const bf16_t* Vsrc; size_t vstride; int qcol;
        if (MODE == 0) { Ksrc = proj + PC_SK + g * 64; kstride = PLD; Vsrc = vtb + (size_t)(4 + g) * 64 * T; vstride = T; qcol = PC_SQ + g * 256; }
        else if (MODE == 1) { Ksrc = proj + PC_KW + g * 64; kstride = PLD; Vsrc = vtb + (size_t)(2 + g) * 64 * T; vstride = T; qcol = PC_NQ + g * 256; }
        else if (MODE == 2) { Ksrc = kcb + (size_t)g * 1024 * 64; kstride = 64; Vsrc = vctb + (size_t)g * 64 * 1024; vstride = 1024; qcol = PC_NQ + g * 256; }
        else { Ksrc = proj + PC_KS + g * 64; kstride = PLD; Vsrc = vtb + (size_t)(0 + g) * 64 * T; vstride = T; qcol = PC_NQ + g * 256; }
        bf16x8 Bq[NQ][2];
#pragma unroll
        for (int qd = 0; qd < NQ; ++qd) { const bf16_t* qp = proj + (size_t)(tw0 + 4 * qd + (n >> 2)) * PLD + qcol + hr * 64 + 8 * q;
            Bq[qd][0] = *(const bf16x8*)qp; Bq[qd][1] = *(const bf16x8*)(qp + 32); }
        const float bfar = reltab[31 * 16 + (MODE == 0 ? 8 : 0) + g * 4 + hr];
        float mrun[NQ], lrun[NQ]; f32x4 O[NQ][4];
#pragma unroll
        for (int qd = 0; qd < NQ; ++qd) { mrun[qd] = -1e30f; lrun[qd] = 0.f;
#pragma unroll
            for (int dt = 0; dt < 4; ++dt) O[qd][dt] = (f32x4){0.f, 0.f, 0.f, 0.f}; }
        float carry3[NQ]; for (int i = 0; i < NQ; ++i) carry3[i] = 0.f;
        const int npass = (MODE == 2) ? 2 : 1;
        for (int pass = 0; pass < npass; ++pass) {
            const bool do_pv = (MODE != 2) || pass == 1;
            float linv[NQ];
            if (MODE == 2 && pass == 1) {
#pragma unroll
                for (int qd = 0; qd < NQ; ++qd) { float mt = mrun[qd]; mt = fmaxf(mt, __shfl_xor(mt, 16)); mt = fmaxf(mt, __shfl_xor(mt, 32));
                    float lt = lrun[qd] * __expf(mrun[qd] - mt); lt += __shfl_xor(lt, 16); lt += __shfl_xor(lt, 32); mrun[qd] = mt; linv[qd] = lt > 0.f ? 1.0f / lt : 0.f; }
            }
#define AT_TILEPOS(ti) ((MODE == 3) ? list[ti] * 64 : (MODE == 2 ? (ti) * 64 : tile_lo + (ti) * 64))
#define AT_ISSUE(rd) do { _Pragma("unroll") for (int i_ = 0; i_ < TS; ++i_) { const int ti_ = (rd) * TS + i_; p0n[i_] = ti_ < ntiles ? AT_TILEPOS(ti_) : -1; \
        if (p0n[i_] >= 0) { kreg[i_] = *(const u32x4*)((Ksrc + (size_t)p0n[i_] * kstride) + kthr); \
            if (do_pv) vreg[i_] = *(const u32x4*)((Vsrc + p0n[i_]) + vthr); } } } while (0)
            const unsigned kthr = (unsigned)(c.tid >> 3) * (unsigned)kstride + (unsigned)(c.tid & 7) * 8u, vthr = (unsigned)(c.tid >> 3) * (unsigned)vstride + (unsigned)(c.tid & 7) * 8u;
            int st_k, st_va;
            { const int row = c.tid >> 3, cj = c.tid & 7, ga = 2 * cj;
              st_k = row * 128 + (((cj ^ row) & 7) << 4);
              st_va = row * 128 + (((((ga >> 3) * 4 + (ga & 3)) ^ row) & 7) << 4) + ((ga >> 2) & 1) * 8; }
            u32x4 kreg[TS], vreg[TS]; int p0n[TS];
            const int nrounds = (ntiles + TS - 1) / TS;
            if (nrounds > 0) AT_ISSUE(0);
            for (int rd = 0; rd < nrounds; ++rd) {
                int p0s[TS];
#pragma unroll
                for (int i = 0; i < TS; ++i) p0s[i] = p0n[i];
                __syncthreads();
#pragma unroll
                for (int i = 0; i < TS; ++i) if (p0s[i] >= 0) {
                    *(LAS u32x4*)(L + AT_K + i * 18432 + st_k) = kreg[i];
                    if (do_pv) { const u32x2 lo = {vreg[i].x, vreg[i].y}, hi = {vreg[i].z, vreg[i].w};
                        *(LAS u32x2*)(L + AT_V + i * 18432 + st_va) = lo; *(LAS u32x2*)(L + AT_V + i * 18432 + (st_va ^ 16)) = hi; } }
                if (rd + 1 < nrounds) AT_ISSUE(rd + 1);
                __syncthreads();
#pragma unroll
              for (int ts = 0; ts < TS; ++ts) {
                const int p0 = p0s[ts]; const int LK = AT_K + ts * 18432, LV = AT_V + ts * 18432;
                if (p0 < 0) continue;
                if (MODE == 0) { if (p0 > tw0 + TW - 1 || p0 + 63 < tw0 - 127) continue; }
                if (MODE == 1) { if (p0 > tw0 + TW - 1 || p0 + 63 < tw0 - 511) continue; }
                if (MODE == 2) { if (16 * p0 + 31 > tw0 + TW - 1) continue; }
                if (MODE == 3) { if (p0 > tw0 + TW - 1) continue; }
                const bool far = (MODE == 2) ? (tw0 - (16 * (p0 + 63) + 31) >= 790) : ((MODE == 3) ? (tw0 - (p0 + 63) >= 790) : false);
                const int jblk = p0 >> 6;
                bf16x8 akf[4][2]; bf16x8 avf[2][4];
                if (MODE != 3) {
#pragma unroll
                    for (int kt = 0; kt < 4; ++kt)
#pragma unroll
                        for (int ks = 0; ks < 2; ++ks) akf[kt][ks] = *(const LAS bf16x8*)(L + LK + (16 * kt + n) * 128 + ((((4 * ks + q) ^ n) & 7) << 4));
                    if (do_pv) {
#pragma unroll
                        for (int st = 0; st < 2; ++st)
#pragma unroll
                            for (int dt = 0; dt < 4; ++dt) avf[st][dt] = *(const LAS bf16x8*)(L + LV + (16 * dt + n) * 128 + ((((4 * st + q) ^ n) & 7) << 4)); }
                }
                unsigned tokmask = 0u;
                if (MODE == 3) { tokmask = (unsigned)__ballot(lane < TW && ((selm[(wave * TW + (lane & (TW - 1))) * 8 + (jblk >> 5)] >> (jblk & 31)) & 1u)); if (tokmask == 0u) continue; }
#pragma unroll
                for (int qd = 0; qd < NQ; ++qd) {
                    const int tq = tw0 + 4 * qd + (n >> 2);
                    if (DBG == 3) continue;
                    bool colsel = true;
                    if (MODE == 3) { colsel = (tokmask >> (4 * qd + (n >> 2))) & 1u; if (((tokmask >> (4 * qd)) & 0xfu) == 0u) continue; }
                    {
                        f32x4 sc[4];
#pragma unroll
                        for (int kt = 0; kt < 4; ++kt) { sc[kt] = (f32x4){0.f, 0.f, 0.f, 0.f};
#pragma unroll
                            for (int ks = 0; ks < 2; ++ks) { const bf16x8 ak = (MODE != 3) ? akf[kt][ks] : *(const LAS bf16x8*)(L + LK + (16 * kt + n) * 128 + ((((4 * ks + q) ^ n) & 7) << 4));
                                sc[kt] = __builtin_amdgcn_mfma_f32_16x16x32_bf16(ak, Bq[qd][ks], sc[kt], 0, 0, 0); } }
                        float mx;
                        if (far) {
#pragma unroll
                            for (int kt = 0; kt < 4; ++kt) sc[kt] = sc[kt] + bfar;
                        } else {
                            const LAS float* tp = (MODE == 2) ? biasd + hr * NT + (DOFF - tq + 31 + 16 * p0) + 64 * q : biasd + hr * NT + (DOFF - tq + p0) + 4 * q;
#pragma unroll
                            for (int kt = 0; kt < 4; ++kt)
#pragma unroll
                                for (int r = 0; r < 4; ++r) sc[kt][r] += (MODE == 2) ? tp[256 * kt + 16 * r] : tp[16 * kt + r];
                        }
                        { float m = fmaxf(fmaxf(sc[0][0], sc[0][1]), sc[0][2]);
                          m = fmaxf(fmaxf(m, sc[0][3]), sc[1][0]); m = fmaxf(fmaxf(m, sc[1][1]), sc[1][2]); m = fmaxf(fmaxf(m, sc[1][3]), sc[2][0]);
                          m = fmaxf(fmaxf(m, sc[2][1]), sc[2][2]); m = fmaxf(fmaxf(m, sc[2][3]), sc[3][0]); m = fmaxf(fmaxf(m, sc[3][1]), sc[3][2]); mx = fmaxf(m, sc[3][3]); }
                        if (MODE == 3 && !colsel) mx = -1e30f;
                        float p[4][4];
                        constexpr float L2E = 1.4426950408889634f;
                        if (MODE == 2 && pass == 1) {
                            const float negm1 = mrun[qd] < -1e29f ? 0.f : -mrun[qd] * L2E;
#pragma unroll
                            for (int kt = 0; kt < 4; ++kt)
#pragma unroll
                                for (int r = 0; r < 4; ++r) p[kt][r] = __builtin_amdgcn_exp2f(__builtin_fmaf(sc[kt][r], L2E, negm1)) * linv[qd];
                        } else if (MODE == 2) {
                            const float mn = fmaxf(mrun[qd], mx), corr = __expf(mrun[qd] - mn); mrun[qd] = mn; float ps = 0.f;
                            const float negm0 = mn < -1e29f ? 0.f : -mn * L2E;
#pragma unroll
                            for (int kt = 0; kt < 4; ++kt)
#pragma unroll
                                for (int r = 0; r < 4; ++r) ps += __builtin_amdgcn_exp2f(__builtin_fmaf(sc[kt][r], L2E, negm0));
                            lrun[qd] = lrun[qd] * corr + ps;
                        } else {
                            if (__any(mx > mrun[qd])) {
                                mx = fmaxf(mx, __shfl_xor(mx, 16)); mx = fmaxf(mx, __shfl_xor(mx, 32));
                                const float mn = fmaxf(mrun[qd], mx), corr = __expf(mrun[qd] - mn); mrun[qd] = mn;
                                lrun[qd] *= corr;
#pragma unroll
                                for (int dt = 0; dt < 4; ++dt) O[qd][dt] = O[qd][dt] * corr;
                            }
                            float negm = mrun[qd] < -1e29f ? 0.f : -mrun[qd] * L2E; float ps = 0.f;
                            if (MODE == 3 && !colsel) negm = -__builtin_inff();
#pragma unroll
                            for (int kt = 0; kt < 4; ++kt)
#pragma unroll
                                for (int r = 0; r < 4; ++r) { p[kt][r] = (DBG == 2) ? sc[kt][r] + negm : __builtin_amdgcn_exp2f(__builtin_fmaf(sc[kt][r], L2E, negm)); ps += p[kt][r]; }
                            lrun[qd] += ps;
                        }
                        if (MODE == 2 && pass == 1) {
                            float i3prev = carry3[qd];
#pragma unroll
                            for (int kt = 0; kt < 4; ++kt) { float im[4];
#pragma unroll
                                for (int r = 0; r < 4; ++r) { float v = p[kt][r]; v += dpp_xor1(v); v += dpp_xor2(v); im[r] = v; }
                                const float same = __shfl(im[3], (lane + 48) & 63), prevt = __shfl(i3prev, (lane + 48) & 63);
                                const float pv3 = q > 0 ? same : prevt;
                                const int jg = (p0 + 16 * kt + 4 * q) >> 2;
                                if (hr == 0 && jg < 256) sscore[(tq - t0) * 256 + jg] = 2.0f * (im[0] + im[1] + im[2]) + im[3] + pv3;
                                i3prev = im[3]; }
                            carry3[qd] = i3prev;
                        }
                        if (do_pv && DBG != 1) {
#pragma unroll
                            for (int st = 0; st < 2; ++st) {
                                u32x4 pw; pw.x = pk2(p[2 * st][0], p[2 * st][1]); pw.y = pk2(p[2 * st][2], p[2 * st][3]); pw.z = pk2(p[2 * st + 1][0], p[2 * st + 1][1]); pw.w = pk2(p[2 * st + 1][2], p[2 * st + 1][3]);
                                const bf16x8 pf = __builtin_bit_cast(bf16x8, pw);
#pragma unroll
                                for (int dt = 0; dt < 4; ++dt) { bf16x8 av;
                                    if (MODE != 3) av = avf[st][dt];
                                    else av = *(const LAS bf16x8*)(L + LV + (16 * dt + n) * 128 + ((((4 * st + q) ^ n) & 7) << 4));
                                    O[qd][dt] = __builtin_amdgcn_mfma_f32_16x16x32_bf16(av, pf, O[qd][dt], 0, 0, 0); } }
                        }
                    }
                }
              }
            }
        }
#undef AT_ISSUE
#undef AT_TILEPOS
        if (MODE == 2) {
            __syncthreads();
#pragma unroll 1
            for (int tk = 0; tk < TW; ++tk) { const int t = tw0 + tk, cur = t >> 6; const LAS float* sp = sscore + (wave * TW + tk) * 256;
                unsigned key[4]; bool forced[4];
#pragma unroll
                for (int jj = 0; jj < 4; ++jj) { const int j = lane + 64 * jj; forced[jj] = (j == 0 || j == cur || j == cur - 1);
                    key[jj] = (!forced[jj] && j < cur - 1) ? __float_as_uint(sp[j]) + 1u : 0u; }
                const int nforced = cur >= 2 ? 3 : cur + 1;
                unsigned prefix = 0u; int remaining = 16 - nforced;
#pragma unroll 1
                for (int bit = 30; bit >= 0; --bit) { const unsigned test = prefix | (1u << bit); int cnt = 0;
#pragma unroll
                    for (int jj = 0; jj < 4; ++jj) cnt += __popcll(__ballot((key[jj] >> bit) == (test >> bit)));
                    if (cnt >= remaining) prefix = test; else remaining -= cnt; }
                int eqbase = 0;
#pragma unroll
                for (int jj = 0; jj < 4; ++jj) { const bool eq = key[jj] == prefix && key[jj] != 0u; const unsigned long long eb = __ballot(eq);
                    const int eqrank = eqbase + __popcll(eb & ((1ull << lane) - 1ull)); eqbase += __popcll(eb);
                    const bool on = forced[jj] || key[jj] > prefix || (eq && eqrank < remaining); const unsigned long long bl = __ballot(on);
                    if (lane == 0) { unsigned* mp = selp((unsigned char*)sel, t, g); mp[2 * jj] = (unsigned)bl; mp[2 * jj + 1] = (unsigned)(bl >> 32); } }
            }
        }
#pragma unroll
        for (int qd = 0; qd < NQ; ++qd) {
            const int tq = tw0 + 4 * qd + (n >> 2), hh = g * 4 + hr;
            float scale;
            if (MODE == 2) scale = 1.0f;
            else { float lt = lrun[qd]; lt += __shfl_xor(lt, 16); lt += __shfl_xor(lt, 32);
                if (MODE == 0) { const float sink = inptr(c, I_SINK)[layer * 8 + hh]; const float mf = fmaxf(mrun[qd], sink), cr = __expf(mrun[qd] - mf); scale = cr / (lt * cr + __expf(sink - mf)); }
                else scale = lt > 0.f ? 1.0f / lt : 0.f; }
            if (MODE != 0) scale *= sigmoidf_(bf2f(proj[(size_t)tq * PLD + PC_GL + (MODE == 2 ? 0 : (MODE == 3 ? 8 : 16)) + hh]));
#pragma unroll
            for (int dt = 0; dt < 4; ++dt) { const f32x4 o = O[qd][dt] * scale; const int col = hh * 64 + 16 * dt + 4 * q;
                if (MODE == 0) { u32x2 w; w.x = pk2(o[0], o[1]); w.y = pk2(o[2], o[3]); *(u32x2*)(oout + (size_t)tq * 512 + col) = w; }
                else if (MODE == 2) *(f32x4*)(nsaacc + (size_t)tq * 512 + col) = o;
                else if (MODE == 1) { f32x4* ap = (f32x4*)(nsaacc + (size_t)tq * 512 + col); *ap = *ap + o; }
                else { const f32x4 t2 = *(const f32x4*)(nsaacc + (size_t)tq * 512 + col) + o; u32x2 w; w.x = pk2(t2[0], t2[1]); w.y = pk2(t2[2], t2[3]); *(u32x2*)(oout + (size_t)tq * 512 + col) = w; } }
        }
    }
}
#define wb ((bf16_t*)(ws + WS_WB))
#define xb ((bf16_t*)(ws + WS_XB))
#define cntp ((unsigned*)(ws + WS_CNT))
#define xres (args.out)
#define kcb ((bf16_t*)(ws + WS_KCB))
#define vctb ((bf16_t*)(ws + WS_VCT))
#define vtb ((bf16_t*)(ws + WS_VT))
#define scores ((float*)(ws + WS_SCORES))
#define sel ((unsigned*)ws)
#define ml ((float*)(ws + WS_ML))
#define hidb ((bf16_t*)(ws + WS_HID))
#define proj ((bf16_t*)(ws + WS_PROJ))
#define gates ((bf16_t*)(ws + WS_GATES))
#define merged ((bf16_t*)(ws + WS_MERGED))
#define tmpb ((bf16_t*)(ws + WS_TMPB))
#define alora ((bf16_t*)(ws + WS_ALORA))
#define rwu ((bf16_t*)(ws + WS_RWU))
#define rws ((bf16_t*)(ws + WS_RWS))
#define bonusg ((float*)(ws + WS_BONUS))
#define nsaacc ((float*)(ws + WS_NSAACC))
#define obuf ((bf16_t*)(ws + WS_O))
#define act ((bf16_t*)(ws + WS_ACT))
#define tmpf ((bf16_t*)(ws + WS_TMPF))
constexpr int PH_PER_BATCH = 8, PH_PER_LAYER = 1 + 2 * PH_PER_BATCH + 2, PH_TOTAL = 1 + DEPTH * PH_PER_LAYER;

__global__ void __launch_bounds__(512, 2) fwd_kernel(Args args) {
    extern __shared__ __attribute__((aligned(16))) unsigned char lds_raw[];
    Ctx c0; c0.lds = (LAS unsigned char*)lds_raw; c0.tid = threadIdx.x; c0.lane = c0.tid & 63; c0.wave = __builtin_amdgcn_readfirstlane(c0.tid >> 6); c0.G = gridDim.x; c0.bid = blockIdx.x; const Ctx& c = c0;
    unsigned char* ws = args.ws;
    volatile LAS unsigned* misc = (volatile LAS unsigned*)(c.lds + LDS_MISC);
    if (c.tid < 4) misc[c.tid] = 0u;
    if (c.tid < 30) { const unsigned long long pv = (unsigned long long)args.in[c.tid & 31]; misc[16 + 2 * c.tid] = (unsigned)pv; misc[17 + 2 * c.tid] = (unsigned)(pv >> 32); }
    __syncthreads();
    XcdBarrier bar; bar.bar = (unsigned*)(ws + WS_CTL); bar.x = 0; bar.st = misc;
    const int lo = args.lo, hi = args.hi;
    const bool multi = (hi - lo) > 1;
    if (multi) bar = xcd_barrier_post((unsigned*)(ws + WS_CTL), misc);
    int gp = 0;
#ifndef ONLY_PH
#define ONLY_PH -1
#endif
#ifndef PHMASK
#define PHMASK 0xffffff
#endif
#ifndef REPMASK
#define REPMASK 0
#endif
#ifndef PR_SEL
#define PR_SEL 0
#endif
#ifndef PR_SWA
#define PR_SWA 0
#endif
#ifndef PR_CMP
#define PR_CMP 0
#endif
#ifndef PR_CHUNK
#define PR_CHUNK 0
#endif
#define PHASE_BEGIN(id) if (gp >= lo && gp < hi) { for (int rep_ = 0; rep_ < (((REPMASK >> (id)) & 1) ? 2 : 1); ++rep_) { if (rep_) __syncthreads(); \
    Ctx pc = c0; asm volatile("" : "+v"(pc.tid), "+s"(pc.bid)); pc.lane = pc.tid & 63; pc.wave = __builtin_amdgcn_readfirstlane(pc.tid >> 6); const Ctx& c = pc;
#define PHASE_END   } if (gp + 1 < hi) xcd_barrier(bar); } ++gp;
#define RELAUNDER() do { asm volatile("" : "+v"(pc.tid), "+s"(pc.bid)); pc.lane = pc.tid & 63; pc.wave = __builtin_amdgcn_readfirstlane(pc.tid >> 6); } while (0)

    PHASE_BEGIN(0) phase_init(c, inptr(c, I_X), xres, xb, ws); PHASE_END

    for (int layer = 0; layer < DEPTH; ++layer) {
        PHASE_BEGIN(1) phase_cvt(c, args, layer, wb); PHASE_END
        for (int b = 0; b < NBATCH; ++b) {
            const int row0 = b * T;
            PHASE_BEGIN(2) {
                pg8::Gemm g{xb + (size_t)row0 * D, wb + WB_WIN, D, D, D}; pg8::Sched S; S.init(T / 256, NIN / 256, c.G, c.bid, 1, (size_t)256 * D * 2, 0, (size_t)256 * D * 2, 0);
                pg8::EpiInProj E{proj, gates, ws, row0}; pg8::gemm_phase(c.lds, c.tid, g, S, E); } PHASE_END
            PHASE_BEGIN(16) {
                { pg8::Gemm g{proj, wb + WB_W1T, 16 * PLD, 2048, 2048, (unsigned)PLD * 2}; pg8::Sched S; S.init(16, 1, c.G, c.bid, 1, 0, 0, 0, 0); S.mode = 1;
                  pg8::EpiCmp1 E{hidb, (const float*)(wb + WB_BH)}; pg8::gemm_phase(c.lds, c.tid, g, S, E); }
                RELAUNDER();
                if (c.bid >= 16) { Ctx cv = c; cv.bid = c.bid - 16; cv.G = c.G - 16; phase_lora_a(cv, args, layer, proj, alora); vt_transpose(cv, proj, vtb); } } PHASE_END
            PHASE_BEGIN(17) {
                { pg8::Gemm g{alora, wb + WB_LORA, 256, 256, 256}; pg8::Sched S; S.init(T / 256, 6, c.G, c.bid, 1, (unsigned)256 * 256 * 2, 0, (unsigned)256 * 256 * 2, 0);
                  pg8::EpiLora E{obuf}; pg8::gemm_phase(c.lds, c.tid, g, S, E); }
                RELAUNDER();
                { pg8::Gemm g{hidb, wb + WB_W2T, 256, 256, 256}; pg8::Sched S; S.init(16, 1, c.G, (c.bid + 16) % c.G, 1, (unsigned)256 * 256 * 2, 0, 0, 0); S.mode = 2;
                  pg8::EpiCmp2 E{kcb, vctb}; pg8::gemm_phase(c.lds, c.tid, g, S, E); } } PHASE_END
            PHASE_BEGIN(18) {
                for (int pr_ = 0; pr_ <= PR_CHUNK; ++pr_) { phase_rwkv_chunk(c, args, layer, proj, obuf + (size_t)T * 512, obuf + (size_t)2 * T * 512, rwu, bonusg);
                __syncthreads(); RELAUNDER(); }
                for (int pr_ = 0; pr_ <= PR_CMP; ++pr_) { phase_attn<2, 2>(c, args, layer, proj, vtb, kcb, vctb, sel, nsaacc, obuf + (size_t)T * 512); __syncthreads(); } } PHASE_END
            PHASE_BEGIN(19) {
                phase_rwkv_scan<0>(c, rwu, rws);
                RELAUNDER();
                if (c.bid >= 32) { Ctx cv = c; cv.bid = c.bid - 32; cv.G = c.G - 32;
                    phase_attn<1, 2>(cv, args, layer, proj, vtb, kcb, vctb, sel, nsaacc, obuf + (size_t)T * 512);
                    asm volatile("" : "+v"(cv.tid), "+s"(cv.bid)); cv.lane = cv.tid & 63; cv.wave = __builtin_amdgcn_readfirstlane(cv.tid >> 6);

#if PR_SWA > 1
                    { phase_attn<0, 2, PR_SWA - 1>(cv, args, layer, proj, vtb, kcb, vctb, sel, nsaacc, obuf + (size_t)2 * T * 512); __syncthreads(); }
#endif
                    for (int pr_ = 0; pr_ <= (PR_SWA == 1 ? 1 : 0); ++pr_) { phase_attn<0, 2>(cv, args, layer, proj, vtb, kcb, vctb, sel, nsaacc, obuf + (size_t)2 * T * 512); __syncthreads(); } } } PHASE_END
            PHASE_BEGIN(9) {
                phase_rwkv_out(c, args, layer, proj, rwu, rws, bonusg, obuf);
                __syncthreads(); RELAUNDER();
                #if PR_SEL > 1
                { phase_attn<3, 2, PR_SEL - 1>(c, args, layer, proj, vtb, kcb, vctb, sel, nsaacc, obuf + (size_t)T * 512); __syncthreads(); }
#endif
                for (int pr_ = 0; pr_ <= (PR_SEL == 1 ? 1 : 0); ++pr_) { phase_attn<3, 2>(c, args, layer, proj, vtb, kcb, vctb, sel, nsaacc, obuf + (size_t)T * 512); __syncthreads(); } } PHASE_END
            PHASE_BEGIN(10) {
                pg8::Gemm g{obuf, wb + WB_WBR, 512, 512, 512}; pg8::Sched S; S.init(T / 256, D / 256, c.G, c.bid, 3, (size_t)256 * 512 * 2, (size_t)T * 512 * 2, (size_t)256 * 512 * 2, (size_t)D * 512 * 2);
                pg8::EpiMerge E{gates, merged}; pg8::gemm_phase(c.lds, c.tid, g, S, E); } PHASE_END
            PHASE_BEGIN(11) {
                pg8::Gemm g{merged, wb + WB_WOUT, D, D, D}; pg8::Sched S; S.init(T / 256, D / 256, c.G, c.bid, 1, (unsigned)256 * D * 2, 0, (unsigned)256 * D * 2, 0);
                pg8::EpiNorm E{xres, xb, inptr(c, I_NQM) + layer * D, ws, cntp, row0, 1, 16u * (2u * layer + 1u), c.lds, c.tid}; pg8::gemm_phase(c.lds, c.tid, g, S, E); } PHASE_END
        }
        PHASE_BEGIN(13) {
            pg8::Gemm g{xb, wb + WB_WGU, D, D, D}; pg8::Sched S; S.init(MROWS / 256, 2 * FFN / 256, c.G, c.bid, 1, (size_t)256 * D * 2, 0, (size_t)256 * D * 2, 0);
            pg8::EpiSwiGLU E{act, ws}; pg8::gemm_phase(c.lds, c.tid, g, S, E); } PHASE_END
        PHASE_BEGIN(14) {
            { pg8::Gemm g{act, wb + WB_WDN, FFN, FFN, FFN}; pg8::Sched S; S.init(T / 256, D / 256, c.G, c.bid, 1, (unsigned)256 * FFN * 2, 0, (unsigned)256 * FFN * 2, 0);
              pg8::EpiNorm E{xres, xb, inptr(c, I_NQF) + layer * D, ws, cntp, 0, 0, 16u * (2u * layer + 2u), c.lds, c.tid}; pg8::gemm_phase(c.lds, c.tid, g, S, E); }
            __syncthreads(); RELAUNDER();
            { pg8::Gemm g{act + (size_t)T * FFN, wb + WB_WDN, FFN, FFN, FFN}; pg8::Sched S; S.init(T / 256, D / 256, c.G, c.bid, 1, (unsigned)256 * FFN * 2, 0, (unsigned)256 * FFN * 2, 0);
              pg8::EpiNorm E{xres, xb, inptr(c, I_NQF) + layer * D, ws, cntp, T, 0, 16u * (2u * layer + 2u), c.lds, c.tid}; pg8::gemm_phase(c.lds, c.tid, g, S, E); } } PHASE_END
    }
#undef PHASE_BEGIN
#undef PHASE_END
}

extern "C" void kernel_launch(void* const* d_in, const int* in_sizes, int n_in, void* d_out, int out_size, void* d_ws, size_t ws_size, hipStream_t stream) {
    static int grid = 0;
    if (grid == 0) {
        if (n_in != 30 || out_size != MROWS * D || ws_size < WS_END) { fprintf(stderr, "kernel_launch: unexpected shapes (n_in %d out %d ws %zu)\n", n_in, out_size, ws_size); grid = -1; return; }
        int dev = 0, cus = 0;
        if (hipGetDevice(&dev) != hipSuccess || hipDeviceGetAttribute(&cus, hipDeviceAttributeMultiprocessorCount, dev) != hipSuccess) { grid = -1; return; }
        if (hipFuncSetAttribute((const void*)fwd_kernel, hipFuncAttributeMaxDynamicSharedMemorySize, LDS_BYTES) != hipSuccess) { fprintf(stderr, "hipFuncSetAttribute failed\n"); grid = -1; return; }
        int per_cu = 0;
        if (hipOccupancyMaxActiveBlocksPerMultiprocessor(&per_cu, (const void*)fwd_kernel, 512, LDS_BYTES) != hipSuccess || per_cu < 1) { fprintf(stderr, "occupancy query: %d\n", per_cu); }
        (void)hipGetLastError();
        grid = cus;
    }
    if (grid < 0) return;
    (void)hipMemsetAsync((char*)d_ws + WS_CTL, 0, CTL_BYTES, stream);
    Args a{};
    for (int i = 0; i < 30; ++i) a.in[i] = (const float*)d_in[i];
    a.out = (float*)d_out; a.ws = (unsigned char*)d_ws;
#if MK_ONE_LAUNCH
    a.lo = 0; a.hi = PH_TOTAL;
    hipLaunchKernelGGL(fwd_kernel, dim3(grid), dim3(512), LDS_BYTES, stream, a);
#else
    for (int p = 0; p < PH_TOTAL; ++p) { a.lo = p; a.hi = p + 1; hipLaunchKernelGGL(fwd_kernel, dim3(grid), dim3(512), LDS_BYTES, stream, a); }
#endif
}
```

```cpp
#include <hip/hip_runtime.h>
#include <stdint.h>
#include <stdio.h>

#ifndef MK_ONE_LAUNCH
#define MK_ONE_LAUNCH 1
#endif

#define LAS __attribute__((address_space(3)))
typedef unsigned short bf16_t;
typedef short bf16x8 __attribute__((ext_vector_type(8)));
typedef float f32x4 __attribute__((ext_vector_type(4)));
typedef float f32x2 __attribute__((ext_vector_type(2)));
typedef unsigned u32x4 __attribute__((ext_vector_type(4)));
typedef unsigned u32x2 __attribute__((ext_vector_type(2)));

constexpr int D = 1024, NBATCH = 2, T = 16384, DEPTH = 4, MROWS = NBATCH * T;
constexpr int IN_COLS = 6936, FFN = 2816;
constexpr int PLD = 4096;
constexpr int PC_R = 0, PC_K = 512, PC_V = 1024, PC_ZW = 1536, PC_ZA = 1600, PC_ZG = 1664;
constexpr int PC_NQ = 1792, PC_KC = 2304, PC_VC = 2432, PC_KS = 2560, PC_VS = 2688, PC_KW = 2816, PC_VW = 2944, PC_GL = 3072;
constexpr int PC_SQ = 3328, PC_SK = 3840, PC_SV = 3968;
constexpr int NIN = 7168;
constexpr int NCMP = 1023;
constexpr float NORM_EPS = 1e-6f;

constexpr size_t MiB = 1u << 20;
constexpr size_t WS_CTL = 0, CTL_BYTES = 65536;
constexpr size_t WS_WB = 65536;
constexpr size_t WB_WIN = 0, WB_WBR = WB_WIN + (size_t)NIN * D, WB_WOUT = WB_WBR + (size_t)3 * D * 512, WB_WGU = WB_WOUT + (size_t)D * D,
                 WB_WDN = WB_WGU + (size_t)2 * FFN * D, WB_LORA = WB_WDN + (size_t)D * FFN, WB_W1T = WB_LORA + (size_t)1536 * 256, WB_W2T = WB_W1T + (size_t)2 * 256 * 2048,
                 WB_BH = WB_W2T + (size_t)2 * 256 * 256, WB_END = WB_BH + 1024;
static_assert(WS_WB + WB_END * 2 <= 38 * MiB + 786432, "weights");
constexpr size_t KiB = 1024;
constexpr size_t WS_XB = 38 * MiB + 768 * KiB;
constexpr size_t WS_CNT = 16384;
constexpr size_t WS_RS = WS_XB + 64 * MiB;
constexpr size_t WS_BONUS = WS_RS + 128 * KiB;
constexpr size_t WS_KCB = WS_BONUS + 512 * KiB;
constexpr size_t WS_VCT = WS_KCB + 256 * KiB;
constexpr size_t WS_STATS = WS_VCT + 256 * KiB;
constexpr size_t WS_SEL = WS_STATS;
constexpr size_t WS_HID = WS_SEL + 1 * MiB;
constexpr size_t WS_ML = WS_HID;
static_assert(WS_HID + 2 * MiB <= 107 * MiB, "small region");
constexpr size_t WS_ALORA = 107 * MiB;
constexpr size_t WS_VT = 115 * MiB;
constexpr size_t WS_BIG = 127 * MiB;
constexpr size_t WS_PROJ = WS_BIG;
constexpr size_t WS_GATES = WS_PROJ + 128 * MiB;
constexpr size_t WS_RWKVS = WS_GATES + 96 * MiB;
constexpr size_t WS_RWU = WS_RWKVS;
constexpr size_t WS_RWS = WS_RWKVS + 64 * MiB;
constexpr size_t WS_SCORES = WS_RWKVS;
constexpr size_t WS_MERGED = WS_RWKVS;
constexpr size_t WS_TMPB = WS_RWKVS + 32 * MiB;
constexpr size_t WS_NSAACC = WS_RWKVS + 80 * MiB;
constexpr size_t WS_O = WS_NSAACC + 32 * MiB;
constexpr size_t WS_END = WS_O + 48 * MiB;
constexpr size_t WS_ACT = WS_BIG;
constexpr size_t WS_TMPF = WS_BIG + 176 * MiB;
static_assert(WS_END <= 512 * MiB, "workspace");
static_assert(WS_TMPF + 64 * MiB <= WS_NSAACC, "ffn overlay");

constexpr int LDS_BYTES = 147456;
constexpr int LDS_MISC = 131072 + 8192;

__device__ __forceinline__ float* statp(unsigned char* ws, int row, int kind) {
    return (float*)(ws + WS_STATS + (kind >= 2 ? 524288 : 0)) + (size_t)row * 4; }
__device__ __forceinline__ unsigned* selp(unsigned char* ws, int t, int g) { return (unsigned*)(ws + WS_PROJ + (size_t)t * (PLD * 2) + 6272 + g * 32); }
__device__ __forceinline__ float bf2f(unsigned v) { return __uint_as_float(v << 16); }
typedef __bf16 bf16n2 __attribute__((ext_vector_type(2)));
__device__ __forceinline__ unsigned pk2(float lo, float hi) { const f32x2 f = {lo, hi}; const bf16n2 v = __builtin_convertvector(f, bf16n2); return __builtin_bit_cast(unsigned, v); }
__device__ __forceinline__ unsigned f2bf(float f) { return pk2(f, 0.f) & 0xffffu; }
__device__ __forceinline__ void unpack8(const u32x4 w, float (&f)[8]) {
    f[0] = __uint_as_float(w.x << 16); f[1] = __uint_as_float(w.x & 0xffff0000u); f[2] = __uint_as_float(w.y << 16); f[3] = __uint_as_float(w.y & 0xffff0000u);
    f[4] = __uint_as_float(w.z << 16); f[5] = __uint_as_float(w.z & 0xffff0000u); f[6] = __uint_as_float(w.w << 16); f[7] = __uint_as_float(w.w & 0xffff0000u);
}
#define DPPF(v, ctrl) __int_as_float(__builtin_amdgcn_update_dpp(0, __float_as_int(v), (ctrl), 0xf, 0xf, false))
__device__ __forceinline__ float row16_sum(float v) {
    v += DPPF(v, 0xB1); v += DPPF(v, 0x4E); v += DPPF(v, 0x141); v += DPPF(v, 0x140); return v;
}
__device__ __forceinline__ float wave_sum(float v) {
    v = row16_sum(v);
    const int iv = __float_as_int(v);
    return (__int_as_float(__builtin_amdgcn_readlane(iv, 0)) + __int_as_float(__builtin_amdgcn_readlane(iv, 16))) + (__int_as_float(__builtin_amdgcn_readlane(iv, 32)) + __int_as_float(__builtin_amdgcn_readlane(iv, 48)));
}
__device__ __forceinline__ float dpp_xor1(float v) { return __int_as_float(__builtin_amdgcn_update_dpp(0, __float_as_int(v), 0xB1, 0xf, 0xf, false)); }
__device__ __forceinline__ float dpp_xor2(float v) { return __int_as_float(__builtin_amdgcn_update_dpp(0, __float_as_int(v), 0x4E, 0xf, 0xf, false)); }
__device__ __forceinline__ float sigmoidf_(float x) { return __builtin_amdgcn_rcpf(1.0f + __expf(-x)); }
__device__ __forceinline__ int t5_bucket(int n) {
    if (n < 16) return n;
    int b = 16;
    b += (n >= 21); b += (n >= 27); b += (n >= 35); b += (n >= 46); b += (n >= 59); b += (n >= 77); b += (n >= 99); b += (n >= 128);
    b += (n >= 166); b += (n >= 216); b += (n >= 280); b += (n >= 363); b += (n >= 470); b += (n >= 609); b += (n >= 790);
    return b;
}

#define XB_TMO      128
#define XB_XCNT(j)  (256  + 64 * (j))
#define XB_XSUB(j)  (1280 + 64 * (j))
#define XB_XGEN(j)  (2304 + 64 * (j))
#define XB_TOP      3328
#define XB_TOPGEN   3392
#define XCD_BAR_WORDS 3456
#define XB_SPIN_CAP (1u << 22)
__device__ __forceinline__ unsigned xb_ld(unsigned* p)              { return __hip_atomic_load(p, __ATOMIC_RELAXED, __HIP_MEMORY_SCOPE_AGENT); }
__device__ __forceinline__ unsigned xb_add(unsigned* p, unsigned v) { return __hip_atomic_fetch_add(p, v, __ATOMIC_RELAXED, __HIP_MEMORY_SCOPE_AGENT); }
__device__ __forceinline__ unsigned xb_xcc_id() { return (unsigned)__builtin_amdgcn_s_getreg((3 << 11) | 20) & 0xFu; }
#define XB_SPIN(cond, bar) do { unsigned _sp = 0; while (cond) { __builtin_amdgcn_s_sleep(1); \
    if ((++_sp & 255u) == 0u) { if (xb_ld(&(bar)[XB_TMO])) break; if (_sp > XB_SPIN_CAP) { atomicAdd(&(bar)[XB_TMO], 1u); break; } } } } while (0)
struct XcdBarrier { unsigned* bar; unsigned x; volatile LAS unsigned* st; };
__device__ __forceinline__ XcdBarrier xcd_barrier_post(unsigned* bar, volatile LAS unsigned* st) {
    XcdBarrier b; b.bar = bar; b.x = xb_xcc_id(); b.st = st;
    if (threadIdx.x == 0) (void)xb_add(&bar[XB_XCNT(b.x)], 1u);
    return b;
}
__device__ __forceinline__ void xcd_barrier_complete(unsigned* bar, unsigned x, unsigned& nloc, unsigned& nx) {
    const unsigned G = gridDim.x * gridDim.y * gridDim.z;
    unsigned sum, cnt, mine, sp = 0u;
    for (;;) {
        sum = 0u; cnt = 0u; mine = 0u;
#pragma unroll
        for (unsigned j = 0; j < 16; ++j) { const unsigned c = xb_ld(&bar[XB_XCNT(j)]); sum += c; cnt += (c > 0u) ? 1u : 0u; mine = (j == x) ? c : mine; }
        if (sum == G) break;
        __builtin_amdgcn_s_sleep(1);
        if ((++sp & 255u) == 0u) { if (xb_ld(&bar[XB_TMO])) break; if (sp > XB_SPIN_CAP) { atomicAdd(&bar[XB_TMO], 1u); break; } }
    }
    nloc = mine > 0u ? mine : 1u; nx = cnt > 0u ? cnt : 1u;
}
__device__ __forceinline__ void xcd_barrier(const XcdBarrier& b) {
    asm volatile("s_waitcnt vmcnt(0)" ::: "memory");
    __syncthreads();
    if (threadIdx.x == 0) {
        unsigned* bar = b.bar;
        __builtin_amdgcn_s_waitcnt(0);
        unsigned nloc = b.st[0], nx = b.st[1];
        if (nloc == 0u) { xcd_barrier_complete(bar, b.x, nloc, nx); b.st[0] = nloc; b.st[1] = nx; }
        const unsigned old = xb_add(&bar[XB_XSUB(b.x)], 1u);
        const unsigned gen = old / nloc;
        if (old + 1u == (gen + 1u) * nloc) {
            __builtin_amdgcn_fence(__ATOMIC_RELEASE, "agent");
            asm volatile("s_waitcnt vmcnt(0)" ::: "memory");
            const unsigned og = xb_add(&bar[XB_TOP], 1u);
            const unsigned tg = og / nx;
            if (og + 1u == (tg + 1u) * nx) xb_add(&bar[XB_TOPGEN], 1u);
            else XB_SPIN(xb_ld(&bar[XB_TOPGEN]) == tg, bar);
            __builtin_amdgcn_fence(__ATOMIC_ACQUIRE, "agent");
            xb_add(&bar[XB_XGEN(b.x)], 1u);
            asm volatile("s_waitcnt vmcnt(0)" ::: "memory");
        } else {
            XB_SPIN(xb_ld(&bar[XB_XGEN(b.x)]) == gen, bar);
            __builtin_amdgcn_fence(__ATOMIC_ACQUIRE, "agent");
            asm volatile("s_waitcnt vmcnt(0)" ::: "memory");
        }
    }
    __syncthreads();
}

namespace pg8 {
constexpr int BM = 256, BK = 64, HALF = 128, HTB = HALF * BK * 2, STAGE_BYTES = 8 * HTB, NXCD = 8, WGM = 8;
__device__ __forceinline__ int lds_byte(int r, int c) { const int st = (r >> 4) * 2 + (c >> 5), rr = r & 15, cc = c & 31, ob = rr * 64 + cc * 2; return st * 1024 + (ob ^ (((ob >> 9) & 1) << 5)); }
__device__ __forceinline__ void stage_rc(int b, int& R, int& C) { const int st = b / 1024, sb = b % 1024, swz = sb ^ (((sb >> 9) & 1) << 5); R = (st >> 1) * 16 + swz / 64; C = (st & 1) * 32 + (swz % 64) / 2; }
__device__ __forceinline__ int perm32(int rho) { const int n = rho >> 4, i = rho & 15; return 8 * (i >> 2) + 4 * n + (i & 3); }

template <class E, class = void> struct epi_after_drain { static constexpr bool value = false; };
template <class E> struct epi_after_drain<E, decltype((void)E::AFTER_DRAIN)> { static constexpr bool value = E::AFTER_DRAIN; };
struct Unit { int pm, pn, sub; unsigned aoff, boff; };
struct Gemm { const bf16_t* A; const bf16_t* Bt; int lda, ldb, K; unsigned kstepA = 128; };
struct Sched {
    int nM, nN, nwg, G, c, nsub, mode = 0; unsigned a_row, a_sub, b_row, b_sub;
    __device__ __forceinline__ void init(int nM_, int nN_, int G_, int c_, int nsub_, unsigned a_row_, unsigned a_sub_, unsigned b_row_, unsigned b_sub_) {
        nM = nM_; nN = nN_; nwg = nM * nN; G = G_; c = c_; nsub = nsub_; a_row = a_row_; a_sub = a_sub_; b_row = b_row_; b_sub = b_sub_; }
    __device__ __forceinline__ bool next(int i, Unit& u) const {
        const int round = i / nsub; u.sub = i - round * nsub;
        const long L = (long)round * G + c; if (L >= nwg) return false;
        int wgid = (int)L; { const int q = nwg / NXCD, r = nwg % NXCD, xcd = wgid % NXCD, off = wgid / NXCD; wgid = (xcd < r ? xcd * (q + 1) : r * (q + 1) + (xcd - r) * q) + off; }
        const int nig = WGM * nN, gid = wgid / nig, fm = gid * WGM, gsz = (nM - fm) < WGM ? (nM - fm) : WGM;
        u.pm = fm + ((wgid % nig) % gsz); u.pn = (wgid % nig) / gsz;
        u.aoff = (unsigned)u.pm * a_row + (unsigned)u.sub * a_sub; u.boff = (unsigned)u.pn * b_row + (unsigned)u.sub * b_sub;
        if (mode == 1) { const int kv = u.pm >> 3, g = (u.pm >> 2) & 1, cp = u.pm & 3;
            u.aoff = (unsigned)(((size_t)cp * 256 * 16 * PLD + (kv ? PC_VC : PC_KC) + g * 64) * 2); u.boff = (unsigned)kv * (256u * 2048u * 2u); }
        if (mode == 2) { const int kv = u.pm >> 3; u.boff = (unsigned)kv * (256u * 256u * 2u); }
        return true;
    }
};

template <class Epi>
__device__ __forceinline__ void gemm_phase(LAS unsigned char* lds, const int tid, const Gemm g, const Sched& S, const Epi& E) {
    const int wid = __builtin_amdgcn_readfirstlane(tid >> 6), lane = tid & 63, wr = wid >> 2, wc = wid & 3, fr = lane & 15, fq = lane >> 4;
    const int K = g.K, nt = K / BK;
    unsigned voffA[2], voffB[2];
#pragma unroll
    for (int i = 0; i < 2; ++i) { int R, C; stage_rc(tid * 16 + i * 8192, R, C); const int Rb = Epi::PERM ? ((R & ~31) + perm32(R & 31)) : R;
        voffA[i] = (unsigned)(R * g.lda + C) * 2u; voffB[i] = (unsigned)(Rb * g.ldb + C) * 2u; }
    const size_t kstep = (size_t)(BK * 2), kstA = g.kstepA;
    const size_t hstepA = (size_t)HALF * g.lda * 2, hstepB = (size_t)HALF * g.ldb * 2;
    const unsigned ldsw = (unsigned)wid * 1024u;
    const int aoff = lds_byte(wr * 64 + fr, fq * 8), boff = lds_byte(wc * 32 + fr, fq * 8);
#define PG8_SA(b, h) (((b) * 2 + (h)) * HTB)
#define PG8_SB(b, h) ((4 + (b) * 2 + (h)) * HTB)
#define PG8_STAGE(bufoff, gbase, voff) do { _Pragma("unroll") for (int _i = 0; _i < 2; ++_i) \
        __builtin_amdgcn_global_load_lds((const unsigned*)((const char*)(gbase) + (voff)[_i]), (LAS unsigned*)(lds + (bufoff) + ldsw + _i * 8192), 16, 0, 0); } while (0)
#define PG8_LDA(dst, b, h) do { _Pragma("unroll") for (int m = 0; m < 4; ++m) _Pragma("unroll") for (int k = 0; k < 2; ++k) dst[m][k] = *(const LAS bf16x8*)(lds + PG8_SA(b, h) + aoff + m * 2048 + k * 1024); } while (0)
#define PG8_LDB(dst, b, h) do { _Pragma("unroll") for (int n = 0; n < 2; ++n) _Pragma("unroll") for (int k = 0; k < 2; ++k) dst[n][k] = *(const LAS bf16x8*)(lds + PG8_SB(b, h) + boff + n * 2048 + k * 1024); } while (0)
#define PG8_MMA(ai, bj, At, Bt) do { __builtin_amdgcn_s_setprio(1); _Pragma("unroll") for (int m = 0; m < 4; ++m) _Pragma("unroll") for (int n = 0; n < 2; ++n) _Pragma("unroll") for (int k = 0; k < 2; ++k) \
        acc[ai][bj][m][n] = __builtin_amdgcn_mfma_f32_16x16x32_bf16(Bt[n][k], At[m][k], acc[ai][bj][m][n], 0, 0, 0); __builtin_amdgcn_s_setprio(0); } while (0)
#define PG8_WAIT_V(n) asm volatile("s_waitcnt vmcnt(" #n ")" ::: "memory")
#define PG8_WAIT_L(n) asm volatile("s_waitcnt lgkmcnt(" #n ")" ::: "memory")
#define PG8_BAR __builtin_amdgcn_s_barrier()
#define PG8_SCHED __builtin_amdgcn_sched_barrier(0)
    Unit cur, nxt; int ui = 0;
    if (!S.next(0, cur)) return;
    f32x4 acc[2][2][4][2];
#pragma unroll
    for (int a = 0; a < 2; ++a)
#pragma unroll
        for (int b = 0; b < 2; ++b)
#pragma unroll
            for (int m = 0; m < 4; ++m)
#pragma unroll
                for (int n = 0; n < 2; ++n) acc[a][b][m][n] = (f32x4){0.f, 0.f, 0.f, 0.f};
    bf16x8 At[4][2], B0[2][2], B1[2][2];
    const char* cA = (const char*)g.A + cur.aoff; const char* cB = (const char*)g.Bt + cur.boff;
    PG8_STAGE(PG8_SB(0, 0), cB, voffB); PG8_STAGE(PG8_SA(0, 0), cA, voffA); PG8_STAGE(PG8_SB(0, 1), cB + hstepB, voffB); PG8_STAGE(PG8_SA(0, 1), cA + hstepA, voffA);
    if (wr == 1) PG8_BAR;
    PG8_WAIT_V(4); PG8_BAR;
    PG8_STAGE(PG8_SB(1, 0), cB + kstep, voffB); PG8_STAGE(PG8_SA(1, 0), cA + kstA, voffA); PG8_STAGE(PG8_SB(1, 1), cB + hstepB + kstep, voffB);
    PG8_WAIT_V(6); PG8_BAR;
    for (;;) {
        const bool has_next = S.next(ui + 1, nxt);
        const char* nA = has_next ? (const char*)g.A + nxt.aoff : cA; const char* nB = has_next ? (const char*)g.Bt + nxt.boff : cB;
        for (int t = 0; t < nt; t += 2) {
            const bool last = (t == nt - 2);
            const char* a1 = cA + (size_t)(t + 1) * kstA;
            const char* a2 = last ? nA : cA + (size_t)(t + 2) * kstA; const char* b2 = last ? nB : cB + (size_t)(t + 2) * kstep;
            const char* a3 = a2 + kstA; const char* b3 = b2 + kstep;
            PG8_LDB(B0, 0, 0); PG8_SCHED; PG8_LDA(At, 0, 0); PG8_STAGE(PG8_SA(1, 1), a1 + hstepA, voffA);
            PG8_WAIT_L(8); PG8_BAR; PG8_WAIT_L(0); PG8_MMA(0, 0, At, B0); PG8_BAR; PG8_SCHED;
            PG8_LDB(B1, 0, 1); PG8_STAGE(PG8_SB(0, 0), b2, voffB);
            PG8_BAR; PG8_WAIT_L(0); PG8_MMA(0, 1, At, B1); PG8_BAR;
            PG8_LDA(At, 0, 1); PG8_STAGE(PG8_SA(0, 0), a2, voffA);
            PG8_BAR; PG8_WAIT_L(0); PG8_MMA(1, 0, At, B0); PG8_BAR; PG8_SCHED;
            PG8_STAGE(PG8_SB(0, 1), b2 + hstepB, voffB);
            PG8_WAIT_V(6); PG8_BAR; PG8_MMA(1, 1, At, B1); PG8_BAR;
            PG8_LDB(B0, 1, 0); PG8_SCHED; PG8_LDA(At, 1, 0); PG8_STAGE(PG8_SA(0, 1), a2 + hstepA, voffA);
            PG8_WAIT_L(8); PG8_BAR; PG8_WAIT_L(0); PG8_MMA(0, 0, At, B0); PG8_BAR; PG8_SCHED;
            PG8_LDB(B1, 1, 1); PG8_STAGE(PG8_SB(1, 0), b3, voffB);
            PG8_BAR; PG8_WAIT_L(0); PG8_MMA(0, 1, At, B1); PG8_BAR;
            PG8_LDA(At, 1, 1); PG8_STAGE(PG8_SA(1, 0), a3, voffA);
            PG8_BAR; PG8_WAIT_L(0); PG8_MMA(1, 0, At, B0); PG8_BAR; PG8_SCHED;
            PG8_STAGE(PG8_SB(1, 1), b3 + hstepB, voffB);
            PG8_WAIT_V(6); PG8_BAR; PG8_MMA(1, 1, At, B1); PG8_BAR;
        }
        bool keep = false;
        if constexpr (!epi_after_drain<Epi>::value) keep = E(acc, cur, wr, wc, fr, fq);
        if (!has_next) break;
        if (!keep) {
#pragma unroll
            for (int a = 0; a < 2; ++a)
#pragma unroll
                for (int b = 0; b < 2; ++b)
#pragma unroll
                    for (int m = 0; m < 4; ++m)
#pragma unroll
                        for (int n = 0; n < 2; ++n) acc[a][b][m][n] = (f32x4){0.f, 0.f, 0.f, 0.f};
        }
        cur = nxt; cA = nA; cB = nB; ++ui;
    }
    PG8_WAIT_V(0);
    if (wr == 0) PG8_BAR;
    PG8_BAR;
    if constexpr (epi_after_drain<Epi>::value) (void)E(acc, cur, wr, wc, fr, fq);
#undef PG8_SA
#undef PG8_SB
#undef PG8_STAGE
#undef PG8_LDA
#undef PG8_LDB
#undef PG8_MMA
#undef PG8_WAIT_V
#undef PG8_WAIT_L
#undef PG8_BAR
#undef PG8_SCHED
}

struct EpiInProj {
    static constexpr bool PERM = true;
    bf16_t* proj; bf16_t* gates; unsigned char* ws; int row_base;
    __device__ __forceinline__ bool operator()(f32x4 (&acc)[2][2][4][2], const Unit& u, int wr, int wc, int fr, int fq) const {
        const int row0 = u.pm * BM + wr * 64 + fr; const bool is_gate = u.pn >= 16;
        bf16_t* base = is_gate ? gates + (u.pn - 16) * 256 : proj + u.pn * 256; const int ld = is_gate ? 3072 : PLD;
        const int col0 = wc * 32 + 8 * fq;
        float sv[2][4];
        { f32x4 pq[2][4];
#pragma unroll
          for (int ai = 0; ai < 2; ++ai)
#pragma unroll
            for (int m = 0; m < 4; ++m) pq[ai][m] = *(const f32x4*)statp(ws, row_base + row0 + ai * HALF + m * 16, 0);
#pragma unroll
          for (int ai = 0; ai < 2; ++ai)
#pragma unroll
            for (int m = 0; m < 4; ++m) sv[ai][m] = rsqrtf(((pq[ai][m][0] + pq[ai][m][1]) + (pq[ai][m][2] + pq[ai][m][3])) * (1.0f / D) + NORM_EPS); }
#pragma unroll
        for (int ai = 0; ai < 2; ++ai)
#pragma unroll
            for (int m = 0; m < 4; ++m) { const int row = row0 + ai * HALF + m * 16;
                const float s = sv[ai][m]; bf16_t* rowp = base + (size_t)row * ld + col0;
#pragma unroll
                for (int bj = 0; bj < 2; ++bj) { f32x4 v0 = acc[ai][bj][m][0] * s, v1 = acc[ai][bj][m][1] * s;
                    if (is_gate) {
#pragma unroll
                        for (int j = 0; j < 4; ++j) { v0[j] = sigmoidf_(v0[j]); v1[j] = sigmoidf_(v1[j]); } }
                    u32x4 w; w.x = pk2(v0[0], v0[1]); w.y = pk2(v0[2], v0[3]); w.z = pk2(v1[0], v1[1]); w.w = pk2(v1[2], v1[3]);
                    if (u.pn != 12 || col0 + bj * HALF < 64) *(u32x4*)(rowp + bj * HALF) = w; } }
        return false;
    }
};
struct EpiStore {
    static constexpr bool PERM = true;
    bf16_t* out; int ld;
    __device__ __forceinline__ bool operator()(f32x4 (&acc)[2][2][4][2], const Unit& u, int wr, int wc, int fr, int fq) const {
        const int row0 = u.pm * BM + wr * 64 + fr; const int col0 = u.pn * BM + wc * 32 + 8 * fq;
#pragma unroll
        for (int ai = 0; ai < 2; ++ai)
#pragma unroll
            for (int m = 0; m < 4; ++m) { bf16_t* rowp = out + (size_t)(row0 + ai * HALF + m * 16) * ld + col0;
#pragma unroll
                for (int bj = 0; bj < 2; ++bj) { const f32x4 v0 = acc[ai][bj][m][0], v1 = acc[ai][bj][m][1];
                    u32x4 w; w.x = pk2(v0[0], v0[1]); w.y = pk2(v0[2], v0[3]); w.z = pk2(v1[0], v1[1]); w.w = pk2(v1[2], v1[3]);
                    *(u32x4*)(rowp + bj * HALF) = w; } }
        return false;
    }
};
struct EpiCmp1 {
    static constexpr bool PERM = true;
    bf16_t* hid; const float* bh;
    __device__ __forceinline__ bool operator()(f32x4 (&acc)[2][2][4][2], const Unit& u, int wr, int wc, int fr, int fq) const {
        const int kv = u.pm >> 3; const int row0 = (u.pm & 7) * BM + wr * 64 + fr; const int col0 = wc * 32 + 8 * fq;
#pragma unroll
        for (int ai = 0; ai < 2; ++ai)
#pragma unroll
            for (int m = 0; m < 4; ++m) { bf16_t* rowp = hid + ((size_t)kv * 2048 + row0 + ai * HALF + m * 16) * 256 + col0;
#pragma unroll
                for (int bj = 0; bj < 2; ++bj) { float o[8];
#pragma unroll
                    for (int j = 0; j < 8; ++j) { const float x = acc[ai][bj][m][j >> 2][j & 3] + bh[kv * 256 + col0 + bj * HALF + j];
                        o[j] = x * sigmoidf_(1.5957691216f * (x + 0.044715f * x * x * x)); }
                    u32x4 w; w.x = pk2(o[0], o[1]); w.y = pk2(o[2], o[3]); w.z = pk2(o[4], o[5]); w.w = pk2(o[6], o[7]);
                    *(u32x4*)(rowp + bj * HALF) = w; } }
        return false;
    }
};
struct EpiCmp2 {
    static constexpr bool PERM = true;
    bf16_t* kcb; bf16_t* vct;
    __device__ __forceinline__ bool operator()(f32x4 (&acc)[2][2][4][2], const Unit& u, int wr, int wc, int fr, int fq) const {
        const int kv = u.pm >> 3; const int row0 = (u.pm & 7) * BM + wr * 64 + fr; const int col0 = wc * 32 + 8 * fq;
        if (col0 >= 64) return false;
#pragma unroll
        for (int ai = 0; ai < 2; ++ai)
#pragma unroll
            for (int m = 0; m < 4; ++m) { const int row = row0 + ai * HALF + m * 16, g = row >> 10, cc = row & 1023; const bool zr = cc == 1023; const f32x4 zz = (f32x4){0.f, 0.f, 0.f, 0.f};
                const f32x4 v0 = zr ? zz : acc[ai][0][m][0], v1 = zr ? zz : acc[ai][0][m][1];
                if (kv == 0) { u32x4 w; w.x = pk2(v0[0], v0[1]); w.y = pk2(v0[2], v0[3]); w.z = pk2(v1[0], v1[1]); w.w = pk2(v1[2], v1[3]); *(u32x4*)(kcb + ((size_t)g * 1024 + cc) * 64 + col0) = w; }
                else {
#pragma unroll
                    for (int j = 0; j < 4; ++j) { vct[((size_t)g * 64 + col0 + j) * 1024 + cc] = (bf16_t)f2bf(v0[j]); vct[((size_t)g * 64 + col0 + 4 + j) * 1024 + cc] = (bf16_t)f2bf(v1[j]); } } }
        return false;
    }
};
struct EpiLora {
    static constexpr bool PERM = true;
    bf16_t* obuf;
    __device__ __forceinline__ bool operator()(f32x4 (&acc)[2][2][4][2], const Unit& u, int wr, int wc, int fr, int fq) const {
        const int sel = u.pn >> 1; bf16_t* out = obuf + (size_t)(sel == 2 ? 0 : sel + 1) * T * 512;
        const int row0 = u.pm * BM + wr * 64 + fr; const int col0 = (u.pn & 1) * BM + wc * 32 + 8 * fq;
#pragma unroll
        for (int ai = 0; ai < 2; ++ai)
#pragma unroll
            for (int m = 0; m < 4; ++m) { bf16_t* rowp = out + (size_t)(row0 + ai * HALF + m * 16) * 512 + col0;
#pragma unroll
                for (int bj = 0; bj < 2; ++bj) { const f32x4 v0 = acc[ai][bj][m][0], v1 = acc[ai][bj][m][1];
                    u32x4 w; w.x = pk2(v0[0], v0[1]); w.y = pk2(v0[2], v0[3]); w.z = pk2(v1[0], v1[1]); w.w = pk2(v1[2], v1[3]);
                    *(u32x4*)(rowp + bj * HALF) = w; } }
        return false;
    }
};
struct EpiMerge {
    static constexpr bool PERM = true;
    const bf16_t* gates; bf16_t* merged;
    __device__ __forceinline__ bool operator()(f32x4 (&acc)[2][2][4][2], const Unit& u, int wr, int wc, int fr, int fq) const {
        const int row0 = u.pm * BM + wr * 64 + fr; const int col0 = u.pn * BM + wc * 32 + 8 * fq; const int sub = u.sub;
#pragma unroll
        for (int ai = 0; ai < 2; ++ai) {
                u32x4 gc[4][2], gn[4][2];
#pragma unroll
                for (int m = 0; m < 4; ++m) { const int row = row0 + ai * HALF + m * 16; const bf16_t* gp = gates + (size_t)row * 3072 + sub * 1024 + col0;
#pragma unroll
                    for (int bj = 0; bj < 2; ++bj) { gc[m][bj] = *(const u32x4*)(gp + bj * HALF); gn[m][bj] = (sub < 2) ? *(const u32x4*)(gp + 1024 + bj * HALF) : gc[m][bj]; } }
#pragma unroll
                for (int m = 0; m < 4; ++m) { const int row = row0 + ai * HALF + m * 16;
#pragma unroll
                    for (int bj = 0; bj < 2; ++bj) {
                        float sc[8], sn[8]; unpack8(gc[m][bj], sc);
                        if (sub < 2) { unpack8(gn[m][bj], sn);
#pragma unroll
                            for (int j = 0; j < 8; ++j) sc[j] = sc[j] * __builtin_amdgcn_rcpf(fmaxf(sn[j], 1e-30f)); }
                        f32x4 v0 = acc[ai][bj][m][0], v1 = acc[ai][bj][m][1];
#pragma unroll
                        for (int j = 0; j < 4; ++j) { v0[j] *= sc[j]; v1[j] *= sc[4 + j]; }
                        acc[ai][bj][m][0] = v0; acc[ai][bj][m][1] = v1;
                        if (sub == 2) { u32x4 w; w.x = pk2(v0[0], v0[1]); w.y = pk2(v0[2], v0[3]); w.z = pk2(v1[0], v1[1]); w.w = pk2(v1[2], v1[3]);
                            *(u32x4*)(merged + (size_t)row * D + col0 + bj * HALF) = w; } } }
                __builtin_amdgcn_sched_barrier(0);
        }
        return sub != 2;
    }
};
struct EpiNorm {
    static constexpr bool PERM = true, AFTER_DRAIN = true;
    float* x; bf16_t* xb; const float* gain; unsigned char* ws; unsigned* cnt; int row_base, kind_next; unsigned target; LAS unsigned char* lds; int tid;
    __device__ __forceinline__ bool operator()(f32x4 (&acc)[2][2][4][2], const Unit& u, int wr, int wc, int fr, int fq) const {
        LAS float* P = (LAS float*)lds; LAS float* S = (LAS float*)(lds + 16384);
        const int lane = tid & 63, wid = __builtin_amdgcn_readfirstlane(tid >> 6);
        const int prow = row_base + u.pm * BM;
        const int col0 = u.pn * BM + wc * 32 + 8 * fq;
#pragma unroll
        for (int ai = 0; ai < 2; ++ai)
#pragma unroll
            for (int m = 0; m < 4; ++m) { float ps = 0.f;
#pragma unroll
                for (int bj = 0; bj < 2; ++bj) { const f32x4 v0 = acc[ai][bj][m][0], v1 = acc[ai][bj][m][1];
                    ps += (v0[0] * v0[0] + v0[1] * v0[1]) + (v0[2] * v0[2] + v0[3] * v0[3]) + (v1[0] * v1[0] + v1[1] * v1[1]) + (v1[2] * v1[2] + v1[3] * v1[3]); }
                P[(ai * HALF + wr * 64 + m * 16 + fr) * 16 + wc * 4 + fq] = ps; }
        asm volatile("s_waitcnt lgkmcnt(0)" ::: "memory"); __builtin_amdgcn_s_barrier(); asm volatile("" ::: "memory");
        if (tid < 256) { const f32x4 a0 = *(const LAS f32x4*)(P + tid * 16), a1 = *(const LAS f32x4*)(P + tid * 16 + 4), a2 = *(const LAS f32x4*)(P + tid * 16 + 8), a3 = *(const LAS f32x4*)(P + tid * 16 + 12);
            const float sm = (((a0[0] + a0[1]) + (a0[2] + a0[3])) + ((a1[0] + a1[1]) + (a1[2] + a1[3]))) + (((a2[0] + a2[1]) + (a2[2] + a2[3])) + ((a3[0] + a3[1]) + (a3[2] + a3[3])));
            __hip_atomic_store(statp(ws, prow + tid, 1 + (int)(target >> 4)) + u.pn, sm, __ATOMIC_RELAXED, __HIP_MEMORY_SCOPE_AGENT); }
        asm volatile("s_waitcnt vmcnt(0)" ::: "memory");
        unsigned* pcnt = cnt + 16 * (prow >> 8);
        if (tid < 256 && lane == 0) (void)__hip_atomic_fetch_add(pcnt, 1u, __ATOMIC_RELAXED, __HIP_MEMORY_SCOPE_AGENT);
        if (wid == 0) { unsigned spins = 0; while ((unsigned)__builtin_amdgcn_readfirstlane(__hip_atomic_load(pcnt, __ATOMIC_RELAXED, __HIP_MEMORY_SCOPE_AGENT)) < target) { __builtin_amdgcn_s_sleep(1); if (++spins > (1u << 20)) break; }
            __builtin_amdgcn_fence(__ATOMIC_ACQUIRE, "agent"); }
        asm volatile("s_waitcnt vmcnt(0) lgkmcnt(0)" ::: "memory"); __builtin_amdgcn_s_barrier(); asm volatile("" ::: "memory");
        if (tid < 256) { float* sp = statp(ws, prow + tid, 1 + (int)(target >> 4));
            const float t0 = __hip_atomic_load(sp, __ATOMIC_RELAXED, __HIP_MEMORY_SCOPE_AGENT), t1 = __hip_atomic_load(sp + 1, __ATOMIC_RELAXED, __HIP_MEMORY_SCOPE_AGENT),
                        t2 = __hip_atomic_load(sp + 2, __ATOMIC_RELAXED, __HIP_MEMORY_SCOPE_AGENT), t3 = __hip_atomic_load(sp + 3, __ATOMIC_RELAXED, __HIP_MEMORY_SCOPE_AGENT);
            S[tid] = rsqrtf(((t0 + t1) + (t2 + t3)) * (1.0f / D) + NORM_EPS); }
        asm volatile("s_waitcnt lgkmcnt(0)" ::: "memory"); __builtin_amdgcn_s_barrier(); asm volatile("" ::: "memory");
        f32x4 gv[2][2];
#pragma unroll
        for (int bj = 0; bj < 2; ++bj) { gv[bj][0] = *(const f32x4*)(gain + col0 + bj * HALF); gv[bj][1] = *(const f32x4*)(gain + col0 + bj * HALF + 4); }
#pragma unroll
        for (int ai = 0; ai < 2; ++ai)
#pragma unroll
            for (int mp = 0; mp < 2; ++mp) {
                f32x4 xv[2][2][2];
#pragma unroll
                for (int mi = 0; mi < 2; ++mi) { const int row = prow + ai * HALF + wr * 64 + (2 * mp + mi) * 16 + fr;
#pragma unroll
                    for (int bj = 0; bj < 2; ++bj) { const float* xp = x + (size_t)row * D + col0 + bj * HALF; xv[mi][bj][0] = *(const f32x4*)xp; xv[mi][bj][1] = *(const f32x4*)(xp + 4); } }
#pragma unroll
                for (int mi = 0; mi < 2; ++mi) { const int m = 2 * mp + mi; const int rl = ai * HALF + wr * 64 + m * 16 + fr; const int row = prow + rl; const float rstd = S[rl]; float qs = 0.f;
#pragma unroll
                    for (int bj = 0; bj < 2; ++bj) { const int col = col0 + bj * HALF; float* xp = x + (size_t)row * D + col; u32x4 w;
                        { f32x4 xa = xv[mi][bj][0]; xa += acc[ai][bj][m][0] * rstd * gv[bj][0]; *(f32x4*)xp = xa;
                          w.x = pk2(xa[0], xa[1]); w.y = pk2(xa[2], xa[3]); qs += (xa[0] * xa[0] + xa[1] * xa[1]) + (xa[2] * xa[2] + xa[3] * xa[3]); }
                        { f32x4 xc = xv[mi][bj][1]; xc += acc[ai][bj][m][1] * rstd * gv[bj][1]; *(f32x4*)(xp + 4) = xc;
                          w.z = pk2(xc[0], xc[1]); w.w = pk2(xc[2], xc[3]); qs += (xc[0] * xc[0] + xc[1] * xc[1]) + (xc[2] * xc[2] + xc[3] * xc[3]); }
                        *(u32x4*)(xb + (size_t)row * D + col) = w; }
                    P[rl * 16 + wc * 4 + fq] = qs; }
                __builtin_amdgcn_sched_barrier(0);
            }
        asm volatile("s_waitcnt lgkmcnt(0)" ::: "memory"); __builtin_amdgcn_s_barrier(); asm volatile("" ::: "memory");
        if (tid < 256) { const f32x4 a0 = *(const LAS f32x4*)(P + tid * 16), a1 = *(const LAS f32x4*)(P + tid * 16 + 4), a2 = *(const LAS f32x4*)(P + tid * 16 + 8), a3 = *(const LAS f32x4*)(P + tid * 16 + 12);
            const float sm = (((a0[0] + a0[1]) + (a0[2] + a0[3])) + ((a1[0] + a1[1]) + (a1[2] + a1[3]))) + (((a2[0] + a2[1]) + (a2[2] + a2[3])) + ((a3[0] + a3[1]) + (a3[2] + a3[3])));
            __hip_atomic_store(statp(ws, prow + tid, kind_next) + u.pn, sm, __ATOMIC_RELAXED, __HIP_MEMORY_SCOPE_AGENT); }
        return false;
    }
};
struct EpiSwiGLU {
    static constexpr bool PERM = true;
    bf16_t* act; unsigned char* ws;
    __device__ __forceinline__ bool operator()(f32x4 (&acc)[2][2][4][2], const Unit& u, int wr, int wc, int fr, int fq) const {
        const int row0 = u.pm * BM + wr * 64 + fr; const int col0 = u.pn * HALF + wc * 32 + 8 * fq;
        float sv[2][4];
        { f32x4 pq[2][4];
#pragma unroll
          for (int ai = 0; ai < 2; ++ai)
#pragma unroll
            for (int m = 0; m < 4; ++m) pq[ai][m] = *(const f32x4*)statp(ws, row0 + ai * HALF + m * 16, 1);
#pragma unroll
          for (int ai = 0; ai < 2; ++ai)
#pragma unroll
            for (int m = 0; m < 4; ++m) sv[ai][m] = rsqrtf(((pq[ai][m][0] + pq[ai][m][1]) + (pq[ai][m][2] + pq[ai][m][3])) * (1.0f / D) + NORM_EPS); }
#pragma unroll
        for (int ai = 0; ai < 2; ++ai)
#pragma unroll
            for (int m = 0; m < 4; ++m) { const int row = row0 + ai * HALF + m * 16;
                const float s = sv[ai][m];
                float o[8];
#pragma unroll
                for (int n = 0; n < 2; ++n)
#pragma unroll
                    for (int j = 0; j < 4; ++j) { const float gg = acc[ai][0][m][n][j] * s, uu = acc[ai][1][m][n][j] * s; o[n * 4 + j] = gg * sigmoidf_(gg) * uu; }
                u32x4 w; w.x = pk2(o[0], o[1]); w.y = pk2(o[2], o[3]); w.z = pk2(o[4], o[5]); w.w = pk2(o[6], o[7]);
                *(u32x4*)(act + (size_t)row * FFN + col0) = w; }
        return false;
    }
};
}

struct Args { const float* in[30]; float* out; unsigned char* ws; int lo, hi; };
enum { I_X = 0, I_NPM, I_NQM, I_NPF, I_NQF, I_WIN, I_MU, I_W0, I_W2, I_A0, I_A2, I_G2, I_KK, I_KA, I_RK, I_LNW, I_LNB, I_PEK, I_PEV, I_CKW1, I_CKW2, I_CVW1, I_CVW2, I_SINK, I_REL, I_WBR, I_WOUT, I_FG, I_FU, I_FD };

struct Ctx { LAS unsigned char* lds; int tid, lane, wave, G, bid; };
__device__ __forceinline__ const float* inptr(const Ctx& c, int i) {
    const volatile LAS unsigned* t = (const volatile LAS unsigned*)(c.lds + LDS_MISC + 64) + 2 * i;
    const unsigned lo = __builtin_amdgcn_readfirstlane(t[0]), hi = __builtin_amdgcn_readfirstlane(t[1]);
    return (const float*)(((unsigned long long)hi << 32) | lo);
}

__device__ __forceinline__ void phase_init(const Ctx& c, const float* x, float* xo, bf16_t* xb, unsigned char* wsb) {
    const int gw = c.bid * 8 + c.wave, NGW = c.G * 8;
    for (int row = gw; row < MROWS; row += NGW) {
        const float* xr = x + (size_t)row * D; float ss = 0.f;
#pragma unroll
        for (int j = 0; j < 2; ++j) { const int e = c.lane * 8 + 512 * j; const f32x4 a = *(const f32x4*)(xr + e), b = *(const f32x4*)(xr + e + 4);
            ss += a[0] * a[0] + a[1] * a[1] + a[2] * a[2] + a[3] * a[3] + b[0] * b[0] + b[1] * b[1] + b[2] * b[2] + b[3] * b[3];
            *(f32x4*)(xo + (size_t)row * D + e) = a; *(f32x4*)(xo + (size_t)row * D + e + 4) = b;
            u32x4 w; w.x = pk2(a[0], a[1]); w.y = pk2(a[2], a[3]); w.z = pk2(b[0], b[1]); w.w = pk2(b[2], b[3]); *(u32x4*)(xb + (size_t)row * D + e) = w; }
        ss = wave_sum(ss);
        if (c.lane < 4) __hip_atomic_store(statp(wsb, row, 0) + c.lane, c.lane == 0 ? ss : 0.f, __ATOMIC_RELAXED, __HIP_MEMORY_SCOPE_AGENT);
    }
}
struct CvtTile { const float* src; const float* gain; bf16_t* dst; int ld, nvalid, K, k0, n0; float extra; bool kvalid; };
__device__ __forceinline__ CvtTile cvt_describe(const Ctx& c, int layer, bf16_t* wb, int it) {
    constexpr int I0 = 16 * 112, I1 = 3 * 8 * 16, I2 = 16 * 16, I3 = 16 * 88, I4 = 44 * 16, I5 = 4 * 24, I6 = 2 * 32 * 4;
    int r = it, kind, sub = 0, K, nblk; bf16_t* dst;
    if (r < I0) { kind = 0; K = D; nblk = 112; dst = wb + WB_WIN; }
    else if ((r -= I0) < I1) { kind = 1; sub = r / 128; r -= sub * 128; K = 512; nblk = 16; dst = wb + WB_WBR + (size_t)sub * D * 512; }
    else if ((r -= I1) < I2) { kind = 2; K = D; nblk = 16; dst = wb + WB_WOUT; }
    else if ((r -= I2) < I3) { kind = 3; K = D; nblk = 88; dst = wb + WB_WGU; }
    else if ((r -= I3) < I4) { kind = 4; K = FFN; nblk = 16; dst = wb + WB_WDN; }
    else if ((r -= I4) < I5) { kind = 5; K = 256; nblk = 24; dst = wb + WB_LORA; }
    else if ((r -= I5) < I6) { kind = 6; sub = r / 128; r -= sub * 128; K = 2048; nblk = 4; dst = wb + WB_W1T + (size_t)sub * 256 * 2048; }
    else { r -= I6; kind = 7; sub = r / 16; r -= sub * 16; K = 256; nblk = 4; dst = wb + WB_W2T + (size_t)sub * 256 * 256; }
    const int kb = r / nblk, nb = r % nblk, k0 = kb * 64, n0 = nb * 64;
    CvtTile t; t.src = nullptr; t.gain = nullptr; t.dst = dst; t.ld = 0; t.nvalid = 64; t.K = K; t.k0 = k0; t.n0 = n0; t.extra = 1.f; t.kvalid = true;
    switch (kind) {
    case 0: { t.gain = inptr(c, I_NPM) + layer * D + k0; t.ld = IN_COLS;
        const int scol = n0 < 3096 ? n0 : n0 - 232; t.nvalid = (n0 < 3096) ? (3096 - n0 < 64 ? 3096 - n0 : 64) : (n0 < 3328 ? 0 : 64);
        if ((n0 >= PC_NQ && n0 < PC_NQ + 512) || (n0 >= PC_SQ && n0 < PC_SQ + 512)) t.extra = 0.125f;
        t.src = inptr(c, I_WIN) + ((size_t)layer * D + k0) * IN_COLS + scol; break; }
    case 1: t.src = inptr(c, I_WBR) + (((size_t)layer * 3 + sub) * 512 + k0) * D + n0; t.ld = D; break;
    case 2: t.src = inptr(c, I_WOUT) + ((size_t)layer * D + k0) * D + n0; t.ld = D; break;
    case 3: { t.gain = inptr(c, I_NPF) + layer * D + k0; t.ld = FFN; const int pn = n0 >> 8, rr = n0 & 255;
        t.src = inptr(c, rr < 128 ? I_FG : I_FU) + ((size_t)layer * D + k0) * FFN + pn * 128 + (rr & 127); break; }
    case 4: t.src = inptr(c, I_FD) + ((size_t)layer * FFN + k0) * D + n0; t.ld = D; break;
    case 5: { t.ld = 512;
        if (n0 < 512) { t.kvalid = k0 < 64; t.src = inptr(c, I_W2) + ((size_t)layer * 64 + k0) * 512 + n0; }
        else if (n0 < 1024) { t.kvalid = (k0 == 64); t.src = inptr(c, I_A2) + ((size_t)layer * 64 + (k0 - 64)) * 512 + n0 - 512; }
        else { t.kvalid = k0 >= 128; t.src = inptr(c, I_G2) + ((size_t)layer * 128 + (k0 - 128)) * 512 + n0 - 1024; }
        break; }
    case 6: t.src = inptr(c, sub ? I_CVW1 : I_CKW1) + ((size_t)layer * 2048 + k0) * 256 + n0; t.ld = 256; break;
    default: t.src = inptr(c, sub ? I_CVW2 : I_CKW2) + ((size_t)layer * 256 + k0) * 64 + n0; t.ld = 64; t.nvalid = n0 < 64 ? 64 : 0; break;
    }
    return t;
}
__device__ __forceinline__ void phase_cvt(const Ctx& c, const Args& a, int layer, bf16_t* wb) {
    LAS float* tile = (LAS float*)c.lds;
    constexpr int NIT = 16 * 112 + 3 * 8 * 16 + 16 * 16 + 16 * 88 + 44 * 16 + 4 * 24 + 2 * 32 * 4 + 2 * 4 * 4;
    for (int it = c.bid; it < NIT; it += 2 * c.G) {
        const int it2 = it + c.G; const bool two = it2 < NIT;
        const CvtTile t0 = cvt_describe(c, layer, wb, it), t1 = cvt_describe(c, layer, wb, two ? it2 : it);
        float v0[8], v1[8];
#pragma unroll
        for (int i = 0; i < 8; ++i) { const int e = c.tid + 512 * i, kk = e >> 6, nn = e & 63;
            v0[i] = (t0.kvalid && nn < t0.nvalid) ? t0.src[(size_t)kk * t0.ld + nn] : 0.f;
            v1[i] = (two && t1.kvalid && nn < t1.nvalid) ? t1.src[(size_t)kk * t1.ld + nn] : 0.f; }
#pragma unroll
        for (int i = 0; i < 8; ++i) { const int e = c.tid + 512 * i, kk = e >> 6, nn = e & 63;
            tile[kk * 65 + nn] = v0[i] * t0.extra * (t0.gain ? t0.gain[kk] : 1.f); tile[4160 + kk * 65 + nn] = v1[i] * t1.extra * (t1.gain ? t1.gain[kk] : 1.f); }
        __syncthreads();
        { const int nn = c.tid >> 3, kc = (c.tid & 7) * 8; u32x4 w;
          w.x = pk2(tile[(kc + 0) * 65 + nn], tile[(kc + 1) * 65 + nn]); w.y = pk2(tile[(kc + 2) * 65 + nn], tile[(kc + 3) * 65 + nn]);
          w.z = pk2(tile[(kc + 4) * 65 + nn], tile[(kc + 5) * 65 + nn]); w.w = pk2(tile[(kc + 6) * 65 + nn], tile[(kc + 7) * 65 + nn]);
          *(u32x4*)(t0.dst + (size_t)(t0.n0 + nn) * t0.K + t0.k0 + kc) = w;
          if (two) { const LAS float* tl = tile + 4160;
            w.x = pk2(tl[(kc + 0) * 65 + nn], tl[(kc + 1) * 65 + nn]); w.y = pk2(tl[(kc + 2) * 65 + nn], tl[(kc + 3) * 65 + nn]);
            w.z = pk2(tl[(kc + 4) * 65 + nn], tl[(kc + 5) * 65 + nn]); w.w = pk2(tl[(kc + 6) * 65 + nn], tl[(kc + 7) * 65 + nn]);
            *(u32x4*)(t1.dst + (size_t)(t1.n0 + nn) * t1.K + t1.k0 + kc) = w; } }
        __syncthreads();
    }
    if (c.bid == c.G - 1) {
        const int kv = c.tid >> 8, u = c.tid & 255; const float* w1 = inptr(c, kv ? I_CVW1 : I_CKW1) + (size_t)layer * 2048 * 256; const float* pe = inptr(c, kv ? I_PEV : I_PEK) + (size_t)layer * 2048;
        float acc = 0.f; for (int k = 0; k < 2048; ++k) acc += pe[k] * w1[(size_t)k * 256 + u];
        ((float*)(wb + WB_BH))[c.tid] = acc;
    }
}

constexpr int RL = 65;
__device__ __forceinline__ float rwkv_mixed(const bf16_t* proj, const float* mu, int t, int col) {
    const float cur = bf2f(proj[(size_t)t * PLD + col]); const float prev = t > 0 ? bf2f(proj[(size_t)(t - 1) * PLD + col]) : 0.f;
    return cur + (prev - cur) * mu[col];
}
__device__ __forceinline__ int kperm32(int jl) { return 8 * ((jl >> 2) & 3) + 4 * (jl >> 4) + (jl & 3); }
__device__ __forceinline__ f32x4 tile_mma64(const LAS unsigned char* A, const LAS unsigned char* B, int a, int b, int lane, f32x4 acc) {
    const int m = lane & 15, q = lane >> 4;
#pragma unroll
    for (int ks = 0; ks < 2; ++ks) {
        const bf16x8 af = *(const LAS bf16x8*)(A + (16 * a + m) * 144 + (32 * ks + 8 * q) * 2);
        const bf16x8 bf = *(const LAS bf16x8*)(B + (16 * b + m) * 144 + (32 * ks + 8 * q) * 2);
        acc = __builtin_amdgcn_mfma_f32_16x16x32_bf16(af, bf, acc, 0, 0, 0);
    }
    return acc;
}
__device__ __forceinline__ void lds_st_bf16(LAS unsigned char* base, int idx, float v) { *(LAS bf16_t*)(base + idx * 2) = (bf16_t)f2bf(v); }

__device__ __forceinline__ void phase_lora_a(const Ctx& c, const Args& a, int layer, const bf16_t* proj, bf16_t* alora) {
    const float* mu = inptr(c, I_MU) + (size_t)layer * 1792;
    const int sub = c.tid & 31, rloc = c.tid >> 5;
    for (int t = c.bid * 16 + rloc; t < T; t += c.G * 16) {
        const int col = PC_ZW + sub * 8; float cur[8], prv[8];
        unpack8(*(const u32x4*)(proj + (size_t)t * PLD + col), cur);
        if (t > 0) unpack8(*(const u32x4*)(proj + (size_t)(t - 1) * PLD + col), prv); else {
#pragma unroll
            for (int k = 0; k < 8; ++k) prv[k] = 0.f; }
        float o[8];
#pragma unroll
        for (int k = 0; k < 8; ++k) { const float v = cur[k] + (prv[k] - cur[k]) * mu[col + k]; o[k] = sub < 8 ? tanhf(v) : (sub < 16 ? v : sigmoidf_(v)); }
        u32x4 w; w.x = pk2(o[0], o[1]); w.y = pk2(o[2], o[3]); w.z = pk2(o[4], o[5]); w.w = pk2(o[6], o[7]);
        *(u32x4*)(alora + (size_t)t * 256 + sub * 8) = w;
    }
}

constexpr int RC_L = 0, RC_AL = 16640, RC_AAK = 0, RC_ARB = 9216, RC_ARK = 18432, RC_AAB = 33280, RC_P2T = 33280, RC_WC = 50688, RC_BS = 50944, RC_M = 52992;
constexpr int RC_AT = RC_M, RC_TINV = RC_M, RC_ATT = RC_M + 9216, RC_RT = RC_M + 2 * 9216, RC_BT = RC_M + 3 * 9216, RC_XT = RC_BT, RC_KT = RC_M + 4 * 9216, RC_P1T = RC_KT,
              RC_VT = RC_M + 5 * 9216, RC_BHT = RC_M + 6 * 9216, RC_KHT = RC_M + 7 * 9216;
constexpr int RC_XOFF = RC_M + 8 * 9216, RC_XTMP = RC_XOFF + 6144;
static_assert(RC_XTMP + 3 * 1088 <= LDS_MISC, "rwkv chunk LDS");

__device__ __forceinline__ void phase_rwkv_chunk(const Ctx& c, const Args& a, int layer, const bf16_t* proj, const bf16_t* wlb, const bf16_t* alb, bf16_t* rwu, float* bonusg) {
    LAS unsigned char* L = c.lds;
    LAS float* sL = (LAS float*)(L + RC_L); LAS float* sAL = (LAS float*)(L + RC_AL); LAS float* sAAB = (LAS float*)(L + RC_AAB);
    LAS float* sWC = (LAS float*)(L + RC_WC); LAS float* sBS = (LAS float*)(L + RC_BS);
    const float* mu = inptr(c, I_MU) + (size_t)layer * 1792;
    const int lane = c.lane, wave = c.wave, n = lane & 15, q = lane >> 4;
    for (int unit = c.bid; unit < 2048; unit += c.G) {
        const int ch = unit >> 3, h = unit & 7, t0 = ch * 64, j = lane;
        {
            const float w0 = inptr(c, I_W0)[layer * 512 + h * 64 + j], a0 = inptr(c, I_A0)[layer * 512 + h * 64 + j];
            bf16_t wraw[8], araw[8];
#pragma unroll
            for (int i = 0; i < 8; ++i) { const size_t gi = (size_t)(t0 + wave * 8 + i) * 512 + h * 64 + j; wraw[i] = wlb[gi]; araw[i] = alb[gi]; }
            float run = 0.f;
#pragma unroll
            for (int i = 0; i < 8; ++i) { const int tt = wave * 8 + i;
                const float wl = w0 + bf2f(wraw[i]); const float nx = -wl; const float sp = nx > 20.f ? nx : __logf(1.0f + __expf(nx)); const float ld = -__expf(-sp - 0.5f);
                run += ld; sL[tt * RL + j] = run; sAL[tt * RL + j] = sigmoidf_(a0 + bf2f(araw[i])); }
            sBS[wave * 64 + j] = run;
        }
        bf16_t rraw[9], kraw[9], vraw[9];
        {
#pragma unroll
            for (int i = 0; i < 9; ++i) { const int t = t0 + wave * 8 + i - 1; const bool ok = t >= 0; const size_t ro = (size_t)(ok ? t : 0) * PLD + h * 64 + j;
                rraw[i] = ok ? proj[ro + PC_R] : (bf16_t)0; kraw[i] = ok ? proj[ro + PC_K] : (bf16_t)0; vraw[i] = ok ? proj[ro + PC_V] : (bf16_t)0; }
        }
        __syncthreads();
        {
            float off = 0.f, tot = 0.f;
#pragma unroll
            for (int w2 = 0; w2 < 8; ++w2) { const float v = sBS[w2 * 64 + j]; tot += v; off += (w2 < wave) ? v : 0.f; }
            if (wave == 0) sWC[j] = __expf(tot);
            const float kkw = inptr(c, I_KK)[layer * 512 + h * 64 + j], kaw = inptr(c, I_KA)[layer * 512 + h * 64 + j], rk = inptr(c, I_RK)[layer * 512 + h * 64 + j];
            const float mur = mu[PC_R + h * 64 + j], muk = mu[PC_K + h * 64 + j], muv = mu[PC_V + h * 64 + j];
            float Lprev = off; float eWprev = __expf(off); const float eTot = __expf(tot);
#pragma unroll
            for (int i = 0; i < 8; ++i) { const int tt = wave * 8 + i, t = t0 + tt;
                const float Lc = sL[tt * RL + j] + off, al = sAL[tt * RL + j];
                const float rc = bf2f(rraw[i + 1]), kc = bf2f(kraw[i + 1]), vc = bf2f(vraw[i + 1]);
                const float r = rc + (bf2f(rraw[i]) - rc) * mur, k = kc + (bf2f(kraw[i]) - kc) * muk, v = vc + (bf2f(vraw[i]) - vc) * muv;
                float kk = k * kkw; const float n2 = wave_sum(kk * kk); kk = kk / fmaxf(sqrtf(n2), 1e-12f);
                const float kp = k * (1.0f + (al - 1.0f) * kaw), av = -kk, bv = kk * al;
                const float eW = __expf(Lc), eInv = __builtin_amdgcn_rcpf(eW), eC = eTot * eInv; const float eWex = eWprev; eWprev = eW;
                lds_st_bf16(L + RC_AT, tt * 72 + j, av * eWex); lds_st_bf16(L + RC_ATT, j * 72 + tt, av * eWex);
                lds_st_bf16(L + RC_RT, tt * 72 + j, r * eW); lds_st_bf16(L + RC_BT, tt * 72 + j, bv * eInv); lds_st_bf16(L + RC_KT, tt * 72 + j, kp * eInv);
                lds_st_bf16(L + RC_VT, j * 72 + tt, v); lds_st_bf16(L + RC_BHT, j * 72 + tt, bv * eC); lds_st_bf16(L + RC_KHT, j * 72 + tt, kp * eC);
                const float bon = wave_sum(r * kp * rk); if (lane == 0) bonusg[(size_t)t * 8 + h] = bon;
                Lprev = Lc; }
        }
        __syncthreads();
        for (int job = wave; job < 64; job += 8) {
            const int p = job >> 4, ta = (job >> 2) & 3, tb = job & 3;
            f32x4 acc = (f32x4){0.f, 0.f, 0.f, 0.f};
            if (ta >= tb) acc = tile_mma64(L + (p < 2 ? RC_AT : RC_RT), L + ((p & 1) ? RC_KT : RC_BT), ta, tb, lane, acc);
            LAS unsigned char* dst = L + (p == 1 ? RC_AAK : (p == 2 ? RC_ARB : RC_ARK));
#pragma unroll
            for (int r = 0; r < 4; ++r) { const int tt = 16 * ta + 4 * q + r, ss = 16 * tb + n; const bool keep = (p < 2) ? (ss < tt) : (ss <= tt); const float v = keep ? acc[r] : 0.f;
                if (p == 0) sAAB[tt * 68 + ss] = v; else lds_st_bf16(dst, tt * 72 + ss, v); }
        }
        __syncthreads();
        if (wave == 0) {
            const int blk = lane >> 4, cc = lane & 15; const LAS float* Ab = sAAB + (16 * blk) * 68 + 16 * blk; float xr[16];
#pragma unroll
            for (int tt = 0; tt < 16; ++tt) { float acc = (tt == cc) ? 1.f : 0.f;
#pragma unroll
                for (int ss = 0; ss < tt; ++ss) acc += Ab[tt * 68 + ss] * xr[ss];
                xr[tt] = acc; }
            asm volatile("s_waitcnt lgkmcnt(0)" ::: "memory");
#pragma unroll
            for (int tt = 0; tt < 16; ++tt) sAAB[(16 * blk + tt) * 68 + 16 * blk + cc] = xr[tt];
        } else {
            for (int job = wave - 1; job < 16; job += 7) { const int ta = job >> 2, tb = job & 3;
                const f32x4 acc = tile_mma64(L + RC_VT, L + RC_AAK, ta, tb, lane, (f32x4){0.f, 0.f, 0.f, 0.f});
#pragma unroll
                for (int r = 0; r < 4; ++r) lds_st_bf16(L + RC_XT, (16 * ta + 4 * q + r) * 72 + 16 * tb + n, acc[r]); }
        }
        __syncthreads();
        {
            LAS float* sXO = (LAS float*)(L + RC_XOFF); LAS float* sT = (LAS float*)(L + RC_XTMP) + wave * 272;
            const int rr = lane >> 2, c4 = (lane & 3) * 4;
#pragma unroll 1
            for (int lev = 1; lev <= 3; ++lev) {
                if (wave < 4 - lev) {
                    const int J = wave, I = wave + lev;
                    f32x4 tacc = (f32x4){0.f, 0.f, 0.f, 0.f};
                    for (int K = J; K < I; ++K) {
                        const LAS float* Ap = sAAB + (16 * I + rr) * 68 + 16 * K; const LAS float* Xp;
                        int xs;
                        if (K == J) { Xp = sAAB + (16 * J) * 68 + 16 * J + c4; xs = 68; }
                        else { const int d = K - J; const int bi = (d == 1) ? J : 3 + J; Xp = sXO + bi * 256 + c4; xs = 16; }
#pragma unroll
                        for (int k = 0; k < 16; ++k) { const float av = Ap[k]; const f32x4 xv = *(const LAS f32x4*)(Xp + k * xs); tacc += xv * av; }
                    }
                    *(LAS f32x4*)(sT + rr * 16 + c4) = tacc;
                    asm volatile("s_waitcnt lgkmcnt(0)" ::: "memory");
                    f32x4 xacc = (f32x4){0.f, 0.f, 0.f, 0.f};
                    const LAS float* Dp = sAAB + (16 * I + rr) * 68 + 16 * I;
#pragma unroll
                    for (int k = 0; k < 16; ++k) { const float dv = Dp[k]; const f32x4 tv = *(const LAS f32x4*)(sT + k * 16 + c4); xacc += tv * dv; }
                    const int bo = (lev == 1) ? J : (lev == 2 ? 3 + J : 5);
                    *(LAS f32x4*)(sXO + bo * 256 + rr * 16 + c4) = xacc;
                }
                __syncthreads();
            }
            for (int e = c.tid; e < 4096; e += 512) { const int tt = e >> 6, ss = e & 63, I = tt >> 4, J = ss >> 4; float v = 0.f;
                if (I == J) v = sAAB[tt * 68 + ss];
                else if (I > J) { const int d = I - J; const int bi = (d == 1) ? J : (d == 2 ? 3 + J : 5); v = sXO[bi * 256 + (tt & 15) * 16 + (ss & 15)]; }
                lds_st_bf16(L + RC_TINV, tt * 72 + ss, v); }
        }
        __syncthreads();
        for (int job = wave; job < 32; job += 8) { const int p = job >> 4, ta = (job >> 2) & 3, tb = job & 3;
            const f32x4 acc = tile_mma64(L + (p ? RC_XT : RC_ATT), L + RC_TINV, ta, tb, lane, (f32x4){0.f, 0.f, 0.f, 0.f});
#pragma unroll
            for (int r = 0; r < 4; ++r) lds_st_bf16(L + (p ? RC_P2T : RC_P1T), (16 * ta + 4 * q + r) * 72 + 16 * tb + n, acc[r]); }
        __syncthreads();
        bf16_t* ug = rwu + (size_t)unit * 16384;
        for (int job = wave; job < 64; job += 8) { const int p = job >> 4, ta = (job >> 2) & 3, tb = job & 3;
            f32x4 acc = (f32x4){0.f, 0.f, 0.f, 0.f};
            if (p == 0) { acc = tile_mma64(L + RC_ARB, L + RC_P1T, ta, tb, lane, acc);
#pragma unroll
                for (int r = 0; r < 4; ++r) { const int tt = 16 * ta + 4 * q + r, jj = 16 * tb + n; const float v = acc[r] + bf2f(*(const LAS bf16_t*)(L + RC_RT + (tt * 72 + jj) * 2));
                    ug[8192 + tt * 64 + (jj & 32) + kperm32(jj & 31)] = (bf16_t)f2bf(v); } }
            else if (p == 1) { acc = tile_mma64(L + RC_ARB, L + RC_P2T, ta, tb, lane, acc); acc = tile_mma64(L + RC_ARK, L + RC_VT, ta, tb, lane, acc);
                u32x2 w; w.x = pk2(acc[0], acc[1]); w.y = pk2(acc[2], acc[3]); *(u32x2*)(ug + 12288 + ((tb * 4 + ta) * 64 + lane) * 4) = w; }
            else if (p == 2) { acc = tile_mma64(L + RC_BHT, L + RC_P1T, ta, tb, lane, acc);
#pragma unroll
                for (int r = 0; r < 4; ++r) { const int jr = 16 * ta + 4 * q + r, jc = 16 * tb + n; const float v = acc[r] + (jr == jc ? sWC[jr] : 0.f);
                    ug[jr * 64 + (jc & 32) + kperm32(jc & 31)] = (bf16_t)f2bf(v); } }
            else { acc = tile_mma64(L + RC_BHT, L + RC_P2T, ta, tb, lane, acc); acc = tile_mma64(L + RC_KHT, L + RC_VT, ta, tb, lane, acc);
                u32x2 w; w.x = pk2(acc[0], acc[1]); w.y = pk2(acc[2], acc[3]); *(u32x2*)(ug + 4096 + ((tb * 4 + ta) * 64 + lane) * 4) = w; }
        }
        __syncthreads();
    }
}

#define RW_LOAD_SET(SET, UNIT) do { const bf16_t* ug_ = rwu + (size_t)(UNIT) * 16384; \
    _Pragma("unroll") for (int ta = 0; ta < 4; ++ta) { An[SET][ta][0] = *(const bf16x8*)(ug_ + (16 * ta + m) * 64 + 8 * q); An[SET][ta][1] = *(const bf16x8*)(ug_ + (16 * ta + m) * 64 + 32 + 8 * q); \
        Zn[SET][ta] = *(const u32x2*)(ug_ + 4096 + ((cq * 4 + ta) * 64 + lane) * 4); } } while (0)
constexpr int RW_SETS = 4;
template <int SM>
__device__ __forceinline__ void phase_rwkv_scan(const Ctx& c, const bf16_t* rwu, bf16_t* rws) {
    const int idx = c.bid; if (idx >= 32 || c.wave != 0) return;
    const int h = idx >> 2, cq = idx & 3, lane = c.lane, m = lane & 15, q = lane >> 4;
    bf16x8 Bhi[2];
#pragma unroll
    for (int s = 0; s < 2; ++s) Bhi[s] = (bf16x8){0, 0, 0, 0, 0, 0, 0, 0};
    bf16x8 An[RW_SETS][4][2]; u32x2 Zn[RW_SETS][4];
#pragma unroll
    for (int u = 0; u < RW_SETS; ++u) RW_LOAD_SET(u, u * 8 + h);
    if (SM == 1) {
        for (int ch = 0; ch < T / 64; ch += 8) {
#pragma unroll
            for (int uu = 0; uu < 8; ++uu) { const int u = uu & 3; const int unit = (ch + uu) * 8 + h;
                bf16_t* sg = rws + (size_t)unit * 4096 + cq * 1024 + lane * 8;
                *(bf16x8*)(sg) = Bhi[0]; *(bf16x8*)(sg + 512) = Bhi[1];
#pragma unroll
                for (int ta = 0; ta < 4; ++ta) { Bhi[0] = Bhi[0] ^ An[u][ta][0]; Bhi[1] = Bhi[1] ^ An[u][ta][1]; Bhi[0][0] ^= (short)Zn[u][ta].x; }
                RW_LOAD_SET(u, (ch + uu + 4 < T / 64) ? unit + 32 : unit); } }
        return;
    }
    for (int ch = 0; ch < T / 64; ch += 32) {
#pragma unroll
        for (int uu = 0; uu < 32; ++uu) {
            const int u = uu % RW_SETS;
            const int unit = (ch + uu) * 8 + h;
            bf16_t* sg = rws + (size_t)unit * 4096 + cq * 1024 + lane * 8;
            *(bf16x8*)(sg) = Bhi[0]; *(bf16x8*)(sg + 512) = Bhi[1];
            f32x4 acc[4];
#pragma unroll
            for (int ta = 0; ta < 4; ++ta) { const u32x2 z = Zn[u][ta];
                acc[ta] = (f32x4){__uint_as_float(z.x << 16), __uint_as_float(z.x & 0xffff0000u), __uint_as_float(z.y << 16), __uint_as_float(z.y & 0xffff0000u)};
#pragma unroll
                for (int s = 0; s < 2; ++s) acc[ta] = __builtin_amdgcn_mfma_f32_16x16x32_bf16(An[u][ta][s], Bhi[s], acc[ta], 0, 0, 0); }
            if (SM == 0) RW_LOAD_SET(u, (ch + uu + RW_SETS < T / 64) ? unit + 8 * RW_SETS : unit);
#pragma unroll
            for (int s = 0; s < 2; ++s) { u32x4 hi;
                hi.x = pk2(acc[2 * s][0], acc[2 * s][1]); hi.y = pk2(acc[2 * s][2], acc[2 * s][3]); hi.z = pk2(acc[2 * s + 1][0], acc[2 * s + 1][1]); hi.w = pk2(acc[2 * s + 1][2], acc[2 * s + 1][3]);
                Bhi[s] = __builtin_bit_cast(bf16x8, hi); }
        }
    }
}
#undef RW_LOAD_SET

__device__ __forceinline__ void phase_rwkv_out(const Ctx& c, const Args& a, int layer, const bf16_t* proj, const bf16_t* rwu, const bf16_t* rws, const float* bonusg, bf16_t* orwkv) {
    const float* mu = inptr(c, I_MU) + (size_t)layer * 1792;
    const int lane = c.lane, m = lane & 15, q = lane >> 4;
    for (int unit = c.bid * 8 + c.wave; unit < 2048; unit += c.G * 8) {
        const int ch = unit >> 3, h = unit & 7, t0 = ch * 64; const bf16_t* ug = rwu + (size_t)unit * 16384; const bf16_t* sg = rws + (size_t)unit * 4096;
        bf16x8 Bf[4][2];
#pragma unroll
        for (int cq = 0; cq < 4; ++cq) { Bf[cq][0] = *(const bf16x8*)(sg + cq * 1024 + lane * 8); Bf[cq][1] = *(const bf16x8*)(sg + cq * 1024 + 512 + lane * 8); }
        float lnw[4], lnb[4];
#pragma unroll
        for (int cq = 0; cq < 4; ++cq) { lnw[cq] = inptr(c, I_LNW)[layer * 512 + h * 64 + 16 * cq + m]; lnb[cq] = inptr(c, I_LNB)[layer * 512 + h * 64 + 16 * cq + m]; }
        float muv[4];
#pragma unroll
        for (int cq = 0; cq < 4; ++cq) muv[cq] = mu[PC_V + h * 64 + 16 * cq + m];
#pragma unroll 1
        for (int ta = 0; ta < 4; ++ta) {
            const bf16x8 A0 = *(const bf16x8*)(ug + 8192 + (16 * ta + m) * 64 + 8 * q), A1 = *(const bf16x8*)(ug + 8192 + (16 * ta + m) * 64 + 32 + 8 * q);
            f32x4 y[4];
#pragma unroll
            for (int cq = 0; cq < 4; ++cq) { const u32x2 z = *(const u32x2*)(ug + 12288 + ((cq * 4 + ta) * 64 + lane) * 4);
                y[cq] = (f32x4){__uint_as_float(z.x << 16), __uint_as_float(z.x & 0xffff0000u), __uint_as_float(z.y << 16), __uint_as_float(z.y & 0xffff0000u)};
                y[cq] = __builtin_amdgcn_mfma_f32_16x16x32_bf16(A0, Bf[cq][0], y[cq], 0, 0, 0); y[cq] = __builtin_amdgcn_mfma_f32_16x16x32_bf16(A1, Bf[cq][1], y[cq], 0, 0, 0); }
            bf16_t vcur[4][4], vprv[4][4], graw[4][4]; float bonv[4];
#pragma unroll
            for (int r = 0; r < 4; ++r) { const int t = t0 + 16 * ta + 4 * q + r; bonv[r] = bonusg[(size_t)t * 8 + h];
#pragma unroll
                for (int cq = 0; cq < 4; ++cq) { const int col = h * 64 + 16 * cq + m; vcur[r][cq] = proj[(size_t)t * PLD + PC_V + col];
                    vprv[r][cq] = t > 0 ? proj[(size_t)(t - 1) * PLD + PC_V + col] : (bf16_t)0; graw[r][cq] = orwkv[(size_t)t * 512 + col]; } }
#pragma unroll
            for (int r = 0; r < 4; ++r) { const int t = t0 + 16 * ta + 4 * q + r;
                float sm = row16_sum(y[0][r] + y[1][r] + y[2][r] + y[3][r]);
                const float mean = sm * (1.0f / 64.0f); float d[4], vs = 0.f;
#pragma unroll
                for (int cq = 0; cq < 4; ++cq) { d[cq] = y[cq][r] - mean; vs += d[cq] * d[cq]; }
                vs = row16_sum(vs);
                const float rstd = rsqrtf(vs * (1.0f / 64.0f) + 64e-5f); const float bon = bonv[r];
#pragma unroll
                for (int cq = 0; cq < 4; ++cq) { const int col = h * 64 + 16 * cq + m; const float vc = bf2f(vcur[r][cq]); const float v = vc + (bf2f(vprv[r][cq]) - vc) * muv[cq];
                    orwkv[(size_t)t * 512 + col] = (bf16_t)f2bf((d[cq] * rstd * lnw[cq] + lnb[cq] + bon * v) * bf2f(graw[r][cq])); } }
        }
    }
}


constexpr int AT_K = 0, AT_V = 9216, AT_SCORE = 18432  , AT_UNUSED = 0;
__device__ __forceinline__ void vt_transpose(const Ctx& c, const bf16_t* proj, bf16_t* vt) {
    LAS bf16_t* tl = (LAS bf16_t*)c.lds;
    for (int it = c.bid; it < 3 * 2 * 256; it += c.G) {
        const int which = it / 512, g = (it >> 8) & 1, tt = it & 255;
        const int col = (which == 0 ? PC_VS : (which == 1 ? PC_VW : PC_SV)) + g * 64;
        { const int tok = c.tid >> 3, ch = c.tid & 7; const u32x4 w = *(const u32x4*)(proj + (size_t)(tt * 64 + tok) * PLD + col + ch * 8);
          *(LAS u32x4*)(tl + tok * 72 + ch * 8) = w; }
        __syncthreads();
        { const int d = c.tid >> 3, ch = c.tid & 7; unsigned short e[8];
#pragma unroll
          for (int k = 0; k < 8; ++k) e[k] = tl[(ch * 8 + k) * 72 + d];
          u32x4 w; w.x = e[0] | ((unsigned)e[1] << 16); w.y = e[2] | ((unsigned)e[3] << 16); w.z = e[4] | ((unsigned)e[5] << 16); w.w = e[6] | ((unsigned)e[7] << 16);
          *(u32x4*)(vt + ((size_t)(which * 2 + g) * 64 + d) * T + tt * 64 + ch * 8) = w; }
        __syncthreads();
    }
}

template <int MODE, int NQ, int DBG = 0>
__device__ __forceinline__ void phase_attn(const Ctx& c, const Args& a, int layer, const bf16_t* proj, const bf16_t* vtb, const bf16_t* kcb, const bf16_t* vctb,
                                           unsigned* sel, float* nsaacc, bf16_t* oout) {
    LAS unsigned char* L = c.lds;
    LAS float* sscore = (LAS float*)(L + AT_SCORE);
    constexpr int NT = (MODE == 2) ? 2856 : 1160, DOFF = (MODE == 2) ? 1823 : 1023;
    constexpr int A_BIAS = (MODE == 2) ? 83968 : 110592, A_SELM = A_BIAS + 16 * NT, A_LIST = A_SELM + 2048, A_NLIST = A_LIST + 1024, A_NEED = A_NLIST + 32, A_REL = A_NEED + 96;
    static_assert(A_REL + 2048 <= LDS_MISC, "attention LDS map");
    LAS float* biasd = (LAS float*)(L + A_BIAS);
    LAS unsigned* selm = (LAS unsigned*)(L + A_SELM);
    LAS int* list = (LAS int*)(L + A_LIST);
    LAS int* nlist = (LAS int*)(L + A_NLIST);
    LAS unsigned* need = (LAS unsigned*)(L + A_NEED);
    const int lane = c.lane, wave = c.wave, n = lane & 15, q = lane >> 4, hr = n & 3;
    LAS float* reltab = (LAS float*)(L + A_REL);
    __syncthreads();
    reltab[c.tid] = inptr(c, I_REL)[c.tid];
    constexpr int TW = 4 * NQ, TB = 8 * TW, NU = T / TB, TS = (MODE == 3) ? 6 : 1;
    for (int unit = c.bid; unit < 2 * NU; unit += c.G) {
        const int g = unit / NU, t0 = ((g == 0) ? (unit % NU) : (NU - 1 - unit % NU)) * TB, tw0 = t0 + wave * TW;
        __syncthreads();
        for (int e = c.tid; e < 4 * NT; e += 512) { const int r = e / NT, dist = DOFF - (e - r * NT); const bool vis = dist >= 0 && (MODE != 0 || dist < 128) && (MODE != 1 || dist < 512);
            biasd[e] = vis ? reltab[t5_bucket(dist > 1023 ? 1023 : dist) * 16 + (MODE == 0 ? 8 : 0) + g * 4 + r] : -1e30f; }
        if (MODE == 3) {
            if (c.tid < 8) need[c.tid] = 0u;
            __syncthreads();
            { const int tok = c.tid >> 3, w8 = c.tid & 7; const unsigned mw = selp((unsigned char*)sel, t0 + tok, g)[w8]; selm[tok * 8 + w8] = mw; atomicOr((unsigned*)&need[w8], mw); }
            __syncthreads();
            if (c.tid < 256) { const int j = c.tid; const unsigned wd = need[j >> 5];
                if ((wd >> (j & 31)) & 1u) { int pos = __popc(wd & ((1u << (j & 31)) - 1u)); for (int w2 = 0; w2 < (j >> 5); ++w2) pos += __popc(need[w2]); list[pos] = j; } }
            if (c.tid == 0) { int cnt = 0; for (int w2 = 0; w2 < 8; ++w2) cnt += __popc(need[w2]); nlist[0] = cnt; }
        }
        __syncthreads();
        int ntiles, tile_lo = 0;
        if (MODE == 0) { ntiles = 2 + TB / 64; tile_lo = t0 - 128; }
        else if (MODE == 1) { ntiles = 8 + TB / 64; tile_lo = t0 - 512; }
        else if (MODE == 2) { const int cmax = (t0 + TB - 1 - 31) >> 4; ntiles = cmax < 0 ? 0 : (cmax >> 6) + 1; }
        else ntiles = nlist[0];
        const bf16_t* Ksrc; size_t kstride; const bf16_t* Vsrc; size_t vstride; int qcol;
        if (MODE == 0) { Ksrc = proj + PC_SK + g * 64; kstride = PLD; Vsrc = vtb + (size_t)(4 + g) * 64 * T; vstride = T; qcol = PC_SQ + g * 256; }
        else if (MODE == 1) { Ksrc = proj + PC_KW + g * 64; kstride = PLD; Vsrc = vtb + (size_t)(2 + g) * 64 * T; vstride = T; qcol = PC_NQ + g * 256; }
        else if (MODE == 2) { Ksrc = kcb + (size_t)g * 1024 * 64; kstride = 64; Vsrc = vctb + (size_t)g * 64 * 1024; vstride = 1024; qcol = PC_NQ + g * 256; }
        else { Ksrc = proj + PC_KS + g * 64; kstride = PLD; Vsrc = vtb + (size_t)(0 + g) * 64 * T; vstride = T; qcol = PC_NQ + g * 256; }
        bf16x8 Bq[NQ][2];
#pragma unroll
        for (int qd = 0; qd < NQ; ++qd) { const bf16_t* qp = proj + (size_t)(tw0 + 4 * qd + (n >> 2)) * PLD + qcol + hr * 64 + 8 * q;
            Bq[qd][0] = *(const bf16x8*)qp; Bq[qd][1] = *(const bf16x8*)(qp + 32); }
        const float bfar = reltab[31 * 16 + (MODE == 0 ? 8 : 0) + g * 4 + hr];
        float mrun[NQ], lrun[NQ]; f32x4 O[NQ][4];
#pragma unroll
        for (int qd = 0; qd < NQ; ++qd) { mrun[qd] = -1e30f; lrun[qd] = 0.f;
#pragma unroll
            for (int dt = 0; dt < 4; ++dt) O[qd][dt] = (f32x4){0.f, 0.f, 0.f, 0.f}; }
        float carry3[NQ]; for (int i = 0; i < NQ; ++i) carry3[i] = 0.f;
        const int npass = (MODE == 2) ? 2 : 1;
        for (int pass = 0; pass < npass; ++pass) {
            const bool do_pv = (MODE != 2) || pass == 1;
            float linv[NQ];
            if (MODE == 2 && pass == 1) {
#pragma unroll
                for (int qd = 0; qd < NQ; ++qd) { float mt = mrun[qd]; mt = fmaxf(mt, __shfl_xor(mt, 16)); mt = fmaxf(mt, __shfl_xor(mt, 32));
                    float lt = lrun[qd] * __expf(mrun[qd] - mt); lt += __shfl_xor(lt, 16); lt += __shfl_xor(lt, 32); mrun[qd] = mt; linv[qd] = lt > 0.f ? 1.0f / lt : 0.f; }
            }
#define AT_TILEPOS(ti) ((MODE == 3) ? list[ti] * 64 : (MODE == 2 ? (ti) * 64 : tile_lo + (ti) * 64))
#define AT_ISSUE(rd) do { _Pragma("unroll") for (int i_ = 0; i_ < TS; ++i_) { const int ti_ = (rd) * TS + i_; p0n[i_] = ti_ < ntiles ? AT_TILEPOS(ti_) : -1; \
        if (p0n[i_] >= 0) { kreg[i_] = *(const u32x4*)((Ksrc + (size_t)p0n[i_] * kstride) + kthr); \
            if (do_pv) vreg[i_] = *(const u32x4*)((Vsrc + p0n[i_]) + vthr); } } } while (0)
            const unsigned kthr = (unsigned)(c.tid >> 3) * (unsigned)kstride + (unsigned)(c.tid & 7) * 8u, vthr = (unsigned)(c.tid >> 3) * (unsigned)vstride + (unsigned)(c.tid & 7) * 8u;
            int st_k, st_va;
            { const int row = c.tid >> 3, cj = c.tid & 7, ga = 2 * cj;
              st_k = row * 128 + (((cj ^ row) & 7) << 4);
              st_va = row * 128 + (((((ga >> 3) * 4 + (ga & 3)) ^ row) & 7) << 4) + ((ga >> 2) & 1) * 8; }
            u32x4 kreg[TS], vreg[TS]; int p0n[TS];
            const int nrounds = (ntiles + TS - 1) / TS;
            if (nrounds > 0) AT_ISSUE(0);
            for (int rd = 0; rd < nrounds; ++rd) {
                int p0s[TS];
#pragma unroll
                for (int i = 0; i < TS; ++i) p0s[i] = p0n[i];
                __syncthreads();
#pragma unroll
                for (int i = 0; i < TS; ++i) if (p0s[i] >= 0) {
                    *(LAS u32x4*)(L + AT_K + i * 18432 + st_k) = kreg[i];
                    if (do_pv) { const u32x2 lo = {vreg[i].x, vreg[i].y}, hi = {vreg[i].z, vreg[i].w};
                        *(LAS u32x2*)(L + AT_V + i * 18432 + st_va) = lo; *(LAS u32x2*)(L + AT_V + i * 18432 + (st_va ^ 16)) = hi; } }
                if (rd + 1 < nrounds) AT_ISSUE(rd + 1);
                __syncthreads();
#pragma unroll
              for (int ts = 0; ts < TS; ++ts) {
                const int p0 = p0s[ts]; const int LK = AT_K + ts * 18432, LV = AT_V + ts * 18432;
                if (p0 < 0) continue;
                if (MODE == 0) { if (p0 > tw0 + TW - 1 || p0 + 63 < tw0 - 127) continue; }
                if (MODE == 1) { if (p0 > tw0 + TW - 1 || p0 + 63 < tw0 - 511) continue; }
                if (MODE == 2) { if (16 * p0 + 31 > tw0 + TW - 1) continue; }
                if (MODE == 3) { if (p0 > tw0 + TW - 1) continue; }
                const bool far = (MODE == 2) ? (tw0 - (16 * (p0 + 63) + 31) >= 790) : ((MODE == 3) ? (tw0 - (p0 + 63) >= 790) : false);
                const int jblk = p0 >> 6;
                bf16x8 akf[4][2]; bf16x8 avf[2][4];
                if (MODE != 3) {
#pragma unroll
                    for (int kt = 0; kt < 4; ++kt)
#pragma unroll
                        for (int ks = 0; ks < 2; ++ks) akf[kt][ks] = *(const LAS bf16x8*)(L + LK + (16 * kt + n) * 128 + ((((4 * ks + q) ^ n) & 7) << 4));
                    if (do_pv) {
#pragma unroll
                        for (int st = 0; st < 2; ++st)
#pragma unroll
                            for (int dt = 0; dt < 4; ++dt) avf[st][dt] = *(const LAS bf16x8*)(L + LV + (16 * dt + n) * 128 + ((((4 * st + q) ^ n) & 7) << 4)); }
                }
                unsigned tokmask = 0u;
                if (MODE == 3) { tokmask = (unsigned)__ballot(lane < TW && ((selm[(wave * TW + (lane & (TW - 1))) * 8 + (jblk >> 5)] >> (jblk & 31)) & 1u)); if (tokmask == 0u) continue; }
#pragma unroll
                for (int qd = 0; qd < NQ; ++qd) {
                    const int tq = tw0 + 4 * qd + (n >> 2);
                    if (DBG == 3) continue;
                    bool colsel = true;
                    if (MODE == 3) { colsel = (tokmask >> (4 * qd + (n >> 2))) & 1u; if (((tokmask >> (4 * qd)) & 0xfu) == 0u) continue; }
                    {
                        f32x4 sc[4];
#pragma unroll
                        for (int kt = 0; kt < 4; ++kt) { sc[kt] = (f32x4){0.f, 0.f, 0.f, 0.f};
#pragma unroll
                            for (int ks = 0; ks < 2; ++ks) { const bf16x8 ak = (MODE != 3) ? akf[kt][ks] : *(const LAS bf16x8*)(L + LK + (16 * kt + n) * 128 + ((((4 * ks + q) ^ n) & 7) << 4));
                                sc[kt] = __builtin_amdgcn_mfma_f32_16x16x32_bf16(ak, Bq[qd][ks], sc[kt], 0, 0, 0); } }
                        if (!far) {
                            const LAS float* tp = (MODE == 2) ? biasd + hr * NT + (DOFF - tq + 31 + 16 * p0) + 64 * q : biasd + hr * NT + (DOFF - tq + p0) + 4 * q;
#pragma unroll
                            for (int kt = 0; kt < 4; ++kt)
#pragma unroll
                                for (int r = 0; r < 4; ++r) sc[kt][r] += (MODE == 2) ? tp[256 * kt + 16 * r] : tp[16 * kt + r];
                        }
                        const float bshift = far ? bfar : 0.f, boff = bshift * 1.4426950408889634f;
                        float mx;
                        { float m = fmaxf(fmaxf(sc[0][0], sc[0][1]), sc[0][2]);
                          m = fmaxf(fmaxf(m, sc[0][3]), sc[1][0]); m = fmaxf(fmaxf(m, sc[1][1]), sc[1][2]); m = fmaxf(fmaxf(m, sc[1][3]), sc[2][0]);
                          m = fmaxf(fmaxf(m, sc[2][1]), sc[2][2]); m = fmaxf(fmaxf(m, sc[2][3]), sc[3][0]); m = fmaxf(fmaxf(m, sc[3][1]), sc[3][2]); mx = fmaxf(m, sc[3][3]) + bshift; }
                        if (MODE == 3 && !colsel) mx = -1e30f;
                        float p[4][4];
                        constexpr float L2E = 1.4426950408889634f;
                        if (MODE == 2 && pass == 1) {
                            const float negm1 = (mrun[qd] < -1e29f ? 0.f : -mrun[qd] * L2E) + boff;
#pragma unroll
                            for (int kt = 0; kt < 4; ++kt)
#pragma unroll
                                for (int r = 0; r < 4; ++r) p[kt][r] = __builtin_amdgcn_exp2f(__builtin_fmaf(sc[kt][r], L2E, negm1)) * linv[qd];
                        } else if (MODE == 2) {
                            const float mn = fmaxf(mrun[qd], mx), corr = __expf(mrun[qd] - mn); mrun[qd] = mn; float ps = 0.f;
                            const float negm0 = (mn < -1e29f ? 0.f : -mn * L2E) + boff;
#pragma unroll
                            for (int kt = 0; kt < 4; ++kt)
#pragma unroll
                                for (int r = 0; r < 4; ++r) ps += __builtin_amdgcn_exp2f(__builtin_fmaf(sc[kt][r], L2E, negm0));
                            lrun[qd] = lrun[qd] * corr + ps;
                        } else {
                            if (__any(mx > mrun[qd])) {
                                mx = fmaxf(mx, __shfl_xor(mx, 16)); mx = fmaxf(mx, __shfl_xor(mx, 32));
                                const float mn = fmaxf(mrun[qd], mx), corr = __expf(mrun[qd] - mn); mrun[qd] = mn;
                                lrun[qd] *= corr;
#pragma unroll
                                for (int dt = 0; dt < 4; ++dt) O[qd][dt] = O[qd][dt] * corr;
                            }
                            float negm = (mrun[qd] < -1e29f ? 0.f : -mrun[qd] * L2E) + boff; float ps = 0.f;
                            if (MODE == 3 && !colsel) negm = -__builtin_inff();
#pragma unroll
                            for (int kt = 0; kt < 4; ++kt)
#pragma unroll
                                for (int r = 0; r < 4; ++r) { p[kt][r] = (DBG == 2) ? sc[kt][r] + negm : __builtin_amdgcn_exp2f(__builtin_fmaf(sc[kt][r], L2E, negm)); ps += p[kt][r]; }
                            lrun[qd] += ps;
                        }
                        if (MODE == 2 && pass == 1) {
                            float i3prev = carry3[qd];
#pragma unroll
                            for (int kt = 0; kt < 4; ++kt) { float im[4];
#pragma unroll
                                for (int r = 0; r < 4; ++r) { float v = p[kt][r]; v += dpp_xor1(v); v += dpp_xor2(v); im[r] = v; }
                                const float same = __shfl(im[3], (lane + 48) & 63), prevt = __shfl(i3prev, (lane + 48) & 63);
                                const float pv3 = q > 0 ? same : prevt;
                                const int jg = (p0 + 16 * kt + 4 * q) >> 2;
                                if (hr == 0 && jg < 256) sscore[(tq - t0) * 256 + jg] = 2.0f * (im[0] + im[1] + im[2]) + im[3] + pv3;
                                i3prev = im[3]; }
                            carry3[qd] = i3prev;
                        }
                        if (do_pv && DBG != 1) {
#pragma unroll
                            for (int st = 0; st < 2; ++st) {
                                u32x4 pw; pw.x = pk2(p[2 * st][0], p[2 * st][1]); pw.y = pk2(p[2 * st][2], p[2 * st][3]); pw.z = pk2(p[2 * st + 1][0], p[2 * st + 1][1]); pw.w = pk2(p[2 * st + 1][2], p[2 * st + 1][3]);
                                const bf16x8 pf = __builtin_bit_cast(bf16x8, pw);
#pragma unroll
                                for (int dt = 0; dt < 4; ++dt) { bf16x8 av;
                                    if (MODE != 3) av = avf[st][dt];
                                    else av = *(const LAS bf16x8*)(L + LV + (16 * dt + n) * 128 + ((((4 * st + q) ^ n) & 7) << 4));
                                    O[qd][dt] = __builtin_amdgcn_mfma_f32_16x16x32_bf16(av, pf, O[qd][dt], 0, 0, 0); } }
                        }
                    }
                }
              }
            }
        }
#undef AT_ISSUE
#undef AT_TILEPOS
        if (MODE == 2) {
            __syncthreads();
#pragma unroll 1
            for (int tk = 0; tk < TW; ++tk) { const int t = tw0 + tk, cur = t >> 6; const LAS float* sp = sscore + (wave * TW + tk) * 256;
                unsigned key[4]; bool forced[4];
#pragma unroll
                for (int jj = 0; jj < 4; ++jj) { const int j = lane + 64 * jj; forced[jj] = (j == 0 || j == cur || j == cur - 1);
                    key[jj] = (!forced[jj] && j < cur - 1) ? __float_as_uint(sp[j]) + 1u : 0u; }
                const int nforced = cur >= 2 ? 3 : cur + 1;
                unsigned prefix = 0u; int remaining = 16 - nforced;
#pragma unroll 1
                for (int bit = 30; bit >= 0; --bit) { const unsigned test = prefix | (1u << bit); int cnt = 0;
#pragma unroll
                    for (int jj = 0; jj < 4; ++jj) cnt += __popcll(__ballot((key[jj] >> bit) == (test >> bit)));
                    if (cnt >= remaining) prefix = test; else remaining -= cnt; }
                int eqbase = 0;
#pragma unroll
                for (int jj = 0; jj < 4; ++jj) { const bool eq = key[jj] == prefix && key[jj] != 0u; const unsigned long long eb = __ballot(eq);
                    const int eqrank = eqbase + __popcll(eb & ((1ull << lane) - 1ull)); eqbase += __popcll(eb);
                    const bool on = forced[jj] || key[jj] > prefix || (eq && eqrank < remaining); const unsigned long long bl = __ballot(on);
                    if (lane == 0) { unsigned* mp = selp((unsigned char*)sel, t, g); mp[2 * jj] = (unsigned)bl; mp[2 * jj + 1] = (unsigned)(bl >> 32); } }
            }
        }
#pragma unroll
        for (int qd = 0; qd < NQ; ++qd) {
            const int tq = tw0 + 4 * qd + (n >> 2), hh = g * 4 + hr;
            float scale;
            if (MODE == 2) scale = 1.0f;
            else { float lt = lrun[qd]; lt += __shfl_xor(lt, 16); lt += __shfl_xor(lt, 32);
                if (MODE == 0) { const float sink = inptr(c, I_SINK)[layer * 8 + hh]; const float mf = fmaxf(mrun[qd], sink), cr = __expf(mrun[qd] - mf); scale = cr / (lt * cr + __expf(sink - mf)); }
                else scale = lt > 0.f ? 1.0f / lt : 0.f; }
            if (MODE != 0) scale *= sigmoidf_(bf2f(proj[(size_t)tq * PLD + PC_GL + (MODE == 2 ? 0 : (MODE == 3 ? 8 : 16)) + hh]));
#pragma unroll
            for (int dt = 0; dt < 4; ++dt) { const f32x4 o = O[qd][dt] * scale; const int col = hh * 64 + 16 * dt + 4 * q;
                if (MODE == 0) { u32x2 w; w.x = pk2(o[0], o[1]); w.y = pk2(o[2], o[3]); *(u32x2*)(oout + (size_t)tq * 512 + col) = w; }
                else if (MODE == 2) *(f32x4*)(nsaacc + (size_t)tq * 512 + col) = o;
                else if (MODE == 1) { f32x4* ap = (f32x4*)(nsaacc + (size_t)tq * 512 + col); *ap = *ap + o; }
                else { const f32x4 t2 = *(const f32x4*)(nsaacc + (size_t)tq * 512 + col) + o; u32x2 w; w.x = pk2(t2[0], t2[1]); w.y = pk2(t2[2], t2[3]); *(u32x2*)(oout + (size_t)tq * 512 + col) = w; } }
        }
    }
}
#define wb ((bf16_t*)(ws + WS_WB))
#define xb ((bf16_t*)(ws + WS_XB))
#define cntp ((unsigned*)(ws + WS_CNT))
#define xres (args.out)
#define kcb ((bf16_t*)(ws + WS_KCB))
#define vctb ((bf16_t*)(ws + WS_VCT))
#define vtb ((bf16_t*)(ws + WS_VT))
#define scores ((float*)(ws + WS_SCORES))
#define sel ((unsigned*)ws)
#define ml ((float*)(ws + WS_ML))
#define hidb ((bf16_t*)(ws + WS_HID))
#define proj ((bf16_t*)(ws + WS_PROJ))
#define gates ((bf16_t*)(ws + WS_GATES))
#define merged ((bf16_t*)(ws + WS_MERGED))
#define tmpb ((bf16_t*)(ws + WS_TMPB))
#define alora ((bf16_t*)(ws + WS_ALORA))
#define rwu ((bf16_t*)(ws + WS_RWU))
#define rws ((bf16_t*)(ws + WS_RWS))
#define bonusg ((float*)(ws + WS_BONUS))
#define nsaacc ((float*)(ws + WS_NSAACC))
#define obuf ((bf16_t*)(ws + WS_O))
#define act ((bf16_t*)(ws + WS_ACT))
#define tmpf ((bf16_t*)(ws + WS_TMPF))
constexpr int PH_PER_BATCH = 8, PH_PER_LAYER = 1 + 2 * PH_PER_BATCH + 2, PH_TOTAL = 1 + DEPTH * PH_PER_LAYER;

__global__ void __launch_bounds__(512, 2) fwd_kernel(Args args) {
    extern __shared__ __attribute__((aligned(16))) unsigned char lds_raw[];
    Ctx c0; c0.lds = (LAS unsigned char*)lds_raw; c0.tid = threadIdx.x; c0.lane = c0.tid & 63; c0.wave = __builtin_amdgcn_readfirstlane(c0.tid >> 6); c0.G = gridDim.x; c0.bid = blockIdx.x; const Ctx& c = c0;
    unsigned char* ws = args.ws;
    volatile LAS unsigned* misc = (volatile LAS unsigned*)(c.lds + LDS_MISC);
    if (c.tid < 4) misc[c.tid] = 0u;
    if (c.tid < 30) { const unsigned long long pv = (unsigned long long)args.in[c.tid & 31]; misc[16 + 2 * c.tid] = (unsigned)pv; misc[17 + 2 * c.tid] = (unsigned)(pv >> 32); }
    __syncthreads();
    XcdBarrier bar; bar.bar = (unsigned*)(ws + WS_CTL); bar.x = 0; bar.st = misc;
    const int lo = args.lo, hi = args.hi;
    const bool multi = (hi - lo) > 1;
    if (multi) bar = xcd_barrier_post((unsigned*)(ws + WS_CTL), misc);
    int gp = 0;
#ifndef ONLY_PH
#define ONLY_PH -1
#endif
#ifndef PHMASK
#define PHMASK 0xffffff
#endif
#ifndef REPMASK
#define REPMASK 0
#endif
#ifndef PR_SEL
#define PR_SEL 0
#endif
#ifndef PR_SWA
#define PR_SWA 0
#endif
#ifndef PR_CMP
#define PR_CMP 0
#endif
#ifndef PR_CHUNK
#define PR_CHUNK 0
#endif
#define PHASE_BEGIN(id) if (gp >= lo && gp < hi) { for (int rep_ = 0; rep_ < (((REPMASK >> (id)) & 1) ? 2 : 1); ++rep_) { if (rep_) __syncthreads(); \
    Ctx pc = c0; asm volatile("" : "+v"(pc.tid), "+s"(pc.bid)); pc.lane = pc.tid & 63; pc.wave = __builtin_amdgcn_readfirstlane(pc.tid >> 6); const Ctx& c = pc;
#define PHASE_END   } if (gp + 1 < hi) xcd_barrier(bar); } ++gp;
#define RELAUNDER() do { asm volatile("" : "+v"(pc.tid), "+s"(pc.bid)); pc.lane = pc.tid & 63; pc.wave = __builtin_amdgcn_readfirstlane(pc.tid >> 6); } while (0)

    PHASE_BEGIN(0) phase_init(c, inptr(c, I_X), xres, xb, ws); PHASE_END

    for (int layer = 0; layer < DEPTH; ++layer) {
        PHASE_BEGIN(1) phase_cvt(c, args, layer, wb); PHASE_END
        for (int b = 0; b < NBATCH; ++b) {
            const int row0 = b * T;
            PHASE_BEGIN(2) {
                pg8::Gemm g{xb + (size_t)row0 * D, wb + WB_WIN, D, D, D}; pg8::Sched S; S.init(T / 256, NIN / 256, c.G, c.bid, 1, (size_t)256 * D * 2, 0, (size_t)256 * D * 2, 0);
                pg8::EpiInProj E{proj, gates, ws, row0}; pg8::gemm_phase(c.lds, c.tid, g, S, E); } PHASE_END
            PHASE_BEGIN(16) {
                { pg8::Gemm g{proj, wb + WB_W1T, 16 * PLD, 2048, 2048, (unsigned)PLD * 2}; pg8::Sched S; S.init(16, 1, c.G, c.bid, 1, 0, 0, 0, 0); S.mode = 1;
                  pg8::EpiCmp1 E{hidb, (const float*)(wb + WB_BH)}; pg8::gemm_phase(c.lds, c.tid, g, S, E); }
                RELAUNDER();
                if (c.bid >= 16) { Ctx cv = c; cv.bid = c.bid - 16; cv.G = c.G - 16; phase_lora_a(cv, args, layer, proj, alora); vt_transpose(cv, proj, vtb); } } PHASE_END
            PHASE_BEGIN(17) {
                { pg8::Gemm g{alora, wb + WB_LORA, 256, 256, 256}; pg8::Sched S; S.init(T / 256, 6, c.G, c.bid, 1, (unsigned)256 * 256 * 2, 0, (unsigned)256 * 256 * 2, 0);
                  pg8::EpiLora E{obuf}; pg8::gemm_phase(c.lds, c.tid, g, S, E); }
                RELAUNDER();
                { pg8::Gemm g{hidb, wb + WB_W2T, 256, 256, 256}; pg8::Sched S; S.init(16, 1, c.G, (c.bid + 16) % c.G, 1, (unsigned)256 * 256 * 2, 0, 0, 0); S.mode = 2;
                  pg8::EpiCmp2 E{kcb, vctb}; pg8::gemm_phase(c.lds, c.tid, g, S, E); } } PHASE_END
            PHASE_BEGIN(18) {
                for (int pr_ = 0; pr_ <= PR_CHUNK; ++pr_) { phase_rwkv_chunk(c, args, layer, proj, obuf + (size_t)T * 512, obuf + (size_t)2 * T * 512, rwu, bonusg);
                __syncthreads(); RELAUNDER(); }
                for (int pr_ = 0; pr_ <= PR_CMP; ++pr_) { phase_attn<2, 2>(c, args, layer, proj, vtb, kcb, vctb, sel, nsaacc, obuf + (size_t)T * 512); __syncthreads(); } } PHASE_END
            PHASE_BEGIN(19) {
                phase_rwkv_scan<0>(c, rwu, rws);
#ifdef PR_SCAN
                phase_rwkv_scan<0>(c, rwu, rws);
#endif
                RELAUNDER();
                if (c.bid >= 32) { Ctx cv = c; cv.bid = c.bid - 32; cv.G = c.G - 32;
                    phase_attn<1, 2>(cv, args, layer, proj, vtb, kcb, vctb, sel, nsaacc, obuf + (size_t)T * 512);
                    asm volatile("" : "+v"(cv.tid), "+s"(cv.bid)); cv.lane = cv.tid & 63; cv.wave = __builtin_amdgcn_readfirstlane(cv.tid >> 6);

#if PR_SWA > 1
                    { phase_attn<0, 2, PR_SWA - 1>(cv, args, layer, proj, vtb, kcb, vctb, sel, nsaacc, obuf + (size_t)2 * T * 512); __syncthreads(); }
#endif
                    for (int pr_ = 0; pr_ <= (PR_SWA == 1 ? 1 : 0); ++pr_) { phase_attn<0, 2>(cv, args, layer, proj, vtb, kcb, vctb, sel, nsaacc, obuf + (size_t)2 * T * 512); __syncthreads(); } } } PHASE_END
            PHASE_BEGIN(9) {
                phase_rwkv_out(c, args, layer, proj, rwu, rws, bonusg, obuf);
                __syncthreads(); RELAUNDER();
                #if PR_SEL > 1
                { phase_attn<3, 2, PR_SEL - 1>(c, args, layer, proj, vtb, kcb, vctb, sel, nsaacc, obuf + (size_t)T * 512); __syncthreads(); }
#endif
                for (int pr_ = 0; pr_ <= (PR_SEL == 1 ? 1 : 0); ++pr_) { phase_attn<3, 2>(c, args, layer, proj, vtb, kcb, vctb, sel, nsaacc, obuf + (size_t)T * 512); __syncthreads(); } } PHASE_END
            PHASE_BEGIN(10) {
                pg8::Gemm g{obuf, wb + WB_WBR, 512, 512, 512}; pg8::Sched S; S.init(T / 256, D / 256, c.G, c.bid, 3, (size_t)256 * 512 * 2, (size_t)T * 512 * 2, (size_t)256 * 512 * 2, (size_t)D * 512 * 2);
                pg8::EpiMerge E{gates, merged}; pg8::gemm_phase(c.lds, c.tid, g, S, E); } PHASE_END
            PHASE_BEGIN(11) {
                pg8::Gemm g{merged, wb + WB_WOUT, D, D, D}; pg8::Sched S; S.init(T / 256, D / 256, c.G, c.bid, 1, (unsigned)256 * D * 2, 0, (unsigned)256 * D * 2, 0);
                pg8::EpiNorm E{xres, xb, inptr(c, I_NQM) + layer * D, ws, cntp, row0, 1, 16u * (2u * layer + 1u), c.lds, c.tid}; pg8::gemm_phase(c.lds, c.tid, g, S, E); } PHASE_END
        }
        PHASE_BEGIN(13) {
            pg8::Gemm g{xb, wb + WB_WGU, D, D, D}; pg8::Sched S; S.init(MROWS / 256, 2 * FFN / 256, c.G, c.bid, 1, (size_t)256 * D * 2, 0, (size_t)256 * D * 2, 0);
            pg8::EpiSwiGLU E{act, ws}; pg8::gemm_phase(c.lds, c.tid, g, S, E); } PHASE_END
        PHASE_BEGIN(14) {
            { pg8::Gemm g{act, wb + WB_WDN, FFN, FFN, FFN}; pg8::Sched S; S.init(T / 256, D / 256, c.G, c.bid, 1, (unsigned)256 * FFN * 2, 0, (unsigned)256 * FFN * 2, 0);
              pg8::EpiNorm E{xres, xb, inptr(c, I_NQF) + layer * D, ws, cntp, 0, 0, 16u * (2u * layer + 2u), c.lds, c.tid}; pg8::gemm_phase(c.lds, c.tid, g, S, E); }
            __syncthreads(); RELAUNDER();
            { pg8::Gemm g{act + (size_t)T * FFN, wb + WB_WDN, FFN, FFN, FFN}; pg8::Sched S; S.init(T / 256, D / 256, c.G, c.bid, 1, (unsigned)256 * FFN * 2, 0, (unsigned)256 * FFN * 2, 0);
              pg8::EpiNorm E{xres, xb, inptr(c, I_NQF) + layer * D, ws, cntp, T, 0, 16u * (2u * layer + 2u), c.lds, c.tid}; pg8::gemm_phase(c.lds, c.tid, g, S, E); } } PHASE_END
    }
#undef PHASE_BEGIN
#undef PHASE_END
}

extern "C" void kernel_launch(void* const* d_in, const int* in_sizes, int n_in, void* d_out, int out_size, void* d_ws, size_t ws_size, hipStream_t stream) {
    static int grid = 0;
    if (grid == 0) {
        if (n_in != 30 || out_size != MROWS * D || ws_size < WS_END) { fprintf(stderr, "kernel_launch: unexpected shapes (n_in %d out %d ws %zu)\n", n_in, out_size, ws_size); grid = -1; return; }
        int dev = 0, cus = 0;
        if (hipGetDevice(&dev) != hipSuccess || hipDeviceGetAttribute(&cus, hipDeviceAttributeMultiprocessorCount, dev) != hipSuccess) { grid = -1; return; }
        if (hipFuncSetAttribute((const void*)fwd_kernel, hipFuncAttributeMaxDynamicSharedMemorySize, LDS_BYTES) != hipSuccess) { fprintf(stderr, "hipFuncSetAttribute failed\n"); grid = -1; return; }
        int per_cu = 0;
        if (hipOccupancyMaxActiveBlocksPerMultiprocessor(&per_cu, (const void*)fwd_kernel, 512, LDS_BYTES) != hipSuccess || per_cu < 1) { fprintf(stderr, "occupancy query: %d\n", per_cu); }
        (void)hipGetLastError();
        grid = cus;
    }
    if (grid < 0) return;
    (void)hipMemsetAsync((char*)d_ws + WS_CTL, 0, CTL_BYTES, stream);
    Args a{};
    for (int i = 0; i < 30; ++i) a.in[i] = (const float*)d_in[i];
    a.out = (float*)d_out; a.ws = (unsigned char*)d_ws;
#if MK_ONE_LAUNCH
    a.lo = 0; a.hi = PH_TOTAL;
    hipLaunchKernelGGL(fwd_kernel, dim3(grid), dim3(512), LDS_BYTES, stream, a);
#else
    for (int p = 0; p < PH_TOTAL; ++p) { a.lo = p; a.hi = p + 1; hipLaunchKernelGGL(fwd_kernel, dim3(grid), dim3(512), LDS_BYTES, stream, a); }
#endif
}
```
